# Optimizing an MI355X kernel written in HIP

```python
import math
import jax, jax.numpy as jnp
from jax import lax
import numpy as np

D_MODEL = 1024
BATCH = 8
SEQ = 2048
DEPTH = 2

GRID_W = 64
CTX_LEN = 256
HEAD_DIM = 64
A_HEADS = 4
A_VDIM = 2 * HEAD_DIM
B_HEADS = 8
B_KV_HEADS = 2
C_HEADS = 8
D_GROUPS = 4
D_GROUP_DIM = 128
POOL_WINDOWS = (2, 4, 8, 16)
NA_ROWS = 8
NA_COLS = 16
N_EXPERTS = 16
EXPERT_FF = 2048
EC_FACTOR = 2
Q_BLOCK = 128
ROPE_THETA = 10000.0
ROPE_AXIS_DIM = HEAD_DIM // 2
LN_EPS = 1e-5
RMS_EPS = 1e-6
DEEPNORM_ALPHA = (2 * DEPTH) ** 0.25
DEEPNORM_BETA = (8 * DEPTH) ** -0.25

A_Q = A_HEADS * 2 * HEAD_DIM
A_K = A_HEADS * 2 * HEAD_DIM
A_V = A_HEADS * A_VDIM
B_Q = B_HEADS * HEAD_DIM
B_K = B_KV_HEADS * HEAD_DIM
B_V = B_KV_HEADS * HEAD_DIM
EVEN_IN = A_Q + A_K + A_V + B_Q + B_K + B_V
EVEN_SPLITS = (A_Q, A_Q + A_K, A_Q + A_K + A_V, A_Q + A_K + A_V + B_Q, A_Q + A_K + A_V + B_Q + B_K)
EVEN_MIX = A_V + B_Q
C_W = C_HEADS * HEAD_DIM
D_W = D_GROUPS * D_GROUP_DIM
ODD_IN = 3 * C_W + D_W
ODD_MIX = C_W + D_W

kernel_name = "hybrid_diffattn_gqa_natten_pool_ecmoe_dit"


def layer_norm(x, g, b):
    xf = x.astype(jnp.float32)
    mu = jnp.mean(xf, axis=-1, keepdims=True)
    var = jnp.mean(jnp.square(xf - mu), axis=-1, keepdims=True)
    return ((xf - mu) * lax.rsqrt(var + LN_EPS) * g + b).astype(x.dtype)


def rms_norm(x, g):
    xf = x.astype(jnp.float32)
    return (xf * lax.rsqrt(jnp.mean(jnp.square(xf), axis=-1, keepdims=True) + RMS_EPS) * g).astype(x.dtype)


def softmax_f32(s, dtype):
    return jax.nn.softmax(s.astype(jnp.float32), axis=-1).astype(dtype)


def rope_angles(n_tokens):
    t = jnp.arange(n_tokens, dtype=jnp.int32)
    n_freq = ROPE_AXIS_DIM // 2
    inv = ROPE_THETA ** (-jnp.arange(n_freq, dtype=jnp.float32) / n_freq)
    ang_r = (t // GRID_W).astype(jnp.float32)[:, None] * inv
    ang_c = (t % GRID_W).astype(jnp.float32)[:, None] * inv
    return (jnp.cos(ang_r), jnp.sin(ang_r), jnp.cos(ang_c), jnp.sin(ang_c))


def _rotate(x, cos, sin):
    x1, x2 = jnp.split(x, 2, axis=-1)
    return jnp.concatenate([x1 * cos - x2 * sin, x2 * cos + x1 * sin], axis=-1)


def rope2d(x, rope):
    cos_r, sin_r, cos_c, sin_c = (a[None, :, None, :].astype(x.dtype) for a in rope)
    xr, xc = jnp.split(x, 2, axis=-1)
    return jnp.concatenate([_rotate(xr, cos_r, sin_r), _rotate(xc, cos_c, sin_c)], axis=-1)


def sweep_query_blocks(fn, *qs):
    b, s = qs[0].shape[:2]
    nb = s // Q_BLOCK
    blocks = tuple(jnp.moveaxis(q.reshape(b, nb, Q_BLOCK, *q.shape[2:]), 1, 0) for q in qs)
    out = lax.map(lambda qb: fn(*qb), blocks)
    return jnp.moveaxis(out, 0, 1).reshape(b, s, *out.shape[3:])


def diff_attention(q1, q2, k1, k2, v, lam):
    scale = HEAD_DIM ** -0.5
    s1 = jnp.einsum('bqhd,bkhd->bhqk', q1, k1) * scale
    s2 = jnp.einsum('bqhd,bkhd->bhqk', q2, k2) * scale
    p = jax.nn.softmax(s1.astype(jnp.float32), axis=-1) - lam * jax.nn.softmax(s2.astype(jnp.float32), axis=-1)
    return jnp.einsum('bhqk,bkhd->bqhd', p.astype(v.dtype), v)


def gqa_attention(q, k, v):
    b, nq = q.shape[:2]
    qg = q.reshape(b, nq, B_KV_HEADS, B_HEADS // B_KV_HEADS, HEAD_DIM)
    s = jnp.einsum('bqngd,bknd->bngqk', qg, k) * (HEAD_DIM ** -0.5)
    p = softmax_f32(s, v.dtype)
    o = jnp.einsum('bngqk,bknd->bqngd', p, v)
    return o.reshape(b, nq, B_HEADS, HEAD_DIM)


def even_heads(p):
    lead = p.shape[:2]
    aq, ak, av, bq, bk, bv = jnp.split(p, list(EVEN_SPLITS), axis=-1)
    aq = aq.reshape(*lead, A_HEADS, 2, HEAD_DIM)
    ak = ak.reshape(*lead, A_HEADS, 2, HEAD_DIM)
    return (aq[..., 0, :], aq[..., 1, :], ak[..., 0, :], ak[..., 1, :],
            av.reshape(*lead, A_HEADS, A_VDIM),
            bq.reshape(*lead, B_HEADS, HEAD_DIM),
            bk.reshape(*lead, B_KV_HEADS, HEAD_DIM),
            bv.reshape(*lead, B_KV_HEADS, HEAD_DIM))


def even_mixer(h, h_ctx, rope, lam_init, w_in, w_out, lam_q1, lam_k1, lam_q2, lam_k2, subln_g, qn_g, kn_g):
    b, s, _ = h.shape
    nc = h_ctx.shape[1]
    a_q1, a_q2, a_k1, a_k2, a_v, b_q, b_k, b_v = even_heads(h @ w_in)
    c_q1, c_q2, c_k1, c_k2, c_v, cb_q, cb_k, cb_v = even_heads(h_ctx @ w_in)
    lam = (jnp.exp(jnp.sum(lam_q1 * lam_k1).astype(jnp.float32))
           - jnp.exp(jnp.sum(lam_q2 * lam_k2).astype(jnp.float32)) + lam_init)
    a_q1, a_q2, a_k1, a_k2 = (rope2d(t, rope) for t in (a_q1, a_q2, a_k1, a_k2))
    b_q = rope2d(rms_norm(b_q, qn_g), rope)
    b_k = rope2d(rms_norm(b_k, kn_g), rope)
    cb_q = rms_norm(cb_q, qn_g)
    cb_k = rms_norm(cb_k, kn_g)
    cat = lambda u, w: jnp.concatenate([u, w], axis=1)
    ka1, ka2, va = cat(a_k1, c_k1), cat(a_k2, c_k2), cat(a_v, c_v)
    kb, vb = cat(b_k, cb_k), cat(b_v, cb_v)
    o_a = sweep_query_blocks(lambda q1, q2: diff_attention(q1, q2, ka1, ka2, va, lam), a_q1, a_q2)
    o_b = sweep_query_blocks(lambda q: gqa_attention(q, kb, vb), b_q)
    oc_a = diff_attention(c_q1, c_q2, c_k1, c_k2, c_v, lam)
    oc_b = gqa_attention(cb_q, cb_k, cb_v)
    sub = lambda o: rms_norm(o, subln_g) * (1.0 - lam_init)
    y = jnp.concatenate([sub(o_a).reshape(b, s, A_V), o_b.reshape(b, s, B_Q)], axis=-1) @ w_out
    y_ctx = jnp.concatenate([sub(oc_a).reshape(b, nc, A_V), oc_b.reshape(b, nc, B_Q)], axis=-1) @ w_out
    return y, y_ctx


def neighbourhood_attention(q, k, v, k_ctx, v_ctx, rpb):
    b, s, h, d = q.shape
    rows = s // GRID_W
    kh = min(NA_ROWS, rows)
    kw = NA_COLS
    grid = lambda t: t.reshape(b, rows, GRID_W, h, d)
    qg, kg, vg = grid(q), grid(k), grid(v)
    cols = jnp.arange(GRID_W, dtype=jnp.int32)
    col_start = jnp.clip(cols - kw // 2, 0, GRID_W - kw)
    col_idx = col_start[:, None] + jnp.arange(kw, dtype=jnp.int32)[None, :]
    dc = col_idx - cols[:, None] + (NA_COLS - 1)
    scale = d ** -0.5
    n_loc = kh * kw

    def row_block(r):
        rs = jnp.clip(r - kh // 2, 0, rows - kh)
        k_rows = lax.dynamic_slice_in_dim(kg, rs, kh, axis=1)
        v_rows = lax.dynamic_slice_in_dim(vg, rs, kh, axis=1)
        k_nb = jnp.moveaxis(k_rows[:, :, col_idx], 1, 2).reshape(b, GRID_W, n_loc, h, d)
        v_nb = jnp.moveaxis(v_rows[:, :, col_idx], 1, 2).reshape(b, GRID_W, n_loc, h, d)
        q_r = lax.dynamic_index_in_dim(qg, r, axis=1, keepdims=False)
        dr = rs + jnp.arange(kh, dtype=jnp.int32) - r + (NA_ROWS - 1)
        bias = rpb[:, dr[None, :, None], dc[:, None, :]].reshape(h, GRID_W, n_loc)
        s_loc = jnp.einsum('bwhd,bwnhd->bhwn', q_r, k_nb) * scale + bias[None]
        s_ctx = jnp.einsum('bwhd,bkhd->bhwk', q_r, k_ctx) * scale
        p = softmax_f32(jnp.concatenate([s_loc, s_ctx], axis=-1), v.dtype)
        return (jnp.einsum('bhwn,bwnhd->bwhd', p[..., :n_loc], v_nb)
                + jnp.einsum('bhwk,bkhd->bwhd', p[..., n_loc:], v_ctx))

    out = lax.map(row_block, jnp.arange(rows, dtype=jnp.int32))
    return jnp.moveaxis(out, 0, 1).reshape(b, s, h * d)


def multi_scale_pool(u):
    s = u.shape[1]
    uf = u.astype(jnp.float32)
    csum = jnp.concatenate([jnp.zeros_like(uf[:, :1]), jnp.cumsum(uf, axis=1)], axis=1)
    t = jnp.arange(s, dtype=jnp.int32)[:, None]
    half = jnp.array(POOL_WINDOWS, dtype=jnp.int32)[None, :] // 2
    lo = jnp.clip(t - half, 0, s)
    hi = jnp.clip(t + half, 0, s)
    g = jnp.arange(D_GROUPS, dtype=jnp.int32)[None, :]
    mean = (csum[:, hi, g] - csum[:, lo, g]) / (hi - lo).astype(jnp.float32)[None, :, :, None]
    return (mean - uf).astype(u.dtype)


def odd_mixer(h, h_ctx, w_in, w_out, rpb, pool_w, pool_scale):
    b, s, _ = h.shape
    p = h @ w_in
    cq, ck, cv, du = jnp.split(p, [C_W, 2 * C_W, 3 * C_W], axis=-1)
    ctx_k, ctx_v = jnp.split(h_ctx @ w_in[:, C_W:3 * C_W], 2, axis=-1)
    heads = lambda t: t.reshape(*t.shape[:2], C_HEADS, HEAD_DIM)
    o_c = neighbourhood_attention(heads(cq), heads(ck), heads(cv), heads(ctx_k), heads(ctx_v), rpb)
    pooled = multi_scale_pool(du.reshape(b, s, D_GROUPS, D_GROUP_DIM))
    o_d = jnp.einsum('bsgc,gce->bsge', pooled, pool_w).reshape(b, s, D_W) * pool_scale
    return jnp.concatenate([o_c, o_d], axis=-1) @ w_out


def expert_choice_ffn(h, router, w_gate, w_up, w_down):
    b, n, _ = h.shape
    cap = EC_FACTOR * n // N_EXPERTS
    aff = jax.nn.softmax((h @ router).astype(jnp.float32), axis=-1)
    gates, idx = lax.top_k(jnp.swapaxes(aff, 1, 2), cap)
    bidx = jnp.arange(b, dtype=jnp.int32)[:, None, None]
    xg = h[bidx, idx]
    hid = jax.nn.silu(jnp.einsum('becd,edf->becf', xg, w_gate)) * jnp.einsum('becd,edf->becf', xg, w_up)
    y = jnp.einsum('becf,efd->becd', hid, w_down) * gates[..., None].astype(h.dtype)
    return jnp.zeros_like(h).at[bidx, idx].add(y)


def ffn_sublayer(x, shift, scale, gate, g, b, router, w_gate, w_up, w_down):
    hm = x * (1 + scale) + shift
    return layer_norm(DEEPNORM_ALPHA * x + gate * expert_choice_ffn(hm, router, w_gate, w_up, w_down), g, b)


def setup_inputs(seed: int = 0) -> dict:
    key = jax.random.key(seed)
    ks = iter(jax.random.split(key, 32))
    nrm = lambda shape, s: jax.random.normal(next(ks), shape, jnp.float32) * s
    D = D_MODEL
    return {
        "x": nrm((BATCH, SEQ, D), 1.0),
        "c": nrm((BATCH, D), 1.0),
        "ctx": nrm((BATCH, CTX_LEN, D), 1.0),
        "c_ctx": nrm((D,), 1.0),
        "ada_w": nrm((DEPTH, D, 6 * D), D ** -0.5),
        "ada_b": nrm((DEPTH, 6 * D), 0.02),
        "ln_g": 1.0 + nrm((DEPTH, 2, D), 0.02),
        "ln_b": nrm((DEPTH, 2, D), 0.02),
        "l0_w_in": nrm((D, EVEN_IN), D ** -0.5),
        "l0_w_out": nrm((EVEN_MIX, D), EVEN_MIX ** -0.5 * DEEPNORM_BETA),
        "l0_lam_q1": nrm((HEAD_DIM,), 0.1),
        "l0_lam_k1": nrm((HEAD_DIM,), 0.1),
        "l0_lam_q2": nrm((HEAD_DIM,), 0.1),
        "l0_lam_k2": nrm((HEAD_DIM,), 0.1),
        "l0_subln_g": 1.0 + nrm((A_VDIM,), 0.02),
        "l0_qnorm_g": 1.0 + nrm((HEAD_DIM,), 0.02),
        "l0_knorm_g": 1.0 + nrm((HEAD_DIM,), 0.02),
        "l1_w_in": nrm((D, ODD_IN), D ** -0.5),
        "l1_w_out": nrm((ODD_MIX, D), ODD_MIX ** -0.5 * DEEPNORM_BETA),
        "l1_rpb": nrm((C_HEADS, 2 * NA_ROWS - 1, 2 * NA_COLS - 1), 0.1),
        "l1_pool_w": nrm((D_GROUPS, D_GROUP_DIM, D_GROUP_DIM), D_GROUP_DIM ** -0.5),
        "l1_pool_scale": 1.0 + nrm((D_W,), 0.02),
        "moe_router": nrm((DEPTH, D, N_EXPERTS), D ** -0.5),
        "moe_w_gate": nrm((DEPTH, N_EXPERTS, D, EXPERT_FF), D ** -0.5),
        "moe_w_up": nrm((DEPTH, N_EXPERTS, D, EXPERT_FF), D ** -0.5),
        "moe_w_down": nrm((DEPTH, N_EXPERTS, EXPERT_FF, D), EXPERT_FF ** -0.5 * DEEPNORM_BETA),
    }


def reference(x, c, ctx, c_ctx, ada_w, ada_b, ln_g, ln_b,
              l0_w_in, l0_w_out, l0_lam_q1, l0_lam_k1, l0_lam_q2, l0_lam_k2, l0_subln_g, l0_qnorm_g, l0_knorm_g,
              l1_w_in, l1_w_out, l1_rpb, l1_pool_w, l1_pool_scale,
              moe_router, moe_w_gate, moe_w_up, moe_w_down):
    rope = rope_angles(x.shape[1])
    for i in range(DEPTH):
        mod = jax.nn.silu(c) @ ada_w[i] + ada_b[i]
        mod_c = jax.nn.silu(c_ctx) @ ada_w[i] + ada_b[i]
        sh1, sc1, g1, sh2, sc2, g2 = (m[:, None, :] for m in jnp.split(mod, 6, axis=-1))
        csh1, csc1, cg1, csh2, csc2, cg2 = (m[None, None, :] for m in jnp.split(mod_c, 6, axis=-1))
        h = x * (1 + sc1) + sh1
        h_ctx = ctx * (1 + csc1) + csh1
        if i % 2 == 0:
            y, y_ctx = even_mixer(h, h_ctx, rope, 0.8 - 0.6 * math.exp(-0.3 * i),
                                  l0_w_in, l0_w_out, l0_lam_q1, l0_lam_k1, l0_lam_q2, l0_lam_k2,
                                  l0_subln_g, l0_qnorm_g, l0_knorm_g)
        else:
            y = odd_mixer(h, h_ctx, l1_w_in, l1_w_out, l1_rpb, l1_pool_w, l1_pool_scale)
        x = layer_norm(DEEPNORM_ALPHA * x + g1 * y, ln_g[i, 0], ln_b[i, 0])
        x = ffn_sublayer(x, sh2, sc2, g2, ln_g[i, 1], ln_b[i, 1],
                         moe_router[i], moe_w_gate[i], moe_w_up[i], moe_w_down[i])
        if i % 2 == 0:
            ctx = layer_norm(DEEPNORM_ALPHA * ctx + cg1 * y_ctx, ln_g[i, 0], ln_b[i, 0])
            ctx = ffn_sublayer(ctx, csh2, csc2, cg2, ln_g[i, 1], ln_b[i, 1],
                               moe_router[i], moe_w_gate[i], moe_w_up[i], moe_w_down[i])
    return x
```

```cpp
#include <hip/hip_runtime.h>
#include <cstdio>
#include <cstdint>

#define GAS __attribute__((address_space(1)))
#define LAS __attribute__((address_space(3)))
typedef unsigned short bf16;
typedef unsigned v4u __attribute__((ext_vector_type(4)));
typedef unsigned v2u __attribute__((ext_vector_type(2)));
typedef float f32x4 __attribute__((ext_vector_type(4)));
typedef float f32x2 __attribute__((ext_vector_type(2)));
typedef float f32x16 __attribute__((ext_vector_type(16)));
typedef GAS unsigned gu32;

#ifndef MK_MULTI
#define MK_MULTI 0
#endif

constexpr int NBATCH = 8, SEQ = 2048, DM = 1024, NCTX = 256;
constexpr int LAT = NBATCH * SEQ;
constexpr int NTOK = LAT + NBATCH * NCTX;
constexpr int EIN = 2304, OIN = 2048, NE = 16, FF = 2048;
constexpr int MR0 = 2304, MR1 = 2048;
constexpr float LOG2E = 1.4426950408889634f;
constexpr float C2 = 0.125f * LOG2E;
constexpr float ALPHA = 1.4142135623730951f;
constexpr float LN_EPS = 1e-5f, RMS_EPS = 1e-6f;
constexpr float LAM_INIT = 0.2f;
constexpr int NPHASE = 20;

constexpr size_t MiB = 1u << 20;
constexpr size_t WS_CTL = 0, CTL_ZERO_BYTES = 1 * MiB;
constexpr size_t WS_MOD = 1 * MiB;
constexpr size_t WS_ROPE = 1 * MiB + 512 * 1024;
constexpr size_t WS_AFF = 16 * MiB;
constexpr size_t WS_INV = 18 * MiB;
constexpr size_t WS_GATE = 20 * MiB;
constexpr size_t WS_XS = 404 * MiB;
constexpr size_t WS_HB = 476 * MiB;
constexpr size_t WS_QKV = 512 * MiB;
constexpr size_t WS_CC = 593 * MiB;
constexpr size_t WS_AO = 629 * MiB;
constexpr size_t WS_Y = 701 * MiB;
constexpr size_t WS_PF = 773 * MiB;
constexpr size_t WS_XG = 512 * MiB;
constexpr size_t WS_HID = 584 * MiB;
constexpr size_t WS_YS = 728 * MiB;
constexpr size_t WS_END = 936 * MiB;

constexpr int CW_BAR = 4096;
constexpr int LDS_BYTES = 147456;
constexpr int MISC_OFF = 131072 + 320;

__device__ __forceinline__ float bf2f(unsigned v) { return __uint_as_float(v << 16); }
__device__ __forceinline__ unsigned f2bf(float f) { unsigned u = __float_as_uint(f); return (u + 0x7fffu + ((u >> 16) & 1u)) >> 16; }
__device__ __forceinline__ unsigned pk2(float lo, float hi) { return f2bf(lo) | (f2bf(hi) << 16); }
__device__ __forceinline__ float wave_sum(float v) {
#pragma unroll
    for (int o = 1; o < 64; o <<= 1) v += __shfl_xor(v, o);
    return v;
}
__device__ __forceinline__ float wave_max(float v) {
#pragma unroll
    for (int o = 1; o < 64; o <<= 1) v = fmaxf(v, __shfl_xor(v, o));
    return v;
}
__device__ __forceinline__ void unpack8(const v4u w, float* f) {
    f[0] = bf2f(w.x & 0xffffu); f[1] = __uint_as_float(w.x & 0xffff0000u);
    f[2] = bf2f(w.y & 0xffffu); f[3] = __uint_as_float(w.y & 0xffff0000u);
    f[4] = bf2f(w.z & 0xffffu); f[5] = __uint_as_float(w.z & 0xffff0000u);
    f[6] = bf2f(w.w & 0xffffu); f[7] = __uint_as_float(w.w & 0xffff0000u);
}

#define XB_TMO      128
#define XB_XCNT(j)  (256  + 64 * (j))
#define XB_XSUB(j)  (1280 + 64 * (j))
#define XB_XGEN(j)  (2304 + 64 * (j))
#define XB_TOP      3328
#define XB_TOPGEN   3392
#define XCD_BAR_WORDS 3456
#define XB_SPIN_CAP (1u << 18)
__device__ __forceinline__ unsigned xb_ld(unsigned* p)              { return __hip_atomic_load(p, __ATOMIC_RELAXED, __HIP_MEMORY_SCOPE_AGENT); }
__device__ __forceinline__ unsigned xb_add(unsigned* p, unsigned v) { return __hip_atomic_fetch_add(p, v, __ATOMIC_RELAXED, __HIP_MEMORY_SCOPE_AGENT); }
__device__ __forceinline__ unsigned xb_xcc_id() { return (unsigned)__builtin_amdgcn_s_getreg((3 << 11) | 20) & 0xFu; }
#define XB_SPIN(cond, bar) do { unsigned _sp = 0; while (cond) { __builtin_amdgcn_s_sleep(1); \
    if ((++_sp & 255u) == 0u) { if (xb_ld(&(bar)[XB_TMO])) break; if (_sp > XB_SPIN_CAP) { atomicAdd(&(bar)[XB_TMO], 1u); break; } } } } while (0)
struct XcdBarrier { unsigned* bar; unsigned x; volatile LAS unsigned* st; };
__device__ __forceinline__ XcdBarrier xcd_barrier_post(unsigned* bar, volatile LAS unsigned* st) {
    XcdBarrier b; b.bar = bar; b.x = xb_xcc_id(); b.st = st;
    if (threadIdx.x == 0) (void)xb_add(&bar[XB_XCNT(b.x)], 1u);
    return b;
}
__device__ __forceinline__ void xcd_barrier_complete(unsigned* bar, unsigned x, unsigned& nloc, unsigned& nx) {
    const unsigned G = gridDim.x * gridDim.y * gridDim.z;
    unsigned sum, cnt, mine, sp = 0u;
    for (;;) {
        sum = 0u; cnt = 0u; mine = 0u;
#pragma unroll
        for (unsigned j = 0; j < 16; ++j) { const unsigned c = xb_ld(&bar[XB_XCNT(j)]); sum += c; cnt += (c > 0u) ? 1u : 0u; mine = (j == x) ? c : mine; }
        if (sum == G) break;
        __builtin_amdgcn_s_sleep(1);
        if ((++sp & 255u) == 0u) { if (xb_ld(&bar[XB_TMO])) break; if (sp > XB_SPIN_CAP) { atomicAdd(&bar[XB_TMO], 1u); break; } }
    }
    nloc = mine > 0u ? mine : 1u; nx = cnt > 0u ? cnt : 1u;
}
__device__ __forceinline__ void xcd_barrier(const XcdBarrier& b) {
    asm volatile("s_waitcnt vmcnt(0)" ::: "memory");
    __syncthreads();
    if (threadIdx.x == 0) {
        unsigned* bar = b.bar;
        __builtin_amdgcn_s_waitcnt(0);
        unsigned nloc = b.st[0], nx = b.st[1];
        if (nloc == 0u) { xcd_barrier_complete(bar, b.x, nloc, nx); b.st[0] = nloc; b.st[1] = nx; }
        const unsigned old = xb_add(&bar[XB_XSUB(b.x)], 1u);
        const unsigned gen = old / nloc;
        if (old + 1u == (gen + 1u) * nloc) {
            __builtin_amdgcn_fence(__ATOMIC_RELEASE, "agent");
            asm volatile("s_waitcnt vmcnt(0)" ::: "memory");
            const unsigned og = xb_add(&bar[XB_TOP], 1u);
            const unsigned tg = og / nx;
            if (og + 1u == (tg + 1u) * nx) xb_add(&bar[XB_TOPGEN], 1u);
            else XB_SPIN(xb_ld(&bar[XB_TOPGEN]) == tg, bar);
            __builtin_amdgcn_fence(__ATOMIC_ACQUIRE, "agent");
            xb_add(&bar[XB_XGEN(b.x)], 1u);
            asm volatile("s_waitcnt vmcnt(0)" ::: "memory");
        } else {
            XB_SPIN(xb_ld(&bar[XB_XGEN(b.x)]) == gen, bar);
            __builtin_amdgcn_fence(__ATOMIC_ACQUIRE, "agent");
            asm volatile("s_waitcnt vmcnt(0)" ::: "memory");
        }
    }
    __syncthreads();
}

struct Params { const float* in[26]; float* out; unsigned char* ws; int ph_lo, ph_hi; };
struct Ctx { LAS unsigned char* lds; int tid, lane, wave, vcu, G, gw, NGW; };
enum { I_X = 0, I_C, I_CTX, I_CCTX, I_ADAW, I_ADAB, I_LNG, I_LNB, I_W0IN, I_W0OUT, I_LQ1, I_LK1, I_LQ2, I_LK2, I_SUBLN, I_QN, I_KN,
       I_W1IN, I_W1OUT, I_RPB, I_POOLW, I_POOLS, I_ROUTER, I_WG, I_WU, I_WD };

__device__ __forceinline__ const float* mod_row(const Params& p, int layer, int row) {
    return (const float*)(p.ws + WS_MOD) + (size_t)(layer * 9 + (row < LAT ? (row >> 11) : 8)) * 6144;
}

__device__ __forceinline__ void ph_prologue(const Params& p, const Ctx& c) {
    const float* cin = p.in[I_C]; const float* cctx = p.in[I_CCTX]; const float* ada_w = p.in[I_ADAW]; const float* ada_b = p.in[I_ADAB];
    float* MOD = (float*)(p.ws + WS_MOD);
    LAS float* sc = (LAS float*)c.lds;
    LAS float* red = sc + 9 * 1024;
    for (int i = c.tid; i < 9 * 1024; i += 512) { const float v = i < 8192 ? cin[i] : cctx[i - 8192]; sc[i] = v / (1.f + expf(-v)); }
    __syncthreads();
    for (int u = c.vcu; u < 256; u += c.G) {
        const int layer = u >> 7, j0 = (u & 127) * 48;
        const int jc = c.tid % 48, kg = c.tid / 48;
        if (kg < 10) {
            float acc[9];
#pragma unroll
            for (int m = 0; m < 9; ++m) acc[m] = 0.f;
            const float* wp = ada_w + (size_t)layer * 1024 * 6144 + j0 + jc;
            for (int k = kg; k < 1024; k += 10) {
                const float w = wp[(size_t)k * 6144];
#pragma unroll
                for (int m = 0; m < 9; ++m) acc[m] += sc[m * 1024 + k] * w;
            }
#pragma unroll
            for (int m = 0; m < 9; ++m) red[(kg * 9 + m) * 48 + jc] = acc[m];
        }
        __syncthreads();
        if (c.tid < 432) {
            const int m = c.tid / 48, j = c.tid % 48; float s = 0.f;
#pragma unroll
            for (int g = 0; g < 10; ++g) s += red[(g * 9 + m) * 48 + j];
            MOD[(size_t)(layer * 9 + m) * 6144 + j0 + j] = s + ada_b[layer * 6144 + j0 + j];
        }
        __syncthreads();
    }
    if (c.vcu == 0) {
        f32x2* R = (f32x2*)(p.ws + WS_ROPE);
        for (int i = c.tid; i < 1024; i += 512) {
            const int pos = i >> 4, f = i & 15;
            const float inv = exp2f(-(float)f * (13.287712379549449f / 16.f));
            const float a = (float)pos * inv;
            const float k = rintf(a * 0.15915494309189535f);
            float rr = fmaf(-k, 6.28125f, a); rr = fmaf(-k, 1.9353071795864769e-3f, rr);
            R[i] = (f32x2){__cosf(rr), __sinf(rr)};
        }
    }
}

__device__ __forceinline__ void ph_modulate0(const Params& p, const Ctx& c) {
    bf16* HB = (bf16*)(p.ws + WS_HB);
    for (int row = c.gw; row < NTOK; row += c.NGW) {
        const float* src = row < LAT ? p.in[I_X] + (size_t)row * DM : p.in[I_CTX] + (size_t)(row - LAT) * DM;
        const float* mod = mod_row(p, 0, row);
#pragma unroll
        for (int j = 0; j < 4; ++j) {
            const int col = 4 * c.lane + 256 * j;
            const f32x4 v = *(const f32x4*)(src + col), sh = *(const f32x4*)(mod + col), s = *(const f32x4*)(mod + 1024 + col);
            const f32x4 h = v * (s + 1.f) + sh;
            *(v2u*)(HB + (size_t)row * DM + col) = (v2u){pk2(h.x, h.y), pk2(h.z, h.w)};
        }
    }
}

struct NG { const bf16* A; int lda; const float* W0; const float* W1; int ldw; size_t wstride; int Mb; int row_begin, row_end, col_begin, col_end, K; };
template <int NB, class Epi>
__device__ __forceinline__ void ngemm(const NG& g, const Ctx& c, const Epi& epi) {
    const int nmt = (g.row_end - g.row_begin) / 32, nnt = (g.col_end - g.col_begin) / 32;
    const int l31 = c.lane & 31, lh = c.lane >> 5;
    for (int t = c.gw; t < nmt * nnt; t += c.NGW) {
        const int mt = t / nnt, nt = t % nnt;
        const int row0 = g.row_begin + mt * 32, col0 = g.col_begin + nt * 32;
        const int e = row0 / g.Mb;
        const bf16* ap = g.A + (size_t)(row0 + l31) * g.lda + lh;
        const float* bp0 = g.W0 + (size_t)e * g.wstride + (size_t)lh * g.ldw + col0 + l31;
        const float* bp1 = NB == 2 ? g.W1 + (size_t)e * g.wstride + (size_t)lh * g.ldw + col0 + l31 : nullptr;
        f32x16 acc0 = {}, acc1 = {};
#pragma unroll 8
        for (int k = 0; k < g.K; k += 2) {
            const float a = bf2f((unsigned)ap[k]);
            const float b0 = bp0[(size_t)k * g.ldw];
            acc0 = __builtin_amdgcn_mfma_f32_32x32x2f32(a, b0, acc0, 0, 0, 0);
            if (NB == 2) { const float b1 = bp1[(size_t)k * g.ldw]; acc1 = __builtin_amdgcn_mfma_f32_32x32x2f32(a, b1, acc1, 0, 0, 0); }
        }
#pragma unroll
        for (int r = 0; r < 16; ++r) {
            const int row = row0 + (r & 3) + 8 * (r >> 2) + 4 * lh, col = col0 + l31;
            epi(row, col, acc0[r], acc1[r]);
        }
    }
}
struct EpiF32 { float* O; int ldc; __device__ __forceinline__ void operator()(int row, int col, float v0, float) const { O[(size_t)row * ldc + col] = v0; } };
struct EpiBf { bf16* O; int ldc; int scale_cols; float sc; __device__ __forceinline__ void operator()(int row, int col, float v0, float) const { O[(size_t)row * ldc + col] = (bf16)f2bf(col < scale_cols ? v0 * sc : v0); } };
struct EpiSwiglu { bf16* O; __device__ __forceinline__ void operator()(int row, int col, float g, float u) const { const float s = g / (1.f + __expf(-g)); O[(size_t)row * FF + col] = (bf16)f2bf(s * u); } };
struct EpiGate { bf16* O; const float* gate; __device__ __forceinline__ void operator()(int row, int col, float v0, float) const { O[(size_t)row * DM + col] = (bf16)f2bf(v0 * gate[row]); } };

__device__ __forceinline__ void ph_qkv_post(const Params& p, const Ctx& c) {
    const float* PF = (const float*)(p.ws + WS_PF);
    bf16* QKV = (bf16*)(p.ws + WS_QKV);
    const f32x2* R = (const f32x2*)(p.ws + WS_ROPE);
    const float* qn = p.in[I_QN]; const float* kn = p.in[I_KN];
    const int d = c.lane;
    const float qg = qn[d], kg = kn[d];
    for (int row = c.gw; row < NTOK; row += c.NGW) {
        const bool lat = row < LAT;
        const int t = row & 2047;
        const int pos = (d < 32) ? (t >> 6) : (t & 63);
        const f32x2 cs = R[pos * 16 + (d & 15)];
        const bool first = (d & 16) == 0;
        for (int hs = 0; hs < 36; ++hs) {
            float v = PF[(size_t)row * EIN + hs * 64 + d];
            const bool isq = hs < 8 || (hs >= 24 && hs < 32);
            const bool isk = (hs >= 8 && hs < 16) || hs == 32 || hs == 33;
            const bool nrm = hs >= 24 && hs < 34;
            if (nrm) { const float ss = wave_sum(v * v); v = v * rsqrtf(ss * (1.f / 64.f) + RMS_EPS) * (hs < 32 ? qg : kg); }
            if ((isq || isk) && lat) { const float pr = __shfl_xor(v, 16); v = first ? v * cs.x - pr * cs.y : v * cs.x + pr * cs.y; }
            if (isq) v *= C2;
            QKV[(size_t)row * EIN + hs * 64 + d] = (bf16)f2bf(v);
        }
    }
}

__device__ __forceinline__ void ph_attn0_naive(const Params& p, const Ctx& c) {
    const bf16* QKV = (const bf16*)(p.ws + WS_QKV);
    bf16* CC = (bf16*)(p.ws + WS_CC);
    float* AO = (float*)(p.ws + WS_AO);
    LAS float* Ks = (LAS float*)c.lds;
    LAS float* Vs = Ks + 4096;
    for (int u = c.vcu; u < 960; u += c.G) {
        const bool isctx = u >= 768;
        int b, vh, qrow, ntiles; bool active = true;
        if (!isctx) { b = u / 96; const int r = u % 96; vh = r >> 2; qrow = b * SEQ + (r & 3) * 512 + c.tid; ntiles = 36; }
        else { const int uu = u - 768; b = uu / 24; vh = uu % 24; qrow = LAT + b * NCTX + (c.tid & 255); active = c.tid < 256; ntiles = 4; }
        int qcol, kcol, vcol;
        if (vh < 16) { const int a = vh >> 2, s = (vh >> 1) & 1, half = vh & 1; qcol = a * 128 + s * 64; kcol = 512 + a * 128 + s * 64; vcol = 1024 + a * 128 + half * 64; }
        else { const int h = vh - 16; qcol = 1536 + h * 64; kcol = 2048 + (h >> 2) * 64; vcol = 2176 + (h >> 2) * 64; }
        float q[64], o[64];
#pragma unroll
        for (int i = 0; i < 8; ++i) { const v4u w = *(const v4u*)(QKV + (size_t)qrow * EIN + qcol + 8 * i); unpack8(w, q + 8 * i); }
#pragma unroll
        for (int i = 0; i < 64; ++i) o[i] = 0.f;
        float m = -1e30f, l = 0.f;
        for (int t = 0; t < ntiles; ++t) {
            const int krow0 = isctx ? LAT + b * NCTX + 64 * t : (t < 32 ? b * SEQ + 64 * t : LAT + b * NCTX + 64 * (t - 32));
            __syncthreads();
            { const int r = c.tid >> 3, ch = c.tid & 7; float f[8];
              const v4u kw = *(const v4u*)(QKV + (size_t)(krow0 + r) * EIN + kcol + ch * 8); unpack8(kw, f);
#pragma unroll
              for (int j = 0; j < 8; ++j) Ks[r * 64 + ch * 8 + j] = f[j];
              const v4u vw = *(const v4u*)(QKV + (size_t)(krow0 + r) * EIN + vcol + ch * 8); unpack8(vw, f);
#pragma unroll
              for (int j = 0; j < 8; ++j) Vs[r * 64 + ch * 8 + j] = f[j]; }
            __syncthreads();
            if (active) {
                for (int kk = 0; kk < 64; ++kk) {
                    float s = 0.f;
#pragma unroll
                    for (int dd = 0; dd < 64; ++dd) s += q[dd] * Ks[kk * 64 + dd];
                    const float mn = fmaxf(m, s), al = exp2f(m - mn), pp = exp2f(s - mn);
                    l = l * al + pp; m = mn;
#pragma unroll
                    for (int dd = 0; dd < 64; ++dd) o[dd] = o[dd] * al + pp * Vs[kk * 64 + dd];
                }
            }
        }
        if (active) {
            const float rl = 1.f / l;
            if (vh < 16) { const int a = vh >> 2, s = (vh >> 1) & 1, half = vh & 1; float* dst = AO + (size_t)qrow * DM + a * 256 + s * 128 + half * 64;
#pragma unroll
                for (int i = 0; i < 16; ++i) *(f32x4*)(dst + 4 * i) = (f32x4){o[4 * i] * rl, o[4 * i + 1] * rl, o[4 * i + 2] * rl, o[4 * i + 3] * rl}; }
            else { bf16* dst = CC + (size_t)qrow * DM + 512 + (vh - 16) * 64;
#pragma unroll
                for (int i = 0; i < 8; ++i) *(v4u*)(dst + 8 * i) = (v4u){pk2(o[8 * i] * rl, o[8 * i + 1] * rl), pk2(o[8 * i + 2] * rl, o[8 * i + 3] * rl), pk2(o[8 * i + 4] * rl, o[8 * i + 5] * rl), pk2(o[8 * i + 6] * rl, o[8 * i + 7] * rl)}; }
        }
    }
}

__device__ __forceinline__ void ph_attn_combine(const Params& p, const Ctx& c) {
    const float* AO = (const float*)(p.ws + WS_AO);
    bf16* CC = (bf16*)(p.ws + WS_CC);
    const float d1 = wave_sum(p.in[I_LQ1][c.lane] * p.in[I_LK1][c.lane]);
    const float d2 = wave_sum(p.in[I_LQ2][c.lane] * p.in[I_LK2][c.lane]);
    const float lam = expf(d1) - expf(d2) + LAM_INIT;
    const float g0 = p.in[I_SUBLN][c.lane] * (1.f - LAM_INIT), g1 = p.in[I_SUBLN][c.lane + 64] * (1.f - LAM_INIT);
    for (int it = c.gw; it < NTOK * 4; it += c.NGW) {
        const int row = it >> 2, a = it & 3;
        const float* src = AO + (size_t)row * DM + a * 256;
        const float x0 = src[c.lane] - lam * src[128 + c.lane], x1 = src[64 + c.lane] - lam * src[192 + c.lane];
        const float ss = wave_sum(x0 * x0 + x1 * x1);
        const float r = rsqrtf(ss * (1.f / 128.f) + RMS_EPS);
        CC[(size_t)row * DM + a * 128 + c.lane] = (bf16)f2bf(x0 * r * g0);
        CC[(size_t)row * DM + a * 128 + 64 + c.lane] = (bf16)f2bf(x1 * r * g1);
    }
}

__device__ __forceinline__ void ph_ln1_router(const Params& p, const Ctx& c, int layer) {
    const float* Y = (const float*)(p.ws + WS_Y);
    float* XS = (float*)(p.ws + WS_XS);
    bf16* HB = (bf16*)(p.ws + WS_HB);
    float* AFF = (float*)(p.ws + WS_AFF);
    const float* lng = p.in[I_LNG] + (size_t)(layer * 2 + 0) * DM; const float* lnb = p.in[I_LNB] + (size_t)(layer * 2 + 0) * DM;
    const float* router = p.in[I_ROUTER] + (size_t)layer * DM * NE;
    const int nrows = layer == 0 ? NTOK : LAT;
    for (int row = c.gw; row < nrows; row += c.NGW) {
        const float* xin = layer == 0 ? (row < LAT ? p.in[I_X] + (size_t)row * DM : p.in[I_CTX] + (size_t)(row - LAT) * DM) : XS + (size_t)row * DM;
        const float* mod = mod_row(p, layer, row);
        f32x4 v[4]; float s = 0.f;
#pragma unroll
        for (int j = 0; j < 4; ++j) { const int col = 4 * c.lane + 256 * j;
            v[j] = *(const f32x4*)(xin + col) * ALPHA + *(const f32x4*)(mod + 2048 + col) * *(const f32x4*)(Y + (size_t)row * DM + col);
            s += (v[j].x + v[j].y) + (v[j].z + v[j].w); }
        const float mean = wave_sum(s) * (1.f / DM); float s2 = 0.f;
#pragma unroll
        for (int j = 0; j < 4; ++j) { v[j] = v[j] - mean; s2 += (v[j].x * v[j].x + v[j].y * v[j].y) + (v[j].z * v[j].z + v[j].w * v[j].w); }
        const float rstd = 1.f / sqrtf(wave_sum(s2) * (1.f / DM) + LN_EPS);
        float lg[16];
#pragma unroll
        for (int e = 0; e < 16; ++e) lg[e] = 0.f;
#pragma unroll
        for (int j = 0; j < 4; ++j) { const int col = 4 * c.lane + 256 * j;
            const f32x4 x1 = v[j] * rstd * *(const f32x4*)(lng + col) + *(const f32x4*)(lnb + col);
            *(f32x4*)(XS + (size_t)row * DM + col) = x1;
            const f32x4 hm = x1 * (*(const f32x4*)(mod + 4096 + col) + 1.f) + *(const f32x4*)(mod + 3072 + col);
            *(v2u*)(HB + (size_t)row * DM + col) = (v2u){pk2(hm.x, hm.y), pk2(hm.z, hm.w)};
#pragma unroll
            for (int q = 0; q < 4; ++q) { const float hv = hm[q]; const float* rp = router + (size_t)(col + q) * NE;
#pragma unroll
                for (int e4 = 0; e4 < 4; ++e4) { const f32x4 rw = *(const f32x4*)(rp + 4 * e4); lg[4 * e4] += hv * rw.x; lg[4 * e4 + 1] += hv * rw.y; lg[4 * e4 + 2] += hv * rw.z; lg[4 * e4 + 3] += hv * rw.w; } } }
        float mx = -1e30f;
#pragma unroll
        for (int e = 0; e < 16; ++e) { lg[e] = wave_sum(lg[e]); mx = fmaxf(mx, lg[e]); }
        float den = 0.f;
#pragma unroll
        for (int e = 0; e < 16; ++e) { lg[e] = expf(lg[e] - mx); den += lg[e]; }
        float mine = 0.f;
#pragma unroll
        for (int e = 0; e < 16; ++e) mine = (c.lane == e) ? lg[e] : mine;
        if (c.lane < 16) AFF[(size_t)row * NE + c.lane] = mine / den;
    }
}

__device__ __forceinline__ void ph_topk(const Params& p, const Ctx& c, int layer) {
    const float* AFF = (const float*)(p.ws + WS_AFF);
    int* INV = (int*)(p.ws + WS_INV);
    float* GATE = (float*)(p.ws + WS_GATE);
    const bf16* HB = (const bf16*)(p.ws + WS_HB);
    bf16* XG = (bf16*)(p.ws + WS_XG);
    LAS float* vals = (LAS float*)c.lds;
    LAS int* sel = (LAS int*)(c.lds + 8192);
    const int MR = layer == 0 ? MR0 : MR1;
    const int ntasks = layer == 0 ? 256 : 128;
    for (int task = c.vcu; task < ntasks; task += c.G) {
        int set, e, n, cap, rowbase, slotbase;
        if (task < 128) { set = task >> 4; e = task & 15; n = SEQ; cap = 256; rowbase = set * SEQ; slotbase = set * 256; }
        else { const int t2 = task - 128; set = t2 >> 4; e = t2 & 15; n = NCTX; cap = 32; rowbase = LAT + set * NCTX; slotbase = 2048 + set * 32; }
        for (int i = c.tid; i < n; i += 512) vals[i] = AFF[(size_t)(rowbase + i) * NE + e];
        __syncthreads();
        float mv[4]; int rk[4];
#pragma unroll
        for (int q = 0; q < 4; ++q) { const int i = c.tid + 512 * q; mv[q] = i < n ? vals[i] : 0.f; rk[q] = 0; }
        for (int j = 0; j < n; ++j) {
            const float vj = vals[j];
#pragma unroll
            for (int q = 0; q < 4; ++q) { const int i = c.tid + 512 * q; rk[q] += (vj > mv[q] || (vj == mv[q] && j < i)) ? 1 : 0; }
        }
#pragma unroll
        for (int q = 0; q < 4; ++q) { const int i = c.tid + 512 * q;
            if (i < n) { int slot = -1;
                if (rk[q] < cap) { slot = e * MR + slotbase + rk[q]; sel[rk[q]] = i; GATE[slot] = mv[q]; }
                INV[(size_t)(rowbase + i) * NE + e] = slot; } }
        __syncthreads();
        for (int s = c.wave; s < cap; s += 8) {
            const bf16* src = HB + (size_t)(rowbase + sel[s]) * DM; bf16* dst = XG + (size_t)(e * MR + slotbase + s) * DM;
            *(v4u*)(dst + 8 * c.lane) = *(const v4u*)(src + 8 * c.lane);
            *(v4u*)(dst + 512 + 8 * c.lane) = *(const v4u*)(src + 512 + 8 * c.lane);
        }
        __syncthreads();
    }
}

__device__ __forceinline__ void ph_combine(const Params& p, const Ctx& c, int layer) {
    const bf16* YS = (const bf16*)(p.ws + WS_YS);
    const int* INV = (const int*)(p.ws + WS_INV);
    float* XS = (float*)(p.ws + WS_XS);
    bf16* HB = (bf16*)(p.ws + WS_HB);
    const float* lng = p.in[I_LNG] + (size_t)(layer * 2 + 1) * DM; const float* lnb = p.in[I_LNB] + (size_t)(layer * 2 + 1) * DM;
    const int nrows = layer == 0 ? NTOK : LAT;
    for (int row = c.gw; row < nrows; row += c.NGW) {
        const float* mod = mod_row(p, layer, row);
        f32x4 mo[4];
#pragma unroll
        for (int j = 0; j < 4; ++j) mo[j] = (f32x4){0.f, 0.f, 0.f, 0.f};
        for (int e = 0; e < NE; ++e) {
            const int s = INV[(size_t)row * NE + e];
            if (s >= 0) {
#pragma unroll
                for (int j = 0; j < 4; ++j) { const v2u w = *(const v2u*)(YS + (size_t)s * DM + 4 * c.lane + 256 * j);
                    mo[j].x += bf2f(w.x & 0xffffu); mo[j].y += __uint_as_float(w.x & 0xffff0000u); mo[j].z += bf2f(w.y & 0xffffu); mo[j].w += __uint_as_float(w.y & 0xffff0000u); }
            }
        }
        f32x4 v[4]; float s = 0.f;
#pragma unroll
        for (int j = 0; j < 4; ++j) { const int col = 4 * c.lane + 256 * j;
            v[j] = *(const f32x4*)(XS + (size_t)row * DM + col) * ALPHA + *(const f32x4*)(mod + 5120 + col) * mo[j];
            s += (v[j].x + v[j].y) + (v[j].z + v[j].w); }
        const float mean = wave_sum(s) * (1.f / DM); float s2 = 0.f;
#pragma unroll
        for (int j = 0; j < 4; ++j) { v[j] = v[j] - mean; s2 += (v[j].x * v[j].x + v[j].y * v[j].y) + (v[j].z * v[j].z + v[j].w * v[j].w); }
        const float rstd = 1.f / sqrtf(wave_sum(s2) * (1.f / DM) + LN_EPS);
        const float* modn = mod_row(p, 1, row);
#pragma unroll
        for (int j = 0; j < 4; ++j) { const int col = 4 * c.lane + 256 * j;
            const f32x4 x2 = v[j] * rstd * *(const f32x4*)(lng + col) + *(const f32x4*)(lnb + col);
            if (layer == 0) {
                *(f32x4*)(XS + (size_t)row * DM + col) = x2;
                const f32x4 h = x2 * (*(const f32x4*)(modn + 1024 + col) + 1.f) + *(const f32x4*)(modn + col);
                *(v2u*)(HB + (size_t)row * DM + col) = (v2u){pk2(h.x, h.y), pk2(h.z, h.w)};
            } else {
                *(f32x4*)(p.out + (size_t)row * DM + col) = x2;
            } }
    }
}

__device__ __forceinline__ void na_key(const float* q, float* o, float& m, float& l, const bf16* kp, const bf16* vp, float bias) {
    float s = bias;
#pragma unroll
    for (int i = 0; i < 8; ++i) { float f[8]; unpack8(*(const v4u*)(kp + 8 * i), f);
#pragma unroll
        for (int j = 0; j < 8; ++j) s += q[8 * i + j] * f[j]; }
    const float mn = fmaxf(m, s), al = exp2f(m - mn), pp = exp2f(s - mn);
    l = l * al + pp; m = mn;
#pragma unroll
    for (int i = 0; i < 8; ++i) { float f[8]; unpack8(*(const v4u*)(vp + 8 * i), f);
#pragma unroll
        for (int j = 0; j < 8; ++j) o[8 * i + j] = o[8 * i + j] * al + pp * f[j]; }
}
__device__ __forceinline__ void ph_mixer1_naive(const Params& p, const Ctx& c) {
    const bf16* P2 = (const bf16*)(p.ws + WS_QKV);
    bf16* CC = (bf16*)(p.ws + WS_CC);
    const float* rpb = p.in[I_RPB]; const float* pool_w = p.in[I_POOLW]; const float* pool_s = p.in[I_POOLS];
    LAS float* pl = (LAS float*)c.lds;
    for (int u = c.vcu; u < 256; u += c.G) {
        const int b = u >> 5, r = u & 31;
        {
            const int h = c.wave, col = c.lane, row = b * SEQ + r * 64 + col;
            const int rs = min(max(r - 4, 0), 24), cs = min(max(col - 8, 0), 48);
            float q[64], o[64];
#pragma unroll
            for (int i = 0; i < 8; ++i) unpack8(*(const v4u*)(P2 + (size_t)row * OIN + h * 64 + 8 * i), q + 8 * i);
#pragma unroll
            for (int i = 0; i < 64; ++i) o[i] = 0.f;
            float m = -1e30f, l = 0.f;
#pragma unroll 1
            for (int i = 0; i < 8; ++i)
#pragma unroll 1
                for (int j = 0; j < 16; ++j) {
                    const int krow = b * SEQ + (rs + i) * 64 + cs + j;
                    const float bias = rpb[(h * 15 + (rs + i - r + 7)) * 31 + (cs + j - col + 15)] * LOG2E;
                    na_key(q, o, m, l, P2 + (size_t)krow * OIN + 512 + h * 64, P2 + (size_t)krow * OIN + 1024 + h * 64, bias);
                }
#pragma unroll 1
            for (int j = 0; j < NCTX; ++j) {
                const int krow = LAT + b * NCTX + j;
                na_key(q, o, m, l, P2 + (size_t)krow * OIN + 512 + h * 64, P2 + (size_t)krow * OIN + 1024 + h * 64, 0.f);
            }
            const float rl = 1.f / l; bf16* dst = CC + (size_t)row * DM + h * 64;
#pragma unroll
            for (int i = 0; i < 8; ++i) *(v4u*)(dst + 8 * i) = (v4u){pk2(o[8 * i] * rl, o[8 * i + 1] * rl), pk2(o[8 * i + 2] * rl, o[8 * i + 3] * rl), pk2(o[8 * i + 4] * rl, o[8 * i + 5] * rl), pk2(o[8 * i + 6] * rl, o[8 * i + 7] * rl)};
        }
        __syncthreads();
        {
            const int ch = c.tid, g = ch >> 7, half = 1 << g;
            for (int tt = 0; tt < 64; ++tt) {
                const int t = r * 64 + tt, lo = max(t - half, 0), hi = min(t + half, SEQ);
                float s = 0.f;
                for (int t2 = lo; t2 < hi; ++t2) s += bf2f((unsigned)P2[(size_t)(b * SEQ + t2) * OIN + 1536 + ch]);
                pl[tt * 512 + ch] = s / (float)(hi - lo) - bf2f((unsigned)P2[(size_t)(b * SEQ + t) * OIN + 1536 + ch]);
            }
        }
        __syncthreads();
        {
            const int g = c.tid >> 7, e = c.tid & 127;
            const float ps = pool_s[g * 128 + e];
#pragma unroll 1
            for (int tb = 0; tb < 64; tb += 16) {
                float acc[16];
#pragma unroll
                for (int i = 0; i < 16; ++i) acc[i] = 0.f;
#pragma unroll 4
                for (int cc = 0; cc < 128; ++cc) {
                    const float w = pool_w[(size_t)(g * 128 + cc) * 128 + e];
#pragma unroll
                    for (int i = 0; i < 16; ++i) acc[i] += pl[(tb + i) * 512 + g * 128 + cc] * w;
                }
#pragma unroll
                for (int i = 0; i < 16; ++i) CC[(size_t)(b * SEQ + r * 64 + tb + i) * DM + 512 + g * 128 + e] = (bf16)f2bf(acc[i] * ps);
            }
        }
        __syncthreads();
    }
}

__global__ void __launch_bounds__(512, 2) mk_fwd(Params p) {
    extern __shared__ __attribute__((aligned(16))) unsigned char lds_raw[];
    Ctx c;
    c.lds = (LAS unsigned char*)lds_raw;
    c.tid = threadIdx.x; c.lane = c.tid & 63; c.wave = __builtin_amdgcn_readfirstlane(c.tid >> 6);
    c.G = gridDim.x; { const int bx = blockIdx.x; c.vcu = (c.G % 8 == 0) ? (bx % 8) * (c.G / 8) + bx / 8 : bx; }
    c.gw = c.vcu * 8 + c.wave; c.NGW = c.G * 8;
    volatile LAS unsigned* MISC = (volatile LAS unsigned*)(c.lds + MISC_OFF);
    if (c.tid < 32) MISC[c.tid] = 0u;
    __syncthreads();
    gu32* ctl = (gu32*)(p.ws + WS_CTL);
    XcdBarrier bar; bar.bar = (unsigned*)(ctl + CW_BAR); bar.x = 0; bar.st = nullptr;
    if (!MK_MULTI) bar = xcd_barrier_post((unsigned*)(ctl + CW_BAR), MISC + 8);
    const int lo = p.ph_lo, hi = p.ph_hi;
#define IN(k) (lo <= (k) && (k) < hi)
#define SEAM(k) do { if (IN(k) && IN((k) + 1)) xcd_barrier(bar); } while (0)

    bf16* HB = (bf16*)(p.ws + WS_HB); bf16* QKV = (bf16*)(p.ws + WS_QKV); bf16* CC = (bf16*)(p.ws + WS_CC);
    float* Y = (float*)(p.ws + WS_Y); float* PF = (float*)(p.ws + WS_PF);
    bf16* XG = (bf16*)(p.ws + WS_XG); bf16* HID = (bf16*)(p.ws + WS_HID); bf16* YS = (bf16*)(p.ws + WS_YS);
    const float* GATE = (const float*)(p.ws + WS_GATE);

    if (IN(0)) { ph_prologue(p, c); } SEAM(0);
    if (IN(1)) { ph_modulate0(p, c); } SEAM(1);
    if (IN(2)) { NG g{HB, DM, p.in[I_W0IN], nullptr, EIN, 0, 1 << 30, 0, NTOK, 0, EIN, DM}; ngemm<1>(g, c, EpiF32{PF, EIN}); } SEAM(2);
    if (IN(3)) { ph_qkv_post(p, c); } SEAM(3);
    if (IN(4)) { ph_attn0_naive(p, c); } SEAM(4);
    if (IN(5)) { ph_attn_combine(p, c); } SEAM(5);
    if (IN(6)) { NG g{CC, DM, p.in[I_W0OUT], nullptr, DM, 0, 1 << 30, 0, NTOK, 0, DM, DM}; ngemm<1>(g, c, EpiF32{Y, DM}); } SEAM(6);
    if (IN(7)) { ph_ln1_router(p, c, 0); } SEAM(7);
    if (IN(8)) { ph_topk(p, c, 0); } SEAM(8);
    if (IN(9)) { NG g{XG, DM, p.in[I_WG], p.in[I_WU], FF, (size_t)DM * FF, MR0, 0, NE * MR0, 0, FF, DM}; ngemm<2>(g, c, EpiSwiglu{HID}); } SEAM(9);
    if (IN(10)) { NG g{HID, FF, p.in[I_WD], nullptr, DM, (size_t)FF * DM, MR0, 0, NE * MR0, 0, DM, FF}; ngemm<1>(g, c, EpiGate{YS, GATE}); } SEAM(10);
    if (IN(11)) { ph_combine(p, c, 0); } SEAM(11);
    if (IN(12)) {
        NG g{HB, DM, p.in[I_W1IN], nullptr, OIN, 0, 1 << 30, 0, LAT, 0, OIN, DM}; ngemm<1>(g, c, EpiBf{QKV, OIN, 512, C2});
        NG g2{HB, DM, p.in[I_W1IN], nullptr, OIN, 0, 1 << 30, LAT, NTOK, 512, 1536, DM}; ngemm<1>(g2, c, EpiBf{QKV, OIN, 0, 1.f});
    } SEAM(12);
    if (IN(13)) { ph_mixer1_naive(p, c); } SEAM(13);
    if (IN(14)) { NG g{CC, DM, p.in[I_W1OUT], nullptr, DM, 0, 1 << 30, 0, LAT, 0, DM, DM}; ngemm<1>(g, c, EpiF32{Y, DM}); } SEAM(14);
    if (IN(15)) { ph_ln1_router(p, c, 1); } SEAM(15);
    if (IN(16)) { ph_topk(p, c, 1); } SEAM(16);
    if (IN(17)) { NG g{XG, DM, p.in[I_WG] + (size_t)NE * DM * FF, p.in[I_WU] + (size_t)NE * DM * FF, FF, (size_t)DM * FF, MR1, 0, NE * MR1, 0, FF, DM}; ngemm<2>(g, c, EpiSwiglu{HID}); } SEAM(17);
    if (IN(18)) { NG g{HID, FF, p.in[I_WD] + (size_t)NE * FF * DM, nullptr, DM, (size_t)FF * DM, MR1, 0, NE * MR1, 0, DM, FF}; ngemm<1>(g, c, EpiGate{YS, GATE}); } SEAM(18);
    if (IN(19)) { ph_combine(p, c, 1); }
#undef IN
#undef SEAM
}

extern "C" void kernel_launch(void* const* d_in, const int* in_sizes, int n_in, void* d_out, int out_size, void* d_ws, size_t ws_size, hipStream_t stream) {
    static int grid = 0;
    if (grid == 0) {
        if (n_in != 26 || out_size != LAT * DM || ws_size < WS_END) { fprintf(stderr, "kernel_launch: unexpected shapes (n_in %d out %d ws %zu)\n", n_in, out_size, ws_size); grid = -1; return; }
        int dev = 0, cus = 0;
        if (hipGetDevice(&dev) != hipSuccess || hipDeviceGetAttribute(&cus, hipDeviceAttributeMultiprocessorCount, dev) != hipSuccess) { grid = -1; return; }
        if (hipFuncSetAttribute((const void*)mk_fwd, hipFuncAttributeMaxDynamicSharedMemorySize, LDS_BYTES) != hipSuccess) { fprintf(stderr, "kernel_launch: hipFuncSetAttribute failed\n"); grid = -1; return; }
        int per_cu = 0;
        if (hipOccupancyMaxActiveBlocksPerMultiprocessor(&per_cu, (const void*)mk_fwd, 512, LDS_BYTES) != hipSuccess || per_cu < 1) fprintf(stderr, "kernel_launch: occupancy query says %d\n", per_cu);
        (void)hipGetLastError();
        grid = cus;
    }
    if (grid < 0) return;
    (void)hipMemsetAsync((char*)d_ws + WS_CTL, 0, CTL_ZERO_BYTES, stream);
    Params a{};
    for (int i = 0; i < 26; ++i) a.in[i] = (const float*)d_in[i];
    a.out = (float*)d_out; a.ws = (unsigned char*)d_ws;
#if MK_MULTI
    for (int ph = 0; ph < NPHASE; ++ph) { a.ph_lo = ph; a.ph_hi = ph + 1; hipLaunchKernelGGL(mk_fwd, dim3(grid), dim3(512), LDS_BYTES, stream, a); }
#else
    a.ph_lo = 0; a.ph_hi = NPHASE;
    hipLaunchKernelGGL(mk_fwd, dim3(grid), dim3(512), LDS_BYTES, stream, a);
#endif
}
```

```cpp
#include <hip/hip_runtime.h>
#include <cstdio>
#include <cstdint>

#define GAS __attribute__((address_space(1)))
#define LAS __attribute__((address_space(3)))
typedef unsigned short bf16;
typedef unsigned v4u __attribute__((ext_vector_type(4)));
typedef unsigned v2u __attribute__((ext_vector_type(2)));
typedef float f32x4 __attribute__((ext_vector_type(4)));
typedef float f32x2 __attribute__((ext_vector_type(2)));
typedef float f32x16 __attribute__((ext_vector_type(16)));
typedef GAS unsigned gu32;

#ifndef FAST_GEMM
#define FAST_GEMM 1
#endif
#ifndef MK_MULTI
#define MK_MULTI 0
#endif

constexpr int NBATCH = 8, SEQ = 2048, DM = 1024, NCTX = 256;
constexpr int LAT = NBATCH * SEQ;
constexpr int NTOK = LAT + NBATCH * NCTX;
constexpr int EIN = 2304, OIN = 2048, NE = 16, FF = 2048;
constexpr int MR0 = 2304, MR1 = 2048;
constexpr float LOG2E = 1.4426950408889634f;
constexpr float C2 = 0.125f * LOG2E;
constexpr float ALPHA = 1.4142135623730951f;
constexpr float LN_EPS = 1e-5f, RMS_EPS = 1e-6f;
constexpr float LAM_INIT = 0.2f;
constexpr int NPHASE = 20;

constexpr size_t MiB = 1u << 20;
constexpr size_t WS_CTL = 0, CTL_ZERO_BYTES = 1 * MiB;
constexpr size_t WS_MOD = 1 * MiB;
constexpr size_t WS_ROPE = 1 * MiB + 512 * 1024;
constexpr size_t WS_W0IN = 2 * MiB;
constexpr size_t WS_W0OUT = 7 * MiB;
constexpr size_t WS_W1IN = 9 * MiB;
constexpr size_t WS_W1OUT = 13 * MiB;
constexpr size_t WS_AFF = 16 * MiB;
constexpr size_t WS_INV = 18 * MiB;
constexpr size_t WS_GATE = 20 * MiB;
constexpr size_t WS_WGU = 24 * MiB;
constexpr size_t WS_WDN = 152 * MiB;
constexpr size_t WS_MOE_LSTRIDE = 192 * MiB;
constexpr size_t WS_XS = 408 * MiB;
constexpr size_t WS_HB = 480 * MiB;
constexpr size_t WS_QKV = 516 * MiB;
constexpr size_t WS_CC = 597 * MiB;
constexpr size_t WS_AO = 633 * MiB;
constexpr size_t WS_Y = 705 * MiB;
constexpr size_t WS_XG = 516 * MiB;
constexpr size_t WS_HID = 588 * MiB;
constexpr size_t WS_YS = 732 * MiB;
constexpr size_t WS_PF = 804 * MiB;
constexpr size_t WS_END = 968 * MiB;

constexpr int CW_BAR = 4096;
constexpr int LDS_BYTES = 147456;
constexpr int MISC_OFF = 131072 + 320;

__device__ __forceinline__ float bf2f(unsigned v) { return __uint_as_float(v << 16); }
__device__ __forceinline__ unsigned f2bf(float f) { unsigned u = __float_as_uint(f); return (u + 0x7fffu + ((u >> 16) & 1u)) >> 16; }
__device__ __forceinline__ unsigned pk2(float lo, float hi) { return f2bf(lo) | (f2bf(hi) << 16); }
__device__ __forceinline__ float wave_sum(float v) {
#pragma unroll
    for (int o = 1; o < 64; o <<= 1) v += __shfl_xor(v, o);
    return v;
}
__device__ __forceinline__ float wave_max(float v) {
#pragma unroll
    for (int o = 1; o < 64; o <<= 1) v = fmaxf(v, __shfl_xor(v, o));
    return v;
}
__device__ __forceinline__ void unpack8(const v4u w, float* f) {
    f[0] = bf2f(w.x & 0xffffu); f[1] = __uint_as_float(w.x & 0xffff0000u);
    f[2] = bf2f(w.y & 0xffffu); f[3] = __uint_as_float(w.y & 0xffff0000u);
    f[4] = bf2f(w.z & 0xffffu); f[5] = __uint_as_float(w.z & 0xffff0000u);
    f[6] = bf2f(w.w & 0xffffu); f[7] = __uint_as_float(w.w & 0xffff0000u);
}

#define XB_TMO      128
#define XB_XCNT(j)  (256  + 64 * (j))
#define XB_XSUB(j)  (1280 + 64 * (j))
#define XB_XGEN(j)  (2304 + 64 * (j))
#define XB_TOP      3328
#define XB_TOPGEN   3392
#define XCD_BAR_WORDS 3456
#define XB_SPIN_CAP (1u << 18)
__device__ __forceinline__ unsigned xb_ld(unsigned* p)              { return __hip_atomic_load(p, __ATOMIC_RELAXED, __HIP_MEMORY_SCOPE_AGENT); }
__device__ __forceinline__ unsigned xb_add(unsigned* p, unsigned v) { return __hip_atomic_fetch_add(p, v, __ATOMIC_RELAXED, __HIP_MEMORY_SCOPE_AGENT); }
__device__ __forceinline__ unsigned xb_xcc_id() { return (unsigned)__builtin_amdgcn_s_getreg((3 << 11) | 20) & 0xFu; }
#define XB_SPIN(cond, bar) do { unsigned _sp = 0; while (cond) { __builtin_amdgcn_s_sleep(1); \
    if ((++_sp & 255u) == 0u) { if (xb_ld(&(bar)[XB_TMO])) break; if (_sp > XB_SPIN_CAP) { atomicAdd(&(bar)[XB_TMO], 1u); break; } } } } while (0)
struct XcdBarrier { unsigned* bar; unsigned x; volatile LAS unsigned* st; };
__device__ __forceinline__ XcdBarrier xcd_barrier_post(unsigned* bar, volatile LAS unsigned* st) {
    XcdBarrier b; b.bar = bar; b.x = xb_xcc_id(); b.st = st;
    if (threadIdx.x == 0) (void)xb_add(&bar[XB_XCNT(b.x)], 1u);
    return b;
}
__device__ __forceinline__ void xcd_barrier_complete(unsigned* bar, unsigned x, unsigned& nloc, unsigned& nx) {
    const unsigned G = gridDim.x * gridDim.y * gridDim.z;
    unsigned sum, cnt, mine, sp = 0u;
    for (;;) {
        sum = 0u; cnt = 0u; mine = 0u;
#pragma unroll
        for (unsigned j = 0; j < 16; ++j) { const unsigned c = xb_ld(&bar[XB_XCNT(j)]); sum += c; cnt += (c > 0u) ? 1u : 0u; mine = (j == x) ? c : mine; }
        if (sum == G) break;
        __builtin_amdgcn_s_sleep(1);
        if ((++sp & 255u) == 0u) { if (xb_ld(&bar[XB_TMO])) break; if (sp > XB_SPIN_CAP) { atomicAdd(&bar[XB_TMO], 1u); break; } }
    }
    nloc = mine > 0u ? mine : 1u; nx = cnt > 0u ? cnt : 1u;
}
__device__ __forceinline__ void xcd_barrier(const XcdBarrier& b) {
    asm volatile("s_waitcnt vmcnt(0)" ::: "memory");
    __syncthreads();
    if (threadIdx.x == 0) {
        unsigned* bar = b.bar;
        __builtin_amdgcn_s_waitcnt(0);
        unsigned nloc = b.st[0], nx = b.st[1];
        if (nloc == 0u) { xcd_barrier_complete(bar, b.x, nloc, nx); b.st[0] = nloc; b.st[1] = nx; }
        const unsigned old = xb_add(&bar[XB_XSUB(b.x)], 1u);
        const unsigned gen = old / nloc;
        if (old + 1u == (gen + 1u) * nloc) {
            __builtin_amdgcn_fence(__ATOMIC_RELEASE, "agent");
            asm volatile("s_waitcnt vmcnt(0)" ::: "memory");
            const unsigned og = xb_add(&bar[XB_TOP], 1u);
            const unsigned tg = og / nx;
            if (og + 1u == (tg + 1u) * nx) xb_add(&bar[XB_TOPGEN], 1u);
            else XB_SPIN(xb_ld(&bar[XB_TOPGEN]) == tg, bar);
            __builtin_amdgcn_fence(__ATOMIC_ACQUIRE, "agent");
            xb_add(&bar[XB_XGEN(b.x)], 1u);
            asm volatile("s_waitcnt vmcnt(0)" ::: "memory");
        } else {
            XB_SPIN(xb_ld(&bar[XB_XGEN(b.x)]) == gen, bar);
            __builtin_amdgcn_fence(__ATOMIC_ACQUIRE, "agent");
            asm volatile("s_waitcnt vmcnt(0)" ::: "memory");
        }
    }
    __syncthreads();
}

namespace pg8 {
#define PG8_LAS __attribute__((address_space(3)))
typedef unsigned short bf16_t;
typedef short bf16x8 __attribute__((ext_vector_type(8)));
typedef float f32x4 __attribute__((ext_vector_type(4)));
typedef unsigned u32x4 __attribute__((ext_vector_type(4)));
constexpr int BM = 256, BK = 64, HALF = 128, HTB = HALF * BK * 2  , STAGE_BYTES = 8 * HTB, NXCD = 8, WGM = 8;

__host__ __device__ __forceinline__ int lds_byte(int r, int c) { const int st = (r >> 4) * 2 + (c >> 5), rr = r & 15, cc = c & 31, ob = rr * 64 + cc * 2; return st * 1024 + (ob ^ (((ob >> 9) & 1) << 5)); }
__host__ __device__ __forceinline__ void stage_rc(int b, int& R, int& C) { const int st = b / 1024, sb = b % 1024, swz = sb ^ (((sb >> 9) & 1) << 5); R = (st >> 1) * 16 + swz / 64; C = (st & 1) * 32 + (swz % 64) / 2; }
__host__ __device__ __forceinline__ int perm32(int rho) { const int n = rho >> 4, i = rho & 15; return 8 * (i >> 2) + 4 * n + (i & 3); }

struct Unit { int pm, pn, e; };
struct Gemm { const bf16_t* A; const bf16_t* Bt; int M, N, K; size_t bstride; };

struct StaticOrder {
    int nM, nN, nwg, G, c;
    __host__ __device__ void init(int M, int N, int G_, int c_) { nM = M / BM; nN = N / BM; nwg = nM * nN; G = G_; c = c_; }
    __host__ __device__ bool next(int i, Unit& u) const {
        const long L = (long)i * G + c; if (L >= nwg) return false;
        int wgid = (int)L; { const int q = nwg / NXCD, r = nwg % NXCD, xcd = wgid % NXCD, off = wgid / NXCD; wgid = (xcd < r ? xcd * (q + 1) : r * (q + 1) + (xcd - r) * q) + off; }
        const int nig = WGM * nN, gid = wgid / nig, fm = gid * WGM, gsz = (nM - fm) < WGM ? (nM - fm) : WGM;
        u.pm = fm + ((wgid % nig) % gsz); u.pn = (wgid % nig) / gsz; u.e = 0; return true;
    }
    __device__ __forceinline__ void a_ready(const Unit&) const {}
    __device__ __forceinline__ void done(const Unit&) const {}
};

__device__ __forceinline__ unsigned cvt_pk_bf16(float lo, float hi) { unsigned r; asm volatile("v_cvt_pk_bf16_f32 %0, %1, %2" : "=v"(r) : "v"(lo), "v"(hi)); return r; }
typedef float f32x2 __attribute__((ext_vector_type(2)));
__device__ __forceinline__ f32x2 gelu_pk(f32x2 v) {
    const f32x2 av = __builtin_elementwise_abs(v), d = av * 0.2316418882f + 1.0f;
    f32x2 t; t.x = __builtin_amdgcn_rcpf(d.x); t.y = __builtin_amdgcn_rcpf(d.y);
    f32x2 q = t * 0.5307027145f + (-0.7265760135f); q = q * t + 0.7107068705f; q = q * t + (-0.142248368f); q = q * t + 0.127414796f; q = q * t;
    const f32x2 s = (v * v) * (-0.72134752044f);
    f32x2 e; e.x = __builtin_amdgcn_exp2f(s.x); e.y = __builtin_amdgcn_exp2f(s.y);
    const f32x2 m = v * (q * e), r = v - m;
    f32x2 o; o.x = v.x < 0.f ? m.x : r.x; o.y = v.y < 0.f ? m.y : r.y; return o;
}

template <int ACT  > struct EpiBf16 {
    static constexpr bool PERM = true, AFTER_DRAIN = false; static_assert(ACT == 0 || ACT == 1, "EpiBf16: ACT is 0 (none) or 1 (gelu_pk)");
    bf16_t* O; int ldc; const float* bias; int split_cols; size_t split_stride; float scale0;
    __device__ __forceinline__ void operator()(const f32x4 (&acc)[2][2][4][2], const Unit& u, int wr, int wc, int fr, int fq) const {
        const int row0 = u.pm * BM + wr * 64 + fr; int colt = u.pn * BM; bf16_t* base = O;
        float sc = 1.f; if (split_cols) { const int t = colt / split_cols; base += (size_t)t * split_stride; colt -= t * split_cols; if (t == 0) sc = scale0; }
        const int col0 = colt + wc * 32 + 8 * fq, bcol0 = u.pn * BM + wc * 32 + 8 * fq;
        f32x4 bv[2][2];
#pragma unroll
        for (int bj = 0; bj < 2; ++bj)
#pragma unroll
            for (int n = 0; n < 2; ++n) bv[bj][n] = bias ? *(const f32x4*)(bias + bcol0 + bj * HALF + 4 * n) : (f32x4){0.f, 0.f, 0.f, 0.f};
#pragma unroll
        for (int ai = 0; ai < 2; ++ai)
#pragma unroll
            for (int m = 0; m < 4; ++m) { bf16_t* rowp = base + (size_t)(row0 + ai * HALF + m * 16) * ldc + col0;
#pragma unroll
                for (int bj = 0; bj < 2; ++bj) { f32x4 v0 = acc[ai][bj][m][0] + bv[bj][0], v1 = acc[ai][bj][m][1] + bv[bj][1];
                    if (ACT == 1) { f32x2 a = gelu_pk((f32x2){v0[0], v0[1]}), b = gelu_pk((f32x2){v0[2], v0[3]}), c = gelu_pk((f32x2){v1[0], v1[1]}), d = gelu_pk((f32x2){v1[2], v1[3]});
                        v0 = (f32x4){a.x, a.y, b.x, b.y}; v1 = (f32x4){c.x, c.y, d.x, d.y}; }
                    v0 = v0 * sc; v1 = v1 * sc; u32x4 w; w.x = cvt_pk_bf16(v0[0], v0[1]); w.y = cvt_pk_bf16(v0[2], v0[3]); w.z = cvt_pk_bf16(v1[0], v1[1]); w.w = cvt_pk_bf16(v1[2], v1[3]);
                    *(u32x4*)(rowp + bj * HALF) = w; } }
    }
};

template <class Epi, class Sched, bool ALIGN_EPI = false, bool SP2 = false>
__device__ __forceinline__ void gemm_phase(PG8_LAS unsigned char* lds, const Gemm g, const Sched& S, const Epi& E) {
    const int tid = threadIdx.x, wid = __builtin_amdgcn_readfirstlane(tid >> 6), lane = tid & 63, wr = wid >> 2, wc = wid & 3, fr = lane & 15, fq = lane >> 4;
    const int K = g.K, nt = K / BK;
    unsigned voffA[2], voffB[2];
#pragma unroll
    for (int i = 0; i < 2; ++i) { int R, C; stage_rc(tid * 16 + i * 8192, R, C); const int Rb = Epi::PERM ? ((R & ~31) + perm32(R & 31)) : R;
        voffA[i] = (unsigned)(R * K + C) * 2u; voffB[i] = (unsigned)(Rb * K + C) * 2u; }
    const size_t kstep = (size_t)(BK * 2);
    const size_t hstep = (size_t)HALF * K * 2;
    const size_t tstep = 2 * hstep;
    const unsigned ldsw = (unsigned)wid * 1024u;
    const int aoff = lds_byte(wr * 64 + fr, fq * 8), boff = lds_byte(wc * 32 + fr, fq * 8);
#define PG8_SA(b, h) (((b) * 2 + (h)) * HTB)
#define PG8_SB(b, h) ((4 + (b) * 2 + (h)) * HTB)
#define PG8_STAGE(bufoff, gbase, voff) do { _Pragma("unroll") for (int _i = 0; _i < 2; ++_i) \
        __builtin_amdgcn_global_load_lds((const unsigned*)((const char*)(gbase) + (voff)[_i]), (PG8_LAS unsigned*)(lds + (bufoff) + ldsw + _i * 8192), 16, 0, 0); } while (0)
#define PG8_LDA(dst, b, h) do { _Pragma("unroll") for (int m = 0; m < 4; ++m) _Pragma("unroll") for (int k = 0; k < 2; ++k) dst[m][k] = *(const PG8_LAS bf16x8*)(lds + PG8_SA(b, h) + aoff + m * 2048 + k * 1024); } while (0)
#define PG8_LDB(dst, b, h) do { _Pragma("unroll") for (int n = 0; n < 2; ++n) _Pragma("unroll") for (int k = 0; k < 2; ++k) dst[n][k] = *(const PG8_LAS bf16x8*)(lds + PG8_SB(b, h) + boff + n * 2048 + k * 1024); } while (0)
#define PG8_MMA(ai, bj, At, Bt) do { __builtin_amdgcn_s_setprio(1); _Pragma("unroll") for (int m = 0; m < 4; ++m) _Pragma("unroll") for (int n = 0; n < 2; ++n) _Pragma("unroll") for (int k = 0; k < 2; ++k) \
        acc[ai][bj][m][n] = __builtin_amdgcn_mfma_f32_16x16x32_bf16(Bt[n][k], At[m][k], acc[ai][bj][m][n], 0, 0, 0); __builtin_amdgcn_s_setprio(0); } while (0)
#define PG8_WAIT_V(n) asm volatile("s_waitcnt vmcnt(" #n ")" ::: "memory")
#define PG8_WAIT_L(n) asm volatile("s_waitcnt lgkmcnt(" #n ")" ::: "memory")
#define PG8_BAR __builtin_amdgcn_s_barrier()
#define PG8_SCHED __builtin_amdgcn_sched_barrier(0)
    Unit cur, nxt; int ui = 0;
    if (!S.next(0, cur)) return;
    f32x4 acc[2][2][4][2];
#pragma unroll
    for (int a = 0; a < 2; ++a)
#pragma unroll
        for (int b = 0; b < 2; ++b)
#pragma unroll
            for (int m = 0; m < 4; ++m)
#pragma unroll
                for (int n = 0; n < 2; ++n) acc[a][b][m][n] = (f32x4){0.f, 0.f, 0.f, 0.f};
    bf16x8 At[4][2], B0[2][2], B1[2][2];
    const char* cA = (const char*)g.A + (size_t)cur.pm * tstep; const char* cB = (const char*)g.Bt + (size_t)cur.pn * tstep + (size_t)cur.e * g.bstride;
    S.a_ready(cur);
    if constexpr (SP2) {
        PG8_STAGE(PG8_SB(0, 0), cB, voffB); PG8_STAGE(PG8_SB(0, 1), cB + hstep, voffB); PG8_STAGE(PG8_SA(0, 0), cA, voffA); PG8_STAGE(PG8_SA(0, 1), cA + hstep, voffA);
        if (wr == 1) PG8_BAR;
        PG8_WAIT_V(2); PG8_BAR;
        PG8_STAGE(PG8_SB(1, 0), cB + kstep, voffB); PG8_STAGE(PG8_SA(1, 0), cA + kstep, voffA); PG8_STAGE(PG8_SB(1, 1), cB + hstep + kstep, voffB);
        PG8_WAIT_V(6); PG8_BAR;
    } else {
        PG8_STAGE(PG8_SB(0, 0), cB, voffB); PG8_STAGE(PG8_SA(0, 0), cA, voffA); PG8_STAGE(PG8_SB(0, 1), cB + hstep, voffB); PG8_STAGE(PG8_SA(0, 1), cA + hstep, voffA);
        if (wr == 1) PG8_BAR;
        PG8_WAIT_V(4); PG8_BAR;
        PG8_STAGE(PG8_SB(1, 0), cB + kstep, voffB); PG8_STAGE(PG8_SA(1, 0), cA + kstep, voffA); PG8_STAGE(PG8_SB(1, 1), cB + hstep + kstep, voffB);
        PG8_WAIT_V(6); PG8_BAR;
    }
    for (;;) {
        const bool has_next = S.next(ui + 1, nxt);
        const char* nA = has_next ? (const char*)g.A + (size_t)nxt.pm * tstep : cA; const char* nB = has_next ? (const char*)g.Bt + (size_t)nxt.pn * tstep + (size_t)nxt.e * g.bstride : cB;
        for (int t = 0; t < nt; t += 2) {
            const bool last = (t == nt - 2);
            const char* a1 = cA + (size_t)(t + 1) * kstep;
            const char* a2 = last ? nA : cA + (size_t)(t + 2) * kstep; const char* b2 = last ? nB : cB + (size_t)(t + 2) * kstep;
            const char* a3 = a2 + kstep; const char* b3 = b2 + kstep;
            if (last && has_next) S.a_ready(nxt);
            if constexpr (SP2) {
            PG8_LDB(B0, 0, 0); PG8_LDB(B1, 0, 1); PG8_SCHED; PG8_LDA(At, 0, 0); PG8_STAGE(PG8_SA(1, 1), a1 + hstep, voffA);
            PG8_WAIT_V(8); PG8_WAIT_L(0); PG8_BAR; PG8_MMA(0, 0, At, B0); PG8_MMA(0, 1, At, B1); PG8_BAR; PG8_SCHED;
            PG8_LDA(At, 0, 1); PG8_STAGE(PG8_SB(0, 0), b2, voffB); PG8_STAGE(PG8_SB(0, 1), b2 + hstep, voffB); PG8_STAGE(PG8_SA(0, 0), a2, voffA);
            PG8_WAIT_V(8); PG8_WAIT_L(0); PG8_BAR; PG8_MMA(1, 0, At, B0); PG8_MMA(1, 1, At, B1); PG8_BAR; PG8_SCHED;
            PG8_LDB(B0, 1, 0); PG8_LDB(B1, 1, 1); PG8_SCHED; PG8_LDA(At, 1, 0); PG8_STAGE(PG8_SA(0, 1), a2 + hstep, voffA);
            PG8_WAIT_V(8); PG8_WAIT_L(0); PG8_BAR; PG8_MMA(0, 0, At, B0); PG8_MMA(0, 1, At, B1); PG8_BAR; PG8_SCHED;
            PG8_LDA(At, 1, 1); PG8_STAGE(PG8_SB(1, 0), b3, voffB); PG8_STAGE(PG8_SB(1, 1), b3 + hstep, voffB); PG8_STAGE(PG8_SA(1, 0), a3, voffA);
            PG8_WAIT_V(8); PG8_WAIT_L(0); PG8_BAR; PG8_MMA(1, 0, At, B0); PG8_MMA(1, 1, At, B1); PG8_BAR; PG8_SCHED;
            } else {
            PG8_LDB(B0, 0, 0); PG8_SCHED; PG8_LDA(At, 0, 0); PG8_STAGE(PG8_SA(1, 1), a1 + hstep, voffA);
            PG8_WAIT_L(8); PG8_BAR; PG8_WAIT_L(0); PG8_MMA(0, 0, At, B0); PG8_BAR; PG8_SCHED;
            PG8_LDB(B1, 0, 1); PG8_STAGE(PG8_SB(0, 0), b2, voffB);
            PG8_BAR; PG8_WAIT_L(0); PG8_MMA(0, 1, At, B1); PG8_BAR;
            PG8_LDA(At, 0, 1); PG8_STAGE(PG8_SA(0, 0), a2, voffA);
            PG8_BAR; PG8_WAIT_L(0); PG8_MMA(1, 0, At, B0); PG8_BAR; PG8_SCHED;
            PG8_STAGE(PG8_SB(0, 1), b2 + hstep, voffB);
            PG8_WAIT_V(6); PG8_BAR; PG8_MMA(1, 1, At, B1); PG8_BAR;
            PG8_LDB(B0, 1, 0); PG8_SCHED; PG8_LDA(At, 1, 0); PG8_STAGE(PG8_SA(0, 1), a2 + hstep, voffA);
            PG8_WAIT_L(8); PG8_BAR; PG8_WAIT_L(0); PG8_MMA(0, 0, At, B0); PG8_BAR; PG8_SCHED;
            PG8_LDB(B1, 1, 1); PG8_STAGE(PG8_SB(1, 0), b3, voffB);
            PG8_BAR; PG8_WAIT_L(0); PG8_MMA(0, 1, At, B1); PG8_BAR;
            PG8_LDA(At, 1, 1); PG8_STAGE(PG8_SA(1, 0), a3, voffA);
            PG8_BAR; PG8_WAIT_L(0); PG8_MMA(1, 0, At, B0); PG8_BAR; PG8_SCHED;
            PG8_STAGE(PG8_SB(1, 1), b3 + hstep, voffB);
            PG8_WAIT_V(6); PG8_BAR; PG8_MMA(1, 1, At, B1); PG8_BAR;
            }
        }
        if constexpr (ALIGN_EPI) { if (wr == 0) PG8_BAR; }
        if constexpr (!Epi::AFTER_DRAIN) { E(acc, cur, wr, wc, fr, fq); S.done(cur); }
        if (!has_next) break;
#pragma unroll
        for (int a = 0; a < 2; ++a)
#pragma unroll
            for (int b = 0; b < 2; ++b)
#pragma unroll
                for (int m = 0; m < 4; ++m)
#pragma unroll
                    for (int n = 0; n < 2; ++n) acc[a][b][m][n] = (f32x4){0.f, 0.f, 0.f, 0.f};
        cur = nxt; cA = nA; cB = nB; ++ui;
        if constexpr (ALIGN_EPI) { if (wr == 1) PG8_BAR; }
    }
    PG8_WAIT_V(0);
    if constexpr (!ALIGN_EPI) { if (wr == 0) PG8_BAR; }
    PG8_BAR;
    if constexpr (Epi::AFTER_DRAIN) { E.fused(acc, cur, wr, wc, fr, fq, lds, wid, lane); S.done(cur); }
#undef PG8_SA
#undef PG8_SB
#undef PG8_STAGE
#undef PG8_LDA
#undef PG8_LDB
#undef PG8_MMA
#undef PG8_WAIT_V
#undef PG8_WAIT_L
#undef PG8_BAR
#undef PG8_SCHED
}
}

namespace pg8 {
struct EpiF32P {
    static constexpr bool PERM = false, AFTER_DRAIN = false;
    float* O; int ldc;
    __device__ __forceinline__ void operator()(const f32x4 (&acc)[2][2][4][2], const Unit& u, int wr, int wc, int fr, int fq) const {
        const int row0 = u.pm * BM + wr * 64 + fr, col0 = u.pn * BM + wc * 32 + 4 * fq;
#pragma unroll
        for (int ai = 0; ai < 2; ++ai)
#pragma unroll
            for (int m = 0; m < 4; ++m) { float* rowp = O + (size_t)(row0 + ai * HALF + m * 16) * ldc + col0;
#pragma unroll
                for (int bj = 0; bj < 2; ++bj)
#pragma unroll
                    for (int n = 0; n < 2; ++n) *(f32x4*)(rowp + bj * HALF + n * 16) = acc[ai][bj][m][n]; }
    }
};
struct EpiSwigluP {
    static constexpr bool PERM = true, AFTER_DRAIN = false;
    bf16_t* O; int ldc;
    __device__ __forceinline__ void operator()(const f32x4 (&acc)[2][2][4][2], const Unit& u, int wr, int wc, int fr, int fq) const {
        const int row0 = u.pm * BM + wr * 64 + fr, col0 = u.pn * HALF + wc * 32 + 8 * fq;
#pragma unroll
        for (int ai = 0; ai < 2; ++ai)
#pragma unroll
            for (int m = 0; m < 4; ++m) {
                float h[8];
#pragma unroll
                for (int n = 0; n < 2; ++n)
#pragma unroll
                    for (int j = 0; j < 4; ++j) { const float g = acc[ai][0][m][n][j], up = acc[ai][1][m][n][j];
                        h[4 * n + j] = g * up * __builtin_amdgcn_rcpf(1.0f + __builtin_amdgcn_exp2f(-1.4426950408889634f * g)); }
                u32x4 w; w.x = cvt_pk_bf16(h[0], h[1]); w.y = cvt_pk_bf16(h[2], h[3]); w.z = cvt_pk_bf16(h[4], h[5]); w.w = cvt_pk_bf16(h[6], h[7]);
                *(u32x4*)(O + (size_t)(row0 + ai * HALF + m * 16) * ldc + col0) = w; }
    }
};
struct EpiGateP {
    static constexpr bool PERM = true, AFTER_DRAIN = false;
    bf16_t* O; int ldc; const float* gate;
    __device__ __forceinline__ void operator()(const f32x4 (&acc)[2][2][4][2], const Unit& u, int wr, int wc, int fr, int fq) const {
        const int row0 = u.pm * BM + wr * 64 + fr, col0 = u.pn * BM + wc * 32 + 8 * fq;
#pragma unroll
        for (int ai = 0; ai < 2; ++ai)
#pragma unroll
            for (int m = 0; m < 4; ++m) { const int row = row0 + ai * HALF + m * 16; const float gt = gate[row]; bf16_t* rowp = O + (size_t)row * ldc + col0;
#pragma unroll
                for (int bj = 0; bj < 2; ++bj) { const f32x4 v0 = acc[ai][bj][m][0] * gt, v1 = acc[ai][bj][m][1] * gt;
                    u32x4 w; w.x = cvt_pk_bf16(v0[0], v0[1]); w.y = cvt_pk_bf16(v0[2], v0[3]); w.z = cvt_pk_bf16(v1[0], v1[1]); w.w = cvt_pk_bf16(v1[2], v1[3]);
                    *(u32x4*)(rowp + bj * HALF) = w; } }
    }
};
struct GroupedOrder {
    int nMe, nN, ntot, G, c;
    __device__ void init(int nMe_, int nN_, int ne, int G_, int c_) { nMe = nMe_; nN = nN_; ntot = nMe_ * nN_ * ne; G = G_; c = c_; }
    __device__ bool next(int i, Unit& u) const {
        const int L = i * G + c; if (L >= ntot) return false;
        const int per = nMe * nN, e = L / per, rem = L - e * per;
        u.e = e; u.pn = rem / nMe; u.pm = e * nMe + (rem - u.pn * nMe); return true;
    }
    __device__ __forceinline__ void a_ready(const Unit&) const {}
    __device__ __forceinline__ void done(const Unit&) const {}
};
struct L1InOrder {
    StaticOrder so; int G, c;
    __device__ void init(int G_, int c_) { so.init(16384, 2048, G_, 0); G = G_; c = c_; }
    __device__ bool next(int i, Unit& u) const {
        const int L = i * G + c;
        if (L < 512) { StaticOrder t = so; t.G = 1; t.c = 0; return t.next(L, u); }
        if (L < 544) { const int l = L - 512; u.pm = 64 + (l >> 2); u.pn = 2 + (l & 3); u.e = 0; return true; }
        return false;
    }
    __device__ __forceinline__ void a_ready(const Unit&) const {}
    __device__ __forceinline__ void done(const Unit&) const {}
};
}

struct Params { const float* in[26]; float* out; unsigned char* ws; int ph_lo, ph_hi; };
struct Ctx { LAS unsigned char* lds; int tid, lane, wave, vcu, G, gw, NGW; };
enum { I_X = 0, I_C, I_CTX, I_CCTX, I_ADAW, I_ADAB, I_LNG, I_LNB, I_W0IN, I_W0OUT, I_LQ1, I_LK1, I_LQ2, I_LK2, I_SUBLN, I_QN, I_KN,
       I_W1IN, I_W1OUT, I_RPB, I_POOLW, I_POOLS, I_ROUTER, I_WG, I_WU, I_WD };

__device__ __forceinline__ const float* mod_row(const Params& p, int layer, int row) {
    return (const float*)(p.ws + WS_MOD) + (size_t)(layer * 9 + (row < LAT ? (row >> 11) : 8)) * 6144;
}

__device__ __forceinline__ void ph_prologue(const Params& p, const Ctx& c) {
    const float* cin = p.in[I_C]; const float* cctx = p.in[I_CCTX]; const float* ada_w = p.in[I_ADAW]; const float* ada_b = p.in[I_ADAB];
    float* MOD = (float*)(p.ws + WS_MOD);
    LAS float* sc = (LAS float*)c.lds;
    LAS float* red = sc + 9 * 1024;
    for (int i = c.tid; i < 9 * 1024; i += 512) { const float v = i < 8192 ? cin[i] : cctx[i - 8192]; sc[i] = v / (1.f + expf(-v)); }
    __syncthreads();
    for (int u = c.vcu; u < 256; u += c.G) {
        const int layer = u >> 7, j0 = (u & 127) * 48;
        const int jc = c.tid % 48, kg = c.tid / 48;
        if (kg < 10) {
            float acc[9];
#pragma unroll
            for (int m = 0; m < 9; ++m) acc[m] = 0.f;
            const float* wp = ada_w + (size_t)layer * 1024 * 6144 + j0 + jc;
            for (int k = kg; k < 1024; k += 10) {
                const float w = wp[(size_t)k * 6144];
#pragma unroll
                for (int m = 0; m < 9; ++m) acc[m] += sc[m * 1024 + k] * w;
            }
#pragma unroll
            for (int m = 0; m < 9; ++m) red[(kg * 9 + m) * 48 + jc] = acc[m];
        }
        __syncthreads();
        if (c.tid < 432) {
            const int m = c.tid / 48, j = c.tid % 48; float s = 0.f;
#pragma unroll
            for (int g = 0; g < 10; ++g) s += red[(g * 9 + m) * 48 + j];
            MOD[(size_t)(layer * 9 + m) * 6144 + j0 + j] = s + ada_b[layer * 6144 + j0 + j];
        }
        __syncthreads();
    }
    if (c.vcu == 0) {
        f32x2* R = (f32x2*)(p.ws + WS_ROPE);
        for (int i = c.tid; i < 1024; i += 512) {
            const int pos = i >> 4, f = i & 15;
            const float inv = exp2f(-(float)f * (13.287712379549449f / 16.f));
            const float a = (float)pos * inv;
            const float k = rintf(a * 0.15915494309189535f);
            float rr = fmaf(-k, 6.28125f, a); rr = fmaf(-k, 1.9353071795864769e-3f, rr);
            R[i] = (f32x2){__cosf(rr), __sinf(rr)};
        }
    }
}


__device__ __forceinline__ void transpose_item(const float* W, int ldw, int k0, int n0, bf16* WT, int Kd, int drow0, LAS float* scr, int lane) {
#pragma unroll 8
    for (int i = 0; i < 32; ++i) { const int kk = 2 * i + (lane >> 5); scr[kk * 33 + (lane & 31)] = W[(size_t)(k0 + kk) * ldw + n0 + (lane & 31)]; }
    asm volatile("s_waitcnt lgkmcnt(0)" ::: "memory");
    const int ch = lane & 7;
#pragma unroll
    for (int j = 0; j < 4; ++j) { const int n = (lane >> 3) + 8 * j; const LAS float* sp = scr + (8 * ch) * 33 + n;
        v4u o; o.x = pk2(sp[0 * 33], sp[1 * 33]); o.y = pk2(sp[2 * 33], sp[3 * 33]); o.z = pk2(sp[4 * 33], sp[5 * 33]); o.w = pk2(sp[6 * 33], sp[7 * 33]);
        *(v4u*)(WT + (size_t)(drow0 + n) * Kd + k0 + 8 * ch) = o; }
    asm volatile("s_waitcnt lgkmcnt(0)" ::: "memory");
}
__device__ __forceinline__ void ph_transposes(const Params& p, const Ctx& c) {
    LAS float* scr = (LAS float*)(c.lds + c.wave * 16384);
    constexpr int I0 = 16 * 72, I1 = 16 * 32, I2 = 16 * 64, I3 = 16 * 32, ISM = I0 + I1 + I2 + I3, IEX = 3072, NIT = ISM + 32 * IEX;
    for (int it = c.gw; it < NIT; it += c.NGW) {
        int r = it;
        if (r < I0) { transpose_item(p.in[I_W0IN], EIN, 64 * (r / 72), 32 * (r % 72), (bf16*)(p.ws + WS_W0IN), DM, 32 * (r % 72), scr, c.lane); continue; } r -= I0;
        if (r < I1) { transpose_item(p.in[I_W0OUT], DM, 64 * (r / 32), 32 * (r % 32), (bf16*)(p.ws + WS_W0OUT), DM, 32 * (r % 32), scr, c.lane); continue; } r -= I1;
        if (r < I2) { transpose_item(p.in[I_W1IN], OIN, 64 * (r / 64), 32 * (r % 64), (bf16*)(p.ws + WS_W1IN), DM, 32 * (r % 64), scr, c.lane); continue; } r -= I2;
        if (r < I3) { transpose_item(p.in[I_W1OUT], DM, 64 * (r / 32), 32 * (r % 32), (bf16*)(p.ws + WS_W1OUT), DM, 32 * (r % 32), scr, c.lane); continue; } r -= I3;
        const int ie = r / IEX, q = r - ie * IEX, layer = ie >> 4, e = ie & 15, which = q >> 10, idx = q & 1023;
        if (which < 2) {
            const float* W = (which == 0 ? p.in[I_WG] : p.in[I_WU]) + (size_t)ie * DM * FF;
            const int k0 = 64 * (idx >> 6), n0 = 32 * (idx & 63);
            bf16* WT = (bf16*)(p.ws + WS_WGU + (size_t)layer * WS_MOE_LSTRIDE) + (size_t)e * 4096 * DM;
            transpose_item(W, FF, k0, n0, WT, DM, (n0 >> 7) * 256 + (n0 & 127) + which * 128, scr, c.lane);
        } else {
            const float* W = p.in[I_WD] + (size_t)ie * FF * DM;
            const int k0 = 64 * (idx >> 5), n0 = 32 * (idx & 31);
            bf16* WT = (bf16*)(p.ws + WS_WDN + (size_t)layer * WS_MOE_LSTRIDE) + (size_t)e * DM * FF;
            transpose_item(W, DM, k0, n0, WT, FF, n0, scr, c.lane);
        }
    }
}

__device__ __forceinline__ void ph_modulate0(const Params& p, const Ctx& c) {
    bf16* HB = (bf16*)(p.ws + WS_HB);
    for (int row = c.gw; row < NTOK; row += c.NGW) {
        const float* src = row < LAT ? p.in[I_X] + (size_t)row * DM : p.in[I_CTX] + (size_t)(row - LAT) * DM;
        const float* mod = mod_row(p, 0, row);
#pragma unroll
        for (int j = 0; j < 4; ++j) {
            const int col = 4 * c.lane + 256 * j;
            const f32x4 v = *(const f32x4*)(src + col), sh = *(const f32x4*)(mod + col), s = *(const f32x4*)(mod + 1024 + col);
            const f32x4 h = v * (s + 1.f) + sh;
            *(v2u*)(HB + (size_t)row * DM + col) = (v2u){pk2(h.x, h.y), pk2(h.z, h.w)};
        }
    }
}

struct NG { const bf16* A; int lda; const float* W0; const float* W1; int ldw; size_t wstride; int Mb; int row_begin, row_end, col_begin, col_end, K; };
template <int NB, class Epi>
__device__ __forceinline__ void ngemm(const NG& g, const Ctx& c, const Epi& epi) {
    const int nmt = (g.row_end - g.row_begin) / 32, nnt = (g.col_end - g.col_begin) / 32;
    const int l31 = c.lane & 31, lh = c.lane >> 5;
    for (int t = c.gw; t < nmt * nnt; t += c.NGW) {
        const int mt = t / nnt, nt = t % nnt;
        const int row0 = g.row_begin + mt * 32, col0 = g.col_begin + nt * 32;
        const int e = row0 / g.Mb;
        const bf16* ap = g.A + (size_t)(row0 + l31) * g.lda + lh;
        const float* bp0 = g.W0 + (size_t)e * g.wstride + (size_t)lh * g.ldw + col0 + l31;
        const float* bp1 = NB == 2 ? g.W1 + (size_t)e * g.wstride + (size_t)lh * g.ldw + col0 + l31 : nullptr;
        f32x16 acc0 = {}, acc1 = {};
#pragma unroll 8
        for (int k = 0; k < g.K; k += 2) {
            const float a = bf2f((unsigned)ap[k]);
            const float b0 = bp0[(size_t)k * g.ldw];
            acc0 = __builtin_amdgcn_mfma_f32_32x32x2f32(a, b0, acc0, 0, 0, 0);
            if (NB == 2) { const float b1 = bp1[(size_t)k * g.ldw]; acc1 = __builtin_amdgcn_mfma_f32_32x32x2f32(a, b1, acc1, 0, 0, 0); }
        }
#pragma unroll
        for (int r = 0; r < 16; ++r) {
            const int row = row0 + (r & 3) + 8 * (r >> 2) + 4 * lh, col = col0 + l31;
            epi(row, col, acc0[r], acc1[r]);
        }
    }
}
struct EpiF32 { float* O; int ldc; __device__ __forceinline__ void operator()(int row, int col, float v0, float) const { O[(size_t)row * ldc + col] = v0; } };
struct EpiBf { bf16* O; int ldc; int scale_cols; float sc; __device__ __forceinline__ void operator()(int row, int col, float v0, float) const { O[(size_t)row * ldc + col] = (bf16)f2bf(col < scale_cols ? v0 * sc : v0); } };
struct EpiSwiglu { bf16* O; __device__ __forceinline__ void operator()(int row, int col, float g, float u) const { const float s = g / (1.f + __expf(-g)); O[(size_t)row * FF + col] = (bf16)f2bf(s * u); } };
struct EpiGate { bf16* O; const float* gate; __device__ __forceinline__ void operator()(int row, int col, float v0, float) const { O[(size_t)row * DM + col] = (bf16)f2bf(v0 * gate[row]); } };

template <bool F32IN> __device__ __forceinline__ void ph_qkv_post(const Params& p, const Ctx& c) {
    const float* PF = (const float*)(p.ws + WS_PF);
    bf16* QKV = (bf16*)(p.ws + WS_QKV);
    const f32x2* R = (const f32x2*)(p.ws + WS_ROPE);
    const float* qn = p.in[I_QN]; const float* kn = p.in[I_KN];
    const int d = c.lane;
    const float qg = qn[d], kg = kn[d];
    for (int row = c.gw; row < NTOK; row += c.NGW) {
        const bool lat = row < LAT;
        const int t = row & 2047;
        const int pos = (d < 32) ? (t >> 6) : (t & 63);
        const f32x2 cs = R[pos * 16 + (d & 15)];
        const bool first = (d & 16) == 0;
        for (int hs = 0; hs < 36; ++hs) {
            float v = F32IN ? PF[(size_t)row * EIN + hs * 64 + d] : bf2f((unsigned)QKV[(size_t)row * EIN + hs * 64 + d]);
            const bool isq = hs < 8 || (hs >= 24 && hs < 32);
            const bool isk = (hs >= 8 && hs < 16) || hs == 32 || hs == 33;
            const bool nrm = hs >= 24 && hs < 34;
            if (nrm) { const float ss = wave_sum(v * v); v = v * rsqrtf(ss * (1.f / 64.f) + RMS_EPS) * (hs < 32 ? qg : kg); }
            if ((isq || isk) && lat) { const float pr = __shfl_xor(v, 16); v = first ? v * cs.x - pr * cs.y : v * cs.x + pr * cs.y; }
            if (isq) v *= C2;
            QKV[(size_t)row * EIN + hs * 64 + d] = (bf16)f2bf(v);
        }
    }
}

__device__ __forceinline__ void ph_attn0_naive(const Params& p, const Ctx& c) {
    const bf16* QKV = (const bf16*)(p.ws + WS_QKV);
    bf16* CC = (bf16*)(p.ws + WS_CC);
    float* AO = (float*)(p.ws + WS_AO);
    LAS float* Ks = (LAS float*)c.lds;
    LAS float* Vs = Ks + 4096;
    for (int u = c.vcu; u < 960; u += c.G) {
        const bool isctx = u >= 768;
        int b, vh, qrow, ntiles; bool active = true;
        if (!isctx) { b = u / 96; const int r = u % 96; vh = r >> 2; qrow = b * SEQ + (r & 3) * 512 + c.tid; ntiles = 36; }
        else { const int uu = u - 768; b = uu / 24; vh = uu % 24; qrow = LAT + b * NCTX + (c.tid & 255); active = c.tid < 256; ntiles = 4; }
        int qcol, kcol, vcol;
        if (vh < 16) { const int a = vh >> 2, s = (vh >> 1) & 1, half = vh & 1; qcol = a * 128 + s * 64; kcol = 512 + a * 128 + s * 64; vcol = 1024 + a * 128 + half * 64; }
        else { const int h = vh - 16; qcol = 1536 + h * 64; kcol = 2048 + (h >> 2) * 64; vcol = 2176 + (h >> 2) * 64; }
        float q[64], o[64];
#pragma unroll
        for (int i = 0; i < 8; ++i) { const v4u w = *(const v4u*)(QKV + (size_t)qrow * EIN + qcol + 8 * i); unpack8(w, q + 8 * i); }
#pragma unroll
        for (int i = 0; i < 64; ++i) o[i] = 0.f;
        float m = -1e30f, l = 0.f;
        for (int t = 0; t < ntiles; ++t) {
            const int krow0 = isctx ? LAT + b * NCTX + 64 * t : (t < 32 ? b * SEQ + 64 * t : LAT + b * NCTX + 64 * (t - 32));
            __syncthreads();
            { const int r = c.tid >> 3, ch = c.tid & 7; float f[8];
              const v4u kw = *(const v4u*)(QKV + (size_t)(krow0 + r) * EIN + kcol + ch * 8); unpack8(kw, f);
#pragma unroll
              for (int j = 0; j < 8; ++j) Ks[r * 64 + ch * 8 + j] = f[j];
              const v4u vw = *(const v4u*)(QKV + (size_t)(krow0 + r) * EIN + vcol + ch * 8); unpack8(vw, f);
#pragma unroll
              for (int j = 0; j < 8; ++j) Vs[r * 64 + ch * 8 + j] = f[j]; }
            __syncthreads();
            if (active) {
                for (int kk = 0; kk < 64; ++kk) {
                    float s = 0.f;
#pragma unroll
                    for (int dd = 0; dd < 64; ++dd) s += q[dd] * Ks[kk * 64 + dd];
                    const float mn = fmaxf(m, s), al = exp2f(m - mn), pp = exp2f(s - mn);
                    l = l * al + pp; m = mn;
#pragma unroll
                    for (int dd = 0; dd < 64; ++dd) o[dd] = o[dd] * al + pp * Vs[kk * 64 + dd];
                }
            }
        }
        if (active) {
            const float rl = 1.f / l;
            if (vh < 16) { const int a = vh >> 2, s = (vh >> 1) & 1, half = vh & 1; float* dst = AO + (size_t)qrow * DM + a * 256 + s * 128 + half * 64;
#pragma unroll
                for (int i = 0; i < 16; ++i) *(f32x4*)(dst + 4 * i) = (f32x4){o[4 * i] * rl, o[4 * i + 1] * rl, o[4 * i + 2] * rl, o[4 * i + 3] * rl}; }
            else { bf16* dst = CC + (size_t)qrow * DM + 512 + (vh - 16) * 64;
#pragma unroll
                for (int i = 0; i < 8; ++i) *(v4u*)(dst + 8 * i) = (v4u){pk2(o[8 * i] * rl, o[8 * i + 1] * rl), pk2(o[8 * i + 2] * rl, o[8 * i + 3] * rl), pk2(o[8 * i + 4] * rl, o[8 * i + 5] * rl), pk2(o[8 * i + 6] * rl, o[8 * i + 7] * rl)}; }
        }
    }
}

__device__ __forceinline__ void ph_attn_combine(const Params& p, const Ctx& c) {
    const float* AO = (const float*)(p.ws + WS_AO);
    bf16* CC = (bf16*)(p.ws + WS_CC);
    const float d1 = wave_sum(p.in[I_LQ1][c.lane] * p.in[I_LK1][c.lane]);
    const float d2 = wave_sum(p.in[I_LQ2][c.lane] * p.in[I_LK2][c.lane]);
    const float lam = expf(d1) - expf(d2) + LAM_INIT;
    const float g0 = p.in[I_SUBLN][c.lane] * (1.f - LAM_INIT), g1 = p.in[I_SUBLN][c.lane + 64] * (1.f - LAM_INIT);
    for (int it = c.gw; it < NTOK * 4; it += c.NGW) {
        const int row = it >> 2, a = it & 3;
        const float* src = AO + (size_t)row * DM + a * 256;
        const float x0 = src[c.lane] - lam * src[128 + c.lane], x1 = src[64 + c.lane] - lam * src[192 + c.lane];
        const float ss = wave_sum(x0 * x0 + x1 * x1);
        const float r = rsqrtf(ss * (1.f / 128.f) + RMS_EPS);
        CC[(size_t)row * DM + a * 128 + c.lane] = (bf16)f2bf(x0 * r * g0);
        CC[(size_t)row * DM + a * 128 + 64 + c.lane] = (bf16)f2bf(x1 * r * g1);
    }
}

__device__ __forceinline__ void ph_ln1_router(const Params& p, const Ctx& c, int layer) {
    const float* Y = (const float*)(p.ws + WS_Y);
    float* XS = (float*)(p.ws + WS_XS);
    bf16* HB = (bf16*)(p.ws + WS_HB);
    float* AFF = (float*)(p.ws + WS_AFF);
    const float* lng = p.in[I_LNG] + (size_t)(layer * 2 + 0) * DM; const float* lnb = p.in[I_LNB] + (size_t)(layer * 2 + 0) * DM;
    const float* router = p.in[I_ROUTER] + (size_t)layer * DM * NE;
    const int nrows = layer == 0 ? NTOK : LAT;
    for (int row = c.gw; row < nrows; row += c.NGW) {
        const float* xin = layer == 0 ? (row < LAT ? p.in[I_X] + (size_t)row * DM : p.in[I_CTX] + (size_t)(row - LAT) * DM) : XS + (size_t)row * DM;
        const float* mod = mod_row(p, layer, row);
        f32x4 v[4]; float s = 0.f;
#pragma unroll
        for (int j = 0; j < 4; ++j) { const int col = 4 * c.lane + 256 * j;
            v[j] = *(const f32x4*)(xin + col) * ALPHA + *(const f32x4*)(mod + 2048 + col) * *(const f32x4*)(Y + (size_t)row * DM + col);
            s += (v[j].x + v[j].y) + (v[j].z + v[j].w); }
        const float mean = wave_sum(s) * (1.f / DM); float s2 = 0.f;
#pragma unroll
        for (int j = 0; j < 4; ++j) { v[j] = v[j] - mean; s2 += (v[j].x * v[j].x + v[j].y * v[j].y) + (v[j].z * v[j].z + v[j].w * v[j].w); }
        const float rstd = 1.f / sqrtf(wave_sum(s2) * (1.f / DM) + LN_EPS);
        float lg[16];
#pragma unroll
        for (int e = 0; e < 16; ++e) lg[e] = 0.f;
#pragma unroll
        for (int j = 0; j < 4; ++j) { const int col = 4 * c.lane + 256 * j;
            const f32x4 x1 = v[j] * rstd * *(const f32x4*)(lng + col) + *(const f32x4*)(lnb + col);
            *(f32x4*)(XS + (size_t)row * DM + col) = x1;
            const f32x4 hm = x1 * (*(const f32x4*)(mod + 4096 + col) + 1.f) + *(const f32x4*)(mod + 3072 + col);
            *(v2u*)(HB + (size_t)row * DM + col) = (v2u){pk2(hm.x, hm.y), pk2(hm.z, hm.w)};
#pragma unroll
            for (int q = 0; q < 4; ++q) { const float hv = hm[q]; const float* rp = router + (size_t)(col + q) * NE;
#pragma unroll
                for (int e4 = 0; e4 < 4; ++e4) { const f32x4 rw = *(const f32x4*)(rp + 4 * e4); lg[4 * e4] += hv * rw.x; lg[4 * e4 + 1] += hv * rw.y; lg[4 * e4 + 2] += hv * rw.z; lg[4 * e4 + 3] += hv * rw.w; } } }
        float mx = -1e30f;
#pragma unroll
        for (int e = 0; e < 16; ++e) { lg[e] = wave_sum(lg[e]); mx = fmaxf(mx, lg[e]); }
        float den = 0.f;
#pragma unroll
        for (int e = 0; e < 16; ++e) { lg[e] = expf(lg[e] - mx); den += lg[e]; }
        float mine = 0.f;
#pragma unroll
        for (int e = 0; e < 16; ++e) mine = (c.lane == e) ? lg[e] : mine;
        if (c.lane < 16) AFF[(size_t)row * NE + c.lane] = mine / den;
    }
}

__device__ __forceinline__ void ph_topk(const Params& p, const Ctx& c, int layer) {
    const float* AFF = (const float*)(p.ws + WS_AFF);
    int* INV = (int*)(p.ws + WS_INV);
    float* GATE = (float*)(p.ws + WS_GATE);
    const bf16* HB = (const bf16*)(p.ws + WS_HB);
    bf16* XG = (bf16*)(p.ws + WS_XG);
    LAS float* vals = (LAS float*)c.lds;
    LAS int* sel = (LAS int*)(c.lds + 8192);
    const int MR = layer == 0 ? MR0 : MR1;
    const int ntasks = layer == 0 ? 256 : 128;
    for (int task = c.vcu; task < ntasks; task += c.G) {
        int set, e, n, cap, rowbase, slotbase;
        if (task < 128) { set = task >> 4; e = task & 15; n = SEQ; cap = 256; rowbase = set * SEQ; slotbase = set * 256; }
        else { const int t2 = task - 128; set = t2 >> 4; e = t2 & 15; n = NCTX; cap = 32; rowbase = LAT + set * NCTX; slotbase = 2048 + set * 32; }
        for (int i = c.tid; i < n; i += 512) vals[i] = AFF[(size_t)(rowbase + i) * NE + e];
        __syncthreads();
        float mv[4]; int rk[4];
#pragma unroll
        for (int q = 0; q < 4; ++q) { const int i = c.tid + 512 * q; mv[q] = i < n ? vals[i] : 0.f; rk[q] = 0; }
        for (int j = 0; j < n; ++j) {
            const float vj = vals[j];
#pragma unroll
            for (int q = 0; q < 4; ++q) { const int i = c.tid + 512 * q; rk[q] += (vj > mv[q] || (vj == mv[q] && j < i)) ? 1 : 0; }
        }
#pragma unroll
        for (int q = 0; q < 4; ++q) { const int i = c.tid + 512 * q;
            if (i < n) { int slot = -1;
                if (rk[q] < cap) { slot = e * MR + slotbase + rk[q]; sel[rk[q]] = i; GATE[slot] = mv[q]; }
                INV[(size_t)(rowbase + i) * NE + e] = slot; } }
        __syncthreads();
        for (int s = c.wave; s < cap; s += 8) {
            const bf16* src = HB + (size_t)(rowbase + sel[s]) * DM; bf16* dst = XG + (size_t)(e * MR + slotbase + s) * DM;
            *(v4u*)(dst + 8 * c.lane) = *(const v4u*)(src + 8 * c.lane);
            *(v4u*)(dst + 512 + 8 * c.lane) = *(const v4u*)(src + 512 + 8 * c.lane);
        }
        __syncthreads();
    }
}

__device__ __forceinline__ void ph_combine(const Params& p, const Ctx& c, int layer) {
    const bf16* YS = (const bf16*)(p.ws + WS_YS);
    const int* INV = (const int*)(p.ws + WS_INV);
    float* XS = (float*)(p.ws + WS_XS);
    bf16* HB = (bf16*)(p.ws + WS_HB);
    const float* lng = p.in[I_LNG] + (size_t)(layer * 2 + 1) * DM; const float* lnb = p.in[I_LNB] + (size_t)(layer * 2 + 1) * DM;
    const int nrows = layer == 0 ? NTOK : LAT;
    for (int row = c.gw; row < nrows; row += c.NGW) {
        const float* mod = mod_row(p, layer, row);
        f32x4 mo[4];
#pragma unroll
        for (int j = 0; j < 4; ++j) mo[j] = (f32x4){0.f, 0.f, 0.f, 0.f};
        for (int e = 0; e < NE; ++e) {
            const int s = INV[(size_t)row * NE + e];
            if (s >= 0) {
#pragma unroll
                for (int j = 0; j < 4; ++j) { const v2u w = *(const v2u*)(YS + (size_t)s * DM + 4 * c.lane + 256 * j);
                    mo[j].x += bf2f(w.x & 0xffffu); mo[j].y += __uint_as_float(w.x & 0xffff0000u); mo[j].z += bf2f(w.y & 0xffffu); mo[j].w += __uint_as_float(w.y & 0xffff0000u); }
            }
        }
        f32x4 v[4]; float s = 0.f;
#pragma unroll
        for (int j = 0; j < 4; ++j) { const int col = 4 * c.lane + 256 * j;
            v[j] = *(const f32x4*)(XS + (size_t)row * DM + col) * ALPHA + *(const f32x4*)(mod + 5120 + col) * mo[j];
            s += (v[j].x + v[j].y) + (v[j].z + v[j].w); }
        const float mean = wave_sum(s) * (1.f / DM); float s2 = 0.f;
#pragma unroll
        for (int j = 0; j < 4; ++j) { v[j] = v[j] - mean; s2 += (v[j].x * v[j].x + v[j].y * v[j].y) + (v[j].z * v[j].z + v[j].w * v[j].w); }
        const float rstd = 1.f / sqrtf(wave_sum(s2) * (1.f / DM) + LN_EPS);
        const float* modn = mod_row(p, 1, row);
#pragma unroll
        for (int j = 0; j < 4; ++j) { const int col = 4 * c.lane + 256 * j;
            const f32x4 x2 = v[j] * rstd * *(const f32x4*)(lng + col) + *(const f32x4*)(lnb + col);
            if (layer == 0) {
                *(f32x4*)(XS + (size_t)row * DM + col) = x2;
                const f32x4 h = x2 * (*(const f32x4*)(modn + 1024 + col) + 1.f) + *(const f32x4*)(modn + col);
                *(v2u*)(HB + (size_t)row * DM + col) = (v2u){pk2(h.x, h.y), pk2(h.z, h.w)};
            } else {
                *(f32x4*)(p.out + (size_t)row * DM + col) = x2;
            } }
    }
}

__device__ __forceinline__ void na_key(const float* q, float* o, float& m, float& l, const bf16* kp, const bf16* vp, float bias) {
    float s = bias;
#pragma unroll
    for (int i = 0; i < 8; ++i) { float f[8]; unpack8(*(const v4u*)(kp + 8 * i), f);
#pragma unroll
        for (int j = 0; j < 8; ++j) s += q[8 * i + j] * f[j]; }
    const float mn = fmaxf(m, s), al = exp2f(m - mn), pp = exp2f(s - mn);
    l = l * al + pp; m = mn;
#pragma unroll
    for (int i = 0; i < 8; ++i) { float f[8]; unpack8(*(const v4u*)(vp + 8 * i), f);
#pragma unroll
        for (int j = 0; j < 8; ++j) o[8 * i + j] = o[8 * i + j] * al + pp * f[j]; }
}
__device__ __forceinline__ void ph_mixer1_naive(const Params& p, const Ctx& c) {
    const bf16* P2 = (const bf16*)(p.ws + WS_QKV);
    bf16* CC = (bf16*)(p.ws + WS_CC);
    const float* rpb = p.in[I_RPB]; const float* pool_w = p.in[I_POOLW]; const float* pool_s = p.in[I_POOLS];
    LAS float* pl = (LAS float*)c.lds;
    for (int u = c.vcu; u < 256; u += c.G) {
        const int b = u >> 5, r = u & 31;
        {
            const int h = c.wave, col = c.lane, row = b * SEQ + r * 64 + col;
            const int rs = min(max(r - 4, 0), 24), cs = min(max(col - 8, 0), 48);
            float q[64], o[64];
#pragma unroll
            for (int i = 0; i < 8; ++i) unpack8(*(const v4u*)(P2 + (size_t)row * OIN + h * 64 + 8 * i), q + 8 * i);
#pragma unroll
            for (int i = 0; i < 64; ++i) o[i] = 0.f;
            float m = -1e30f, l = 0.f;
#pragma unroll 1
            for (int i = 0; i < 8; ++i)
#pragma unroll 1
                for (int j = 0; j < 16; ++j) {
                    const int krow = b * SEQ + (rs + i) * 64 + cs + j;
                    const float bias = rpb[(h * 15 + (rs + i - r + 7)) * 31 + (cs + j - col + 15)] * LOG2E;
                    na_key(q, o, m, l, P2 + (size_t)krow * OIN + 512 + h * 64, P2 + (size_t)krow * OIN + 1024 + h * 64, bias);
                }
#pragma unroll 1
            for (int j = 0; j < NCTX; ++j) {
                const int krow = LAT + b * NCTX + j;
                na_key(q, o, m, l, P2 + (size_t)krow * OIN + 512 + h * 64, P2 + (size_t)krow * OIN + 1024 + h * 64, 0.f);
            }
            const float rl = 1.f / l; bf16* dst = CC + (size_t)row * DM + h * 64;
#pragma unroll
            for (int i = 0; i < 8; ++i) *(v4u*)(dst + 8 * i) = (v4u){pk2(o[8 * i] * rl, o[8 * i + 1] * rl), pk2(o[8 * i + 2] * rl, o[8 * i + 3] * rl), pk2(o[8 * i + 4] * rl, o[8 * i + 5] * rl), pk2(o[8 * i + 6] * rl, o[8 * i + 7] * rl)};
        }
        __syncthreads();
        {
            const int ch = c.tid, g = ch >> 7, half = 1 << g;
            for (int tt = 0; tt < 64; ++tt) {
                const int t = r * 64 + tt, lo = max(t - half, 0), hi = min(t + half, SEQ);
                float s = 0.f;
                for (int t2 = lo; t2 < hi; ++t2) s += bf2f((unsigned)P2[(size_t)(b * SEQ + t2) * OIN + 1536 + ch]);
                pl[tt * 512 + ch] = s / (float)(hi - lo) - bf2f((unsigned)P2[(size_t)(b * SEQ + t) * OIN + 1536 + ch]);
            }
        }
        __syncthreads();
        {
            const int g = c.tid >> 7, e = c.tid & 127;
            const float ps = pool_s[g * 128 + e];
#pragma unroll 1
            for (int tb = 0; tb < 64; tb += 16) {
                float acc[16];
#pragma unroll
                for (int i = 0; i < 16; ++i) acc[i] = 0.f;
#pragma unroll 4
                for (int cc = 0; cc < 128; ++cc) {
                    const float w = pool_w[(size_t)(g * 128 + cc) * 128 + e];
#pragma unroll
                    for (int i = 0; i < 16; ++i) acc[i] += pl[(tb + i) * 512 + g * 128 + cc] * w;
                }
#pragma unroll
                for (int i = 0; i < 16; ++i) CC[(size_t)(b * SEQ + r * 64 + tb + i) * DM + 512 + g * 128 + e] = (bf16)f2bf(acc[i] * ps);
            }
        }
        __syncthreads();
    }
}

__global__ void __launch_bounds__(512, 2) mk_fwd(Params p) {
    extern __shared__ __attribute__((aligned(16))) unsigned char lds_raw[];
    Ctx c;
    c.lds = (LAS unsigned char*)lds_raw;
    c.tid = threadIdx.x; c.lane = c.tid & 63; c.wave = __builtin_amdgcn_readfirstlane(c.tid >> 6);
    c.G = gridDim.x; { const int bx = blockIdx.x; c.vcu = (c.G % 8 == 0) ? (bx % 8) * (c.G / 8) + bx / 8 : bx; }
    c.gw = c.vcu * 8 + c.wave; c.NGW = c.G * 8;
    volatile LAS unsigned* MISC = (volatile LAS unsigned*)(c.lds + MISC_OFF);
    if (c.tid < 32) MISC[c.tid] = 0u;
    __syncthreads();
    gu32* ctl = (gu32*)(p.ws + WS_CTL);
    XcdBarrier bar; bar.bar = (unsigned*)(ctl + CW_BAR); bar.x = 0; bar.st = nullptr;
    if (!MK_MULTI) bar = xcd_barrier_post((unsigned*)(ctl + CW_BAR), MISC + 8);
    const int lo = p.ph_lo, hi = p.ph_hi;
#define IN(k) (lo <= (k) && (k) < hi)
#define SEAM(k) do { if (IN(k) && IN((k) + 1)) xcd_barrier(bar); } while (0)

    bf16* HB = (bf16*)(p.ws + WS_HB); bf16* QKV = (bf16*)(p.ws + WS_QKV); bf16* CC = (bf16*)(p.ws + WS_CC);
    float* Y = (float*)(p.ws + WS_Y); float* PF = (float*)(p.ws + WS_PF);
    bf16* XG = (bf16*)(p.ws + WS_XG); bf16* HID = (bf16*)(p.ws + WS_HID); bf16* YS = (bf16*)(p.ws + WS_YS);
    const float* GATE = (const float*)(p.ws + WS_GATE);

    if (IN(0)) { ph_prologue(p, c); if (FAST_GEMM) { __syncthreads(); ph_transposes(p, c); } } SEAM(0);
    if (IN(1)) { ph_modulate0(p, c); } SEAM(1);
    if (IN(2)) {
        if (FAST_GEMM) { pg8::Gemm g{HB, (const bf16*)(p.ws + WS_W0IN), NTOK, EIN, DM, 0}; pg8::StaticOrder S; S.init(NTOK, EIN, c.G, (int)blockIdx.x);
            pg8::EpiBf16<0> E{QKV, EIN, nullptr, 0, 0, 1.f}; pg8::gemm_phase<pg8::EpiBf16<0>, pg8::StaticOrder, true, true>(c.lds, g, S, E); }
        else { NG g{HB, DM, p.in[I_W0IN], nullptr, EIN, 0, 1 << 30, 0, NTOK, 0, EIN, DM}; ngemm<1>(g, c, EpiF32{PF, EIN}); }
    } SEAM(2);
    if (IN(3)) { if (FAST_GEMM) ph_qkv_post<false>(p, c); else ph_qkv_post<true>(p, c); } SEAM(3);
    if (IN(4)) { ph_attn0_naive(p, c); } SEAM(4);
    if (IN(5)) { ph_attn_combine(p, c); } SEAM(5);
    if (IN(6)) {
        if (FAST_GEMM) { pg8::Gemm g{CC, (const bf16*)(p.ws + WS_W0OUT), NTOK, DM, DM, 0}; pg8::StaticOrder S; S.init(NTOK, DM, c.G, (int)blockIdx.x);
            pg8::EpiF32P E{Y, DM}; pg8::gemm_phase<pg8::EpiF32P, pg8::StaticOrder, true, true>(c.lds, g, S, E); }
        else { NG g{CC, DM, p.in[I_W0OUT], nullptr, DM, 0, 1 << 30, 0, NTOK, 0, DM, DM}; ngemm<1>(g, c, EpiF32{Y, DM}); }
    } SEAM(6);
    if (IN(7)) { ph_ln1_router(p, c, 0); } SEAM(7);
    if (IN(8)) { ph_topk(p, c, 0); } SEAM(8);
    if (IN(9)) {
        if (FAST_GEMM) { pg8::Gemm g{XG, (const bf16*)(p.ws + WS_WGU), NE * MR0, 4096, DM, (size_t)4096 * DM * 2}; pg8::GroupedOrder S; S.init(MR0 / 256, 16, NE, c.G, c.vcu);
            pg8::EpiSwigluP E{HID, FF}; pg8::gemm_phase<pg8::EpiSwigluP, pg8::GroupedOrder, true, true>(c.lds, g, S, E); }
        else { NG g{XG, DM, p.in[I_WG], p.in[I_WU], FF, (size_t)DM * FF, MR0, 0, NE * MR0, 0, FF, DM}; ngemm<2>(g, c, EpiSwiglu{HID}); }
    } SEAM(9);
    if (IN(10)) {
        if (FAST_GEMM) { pg8::Gemm g{HID, (const bf16*)(p.ws + WS_WDN), NE * MR0, DM, FF, (size_t)DM * FF * 2}; pg8::GroupedOrder S; S.init(MR0 / 256, 4, NE, c.G, c.vcu);
            pg8::EpiGateP E{YS, DM, GATE}; pg8::gemm_phase<pg8::EpiGateP, pg8::GroupedOrder, true, true>(c.lds, g, S, E); }
        else { NG g{HID, FF, p.in[I_WD], nullptr, DM, (size_t)FF * DM, MR0, 0, NE * MR0, 0, DM, FF}; ngemm<1>(g, c, EpiGate{YS, GATE}); }
    } SEAM(10);
    if (IN(11)) { ph_combine(p, c, 0); } SEAM(11);
    if (IN(12)) {
        if (FAST_GEMM) { pg8::Gemm g{HB, (const bf16*)(p.ws + WS_W1IN), NTOK, OIN, DM, 0}; pg8::L1InOrder S; S.init(c.G, (int)blockIdx.x);
            pg8::EpiBf16<0> E{QKV, OIN, nullptr, 512, 512, C2}; pg8::gemm_phase<pg8::EpiBf16<0>, pg8::L1InOrder, true, true>(c.lds, g, S, E); }
        else {
        NG g{HB, DM, p.in[I_W1IN], nullptr, OIN, 0, 1 << 30, 0, LAT, 0, OIN, DM}; ngemm<1>(g, c, EpiBf{QKV, OIN, 512, C2});
        NG g2{HB, DM, p.in[I_W1IN], nullptr, OIN, 0, 1 << 30, LAT, NTOK, 512, 1536, DM}; ngemm<1>(g2, c, EpiBf{QKV, OIN, 0, 1.f}); }
    } SEAM(12);
    if (IN(13)) { ph_mixer1_naive(p, c); } SEAM(13);
    if (IN(14)) {
        if (FAST_GEMM) { pg8::Gemm g{CC, (const bf16*)(p.ws + WS_W1OUT), LAT, DM, DM, 0}; pg8::StaticOrder S; S.init(LAT, DM, c.G, (int)blockIdx.x);
            pg8::EpiF32P E{Y, DM}; pg8::gemm_phase<pg8::EpiF32P, pg8::StaticOrder, true, true>(c.lds, g, S, E); }
        else { NG g{CC, DM, p.in[I_W1OUT], nullptr, DM, 0, 1 << 30, 0, LAT, 0, DM, DM}; ngemm<1>(g, c, EpiF32{Y, DM}); }
    } SEAM(14);
    if (IN(15)) { ph_ln1_router(p, c, 1); } SEAM(15);
    if (IN(16)) { ph_topk(p, c, 1); } SEAM(16);
    if (IN(17)) {
        if (FAST_GEMM) { pg8::Gemm g{XG, (const bf16*)(p.ws + WS_WGU + WS_MOE_LSTRIDE), NE * MR1, 4096, DM, (size_t)4096 * DM * 2}; pg8::GroupedOrder S; S.init(MR1 / 256, 16, NE, c.G, c.vcu);
            pg8::EpiSwigluP E{HID, FF}; pg8::gemm_phase<pg8::EpiSwigluP, pg8::GroupedOrder, true, true>(c.lds, g, S, E); }
        else { NG g{XG, DM, p.in[I_WG] + (size_t)NE * DM * FF, p.in[I_WU] + (size_t)NE * DM * FF, FF, (size_t)DM * FF, MR1, 0, NE * MR1, 0, FF, DM}; ngemm<2>(g, c, EpiSwiglu{HID}); }
    } SEAM(17);
    if (IN(18)) {
        if (FAST_GEMM) { pg8::Gemm g{HID, (const bf16*)(p.ws + WS_WDN + WS_MOE_LSTRIDE), NE * MR1, DM, FF, (size_t)DM * FF * 2}; pg8::GroupedOrder S; S.init(MR1 / 256, 4, NE, c.G, c.vcu);
            pg8::EpiGateP E{YS, DM, GATE}; pg8::gemm_phase<pg8::EpiGateP, pg8::GroupedOrder, true, true>(c.lds, g, S, E); }
        else { NG g{HID, FF, p.in[I_WD] + (size_t)NE * FF * DM, nullptr, DM, (size_t)FF * DM, MR1, 0, NE * MR1, 0, DM, FF}; ngemm<1>(g, c, EpiGate{YS, GATE}); }
    } SEAM(18);
    if (IN(19)) { ph_combine(p, c, 1); }
#undef IN
#undef SEAM
}

extern "C" void kernel_launch(void* const* d_in, const int* in_sizes, int n_in, void* d_out, int out_size, void* d_ws, size_t ws_size, hipStream_t stream) {
    static int grid = 0;
    if (grid == 0) {
        if (n_in != 26 || out_size != LAT * DM || ws_size < WS_END) { fprintf(stderr, "kernel_launch: unexpected shapes (n_in %d out %d ws %zu)\n", n_in, out_size, ws_size); grid = -1; return; }
        int dev = 0, cus = 0;
        if (hipGetDevice(&dev) != hipSuccess || hipDeviceGetAttribute(&cus, hipDeviceAttributeMultiprocessorCount, dev) != hipSuccess) { grid = -1; return; }
        if (hipFuncSetAttribute((const void*)mk_fwd, hipFuncAttributeMaxDynamicSharedMemorySize, LDS_BYTES) != hipSuccess) { fprintf(stderr, "kernel_launch: hipFuncSetAttribute failed\n"); grid = -1; return; }
        int per_cu = 0;
        if (hipOccupancyMaxActiveBlocksPerMultiprocessor(&per_cu, (const void*)mk_fwd, 512, LDS_BYTES) != hipSuccess || per_cu < 1) fprintf(stderr, "kernel_launch: occupancy query says %d\n", per_cu);
        (void)hipGetLastError();
        grid = cus;
    }
    if (grid < 0) return;
    (void)hipMemsetAsync((char*)d_ws + WS_CTL, 0, CTL_ZERO_BYTES, stream);
    Params a{};
    for (int i = 0; i < 26; ++i) a.in[i] = (const float*)d_in[i];
    a.out = (float*)d_out; a.ws = (unsigned char*)d_ws;
#if MK_MULTI
    for (int ph = 0; ph < NPHASE; ++ph) { a.ph_lo = ph; a.ph_hi = ph + 1; hipLaunchKernelGGL(mk_fwd, dim3(grid), dim3(512), LDS_BYTES, stream, a); }
#else
    a.ph_lo = 0; a.ph_hi = NPHASE;
    hipLaunchKernelGGL(mk_fwd, dim3(grid), dim3(512), LDS_BYTES, stream, a);
#endif
}
```

```cpp
#include <hip/hip_runtime.h>
#include <cstdio>
#include <cstdint>

#define GAS __attribute__((address_space(1)))
#define LAS __attribute__((address_space(3)))
typedef unsigned short bf16;
typedef unsigned v4u __attribute__((ext_vector_type(4)));
typedef unsigned v2u __attribute__((ext_vector_type(2)));
typedef float f32x4 __attribute__((ext_vector_type(4)));
typedef float f32x2 __attribute__((ext_vector_type(2)));
typedef float f32x16 __attribute__((ext_vector_type(16)));
typedef GAS unsigned gu32;

#ifndef FAST_ATTN
#define FAST_ATTN 1
#endif
#ifndef FAST_GEMM
#define FAST_GEMM 1
#endif
#ifndef MK_MULTI
#define MK_MULTI 0
#endif

constexpr int NBATCH = 8, SEQ = 2048, DM = 1024, NCTX = 256;
constexpr int LAT = NBATCH * SEQ;
constexpr int NTOK = LAT + NBATCH * NCTX;
constexpr int EIN = 2304, OIN = 2048, NE = 16, FF = 2048;
constexpr int MR0 = 2304, MR1 = 2048;
constexpr float LOG2E = 1.4426950408889634f;
constexpr float C2 = 0.125f * LOG2E;
constexpr float ALPHA = 1.4142135623730951f;
constexpr float LN_EPS = 1e-5f, RMS_EPS = 1e-6f;
constexpr float LAM_INIT = 0.2f;
constexpr int NPHASE = 20;

constexpr size_t MiB = 1u << 20;
constexpr size_t WS_CTL = 0, CTL_ZERO_BYTES = 1 * MiB;
constexpr size_t WS_MOD = 1 * MiB;
constexpr size_t WS_ROPE = 1 * MiB + 512 * 1024;
constexpr size_t WS_W0IN = 2 * MiB;
constexpr size_t WS_W0OUT = 7 * MiB;
constexpr size_t WS_W1IN = 9 * MiB;
constexpr size_t WS_W1OUT = 13 * MiB;
constexpr size_t WS_AFF = 16 * MiB;
constexpr size_t WS_INV = 18 * MiB;
constexpr size_t WS_GATE = 20 * MiB;
constexpr size_t WS_WGU = 24 * MiB;
constexpr size_t WS_WDN = 152 * MiB;
constexpr size_t WS_MOE_LSTRIDE = 192 * MiB;
constexpr size_t WS_XS = 408 * MiB;
constexpr size_t WS_HB = 480 * MiB;
constexpr size_t WS_QKV = 516 * MiB;
constexpr size_t WS_CC = 597 * MiB;
constexpr size_t WS_AO = 633 * MiB;
constexpr size_t WS_Y = 705 * MiB;
constexpr size_t WS_XG = 516 * MiB;
constexpr size_t WS_HID = 588 * MiB;
constexpr size_t WS_YS = 732 * MiB;
constexpr size_t WS_PF = 804 * MiB;
constexpr size_t WS_END = 968 * MiB;

constexpr int CW_BAR = 4096;
constexpr int LDS_BYTES = 147456;
constexpr int MISC_OFF = 131072 + 320;

__device__ __forceinline__ float bf2f(unsigned v) { return __uint_as_float(v << 16); }
__device__ __forceinline__ unsigned f2bf(float f) { unsigned u = __float_as_uint(f); return (u + 0x7fffu + ((u >> 16) & 1u)) >> 16; }
__device__ __forceinline__ unsigned pk2(float lo, float hi) { return f2bf(lo) | (f2bf(hi) << 16); }
__device__ __forceinline__ float wave_sum(float v) {
#pragma unroll
    for (int o = 1; o < 64; o <<= 1) v += __shfl_xor(v, o);
    return v;
}
__device__ __forceinline__ float wave_max(float v) {
#pragma unroll
    for (int o = 1; o < 64; o <<= 1) v = fmaxf(v, __shfl_xor(v, o));
    return v;
}
__device__ __forceinline__ void unpack8(const v4u w, float* f) {
    f[0] = bf2f(w.x & 0xffffu); f[1] = __uint_as_float(w.x & 0xffff0000u);
    f[2] = bf2f(w.y & 0xffffu); f[3] = __uint_as_float(w.y & 0xffff0000u);
    f[4] = bf2f(w.z & 0xffffu); f[5] = __uint_as_float(w.z & 0xffff0000u);
    f[6] = bf2f(w.w & 0xffffu); f[7] = __uint_as_float(w.w & 0xffff0000u);
}

#define XB_TMO      128
#define XB_XCNT(j)  (256  + 64 * (j))
#define XB_XSUB(j)  (1280 + 64 * (j))
#define XB_XGEN(j)  (2304 + 64 * (j))
#define XB_TOP      3328
#define XB_TOPGEN   3392
#define XCD_BAR_WORDS 3456
#define XB_SPIN_CAP (1u << 18)
__device__ __forceinline__ unsigned xb_ld(unsigned* p)              { return __hip_atomic_load(p, __ATOMIC_RELAXED, __HIP_MEMORY_SCOPE_AGENT); }
__device__ __forceinline__ unsigned xb_add(unsigned* p, unsigned v) { return __hip_atomic_fetch_add(p, v, __ATOMIC_RELAXED, __HIP_MEMORY_SCOPE_AGENT); }
__device__ __forceinline__ unsigned xb_xcc_id() { return (unsigned)__builtin_amdgcn_s_getreg((3 << 11) | 20) & 0xFu; }
#define XB_SPIN(cond, bar) do { unsigned _sp = 0; while (cond) { __builtin_amdgcn_s_sleep(1); \
    if ((++_sp & 255u) == 0u) { if (xb_ld(&(bar)[XB_TMO])) break; if (_sp > XB_SPIN_CAP) { atomicAdd(&(bar)[XB_TMO], 1u); break; } } } } while (0)
struct XcdBarrier { unsigned* bar; unsigned x; volatile LAS unsigned* st; };
__device__ __forceinline__ XcdBarrier xcd_barrier_post(unsigned* bar, volatile LAS unsigned* st) {
    XcdBarrier b; b.bar = bar; b.x = xb_xcc_id(); b.st = st;
    if (threadIdx.x == 0) (void)xb_add(&bar[XB_XCNT(b.x)], 1u);
    return b;
}
__device__ __forceinline__ void xcd_barrier_complete(unsigned* bar, unsigned x, unsigned& nloc, unsigned& nx) {
    const unsigned G = gridDim.x * gridDim.y * gridDim.z;
    unsigned sum, cnt, mine, sp = 0u;
    for (;;) {
        sum = 0u; cnt = 0u; mine = 0u;
#pragma unroll
        for (unsigned j = 0; j < 16; ++j) { const unsigned c = xb_ld(&bar[XB_XCNT(j)]); sum += c; cnt += (c > 0u) ? 1u : 0u; mine = (j == x) ? c : mine; }
        if (sum == G) break;
        __builtin_amdgcn_s_sleep(1);
        if ((++sp & 255u) == 0u) { if (xb_ld(&bar[XB_TMO])) break; if (sp > XB_SPIN_CAP) { atomicAdd(&bar[XB_TMO], 1u); break; } }
    }
    nloc = mine > 0u ? mine : 1u; nx = cnt > 0u ? cnt : 1u;
}
__device__ __forceinline__ void xcd_barrier(const XcdBarrier& b) {
    asm volatile("s_waitcnt vmcnt(0)" ::: "memory");
    __syncthreads();
    if (threadIdx.x == 0) {
        unsigned* bar = b.bar;
        __builtin_amdgcn_s_waitcnt(0);
        unsigned nloc = b.st[0], nx = b.st[1];
        if (nloc == 0u) { xcd_barrier_complete(bar, b.x, nloc, nx); b.st[0] = nloc; b.st[1] = nx; }
        const unsigned old = xb_add(&bar[XB_XSUB(b.x)], 1u);
        const unsigned gen = old / nloc;
        if (old + 1u == (gen + 1u) * nloc) {
            __builtin_amdgcn_fence(__ATOMIC_RELEASE, "agent");
            asm volatile("s_waitcnt vmcnt(0)" ::: "memory");
            const unsigned og = xb_add(&bar[XB_TOP], 1u);
            const unsigned tg = og / nx;
            if (og + 1u == (tg + 1u) * nx) xb_add(&bar[XB_TOPGEN], 1u);
            else XB_SPIN(xb_ld(&bar[XB_TOPGEN]) == tg, bar);
            __builtin_amdgcn_fence(__ATOMIC_ACQUIRE, "agent");
            xb_add(&bar[XB_XGEN(b.x)], 1u);
            asm volatile("s_waitcnt vmcnt(0)" ::: "memory");
        } else {
            XB_SPIN(xb_ld(&bar[XB_XGEN(b.x)]) == gen, bar);
            __builtin_amdgcn_fence(__ATOMIC_ACQUIRE, "agent");
            asm volatile("s_waitcnt vmcnt(0)" ::: "memory");
        }
    }
    __syncthreads();
}

namespace pg8 {
#define PG8_LAS __attribute__((address_space(3)))
typedef unsigned short bf16_t;
typedef short bf16x8 __attribute__((ext_vector_type(8)));
typedef float f32x4 __attribute__((ext_vector_type(4)));
typedef unsigned u32x4 __attribute__((ext_vector_type(4)));
constexpr int BM = 256, BK = 64, HALF = 128, HTB = HALF * BK * 2  , STAGE_BYTES = 8 * HTB, NXCD = 8, WGM = 8;

__host__ __device__ __forceinline__ int lds_byte(int r, int c) { const int st = (r >> 4) * 2 + (c >> 5), rr = r & 15, cc = c & 31, ob = rr * 64 + cc * 2; return st * 1024 + (ob ^ (((ob >> 9) & 1) << 5)); }
__host__ __device__ __forceinline__ void stage_rc(int b, int& R, int& C) { const int st = b / 1024, sb = b % 1024, swz = sb ^ (((sb >> 9) & 1) << 5); R = (st >> 1) * 16 + swz / 64; C = (st & 1) * 32 + (swz % 64) / 2; }
__host__ __device__ __forceinline__ int perm32(int rho) { const int n = rho >> 4, i = rho & 15; return 8 * (i >> 2) + 4 * n + (i & 3); }

struct Unit { int pm, pn, e; };
struct Gemm { const bf16_t* A; const bf16_t* Bt; int M, N, K; size_t bstride; };

struct StaticOrder {
    int nM, nN, nwg, G, c;
    __host__ __device__ void init(int M, int N, int G_, int c_) { nM = M / BM; nN = N / BM; nwg = nM * nN; G = G_; c = c_; }
    __host__ __device__ bool next(int i, Unit& u) const {
        const long L = (long)i * G + c; if (L >= nwg) return false;
        int wgid = (int)L; { const int q = nwg / NXCD, r = nwg % NXCD, xcd = wgid % NXCD, off = wgid / NXCD; wgid = (xcd < r ? xcd * (q + 1) : r * (q + 1) + (xcd - r) * q) + off; }
        const int nig = WGM * nN, gid = wgid / nig, fm = gid * WGM, gsz = (nM - fm) < WGM ? (nM - fm) : WGM;
        u.pm = fm + ((wgid % nig) % gsz); u.pn = (wgid % nig) / gsz; u.e = 0; return true;
    }
    __device__ __forceinline__ void a_ready(const Unit&) const {}
    __device__ __forceinline__ void done(const Unit&) const {}
};

__device__ __forceinline__ unsigned cvt_pk_bf16(float lo, float hi) { unsigned r; asm volatile("v_cvt_pk_bf16_f32 %0, %1, %2" : "=v"(r) : "v"(lo), "v"(hi)); return r; }
typedef float f32x2 __attribute__((ext_vector_type(2)));
__device__ __forceinline__ f32x2 gelu_pk(f32x2 v) {
    const f32x2 av = __builtin_elementwise_abs(v), d = av * 0.2316418882f + 1.0f;
    f32x2 t; t.x = __builtin_amdgcn_rcpf(d.x); t.y = __builtin_amdgcn_rcpf(d.y);
    f32x2 q = t * 0.5307027145f + (-0.7265760135f); q = q * t + 0.7107068705f; q = q * t + (-0.142248368f); q = q * t + 0.127414796f; q = q * t;
    const f32x2 s = (v * v) * (-0.72134752044f);
    f32x2 e; e.x = __builtin_amdgcn_exp2f(s.x); e.y = __builtin_amdgcn_exp2f(s.y);
    const f32x2 m = v * (q * e), r = v - m;
    f32x2 o; o.x = v.x < 0.f ? m.x : r.x; o.y = v.y < 0.f ? m.y : r.y; return o;
}

template <int ACT  > struct EpiBf16 {
    static constexpr bool PERM = true, AFTER_DRAIN = false; static_assert(ACT == 0 || ACT == 1, "EpiBf16: ACT is 0 (none) or 1 (gelu_pk)");
    bf16_t* O; int ldc; const float* bias; int split_cols; size_t split_stride; float scale0;
    __device__ __forceinline__ void operator()(const f32x4 (&acc)[2][2][4][2], const Unit& u, int wr, int wc, int fr, int fq) const {
        const int row0 = u.pm * BM + wr * 64 + fr; int colt = u.pn * BM; bf16_t* base = O;
        float sc = 1.f; if (split_cols) { const int t = colt / split_cols; base += (size_t)t * split_stride; colt -= t * split_cols; if (t == 0) sc = scale0; }
        const int col0 = colt + wc * 32 + 8 * fq, bcol0 = u.pn * BM + wc * 32 + 8 * fq;
        f32x4 bv[2][2];
#pragma unroll
        for (int bj = 0; bj < 2; ++bj)
#pragma unroll
            for (int n = 0; n < 2; ++n) bv[bj][n] = bias ? *(const f32x4*)(bias + bcol0 + bj * HALF + 4 * n) : (f32x4){0.f, 0.f, 0.f, 0.f};
#pragma unroll
        for (int ai = 0; ai < 2; ++ai)
#pragma unroll
            for (int m = 0; m < 4; ++m) { bf16_t* rowp = base + (size_t)(row0 + ai * HALF + m * 16) * ldc + col0;
#pragma unroll
                for (int bj = 0; bj < 2; ++bj) { f32x4 v0 = acc[ai][bj][m][0] + bv[bj][0], v1 = acc[ai][bj][m][1] + bv[bj][1];
                    if (ACT == 1) { f32x2 a = gelu_pk((f32x2){v0[0], v0[1]}), b = gelu_pk((f32x2){v0[2], v0[3]}), c = gelu_pk((f32x2){v1[0], v1[1]}), d = gelu_pk((f32x2){v1[2], v1[3]});
                        v0 = (f32x4){a.x, a.y, b.x, b.y}; v1 = (f32x4){c.x, c.y, d.x, d.y}; }
                    v0 = v0 * sc; v1 = v1 * sc; u32x4 w; w.x = cvt_pk_bf16(v0[0], v0[1]); w.y = cvt_pk_bf16(v0[2], v0[3]); w.z = cvt_pk_bf16(v1[0], v1[1]); w.w = cvt_pk_bf16(v1[2], v1[3]);
                    *(u32x4*)(rowp + bj * HALF) = w; } }
    }
};

template <class Epi, class Sched, bool ALIGN_EPI = false, bool SP2 = false>
__device__ __forceinline__ void gemm_phase(PG8_LAS unsigned char* lds, const Gemm g, const Sched& S, const Epi& E) {
    const int tid = threadIdx.x, wid = __builtin_amdgcn_readfirstlane(tid >> 6), lane = tid & 63, wr = wid >> 2, wc = wid & 3, fr = lane & 15, fq = lane >> 4;
    const int K = g.K, nt = K / BK;
    unsigned voffA[2], voffB[2];
#pragma unroll
    for (int i = 0; i < 2; ++i) { int R, C; stage_rc(tid * 16 + i * 8192, R, C); const int Rb = Epi::PERM ? ((R & ~31) + perm32(R & 31)) : R;
        voffA[i] = (unsigned)(R * K + C) * 2u; voffB[i] = (unsigned)(Rb * K + C) * 2u; }
    const size_t kstep = (size_t)(BK * 2);
    const size_t hstep = (size_t)HALF * K * 2;
    const size_t tstep = 2 * hstep;
    const unsigned ldsw = (unsigned)wid * 1024u;
    const int aoff = lds_byte(wr * 64 + fr, fq * 8), boff = lds_byte(wc * 32 + fr, fq * 8);
#define PG8_SA(b, h) (((b) * 2 + (h)) * HTB)
#define PG8_SB(b, h) ((4 + (b) * 2 + (h)) * HTB)
#define PG8_STAGE(bufoff, gbase, voff) do { _Pragma("unroll") for (int _i = 0; _i < 2; ++_i) \
        __builtin_amdgcn_global_load_lds((const unsigned*)((const char*)(gbase) + (voff)[_i]), (PG8_LAS unsigned*)(lds + (bufoff) + ldsw + _i * 8192), 16, 0, 0); } while (0)
#define PG8_LDA(dst, b, h) do { _Pragma("unroll") for (int m = 0; m < 4; ++m) _Pragma("unroll") for (int k = 0; k < 2; ++k) dst[m][k] = *(const PG8_LAS bf16x8*)(lds + PG8_SA(b, h) + aoff + m * 2048 + k * 1024); } while (0)
#define PG8_LDB(dst, b, h) do { _Pragma("unroll") for (int n = 0; n < 2; ++n) _Pragma("unroll") for (int k = 0; k < 2; ++k) dst[n][k] = *(const PG8_LAS bf16x8*)(lds + PG8_SB(b, h) + boff + n * 2048 + k * 1024); } while (0)
#define PG8_MMA(ai, bj, At, Bt) do { __builtin_amdgcn_s_setprio(1); _Pragma("unroll") for (int m = 0; m < 4; ++m) _Pragma("unroll") for (int n = 0; n < 2; ++n) _Pragma("unroll") for (int k = 0; k < 2; ++k) \
        acc[ai][bj][m][n] = __builtin_amdgcn_mfma_f32_16x16x32_bf16(Bt[n][k], At[m][k], acc[ai][bj][m][n], 0, 0, 0); __builtin_amdgcn_s_setprio(0); } while (0)
#define PG8_WAIT_V(n) asm volatile("s_waitcnt vmcnt(" #n ")" ::: "memory")
#define PG8_WAIT_L(n) asm volatile("s_waitcnt lgkmcnt(" #n ")" ::: "memory")
#define PG8_BAR __builtin_amdgcn_s_barrier()
#define PG8_SCHED __builtin_amdgcn_sched_barrier(0)
    Unit cur, nxt; int ui = 0;
    if (!S.next(0, cur)) return;
    f32x4 acc[2][2][4][2];
#pragma unroll
    for (int a = 0; a < 2; ++a)
#pragma unroll
        for (int b = 0; b < 2; ++b)
#pragma unroll
            for (int m = 0; m < 4; ++m)
#pragma unroll
                for (int n = 0; n < 2; ++n) acc[a][b][m][n] = (f32x4){0.f, 0.f, 0.f, 0.f};
    bf16x8 At[4][2], B0[2][2], B1[2][2];
    const char* cA = (const char*)g.A + (size_t)cur.pm * tstep; const char* cB = (const char*)g.Bt + (size_t)cur.pn * tstep + (size_t)cur.e * g.bstride;
    S.a_ready(cur);
    if constexpr (SP2) {
        PG8_STAGE(PG8_SB(0, 0), cB, voffB); PG8_STAGE(PG8_SB(0, 1), cB + hstep, voffB); PG8_STAGE(PG8_SA(0, 0), cA, voffA); PG8_STAGE(PG8_SA(0, 1), cA + hstep, voffA);
        if (wr == 1) PG8_BAR;
        PG8_WAIT_V(2); PG8_BAR;
        PG8_STAGE(PG8_SB(1, 0), cB + kstep, voffB); PG8_STAGE(PG8_SA(1, 0), cA + kstep, voffA); PG8_STAGE(PG8_SB(1, 1), cB + hstep + kstep, voffB);
        PG8_WAIT_V(6); PG8_BAR;
    } else {
        PG8_STAGE(PG8_SB(0, 0), cB, voffB); PG8_STAGE(PG8_SA(0, 0), cA, voffA); PG8_STAGE(PG8_SB(0, 1), cB + hstep, voffB); PG8_STAGE(PG8_SA(0, 1), cA + hstep, voffA);
        if (wr == 1) PG8_BAR;
        PG8_WAIT_V(4); PG8_BAR;
        PG8_STAGE(PG8_SB(1, 0), cB + kstep, voffB); PG8_STAGE(PG8_SA(1, 0), cA + kstep, voffA); PG8_STAGE(PG8_SB(1, 1), cB + hstep + kstep, voffB);
        PG8_WAIT_V(6); PG8_BAR;
    }
    for (;;) {
        const bool has_next = S.next(ui + 1, nxt);
        const char* nA = has_next ? (const char*)g.A + (size_t)nxt.pm * tstep : cA; const char* nB = has_next ? (const char*)g.Bt + (size_t)nxt.pn * tstep + (size_t)nxt.e * g.bstride : cB;
        for (int t = 0; t < nt; t += 2) {
            const bool last = (t == nt - 2);
            const char* a1 = cA + (size_t)(t + 1) * kstep;
            const char* a2 = last ? nA : cA + (size_t)(t + 2) * kstep; const char* b2 = last ? nB : cB + (size_t)(t + 2) * kstep;
            const char* a3 = a2 + kstep; const char* b3 = b2 + kstep;
            if (last && has_next) S.a_ready(nxt);
            if constexpr (SP2) {
            PG8_LDB(B0, 0, 0); PG8_LDB(B1, 0, 1); PG8_SCHED; PG8_LDA(At, 0, 0); PG8_STAGE(PG8_SA(1, 1), a1 + hstep, voffA);
            PG8_WAIT_V(8); PG8_WAIT_L(0); PG8_BAR; PG8_MMA(0, 0, At, B0); PG8_MMA(0, 1, At, B1); PG8_BAR; PG8_SCHED;
            PG8_LDA(At, 0, 1); PG8_STAGE(PG8_SB(0, 0), b2, voffB); PG8_STAGE(PG8_SB(0, 1), b2 + hstep, voffB); PG8_STAGE(PG8_SA(0, 0), a2, voffA);
            PG8_WAIT_V(8); PG8_WAIT_L(0); PG8_BAR; PG8_MMA(1, 0, At, B0); PG8_MMA(1, 1, At, B1); PG8_BAR; PG8_SCHED;
            PG8_LDB(B0, 1, 0); PG8_LDB(B1, 1, 1); PG8_SCHED; PG8_LDA(At, 1, 0); PG8_STAGE(PG8_SA(0, 1), a2 + hstep, voffA);
            PG8_WAIT_V(8); PG8_WAIT_L(0); PG8_BAR; PG8_MMA(0, 0, At, B0); PG8_MMA(0, 1, At, B1); PG8_BAR; PG8_SCHED;
            PG8_LDA(At, 1, 1); PG8_STAGE(PG8_SB(1, 0), b3, voffB); PG8_STAGE(PG8_SB(1, 1), b3 + hstep, voffB); PG8_STAGE(PG8_SA(1, 0), a3, voffA);
            PG8_WAIT_V(8); PG8_WAIT_L(0); PG8_BAR; PG8_MMA(1, 0, At, B0); PG8_MMA(1, 1, At, B1); PG8_BAR; PG8_SCHED;
            } else {
            PG8_LDB(B0, 0, 0); PG8_SCHED; PG8_LDA(At, 0, 0); PG8_STAGE(PG8_SA(1, 1), a1 + hstep, voffA);
            PG8_WAIT_L(8); PG8_BAR; PG8_WAIT_L(0); PG8_MMA(0, 0, At, B0); PG8_BAR; PG8_SCHED;
            PG8_LDB(B1, 0, 1); PG8_STAGE(PG8_SB(0, 0), b2, voffB);
            PG8_BAR; PG8_WAIT_L(0); PG8_MMA(0, 1, At, B1); PG8_BAR;
            PG8_LDA(At, 0, 1); PG8_STAGE(PG8_SA(0, 0), a2, voffA);
            PG8_BAR; PG8_WAIT_L(0); PG8_MMA(1, 0, At, B0); PG8_BAR; PG8_SCHED;
            PG8_STAGE(PG8_SB(0, 1), b2 + hstep, voffB);
            PG8_WAIT_V(6); PG8_BAR; PG8_MMA(1, 1, At, B1); PG8_BAR;
            PG8_LDB(B0, 1, 0); PG8_SCHED; PG8_LDA(At, 1, 0); PG8_STAGE(PG8_SA(0, 1), a2 + hstep, voffA);
            PG8_WAIT_L(8); PG8_BAR; PG8_WAIT_L(0); PG8_MMA(0, 0, At, B0); PG8_BAR; PG8_SCHED;
            PG8_LDB(B1, 1, 1); PG8_STAGE(PG8_SB(1, 0), b3, voffB);
            PG8_BAR; PG8_WAIT_L(0); PG8_MMA(0, 1, At, B1); PG8_BAR;
            PG8_LDA(At, 1, 1); PG8_STAGE(PG8_SA(1, 0), a3, voffA);
            PG8_BAR; PG8_WAIT_L(0); PG8_MMA(1, 0, At, B0); PG8_BAR; PG8_SCHED;
            PG8_STAGE(PG8_SB(1, 1), b3 + hstep, voffB);
            PG8_WAIT_V(6); PG8_BAR; PG8_MMA(1, 1, At, B1); PG8_BAR;
            }
        }
        if constexpr (ALIGN_EPI) { if (wr == 0) PG8_BAR; }
        if constexpr (!Epi::AFTER_DRAIN) { E(acc, cur, wr, wc, fr, fq); S.done(cur); }
        if (!has_next) break;
#pragma unroll
        for (int a = 0; a < 2; ++a)
#pragma unroll
            for (int b = 0; b < 2; ++b)
#pragma unroll
                for (int m = 0; m < 4; ++m)
#pragma unroll
                    for (int n = 0; n < 2; ++n) acc[a][b][m][n] = (f32x4){0.f, 0.f, 0.f, 0.f};
        cur = nxt; cA = nA; cB = nB; ++ui;
        if constexpr (ALIGN_EPI) { if (wr == 1) PG8_BAR; }
    }
    PG8_WAIT_V(0);
    if constexpr (!ALIGN_EPI) { if (wr == 0) PG8_BAR; }
    PG8_BAR;
    if constexpr (Epi::AFTER_DRAIN) { E.fused(acc, cur, wr, wc, fr, fq, lds, wid, lane); S.done(cur); }
#undef PG8_SA
#undef PG8_SB
#undef PG8_STAGE
#undef PG8_LDA
#undef PG8_LDB
#undef PG8_MMA
#undef PG8_WAIT_V
#undef PG8_WAIT_L
#undef PG8_BAR
#undef PG8_SCHED
}
}

namespace pg8 {
struct EpiF32P {
    static constexpr bool PERM = false, AFTER_DRAIN = false;
    float* O; int ldc;
    __device__ __forceinline__ void operator()(const f32x4 (&acc)[2][2][4][2], const Unit& u, int wr, int wc, int fr, int fq) const {
        const int row0 = u.pm * BM + wr * 64 + fr, col0 = u.pn * BM + wc * 32 + 4 * fq;
#pragma unroll
        for (int ai = 0; ai < 2; ++ai)
#pragma unroll
            for (int m = 0; m < 4; ++m) { float* rowp = O + (size_t)(row0 + ai * HALF + m * 16) * ldc + col0;
#pragma unroll
                for (int bj = 0; bj < 2; ++bj)
#pragma unroll
                    for (int n = 0; n < 2; ++n) *(f32x4*)(rowp + bj * HALF + n * 16) = acc[ai][bj][m][n]; }
    }
};
struct EpiSwigluP {
    static constexpr bool PERM = true, AFTER_DRAIN = false;
    bf16_t* O; int ldc;
    __device__ __forceinline__ void operator()(const f32x4 (&acc)[2][2][4][2], const Unit& u, int wr, int wc, int fr, int fq) const {
        const int row0 = u.pm * BM + wr * 64 + fr, col0 = u.pn * HALF + wc * 32 + 8 * fq;
#pragma unroll
        for (int ai = 0; ai < 2; ++ai)
#pragma unroll
            for (int m = 0; m < 4; ++m) {
                float h[8];
#pragma unroll
                for (int n = 0; n < 2; ++n)
#pragma unroll
                    for (int j = 0; j < 4; ++j) { const float g = acc[ai][0][m][n][j], up = acc[ai][1][m][n][j];
                        h[4 * n + j] = g * up * __builtin_amdgcn_rcpf(1.0f + __builtin_amdgcn_exp2f(-1.4426950408889634f * g)); }
                u32x4 w; w.x = cvt_pk_bf16(h[0], h[1]); w.y = cvt_pk_bf16(h[2], h[3]); w.z = cvt_pk_bf16(h[4], h[5]); w.w = cvt_pk_bf16(h[6], h[7]);
                *(u32x4*)(O + (size_t)(row0 + ai * HALF + m * 16) * ldc + col0) = w; }
    }
};
struct EpiGateP {
    static constexpr bool PERM = true, AFTER_DRAIN = false;
    bf16_t* O; int ldc; const float* gate;
    __device__ __forceinline__ void operator()(const f32x4 (&acc)[2][2][4][2], const Unit& u, int wr, int wc, int fr, int fq) const {
        const int row0 = u.pm * BM + wr * 64 + fr, col0 = u.pn * BM + wc * 32 + 8 * fq;
#pragma unroll
        for (int ai = 0; ai < 2; ++ai)
#pragma unroll
            for (int m = 0; m < 4; ++m) { const int row = row0 + ai * HALF + m * 16; const float gt = gate[row]; bf16_t* rowp = O + (size_t)row * ldc + col0;
#pragma unroll
                for (int bj = 0; bj < 2; ++bj) { const f32x4 v0 = acc[ai][bj][m][0] * gt, v1 = acc[ai][bj][m][1] * gt;
                    u32x4 w; w.x = cvt_pk_bf16(v0[0], v0[1]); w.y = cvt_pk_bf16(v0[2], v0[3]); w.z = cvt_pk_bf16(v1[0], v1[1]); w.w = cvt_pk_bf16(v1[2], v1[3]);
                    *(u32x4*)(rowp + bj * HALF) = w; } }
    }
};
struct GroupedOrder {
    int nMe, nN, ntot, G, c;
    __device__ void init(int nMe_, int nN_, int ne, int G_, int c_) { nMe = nMe_; nN = nN_; ntot = nMe_ * nN_ * ne; G = G_; c = c_; }
    __device__ bool next(int i, Unit& u) const {
        const int L = i * G + c; if (L >= ntot) return false;
        const int per = nMe * nN, e = L / per, rem = L - e * per;
        u.e = e; u.pn = rem / nMe; u.pm = e * nMe + (rem - u.pn * nMe); return true;
    }
    __device__ __forceinline__ void a_ready(const Unit&) const {}
    __device__ __forceinline__ void done(const Unit&) const {}
};
struct L1InOrder {
    StaticOrder so; int G, c;
    __device__ void init(int G_, int c_) { so.init(16384, 2048, G_, 0); G = G_; c = c_; }
    __device__ bool next(int i, Unit& u) const {
        const int L = i * G + c;
        if (L < 512) { StaticOrder t = so; t.G = 1; t.c = 0; return t.next(L, u); }
        if (L < 544) { const int l = L - 512; u.pm = 64 + (l >> 2); u.pn = 2 + (l & 3); u.e = 0; return true; }
        return false;
    }
    __device__ __forceinline__ void a_ready(const Unit&) const {}
    __device__ __forceinline__ void done(const Unit&) const {}
};
}

#include <hip/hip_bf16.h>
#include <cmath>
namespace attn_body {
using bf16=__hip_bfloat16;
using bf16x8=__attribute__((ext_vector_type(8)))short;
using s16x4=__attribute__((ext_vector_type(4)))short;
using f32x16=__attribute__((ext_vector_type(16)))float;
using u32x4=__attribute__((ext_vector_type(4)))unsigned;
constexpr int D=64,PITCH=2304,OPITCH=1024;
constexpr int NW=8,QBLK=32,QB=QBLK*NW,KVBLK=64;
__device__ __forceinline__ int crow(int r,int hi){return (r&3)+8*(r>>2)+4*hi;}
#define SBAR() __builtin_amdgcn_sched_barrier(0)
__device__ __forceinline__ void cmask(f32x16&p0,f32x16&p1,int jb,int qrel,int hi){
  const float NEG=-INFINITY; int kb=64*jb+4*hi;
  #pragma unroll
  for(int r=0;r<16;++r){int kv=kb+(r&3)+8*(r>>2); if(kv>qrel)p0[r]=NEG; if(kv+32>qrel)p1[r]=NEG;}
}

constexpr int NSLOT=3, SLOTB=8192;
constexpr int LDS_K=0, LDS_V=NSLOT*SLOTB, LDS_WS=2*NSLOT*SLOTB, LDS_OST=LDS_WS+NW*64*4, LDS_BYTES=LDS_OST+NW*4096;
constexpr float C2=0.125f*1.4426950408889634f;
__device__ __forceinline__ void glds16(const void*gsrc,unsigned lds_dst){unsigned keep;
  asm volatile("s_mov_b32 %0, m0\n\ts_mov_b32 m0, %2\n\ts_nop 0\n\tglobal_load_lds_dwordx4 %1, off\n\ts_mov_b32 m0, %0":"=&s"(keep):"v"(gsrc),"s"(lds_dst):"memory");}
__device__ __forceinline__ float max3f(float a,float b,float c){float r;asm("v_max3_f32 %0, %1, %2, %3":"=v"(r):"v"(a),"v"(b),"v"(c));return r;}
__device__ __forceinline__ float max2f(float a,float b){float r;asm("v_max_f32_e32 %0, %1, %2":"=v"(r):"v"(a),"v"(b));return r;}
__device__ __forceinline__ float fadd_s(float a,float b){float r;asm("v_add_f32_e32 %0, %1, %2":"=v"(r):"v"(a),"v"(b));return r;}
__device__ __forceinline__ float fsub_s(float a,float b){float r;asm("v_sub_f32_e32 %0, %1, %2":"=v"(r):"v"(a),"v"(b));return r;}
typedef float f32x2_t __attribute__((ext_vector_type(2))); typedef __bf16 bf16x2_t __attribute__((ext_vector_type(2)));
__device__ __forceinline__ unsigned cvtpk_s(float lo,float hi){f32x2_t v={lo,hi};bf16x2_t b=__builtin_convertvector(v,bf16x2_t);return __builtin_bit_cast(unsigned,b);}
#define WAIT_BAR(N) asm volatile("s_waitcnt vmcnt(" #N ") lgkmcnt(0)\n\ts_barrier":::"memory")

__device__ __forceinline__ void qkt(f32x16&p0,f32x16&p1,const char*Kslot,const bf16x8*qr,const f32x16&negm,int r32,int hi){
  const char*kb=Kslot+hi*1024+r32*16;
  #pragma unroll
  for(int d0=0;d0<4;++d0){
    const bf16x8 b0=*reinterpret_cast<const bf16x8*>(kb+d0*2048);
    const bf16x8 b1=*reinterpret_cast<const bf16x8*>(kb+d0*2048+512);
    if(d0==0){p0=__builtin_amdgcn_mfma_f32_32x32x16_bf16(b0,qr[0],negm,0,0,0);p1=__builtin_amdgcn_mfma_f32_32x32x16_bf16(b1,qr[0],negm,0,0,0);}
    else{p0=__builtin_amdgcn_mfma_f32_32x32x16_bf16(b0,qr[d0],p0,0,0,0);p1=__builtin_amdgcn_mfma_f32_32x32x16_bf16(b1,qr[d0],p1,0,0,0);}}
}
typedef __attribute__((address_space(3))) const char* lds_cptr;
typedef short v4i16_t __attribute__((ext_vector_type(4)));
__device__ __forceinline__ void kload8(bf16x8*kf,lds_cptr kp){
  kf[0]=*(const __attribute__((address_space(3))) bf16x8*)(kp);      kf[1]=*(const __attribute__((address_space(3))) bf16x8*)(kp+512);
  kf[2]=*(const __attribute__((address_space(3))) bf16x8*)(kp+2048); kf[3]=*(const __attribute__((address_space(3))) bf16x8*)(kp+2560);
  kf[4]=*(const __attribute__((address_space(3))) bf16x8*)(kp+4096); kf[5]=*(const __attribute__((address_space(3))) bf16x8*)(kp+4608);
  kf[6]=*(const __attribute__((address_space(3))) bf16x8*)(kp+6144); kf[7]=*(const __attribute__((address_space(3))) bf16x8*)(kp+6656);
}
__device__ __forceinline__ void kload2(bf16x8*kf,lds_cptr kp,int j){ kf[2*j]=*(const __attribute__((address_space(3))) bf16x8*)(kp+j*2048); kf[2*j+1]=*(const __attribute__((address_space(3))) bf16x8*)(kp+j*2048+512); }
__device__ __forceinline__ s16x4 vtr(lds_cptr p){ return __builtin_bit_cast(s16x4,__builtin_amdgcn_ds_read_tr16_b64_v4i16((__attribute__((address_space(3))) v4i16_t*)p)); }
__device__ __forceinline__ float rowmax(const f32x16&p0,const f32x16&p1){
  float a=max3f(p0[0],p0[1],p1[0]),b=max3f(p0[2],p0[3],p1[1]);a=max3f(a,p1[2],p1[3]);
  #pragma unroll
  for(int r=4;r<16;r+=4){a=max3f(a,p0[r],p0[r+1]);b=max3f(b,p0[r+2],p0[r+3]);a=max3f(a,p1[r],p1[r+1]);b=max3f(b,p1[r+2],p1[r+3]);}
  const float m=max2f(a,b);
  auto rr=__builtin_amdgcn_permlane32_swap(__float_as_uint(m),__float_as_uint(m),false,false);
  return max2f(__uint_as_float(rr[0]),__uint_as_float(rr[1]));
}
__device__ __forceinline__ void pv(f32x16*o,int vb,bf16x8 pa0,bf16x8 pa1,bf16x8 pa2,bf16x8 pa3){
  #pragma unroll
  for(int d0=0;d0<2;++d0){s16x4 lo[4],hi[4];
    #pragma unroll
    for(int ks=0;ks<4;++ks){
      asm volatile("ds_read_b64_tr_b16 %0,%1 offset:%c2":"=&v"(lo[ks]):"v"(vb),"i"(d0*4096+ks*1024):"memory");
      asm volatile("ds_read_b64_tr_b16 %0,%1 offset:%c2":"=&v"(hi[ks]):"v"(vb),"i"(d0*4096+ks*1024+512):"memory");}
    asm volatile("s_waitcnt lgkmcnt(0)":::"memory");SBAR();
    #define PK(k) (bf16x8){lo[k][0],lo[k][1],lo[k][2],lo[k][3],hi[k][0],hi[k][1],hi[k][2],hi[k][3]}
    o[d0]=__builtin_amdgcn_mfma_f32_32x32x16_bf16(pa0,PK(0),o[d0],0,0,0);
    o[d0]=__builtin_amdgcn_mfma_f32_32x32x16_bf16(pa1,PK(1),o[d0],0,0,0);
    o[d0]=__builtin_amdgcn_mfma_f32_32x32x16_bf16(pa2,PK(2),o[d0],0,0,0);
    o[d0]=__builtin_amdgcn_mfma_f32_32x32x16_bf16(pa3,PK(3),o[d0],0,0,0);
    #undef PK
  }
}

#ifndef ATTN_STORE16
#define ATTN_STORE16(p,v) (*(u32x4*)(p)=(v))
#endif
struct AU { const bf16* Qp; const bf16* Kp; const bf16* Vp; bf16* Op; int qrow0, lat_row0, ctx_row0, nlat_t, NT; };
template<int THRL> __device__ __forceinline__ void attn_unit(const AU& u,char*shm){
  const int tid=threadIdx.x,lane=tid&63,r32=lane&31,hi=lane>>5; const int wid=__builtin_amdgcn_readfirstlane(tid>>6);
  const bf16*Qw=u.Qp+(long)(u.qrow0+wid*QBLK)*PITCH;
  const bf16*Kh=u.Kp,*Vh=u.Vp;
  const unsigned lds0=(unsigned)(uintptr_t)shm;
  float*wsf=(float*)(shm+LDS_WS)+wid*64;
  const bf16*ksrc=Kh+(long)lane*PITCH+wid*8;
  const bf16*vsrc=Vh+(long)(16*(wid&3)+(lane>>2))*PITCH+(wid>>2)*32+(lane&3)*8;
  const unsigned kdst=lds0+LDS_K+wid*1024, vdst=lds0+LDS_V+wid*1024;
  #define TROW(t) ((long)((t)<u.nlat_t?u.lat_row0+KVBLK*(t):u.ctx_row0+KVBLK*((t)-u.nlat_t))*PITCH)
  #define DMA_K(t,slot) glds16(ksrc+TROW(t),(unsigned)__builtin_amdgcn_readfirstlane(kdst+(slot)))
  #define DMA_V(t,slot) glds16(vsrc+TROW(t),(unsigned)__builtin_amdgcn_readfirstlane(vdst+(slot)))
  const int vb0=(int)(lds0+LDS_V)+((lane>>4)&1)*32+(lane&3)*8+(4*hi+((lane&15)>>2))*64;
  const char*Kbase=shm+LDS_K; bf16x8 kf[8];
  const lds_cptr shm3=(lds_cptr)shm; const lds_cptr kp0=shm3+LDS_K+hi*1024+r32*16; const lds_cptr vp0=shm3+LDS_V+((lane>>4)&1)*32+(lane&3)*8+(4*hi+((lane&15)>>2))*64;
  const int NT=u.NT;
  DMA_K(0,0);DMA_V(0,0);DMA_K(1,SLOTB);
  bf16x8 qr[4];
  #pragma unroll
  for(int d0=0;d0<4;++d0)qr[d0]=*reinterpret_cast<const bf16x8*>(&Qw[(long)r32*PITCH+d0*16+hi*8]);
  float mhat=0.f,l_reg=0.f;f32x16 o[2];o[0]=f32x16{};o[1]=f32x16{};f32x16 negm=f32x16{};asm volatile("":"+v"(negm));
  #define CMASK(P0,P1,t) do{}while(0)
  bool resc=false;
  #define START(P0,P1) do{ const float rm=rowmax(P0,P1); resc=false; \
    { const float dl=rm; mhat=fadd_s(mhat,dl); \
      _Pragma("unroll") for(int r=0;r<16;++r){P0[r]=fsub_s(P0[r],dl);P1[r]=fsub_s(P1[r],dl);} \
      _Pragma("unroll") for(int r=0;r<16;++r)negm[r]=-mhat; asm volatile("":"+v"(negm)); } \
    _Pragma("unroll") for(int r=0;r<16;++r)P0[r]=__builtin_amdgcn_exp2f(P0[r]); }while(0)
  #define RESC() do{ if(resc){ asm volatile("s_waitcnt lgkmcnt(0)":::"memory"); \
      _Pragma("unroll") for(int d_=0;d_<2;++d_) _Pragma("unroll") for(int r=0;r<16;++r)o[d_][r]*=wsf[crow(r,hi)]; } }while(0)
  f32x16 pA0,pA1,pB0,pB1;
  int sl_prev=0,sl_cur=0,sl_next=SLOTB;
  #define ROT() do{sl_prev=sl_cur;sl_cur=sl_next;sl_next=(sl_next==(NSLOT-1)*SLOTB)?0:sl_next+SLOTB;}while(0)
  DMA_K(2,2*SLOTB);
  WAIT_BAR(3);
  qkt(pA0,pA1,Kbase,qr,negm,r32,hi);asm volatile("s_nop 15\n\ts_nop 7":"+v"(pA0),"+v"(pA1));CMASK(pA0,pA1,0);
  START(pA0,pA1);
  _Pragma("unroll") for(int r=0;r<16;++r)pA1[r]=__builtin_amdgcn_exp2f(pA1[r]);
  WAIT_BAR(0);
  DMA_K(3,0);DMA_V(1,SLOTB);
  ROT();
  kload8(kf,kp0+sl_cur);
  WAIT_BAR(2);
  s16x4 vlo[8],vhi[8]; u32x4 pw0,pw1,pw2,pw3;
  #define PKW(P,B) cvtpk_s(P[B],P[B+1])
  #define PAF(k) __builtin_bit_cast(bf16x8,pw##k)
  #define VFR(i) (bf16x8){vlo[i][0],vlo[i][1],vlo[i][2],vlo[i][3],vhi[i][0],vhi[i][1],vhi[i][2],vhi[i][3]}
  #define PIN(x) asm volatile("":"+v"(x))
  #define MX3(a,b,c) __builtin_fmaxf(__builtin_fmaxf((a),(b)),(c))
  #define GAPA(MF,A0,A1,A2,A3,W0,W1,PW) do{ MF; sacc+=A0; sacc+=A1; sacc+=A2; sacc+=A3; PIN(sacc); W0; W1; PIN(PW); SBAR(); }while(0)
  #define EX(v) __builtin_amdgcn_exp2f(v)
  #define GAPB(MF,X,B) do{ MF; X[B]=EX(X[B]); X[B+1]=EX(X[B+1]); X[B+2]=EX(X[B+2]); X[B+3]=EX(X[B+3]); PIN(X); SBAR(); }while(0)
  #define VRD(i) do{ vlo[i]=vtr(vp_+(((i)>>2)*4096+((i)&3)*1024)); vhi[i]=vtr(vp_+(((i)>>2)*4096+((i)&3)*1024+512)); }while(0)
  #define KRD(G,j) do{ if(G){ kload2(kf,kp0+sl_next,j); SBAR(); } }while(0)
  #define STEP(C0,C1,P0,P1,t,GK,GV,GL) do{ SBAR(); \
    const lds_cptr vp_=vp0+sl_prev; \
    VRD(0); SBAR(); float sacc=(P0[0]+P0[1]); \
    GAPA(C0=__builtin_amdgcn_mfma_f32_32x32x16_bf16(kf[0],qr[0],negm,0,0,0), P0[2],P0[3],P0[4],P0[5],     pw0[0]=PKW(P0,0), pw0[1]=PKW(P0,2), pw0); \
    VRD(4); SBAR(); GAPA(C1=__builtin_amdgcn_mfma_f32_32x32x16_bf16(kf[1],qr[0],negm,0,0,0), P0[6],P0[7],P0[8],P0[9],     pw0[2]=PKW(P0,4), pw0[3]=PKW(P0,6), pw0); \
    VRD(1); SBAR(); GAPA(C0=__builtin_amdgcn_mfma_f32_32x32x16_bf16(kf[2],qr[1],C0,0,0,0),   P0[10],P0[11],P0[12],P0[13], pw1[0]=PKW(P0,8), pw1[1]=PKW(P0,10), pw1); \
    VRD(5); SBAR(); GAPA(C1=__builtin_amdgcn_mfma_f32_32x32x16_bf16(kf[3],qr[1],C1,0,0,0),   P0[14],P0[15],P1[0],P1[1],   pw1[2]=PKW(P0,12),pw1[3]=PKW(P0,14), pw1); \
    VRD(2); SBAR(); GAPA(C0=__builtin_amdgcn_mfma_f32_32x32x16_bf16(kf[4],qr[2],C0,0,0,0),   P1[2],P1[3],P1[4],P1[5],     pw2[0]=PKW(P1,0), pw2[1]=PKW(P1,2), pw2); \
    VRD(6); SBAR(); GAPA(C1=__builtin_amdgcn_mfma_f32_32x32x16_bf16(kf[5],qr[2],C1,0,0,0),   P1[6],P1[7],P1[8],P1[9],     pw2[2]=PKW(P1,4), pw2[3]=PKW(P1,6), pw2); \
    VRD(3); SBAR(); GAPA(C0=__builtin_amdgcn_mfma_f32_32x32x16_bf16(kf[6],qr[3],C0,0,0,0),   P1[10],P1[11],P1[12],P1[13], pw3[0]=PKW(P1,8), pw3[1]=PKW(P1,10), pw3); \
    VRD(7); SBAR(); GAPA(C1=__builtin_amdgcn_mfma_f32_32x32x16_bf16(kf[7],qr[3],C1,0,0,0),   P1[14],P1[15],0.f,0.f,       pw3[2]=PKW(P1,12),pw3[3]=PKW(P1,14), pw3); \
    l_reg+=sacc; \
    if(GK){DMA_K((t)+3,sl_cur);} if(GV){DMA_V((t)+1,sl_next);} \
    CMASK(C0,C1,t); \
    { float a=MX3(C0[0],C0[1],C1[0]),b=MX3(C0[2],C0[3],C1[1]); a=MX3(a,C1[2],C1[3]); \
      _Pragma("unroll") for(int r=4;r<16;r+=4){a=MX3(a,C0[r],C0[r+1]);b=MX3(b,C0[r+2],C0[r+3]);a=MX3(a,C1[r],C1[r+1]);b=MX3(b,C1[r+2],C1[r+3]);} \
      float rm=__builtin_fmaxf(a,b); { auto rr=__builtin_amdgcn_permlane32_swap(__float_as_uint(rm),__float_as_uint(rm),false,false); rm=__builtin_fmaxf(__uint_as_float(rr[0]),__uint_as_float(rr[1])); } \
      resc=false; \
      if(__builtin_expect(__any(rm>(float)THRL),0)){ const float dl=__builtin_fmaxf(rm,0.f); mhat+=dl; \
        _Pragma("unroll") for(int r=0;r<16;++r){C0[r]-=dl;C1[r]-=dl;} \
        _Pragma("unroll") for(int r=0;r<16;++r)negm[r]=-mhat; asm volatile("":"+v"(negm)); \
        const float f=__builtin_amdgcn_exp2f(-dl); l_reg*=f; if(hi==0)wsf[r32]=f; resc=true; } } \
    SBAR(); \
    GAPB(o[0]=__builtin_amdgcn_mfma_f32_32x32x16_bf16(PAF(0),VFR(0),o[0],0,0,0), C0,0); \
    GAPB(o[1]=__builtin_amdgcn_mfma_f32_32x32x16_bf16(PAF(0),VFR(4),o[1],0,0,0), C0,4); \
    KRD(GL,0); GAPB(o[0]=__builtin_amdgcn_mfma_f32_32x32x16_bf16(PAF(1),VFR(1),o[0],0,0,0), C0,8); \
    KRD(GL,1); GAPB(o[1]=__builtin_amdgcn_mfma_f32_32x32x16_bf16(PAF(1),VFR(5),o[1],0,0,0), C0,12); \
    KRD(GL,2); GAPB(o[0]=__builtin_amdgcn_mfma_f32_32x32x16_bf16(PAF(2),VFR(2),o[0],0,0,0), C1,0); \
    KRD(GL,3); GAPB(o[1]=__builtin_amdgcn_mfma_f32_32x32x16_bf16(PAF(2),VFR(6),o[1],0,0,0), C1,4); \
    GAPB(o[0]=__builtin_amdgcn_mfma_f32_32x32x16_bf16(PAF(3),VFR(3),o[0],0,0,0), C1,8); \
    GAPB(o[1]=__builtin_amdgcn_mfma_f32_32x32x16_bf16(PAF(3),VFR(7),o[1],0,0,0), C1,12); \
    }while(0)
  int t=1;
  #undef CMASK
  #define CMASK(P0,P1,t) do{}while(0)
  for(;t+5<NT;t+=2){
    STEP(pB0,pB1,pA0,pA1,t,true,true,true);     WAIT_BAR(2); RESC(); ROT();
    STEP(pA0,pA1,pB0,pB1,t+1,true,true,true);   WAIT_BAR(2); RESC(); ROT();
  }
  #undef CMASK
  #define CMASK(P0,P1,t) do{}while(0)
  #define ENDW(tt) do{ if((tt)+3<NT){WAIT_BAR(2);} else if((tt)+2<NT){WAIT_BAR(1);} else {WAIT_BAR(0);} }while(0)
  for(;t+1<NT;t+=2){
    STEP(pB0,pB1,pA0,pA1,t,(t+3<NT),(t+1<NT),(t+1<NT));       ENDW(t);   RESC(); ROT();
    STEP(pA0,pA1,pB0,pB1,t+1,(t+4<NT),(t+2<NT),(t+2<NT));     ENDW(t+1); RESC(); ROT();
  }
  STEP(pB0,pB1,pA0,pA1,NT-1,false,false,false); RESC();
  { float sacc=pB0[0]+pB0[1]; _Pragma("unroll") for(int r=2;r<16;++r)sacc+=pB0[r]; _Pragma("unroll") for(int r=0;r<16;++r)sacc+=pB1[r]; l_reg+=sacc;
    pw0=(u32x4){PKW(pB0,0),PKW(pB0,2),PKW(pB0,4),PKW(pB0,6)};pw1=(u32x4){PKW(pB0,8),PKW(pB0,10),PKW(pB0,12),PKW(pB0,14)};pw2=(u32x4){PKW(pB1,0),PKW(pB1,2),PKW(pB1,4),PKW(pB1,6)};pw3=(u32x4){PKW(pB1,8),PKW(pB1,10),PKW(pB1,12),PKW(pB1,14)};
    SBAR(); pv(o,vb0+sl_cur,PAF(0),PAF(1),PAF(2),PAF(3)); }
  #undef PKW
  #undef PAF
  #undef VFR
  #undef PIN
  #undef MX3
  #undef GAPA
  #undef GAPB
  #undef EX
  #undef VRD
  #undef KRD
  #undef STEP
  #undef ENDW
  {auto rr=__builtin_amdgcn_permlane32_swap(__float_as_uint(l_reg),__float_as_uint(l_reg),false,false);l_reg=__uint_as_float(rr[0])+__uint_as_float(rr[1]);}
  if(hi==0)wsf[32+r32]=l_reg;asm volatile("s_waitcnt lgkmcnt(0)":::"memory");
  float rli[16];
  #pragma unroll
  for(int r=0;r<16;++r)rli[r]=__builtin_amdgcn_rcpf(wsf[32+crow(r,hi)]);
  bf16*Ow=u.Op+(long)(u.qrow0+wid*QBLK)*OPITCH;
  { bf16*stg=(bf16*)(shm+LDS_OST)+wid*2048;
    #pragma unroll
    for(int r=0;r<16;++r){const int orow=crow(r,hi);
      #pragma unroll
      for(int d0=0;d0<2;++d0)stg[orow*64+d0*32+r32]=__float2bfloat16(o[d0][r]*rli[r]);}
    asm volatile("s_waitcnt lgkmcnt(0)":::"memory");
    #pragma unroll
    for(int i=0;i<4;++i){const int row=i*8+(lane>>3),ch=lane&7; const u32x4 v=*(const u32x4*)(stg+row*64+ch*8); ATTN_STORE16(Ow+(long)row*OPITCH+ch*8,v);} }
  asm volatile("s_waitcnt lgkmcnt(0)\n\ts_barrier":::"memory");
  #undef DMA_K
  #undef TROW
  #undef DMA_V
  #undef CMASK
  #undef START
  #undef RESC
  #undef ROT
}
constexpr int ATTN_LDS_BYTES=LDS_BYTES;
#undef SBAR
#undef WAIT_BAR
}

struct Params { const float* in[26]; float* out; unsigned char* ws; int ph_lo, ph_hi; };
struct Ctx { LAS unsigned char* lds; int tid, lane, wave, vcu, G, gw, NGW; };
enum { I_X = 0, I_C, I_CTX, I_CCTX, I_ADAW, I_ADAB, I_LNG, I_LNB, I_W0IN, I_W0OUT, I_LQ1, I_LK1, I_LQ2, I_LK2, I_SUBLN, I_QN, I_KN,
       I_W1IN, I_W1OUT, I_RPB, I_POOLW, I_POOLS, I_ROUTER, I_WG, I_WU, I_WD };

__device__ __forceinline__ const float* mod_row(const Params& p, int layer, int row) {
    return (const float*)(p.ws + WS_MOD) + (size_t)(layer * 9 + (row < LAT ? (row >> 11) : 8)) * 6144;
}

__device__ __forceinline__ void ph_prologue(const Params& p, const Ctx& c) {
    const float* cin = p.in[I_C]; const float* cctx = p.in[I_CCTX]; const float* ada_w = p.in[I_ADAW]; const float* ada_b = p.in[I_ADAB];
    float* MOD = (float*)(p.ws + WS_MOD);
    LAS float* sc = (LAS float*)c.lds;
    LAS float* red = sc + 9 * 1024;
    for (int i = c.tid; i < 9 * 1024; i += 512) { const float v = i < 8192 ? cin[i] : cctx[i - 8192]; sc[i] = v / (1.f + expf(-v)); }
    __syncthreads();
    for (int u = c.vcu; u < 256; u += c.G) {
        const int layer = u >> 7, j0 = (u & 127) * 48;
        const int jc = c.tid % 48, kg = c.tid / 48;
        if (kg < 10) {
            float acc[9];
#pragma unroll
            for (int m = 0; m < 9; ++m) acc[m] = 0.f;
            const float* wp = ada_w + (size_t)layer * 1024 * 6144 + j0 + jc;
            for (int k = kg; k < 1024; k += 10) {
                const float w = wp[(size_t)k * 6144];
#pragma unroll
                for (int m = 0; m < 9; ++m) acc[m] += sc[m * 1024 + k] * w;
            }
#pragma unroll
            for (int m = 0; m < 9; ++m) red[(kg * 9 + m) * 48 + jc] = acc[m];
        }
        __syncthreads();
        if (c.tid < 432) {
            const int m = c.tid / 48, j = c.tid % 48; float s = 0.f;
#pragma unroll
            for (int g = 0; g < 10; ++g) s += red[(g * 9 + m) * 48 + j];
            MOD[(size_t)(layer * 9 + m) * 6144 + j0 + j] = s + ada_b[layer * 6144 + j0 + j];
        }
        __syncthreads();
    }
    if (c.vcu == 0) {
        f32x2* R = (f32x2*)(p.ws + WS_ROPE);
        for (int i = c.tid; i < 1024; i += 512) {
            const int pos = i >> 4, f = i & 15;
            const float inv = exp2f(-(float)f * (13.287712379549449f / 16.f));
            const float a = (float)pos * inv;
            const float k = rintf(a * 0.15915494309189535f);
            float rr = fmaf(-k, 6.28125f, a); rr = fmaf(-k, 1.9353071795864769e-3f, rr);
            R[i] = (f32x2){__cosf(rr), __sinf(rr)};
        }
    }
}


__device__ __forceinline__ void transpose_item(const float* W, int ldw, int k0, int n0, bf16* WT, int Kd, int drow0, LAS float* scr, int lane) {
#pragma unroll 8
    for (int i = 0; i < 32; ++i) { const int kk = 2 * i + (lane >> 5); scr[kk * 33 + (lane & 31)] = W[(size_t)(k0 + kk) * ldw + n0 + (lane & 31)]; }
    asm volatile("s_waitcnt lgkmcnt(0)" ::: "memory");
    const int ch = lane & 7;
#pragma unroll
    for (int j = 0; j < 4; ++j) { const int n = (lane >> 3) + 8 * j; const LAS float* sp = scr + (8 * ch) * 33 + n;
        v4u o; o.x = pk2(sp[0 * 33], sp[1 * 33]); o.y = pk2(sp[2 * 33], sp[3 * 33]); o.z = pk2(sp[4 * 33], sp[5 * 33]); o.w = pk2(sp[6 * 33], sp[7 * 33]);
        *(v4u*)(WT + (size_t)(drow0 + n) * Kd + k0 + 8 * ch) = o; }
    asm volatile("s_waitcnt lgkmcnt(0)" ::: "memory");
}
__device__ __forceinline__ void ph_transposes(const Params& p, const Ctx& c) {
    LAS float* scr = (LAS float*)(c.lds + c.wave * 16384);
    constexpr int I0 = 16 * 72, I1 = 16 * 32, I2 = 16 * 64, I3 = 16 * 32, ISM = I0 + I1 + I2 + I3, IEX = 3072, NIT = ISM + 32 * IEX;
    for (int it = c.gw; it < NIT; it += c.NGW) {
        int r = it;
        if (r < I0) { transpose_item(p.in[I_W0IN], EIN, 64 * (r / 72), 32 * (r % 72), (bf16*)(p.ws + WS_W0IN), DM, 32 * (r % 72), scr, c.lane); continue; } r -= I0;
        if (r < I1) { transpose_item(p.in[I_W0OUT], DM, 64 * (r / 32), 32 * (r % 32), (bf16*)(p.ws + WS_W0OUT), DM, 32 * (r % 32), scr, c.lane); continue; } r -= I1;
        if (r < I2) { transpose_item(p.in[I_W1IN], OIN, 64 * (r / 64), 32 * (r % 64), (bf16*)(p.ws + WS_W1IN), DM, 32 * (r % 64), scr, c.lane); continue; } r -= I2;
        if (r < I3) { transpose_item(p.in[I_W1OUT], DM, 64 * (r / 32), 32 * (r % 32), (bf16*)(p.ws + WS_W1OUT), DM, 32 * (r % 32), scr, c.lane); continue; } r -= I3;
        const int ie = r / IEX, q = r - ie * IEX, layer = ie >> 4, e = ie & 15, which = q >> 10, idx = q & 1023;
        if (which < 2) {
            const float* W = (which == 0 ? p.in[I_WG] : p.in[I_WU]) + (size_t)ie * DM * FF;
            const int k0 = 64 * (idx >> 6), n0 = 32 * (idx & 63);
            bf16* WT = (bf16*)(p.ws + WS_WGU + (size_t)layer * WS_MOE_LSTRIDE) + (size_t)e * 4096 * DM;
            transpose_item(W, FF, k0, n0, WT, DM, (n0 >> 7) * 256 + (n0 & 127) + which * 128, scr, c.lane);
        } else {
            const float* W = p.in[I_WD] + (size_t)ie * FF * DM;
            const int k0 = 64 * (idx >> 5), n0 = 32 * (idx & 31);
            bf16* WT = (bf16*)(p.ws + WS_WDN + (size_t)layer * WS_MOE_LSTRIDE) + (size_t)e * DM * FF;
            transpose_item(W, DM, k0, n0, WT, FF, n0, scr, c.lane);
        }
    }
}

__device__ __forceinline__ void ph_modulate0(const Params& p, const Ctx& c) {
    bf16* HB = (bf16*)(p.ws + WS_HB);
    for (int row = c.gw; row < NTOK; row += c.NGW) {
        const float* src = row < LAT ? p.in[I_X] + (size_t)row * DM : p.in[I_CTX] + (size_t)(row - LAT) * DM;
        const float* mod = mod_row(p, 0, row);
#pragma unroll
        for (int j = 0; j < 4; ++j) {
            const int col = 4 * c.lane + 256 * j;
            const f32x4 v = *(const f32x4*)(src + col), sh = *(const f32x4*)(mod + col), s = *(const f32x4*)(mod + 1024 + col);
            const f32x4 h = v * (s + 1.f) + sh;
            *(v2u*)(HB + (size_t)row * DM + col) = (v2u){pk2(h.x, h.y), pk2(h.z, h.w)};
        }
    }
}

struct NG { const bf16* A; int lda; const float* W0; const float* W1; int ldw; size_t wstride; int Mb; int row_begin, row_end, col_begin, col_end, K; };
template <int NB, class Epi>
__device__ __forceinline__ void ngemm(const NG& g, const Ctx& c, const Epi& epi) {
    const int nmt = (g.row_end - g.row_begin) / 32, nnt = (g.col_end - g.col_begin) / 32;
    const int l31 = c.lane & 31, lh = c.lane >> 5;
    for (int t = c.gw; t < nmt * nnt; t += c.NGW) {
        const int mt = t / nnt, nt = t % nnt;
        const int row0 = g.row_begin + mt * 32, col0 = g.col_begin + nt * 32;
        const int e = row0 / g.Mb;
        const bf16* ap = g.A + (size_t)(row0 + l31) * g.lda + lh;
        const float* bp0 = g.W0 + (size_t)e * g.wstride + (size_t)lh * g.ldw + col0 + l31;
        const float* bp1 = NB == 2 ? g.W1 + (size_t)e * g.wstride + (size_t)lh * g.ldw + col0 + l31 : nullptr;
        f32x16 acc0 = {}, acc1 = {};
#pragma unroll 8
        for (int k = 0; k < g.K; k += 2) {
            const float a = bf2f((unsigned)ap[k]);
            const float b0 = bp0[(size_t)k * g.ldw];
            acc0 = __builtin_amdgcn_mfma_f32_32x32x2f32(a, b0, acc0, 0, 0, 0);
            if (NB == 2) { const float b1 = bp1[(size_t)k * g.ldw]; acc1 = __builtin_amdgcn_mfma_f32_32x32x2f32(a, b1, acc1, 0, 0, 0); }
        }
#pragma unroll
        for (int r = 0; r < 16; ++r) {
            const int row = row0 + (r & 3) + 8 * (r >> 2) + 4 * lh, col = col0 + l31;
            epi(row, col, acc0[r], acc1[r]);
        }
    }
}
struct EpiF32 { float* O; int ldc; __device__ __forceinline__ void operator()(int row, int col, float v0, float) const { O[(size_t)row * ldc + col] = v0; } };
struct EpiBf { bf16* O; int ldc; int scale_cols; float sc; __device__ __forceinline__ void operator()(int row, int col, float v0, float) const { O[(size_t)row * ldc + col] = (bf16)f2bf(col < scale_cols ? v0 * sc : v0); } };
struct EpiSwiglu { bf16* O; __device__ __forceinline__ void operator()(int row, int col, float g, float u) const { const float s = g / (1.f + __expf(-g)); O[(size_t)row * FF + col] = (bf16)f2bf(s * u); } };
struct EpiGate { bf16* O; const float* gate; __device__ __forceinline__ void operator()(int row, int col, float v0, float) const { O[(size_t)row * DM + col] = (bf16)f2bf(v0 * gate[row]); } };

template <bool F32IN> __device__ __forceinline__ void ph_qkv_post(const Params& p, const Ctx& c) {
    const float* PF = (const float*)(p.ws + WS_PF);
    bf16* QKV = (bf16*)(p.ws + WS_QKV);
    const f32x2* R = (const f32x2*)(p.ws + WS_ROPE);
    const float* qn = p.in[I_QN]; const float* kn = p.in[I_KN];
    const int d = c.lane;
    const float qg = qn[d], kg = kn[d];
    for (int row = c.gw; row < NTOK; row += c.NGW) {
        const bool lat = row < LAT;
        const int t = row & 2047;
        const int pos = (d < 32) ? (t >> 6) : (t & 63);
        const f32x2 cs = R[pos * 16 + (d & 15)];
        const bool first = (d & 16) == 0;
        for (int hs = 0; hs < 36; ++hs) {
            float v = F32IN ? PF[(size_t)row * EIN + hs * 64 + d] : bf2f((unsigned)QKV[(size_t)row * EIN + hs * 64 + d]);
            const bool isq = hs < 8 || (hs >= 24 && hs < 32);
            const bool isk = (hs >= 8 && hs < 16) || hs == 32 || hs == 33;
            const bool nrm = hs >= 24 && hs < 34;
            if (nrm) { const float ss = wave_sum(v * v); v = v * rsqrtf(ss * (1.f / 64.f) + RMS_EPS) * (hs < 32 ? qg : kg); }
            if ((isq || isk) && lat) { const float pr = __shfl_xor(v, 16); v = first ? v * cs.x - pr * cs.y : v * cs.x + pr * cs.y; }
            if (isq) v *= C2;
            QKV[(size_t)row * EIN + hs * 64 + d] = (bf16)f2bf(v);
        }
    }
}

__device__ __forceinline__ void ph_attn0_naive(const Params& p, const Ctx& c) {
    const bf16* QKV = (const bf16*)(p.ws + WS_QKV);
    bf16* CC = (bf16*)(p.ws + WS_CC);
    bf16* AO = (bf16*)(p.ws + WS_AO);
    LAS float* Ks = (LAS float*)c.lds;
    LAS float* Vs = Ks + 4096;
    for (int u = c.vcu; u < 960; u += c.G) {
        const bool isctx = u >= 768;
        int b, vh, qrow, ntiles; bool active = true;
        if (!isctx) { b = u / 96; const int r = u % 96; vh = r >> 2; qrow = b * SEQ + (r & 3) * 512 + c.tid; ntiles = 36; }
        else { const int uu = u - 768; b = uu / 24; vh = uu % 24; qrow = LAT + b * NCTX + (c.tid & 255); active = c.tid < 256; ntiles = 4; }
        int qcol, kcol, vcol;
        if (vh < 16) { const int a = vh >> 2, s = (vh >> 1) & 1, half = vh & 1; qcol = a * 128 + s * 64; kcol = 512 + a * 128 + s * 64; vcol = 1024 + a * 128 + half * 64; }
        else { const int h = vh - 16; qcol = 1536 + h * 64; kcol = 2048 + (h >> 2) * 64; vcol = 2176 + (h >> 2) * 64; }
        float q[64], o[64];
#pragma unroll
        for (int i = 0; i < 8; ++i) { const v4u w = *(const v4u*)(QKV + (size_t)qrow * EIN + qcol + 8 * i); unpack8(w, q + 8 * i); }
#pragma unroll
        for (int i = 0; i < 64; ++i) o[i] = 0.f;
        float m = -1e30f, l = 0.f;
        for (int t = 0; t < ntiles; ++t) {
            const int krow0 = isctx ? LAT + b * NCTX + 64 * t : (t < 32 ? b * SEQ + 64 * t : LAT + b * NCTX + 64 * (t - 32));
            __syncthreads();
            { const int r = c.tid >> 3, ch = c.tid & 7; float f[8];
              const v4u kw = *(const v4u*)(QKV + (size_t)(krow0 + r) * EIN + kcol + ch * 8); unpack8(kw, f);
#pragma unroll
              for (int j = 0; j < 8; ++j) Ks[r * 64 + ch * 8 + j] = f[j];
              const v4u vw = *(const v4u*)(QKV + (size_t)(krow0 + r) * EIN + vcol + ch * 8); unpack8(vw, f);
#pragma unroll
              for (int j = 0; j < 8; ++j) Vs[r * 64 + ch * 8 + j] = f[j]; }
            __syncthreads();
            if (active) {
                for (int kk = 0; kk < 64; ++kk) {
                    float s = 0.f;
#pragma unroll
                    for (int dd = 0; dd < 64; ++dd) s += q[dd] * Ks[kk * 64 + dd];
                    const float mn = fmaxf(m, s), al = exp2f(m - mn), pp = exp2f(s - mn);
                    l = l * al + pp; m = mn;
#pragma unroll
                    for (int dd = 0; dd < 64; ++dd) o[dd] = o[dd] * al + pp * Vs[kk * 64 + dd];
                }
            }
        }
        if (active) {
            const float rl = 1.f / l;
            bf16* dst = vh < 16 ? AO + (size_t)qrow * DM + (vh >> 2) * 256 + ((vh >> 1) & 1) * 128 + (vh & 1) * 64 : CC + (size_t)qrow * DM + 512 + (vh - 16) * 64;
            {
#pragma unroll
                for (int i = 0; i < 8; ++i) *(v4u*)(dst + 8 * i) = (v4u){pk2(o[8 * i] * rl, o[8 * i + 1] * rl), pk2(o[8 * i + 2] * rl, o[8 * i + 3] * rl), pk2(o[8 * i + 4] * rl, o[8 * i + 5] * rl), pk2(o[8 * i + 6] * rl, o[8 * i + 7] * rl)}; }
        }
    }
}


__device__ __forceinline__ void ph_attn0_fast(const Params& p, const Ctx& c, char* lds_generic) {
    typedef attn_body::bf16 abf;
    const abf* Q = (const abf*)(p.ws + WS_QKV); abf* CCb = (abf*)(p.ws + WS_CC); abf* AOb = (abf*)(p.ws + WS_AO);
    for (int i = 0;; ++i) {
        const int U = i * c.G + c.vcu;
        if (U >= 1536 + 192) break;
        attn_body::AU u; int vh;
        if (U < 1536) { const int b = U / 192, rem = U - b * 192; vh = rem >> 3; u.qrow0 = b * SEQ + (rem & 7) * 256; u.lat_row0 = b * SEQ; u.ctx_row0 = LAT + b * NCTX; u.nlat_t = 32; u.NT = 36; }
        else { const int uu = U - 1536, b = uu / 24; vh = uu - b * 24; u.qrow0 = LAT + b * NCTX; u.lat_row0 = 0; u.ctx_row0 = LAT + b * NCTX; u.nlat_t = 0; u.NT = 4; }
        int qcol, kcol, vcol; abf* op;
        if (vh < 16) { const int a = vh >> 2, s = (vh >> 1) & 1, half = vh & 1; qcol = a * 128 + s * 64; kcol = 512 + a * 128 + s * 64; vcol = 1024 + a * 128 + half * 64; op = AOb + a * 256 + s * 128 + half * 64; }
        else { const int h = vh - 16; qcol = 1536 + h * 64; kcol = 2048 + (h >> 2) * 64; vcol = 2176 + (h >> 2) * 64; op = CCb + 512 + h * 64; }
        u.Qp = Q + qcol; u.Kp = Q + kcol; u.Vp = Q + vcol; u.Op = op;
        attn_body::attn_unit<8>(u, lds_generic);
    }
}

__device__ __forceinline__ void ph_attn_combine(const Params& p, const Ctx& c) {
    const bf16* AO = (const bf16*)(p.ws + WS_AO);
    bf16* CC = (bf16*)(p.ws + WS_CC);
    const float d1 = wave_sum(p.in[I_LQ1][c.lane] * p.in[I_LK1][c.lane]);
    const float d2 = wave_sum(p.in[I_LQ2][c.lane] * p.in[I_LK2][c.lane]);
    const float lam = expf(d1) - expf(d2) + LAM_INIT;
    const float g0 = p.in[I_SUBLN][c.lane] * (1.f - LAM_INIT), g1 = p.in[I_SUBLN][c.lane + 64] * (1.f - LAM_INIT);
    for (int it = c.gw; it < NTOK * 4; it += c.NGW) {
        const int row = it >> 2, a = it & 3;
        const bf16* src = AO + (size_t)row * DM + a * 256;
        const float x0 = bf2f((unsigned)src[c.lane]) - lam * bf2f((unsigned)src[128 + c.lane]), x1 = bf2f((unsigned)src[64 + c.lane]) - lam * bf2f((unsigned)src[192 + c.lane]);
        const float ss = wave_sum(x0 * x0 + x1 * x1);
        const float r = rsqrtf(ss * (1.f / 128.f) + RMS_EPS);
        CC[(size_t)row * DM + a * 128 + c.lane] = (bf16)f2bf(x0 * r * g0);
        CC[(size_t)row * DM + a * 128 + 64 + c.lane] = (bf16)f2bf(x1 * r * g1);
    }
}

__device__ __forceinline__ void ph_ln1_router(const Params& p, const Ctx& c, int layer) {
    const float* Y = (const float*)(p.ws + WS_Y);
    float* XS = (float*)(p.ws + WS_XS);
    bf16* HB = (bf16*)(p.ws + WS_HB);
    float* AFF = (float*)(p.ws + WS_AFF);
    const float* lng = p.in[I_LNG] + (size_t)(layer * 2 + 0) * DM; const float* lnb = p.in[I_LNB] + (size_t)(layer * 2 + 0) * DM;
    const float* router = p.in[I_ROUTER] + (size_t)layer * DM * NE;
    const int nrows = layer == 0 ? NTOK : LAT;
    for (int row = c.gw; row < nrows; row += c.NGW) {
        const float* xin = layer == 0 ? (row < LAT ? p.in[I_X] + (size_t)row * DM : p.in[I_CTX] + (size_t)(row - LAT) * DM) : XS + (size_t)row * DM;
        const float* mod = mod_row(p, layer, row);
        f32x4 v[4]; float s = 0.f;
#pragma unroll
        for (int j = 0; j < 4; ++j) { const int col = 4 * c.lane + 256 * j;
            v[j] = *(const f32x4*)(xin + col) * ALPHA + *(const f32x4*)(mod + 2048 + col) * *(const f32x4*)(Y + (size_t)row * DM + col);
            s += (v[j].x + v[j].y) + (v[j].z + v[j].w); }
        const float mean = wave_sum(s) * (1.f / DM); float s2 = 0.f;
#pragma unroll
        for (int j = 0; j < 4; ++j) { v[j] = v[j] - mean; s2 += (v[j].x * v[j].x + v[j].y * v[j].y) + (v[j].z * v[j].z + v[j].w * v[j].w); }
        const float rstd = 1.f / sqrtf(wave_sum(s2) * (1.f / DM) + LN_EPS);
        float lg[16];
#pragma unroll
        for (int e = 0; e < 16; ++e) lg[e] = 0.f;
#pragma unroll
        for (int j = 0; j < 4; ++j) { const int col = 4 * c.lane + 256 * j;
            const f32x4 x1 = v[j] * rstd * *(const f32x4*)(lng + col) + *(const f32x4*)(lnb + col);
            *(f32x4*)(XS + (size_t)row * DM + col) = x1;
            const f32x4 hm = x1 * (*(const f32x4*)(mod + 4096 + col) + 1.f) + *(const f32x4*)(mod + 3072 + col);
            *(v2u*)(HB + (size_t)row * DM + col) = (v2u){pk2(hm.x, hm.y), pk2(hm.z, hm.w)};
#pragma unroll
            for (int q = 0; q < 4; ++q) { const float hv = hm[q]; const float* rp = router + (size_t)(col + q) * NE;
#pragma unroll
                for (int e4 = 0; e4 < 4; ++e4) { const f32x4 rw = *(const f32x4*)(rp + 4 * e4); lg[4 * e4] += hv * rw.x; lg[4 * e4 + 1] += hv * rw.y; lg[4 * e4 + 2] += hv * rw.z; lg[4 * e4 + 3] += hv * rw.w; } } }
        float mx = -1e30f;
#pragma unroll
        for (int e = 0; e < 16; ++e) { lg[e] = wave_sum(lg[e]); mx = fmaxf(mx, lg[e]); }
        float den = 0.f;
#pragma unroll
        for (int e = 0; e < 16; ++e) { lg[e] = expf(lg[e] - mx); den += lg[e]; }
        float mine = 0.f;
#pragma unroll
        for (int e = 0; e < 16; ++e) mine = (c.lane == e) ? lg[e] : mine;
        if (c.lane < 16) AFF[(size_t)row * NE + c.lane] = mine / den;
    }
}

__device__ __forceinline__ void ph_topk(const Params& p, const Ctx& c, int layer) {
    const float* AFF = (const float*)(p.ws + WS_AFF);
    int* INV = (int*)(p.ws + WS_INV);
    float* GATE = (float*)(p.ws + WS_GATE);
    const bf16* HB = (const bf16*)(p.ws + WS_HB);
    bf16* XG = (bf16*)(p.ws + WS_XG);
    LAS float* vals = (LAS float*)c.lds;
    LAS int* sel = (LAS int*)(c.lds + 8192);
    const int MR = layer == 0 ? MR0 : MR1;
    const int ntasks = layer == 0 ? 256 : 128;
    for (int task = c.vcu; task < ntasks; task += c.G) {
        int set, e, n, cap, rowbase, slotbase;
        if (task < 128) { set = task >> 4; e = task & 15; n = SEQ; cap = 256; rowbase = set * SEQ; slotbase = set * 256; }
        else { const int t2 = task - 128; set = t2 >> 4; e = t2 & 15; n = NCTX; cap = 32; rowbase = LAT + set * NCTX; slotbase = 2048 + set * 32; }
        for (int i = c.tid; i < n; i += 512) vals[i] = AFF[(size_t)(rowbase + i) * NE + e];
        __syncthreads();
        float mv[4]; int rk[4];
#pragma unroll
        for (int q = 0; q < 4; ++q) { const int i = c.tid + 512 * q; mv[q] = i < n ? vals[i] : 0.f; rk[q] = 0; }
        for (int j = 0; j < n; ++j) {
            const float vj = vals[j];
#pragma unroll
            for (int q = 0; q < 4; ++q) { const int i = c.tid + 512 * q; rk[q] += (vj > mv[q] || (vj == mv[q] && j < i)) ? 1 : 0; }
        }
#pragma unroll
        for (int q = 0; q < 4; ++q) { const int i = c.tid + 512 * q;
            if (i < n) { int slot = -1;
                if (rk[q] < cap) { slot = e * MR + slotbase + rk[q]; sel[rk[q]] = i; GATE[slot] = mv[q]; }
                INV[(size_t)(rowbase + i) * NE + e] = slot; } }
        __syncthreads();
        for (int s = c.wave; s < cap; s += 8) {
            const bf16* src = HB + (size_t)(rowbase + sel[s]) * DM; bf16* dst = XG + (size_t)(e * MR + slotbase + s) * DM;
            *(v4u*)(dst + 8 * c.lane) = *(const v4u*)(src + 8 * c.lane);
            *(v4u*)(dst + 512 + 8 * c.lane) = *(const v4u*)(src + 512 + 8 * c.lane);
        }
        __syncthreads();
    }
}

__device__ __forceinline__ void ph_combine(const Params& p, const Ctx& c, int layer) {
    const bf16* YS = (const bf16*)(p.ws + WS_YS);
    const int* INV = (const int*)(p.ws + WS_INV);
    float* XS = (float*)(p.ws + WS_XS);
    bf16* HB = (bf16*)(p.ws + WS_HB);
    const float* lng = p.in[I_LNG] + (size_t)(layer * 2 + 1) * DM; const float* lnb = p.in[I_LNB] + (size_t)(layer * 2 + 1) * DM;
    const int nrows = layer == 0 ? NTOK : LAT;
    for (int row = c.gw; row < nrows; row += c.NGW) {
        const float* mod = mod_row(p, layer, row);
        f32x4 mo[4];
#pragma unroll
        for (int j = 0; j < 4; ++j) mo[j] = (f32x4){0.f, 0.f, 0.f, 0.f};
        for (int e = 0; e < NE; ++e) {
            const int s = INV[(size_t)row * NE + e];
            if (s >= 0) {
#pragma unroll
                for (int j = 0; j < 4; ++j) { const v2u w = *(const v2u*)(YS + (size_t)s * DM + 4 * c.lane + 256 * j);
                    mo[j].x += bf2f(w.x & 0xffffu); mo[j].y += __uint_as_float(w.x & 0xffff0000u); mo[j].z += bf2f(w.y & 0xffffu); mo[j].w += __uint_as_float(w.y & 0xffff0000u); }
            }
        }
        f32x4 v[4]; float s = 0.f;
#pragma unroll
        for (int j = 0; j < 4; ++j) { const int col = 4 * c.lane + 256 * j;
            v[j] = *(const f32x4*)(XS + (size_t)row * DM + col) * ALPHA + *(const f32x4*)(mod + 5120 + col) * mo[j];
            s += (v[j].x + v[j].y) + (v[j].z + v[j].w); }
        const float mean = wave_sum(s) * (1.f / DM); float s2 = 0.f;
#pragma unroll
        for (int j = 0; j < 4; ++j) { v[j] = v[j] - mean; s2 += (v[j].x * v[j].x + v[j].y * v[j].y) + (v[j].z * v[j].z + v[j].w * v[j].w); }
        const float rstd = 1.f / sqrtf(wave_sum(s2) * (1.f / DM) + LN_EPS);
        const float* modn = mod_row(p, 1, row);
#pragma unroll
        for (int j = 0; j < 4; ++j) { const int col = 4 * c.lane + 256 * j;
            const f32x4 x2 = v[j] * rstd * *(const f32x4*)(lng + col) + *(const f32x4*)(lnb + col);
            if (layer == 0) {
                *(f32x4*)(XS + (size_t)row * DM + col) = x2;
                const f32x4 h = x2 * (*(const f32x4*)(modn + 1024 + col) + 1.f) + *(const f32x4*)(modn + col);
                *(v2u*)(HB + (size_t)row * DM + col) = (v2u){pk2(h.x, h.y), pk2(h.z, h.w)};
            } else {
                *(f32x4*)(p.out + (size_t)row * DM + col) = x2;
            } }
    }
}

__device__ __forceinline__ void na_key(const float* q, float* o, float& m, float& l, const bf16* kp, const bf16* vp, float bias) {
    float s = bias;
#pragma unroll
    for (int i = 0; i < 8; ++i) { float f[8]; unpack8(*(const v4u*)(kp + 8 * i), f);
#pragma unroll
        for (int j = 0; j < 8; ++j) s += q[8 * i + j] * f[j]; }
    const float mn = fmaxf(m, s), al = exp2f(m - mn), pp = exp2f(s - mn);
    l = l * al + pp; m = mn;
#pragma unroll
    for (int i = 0; i < 8; ++i) { float f[8]; unpack8(*(const v4u*)(vp + 8 * i), f);
#pragma unroll
        for (int j = 0; j < 8; ++j) o[8 * i + j] = o[8 * i + j] * al + pp * f[j]; }
}
__device__ __forceinline__ void ph_mixer1_naive(const Params& p, const Ctx& c) {
    const bf16* P2 = (const bf16*)(p.ws + WS_QKV);
    bf16* CC = (bf16*)(p.ws + WS_CC);
    const float* rpb = p.in[I_RPB]; const float* pool_w = p.in[I_POOLW]; const float* pool_s = p.in[I_POOLS];
    LAS float* pl = (LAS float*)c.lds;
    for (int u = c.vcu; u < 256; u += c.G) {
        const int b = u >> 5, r = u & 31;
        {
            const int h = c.wave, col = c.lane, row = b * SEQ + r * 64 + col;
            const int rs = min(max(r - 4, 0), 24), cs = min(max(col - 8, 0), 48);
            float q[64], o[64];
#pragma unroll
            for (int i = 0; i < 8; ++i) unpack8(*(const v4u*)(P2 + (size_t)row * OIN + h * 64 + 8 * i), q + 8 * i);
#pragma unroll
            for (int i = 0; i < 64; ++i) o[i] = 0.f;
            float m = -1e30f, l = 0.f;
#pragma unroll 1
            for (int i = 0; i < 8; ++i)
#pragma unroll 1
                for (int j = 0; j < 16; ++j) {
                    const int krow = b * SEQ + (rs + i) * 64 + cs + j;
                    const float bias = rpb[(h * 15 + (rs + i - r + 7)) * 31 + (cs + j - col + 15)] * LOG2E;
                    na_key(q, o, m, l, P2 + (size_t)krow * OIN + 512 + h * 64, P2 + (size_t)krow * OIN + 1024 + h * 64, bias);
                }
#pragma unroll 1
            for (int j = 0; j < NCTX; ++j) {
                const int krow = LAT + b * NCTX + j;
                na_key(q, o, m, l, P2 + (size_t)krow * OIN + 512 + h * 64, P2 + (size_t)krow * OIN + 1024 + h * 64, 0.f);
            }
            const float rl = 1.f / l; bf16* dst = CC + (size_t)row * DM + h * 64;
#pragma unroll
            for (int i = 0; i < 8; ++i) *(v4u*)(dst + 8 * i) = (v4u){pk2(o[8 * i] * rl, o[8 * i + 1] * rl), pk2(o[8 * i + 2] * rl, o[8 * i + 3] * rl), pk2(o[8 * i + 4] * rl, o[8 * i + 5] * rl), pk2(o[8 * i + 6] * rl, o[8 * i + 7] * rl)};
        }
        __syncthreads();
        {
            const int ch = c.tid, g = ch >> 7, half = 1 << g;
            for (int tt = 0; tt < 64; ++tt) {
                const int t = r * 64 + tt, lo = max(t - half, 0), hi = min(t + half, SEQ);
                float s = 0.f;
                for (int t2 = lo; t2 < hi; ++t2) s += bf2f((unsigned)P2[(size_t)(b * SEQ + t2) * OIN + 1536 + ch]);
                pl[tt * 512 + ch] = s / (float)(hi - lo) - bf2f((unsigned)P2[(size_t)(b * SEQ + t) * OIN + 1536 + ch]);
            }
        }
        __syncthreads();
        {
            const int g = c.tid >> 7, e = c.tid & 127;
            const float ps = pool_s[g * 128 + e];
#pragma unroll 1
            for (int tb = 0; tb < 64; tb += 16) {
                float acc[16];
#pragma unroll
                for (int i = 0; i < 16; ++i) acc[i] = 0.f;
#pragma unroll 4
                for (int cc = 0; cc < 128; ++cc) {
                    const float w = pool_w[(size_t)(g * 128 + cc) * 128 + e];
#pragma unroll
                    for (int i = 0; i < 16; ++i) acc[i] += pl[(tb + i) * 512 + g * 128 + cc] * w;
                }
#pragma unroll
                for (int i = 0; i < 16; ++i) CC[(size_t)(b * SEQ + r * 64 + tb + i) * DM + 512 + g * 128 + e] = (bf16)f2bf(acc[i] * ps);
            }
        }
        __syncthreads();
    }
}

__global__ void __launch_bounds__(512, 2) mk_fwd(Params p) {
    extern __shared__ __attribute__((aligned(16))) unsigned char lds_raw[];
    Ctx c;
    c.lds = (LAS unsigned char*)lds_raw;
    c.tid = threadIdx.x; c.lane = c.tid & 63; c.wave = __builtin_amdgcn_readfirstlane(c.tid >> 6);
    c.G = gridDim.x; { const int bx = blockIdx.x; c.vcu = (c.G % 8 == 0) ? (bx % 8) * (c.G / 8) + bx / 8 : bx; }
    c.gw = c.vcu * 8 + c.wave; c.NGW = c.G * 8;
    volatile LAS unsigned* MISC = (volatile LAS unsigned*)(c.lds + MISC_OFF);
    if (c.tid < 32) MISC[c.tid] = 0u;
    __syncthreads();
    gu32* ctl = (gu32*)(p.ws + WS_CTL);
    XcdBarrier bar; bar.bar = (unsigned*)(ctl + CW_BAR); bar.x = 0; bar.st = nullptr;
    if (!MK_MULTI) bar = xcd_barrier_post((unsigned*)(ctl + CW_BAR), MISC + 8);
    const int lo = p.ph_lo, hi = p.ph_hi;
#define IN(k) (lo <= (k) && (k) < hi)
#define SEAM(k) do { if (IN(k) && IN((k) + 1)) xcd_barrier(bar); } while (0)

    bf16* HB = (bf16*)(p.ws + WS_HB); bf16* QKV = (bf16*)(p.ws + WS_QKV); bf16* CC = (bf16*)(p.ws + WS_CC);
    float* Y = (float*)(p.ws + WS_Y); float* PF = (float*)(p.ws + WS_PF);
    bf16* XG = (bf16*)(p.ws + WS_XG); bf16* HID = (bf16*)(p.ws + WS_HID); bf16* YS = (bf16*)(p.ws + WS_YS);
    const float* GATE = (const float*)(p.ws + WS_GATE);

    if (IN(0)) { ph_prologue(p, c); if (FAST_GEMM) { __syncthreads(); ph_transposes(p, c); } } SEAM(0);
    if (IN(1)) { ph_modulate0(p, c); } SEAM(1);
    if (IN(2)) {
        if (FAST_GEMM) { pg8::Gemm g{HB, (const bf16*)(p.ws + WS_W0IN), NTOK, EIN, DM, 0}; pg8::StaticOrder S; S.init(NTOK, EIN, c.G, (int)blockIdx.x);
            pg8::EpiBf16<0> E{QKV, EIN, nullptr, 0, 0, 1.f}; pg8::gemm_phase<pg8::EpiBf16<0>, pg8::StaticOrder, true, true>(c.lds, g, S, E); }
        else { NG g{HB, DM, p.in[I_W0IN], nullptr, EIN, 0, 1 << 30, 0, NTOK, 0, EIN, DM}; ngemm<1>(g, c, EpiF32{PF, EIN}); }
    } SEAM(2);
    if (IN(3)) { if (FAST_GEMM) ph_qkv_post<false>(p, c); else ph_qkv_post<true>(p, c); } SEAM(3);
    if (IN(4)) { if (FAST_ATTN) ph_attn0_fast(p, c, (char*)lds_raw); else ph_attn0_naive(p, c); } SEAM(4);
    if (IN(5)) { ph_attn_combine(p, c); } SEAM(5);
    if (IN(6)) {
        if (FAST_GEMM) { pg8::Gemm g{CC, (const bf16*)(p.ws + WS_W0OUT), NTOK, DM, DM, 0}; pg8::StaticOrder S; S.init(NTOK, DM, c.G, (int)blockIdx.x);
            pg8::EpiF32P E{Y, DM}; pg8::gemm_phase<pg8::EpiF32P, pg8::StaticOrder, true, true>(c.lds, g, S, E); }
        else { NG g{CC, DM, p.in[I_W0OUT], nullptr, DM, 0, 1 << 30, 0, NTOK, 0, DM, DM}; ngemm<1>(g, c, EpiF32{Y, DM}); }
    } SEAM(6);
    if (IN(7)) { ph_ln1_router(p, c, 0); } SEAM(7);
    if (IN(8)) { ph_topk(p, c, 0); } SEAM(8);
    if (IN(9)) {
        if (FAST_GEMM) { pg8::Gemm g{XG, (const bf16*)(p.ws + WS_WGU), NE * MR0, 4096, DM, (size_t)4096 * DM * 2}; pg8::GroupedOrder S; S.init(MR0 / 256, 16, NE, c.G, c.vcu);
            pg8::EpiSwigluP E{HID, FF}; pg8::gemm_phase<pg8::EpiSwigluP, pg8::GroupedOrder, true, true>(c.lds, g, S, E); }
        else { NG g{XG, DM, p.in[I_WG], p.in[I_WU], FF, (size_t)DM * FF, MR0, 0, NE * MR0, 0, FF, DM}; ngemm<2>(g, c, EpiSwiglu{HID}); }
    } SEAM(9);
    if (IN(10)) {
        if (FAST_GEMM) { pg8::Gemm g{HID, (const bf16*)(p.ws + WS_WDN), NE * MR0, DM, FF, (size_t)DM * FF * 2}; pg8::GroupedOrder S; S.init(MR0 / 256, 4, NE, c.G, c.vcu);
            pg8::EpiGateP E{YS, DM, GATE}; pg8::gemm_phase<pg8::EpiGateP, pg8::GroupedOrder, true, true>(c.lds, g, S, E); }
        else { NG g{HID, FF, p.in[I_WD], nullptr, DM, (size_t)FF * DM, MR0, 0, NE * MR0, 0, DM, FF}; ngemm<1>(g, c, EpiGate{YS, GATE}); }
    } SEAM(10);
    if (IN(11)) { ph_combine(p, c, 0); } SEAM(11);
    if (IN(12)) {
        if (FAST_GEMM) { pg8::Gemm g{HB, (const bf16*)(p.ws + WS_W1IN), NTOK, OIN, DM, 0}; pg8::L1InOrder S; S.init(c.G, (int)blockIdx.x);
            pg8::EpiBf16<0> E{QKV, OIN, nullptr, 512, 512, C2}; pg8::gemm_phase<pg8::EpiBf16<0>, pg8::L1InOrder, true, true>(c.lds, g, S, E); }
        else {
        NG g{HB, DM, p.in[I_W1IN], nullptr, OIN, 0, 1 << 30, 0, LAT, 0, OIN, DM}; ngemm<1>(g, c, EpiBf{QKV, OIN, 512, C2});
        NG g2{HB, DM, p.in[I_W1IN], nullptr, OIN, 0, 1 << 30, LAT, NTOK, 512, 1536, DM}; ngemm<1>(g2, c, EpiBf{QKV, OIN, 0, 1.f}); }
    } SEAM(12);
    if (IN(13)) { ph_mixer1_naive(p, c); } SEAM(13);
    if (IN(14)) {
        if (FAST_GEMM) { pg8::Gemm g{CC, (const bf16*)(p.ws + WS_W1OUT), LAT, DM, DM, 0}; pg8::StaticOrder S; S.init(LAT, DM, c.G, (int)blockIdx.x);
            pg8::EpiF32P E{Y, DM}; pg8::gemm_phase<pg8::EpiF32P, pg8::StaticOrder, true, true>(c.lds, g, S, E); }
        else { NG g{CC, DM, p.in[I_W1OUT], nullptr, DM, 0, 1 << 30, 0, LAT, 0, DM, DM}; ngemm<1>(g, c, EpiF32{Y, DM}); }
    } SEAM(14);
    if (IN(15)) { ph_ln1_router(p, c, 1); } SEAM(15);
    if (IN(16)) { ph_topk(p, c, 1); } SEAM(16);
    if (IN(17)) {
        if (FAST_GEMM) { pg8::Gemm g{XG, (const bf16*)(p.ws + WS_WGU + WS_MOE_LSTRIDE), NE * MR1, 4096, DM, (size_t)4096 * DM * 2}; pg8::GroupedOrder S; S.init(MR1 / 256, 16, NE, c.G, c.vcu);
            pg8::EpiSwigluP E{HID, FF}; pg8::gemm_phase<pg8::EpiSwigluP, pg8::GroupedOrder, true, true>(c.lds, g, S, E); }
        else { NG g{XG, DM, p.in[I_WG] + (size_t)NE * DM * FF, p.in[I_WU] + (size_t)NE * DM * FF, FF, (size_t)DM * FF, MR1, 0, NE * MR1, 0, FF, DM}; ngemm<2>(g, c, EpiSwiglu{HID}); }
    } SEAM(17);
    if (IN(18)) {
        if (FAST_GEMM) { pg8::Gemm g{HID, (const bf16*)(p.ws + WS_WDN + WS_MOE_LSTRIDE), NE * MR1, DM, FF, (size_t)DM * FF * 2}; pg8::GroupedOrder S; S.init(MR1 / 256, 4, NE, c.G, c.vcu);
            pg8::EpiGateP E{YS, DM, GATE}; pg8::gemm_phase<pg8::EpiGateP, pg8::GroupedOrder, true, true>(c.lds, g, S, E); }
        else { NG g{HID, FF, p.in[I_WD] + (size_t)NE * FF * DM, nullptr, DM, (size_t)FF * DM, MR1, 0, NE * MR1, 0, DM, FF}; ngemm<1>(g, c, EpiGate{YS, GATE}); }
    } SEAM(18);
    if (IN(19)) { ph_combine(p, c, 1); }
#undef IN
#undef SEAM
}

extern "C" void kernel_launch(void* const* d_in, const int* in_sizes, int n_in, void* d_out, int out_size, void* d_ws, size_t ws_size, hipStream_t stream) {
    static int grid = 0;
    if (grid == 0) {
        if (n_in != 26 || out_size != LAT * DM || ws_size < WS_END) { fprintf(stderr, "kernel_launch: unexpected shapes (n_in %d out %d ws %zu)\n", n_in, out_size, ws_size); grid = -1; return; }
        int dev = 0, cus = 0;
        if (hipGetDevice(&dev) != hipSuccess || hipDeviceGetAttribute(&cus, hipDeviceAttributeMultiprocessorCount, dev) != hipSuccess) { grid = -1; return; }
        if (hipFuncSetAttribute((const void*)mk_fwd, hipFuncAttributeMaxDynamicSharedMemorySize, LDS_BYTES) != hipSuccess) { fprintf(stderr, "kernel_launch: hipFuncSetAttribute failed\n"); grid = -1; return; }
        int per_cu = 0;
        if (hipOccupancyMaxActiveBlocksPerMultiprocessor(&per_cu, (const void*)mk_fwd, 512, LDS_BYTES) != hipSuccess || per_cu < 1) fprintf(stderr, "kernel_launch: occupancy query says %d\n", per_cu);
        (void)hipGetLastError();
        grid = cus;
    }
    if (grid < 0) return;
    (void)hipMemsetAsync((char*)d_ws + WS_CTL, 0, CTL_ZERO_BYTES, stream);
    Params a{};
    for (int i = 0; i < 26; ++i) a.in[i] = (const float*)d_in[i];
    a.out = (float*)d_out; a.ws = (unsigned char*)d_ws;
#if MK_MULTI
    for (int ph = 0; ph < NPHASE; ++ph) { a.ph_lo = ph; a.ph_hi = ph + 1; hipLaunchKernelGGL(mk_fwd, dim3(grid), dim3(512), LDS_BYTES, stream, a); }
#else
    a.ph_lo = 0; a.ph_hi = NPHASE;
    hipLaunchKernelGGL(mk_fwd, dim3(grid), dim3(512), LDS_BYTES, stream, a);
#endif
}
```

```cpp
#include <hip/hip_runtime.h>
#include <cstdio>
#include <cstdint>

#define GAS __attribute__((address_space(1)))
#define LAS __attribute__((address_space(3)))
typedef unsigned short bf16;
typedef unsigned v4u __attribute__((ext_vector_type(4)));
typedef unsigned v2u __attribute__((ext_vector_type(2)));
typedef float f32x4 __attribute__((ext_vector_type(4)));
typedef float f32x2 __attribute__((ext_vector_type(2)));
typedef float f32x16 __attribute__((ext_vector_type(16)));
typedef GAS unsigned gu32;

#ifndef FAST_NA
#define FAST_NA 1
#endif
#ifndef FAST_ATTN
#define FAST_ATTN 1
#endif
#ifndef FAST_GEMM
#define FAST_GEMM 1
#endif
#ifndef MK_MULTI
#define MK_MULTI 0
#endif

constexpr int NBATCH = 8, SEQ = 2048, DM = 1024, NCTX = 256;
constexpr int LAT = NBATCH * SEQ;
constexpr int NTOK = LAT + NBATCH * NCTX;
constexpr int EIN = 2304, OIN = 2048, NE = 16, FF = 2048;
constexpr int MR0 = 2304, MR1 = 2048;
constexpr float LOG2E = 1.4426950408889634f;
constexpr float C2 = 0.125f * LOG2E;
constexpr float ALPHA = 1.4142135623730951f;
constexpr float LN_EPS = 1e-5f, RMS_EPS = 1e-6f;
constexpr float LAM_INIT = 0.2f;
constexpr int NPHASE = 20;

constexpr size_t MiB = 1u << 20;
constexpr size_t WS_CTL = 0, CTL_ZERO_BYTES = 1 * MiB;
constexpr size_t WS_MOD = 1 * MiB;
constexpr size_t WS_ROPE = 1 * MiB + 512 * 1024;
constexpr size_t WS_W0IN = 2 * MiB;
constexpr size_t WS_W0OUT = 7 * MiB;
constexpr size_t WS_W1IN = 9 * MiB;
constexpr size_t WS_W1OUT = 13 * MiB;
constexpr size_t WS_AFF = 16 * MiB;
constexpr size_t WS_INV = 18 * MiB;
constexpr size_t WS_GATE = 20 * MiB;
constexpr size_t WS_WGU = 24 * MiB;
constexpr size_t WS_WDN = 152 * MiB;
constexpr size_t WS_MOE_LSTRIDE = 192 * MiB;
constexpr size_t WS_XS = 408 * MiB;
constexpr size_t WS_HB = 480 * MiB;
constexpr size_t WS_QKV = 516 * MiB;
constexpr size_t WS_CC = 597 * MiB;
constexpr size_t WS_AO = 633 * MiB;
constexpr size_t WS_Y = 705 * MiB;
constexpr size_t WS_XG = 516 * MiB;
constexpr size_t WS_HID = 588 * MiB;
constexpr size_t WS_YS = 732 * MiB;
constexpr size_t WS_PF = 804 * MiB;
constexpr size_t WS_END = 968 * MiB;

constexpr int CW_BAR = 4096;
constexpr int LDS_BYTES = 147456;
constexpr int MISC_OFF = 131072 + 320;

__device__ __forceinline__ float bf2f(unsigned v) { return __uint_as_float(v << 16); }
__device__ __forceinline__ unsigned f2bf(float f) { unsigned u = __float_as_uint(f); return (u + 0x7fffu + ((u >> 16) & 1u)) >> 16; }
__device__ __forceinline__ unsigned pk2(float lo, float hi) { return f2bf(lo) | (f2bf(hi) << 16); }
__device__ __forceinline__ float wave_sum(float v) {
#pragma unroll
    for (int o = 1; o < 64; o <<= 1) v += __shfl_xor(v, o);
    return v;
}
__device__ __forceinline__ float wave_max(float v) {
#pragma unroll
    for (int o = 1; o < 64; o <<= 1) v = fmaxf(v, __shfl_xor(v, o));
    return v;
}
__device__ __forceinline__ void unpack8(const v4u w, float* f) {
    f[0] = bf2f(w.x & 0xffffu); f[1] = __uint_as_float(w.x & 0xffff0000u);
    f[2] = bf2f(w.y & 0xffffu); f[3] = __uint_as_float(w.y & 0xffff0000u);
    f[4] = bf2f(w.z & 0xffffu); f[5] = __uint_as_float(w.z & 0xffff0000u);
    f[6] = bf2f(w.w & 0xffffu); f[7] = __uint_as_float(w.w & 0xffff0000u);
}

#define XB_TMO      128
#define XB_XCNT(j)  (256  + 64 * (j))
#define XB_XSUB(j)  (1280 + 64 * (j))
#define XB_XGEN(j)  (2304 + 64 * (j))
#define XB_TOP      3328
#define XB_TOPGEN   3392
#define XCD_BAR_WORDS 3456
#define XB_SPIN_CAP (1u << 18)
__device__ __forceinline__ unsigned xb_ld(unsigned* p)              { return __hip_atomic_load(p, __ATOMIC_RELAXED, __HIP_MEMORY_SCOPE_AGENT); }
__device__ __forceinline__ unsigned xb_add(unsigned* p, unsigned v) { return __hip_atomic_fetch_add(p, v, __ATOMIC_RELAXED, __HIP_MEMORY_SCOPE_AGENT); }
__device__ __forceinline__ unsigned xb_xcc_id() { return (unsigned)__builtin_amdgcn_s_getreg((3 << 11) | 20) & 0xFu; }
#define XB_SPIN(cond, bar) do { unsigned _sp = 0; while (cond) { __builtin_amdgcn_s_sleep(1); \
    if ((++_sp & 255u) == 0u) { if (xb_ld(&(bar)[XB_TMO])) break; if (_sp > XB_SPIN_CAP) { atomicAdd(&(bar)[XB_TMO], 1u); break; } } } } while (0)
struct XcdBarrier { unsigned* bar; unsigned x; volatile LAS unsigned* st; };
__device__ __forceinline__ XcdBarrier xcd_barrier_post(unsigned* bar, volatile LAS unsigned* st) {
    XcdBarrier b; b.bar = bar; b.x = xb_xcc_id(); b.st = st;
    if (threadIdx.x == 0) (void)xb_add(&bar[XB_XCNT(b.x)], 1u);
    return b;
}
__device__ __forceinline__ void xcd_barrier_complete(unsigned* bar, unsigned x, unsigned& nloc, unsigned& nx) {
    const unsigned G = gridDim.x * gridDim.y * gridDim.z;
    unsigned sum, cnt, mine, sp = 0u;
    for (;;) {
        sum = 0u; cnt = 0u; mine = 0u;
#pragma unroll
        for (unsigned j = 0; j < 16; ++j) { const unsigned c = xb_ld(&bar[XB_XCNT(j)]); sum += c; cnt += (c > 0u) ? 1u : 0u; mine = (j == x) ? c : mine; }
        if (sum == G) break;
        __builtin_amdgcn_s_sleep(1);
        if ((++sp & 255u) == 0u) { if (xb_ld(&bar[XB_TMO])) break; if (sp > XB_SPIN_CAP) { atomicAdd(&bar[XB_TMO], 1u); break; } }
    }
    nloc = mine > 0u ? mine : 1u; nx = cnt > 0u ? cnt : 1u;
}
__device__ __forceinline__ void xcd_barrier(const XcdBarrier& b) {
    asm volatile("s_waitcnt vmcnt(0)" ::: "memory");
    __syncthreads();
    if (threadIdx.x == 0) {
        unsigned* bar = b.bar;
        __builtin_amdgcn_s_waitcnt(0);
        unsigned nloc = b.st[0], nx = b.st[1];
        if (nloc == 0u) { xcd_barrier_complete(bar, b.x, nloc, nx); b.st[0] = nloc; b.st[1] = nx; }
        const unsigned old = xb_add(&bar[XB_XSUB(b.x)], 1u);
        const unsigned gen = old / nloc;
        if (old + 1u == (gen + 1u) * nloc) {
            __builtin_amdgcn_fence(__ATOMIC_RELEASE, "agent");
            asm volatile("s_waitcnt vmcnt(0)" ::: "memory");
            const unsigned og = xb_add(&bar[XB_TOP], 1u);
            const unsigned tg = og / nx;
            if (og + 1u == (tg + 1u) * nx) xb_add(&bar[XB_TOPGEN], 1u);
            else XB_SPIN(xb_ld(&bar[XB_TOPGEN]) == tg, bar);
            __builtin_amdgcn_fence(__ATOMIC_ACQUIRE, "agent");
            xb_add(&bar[XB_XGEN(b.x)], 1u);
            asm volatile("s_waitcnt vmcnt(0)" ::: "memory");
        } else {
            XB_SPIN(xb_ld(&bar[XB_XGEN(b.x)]) == gen, bar);
            __builtin_amdgcn_fence(__ATOMIC_ACQUIRE, "agent");
            asm volatile("s_waitcnt vmcnt(0)" ::: "memory");
        }
    }
    __syncthreads();
}

namespace pg8 {
#define PG8_LAS __attribute__((address_space(3)))
typedef unsigned short bf16_t;
typedef short bf16x8 __attribute__((ext_vector_type(8)));
typedef float f32x4 __attribute__((ext_vector_type(4)));
typedef unsigned u32x4 __attribute__((ext_vector_type(4)));
constexpr int BM = 256, BK = 64, HALF = 128, HTB = HALF * BK * 2  , STAGE_BYTES = 8 * HTB, NXCD = 8, WGM = 8;

__host__ __device__ __forceinline__ int lds_byte(int r, int c) { const int st = (r >> 4) * 2 + (c >> 5), rr = r & 15, cc = c & 31, ob = rr * 64 + cc * 2; return st * 1024 + (ob ^ (((ob >> 9) & 1) << 5)); }
__host__ __device__ __forceinline__ void stage_rc(int b, int& R, int& C) { const int st = b / 1024, sb = b % 1024, swz = sb ^ (((sb >> 9) & 1) << 5); R = (st >> 1) * 16 + swz / 64; C = (st & 1) * 32 + (swz % 64) / 2; }
__host__ __device__ __forceinline__ int perm32(int rho) { const int n = rho >> 4, i = rho & 15; return 8 * (i >> 2) + 4 * n + (i & 3); }

struct Unit { int pm, pn, e; };
struct Gemm { const bf16_t* A; const bf16_t* Bt; int M, N, K; size_t bstride; };

struct StaticOrder {
    int nM, nN, nwg, G, c;
    __host__ __device__ void init(int M, int N, int G_, int c_) { nM = M / BM; nN = N / BM; nwg = nM * nN; G = G_; c = c_; }
    __host__ __device__ bool next(int i, Unit& u) const {
        const long L = (long)i * G + c; if (L >= nwg) return false;
        int wgid = (int)L; { const int q = nwg / NXCD, r = nwg % NXCD, xcd = wgid % NXCD, off = wgid / NXCD; wgid = (xcd < r ? xcd * (q + 1) : r * (q + 1) + (xcd - r) * q) + off; }
        const int nig = WGM * nN, gid = wgid / nig, fm = gid * WGM, gsz = (nM - fm) < WGM ? (nM - fm) : WGM;
        u.pm = fm + ((wgid % nig) % gsz); u.pn = (wgid % nig) / gsz; u.e = 0; return true;
    }
    __device__ __forceinline__ void a_ready(const Unit&) const {}
    __device__ __forceinline__ void done(const Unit&) const {}
};

__device__ __forceinline__ unsigned cvt_pk_bf16(float lo, float hi) { unsigned r; asm volatile("v_cvt_pk_bf16_f32 %0, %1, %2" : "=v"(r) : "v"(lo), "v"(hi)); return r; }
typedef float f32x2 __attribute__((ext_vector_type(2)));
__device__ __forceinline__ f32x2 gelu_pk(f32x2 v) {
    const f32x2 av = __builtin_elementwise_abs(v), d = av * 0.2316418882f + 1.0f;
    f32x2 t; t.x = __builtin_amdgcn_rcpf(d.x); t.y = __builtin_amdgcn_rcpf(d.y);
    f32x2 q = t * 0.5307027145f + (-0.7265760135f); q = q * t + 0.7107068705f; q = q * t + (-0.142248368f); q = q * t + 0.127414796f; q = q * t;
    const f32x2 s = (v * v) * (-0.72134752044f);
    f32x2 e; e.x = __builtin_amdgcn_exp2f(s.x); e.y = __builtin_amdgcn_exp2f(s.y);
    const f32x2 m = v * (q * e), r = v - m;
    f32x2 o; o.x = v.x < 0.f ? m.x : r.x; o.y = v.y < 0.f ? m.y : r.y; return o;
}

template <int ACT  > struct EpiBf16 {
    static constexpr bool PERM = true, AFTER_DRAIN = false; static_assert(ACT == 0 || ACT == 1, "EpiBf16: ACT is 0 (none) or 1 (gelu_pk)");
    bf16_t* O; int ldc; const float* bias; int split_cols; size_t split_stride; float scale0;
    __device__ __forceinline__ void operator()(const f32x4 (&acc)[2][2][4][2], const Unit& u, int wr, int wc, int fr, int fq) const {
        const int row0 = u.pm * BM + wr * 64 + fr; int colt = u.pn * BM; bf16_t* base = O;
        float sc = 1.f; if (split_cols) { const int t = colt / split_cols; base += (size_t)t * split_stride; colt -= t * split_cols; if (t == 0) sc = scale0; }
        const int col0 = colt + wc * 32 + 8 * fq, bcol0 = u.pn * BM + wc * 32 + 8 * fq;
        f32x4 bv[2][2];
#pragma unroll
        for (int bj = 0; bj < 2; ++bj)
#pragma unroll
            for (int n = 0; n < 2; ++n) bv[bj][n] = bias ? *(const f32x4*)(bias + bcol0 + bj * HALF + 4 * n) : (f32x4){0.f, 0.f, 0.f, 0.f};
#pragma unroll
        for (int ai = 0; ai < 2; ++ai)
#pragma unroll
            for (int m = 0; m < 4; ++m) { bf16_t* rowp = base + (size_t)(row0 + ai * HALF + m * 16) * ldc + col0;
#pragma unroll
                for (int bj = 0; bj < 2; ++bj) { f32x4 v0 = acc[ai][bj][m][0] + bv[bj][0], v1 = acc[ai][bj][m][1] + bv[bj][1];
                    if (ACT == 1) { f32x2 a = gelu_pk((f32x2){v0[0], v0[1]}), b = gelu_pk((f32x2){v0[2], v0[3]}), c = gelu_pk((f32x2){v1[0], v1[1]}), d = gelu_pk((f32x2){v1[2], v1[3]});
                        v0 = (f32x4){a.x, a.y, b.x, b.y}; v1 = (f32x4){c.x, c.y, d.x, d.y}; }
                    v0 = v0 * sc; v1 = v1 * sc; u32x4 w; w.x = cvt_pk_bf16(v0[0], v0[1]); w.y = cvt_pk_bf16(v0[2], v0[3]); w.z = cvt_pk_bf16(v1[0], v1[1]); w.w = cvt_pk_bf16(v1[2], v1[3]);
                    *(u32x4*)(rowp + bj * HALF) = w; } }
    }
};

template <class Epi, class Sched, bool ALIGN_EPI = false, bool SP2 = false>
__device__ __forceinline__ void gemm_phase(PG8_LAS unsigned char* lds, const Gemm g, const Sched& S, const Epi& E) {
    const int tid = threadIdx.x, wid = __builtin_amdgcn_readfirstlane(tid >> 6), lane = tid & 63, wr = wid >> 2, wc = wid & 3, fr = lane & 15, fq = lane >> 4;
    const int K = g.K, nt = K / BK;
    unsigned voffA[2], voffB[2];
#pragma unroll
    for (int i = 0; i < 2; ++i) { int R, C; stage_rc(tid * 16 + i * 8192, R, C); const int Rb = Epi::PERM ? ((R & ~31) + perm32(R & 31)) : R;
        voffA[i] = (unsigned)(R * K + C) * 2u; voffB[i] = (unsigned)(Rb * K + C) * 2u; }
    const size_t kstep = (size_t)(BK * 2);
    const size_t hstep = (size_t)HALF * K * 2;
    const size_t tstep = 2 * hstep;
    const unsigned ldsw = (unsigned)wid * 1024u;
    const int aoff = lds_byte(wr * 64 + fr, fq * 8), boff = lds_byte(wc * 32 + fr, fq * 8);
#define PG8_SA(b, h) (((b) * 2 + (h)) * HTB)
#define PG8_SB(b, h) ((4 + (b) * 2 + (h)) * HTB)
#define PG8_STAGE(bufoff, gbase, voff) do { _Pragma("unroll") for (int _i = 0; _i < 2; ++_i) \
        __builtin_amdgcn_global_load_lds((const unsigned*)((const char*)(gbase) + (voff)[_i]), (PG8_LAS unsigned*)(lds + (bufoff) + ldsw + _i * 8192), 16, 0, 0); } while (0)
#define PG8_LDA(dst, b, h) do { _Pragma("unroll") for (int m = 0; m < 4; ++m) _Pragma("unroll") for (int k = 0; k < 2; ++k) dst[m][k] = *(const PG8_LAS bf16x8*)(lds + PG8_SA(b, h) + aoff + m * 2048 + k * 1024); } while (0)
#define PG8_LDB(dst, b, h) do { _Pragma("unroll") for (int n = 0; n < 2; ++n) _Pragma("unroll") for (int k = 0; k < 2; ++k) dst[n][k] = *(const PG8_LAS bf16x8*)(lds + PG8_SB(b, h) + boff + n * 2048 + k * 1024); } while (0)
#define PG8_MMA(ai, bj, At, Bt) do { __builtin_amdgcn_s_setprio(1); _Pragma("unroll") for (int m = 0; m < 4; ++m) _Pragma("unroll") for (int n = 0; n < 2; ++n) _Pragma("unroll") for (int k = 0; k < 2; ++k) \
        acc[ai][bj][m][n] = __builtin_amdgcn_mfma_f32_16x16x32_bf16(Bt[n][k], At[m][k], acc[ai][bj][m][n], 0, 0, 0); __builtin_amdgcn_s_setprio(0); } while (0)
#define PG8_WAIT_V(n) asm volatile("s_waitcnt vmcnt(" #n ")" ::: "memory")
#define PG8_WAIT_L(n) asm volatile("s_waitcnt lgkmcnt(" #n ")" ::: "memory")
#define PG8_BAR __builtin_amdgcn_s_barrier()
#define PG8_SCHED __builtin_amdgcn_sched_barrier(0)
    Unit cur, nxt; int ui = 0;
    if (!S.next(0, cur)) return;
    f32x4 acc[2][2][4][2];
#pragma unroll
    for (int a = 0; a < 2; ++a)
#pragma unroll
        for (int b = 0; b < 2; ++b)
#pragma unroll
            for (int m = 0; m < 4; ++m)
#pragma unroll
                for (int n = 0; n < 2; ++n) acc[a][b][m][n] = (f32x4){0.f, 0.f, 0.f, 0.f};
    bf16x8 At[4][2], B0[2][2], B1[2][2];
    const char* cA = (const char*)g.A + (size_t)cur.pm * tstep; const char* cB = (const char*)g.Bt + (size_t)cur.pn * tstep + (size_t)cur.e * g.bstride;
    S.a_ready(cur);
    if constexpr (SP2) {
        PG8_STAGE(PG8_SB(0, 0), cB, voffB); PG8_STAGE(PG8_SB(0, 1), cB + hstep, voffB); PG8_STAGE(PG8_SA(0, 0), cA, voffA); PG8_STAGE(PG8_SA(0, 1), cA + hstep, voffA);
        if (wr == 1) PG8_BAR;
        PG8_WAIT_V(2); PG8_BAR;
        PG8_STAGE(PG8_SB(1, 0), cB + kstep, voffB); PG8_STAGE(PG8_SA(1, 0), cA + kstep, voffA); PG8_STAGE(PG8_SB(1, 1), cB + hstep + kstep, voffB);
        PG8_WAIT_V(6); PG8_BAR;
    } else {
        PG8_STAGE(PG8_SB(0, 0), cB, voffB); PG8_STAGE(PG8_SA(0, 0), cA, voffA); PG8_STAGE(PG8_SB(0, 1), cB + hstep, voffB); PG8_STAGE(PG8_SA(0, 1), cA + hstep, voffA);
        if (wr == 1) PG8_BAR;
        PG8_WAIT_V(4); PG8_BAR;
        PG8_STAGE(PG8_SB(1, 0), cB + kstep, voffB); PG8_STAGE(PG8_SA(1, 0), cA + kstep, voffA); PG8_STAGE(PG8_SB(1, 1), cB + hstep + kstep, voffB);
        PG8_WAIT_V(6); PG8_BAR;
    }
    for (;;) {
        const bool has_next = S.next(ui + 1, nxt);
        const char* nA = has_next ? (const char*)g.A + (size_t)nxt.pm * tstep : cA; const char* nB = has_next ? (const char*)g.Bt + (size_t)nxt.pn * tstep + (size_t)nxt.e * g.bstride : cB;
        for (int t = 0; t < nt; t += 2) {
            const bool last = (t == nt - 2);
            const char* a1 = cA + (size_t)(t + 1) * kstep;
            const char* a2 = last ? nA : cA + (size_t)(t + 2) * kstep; const char* b2 = last ? nB : cB + (size_t)(t + 2) * kstep;
            const char* a3 = a2 + kstep; const char* b3 = b2 + kstep;
            if (last && has_next) S.a_ready(nxt);
            if constexpr (SP2) {
            PG8_LDB(B0, 0, 0); PG8_LDB(B1, 0, 1); PG8_SCHED; PG8_LDA(At, 0, 0); PG8_STAGE(PG8_SA(1, 1), a1 + hstep, voffA);
            PG8_WAIT_V(8); PG8_WAIT_L(0); PG8_BAR; PG8_MMA(0, 0, At, B0); PG8_MMA(0, 1, At, B1); PG8_BAR; PG8_SCHED;
            PG8_LDA(At, 0, 1); PG8_STAGE(PG8_SB(0, 0), b2, voffB); PG8_STAGE(PG8_SB(0, 1), b2 + hstep, voffB); PG8_STAGE(PG8_SA(0, 0), a2, voffA);
            PG8_WAIT_V(8); PG8_WAIT_L(0); PG8_BAR; PG8_MMA(1, 0, At, B0); PG8_MMA(1, 1, At, B1); PG8_BAR; PG8_SCHED;
            PG8_LDB(B0, 1, 0); PG8_LDB(B1, 1, 1); PG8_SCHED; PG8_LDA(At, 1, 0); PG8_STAGE(PG8_SA(0, 1), a2 + hstep, voffA);
            PG8_WAIT_V(8); PG8_WAIT_L(0); PG8_BAR; PG8_MMA(0, 0, At, B0); PG8_MMA(0, 1, At, B1); PG8_BAR; PG8_SCHED;
            PG8_LDA(At, 1, 1); PG8_STAGE(PG8_SB(1, 0), b3, voffB); PG8_STAGE(PG8_SB(1, 1), b3 + hstep, voffB); PG8_STAGE(PG8_SA(1, 0), a3, voffA);
            PG8_WAIT_V(8); PG8_WAIT_L(0); PG8_BAR; PG8_MMA(1, 0, At, B0); PG8_MMA(1, 1, At, B1); PG8_BAR; PG8_SCHED;
            } else {
            PG8_LDB(B0, 0, 0); PG8_SCHED; PG8_LDA(At, 0, 0); PG8_STAGE(PG8_SA(1, 1), a1 + hstep, voffA);
            PG8_WAIT_L(8); PG8_BAR; PG8_WAIT_L(0); PG8_MMA(0, 0, At, B0); PG8_BAR; PG8_SCHED;
            PG8_LDB(B1, 0, 1); PG8_STAGE(PG8_SB(0, 0), b2, voffB);
            PG8_BAR; PG8_WAIT_L(0); PG8_MMA(0, 1, At, B1); PG8_BAR;
            PG8_LDA(At, 0, 1); PG8_STAGE(PG8_SA(0, 0), a2, voffA);
            PG8_BAR; PG8_WAIT_L(0); PG8_MMA(1, 0, At, B0); PG8_BAR; PG8_SCHED;
            PG8_STAGE(PG8_SB(0, 1), b2 + hstep, voffB);
            PG8_WAIT_V(6); PG8_BAR; PG8_MMA(1, 1, At, B1); PG8_BAR;
            PG8_LDB(B0, 1, 0); PG8_SCHED; PG8_LDA(At, 1, 0); PG8_STAGE(PG8_SA(0, 1), a2 + hstep, voffA);
            PG8_WAIT_L(8); PG8_BAR; PG8_WAIT_L(0); PG8_MMA(0, 0, At, B0); PG8_BAR; PG8_SCHED;
            PG8_LDB(B1, 1, 1); PG8_STAGE(PG8_SB(1, 0), b3, voffB);
            PG8_BAR; PG8_WAIT_L(0); PG8_MMA(0, 1, At, B1); PG8_BAR;
            PG8_LDA(At, 1, 1); PG8_STAGE(PG8_SA(1, 0), a3, voffA);
            PG8_BAR; PG8_WAIT_L(0); PG8_MMA(1, 0, At, B0); PG8_BAR; PG8_SCHED;
            PG8_STAGE(PG8_SB(1, 1), b3 + hstep, voffB);
            PG8_WAIT_V(6); PG8_BAR; PG8_MMA(1, 1, At, B1); PG8_BAR;
            }
        }
        if constexpr (ALIGN_EPI) { if (wr == 0) PG8_BAR; }
        if constexpr (!Epi::AFTER_DRAIN) { E(acc, cur, wr, wc, fr, fq); S.done(cur); }
        if (!has_next) break;
#pragma unroll
        for (int a = 0; a < 2; ++a)
#pragma unroll
            for (int b = 0; b < 2; ++b)
#pragma unroll
                for (int m = 0; m < 4; ++m)
#pragma unroll
                    for (int n = 0; n < 2; ++n) acc[a][b][m][n] = (f32x4){0.f, 0.f, 0.f, 0.f};
        cur = nxt; cA = nA; cB = nB; ++ui;
        if constexpr (ALIGN_EPI) { if (wr == 1) PG8_BAR; }
    }
    PG8_WAIT_V(0);
    if constexpr (!ALIGN_EPI) { if (wr == 0) PG8_BAR; }
    PG8_BAR;
    if constexpr (Epi::AFTER_DRAIN) { E.fused(acc, cur, wr, wc, fr, fq, lds, wid, lane); S.done(cur); }
#undef PG8_SA
#undef PG8_SB
#undef PG8_STAGE
#undef PG8_LDA
#undef PG8_LDB
#undef PG8_MMA
#undef PG8_WAIT_V
#undef PG8_WAIT_L
#undef PG8_BAR
#undef PG8_SCHED
}
}

namespace pg8 {
struct EpiF32P {
    static constexpr bool PERM = false, AFTER_DRAIN = false;
    float* O; int ldc;
    __device__ __forceinline__ void operator()(const f32x4 (&acc)[2][2][4][2], const Unit& u, int wr, int wc, int fr, int fq) const {
        const int row0 = u.pm * BM + wr * 64 + fr, col0 = u.pn * BM + wc * 32 + 4 * fq;
#pragma unroll
        for (int ai = 0; ai < 2; ++ai)
#pragma unroll
            for (int m = 0; m < 4; ++m) { float* rowp = O + (size_t)(row0 + ai * HALF + m * 16) * ldc + col0;
#pragma unroll
                for (int bj = 0; bj < 2; ++bj)
#pragma unroll
                    for (int n = 0; n < 2; ++n) *(f32x4*)(rowp + bj * HALF + n * 16) = acc[ai][bj][m][n]; }
    }
};
struct EpiSwigluP {
    static constexpr bool PERM = true, AFTER_DRAIN = false;
    bf16_t* O; int ldc;
    __device__ __forceinline__ void operator()(const f32x4 (&acc)[2][2][4][2], const Unit& u, int wr, int wc, int fr, int fq) const {
        const int row0 = u.pm * BM + wr * 64 + fr, col0 = u.pn * HALF + wc * 32 + 8 * fq;
#pragma unroll
        for (int ai = 0; ai < 2; ++ai)
#pragma unroll
            for (int m = 0; m < 4; ++m) {
                float h[8];
#pragma unroll
                for (int n = 0; n < 2; ++n)
#pragma unroll
                    for (int j = 0; j < 4; ++j) { const float g = acc[ai][0][m][n][j], up = acc[ai][1][m][n][j];
                        h[4 * n + j] = g * up * __builtin_amdgcn_rcpf(1.0f + __builtin_amdgcn_exp2f(-1.4426950408889634f * g)); }
                u32x4 w; w.x = cvt_pk_bf16(h[0], h[1]); w.y = cvt_pk_bf16(h[2], h[3]); w.z = cvt_pk_bf16(h[4], h[5]); w.w = cvt_pk_bf16(h[6], h[7]);
                *(u32x4*)(O + (size_t)(row0 + ai * HALF + m * 16) * ldc + col0) = w; }
    }
};
struct EpiGateP {
    static constexpr bool PERM = true, AFTER_DRAIN = false;
    bf16_t* O; int ldc; const float* gate;
    __device__ __forceinline__ void operator()(const f32x4 (&acc)[2][2][4][2], const Unit& u, int wr, int wc, int fr, int fq) const {
        const int row0 = u.pm * BM + wr * 64 + fr, col0 = u.pn * BM + wc * 32 + 8 * fq;
#pragma unroll
        for (int ai = 0; ai < 2; ++ai)
#pragma unroll
            for (int m = 0; m < 4; ++m) { const int row = row0 + ai * HALF + m * 16; const float gt = gate[row]; bf16_t* rowp = O + (size_t)row * ldc + col0;
#pragma unroll
                for (int bj = 0; bj < 2; ++bj) { const f32x4 v0 = acc[ai][bj][m][0] * gt, v1 = acc[ai][bj][m][1] * gt;
                    u32x4 w; w.x = cvt_pk_bf16(v0[0], v0[1]); w.y = cvt_pk_bf16(v0[2], v0[3]); w.z = cvt_pk_bf16(v1[0], v1[1]); w.w = cvt_pk_bf16(v1[2], v1[3]);
                    *(u32x4*)(rowp + bj * HALF) = w; } }
    }
};
struct GroupedOrder {
    int nMe, nN, ntot, G, c;
    __device__ void init(int nMe_, int nN_, int ne, int G_, int c_) { nMe = nMe_; nN = nN_; ntot = nMe_ * nN_ * ne; G = G_; c = c_; }
    __device__ bool next(int i, Unit& u) const {
        const int L = i * G + c; if (L >= ntot) return false;
        const int per = nMe * nN, e = L / per, rem = L - e * per;
        u.e = e; u.pn = rem / nMe; u.pm = e * nMe + (rem - u.pn * nMe); return true;
    }
    __device__ __forceinline__ void a_ready(const Unit&) const {}
    __device__ __forceinline__ void done(const Unit&) const {}
};
struct L1InOrder {
    StaticOrder so; int G, c;
    __device__ void init(int G_, int c_) { so.init(16384, 2048, G_, 0); G = G_; c = c_; }
    __device__ bool next(int i, Unit& u) const {
        const int L = i * G + c;
        if (L < 512) { StaticOrder t = so; t.G = 1; t.c = 0; return t.next(L, u); }
        if (L < 544) { const int l = L - 512; u.pm = 64 + (l >> 2); u.pn = 2 + (l & 3); u.e = 0; return true; }
        return false;
    }
    __device__ __forceinline__ void a_ready(const Unit&) const {}
    __device__ __forceinline__ void done(const Unit&) const {}
};
}

#include <hip/hip_bf16.h>
#include <cmath>
namespace attn_body {
using bf16=__hip_bfloat16;
using bf16x8=__attribute__((ext_vector_type(8)))short;
using s16x4=__attribute__((ext_vector_type(4)))short;
using f32x16=__attribute__((ext_vector_type(16)))float;
using u32x4=__attribute__((ext_vector_type(4)))unsigned;
constexpr int D=64,OPITCH=1024;
constexpr int NW=8,QBLK=32,QB=QBLK*NW,KVBLK=64;
__device__ __forceinline__ int crow(int r,int hi){return (r&3)+8*(r>>2)+4*hi;}
#define SBAR() __builtin_amdgcn_sched_barrier(0)
__device__ __forceinline__ void cmask(f32x16&p0,f32x16&p1,int jb,int qrel,int hi){
  const float NEG=-INFINITY; int kb=64*jb+4*hi;
  #pragma unroll
  for(int r=0;r<16;++r){int kv=kb+(r&3)+8*(r>>2); if(kv>qrel)p0[r]=NEG; if(kv+32>qrel)p1[r]=NEG;}
}

constexpr int NSLOT=3, SLOTB=8192;
constexpr int LDS_K=0, LDS_V=NSLOT*SLOTB, LDS_WS=2*NSLOT*SLOTB, LDS_OST=LDS_WS+NW*64*4, LDS_BYTES=LDS_OST+NW*4096;
constexpr float C2=0.125f*1.4426950408889634f;
__device__ __forceinline__ void glds16(const void*gsrc,unsigned lds_dst){unsigned keep;
  asm volatile("s_mov_b32 %0, m0\n\ts_mov_b32 m0, %2\n\ts_nop 0\n\tglobal_load_lds_dwordx4 %1, off\n\ts_mov_b32 m0, %0":"=&s"(keep):"v"(gsrc),"s"(lds_dst):"memory");}
__device__ __forceinline__ float max3f(float a,float b,float c){float r;asm("v_max3_f32 %0, %1, %2, %3":"=v"(r):"v"(a),"v"(b),"v"(c));return r;}
__device__ __forceinline__ float max2f(float a,float b){float r;asm("v_max_f32_e32 %0, %1, %2":"=v"(r):"v"(a),"v"(b));return r;}
__device__ __forceinline__ float fadd_s(float a,float b){float r;asm("v_add_f32_e32 %0, %1, %2":"=v"(r):"v"(a),"v"(b));return r;}
__device__ __forceinline__ float fsub_s(float a,float b){float r;asm("v_sub_f32_e32 %0, %1, %2":"=v"(r):"v"(a),"v"(b));return r;}
typedef float f32x2_t __attribute__((ext_vector_type(2))); typedef __bf16 bf16x2_t __attribute__((ext_vector_type(2)));
__device__ __forceinline__ unsigned cvtpk_s(float lo,float hi){f32x2_t v={lo,hi};bf16x2_t b=__builtin_convertvector(v,bf16x2_t);return __builtin_bit_cast(unsigned,b);}
#define WAIT_BAR(N) asm volatile("s_waitcnt vmcnt(" #N ") lgkmcnt(0)\n\ts_barrier":::"memory")

__device__ __forceinline__ void qkt(f32x16&p0,f32x16&p1,const char*Kslot,const bf16x8*qr,const f32x16&negm,int r32,int hi){
  const char*kb=Kslot+hi*1024+r32*16;
  #pragma unroll
  for(int d0=0;d0<4;++d0){
    const bf16x8 b0=*reinterpret_cast<const bf16x8*>(kb+d0*2048);
    const bf16x8 b1=*reinterpret_cast<const bf16x8*>(kb+d0*2048+512);
    if(d0==0){p0=__builtin_amdgcn_mfma_f32_32x32x16_bf16(b0,qr[0],negm,0,0,0);p1=__builtin_amdgcn_mfma_f32_32x32x16_bf16(b1,qr[0],negm,0,0,0);}
    else{p0=__builtin_amdgcn_mfma_f32_32x32x16_bf16(b0,qr[d0],p0,0,0,0);p1=__builtin_amdgcn_mfma_f32_32x32x16_bf16(b1,qr[d0],p1,0,0,0);}}
}
typedef __attribute__((address_space(3))) const char* lds_cptr;
typedef short v4i16_t __attribute__((ext_vector_type(4)));
__device__ __forceinline__ void kload8(bf16x8*kf,lds_cptr kp){
  kf[0]=*(const __attribute__((address_space(3))) bf16x8*)(kp);      kf[1]=*(const __attribute__((address_space(3))) bf16x8*)(kp+512);
  kf[2]=*(const __attribute__((address_space(3))) bf16x8*)(kp+2048); kf[3]=*(const __attribute__((address_space(3))) bf16x8*)(kp+2560);
  kf[4]=*(const __attribute__((address_space(3))) bf16x8*)(kp+4096); kf[5]=*(const __attribute__((address_space(3))) bf16x8*)(kp+4608);
  kf[6]=*(const __attribute__((address_space(3))) bf16x8*)(kp+6144); kf[7]=*(const __attribute__((address_space(3))) bf16x8*)(kp+6656);
}
__device__ __forceinline__ void kload2(bf16x8*kf,lds_cptr kp,int j){ kf[2*j]=*(const __attribute__((address_space(3))) bf16x8*)(kp+j*2048); kf[2*j+1]=*(const __attribute__((address_space(3))) bf16x8*)(kp+j*2048+512); }
__device__ __forceinline__ s16x4 vtr(lds_cptr p){ return __builtin_bit_cast(s16x4,__builtin_amdgcn_ds_read_tr16_b64_v4i16((__attribute__((address_space(3))) v4i16_t*)p)); }
__device__ __forceinline__ float rowmax(const f32x16&p0,const f32x16&p1){
  float a=max3f(p0[0],p0[1],p1[0]),b=max3f(p0[2],p0[3],p1[1]);a=max3f(a,p1[2],p1[3]);
  #pragma unroll
  for(int r=4;r<16;r+=4){a=max3f(a,p0[r],p0[r+1]);b=max3f(b,p0[r+2],p0[r+3]);a=max3f(a,p1[r],p1[r+1]);b=max3f(b,p1[r+2],p1[r+3]);}
  const float m=max2f(a,b);
  auto rr=__builtin_amdgcn_permlane32_swap(__float_as_uint(m),__float_as_uint(m),false,false);
  return max2f(__uint_as_float(rr[0]),__uint_as_float(rr[1]));
}
__device__ __forceinline__ void pv(f32x16*o,int vb,bf16x8 pa0,bf16x8 pa1,bf16x8 pa2,bf16x8 pa3){
  #pragma unroll
  for(int d0=0;d0<2;++d0){s16x4 lo[4],hi[4];
    #pragma unroll
    for(int ks=0;ks<4;++ks){
      asm volatile("ds_read_b64_tr_b16 %0,%1 offset:%c2":"=&v"(lo[ks]):"v"(vb),"i"(d0*4096+ks*1024):"memory");
      asm volatile("ds_read_b64_tr_b16 %0,%1 offset:%c2":"=&v"(hi[ks]):"v"(vb),"i"(d0*4096+ks*1024+512):"memory");}
    asm volatile("s_waitcnt lgkmcnt(0)":::"memory");SBAR();
    #define PK(k) (bf16x8){lo[k][0],lo[k][1],lo[k][2],lo[k][3],hi[k][0],hi[k][1],hi[k][2],hi[k][3]}
    o[d0]=__builtin_amdgcn_mfma_f32_32x32x16_bf16(pa0,PK(0),o[d0],0,0,0);
    o[d0]=__builtin_amdgcn_mfma_f32_32x32x16_bf16(pa1,PK(1),o[d0],0,0,0);
    o[d0]=__builtin_amdgcn_mfma_f32_32x32x16_bf16(pa2,PK(2),o[d0],0,0,0);
    o[d0]=__builtin_amdgcn_mfma_f32_32x32x16_bf16(pa3,PK(3),o[d0],0,0,0);
    #undef PK
  }
}

#ifndef ATTN_STORE16
#define ATTN_STORE16(p,v) (*(u32x4*)(p)=(v))
#endif
struct AU { const bf16* Qp; const bf16* Kp; const bf16* Vp; bf16* Op; int qrow0, lat_row0, ctx_row0, nlat_t, NT; };
struct NoMask { __device__ __forceinline__ void apply(f32x16&,f32x16&,int,int)const{} };
typedef __attribute__((address_space(3))) const float* lds_cfptr;
struct NAMask { lds_cfptr tb0; int r, rs, rs_min, cb;
  __device__ __forceinline__ void apply(f32x16&p0,f32x16&p1,int t,int hi)const{
    if(t<4)return;
    const int kr=rs_min+t-4; const float NEG=-INFINITY;
    if((unsigned)(kr-rs)>7u){
      #pragma unroll
      for(int i=0;i<16;++i){p0[i]=NEG;p1[i]=NEG;}
      return; }
    const lds_cfptr tb=tb0+(kr-r+7)*32+4*hi;
    #pragma unroll
    for(int i=0;i<16;++i){ const int k0=(i&3)+8*(i>>2); const int d0=cb+k0, d1=cb+k0+32;
      const float b0=tb[k0], b1=tb[k0+32];
      p0[i]=((unsigned)d0<=15u)?p0[i]+b0:NEG; p1[i]=((unsigned)d1<=15u)?p1[i]+b1:NEG; }
  }
};
template<int THRL,int PITCH,class MaskT> __device__ __forceinline__ void attn_unit(const AU& u,char*shm,const MaskT& mk){
  const int tid=threadIdx.x,lane=tid&63,r32=lane&31,hi=lane>>5; const int wid=__builtin_amdgcn_readfirstlane(tid>>6);
  const bf16*Qw=u.Qp+(long)(u.qrow0+wid*QBLK)*PITCH;
  const bf16*Kh=u.Kp,*Vh=u.Vp;
  const unsigned lds0=(unsigned)(uintptr_t)shm;
  float*wsf=(float*)(shm+LDS_WS)+wid*64;
  const bf16*ksrc=Kh+(long)lane*PITCH+wid*8;
  const bf16*vsrc=Vh+(long)(16*(wid&3)+(lane>>2))*PITCH+(wid>>2)*32+(lane&3)*8;
  const unsigned kdst=lds0+LDS_K+wid*1024, vdst=lds0+LDS_V+wid*1024;
  #define TROW(t) ((long)((t)<u.nlat_t?u.lat_row0+KVBLK*(t):u.ctx_row0+KVBLK*((t)-u.nlat_t))*PITCH)
  #define DMA_K(t,slot) glds16(ksrc+TROW(t),(unsigned)__builtin_amdgcn_readfirstlane(kdst+(slot)))
  #define DMA_V(t,slot) glds16(vsrc+TROW(t),(unsigned)__builtin_amdgcn_readfirstlane(vdst+(slot)))
  const int vb0=(int)(lds0+LDS_V)+((lane>>4)&1)*32+(lane&3)*8+(4*hi+((lane&15)>>2))*64;
  const char*Kbase=shm+LDS_K; bf16x8 kf[8];
  const lds_cptr shm3=(lds_cptr)shm; const lds_cptr kp0=shm3+LDS_K+hi*1024+r32*16; const lds_cptr vp0=shm3+LDS_V+((lane>>4)&1)*32+(lane&3)*8+(4*hi+((lane&15)>>2))*64;
  const int NT=u.NT;
  DMA_K(0,0);DMA_V(0,0);DMA_K(1,SLOTB);
  bf16x8 qr[4];
  #pragma unroll
  for(int d0=0;d0<4;++d0)qr[d0]=*reinterpret_cast<const bf16x8*>(&Qw[(long)r32*PITCH+d0*16+hi*8]);
  float mhat=0.f,l_reg=0.f;f32x16 o[2];o[0]=f32x16{};o[1]=f32x16{};f32x16 negm=f32x16{};asm volatile("":"+v"(negm));
  #define CMASK(P0,P1,t) mk.apply(P0,P1,(t),hi)
  bool resc=false;
  #define START(P0,P1) do{ const float rm=rowmax(P0,P1); resc=false; \
    { const float dl=rm; mhat=fadd_s(mhat,dl); \
      _Pragma("unroll") for(int r=0;r<16;++r){P0[r]=fsub_s(P0[r],dl);P1[r]=fsub_s(P1[r],dl);} \
      _Pragma("unroll") for(int r=0;r<16;++r)negm[r]=-mhat; asm volatile("":"+v"(negm)); } \
    _Pragma("unroll") for(int r=0;r<16;++r)P0[r]=__builtin_amdgcn_exp2f(P0[r]); }while(0)
  #define RESC() do{ if(resc){ asm volatile("s_waitcnt lgkmcnt(0)":::"memory"); \
      _Pragma("unroll") for(int d_=0;d_<2;++d_) _Pragma("unroll") for(int r=0;r<16;++r)o[d_][r]*=wsf[crow(r,hi)]; } }while(0)
  f32x16 pA0,pA1,pB0,pB1;
  int sl_prev=0,sl_cur=0,sl_next=SLOTB;
  #define ROT() do{sl_prev=sl_cur;sl_cur=sl_next;sl_next=(sl_next==(NSLOT-1)*SLOTB)?0:sl_next+SLOTB;}while(0)
  DMA_K(2,2*SLOTB);
  WAIT_BAR(3);
  qkt(pA0,pA1,Kbase,qr,negm,r32,hi);asm volatile("s_nop 15\n\ts_nop 7":"+v"(pA0),"+v"(pA1));CMASK(pA0,pA1,0);
  START(pA0,pA1);
  _Pragma("unroll") for(int r=0;r<16;++r)pA1[r]=__builtin_amdgcn_exp2f(pA1[r]);
  WAIT_BAR(0);
  DMA_K(3,0);DMA_V(1,SLOTB);
  ROT();
  kload8(kf,kp0+sl_cur);
  WAIT_BAR(2);
  s16x4 vlo[8],vhi[8]; u32x4 pw0,pw1,pw2,pw3;
  #define PKW(P,B) cvtpk_s(P[B],P[B+1])
  #define PAF(k) __builtin_bit_cast(bf16x8,pw##k)
  #define VFR(i) (bf16x8){vlo[i][0],vlo[i][1],vlo[i][2],vlo[i][3],vhi[i][0],vhi[i][1],vhi[i][2],vhi[i][3]}
  #define PIN(x) asm volatile("":"+v"(x))
  #define MX3(a,b,c) __builtin_fmaxf(__builtin_fmaxf((a),(b)),(c))
  #define GAPA(MF,A0,A1,A2,A3,W0,W1,PW) do{ MF; sacc+=A0; sacc+=A1; sacc+=A2; sacc+=A3; PIN(sacc); W0; W1; PIN(PW); SBAR(); }while(0)
  #define EX(v) __builtin_amdgcn_exp2f(v)
  #define GAPB(MF,X,B) do{ MF; X[B]=EX(X[B]); X[B+1]=EX(X[B+1]); X[B+2]=EX(X[B+2]); X[B+3]=EX(X[B+3]); PIN(X); SBAR(); }while(0)
  #define VRD(i) do{ vlo[i]=vtr(vp_+(((i)>>2)*4096+((i)&3)*1024)); vhi[i]=vtr(vp_+(((i)>>2)*4096+((i)&3)*1024+512)); }while(0)
  #define KRD(G,j) do{ if(G){ kload2(kf,kp0+sl_next,j); SBAR(); } }while(0)
  #define STEP(C0,C1,P0,P1,t,GK,GV,GL) do{ SBAR(); \
    const lds_cptr vp_=vp0+sl_prev; \
    VRD(0); SBAR(); float sacc=(P0[0]+P0[1]); \
    GAPA(C0=__builtin_amdgcn_mfma_f32_32x32x16_bf16(kf[0],qr[0],negm,0,0,0), P0[2],P0[3],P0[4],P0[5],     pw0[0]=PKW(P0,0), pw0[1]=PKW(P0,2), pw0); \
    VRD(4); SBAR(); GAPA(C1=__builtin_amdgcn_mfma_f32_32x32x16_bf16(kf[1],qr[0],negm,0,0,0), P0[6],P0[7],P0[8],P0[9],     pw0[2]=PKW(P0,4), pw0[3]=PKW(P0,6), pw0); \
    VRD(1); SBAR(); GAPA(C0=__builtin_amdgcn_mfma_f32_32x32x16_bf16(kf[2],qr[1],C0,0,0,0),   P0[10],P0[11],P0[12],P0[13], pw1[0]=PKW(P0,8), pw1[1]=PKW(P0,10), pw1); \
    VRD(5); SBAR(); GAPA(C1=__builtin_amdgcn_mfma_f32_32x32x16_bf16(kf[3],qr[1],C1,0,0,0),   P0[14],P0[15],P1[0],P1[1],   pw1[2]=PKW(P0,12),pw1[3]=PKW(P0,14), pw1); \
    VRD(2); SBAR(); GAPA(C0=__builtin_amdgcn_mfma_f32_32x32x16_bf16(kf[4],qr[2],C0,0,0,0),   P1[2],P1[3],P1[4],P1[5],     pw2[0]=PKW(P1,0), pw2[1]=PKW(P1,2), pw2); \
    VRD(6); SBAR(); GAPA(C1=__builtin_amdgcn_mfma_f32_32x32x16_bf16(kf[5],qr[2],C1,0,0,0),   P1[6],P1[7],P1[8],P1[9],     pw2[2]=PKW(P1,4), pw2[3]=PKW(P1,6), pw2); \
    VRD(3); SBAR(); GAPA(C0=__builtin_amdgcn_mfma_f32_32x32x16_bf16(kf[6],qr[3],C0,0,0,0),   P1[10],P1[11],P1[12],P1[13], pw3[0]=PKW(P1,8), pw3[1]=PKW(P1,10), pw3); \
    VRD(7); SBAR(); GAPA(C1=__builtin_amdgcn_mfma_f32_32x32x16_bf16(kf[7],qr[3],C1,0,0,0),   P1[14],P1[15],0.f,0.f,       pw3[2]=PKW(P1,12),pw3[3]=PKW(P1,14), pw3); \
    l_reg+=sacc; \
    if(GK){DMA_K((t)+3,sl_cur);} if(GV){DMA_V((t)+1,sl_next);} \
    CMASK(C0,C1,t); \
    { float a=MX3(C0[0],C0[1],C1[0]),b=MX3(C0[2],C0[3],C1[1]); a=MX3(a,C1[2],C1[3]); \
      _Pragma("unroll") for(int r=4;r<16;r+=4){a=MX3(a,C0[r],C0[r+1]);b=MX3(b,C0[r+2],C0[r+3]);a=MX3(a,C1[r],C1[r+1]);b=MX3(b,C1[r+2],C1[r+3]);} \
      float rm=__builtin_fmaxf(a,b); { auto rr=__builtin_amdgcn_permlane32_swap(__float_as_uint(rm),__float_as_uint(rm),false,false); rm=__builtin_fmaxf(__uint_as_float(rr[0]),__uint_as_float(rr[1])); } \
      resc=false; \
      if(__builtin_expect(__any(rm>(float)THRL),0)){ const float dl=__builtin_fmaxf(rm,0.f); mhat+=dl; \
        _Pragma("unroll") for(int r=0;r<16;++r){C0[r]-=dl;C1[r]-=dl;} \
        _Pragma("unroll") for(int r=0;r<16;++r)negm[r]=-mhat; asm volatile("":"+v"(negm)); \
        const float f=__builtin_amdgcn_exp2f(-dl); l_reg*=f; if(hi==0)wsf[r32]=f; resc=true; } } \
    SBAR(); \
    GAPB(o[0]=__builtin_amdgcn_mfma_f32_32x32x16_bf16(PAF(0),VFR(0),o[0],0,0,0), C0,0); \
    GAPB(o[1]=__builtin_amdgcn_mfma_f32_32x32x16_bf16(PAF(0),VFR(4),o[1],0,0,0), C0,4); \
    KRD(GL,0); GAPB(o[0]=__builtin_amdgcn_mfma_f32_32x32x16_bf16(PAF(1),VFR(1),o[0],0,0,0), C0,8); \
    KRD(GL,1); GAPB(o[1]=__builtin_amdgcn_mfma_f32_32x32x16_bf16(PAF(1),VFR(5),o[1],0,0,0), C0,12); \
    KRD(GL,2); GAPB(o[0]=__builtin_amdgcn_mfma_f32_32x32x16_bf16(PAF(2),VFR(2),o[0],0,0,0), C1,0); \
    KRD(GL,3); GAPB(o[1]=__builtin_amdgcn_mfma_f32_32x32x16_bf16(PAF(2),VFR(6),o[1],0,0,0), C1,4); \
    GAPB(o[0]=__builtin_amdgcn_mfma_f32_32x32x16_bf16(PAF(3),VFR(3),o[0],0,0,0), C1,8); \
    GAPB(o[1]=__builtin_amdgcn_mfma_f32_32x32x16_bf16(PAF(3),VFR(7),o[1],0,0,0), C1,12); \
    }while(0)
  int t=1;
  #undef CMASK
  #define CMASK(P0,P1,t) mk.apply(P0,P1,(t),hi)
  for(;t+5<NT;t+=2){
    STEP(pB0,pB1,pA0,pA1,t,true,true,true);     WAIT_BAR(2); RESC(); ROT();
    STEP(pA0,pA1,pB0,pB1,t+1,true,true,true);   WAIT_BAR(2); RESC(); ROT();
  }
  #undef CMASK
  #define CMASK(P0,P1,t) mk.apply(P0,P1,(t),hi)
  #define ENDW(tt) do{ if((tt)+3<NT){WAIT_BAR(2);} else if((tt)+2<NT){WAIT_BAR(1);} else {WAIT_BAR(0);} }while(0)
  for(;t+1<NT;t+=2){
    STEP(pB0,pB1,pA0,pA1,t,(t+3<NT),(t+1<NT),(t+1<NT));       ENDW(t);   RESC(); ROT();
    STEP(pA0,pA1,pB0,pB1,t+1,(t+4<NT),(t+2<NT),(t+2<NT));     ENDW(t+1); RESC(); ROT();
  }
  STEP(pB0,pB1,pA0,pA1,NT-1,false,false,false); RESC();
  { float sacc=pB0[0]+pB0[1]; _Pragma("unroll") for(int r=2;r<16;++r)sacc+=pB0[r]; _Pragma("unroll") for(int r=0;r<16;++r)sacc+=pB1[r]; l_reg+=sacc;
    pw0=(u32x4){PKW(pB0,0),PKW(pB0,2),PKW(pB0,4),PKW(pB0,6)};pw1=(u32x4){PKW(pB0,8),PKW(pB0,10),PKW(pB0,12),PKW(pB0,14)};pw2=(u32x4){PKW(pB1,0),PKW(pB1,2),PKW(pB1,4),PKW(pB1,6)};pw3=(u32x4){PKW(pB1,8),PKW(pB1,10),PKW(pB1,12),PKW(pB1,14)};
    SBAR(); pv(o,vb0+sl_cur,PAF(0),PAF(1),PAF(2),PAF(3)); }
  #undef PKW
  #undef PAF
  #undef VFR
  #undef PIN
  #undef MX3
  #undef GAPA
  #undef GAPB
  #undef EX
  #undef VRD
  #undef KRD
  #undef STEP
  #undef ENDW
  {auto rr=__builtin_amdgcn_permlane32_swap(__float_as_uint(l_reg),__float_as_uint(l_reg),false,false);l_reg=__uint_as_float(rr[0])+__uint_as_float(rr[1]);}
  if(hi==0)wsf[32+r32]=l_reg;asm volatile("s_waitcnt lgkmcnt(0)":::"memory");
  float rli[16];
  #pragma unroll
  for(int r=0;r<16;++r)rli[r]=__builtin_amdgcn_rcpf(wsf[32+crow(r,hi)]);
  bf16*Ow=u.Op+(long)(u.qrow0+wid*QBLK)*OPITCH;
  { bf16*stg=(bf16*)(shm+LDS_OST)+wid*2048;
    #pragma unroll
    for(int r=0;r<16;++r){const int orow=crow(r,hi);
      #pragma unroll
      for(int d0=0;d0<2;++d0)stg[orow*64+d0*32+r32]=__float2bfloat16(o[d0][r]*rli[r]);}
    asm volatile("s_waitcnt lgkmcnt(0)":::"memory");
    #pragma unroll
    for(int i=0;i<4;++i){const int row=i*8+(lane>>3),ch=lane&7; const u32x4 v=*(const u32x4*)(stg+row*64+ch*8); ATTN_STORE16(Ow+(long)row*OPITCH+ch*8,v);} }
  asm volatile("s_waitcnt lgkmcnt(0)\n\ts_barrier":::"memory");
  #undef DMA_K
  #undef TROW
  #undef DMA_V
  #undef CMASK
  #undef START
  #undef RESC
  #undef ROT
}
constexpr int ATTN_LDS_BYTES=LDS_BYTES;
#undef SBAR
#undef WAIT_BAR
}

struct Params { const float* in[26]; float* out; unsigned char* ws; int ph_lo, ph_hi; };
struct Ctx { LAS unsigned char* lds; int tid, lane, wave, vcu, G, gw, NGW; };
enum { I_X = 0, I_C, I_CTX, I_CCTX, I_ADAW, I_ADAB, I_LNG, I_LNB, I_W0IN, I_W0OUT, I_LQ1, I_LK1, I_LQ2, I_LK2, I_SUBLN, I_QN, I_KN,
       I_W1IN, I_W1OUT, I_RPB, I_POOLW, I_POOLS, I_ROUTER, I_WG, I_WU, I_WD };

__device__ __forceinline__ const float* mod_row(const Params& p, int layer, int row) {
    return (const float*)(p.ws + WS_MOD) + (size_t)(layer * 9 + (row < LAT ? (row >> 11) : 8)) * 6144;
}

__device__ __forceinline__ void ph_prologue(const Params& p, const Ctx& c) {
    const float* cin = p.in[I_C]; const float* cctx = p.in[I_CCTX]; const float* ada_w = p.in[I_ADAW]; const float* ada_b = p.in[I_ADAB];
    float* MOD = (float*)(p.ws + WS_MOD);
    LAS float* sc = (LAS float*)c.lds;
    LAS float* red = sc + 9 * 1024;
    for (int i = c.tid; i < 9 * 1024; i += 512) { const float v = i < 8192 ? cin[i] : cctx[i - 8192]; sc[i] = v / (1.f + expf(-v)); }
    __syncthreads();
    for (int u = c.vcu; u < 256; u += c.G) {
        const int layer = u >> 7, j0 = (u & 127) * 48;
        const int jc = c.tid % 48, kg = c.tid / 48;
        if (kg < 10) {
            float acc[9];
#pragma unroll
            for (int m = 0; m < 9; ++m) acc[m] = 0.f;
            const float* wp = ada_w + (size_t)layer * 1024 * 6144 + j0 + jc;
            for (int k = kg; k < 1024; k += 10) {
                const float w = wp[(size_t)k * 6144];
#pragma unroll
                for (int m = 0; m < 9; ++m) acc[m] += sc[m * 1024 + k] * w;
            }
#pragma unroll
            for (int m = 0; m < 9; ++m) red[(kg * 9 + m) * 48 + jc] = acc[m];
        }
        __syncthreads();
        if (c.tid < 432) {
            const int m = c.tid / 48, j = c.tid % 48; float s = 0.f;
#pragma unroll
            for (int g = 0; g < 10; ++g) s += red[(g * 9 + m) * 48 + j];
            MOD[(size_t)(layer * 9 + m) * 6144 + j0 + j] = s + ada_b[layer * 6144 + j0 + j];
        }
        __syncthreads();
    }
    if (c.vcu == 0) {
        f32x2* R = (f32x2*)(p.ws + WS_ROPE);
        for (int i = c.tid; i < 1024; i += 512) {
            const int pos = i >> 4, f = i & 15;
            const float inv = exp2f(-(float)f * (13.287712379549449f / 16.f));
            const float a = (float)pos * inv;
            const float k = rintf(a * 0.15915494309189535f);
            float rr = fmaf(-k, 6.28125f, a); rr = fmaf(-k, 1.9353071795864769e-3f, rr);
            R[i] = (f32x2){__cosf(rr), __sinf(rr)};
        }
    }
}


__device__ __forceinline__ void transpose_item(const float* W, int ldw, int k0, int n0, bf16* WT, int Kd, int drow0, LAS float* scr, int lane) {
#pragma unroll 8
    for (int i = 0; i < 32; ++i) { const int kk = 2 * i + (lane >> 5); scr[kk * 33 + (lane & 31)] = W[(size_t)(k0 + kk) * ldw + n0 + (lane & 31)]; }
    asm volatile("s_waitcnt lgkmcnt(0)" ::: "memory");
    const int ch = lane & 7;
#pragma unroll
    for (int j = 0; j < 4; ++j) { const int n = (lane >> 3) + 8 * j; const LAS float* sp = scr + (8 * ch) * 33 + n;
        v4u o; o.x = pk2(sp[0 * 33], sp[1 * 33]); o.y = pk2(sp[2 * 33], sp[3 * 33]); o.z = pk2(sp[4 * 33], sp[5 * 33]); o.w = pk2(sp[6 * 33], sp[7 * 33]);
        *(v4u*)(WT + (size_t)(drow0 + n) * Kd + k0 + 8 * ch) = o; }
    asm volatile("s_waitcnt lgkmcnt(0)" ::: "memory");
}
__device__ __forceinline__ void ph_transposes(const Params& p, const Ctx& c) {
    LAS float* scr = (LAS float*)(c.lds + c.wave * 16384);
    constexpr int I0 = 16 * 72, I1 = 16 * 32, I2 = 16 * 64, I3 = 16 * 32, ISM = I0 + I1 + I2 + I3, IEX = 3072, NIT = ISM + 32 * IEX;
    for (int it = c.gw; it < NIT; it += c.NGW) {
        int r = it;
        if (r < I0) { transpose_item(p.in[I_W0IN], EIN, 64 * (r / 72), 32 * (r % 72), (bf16*)(p.ws + WS_W0IN), DM, 32 * (r % 72), scr, c.lane); continue; } r -= I0;
        if (r < I1) { transpose_item(p.in[I_W0OUT], DM, 64 * (r / 32), 32 * (r % 32), (bf16*)(p.ws + WS_W0OUT), DM, 32 * (r % 32), scr, c.lane); continue; } r -= I1;
        if (r < I2) { transpose_item(p.in[I_W1IN], OIN, 64 * (r / 64), 32 * (r % 64), (bf16*)(p.ws + WS_W1IN), DM, 32 * (r % 64), scr, c.lane); continue; } r -= I2;
        if (r < I3) { transpose_item(p.in[I_W1OUT], DM, 64 * (r / 32), 32 * (r % 32), (bf16*)(p.ws + WS_W1OUT), DM, 32 * (r % 32), scr, c.lane); continue; } r -= I3;
        const int ie = r / IEX, q = r - ie * IEX, layer = ie >> 4, e = ie & 15, which = q >> 10, idx = q & 1023;
        if (which < 2) {
            const float* W = (which == 0 ? p.in[I_WG] : p.in[I_WU]) + (size_t)ie * DM * FF;
            const int k0 = 64 * (idx >> 6), n0 = 32 * (idx & 63);
            bf16* WT = (bf16*)(p.ws + WS_WGU + (size_t)layer * WS_MOE_LSTRIDE) + (size_t)e * 4096 * DM;
            transpose_item(W, FF, k0, n0, WT, DM, (n0 >> 7) * 256 + (n0 & 127) + which * 128, scr, c.lane);
        } else {
            const float* W = p.in[I_WD] + (size_t)ie * FF * DM;
            const int k0 = 64 * (idx >> 5), n0 = 32 * (idx & 31);
            bf16* WT = (bf16*)(p.ws + WS_WDN + (size_t)layer * WS_MOE_LSTRIDE) + (size_t)e * DM * FF;
            transpose_item(W, DM, k0, n0, WT, FF, n0, scr, c.lane);
        }
    }
}

__device__ __forceinline__ void ph_modulate0(const Params& p, const Ctx& c) {
    bf16* HB = (bf16*)(p.ws + WS_HB);
    for (int row = c.gw; row < NTOK; row += c.NGW) {
        const float* src = row < LAT ? p.in[I_X] + (size_t)row * DM : p.in[I_CTX] + (size_t)(row - LAT) * DM;
        const float* mod = mod_row(p, 0, row);
#pragma unroll
        for (int j = 0; j < 4; ++j) {
            const int col = 4 * c.lane + 256 * j;
            const f32x4 v = *(const f32x4*)(src + col), sh = *(const f32x4*)(mod + col), s = *(const f32x4*)(mod + 1024 + col);
            const f32x4 h = v * (s + 1.f) + sh;
            *(v2u*)(HB + (size_t)row * DM + col) = (v2u){pk2(h.x, h.y), pk2(h.z, h.w)};
        }
    }
}

struct NG { const bf16* A; int lda; const float* W0; const float* W1; int ldw; size_t wstride; int Mb; int row_begin, row_end, col_begin, col_end, K; };
template <int NB, class Epi>
__device__ __forceinline__ void ngemm(const NG& g, const Ctx& c, const Epi& epi) {
    const int nmt = (g.row_end - g.row_begin) / 32, nnt = (g.col_end - g.col_begin) / 32;
    const int l31 = c.lane & 31, lh = c.lane >> 5;
    for (int t = c.gw; t < nmt * nnt; t += c.NGW) {
        const int mt = t / nnt, nt = t % nnt;
        const int row0 = g.row_begin + mt * 32, col0 = g.col_begin + nt * 32;
        const int e = row0 / g.Mb;
        const bf16* ap = g.A + (size_t)(row0 + l31) * g.lda + lh;
        const float* bp0 = g.W0 + (size_t)e * g.wstride + (size_t)lh * g.ldw + col0 + l31;
        const float* bp1 = NB == 2 ? g.W1 + (size_t)e * g.wstride + (size_t)lh * g.ldw + col0 + l31 : nullptr;
        f32x16 acc0 = {}, acc1 = {};
#pragma unroll 8
        for (int k = 0; k < g.K; k += 2) {
            const float a = bf2f((unsigned)ap[k]);
            const float b0 = bp0[(size_t)k * g.ldw];
            acc0 = __builtin_amdgcn_mfma_f32_32x32x2f32(a, b0, acc0, 0, 0, 0);
            if (NB == 2) { const float b1 = bp1[(size_t)k * g.ldw]; acc1 = __builtin_amdgcn_mfma_f32_32x32x2f32(a, b1, acc1, 0, 0, 0); }
        }
#pragma unroll
        for (int r = 0; r < 16; ++r) {
            const int row = row0 + (r & 3) + 8 * (r >> 2) + 4 * lh, col = col0 + l31;
            epi(row, col, acc0[r], acc1[r]);
        }
    }
}
struct EpiF32 { float* O; int ldc; __device__ __forceinline__ void operator()(int row, int col, float v0, float) const { O[(size_t)row * ldc + col] = v0; } };
struct EpiBf { bf16* O; int ldc; int scale_cols; float sc; __device__ __forceinline__ void operator()(int row, int col, float v0, float) const { O[(size_t)row * ldc + col] = (bf16)f2bf(col < scale_cols ? v0 * sc : v0); } };
struct EpiSwiglu { bf16* O; __device__ __forceinline__ void operator()(int row, int col, float g, float u) const { const float s = g / (1.f + __expf(-g)); O[(size_t)row * FF + col] = (bf16)f2bf(s * u); } };
struct EpiGate { bf16* O; const float* gate; __device__ __forceinline__ void operator()(int row, int col, float v0, float) const { O[(size_t)row * DM + col] = (bf16)f2bf(v0 * gate[row]); } };

template <bool F32IN> __device__ __forceinline__ void ph_qkv_post(const Params& p, const Ctx& c) {
    const float* PF = (const float*)(p.ws + WS_PF);
    bf16* QKV = (bf16*)(p.ws + WS_QKV);
    const f32x2* R = (const f32x2*)(p.ws + WS_ROPE);
    const float* qn = p.in[I_QN]; const float* kn = p.in[I_KN];
    const int d = c.lane;
    const float qg = qn[d], kg = kn[d];
    for (int row = c.gw; row < NTOK; row += c.NGW) {
        const bool lat = row < LAT;
        const int t = row & 2047;
        const int pos = (d < 32) ? (t >> 6) : (t & 63);
        const f32x2 cs = R[pos * 16 + (d & 15)];
        const bool first = (d & 16) == 0;
        for (int hs = 0; hs < 36; ++hs) {
            float v = F32IN ? PF[(size_t)row * EIN + hs * 64 + d] : bf2f((unsigned)QKV[(size_t)row * EIN + hs * 64 + d]);
            const bool isq = hs < 8 || (hs >= 24 && hs < 32);
            const bool isk = (hs >= 8 && hs < 16) || hs == 32 || hs == 33;
            const bool nrm = hs >= 24 && hs < 34;
            if (nrm) { const float ss = wave_sum(v * v); v = v * rsqrtf(ss * (1.f / 64.f) + RMS_EPS) * (hs < 32 ? qg : kg); }
            if ((isq || isk) && lat) { const float pr = __shfl_xor(v, 16); v = first ? v * cs.x - pr * cs.y : v * cs.x + pr * cs.y; }
            if (isq) v *= C2;
            QKV[(size_t)row * EIN + hs * 64 + d] = (bf16)f2bf(v);
        }
    }
}

__device__ __forceinline__ void ph_attn0_naive(const Params& p, const Ctx& c) {
    const bf16* QKV = (const bf16*)(p.ws + WS_QKV);
    bf16* CC = (bf16*)(p.ws + WS_CC);
    bf16* AO = (bf16*)(p.ws + WS_AO);
    LAS float* Ks = (LAS float*)c.lds;
    LAS float* Vs = Ks + 4096;
    for (int u = c.vcu; u < 960; u += c.G) {
        const bool isctx = u >= 768;
        int b, vh, qrow, ntiles; bool active = true;
        if (!isctx) { b = u / 96; const int r = u % 96; vh = r >> 2; qrow = b * SEQ + (r & 3) * 512 + c.tid; ntiles = 36; }
        else { const int uu = u - 768; b = uu / 24; vh = uu % 24; qrow = LAT + b * NCTX + (c.tid & 255); active = c.tid < 256; ntiles = 4; }
        int qcol, kcol, vcol;
        if (vh < 16) { const int a = vh >> 2, s = (vh >> 1) & 1, half = vh & 1; qcol = a * 128 + s * 64; kcol = 512 + a * 128 + s * 64; vcol = 1024 + a * 128 + half * 64; }
        else { const int h = vh - 16; qcol = 1536 + h * 64; kcol = 2048 + (h >> 2) * 64; vcol = 2176 + (h >> 2) * 64; }
        float q[64], o[64];
#pragma unroll
        for (int i = 0; i < 8; ++i) { const v4u w = *(const v4u*)(QKV + (size_t)qrow * EIN + qcol + 8 * i); unpack8(w, q + 8 * i); }
#pragma unroll
        for (int i = 0; i < 64; ++i) o[i] = 0.f;
        float m = -1e30f, l = 0.f;
        for (int t = 0; t < ntiles; ++t) {
            const int krow0 = isctx ? LAT + b * NCTX + 64 * t : (t < 32 ? b * SEQ + 64 * t : LAT + b * NCTX + 64 * (t - 32));
            __syncthreads();
            { const int r = c.tid >> 3, ch = c.tid & 7; float f[8];
              const v4u kw = *(const v4u*)(QKV + (size_t)(krow0 + r) * EIN + kcol + ch * 8); unpack8(kw, f);
#pragma unroll
              for (int j = 0; j < 8; ++j) Ks[r * 64 + ch * 8 + j] = f[j];
              const v4u vw = *(const v4u*)(QKV + (size_t)(krow0 + r) * EIN + vcol + ch * 8); unpack8(vw, f);
#pragma unroll
              for (int j = 0; j < 8; ++j) Vs[r * 64 + ch * 8 + j] = f[j]; }
            __syncthreads();
            if (active) {
                for (int kk = 0; kk < 64; ++kk) {
                    float s = 0.f;
#pragma unroll
                    for (int dd = 0; dd < 64; ++dd) s += q[dd] * Ks[kk * 64 + dd];
                    const float mn = fmaxf(m, s), al = exp2f(m - mn), pp = exp2f(s - mn);
                    l = l * al + pp; m = mn;
#pragma unroll
                    for (int dd = 0; dd < 64; ++dd) o[dd] = o[dd] * al + pp * Vs[kk * 64 + dd];
                }
            }
        }
        if (active) {
            const float rl = 1.f / l;
            bf16* dst = vh < 16 ? AO + (size_t)qrow * DM + (vh >> 2) * 256 + ((vh >> 1) & 1) * 128 + (vh & 1) * 64 : CC + (size_t)qrow * DM + 512 + (vh - 16) * 64;
            {
#pragma unroll
                for (int i = 0; i < 8; ++i) *(v4u*)(dst + 8 * i) = (v4u){pk2(o[8 * i] * rl, o[8 * i + 1] * rl), pk2(o[8 * i + 2] * rl, o[8 * i + 3] * rl), pk2(o[8 * i + 4] * rl, o[8 * i + 5] * rl), pk2(o[8 * i + 6] * rl, o[8 * i + 7] * rl)}; }
        }
    }
}


__device__ __forceinline__ void ph_attn0_fast(const Params& p, const Ctx& c, char* lds_generic) {
    typedef attn_body::bf16 abf;
    const abf* Q = (const abf*)(p.ws + WS_QKV); abf* CCb = (abf*)(p.ws + WS_CC); abf* AOb = (abf*)(p.ws + WS_AO);
    for (int i = 0;; ++i) {
        const int U = i * c.G + c.vcu;
        if (U >= 1536 + 192) break;
        attn_body::AU u; int vh;
        if (U < 1536) { const int b = U / 192, rem = U - b * 192; vh = rem >> 3; u.qrow0 = b * SEQ + (rem & 7) * 256; u.lat_row0 = b * SEQ; u.ctx_row0 = LAT + b * NCTX; u.nlat_t = 32; u.NT = 36; }
        else { const int uu = U - 1536, b = uu / 24; vh = uu - b * 24; u.qrow0 = LAT + b * NCTX; u.lat_row0 = 0; u.ctx_row0 = LAT + b * NCTX; u.nlat_t = 0; u.NT = 4; }
        int qcol, kcol, vcol; abf* op;
        if (vh < 16) { const int a = vh >> 2, s = (vh >> 1) & 1, half = vh & 1; qcol = a * 128 + s * 64; kcol = 512 + a * 128 + s * 64; vcol = 1024 + a * 128 + half * 64; op = AOb + a * 256 + s * 128 + half * 64; }
        else { const int h = vh - 16; qcol = 1536 + h * 64; kcol = 2048 + (h >> 2) * 64; vcol = 2176 + (h >> 2) * 64; op = CCb + 512 + h * 64; }
        u.Qp = Q + qcol; u.Kp = Q + kcol; u.Vp = Q + vcol; u.Op = op;
        attn_body::attn_unit<8, EIN, attn_body::NoMask>(u, lds_generic, attn_body::NoMask{});
    }
}

__device__ __forceinline__ void ph_attn_combine(const Params& p, const Ctx& c) {
    const bf16* AO = (const bf16*)(p.ws + WS_AO);
    bf16* CC = (bf16*)(p.ws + WS_CC);
    const float d1 = wave_sum(p.in[I_LQ1][c.lane] * p.in[I_LK1][c.lane]);
    const float d2 = wave_sum(p.in[I_LQ2][c.lane] * p.in[I_LK2][c.lane]);
    const float lam = expf(d1) - expf(d2) + LAM_INIT;
    const float g0 = p.in[I_SUBLN][c.lane] * (1.f - LAM_INIT), g1 = p.in[I_SUBLN][c.lane + 64] * (1.f - LAM_INIT);
    for (int it = c.gw; it < NTOK * 4; it += c.NGW) {
        const int row = it >> 2, a = it & 3;
        const bf16* src = AO + (size_t)row * DM + a * 256;
        const float x0 = bf2f((unsigned)src[c.lane]) - lam * bf2f((unsigned)src[128 + c.lane]), x1 = bf2f((unsigned)src[64 + c.lane]) - lam * bf2f((unsigned)src[192 + c.lane]);
        const float ss = wave_sum(x0 * x0 + x1 * x1);
        const float r = rsqrtf(ss * (1.f / 128.f) + RMS_EPS);
        CC[(size_t)row * DM + a * 128 + c.lane] = (bf16)f2bf(x0 * r * g0);
        CC[(size_t)row * DM + a * 128 + 64 + c.lane] = (bf16)f2bf(x1 * r * g1);
    }
}

__device__ __forceinline__ void ph_ln1_router(const Params& p, const Ctx& c, int layer) {
    const float* Y = (const float*)(p.ws + WS_Y);
    float* XS = (float*)(p.ws + WS_XS);
    bf16* HB = (bf16*)(p.ws + WS_HB);
    float* AFF = (float*)(p.ws + WS_AFF);
    const float* lng = p.in[I_LNG] + (size_t)(layer * 2 + 0) * DM; const float* lnb = p.in[I_LNB] + (size_t)(layer * 2 + 0) * DM;
    const float* router = p.in[I_ROUTER] + (size_t)layer * DM * NE;
    const int nrows = layer == 0 ? NTOK : LAT;
    for (int row = c.gw; row < nrows; row += c.NGW) {
        const float* xin = layer == 0 ? (row < LAT ? p.in[I_X] + (size_t)row * DM : p.in[I_CTX] + (size_t)(row - LAT) * DM) : XS + (size_t)row * DM;
        const float* mod = mod_row(p, layer, row);
        f32x4 v[4]; float s = 0.f;
#pragma unroll
        for (int j = 0; j < 4; ++j) { const int col = 4 * c.lane + 256 * j;
            v[j] = *(const f32x4*)(xin + col) * ALPHA + *(const f32x4*)(mod + 2048 + col) * *(const f32x4*)(Y + (size_t)row * DM + col);
            s += (v[j].x + v[j].y) + (v[j].z + v[j].w); }
        const float mean = wave_sum(s) * (1.f / DM); float s2 = 0.f;
#pragma unroll
        for (int j = 0; j < 4; ++j) { v[j] = v[j] - mean; s2 += (v[j].x * v[j].x + v[j].y * v[j].y) + (v[j].z * v[j].z + v[j].w * v[j].w); }
        const float rstd = 1.f / sqrtf(wave_sum(s2) * (1.f / DM) + LN_EPS);
        float lg[16];
#pragma unroll
        for (int e = 0; e < 16; ++e) lg[e] = 0.f;
#pragma unroll
        for (int j = 0; j < 4; ++j) { const int col = 4 * c.lane + 256 * j;
            const f32x4 x1 = v[j] * rstd * *(const f32x4*)(lng + col) + *(const f32x4*)(lnb + col);
            *(f32x4*)(XS + (size_t)row * DM + col) = x1;
            const f32x4 hm = x1 * (*(const f32x4*)(mod + 4096 + col) + 1.f) + *(const f32x4*)(mod + 3072 + col);
            *(v2u*)(HB + (size_t)row * DM + col) = (v2u){pk2(hm.x, hm.y), pk2(hm.z, hm.w)};
#pragma unroll
            for (int q = 0; q < 4; ++q) { const float hv = hm[q]; const float* rp = router + (size_t)(col + q) * NE;
#pragma unroll
                for (int e4 = 0; e4 < 4; ++e4) { const f32x4 rw = *(const f32x4*)(rp + 4 * e4); lg[4 * e4] += hv * rw.x; lg[4 * e4 + 1] += hv * rw.y; lg[4 * e4 + 2] += hv * rw.z; lg[4 * e4 + 3] += hv * rw.w; } } }
        float mx = -1e30f;
#pragma unroll
        for (int e = 0; e < 16; ++e) { lg[e] = wave_sum(lg[e]); mx = fmaxf(mx, lg[e]); }
        float den = 0.f;
#pragma unroll
        for (int e = 0; e < 16; ++e) { lg[e] = expf(lg[e] - mx); den += lg[e]; }
        float mine = 0.f;
#pragma unroll
        for (int e = 0; e < 16; ++e) mine = (c.lane == e) ? lg[e] : mine;
        if (c.lane < 16) AFF[(size_t)row * NE + c.lane] = mine / den;
    }
}

__device__ __forceinline__ void ph_topk(const Params& p, const Ctx& c, int layer) {
    const float* AFF = (const float*)(p.ws + WS_AFF);
    int* INV = (int*)(p.ws + WS_INV);
    float* GATE = (float*)(p.ws + WS_GATE);
    const bf16* HB = (const bf16*)(p.ws + WS_HB);
    bf16* XG = (bf16*)(p.ws + WS_XG);
    LAS float* vals = (LAS float*)c.lds;
    LAS int* sel = (LAS int*)(c.lds + 8192);
    const int MR = layer == 0 ? MR0 : MR1;
    const int ntasks = layer == 0 ? 256 : 128;
    for (int task = c.vcu; task < ntasks; task += c.G) {
        int set, e, n, cap, rowbase, slotbase;
        if (task < 128) { set = task >> 4; e = task & 15; n = SEQ; cap = 256; rowbase = set * SEQ; slotbase = set * 256; }
        else { const int t2 = task - 128; set = t2 >> 4; e = t2 & 15; n = NCTX; cap = 32; rowbase = LAT + set * NCTX; slotbase = 2048 + set * 32; }
        for (int i = c.tid; i < n; i += 512) vals[i] = AFF[(size_t)(rowbase + i) * NE + e];
        __syncthreads();
        float mv[4]; int rk[4];
#pragma unroll
        for (int q = 0; q < 4; ++q) { const int i = c.tid + 512 * q; mv[q] = i < n ? vals[i] : 0.f; rk[q] = 0; }
        for (int j = 0; j < n; ++j) {
            const float vj = vals[j];
#pragma unroll
            for (int q = 0; q < 4; ++q) { const int i = c.tid + 512 * q; rk[q] += (vj > mv[q] || (vj == mv[q] && j < i)) ? 1 : 0; }
        }
#pragma unroll
        for (int q = 0; q < 4; ++q) { const int i = c.tid + 512 * q;
            if (i < n) { int slot = -1;
                if (rk[q] < cap) { slot = e * MR + slotbase + rk[q]; sel[rk[q]] = i; GATE[slot] = mv[q]; }
                INV[(size_t)(rowbase + i) * NE + e] = slot; } }
        __syncthreads();
        for (int s = c.wave; s < cap; s += 8) {
            const bf16* src = HB + (size_t)(rowbase + sel[s]) * DM; bf16* dst = XG + (size_t)(e * MR + slotbase + s) * DM;
            *(v4u*)(dst + 8 * c.lane) = *(const v4u*)(src + 8 * c.lane);
            *(v4u*)(dst + 512 + 8 * c.lane) = *(const v4u*)(src + 512 + 8 * c.lane);
        }
        __syncthreads();
    }
}

__device__ __forceinline__ void ph_combine(const Params& p, const Ctx& c, int layer) {
    const bf16* YS = (const bf16*)(p.ws + WS_YS);
    const int* INV = (const int*)(p.ws + WS_INV);
    float* XS = (float*)(p.ws + WS_XS);
    bf16* HB = (bf16*)(p.ws + WS_HB);
    const float* lng = p.in[I_LNG] + (size_t)(layer * 2 + 1) * DM; const float* lnb = p.in[I_LNB] + (size_t)(layer * 2 + 1) * DM;
    const int nrows = layer == 0 ? NTOK : LAT;
    for (int row = c.gw; row < nrows; row += c.NGW) {
        const float* mod = mod_row(p, layer, row);
        f32x4 mo[4];
#pragma unroll
        for (int j = 0; j < 4; ++j) mo[j] = (f32x4){0.f, 0.f, 0.f, 0.f};
        for (int e = 0; e < NE; ++e) {
            const int s = INV[(size_t)row * NE + e];
            if (s >= 0) {
#pragma unroll
                for (int j = 0; j < 4; ++j) { const v2u w = *(const v2u*)(YS + (size_t)s * DM + 4 * c.lane + 256 * j);
                    mo[j].x += bf2f(w.x & 0xffffu); mo[j].y += __uint_as_float(w.x & 0xffff0000u); mo[j].z += bf2f(w.y & 0xffffu); mo[j].w += __uint_as_float(w.y & 0xffff0000u); }
            }
        }
        f32x4 v[4]; float s = 0.f;
#pragma unroll
        for (int j = 0; j < 4; ++j) { const int col = 4 * c.lane + 256 * j;
            v[j] = *(const f32x4*)(XS + (size_t)row * DM + col) * ALPHA + *(const f32x4*)(mod + 5120 + col) * mo[j];
            s += (v[j].x + v[j].y) + (v[j].z + v[j].w); }
        const float mean = wave_sum(s) * (1.f / DM); float s2 = 0.f;
#pragma unroll
        for (int j = 0; j < 4; ++j) { v[j] = v[j] - mean; s2 += (v[j].x * v[j].x + v[j].y * v[j].y) + (v[j].z * v[j].z + v[j].w * v[j].w); }
        const float rstd = 1.f / sqrtf(wave_sum(s2) * (1.f / DM) + LN_EPS);
        const float* modn = mod_row(p, 1, row);
#pragma unroll
        for (int j = 0; j < 4; ++j) { const int col = 4 * c.lane + 256 * j;
            const f32x4 x2 = v[j] * rstd * *(const f32x4*)(lng + col) + *(const f32x4*)(lnb + col);
            if (layer == 0) {
                *(f32x4*)(XS + (size_t)row * DM + col) = x2;
                const f32x4 h = x2 * (*(const f32x4*)(modn + 1024 + col) + 1.f) + *(const f32x4*)(modn + col);
                *(v2u*)(HB + (size_t)row * DM + col) = (v2u){pk2(h.x, h.y), pk2(h.z, h.w)};
            } else {
                *(f32x4*)(p.out + (size_t)row * DM + col) = x2;
            } }
    }
}

__device__ __forceinline__ void na_key(const float* q, float* o, float& m, float& l, const bf16* kp, const bf16* vp, float bias) {
    float s = bias;
#pragma unroll
    for (int i = 0; i < 8; ++i) { float f[8]; unpack8(*(const v4u*)(kp + 8 * i), f);
#pragma unroll
        for (int j = 0; j < 8; ++j) s += q[8 * i + j] * f[j]; }
    const float mn = fmaxf(m, s), al = exp2f(m - mn), pp = exp2f(s - mn);
    l = l * al + pp; m = mn;
#pragma unroll
    for (int i = 0; i < 8; ++i) { float f[8]; unpack8(*(const v4u*)(vp + 8 * i), f);
#pragma unroll
        for (int j = 0; j < 8; ++j) o[8 * i + j] = o[8 * i + j] * al + pp * f[j]; }
}
__device__ __forceinline__ void ph_mixer1_naive(const Params& p, const Ctx& c) {
    const bf16* P2 = (const bf16*)(p.ws + WS_QKV);
    bf16* CC = (bf16*)(p.ws + WS_CC);
    const float* rpb = p.in[I_RPB]; const float* pool_w = p.in[I_POOLW]; const float* pool_s = p.in[I_POOLS];
    LAS float* pl = (LAS float*)c.lds;
    for (int u = c.vcu; u < 256; u += c.G) {
        const int b = u >> 5, r = u & 31;
        {
            const int h = c.wave, col = c.lane, row = b * SEQ + r * 64 + col;
            const int rs = min(max(r - 4, 0), 24), cs = min(max(col - 8, 0), 48);
            float q[64], o[64];
#pragma unroll
            for (int i = 0; i < 8; ++i) unpack8(*(const v4u*)(P2 + (size_t)row * OIN + h * 64 + 8 * i), q + 8 * i);
#pragma unroll
            for (int i = 0; i < 64; ++i) o[i] = 0.f;
            float m = -1e30f, l = 0.f;
#pragma unroll 1
            for (int i = 0; i < 8; ++i)
#pragma unroll 1
                for (int j = 0; j < 16; ++j) {
                    const int krow = b * SEQ + (rs + i) * 64 + cs + j;
                    const float bias = rpb[(h * 15 + (rs + i - r + 7)) * 31 + (cs + j - col + 15)] * LOG2E;
                    na_key(q, o, m, l, P2 + (size_t)krow * OIN + 512 + h * 64, P2 + (size_t)krow * OIN + 1024 + h * 64, bias);
                }
#pragma unroll 1
            for (int j = 0; j < NCTX; ++j) {
                const int krow = LAT + b * NCTX + j;
                na_key(q, o, m, l, P2 + (size_t)krow * OIN + 512 + h * 64, P2 + (size_t)krow * OIN + 1024 + h * 64, 0.f);
            }
            const float rl = 1.f / l; bf16* dst = CC + (size_t)row * DM + h * 64;
#pragma unroll
            for (int i = 0; i < 8; ++i) *(v4u*)(dst + 8 * i) = (v4u){pk2(o[8 * i] * rl, o[8 * i + 1] * rl), pk2(o[8 * i + 2] * rl, o[8 * i + 3] * rl), pk2(o[8 * i + 4] * rl, o[8 * i + 5] * rl), pk2(o[8 * i + 6] * rl, o[8 * i + 7] * rl)};
        }
        __syncthreads();
        {
            const int ch = c.tid, g = ch >> 7, half = 1 << g;
            for (int tt = 0; tt < 64; ++tt) {
                const int t = r * 64 + tt, lo = max(t - half, 0), hi = min(t + half, SEQ);
                float s = 0.f;
                for (int t2 = lo; t2 < hi; ++t2) s += bf2f((unsigned)P2[(size_t)(b * SEQ + t2) * OIN + 1536 + ch]);
                pl[tt * 512 + ch] = s / (float)(hi - lo) - bf2f((unsigned)P2[(size_t)(b * SEQ + t) * OIN + 1536 + ch]);
            }
        }
        __syncthreads();
        {
            const int g = c.tid >> 7, e = c.tid & 127;
            const float ps = pool_s[g * 128 + e];
#pragma unroll 1
            for (int tb = 0; tb < 64; tb += 16) {
                float acc[16];
#pragma unroll
                for (int i = 0; i < 16; ++i) acc[i] = 0.f;
#pragma unroll 4
                for (int cc = 0; cc < 128; ++cc) {
                    const float w = pool_w[(size_t)(g * 128 + cc) * 128 + e];
#pragma unroll
                    for (int i = 0; i < 16; ++i) acc[i] += pl[(tb + i) * 512 + g * 128 + cc] * w;
                }
#pragma unroll
                for (int i = 0; i < 16; ++i) CC[(size_t)(b * SEQ + r * 64 + tb + i) * DM + 512 + g * 128 + e] = (bf16)f2bf(acc[i] * ps);
            }
        }
        __syncthreads();
    }
}


constexpr int NA_TAB_OFF = 86016 + 1024;
__device__ __forceinline__ void ph_mixer1_fast(const Params& p, const Ctx& c, char* lds_generic) {
    typedef attn_body::bf16 abf;
    const abf* P2a = (const abf*)(p.ws + WS_QKV); abf* CCa = (abf*)(p.ws + WS_CC);
    LAS float* tab = (LAS float*)(c.lds + NA_TAB_OFF);
    for (int i = c.tid; i < 8 * 15 * 32; i += 512) { const int hd = i >> 5, j = i & 31; tab[i] = j < 31 ? p.in[I_RPB][hd * 31 + j] * LOG2E : 0.f; }
    __syncthreads();
    for (int it = 0;; ++it) {
        const int U = it * c.G + c.vcu;
        if (U >= 512) break;
        const int b = U >> 6, h = (U >> 3) & 7, rq = U & 7;
        const int rs_min = min(max(4 * rq - 4, 0), 24);
        const int nloc = (rq == 0 || rq == 7) ? 8 : 12;
        attn_body::AU u;
        u.qrow0 = b * SEQ + rq * 256; u.lat_row0 = LAT + b * NCTX; u.nlat_t = 4; u.ctx_row0 = b * SEQ + rs_min * 64; u.NT = 4 + nloc;
        u.Qp = P2a + h * 64; u.Kp = P2a + 512 + h * 64; u.Vp = P2a + 1024 + h * 64; u.Op = CCa + h * 64;
        const int r = 4 * rq + (c.wave >> 1), col = (c.wave & 1) * 32 + (c.lane & 31), hi = c.lane >> 5;
        const int cs = min(max(col - 8, 0), 48);
        attn_body::NAMask mk; mk.tb0 = (attn_body::lds_cfptr)(tab + h * 15 * 32 + 15 - col); mk.r = r; mk.rs = min(max(r - 4, 0), 24); mk.rs_min = rs_min; mk.cb = 4 * hi - cs;
        attn_body::attn_unit<8, OIN, attn_body::NAMask>(u, lds_generic, mk);
    }
    __syncthreads();
    const bf16* P2 = (const bf16*)(p.ws + WS_QKV); bf16* CC = (bf16*)(p.ws + WS_CC);
    const float* pool_w = p.in[I_POOLW]; const float* pool_s = p.in[I_POOLS];
    LAS float* pl = (LAS float*)c.lds;
    for (int u = c.vcu; u < 256; u += c.G) {
        const int b = u >> 5, r = u & 31;
        {
            const int ch = c.tid, g = ch >> 7, half = 1 << g;
            const bf16* du = P2 + (size_t)b * SEQ * OIN + 1536 + ch;
            const int t0 = r * 64;
            float ws = 0.f;
            for (int t2 = max(t0 - half, 0); t2 < min(t0 + half, SEQ); ++t2) ws += bf2f((unsigned)du[(size_t)t2 * OIN]);
            for (int tt = 0; tt < 64; ++tt) {
                const int t = t0 + tt, lo = max(t - half, 0), hi = min(t + half, SEQ);
                pl[tt * 512 + ch] = ws / (float)(hi - lo) - bf2f((unsigned)du[(size_t)t * OIN]);
                if (t + half < SEQ) ws += bf2f((unsigned)du[(size_t)(t + half) * OIN]);
                if (t - half >= 0) ws -= bf2f((unsigned)du[(size_t)(t - half) * OIN]);
            }
        }
        __syncthreads();
        {
            const int g = c.tid >> 7, e = c.tid & 127;
            const float ps = pool_s[g * 128 + e];
#pragma unroll 1
            for (int tb = 0; tb < 64; tb += 16) {
                float acc[16];
#pragma unroll
                for (int i = 0; i < 16; ++i) acc[i] = 0.f;
#pragma unroll 2
                for (int cc = 0; cc < 128; cc += 4) {
                    const float w0 = pool_w[(size_t)(g * 128 + cc) * 128 + e], w1 = pool_w[(size_t)(g * 128 + cc + 1) * 128 + e], w2 = pool_w[(size_t)(g * 128 + cc + 2) * 128 + e], w3 = pool_w[(size_t)(g * 128 + cc + 3) * 128 + e];
#pragma unroll
                    for (int i = 0; i < 16; ++i) { const f32x4 pv = *(const LAS f32x4*)(pl + (tb + i) * 512 + g * 128 + cc); acc[i] += pv.x * w0 + pv.y * w1 + pv.z * w2 + pv.w * w3; }
                }
#pragma unroll
                for (int i = 0; i < 16; ++i) CC[(size_t)(b * SEQ + r * 64 + tb + i) * DM + 512 + g * 128 + e] = (bf16)f2bf(acc[i] * ps);
            }
        }
        __syncthreads();
    }
}

__global__ void __launch_bounds__(512, 2) mk_fwd(Params p) {
    extern __shared__ __attribute__((aligned(16))) unsigned char lds_raw[];
    Ctx c;
    c.lds = (LAS unsigned char*)lds_raw;
    c.tid = threadIdx.x; c.lane = c.tid & 63; c.wave = __builtin_amdgcn_readfirstlane(c.tid >> 6);
    c.G = gridDim.x; { const int bx = blockIdx.x; c.vcu = (c.G % 8 == 0) ? (bx % 8) * (c.G / 8) + bx / 8 : bx; }
    c.gw = c.vcu * 8 + c.wave; c.NGW = c.G * 8;
    volatile LAS unsigned* MISC = (volatile LAS unsigned*)(c.lds + MISC_OFF);
    if (c.tid < 32) MISC[c.tid] = 0u;
    __syncthreads();
    gu32* ctl = (gu32*)(p.ws + WS_CTL);
    XcdBarrier bar; bar.bar = (unsigned*)(ctl + CW_BAR); bar.x = 0; bar.st = nullptr;
    if (!MK_MULTI) bar = xcd_barrier_post((unsigned*)(ctl + CW_BAR), MISC + 8);
    const int lo = p.ph_lo, hi = p.ph_hi;
#define IN(k) (lo <= (k) && (k) < hi)
#define SEAM(k) do { if (IN(k) && IN((k) + 1)) xcd_barrier(bar); } while (0)

    bf16* HB = (bf16*)(p.ws + WS_HB); bf16* QKV = (bf16*)(p.ws + WS_QKV); bf16* CC = (bf16*)(p.ws + WS_CC);
    float* Y = (float*)(p.ws + WS_Y); float* PF = (float*)(p.ws + WS_PF);
    bf16* XG = (bf16*)(p.ws + WS_XG); bf16* HID = (bf16*)(p.ws + WS_HID); bf16* YS = (bf16*)(p.ws + WS_YS);
    const float* GATE = (const float*)(p.ws + WS_GATE);

    if (IN(0)) { ph_prologue(p, c); if (FAST_GEMM) { __syncthreads(); ph_transposes(p, c); } } SEAM(0);
    if (IN(1)) { ph_modulate0(p, c); } SEAM(1);
    if (IN(2)) {
        if (FAST_GEMM) { pg8::Gemm g{HB, (const bf16*)(p.ws + WS_W0IN), NTOK, EIN, DM, 0}; pg8::StaticOrder S; S.init(NTOK, EIN, c.G, (int)blockIdx.x);
            pg8::EpiBf16<0> E{QKV, EIN, nullptr, 0, 0, 1.f}; pg8::gemm_phase<pg8::EpiBf16<0>, pg8::StaticOrder, true, true>(c.lds, g, S, E); }
        else { NG g{HB, DM, p.in[I_W0IN], nullptr, EIN, 0, 1 << 30, 0, NTOK, 0, EIN, DM}; ngemm<1>(g, c, EpiF32{PF, EIN}); }
    } SEAM(2);
    if (IN(3)) { if (FAST_GEMM) ph_qkv_post<false>(p, c); else ph_qkv_post<true>(p, c); } SEAM(3);
    if (IN(4)) { if (FAST_ATTN) ph_attn0_fast(p, c, (char*)lds_raw); else ph_attn0_naive(p, c); } SEAM(4);
    if (IN(5)) { ph_attn_combine(p, c); } SEAM(5);
    if (IN(6)) {
        if (FAST_GEMM) { pg8::Gemm g{CC, (const bf16*)(p.ws + WS_W0OUT), NTOK, DM, DM, 0}; pg8::StaticOrder S; S.init(NTOK, DM, c.G, (int)blockIdx.x);
            pg8::EpiF32P E{Y, DM}; pg8::gemm_phase<pg8::EpiF32P, pg8::StaticOrder, true, true>(c.lds, g, S, E); }
        else { NG g{CC, DM, p.in[I_W0OUT], nullptr, DM, 0, 1 << 30, 0, NTOK, 0, DM, DM}; ngemm<1>(g, c, EpiF32{Y, DM}); }
    } SEAM(6);
    if (IN(7)) { ph_ln1_router(p, c, 0); } SEAM(7);
    if (IN(8)) { ph_topk(p, c, 0); } SEAM(8);
    if (IN(9)) {
        if (FAST_GEMM) { pg8::Gemm g{XG, (const bf16*)(p.ws + WS_WGU), NE * MR0, 4096, DM, (size_t)4096 * DM * 2}; pg8::GroupedOrder S; S.init(MR0 / 256, 16, NE, c.G, c.vcu);
            pg8::EpiSwigluP E{HID, FF}; pg8::gemm_phase<pg8::EpiSwigluP, pg8::GroupedOrder, true, true>(c.lds, g, S, E); }
        else { NG g{XG, DM, p.in[I_WG], p.in[I_WU], FF, (size_t)DM * FF, MR0, 0, NE * MR0, 0, FF, DM}; ngemm<2>(g, c, EpiSwiglu{HID}); }
    } SEAM(9);
    if (IN(10)) {
        if (FAST_GEMM) { pg8::Gemm g{HID, (const bf16*)(p.ws + WS_WDN), NE * MR0, DM, FF, (size_t)DM * FF * 2}; pg8::GroupedOrder S; S.init(MR0 / 256, 4, NE, c.G, c.vcu);
            pg8::EpiGateP E{YS, DM, GATE}; pg8::gemm_phase<pg8::EpiGateP, pg8::GroupedOrder, true, true>(c.lds, g, S, E); }
        else { NG g{HID, FF, p.in[I_WD], nullptr, DM, (size_t)FF * DM, MR0, 0, NE * MR0, 0, DM, FF}; ngemm<1>(g, c, EpiGate{YS, GATE}); }
    } SEAM(10);
    if (IN(11)) { ph_combine(p, c, 0); } SEAM(11);
    if (IN(12)) {
        if (FAST_GEMM) { pg8::Gemm g{HB, (const bf16*)(p.ws + WS_W1IN), NTOK, OIN, DM, 0}; pg8::L1InOrder S; S.init(c.G, (int)blockIdx.x);
            pg8::EpiBf16<0> E{QKV, OIN, nullptr, 512, 512, C2}; pg8::gemm_phase<pg8::EpiBf16<0>, pg8::L1InOrder, true, true>(c.lds, g, S, E); }
        else {
        NG g{HB, DM, p.in[I_W1IN], nullptr, OIN, 0, 1 << 30, 0, LAT, 0, OIN, DM}; ngemm<1>(g, c, EpiBf{QKV, OIN, 512, C2});
        NG g2{HB, DM, p.in[I_W1IN], nullptr, OIN, 0, 1 << 30, LAT, NTOK, 512, 1536, DM}; ngemm<1>(g2, c, EpiBf{QKV, OIN, 0, 1.f}); }
    } SEAM(12);
    if (IN(13)) { if (FAST_NA) ph_mixer1_fast(p, c, (char*)lds_raw); else ph_mixer1_naive(p, c); } SEAM(13);
    if (IN(14)) {
        if (FAST_GEMM) { pg8::Gemm g{CC, (const bf16*)(p.ws + WS_W1OUT), LAT, DM, DM, 0}; pg8::StaticOrder S; S.init(LAT, DM, c.G, (int)blockIdx.x);
            pg8::EpiF32P E{Y, DM}; pg8::gemm_phase<pg8::EpiF32P, pg8::StaticOrder, true, true>(c.lds, g, S, E); }
        else { NG g{CC, DM, p.in[I_W1OUT], nullptr, DM, 0, 1 << 30, 0, LAT, 0, DM, DM}; ngemm<1>(g, c, EpiF32{Y, DM}); }
    } SEAM(14);
    if (IN(15)) { ph_ln1_router(p, c, 1); } SEAM(15);
    if (IN(16)) { ph_topk(p, c, 1); } SEAM(16);
    if (IN(17)) {
        if (FAST_GEMM) { pg8::Gemm g{XG, (const bf16*)(p.ws + WS_WGU + WS_MOE_LSTRIDE), NE * MR1, 4096, DM, (size_t)4096 * DM * 2}; pg8::GroupedOrder S; S.init(MR1 / 256, 16, NE, c.G, c.vcu);
            pg8::EpiSwigluP E{HID, FF}; pg8::gemm_phase<pg8::EpiSwigluP, pg8::GroupedOrder, true, true>(c.lds, g, S, E); }
        else { NG g{XG, DM, p.in[I_WG] + (size_t)NE * DM * FF, p.in[I_WU] + (size_t)NE * DM * FF, FF, (size_t)DM * FF, MR1, 0, NE * MR1, 0, FF, DM}; ngemm<2>(g, c, EpiSwiglu{HID}); }
    } SEAM(17);
    if (IN(18)) {
        if (FAST_GEMM) { pg8::Gemm g{HID, (const bf16*)(p.ws + WS_WDN + WS_MOE_LSTRIDE), NE * MR1, DM, FF, (size_t)DM * FF * 2}; pg8::GroupedOrder S; S.init(MR1 / 256, 4, NE, c.G, c.vcu);
            pg8::EpiGateP E{YS, DM, GATE}; pg8::gemm_phase<pg8::EpiGateP, pg8::GroupedOrder, true, true>(c.lds, g, S, E); }
        else { NG g{HID, FF, p.in[I_WD] + (size_t)NE * FF * DM, nullptr, DM, (size_t)FF * DM, MR1, 0, NE * MR1, 0, DM, FF}; ngemm<1>(g, c, EpiGate{YS, GATE}); }
    } SEAM(18);
    if (IN(19)) { ph_combine(p, c, 1); }
#undef IN
#undef SEAM
}

extern "C" void kernel_launch(void* const* d_in, const int* in_sizes, int n_in, void* d_out, int out_size, void* d_ws, size_t ws_size, hipStream_t stream) {
    static int grid = 0;
    if (grid == 0) {
        if (n_in != 26 || out_size != LAT * DM || ws_size < WS_END) { fprintf(stderr, "kernel_launch: unexpected shapes (n_in %d out %d ws %zu)\n", n_in, out_size, ws_size); grid = -1; return; }
        int dev = 0, cus = 0;
        if (hipGetDevice(&dev) != hipSuccess || hipDeviceGetAttribute(&cus, hipDeviceAttributeMultiprocessorCount, dev) != hipSuccess) { grid = -1; return; }
        if (hipFuncSetAttribute((const void*)mk_fwd, hipFuncAttributeMaxDynamicSharedMemorySize, LDS_BYTES) != hipSuccess) { fprintf(stderr, "kernel_launch: hipFuncSetAttribute failed\n"); grid = -1; return; }
        int per_cu = 0;
        if (hipOccupancyMaxActiveBlocksPerMultiprocessor(&per_cu, (const void*)mk_fwd, 512, LDS_BYTES) != hipSuccess || per_cu < 1) fprintf(stderr, "kernel_launch: occupancy query says %d\n", per_cu);
        (void)hipGetLastError();
        grid = cus;
    }
    if (grid < 0) return;
    (void)hipMemsetAsync((char*)d_ws + WS_CTL, 0, CTL_ZERO_BYTES, stream);
    Params a{};
    for (int i = 0; i < 26; ++i) a.in[i] = (const float*)d_in[i];
    a.out = (float*)d_out; a.ws = (unsigned char*)d_ws;
#if MK_MULTI
    for (int ph = 0; ph < NPHASE; ++ph) { a.ph_lo = ph; a.ph_hi = ph + 1; hipLaunchKernelGGL(mk_fwd, dim3(grid), dim3(512), LDS_BYTES, stream, a); }
#else
    a.ph_lo = 0; a.ph_hi = NPHASE;
    hipLaunchKernelGGL(mk_fwd, dim3(grid), dim3(512), LDS_BYTES, stream, a);
#endif
}
```

```cpp
#include <hip/hip_runtime.h>
#include <cstdio>
#include <cstdint>

#define GAS __attribute__((address_space(1)))
#define LAS __attribute__((address_space(3)))
typedef unsigned short bf16;
typedef unsigned v4u __attribute__((ext_vector_type(4)));
typedef unsigned v2u __attribute__((ext_vector_type(2)));
typedef float f32x4 __attribute__((ext_vector_type(4)));
typedef float f32x2 __attribute__((ext_vector_type(2)));
typedef float f32x16 __attribute__((ext_vector_type(16)));
typedef GAS unsigned gu32;

#ifndef PROBE_MASK
#define PROBE_MASK 0u
#endif
#ifndef FAST_NA
#define FAST_NA 1
#endif
#ifndef FAST_ATTN
#define FAST_ATTN 1
#endif
#ifndef FAST_GEMM
#define FAST_GEMM 1
#endif
#ifndef MK_MULTI
#define MK_MULTI 0
#endif

constexpr int NBATCH = 8, SEQ = 2048, DM = 1024, NCTX = 256;
constexpr int LAT = NBATCH * SEQ;
constexpr int NTOK = LAT + NBATCH * NCTX;
constexpr int EIN = 2304, OIN = 2048, NE = 16, FF = 2048;
constexpr int MR0 = 2304, MR1 = 2048;
constexpr float LOG2E = 1.4426950408889634f;
constexpr float C2 = 0.125f * LOG2E;
constexpr float ALPHA = 1.4142135623730951f;
constexpr float LN_EPS = 1e-5f, RMS_EPS = 1e-6f;
constexpr float LAM_INIT = 0.2f;
constexpr int NPHASE = 20;

constexpr size_t MiB = 1u << 20;
constexpr size_t WS_CTL = 0, CTL_ZERO_BYTES = 1 * MiB;
constexpr size_t WS_MOD = 1 * MiB;
constexpr size_t WS_ROPE = 1 * MiB + 512 * 1024;
constexpr size_t WS_W0IN = 2 * MiB;
constexpr size_t WS_W0OUT = 7 * MiB;
constexpr size_t WS_W1IN = 9 * MiB;
constexpr size_t WS_W1OUT = 13 * MiB;
constexpr size_t WS_AFF = 16 * MiB;
constexpr size_t WS_INV = 18 * MiB;
constexpr size_t WS_GATE = 20 * MiB;
constexpr size_t WS_WGU = 24 * MiB;
constexpr size_t WS_WDN = 152 * MiB;
constexpr size_t WS_MOE_LSTRIDE = 192 * MiB;
constexpr size_t WS_XS = 408 * MiB;
constexpr size_t WS_HB = 480 * MiB;
constexpr size_t WS_QKV = 516 * MiB;
constexpr size_t WS_CC = 597 * MiB;
constexpr size_t WS_AO = 633 * MiB;
constexpr size_t WS_Y = 705 * MiB;
constexpr size_t WS_XG = 516 * MiB;
constexpr size_t WS_HID = 588 * MiB;
constexpr size_t WS_YS = 732 * MiB;
constexpr size_t WS_PF = 804 * MiB;
constexpr size_t WS_END = 968 * MiB;

constexpr int CW_BAR = 4096;
constexpr int LDS_BYTES = 147456;
constexpr int MISC_OFF = 131072 + 320;

__device__ __forceinline__ float bf2f(unsigned v) { return __uint_as_float(v << 16); }
__device__ __forceinline__ unsigned f2bf(float f) { unsigned u = __float_as_uint(f); return (u + 0x7fffu + ((u >> 16) & 1u)) >> 16; }
__device__ __forceinline__ unsigned pk2(float lo, float hi) { return f2bf(lo) | (f2bf(hi) << 16); }
__device__ __forceinline__ float wave_sum(float v) {
#pragma unroll
    for (int o = 1; o < 64; o <<= 1) v += __shfl_xor(v, o);
    return v;
}
__device__ __forceinline__ float wave_max(float v) {
#pragma unroll
    for (int o = 1; o < 64; o <<= 1) v = fmaxf(v, __shfl_xor(v, o));
    return v;
}
__device__ __forceinline__ void unpack8(const v4u w, float* f) {
    f[0] = bf2f(w.x & 0xffffu); f[1] = __uint_as_float(w.x & 0xffff0000u);
    f[2] = bf2f(w.y & 0xffffu); f[3] = __uint_as_float(w.y & 0xffff0000u);
    f[4] = bf2f(w.z & 0xffffu); f[5] = __uint_as_float(w.z & 0xffff0000u);
    f[6] = bf2f(w.w & 0xffffu); f[7] = __uint_as_float(w.w & 0xffff0000u);
}

#define XB_TMO      128
#define XB_XCNT(j)  (256  + 64 * (j))
#define XB_XSUB(j)  (1280 + 64 * (j))
#define XB_XGEN(j)  (2304 + 64 * (j))
#define XB_TOP      3328
#define XB_TOPGEN   3392
#define XCD_BAR_WORDS 3456
#define XB_SPIN_CAP (1u << 18)
__device__ __forceinline__ unsigned xb_ld(unsigned* p)              { return __hip_atomic_load(p, __ATOMIC_RELAXED, __HIP_MEMORY_SCOPE_AGENT); }
__device__ __forceinline__ unsigned xb_add(unsigned* p, unsigned v) { return __hip_atomic_fetch_add(p, v, __ATOMIC_RELAXED, __HIP_MEMORY_SCOPE_AGENT); }
__device__ __forceinline__ unsigned xb_xcc_id() { return (unsigned)__builtin_amdgcn_s_getreg((3 << 11) | 20) & 0xFu; }
#define XB_SPIN(cond, bar) do { unsigned _sp = 0; while (cond) { __builtin_amdgcn_s_sleep(1); \
    if ((++_sp & 255u) == 0u) { if (xb_ld(&(bar)[XB_TMO])) break; if (_sp > XB_SPIN_CAP) { atomicAdd(&(bar)[XB_TMO], 1u); break; } } } } while (0)
struct XcdBarrier { unsigned* bar; unsigned x; volatile LAS unsigned* st; };
__device__ __forceinline__ XcdBarrier xcd_barrier_post(unsigned* bar, volatile LAS unsigned* st) {
    XcdBarrier b; b.bar = bar; b.x = xb_xcc_id(); b.st = st;
    if (threadIdx.x == 0) (void)xb_add(&bar[XB_XCNT(b.x)], 1u);
    return b;
}
__device__ __forceinline__ void xcd_barrier_complete(unsigned* bar, unsigned x, unsigned& nloc, unsigned& nx) {
    const unsigned G = gridDim.x * gridDim.y * gridDim.z;
    unsigned sum, cnt, mine, sp = 0u;
    for (;;) {
        sum = 0u; cnt = 0u; mine = 0u;
#pragma unroll
        for (unsigned j = 0; j < 16; ++j) { const unsigned c = xb_ld(&bar[XB_XCNT(j)]); sum += c; cnt += (c > 0u) ? 1u : 0u; mine = (j == x) ? c : mine; }
        if (sum == G) break;
        __builtin_amdgcn_s_sleep(1);
        if ((++sp & 255u) == 0u) { if (xb_ld(&bar[XB_TMO])) break; if (sp > XB_SPIN_CAP) { atomicAdd(&bar[XB_TMO], 1u); break; } }
    }
    nloc = mine > 0u ? mine : 1u; nx = cnt > 0u ? cnt : 1u;
}
__device__ __forceinline__ void xcd_barrier(const XcdBarrier& b) {
    asm volatile("s_waitcnt vmcnt(0)" ::: "memory");
    __syncthreads();
    if (threadIdx.x == 0) {
        unsigned* bar = b.bar;
        __builtin_amdgcn_s_waitcnt(0);
        unsigned nloc = b.st[0], nx = b.st[1];
        if (nloc == 0u) { xcd_barrier_complete(bar, b.x, nloc, nx); b.st[0] = nloc; b.st[1] = nx; }
        const unsigned old = xb_add(&bar[XB_XSUB(b.x)], 1u);
        const unsigned gen = old / nloc;
        if (old + 1u == (gen + 1u) * nloc) {
            __builtin_amdgcn_fence(__ATOMIC_RELEASE, "agent");
            asm volatile("s_waitcnt vmcnt(0)" ::: "memory");
            const unsigned og = xb_add(&bar[XB_TOP], 1u);
            const unsigned tg = og / nx;
            if (og + 1u == (tg + 1u) * nx) xb_add(&bar[XB_TOPGEN], 1u);
            else XB_SPIN(xb_ld(&bar[XB_TOPGEN]) == tg, bar);
            __builtin_amdgcn_fence(__ATOMIC_ACQUIRE, "agent");
            xb_add(&bar[XB_XGEN(b.x)], 1u);
            asm volatile("s_waitcnt vmcnt(0)" ::: "memory");
        } else {
            XB_SPIN(xb_ld(&bar[XB_XGEN(b.x)]) == gen, bar);
            __builtin_amdgcn_fence(__ATOMIC_ACQUIRE, "agent");
            asm volatile("s_waitcnt vmcnt(0)" ::: "memory");
        }
    }
    __syncthreads();
}

namespace pg8 {
#define PG8_LAS __attribute__((address_space(3)))
typedef unsigned short bf16_t;
typedef short bf16x8 __attribute__((ext_vector_type(8)));
typedef float f32x4 __attribute__((ext_vector_type(4)));
typedef unsigned u32x4 __attribute__((ext_vector_type(4)));
constexpr int BM = 256, BK = 64, HALF = 128, HTB = HALF * BK * 2  , STAGE_BYTES = 8 * HTB, NXCD = 8, WGM = 8;

__host__ __device__ __forceinline__ int lds_byte(int r, int c) { const int st = (r >> 4) * 2 + (c >> 5), rr = r & 15, cc = c & 31, ob = rr * 64 + cc * 2; return st * 1024 + (ob ^ (((ob >> 9) & 1) << 5)); }
__host__ __device__ __forceinline__ void stage_rc(int b, int& R, int& C) { const int st = b / 1024, sb = b % 1024, swz = sb ^ (((sb >> 9) & 1) << 5); R = (st >> 1) * 16 + swz / 64; C = (st & 1) * 32 + (swz % 64) / 2; }
__host__ __device__ __forceinline__ int perm32(int rho) { const int n = rho >> 4, i = rho & 15; return 8 * (i >> 2) + 4 * n + (i & 3); }

struct Unit { int pm, pn, e; };
struct Gemm { const bf16_t* A; const bf16_t* Bt; int M, N, K; size_t bstride; };

struct StaticOrder {
    int nM, nN, nwg, G, c;
    __host__ __device__ void init(int M, int N, int G_, int c_) { nM = M / BM; nN = N / BM; nwg = nM * nN; G = G_; c = c_; }
    __host__ __device__ bool next(int i, Unit& u) const {
        const long L = (long)i * G + c; if (L >= nwg) return false;
        int wgid = (int)L; { const int q = nwg / NXCD, r = nwg % NXCD, xcd = wgid % NXCD, off = wgid / NXCD; wgid = (xcd < r ? xcd * (q + 1) : r * (q + 1) + (xcd - r) * q) + off; }
        const int nig = WGM * nN, gid = wgid / nig, fm = gid * WGM, gsz = (nM - fm) < WGM ? (nM - fm) : WGM;
        u.pm = fm + ((wgid % nig) % gsz); u.pn = (wgid % nig) / gsz; u.e = 0; return true;
    }
    __device__ __forceinline__ void a_ready(const Unit&) const {}
    __device__ __forceinline__ void done(const Unit&) const {}
};

__device__ __forceinline__ unsigned cvt_pk_bf16(float lo, float hi) { unsigned r; asm volatile("v_cvt_pk_bf16_f32 %0, %1, %2" : "=v"(r) : "v"(lo), "v"(hi)); return r; }
typedef float f32x2 __attribute__((ext_vector_type(2)));
__device__ __forceinline__ f32x2 gelu_pk(f32x2 v) {
    const f32x2 av = __builtin_elementwise_abs(v), d = av * 0.2316418882f + 1.0f;
    f32x2 t; t.x = __builtin_amdgcn_rcpf(d.x); t.y = __builtin_amdgcn_rcpf(d.y);
    f32x2 q = t * 0.5307027145f + (-0.7265760135f); q = q * t + 0.7107068705f; q = q * t + (-0.142248368f); q = q * t + 0.127414796f; q = q * t;
    const f32x2 s = (v * v) * (-0.72134752044f);
    f32x2 e; e.x = __builtin_amdgcn_exp2f(s.x); e.y = __builtin_amdgcn_exp2f(s.y);
    const f32x2 m = v * (q * e), r = v - m;
    f32x2 o; o.x = v.x < 0.f ? m.x : r.x; o.y = v.y < 0.f ? m.y : r.y; return o;
}

template <int ACT  > struct EpiBf16 {
    static constexpr bool PERM = true, AFTER_DRAIN = false; static_assert(ACT == 0 || ACT == 1, "EpiBf16: ACT is 0 (none) or 1 (gelu_pk)");
    bf16_t* O; int ldc; const float* bias; int split_cols; size_t split_stride; float scale0;
    __device__ __forceinline__ void operator()(const f32x4 (&acc)[2][2][4][2], const Unit& u, int wr, int wc, int fr, int fq) const {
        const int row0 = u.pm * BM + wr * 64 + fr; int colt = u.pn * BM; bf16_t* base = O;
        float sc = 1.f; if (split_cols) { const int t = colt / split_cols; base += (size_t)t * split_stride; colt -= t * split_cols; if (t == 0) sc = scale0; }
        const int col0 = colt + wc * 32 + 8 * fq, bcol0 = u.pn * BM + wc * 32 + 8 * fq;
        f32x4 bv[2][2];
#pragma unroll
        for (int bj = 0; bj < 2; ++bj)
#pragma unroll
            for (int n = 0; n < 2; ++n) bv[bj][n] = bias ? *(const f32x4*)(bias + bcol0 + bj * HALF + 4 * n) : (f32x4){0.f, 0.f, 0.f, 0.f};
#pragma unroll
        for (int ai = 0; ai < 2; ++ai)
#pragma unroll
            for (int m = 0; m < 4; ++m) { bf16_t* rowp = base + (size_t)(row0 + ai * HALF + m * 16) * ldc + col0;
#pragma unroll
                for (int bj = 0; bj < 2; ++bj) { f32x4 v0 = acc[ai][bj][m][0] + bv[bj][0], v1 = acc[ai][bj][m][1] + bv[bj][1];
                    if (ACT == 1) { f32x2 a = gelu_pk((f32x2){v0[0], v0[1]}), b = gelu_pk((f32x2){v0[2], v0[3]}), c = gelu_pk((f32x2){v1[0], v1[1]}), d = gelu_pk((f32x2){v1[2], v1[3]});
                        v0 = (f32x4){a.x, a.y, b.x, b.y}; v1 = (f32x4){c.x, c.y, d.x, d.y}; }
                    v0 = v0 * sc; v1 = v1 * sc; u32x4 w; w.x = cvt_pk_bf16(v0[0], v0[1]); w.y = cvt_pk_bf16(v0[2], v0[3]); w.z = cvt_pk_bf16(v1[0], v1[1]); w.w = cvt_pk_bf16(v1[2], v1[3]);
                    *(u32x4*)(rowp + bj * HALF) = w; } }
    }
};

template <class Epi, class Sched, bool ALIGN_EPI = false, bool SP2 = false>
__device__ __forceinline__ void gemm_phase(PG8_LAS unsigned char* lds, const Gemm g, const Sched& S, const Epi& E) {
    const int tid = threadIdx.x, wid = __builtin_amdgcn_readfirstlane(tid >> 6), lane = tid & 63, wr = wid >> 2, wc = wid & 3, fr = lane & 15, fq = lane >> 4;
    const int K = g.K, nt = K / BK;
    unsigned voffA[2], voffB[2];
#pragma unroll
    for (int i = 0; i < 2; ++i) { int R, C; stage_rc(tid * 16 + i * 8192, R, C); const int Rb = Epi::PERM ? ((R & ~31) + perm32(R & 31)) : R;
        voffA[i] = (unsigned)(R * K + C) * 2u; voffB[i] = (unsigned)(Rb * K + C) * 2u; }
    const size_t kstep = (size_t)(BK * 2);
    const size_t hstep = (size_t)HALF * K * 2;
    const size_t tstep = 2 * hstep;
    const unsigned ldsw = (unsigned)wid * 1024u;
    const int aoff = lds_byte(wr * 64 + fr, fq * 8), boff = lds_byte(wc * 32 + fr, fq * 8);
#define PG8_SA(b, h) (((b) * 2 + (h)) * HTB)
#define PG8_SB(b, h) ((4 + (b) * 2 + (h)) * HTB)
#define PG8_STAGE(bufoff, gbase, voff) do { _Pragma("unroll") for (int _i = 0; _i < 2; ++_i) \
        __builtin_amdgcn_global_load_lds((const unsigned*)((const char*)(gbase) + (voff)[_i]), (PG8_LAS unsigned*)(lds + (bufoff) + ldsw + _i * 8192), 16, 0, 0); } while (0)
#define PG8_LDA(dst, b, h) do { _Pragma("unroll") for (int m = 0; m < 4; ++m) _Pragma("unroll") for (int k = 0; k < 2; ++k) dst[m][k] = *(const PG8_LAS bf16x8*)(lds + PG8_SA(b, h) + aoff + m * 2048 + k * 1024); } while (0)
#define PG8_LDB(dst, b, h) do { _Pragma("unroll") for (int n = 0; n < 2; ++n) _Pragma("unroll") for (int k = 0; k < 2; ++k) dst[n][k] = *(const PG8_LAS bf16x8*)(lds + PG8_SB(b, h) + boff + n * 2048 + k * 1024); } while (0)
#define PG8_MMA(ai, bj, At, Bt) do { __builtin_amdgcn_s_setprio(1); _Pragma("unroll") for (int m = 0; m < 4; ++m) _Pragma("unroll") for (int n = 0; n < 2; ++n) _Pragma("unroll") for (int k = 0; k < 2; ++k) \
        acc[ai][bj][m][n] = __builtin_amdgcn_mfma_f32_16x16x32_bf16(Bt[n][k], At[m][k], acc[ai][bj][m][n], 0, 0, 0); __builtin_amdgcn_s_setprio(0); } while (0)
#define PG8_WAIT_V(n) asm volatile("s_waitcnt vmcnt(" #n ")" ::: "memory")
#define PG8_WAIT_L(n) asm volatile("s_waitcnt lgkmcnt(" #n ")" ::: "memory")
#define PG8_BAR __builtin_amdgcn_s_barrier()
#define PG8_SCHED __builtin_amdgcn_sched_barrier(0)
    Unit cur, nxt; int ui = 0;
    if (!S.next(0, cur)) return;
    f32x4 acc[2][2][4][2];
#pragma unroll
    for (int a = 0; a < 2; ++a)
#pragma unroll
        for (int b = 0; b < 2; ++b)
#pragma unroll
            for (int m = 0; m < 4; ++m)
#pragma unroll
                for (int n = 0; n < 2; ++n) acc[a][b][m][n] = (f32x4){0.f, 0.f, 0.f, 0.f};
    bf16x8 At[4][2], B0[2][2], B1[2][2];
    const char* cA = (const char*)g.A + (size_t)cur.pm * tstep; const char* cB = (const char*)g.Bt + (size_t)cur.pn * tstep + (size_t)cur.e * g.bstride;
    S.a_ready(cur);
    if constexpr (SP2) {
        PG8_STAGE(PG8_SB(0, 0), cB, voffB); PG8_STAGE(PG8_SB(0, 1), cB + hstep, voffB); PG8_STAGE(PG8_SA(0, 0), cA, voffA); PG8_STAGE(PG8_SA(0, 1), cA + hstep, voffA);
        if (wr == 1) PG8_BAR;
        PG8_WAIT_V(2); PG8_BAR;
        PG8_STAGE(PG8_SB(1, 0), cB + kstep, voffB); PG8_STAGE(PG8_SA(1, 0), cA + kstep, voffA); PG8_STAGE(PG8_SB(1, 1), cB + hstep + kstep, voffB);
        PG8_WAIT_V(6); PG8_BAR;
    } else {
        PG8_STAGE(PG8_SB(0, 0), cB, voffB); PG8_STAGE(PG8_SA(0, 0), cA, voffA); PG8_STAGE(PG8_SB(0, 1), cB + hstep, voffB); PG8_STAGE(PG8_SA(0, 1), cA + hstep, voffA);
        if (wr == 1) PG8_BAR;
        PG8_WAIT_V(4); PG8_BAR;
        PG8_STAGE(PG8_SB(1, 0), cB + kstep, voffB); PG8_STAGE(PG8_SA(1, 0), cA + kstep, voffA); PG8_STAGE(PG8_SB(1, 1), cB + hstep + kstep, voffB);
        PG8_WAIT_V(6); PG8_BAR;
    }
    for (;;) {
        const bool has_next = S.next(ui + 1, nxt);
        const char* nA = has_next ? (const char*)g.A + (size_t)nxt.pm * tstep : cA; const char* nB = has_next ? (const char*)g.Bt + (size_t)nxt.pn * tstep + (size_t)nxt.e * g.bstride : cB;
        for (int t = 0; t < nt; t += 2) {
            const bool last = (t == nt - 2);
            const char* a1 = cA + (size_t)(t + 1) * kstep;
            const char* a2 = last ? nA : cA + (size_t)(t + 2) * kstep; const char* b2 = last ? nB : cB + (size_t)(t + 2) * kstep;
            const char* a3 = a2 + kstep; const char* b3 = b2 + kstep;
            if (last && has_next) S.a_ready(nxt);
            if constexpr (SP2) {
            PG8_LDB(B0, 0, 0); PG8_LDB(B1, 0, 1); PG8_SCHED; PG8_LDA(At, 0, 0); PG8_STAGE(PG8_SA(1, 1), a1 + hstep, voffA);
            PG8_WAIT_V(8); PG8_WAIT_L(0); PG8_BAR; PG8_MMA(0, 0, At, B0); PG8_MMA(0, 1, At, B1); PG8_BAR; PG8_SCHED;
            PG8_LDA(At, 0, 1); PG8_STAGE(PG8_SB(0, 0), b2, voffB); PG8_STAGE(PG8_SB(0, 1), b2 + hstep, voffB); PG8_STAGE(PG8_SA(0, 0), a2, voffA);
            PG8_WAIT_V(8); PG8_WAIT_L(0); PG8_BAR; PG8_MMA(1, 0, At, B0); PG8_MMA(1, 1, At, B1); PG8_BAR; PG8_SCHED;
            PG8_LDB(B0, 1, 0); PG8_LDB(B1, 1, 1); PG8_SCHED; PG8_LDA(At, 1, 0); PG8_STAGE(PG8_SA(0, 1), a2 + hstep, voffA);
            PG8_WAIT_V(8); PG8_WAIT_L(0); PG8_BAR; PG8_MMA(0, 0, At, B0); PG8_MMA(0, 1, At, B1); PG8_BAR; PG8_SCHED;
            PG8_LDA(At, 1, 1); PG8_STAGE(PG8_SB(1, 0), b3, voffB); PG8_STAGE(PG8_SB(1, 1), b3 + hstep, voffB); PG8_STAGE(PG8_SA(1, 0), a3, voffA);
            PG8_WAIT_V(8); PG8_WAIT_L(0); PG8_BAR; PG8_MMA(1, 0, At, B0); PG8_MMA(1, 1, At, B1); PG8_BAR; PG8_SCHED;
            } else {
            PG8_LDB(B0, 0, 0); PG8_SCHED; PG8_LDA(At, 0, 0); PG8_STAGE(PG8_SA(1, 1), a1 + hstep, voffA);
            PG8_WAIT_L(8); PG8_BAR; PG8_WAIT_L(0); PG8_MMA(0, 0, At, B0); PG8_BAR; PG8_SCHED;
            PG8_LDB(B1, 0, 1); PG8_STAGE(PG8_SB(0, 0), b2, voffB);
            PG8_BAR; PG8_WAIT_L(0); PG8_MMA(0, 1, At, B1); PG8_BAR;
            PG8_LDA(At, 0, 1); PG8_STAGE(PG8_SA(0, 0), a2, voffA);
            PG8_BAR; PG8_WAIT_L(0); PG8_MMA(1, 0, At, B0); PG8_BAR; PG8_SCHED;
            PG8_STAGE(PG8_SB(0, 1), b2 + hstep, voffB);
            PG8_WAIT_V(6); PG8_BAR; PG8_MMA(1, 1, At, B1); PG8_BAR;
            PG8_LDB(B0, 1, 0); PG8_SCHED; PG8_LDA(At, 1, 0); PG8_STAGE(PG8_SA(0, 1), a2 + hstep, voffA);
            PG8_WAIT_L(8); PG8_BAR; PG8_WAIT_L(0); PG8_MMA(0, 0, At, B0); PG8_BAR; PG8_SCHED;
            PG8_LDB(B1, 1, 1); PG8_STAGE(PG8_SB(1, 0), b3, voffB);
            PG8_BAR; PG8_WAIT_L(0); PG8_MMA(0, 1, At, B1); PG8_BAR;
            PG8_LDA(At, 1, 1); PG8_STAGE(PG8_SA(1, 0), a3, voffA);
            PG8_BAR; PG8_WAIT_L(0); PG8_MMA(1, 0, At, B0); PG8_BAR; PG8_SCHED;
            PG8_STAGE(PG8_SB(1, 1), b3 + hstep, voffB);
            PG8_WAIT_V(6); PG8_BAR; PG8_MMA(1, 1, At, B1); PG8_BAR;
            }
        }
        if constexpr (ALIGN_EPI) { if (wr == 0) PG8_BAR; }
        if constexpr (!Epi::AFTER_DRAIN) { E(acc, cur, wr, wc, fr, fq); S.done(cur); }
        if (!has_next) break;
#pragma unroll
        for (int a = 0; a < 2; ++a)
#pragma unroll
            for (int b = 0; b < 2; ++b)
#pragma unroll
                for (int m = 0; m < 4; ++m)
#pragma unroll
                    for (int n = 0; n < 2; ++n) acc[a][b][m][n] = (f32x4){0.f, 0.f, 0.f, 0.f};
        cur = nxt; cA = nA; cB = nB; ++ui;
        if constexpr (ALIGN_EPI) { if (wr == 1) PG8_BAR; }
    }
    PG8_WAIT_V(0);
    if constexpr (!ALIGN_EPI) { if (wr == 0) PG8_BAR; }
    PG8_BAR;
    if constexpr (Epi::AFTER_DRAIN) { E.fused(acc, cur, wr, wc, fr, fq, lds, wid, lane); S.done(cur); }
#undef PG8_SA
#undef PG8_SB
#undef PG8_STAGE
#undef PG8_LDA
#undef PG8_LDB
#undef PG8_MMA
#undef PG8_WAIT_V
#undef PG8_WAIT_L
#undef PG8_BAR
#undef PG8_SCHED
}
}

namespace pg8 {
struct EpiF32P {
    static constexpr bool PERM = false, AFTER_DRAIN = false;
    float* O; int ldc;
    __device__ __forceinline__ void operator()(const f32x4 (&acc)[2][2][4][2], const Unit& u, int wr, int wc, int fr, int fq) const {
        const int row0 = u.pm * BM + wr * 64 + fr, col0 = u.pn * BM + wc * 32 + 4 * fq;
#pragma unroll
        for (int ai = 0; ai < 2; ++ai)
#pragma unroll
            for (int m = 0; m < 4; ++m) { float* rowp = O + (size_t)(row0 + ai * HALF + m * 16) * ldc + col0;
#pragma unroll
                for (int bj = 0; bj < 2; ++bj)
#pragma unroll
                    for (int n = 0; n < 2; ++n) *(f32x4*)(rowp + bj * HALF + n * 16) = acc[ai][bj][m][n]; }
    }
};
struct EpiSwigluP {
    static constexpr bool PERM = true, AFTER_DRAIN = false;
    bf16_t* O; int ldc;
    __device__ __forceinline__ void operator()(const f32x4 (&acc)[2][2][4][2], const Unit& u, int wr, int wc, int fr, int fq) const {
        const int row0 = u.pm * BM + wr * 64 + fr, col0 = u.pn * HALF + wc * 32 + 8 * fq;
#pragma unroll
        for (int ai = 0; ai < 2; ++ai)
#pragma unroll
            for (int m = 0; m < 4; ++m) {
                float h[8];
#pragma unroll
                for (int n = 0; n < 2; ++n)
#pragma unroll
                    for (int j = 0; j < 4; ++j) { const float g = acc[ai][0][m][n][j], up = acc[ai][1][m][n][j];
                        h[4 * n + j] = g * up * __builtin_amdgcn_rcpf(1.0f + __builtin_amdgcn_exp2f(-1.4426950408889634f * g)); }
                u32x4 w; w.x = cvt_pk_bf16(h[0], h[1]); w.y = cvt_pk_bf16(h[2], h[3]); w.z = cvt_pk_bf16(h[4], h[5]); w.w = cvt_pk_bf16(h[6], h[7]);
                *(u32x4*)(O + (size_t)(row0 + ai * HALF + m * 16) * ldc + col0) = w; }
    }
};
struct EpiGateP {
    static constexpr bool PERM = true, AFTER_DRAIN = false;
    bf16_t* O; int ldc; const float* gate;
    __device__ __forceinline__ void operator()(const f32x4 (&acc)[2][2][4][2], const Unit& u, int wr, int wc, int fr, int fq) const {
        const int row0 = u.pm * BM + wr * 64 + fr, col0 = u.pn * BM + wc * 32 + 8 * fq;
#pragma unroll
        for (int ai = 0; ai < 2; ++ai)
#pragma unroll
            for (int m = 0; m < 4; ++m) { const int row = row0 + ai * HALF + m * 16; const float gt = gate[row]; bf16_t* rowp = O + (size_t)row * ldc + col0;
#pragma unroll
                for (int bj = 0; bj < 2; ++bj) { const f32x4 v0 = acc[ai][bj][m][0] * gt, v1 = acc[ai][bj][m][1] * gt;
                    u32x4 w; w.x = cvt_pk_bf16(v0[0], v0[1]); w.y = cvt_pk_bf16(v0[2], v0[3]); w.z = cvt_pk_bf16(v1[0], v1[1]); w.w = cvt_pk_bf16(v1[2], v1[3]);
                    *(u32x4*)(rowp + bj * HALF) = w; } }
    }
};
struct GroupedOrder {
    int nMe, nN, ntot, G, c;
    __device__ void init(int nMe_, int nN_, int ne, int G_, int c_) { nMe = nMe_; nN = nN_; ntot = nMe_ * nN_ * ne; G = G_; c = c_; }
    __device__ bool next(int i, Unit& u) const {
        const int L = i * G + c; if (L >= ntot) return false;
        const int per = nMe * nN, e = L / per, rem = L - e * per;
        u.e = e; u.pn = rem / nMe; u.pm = e * nMe + (rem - u.pn * nMe); return true;
    }
    __device__ __forceinline__ void a_ready(const Unit&) const {}
    __device__ __forceinline__ void done(const Unit&) const {}
};
struct L1InOrder {
    StaticOrder so; int G, c;
    __device__ void init(int G_, int c_) { so.init(16384, 2048, G_, 0); G = G_; c = c_; }
    __device__ bool next(int i, Unit& u) const {
        const int L = i * G + c;
        if (L < 512) { StaticOrder t = so; t.G = 1; t.c = 0; return t.next(L, u); }
        if (L < 544) { const int l = L - 512; u.pm = 64 + (l >> 2); u.pn = 2 + (l & 3); u.e = 0; return true; }
        return false;
    }
    __device__ __forceinline__ void a_ready(const Unit&) const {}
    __device__ __forceinline__ void done(const Unit&) const {}
};
}

#include <hip/hip_bf16.h>
#include <cmath>
namespace attn_body {
using bf16=__hip_bfloat16;
using bf16x8=__attribute__((ext_vector_type(8)))short;
using s16x4=__attribute__((ext_vector_type(4)))short;
using f32x16=__attribute__((ext_vector_type(16)))float;
using u32x4=__attribute__((ext_vector_type(4)))unsigned;
constexpr int D=64,OPITCH=1024;
constexpr int NW=8,QBLK=32,QB=QBLK*NW,KVBLK=64;
__device__ __forceinline__ int crow(int r,int hi){return (r&3)+8*(r>>2)+4*hi;}
#define SBAR() __builtin_amdgcn_sched_barrier(0)
__device__ __forceinline__ void cmask(f32x16&p0,f32x16&p1,int jb,int qrel,int hi){
  const float NEG=-INFINITY; int kb=64*jb+4*hi;
  #pragma unroll
  for(int r=0;r<16;++r){int kv=kb+(r&3)+8*(r>>2); if(kv>qrel)p0[r]=NEG; if(kv+32>qrel)p1[r]=NEG;}
}

constexpr int NSLOT=3, SLOTB=8192;
constexpr int LDS_K=0, LDS_V=NSLOT*SLOTB, LDS_WS=2*NSLOT*SLOTB, LDS_OST=LDS_WS+NW*64*4, LDS_BYTES=LDS_OST+NW*4096;
constexpr float C2=0.125f*1.4426950408889634f;
__device__ __forceinline__ void glds16(const void*gsrc,unsigned lds_dst){unsigned keep;
  asm volatile("s_mov_b32 %0, m0\n\ts_mov_b32 m0, %2\n\ts_nop 0\n\tglobal_load_lds_dwordx4 %1, off\n\ts_mov_b32 m0, %0":"=&s"(keep):"v"(gsrc),"s"(lds_dst):"memory");}
__device__ __forceinline__ float max3f(float a,float b,float c){float r;asm("v_max3_f32 %0, %1, %2, %3":"=v"(r):"v"(a),"v"(b),"v"(c));return r;}
__device__ __forceinline__ float max2f(float a,float b){float r;asm("v_max_f32_e32 %0, %1, %2":"=v"(r):"v"(a),"v"(b));return r;}
__device__ __forceinline__ float fadd_s(float a,float b){float r;asm("v_add_f32_e32 %0, %1, %2":"=v"(r):"v"(a),"v"(b));return r;}
__device__ __forceinline__ float fsub_s(float a,float b){float r;asm("v_sub_f32_e32 %0, %1, %2":"=v"(r):"v"(a),"v"(b));return r;}
typedef float f32x2_t __attribute__((ext_vector_type(2))); typedef __bf16 bf16x2_t __attribute__((ext_vector_type(2)));
__device__ __forceinline__ unsigned cvtpk_s(float lo,float hi){f32x2_t v={lo,hi};bf16x2_t b=__builtin_convertvector(v,bf16x2_t);return __builtin_bit_cast(unsigned,b);}
#define WAIT_BAR(N) asm volatile("s_waitcnt vmcnt(" #N ") lgkmcnt(0)\n\ts_barrier":::"memory")

__device__ __forceinline__ void qkt(f32x16&p0,f32x16&p1,const char*Kslot,const bf16x8*qr,const f32x16&negm,int r32,int hi){
  const char*kb=Kslot+hi*1024+r32*16;
  #pragma unroll
  for(int d0=0;d0<4;++d0){
    const bf16x8 b0=*reinterpret_cast<const bf16x8*>(kb+d0*2048);
    const bf16x8 b1=*reinterpret_cast<const bf16x8*>(kb+d0*2048+512);
    if(d0==0){p0=__builtin_amdgcn_mfma_f32_32x32x16_bf16(b0,qr[0],negm,0,0,0);p1=__builtin_amdgcn_mfma_f32_32x32x16_bf16(b1,qr[0],negm,0,0,0);}
    else{p0=__builtin_amdgcn_mfma_f32_32x32x16_bf16(b0,qr[d0],p0,0,0,0);p1=__builtin_amdgcn_mfma_f32_32x32x16_bf16(b1,qr[d0],p1,0,0,0);}}
}
typedef __attribute__((address_space(3))) const char* lds_cptr;
typedef short v4i16_t __attribute__((ext_vector_type(4)));
__device__ __forceinline__ void kload8(bf16x8*kf,lds_cptr kp){
  kf[0]=*(const __attribute__((address_space(3))) bf16x8*)(kp);      kf[1]=*(const __attribute__((address_space(3))) bf16x8*)(kp+512);
  kf[2]=*(const __attribute__((address_space(3))) bf16x8*)(kp+2048); kf[3]=*(const __attribute__((address_space(3))) bf16x8*)(kp+2560);
  kf[4]=*(const __attribute__((address_space(3))) bf16x8*)(kp+4096); kf[5]=*(const __attribute__((address_space(3))) bf16x8*)(kp+4608);
  kf[6]=*(const __attribute__((address_space(3))) bf16x8*)(kp+6144); kf[7]=*(const __attribute__((address_space(3))) bf16x8*)(kp+6656);
}
__device__ __forceinline__ void kload2(bf16x8*kf,lds_cptr kp,int j){ kf[2*j]=*(const __attribute__((address_space(3))) bf16x8*)(kp+j*2048); kf[2*j+1]=*(const __attribute__((address_space(3))) bf16x8*)(kp+j*2048+512); }
__device__ __forceinline__ s16x4 vtr(lds_cptr p){ return __builtin_bit_cast(s16x4,__builtin_amdgcn_ds_read_tr16_b64_v4i16((__attribute__((address_space(3))) v4i16_t*)p)); }
__device__ __forceinline__ float rowmax(const f32x16&p0,const f32x16&p1){
  float a=max3f(p0[0],p0[1],p1[0]),b=max3f(p0[2],p0[3],p1[1]);a=max3f(a,p1[2],p1[3]);
  #pragma unroll
  for(int r=4;r<16;r+=4){a=max3f(a,p0[r],p0[r+1]);b=max3f(b,p0[r+2],p0[r+3]);a=max3f(a,p1[r],p1[r+1]);b=max3f(b,p1[r+2],p1[r+3]);}
  const float m=max2f(a,b);
  auto rr=__builtin_amdgcn_permlane32_swap(__float_as_uint(m),__float_as_uint(m),false,false);
  return max2f(__uint_as_float(rr[0]),__uint_as_float(rr[1]));
}
__device__ __forceinline__ void pv(f32x16*o,int vb,bf16x8 pa0,bf16x8 pa1,bf16x8 pa2,bf16x8 pa3){
  #pragma unroll
  for(int d0=0;d0<2;++d0){s16x4 lo[4],hi[4];
    #pragma unroll
    for(int ks=0;ks<4;++ks){
      asm volatile("ds_read_b64_tr_b16 %0,%1 offset:%c2":"=&v"(lo[ks]):"v"(vb),"i"(d0*4096+ks*1024):"memory");
      asm volatile("ds_read_b64_tr_b16 %0,%1 offset:%c2":"=&v"(hi[ks]):"v"(vb),"i"(d0*4096+ks*1024+512):"memory");}
    asm volatile("s_waitcnt lgkmcnt(0)":::"memory");SBAR();
    #define PK(k) (bf16x8){lo[k][0],lo[k][1],lo[k][2],lo[k][3],hi[k][0],hi[k][1],hi[k][2],hi[k][3]}
    o[d0]=__builtin_amdgcn_mfma_f32_32x32x16_bf16(pa0,PK(0),o[d0],0,0,0);
    o[d0]=__builtin_amdgcn_mfma_f32_32x32x16_bf16(pa1,PK(1),o[d0],0,0,0);
    o[d0]=__builtin_amdgcn_mfma_f32_32x32x16_bf16(pa2,PK(2),o[d0],0,0,0);
    o[d0]=__builtin_amdgcn_mfma_f32_32x32x16_bf16(pa3,PK(3),o[d0],0,0,0);
    #undef PK
  }
}

#ifndef ATTN_STORE16
#define ATTN_STORE16(p,v) (*(u32x4*)(p)=(v))
#endif
struct AU { const bf16* Qp; const bf16* Kp; const bf16* Vp; bf16* Op; int qrow0, lat_row0, ctx_row0, nlat_t, NT; };
struct NoMask { __device__ __forceinline__ void apply(f32x16&,f32x16&,int,int)const{} };
typedef __attribute__((address_space(3))) const float* lds_cfptr;
struct NAMask { lds_cfptr tb0; int r, rs, rs_min, cb;
  __device__ __forceinline__ void apply(f32x16&p0,f32x16&p1,int t,int hi)const{
    if(t<4)return;
    const int kr=rs_min+t-4; const float NEG=-INFINITY;
    if((unsigned)(kr-rs)>7u){
      #pragma unroll
      for(int i=0;i<16;++i){p0[i]=NEG;p1[i]=NEG;}
      return; }
    const lds_cfptr tb=tb0+(kr-r+7)*32+4*hi;
    #pragma unroll
    for(int i=0;i<16;++i){ const int k0=(i&3)+8*(i>>2); const int d0=cb+k0, d1=cb+k0+32;
      const float b0=tb[k0], b1=tb[k0+32];
      p0[i]=((unsigned)d0<=15u)?p0[i]+b0:NEG; p1[i]=((unsigned)d1<=15u)?p1[i]+b1:NEG; }
  }
};
template<int THRL,int PITCH,class MaskT> __device__ __forceinline__ void attn_unit(const AU& u,char*shm,const MaskT& mk){
  const int tid=threadIdx.x,lane=tid&63,r32=lane&31,hi=lane>>5; const int wid=__builtin_amdgcn_readfirstlane(tid>>6);
  const bf16*Qw=u.Qp+(long)(u.qrow0+wid*QBLK)*PITCH;
  const bf16*Kh=u.Kp,*Vh=u.Vp;
  const unsigned lds0=(unsigned)(uintptr_t)shm;
  float*wsf=(float*)(shm+LDS_WS)+wid*64;
  const bf16*ksrc=Kh+(long)lane*PITCH+wid*8;
  const bf16*vsrc=Vh+(long)(16*(wid&3)+(lane>>2))*PITCH+(wid>>2)*32+(lane&3)*8;
  const unsigned kdst=lds0+LDS_K+wid*1024, vdst=lds0+LDS_V+wid*1024;
  #define TROW(t) ((long)((t)<u.nlat_t?u.lat_row0+KVBLK*(t):u.ctx_row0+KVBLK*((t)-u.nlat_t))*PITCH)
  #define DMA_K(t,slot) glds16(ksrc+TROW(t),(unsigned)__builtin_amdgcn_readfirstlane(kdst+(slot)))
  #define DMA_V(t,slot) glds16(vsrc+TROW(t),(unsigned)__builtin_amdgcn_readfirstlane(vdst+(slot)))
  const int vb0=(int)(lds0+LDS_V)+((lane>>4)&1)*32+(lane&3)*8+(4*hi+((lane&15)>>2))*64;
  const char*Kbase=shm+LDS_K; bf16x8 kf[8];
  const lds_cptr shm3=(lds_cptr)shm; const lds_cptr kp0=shm3+LDS_K+hi*1024+r32*16; const lds_cptr vp0=shm3+LDS_V+((lane>>4)&1)*32+(lane&3)*8+(4*hi+((lane&15)>>2))*64;
  const int NT=u.NT;
  DMA_K(0,0);DMA_V(0,0);DMA_K(1,SLOTB);
  bf16x8 qr[4];
  #pragma unroll
  for(int d0=0;d0<4;++d0)qr[d0]=*reinterpret_cast<const bf16x8*>(&Qw[(long)r32*PITCH+d0*16+hi*8]);
  float mhat=0.f,l_reg=0.f;f32x16 o[2];o[0]=f32x16{};o[1]=f32x16{};f32x16 negm=f32x16{};asm volatile("":"+v"(negm));
  #define CMASK(P0,P1,t) mk.apply(P0,P1,(t),hi)
  bool resc=false;
  #define START(P0,P1) do{ const float rm=rowmax(P0,P1); resc=false; \
    { const float dl=rm; mhat=fadd_s(mhat,dl); \
      _Pragma("unroll") for(int r=0;r<16;++r){P0[r]=fsub_s(P0[r],dl);P1[r]=fsub_s(P1[r],dl);} \
      _Pragma("unroll") for(int r=0;r<16;++r)negm[r]=-mhat; asm volatile("":"+v"(negm)); } \
    _Pragma("unroll") for(int r=0;r<16;++r)P0[r]=__builtin_amdgcn_exp2f(P0[r]); }while(0)
  #define RESC() do{ if(resc){ asm volatile("s_waitcnt lgkmcnt(0)":::"memory"); \
      _Pragma("unroll") for(int d_=0;d_<2;++d_) _Pragma("unroll") for(int r=0;r<16;++r)o[d_][r]*=wsf[crow(r,hi)]; } }while(0)
  f32x16 pA0,pA1,pB0,pB1;
  int sl_prev=0,sl_cur=0,sl_next=SLOTB;
  #define ROT() do{sl_prev=sl_cur;sl_cur=sl_next;sl_next=(sl_next==(NSLOT-1)*SLOTB)?0:sl_next+SLOTB;}while(0)
  DMA_K(2,2*SLOTB);
  WAIT_BAR(3);
  qkt(pA0,pA1,Kbase,qr,negm,r32,hi);asm volatile("s_nop 15\n\ts_nop 7":"+v"(pA0),"+v"(pA1));CMASK(pA0,pA1,0);
  START(pA0,pA1);
  _Pragma("unroll") for(int r=0;r<16;++r)pA1[r]=__builtin_amdgcn_exp2f(pA1[r]);
  WAIT_BAR(0);
  DMA_K(3,0);DMA_V(1,SLOTB);
  ROT();
  kload8(kf,kp0+sl_cur);
  WAIT_BAR(2);
  s16x4 vlo[8],vhi[8]; u32x4 pw0,pw1,pw2,pw3;
  #define PKW(P,B) cvtpk_s(P[B],P[B+1])
  #define PAF(k) __builtin_bit_cast(bf16x8,pw##k)
  #define VFR(i) (bf16x8){vlo[i][0],vlo[i][1],vlo[i][2],vlo[i][3],vhi[i][0],vhi[i][1],vhi[i][2],vhi[i][3]}
  #define PIN(x) asm volatile("":"+v"(x))
  #define MX3(a,b,c) __builtin_fmaxf(__builtin_fmaxf((a),(b)),(c))
  #define GAPA(MF,A0,A1,A2,A3,W0,W1,PW) do{ MF; sacc+=A0; sacc+=A1; sacc+=A2; sacc+=A3; PIN(sacc); W0; W1; PIN(PW); SBAR(); }while(0)
  #define EX(v) __builtin_amdgcn_exp2f(v)
  #define GAPB(MF,X,B) do{ MF; X[B]=EX(X[B]); X[B+1]=EX(X[B+1]); X[B+2]=EX(X[B+2]); X[B+3]=EX(X[B+3]); PIN(X); SBAR(); }while(0)
  #define VRD(i) do{ vlo[i]=vtr(vp_+(((i)>>2)*4096+((i)&3)*1024)); vhi[i]=vtr(vp_+(((i)>>2)*4096+((i)&3)*1024+512)); }while(0)
  #define KRD(G,j) do{ if(G){ kload2(kf,kp0+sl_next,j); SBAR(); } }while(0)
  #define STEP(C0,C1,P0,P1,t,GK,GV,GL) do{ SBAR(); \
    const lds_cptr vp_=vp0+sl_prev; \
    VRD(0); SBAR(); float sacc=(P0[0]+P0[1]); \
    GAPA(C0=__builtin_amdgcn_mfma_f32_32x32x16_bf16(kf[0],qr[0],negm,0,0,0), P0[2],P0[3],P0[4],P0[5],     pw0[0]=PKW(P0,0), pw0[1]=PKW(P0,2), pw0); \
    VRD(4); SBAR(); GAPA(C1=__builtin_amdgcn_mfma_f32_32x32x16_bf16(kf[1],qr[0],negm,0,0,0), P0[6],P0[7],P0[8],P0[9],     pw0[2]=PKW(P0,4), pw0[3]=PKW(P0,6), pw0); \
    VRD(1); SBAR(); GAPA(C0=__builtin_amdgcn_mfma_f32_32x32x16_bf16(kf[2],qr[1],C0,0,0,0),   P0[10],P0[11],P0[12],P0[13], pw1[0]=PKW(P0,8), pw1[1]=PKW(P0,10), pw1); \
    VRD(5); SBAR(); GAPA(C1=__builtin_amdgcn_mfma_f32_32x32x16_bf16(kf[3],qr[1],C1,0,0,0),   P0[14],P0[15],P1[0],P1[1],   pw1[2]=PKW(P0,12),pw1[3]=PKW(P0,14), pw1); \
    VRD(2); SBAR(); GAPA(C0=__builtin_amdgcn_mfma_f32_32x32x16_bf16(kf[4],qr[2],C0,0,0,0),   P1[2],P1[3],P1[4],P1[5],     pw2[0]=PKW(P1,0), pw2[1]=PKW(P1,2), pw2); \
    VRD(6); SBAR(); GAPA(C1=__builtin_amdgcn_mfma_f32_32x32x16_bf16(kf[5],qr[2],C1,0,0,0),   P1[6],P1[7],P1[8],P1[9],     pw2[2]=PKW(P1,4), pw2[3]=PKW(P1,6), pw2); \
    VRD(3); SBAR(); GAPA(C0=__builtin_amdgcn_mfma_f32_32x32x16_bf16(kf[6],qr[3],C0,0,0,0),   P1[10],P1[11],P1[12],P1[13], pw3[0]=PKW(P1,8), pw3[1]=PKW(P1,10), pw3); \
    VRD(7); SBAR(); GAPA(C1=__builtin_amdgcn_mfma_f32_32x32x16_bf16(kf[7],qr[3],C1,0,0,0),   P1[14],P1[15],0.f,0.f,       pw3[2]=PKW(P1,12),pw3[3]=PKW(P1,14), pw3); \
    l_reg+=sacc; \
    if(GK){DMA_K((t)+3,sl_cur);} if(GV){DMA_V((t)+1,sl_next);} \
    CMASK(C0,C1,t); \
    { float a=MX3(C0[0],C0[1],C1[0]),b=MX3(C0[2],C0[3],C1[1]); a=MX3(a,C1[2],C1[3]); \
      _Pragma("unroll") for(int r=4;r<16;r+=4){a=MX3(a,C0[r],C0[r+1]);b=MX3(b,C0[r+2],C0[r+3]);a=MX3(a,C1[r],C1[r+1]);b=MX3(b,C1[r+2],C1[r+3]);} \
      float rm=__builtin_fmaxf(a,b); { auto rr=__builtin_amdgcn_permlane32_swap(__float_as_uint(rm),__float_as_uint(rm),false,false); rm=__builtin_fmaxf(__uint_as_float(rr[0]),__uint_as_float(rr[1])); } \
      resc=false; \
      if(__builtin_expect(__any(rm>(float)THRL),0)){ const float dl=__builtin_fmaxf(rm,0.f); mhat+=dl; \
        _Pragma("unroll") for(int r=0;r<16;++r){C0[r]-=dl;C1[r]-=dl;} \
        _Pragma("unroll") for(int r=0;r<16;++r)negm[r]=-mhat; asm volatile("":"+v"(negm)); \
        const float f=__builtin_amdgcn_exp2f(-dl); l_reg*=f; if(hi==0)wsf[r32]=f; resc=true; } } \
    SBAR(); \
    GAPB(o[0]=__builtin_amdgcn_mfma_f32_32x32x16_bf16(PAF(0),VFR(0),o[0],0,0,0), C0,0); \
    GAPB(o[1]=__builtin_amdgcn_mfma_f32_32x32x16_bf16(PAF(0),VFR(4),o[1],0,0,0), C0,4); \
    KRD(GL,0); GAPB(o[0]=__builtin_amdgcn_mfma_f32_32x32x16_bf16(PAF(1),VFR(1),o[0],0,0,0), C0,8); \
    KRD(GL,1); GAPB(o[1]=__builtin_amdgcn_mfma_f32_32x32x16_bf16(PAF(1),VFR(5),o[1],0,0,0), C0,12); \
    KRD(GL,2); GAPB(o[0]=__builtin_amdgcn_mfma_f32_32x32x16_bf16(PAF(2),VFR(2),o[0],0,0,0), C1,0); \
    KRD(GL,3); GAPB(o[1]=__builtin_amdgcn_mfma_f32_32x32x16_bf16(PAF(2),VFR(6),o[1],0,0,0), C1,4); \
    GAPB(o[0]=__builtin_amdgcn_mfma_f32_32x32x16_bf16(PAF(3),VFR(3),o[0],0,0,0), C1,8); \
    GAPB(o[1]=__builtin_amdgcn_mfma_f32_32x32x16_bf16(PAF(3),VFR(7),o[1],0,0,0), C1,12); \
    }while(0)
  int t=1;
  #undef CMASK
  #define CMASK(P0,P1,t) mk.apply(P0,P1,(t),hi)
  for(;t+5<NT;t+=2){
    STEP(pB0,pB1,pA0,pA1,t,true,true,true);     WAIT_BAR(2); RESC(); ROT();
    STEP(pA0,pA1,pB0,pB1,t+1,true,true,true);   WAIT_BAR(2); RESC(); ROT();
  }
  #undef CMASK
  #define CMASK(P0,P1,t) mk.apply(P0,P1,(t),hi)
  #define ENDW(tt) do{ if((tt)+3<NT){WAIT_BAR(2);} else if((tt)+2<NT){WAIT_BAR(1);} else {WAIT_BAR(0);} }while(0)
  for(;t+1<NT;t+=2){
    STEP(pB0,pB1,pA0,pA1,t,(t+3<NT),(t+1<NT),(t+1<NT));       ENDW(t);   RESC(); ROT();
    STEP(pA0,pA1,pB0,pB1,t+1,(t+4<NT),(t+2<NT),(t+2<NT));     ENDW(t+1); RESC(); ROT();
  }
  STEP(pB0,pB1,pA0,pA1,NT-1,false,false,false); RESC();
  { float sacc=pB0[0]+pB0[1]; _Pragma("unroll") for(int r=2;r<16;++r)sacc+=pB0[r]; _Pragma("unroll") for(int r=0;r<16;++r)sacc+=pB1[r]; l_reg+=sacc;
    pw0=(u32x4){PKW(pB0,0),PKW(pB0,2),PKW(pB0,4),PKW(pB0,6)};pw1=(u32x4){PKW(pB0,8),PKW(pB0,10),PKW(pB0,12),PKW(pB0,14)};pw2=(u32x4){PKW(pB1,0),PKW(pB1,2),PKW(pB1,4),PKW(pB1,6)};pw3=(u32x4){PKW(pB1,8),PKW(pB1,10),PKW(pB1,12),PKW(pB1,14)};
    SBAR(); pv(o,vb0+sl_cur,PAF(0),PAF(1),PAF(2),PAF(3)); }
  #undef PKW
  #undef PAF
  #undef VFR
  #undef PIN
  #undef MX3
  #undef GAPA
  #undef GAPB
  #undef EX
  #undef VRD
  #undef KRD
  #undef STEP
  #undef ENDW
  {auto rr=__builtin_amdgcn_permlane32_swap(__float_as_uint(l_reg),__float_as_uint(l_reg),false,false);l_reg=__uint_as_float(rr[0])+__uint_as_float(rr[1]);}
  if(hi==0)wsf[32+r32]=l_reg;asm volatile("s_waitcnt lgkmcnt(0)":::"memory");
  float rli[16];
  #pragma unroll
  for(int r=0;r<16;++r)rli[r]=__builtin_amdgcn_rcpf(wsf[32+crow(r,hi)]);
  bf16*Ow=u.Op+(long)(u.qrow0+wid*QBLK)*OPITCH;
  { bf16*stg=(bf16*)(shm+LDS_OST)+wid*2048;
    #pragma unroll
    for(int r=0;r<16;++r){const int orow=crow(r,hi);
      #pragma unroll
      for(int d0=0;d0<2;++d0)stg[orow*64+d0*32+r32]=__float2bfloat16(o[d0][r]*rli[r]);}
    asm volatile("s_waitcnt lgkmcnt(0)":::"memory");
    #pragma unroll
    for(int i=0;i<4;++i){const int row=i*8+(lane>>3),ch=lane&7; const u32x4 v=*(const u32x4*)(stg+row*64+ch*8); ATTN_STORE16(Ow+(long)row*OPITCH+ch*8,v);} }
  asm volatile("s_waitcnt lgkmcnt(0)\n\ts_barrier":::"memory");
  #undef DMA_K
  #undef TROW
  #undef DMA_V
  #undef CMASK
  #undef START
  #undef RESC
  #undef ROT
}
constexpr int ATTN_LDS_BYTES=LDS_BYTES;
#undef SBAR
#undef WAIT_BAR
}

struct Params { const float* in[26]; float* out; unsigned char* ws; int ph_lo, ph_hi; };
struct Ctx { LAS unsigned char* lds; int tid, lane, wave, vcu, G, gw, NGW; };
enum { I_X = 0, I_C, I_CTX, I_CCTX, I_ADAW, I_ADAB, I_LNG, I_LNB, I_W0IN, I_W0OUT, I_LQ1, I_LK1, I_LQ2, I_LK2, I_SUBLN, I_QN, I_KN,
       I_W1IN, I_W1OUT, I_RPB, I_POOLW, I_POOLS, I_ROUTER, I_WG, I_WU, I_WD };

__device__ __forceinline__ const float* mod_row(const Params& p, int layer, int row) {
    return (const float*)(p.ws + WS_MOD) + (size_t)(layer * 9 + (row < LAT ? (row >> 11) : 8)) * 6144;
}

__device__ __forceinline__ void ph_prologue(const Params& p, const Ctx& c) {
    const float* cin = p.in[I_C]; const float* cctx = p.in[I_CCTX]; const float* ada_w = p.in[I_ADAW]; const float* ada_b = p.in[I_ADAB];
    float* MOD = (float*)(p.ws + WS_MOD);
    LAS float* sc = (LAS float*)c.lds;
    LAS float* red = sc + 9 * 1024;
    for (int i = c.tid; i < 9 * 1024; i += 512) { const float v = i < 8192 ? cin[i] : cctx[i - 8192]; sc[i] = v / (1.f + expf(-v)); }
    __syncthreads();
    for (int u = c.vcu; u < 256; u += c.G) {
        const int layer = u >> 7, j0 = (u & 127) * 48;
        const int jc = c.tid % 48, kg = c.tid / 48;
        if (kg < 10) {
            float acc[9];
#pragma unroll
            for (int m = 0; m < 9; ++m) acc[m] = 0.f;
            const float* wp = ada_w + (size_t)layer * 1024 * 6144 + j0 + jc;
            for (int k = kg; k < 1024; k += 10) {
                const float w = wp[(size_t)k * 6144];
#pragma unroll
                for (int m = 0; m < 9; ++m) acc[m] += sc[m * 1024 + k] * w;
            }
#pragma unroll
            for (int m = 0; m < 9; ++m) red[(kg * 9 + m) * 48 + jc] = acc[m];
        }
        __syncthreads();
        if (c.tid < 432) {
            const int m = c.tid / 48, j = c.tid % 48; float s = 0.f;
#pragma unroll
            for (int g = 0; g < 10; ++g) s += red[(g * 9 + m) * 48 + j];
            MOD[(size_t)(layer * 9 + m) * 6144 + j0 + j] = s + ada_b[layer * 6144 + j0 + j];
        }
        __syncthreads();
    }
    if (c.vcu == 0) {
        f32x2* R = (f32x2*)(p.ws + WS_ROPE);
        for (int i = c.tid; i < 1024; i += 512) {
            const int pos = i >> 4, f = i & 15;
            const float inv = exp2f(-(float)f * (13.287712379549449f / 16.f));
            const float a = (float)pos * inv;
            const float k = rintf(a * 0.15915494309189535f);
            float rr = fmaf(-k, 6.28125f, a); rr = fmaf(-k, 1.9353071795864769e-3f, rr);
            R[i] = (f32x2){__cosf(rr), __sinf(rr)};
        }
    }
}


__device__ __forceinline__ void transpose_item(const float* W, int ldw, int k0, int n0, bf16* WT, int Kd, int drow0, LAS float* scr, int lane) {
#pragma unroll 8
    for (int i = 0; i < 32; ++i) { const int kk = 2 * i + (lane >> 5); scr[kk * 33 + (lane & 31)] = W[(size_t)(k0 + kk) * ldw + n0 + (lane & 31)]; }
    asm volatile("s_waitcnt lgkmcnt(0)" ::: "memory");
    const int ch = lane & 7;
#pragma unroll
    for (int j = 0; j < 4; ++j) { const int n = (lane >> 3) + 8 * j; const LAS float* sp = scr + (8 * ch) * 33 + n;
        v4u o; o.x = pk2(sp[0 * 33], sp[1 * 33]); o.y = pk2(sp[2 * 33], sp[3 * 33]); o.z = pk2(sp[4 * 33], sp[5 * 33]); o.w = pk2(sp[6 * 33], sp[7 * 33]);
        *(v4u*)(WT + (size_t)(drow0 + n) * Kd + k0 + 8 * ch) = o; }
    asm volatile("s_waitcnt lgkmcnt(0)" ::: "memory");
}
__device__ __forceinline__ void ph_transposes(const Params& p, const Ctx& c) {
    LAS float* scr = (LAS float*)(c.lds + c.wave * 16384);
    constexpr int I0 = 16 * 72, I1 = 16 * 32, I2 = 16 * 64, I3 = 16 * 32, ISM = I0 + I1 + I2 + I3, IEX = 3072, NIT = ISM + 32 * IEX;
    for (int it = c.gw; it < NIT; it += c.NGW) {
        int r = it;
        if (r < I0) { transpose_item(p.in[I_W0IN], EIN, 64 * (r / 72), 32 * (r % 72), (bf16*)(p.ws + WS_W0IN), DM, 32 * (r % 72), scr, c.lane); continue; } r -= I0;
        if (r < I1) { transpose_item(p.in[I_W0OUT], DM, 64 * (r / 32), 32 * (r % 32), (bf16*)(p.ws + WS_W0OUT), DM, 32 * (r % 32), scr, c.lane); continue; } r -= I1;
        if (r < I2) { transpose_item(p.in[I_W1IN], OIN, 64 * (r / 64), 32 * (r % 64), (bf16*)(p.ws + WS_W1IN), DM, 32 * (r % 64), scr, c.lane); continue; } r -= I2;
        if (r < I3) { transpose_item(p.in[I_W1OUT], DM, 64 * (r / 32), 32 * (r % 32), (bf16*)(p.ws + WS_W1OUT), DM, 32 * (r % 32), scr, c.lane); continue; } r -= I3;
        const int ie = r / IEX, q = r - ie * IEX, layer = ie >> 4, e = ie & 15, which = q >> 10, idx = q & 1023;
        if (which < 2) {
            const float* W = (which == 0 ? p.in[I_WG] : p.in[I_WU]) + (size_t)ie * DM * FF;
            const int k0 = 64 * (idx >> 6), n0 = 32 * (idx & 63);
            bf16* WT = (bf16*)(p.ws + WS_WGU + (size_t)layer * WS_MOE_LSTRIDE) + (size_t)e * 4096 * DM;
            transpose_item(W, FF, k0, n0, WT, DM, (n0 >> 7) * 256 + (n0 & 127) + which * 128, scr, c.lane);
        } else {
            const float* W = p.in[I_WD] + (size_t)ie * FF * DM;
            const int k0 = 64 * (idx >> 5), n0 = 32 * (idx & 31);
            bf16* WT = (bf16*)(p.ws + WS_WDN + (size_t)layer * WS_MOE_LSTRIDE) + (size_t)e * DM * FF;
            transpose_item(W, DM, k0, n0, WT, FF, n0, scr, c.lane);
        }
    }
}

__device__ __forceinline__ void ph_modulate0(const Params& p, const Ctx& c) {
    bf16* HB = (bf16*)(p.ws + WS_HB);
    for (int row = c.gw; row < NTOK; row += c.NGW) {
        const float* src = row < LAT ? p.in[I_X] + (size_t)row * DM : p.in[I_CTX] + (size_t)(row - LAT) * DM;
        const float* mod = mod_row(p, 0, row);
#pragma unroll
        for (int j = 0; j < 4; ++j) {
            const int col = 4 * c.lane + 256 * j;
            const f32x4 v = *(const f32x4*)(src + col), sh = *(const f32x4*)(mod + col), s = *(const f32x4*)(mod + 1024 + col);
            const f32x4 h = v * (s + 1.f) + sh;
            *(v2u*)(HB + (size_t)row * DM + col) = (v2u){pk2(h.x, h.y), pk2(h.z, h.w)};
        }
    }
}

struct NG { const bf16* A; int lda; const float* W0; const float* W1; int ldw; size_t wstride; int Mb; int row_begin, row_end, col_begin, col_end, K; };
template <int NB, class Epi>
__device__ __forceinline__ void ngemm(const NG& g, const Ctx& c, const Epi& epi) {
    const int nmt = (g.row_end - g.row_begin) / 32, nnt = (g.col_end - g.col_begin) / 32;
    const int l31 = c.lane & 31, lh = c.lane >> 5;
    for (int t = c.gw; t < nmt * nnt; t += c.NGW) {
        const int mt = t / nnt, nt = t % nnt;
        const int row0 = g.row_begin + mt * 32, col0 = g.col_begin + nt * 32;
        const int e = row0 / g.Mb;
        const bf16* ap = g.A + (size_t)(row0 + l31) * g.lda + lh;
        const float* bp0 = g.W0 + (size_t)e * g.wstride + (size_t)lh * g.ldw + col0 + l31;
        const float* bp1 = NB == 2 ? g.W1 + (size_t)e * g.wstride + (size_t)lh * g.ldw + col0 + l31 : nullptr;
        f32x16 acc0 = {}, acc1 = {};
#pragma unroll 8
        for (int k = 0; k < g.K; k += 2) {
            const float a = bf2f((unsigned)ap[k]);
            const float b0 = bp0[(size_t)k * g.ldw];
            acc0 = __builtin_amdgcn_mfma_f32_32x32x2f32(a, b0, acc0, 0, 0, 0);
            if (NB == 2) { const float b1 = bp1[(size_t)k * g.ldw]; acc1 = __builtin_amdgcn_mfma_f32_32x32x2f32(a, b1, acc1, 0, 0, 0); }
        }
#pragma unroll
        for (int r = 0; r < 16; ++r) {
            const int row = row0 + (r & 3) + 8 * (r >> 2) + 4 * lh, col = col0 + l31;
            epi(row, col, acc0[r], acc1[r]);
        }
    }
}
struct EpiF32 { float* O; int ldc; __device__ __forceinline__ void operator()(int row, int col, float v0, float) const { O[(size_t)row * ldc + col] = v0; } };
struct EpiBf { bf16* O; int ldc; int scale_cols; float sc; __device__ __forceinline__ void operator()(int row, int col, float v0, float) const { O[(size_t)row * ldc + col] = (bf16)f2bf(col < scale_cols ? v0 * sc : v0); } };
struct EpiSwiglu { bf16* O; __device__ __forceinline__ void operator()(int row, int col, float g, float u) const { const float s = g / (1.f + __expf(-g)); O[(size_t)row * FF + col] = (bf16)f2bf(s * u); } };
struct EpiGate { bf16* O; const float* gate; __device__ __forceinline__ void operator()(int row, int col, float v0, float) const { O[(size_t)row * DM + col] = (bf16)f2bf(v0 * gate[row]); } };

template <bool F32IN> __device__ __forceinline__ void ph_qkv_post(const Params& p, const Ctx& c) {
    const float* PF = (const float*)(p.ws + WS_PF);
    bf16* QKV = (bf16*)(p.ws + WS_QKV);
    const f32x2* R = (const f32x2*)(p.ws + WS_ROPE);
    const float* qn = p.in[I_QN]; const float* kn = p.in[I_KN];
    const int d = c.lane;
    const float qg = qn[d], kg = kn[d];
    for (int row = c.gw; row < NTOK; row += c.NGW) {
        const bool lat = row < LAT;
        const int t = row & 2047;
        const int pos = (d < 32) ? (t >> 6) : (t & 63);
        const f32x2 cs = R[pos * 16 + (d & 15)];
        const bool first = (d & 16) == 0;
        for (int hs = 0; hs < 36; ++hs) {
            float v = F32IN ? PF[(size_t)row * EIN + hs * 64 + d] : bf2f((unsigned)QKV[(size_t)row * EIN + hs * 64 + d]);
            const bool isq = hs < 8 || (hs >= 24 && hs < 32);
            const bool isk = (hs >= 8 && hs < 16) || hs == 32 || hs == 33;
            const bool nrm = hs >= 24 && hs < 34;
            if (nrm) { const float ss = wave_sum(v * v); v = v * rsqrtf(ss * (1.f / 64.f) + RMS_EPS) * (hs < 32 ? qg : kg); }
            if ((isq || isk) && lat) { const float pr = __shfl_xor(v, 16); v = first ? v * cs.x - pr * cs.y : v * cs.x + pr * cs.y; }
            if (isq) v *= C2;
            QKV[(size_t)row * EIN + hs * 64 + d] = (bf16)f2bf(v);
        }
    }
}

__device__ __forceinline__ void ph_attn0_naive(const Params& p, const Ctx& c) {
    const bf16* QKV = (const bf16*)(p.ws + WS_QKV);
    bf16* CC = (bf16*)(p.ws + WS_CC);
    bf16* AO = (bf16*)(p.ws + WS_AO);
    LAS float* Ks = (LAS float*)c.lds;
    LAS float* Vs = Ks + 4096;
    for (int u = c.vcu; u < 960; u += c.G) {
        const bool isctx = u >= 768;
        int b, vh, qrow, ntiles; bool active = true;
        if (!isctx) { b = u / 96; const int r = u % 96; vh = r >> 2; qrow = b * SEQ + (r & 3) * 512 + c.tid; ntiles = 36; }
        else { const int uu = u - 768; b = uu / 24; vh = uu % 24; qrow = LAT + b * NCTX + (c.tid & 255); active = c.tid < 256; ntiles = 4; }
        int qcol, kcol, vcol;
        if (vh < 16) { const int a = vh >> 2, s = (vh >> 1) & 1, half = vh & 1; qcol = a * 128 + s * 64; kcol = 512 + a * 128 + s * 64; vcol = 1024 + a * 128 + half * 64; }
        else { const int h = vh - 16; qcol = 1536 + h * 64; kcol = 2048 + (h >> 2) * 64; vcol = 2176 + (h >> 2) * 64; }
        float q[64], o[64];
#pragma unroll
        for (int i = 0; i < 8; ++i) { const v4u w = *(const v4u*)(QKV + (size_t)qrow * EIN + qcol + 8 * i); unpack8(w, q + 8 * i); }
#pragma unroll
        for (int i = 0; i < 64; ++i) o[i] = 0.f;
        float m = -1e30f, l = 0.f;
        for (int t = 0; t < ntiles; ++t) {
            const int krow0 = isctx ? LAT + b * NCTX + 64 * t : (t < 32 ? b * SEQ + 64 * t : LAT + b * NCTX + 64 * (t - 32));
            __syncthreads();
            { const int r = c.tid >> 3, ch = c.tid & 7; float f[8];
              const v4u kw = *(const v4u*)(QKV + (size_t)(krow0 + r) * EIN + kcol + ch * 8); unpack8(kw, f);
#pragma unroll
              for (int j = 0; j < 8; ++j) Ks[r * 64 + ch * 8 + j] = f[j];
              const v4u vw = *(const v4u*)(QKV + (size_t)(krow0 + r) * EIN + vcol + ch * 8); unpack8(vw, f);
#pragma unroll
              for (int j = 0; j < 8; ++j) Vs[r * 64 + ch * 8 + j] = f[j]; }
            __syncthreads();
            if (active) {
                for (int kk = 0; kk < 64; ++kk) {
                    float s = 0.f;
#pragma unroll
                    for (int dd = 0; dd < 64; ++dd) s += q[dd] * Ks[kk * 64 + dd];
                    const float mn = fmaxf(m, s), al = exp2f(m - mn), pp = exp2f(s - mn);
                    l = l * al + pp; m = mn;
#pragma unroll
                    for (int dd = 0; dd < 64; ++dd) o[dd] = o[dd] * al + pp * Vs[kk * 64 + dd];
                }
            }
        }
        if (active) {
            const float rl = 1.f / l;
            bf16* dst = vh < 16 ? AO + (size_t)qrow * DM + (vh >> 2) * 256 + ((vh >> 1) & 1) * 128 + (vh & 1) * 64 : CC + (size_t)qrow * DM + 512 + (vh - 16) * 64;
            {
#pragma unroll
                for (int i = 0; i < 8; ++i) *(v4u*)(dst + 8 * i) = (v4u){pk2(o[8 * i] * rl, o[8 * i + 1] * rl), pk2(o[8 * i + 2] * rl, o[8 * i + 3] * rl), pk2(o[8 * i + 4] * rl, o[8 * i + 5] * rl), pk2(o[8 * i + 6] * rl, o[8 * i + 7] * rl)}; }
        }
    }
}


__device__ __forceinline__ void ph_attn0_fast(const Params& p, const Ctx& c, char* lds_generic) {
    typedef attn_body::bf16 abf;
    const abf* Q = (const abf*)(p.ws + WS_QKV); abf* CCb = (abf*)(p.ws + WS_CC); abf* AOb = (abf*)(p.ws + WS_AO);
    for (int i = 0;; ++i) {
        const int U = i * c.G + c.vcu;
        if (U >= 1536 + 192) break;
        attn_body::AU u; int vh;
        if (U < 1536) { const int b = U / 192, rem = U - b * 192; vh = rem >> 3; u.qrow0 = b * SEQ + (rem & 7) * 256; u.lat_row0 = b * SEQ; u.ctx_row0 = LAT + b * NCTX; u.nlat_t = 32; u.NT = 36; }
        else { const int uu = U - 1536, b = uu / 24; vh = uu - b * 24; u.qrow0 = LAT + b * NCTX; u.lat_row0 = 0; u.ctx_row0 = LAT + b * NCTX; u.nlat_t = 0; u.NT = 4; }
        int qcol, kcol, vcol; abf* op;
        if (vh < 16) { const int a = vh >> 2, s = (vh >> 1) & 1, half = vh & 1; qcol = a * 128 + s * 64; kcol = 512 + a * 128 + s * 64; vcol = 1024 + a * 128 + half * 64; op = AOb + a * 256 + s * 128 + half * 64; }
        else { const int h = vh - 16; qcol = 1536 + h * 64; kcol = 2048 + (h >> 2) * 64; vcol = 2176 + (h >> 2) * 64; op = CCb + 512 + h * 64; }
        u.Qp = Q + qcol; u.Kp = Q + kcol; u.Vp = Q + vcol; u.Op = op;
        attn_body::attn_unit<8, EIN, attn_body::NoMask>(u, lds_generic, attn_body::NoMask{});
    }
}

__device__ __forceinline__ void ph_attn_combine(const Params& p, const Ctx& c) {
    const bf16* AO = (const bf16*)(p.ws + WS_AO);
    bf16* CC = (bf16*)(p.ws + WS_CC);
    const float d1 = wave_sum(p.in[I_LQ1][c.lane] * p.in[I_LK1][c.lane]);
    const float d2 = wave_sum(p.in[I_LQ2][c.lane] * p.in[I_LK2][c.lane]);
    const float lam = expf(d1) - expf(d2) + LAM_INIT;
    const float g0 = p.in[I_SUBLN][c.lane] * (1.f - LAM_INIT), g1 = p.in[I_SUBLN][c.lane + 64] * (1.f - LAM_INIT);
    for (int it = c.gw; it < NTOK * 4; it += c.NGW) {
        const int row = it >> 2, a = it & 3;
        const bf16* src = AO + (size_t)row * DM + a * 256;
        const float x0 = bf2f((unsigned)src[c.lane]) - lam * bf2f((unsigned)src[128 + c.lane]), x1 = bf2f((unsigned)src[64 + c.lane]) - lam * bf2f((unsigned)src[192 + c.lane]);
        const float ss = wave_sum(x0 * x0 + x1 * x1);
        const float r = rsqrtf(ss * (1.f / 128.f) + RMS_EPS);
        CC[(size_t)row * DM + a * 128 + c.lane] = (bf16)f2bf(x0 * r * g0);
        CC[(size_t)row * DM + a * 128 + 64 + c.lane] = (bf16)f2bf(x1 * r * g1);
    }
}

__device__ __forceinline__ void ph_ln1_router(const Params& p, const Ctx& c, int layer) {
    const float* Y = (const float*)(p.ws + WS_Y);
    float* XS = (float*)(p.ws + WS_XS);
    bf16* HB = (bf16*)(p.ws + WS_HB);
    float* AFF = (float*)(p.ws + WS_AFF);
    const float* lng = p.in[I_LNG] + (size_t)(layer * 2 + 0) * DM; const float* lnb = p.in[I_LNB] + (size_t)(layer * 2 + 0) * DM;
    const float* router = p.in[I_ROUTER] + (size_t)layer * DM * NE;
    LAS f32x4* R = (LAS f32x4*)c.lds;
    for (int idx = c.tid; idx < 4096; idx += 512) { const int e4 = idx & 3, k = idx >> 2, ln = (k & 255) >> 2, q = k & 3, j = k >> 8;
        R[((j * 4 + q) * 4 + e4) * 64 + ln] = *(const f32x4*)(router + (size_t)k * NE + 4 * e4); }
    __syncthreads();
    const int nrows = layer == 0 ? NTOK : LAT;
    const int lane = c.lane;
    for (int row = c.gw; row < nrows; row += c.NGW) {
        const float* xin = layer == 0 ? (row < LAT ? p.in[I_X] + (size_t)row * DM : p.in[I_CTX] + (size_t)(row - LAT) * DM) : XS + (size_t)row * DM;
        const float* mod = mod_row(p, layer, row);
        f32x4 v[4]; float s = 0.f;
#pragma unroll
        for (int j = 0; j < 4; ++j) { const int col = 4 * lane + 256 * j;
            v[j] = *(const f32x4*)(xin + col) * ALPHA + *(const f32x4*)(mod + 2048 + col) * *(const f32x4*)(Y + (size_t)row * DM + col);
            s += (v[j].x + v[j].y) + (v[j].z + v[j].w); }
        const float mean = wave_sum(s) * (1.f / DM); float s2 = 0.f;
#pragma unroll
        for (int j = 0; j < 4; ++j) { v[j] = v[j] - mean; s2 += (v[j].x * v[j].x + v[j].y * v[j].y) + (v[j].z * v[j].z + v[j].w * v[j].w); }
        const float rstd = 1.f / sqrtf(wave_sum(s2) * (1.f / DM) + LN_EPS);
        f32x4 lg[4];
#pragma unroll
        for (int e = 0; e < 4; ++e) lg[e] = (f32x4){0.f, 0.f, 0.f, 0.f};
#pragma unroll
        for (int j = 0; j < 4; ++j) { const int col = 4 * lane + 256 * j;
            const f32x4 x1 = v[j] * rstd * *(const f32x4*)(lng + col) + *(const f32x4*)(lnb + col);
            *(f32x4*)(XS + (size_t)row * DM + col) = x1;
            const f32x4 hm = x1 * (*(const f32x4*)(mod + 4096 + col) + 1.f) + *(const f32x4*)(mod + 3072 + col);
            *(v2u*)(HB + (size_t)row * DM + col) = (v2u){pk2(hm.x, hm.y), pk2(hm.z, hm.w)};
            asm volatile("" ::: "memory");
#pragma unroll
            for (int q = 0; q < 4; ++q) { const float hv = hm[q];
#pragma unroll
                for (int e4 = 0; e4 < 4; ++e4) lg[e4] += R[((j * 4 + q) * 4 + e4) * 64 + lane] * hv; } }
        float w8[8], w4[4], w2[2], w1;
        { const bool hi = (lane & 32) != 0;
#pragma unroll
          for (int i = 0; i < 8; ++i) { const float a0 = lg[i >> 2][i & 3], a1 = lg[2 + (i >> 2)][i & 3]; const float keep = hi ? a1 : a0, send = hi ? a0 : a1; w8[i] = keep + __shfl_xor(send, 32); } }
        { const bool hi = (lane & 16) != 0;
#pragma unroll
          for (int i = 0; i < 4; ++i) { const float keep = hi ? w8[i + 4] : w8[i], send = hi ? w8[i] : w8[i + 4]; w4[i] = keep + __shfl_xor(send, 16); } }
        { const bool hi = (lane & 8) != 0;
#pragma unroll
          for (int i = 0; i < 2; ++i) { const float keep = hi ? w4[i + 2] : w4[i], send = hi ? w4[i] : w4[i + 2]; w2[i] = keep + __shfl_xor(send, 8); } }
        { const bool hi = (lane & 4) != 0; const float keep = hi ? w2[1] : w2[0], send = hi ? w2[0] : w2[1]; w1 = keep + __shfl_xor(send, 4); }
        w1 += __shfl_xor(w1, 2); w1 += __shfl_xor(w1, 1);
        float mx = w1;
#pragma unroll
        for (int o = 4; o < 64; o <<= 1) mx = fmaxf(mx, __shfl_xor(mx, o));
        const float ex = expf(w1 - mx); float den = ex;
#pragma unroll
        for (int o = 4; o < 64; o <<= 1) den += __shfl_xor(den, o);
        if ((lane & 3) == 0) { const int e = ((lane >> 5) & 1) * 8 + ((lane >> 4) & 1) * 4 + ((lane >> 3) & 1) * 2 + ((lane >> 2) & 1); AFF[(size_t)row * NE + e] = ex / den; }
    }
}

__device__ __forceinline__ void ph_topk(const Params& p, const Ctx& c, int layer) {
    const float* AFF = (const float*)(p.ws + WS_AFF);
    int* INV = (int*)(p.ws + WS_INV);
    float* GATE = (float*)(p.ws + WS_GATE);
    const bf16* HB = (const bf16*)(p.ws + WS_HB);
    bf16* XG = (bf16*)(p.ws + WS_XG);
    LAS unsigned* hist = (LAS unsigned*)c.lds;
    LAS unsigned* ctl = hist + 256;
    LAS int* sel = (LAS int*)(c.lds + 2048);
    const int MR = layer == 0 ? MR0 : MR1;
    const int ntasks = layer == 0 ? 256 : 128;
    const int lane = c.lane;
    for (int task = c.vcu; task < ntasks; task += c.G) {
        int set, e, n, cap, rowbase, slotbase;
        if (task < 128) { set = task >> 4; e = task & 15; n = SEQ; cap = 256; rowbase = set * SEQ; slotbase = set * 256; }
        else { const int t2 = task - 128; set = t2 >> 4; e = t2 & 15; n = NCTX; cap = 32; rowbase = LAT + set * NCTX; slotbase = 2048 + set * 32; }
        const bool valid = 4 * c.tid < n;
        unsigned key[4];
#pragma unroll
        for (int q = 0; q < 4; ++q) key[q] = valid ? __float_as_uint(AFF[(size_t)(rowbase + 4 * c.tid + q) * NE + e]) : 0u;
        unsigned prefix = 0u, need = (unsigned)cap;
#pragma unroll 1
        for (int pass = 0; pass < 4; ++pass) {
            const int shift = 24 - 8 * pass;
            if (c.tid < 256) hist[c.tid] = 0u;
            __syncthreads();
            if (valid) {
#pragma unroll
                for (int q = 0; q < 4; ++q) if (pass == 0 || (key[q] >> (shift + 8)) == (prefix >> (shift + 8))) __hip_atomic_fetch_add(&hist[(key[q] >> shift) & 255u], 1u, __ATOMIC_RELAXED, __HIP_MEMORY_SCOPE_WORKGROUP);
            }
            __syncthreads();
            if (c.wave == 0) {
                const unsigned h0 = hist[4 * lane], h1 = hist[4 * lane + 1], h2 = hist[4 * lane + 2], h3 = hist[4 * lane + 3];
                const unsigned tot = h0 + h1 + h2 + h3; unsigned sfx = tot;
#pragma unroll
                for (int o = 1; o < 64; o <<= 1) { const unsigned t = __shfl_down(sfx, o); if (lane + o < 64) sfx += t; }
                const unsigned above = sfx - tot, c3 = above + h3, c2 = c3 + h2, c1 = c2 + h1, c0 = c1 + h0;
                int d = -1; unsigned gtc = 0u;
                if (above < need && need <= c3) { d = 3; gtc = above; }
                else if (c3 < need && need <= c2) { d = 2; gtc = c3; }
                else if (c2 < need && need <= c1) { d = 1; gtc = c2; }
                else if (c1 < need && need <= c0) { d = 0; gtc = c1; }
                if (d >= 0) { ctl[0] = prefix | ((unsigned)(4 * lane + d) << shift); ctl[1] = need - gtc; }
            }
            __syncthreads();
            prefix = ctl[0]; need = ctl[1];
        }
        unsigned ngt = 0u, neq = 0u;
#pragma unroll
        for (int q = 0; q < 4; ++q) { ngt += (valid && key[q] > prefix) ? 1u : 0u; neq += (valid && key[q] == prefix) ? 1u : 0u; }
        const unsigned cnt = ngt | (neq << 16); unsigned inc = cnt;
#pragma unroll
        for (int o = 1; o < 64; o <<= 1) { const unsigned t = __shfl_up(inc, o); if (lane >= o) inc += t; }
        if (lane == 63) ctl[8 + c.wave] = inc;
        __syncthreads();
        unsigned base = 0u;
#pragma unroll
        for (int w = 0; w < 8; ++w) base += (w < c.wave) ? ctl[8 + w] : 0u;
        const unsigned ex = base + inc - cnt; unsigned gtb = ex & 0xffffu, eqb = ex >> 16;
        if (valid) {
#pragma unroll
            for (int q = 0; q < 4; ++q) { const int i = 4 * c.tid + q; int slot = -1;
                if (key[q] > prefix) { slot = (int)(gtb + (eqb < need ? eqb : need)); ++gtb; }
                else if (key[q] == prefix) { if (eqb < need) slot = (int)(gtb + eqb); ++eqb; }
                int gs = -1;
                if (slot >= 0) { gs = e * MR + slotbase + slot; sel[slot] = i; GATE[gs] = __uint_as_float(key[q]); }
                INV[(size_t)(rowbase + i) * NE + e] = gs; }
        }
        __syncthreads();
        for (int sidx = c.wave; sidx < cap; sidx += 8) {
            const bf16* src = HB + (size_t)(rowbase + sel[sidx]) * DM; bf16* dst = XG + (size_t)(e * MR + slotbase + sidx) * DM;
            const v4u a0 = *(const v4u*)(src + 8 * lane), a1 = *(const v4u*)(src + 512 + 8 * lane);
            *(v4u*)(dst + 8 * lane) = a0; *(v4u*)(dst + 512 + 8 * lane) = a1;
        }
        __syncthreads();
    }
}

__device__ __forceinline__ void ph_combine(const Params& p, const Ctx& c, int layer) {
    const bf16* YS = (const bf16*)(p.ws + WS_YS);
    const int* INV = (const int*)(p.ws + WS_INV);
    float* XS = (float*)(p.ws + WS_XS);
    bf16* HB = (bf16*)(p.ws + WS_HB);
    const float* lng = p.in[I_LNG] + (size_t)(layer * 2 + 1) * DM; const float* lnb = p.in[I_LNB] + (size_t)(layer * 2 + 1) * DM;
    const int nrows = layer == 0 ? NTOK : LAT;
    for (int row = c.gw; row < nrows; row += c.NGW) {
        const float* mod = mod_row(p, layer, row);
        f32x4 mo[4];
#pragma unroll
        for (int j = 0; j < 4; ++j) mo[j] = (f32x4){0.f, 0.f, 0.f, 0.f};
        const int inv = (c.lane < NE) ? INV[(size_t)row * NE + c.lane] : -1;
        unsigned long long msk = __ballot(inv >= 0);
        while (msk) {
            const int e = __builtin_ctzll(msk); msk &= msk - 1;
            const int sl = __builtin_amdgcn_readlane(inv, e);
#pragma unroll
            for (int j = 0; j < 4; ++j) { const v2u w = *(const v2u*)(YS + (size_t)sl * DM + 4 * c.lane + 256 * j);
                mo[j].x += bf2f(w.x & 0xffffu); mo[j].y += __uint_as_float(w.x & 0xffff0000u); mo[j].z += bf2f(w.y & 0xffffu); mo[j].w += __uint_as_float(w.y & 0xffff0000u); }
        }
        f32x4 v[4]; float s = 0.f;
#pragma unroll
        for (int j = 0; j < 4; ++j) { const int col = 4 * c.lane + 256 * j;
            v[j] = *(const f32x4*)(XS + (size_t)row * DM + col) * ALPHA + *(const f32x4*)(mod + 5120 + col) * mo[j];
            s += (v[j].x + v[j].y) + (v[j].z + v[j].w); }
        const float mean = wave_sum(s) * (1.f / DM); float s2 = 0.f;
#pragma unroll
        for (int j = 0; j < 4; ++j) { v[j] = v[j] - mean; s2 += (v[j].x * v[j].x + v[j].y * v[j].y) + (v[j].z * v[j].z + v[j].w * v[j].w); }
        const float rstd = 1.f / sqrtf(wave_sum(s2) * (1.f / DM) + LN_EPS);
        const float* modn = mod_row(p, 1, row);
#pragma unroll
        for (int j = 0; j < 4; ++j) { const int col = 4 * c.lane + 256 * j;
            const f32x4 x2 = v[j] * rstd * *(const f32x4*)(lng + col) + *(const f32x4*)(lnb + col);
            if (layer == 0) {
                *(f32x4*)(XS + (size_t)row * DM + col) = x2;
                const f32x4 h = x2 * (*(const f32x4*)(modn + 1024 + col) + 1.f) + *(const f32x4*)(modn + col);
                *(v2u*)(HB + (size_t)row * DM + col) = (v2u){pk2(h.x, h.y), pk2(h.z, h.w)};
            } else {
                *(f32x4*)(p.out + (size_t)row * DM + col) = x2;
            } }
    }
}

__device__ __forceinline__ void na_key(const float* q, float* o, float& m, float& l, const bf16* kp, const bf16* vp, float bias) {
    float s = bias;
#pragma unroll
    for (int i = 0; i < 8; ++i) { float f[8]; unpack8(*(const v4u*)(kp + 8 * i), f);
#pragma unroll
        for (int j = 0; j < 8; ++j) s += q[8 * i + j] * f[j]; }
    const float mn = fmaxf(m, s), al = exp2f(m - mn), pp = exp2f(s - mn);
    l = l * al + pp; m = mn;
#pragma unroll
    for (int i = 0; i < 8; ++i) { float f[8]; unpack8(*(const v4u*)(vp + 8 * i), f);
#pragma unroll
        for (int j = 0; j < 8; ++j) o[8 * i + j] = o[8 * i + j] * al + pp * f[j]; }
}
__device__ __forceinline__ void ph_mixer1_naive(const Params& p, const Ctx& c) {
    const bf16* P2 = (const bf16*)(p.ws + WS_QKV);
    bf16* CC = (bf16*)(p.ws + WS_CC);
    const float* rpb = p.in[I_RPB]; const float* pool_w = p.in[I_POOLW]; const float* pool_s = p.in[I_POOLS];
    LAS float* pl = (LAS float*)c.lds;
    for (int u = c.vcu; u < 256; u += c.G) {
        const int b = u >> 5, r = u & 31;
        {
            const int h = c.wave, col = c.lane, row = b * SEQ + r * 64 + col;
            const int rs = min(max(r - 4, 0), 24), cs = min(max(col - 8, 0), 48);
            float q[64], o[64];
#pragma unroll
            for (int i = 0; i < 8; ++i) unpack8(*(const v4u*)(P2 + (size_t)row * OIN + h * 64 + 8 * i), q + 8 * i);
#pragma unroll
            for (int i = 0; i < 64; ++i) o[i] = 0.f;
            float m = -1e30f, l = 0.f;
#pragma unroll 1
            for (int i = 0; i < 8; ++i)
#pragma unroll 1
                for (int j = 0; j < 16; ++j) {
                    const int krow = b * SEQ + (rs + i) * 64 + cs + j;
                    const float bias = rpb[(h * 15 + (rs + i - r + 7)) * 31 + (cs + j - col + 15)] * LOG2E;
                    na_key(q, o, m, l, P2 + (size_t)krow * OIN + 512 + h * 64, P2 + (size_t)krow * OIN + 1024 + h * 64, bias);
                }
#pragma unroll 1
            for (int j = 0; j < NCTX; ++j) {
                const int krow = LAT + b * NCTX + j;
                na_key(q, o, m, l, P2 + (size_t)krow * OIN + 512 + h * 64, P2 + (size_t)krow * OIN + 1024 + h * 64, 0.f);
            }
            const float rl = 1.f / l; bf16* dst = CC + (size_t)row * DM + h * 64;
#pragma unroll
            for (int i = 0; i < 8; ++i) *(v4u*)(dst + 8 * i) = (v4u){pk2(o[8 * i] * rl, o[8 * i + 1] * rl), pk2(o[8 * i + 2] * rl, o[8 * i + 3] * rl), pk2(o[8 * i + 4] * rl, o[8 * i + 5] * rl), pk2(o[8 * i + 6] * rl, o[8 * i + 7] * rl)};
        }
        __syncthreads();
        {
            const int ch = c.tid, g = ch >> 7, half = 1 << g;
            for (int tt = 0; tt < 64; ++tt) {
                const int t = r * 64 + tt, lo = max(t - half, 0), hi = min(t + half, SEQ);
                float s = 0.f;
                for (int t2 = lo; t2 < hi; ++t2) s += bf2f((unsigned)P2[(size_t)(b * SEQ + t2) * OIN + 1536 + ch]);
                pl[tt * 512 + ch] = s / (float)(hi - lo) - bf2f((unsigned)P2[(size_t)(b * SEQ + t) * OIN + 1536 + ch]);
            }
        }
        __syncthreads();
        {
            const int g = c.tid >> 7, e = c.tid & 127;
            const float ps = pool_s[g * 128 + e];
#pragma unroll 1
            for (int tb = 0; tb < 64; tb += 16) {
                float acc[16];
#pragma unroll
                for (int i = 0; i < 16; ++i) acc[i] = 0.f;
#pragma unroll 4
                for (int cc = 0; cc < 128; ++cc) {
                    const float w = pool_w[(size_t)(g * 128 + cc) * 128 + e];
#pragma unroll
                    for (int i = 0; i < 16; ++i) acc[i] += pl[(tb + i) * 512 + g * 128 + cc] * w;
                }
#pragma unroll
                for (int i = 0; i < 16; ++i) CC[(size_t)(b * SEQ + r * 64 + tb + i) * DM + 512 + g * 128 + e] = (bf16)f2bf(acc[i] * ps);
            }
        }
        __syncthreads();
    }
}


constexpr int NA_TAB_OFF = 86016 + 1024;
__device__ __forceinline__ void ph_mixer1_fast(const Params& p, const Ctx& c, char* lds_generic) {
    typedef attn_body::bf16 abf;
    const abf* P2a = (const abf*)(p.ws + WS_QKV); abf* CCa = (abf*)(p.ws + WS_CC);
    LAS float* tab = (LAS float*)(c.lds + NA_TAB_OFF);
    for (int i = c.tid; i < 8 * 15 * 32; i += 512) { const int hd = i >> 5, j = i & 31; tab[i] = j < 31 ? p.in[I_RPB][hd * 31 + j] * LOG2E : 0.f; }
    __syncthreads();
    for (int it = 0;; ++it) {
        const int U = it * c.G + c.vcu;
        if (U >= 512) break;
        const int b = U >> 6, h = (U >> 3) & 7, rq = U & 7;
        const int rs_min = min(max(4 * rq - 4, 0), 24);
        const int nloc = (rq == 0 || rq == 7) ? 8 : 12;
        attn_body::AU u;
        u.qrow0 = b * SEQ + rq * 256; u.lat_row0 = LAT + b * NCTX; u.nlat_t = 4; u.ctx_row0 = b * SEQ + rs_min * 64; u.NT = 4 + nloc;
        u.Qp = P2a + h * 64; u.Kp = P2a + 512 + h * 64; u.Vp = P2a + 1024 + h * 64; u.Op = CCa + h * 64;
        const int r = 4 * rq + (c.wave >> 1), col = (c.wave & 1) * 32 + (c.lane & 31), hi = c.lane >> 5;
        const int cs = min(max(col - 8, 0), 48);
        attn_body::NAMask mk; mk.tb0 = (attn_body::lds_cfptr)(tab + h * 15 * 32 + 15 - col); mk.r = r; mk.rs = min(max(r - 4, 0), 24); mk.rs_min = rs_min; mk.cb = 4 * hi - cs;
        attn_body::attn_unit<8, OIN, attn_body::NAMask>(u, lds_generic, mk);
    }
    __syncthreads();
    const bf16* P2 = (const bf16*)(p.ws + WS_QKV); bf16* CC = (bf16*)(p.ws + WS_CC);
    const float* pool_w = p.in[I_POOLW]; const float* pool_s = p.in[I_POOLS];
    LAS float* pl = (LAS float*)c.lds;
    for (int u = c.vcu; u < 256; u += c.G) {
        const int b = u >> 5, r = u & 31;
        {
            const int ch = c.tid, g = ch >> 7, half = 1 << g;
            const bf16* du = P2 + (size_t)b * SEQ * OIN + 1536 + ch;
            const int t0 = r * 64;
            float ws = 0.f;
            for (int t2 = max(t0 - half, 0); t2 < min(t0 + half, SEQ); ++t2) ws += bf2f((unsigned)du[(size_t)t2 * OIN]);
            for (int tt = 0; tt < 64; ++tt) {
                const int t = t0 + tt, lo = max(t - half, 0), hi = min(t + half, SEQ);
                pl[tt * 512 + ch] = ws / (float)(hi - lo) - bf2f((unsigned)du[(size_t)t * OIN]);
                if (t + half < SEQ) ws += bf2f((unsigned)du[(size_t)(t + half) * OIN]);
                if (t - half >= 0) ws -= bf2f((unsigned)du[(size_t)(t - half) * OIN]);
            }
        }
        __syncthreads();
        {
            const int g = c.tid >> 7, e = c.tid & 127;
            const float ps = pool_s[g * 128 + e];
#pragma unroll 1
            for (int tb = 0; tb < 64; tb += 16) {
                float acc[16];
#pragma unroll
                for (int i = 0; i < 16; ++i) acc[i] = 0.f;
#pragma unroll 2
                for (int cc = 0; cc < 128; cc += 4) {
                    const float w0 = pool_w[(size_t)(g * 128 + cc) * 128 + e], w1 = pool_w[(size_t)(g * 128 + cc + 1) * 128 + e], w2 = pool_w[(size_t)(g * 128 + cc + 2) * 128 + e], w3 = pool_w[(size_t)(g * 128 + cc + 3) * 128 + e];
#pragma unroll
                    for (int i = 0; i < 16; ++i) { const f32x4 pv = *(const LAS f32x4*)(pl + (tb + i) * 512 + g * 128 + cc); acc[i] += pv.x * w0 + pv.y * w1 + pv.z * w2 + pv.w * w3; }
                }
#pragma unroll
                for (int i = 0; i < 16; ++i) CC[(size_t)(b * SEQ + r * 64 + tb + i) * DM + 512 + g * 128 + e] = (bf16)f2bf(acc[i] * ps);
            }
        }
        __syncthreads();
    }
}

__global__ void __launch_bounds__(512, 2) mk_fwd(Params p) {
    extern __shared__ __attribute__((aligned(16))) unsigned char lds_raw[];
    Ctx c;
    c.lds = (LAS unsigned char*)lds_raw;
    c.tid = threadIdx.x; c.lane = c.tid & 63; c.wave = __builtin_amdgcn_readfirstlane(c.tid >> 6);
    c.G = gridDim.x; { const int bx = blockIdx.x; c.vcu = (c.G % 8 == 0) ? (bx % 8) * (c.G / 8) + bx / 8 : bx; }
    c.gw = c.vcu * 8 + c.wave; c.NGW = c.G * 8;
    volatile LAS unsigned* MISC = (volatile LAS unsigned*)(c.lds + MISC_OFF);
    if (c.tid < 32) MISC[c.tid] = 0u;
    __syncthreads();
    gu32* ctl = (gu32*)(p.ws + WS_CTL);
    XcdBarrier bar; bar.bar = (unsigned*)(ctl + CW_BAR); bar.x = 0; bar.st = nullptr;
    if (!MK_MULTI) bar = xcd_barrier_post((unsigned*)(ctl + CW_BAR), MISC + 8);
    const int lo = p.ph_lo, hi = p.ph_hi;
#define IN(k) (lo <= (k) && (k) < hi)
#define SEAM(k) do { if (IN(k) && IN((k) + 1)) xcd_barrier(bar); } while (0)

    bf16* HB = (bf16*)(p.ws + WS_HB); bf16* QKV = (bf16*)(p.ws + WS_QKV); bf16* CC = (bf16*)(p.ws + WS_CC);
    float* Y = (float*)(p.ws + WS_Y); float* PF = (float*)(p.ws + WS_PF);
    bf16* XG = (bf16*)(p.ws + WS_XG); bf16* HID = (bf16*)(p.ws + WS_HID); bf16* YS = (bf16*)(p.ws + WS_YS);
    const float* GATE = (const float*)(p.ws + WS_GATE);

    if (IN(0)) for (int rep_ = 0; rep_ < 1 + (int)((PROBE_MASK >> 0) & 1u); ++rep_) { if (rep_) __syncthreads(); ph_prologue(p, c); if (FAST_GEMM) { __syncthreads(); ph_transposes(p, c); } } SEAM(0);
    if (IN(1)) for (int rep_ = 0; rep_ < 1 + (int)((PROBE_MASK >> 1) & 1u); ++rep_) { if (rep_) __syncthreads(); ph_modulate0(p, c); } SEAM(1);
    if (IN(2)) for (int rep_ = 0; rep_ < 1 + (int)((PROBE_MASK >> 2) & 1u); ++rep_) { if (rep_) __syncthreads();
        if (FAST_GEMM) { pg8::Gemm g{HB, (const bf16*)(p.ws + WS_W0IN), NTOK, EIN, DM, 0}; pg8::StaticOrder S; S.init(NTOK, EIN, c.G, (int)blockIdx.x);
            pg8::EpiBf16<0> E{QKV, EIN, nullptr, 0, 0, 1.f}; pg8::gemm_phase<pg8::EpiBf16<0>, pg8::StaticOrder, true, true>(c.lds, g, S, E); }
        else { NG g{HB, DM, p.in[I_W0IN], nullptr, EIN, 0, 1 << 30, 0, NTOK, 0, EIN, DM}; ngemm<1>(g, c, EpiF32{PF, EIN}); }
    } SEAM(2);
    if (IN(3)) for (int rep_ = 0; rep_ < 1 + (int)((PROBE_MASK >> 3) & 1u); ++rep_) { if (rep_) __syncthreads(); if (FAST_GEMM) ph_qkv_post<false>(p, c); else ph_qkv_post<true>(p, c); } SEAM(3);
    if (IN(4)) for (int rep_ = 0; rep_ < 1 + (int)((PROBE_MASK >> 4) & 1u); ++rep_) { if (rep_) __syncthreads(); if (FAST_ATTN) ph_attn0_fast(p, c, (char*)lds_raw); else ph_attn0_naive(p, c); } SEAM(4);
    if (IN(5)) for (int rep_ = 0; rep_ < 1 + (int)((PROBE_MASK >> 5) & 1u); ++rep_) { if (rep_) __syncthreads(); ph_attn_combine(p, c); } SEAM(5);
    if (IN(6)) for (int rep_ = 0; rep_ < 1 + (int)((PROBE_MASK >> 6) & 1u); ++rep_) { if (rep_) __syncthreads();
        if (FAST_GEMM) { pg8::Gemm g{CC, (const bf16*)(p.ws + WS_W0OUT), NTOK, DM, DM, 0}; pg8::StaticOrder S; S.init(NTOK, DM, c.G, (int)blockIdx.x);
            pg8::EpiF32P E{Y, DM}; pg8::gemm_phase<pg8::EpiF32P, pg8::StaticOrder, true, true>(c.lds, g, S, E); }
        else { NG g{CC, DM, p.in[I_W0OUT], nullptr, DM, 0, 1 << 30, 0, NTOK, 0, DM, DM}; ngemm<1>(g, c, EpiF32{Y, DM}); }
    } SEAM(6);
    if (IN(7)) for (int rep_ = 0; rep_ < 1 + (int)((PROBE_MASK >> 7) & 1u); ++rep_) { if (rep_) __syncthreads(); ph_ln1_router(p, c, 0); } SEAM(7);
    if (IN(8)) for (int rep_ = 0; rep_ < 1 + (int)((PROBE_MASK >> 8) & 1u); ++rep_) { if (rep_) __syncthreads(); ph_topk(p, c, 0); } SEAM(8);
    if (IN(9)) for (int rep_ = 0; rep_ < 1 + (int)((PROBE_MASK >> 9) & 1u); ++rep_) { if (rep_) __syncthreads();
        if (FAST_GEMM) { pg8::Gemm g{XG, (const bf16*)(p.ws + WS_WGU), NE * MR0, 4096, DM, (size_t)4096 * DM * 2}; pg8::GroupedOrder S; S.init(MR0 / 256, 16, NE, c.G, c.vcu);
            pg8::EpiSwigluP E{HID, FF}; pg8::gemm_phase<pg8::EpiSwigluP, pg8::GroupedOrder, true, true>(c.lds, g, S, E); }
        else { NG g{XG, DM, p.in[I_WG], p.in[I_WU], FF, (size_t)DM * FF, MR0, 0, NE * MR0, 0, FF, DM}; ngemm<2>(g, c, EpiSwiglu{HID}); }
    } SEAM(9);
    if (IN(10)) for (int rep_ = 0; rep_ < 1 + (int)((PROBE_MASK >> 10) & 1u); ++rep_) { if (rep_) __syncthreads();
        if (FAST_GEMM) { pg8::Gemm g{HID, (const bf16*)(p.ws + WS_WDN), NE * MR0, DM, FF, (size_t)DM * FF * 2}; pg8::GroupedOrder S; S.init(MR0 / 256, 4, NE, c.G, c.vcu);
            pg8::EpiGateP E{YS, DM, GATE}; pg8::gemm_phase<pg8::EpiGateP, pg8::GroupedOrder, true, true>(c.lds, g, S, E); }
        else { NG g{HID, FF, p.in[I_WD], nullptr, DM, (size_t)FF * DM, MR0, 0, NE * MR0, 0, DM, FF}; ngemm<1>(g, c, EpiGate{YS, GATE}); }
    } SEAM(10);
    if (IN(11)) for (int rep_ = 0; rep_ < 1 + (int)((PROBE_MASK >> 11) & 1u); ++rep_) { if (rep_) __syncthreads(); ph_combine(p, c, 0); } SEAM(11);
    if (IN(12)) for (int rep_ = 0; rep_ < 1 + (int)((PROBE_MASK >> 12) & 1u); ++rep_) { if (rep_) __syncthreads();
        if (FAST_GEMM) { pg8::Gemm g{HB, (const bf16*)(p.ws + WS_W1IN), NTOK, OIN, DM, 0}; pg8::L1InOrder S; S.init(c.G, (int)blockIdx.x);
            pg8::EpiBf16<0> E{QKV, OIN, nullptr, 512, 512, C2}; pg8::gemm_phase<pg8::EpiBf16<0>, pg8::L1InOrder, true, true>(c.lds, g, S, E); }
        else {
        NG g{HB, DM, p.in[I_W1IN], nullptr, OIN, 0, 1 << 30, 0, LAT, 0, OIN, DM}; ngemm<1>(g, c, EpiBf{QKV, OIN, 512, C2});
        NG g2{HB, DM, p.in[I_W1IN], nullptr, OIN, 0, 1 << 30, LAT, NTOK, 512, 1536, DM}; ngemm<1>(g2, c, EpiBf{QKV, OIN, 0, 1.f}); }
    } SEAM(12);
    if (IN(13)) for (int rep_ = 0; rep_ < 1 + (int)((PROBE_MASK >> 13) & 1u); ++rep_) { if (rep_) __syncthreads(); if (FAST_NA) ph_mixer1_fast(p, c, (char*)lds_raw); else ph_mixer1_naive(p, c); } SEAM(13);
    if (IN(14)) for (int rep_ = 0; rep_ < 1 + (int)((PROBE_MASK >> 14) & 1u); ++rep_) { if (rep_) __syncthreads();
        if (FAST_GEMM) { pg8::Gemm g{CC, (const bf16*)(p.ws + WS_W1OUT), LAT, DM, DM, 0}; pg8::StaticOrder S; S.init(LAT, DM, c.G, (int)blockIdx.x);
            pg8::EpiF32P E{Y, DM}; pg8::gemm_phase<pg8::EpiF32P, pg8::StaticOrder, true, true>(c.lds, g, S, E); }
        else { NG g{CC, DM, p.in[I_W1OUT], nullptr, DM, 0, 1 << 30, 0, LAT, 0, DM, DM}; ngemm<1>(g, c, EpiF32{Y, DM}); }
    } SEAM(14);
    if (IN(15)) for (int rep_ = 0; rep_ < 1 + (int)((PROBE_MASK >> 15) & 1u); ++rep_) { if (rep_) __syncthreads(); ph_ln1_router(p, c, 1); } SEAM(15);
    if (IN(16)) for (int rep_ = 0; rep_ < 1 + (int)((PROBE_MASK >> 16) & 1u); ++rep_) { if (rep_) __syncthreads(); ph_topk(p, c, 1); } SEAM(16);
    if (IN(17)) for (int rep_ = 0; rep_ < 1 + (int)((PROBE_MASK >> 17) & 1u); ++rep_) { if (rep_) __syncthreads();
        if (FAST_GEMM) { pg8::Gemm g{XG, (const bf16*)(p.ws + WS_WGU + WS_MOE_LSTRIDE), NE * MR1, 4096, DM, (size_t)4096 * DM * 2}; pg8::GroupedOrder S; S.init(MR1 / 256, 16, NE, c.G, c.vcu);
            pg8::EpiSwigluP E{HID, FF}; pg8::gemm_phase<pg8::EpiSwigluP, pg8::GroupedOrder, true, true>(c.lds, g, S, E); }
        else { NG g{XG, DM, p.in[I_WG] + (size_t)NE * DM * FF, p.in[I_WU] + (size_t)NE * DM * FF, FF, (size_t)DM * FF, MR1, 0, NE * MR1, 0, FF, DM}; ngemm<2>(g, c, EpiSwiglu{HID}); }
    } SEAM(17);
    if (IN(18)) for (int rep_ = 0; rep_ < 1 + (int)((PROBE_MASK >> 18) & 1u); ++rep_) { if (rep_) __syncthreads();
        if (FAST_GEMM) { pg8::Gemm g{HID, (const bf16*)(p.ws + WS_WDN + WS_MOE_LSTRIDE), NE * MR1, DM, FF, (size_t)DM * FF * 2}; pg8::GroupedOrder S; S.init(MR1 / 256, 4, NE, c.G, c.vcu);
            pg8::EpiGateP E{YS, DM, GATE}; pg8::gemm_phase<pg8::EpiGateP, pg8::GroupedOrder, true, true>(c.lds, g, S, E); }
        else { NG g{HID, FF, p.in[I_WD] + (size_t)NE * FF * DM, nullptr, DM, (size_t)FF * DM, MR1, 0, NE * MR1, 0, DM, FF}; ngemm<1>(g, c, EpiGate{YS, GATE}); }
    } SEAM(18);
    if (IN(19)) for (int rep_ = 0; rep_ < 1 + (int)((PROBE_MASK >> 19) & 1u); ++rep_) { if (rep_) __syncthreads(); ph_combine(p, c, 1); }
#undef IN
#undef SEAM
}

extern "C" void kernel_launch(void* const* d_in, const int* in_sizes, int n_in, void* d_out, int out_size, void* d_ws, size_t ws_size, hipStream_t stream) {
    static int grid = 0;
    if (grid == 0) {
        if (n_in != 26 || out_size != LAT * DM || ws_size < WS_END) { fprintf(stderr, "kernel_launch: unexpected shapes (n_in %d out %d ws %zu)\n", n_in, out_size, ws_size); grid = -1; return; }
        int dev = 0, cus = 0;
        if (hipGetDevice(&dev) != hipSuccess || hipDeviceGetAttribute(&cus, hipDeviceAttributeMultiprocessorCount, dev) != hipSuccess) { grid = -1; return; }
        if (hipFuncSetAttribute((const void*)mk_fwd, hipFuncAttributeMaxDynamicSharedMemorySize, LDS_BYTES) != hipSuccess) { fprintf(stderr, "kernel_launch: hipFuncSetAttribute failed\n"); grid = -1; return; }
        int per_cu = 0;
        if (hipOccupancyMaxActiveBlocksPerMultiprocessor(&per_cu, (const void*)mk_fwd, 512, LDS_BYTES) != hipSuccess || per_cu < 1) fprintf(stderr, "kernel_launch: occupancy query says %d\n", per_cu);
        (void)hipGetLastError();
        grid = cus;
    }
    if (grid < 0) return;
    (void)hipMemsetAsync((char*)d_ws + WS_CTL, 0, CTL_ZERO_BYTES, stream);
    Params a{};
    for (int i = 0; i < 26; ++i) a.in[i] = (const float*)d_in[i];
    a.out = (float*)d_out; a.ws = (unsigned char*)d_ws;
#if MK_MULTI
    for (int ph = 0; ph < NPHASE; ++ph) { a.ph_lo = ph; a.ph_hi = ph + 1; hipLaunchKernelGGL(mk_fwd, dim3(grid), dim3(512), LDS_BYTES, stream, a); }
#else
    a.ph_lo = 0; a.ph_hi = NPHASE;
    hipLaunchKernelGGL(mk_fwd, dim3(grid), dim3(512), LDS_BYTES, stream, a);
#endif
}
```

```cpp
#include <hip/hip_runtime.h>
#include <cstdio>
#include <cstdint>

#define GAS __attribute__((address_space(1)))
#define LAS __attribute__((address_space(3)))
typedef unsigned short bf16;
typedef unsigned v4u __attribute__((ext_vector_type(4)));
typedef unsigned v2u __attribute__((ext_vector_type(2)));
typedef float f32x4 __attribute__((ext_vector_type(4)));
typedef float f32x2 __attribute__((ext_vector_type(2)));
typedef float f32x16 __attribute__((ext_vector_type(16)));
typedef GAS unsigned gu32;

#ifndef PROBE_MASK
#define PROBE_MASK 0u
#endif
#ifndef FAST_NA
#define FAST_NA 1
#endif
#ifndef FAST_ATTN
#define FAST_ATTN 1
#endif
#ifndef FAST_GEMM
#define FAST_GEMM 1
#endif
#ifndef MK_MULTI
#define MK_MULTI 0
#endif

constexpr int NBATCH = 8, SEQ = 2048, DM = 1024, NCTX = 256;
constexpr int LAT = NBATCH * SEQ;
constexpr int NTOK = LAT + NBATCH * NCTX;
constexpr int EIN = 2304, OIN = 2048, NE = 16, FF = 2048;
constexpr int MR0 = 2304, MR1 = 2048;
constexpr float LOG2E = 1.4426950408889634f;
constexpr float C2 = 0.125f * LOG2E;
constexpr float ALPHA = 1.4142135623730951f;
constexpr float LN_EPS = 1e-5f, RMS_EPS = 1e-6f;
constexpr float LAM_INIT = 0.2f;
constexpr int NPHASE = 20;

constexpr size_t MiB = 1u << 20;
constexpr size_t WS_CTL = 0, CTL_ZERO_BYTES = 1 * MiB;
constexpr size_t WS_MOD = 1 * MiB;
constexpr size_t WS_ROPE = 1 * MiB + 512 * 1024;
constexpr size_t WS_W0IN = 2 * MiB;
constexpr size_t WS_W0OUT = 7 * MiB;
constexpr size_t WS_W1IN = 9 * MiB;
constexpr size_t WS_W1OUT = 13 * MiB;
constexpr size_t WS_AFF = 16 * MiB;
constexpr size_t WS_INV = 18 * MiB;
constexpr size_t WS_GATE = 20 * MiB;
constexpr size_t WS_WGU = 24 * MiB;
constexpr size_t WS_WDN = 152 * MiB;
constexpr size_t WS_MOE_LSTRIDE = 192 * MiB;
constexpr size_t WS_XS = 408 * MiB;
constexpr size_t WS_HB = 480 * MiB;
constexpr size_t WS_QKV = 516 * MiB;
constexpr size_t WS_CC = 597 * MiB;
constexpr size_t WS_AO = 633 * MiB;
constexpr size_t WS_Y = 705 * MiB;
constexpr size_t WS_XG = 516 * MiB;
constexpr size_t WS_HID = 588 * MiB;
constexpr size_t WS_YS = 732 * MiB;
constexpr size_t WS_PF = 804 * MiB;
constexpr size_t WS_END = 968 * MiB;

constexpr int CW_BAR = 4096;
constexpr int LDS_BYTES = 147456;
constexpr int MISC_OFF = 131072 + 320;

__device__ __forceinline__ float bf2f(unsigned v) { return __uint_as_float(v << 16); }
__device__ __forceinline__ unsigned f2bf(float f) { unsigned u = __float_as_uint(f); return (u + 0x7fffu + ((u >> 16) & 1u)) >> 16; }
__device__ __forceinline__ unsigned pk2(float lo, float hi) { return f2bf(lo) | (f2bf(hi) << 16); }
__device__ __forceinline__ float wave_sum(float v) {
#pragma unroll
    for (int o = 1; o < 64; o <<= 1) v += __shfl_xor(v, o);
    return v;
}
__device__ __forceinline__ float wave_max(float v) {
#pragma unroll
    for (int o = 1; o < 64; o <<= 1) v = fmaxf(v, __shfl_xor(v, o));
    return v;
}
__device__ __forceinline__ void unpack8(const v4u w, float* f) {
    f[0] = bf2f(w.x & 0xffffu); f[1] = __uint_as_float(w.x & 0xffff0000u);
    f[2] = bf2f(w.y & 0xffffu); f[3] = __uint_as_float(w.y & 0xffff0000u);
    f[4] = bf2f(w.z & 0xffffu); f[5] = __uint_as_float(w.z & 0xffff0000u);
    f[6] = bf2f(w.w & 0xffffu); f[7] = __uint_as_float(w.w & 0xffff0000u);
}

#define XB_TMO      128
#define XB_XCNT(j)  (256  + 64 * (j))
#define XB_XSUB(j)  (1280 + 64 * (j))
#define XB_XGEN(j)  (2304 + 64 * (j))
#define XB_TOP      3328
#define XB_TOPGEN   3392
#define XCD_BAR_WORDS 3456
#define XB_SPIN_CAP (1u << 18)
__device__ __forceinline__ unsigned xb_ld(unsigned* p)              { return __hip_atomic_load(p, __ATOMIC_RELAXED, __HIP_MEMORY_SCOPE_AGENT); }
__device__ __forceinline__ unsigned xb_add(unsigned* p, unsigned v) { return __hip_atomic_fetch_add(p, v, __ATOMIC_RELAXED, __HIP_MEMORY_SCOPE_AGENT); }
__device__ __forceinline__ unsigned xb_xcc_id() { return (unsigned)__builtin_amdgcn_s_getreg((3 << 11) | 20) & 0xFu; }
#define XB_SPIN(cond, bar) do { unsigned _sp = 0; while (cond) { __builtin_amdgcn_s_sleep(1); \
    if ((++_sp & 255u) == 0u) { if (xb_ld(&(bar)[XB_TMO])) break; if (_sp > XB_SPIN_CAP) { atomicAdd(&(bar)[XB_TMO], 1u); break; } } } } while (0)
struct XcdBarrier { unsigned* bar; unsigned x; volatile LAS unsigned* st; };
__device__ __forceinline__ XcdBarrier xcd_barrier_post(unsigned* bar, volatile LAS unsigned* st) {
    XcdBarrier b; b.bar = bar; b.x = xb_xcc_id(); b.st = st;
    if (threadIdx.x == 0) (void)xb_add(&bar[XB_XCNT(b.x)], 1u);
    return b;
}
__device__ __forceinline__ void xcd_barrier_complete(unsigned* bar, unsigned x, unsigned& nloc, unsigned& nx) {
    const unsigned G = gridDim.x * gridDim.y * gridDim.z;
    unsigned sum, cnt, mine, sp = 0u;
    for (;;) {
        sum = 0u; cnt = 0u; mine = 0u;
#pragma unroll
        for (unsigned j = 0; j < 16; ++j) { const unsigned c = xb_ld(&bar[XB_XCNT(j)]); sum += c; cnt += (c > 0u) ? 1u : 0u; mine = (j == x) ? c : mine; }
        if (sum == G) break;
        __builtin_amdgcn_s_sleep(1);
        if ((++sp & 255u) == 0u) { if (xb_ld(&bar[XB_TMO])) break; if (sp > XB_SPIN_CAP) { atomicAdd(&bar[XB_TMO], 1u); break; } }
    }
    nloc = mine > 0u ? mine : 1u; nx = cnt > 0u ? cnt : 1u;
}
__device__ __forceinline__ void xcd_barrier(const XcdBarrier& b) {
    asm volatile("s_waitcnt vmcnt(0)" ::: "memory");
    __syncthreads();
    if (threadIdx.x == 0) {
        unsigned* bar = b.bar;
        __builtin_amdgcn_s_waitcnt(0);
        unsigned nloc = b.st[0], nx = b.st[1];
        if (nloc == 0u) { xcd_barrier_complete(bar, b.x, nloc, nx); b.st[0] = nloc; b.st[1] = nx; }
        const unsigned old = xb_add(&bar[XB_XSUB(b.x)], 1u);
        const unsigned gen = old / nloc;
        if (old + 1u == (gen + 1u) * nloc) {
            __builtin_amdgcn_fence(__ATOMIC_RELEASE, "agent");
            asm volatile("s_waitcnt vmcnt(0)" ::: "memory");
            const unsigned og = xb_add(&bar[XB_TOP], 1u);
            const unsigned tg = og / nx;
            if (og + 1u == (tg + 1u) * nx) xb_add(&bar[XB_TOPGEN], 1u);
            else XB_SPIN(xb_ld(&bar[XB_TOPGEN]) == tg, bar);
            __builtin_amdgcn_fence(__ATOMIC_ACQUIRE, "agent");
            xb_add(&bar[XB_XGEN(b.x)], 1u);
            asm volatile("s_waitcnt vmcnt(0)" ::: "memory");
        } else {
            XB_SPIN(xb_ld(&bar[XB_XGEN(b.x)]) == gen, bar);
            __builtin_amdgcn_fence(__ATOMIC_ACQUIRE, "agent");
            asm volatile("s_waitcnt vmcnt(0)" ::: "memory");
        }
    }
    __syncthreads();
}

namespace pg8 {
#define PG8_LAS __attribute__((address_space(3)))
typedef unsigned short bf16_t;
typedef short bf16x8 __attribute__((ext_vector_type(8)));
typedef float f32x4 __attribute__((ext_vector_type(4)));
typedef unsigned u32x4 __attribute__((ext_vector_type(4)));
constexpr int BM = 256, BK = 64, HALF = 128, HTB = HALF * BK * 2  , STAGE_BYTES = 8 * HTB, NXCD = 8, WGM = 8;

__host__ __device__ __forceinline__ int lds_byte(int r, int c) { const int st = (r >> 4) * 2 + (c >> 5), rr = r & 15, cc = c & 31, ob = rr * 64 + cc * 2; return st * 1024 + (ob ^ (((ob >> 9) & 1) << 5)); }
__host__ __device__ __forceinline__ void stage_rc(int b, int& R, int& C) { const int st = b / 1024, sb = b % 1024, swz = sb ^ (((sb >> 9) & 1) << 5); R = (st >> 1) * 16 + swz / 64; C = (st & 1) * 32 + (swz % 64) / 2; }
__host__ __device__ __forceinline__ int perm32(int rho) { const int n = rho >> 4, i = rho & 15; return 8 * (i >> 2) + 4 * n + (i & 3); }

struct Unit { int pm, pn, e; };
struct Gemm { const bf16_t* A; const bf16_t* Bt; int M, N, K; size_t bstride; };

struct StaticOrder {
    int nM, nN, nwg, G, c;
    __host__ __device__ void init(int M, int N, int G_, int c_) { nM = M / BM; nN = N / BM; nwg = nM * nN; G = G_; c = c_; }
    __host__ __device__ bool next(int i, Unit& u) const {
        const long L = (long)i * G + c; if (L >= nwg) return false;
        int wgid = (int)L; { const int q = nwg / NXCD, r = nwg % NXCD, xcd = wgid % NXCD, off = wgid / NXCD; wgid = (xcd < r ? xcd * (q + 1) : r * (q + 1) + (xcd - r) * q) + off; }
        const int nig = WGM * nN, gid = wgid / nig, fm = gid * WGM, gsz = (nM - fm) < WGM ? (nM - fm) : WGM;
        u.pm = fm + ((wgid % nig) % gsz); u.pn = (wgid % nig) / gsz; u.e = 0; return true;
    }
    __device__ __forceinline__ void a_ready(const Unit&) const {}
    __device__ __forceinline__ void done(const Unit&) const {}
};

__device__ __forceinline__ unsigned cvt_pk_bf16(float lo, float hi) { unsigned r; asm volatile("v_cvt_pk_bf16_f32 %0, %1, %2" : "=v"(r) : "v"(lo), "v"(hi)); return r; }
typedef float f32x2 __attribute__((ext_vector_type(2)));
__device__ __forceinline__ f32x2 gelu_pk(f32x2 v) {
    const f32x2 av = __builtin_elementwise_abs(v), d = av * 0.2316418882f + 1.0f;
    f32x2 t; t.x = __builtin_amdgcn_rcpf(d.x); t.y = __builtin_amdgcn_rcpf(d.y);
    f32x2 q = t * 0.5307027145f + (-0.7265760135f); q = q * t + 0.7107068705f; q = q * t + (-0.142248368f); q = q * t + 0.127414796f; q = q * t;
    const f32x2 s = (v * v) * (-0.72134752044f);
    f32x2 e; e.x = __builtin_amdgcn_exp2f(s.x); e.y = __builtin_amdgcn_exp2f(s.y);
    const f32x2 m = v * (q * e), r = v - m;
    f32x2 o; o.x = v.x < 0.f ? m.x : r.x; o.y = v.y < 0.f ? m.y : r.y; return o;
}

template <int ACT  > struct EpiBf16 {
    static constexpr bool PERM = true, AFTER_DRAIN = false; static_assert(ACT == 0 || ACT == 1, "EpiBf16: ACT is 0 (none) or 1 (gelu_pk)");
    bf16_t* O; int ldc; const float* bias; int split_cols; size_t split_stride; float scale0;
    __device__ __forceinline__ void operator()(const f32x4 (&acc)[2][2][4][2], const Unit& u, int wr, int wc, int fr, int fq) const {
        const int row0 = u.pm * BM + wr * 64 + fr; int colt = u.pn * BM; bf16_t* base = O;
        float sc = 1.f; if (split_cols) { const int t = colt / split_cols; base += (size_t)t * split_stride; colt -= t * split_cols; if (t == 0) sc = scale0; }
        const int col0 = colt + wc * 32 + 8 * fq, bcol0 = u.pn * BM + wc * 32 + 8 * fq;
        f32x4 bv[2][2];
#pragma unroll
        for (int bj = 0; bj < 2; ++bj)
#pragma unroll
            for (int n = 0; n < 2; ++n) bv[bj][n] = bias ? *(const f32x4*)(bias + bcol0 + bj * HALF + 4 * n) : (f32x4){0.f, 0.f, 0.f, 0.f};
#pragma unroll
        for (int ai = 0; ai < 2; ++ai)
#pragma unroll
            for (int m = 0; m < 4; ++m) { bf16_t* rowp = base + (size_t)(row0 + ai * HALF + m * 16) * ldc + col0;
#pragma unroll
                for (int bj = 0; bj < 2; ++bj) { f32x4 v0 = acc[ai][bj][m][0] + bv[bj][0], v1 = acc[ai][bj][m][1] + bv[bj][1];
                    if (ACT == 1) { f32x2 a = gelu_pk((f32x2){v0[0], v0[1]}), b = gelu_pk((f32x2){v0[2], v0[3]}), c = gelu_pk((f32x2){v1[0], v1[1]}), d = gelu_pk((f32x2){v1[2], v1[3]});
                        v0 = (f32x4){a.x, a.y, b.x, b.y}; v1 = (f32x4){c.x, c.y, d.x, d.y}; }
                    v0 = v0 * sc; v1 = v1 * sc; u32x4 w; w.x = cvt_pk_bf16(v0[0], v0[1]); w.y = cvt_pk_bf16(v0[2], v0[3]); w.z = cvt_pk_bf16(v1[0], v1[1]); w.w = cvt_pk_bf16(v1[2], v1[3]);
                    *(u32x4*)(rowp + bj * HALF) = w; } }
    }
};

template <class Epi, class Sched, bool ALIGN_EPI = false, bool SP2 = false>
__device__ __forceinline__ void gemm_phase(PG8_LAS unsigned char* lds, const Gemm g, const Sched& S, const Epi& E) {
    const int tid = threadIdx.x, wid = __builtin_amdgcn_readfirstlane(tid >> 6), lane = tid & 63, wr = wid >> 2, wc = wid & 3, fr = lane & 15, fq = lane >> 4;
    const int K = g.K, nt = K / BK;
    unsigned voffA[2], voffB[2];
#pragma unroll
    for (int i = 0; i < 2; ++i) { int R, C; stage_rc(tid * 16 + i * 8192, R, C); const int Rb = Epi::PERM ? ((R & ~31) + perm32(R & 31)) : R;
        voffA[i] = (unsigned)(R * K + C) * 2u; voffB[i] = (unsigned)(Rb * K + C) * 2u; }
    const size_t kstep = (size_t)(BK * 2);
    const size_t hstep = (size_t)HALF * K * 2;
    const size_t tstep = 2 * hstep;
    const unsigned ldsw = (unsigned)wid * 1024u;
    const int aoff = lds_byte(wr * 64 + fr, fq * 8), boff = lds_byte(wc * 32 + fr, fq * 8);
#define PG8_SA(b, h) (((b) * 2 + (h)) * HTB)
#define PG8_SB(b, h) ((4 + (b) * 2 + (h)) * HTB)
#define PG8_STAGE(bufoff, gbase, voff) do { _Pragma("unroll") for (int _i = 0; _i < 2; ++_i) \
        __builtin_amdgcn_global_load_lds((const unsigned*)((const char*)(gbase) + (voff)[_i]), (PG8_LAS unsigned*)(lds + (bufoff) + ldsw + _i * 8192), 16, 0, 0); } while (0)
#define PG8_LDA(dst, b, h) do { _Pragma("unroll") for (int m = 0; m < 4; ++m) _Pragma("unroll") for (int k = 0; k < 2; ++k) dst[m][k] = *(const PG8_LAS bf16x8*)(lds + PG8_SA(b, h) + aoff + m * 2048 + k * 1024); } while (0)
#define PG8_LDB(dst, b, h) do { _Pragma("unroll") for (int n = 0; n < 2; ++n) _Pragma("unroll") for (int k = 0; k < 2; ++k) dst[n][k] = *(const PG8_LAS bf16x8*)(lds + PG8_SB(b, h) + boff + n * 2048 + k * 1024); } while (0)
#define PG8_MMA(ai, bj, At, Bt) do { __builtin_amdgcn_s_setprio(1); _Pragma("unroll") for (int m = 0; m < 4; ++m) _Pragma("unroll") for (int n = 0; n < 2; ++n) _Pragma("unroll") for (int k = 0; k < 2; ++k) \
        acc[ai][bj][m][n] = __builtin_amdgcn_mfma_f32_16x16x32_bf16(Bt[n][k], At[m][k], acc[ai][bj][m][n], 0, 0, 0); __builtin_amdgcn_s_setprio(0); } while (0)
#define PG8_WAIT_V(n) asm volatile("s_waitcnt vmcnt(" #n ")" ::: "memory")
#define PG8_WAIT_L(n) asm volatile("s_waitcnt lgkmcnt(" #n ")" ::: "memory")
#define PG8_BAR __builtin_amdgcn_s_barrier()
#define PG8_SCHED __builtin_amdgcn_sched_barrier(0)
    Unit cur, nxt; int ui = 0;
    if (!S.next(0, cur)) return;
    f32x4 acc[2][2][4][2];
#pragma unroll
    for (int a = 0; a < 2; ++a)
#pragma unroll
        for (int b = 0; b < 2; ++b)
#pragma unroll
            for (int m = 0; m < 4; ++m)
#pragma unroll
                for (int n = 0; n < 2; ++n) acc[a][b][m][n] = (f32x4){0.f, 0.f, 0.f, 0.f};
    bf16x8 At[4][2], B0[2][2], B1[2][2];
    const char* cA = (const char*)g.A + (size_t)cur.pm * tstep; const char* cB = (const char*)g.Bt + (size_t)cur.pn * tstep + (size_t)cur.e * g.bstride;
    S.a_ready(cur);
    if constexpr (SP2) {
        PG8_STAGE(PG8_SB(0, 0), cB, voffB); PG8_STAGE(PG8_SB(0, 1), cB + hstep, voffB); PG8_STAGE(PG8_SA(0, 0), cA, voffA); PG8_STAGE(PG8_SA(0, 1), cA + hstep, voffA);
        if (wr == 1) PG8_BAR;
        PG8_WAIT_V(2); PG8_BAR;
        PG8_STAGE(PG8_SB(1, 0), cB + kstep, voffB); PG8_STAGE(PG8_SA(1, 0), cA + kstep, voffA); PG8_STAGE(PG8_SB(1, 1), cB + hstep + kstep, voffB);
        PG8_WAIT_V(6); PG8_BAR;
    } else {
        PG8_STAGE(PG8_SB(0, 0), cB, voffB); PG8_STAGE(PG8_SA(0, 0), cA, voffA); PG8_STAGE(PG8_SB(0, 1), cB + hstep, voffB); PG8_STAGE(PG8_SA(0, 1), cA + hstep, voffA);
        if (wr == 1) PG8_BAR;
        PG8_WAIT_V(4); PG8_BAR;
        PG8_STAGE(PG8_SB(1, 0), cB + kstep, voffB); PG8_STAGE(PG8_SA(1, 0), cA + kstep, voffA); PG8_STAGE(PG8_SB(1, 1), cB + hstep + kstep, voffB);
        PG8_WAIT_V(6); PG8_BAR;
    }
    for (;;) {
        const bool has_next = S.next(ui + 1, nxt);
        const char* nA = has_next ? (const char*)g.A + (size_t)nxt.pm * tstep : cA; const char* nB = has_next ? (const char*)g.Bt + (size_t)nxt.pn * tstep + (size_t)nxt.e * g.bstride : cB;
        for (int t = 0; t < nt; t += 2) {
            const bool last = (t == nt - 2);
            const char* a1 = cA + (size_t)(t + 1) * kstep;
            const char* a2 = last ? nA : cA + (size_t)(t + 2) * kstep; const char* b2 = last ? nB : cB + (size_t)(t + 2) * kstep;
            const char* a3 = a2 + kstep; const char* b3 = b2 + kstep;
            if (last && has_next) S.a_ready(nxt);
            if constexpr (SP2) {
            PG8_LDB(B0, 0, 0); PG8_LDB(B1, 0, 1); PG8_SCHED; PG8_LDA(At, 0, 0); PG8_STAGE(PG8_SA(1, 1), a1 + hstep, voffA);
            PG8_WAIT_V(8); PG8_WAIT_L(0); PG8_BAR; PG8_MMA(0, 0, At, B0); PG8_MMA(0, 1, At, B1); PG8_BAR; PG8_SCHED;
            PG8_LDA(At, 0, 1); PG8_STAGE(PG8_SB(0, 0), b2, voffB); PG8_STAGE(PG8_SB(0, 1), b2 + hstep, voffB); PG8_STAGE(PG8_SA(0, 0), a2, voffA);
            PG8_WAIT_V(8); PG8_WAIT_L(0); PG8_BAR; PG8_MMA(1, 0, At, B0); PG8_MMA(1, 1, At, B1); PG8_BAR; PG8_SCHED;
            PG8_LDB(B0, 1, 0); PG8_LDB(B1, 1, 1); PG8_SCHED; PG8_LDA(At, 1, 0); PG8_STAGE(PG8_SA(0, 1), a2 + hstep, voffA);
            PG8_WAIT_V(8); PG8_WAIT_L(0); PG8_BAR; PG8_MMA(0, 0, At, B0); PG8_MMA(0, 1, At, B1); PG8_BAR; PG8_SCHED;
            PG8_LDA(At, 1, 1); PG8_STAGE(PG8_SB(1, 0), b3, voffB); PG8_STAGE(PG8_SB(1, 1), b3 + hstep, voffB); PG8_STAGE(PG8_SA(1, 0), a3, voffA);
            PG8_WAIT_V(8); PG8_WAIT_L(0); PG8_BAR; PG8_MMA(1, 0, At, B0); PG8_MMA(1, 1, At, B1); PG8_BAR; PG8_SCHED;
            } else {
            PG8_LDB(B0, 0, 0); PG8_SCHED; PG8_LDA(At, 0, 0); PG8_STAGE(PG8_SA(1, 1), a1 + hstep, voffA);
            PG8_WAIT_L(8); PG8_BAR; PG8_WAIT_L(0); PG8_MMA(0, 0, At, B0); PG8_BAR; PG8_SCHED;
            PG8_LDB(B1, 0, 1); PG8_STAGE(PG8_SB(0, 0), b2, voffB);
            PG8_BAR; PG8_WAIT_L(0); PG8_MMA(0, 1, At, B1); PG8_BAR;
            PG8_LDA(At, 0, 1); PG8_STAGE(PG8_SA(0, 0), a2, voffA);
            PG8_BAR; PG8_WAIT_L(0); PG8_MMA(1, 0, At, B0); PG8_BAR; PG8_SCHED;
            PG8_STAGE(PG8_SB(0, 1), b2 + hstep, voffB);
            PG8_WAIT_V(6); PG8_BAR; PG8_MMA(1, 1, At, B1); PG8_BAR;
            PG8_LDB(B0, 1, 0); PG8_SCHED; PG8_LDA(At, 1, 0); PG8_STAGE(PG8_SA(0, 1), a2 + hstep, voffA);
            PG8_WAIT_L(8); PG8_BAR; PG8_WAIT_L(0); PG8_MMA(0, 0, At, B0); PG8_BAR; PG8_SCHED;
            PG8_LDB(B1, 1, 1); PG8_STAGE(PG8_SB(1, 0), b3, voffB);
            PG8_BAR; PG8_WAIT_L(0); PG8_MMA(0, 1, At, B1); PG8_BAR;
            PG8_LDA(At, 1, 1); PG8_STAGE(PG8_SA(1, 0), a3, voffA);
            PG8_BAR; PG8_WAIT_L(0); PG8_MMA(1, 0, At, B0); PG8_BAR; PG8_SCHED;
            PG8_STAGE(PG8_SB(1, 1), b3 + hstep, voffB);
            PG8_WAIT_V(6); PG8_BAR; PG8_MMA(1, 1, At, B1); PG8_BAR;
            }
        }
        if constexpr (ALIGN_EPI) { if (wr == 0) PG8_BAR; }
        if constexpr (!Epi::AFTER_DRAIN) { E(acc, cur, wr, wc, fr, fq); S.done(cur); }
        if (!has_next) break;
#pragma unroll
        for (int a = 0; a < 2; ++a)
#pragma unroll
            for (int b = 0; b < 2; ++b)
#pragma unroll
                for (int m = 0; m < 4; ++m)
#pragma unroll
                    for (int n = 0; n < 2; ++n) acc[a][b][m][n] = (f32x4){0.f, 0.f, 0.f, 0.f};
        cur = nxt; cA = nA; cB = nB; ++ui;
        if constexpr (ALIGN_EPI) { if (wr == 1) PG8_BAR; }
    }
    PG8_WAIT_V(0);
    if constexpr (!ALIGN_EPI) { if (wr == 0) PG8_BAR; }
    PG8_BAR;
    if constexpr (Epi::AFTER_DRAIN) { E.fused(acc, cur, wr, wc, fr, fq, lds, wid, lane); S.done(cur); }
#undef PG8_SA
#undef PG8_SB
#undef PG8_STAGE
#undef PG8_LDA
#undef PG8_LDB
#undef PG8_MMA
#undef PG8_WAIT_V
#undef PG8_WAIT_L
#undef PG8_BAR
#undef PG8_SCHED
}
}

namespace pg8 {
struct EpiF32P {
    static constexpr bool PERM = false, AFTER_DRAIN = false;
    float* O; int ldc;
    __device__ __forceinline__ void operator()(const f32x4 (&acc)[2][2][4][2], const Unit& u, int wr, int wc, int fr, int fq) const {
        const int row0 = u.pm * BM + wr * 64 + fr, col0 = u.pn * BM + wc * 32 + 4 * fq;
#pragma unroll
        for (int ai = 0; ai < 2; ++ai)
#pragma unroll
            for (int m = 0; m < 4; ++m) { float* rowp = O + (size_t)(row0 + ai * HALF + m * 16) * ldc + col0;
#pragma unroll
                for (int bj = 0; bj < 2; ++bj)
#pragma unroll
                    for (int n = 0; n < 2; ++n) *(f32x4*)(rowp + bj * HALF + n * 16) = acc[ai][bj][m][n]; }
    }
};
struct EpiSwigluP {
    static constexpr bool PERM = true, AFTER_DRAIN = false;
    bf16_t* O; int ldc;
    __device__ __forceinline__ void operator()(const f32x4 (&acc)[2][2][4][2], const Unit& u, int wr, int wc, int fr, int fq) const {
        const int row0 = u.pm * BM + wr * 64 + fr, col0 = u.pn * HALF + wc * 32 + 8 * fq;
#pragma unroll
        for (int ai = 0; ai < 2; ++ai)
#pragma unroll
            for (int m = 0; m < 4; ++m) {
                float h[8];
#pragma unroll
                for (int n = 0; n < 2; ++n)
#pragma unroll
                    for (int j = 0; j < 4; ++j) { const float g = acc[ai][0][m][n][j], up = acc[ai][1][m][n][j];
                        h[4 * n + j] = g * up * __builtin_amdgcn_rcpf(1.0f + __builtin_amdgcn_exp2f(-1.4426950408889634f * g)); }
                u32x4 w; w.x = cvt_pk_bf16(h[0], h[1]); w.y = cvt_pk_bf16(h[2], h[3]); w.z = cvt_pk_bf16(h[4], h[5]); w.w = cvt_pk_bf16(h[6], h[7]);
                *(u32x4*)(O + (size_t)(row0 + ai * HALF + m * 16) * ldc + col0) = w; }
    }
};
struct EpiGateP {
    static constexpr bool PERM = true, AFTER_DRAIN = false;
    bf16_t* O; int ldc; const float* gate;
    __device__ __forceinline__ void operator()(const f32x4 (&acc)[2][2][4][2], const Unit& u, int wr, int wc, int fr, int fq) const {
        const int row0 = u.pm * BM + wr * 64 + fr, col0 = u.pn * BM + wc * 32 + 8 * fq;
#pragma unroll
        for (int ai = 0; ai < 2; ++ai)
#pragma unroll
            for (int m = 0; m < 4; ++m) { const int row = row0 + ai * HALF + m * 16; const float gt = gate[row]; bf16_t* rowp = O + (size_t)row * ldc + col0;
#pragma unroll
                for (int bj = 0; bj < 2; ++bj) { const f32x4 v0 = acc[ai][bj][m][0] * gt, v1 = acc[ai][bj][m][1] * gt;
                    u32x4 w; w.x = cvt_pk_bf16(v0[0], v0[1]); w.y = cvt_pk_bf16(v0[2], v0[3]); w.z = cvt_pk_bf16(v1[0], v1[1]); w.w = cvt_pk_bf16(v1[2], v1[3]);
                    *(u32x4*)(rowp + bj * HALF) = w; } }
    }
};
struct GroupedOrder {
    int nMe, nN, ntot, G, c;
    __device__ void init(int nMe_, int nN_, int ne, int G_, int c_) { nMe = nMe_; nN = nN_; ntot = nMe_ * nN_ * ne; G = G_; c = c_; }
    __device__ bool next(int i, Unit& u) const {
        const int L = i * G + c; if (L >= ntot) return false;
        const int per = nMe * nN, e = L / per, rem = L - e * per;
        u.e = e; u.pn = rem / nMe; u.pm = e * nMe + (rem - u.pn * nMe); return true;
    }
    __device__ __forceinline__ void a_ready(const Unit&) const {}
    __device__ __forceinline__ void done(const Unit&) const {}
};
struct L1InOrder {
    StaticOrder so; int G, c;
    __device__ void init(int G_, int c_) { so.init(16384, 2048, G_, 0); G = G_; c = c_; }
    __device__ bool next(int i, Unit& u) const {
        const int L = i * G + c;
        if (L < 512) { StaticOrder t = so; t.G = 1; t.c = 0; return t.next(L, u); }
        if (L < 544) { const int l = L - 512; u.pm = 64 + (l >> 2); u.pn = 2 + (l & 3); u.e = 0; return true; }
        return false;
    }
    __device__ __forceinline__ void a_ready(const Unit&) const {}
    __device__ __forceinline__ void done(const Unit&) const {}
};
}

#include <hip/hip_bf16.h>
#include <cmath>
namespace attn_body {
using bf16=__hip_bfloat16;
using bf16x8=__attribute__((ext_vector_type(8)))short;
using s16x4=__attribute__((ext_vector_type(4)))short;
using f32x16=__attribute__((ext_vector_type(16)))float;
using u32x4=__attribute__((ext_vector_type(4)))unsigned;
constexpr int D=64,OPITCH=1024;
constexpr int NW=8,QBLK=32,QB=QBLK*NW,KVBLK=64;
__device__ __forceinline__ int crow(int r,int hi){return (r&3)+8*(r>>2)+4*hi;}
#define SBAR() __builtin_amdgcn_sched_barrier(0)
__device__ __forceinline__ void cmask(f32x16&p0,f32x16&p1,int jb,int qrel,int hi){
  const float NEG=-INFINITY; int kb=64*jb+4*hi;
  #pragma unroll
  for(int r=0;r<16;++r){int kv=kb+(r&3)+8*(r>>2); if(kv>qrel)p0[r]=NEG; if(kv+32>qrel)p1[r]=NEG;}
}

constexpr int NSLOT=3, SLOTB=8192;
constexpr int LDS_K=0, LDS_V=NSLOT*SLOTB, LDS_WS=2*NSLOT*SLOTB, LDS_OST=LDS_WS+NW*64*4, LDS_BYTES=LDS_OST+NW*4096;
constexpr float C2=0.125f*1.4426950408889634f;
__device__ __forceinline__ void glds16(const void*gsrc,unsigned lds_dst){unsigned keep;
  asm volatile("s_mov_b32 %0, m0\n\ts_mov_b32 m0, %2\n\ts_nop 0\n\tglobal_load_lds_dwordx4 %1, off\n\ts_mov_b32 m0, %0":"=&s"(keep):"v"(gsrc),"s"(lds_dst):"memory");}
__device__ __forceinline__ float max3f(float a,float b,float c){float r;asm("v_max3_f32 %0, %1, %2, %3":"=v"(r):"v"(a),"v"(b),"v"(c));return r;}
__device__ __forceinline__ float max2f(float a,float b){float r;asm("v_max_f32_e32 %0, %1, %2":"=v"(r):"v"(a),"v"(b));return r;}
__device__ __forceinline__ float fadd_s(float a,float b){float r;asm("v_add_f32_e32 %0, %1, %2":"=v"(r):"v"(a),"v"(b));return r;}
__device__ __forceinline__ float fsub_s(float a,float b){float r;asm("v_sub_f32_e32 %0, %1, %2":"=v"(r):"v"(a),"v"(b));return r;}
typedef float f32x2_t __attribute__((ext_vector_type(2))); typedef __bf16 bf16x2_t __attribute__((ext_vector_type(2)));
__device__ __forceinline__ unsigned cvtpk_s(float lo,float hi){f32x2_t v={lo,hi};bf16x2_t b=__builtin_convertvector(v,bf16x2_t);return __builtin_bit_cast(unsigned,b);}
#define WAIT_BAR(N) asm volatile("s_waitcnt vmcnt(" #N ") lgkmcnt(0)\n\ts_barrier":::"memory")

__device__ __forceinline__ void qkt(f32x16&p0,f32x16&p1,const char*Kslot,const bf16x8*qr,const f32x16&negm,int r32,int hi){
  const char*kb=Kslot+hi*1024+r32*16;
  #pragma unroll
  for(int d0=0;d0<4;++d0){
    const bf16x8 b0=*reinterpret_cast<const bf16x8*>(kb+d0*2048);
    const bf16x8 b1=*reinterpret_cast<const bf16x8*>(kb+d0*2048+512);
    if(d0==0){p0=__builtin_amdgcn_mfma_f32_32x32x16_bf16(b0,qr[0],negm,0,0,0);p1=__builtin_amdgcn_mfma_f32_32x32x16_bf16(b1,qr[0],negm,0,0,0);}
    else{p0=__builtin_amdgcn_mfma_f32_32x32x16_bf16(b0,qr[d0],p0,0,0,0);p1=__builtin_amdgcn_mfma_f32_32x32x16_bf16(b1,qr[d0],p1,0,0,0);}}
}
typedef __attribute__((address_space(3))) const char* lds_cptr;
typedef short v4i16_t __attribute__((ext_vector_type(4)));
__device__ __forceinline__ void kload8(bf16x8*kf,lds_cptr kp){
  kf[0]=*(const __attribute__((address_space(3))) bf16x8*)(kp);      kf[1]=*(const __attribute__((address_space(3))) bf16x8*)(kp+512);
  kf[2]=*(const __attribute__((address_space(3))) bf16x8*)(kp+2048); kf[3]=*(const __attribute__((address_space(3))) bf16x8*)(kp+2560);
  kf[4]=*(const __attribute__((address_space(3))) bf16x8*)(kp+4096); kf[5]=*(const __attribute__((address_space(3))) bf16x8*)(kp+4608);
  kf[6]=*(const __attribute__((address_space(3))) bf16x8*)(kp+6144); kf[7]=*(const __attribute__((address_space(3))) bf16x8*)(kp+6656);
}
__device__ __forceinline__ void kload2(bf16x8*kf,lds_cptr kp,int j){ kf[2*j]=*(const __attribute__((address_space(3))) bf16x8*)(kp+j*2048); kf[2*j+1]=*(const __attribute__((address_space(3))) bf16x8*)(kp+j*2048+512); }
__device__ __forceinline__ s16x4 vtr(lds_cptr p){ return __builtin_bit_cast(s16x4,__builtin_amdgcn_ds_read_tr16_b64_v4i16((__attribute__((address_space(3))) v4i16_t*)p)); }
__device__ __forceinline__ float rowmax(const f32x16&p0,const f32x16&p1){
  float a=max3f(p0[0],p0[1],p1[0]),b=max3f(p0[2],p0[3],p1[1]);a=max3f(a,p1[2],p1[3]);
  #pragma unroll
  for(int r=4;r<16;r+=4){a=max3f(a,p0[r],p0[r+1]);b=max3f(b,p0[r+2],p0[r+3]);a=max3f(a,p1[r],p1[r+1]);b=max3f(b,p1[r+2],p1[r+3]);}
  const float m=max2f(a,b);
  auto rr=__builtin_amdgcn_permlane32_swap(__float_as_uint(m),__float_as_uint(m),false,false);
  return max2f(__uint_as_float(rr[0]),__uint_as_float(rr[1]));
}
__device__ __forceinline__ void pv(f32x16*o,int vb,bf16x8 pa0,bf16x8 pa1,bf16x8 pa2,bf16x8 pa3){
  #pragma unroll
  for(int d0=0;d0<2;++d0){s16x4 lo[4],hi[4];
    #pragma unroll
    for(int ks=0;ks<4;++ks){
      asm volatile("ds_read_b64_tr_b16 %0,%1 offset:%c2":"=&v"(lo[ks]):"v"(vb),"i"(d0*4096+ks*1024):"memory");
      asm volatile("ds_read_b64_tr_b16 %0,%1 offset:%c2":"=&v"(hi[ks]):"v"(vb),"i"(d0*4096+ks*1024+512):"memory");}
    asm volatile("s_waitcnt lgkmcnt(0)":::"memory");SBAR();
    #define PK(k) (bf16x8){lo[k][0],lo[k][1],lo[k][2],lo[k][3],hi[k][0],hi[k][1],hi[k][2],hi[k][3]}
    o[d0]=__builtin_amdgcn_mfma_f32_32x32x16_bf16(pa0,PK(0),o[d0],0,0,0);
    o[d0]=__builtin_amdgcn_mfma_f32_32x32x16_bf16(pa1,PK(1),o[d0],0,0,0);
    o[d0]=__builtin_amdgcn_mfma_f32_32x32x16_bf16(pa2,PK(2),o[d0],0,0,0);
    o[d0]=__builtin_amdgcn_mfma_f32_32x32x16_bf16(pa3,PK(3),o[d0],0,0,0);
    #undef PK
  }
}

#ifndef ATTN_STORE16
#define ATTN_STORE16(p,v) (*(u32x4*)(p)=(v))
#endif
struct AU { const bf16* Qp; const bf16* Kp; const bf16* Vp; bf16* Op; int qrow0, lat_row0, ctx_row0, nlat_t, NT; };
struct NoMask { __device__ __forceinline__ void apply(f32x16&,f32x16&,int,int)const{} };
typedef __attribute__((address_space(3))) const float* lds_cfptr;
struct NAMask { lds_cfptr tb0; int r, rs, rs_min, cb;
  __device__ __forceinline__ void apply(f32x16&p0,f32x16&p1,int t,int hi)const{
    if(t<4)return;
    const int kr=rs_min+t-4; const float NEG=-INFINITY;
    if((unsigned)(kr-rs)>7u){
      #pragma unroll
      for(int i=0;i<16;++i){p0[i]=NEG;p1[i]=NEG;}
      return; }
    const lds_cfptr tb=tb0+(kr-r+7)*32+4*hi;
    #pragma unroll
    for(int i=0;i<16;++i){ const int k0=(i&3)+8*(i>>2); const int d0=cb+k0, d1=cb+k0+32;
      const float b0=tb[k0], b1=tb[k0+32];
      p0[i]=((unsigned)d0<=15u)?p0[i]+b0:NEG; p1[i]=((unsigned)d1<=15u)?p1[i]+b1:NEG; }
  }
};
template<int THRL,int PITCH,class MaskT> __device__ __forceinline__ void attn_unit(const AU& u,char*shm,const MaskT& mk){
  const int tid=threadIdx.x,lane=tid&63,r32=lane&31,hi=lane>>5; const int wid=__builtin_amdgcn_readfirstlane(tid>>6);
  const bf16*Qw=u.Qp+(long)(u.qrow0+wid*QBLK)*PITCH;
  const bf16*Kh=u.Kp,*Vh=u.Vp;
  const unsigned lds0=(unsigned)(uintptr_t)shm;
  float*wsf=(float*)(shm+LDS_WS)+wid*64;
  const bf16*ksrc=Kh+(long)lane*PITCH+wid*8;
  const bf16*vsrc=Vh+(long)(16*(wid&3)+(lane>>2))*PITCH+(wid>>2)*32+(lane&3)*8;
  const unsigned kdst=lds0+LDS_K+wid*1024, vdst=lds0+LDS_V+wid*1024;
  #define TROW(t) ((long)((t)<u.nlat_t?u.lat_row0+KVBLK*(t):u.ctx_row0+KVBLK*((t)-u.nlat_t))*PITCH)
  #define DMA_K(t,slot) glds16(ksrc+TROW(t),(unsigned)__builtin_amdgcn_readfirstlane(kdst+(slot)))
  #define DMA_V(t,slot) glds16(vsrc+TROW(t),(unsigned)__builtin_amdgcn_readfirstlane(vdst+(slot)))
  const int vb0=(int)(lds0+LDS_V)+((lane>>4)&1)*32+(lane&3)*8+(4*hi+((lane&15)>>2))*64;
  const char*Kbase=shm+LDS_K; bf16x8 kf[8];
  const lds_cptr shm3=(lds_cptr)shm; const lds_cptr kp0=shm3+LDS_K+hi*1024+r32*16; const lds_cptr vp0=shm3+LDS_V+((lane>>4)&1)*32+(lane&3)*8+(4*hi+((lane&15)>>2))*64;
  const int NT=u.NT;
  DMA_K(0,0);DMA_V(0,0);DMA_K(1,SLOTB);
  bf16x8 qr[4];
  #pragma unroll
  for(int d0=0;d0<4;++d0)qr[d0]=*reinterpret_cast<const bf16x8*>(&Qw[(long)r32*PITCH+d0*16+hi*8]);
  float mhat=0.f,l_reg=0.f;f32x16 o[2];o[0]=f32x16{};o[1]=f32x16{};f32x16 negm=f32x16{};asm volatile("":"+v"(negm));
  #define CMASK(P0,P1,t) mk.apply(P0,P1,(t),hi)
  bool resc=false;
  #define START(P0,P1) do{ const float rm=rowmax(P0,P1); resc=false; \
    { const float dl=rm; mhat=fadd_s(mhat,dl); \
      _Pragma("unroll") for(int r=0;r<16;++r){P0[r]=fsub_s(P0[r],dl);P1[r]=fsub_s(P1[r],dl);} \
      _Pragma("unroll") for(int r=0;r<16;++r)negm[r]=-mhat; asm volatile("":"+v"(negm)); } \
    _Pragma("unroll") for(int r=0;r<16;++r)P0[r]=__builtin_amdgcn_exp2f(P0[r]); }while(0)
  #define RESC() do{ if(resc){ asm volatile("s_waitcnt lgkmcnt(0)":::"memory"); \
      _Pragma("unroll") for(int d_=0;d_<2;++d_) _Pragma("unroll") for(int r=0;r<16;++r)o[d_][r]*=wsf[crow(r,hi)]; } }while(0)
  f32x16 pA0,pA1,pB0,pB1;
  int sl_prev=0,sl_cur=0,sl_next=SLOTB;
  #define ROT() do{sl_prev=sl_cur;sl_cur=sl_next;sl_next=(sl_next==(NSLOT-1)*SLOTB)?0:sl_next+SLOTB;}while(0)
  DMA_K(2,2*SLOTB);
  WAIT_BAR(3);
  qkt(pA0,pA1,Kbase,qr,negm,r32,hi);asm volatile("s_nop 15\n\ts_nop 7":"+v"(pA0),"+v"(pA1));CMASK(pA0,pA1,0);
  START(pA0,pA1);
  _Pragma("unroll") for(int r=0;r<16;++r)pA1[r]=__builtin_amdgcn_exp2f(pA1[r]);
  WAIT_BAR(0);
  DMA_K(3,0);DMA_V(1,SLOTB);
  ROT();
  kload8(kf,kp0+sl_cur);
  WAIT_BAR(2);
  s16x4 vlo[8],vhi[8]; u32x4 pw0,pw1,pw2,pw3;
  #define PKW(P,B) cvtpk_s(P[B],P[B+1])
  #define PAF(k) __builtin_bit_cast(bf16x8,pw##k)
  #define VFR(i) (bf16x8){vlo[i][0],vlo[i][1],vlo[i][2],vlo[i][3],vhi[i][0],vhi[i][1],vhi[i][2],vhi[i][3]}
  #define PIN(x) asm volatile("":"+v"(x))
  #define MX3(a,b,c) __builtin_fmaxf(__builtin_fmaxf((a),(b)),(c))
  #define GAPA(MF,A0,A1,A2,A3,W0,W1,PW) do{ MF; sacc+=A0; sacc+=A1; sacc+=A2; sacc+=A3; PIN(sacc); W0; W1; PIN(PW); SBAR(); }while(0)
  #define EX(v) __builtin_amdgcn_exp2f(v)
  #define GAPB(MF,X,B) do{ MF; X[B]=EX(X[B]); X[B+1]=EX(X[B+1]); X[B+2]=EX(X[B+2]); X[B+3]=EX(X[B+3]); PIN(X); SBAR(); }while(0)
  #define VRD(i) do{ vlo[i]=vtr(vp_+(((i)>>2)*4096+((i)&3)*1024)); vhi[i]=vtr(vp_+(((i)>>2)*4096+((i)&3)*1024+512)); }while(0)
  #define KRD(G,j) do{ if(G){ kload2(kf,kp0+sl_next,j); SBAR(); } }while(0)
  #define STEP(C0,C1,P0,P1,t,GK,GV,GL) do{ SBAR(); \
    const lds_cptr vp_=vp0+sl_prev; \
    VRD(0); SBAR(); float sacc=(P0[0]+P0[1]); \
    GAPA(C0=__builtin_amdgcn_mfma_f32_32x32x16_bf16(kf[0],qr[0],negm,0,0,0), P0[2],P0[3],P0[4],P0[5],     pw0[0]=PKW(P0,0), pw0[1]=PKW(P0,2), pw0); \
    VRD(4); SBAR(); GAPA(C1=__builtin_amdgcn_mfma_f32_32x32x16_bf16(kf[1],qr[0],negm,0,0,0), P0[6],P0[7],P0[8],P0[9],     pw0[2]=PKW(P0,4), pw0[3]=PKW(P0,6), pw0); \
    VRD(1); SBAR(); GAPA(C0=__builtin_amdgcn_mfma_f32_32x32x16_bf16(kf[2],qr[1],C0,0,0,0),   P0[10],P0[11],P0[12],P0[13], pw1[0]=PKW(P0,8), pw1[1]=PKW(P0,10), pw1); \
    VRD(5); SBAR(); GAPA(C1=__builtin_amdgcn_mfma_f32_32x32x16_bf16(kf[3],qr[1],C1,0,0,0),   P0[14],P0[15],P1[0],P1[1],   pw1[2]=PKW(P0,12),pw1[3]=PKW(P0,14), pw1); \
    VRD(2); SBAR(); GAPA(C0=__builtin_amdgcn_mfma_f32_32x32x16_bf16(kf[4],qr[2],C0,0,0,0),   P1[2],P1[3],P1[4],P1[5],     pw2[0]=PKW(P1,0), pw2[1]=PKW(P1,2), pw2); \
    VRD(6); SBAR(); GAPA(C1=__builtin_amdgcn_mfma_f32_32x32x16_bf16(kf[5],qr[2],C1,0,0,0),   P1[6],P1[7],P1[8],P1[9],     pw2[2]=PKW(P1,4), pw2[3]=PKW(P1,6), pw2); \
    VRD(3); SBAR(); GAPA(C0=__builtin_amdgcn_mfma_f32_32x32x16_bf16(kf[6],qr[3],C0,0,0,0),   P1[10],P1[11],P1[12],P1[13], pw3[0]=PKW(P1,8), pw3[1]=PKW(P1,10), pw3); \
    VRD(7); SBAR(); GAPA(C1=__builtin_amdgcn_mfma_f32_32x32x16_bf16(kf[7],qr[3],C1,0,0,0),   P1[14],P1[15],0.f,0.f,       pw3[2]=PKW(P1,12),pw3[3]=PKW(P1,14), pw3); \
    l_reg+=sacc; \
    if(GK){DMA_K((t)+3,sl_cur);} if(GV){DMA_V((t)+1,sl_next);} \
    CMASK(C0,C1,t); \
    { float a=MX3(C0[0],C0[1],C1[0]),b=MX3(C0[2],C0[3],C1[1]); a=MX3(a,C1[2],C1[3]); \
      _Pragma("unroll") for(int r=4;r<16;r+=4){a=MX3(a,C0[r],C0[r+1]);b=MX3(b,C0[r+2],C0[r+3]);a=MX3(a,C1[r],C1[r+1]);b=MX3(b,C1[r+2],C1[r+3]);} \
      float rm=__builtin_fmaxf(a,b); { auto rr=__builtin_amdgcn_permlane32_swap(__float_as_uint(rm),__float_as_uint(rm),false,false); rm=__builtin_fmaxf(__uint_as_float(rr[0]),__uint_as_float(rr[1])); } \
      resc=false; \
      if(__builtin_expect(__any(rm>(float)THRL),0)){ const float dl=__builtin_fmaxf(rm,0.f); mhat+=dl; \
        _Pragma("unroll") for(int r=0;r<16;++r){C0[r]-=dl;C1[r]-=dl;} \
        _Pragma("unroll") for(int r=0;r<16;++r)negm[r]=-mhat; asm volatile("":"+v"(negm)); \
        const float f=__builtin_amdgcn_exp2f(-dl); l_reg*=f; if(hi==0)wsf[r32]=f; resc=true; } } \
    SBAR(); \
    GAPB(o[0]=__builtin_amdgcn_mfma_f32_32x32x16_bf16(PAF(0),VFR(0),o[0],0,0,0), C0,0); \
    GAPB(o[1]=__builtin_amdgcn_mfma_f32_32x32x16_bf16(PAF(0),VFR(4),o[1],0,0,0), C0,4); \
    KRD(GL,0); GAPB(o[0]=__builtin_amdgcn_mfma_f32_32x32x16_bf16(PAF(1),VFR(1),o[0],0,0,0), C0,8); \
    KRD(GL,1); GAPB(o[1]=__builtin_amdgcn_mfma_f32_32x32x16_bf16(PAF(1),VFR(5),o[1],0,0,0), C0,12); \
    KRD(GL,2); GAPB(o[0]=__builtin_amdgcn_mfma_f32_32x32x16_bf16(PAF(2),VFR(2),o[0],0,0,0), C1,0); \
    KRD(GL,3); GAPB(o[1]=__builtin_amdgcn_mfma_f32_32x32x16_bf16(PAF(2),VFR(6),o[1],0,0,0), C1,4); \
    GAPB(o[0]=__builtin_amdgcn_mfma_f32_32x32x16_bf16(PAF(3),VFR(3),o[0],0,0,0), C1,8); \
    GAPB(o[1]=__builtin_amdgcn_mfma_f32_32x32x16_bf16(PAF(3),VFR(7),o[1],0,0,0), C1,12); \
    }while(0)
  int t=1;
  #undef CMASK
  #define CMASK(P0,P1,t) mk.apply(P0,P1,(t),hi)
  for(;t+5<NT;t+=2){
    STEP(pB0,pB1,pA0,pA1,t,true,true,true);     WAIT_BAR(2); RESC(); ROT();
    STEP(pA0,pA1,pB0,pB1,t+1,true,true,true);   WAIT_BAR(2); RESC(); ROT();
  }
  #undef CMASK
  #define CMASK(P0,P1,t) mk.apply(P0,P1,(t),hi)
  #define ENDW(tt) do{ if((tt)+3<NT){WAIT_BAR(2);} else if((tt)+2<NT){WAIT_BAR(1);} else {WAIT_BAR(0);} }while(0)
  for(;t+1<NT;t+=2){
    STEP(pB0,pB1,pA0,pA1,t,(t+3<NT),(t+1<NT),(t+1<NT));       ENDW(t);   RESC(); ROT();
    STEP(pA0,pA1,pB0,pB1,t+1,(t+4<NT),(t+2<NT),(t+2<NT));     ENDW(t+1); RESC(); ROT();
  }
  STEP(pB0,pB1,pA0,pA1,NT-1,false,false,false); RESC();
  { float sacc=pB0[0]+pB0[1]; _Pragma("unroll") for(int r=2;r<16;++r)sacc+=pB0[r]; _Pragma("unroll") for(int r=0;r<16;++r)sacc+=pB1[r]; l_reg+=sacc;
    pw0=(u32x4){PKW(pB0,0),PKW(pB0,2),PKW(pB0,4),PKW(pB0,6)};pw1=(u32x4){PKW(pB0,8),PKW(pB0,10),PKW(pB0,12),PKW(pB0,14)};pw2=(u32x4){PKW(pB1,0),PKW(pB1,2),PKW(pB1,4),PKW(pB1,6)};pw3=(u32x4){PKW(pB1,8),PKW(pB1,10),PKW(pB1,12),PKW(pB1,14)};
    SBAR(); pv(o,vb0+sl_cur,PAF(0),PAF(1),PAF(2),PAF(3)); }
  #undef PKW
  #undef PAF
  #undef VFR
  #undef PIN
  #undef MX3
  #undef GAPA
  #undef GAPB
  #undef EX
  #undef VRD
  #undef KRD
  #undef STEP
  #undef ENDW
  {auto rr=__builtin_amdgcn_permlane32_swap(__float_as_uint(l_reg),__float_as_uint(l_reg),false,false);l_reg=__uint_as_float(rr[0])+__uint_as_float(rr[1]);}
  if(hi==0)wsf[32+r32]=l_reg;asm volatile("s_waitcnt lgkmcnt(0)":::"memory");
  float rli[16];
  #pragma unroll
  for(int r=0;r<16;++r)rli[r]=__builtin_amdgcn_rcpf(wsf[32+crow(r,hi)]);
  bf16*Ow=u.Op+(long)(u.qrow0+wid*QBLK)*OPITCH;
  { bf16*stg=(bf16*)(shm+LDS_OST)+wid*2048;
    #pragma unroll
    for(int r=0;r<16;++r){const int orow=crow(r,hi);
      #pragma unroll
      for(int d0=0;d0<2;++d0)stg[orow*64+d0*32+r32]=__float2bfloat16(o[d0][r]*rli[r]);}
    asm volatile("s_waitcnt lgkmcnt(0)":::"memory");
    #pragma unroll
    for(int i=0;i<4;++i){const int row=i*8+(lane>>3),ch=lane&7; const u32x4 v=*(const u32x4*)(stg+row*64+ch*8); ATTN_STORE16(Ow+(long)row*OPITCH+ch*8,v);} }
  asm volatile("s_waitcnt lgkmcnt(0)\n\ts_barrier":::"memory");
  #undef DMA_K
  #undef TROW
  #undef DMA_V
  #undef CMASK
  #undef START
  #undef RESC
  #undef ROT
}
constexpr int ATTN_LDS_BYTES=LDS_BYTES;
#undef SBAR
#undef WAIT_BAR
}

struct Params { const float* in[26]; float* out; unsigned char* ws; int ph_lo, ph_hi; };
struct Ctx { LAS unsigned char* lds; int tid, lane, wave, vcu, G, gw, NGW; };
enum { I_X = 0, I_C, I_CTX, I_CCTX, I_ADAW, I_ADAB, I_LNG, I_LNB, I_W0IN, I_W0OUT, I_LQ1, I_LK1, I_LQ2, I_LK2, I_SUBLN, I_QN, I_KN,
       I_W1IN, I_W1OUT, I_RPB, I_POOLW, I_POOLS, I_ROUTER, I_WG, I_WU, I_WD };

__device__ __forceinline__ const float* mod_row(const Params& p, int layer, int row) {
    return (const float*)(p.ws + WS_MOD) + (size_t)(layer * 9 + (row < LAT ? (row >> 11) : 8)) * 6144;
}

__device__ __forceinline__ void ph_prologue(const Params& p, const Ctx& c) {
    const float* cin = p.in[I_C]; const float* cctx = p.in[I_CCTX]; const float* ada_w = p.in[I_ADAW]; const float* ada_b = p.in[I_ADAB];
    float* MOD = (float*)(p.ws + WS_MOD);
    LAS float* sc = (LAS float*)c.lds;
    LAS float* red = sc + 9 * 1024;
    for (int i = c.tid; i < 9 * 1024; i += 512) { const float v = i < 8192 ? cin[i] : cctx[i - 8192]; sc[i] = v / (1.f + expf(-v)); }
    __syncthreads();
    for (int u = c.vcu; u < 256; u += c.G) {
        const int layer = u >> 7, j0 = (u & 127) * 48;
        const int jc = c.tid % 48, kg = c.tid / 48;
        if (kg < 10) {
            float acc[9];
#pragma unroll
            for (int m = 0; m < 9; ++m) acc[m] = 0.f;
            const float* wp = ada_w + (size_t)layer * 1024 * 6144 + j0 + jc;
            for (int k = kg; k < 1024; k += 10) {
                const float w = wp[(size_t)k * 6144];
#pragma unroll
                for (int m = 0; m < 9; ++m) acc[m] += sc[m * 1024 + k] * w;
            }
#pragma unroll
            for (int m = 0; m < 9; ++m) red[(kg * 9 + m) * 48 + jc] = acc[m];
        }
        __syncthreads();
        if (c.tid < 432) {
            const int m = c.tid / 48, j = c.tid % 48; float s = 0.f;
#pragma unroll
            for (int g = 0; g < 10; ++g) s += red[(g * 9 + m) * 48 + j];
            MOD[(size_t)(layer * 9 + m) * 6144 + j0 + j] = s + ada_b[layer * 6144 + j0 + j];
        }
        __syncthreads();
    }
    if (c.vcu == 0) {
        f32x2* R = (f32x2*)(p.ws + WS_ROPE);
        for (int i = c.tid; i < 1024; i += 512) {
            const int pos = i >> 4, f = i & 15;
            const float inv = exp2f(-(float)f * (13.287712379549449f / 16.f));
            const float a = (float)pos * inv;
            const float k = rintf(a * 0.15915494309189535f);
            float rr = fmaf(-k, 6.28125f, a); rr = fmaf(-k, 1.9353071795864769e-3f, rr);
            R[i] = (f32x2){__cosf(rr), __sinf(rr)};
        }
    }
}


__device__ __forceinline__ void transpose_item(const float* W, int ldw, int k0, int n0, bf16* WT, int Kd, int drow0, LAS float* scr, int lane) {
#pragma unroll 8
    for (int i = 0; i < 32; ++i) { const int kk = 2 * i + (lane >> 5); scr[kk * 33 + (lane & 31)] = W[(size_t)(k0 + kk) * ldw + n0 + (lane & 31)]; }
    asm volatile("s_waitcnt lgkmcnt(0)" ::: "memory");
    const int ch = lane & 7;
#pragma unroll
    for (int j = 0; j < 4; ++j) { const int n = (lane >> 3) + 8 * j; const LAS float* sp = scr + (8 * ch) * 33 + n;
        v4u o; o.x = pk2(sp[0 * 33], sp[1 * 33]); o.y = pk2(sp[2 * 33], sp[3 * 33]); o.z = pk2(sp[4 * 33], sp[5 * 33]); o.w = pk2(sp[6 * 33], sp[7 * 33]);
        *(v4u*)(WT + (size_t)(drow0 + n) * Kd + k0 + 8 * ch) = o; }
    asm volatile("s_waitcnt lgkmcnt(0)" ::: "memory");
}
__device__ __forceinline__ void ph_transposes(const Params& p, const Ctx& c) {
    LAS float* scr = (LAS float*)(c.lds + c.wave * 16384);
    constexpr int I0 = 16 * 72, I1 = 16 * 32, I2 = 16 * 64, I3 = 16 * 32, ISM = I0 + I1 + I2 + I3, IEX = 3072, NIT = ISM + 32 * IEX;
    for (int it = c.gw; it < NIT; it += c.NGW) {
        int r = it;
        if (r < I0) { transpose_item(p.in[I_W0IN], EIN, 64 * (r / 72), 32 * (r % 72), (bf16*)(p.ws + WS_W0IN), DM, 32 * (r % 72), scr, c.lane); continue; } r -= I0;
        if (r < I1) { transpose_item(p.in[I_W0OUT], DM, 64 * (r / 32), 32 * (r % 32), (bf16*)(p.ws + WS_W0OUT), DM, 32 * (r % 32), scr, c.lane); continue; } r -= I1;
        if (r < I2) { transpose_item(p.in[I_W1IN], OIN, 64 * (r / 64), 32 * (r % 64), (bf16*)(p.ws + WS_W1IN), DM, 32 * (r % 64), scr, c.lane); continue; } r -= I2;
        if (r < I3) { transpose_item(p.in[I_W1OUT], DM, 64 * (r / 32), 32 * (r % 32), (bf16*)(p.ws + WS_W1OUT), DM, 32 * (r % 32), scr, c.lane); continue; } r -= I3;
        const int ie = r / IEX, q = r - ie * IEX, layer = ie >> 4, e = ie & 15, which = q >> 10, idx = q & 1023;
        if (which < 2) {
            const float* W = (which == 0 ? p.in[I_WG] : p.in[I_WU]) + (size_t)ie * DM * FF;
            const int k0 = 64 * (idx >> 6), n0 = 32 * (idx & 63);
            bf16* WT = (bf16*)(p.ws + WS_WGU + (size_t)layer * WS_MOE_LSTRIDE) + (size_t)e * 4096 * DM;
            transpose_item(W, FF, k0, n0, WT, DM, (n0 >> 7) * 256 + (n0 & 127) + which * 128, scr, c.lane);
        } else {
            const float* W = p.in[I_WD] + (size_t)ie * FF * DM;
            const int k0 = 64 * (idx >> 5), n0 = 32 * (idx & 31);
            bf16* WT = (bf16*)(p.ws + WS_WDN + (size_t)layer * WS_MOE_LSTRIDE) + (size_t)e * DM * FF;
            transpose_item(W, DM, k0, n0, WT, FF, n0, scr, c.lane);
        }
    }
}

__device__ __forceinline__ void ph_modulate0(const Params& p, const Ctx& c) {
    bf16* HB = (bf16*)(p.ws + WS_HB);
    for (int row = c.gw; row < NTOK; row += c.NGW) {
        const float* src = row < LAT ? p.in[I_X] + (size_t)row * DM : p.in[I_CTX] + (size_t)(row - LAT) * DM;
        const float* mod = mod_row(p, 0, row);
#pragma unroll
        for (int j = 0; j < 4; ++j) {
            const int col = 4 * c.lane + 256 * j;
            const f32x4 v = *(const f32x4*)(src + col), sh = *(const f32x4*)(mod + col), s = *(const f32x4*)(mod + 1024 + col);
            const f32x4 h = v * (s + 1.f) + sh;
            *(v2u*)(HB + (size_t)row * DM + col) = (v2u){pk2(h.x, h.y), pk2(h.z, h.w)};
        }
    }
}

struct NG { const bf16* A; int lda; const float* W0; const float* W1; int ldw; size_t wstride; int Mb; int row_begin, row_end, col_begin, col_end, K; };
template <int NB, class Epi>
__device__ __forceinline__ void ngemm(const NG& g, const Ctx& c, const Epi& epi) {
    const int nmt = (g.row_end - g.row_begin) / 32, nnt = (g.col_end - g.col_begin) / 32;
    const int l31 = c.lane & 31, lh = c.lane >> 5;
    for (int t = c.gw; t < nmt * nnt; t += c.NGW) {
        const int mt = t / nnt, nt = t % nnt;
        const int row0 = g.row_begin + mt * 32, col0 = g.col_begin + nt * 32;
        const int e = row0 / g.Mb;
        const bf16* ap = g.A + (size_t)(row0 + l31) * g.lda + lh;
        const float* bp0 = g.W0 + (size_t)e * g.wstride + (size_t)lh * g.ldw + col0 + l31;
        const float* bp1 = NB == 2 ? g.W1 + (size_t)e * g.wstride + (size_t)lh * g.ldw + col0 + l31 : nullptr;
        f32x16 acc0 = {}, acc1 = {};
#pragma unroll 8
        for (int k = 0; k < g.K; k += 2) {
            const float a = bf2f((unsigned)ap[k]);
            const float b0 = bp0[(size_t)k * g.ldw];
            acc0 = __builtin_amdgcn_mfma_f32_32x32x2f32(a, b0, acc0, 0, 0, 0);
            if (NB == 2) { const float b1 = bp1[(size_t)k * g.ldw]; acc1 = __builtin_amdgcn_mfma_f32_32x32x2f32(a, b1, acc1, 0, 0, 0); }
        }
#pragma unroll
        for (int r = 0; r < 16; ++r) {
            const int row = row0 + (r & 3) + 8 * (r >> 2) + 4 * lh, col = col0 + l31;
            epi(row, col, acc0[r], acc1[r]);
        }
    }
}
struct EpiF32 { float* O; int ldc; __device__ __forceinline__ void operator()(int row, int col, float v0, float) const { O[(size_t)row * ldc + col] = v0; } };
struct EpiBf { bf16* O; int ldc; int scale_cols; float sc; __device__ __forceinline__ void operator()(int row, int col, float v0, float) const { O[(size_t)row * ldc + col] = (bf16)f2bf(col < scale_cols ? v0 * sc : v0); } };
struct EpiSwiglu { bf16* O; __device__ __forceinline__ void operator()(int row, int col, float g, float u) const { const float s = g / (1.f + __expf(-g)); O[(size_t)row * FF + col] = (bf16)f2bf(s * u); } };
struct EpiGate { bf16* O; const float* gate; __device__ __forceinline__ void operator()(int row, int col, float v0, float) const { O[(size_t)row * DM + col] = (bf16)f2bf(v0 * gate[row]); } };

template <bool F32IN> __device__ __forceinline__ void ph_qkv_post(const Params& p, const Ctx& c) {
    const float* PF = (const float*)(p.ws + WS_PF);
    bf16* QKV = (bf16*)(p.ws + WS_QKV);
    const f32x2* R = (const f32x2*)(p.ws + WS_ROPE);
    const float* qn = p.in[I_QN]; const float* kn = p.in[I_KN];
    const int d = c.lane;
    const float qg = qn[d], kg = kn[d];
    for (int row = c.gw; row < NTOK; row += c.NGW) {
        const bool lat = row < LAT;
        const int t = row & 2047;
        const int pos = (d < 32) ? (t >> 6) : (t & 63);
        const f32x2 cs = R[pos * 16 + (d & 15)];
        const bool first = (d & 16) == 0;
        float vv[36];
#pragma unroll
        for (int hs = 0; hs < 36; ++hs) vv[hs] = F32IN ? PF[(size_t)row * EIN + hs * 64 + d] : bf2f((unsigned)QKV[(size_t)row * EIN + hs * 64 + d]);
#pragma unroll
        for (int hs = 0; hs < 36; ++hs) {
            float v = vv[hs];
            const bool isq = hs < 8 || (hs >= 24 && hs < 32);
            const bool isk = (hs >= 8 && hs < 16) || hs == 32 || hs == 33;
            const bool nrm = hs >= 24 && hs < 34;
            if (nrm) { const float ss = wave_sum(v * v); v = v * rsqrtf(ss * (1.f / 64.f) + RMS_EPS) * (hs < 32 ? qg : kg); }
            if ((isq || isk) && lat) { const float pr = __shfl_xor(v, 16); v = first ? v * cs.x - pr * cs.y : v * cs.x + pr * cs.y; }
            if (isq) v *= C2;
            QKV[(size_t)row * EIN + hs * 64 + d] = (bf16)f2bf(v);
        }
    }
}

__device__ __forceinline__ void ph_attn0_naive(const Params& p, const Ctx& c) {
    const bf16* QKV = (const bf16*)(p.ws + WS_QKV);
    bf16* CC = (bf16*)(p.ws + WS_CC);
    bf16* AO = (bf16*)(p.ws + WS_AO);
    LAS float* Ks = (LAS float*)c.lds;
    LAS float* Vs = Ks + 4096;
    for (int u = c.vcu; u < 960; u += c.G) {
        const bool isctx = u >= 768;
        int b, vh, qrow, ntiles; bool active = true;
        if (!isctx) { b = u / 96; const int r = u % 96; vh = r >> 2; qrow = b * SEQ + (r & 3) * 512 + c.tid; ntiles = 36; }
        else { const int uu = u - 768; b = uu / 24; vh = uu % 24; qrow = LAT + b * NCTX + (c.tid & 255); active = c.tid < 256; ntiles = 4; }
        int qcol, kcol, vcol;
        if (vh < 16) { const int a = vh >> 2, s = (vh >> 1) & 1, half = vh & 1; qcol = a * 128 + s * 64; kcol = 512 + a * 128 + s * 64; vcol = 1024 + a * 128 + half * 64; }
        else { const int h = vh - 16; qcol = 1536 + h * 64; kcol = 2048 + (h >> 2) * 64; vcol = 2176 + (h >> 2) * 64; }
        float q[64], o[64];
#pragma unroll
        for (int i = 0; i < 8; ++i) { const v4u w = *(const v4u*)(QKV + (size_t)qrow * EIN + qcol + 8 * i); unpack8(w, q + 8 * i); }
#pragma unroll
        for (int i = 0; i < 64; ++i) o[i] = 0.f;
        float m = -1e30f, l = 0.f;
        for (int t = 0; t < ntiles; ++t) {
            const int krow0 = isctx ? LAT + b * NCTX + 64 * t : (t < 32 ? b * SEQ + 64 * t : LAT + b * NCTX + 64 * (t - 32));
            __syncthreads();
            { const int r = c.tid >> 3, ch = c.tid & 7; float f[8];
              const v4u kw = *(const v4u*)(QKV + (size_t)(krow0 + r) * EIN + kcol + ch * 8); unpack8(kw, f);
#pragma unroll
              for (int j = 0; j < 8; ++j) Ks[r * 64 + ch * 8 + j] = f[j];
              const v4u vw = *(const v4u*)(QKV + (size_t)(krow0 + r) * EIN + vcol + ch * 8); unpack8(vw, f);
#pragma unroll
              for (int j = 0; j < 8; ++j) Vs[r * 64 + ch * 8 + j] = f[j]; }
            __syncthreads();
            if (active) {
                for (int kk = 0; kk < 64; ++kk) {
                    float s = 0.f;
#pragma unroll
                    for (int dd = 0; dd < 64; ++dd) s += q[dd] * Ks[kk * 64 + dd];
                    const float mn = fmaxf(m, s), al = exp2f(m - mn), pp = exp2f(s - mn);
                    l = l * al + pp; m = mn;
#pragma unroll
                    for (int dd = 0; dd < 64; ++dd) o[dd] = o[dd] * al + pp * Vs[kk * 64 + dd];
                }
            }
        }
        if (active) {
            const float rl = 1.f / l;
            bf16* dst = vh < 16 ? AO + (size_t)qrow * DM + (vh >> 2) * 256 + ((vh >> 1) & 1) * 128 + (vh & 1) * 64 : CC + (size_t)qrow * DM + 512 + (vh - 16) * 64;
            {
#pragma unroll
                for (int i = 0; i < 8; ++i) *(v4u*)(dst + 8 * i) = (v4u){pk2(o[8 * i] * rl, o[8 * i + 1] * rl), pk2(o[8 * i + 2] * rl, o[8 * i + 3] * rl), pk2(o[8 * i + 4] * rl, o[8 * i + 5] * rl), pk2(o[8 * i + 6] * rl, o[8 * i + 7] * rl)}; }
        }
    }
}


__device__ __forceinline__ void ph_attn0_fast(const Params& p, const Ctx& c, char* lds_generic) {
    typedef attn_body::bf16 abf;
    const abf* Q = (const abf*)(p.ws + WS_QKV); abf* CCb = (abf*)(p.ws + WS_CC); abf* AOb = (abf*)(p.ws + WS_AO);
    for (int i = 0;; ++i) {
        const int U = i * c.G + c.vcu;
        if (U >= 1536 + 192) break;
        attn_body::AU u; int vh;
        if (U < 1536) { const int b = U / 192, rem = U - b * 192; vh = rem >> 3; u.qrow0 = b * SEQ + (rem & 7) * 256; u.lat_row0 = b * SEQ; u.ctx_row0 = LAT + b * NCTX; u.nlat_t = 32; u.NT = 36; }
        else { const int uu = U - 1536, b = uu / 24; vh = uu - b * 24; u.qrow0 = LAT + b * NCTX; u.lat_row0 = 0; u.ctx_row0 = LAT + b * NCTX; u.nlat_t = 0; u.NT = 4; }
        int qcol, kcol, vcol; abf* op;
        if (vh < 16) { const int a = vh >> 2, s = (vh >> 1) & 1, half = vh & 1; qcol = a * 128 + s * 64; kcol = 512 + a * 128 + s * 64; vcol = 1024 + a * 128 + half * 64; op = AOb + a * 256 + s * 128 + half * 64; }
        else { const int h = vh - 16; qcol = 1536 + h * 64; kcol = 2048 + (h >> 2) * 64; vcol = 2176 + (h >> 2) * 64; op = CCb + 512 + h * 64; }
        u.Qp = Q + qcol; u.Kp = Q + kcol; u.Vp = Q + vcol; u.Op = op;
        attn_body::attn_unit<8, EIN, attn_body::NoMask>(u, lds_generic, attn_body::NoMask{});
    }
}

__device__ __forceinline__ void ph_attn_combine(const Params& p, const Ctx& c) {
    const bf16* AO = (const bf16*)(p.ws + WS_AO);
    bf16* CC = (bf16*)(p.ws + WS_CC);
    const float d1 = wave_sum(p.in[I_LQ1][c.lane] * p.in[I_LK1][c.lane]);
    const float d2 = wave_sum(p.in[I_LQ2][c.lane] * p.in[I_LK2][c.lane]);
    const float lam = expf(d1) - expf(d2) + LAM_INIT;
    const float g0 = p.in[I_SUBLN][c.lane] * (1.f - LAM_INIT), g1 = p.in[I_SUBLN][c.lane + 64] * (1.f - LAM_INIT);
    for (int it = c.gw; it < NTOK * 4; it += c.NGW) {
        const int row = it >> 2, a = it & 3;
        const bf16* src = AO + (size_t)row * DM + a * 256;
        const float x0 = bf2f((unsigned)src[c.lane]) - lam * bf2f((unsigned)src[128 + c.lane]), x1 = bf2f((unsigned)src[64 + c.lane]) - lam * bf2f((unsigned)src[192 + c.lane]);
        const float ss = wave_sum(x0 * x0 + x1 * x1);
        const float r = rsqrtf(ss * (1.f / 128.f) + RMS_EPS);
        CC[(size_t)row * DM + a * 128 + c.lane] = (bf16)f2bf(x0 * r * g0);
        CC[(size_t)row * DM + a * 128 + 64 + c.lane] = (bf16)f2bf(x1 * r * g1);
    }
}

__device__ __forceinline__ void ph_ln1_router(const Params& p, const Ctx& c, int layer) {
    const float* Y = (const float*)(p.ws + WS_Y);
    float* XS = (float*)(p.ws + WS_XS);
    bf16* HB = (bf16*)(p.ws + WS_HB);
    float* AFF = (float*)(p.ws + WS_AFF);
    const float* lng = p.in[I_LNG] + (size_t)(layer * 2 + 0) * DM; const float* lnb = p.in[I_LNB] + (size_t)(layer * 2 + 0) * DM;
    const float* router = p.in[I_ROUTER] + (size_t)layer * DM * NE;
    LAS f32x4* R = (LAS f32x4*)c.lds;
    for (int idx = c.tid; idx < 4096; idx += 512) { const int e4 = idx & 3, k = idx >> 2, ln = (k & 255) >> 2, q = k & 3, j = k >> 8;
        R[((j * 4 + q) * 4 + e4) * 64 + ln] = *(const f32x4*)(router + (size_t)k * NE + 4 * e4); }
    __syncthreads();
    const int nrows = layer == 0 ? NTOK : LAT;
    const int lane = c.lane;
    for (int row = c.gw; row < nrows; row += c.NGW) {
        const float* xin = layer == 0 ? (row < LAT ? p.in[I_X] + (size_t)row * DM : p.in[I_CTX] + (size_t)(row - LAT) * DM) : XS + (size_t)row * DM;
        const float* mod = mod_row(p, layer, row);
        f32x4 v[4]; float s = 0.f;
#pragma unroll
        for (int j = 0; j < 4; ++j) { const int col = 4 * lane + 256 * j;
            v[j] = *(const f32x4*)(xin + col) * ALPHA + *(const f32x4*)(mod + 2048 + col) * *(const f32x4*)(Y + (size_t)row * DM + col);
            s += (v[j].x + v[j].y) + (v[j].z + v[j].w); }
        const float mean = wave_sum(s) * (1.f / DM); float s2 = 0.f;
#pragma unroll
        for (int j = 0; j < 4; ++j) { v[j] = v[j] - mean; s2 += (v[j].x * v[j].x + v[j].y * v[j].y) + (v[j].z * v[j].z + v[j].w * v[j].w); }
        const float rstd = 1.f / sqrtf(wave_sum(s2) * (1.f / DM) + LN_EPS);
        f32x4 lg[4];
#pragma unroll
        for (int e = 0; e < 4; ++e) lg[e] = (f32x4){0.f, 0.f, 0.f, 0.f};
#pragma unroll
        for (int j = 0; j < 4; ++j) { const int col = 4 * lane + 256 * j;
            const f32x4 x1 = v[j] * rstd * *(const f32x4*)(lng + col) + *(const f32x4*)(lnb + col);
            *(f32x4*)(XS + (size_t)row * DM + col) = x1;
            const f32x4 hm = x1 * (*(const f32x4*)(mod + 4096 + col) + 1.f) + *(const f32x4*)(mod + 3072 + col);
            *(v2u*)(HB + (size_t)row * DM + col) = (v2u){pk2(hm.x, hm.y), pk2(hm.z, hm.w)};
            asm volatile("" ::: "memory");
#pragma unroll
            for (int q = 0; q < 4; ++q) { const float hv = hm[q];
#pragma unroll
                for (int e4 = 0; e4 < 4; ++e4) lg[e4] += R[((j * 4 + q) * 4 + e4) * 64 + lane] * hv; } }
        float w8[8], w4[4], w2[2], w1;
        { const bool hi = (lane & 32) != 0;
#pragma unroll
          for (int i = 0; i < 8; ++i) { const float a0 = lg[i >> 2][i & 3], a1 = lg[2 + (i >> 2)][i & 3]; const float keep = hi ? a1 : a0, send = hi ? a0 : a1; w8[i] = keep + __shfl_xor(send, 32); } }
        { const bool hi = (lane & 16) != 0;
#pragma unroll
          for (int i = 0; i < 4; ++i) { const float keep = hi ? w8[i + 4] : w8[i], send = hi ? w8[i] : w8[i + 4]; w4[i] = keep + __shfl_xor(send, 16); } }
        { const bool hi = (lane & 8) != 0;
#pragma unroll
          for (int i = 0; i < 2; ++i) { const float keep = hi ? w4[i + 2] : w4[i], send = hi ? w4[i] : w4[i + 2]; w2[i] = keep + __shfl_xor(send, 8); } }
        { const bool hi = (lane & 4) != 0; const float keep = hi ? w2[1] : w2[0], send = hi ? w2[0] : w2[1]; w1 = keep + __shfl_xor(send, 4); }
        w1 += __shfl_xor(w1, 2); w1 += __shfl_xor(w1, 1);
        float mx = w1;
#pragma unroll
        for (int o = 4; o < 64; o <<= 1) mx = fmaxf(mx, __shfl_xor(mx, o));
        const float ex = expf(w1 - mx); float den = ex;
#pragma unroll
        for (int o = 4; o < 64; o <<= 1) den += __shfl_xor(den, o);
        if ((lane & 3) == 0) { const int e = ((lane >> 5) & 1) * 8 + ((lane >> 4) & 1) * 4 + ((lane >> 3) & 1) * 2 + ((lane >> 2) & 1); AFF[(size_t)row * NE + e] = ex / den; }
    }
}

__device__ __forceinline__ void ph_topk(const Params& p, const Ctx& c, int layer) {
    const float* AFF = (const float*)(p.ws + WS_AFF);
    int* INV = (int*)(p.ws + WS_INV);
    float* GATE = (float*)(p.ws + WS_GATE);
    const bf16* HB = (const bf16*)(p.ws + WS_HB);
    bf16* XG = (bf16*)(p.ws + WS_XG);
    LAS unsigned* hist = (LAS unsigned*)c.lds;
    LAS unsigned* ctl = hist + 256;
    LAS int* sel = (LAS int*)(c.lds + 2048);
    const int MR = layer == 0 ? MR0 : MR1;
    const int ntasks = layer == 0 ? 256 : 128;
    const int lane = c.lane;
    for (int task = c.vcu; task < ntasks; task += c.G) {
        int set, e, n, cap, rowbase, slotbase;
        if (task < 128) { set = task >> 4; e = task & 15; n = SEQ; cap = 256; rowbase = set * SEQ; slotbase = set * 256; }
        else { const int t2 = task - 128; set = t2 >> 4; e = t2 & 15; n = NCTX; cap = 32; rowbase = LAT + set * NCTX; slotbase = 2048 + set * 32; }
        const bool valid = 4 * c.tid < n;
        unsigned key[4];
#pragma unroll
        for (int q = 0; q < 4; ++q) key[q] = valid ? __float_as_uint(AFF[(size_t)(rowbase + 4 * c.tid + q) * NE + e]) : 0u;
        unsigned prefix = 0u, need = (unsigned)cap;
#pragma unroll 1
        for (int pass = 0; pass < 4; ++pass) {
            const int shift = 24 - 8 * pass;
            if (c.tid < 256) hist[c.tid] = 0u;
            __syncthreads();
            if (valid) {
#pragma unroll
                for (int q = 0; q < 4; ++q) if (pass == 0 || (key[q] >> (shift + 8)) == (prefix >> (shift + 8))) __hip_atomic_fetch_add(&hist[(key[q] >> shift) & 255u], 1u, __ATOMIC_RELAXED, __HIP_MEMORY_SCOPE_WORKGROUP);
            }
            __syncthreads();
            if (c.wave == 0) {
                const unsigned h0 = hist[4 * lane], h1 = hist[4 * lane + 1], h2 = hist[4 * lane + 2], h3 = hist[4 * lane + 3];
                const unsigned tot = h0 + h1 + h2 + h3; unsigned sfx = tot;
#pragma unroll
                for (int o = 1; o < 64; o <<= 1) { const unsigned t = __shfl_down(sfx, o); if (lane + o < 64) sfx += t; }
                const unsigned above = sfx - tot, c3 = above + h3, c2 = c3 + h2, c1 = c2 + h1, c0 = c1 + h0;
                int d = -1; unsigned gtc = 0u;
                if (above < need && need <= c3) { d = 3; gtc = above; }
                else if (c3 < need && need <= c2) { d = 2; gtc = c3; }
                else if (c2 < need && need <= c1) { d = 1; gtc = c2; }
                else if (c1 < need && need <= c0) { d = 0; gtc = c1; }
                if (d >= 0) { ctl[0] = prefix | ((unsigned)(4 * lane + d) << shift); ctl[1] = need - gtc; }
            }
            __syncthreads();
            prefix = ctl[0]; need = ctl[1];
        }
        unsigned ngt = 0u, neq = 0u;
#pragma unroll
        for (int q = 0; q < 4; ++q) { ngt += (valid && key[q] > prefix) ? 1u : 0u; neq += (valid && key[q] == prefix) ? 1u : 0u; }
        const unsigned cnt = ngt | (neq << 16); unsigned inc = cnt;
#pragma unroll
        for (int o = 1; o < 64; o <<= 1) { const unsigned t = __shfl_up(inc, o); if (lane >= o) inc += t; }
        if (lane == 63) ctl[8 + c.wave] = inc;
        __syncthreads();
        unsigned base = 0u;
#pragma unroll
        for (int w = 0; w < 8; ++w) base += (w < c.wave) ? ctl[8 + w] : 0u;
        const unsigned ex = base + inc - cnt; unsigned gtb = ex & 0xffffu, eqb = ex >> 16;
        if (valid) {
#pragma unroll
            for (int q = 0; q < 4; ++q) { const int i = 4 * c.tid + q; int slot = -1;
                if (key[q] > prefix) { slot = (int)(gtb + (eqb < need ? eqb : need)); ++gtb; }
                else if (key[q] == prefix) { if (eqb < need) slot = (int)(gtb + eqb); ++eqb; }
                int gs = -1;
                if (slot >= 0) { gs = e * MR + slotbase + slot; sel[slot] = i; GATE[gs] = __uint_as_float(key[q]); }
                INV[(size_t)(rowbase + i) * NE + e] = gs; }
        }
        __syncthreads();
        for (int sidx = c.wave; sidx < cap; sidx += 8) {
            const bf16* src = HB + (size_t)(rowbase + sel[sidx]) * DM; bf16* dst = XG + (size_t)(e * MR + slotbase + sidx) * DM;
            const v4u a0 = *(const v4u*)(src + 8 * lane), a1 = *(const v4u*)(src + 512 + 8 * lane);
            *(v4u*)(dst + 8 * lane) = a0; *(v4u*)(dst + 512 + 8 * lane) = a1;
        }
        __syncthreads();
    }
}

__device__ __forceinline__ void ph_combine(const Params& p, const Ctx& c, int layer) {
    const bf16* YS = (const bf16*)(p.ws + WS_YS);
    const int* INV = (const int*)(p.ws + WS_INV);
    float* XS = (float*)(p.ws + WS_XS);
    bf16* HB = (bf16*)(p.ws + WS_HB);
    const float* lng = p.in[I_LNG] + (size_t)(layer * 2 + 1) * DM; const float* lnb = p.in[I_LNB] + (size_t)(layer * 2 + 1) * DM;
    const int nrows = layer == 0 ? NTOK : LAT;
    for (int row = c.gw; row < nrows; row += c.NGW) {
        const float* mod = mod_row(p, layer, row);
        f32x4 mo[4];
#pragma unroll
        for (int j = 0; j < 4; ++j) mo[j] = (f32x4){0.f, 0.f, 0.f, 0.f};
        const int inv = (c.lane < NE) ? INV[(size_t)row * NE + c.lane] : -1;
        unsigned long long msk = __ballot(inv >= 0);
        while (msk) {
            const int e = __builtin_ctzll(msk); msk &= msk - 1;
            const int sl = __builtin_amdgcn_readlane(inv, e);
#pragma unroll
            for (int j = 0; j < 4; ++j) { const v2u w = *(const v2u*)(YS + (size_t)sl * DM + 4 * c.lane + 256 * j);
                mo[j].x += bf2f(w.x & 0xffffu); mo[j].y += __uint_as_float(w.x & 0xffff0000u); mo[j].z += bf2f(w.y & 0xffffu); mo[j].w += __uint_as_float(w.y & 0xffff0000u); }
        }
        f32x4 v[4]; float s = 0.f;
#pragma unroll
        for (int j = 0; j < 4; ++j) { const int col = 4 * c.lane + 256 * j;
            v[j] = *(const f32x4*)(XS + (size_t)row * DM + col) * ALPHA + *(const f32x4*)(mod + 5120 + col) * mo[j];
            s += (v[j].x + v[j].y) + (v[j].z + v[j].w); }
        const float mean = wave_sum(s) * (1.f / DM); float s2 = 0.f;
#pragma unroll
        for (int j = 0; j < 4; ++j) { v[j] = v[j] - mean; s2 += (v[j].x * v[j].x + v[j].y * v[j].y) + (v[j].z * v[j].z + v[j].w * v[j].w); }
        const float rstd = 1.f / sqrtf(wave_sum(s2) * (1.f / DM) + LN_EPS);
        const float* modn = mod_row(p, 1, row);
#pragma unroll
        for (int j = 0; j < 4; ++j) { const int col = 4 * c.lane + 256 * j;
            const f32x4 x2 = v[j] * rstd * *(const f32x4*)(lng + col) + *(const f32x4*)(lnb + col);
            if (layer == 0) {
                *(f32x4*)(XS + (size_t)row * DM + col) = x2;
                const f32x4 h = x2 * (*(const f32x4*)(modn + 1024 + col) + 1.f) + *(const f32x4*)(modn + col);
                *(v2u*)(HB + (size_t)row * DM + col) = (v2u){pk2(h.x, h.y), pk2(h.z, h.w)};
            } else {
                *(f32x4*)(p.out + (size_t)row * DM + col) = x2;
            } }
    }
}

__device__ __forceinline__ void na_key(const float* q, float* o, float& m, float& l, const bf16* kp, const bf16* vp, float bias) {
    float s = bias;
#pragma unroll
    for (int i = 0; i < 8; ++i) { float f[8]; unpack8(*(const v4u*)(kp + 8 * i), f);
#pragma unroll
        for (int j = 0; j < 8; ++j) s += q[8 * i + j] * f[j]; }
    const float mn = fmaxf(m, s), al = exp2f(m - mn), pp = exp2f(s - mn);
    l = l * al + pp; m = mn;
#pragma unroll
    for (int i = 0; i < 8; ++i) { float f[8]; unpack8(*(const v4u*)(vp + 8 * i), f);
#pragma unroll
        for (int j = 0; j < 8; ++j) o[8 * i + j] = o[8 * i + j] * al + pp * f[j]; }
}
__device__ __forceinline__ void ph_mixer1_naive(const Params& p, const Ctx& c) {
    const bf16* P2 = (const bf16*)(p.ws + WS_QKV);
    bf16* CC = (bf16*)(p.ws + WS_CC);
    const float* rpb = p.in[I_RPB]; const float* pool_w = p.in[I_POOLW]; const float* pool_s = p.in[I_POOLS];
    LAS float* pl = (LAS float*)c.lds;
    for (int u = c.vcu; u < 256; u += c.G) {
        const int b = u >> 5, r = u & 31;
        {
            const int h = c.wave, col = c.lane, row = b * SEQ + r * 64 + col;
            const int rs = min(max(r - 4, 0), 24), cs = min(max(col - 8, 0), 48);
            float q[64], o[64];
#pragma unroll
            for (int i = 0; i < 8; ++i) unpack8(*(const v4u*)(P2 + (size_t)row * OIN + h * 64 + 8 * i), q + 8 * i);
#pragma unroll
            for (int i = 0; i < 64; ++i) o[i] = 0.f;
            float m = -1e30f, l = 0.f;
#pragma unroll 1
            for (int i = 0; i < 8; ++i)
#pragma unroll 1
                for (int j = 0; j < 16; ++j) {
                    const int krow = b * SEQ + (rs + i) * 64 + cs + j;
                    const float bias = rpb[(h * 15 + (rs + i - r + 7)) * 31 + (cs + j - col + 15)] * LOG2E;
                    na_key(q, o, m, l, P2 + (size_t)krow * OIN + 512 + h * 64, P2 + (size_t)krow * OIN + 1024 + h * 64, bias);
                }
#pragma unroll 1
            for (int j = 0; j < NCTX; ++j) {
                const int krow = LAT + b * NCTX + j;
                na_key(q, o, m, l, P2 + (size_t)krow * OIN + 512 + h * 64, P2 + (size_t)krow * OIN + 1024 + h * 64, 0.f);
            }
            const float rl = 1.f / l; bf16* dst = CC + (size_t)row * DM + h * 64;
#pragma unroll
            for (int i = 0; i < 8; ++i) *(v4u*)(dst + 8 * i) = (v4u){pk2(o[8 * i] * rl, o[8 * i + 1] * rl), pk2(o[8 * i + 2] * rl, o[8 * i + 3] * rl), pk2(o[8 * i + 4] * rl, o[8 * i + 5] * rl), pk2(o[8 * i + 6] * rl, o[8 * i + 7] * rl)};
        }
        __syncthreads();
        {
            const int ch = c.tid, g = ch >> 7, half = 1 << g;
            for (int tt = 0; tt < 64; ++tt) {
                const int t = r * 64 + tt, lo = max(t - half, 0), hi = min(t + half, SEQ);
                float s = 0.f;
                for (int t2 = lo; t2 < hi; ++t2) s += bf2f((unsigned)P2[(size_t)(b * SEQ + t2) * OIN + 1536 + ch]);
                pl[tt * 512 + ch] = s / (float)(hi - lo) - bf2f((unsigned)P2[(size_t)(b * SEQ + t) * OIN + 1536 + ch]);
            }
        }
        __syncthreads();
        {
            const int g = c.tid >> 7, e = c.tid & 127;
            const float ps = pool_s[g * 128 + e];
#pragma unroll 1
            for (int tb = 0; tb < 64; tb += 16) {
                float acc[16];
#pragma unroll
                for (int i = 0; i < 16; ++i) acc[i] = 0.f;
#pragma unroll 4
                for (int cc = 0; cc < 128; ++cc) {
                    const float w = pool_w[(size_t)(g * 128 + cc) * 128 + e];
#pragma unroll
                    for (int i = 0; i < 16; ++i) acc[i] += pl[(tb + i) * 512 + g * 128 + cc] * w;
                }
#pragma unroll
                for (int i = 0; i < 16; ++i) CC[(size_t)(b * SEQ + r * 64 + tb + i) * DM + 512 + g * 128 + e] = (bf16)f2bf(acc[i] * ps);
            }
        }
        __syncthreads();
    }
}


constexpr int NA_TAB_OFF = 86016 + 1024;
__device__ __forceinline__ void ph_mixer1_fast(const Params& p, const Ctx& c, char* lds_generic) {
    typedef attn_body::bf16 abf;
    const abf* P2a = (const abf*)(p.ws + WS_QKV); abf* CCa = (abf*)(p.ws + WS_CC);
    LAS float* tab = (LAS float*)(c.lds + NA_TAB_OFF);
    for (int i = c.tid; i < 8 * 15 * 32; i += 512) { const int hd = i >> 5, j = i & 31; tab[i] = j < 31 ? p.in[I_RPB][hd * 31 + j] * LOG2E : 0.f; }
    __syncthreads();
    for (int it = 0;; ++it) {
        const int U = it * c.G + c.vcu;
        if (U >= 512) break;
        const int b = U >> 6, h = (U >> 3) & 7, rq = U & 7;
        const int rs_min = min(max(4 * rq - 4, 0), 24);
        const int nloc = (rq == 0 || rq == 7) ? 8 : 12;
        attn_body::AU u;
        u.qrow0 = b * SEQ + rq * 256; u.lat_row0 = LAT + b * NCTX; u.nlat_t = 4; u.ctx_row0 = b * SEQ + rs_min * 64; u.NT = 4 + nloc;
        u.Qp = P2a + h * 64; u.Kp = P2a + 512 + h * 64; u.Vp = P2a + 1024 + h * 64; u.Op = CCa + h * 64;
        const int r = 4 * rq + (c.wave >> 1), col = (c.wave & 1) * 32 + (c.lane & 31), hi = c.lane >> 5;
        const int cs = min(max(col - 8, 0), 48);
        attn_body::NAMask mk; mk.tb0 = (attn_body::lds_cfptr)(tab + h * 15 * 32 + 15 - col); mk.r = r; mk.rs = min(max(r - 4, 0), 24); mk.rs_min = rs_min; mk.cb = 4 * hi - cs;
        attn_body::attn_unit<8, OIN, attn_body::NAMask>(u, lds_generic, mk);
    }
    __syncthreads();
    const bf16* P2 = (const bf16*)(p.ws + WS_QKV); bf16* CC = (bf16*)(p.ws + WS_CC);
    const float* pool_w = p.in[I_POOLW]; const float* pool_s = p.in[I_POOLS];
    LAS float* pl = (LAS float*)c.lds;
    for (int u = c.vcu; u < 256; u += c.G) {
        const int b = u >> 5, r = u & 31;
        {
            const int ch = c.tid, g = ch >> 7, half = 1 << g;
            const bf16* du = P2 + (size_t)b * SEQ * OIN + 1536 + ch;
            const int t0 = r * 64;
            float ws = 0.f;
            { float iv[16];
#pragma unroll
              for (int k = 0; k < 16; ++k) { const int t2 = t0 - half + k; const float w = (k < 2 * half && t2 >= 0 && t2 < SEQ) ? 1.f : 0.f; iv[k] = w * bf2f((unsigned)du[(size_t)min(max(t2, 0), SEQ - 1) * OIN]); }
#pragma unroll
              for (int k = 0; k < 16; ++k) ws += iv[k]; }
#pragma unroll 1
            for (int tb = 0; tb < 64; tb += 8) {
                float cur[8], add[8], sub[8];
#pragma unroll
                for (int k = 0; k < 8; ++k) { const int t = t0 + tb + k;
                    cur[k] = bf2f((unsigned)du[(size_t)t * OIN]);
                    add[k] = ((t + half < SEQ) ? 1.f : 0.f) * bf2f((unsigned)du[(size_t)min(t + half, SEQ - 1) * OIN]);
                    sub[k] = ((t - half >= 0) ? 1.f : 0.f) * bf2f((unsigned)du[(size_t)max(t - half, 0) * OIN]); }
#pragma unroll
                for (int k = 0; k < 8; ++k) { const int t = t0 + tb + k, lo = max(t - half, 0), hi = min(t + half, SEQ);
                    pl[(tb + k) * 512 + ch] = ws / (float)(hi - lo) - cur[k];
                    ws += add[k] - sub[k]; }
            }
        }
        __syncthreads();
        {
            const int g = c.tid >> 7, e = c.tid & 127;
            const float ps = pool_s[g * 128 + e];
#pragma unroll 1
            for (int tb = 0; tb < 64; tb += 16) {
                float acc[16];
#pragma unroll
                for (int i = 0; i < 16; ++i) acc[i] = 0.f;
#pragma unroll 2
                for (int cc = 0; cc < 128; cc += 4) {
                    const float w0 = pool_w[(size_t)(g * 128 + cc) * 128 + e], w1 = pool_w[(size_t)(g * 128 + cc + 1) * 128 + e], w2 = pool_w[(size_t)(g * 128 + cc + 2) * 128 + e], w3 = pool_w[(size_t)(g * 128 + cc + 3) * 128 + e];
#pragma unroll
                    for (int i = 0; i < 16; ++i) { const f32x4 pv = *(const LAS f32x4*)(pl + (tb + i) * 512 + g * 128 + cc); acc[i] += pv.x * w0 + pv.y * w1 + pv.z * w2 + pv.w * w3; }
                }
#pragma unroll
                for (int i = 0; i < 16; ++i) CC[(size_t)(b * SEQ + r * 64 + tb + i) * DM + 512 + g * 128 + e] = (bf16)f2bf(acc[i] * ps);
            }
        }
        __syncthreads();
    }
}

__global__ void __launch_bounds__(512, 2) mk_fwd(Params p) {
    extern __shared__ __attribute__((aligned(16))) unsigned char lds_raw[];
    Ctx c;
    c.lds = (LAS unsigned char*)lds_raw;
    c.tid = threadIdx.x; c.lane = c.tid & 63; c.wave = __builtin_amdgcn_readfirstlane(c.tid >> 6);
    c.G = gridDim.x; { const int bx = blockIdx.x; c.vcu = (c.G % 8 == 0) ? (bx % 8) * (c.G / 8) + bx / 8 : bx; }
    c.gw = c.vcu * 8 + c.wave; c.NGW = c.G * 8;
    volatile LAS unsigned* MISC = (volatile LAS unsigned*)(c.lds + MISC_OFF);
    if (c.tid < 32) MISC[c.tid] = 0u;
    __syncthreads();
    gu32* ctl = (gu32*)(p.ws + WS_CTL);
    XcdBarrier bar; bar.bar = (unsigned*)(ctl + CW_BAR); bar.x = 0; bar.st = nullptr;
    if (!MK_MULTI) bar = xcd_barrier_post((unsigned*)(ctl + CW_BAR), MISC + 8);
    const int lo = p.ph_lo, hi = p.ph_hi;
#define IN(k) (lo <= (k) && (k) < hi)
#define SEAM(k) do { if (IN(k) && IN((k) + 1)) xcd_barrier(bar); } while (0)

    bf16* HB = (bf16*)(p.ws + WS_HB); bf16* QKV = (bf16*)(p.ws + WS_QKV); bf16* CC = (bf16*)(p.ws + WS_CC);
    float* Y = (float*)(p.ws + WS_Y); float* PF = (float*)(p.ws + WS_PF);
    bf16* XG = (bf16*)(p.ws + WS_XG); bf16* HID = (bf16*)(p.ws + WS_HID); bf16* YS = (bf16*)(p.ws + WS_YS);
    const float* GATE = (const float*)(p.ws + WS_GATE);

    if (IN(0)) for (int rep_ = 0; rep_ < 1 + (int)((PROBE_MASK >> 0) & 1u); ++rep_) { if (rep_) __syncthreads(); ph_prologue(p, c); if (FAST_GEMM) { __syncthreads(); ph_transposes(p, c); } } SEAM(0);
    if (IN(1)) for (int rep_ = 0; rep_ < 1 + (int)((PROBE_MASK >> 1) & 1u); ++rep_) { if (rep_) __syncthreads(); ph_modulate0(p, c); } SEAM(1);
    if (IN(2)) for (int rep_ = 0; rep_ < 1 + (int)((PROBE_MASK >> 2) & 1u); ++rep_) { if (rep_) __syncthreads();
        if (FAST_GEMM) { pg8::Gemm g{HB, (const bf16*)(p.ws + WS_W0IN), NTOK, EIN, DM, 0}; pg8::StaticOrder S; S.init(NTOK, EIN, c.G, (int)blockIdx.x);
            pg8::EpiBf16<0> E{QKV, EIN, nullptr, 0, 0, 1.f}; pg8::gemm_phase<pg8::EpiBf16<0>, pg8::StaticOrder, true, true>(c.lds, g, S, E); }
        else { NG g{HB, DM, p.in[I_W0IN], nullptr, EIN, 0, 1 << 30, 0, NTOK, 0, EIN, DM}; ngemm<1>(g, c, EpiF32{PF, EIN}); }
    } SEAM(2);
    if (IN(3)) for (int rep_ = 0; rep_ < 1 + (int)((PROBE_MASK >> 3) & 1u); ++rep_) { if (rep_) __syncthreads(); if (FAST_GEMM) ph_qkv_post<false>(p, c); else ph_qkv_post<true>(p, c); } SEAM(3);
    if (IN(4)) for (int rep_ = 0; rep_ < 1 + (int)((PROBE_MASK >> 4) & 1u); ++rep_) { if (rep_) __syncthreads(); if (FAST_ATTN) ph_attn0_fast(p, c, (char*)lds_raw); else ph_attn0_naive(p, c); } SEAM(4);
    if (IN(5)) for (int rep_ = 0; rep_ < 1 + (int)((PROBE_MASK >> 5) & 1u); ++rep_) { if (rep_) __syncthreads(); ph_attn_combine(p, c); } SEAM(5);
    if (IN(6)) for (int rep_ = 0; rep_ < 1 + (int)((PROBE_MASK >> 6) & 1u); ++rep_) { if (rep_) __syncthreads();
        if (FAST_GEMM) { pg8::Gemm g{CC, (const bf16*)(p.ws + WS_W0OUT), NTOK, DM, DM, 0}; pg8::StaticOrder S; S.init(NTOK, DM, c.G, (int)blockIdx.x);
            pg8::EpiF32P E{Y, DM}; pg8::gemm_phase<pg8::EpiF32P, pg8::StaticOrder, true, true>(c.lds, g, S, E); }
        else { NG g{CC, DM, p.in[I_W0OUT], nullptr, DM, 0, 1 << 30, 0, NTOK, 0, DM, DM}; ngemm<1>(g, c, EpiF32{Y, DM}); }
    } SEAM(6);
    if (IN(7)) for (int rep_ = 0; rep_ < 1 + (int)((PROBE_MASK >> 7) & 1u); ++rep_) { if (rep_) __syncthreads(); ph_ln1_router(p, c, 0); } SEAM(7);
    if (IN(8)) for (int rep_ = 0; rep_ < 1 + (int)((PROBE_MASK >> 8) & 1u); ++rep_) { if (rep_) __syncthreads(); ph_topk(p, c, 0); } SEAM(8);
    if (IN(9)) for (int rep_ = 0; rep_ < 1 + (int)((PROBE_MASK >> 9) & 1u); ++rep_) { if (rep_) __syncthreads();
        if (FAST_GEMM) { pg8::Gemm g{XG, (const bf16*)(p.ws + WS_WGU), NE * MR0, 4096, DM, (size_t)4096 * DM * 2}; pg8::GroupedOrder S; S.init(MR0 / 256, 16, NE, c.G, c.vcu);
            pg8::EpiSwigluP E{HID, FF}; pg8::gemm_phase<pg8::EpiSwigluP, pg8::GroupedOrder, true, true>(c.lds, g, S, E); }
        else { NG g{XG, DM, p.in[I_WG], p.in[I_WU], FF, (size_t)DM * FF, MR0, 0, NE * MR0, 0, FF, DM}; ngemm<2>(g, c, EpiSwiglu{HID}); }
    } SEAM(9);
    if (IN(10)) for (int rep_ = 0; rep_ < 1 + (int)((PROBE_MASK >> 10) & 1u); ++rep_) { if (rep_) __syncthreads();
        if (FAST_GEMM) { pg8::Gemm g{HID, (const bf16*)(p.ws + WS_WDN), NE * MR0, DM, FF, (size_t)DM * FF * 2}; pg8::GroupedOrder S; S.init(MR0 / 256, 4, NE, c.G, c.vcu);
            pg8::EpiGateP E{YS, DM, GATE}; pg8::gemm_phase<pg8::EpiGateP, pg8::GroupedOrder, true, true>(c.lds, g, S, E); }
        else { NG g{HID, FF, p.in[I_WD], nullptr, DM, (size_t)FF * DM, MR0, 0, NE * MR0, 0, DM, FF}; ngemm<1>(g, c, EpiGate{YS, GATE}); }
    } SEAM(10);
    if (IN(11)) for (int rep_ = 0; rep_ < 1 + (int)((PROBE_MASK >> 11) & 1u); ++rep_) { if (rep_) __syncthreads(); ph_combine(p, c, 0); } SEAM(11);
    if (IN(12)) for (int rep_ = 0; rep_ < 1 + (int)((PROBE_MASK >> 12) & 1u); ++rep_) { if (rep_) __syncthreads();
        if (FAST_GEMM) { pg8::Gemm g{HB, (const bf16*)(p.ws + WS_W1IN), NTOK, OIN, DM, 0}; pg8::L1InOrder S; S.init(c.G, (int)blockIdx.x);
            pg8::EpiBf16<0> E{QKV, OIN, nullptr, 512, 512, C2}; pg8::gemm_phase<pg8::EpiBf16<0>, pg8::L1InOrder, true, true>(c.lds, g, S, E); }
        else {
        NG g{HB, DM, p.in[I_W1IN], nullptr, OIN, 0, 1 << 30, 0, LAT, 0, OIN, DM}; ngemm<1>(g, c, EpiBf{QKV, OIN, 512, C2});
        NG g2{HB, DM, p.in[I_W1IN], nullptr, OIN, 0, 1 << 30, LAT, NTOK, 512, 1536, DM}; ngemm<1>(g2, c, EpiBf{QKV, OIN, 0, 1.f}); }
    } SEAM(12);
    if (IN(13)) for (int rep_ = 0; rep_ < 1 + (int)((PROBE_MASK >> 13) & 1u); ++rep_) { if (rep_) __syncthreads(); if (FAST_NA) ph_mixer1_fast(p, c, (char*)lds_raw); else ph_mixer1_naive(p, c); } SEAM(13);
    if (IN(14)) for (int rep_ = 0; rep_ < 1 + (int)((PROBE_MASK >> 14) & 1u); ++rep_) { if (rep_) __syncthreads();
        if (FAST_GEMM) { pg8::Gemm g{CC, (const bf16*)(p.ws + WS_W1OUT), LAT, DM, DM, 0}; pg8::StaticOrder S; S.init(LAT, DM, c.G, (int)blockIdx.x);
            pg8::EpiF32P E{Y, DM}; pg8::gemm_phase<pg8::EpiF32P, pg8::StaticOrder, true, true>(c.lds, g, S, E); }
        else { NG g{CC, DM, p.in[I_W1OUT], nullptr, DM, 0, 1 << 30, 0, LAT, 0, DM, DM}; ngemm<1>(g, c, EpiF32{Y, DM}); }
    } SEAM(14);
    if (IN(15)) for (int rep_ = 0; rep_ < 1 + (int)((PROBE_MASK >> 15) & 1u); ++rep_) { if (rep_) __syncthreads(); ph_ln1_router(p, c, 1); } SEAM(15);
    if (IN(16)) for (int rep_ = 0; rep_ < 1 + (int)((PROBE_MASK >> 16) & 1u); ++rep_) { if (rep_) __syncthreads(); ph_topk(p, c, 1); } SEAM(16);
    if (IN(17)) for (int rep_ = 0; rep_ < 1 + (int)((PROBE_MASK >> 17) & 1u); ++rep_) { if (rep_) __syncthreads();
        if (FAST_GEMM) { pg8::Gemm g{XG, (const bf16*)(p.ws + WS_WGU + WS_MOE_LSTRIDE), NE * MR1, 4096, DM, (size_t)4096 * DM * 2}; pg8::GroupedOrder S; S.init(MR1 / 256, 16, NE, c.G, c.vcu);
            pg8::EpiSwigluP E{HID, FF}; pg8::gemm_phase<pg8::EpiSwigluP, pg8::GroupedOrder, true, true>(c.lds, g, S, E); }
        else { NG g{XG, DM, p.in[I_WG] + (size_t)NE * DM * FF, p.in[I_WU] + (size_t)NE * DM * FF, FF, (size_t)DM * FF, MR1, 0, NE * MR1, 0, FF, DM}; ngemm<2>(g, c, EpiSwiglu{HID}); }
    } SEAM(17);
    if (IN(18)) for (int rep_ = 0; rep_ < 1 + (int)((PROBE_MASK >> 18) & 1u); ++rep_) { if (rep_) __syncthreads();
        if (FAST_GEMM) { pg8::Gemm g{HID, (const bf16*)(p.ws + WS_WDN + WS_MOE_LSTRIDE), NE * MR1, DM, FF, (size_t)DM * FF * 2}; pg8::GroupedOrder S; S.init(MR1 / 256, 4, NE, c.G, c.vcu);
            pg8::EpiGateP E{YS, DM, GATE}; pg8::gemm_phase<pg8::EpiGateP, pg8::GroupedOrder, true, true>(c.lds, g, S, E); }
        else { NG g{HID, FF, p.in[I_WD] + (size_t)NE * FF * DM, nullptr, DM, (size_t)FF * DM, MR1, 0, NE * MR1, 0, DM, FF}; ngemm<1>(g, c, EpiGate{YS, GATE}); }
    } SEAM(18);
    if (IN(19)) for (int rep_ = 0; rep_ < 1 + (int)((PROBE_MASK >> 19) & 1u); ++rep_) { if (rep_) __syncthreads(); ph_combine(p, c, 1); }
#undef IN
#undef SEAM
}

extern "C" void kernel_launch(void* const* d_in, const int* in_sizes, int n_in, void* d_out, int out_size, void* d_ws, size_t ws_size, hipStream_t stream) {
    static int grid = 0;
    if (grid == 0) {
        if (n_in != 26 || out_size != LAT * DM || ws_size < WS_END) { fprintf(stderr, "kernel_launch: unexpected shapes (n_in %d out %d ws %zu)\n", n_in, out_size, ws_size); grid = -1; return; }
        int dev = 0, cus = 0;
        if (hipGetDevice(&dev) != hipSuccess || hipDeviceGetAttribute(&cus, hipDeviceAttributeMultiprocessorCount, dev) != hipSuccess) { grid = -1; return; }
        if (hipFuncSetAttribute((const void*)mk_fwd, hipFuncAttributeMaxDynamicSharedMemorySize, LDS_BYTES) != hipSuccess) { fprintf(stderr, "kernel_launch: hipFuncSetAttribute failed\n"); grid = -1; return; }
        int per_cu = 0;
        if (hipOccupancyMaxActiveBlocksPerMultiprocessor(&per_cu, (const void*)mk_fwd, 512, LDS_BYTES) != hipSuccess || per_cu < 1) fprintf(stderr, "kernel_launch: occupancy query says %d\n", per_cu);
        (void)hipGetLastError();
        grid = cus;
    }
    if (grid < 0) return;
    (void)hipMemsetAsync((char*)d_ws + WS_CTL, 0, CTL_ZERO_BYTES, stream);
    Params a{};
    for (int i = 0; i < 26; ++i) a.in[i] = (const float*)d_in[i];
    a.out = (float*)d_out; a.ws = (unsigned char*)d_ws;
#if MK_MULTI
    for (int ph = 0; ph < NPHASE; ++ph) { a.ph_lo = ph; a.ph_hi = ph + 1; hipLaunchKernelGGL(mk_fwd, dim3(grid), dim3(512), LDS_BYTES, stream, a); }
#else
    a.ph_lo = 0; a.ph_hi = NPHASE;
    hipLaunchKernelGGL(mk_fwd, dim3(grid), dim3(512), LDS_BYTES, stream, a);
#endif
}
```

```cpp
#include <hip/hip_runtime.h>
#include <cstdio>
#include <cstdint>

#define GAS __attribute__((address_space(1)))
#define LAS __attribute__((address_space(3)))
typedef unsigned short bf16;
typedef unsigned v4u __attribute__((ext_vector_type(4)));
typedef unsigned v2u __attribute__((ext_vector_type(2)));
typedef float f32x4 __attribute__((ext_vector_type(4)));
typedef float f32x2 __attribute__((ext_vector_type(2)));
typedef float f32x16 __attribute__((ext_vector_type(16)));
typedef GAS unsigned gu32;

#ifndef PROBE_PH
#define PROBE_PH -1
#endif
#ifndef PROBE_MASK
#define PROBE_MASK 0u
#endif
#ifndef MOE_FP8
#define MOE_FP8 1
#endif
#ifndef FAST_NA
#define FAST_NA 1
#endif
#ifndef FAST_ATTN
#define FAST_ATTN 1
#endif
#ifndef FAST_GEMM
#define FAST_GEMM 1
#endif
#ifndef MK_MULTI
#define MK_MULTI 0
#endif

constexpr int NBATCH = 8, SEQ = 2048, DM = 1024, NCTX = 256;
constexpr int LAT = NBATCH * SEQ;
constexpr int NTOK = LAT + NBATCH * NCTX;
constexpr int EIN = 2304, OIN = 2048, NE = 16, FF = 2048;
constexpr int MR0 = 2304, MR1 = 2048;
constexpr float LOG2E = 1.4426950408889634f;
constexpr float C2 = 0.125f * LOG2E;
constexpr float ALPHA = 1.4142135623730951f;
constexpr float LN_EPS = 1e-5f, RMS_EPS = 1e-6f;
constexpr float LAM_INIT = 0.2f;
constexpr int NPHASE = 20;
constexpr float W8_GU = 32.f, W8_DN = 64.f, H8_SC = 8.f;

constexpr size_t MiB = 1u << 20;
constexpr size_t WS_CTL = 0, CTL_ZERO_BYTES = 1 * MiB;
constexpr size_t WS_MOD = 1 * MiB;
constexpr size_t WS_ROPE = 1 * MiB + 512 * 1024;
constexpr size_t WS_W0IN = 2 * MiB;
constexpr size_t WS_W0OUT = 7 * MiB;
constexpr size_t WS_W1IN = 9 * MiB;
constexpr size_t WS_W1OUT = 13 * MiB;
constexpr size_t WS_AFF = 16 * MiB;
constexpr size_t WS_INV = 18 * MiB;
constexpr size_t WS_GATE = 20 * MiB;
constexpr size_t WS_WGU = 24 * MiB;
constexpr size_t WS_WDN = 152 * MiB;
constexpr size_t WS_MOE_LSTRIDE = 192 * MiB;
constexpr size_t WS_XS = 408 * MiB;
constexpr size_t WS_HB = 480 * MiB;
constexpr size_t WS_QKV = 516 * MiB;
constexpr size_t WS_CC = 597 * MiB;
constexpr size_t WS_AO = 633 * MiB;
constexpr size_t WS_Y = 705 * MiB;
constexpr size_t WS_XG = 516 * MiB;
constexpr size_t WS_HID = 588 * MiB;
constexpr size_t WS_YS = 732 * MiB;
constexpr size_t WS_PF = 804 * MiB;
constexpr size_t WS_END = 968 * MiB;

constexpr int CW_BAR = 4096;
constexpr int LDS_BYTES = 147456;
constexpr int MISC_OFF = 131072 + 320;

__device__ __forceinline__ float bf2f(unsigned v) { return __uint_as_float(v << 16); }
__device__ __forceinline__ unsigned f2bf(float f) { unsigned u = __float_as_uint(f); return (u + 0x7fffu + ((u >> 16) & 1u)) >> 16; }
__device__ __forceinline__ unsigned pk2(float lo, float hi) { return f2bf(lo) | (f2bf(hi) << 16); }
__device__ __forceinline__ float wave_sum(float v) {
#pragma unroll
    for (int o = 1; o < 64; o <<= 1) v += __shfl_xor(v, o);
    return v;
}
__device__ __forceinline__ float wave_max(float v) {
#pragma unroll
    for (int o = 1; o < 64; o <<= 1) v = fmaxf(v, __shfl_xor(v, o));
    return v;
}
__device__ __forceinline__ void unpack8(const v4u w, float* f) {
    f[0] = bf2f(w.x & 0xffffu); f[1] = __uint_as_float(w.x & 0xffff0000u);
    f[2] = bf2f(w.y & 0xffffu); f[3] = __uint_as_float(w.y & 0xffff0000u);
    f[4] = bf2f(w.z & 0xffffu); f[5] = __uint_as_float(w.z & 0xffff0000u);
    f[6] = bf2f(w.w & 0xffffu); f[7] = __uint_as_float(w.w & 0xffff0000u);
}

#define XB_TMO      128
#define XB_XCNT(j)  (256  + 64 * (j))
#define XB_XSUB(j)  (1280 + 64 * (j))
#define XB_XGEN(j)  (2304 + 64 * (j))
#define XB_TOP      3328
#define XB_TOPGEN   3392
#define XCD_BAR_WORDS 3456
#define XB_SPIN_CAP (1u << 18)
__device__ __forceinline__ unsigned xb_ld(unsigned* p)              { return __hip_atomic_load(p, __ATOMIC_RELAXED, __HIP_MEMORY_SCOPE_AGENT); }
__device__ __forceinline__ unsigned xb_add(unsigned* p, unsigned v) { return __hip_atomic_fetch_add(p, v, __ATOMIC_RELAXED, __HIP_MEMORY_SCOPE_AGENT); }
__device__ __forceinline__ unsigned xb_xcc_id() { return (unsigned)__builtin_amdgcn_s_getreg((3 << 11) | 20) & 0xFu; }
#define XB_SPIN(cond, bar) do { unsigned _sp = 0; while (cond) { __builtin_amdgcn_s_sleep(1); \
    if ((++_sp & 255u) == 0u) { if (xb_ld(&(bar)[XB_TMO])) break; if (_sp > XB_SPIN_CAP) { atomicAdd(&(bar)[XB_TMO], 1u); break; } } } } while (0)
struct XcdBarrier { unsigned* bar; unsigned x; volatile LAS unsigned* st; };
__device__ __forceinline__ XcdBarrier xcd_barrier_post(unsigned* bar, volatile LAS unsigned* st) {
    XcdBarrier b; b.bar = bar; b.x = xb_xcc_id(); b.st = st;
    if (threadIdx.x == 0) (void)xb_add(&bar[XB_XCNT(b.x)], 1u);
    return b;
}
__device__ __forceinline__ void xcd_barrier_complete(unsigned* bar, unsigned x, unsigned& nloc, unsigned& nx) {
    const unsigned G = gridDim.x * gridDim.y * gridDim.z;
    unsigned sum, cnt, mine, sp = 0u;
    for (;;) {
        sum = 0u; cnt = 0u; mine = 0u;
#pragma unroll
        for (unsigned j = 0; j < 16; ++j) { const unsigned c = xb_ld(&bar[XB_XCNT(j)]); sum += c; cnt += (c > 0u) ? 1u : 0u; mine = (j == x) ? c : mine; }
        if (sum == G) break;
        __builtin_amdgcn_s_sleep(1);
        if ((++sp & 255u) == 0u) { if (xb_ld(&bar[XB_TMO])) break; if (sp > XB_SPIN_CAP) { atomicAdd(&bar[XB_TMO], 1u); break; } }
    }
    nloc = mine > 0u ? mine : 1u; nx = cnt > 0u ? cnt : 1u;
}
__device__ __forceinline__ void xcd_barrier(const XcdBarrier& b) {
    asm volatile("s_waitcnt vmcnt(0)" ::: "memory");
    __syncthreads();
    if (threadIdx.x == 0) {
        unsigned* bar = b.bar;
        __builtin_amdgcn_s_waitcnt(0);
        unsigned nloc = b.st[0], nx = b.st[1];
        if (nloc == 0u) { xcd_barrier_complete(bar, b.x, nloc, nx); b.st[0] = nloc; b.st[1] = nx; }
        const unsigned old = xb_add(&bar[XB_XSUB(b.x)], 1u);
        const unsigned gen = old / nloc;
        if (old + 1u == (gen + 1u) * nloc) {
            __builtin_amdgcn_fence(__ATOMIC_RELEASE, "agent");
            asm volatile("s_waitcnt vmcnt(0)" ::: "memory");
            const unsigned og = xb_add(&bar[XB_TOP], 1u);
            const unsigned tg = og / nx;
            if (og + 1u == (tg + 1u) * nx) xb_add(&bar[XB_TOPGEN], 1u);
            else XB_SPIN(xb_ld(&bar[XB_TOPGEN]) == tg, bar);
            __builtin_amdgcn_fence(__ATOMIC_ACQUIRE, "agent");
            xb_add(&bar[XB_XGEN(b.x)], 1u);
            asm volatile("s_waitcnt vmcnt(0)" ::: "memory");
        } else {
            XB_SPIN(xb_ld(&bar[XB_XGEN(b.x)]) == gen, bar);
            __builtin_amdgcn_fence(__ATOMIC_ACQUIRE, "agent");
            asm volatile("s_waitcnt vmcnt(0)" ::: "memory");
        }
    }
    __syncthreads();
}

namespace pg8 {
#define PG8_LAS __attribute__((address_space(3)))
typedef unsigned short bf16_t;
typedef short bf16x8 __attribute__((ext_vector_type(8)));
typedef float f32x4 __attribute__((ext_vector_type(4)));
typedef unsigned u32x4 __attribute__((ext_vector_type(4)));
constexpr int BM = 256, BK = 64, HALF = 128, HTB = HALF * BK * 2  , STAGE_BYTES = 8 * HTB, NXCD = 8, WGM = 8;

__host__ __device__ __forceinline__ int lds_byte(int r, int c) { const int st = (r >> 4) * 2 + (c >> 5), rr = r & 15, cc = c & 31, ob = rr * 64 + cc * 2; return st * 1024 + (ob ^ (((ob >> 9) & 1) << 5)); }
__host__ __device__ __forceinline__ void stage_rc(int b, int& R, int& C) { const int st = b / 1024, sb = b % 1024, swz = sb ^ (((sb >> 9) & 1) << 5); R = (st >> 1) * 16 + swz / 64; C = (st & 1) * 32 + (swz % 64) / 2; }
__host__ __device__ __forceinline__ int perm32(int rho) { const int n = rho >> 4, i = rho & 15; return 8 * (i >> 2) + 4 * n + (i & 3); }

struct Unit { int pm, pn, e; };
struct Gemm { const bf16_t* A; const bf16_t* Bt; int M, N, K; size_t bstride; };

struct StaticOrder {
    int nM, nN, nwg, G, c;
    __host__ __device__ void init(int M, int N, int G_, int c_) { nM = M / BM; nN = N / BM; nwg = nM * nN; G = G_; c = c_; }
    __host__ __device__ bool next(int i, Unit& u) const {
        const long L = (long)i * G + c; if (L >= nwg) return false;
        int wgid = (int)L; { const int q = nwg / NXCD, r = nwg % NXCD, xcd = wgid % NXCD, off = wgid / NXCD; wgid = (xcd < r ? xcd * (q + 1) : r * (q + 1) + (xcd - r) * q) + off; }
        const int nig = WGM * nN, gid = wgid / nig, fm = gid * WGM, gsz = (nM - fm) < WGM ? (nM - fm) : WGM;
        u.pm = fm + ((wgid % nig) % gsz); u.pn = (wgid % nig) / gsz; u.e = 0; return true;
    }
    __device__ __forceinline__ void a_ready(const Unit&) const {}
    __device__ __forceinline__ void done(const Unit&) const {}
};

__device__ __forceinline__ unsigned cvt_pk_bf16(float lo, float hi) { unsigned r; asm volatile("v_cvt_pk_bf16_f32 %0, %1, %2" : "=v"(r) : "v"(lo), "v"(hi)); return r; }
typedef float f32x2 __attribute__((ext_vector_type(2)));
__device__ __forceinline__ f32x2 gelu_pk(f32x2 v) {
    const f32x2 av = __builtin_elementwise_abs(v), d = av * 0.2316418882f + 1.0f;
    f32x2 t; t.x = __builtin_amdgcn_rcpf(d.x); t.y = __builtin_amdgcn_rcpf(d.y);
    f32x2 q = t * 0.5307027145f + (-0.7265760135f); q = q * t + 0.7107068705f; q = q * t + (-0.142248368f); q = q * t + 0.127414796f; q = q * t;
    const f32x2 s = (v * v) * (-0.72134752044f);
    f32x2 e; e.x = __builtin_amdgcn_exp2f(s.x); e.y = __builtin_amdgcn_exp2f(s.y);
    const f32x2 m = v * (q * e), r = v - m;
    f32x2 o; o.x = v.x < 0.f ? m.x : r.x; o.y = v.y < 0.f ? m.y : r.y; return o;
}

template <int ACT  > struct EpiBf16 {
    static constexpr bool PERM = true, AFTER_DRAIN = false; static_assert(ACT == 0 || ACT == 1, "EpiBf16: ACT is 0 (none) or 1 (gelu_pk)");
    bf16_t* O; int ldc; const float* bias; int split_cols; size_t split_stride; float scale0;
    __device__ __forceinline__ void operator()(const f32x4 (&acc)[2][2][4][2], const Unit& u, int wr, int wc, int fr, int fq) const {
        const int row0 = u.pm * BM + wr * 64 + fr; int colt = u.pn * BM; bf16_t* base = O;
        float sc = 1.f; if (split_cols) { const int t = colt / split_cols; base += (size_t)t * split_stride; colt -= t * split_cols; if (t == 0) sc = scale0; }
        const int col0 = colt + wc * 32 + 8 * fq, bcol0 = u.pn * BM + wc * 32 + 8 * fq;
        f32x4 bv[2][2];
#pragma unroll
        for (int bj = 0; bj < 2; ++bj)
#pragma unroll
            for (int n = 0; n < 2; ++n) bv[bj][n] = bias ? *(const f32x4*)(bias + bcol0 + bj * HALF + 4 * n) : (f32x4){0.f, 0.f, 0.f, 0.f};
#pragma unroll
        for (int ai = 0; ai < 2; ++ai)
#pragma unroll
            for (int m = 0; m < 4; ++m) { bf16_t* rowp = base + (size_t)(row0 + ai * HALF + m * 16) * ldc + col0;
#pragma unroll
                for (int bj = 0; bj < 2; ++bj) { f32x4 v0 = acc[ai][bj][m][0] + bv[bj][0], v1 = acc[ai][bj][m][1] + bv[bj][1];
                    if (ACT == 1) { f32x2 a = gelu_pk((f32x2){v0[0], v0[1]}), b = gelu_pk((f32x2){v0[2], v0[3]}), c = gelu_pk((f32x2){v1[0], v1[1]}), d = gelu_pk((f32x2){v1[2], v1[3]});
                        v0 = (f32x4){a.x, a.y, b.x, b.y}; v1 = (f32x4){c.x, c.y, d.x, d.y}; }
                    v0 = v0 * sc; v1 = v1 * sc; u32x4 w; w.x = cvt_pk_bf16(v0[0], v0[1]); w.y = cvt_pk_bf16(v0[2], v0[3]); w.z = cvt_pk_bf16(v1[0], v1[1]); w.w = cvt_pk_bf16(v1[2], v1[3]);
                    *(u32x4*)(rowp + bj * HALF) = w; } }
    }
};

typedef int i32x4 __attribute__((ext_vector_type(4))); typedef int i32x8 __attribute__((ext_vector_type(8)));
__device__ __forceinline__ i32x8 cat16(bf16x8 lo, bf16x8 hi) { const i32x4 a = __builtin_bit_cast(i32x4, lo), b = __builtin_bit_cast(i32x4, hi); return __builtin_shufflevector(a, b, 0, 1, 2, 3, 4, 5, 6, 7); }
__device__ __forceinline__ void mfma_f8_acc(f32x4& acc, const i32x8& b, const i32x8& a, int sc) {
    asm volatile("v_mfma_scale_f32_16x16x128_f8f6f4 %0, %1, %2, %0, %3, %3 op_sel_hi:[0,0,0]" : "+v"(acc) : "v"(b), "v"(a), "v"(sc)); }
template <class Epi, class Sched, bool ALIGN_EPI = false, bool SP2 = false, bool FP8 = false>
__device__ __forceinline__ void gemm_phase(PG8_LAS unsigned char* lds, const Gemm g, const Sched& S, const Epi& E) {
    const int tid = threadIdx.x, wid = __builtin_amdgcn_readfirstlane(tid >> 6), lane = tid & 63, wr = wid >> 2, wc = wid & 3, fr = lane & 15, fq = lane >> 4;
    const int K = g.K, nt = K / BK;
    unsigned voffA[2], voffB[2];
#pragma unroll
    for (int i = 0; i < 2; ++i) { int R, C; stage_rc(tid * 16 + i * 8192, R, C); const int Rb = Epi::PERM ? ((R & ~31) + perm32(R & 31)) : R;
        voffA[i] = (unsigned)(R * K + C) * 2u; voffB[i] = (unsigned)(Rb * K + C) * 2u; }
    const size_t kstep = (size_t)(BK * 2);
    const size_t hstep = (size_t)HALF * K * 2;
    const size_t tstep = 2 * hstep;
    const unsigned ldsw = (unsigned)wid * 1024u;
    const int aoff = FP8 ? lds_byte(wr * 64 + fr, 16 * fq) : lds_byte(wr * 64 + fr, fq * 8), boff = FP8 ? lds_byte(wc * 32 + fr, 16 * fq) : lds_byte(wc * 32 + fr, fq * 8);
    constexpr int KOFF = FP8 ? 16 : 1024;
#define PG8_SA(b, h) (((b) * 2 + (h)) * HTB)
#define PG8_SB(b, h) ((4 + (b) * 2 + (h)) * HTB)
#define PG8_STAGE(bufoff, gbase, voff) do { _Pragma("unroll") for (int _i = 0; _i < 2; ++_i) \
        __builtin_amdgcn_global_load_lds((const unsigned*)((const char*)(gbase) + (voff)[_i]), (PG8_LAS unsigned*)(lds + (bufoff) + ldsw + _i * 8192), 16, 0, 0); } while (0)
#define PG8_LDA(dst, b, h) do { _Pragma("unroll") for (int m = 0; m < 4; ++m) _Pragma("unroll") for (int k = 0; k < 2; ++k) dst[m][k] = *(const PG8_LAS bf16x8*)(lds + PG8_SA(b, h) + aoff + m * 2048 + k * KOFF); } while (0)
#define PG8_LDB(dst, b, h) do { _Pragma("unroll") for (int n = 0; n < 2; ++n) _Pragma("unroll") for (int k = 0; k < 2; ++k) dst[n][k] = *(const PG8_LAS bf16x8*)(lds + PG8_SB(b, h) + boff + n * 2048 + k * KOFF); } while (0)
#define PG8_MMA(ai, bj, At, Bt) do { __builtin_amdgcn_s_setprio(1); _Pragma("unroll") for (int m = 0; m < 4; ++m) _Pragma("unroll") for (int n = 0; n < 2; ++n) { \
        if constexpr (FP8) mfma_f8_acc(acc[ai][bj][m][n], cat16(Bt[n][0], Bt[n][1]), cat16(At[m][0], At[m][1]), f8scale); \
        else { _Pragma("unroll") for (int k = 0; k < 2; ++k) acc[ai][bj][m][n] = __builtin_amdgcn_mfma_f32_16x16x32_bf16(Bt[n][k], At[m][k], acc[ai][bj][m][n], 0, 0, 0); } } __builtin_amdgcn_s_setprio(0); } while (0)
#define PG8_WAIT_V(n) asm volatile("s_waitcnt vmcnt(" #n ")" ::: "memory")
#define PG8_WAIT_L(n) asm volatile("s_waitcnt lgkmcnt(" #n ")" ::: "memory")
#define PG8_BAR __builtin_amdgcn_s_barrier()
#define PG8_SCHED __builtin_amdgcn_sched_barrier(0)
    Unit cur, nxt; int ui = 0;
    if (!S.next(0, cur)) return;
    f32x4 acc[2][2][4][2];
#pragma unroll
    for (int a = 0; a < 2; ++a)
#pragma unroll
        for (int b = 0; b < 2; ++b)
#pragma unroll
            for (int m = 0; m < 4; ++m)
#pragma unroll
                for (int n = 0; n < 2; ++n) acc[a][b][m][n] = (f32x4){0.f, 0.f, 0.f, 0.f};
    int f8scale = 0x7F7F7F7F; asm volatile("" : "+v"(f8scale));
    bf16x8 At[4][2], B0[2][2], B1[2][2];
    const char* cA = (const char*)g.A + (size_t)cur.pm * tstep; const char* cB = (const char*)g.Bt + (size_t)cur.pn * tstep + (size_t)cur.e * g.bstride;
    S.a_ready(cur);
    if constexpr (SP2) {
        PG8_STAGE(PG8_SB(0, 0), cB, voffB); PG8_STAGE(PG8_SB(0, 1), cB + hstep, voffB); PG8_STAGE(PG8_SA(0, 0), cA, voffA); PG8_STAGE(PG8_SA(0, 1), cA + hstep, voffA);
        if (wr == 1) PG8_BAR;
        PG8_WAIT_V(2); PG8_BAR;
        PG8_STAGE(PG8_SB(1, 0), cB + kstep, voffB); PG8_STAGE(PG8_SA(1, 0), cA + kstep, voffA); PG8_STAGE(PG8_SB(1, 1), cB + hstep + kstep, voffB);
        PG8_WAIT_V(6); PG8_BAR;
    } else {
        PG8_STAGE(PG8_SB(0, 0), cB, voffB); PG8_STAGE(PG8_SA(0, 0), cA, voffA); PG8_STAGE(PG8_SB(0, 1), cB + hstep, voffB); PG8_STAGE(PG8_SA(0, 1), cA + hstep, voffA);
        if (wr == 1) PG8_BAR;
        PG8_WAIT_V(4); PG8_BAR;
        PG8_STAGE(PG8_SB(1, 0), cB + kstep, voffB); PG8_STAGE(PG8_SA(1, 0), cA + kstep, voffA); PG8_STAGE(PG8_SB(1, 1), cB + hstep + kstep, voffB);
        PG8_WAIT_V(6); PG8_BAR;
    }
    for (;;) {
        const bool has_next = S.next(ui + 1, nxt);
        const char* nA = has_next ? (const char*)g.A + (size_t)nxt.pm * tstep : cA; const char* nB = has_next ? (const char*)g.Bt + (size_t)nxt.pn * tstep + (size_t)nxt.e * g.bstride : cB;
        for (int t = 0; t < nt; t += 2) {
            const bool last = (t == nt - 2);
            const char* a1 = cA + (size_t)(t + 1) * kstep;
            const char* a2 = last ? nA : cA + (size_t)(t + 2) * kstep; const char* b2 = last ? nB : cB + (size_t)(t + 2) * kstep;
            const char* a3 = a2 + kstep; const char* b3 = b2 + kstep;
            if (last && has_next) S.a_ready(nxt);
            if constexpr (SP2) {
            PG8_LDB(B0, 0, 0); PG8_LDB(B1, 0, 1); PG8_SCHED; PG8_LDA(At, 0, 0); PG8_STAGE(PG8_SA(1, 1), a1 + hstep, voffA);
            PG8_WAIT_V(8); PG8_WAIT_L(0); PG8_BAR; PG8_MMA(0, 0, At, B0); PG8_MMA(0, 1, At, B1); PG8_BAR; PG8_SCHED;
            PG8_LDA(At, 0, 1); PG8_STAGE(PG8_SB(0, 0), b2, voffB); PG8_STAGE(PG8_SB(0, 1), b2 + hstep, voffB); PG8_STAGE(PG8_SA(0, 0), a2, voffA);
            PG8_WAIT_V(8); PG8_WAIT_L(0); PG8_BAR; PG8_MMA(1, 0, At, B0); PG8_MMA(1, 1, At, B1); PG8_BAR; PG8_SCHED;
            PG8_LDB(B0, 1, 0); PG8_LDB(B1, 1, 1); PG8_SCHED; PG8_LDA(At, 1, 0); PG8_STAGE(PG8_SA(0, 1), a2 + hstep, voffA);
            PG8_WAIT_V(8); PG8_WAIT_L(0); PG8_BAR; PG8_MMA(0, 0, At, B0); PG8_MMA(0, 1, At, B1); PG8_BAR; PG8_SCHED;
            PG8_LDA(At, 1, 1); PG8_STAGE(PG8_SB(1, 0), b3, voffB); PG8_STAGE(PG8_SB(1, 1), b3 + hstep, voffB); PG8_STAGE(PG8_SA(1, 0), a3, voffA);
            PG8_WAIT_V(8); PG8_WAIT_L(0); PG8_BAR; PG8_MMA(1, 0, At, B0); PG8_MMA(1, 1, At, B1); PG8_BAR; PG8_SCHED;
            } else {
            PG8_LDB(B0, 0, 0); PG8_SCHED; PG8_LDA(At, 0, 0); PG8_STAGE(PG8_SA(1, 1), a1 + hstep, voffA);
            PG8_WAIT_L(8); PG8_BAR; PG8_WAIT_L(0); PG8_MMA(0, 0, At, B0); PG8_BAR; PG8_SCHED;
            PG8_LDB(B1, 0, 1); PG8_STAGE(PG8_SB(0, 0), b2, voffB);
            PG8_BAR; PG8_WAIT_L(0); PG8_MMA(0, 1, At, B1); PG8_BAR;
            PG8_LDA(At, 0, 1); PG8_STAGE(PG8_SA(0, 0), a2, voffA);
            PG8_BAR; PG8_WAIT_L(0); PG8_MMA(1, 0, At, B0); PG8_BAR; PG8_SCHED;
            PG8_STAGE(PG8_SB(0, 1), b2 + hstep, voffB);
            PG8_WAIT_V(6); PG8_BAR; PG8_MMA(1, 1, At, B1); PG8_BAR;
            PG8_LDB(B0, 1, 0); PG8_SCHED; PG8_LDA(At, 1, 0); PG8_STAGE(PG8_SA(0, 1), a2 + hstep, voffA);
            PG8_WAIT_L(8); PG8_BAR; PG8_WAIT_L(0); PG8_MMA(0, 0, At, B0); PG8_BAR; PG8_SCHED;
            PG8_LDB(B1, 1, 1); PG8_STAGE(PG8_SB(1, 0), b3, voffB);
            PG8_BAR; PG8_WAIT_L(0); PG8_MMA(0, 1, At, B1); PG8_BAR;
            PG8_LDA(At, 1, 1); PG8_STAGE(PG8_SA(1, 0), a3, voffA);
            PG8_BAR; PG8_WAIT_L(0); PG8_MMA(1, 0, At, B0); PG8_BAR; PG8_SCHED;
            PG8_STAGE(PG8_SB(1, 1), b3 + hstep, voffB);
            PG8_WAIT_V(6); PG8_BAR; PG8_MMA(1, 1, At, B1); PG8_BAR;
            }
        }
        if constexpr (ALIGN_EPI) { if (wr == 0) PG8_BAR; }
        if constexpr (FP8) asm volatile("s_nop 15\n\ts_nop 15" : "+v"(acc[1][1][0][0]), "+v"(acc[1][1][0][1]), "+v"(acc[1][1][1][0]), "+v"(acc[1][1][1][1]), "+v"(acc[1][1][2][0]), "+v"(acc[1][1][2][1]), "+v"(acc[1][1][3][0]), "+v"(acc[1][1][3][1]));
        if constexpr (!Epi::AFTER_DRAIN) { E(acc, cur, wr, wc, fr, fq); S.done(cur); }
        if (!has_next) break;
#pragma unroll
        for (int a = 0; a < 2; ++a)
#pragma unroll
            for (int b = 0; b < 2; ++b)
#pragma unroll
                for (int m = 0; m < 4; ++m)
#pragma unroll
                    for (int n = 0; n < 2; ++n) acc[a][b][m][n] = (f32x4){0.f, 0.f, 0.f, 0.f};
        cur = nxt; cA = nA; cB = nB; ++ui;
        if constexpr (ALIGN_EPI) { if (wr == 1) PG8_BAR; }
    }
    PG8_WAIT_V(0);
    if constexpr (!ALIGN_EPI) { if (wr == 0) PG8_BAR; }
    PG8_BAR;
    if constexpr (Epi::AFTER_DRAIN) { E.fused(acc, cur, wr, wc, fr, fq, lds, wid, lane); S.done(cur); }
#undef PG8_SA
#undef PG8_SB
#undef PG8_STAGE
#undef PG8_LDA
#undef PG8_LDB
#undef PG8_MMA
#undef PG8_WAIT_V
#undef PG8_WAIT_L
#undef PG8_BAR
#undef PG8_SCHED
}
}

namespace pg8 {
struct EpiF32P {
    static constexpr bool PERM = false, AFTER_DRAIN = false;
    float* O; int ldc;
    __device__ __forceinline__ void operator()(const f32x4 (&acc)[2][2][4][2], const Unit& u, int wr, int wc, int fr, int fq) const {
        const int row0 = u.pm * BM + wr * 64 + fr, col0 = u.pn * BM + wc * 32 + 4 * fq;
#pragma unroll
        for (int ai = 0; ai < 2; ++ai)
#pragma unroll
            for (int m = 0; m < 4; ++m) { float* rowp = O + (size_t)(row0 + ai * HALF + m * 16) * ldc + col0;
#pragma unroll
                for (int bj = 0; bj < 2; ++bj)
#pragma unroll
                    for (int n = 0; n < 2; ++n) *(f32x4*)(rowp + bj * HALF + n * 16) = acc[ai][bj][m][n]; }
    }
};
struct EpiSwigluP {
    static constexpr bool PERM = true, AFTER_DRAIN = false;
    bf16_t* O; int ldc;
    __device__ __forceinline__ void operator()(const f32x4 (&acc)[2][2][4][2], const Unit& u, int wr, int wc, int fr, int fq) const {
        const int row0 = u.pm * BM + wr * 64 + fr, col0 = u.pn * HALF + wc * 32 + 8 * fq;
#pragma unroll
        for (int ai = 0; ai < 2; ++ai)
#pragma unroll
            for (int m = 0; m < 4; ++m) {
                float h[8];
#pragma unroll
                for (int n = 0; n < 2; ++n)
#pragma unroll
                    for (int j = 0; j < 4; ++j) { const float g = acc[ai][0][m][n][j], up = acc[ai][1][m][n][j];
                        h[4 * n + j] = g * up * __builtin_amdgcn_rcpf(1.0f + __builtin_amdgcn_exp2f(-1.4426950408889634f * g)); }
                u32x4 w; w.x = cvt_pk_bf16(h[0], h[1]); w.y = cvt_pk_bf16(h[2], h[3]); w.z = cvt_pk_bf16(h[4], h[5]); w.w = cvt_pk_bf16(h[6], h[7]);
                *(u32x4*)(O + (size_t)(row0 + ai * HALF + m * 16) * ldc + col0) = w; }
    }
};
struct EpiGateP {
    static constexpr bool PERM = true, AFTER_DRAIN = false;
    bf16_t* O; int ldc; const float* gate;
    __device__ __forceinline__ void operator()(const f32x4 (&acc)[2][2][4][2], const Unit& u, int wr, int wc, int fr, int fq) const {
        const int row0 = u.pm * BM + wr * 64 + fr, col0 = u.pn * BM + wc * 32 + 8 * fq;
#pragma unroll
        for (int ai = 0; ai < 2; ++ai)
#pragma unroll
            for (int m = 0; m < 4; ++m) { const int row = row0 + ai * HALF + m * 16; const float gt = gate[row]; bf16_t* rowp = O + (size_t)row * ldc + col0;
#pragma unroll
                for (int bj = 0; bj < 2; ++bj) { const f32x4 v0 = acc[ai][bj][m][0] * gt, v1 = acc[ai][bj][m][1] * gt;
                    u32x4 w; w.x = cvt_pk_bf16(v0[0], v0[1]); w.y = cvt_pk_bf16(v0[2], v0[3]); w.z = cvt_pk_bf16(v1[0], v1[1]); w.w = cvt_pk_bf16(v1[2], v1[3]);
                    *(u32x4*)(rowp + bj * HALF) = w; } }
    }
};
__device__ __forceinline__ unsigned pk4_fp8(float a, float b, float c, float d) {
    a = __builtin_fminf(__builtin_fmaxf(a, -448.f), 448.f); b = __builtin_fminf(__builtin_fmaxf(b, -448.f), 448.f);
    c = __builtin_fminf(__builtin_fmaxf(c, -448.f), 448.f); d = __builtin_fminf(__builtin_fmaxf(d, -448.f), 448.f);
    int w = 0; w = __builtin_amdgcn_cvt_pk_fp8_f32(a, b, w, false); w = __builtin_amdgcn_cvt_pk_fp8_f32(c, d, w, true); return (unsigned)w; }
struct EpiSwigluF8 {
    static constexpr bool PERM = true, AFTER_DRAIN = false;
    unsigned char* O; int ldc; float ws, hs;
    __device__ __forceinline__ void operator()(const f32x4 (&acc)[2][2][4][2], const Unit& u, int wr, int wc, int fr, int fq) const {
        const int row0 = u.pm * BM + wr * 64 + fr, col0 = u.pn * HALF + wc * 32 + 8 * fq;
#pragma unroll
        for (int ai = 0; ai < 2; ++ai)
#pragma unroll
            for (int m = 0; m < 4; ++m) {
                float h[8];
#pragma unroll
                for (int n = 0; n < 2; ++n)
#pragma unroll
                    for (int j = 0; j < 4; ++j) { const float g = acc[ai][0][m][n][j] * ws, up = acc[ai][1][m][n][j] * ws;
                        h[4 * n + j] = g * up * hs * __builtin_amdgcn_rcpf(1.0f + __builtin_amdgcn_exp2f(-1.4426950408889634f * g)); }
                typedef unsigned u32x2 __attribute__((ext_vector_type(2)));
                *(u32x2*)(O + (size_t)(row0 + ai * HALF + m * 16) * ldc + col0) = (u32x2){pk4_fp8(h[0], h[1], h[2], h[3]), pk4_fp8(h[4], h[5], h[6], h[7])}; }
    }
};
struct EpiGateS {
    static constexpr bool PERM = true, AFTER_DRAIN = false;
    bf16_t* O; int ldc; const float* gate; float sc;
    __device__ __forceinline__ void operator()(const f32x4 (&acc)[2][2][4][2], const Unit& u, int wr, int wc, int fr, int fq) const {
        const int row0 = u.pm * BM + wr * 64 + fr, col0 = u.pn * BM + wc * 32 + 8 * fq;
#pragma unroll
        for (int ai = 0; ai < 2; ++ai)
#pragma unroll
            for (int m = 0; m < 4; ++m) { const int row = row0 + ai * HALF + m * 16; const float gt = gate[row] * sc; bf16_t* rowp = O + (size_t)row * ldc + col0;
#pragma unroll
                for (int bj = 0; bj < 2; ++bj) { const f32x4 v0 = acc[ai][bj][m][0] * gt, v1 = acc[ai][bj][m][1] * gt;
                    u32x4 w; w.x = cvt_pk_bf16(v0[0], v0[1]); w.y = cvt_pk_bf16(v0[2], v0[3]); w.z = cvt_pk_bf16(v1[0], v1[1]); w.w = cvt_pk_bf16(v1[2], v1[3]);
                    *(u32x4*)(rowp + bj * HALF) = w; } }
    }
};
struct GroupedOrder {
    int nMe, nN, ntot, G, c;
    __device__ void init(int nMe_, int nN_, int ne, int G_, int c_) { nMe = nMe_; nN = nN_; ntot = nMe_ * nN_ * ne; G = G_; c = c_; }
    __device__ bool next(int i, Unit& u) const {
        const int L = i * G + c; if (L >= ntot) return false;
        const int per = nMe * nN, e = L / per, rem = L - e * per;
        u.e = e; u.pn = rem / nMe; u.pm = e * nMe + (rem - u.pn * nMe); return true;
    }
    __device__ __forceinline__ void a_ready(const Unit&) const {}
    __device__ __forceinline__ void done(const Unit&) const {}
};
struct L1InOrder {
    StaticOrder so; int G, c;
    __device__ void init(int G_, int c_) { so.init(16384, 2048, G_, 0); G = G_; c = c_; }
    __device__ bool next(int i, Unit& u) const {
        const int L = i * G + c;
        if (L < 512) { StaticOrder t = so; t.G = 1; t.c = 0; return t.next(L, u); }
        if (L < 544) { const int l = L - 512; u.pm = 64 + (l >> 2); u.pn = 2 + (l & 3); u.e = 0; return true; }
        return false;
    }
    __device__ __forceinline__ void a_ready(const Unit&) const {}
    __device__ __forceinline__ void done(const Unit&) const {}
};
}

#include <hip/hip_bf16.h>
#include <cmath>
namespace attn_body {
using bf16=__hip_bfloat16;
using bf16x8=__attribute__((ext_vector_type(8)))short;
using s16x4=__attribute__((ext_vector_type(4)))short;
using f32x16=__attribute__((ext_vector_type(16)))float;
using u32x4=__attribute__((ext_vector_type(4)))unsigned;
constexpr int D=64,OPITCH=1024;
constexpr int NW=8,QBLK=32,QB=QBLK*NW,KVBLK=64;
__device__ __forceinline__ int crow(int r,int hi){return (r&3)+8*(r>>2)+4*hi;}
#define SBAR() __builtin_amdgcn_sched_barrier(0)
__device__ __forceinline__ void cmask(f32x16&p0,f32x16&p1,int jb,int qrel,int hi){
  const float NEG=-INFINITY; int kb=64*jb+4*hi;
  #pragma unroll
  for(int r=0;r<16;++r){int kv=kb+(r&3)+8*(r>>2); if(kv>qrel)p0[r]=NEG; if(kv+32>qrel)p1[r]=NEG;}
}

constexpr int NSLOT=3, SLOTB=8192;
constexpr int LDS_K=0, LDS_V=NSLOT*SLOTB, LDS_WS=2*NSLOT*SLOTB, LDS_OST=LDS_WS+NW*64*4, LDS_BYTES=LDS_OST+NW*4096;
constexpr float C2=0.125f*1.4426950408889634f;
__device__ __forceinline__ void glds16(const void*gsrc,unsigned lds_dst){unsigned keep;
  asm volatile("s_mov_b32 %0, m0\n\ts_mov_b32 m0, %2\n\ts_nop 0\n\tglobal_load_lds_dwordx4 %1, off\n\ts_mov_b32 m0, %0":"=&s"(keep):"v"(gsrc),"s"(lds_dst):"memory");}
__device__ __forceinline__ float max3f(float a,float b,float c){float r;asm("v_max3_f32 %0, %1, %2, %3":"=v"(r):"v"(a),"v"(b),"v"(c));return r;}
__device__ __forceinline__ float max2f(float a,float b){float r;asm("v_max_f32_e32 %0, %1, %2":"=v"(r):"v"(a),"v"(b));return r;}
__device__ __forceinline__ float fadd_s(float a,float b){float r;asm("v_add_f32_e32 %0, %1, %2":"=v"(r):"v"(a),"v"(b));return r;}
__device__ __forceinline__ float fsub_s(float a,float b){float r;asm("v_sub_f32_e32 %0, %1, %2":"=v"(r):"v"(a),"v"(b));return r;}
typedef float f32x2_t __attribute__((ext_vector_type(2))); typedef __bf16 bf16x2_t __attribute__((ext_vector_type(2)));
__device__ __forceinline__ unsigned cvtpk_s(float lo,float hi){f32x2_t v={lo,hi};bf16x2_t b=__builtin_convertvector(v,bf16x2_t);return __builtin_bit_cast(unsigned,b);}
#define WAIT_BAR(N) asm volatile("s_waitcnt vmcnt(" #N ") lgkmcnt(0)\n\ts_barrier":::"memory")

__device__ __forceinline__ void qkt(f32x16&p0,f32x16&p1,const char*Kslot,const bf16x8*qr,const f32x16&negm,int r32,int hi){
  const char*kb=Kslot+hi*1024+r32*16;
  #pragma unroll
  for(int d0=0;d0<4;++d0){
    const bf16x8 b0=*reinterpret_cast<const bf16x8*>(kb+d0*2048);
    const bf16x8 b1=*reinterpret_cast<const bf16x8*>(kb+d0*2048+512);
    if(d0==0){p0=__builtin_amdgcn_mfma_f32_32x32x16_bf16(b0,qr[0],negm,0,0,0);p1=__builtin_amdgcn_mfma_f32_32x32x16_bf16(b1,qr[0],negm,0,0,0);}
    else{p0=__builtin_amdgcn_mfma_f32_32x32x16_bf16(b0,qr[d0],p0,0,0,0);p1=__builtin_amdgcn_mfma_f32_32x32x16_bf16(b1,qr[d0],p1,0,0,0);}}
}
typedef __attribute__((address_space(3))) const char* lds_cptr;
typedef short v4i16_t __attribute__((ext_vector_type(4)));
__device__ __forceinline__ void kload8(bf16x8*kf,lds_cptr kp){
  kf[0]=*(const __attribute__((address_space(3))) bf16x8*)(kp);      kf[1]=*(const __attribute__((address_space(3))) bf16x8*)(kp+512);
  kf[2]=*(const __attribute__((address_space(3))) bf16x8*)(kp+2048); kf[3]=*(const __attribute__((address_space(3))) bf16x8*)(kp+2560);
  kf[4]=*(const __attribute__((address_space(3))) bf16x8*)(kp+4096); kf[5]=*(const __attribute__((address_space(3))) bf16x8*)(kp+4608);
  kf[6]=*(const __attribute__((address_space(3))) bf16x8*)(kp+6144); kf[7]=*(const __attribute__((address_space(3))) bf16x8*)(kp+6656);
}
__device__ __forceinline__ void kload2(bf16x8*kf,lds_cptr kp,int j){ kf[2*j]=*(const __attribute__((address_space(3))) bf16x8*)(kp+j*2048); kf[2*j+1]=*(const __attribute__((address_space(3))) bf16x8*)(kp+j*2048+512); }
__device__ __forceinline__ s16x4 vtr(lds_cptr p){ return __builtin_bit_cast(s16x4,__builtin_amdgcn_ds_read_tr16_b64_v4i16((__attribute__((address_space(3))) v4i16_t*)p)); }
__device__ __forceinline__ float rowmax(const f32x16&p0,const f32x16&p1){
  float a=max3f(p0[0],p0[1],p1[0]),b=max3f(p0[2],p0[3],p1[1]);a=max3f(a,p1[2],p1[3]);
  #pragma unroll
  for(int r=4;r<16;r+=4){a=max3f(a,p0[r],p0[r+1]);b=max3f(b,p0[r+2],p0[r+3]);a=max3f(a,p1[r],p1[r+1]);b=max3f(b,p1[r+2],p1[r+3]);}
  const float m=max2f(a,b);
  auto rr=__builtin_amdgcn_permlane32_swap(__float_as_uint(m),__float_as_uint(m),false,false);
  return max2f(__uint_as_float(rr[0]),__uint_as_float(rr[1]));
}
__device__ __forceinline__ void pv(f32x16*o,int vb,bf16x8 pa0,bf16x8 pa1,bf16x8 pa2,bf16x8 pa3){
  #pragma unroll
  for(int d0=0;d0<2;++d0){s16x4 lo[4],hi[4];
    #pragma unroll
    for(int ks=0;ks<4;++ks){
      asm volatile("ds_read_b64_tr_b16 %0,%1 offset:%c2":"=&v"(lo[ks]):"v"(vb),"i"(d0*4096+ks*1024):"memory");
      asm volatile("ds_read_b64_tr_b16 %0,%1 offset:%c2":"=&v"(hi[ks]):"v"(vb),"i"(d0*4096+ks*1024+512):"memory");}
    asm volatile("s_waitcnt lgkmcnt(0)":::"memory");SBAR();
    #define PK(k) (bf16x8){lo[k][0],lo[k][1],lo[k][2],lo[k][3],hi[k][0],hi[k][1],hi[k][2],hi[k][3]}
    o[d0]=__builtin_amdgcn_mfma_f32_32x32x16_bf16(pa0,PK(0),o[d0],0,0,0);
    o[d0]=__builtin_amdgcn_mfma_f32_32x32x16_bf16(pa1,PK(1),o[d0],0,0,0);
    o[d0]=__builtin_amdgcn_mfma_f32_32x32x16_bf16(pa2,PK(2),o[d0],0,0,0);
    o[d0]=__builtin_amdgcn_mfma_f32_32x32x16_bf16(pa3,PK(3),o[d0],0,0,0);
    #undef PK
  }
}

#ifndef ATTN_STORE16
#define ATTN_STORE16(p,v) (*(u32x4*)(p)=(v))
#endif
struct AU { const bf16* Qp; const bf16* Kp; const bf16* Vp; bf16* Op; int qrow0, lat_row0, ctx_row0, nlat_t, NT; };
struct NoMask { __device__ __forceinline__ void apply(f32x16&,f32x16&,int,int)const{} };
typedef __attribute__((address_space(3))) const float* lds_cfptr;
struct NAMask { lds_cfptr tb0; int r, rs, rs_min, cb;
  __device__ __forceinline__ void apply(f32x16&p0,f32x16&p1,int t,int hi)const{
    if(t<4)return;
    const int kr=rs_min+t-4; const float NEG=-INFINITY;
    if((unsigned)(kr-rs)>7u){
      #pragma unroll
      for(int i=0;i<16;++i){p0[i]=NEG;p1[i]=NEG;}
      return; }
    const lds_cfptr tb=tb0+(kr-r+7)*32+4*hi;
    #pragma unroll
    for(int i=0;i<16;++i){ const int k0=(i&3)+8*(i>>2); const int d0=cb+k0, d1=cb+k0+32;
      const float b0=tb[k0], b1=tb[k0+32];
      p0[i]=((unsigned)d0<=15u)?p0[i]+b0:NEG; p1[i]=((unsigned)d1<=15u)?p1[i]+b1:NEG; }
  }
};
template<int THRL,int PITCH,class MaskT> __device__ __forceinline__ void attn_unit(const AU& u,char*shm,const MaskT& mk){
  const int tid=threadIdx.x,lane=tid&63,r32=lane&31,hi=lane>>5; const int wid=__builtin_amdgcn_readfirstlane(tid>>6);
  const bf16*Qw=u.Qp+(long)(u.qrow0+wid*QBLK)*PITCH;
  const bf16*Kh=u.Kp,*Vh=u.Vp;
  const unsigned lds0=(unsigned)(uintptr_t)shm;
  float*wsf=(float*)(shm+LDS_WS)+wid*64;
  const bf16*ksrc=Kh+(long)lane*PITCH+wid*8;
  const bf16*vsrc=Vh+(long)(16*(wid&3)+(lane>>2))*PITCH+(wid>>2)*32+(lane&3)*8;
  const unsigned kdst=lds0+LDS_K+wid*1024, vdst=lds0+LDS_V+wid*1024;
  #define TROW(t) ((long)((t)<u.nlat_t?u.lat_row0+KVBLK*(t):u.ctx_row0+KVBLK*((t)-u.nlat_t))*PITCH)
  #define DMA_K(t,slot) glds16(ksrc+TROW(t),(unsigned)__builtin_amdgcn_readfirstlane(kdst+(slot)))
  #define DMA_V(t,slot) glds16(vsrc+TROW(t),(unsigned)__builtin_amdgcn_readfirstlane(vdst+(slot)))
  const int vb0=(int)(lds0+LDS_V)+((lane>>4)&1)*32+(lane&3)*8+(4*hi+((lane&15)>>2))*64;
  const char*Kbase=shm+LDS_K; bf16x8 kf[8];
  const lds_cptr shm3=(lds_cptr)shm; const lds_cptr kp0=shm3+LDS_K+hi*1024+r32*16; const lds_cptr vp0=shm3+LDS_V+((lane>>4)&1)*32+(lane&3)*8+(4*hi+((lane&15)>>2))*64;
  const int NT=u.NT;
  DMA_K(0,0);DMA_V(0,0);DMA_K(1,SLOTB);
  bf16x8 qr[4];
  #pragma unroll
  for(int d0=0;d0<4;++d0)qr[d0]=*reinterpret_cast<const bf16x8*>(&Qw[(long)r32*PITCH+d0*16+hi*8]);
  float mhat=0.f,l_reg=0.f;f32x16 o[2];o[0]=f32x16{};o[1]=f32x16{};f32x16 negm=f32x16{};asm volatile("":"+v"(negm));
  #define CMASK(P0,P1,t) mk.apply(P0,P1,(t),hi)
  bool resc=false;
  #define START(P0,P1) do{ const float rm=rowmax(P0,P1); resc=false; \
    { const float dl=rm; mhat=fadd_s(mhat,dl); \
      _Pragma("unroll") for(int r=0;r<16;++r){P0[r]=fsub_s(P0[r],dl);P1[r]=fsub_s(P1[r],dl);} \
      _Pragma("unroll") for(int r=0;r<16;++r)negm[r]=-mhat; asm volatile("":"+v"(negm)); } \
    _Pragma("unroll") for(int r=0;r<16;++r)P0[r]=__builtin_amdgcn_exp2f(P0[r]); }while(0)
  #define RESC() do{ if(resc){ asm volatile("s_waitcnt lgkmcnt(0)":::"memory"); \
      _Pragma("unroll") for(int d_=0;d_<2;++d_) _Pragma("unroll") for(int r=0;r<16;++r)o[d_][r]*=wsf[crow(r,hi)]; } }while(0)
  f32x16 pA0,pA1,pB0,pB1;
  int sl_prev=0,sl_cur=0,sl_next=SLOTB;
  #define ROT() do{sl_prev=sl_cur;sl_cur=sl_next;sl_next=(sl_next==(NSLOT-1)*SLOTB)?0:sl_next+SLOTB;}while(0)
  DMA_K(2,2*SLOTB);
  WAIT_BAR(3);
  qkt(pA0,pA1,Kbase,qr,negm,r32,hi);asm volatile("s_nop 15\n\ts_nop 7":"+v"(pA0),"+v"(pA1));CMASK(pA0,pA1,0);
  START(pA0,pA1);
  _Pragma("unroll") for(int r=0;r<16;++r)pA1[r]=__builtin_amdgcn_exp2f(pA1[r]);
  WAIT_BAR(0);
  DMA_K(3,0);DMA_V(1,SLOTB);
  ROT();
  kload8(kf,kp0+sl_cur);
  WAIT_BAR(2);
  s16x4 vlo[8],vhi[8]; u32x4 pw0,pw1,pw2,pw3;
  #define PKW(P,B) cvtpk_s(P[B],P[B+1])
  #define PAF(k) __builtin_bit_cast(bf16x8,pw##k)
  #define VFR(i) (bf16x8){vlo[i][0],vlo[i][1],vlo[i][2],vlo[i][3],vhi[i][0],vhi[i][1],vhi[i][2],vhi[i][3]}
  #define PIN(x) asm volatile("":"+v"(x))
  #define MX3(a,b,c) __builtin_fmaxf(__builtin_fmaxf((a),(b)),(c))
  #define GAPA(MF,A0,A1,A2,A3,W0,W1,PW) do{ MF; sacc+=A0; sacc+=A1; sacc+=A2; sacc+=A3; PIN(sacc); W0; W1; PIN(PW); SBAR(); }while(0)
  #define EX(v) __builtin_amdgcn_exp2f(v)
  #define GAPB(MF,X,B) do{ MF; X[B]=EX(X[B]); X[B+1]=EX(X[B+1]); X[B+2]=EX(X[B+2]); X[B+3]=EX(X[B+3]); PIN(X); SBAR(); }while(0)
  #define VRD(i) do{ vlo[i]=vtr(vp_+(((i)>>2)*4096+((i)&3)*1024)); vhi[i]=vtr(vp_+(((i)>>2)*4096+((i)&3)*1024+512)); }while(0)
  #define KRD(G,j) do{ if(G){ kload2(kf,kp0+sl_next,j); SBAR(); } }while(0)
  #define STEP(C0,C1,P0,P1,t,GK,GV,GL) do{ SBAR(); \
    const lds_cptr vp_=vp0+sl_prev; \
    VRD(0); SBAR(); float sacc=(P0[0]+P0[1]); \
    GAPA(C0=__builtin_amdgcn_mfma_f32_32x32x16_bf16(kf[0],qr[0],negm,0,0,0), P0[2],P0[3],P0[4],P0[5],     pw0[0]=PKW(P0,0), pw0[1]=PKW(P0,2), pw0); \
    VRD(4); SBAR(); GAPA(C1=__builtin_amdgcn_mfma_f32_32x32x16_bf16(kf[1],qr[0],negm,0,0,0), P0[6],P0[7],P0[8],P0[9],     pw0[2]=PKW(P0,4), pw0[3]=PKW(P0,6), pw0); \
    VRD(1); SBAR(); GAPA(C0=__builtin_amdgcn_mfma_f32_32x32x16_bf16(kf[2],qr[1],C0,0,0,0),   P0[10],P0[11],P0[12],P0[13], pw1[0]=PKW(P0,8), pw1[1]=PKW(P0,10), pw1); \
    VRD(5); SBAR(); GAPA(C1=__builtin_amdgcn_mfma_f32_32x32x16_bf16(kf[3],qr[1],C1,0,0,0),   P0[14],P0[15],P1[0],P1[1],   pw1[2]=PKW(P0,12),pw1[3]=PKW(P0,14), pw1); \
    VRD(2); SBAR(); GAPA(C0=__builtin_amdgcn_mfma_f32_32x32x16_bf16(kf[4],qr[2],C0,0,0,0),   P1[2],P1[3],P1[4],P1[5],     pw2[0]=PKW(P1,0), pw2[1]=PKW(P1,2), pw2); \
    VRD(6); SBAR(); GAPA(C1=__builtin_amdgcn_mfma_f32_32x32x16_bf16(kf[5],qr[2],C1,0,0,0),   P1[6],P1[7],P1[8],P1[9],     pw2[2]=PKW(P1,4), pw2[3]=PKW(P1,6), pw2); \
    VRD(3); SBAR(); GAPA(C0=__builtin_amdgcn_mfma_f32_32x32x16_bf16(kf[6],qr[3],C0,0,0,0),   P1[10],P1[11],P1[12],P1[13], pw3[0]=PKW(P1,8), pw3[1]=PKW(P1,10), pw3); \
    VRD(7); SBAR(); GAPA(C1=__builtin_amdgcn_mfma_f32_32x32x16_bf16(kf[7],qr[3],C1,0,0,0),   P1[14],P1[15],0.f,0.f,       pw3[2]=PKW(P1,12),pw3[3]=PKW(P1,14), pw3); \
    l_reg+=sacc; \
    if(GK){DMA_K((t)+3,sl_cur);} if(GV){DMA_V((t)+1,sl_next);} \
    CMASK(C0,C1,t); \
    { float a=MX3(C0[0],C0[1],C1[0]),b=MX3(C0[2],C0[3],C1[1]); a=MX3(a,C1[2],C1[3]); \
      _Pragma("unroll") for(int r=4;r<16;r+=4){a=MX3(a,C0[r],C0[r+1]);b=MX3(b,C0[r+2],C0[r+3]);a=MX3(a,C1[r],C1[r+1]);b=MX3(b,C1[r+2],C1[r+3]);} \
      float rm=__builtin_fmaxf(a,b); { auto rr=__builtin_amdgcn_permlane32_swap(__float_as_uint(rm),__float_as_uint(rm),false,false); rm=__builtin_fmaxf(__uint_as_float(rr[0]),__uint_as_float(rr[1])); } \
      resc=false; \
      if(__builtin_expect(__any(rm>(float)THRL),0)){ const float dl=__builtin_fmaxf(rm,0.f); mhat+=dl; \
        _Pragma("unroll") for(int r=0;r<16;++r){C0[r]-=dl;C1[r]-=dl;} \
        _Pragma("unroll") for(int r=0;r<16;++r)negm[r]=-mhat; asm volatile("":"+v"(negm)); \
        const float f=__builtin_amdgcn_exp2f(-dl); l_reg*=f; if(hi==0)wsf[r32]=f; resc=true; } } \
    SBAR(); \
    GAPB(o[0]=__builtin_amdgcn_mfma_f32_32x32x16_bf16(PAF(0),VFR(0),o[0],0,0,0), C0,0); \
    GAPB(o[1]=__builtin_amdgcn_mfma_f32_32x32x16_bf16(PAF(0),VFR(4),o[1],0,0,0), C0,4); \
    KRD(GL,0); GAPB(o[0]=__builtin_amdgcn_mfma_f32_32x32x16_bf16(PAF(1),VFR(1),o[0],0,0,0), C0,8); \
    KRD(GL,1); GAPB(o[1]=__builtin_amdgcn_mfma_f32_32x32x16_bf16(PAF(1),VFR(5),o[1],0,0,0), C0,12); \
    KRD(GL,2); GAPB(o[0]=__builtin_amdgcn_mfma_f32_32x32x16_bf16(PAF(2),VFR(2),o[0],0,0,0), C1,0); \
    KRD(GL,3); GAPB(o[1]=__builtin_amdgcn_mfma_f32_32x32x16_bf16(PAF(2),VFR(6),o[1],0,0,0), C1,4); \
    GAPB(o[0]=__builtin_amdgcn_mfma_f32_32x32x16_bf16(PAF(3),VFR(3),o[0],0,0,0), C1,8); \
    GAPB(o[1]=__builtin_amdgcn_mfma_f32_32x32x16_bf16(PAF(3),VFR(7),o[1],0,0,0), C1,12); \
    }while(0)
  int t=1;
  #undef CMASK
  #define CMASK(P0,P1,t) mk.apply(P0,P1,(t),hi)
  for(;t+5<NT;t+=2){
    STEP(pB0,pB1,pA0,pA1,t,true,true,true);     WAIT_BAR(2); RESC(); ROT();
    STEP(pA0,pA1,pB0,pB1,t+1,true,true,true);   WAIT_BAR(2); RESC(); ROT();
  }
  #undef CMASK
  #define CMASK(P0,P1,t) mk.apply(P0,P1,(t),hi)
  #define ENDW(tt) do{ if((tt)+3<NT){WAIT_BAR(2);} else if((tt)+2<NT){WAIT_BAR(1);} else {WAIT_BAR(0);} }while(0)
  for(;t+1<NT;t+=2){
    STEP(pB0,pB1,pA0,pA1,t,(t+3<NT),(t+1<NT),(t+1<NT));       ENDW(t);   RESC(); ROT();
    STEP(pA0,pA1,pB0,pB1,t+1,(t+4<NT),(t+2<NT),(t+2<NT));     ENDW(t+1); RESC(); ROT();
  }
  STEP(pB0,pB1,pA0,pA1,NT-1,false,false,false); RESC();
  { float sacc=pB0[0]+pB0[1]; _Pragma("unroll") for(int r=2;r<16;++r)sacc+=pB0[r]; _Pragma("unroll") for(int r=0;r<16;++r)sacc+=pB1[r]; l_reg+=sacc;
    pw0=(u32x4){PKW(pB0,0),PKW(pB0,2),PKW(pB0,4),PKW(pB0,6)};pw1=(u32x4){PKW(pB0,8),PKW(pB0,10),PKW(pB0,12),PKW(pB0,14)};pw2=(u32x4){PKW(pB1,0),PKW(pB1,2),PKW(pB1,4),PKW(pB1,6)};pw3=(u32x4){PKW(pB1,8),PKW(pB1,10),PKW(pB1,12),PKW(pB1,14)};
    SBAR(); pv(o,vb0+sl_cur,PAF(0),PAF(1),PAF(2),PAF(3)); }
  #undef PKW
  #undef PAF
  #undef VFR
  #undef PIN
  #undef MX3
  #undef GAPA
  #undef GAPB
  #undef EX
  #undef VRD
  #undef KRD
  #undef STEP
  #undef ENDW
  {auto rr=__builtin_amdgcn_permlane32_swap(__float_as_uint(l_reg),__float_as_uint(l_reg),false,false);l_reg=__uint_as_float(rr[0])+__uint_as_float(rr[1]);}
  if(hi==0)wsf[32+r32]=l_reg;asm volatile("s_waitcnt lgkmcnt(0)":::"memory");
  float rli[16];
  #pragma unroll
  for(int r=0;r<16;++r)rli[r]=__builtin_amdgcn_rcpf(wsf[32+crow(r,hi)]);
  bf16*Ow=u.Op+(long)(u.qrow0+wid*QBLK)*OPITCH;
  { bf16*stg=(bf16*)(shm+LDS_OST)+wid*2048;
    #pragma unroll
    for(int r=0;r<16;++r){const int orow=crow(r,hi);
      #pragma unroll
      for(int d0=0;d0<2;++d0)stg[orow*64+d0*32+r32]=__float2bfloat16(o[d0][r]*rli[r]);}
    asm volatile("s_waitcnt lgkmcnt(0)":::"memory");
    #pragma unroll
    for(int i=0;i<4;++i){const int row=i*8+(lane>>3),ch=lane&7; const u32x4 v=*(const u32x4*)(stg+row*64+ch*8); ATTN_STORE16(Ow+(long)row*OPITCH+ch*8,v);} }
  asm volatile("s_waitcnt lgkmcnt(0)\n\ts_barrier":::"memory");
  #undef DMA_K
  #undef TROW
  #undef DMA_V
  #undef CMASK
  #undef START
  #undef RESC
  #undef ROT
}
constexpr int ATTN_LDS_BYTES=LDS_BYTES;
#undef SBAR
#undef WAIT_BAR
}

struct Params { const float* in[26]; float* out; unsigned char* ws; int ph_lo, ph_hi; };
struct Ctx { LAS unsigned char* lds; int tid, lane, wave, vcu, G, gw, NGW; };
enum { I_X = 0, I_C, I_CTX, I_CCTX, I_ADAW, I_ADAB, I_LNG, I_LNB, I_W0IN, I_W0OUT, I_LQ1, I_LK1, I_LQ2, I_LK2, I_SUBLN, I_QN, I_KN,
       I_W1IN, I_W1OUT, I_RPB, I_POOLW, I_POOLS, I_ROUTER, I_WG, I_WU, I_WD };

__device__ __forceinline__ const float* mod_row(const Params& p, int layer, int row) {
    return (const float*)(p.ws + WS_MOD) + (size_t)(layer * 9 + (row < LAT ? (row >> 11) : 8)) * 6144;
}

__device__ __forceinline__ void ph_prologue(const Params& p, const Ctx& c) {
    const float* cin = p.in[I_C]; const float* cctx = p.in[I_CCTX]; const float* ada_w = p.in[I_ADAW]; const float* ada_b = p.in[I_ADAB];
    float* MOD = (float*)(p.ws + WS_MOD);
    LAS float* sc = (LAS float*)c.lds;
    LAS float* red = sc + 9 * 1024;
    for (int i = c.tid; i < 9 * 1024; i += 512) { const float v = i < 8192 ? cin[i] : cctx[i - 8192]; sc[i] = v / (1.f + expf(-v)); }
    __syncthreads();
    for (int u = c.vcu; u < 256; u += c.G) {
        const int layer = u >> 7, j0 = (u & 127) * 48;
        const int jc = c.tid % 48, kg = c.tid / 48;
        if (kg < 10) {
            float acc[9];
#pragma unroll
            for (int m = 0; m < 9; ++m) acc[m] = 0.f;
            const float* wp = ada_w + (size_t)layer * 1024 * 6144 + j0 + jc;
            for (int k = kg; k < 1024; k += 10) {
                const float w = wp[(size_t)k * 6144];
#pragma unroll
                for (int m = 0; m < 9; ++m) acc[m] += sc[m * 1024 + k] * w;
            }
#pragma unroll
            for (int m = 0; m < 9; ++m) red[(kg * 9 + m) * 48 + jc] = acc[m];
        }
        __syncthreads();
        if (c.tid < 432) {
            const int m = c.tid / 48, j = c.tid % 48; float s = 0.f;
#pragma unroll
            for (int g = 0; g < 10; ++g) s += red[(g * 9 + m) * 48 + j];
            MOD[(size_t)(layer * 9 + m) * 6144 + j0 + j] = s + ada_b[layer * 6144 + j0 + j];
        }
        __syncthreads();
    }
    if (c.vcu == 0) {
        f32x2* R = (f32x2*)(p.ws + WS_ROPE);
        for (int i = c.tid; i < 1024; i += 512) {
            const int pos = i >> 4, f = i & 15;
            const float inv = exp2f(-(float)f * (13.287712379549449f / 16.f));
            const float a = (float)pos * inv;
            const float k = rintf(a * 0.15915494309189535f);
            float rr = fmaf(-k, 6.28125f, a); rr = fmaf(-k, 1.9353071795864769e-3f, rr);
            R[i] = (f32x2){__cosf(rr), __sinf(rr)};
        }
    }
}


__device__ __forceinline__ void transpose_item(const float* W, int ldw, int k0, int n0, bf16* WT, int Kd, int drow0, LAS float* scr, int lane) {
#pragma unroll 8
    for (int i = 0; i < 32; ++i) { const int kk = 2 * i + (lane >> 5); scr[kk * 33 + (lane & 31)] = W[(size_t)(k0 + kk) * ldw + n0 + (lane & 31)]; }
    asm volatile("s_waitcnt lgkmcnt(0)" ::: "memory");
    const int ch = lane & 7;
#pragma unroll
    for (int j = 0; j < 4; ++j) { const int n = (lane >> 3) + 8 * j; const LAS float* sp = scr + (8 * ch) * 33 + n;
        v4u o; o.x = pk2(sp[0 * 33], sp[1 * 33]); o.y = pk2(sp[2 * 33], sp[3 * 33]); o.z = pk2(sp[4 * 33], sp[5 * 33]); o.w = pk2(sp[6 * 33], sp[7 * 33]);
        *(v4u*)(WT + (size_t)(drow0 + n) * Kd + k0 + 8 * ch) = o; }
    asm volatile("s_waitcnt lgkmcnt(0)" ::: "memory");
}
__device__ __forceinline__ void transpose_item8(const float* W, int ldw, int k0, int n0, unsigned char* WT8, int Kd, int drow0, float scale, LAS float* scr, int lane) {
#pragma unroll 8
    for (int i = 0; i < 32; ++i) { const int kk = 2 * i + (lane >> 5); scr[kk * 33 + (lane & 31)] = W[(size_t)(k0 + kk) * ldw + n0 + (lane & 31)]; }
    asm volatile("s_waitcnt lgkmcnt(0)" ::: "memory");
    const int n = lane >> 1, hf = lane & 1; const LAS float* sp = scr + (32 * hf) * 33 + n;
    v4u o0, o1;
    o0.x = pg8::pk4_fp8(sp[0 * 33] * scale, sp[1 * 33] * scale, sp[2 * 33] * scale, sp[3 * 33] * scale);     o0.y = pg8::pk4_fp8(sp[4 * 33] * scale, sp[5 * 33] * scale, sp[6 * 33] * scale, sp[7 * 33] * scale);
    o0.z = pg8::pk4_fp8(sp[8 * 33] * scale, sp[9 * 33] * scale, sp[10 * 33] * scale, sp[11 * 33] * scale);   o0.w = pg8::pk4_fp8(sp[12 * 33] * scale, sp[13 * 33] * scale, sp[14 * 33] * scale, sp[15 * 33] * scale);
    o1.x = pg8::pk4_fp8(sp[16 * 33] * scale, sp[17 * 33] * scale, sp[18 * 33] * scale, sp[19 * 33] * scale); o1.y = pg8::pk4_fp8(sp[20 * 33] * scale, sp[21 * 33] * scale, sp[22 * 33] * scale, sp[23 * 33] * scale);
    o1.z = pg8::pk4_fp8(sp[24 * 33] * scale, sp[25 * 33] * scale, sp[26 * 33] * scale, sp[27 * 33] * scale); o1.w = pg8::pk4_fp8(sp[28 * 33] * scale, sp[29 * 33] * scale, sp[30 * 33] * scale, sp[31 * 33] * scale);
    unsigned char* dst = WT8 + (size_t)(drow0 + n) * Kd + k0 + 32 * hf;
    *(v4u*)dst = o0; *(v4u*)(dst + 16) = o1;
    asm volatile("s_waitcnt lgkmcnt(0)" ::: "memory");
}
__device__ __forceinline__ void ph_transposes(const Params& p, const Ctx& c) {
    LAS float* scr = (LAS float*)(c.lds + c.wave * 16384);
    constexpr int I0 = 16 * 72, I1 = 16 * 32, I2 = 16 * 64, I3 = 16 * 32, ISM = I0 + I1 + I2 + I3, IEX = 3072, NIT = ISM + 32 * IEX;
    for (int pr = c.gw; 2 * pr < NIT; pr += c.NGW)
    for (int sub = 0; sub < 2; ++sub) {
        int r = 2 * pr + sub;
        if (r < I0) { transpose_item(p.in[I_W0IN], EIN, 64 * (r / 72), 32 * (r % 72), (bf16*)(p.ws + WS_W0IN), DM, 32 * (r % 72), scr, c.lane); continue; } r -= I0;
        if (r < I1) { transpose_item(p.in[I_W0OUT], DM, 64 * (r / 32), 32 * (r % 32), (bf16*)(p.ws + WS_W0OUT), DM, 32 * (r % 32), scr, c.lane); continue; } r -= I1;
        if (r < I2) { transpose_item(p.in[I_W1IN], OIN, 64 * (r / 64), 32 * (r % 64), (bf16*)(p.ws + WS_W1IN), DM, 32 * (r % 64), scr, c.lane); continue; } r -= I2;
        if (r < I3) { transpose_item(p.in[I_W1OUT], DM, 64 * (r / 32), 32 * (r % 32), (bf16*)(p.ws + WS_W1OUT), DM, 32 * (r % 32), scr, c.lane); continue; } r -= I3;
        const int ie = r / IEX, q = r - ie * IEX, layer = ie >> 4, e = ie & 15, which = q >> 10, idx = q & 1023;
        if (MOE_FP8) {
            if (which < 2) {
                const float* W = (which == 0 ? p.in[I_WG] : p.in[I_WU]) + (size_t)ie * DM * FF;
                const int k0 = 64 * (idx & 15), n0 = 32 * (idx >> 4);
                unsigned char* WT8 = p.ws + WS_WGU + (size_t)layer * WS_MOE_LSTRIDE + (size_t)e * 4096 * DM;
                transpose_item8(W, FF, k0, n0, WT8, DM, (n0 >> 7) * 256 + (n0 & 127) + which * 128, W8_GU, scr, c.lane);
            } else {
                const float* W = p.in[I_WD] + (size_t)ie * FF * DM;
                const int k0 = 64 * (idx & 31), n0 = 32 * (idx >> 5);
                unsigned char* WT8 = p.ws + WS_WDN + (size_t)layer * WS_MOE_LSTRIDE + (size_t)e * DM * FF;
                transpose_item8(W, DM, k0, n0, WT8, FF, n0, W8_DN, scr, c.lane);
            }
        } else if (which < 2) {
            const float* W = (which == 0 ? p.in[I_WG] : p.in[I_WU]) + (size_t)ie * DM * FF;
            const int k0 = 64 * (idx >> 6), n0 = 32 * (idx & 63);
            bf16* WT = (bf16*)(p.ws + WS_WGU + (size_t)layer * WS_MOE_LSTRIDE) + (size_t)e * 4096 * DM;
            transpose_item(W, FF, k0, n0, WT, DM, (n0 >> 7) * 256 + (n0 & 127) + which * 128, scr, c.lane);
        } else {
            const float* W = p.in[I_WD] + (size_t)ie * FF * DM;
            const int k0 = 64 * (idx >> 5), n0 = 32 * (idx & 31);
            bf16* WT = (bf16*)(p.ws + WS_WDN + (size_t)layer * WS_MOE_LSTRIDE) + (size_t)e * DM * FF;
            transpose_item(W, DM, k0, n0, WT, FF, n0, scr, c.lane);
        }
    }
}

__device__ __forceinline__ void ph_modulate0(const Params& p, const Ctx& c) {
    bf16* HB = (bf16*)(p.ws + WS_HB);
    for (int row = c.gw; row < NTOK; row += c.NGW) {
        const float* src = row < LAT ? p.in[I_X] + (size_t)row * DM : p.in[I_CTX] + (size_t)(row - LAT) * DM;
        const float* mod = mod_row(p, 0, row);
#pragma unroll
        for (int j = 0; j < 4; ++j) {
            const int col = 4 * c.lane + 256 * j;
            const f32x4 v = *(const f32x4*)(src + col), sh = *(const f32x4*)(mod + col), s = *(const f32x4*)(mod + 1024 + col);
            const f32x4 h = v * (s + 1.f) + sh;
            *(v2u*)(HB + (size_t)row * DM + col) = (v2u){pk2(h.x, h.y), pk2(h.z, h.w)};
        }
    }
}

struct NG { const bf16* A; int lda; const float* W0; const float* W1; int ldw; size_t wstride; int Mb; int row_begin, row_end, col_begin, col_end, K; };
template <int NB, class Epi>
__device__ __forceinline__ void ngemm(const NG& g, const Ctx& c, const Epi& epi) {
    const int nmt = (g.row_end - g.row_begin) / 32, nnt = (g.col_end - g.col_begin) / 32;
    const int l31 = c.lane & 31, lh = c.lane >> 5;
    for (int t = c.gw; t < nmt * nnt; t += c.NGW) {
        const int mt = t / nnt, nt = t % nnt;
        const int row0 = g.row_begin + mt * 32, col0 = g.col_begin + nt * 32;
        const int e = row0 / g.Mb;
        const bf16* ap = g.A + (size_t)(row0 + l31) * g.lda + lh;
        const float* bp0 = g.W0 + (size_t)e * g.wstride + (size_t)lh * g.ldw + col0 + l31;
        const float* bp1 = NB == 2 ? g.W1 + (size_t)e * g.wstride + (size_t)lh * g.ldw + col0 + l31 : nullptr;
        f32x16 acc0 = {}, acc1 = {};
#pragma unroll 8
        for (int k = 0; k < g.K; k += 2) {
            const float a = bf2f((unsigned)ap[k]);
            const float b0 = bp0[(size_t)k * g.ldw];
            acc0 = __builtin_amdgcn_mfma_f32_32x32x2f32(a, b0, acc0, 0, 0, 0);
            if (NB == 2) { const float b1 = bp1[(size_t)k * g.ldw]; acc1 = __builtin_amdgcn_mfma_f32_32x32x2f32(a, b1, acc1, 0, 0, 0); }
        }
#pragma unroll
        for (int r = 0; r < 16; ++r) {
            const int row = row0 + (r & 3) + 8 * (r >> 2) + 4 * lh, col = col0 + l31;
            epi(row, col, acc0[r], acc1[r]);
        }
    }
}
struct EpiF32 { float* O; int ldc; __device__ __forceinline__ void operator()(int row, int col, float v0, float) const { O[(size_t)row * ldc + col] = v0; } };
struct EpiBf { bf16* O; int ldc; int scale_cols; float sc; __device__ __forceinline__ void operator()(int row, int col, float v0, float) const { O[(size_t)row * ldc + col] = (bf16)f2bf(col < scale_cols ? v0 * sc : v0); } };
struct EpiSwiglu { bf16* O; __device__ __forceinline__ void operator()(int row, int col, float g, float u) const { const float s = g / (1.f + __expf(-g)); O[(size_t)row * FF + col] = (bf16)f2bf(s * u); } };
struct EpiGate { bf16* O; const float* gate; __device__ __forceinline__ void operator()(int row, int col, float v0, float) const { O[(size_t)row * DM + col] = (bf16)f2bf(v0 * gate[row]); } };

template <bool F32IN> __device__ __forceinline__ void ph_qkv_post(const Params& p, const Ctx& c) {
    const float* PF = (const float*)(p.ws + WS_PF);
    bf16* QKV = (bf16*)(p.ws + WS_QKV);
    const f32x2* R = (const f32x2*)(p.ws + WS_ROPE);
    const float* qn = p.in[I_QN]; const float* kn = p.in[I_KN];
    const int d = c.lane;
    const float qg = qn[d], kg = kn[d];
    for (int row = c.gw; row < NTOK; row += c.NGW) {
        const bool lat = row < LAT;
        const int t = row & 2047;
        const int pos = (d < 32) ? (t >> 6) : (t & 63);
        const f32x2 cs = R[pos * 16 + (d & 15)];
        const bool first = (d & 16) == 0;
        float vv[36];
#pragma unroll
        for (int hs = 0; hs < 36; ++hs) vv[hs] = F32IN ? PF[(size_t)row * EIN + hs * 64 + d] : bf2f((unsigned)QKV[(size_t)row * EIN + hs * 64 + d]);
#pragma unroll
        for (int hs = 0; hs < 36; ++hs) {
            float v = vv[hs];
            const bool isq = hs < 8 || (hs >= 24 && hs < 32);
            const bool isk = (hs >= 8 && hs < 16) || hs == 32 || hs == 33;
            const bool nrm = hs >= 24 && hs < 34;
            if (nrm) { const float ss = wave_sum(v * v); v = v * rsqrtf(ss * (1.f / 64.f) + RMS_EPS) * (hs < 32 ? qg : kg); }
            if ((isq || isk) && lat) { const float pr = __shfl_xor(v, 16); v = first ? v * cs.x - pr * cs.y : v * cs.x + pr * cs.y; }
            if (isq) v *= C2;
            QKV[(size_t)row * EIN + hs * 64 + d] = (bf16)f2bf(v);
        }
    }
}

__device__ __forceinline__ void ph_attn0_naive(const Params& p, const Ctx& c) {
    const bf16* QKV = (const bf16*)(p.ws + WS_QKV);
    bf16* CC = (bf16*)(p.ws + WS_CC);
    bf16* AO = (bf16*)(p.ws + WS_AO);
    LAS float* Ks = (LAS float*)c.lds;
    LAS float* Vs = Ks + 4096;
    for (int u = c.vcu; u < 960; u += c.G) {
        const bool isctx = u >= 768;
        int b, vh, qrow, ntiles; bool active = true;
        if (!isctx) { b = u / 96; const int r = u % 96; vh = r >> 2; qrow = b * SEQ + (r & 3) * 512 + c.tid; ntiles = 36; }
        else { const int uu = u - 768; b = uu / 24; vh = uu % 24; qrow = LAT + b * NCTX + (c.tid & 255); active = c.tid < 256; ntiles = 4; }
        int qcol, kcol, vcol;
        if (vh < 16) { const int a = vh >> 2, s = (vh >> 1) & 1, half = vh & 1; qcol = a * 128 + s * 64; kcol = 512 + a * 128 + s * 64; vcol = 1024 + a * 128 + half * 64; }
        else { const int h = vh - 16; qcol = 1536 + h * 64; kcol = 2048 + (h >> 2) * 64; vcol = 2176 + (h >> 2) * 64; }
        float q[64], o[64];
#pragma unroll
        for (int i = 0; i < 8; ++i) { const v4u w = *(const v4u*)(QKV + (size_t)qrow * EIN + qcol + 8 * i); unpack8(w, q + 8 * i); }
#pragma unroll
        for (int i = 0; i < 64; ++i) o[i] = 0.f;
        float m = -1e30f, l = 0.f;
        for (int t = 0; t < ntiles; ++t) {
            const int krow0 = isctx ? LAT + b * NCTX + 64 * t : (t < 32 ? b * SEQ + 64 * t : LAT + b * NCTX + 64 * (t - 32));
            __syncthreads();
            { const int r = c.tid >> 3, ch = c.tid & 7; float f[8];
              const v4u kw = *(const v4u*)(QKV + (size_t)(krow0 + r) * EIN + kcol + ch * 8); unpack8(kw, f);
#pragma unroll
              for (int j = 0; j < 8; ++j) Ks[r * 64 + ch * 8 + j] = f[j];
              const v4u vw = *(const v4u*)(QKV + (size_t)(krow0 + r) * EIN + vcol + ch * 8); unpack8(vw, f);
#pragma unroll
              for (int j = 0; j < 8; ++j) Vs[r * 64 + ch * 8 + j] = f[j]; }
            __syncthreads();
            if (active) {
                for (int kk = 0; kk < 64; ++kk) {
                    float s = 0.f;
#pragma unroll
                    for (int dd = 0; dd < 64; ++dd) s += q[dd] * Ks[kk * 64 + dd];
                    const float mn = fmaxf(m, s), al = exp2f(m - mn), pp = exp2f(s - mn);
                    l = l * al + pp; m = mn;
#pragma unroll
                    for (int dd = 0; dd < 64; ++dd) o[dd] = o[dd] * al + pp * Vs[kk * 64 + dd];
                }
            }
        }
        if (active) {
            const float rl = 1.f / l;
            bf16* dst = vh < 16 ? AO + (size_t)qrow * DM + (vh >> 2) * 256 + ((vh >> 1) & 1) * 128 + (vh & 1) * 64 : CC + (size_t)qrow * DM + 512 + (vh - 16) * 64;
            {
#pragma unroll
                for (int i = 0; i < 8; ++i) *(v4u*)(dst + 8 * i) = (v4u){pk2(o[8 * i] * rl, o[8 * i + 1] * rl), pk2(o[8 * i + 2] * rl, o[8 * i + 3] * rl), pk2(o[8 * i + 4] * rl, o[8 * i + 5] * rl), pk2(o[8 * i + 6] * rl, o[8 * i + 7] * rl)}; }
        }
    }
}


__device__ __forceinline__ void ph_attn0_fast(const Params& p, const Ctx& c, char* lds_generic) {
    typedef attn_body::bf16 abf;
    const abf* Q = (const abf*)(p.ws + WS_QKV); abf* CCb = (abf*)(p.ws + WS_CC); abf* AOb = (abf*)(p.ws + WS_AO);
    for (int i = 0;; ++i) {
        const int U = i * c.G + c.vcu;
        if (U >= 1536 + 192) break;
        attn_body::AU u; int vh;
        if (U < 1536) { const int b = U / 192, rem = U - b * 192; vh = rem >> 3; u.qrow0 = b * SEQ + (rem & 7) * 256; u.lat_row0 = b * SEQ; u.ctx_row0 = LAT + b * NCTX; u.nlat_t = 32; u.NT = 36; }
        else { const int uu = U - 1536, b = uu / 24; vh = uu - b * 24; u.qrow0 = LAT + b * NCTX; u.lat_row0 = 0; u.ctx_row0 = LAT + b * NCTX; u.nlat_t = 0; u.NT = 4; }
        int qcol, kcol, vcol; abf* op;
        if (vh < 16) { const int a = vh >> 2, s = (vh >> 1) & 1, half = vh & 1; qcol = a * 128 + s * 64; kcol = 512 + a * 128 + s * 64; vcol = 1024 + a * 128 + half * 64; op = AOb + a * 256 + s * 128 + half * 64; }
        else { const int h = vh - 16; qcol = 1536 + h * 64; kcol = 2048 + (h >> 2) * 64; vcol = 2176 + (h >> 2) * 64; op = CCb + 512 + h * 64; }
        u.Qp = Q + qcol; u.Kp = Q + kcol; u.Vp = Q + vcol; u.Op = op;
        attn_body::attn_unit<8, EIN, attn_body::NoMask>(u, lds_generic, attn_body::NoMask{});
    }
}

__device__ __forceinline__ void ph_attn_combine(const Params& p, const Ctx& c) {
    const bf16* AO = (const bf16*)(p.ws + WS_AO);
    bf16* CC = (bf16*)(p.ws + WS_CC);
    const float d1 = wave_sum(p.in[I_LQ1][c.lane] * p.in[I_LK1][c.lane]);
    const float d2 = wave_sum(p.in[I_LQ2][c.lane] * p.in[I_LK2][c.lane]);
    const float lam = expf(d1) - expf(d2) + LAM_INIT;
    const float g0 = p.in[I_SUBLN][c.lane] * (1.f - LAM_INIT), g1 = p.in[I_SUBLN][c.lane + 64] * (1.f - LAM_INIT);
    for (int it = c.gw; it < NTOK * 4; it += c.NGW) {
        const int row = it >> 2, a = it & 3;
        const bf16* src = AO + (size_t)row * DM + a * 256;
        const float x0 = bf2f((unsigned)src[c.lane]) - lam * bf2f((unsigned)src[128 + c.lane]), x1 = bf2f((unsigned)src[64 + c.lane]) - lam * bf2f((unsigned)src[192 + c.lane]);
        const float ss = wave_sum(x0 * x0 + x1 * x1);
        const float r = rsqrtf(ss * (1.f / 128.f) + RMS_EPS);
        CC[(size_t)row * DM + a * 128 + c.lane] = (bf16)f2bf(x0 * r * g0);
        CC[(size_t)row * DM + a * 128 + 64 + c.lane] = (bf16)f2bf(x1 * r * g1);
    }
}

__device__ __forceinline__ void ph_ln1_router(const Params& p, const Ctx& c, int layer) {
    const float* Y = (const float*)(p.ws + WS_Y);
    float* XS = (float*)(p.ws + WS_XS);
    bf16* HB = (bf16*)(p.ws + WS_HB);
    float* AFF = (float*)(p.ws + WS_AFF);
    const float* lng = p.in[I_LNG] + (size_t)(layer * 2 + 0) * DM; const float* lnb = p.in[I_LNB] + (size_t)(layer * 2 + 0) * DM;
    const float* router = p.in[I_ROUTER] + (size_t)layer * DM * NE;
    LAS f32x4* R = (LAS f32x4*)c.lds;
    for (int idx = c.tid; idx < 4096; idx += 512) { const int e4 = idx & 3, k = idx >> 2, ln = (k & 255) >> 2, q = k & 3, j = k >> 8;
        R[((j * 4 + q) * 4 + e4) * 64 + ln] = *(const f32x4*)(router + (size_t)k * NE + 4 * e4); }
    __syncthreads();
    const int nrows = layer == 0 ? NTOK : LAT;
    const int lane = c.lane;
    for (int row = c.gw; row < nrows; row += c.NGW) {
        const float* xin = layer == 0 ? (row < LAT ? p.in[I_X] + (size_t)row * DM : p.in[I_CTX] + (size_t)(row - LAT) * DM) : XS + (size_t)row * DM;
        const float* mod = mod_row(p, layer, row);
        f32x4 v[4]; float s = 0.f;
#pragma unroll
        for (int j = 0; j < 4; ++j) { const int col = 4 * lane + 256 * j;
            v[j] = *(const f32x4*)(xin + col) * ALPHA + *(const f32x4*)(mod + 2048 + col) * *(const f32x4*)(Y + (size_t)row * DM + col);
            s += (v[j].x + v[j].y) + (v[j].z + v[j].w); }
        const float mean = wave_sum(s) * (1.f / DM); float s2 = 0.f;
#pragma unroll
        for (int j = 0; j < 4; ++j) { v[j] = v[j] - mean; s2 += (v[j].x * v[j].x + v[j].y * v[j].y) + (v[j].z * v[j].z + v[j].w * v[j].w); }
        const float rstd = 1.f / sqrtf(wave_sum(s2) * (1.f / DM) + LN_EPS);
        f32x4 lg[4];
#pragma unroll
        for (int e = 0; e < 4; ++e) lg[e] = (f32x4){0.f, 0.f, 0.f, 0.f};
#pragma unroll
        for (int j = 0; j < 4; ++j) { const int col = 4 * lane + 256 * j;
            const f32x4 x1 = v[j] * rstd * *(const f32x4*)(lng + col) + *(const f32x4*)(lnb + col);
            *(f32x4*)(XS + (size_t)row * DM + col) = x1;
            const f32x4 hm = x1 * (*(const f32x4*)(mod + 4096 + col) + 1.f) + *(const f32x4*)(mod + 3072 + col);
            if (MOE_FP8) *(unsigned*)((unsigned char*)HB + (size_t)row * DM + col) = pg8::pk4_fp8(hm.x, hm.y, hm.z, hm.w);
            else *(v2u*)(HB + (size_t)row * DM + col) = (v2u){pk2(hm.x, hm.y), pk2(hm.z, hm.w)};
            asm volatile("" ::: "memory");
#pragma unroll
            for (int q = 0; q < 4; ++q) { const float hv = hm[q];
#pragma unroll
                for (int e4 = 0; e4 < 4; ++e4) lg[e4] += R[((j * 4 + q) * 4 + e4) * 64 + lane] * hv; } }
        float w8[8], w4[4], w2[2], w1;
        { const bool hi = (lane & 32) != 0;
#pragma unroll
          for (int i = 0; i < 8; ++i) { const float a0 = lg[i >> 2][i & 3], a1 = lg[2 + (i >> 2)][i & 3]; const float keep = hi ? a1 : a0, send = hi ? a0 : a1; w8[i] = keep + __shfl_xor(send, 32); } }
        { const bool hi = (lane & 16) != 0;
#pragma unroll
          for (int i = 0; i < 4; ++i) { const float keep = hi ? w8[i + 4] : w8[i], send = hi ? w8[i] : w8[i + 4]; w4[i] = keep + __shfl_xor(send, 16); } }
        { const bool hi = (lane & 8) != 0;
#pragma unroll
          for (int i = 0; i < 2; ++i) { const float keep = hi ? w4[i + 2] : w4[i], send = hi ? w4[i] : w4[i + 2]; w2[i] = keep + __shfl_xor(send, 8); } }
        { const bool hi = (lane & 4) != 0; const float keep = hi ? w2[1] : w2[0], send = hi ? w2[0] : w2[1]; w1 = keep + __shfl_xor(send, 4); }
        w1 += __shfl_xor(w1, 2); w1 += __shfl_xor(w1, 1);
        float mx = w1;
#pragma unroll
        for (int o = 4; o < 64; o <<= 1) mx = fmaxf(mx, __shfl_xor(mx, o));
        const float ex = expf(w1 - mx); float den = ex;
#pragma unroll
        for (int o = 4; o < 64; o <<= 1) den += __shfl_xor(den, o);
        if ((lane & 3) == 0) { const int e = ((lane >> 5) & 1) * 8 + ((lane >> 4) & 1) * 4 + ((lane >> 3) & 1) * 2 + ((lane >> 2) & 1); AFF[(size_t)row * NE + e] = ex / den; }
    }
}

__device__ __forceinline__ void ph_topk(const Params& p, const Ctx& c, int layer) {
    const float* AFF = (const float*)(p.ws + WS_AFF);
    int* INV = (int*)(p.ws + WS_INV);
    float* GATE = (float*)(p.ws + WS_GATE);
    const bf16* HB = (const bf16*)(p.ws + WS_HB);
    bf16* XG = (bf16*)(p.ws + WS_XG);
    LAS unsigned* hist = (LAS unsigned*)c.lds;
    LAS unsigned* ctl = hist + 256;
    LAS int* sel = (LAS int*)(c.lds + 2048);
    const int MR = layer == 0 ? MR0 : MR1;
    const int ntasks = layer == 0 ? 256 : 128;
    const int lane = c.lane;
    for (int task = c.vcu; task < ntasks; task += c.G) {
        int set, e, n, cap, rowbase, slotbase;
        if (task < 128) { set = task >> 4; e = task & 15; n = SEQ; cap = 256; rowbase = set * SEQ; slotbase = set * 256; }
        else { const int t2 = task - 128; set = t2 >> 4; e = t2 & 15; n = NCTX; cap = 32; rowbase = LAT + set * NCTX; slotbase = 2048 + set * 32; }
        const bool valid = 4 * c.tid < n;
        unsigned key[4];
#pragma unroll
        for (int q = 0; q < 4; ++q) key[q] = valid ? __float_as_uint(AFF[(size_t)(rowbase + 4 * c.tid + q) * NE + e]) : 0u;
        unsigned prefix = 0u, need = (unsigned)cap;
#pragma unroll 1
        for (int pass = 0; pass < 4; ++pass) {
            const int shift = 24 - 8 * pass;
            if (c.tid < 256) hist[c.tid] = 0u;
            __syncthreads();
            if (valid) {
#pragma unroll
                for (int q = 0; q < 4; ++q) if (pass == 0 || (key[q] >> (shift + 8)) == (prefix >> (shift + 8))) __hip_atomic_fetch_add(&hist[(key[q] >> shift) & 255u], 1u, __ATOMIC_RELAXED, __HIP_MEMORY_SCOPE_WORKGROUP);
            }
            __syncthreads();
            if (c.wave == 0) {
                const unsigned h0 = hist[4 * lane], h1 = hist[4 * lane + 1], h2 = hist[4 * lane + 2], h3 = hist[4 * lane + 3];
                const unsigned tot = h0 + h1 + h2 + h3; unsigned sfx = tot;
#pragma unroll
                for (int o = 1; o < 64; o <<= 1) { const unsigned t = __shfl_down(sfx, o); if (lane + o < 64) sfx += t; }
                const unsigned above = sfx - tot, c3 = above + h3, c2 = c3 + h2, c1 = c2 + h1, c0 = c1 + h0;
                int d = -1; unsigned gtc = 0u;
                if (above < need && need <= c3) { d = 3; gtc = above; }
                else if (c3 < need && need <= c2) { d = 2; gtc = c3; }
                else if (c2 < need && need <= c1) { d = 1; gtc = c2; }
                else if (c1 < need && need <= c0) { d = 0; gtc = c1; }
                if (d >= 0) { ctl[0] = prefix | ((unsigned)(4 * lane + d) << shift); ctl[1] = need - gtc; }
            }
            __syncthreads();
            prefix = ctl[0]; need = ctl[1];
        }
        unsigned ngt = 0u, neq = 0u;
#pragma unroll
        for (int q = 0; q < 4; ++q) { ngt += (valid && key[q] > prefix) ? 1u : 0u; neq += (valid && key[q] == prefix) ? 1u : 0u; }
        const unsigned cnt = ngt | (neq << 16); unsigned inc = cnt;
#pragma unroll
        for (int o = 1; o < 64; o <<= 1) { const unsigned t = __shfl_up(inc, o); if (lane >= o) inc += t; }
        if (lane == 63) ctl[8 + c.wave] = inc;
        __syncthreads();
        unsigned base = 0u;
#pragma unroll
        for (int w = 0; w < 8; ++w) base += (w < c.wave) ? ctl[8 + w] : 0u;
        const unsigned ex = base + inc - cnt; unsigned gtb = ex & 0xffffu, eqb = ex >> 16;
        if (valid) {
#pragma unroll
            for (int q = 0; q < 4; ++q) { const int i = 4 * c.tid + q; int slot = -1;
                if (key[q] > prefix) { slot = (int)(gtb + (eqb < need ? eqb : need)); ++gtb; }
                else if (key[q] == prefix) { if (eqb < need) slot = (int)(gtb + eqb); ++eqb; }
                int gs = -1;
                if (slot >= 0) { gs = e * MR + slotbase + slot; sel[slot] = i; GATE[gs] = __uint_as_float(key[q]); }
                INV[(size_t)(rowbase + i) * NE + e] = gs; }
        }
        __syncthreads();
        for (int sidx = c.wave; sidx < cap; sidx += 8) {
            if (MOE_FP8) { const unsigned char* src = (const unsigned char*)HB + (size_t)(rowbase + sel[sidx]) * DM; unsigned char* dst = (unsigned char*)XG + (size_t)(e * MR + slotbase + sidx) * DM;
                *(v4u*)(dst + 16 * lane) = *(const v4u*)(src + 16 * lane); }
            else { const bf16* src = HB + (size_t)(rowbase + sel[sidx]) * DM; bf16* dst = XG + (size_t)(e * MR + slotbase + sidx) * DM;
            const v4u a0 = *(const v4u*)(src + 8 * lane), a1 = *(const v4u*)(src + 512 + 8 * lane);
            *(v4u*)(dst + 8 * lane) = a0; *(v4u*)(dst + 512 + 8 * lane) = a1; }
        }
        __syncthreads();
    }
}

__device__ __forceinline__ void ph_combine(const Params& p, const Ctx& c, int layer) {
    const bf16* YS = (const bf16*)(p.ws + WS_YS);
    const int* INV = (const int*)(p.ws + WS_INV);
    float* XS = (float*)(p.ws + WS_XS);
    bf16* HB = (bf16*)(p.ws + WS_HB);
    const float* lng = p.in[I_LNG] + (size_t)(layer * 2 + 1) * DM; const float* lnb = p.in[I_LNB] + (size_t)(layer * 2 + 1) * DM;
    const int nrows = layer == 0 ? NTOK : LAT;
    for (int row = c.gw; row < nrows; row += c.NGW) {
        const float* mod = mod_row(p, layer, row);
        f32x4 mo[4];
#pragma unroll
        for (int j = 0; j < 4; ++j) mo[j] = (f32x4){0.f, 0.f, 0.f, 0.f};
        const int inv = (c.lane < NE) ? INV[(size_t)row * NE + c.lane] : -1;
        unsigned long long msk = __ballot(inv >= 0);
        while (msk) {
            const int e = __builtin_ctzll(msk); msk &= msk - 1;
            const int sl = __builtin_amdgcn_readlane(inv, e);
#pragma unroll
            for (int j = 0; j < 4; ++j) { const v2u w = *(const v2u*)(YS + (size_t)sl * DM + 4 * c.lane + 256 * j);
                mo[j].x += bf2f(w.x & 0xffffu); mo[j].y += __uint_as_float(w.x & 0xffff0000u); mo[j].z += bf2f(w.y & 0xffffu); mo[j].w += __uint_as_float(w.y & 0xffff0000u); }
        }
        f32x4 v[4]; float s = 0.f;
#pragma unroll
        for (int j = 0; j < 4; ++j) { const int col = 4 * c.lane + 256 * j;
            v[j] = *(const f32x4*)(XS + (size_t)row * DM + col) * ALPHA + *(const f32x4*)(mod + 5120 + col) * mo[j];
            s += (v[j].x + v[j].y) + (v[j].z + v[j].w); }
        const float mean = wave_sum(s) * (1.f / DM); float s2 = 0.f;
#pragma unroll
        for (int j = 0; j < 4; ++j) { v[j] = v[j] - mean; s2 += (v[j].x * v[j].x + v[j].y * v[j].y) + (v[j].z * v[j].z + v[j].w * v[j].w); }
        const float rstd = 1.f / sqrtf(wave_sum(s2) * (1.f / DM) + LN_EPS);
        const float* modn = mod_row(p, 1, row);
#pragma unroll
        for (int j = 0; j < 4; ++j) { const int col = 4 * c.lane + 256 * j;
            const f32x4 x2 = v[j] * rstd * *(const f32x4*)(lng + col) + *(const f32x4*)(lnb + col);
            if (layer == 0) {
                *(f32x4*)(XS + (size_t)row * DM + col) = x2;
                const f32x4 h = x2 * (*(const f32x4*)(modn + 1024 + col) + 1.f) + *(const f32x4*)(modn + col);
                *(v2u*)(HB + (size_t)row * DM + col) = (v2u){pk2(h.x, h.y), pk2(h.z, h.w)};
            } else {
                *(f32x4*)(p.out + (size_t)row * DM + col) = x2;
            } }
    }
}

__device__ __forceinline__ void na_key(const float* q, float* o, float& m, float& l, const bf16* kp, const bf16* vp, float bias) {
    float s = bias;
#pragma unroll
    for (int i = 0; i < 8; ++i) { float f[8]; unpack8(*(const v4u*)(kp + 8 * i), f);
#pragma unroll
        for (int j = 0; j < 8; ++j) s += q[8 * i + j] * f[j]; }
    const float mn = fmaxf(m, s), al = exp2f(m - mn), pp = exp2f(s - mn);
    l = l * al + pp; m = mn;
#pragma unroll
    for (int i = 0; i < 8; ++i) { float f[8]; unpack8(*(const v4u*)(vp + 8 * i), f);
#pragma unroll
        for (int j = 0; j < 8; ++j) o[8 * i + j] = o[8 * i + j] * al + pp * f[j]; }
}
__device__ __forceinline__ void ph_mixer1_naive(const Params& p, const Ctx& c) {
    const bf16* P2 = (const bf16*)(p.ws + WS_QKV);
    bf16* CC = (bf16*)(p.ws + WS_CC);
    const float* rpb = p.in[I_RPB]; const float* pool_w = p.in[I_POOLW]; const float* pool_s = p.in[I_POOLS];
    LAS float* pl = (LAS float*)c.lds;
    for (int u = c.vcu; u < 256; u += c.G) {
        const int b = u >> 5, r = u & 31;
        {
            const int h = c.wave, col = c.lane, row = b * SEQ + r * 64 + col;
            const int rs = min(max(r - 4, 0), 24), cs = min(max(col - 8, 0), 48);
            float q[64], o[64];
#pragma unroll
            for (int i = 0; i < 8; ++i) unpack8(*(const v4u*)(P2 + (size_t)row * OIN + h * 64 + 8 * i), q + 8 * i);
#pragma unroll
            for (int i = 0; i < 64; ++i) o[i] = 0.f;
            float m = -1e30f, l = 0.f;
#pragma unroll 1
            for (int i = 0; i < 8; ++i)
#pragma unroll 1
                for (int j = 0; j < 16; ++j) {
                    const int krow = b * SEQ + (rs + i) * 64 + cs + j;
                    const float bias = rpb[(h * 15 + (rs + i - r + 7)) * 31 + (cs + j - col + 15)] * LOG2E;
                    na_key(q, o, m, l, P2 + (size_t)krow * OIN + 512 + h * 64, P2 + (size_t)krow * OIN + 1024 + h * 64, bias);
                }
#pragma unroll 1
            for (int j = 0; j < NCTX; ++j) {
                const int krow = LAT + b * NCTX + j;
                na_key(q, o, m, l, P2 + (size_t)krow * OIN + 512 + h * 64, P2 + (size_t)krow * OIN + 1024 + h * 64, 0.f);
            }
            const float rl = 1.f / l; bf16* dst = CC + (size_t)row * DM + h * 64;
#pragma unroll
            for (int i = 0; i < 8; ++i) *(v4u*)(dst + 8 * i) = (v4u){pk2(o[8 * i] * rl, o[8 * i + 1] * rl), pk2(o[8 * i + 2] * rl, o[8 * i + 3] * rl), pk2(o[8 * i + 4] * rl, o[8 * i + 5] * rl), pk2(o[8 * i + 6] * rl, o[8 * i + 7] * rl)};
        }
        __syncthreads();
        {
            const int ch = c.tid, g = ch >> 7, half = 1 << g;
            for (int tt = 0; tt < 64; ++tt) {
                const int t = r * 64 + tt, lo = max(t - half, 0), hi = min(t + half, SEQ);
                float s = 0.f;
                for (int t2 = lo; t2 < hi; ++t2) s += bf2f((unsigned)P2[(size_t)(b * SEQ + t2) * OIN + 1536 + ch]);
                pl[tt * 512 + ch] = s / (float)(hi - lo) - bf2f((unsigned)P2[(size_t)(b * SEQ + t) * OIN + 1536 + ch]);
            }
        }
        __syncthreads();
        {
            const int g = c.tid >> 7, e = c.tid & 127;
            const float ps = pool_s[g * 128 + e];
#pragma unroll 1
            for (int tb = 0; tb < 64; tb += 16) {
                float acc[16];
#pragma unroll
                for (int i = 0; i < 16; ++i) acc[i] = 0.f;
#pragma unroll 4
                for (int cc = 0; cc < 128; ++cc) {
                    const float w = pool_w[(size_t)(g * 128 + cc) * 128 + e];
#pragma unroll
                    for (int i = 0; i < 16; ++i) acc[i] += pl[(tb + i) * 512 + g * 128 + cc] * w;
                }
#pragma unroll
                for (int i = 0; i < 16; ++i) CC[(size_t)(b * SEQ + r * 64 + tb + i) * DM + 512 + g * 128 + e] = (bf16)f2bf(acc[i] * ps);
            }
        }
        __syncthreads();
    }
}


constexpr int NA_TAB_OFF = 86016 + 1024;
__device__ __forceinline__ void ph_mixer1_fast(const Params& p, const Ctx& c, char* lds_generic) {
    typedef attn_body::bf16 abf;
    const abf* P2a = (const abf*)(p.ws + WS_QKV); abf* CCa = (abf*)(p.ws + WS_CC);
    LAS float* tab = (LAS float*)(c.lds + NA_TAB_OFF);
    for (int i = c.tid; i < 8 * 15 * 32; i += 512) { const int hd = i >> 5, j = i & 31; tab[i] = j < 31 ? p.in[I_RPB][hd * 31 + j] * LOG2E : 0.f; }
    __syncthreads();
    for (int it = 0;; ++it) {
        const int U = it * c.G + c.vcu;
        if (U >= 512) break;
        const int b = U >> 6, h = (U >> 3) & 7, rq = U & 7;
        const int rs_min = min(max(4 * rq - 4, 0), 24);
        const int nloc = (rq == 0 || rq == 7) ? 8 : 12;
        attn_body::AU u;
        u.qrow0 = b * SEQ + rq * 256; u.lat_row0 = LAT + b * NCTX; u.nlat_t = 4; u.ctx_row0 = b * SEQ + rs_min * 64; u.NT = 4 + nloc;
        u.Qp = P2a + h * 64; u.Kp = P2a + 512 + h * 64; u.Vp = P2a + 1024 + h * 64; u.Op = CCa + h * 64;
        const int r = 4 * rq + (c.wave >> 1), col = (c.wave & 1) * 32 + (c.lane & 31), hi = c.lane >> 5;
        const int cs = min(max(col - 8, 0), 48);
        attn_body::NAMask mk; mk.tb0 = (attn_body::lds_cfptr)(tab + h * 15 * 32 + 15 - col); mk.r = r; mk.rs = min(max(r - 4, 0), 24); mk.rs_min = rs_min; mk.cb = 4 * hi - cs;
        attn_body::attn_unit<8, OIN, attn_body::NAMask>(u, lds_generic, mk);
    }
    __syncthreads();
    const bf16* P2 = (const bf16*)(p.ws + WS_QKV); bf16* CC = (bf16*)(p.ws + WS_CC);
    const float* pool_w = p.in[I_POOLW]; const float* pool_s = p.in[I_POOLS];
    LAS float* pl = (LAS float*)c.lds;
    for (int u = c.vcu; u < 256; u += c.G) {
        const int b = u >> 5, r = u & 31;
        {
            const int ch = c.tid, g = ch >> 7, half = 1 << g;
            const bf16* du = P2 + (size_t)b * SEQ * OIN + 1536 + ch;
            const int t0 = r * 64;
            float ws = 0.f;
            { float iv[16];
#pragma unroll
              for (int k = 0; k < 16; ++k) { const int t2 = t0 - half + k; const float w = (k < 2 * half && t2 >= 0 && t2 < SEQ) ? 1.f : 0.f; iv[k] = w * bf2f((unsigned)du[(size_t)min(max(t2, 0), SEQ - 1) * OIN]); }
#pragma unroll
              for (int k = 0; k < 16; ++k) ws += iv[k]; }
#pragma unroll 1
            for (int tb = 0; tb < 64; tb += 8) {
                float cur[8], add[8], sub[8];
#pragma unroll
                for (int k = 0; k < 8; ++k) { const int t = t0 + tb + k;
                    cur[k] = bf2f((unsigned)du[(size_t)t * OIN]);
                    add[k] = ((t + half < SEQ) ? 1.f : 0.f) * bf2f((unsigned)du[(size_t)min(t + half, SEQ - 1) * OIN]);
                    sub[k] = ((t - half >= 0) ? 1.f : 0.f) * bf2f((unsigned)du[(size_t)max(t - half, 0) * OIN]); }
#pragma unroll
                for (int k = 0; k < 8; ++k) { const int t = t0 + tb + k, lo = max(t - half, 0), hi = min(t + half, SEQ);
                    pl[(tb + k) * 512 + ch] = ws / (float)(hi - lo) - cur[k];
                    ws += add[k] - sub[k]; }
            }
        }
        __syncthreads();
        {
            const int g = c.tid >> 7, e = c.tid & 127;
            const float ps = pool_s[g * 128 + e];
#pragma unroll 1
            for (int tb = 0; tb < 64; tb += 16) {
                float acc[16];
#pragma unroll
                for (int i = 0; i < 16; ++i) acc[i] = 0.f;
#pragma unroll 2
                for (int cc = 0; cc < 128; cc += 4) {
                    const float w0 = pool_w[(size_t)(g * 128 + cc) * 128 + e], w1 = pool_w[(size_t)(g * 128 + cc + 1) * 128 + e], w2 = pool_w[(size_t)(g * 128 + cc + 2) * 128 + e], w3 = pool_w[(size_t)(g * 128 + cc + 3) * 128 + e];
#pragma unroll
                    for (int i = 0; i < 16; ++i) { const f32x4 pv = *(const LAS f32x4*)(pl + (tb + i) * 512 + g * 128 + cc); acc[i] += pv.x * w0 + pv.y * w1 + pv.z * w2 + pv.w * w3; }
                }
#pragma unroll
                for (int i = 0; i < 16; ++i) CC[(size_t)(b * SEQ + r * 64 + tb + i) * DM + 512 + g * 128 + e] = (bf16)f2bf(acc[i] * ps);
            }
        }
        __syncthreads();
    }
}

__global__ void __launch_bounds__(512, 2) mk_fwd(Params p) {
    extern __shared__ __attribute__((aligned(16))) unsigned char lds_raw[];
    Ctx c;
    c.lds = (LAS unsigned char*)lds_raw;
    c.tid = threadIdx.x; c.lane = c.tid & 63; c.wave = __builtin_amdgcn_readfirstlane(c.tid >> 6);
    c.G = gridDim.x; { const int bx = blockIdx.x; c.vcu = (c.G % 8 == 0) ? (bx % 8) * (c.G / 8) + bx / 8 : bx; }
    c.gw = c.vcu * 8 + c.wave; c.NGW = c.G * 8;
    volatile LAS unsigned* MISC = (volatile LAS unsigned*)(c.lds + MISC_OFF);
    if (c.tid < 32) MISC[c.tid] = 0u;
    __syncthreads();
    gu32* ctl = (gu32*)(p.ws + WS_CTL);
    XcdBarrier bar; bar.bar = (unsigned*)(ctl + CW_BAR); bar.x = 0; bar.st = nullptr;
    if (!MK_MULTI) bar = xcd_barrier_post((unsigned*)(ctl + CW_BAR), MISC + 8);
    const int lo = p.ph_lo, hi = p.ph_hi;
    unsigned long long pt0 = 0, pt1 = 0; if (PROBE_PH == 0) pt0 = __builtin_amdgcn_s_memrealtime();
#define IN(k) (lo <= (k) && (k) < hi)
#define SEAM(k) do { if (IN(k) && IN((k) + 1)) xcd_barrier(bar); if ((k) + 1 == PROBE_PH) pt0 = __builtin_amdgcn_s_memrealtime(); if ((k) == PROBE_PH) pt1 = __builtin_amdgcn_s_memrealtime(); } while (0)

    bf16* HB = (bf16*)(p.ws + WS_HB); bf16* QKV = (bf16*)(p.ws + WS_QKV); bf16* CC = (bf16*)(p.ws + WS_CC);
    float* Y = (float*)(p.ws + WS_Y); float* PF = (float*)(p.ws + WS_PF);
    bf16* XG = (bf16*)(p.ws + WS_XG); bf16* HID = (bf16*)(p.ws + WS_HID); bf16* YS = (bf16*)(p.ws + WS_YS);
    const float* GATE = (const float*)(p.ws + WS_GATE);

    if (IN(0)) for (int rep_ = 0; rep_ < 1 + (int)((PROBE_MASK >> 0) & 1u); ++rep_) { if (rep_) __syncthreads(); ph_prologue(p, c); if (FAST_GEMM) { __syncthreads(); ph_transposes(p, c); } } SEAM(0);
    if (IN(1)) for (int rep_ = 0; rep_ < 1 + (int)((PROBE_MASK >> 1) & 1u); ++rep_) { if (rep_) __syncthreads(); ph_modulate0(p, c); } SEAM(1);
    if (IN(2)) for (int rep_ = 0; rep_ < 1 + (int)((PROBE_MASK >> 2) & 1u); ++rep_) { if (rep_) __syncthreads();
        if (FAST_GEMM) { pg8::Gemm g{HB, (const bf16*)(p.ws + WS_W0IN), NTOK, EIN, DM, 0}; pg8::StaticOrder S; S.init(NTOK, EIN, c.G, (int)blockIdx.x);
            pg8::EpiBf16<0> E{QKV, EIN, nullptr, 0, 0, 1.f}; pg8::gemm_phase<pg8::EpiBf16<0>, pg8::StaticOrder, true, true>(c.lds, g, S, E); }
        else { NG g{HB, DM, p.in[I_W0IN], nullptr, EIN, 0, 1 << 30, 0, NTOK, 0, EIN, DM}; ngemm<1>(g, c, EpiF32{PF, EIN}); }
    } SEAM(2);
    if (IN(3)) for (int rep_ = 0; rep_ < 1 + (int)((PROBE_MASK >> 3) & 1u); ++rep_) { if (rep_) __syncthreads(); if (FAST_GEMM) ph_qkv_post<false>(p, c); else ph_qkv_post<true>(p, c); } SEAM(3);
    if (IN(4)) for (int rep_ = 0; rep_ < 1 + (int)((PROBE_MASK >> 4) & 1u); ++rep_) { if (rep_) __syncthreads(); if (FAST_ATTN) ph_attn0_fast(p, c, (char*)lds_raw); else ph_attn0_naive(p, c); } SEAM(4);
    if (IN(5)) for (int rep_ = 0; rep_ < 1 + (int)((PROBE_MASK >> 5) & 1u); ++rep_) { if (rep_) __syncthreads(); ph_attn_combine(p, c); } SEAM(5);
    if (IN(6)) for (int rep_ = 0; rep_ < 1 + (int)((PROBE_MASK >> 6) & 1u); ++rep_) { if (rep_) __syncthreads();
        if (FAST_GEMM) { pg8::Gemm g{CC, (const bf16*)(p.ws + WS_W0OUT), NTOK, DM, DM, 0}; pg8::StaticOrder S; S.init(NTOK, DM, c.G, (int)blockIdx.x);
            pg8::EpiF32P E{Y, DM}; pg8::gemm_phase<pg8::EpiF32P, pg8::StaticOrder, true, true>(c.lds, g, S, E); }
        else { NG g{CC, DM, p.in[I_W0OUT], nullptr, DM, 0, 1 << 30, 0, NTOK, 0, DM, DM}; ngemm<1>(g, c, EpiF32{Y, DM}); }
    } SEAM(6);
    if (IN(7)) for (int rep_ = 0; rep_ < 1 + (int)((PROBE_MASK >> 7) & 1u); ++rep_) { if (rep_) __syncthreads(); ph_ln1_router(p, c, 0); } SEAM(7);
    if (IN(8)) for (int rep_ = 0; rep_ < 1 + (int)((PROBE_MASK >> 8) & 1u); ++rep_) { if (rep_) __syncthreads(); ph_topk(p, c, 0); } SEAM(8);
    if (IN(9)) for (int rep_ = 0; rep_ < 1 + (int)((PROBE_MASK >> 9) & 1u); ++rep_) { if (rep_) __syncthreads();
        if (FAST_GEMM && MOE_FP8) { pg8::Gemm g{XG, (const bf16*)(p.ws + WS_WGU), NE * MR0, 4096, DM / 2, (size_t)4096 * DM}; pg8::GroupedOrder S; S.init(MR0 / 256, 16, NE, c.G, c.vcu);
            pg8::EpiSwigluF8 E{(unsigned char*)HID, FF, 1.f / W8_GU, H8_SC}; pg8::gemm_phase<pg8::EpiSwigluF8, pg8::GroupedOrder, true, true, true>(c.lds, g, S, E); }
        else if (FAST_GEMM) { pg8::Gemm g{XG, (const bf16*)(p.ws + WS_WGU), NE * MR0, 4096, DM, (size_t)4096 * DM * 2}; pg8::GroupedOrder S; S.init(MR0 / 256, 16, NE, c.G, c.vcu);
            pg8::EpiSwigluP E{HID, FF}; pg8::gemm_phase<pg8::EpiSwigluP, pg8::GroupedOrder, true, true>(c.lds, g, S, E); }
        else { NG g{XG, DM, p.in[I_WG], p.in[I_WU], FF, (size_t)DM * FF, MR0, 0, NE * MR0, 0, FF, DM}; ngemm<2>(g, c, EpiSwiglu{HID}); }
    } SEAM(9);
    if (IN(10)) for (int rep_ = 0; rep_ < 1 + (int)((PROBE_MASK >> 10) & 1u); ++rep_) { if (rep_) __syncthreads();
        if (FAST_GEMM && MOE_FP8) { pg8::Gemm g{HID, (const bf16*)(p.ws + WS_WDN), NE * MR0, DM, FF / 2, (size_t)DM * FF}; pg8::GroupedOrder S; S.init(MR0 / 256, 4, NE, c.G, c.vcu);
            pg8::EpiGateS E{YS, DM, GATE, 1.f / (W8_DN * H8_SC)}; pg8::gemm_phase<pg8::EpiGateS, pg8::GroupedOrder, true, true, true>(c.lds, g, S, E); }
        else if (FAST_GEMM) { pg8::Gemm g{HID, (const bf16*)(p.ws + WS_WDN), NE * MR0, DM, FF, (size_t)DM * FF * 2}; pg8::GroupedOrder S; S.init(MR0 / 256, 4, NE, c.G, c.vcu);
            pg8::EpiGateP E{YS, DM, GATE}; pg8::gemm_phase<pg8::EpiGateP, pg8::GroupedOrder, true, true>(c.lds, g, S, E); }
        else { NG g{HID, FF, p.in[I_WD], nullptr, DM, (size_t)FF * DM, MR0, 0, NE * MR0, 0, DM, FF}; ngemm<1>(g, c, EpiGate{YS, GATE}); }
    } SEAM(10);
    if (IN(11)) for (int rep_ = 0; rep_ < 1 + (int)((PROBE_MASK >> 11) & 1u); ++rep_) { if (rep_) __syncthreads(); ph_combine(p, c, 0); } SEAM(11);
    if (IN(12)) for (int rep_ = 0; rep_ < 1 + (int)((PROBE_MASK >> 12) & 1u); ++rep_) { if (rep_) __syncthreads();
        if (FAST_GEMM) { pg8::Gemm g{HB, (const bf16*)(p.ws + WS_W1IN), NTOK, OIN, DM, 0}; pg8::L1InOrder S; S.init(c.G, (int)blockIdx.x);
            pg8::EpiBf16<0> E{QKV, OIN, nullptr, 512, 512, C2}; pg8::gemm_phase<pg8::EpiBf16<0>, pg8::L1InOrder, true, true>(c.lds, g, S, E); }
        else {
        NG g{HB, DM, p.in[I_W1IN], nullptr, OIN, 0, 1 << 30, 0, LAT, 0, OIN, DM}; ngemm<1>(g, c, EpiBf{QKV, OIN, 512, C2});
        NG g2{HB, DM, p.in[I_W1IN], nullptr, OIN, 0, 1 << 30, LAT, NTOK, 512, 1536, DM}; ngemm<1>(g2, c, EpiBf{QKV, OIN, 0, 1.f}); }
    } SEAM(12);
    if (IN(13)) for (int rep_ = 0; rep_ < 1 + (int)((PROBE_MASK >> 13) & 1u); ++rep_) { if (rep_) __syncthreads(); if (FAST_NA) ph_mixer1_fast(p, c, (char*)lds_raw); else ph_mixer1_naive(p, c); } SEAM(13);
    if (IN(14)) for (int rep_ = 0; rep_ < 1 + (int)((PROBE_MASK >> 14) & 1u); ++rep_) { if (rep_) __syncthreads();
        if (FAST_GEMM) { pg8::Gemm g{CC, (const bf16*)(p.ws + WS_W1OUT), LAT, DM, DM, 0}; pg8::StaticOrder S; S.init(LAT, DM, c.G, (int)blockIdx.x);
            pg8::EpiF32P E{Y, DM}; pg8::gemm_phase<pg8::EpiF32P, pg8::StaticOrder, true, true>(c.lds, g, S, E); }
        else { NG g{CC, DM, p.in[I_W1OUT], nullptr, DM, 0, 1 << 30, 0, LAT, 0, DM, DM}; ngemm<1>(g, c, EpiF32{Y, DM}); }
    } SEAM(14);
    if (IN(15)) for (int rep_ = 0; rep_ < 1 + (int)((PROBE_MASK >> 15) & 1u); ++rep_) { if (rep_) __syncthreads(); ph_ln1_router(p, c, 1); } SEAM(15);
    if (IN(16)) for (int rep_ = 0; rep_ < 1 + (int)((PROBE_MASK >> 16) & 1u); ++rep_) { if (rep_) __syncthreads(); ph_topk(p, c, 1); } SEAM(16);
    if (IN(17)) for (int rep_ = 0; rep_ < 1 + (int)((PROBE_MASK >> 17) & 1u); ++rep_) { if (rep_) __syncthreads();
        if (FAST_GEMM && MOE_FP8) { pg8::Gemm g{XG, (const bf16*)(p.ws + WS_WGU + WS_MOE_LSTRIDE), NE * MR1, 4096, DM / 2, (size_t)4096 * DM}; pg8::GroupedOrder S; S.init(MR1 / 256, 16, NE, c.G, c.vcu);
            pg8::EpiSwigluF8 E{(unsigned char*)HID, FF, 1.f / W8_GU, H8_SC}; pg8::gemm_phase<pg8::EpiSwigluF8, pg8::GroupedOrder, true, true, true>(c.lds, g, S, E); }
        else if (FAST_GEMM) { pg8::Gemm g{XG, (const bf16*)(p.ws + WS_WGU + WS_MOE_LSTRIDE), NE * MR1, 4096, DM, (size_t)4096 * DM * 2}; pg8::GroupedOrder S; S.init(MR1 / 256, 16, NE, c.G, c.vcu);
            pg8::EpiSwigluP E{HID, FF}; pg8::gemm_phase<pg8::EpiSwigluP, pg8::GroupedOrder, true, true>(c.lds, g, S, E); }
        else { NG g{XG, DM, p.in[I_WG] + (size_t)NE * DM * FF, p.in[I_WU] + (size_t)NE * DM * FF, FF, (size_t)DM * FF, MR1, 0, NE * MR1, 0, FF, DM}; ngemm<2>(g, c, EpiSwiglu{HID}); }
    } SEAM(17);
    if (IN(18)) for (int rep_ = 0; rep_ < 1 + (int)((PROBE_MASK >> 18) & 1u); ++rep_) { if (rep_) __syncthreads();
        if (FAST_GEMM && MOE_FP8) { pg8::Gemm g{HID, (const bf16*)(p.ws + WS_WDN + WS_MOE_LSTRIDE), NE * MR1, DM, FF / 2, (size_t)DM * FF}; pg8::GroupedOrder S; S.init(MR1 / 256, 4, NE, c.G, c.vcu);
            pg8::EpiGateS E{YS, DM, GATE, 1.f / (W8_DN * H8_SC)}; pg8::gemm_phase<pg8::EpiGateS, pg8::GroupedOrder, true, true, true>(c.lds, g, S, E); }
        else if (FAST_GEMM) { pg8::Gemm g{HID, (const bf16*)(p.ws + WS_WDN + WS_MOE_LSTRIDE), NE * MR1, DM, FF, (size_t)DM * FF * 2}; pg8::GroupedOrder S; S.init(MR1 / 256, 4, NE, c.G, c.vcu);
            pg8::EpiGateP E{YS, DM, GATE}; pg8::gemm_phase<pg8::EpiGateP, pg8::GroupedOrder, true, true>(c.lds, g, S, E); }
        else { NG g{HID, FF, p.in[I_WD] + (size_t)NE * FF * DM, nullptr, DM, (size_t)FF * DM, MR1, 0, NE * MR1, 0, DM, FF}; ngemm<1>(g, c, EpiGate{YS, GATE}); }
    } SEAM(18);
    if (IN(19)) for (int rep_ = 0; rep_ < 1 + (int)((PROBE_MASK >> 19) & 1u); ++rep_) { if (rep_) __syncthreads(); ph_combine(p, c, 1); }
    if (PROBE_PH == 19) pt1 = __builtin_amdgcn_s_memrealtime();
    if (PROBE_PH >= 0 && blockIdx.x == 0 && c.tid == 0) { const unsigned long long te = __builtin_amdgcn_s_memrealtime(); while (__builtin_amdgcn_s_memrealtime() - te < pt1 - pt0) __builtin_amdgcn_s_sleep(8); }
#undef IN
#undef SEAM
}

extern "C" void kernel_launch(void* const* d_in, const int* in_sizes, int n_in, void* d_out, int out_size, void* d_ws, size_t ws_size, hipStream_t stream) {
    static int grid = 0;
    if (grid == 0) {
        if (n_in != 26 || out_size != LAT * DM || ws_size < WS_END) { fprintf(stderr, "kernel_launch: unexpected shapes (n_in %d out %d ws %zu)\n", n_in, out_size, ws_size); grid = -1; return; }
        int dev = 0, cus = 0;
        if (hipGetDevice(&dev) != hipSuccess || hipDeviceGetAttribute(&cus, hipDeviceAttributeMultiprocessorCount, dev) != hipSuccess) { grid = -1; return; }
        if (hipFuncSetAttribute((const void*)mk_fwd, hipFuncAttributeMaxDynamicSharedMemorySize, LDS_BYTES) != hipSuccess) { fprintf(stderr, "kernel_launch: hipFuncSetAttribute failed\n"); grid = -1; return; }
        int per_cu = 0;
        if (hipOccupancyMaxActiveBlocksPerMultiprocessor(&per_cu, (const void*)mk_fwd, 512, LDS_BYTES) != hipSuccess || per_cu < 1) fprintf(stderr, "kernel_launch: occupancy query says %d\n", per_cu);
        (void)hipGetLastError();
        grid = cus;
    }
    if (grid < 0) return;
    (void)hipMemsetAsync((char*)d_ws + WS_CTL, 0, CTL_ZERO_BYTES, stream);
    Params a{};
    for (int i = 0; i < 26; ++i) a.in[i] = (const float*)d_in[i];
    a.out = (float*)d_out; a.ws = (unsigned char*)d_ws;
#if MK_MULTI
    for (int ph = 0; ph < NPHASE; ++ph) { a.ph_lo = ph; a.ph_hi = ph + 1; hipLaunchKernelGGL(mk_fwd, dim3(grid), dim3(512), LDS_BYTES, stream, a); }
#else
    a.ph_lo = 0; a.ph_hi = NPHASE;
    hipLaunchKernelGGL(mk_fwd, dim3(grid), dim3(512), LDS_BYTES, stream, a);
#endif
}
```

```cpp
#include <hip/hip_runtime.h>
#include <cstdio>
#include <cstdint>

#define GAS __attribute__((address_space(1)))
#define LAS __attribute__((address_space(3)))
typedef unsigned short bf16;
typedef unsigned v4u __attribute__((ext_vector_type(4)));
typedef unsigned v2u __attribute__((ext_vector_type(2)));
typedef float f32x4 __attribute__((ext_vector_type(4)));
typedef float f32x2 __attribute__((ext_vector_type(2)));
typedef float f32x16 __attribute__((ext_vector_type(16)));
typedef GAS unsigned gu32;

#ifndef PROBE_PH
#define PROBE_PH -1
#endif
#ifndef PROBE_MASK
#define PROBE_MASK 0u
#endif
#ifndef MOE_FP8
#define MOE_FP8 1
#endif
#ifndef FAST_NA
#define FAST_NA 1
#endif
#ifndef FAST_ATTN
#define FAST_ATTN 1
#endif
#ifndef FAST_GEMM
#define FAST_GEMM 1
#endif
#ifndef MK_MULTI
#define MK_MULTI 0
#endif

constexpr int NBATCH = 8, SEQ = 2048, DM = 1024, NCTX = 256;
constexpr int LAT = NBATCH * SEQ;
constexpr int NTOK = LAT + NBATCH * NCTX;
constexpr int EIN = 2304, OIN = 2048, NE = 16, FF = 2048;
constexpr int MR0 = 2304, MR1 = 2048;
constexpr float LOG2E = 1.4426950408889634f;
constexpr float C2 = 0.125f * LOG2E;
constexpr float ALPHA = 1.4142135623730951f;
constexpr float LN_EPS = 1e-5f, RMS_EPS = 1e-6f;
constexpr float LAM_INIT = 0.2f;
constexpr int NPHASE = 20;
constexpr float W8_GU = 32.f, W8_DN = 64.f, H8_SC = 8.f;

constexpr size_t MiB = 1u << 20;
constexpr size_t WS_CTL = 0, CTL_ZERO_BYTES = 1 * MiB;
constexpr size_t WS_MOD = 1 * MiB;
constexpr size_t WS_ROPE = 1 * MiB + 512 * 1024;
constexpr size_t WS_W0IN = 2 * MiB;
constexpr size_t WS_W0OUT = 7 * MiB;
constexpr size_t WS_W1IN = 9 * MiB;
constexpr size_t WS_W1OUT = 13 * MiB;
constexpr size_t WS_AFF = 16 * MiB;
constexpr size_t WS_INV = 18 * MiB;
constexpr size_t WS_GATE = 20 * MiB;
constexpr size_t WS_WGU = 24 * MiB;
constexpr size_t WS_WDN = 152 * MiB;
constexpr size_t WS_MOE_LSTRIDE = 192 * MiB;
constexpr size_t WS_XS = 408 * MiB;
constexpr size_t WS_HB = 480 * MiB;
constexpr size_t WS_QKV = 516 * MiB;
constexpr size_t WS_CC = 597 * MiB;
constexpr size_t WS_AO = 633 * MiB;
constexpr size_t WS_Y = 705 * MiB;
constexpr size_t WS_XG = 516 * MiB;
constexpr size_t WS_HID = 588 * MiB;
constexpr size_t WS_YS = 732 * MiB;
constexpr size_t WS_PF = 804 * MiB;
constexpr size_t WS_END = 968 * MiB;

constexpr int CW_BAR = 4096;
constexpr int LDS_BYTES = 147456;
constexpr int MISC_OFF = 131072 + 320;

__device__ __forceinline__ float bf2f(unsigned v) { return __uint_as_float(v << 16); }
__device__ __forceinline__ unsigned f2bf(float f) { unsigned u = __float_as_uint(f); return (u + 0x7fffu + ((u >> 16) & 1u)) >> 16; }
__device__ __forceinline__ unsigned pk2(float lo, float hi) { return f2bf(lo) | (f2bf(hi) << 16); }
__device__ __forceinline__ float wave_sum(float v) {
#pragma unroll
    for (int o = 1; o < 64; o <<= 1) v += __shfl_xor(v, o);
    return v;
}
__device__ __forceinline__ float wave_max(float v) {
#pragma unroll
    for (int o = 1; o < 64; o <<= 1) v = fmaxf(v, __shfl_xor(v, o));
    return v;
}
__device__ __forceinline__ void unpack8(const v4u w, float* f) {
    f[0] = bf2f(w.x & 0xffffu); f[1] = __uint_as_float(w.x & 0xffff0000u);
    f[2] = bf2f(w.y & 0xffffu); f[3] = __uint_as_float(w.y & 0xffff0000u);
    f[4] = bf2f(w.z & 0xffffu); f[5] = __uint_as_float(w.z & 0xffff0000u);
    f[6] = bf2f(w.w & 0xffffu); f[7] = __uint_as_float(w.w & 0xffff0000u);
}

#define XB_TMO      128
#define XB_XCNT(j)  (256  + 64 * (j))
#define XB_XSUB(j)  (1280 + 64 * (j))
#define XB_XGEN(j)  (2304 + 64 * (j))
#define XB_TOP      3328
#define XB_TOPGEN   3392
#define XCD_BAR_WORDS 3456
#define XB_SPIN_CAP (1u << 18)
__device__ __forceinline__ unsigned xb_ld(unsigned* p)              { return __hip_atomic_load(p, __ATOMIC_RELAXED, __HIP_MEMORY_SCOPE_AGENT); }
__device__ __forceinline__ unsigned xb_add(unsigned* p, unsigned v) { return __hip_atomic_fetch_add(p, v, __ATOMIC_RELAXED, __HIP_MEMORY_SCOPE_AGENT); }
__device__ __forceinline__ unsigned xb_xcc_id() { return (unsigned)__builtin_amdgcn_s_getreg((3 << 11) | 20) & 0xFu; }
#define XB_SPIN(cond, bar) do { unsigned _sp = 0; while (cond) { __builtin_amdgcn_s_sleep(1); \
    if ((++_sp & 255u) == 0u) { if (xb_ld(&(bar)[XB_TMO])) break; if (_sp > XB_SPIN_CAP) { atomicAdd(&(bar)[XB_TMO], 1u); break; } } } } while (0)
struct XcdBarrier { unsigned* bar; unsigned x; volatile LAS unsigned* st; };
__device__ __forceinline__ XcdBarrier xcd_barrier_post(unsigned* bar, volatile LAS unsigned* st) {
    XcdBarrier b; b.bar = bar; b.x = xb_xcc_id(); b.st = st;
    if (threadIdx.x == 0) (void)xb_add(&bar[XB_XCNT(b.x)], 1u);
    return b;
}
__device__ __forceinline__ void xcd_barrier_complete(unsigned* bar, unsigned x, unsigned& nloc, unsigned& nx) {
    const unsigned G = gridDim.x * gridDim.y * gridDim.z;
    unsigned sum, cnt, mine, sp = 0u;
    for (;;) {
        sum = 0u; cnt = 0u; mine = 0u;
#pragma unroll
        for (unsigned j = 0; j < 16; ++j) { const unsigned c = xb_ld(&bar[XB_XCNT(j)]); sum += c; cnt += (c > 0u) ? 1u : 0u; mine = (j == x) ? c : mine; }
        if (sum == G) break;
        __builtin_amdgcn_s_sleep(1);
        if ((++sp & 255u) == 0u) { if (xb_ld(&bar[XB_TMO])) break; if (sp > XB_SPIN_CAP) { atomicAdd(&bar[XB_TMO], 1u); break; } }
    }
    nloc = mine > 0u ? mine : 1u; nx = cnt > 0u ? cnt : 1u;
}
__device__ __forceinline__ void xcd_barrier(const XcdBarrier& b) {
    asm volatile("s_waitcnt vmcnt(0)" ::: "memory");
    __syncthreads();
    if (threadIdx.x == 0) {
        unsigned* bar = b.bar;
        __builtin_amdgcn_s_waitcnt(0);
        unsigned nloc = b.st[0], nx = b.st[1];
        if (nloc == 0u) { xcd_barrier_complete(bar, b.x, nloc, nx); b.st[0] = nloc; b.st[1] = nx; }
        const unsigned old = xb_add(&bar[XB_XSUB(b.x)], 1u);
        const unsigned gen = old / nloc;
        if (old + 1u == (gen + 1u) * nloc) {
            __builtin_amdgcn_fence(__ATOMIC_RELEASE, "agent");
            asm volatile("s_waitcnt vmcnt(0)" ::: "memory");
            const unsigned og = xb_add(&bar[XB_TOP], 1u);
            const unsigned tg = og / nx;
            if (og + 1u == (tg + 1u) * nx) xb_add(&bar[XB_TOPGEN], 1u);
            else XB_SPIN(xb_ld(&bar[XB_TOPGEN]) == tg, bar);
            __builtin_amdgcn_fence(__ATOMIC_ACQUIRE, "agent");
            xb_add(&bar[XB_XGEN(b.x)], 1u);
            asm volatile("s_waitcnt vmcnt(0)" ::: "memory");
        } else {
            XB_SPIN(xb_ld(&bar[XB_XGEN(b.x)]) == gen, bar);
            __builtin_amdgcn_fence(__ATOMIC_ACQUIRE, "agent");
            asm volatile("s_waitcnt vmcnt(0)" ::: "memory");
        }
    }
    __syncthreads();
}

namespace pg8 {
#define PG8_LAS __attribute__((address_space(3)))
typedef unsigned short bf16_t;
typedef short bf16x8 __attribute__((ext_vector_type(8)));
typedef float f32x4 __attribute__((ext_vector_type(4)));
typedef unsigned u32x4 __attribute__((ext_vector_type(4)));
constexpr int BM = 256, BK = 64, HALF = 128, HTB = HALF * BK * 2  , STAGE_BYTES = 8 * HTB, NXCD = 8, WGM = 8;

__host__ __device__ __forceinline__ int lds_byte(int r, int c) { const int st = (r >> 4) * 2 + (c >> 5), rr = r & 15, cc = c & 31, ob = rr * 64 + cc * 2; return st * 1024 + (ob ^ (((ob >> 9) & 1) << 5)); }
__host__ __device__ __forceinline__ void stage_rc(int b, int& R, int& C) { const int st = b / 1024, sb = b % 1024, swz = sb ^ (((sb >> 9) & 1) << 5); R = (st >> 1) * 16 + swz / 64; C = (st & 1) * 32 + (swz % 64) / 2; }
__host__ __device__ __forceinline__ int perm32(int rho) { const int n = rho >> 4, i = rho & 15; return 8 * (i >> 2) + 4 * n + (i & 3); }

struct Unit { int pm, pn, e; };
struct Gemm { const bf16_t* A; const bf16_t* Bt; int M, N, K; size_t bstride; };

struct StaticOrder {
    int nM, nN, nwg, G, c;
    __host__ __device__ void init(int M, int N, int G_, int c_) { nM = M / BM; nN = N / BM; nwg = nM * nN; G = G_; c = c_; }
    __host__ __device__ bool next(int i, Unit& u) const {
        const long L = (long)i * G + c; if (L >= nwg) return false;
        int wgid = (int)L; { const int q = nwg / NXCD, r = nwg % NXCD, xcd = wgid % NXCD, off = wgid / NXCD; wgid = (xcd < r ? xcd * (q + 1) : r * (q + 1) + (xcd - r) * q) + off; }
        const int nig = WGM * nN, gid = wgid / nig, fm = gid * WGM, gsz = (nM - fm) < WGM ? (nM - fm) : WGM;
        u.pm = fm + ((wgid % nig) % gsz); u.pn = (wgid % nig) / gsz; u.e = 0; return true;
    }
    __device__ __forceinline__ void a_ready(const Unit&) const {}
    __device__ __forceinline__ void done(const Unit&) const {}
};

__device__ __forceinline__ unsigned cvt_pk_bf16(float lo, float hi) { unsigned r; asm volatile("v_cvt_pk_bf16_f32 %0, %1, %2" : "=v"(r) : "v"(lo), "v"(hi)); return r; }
typedef float f32x2 __attribute__((ext_vector_type(2)));
__device__ __forceinline__ f32x2 gelu_pk(f32x2 v) {
    const f32x2 av = __builtin_elementwise_abs(v), d = av * 0.2316418882f + 1.0f;
    f32x2 t; t.x = __builtin_amdgcn_rcpf(d.x); t.y = __builtin_amdgcn_rcpf(d.y);
    f32x2 q = t * 0.5307027145f + (-0.7265760135f); q = q * t + 0.7107068705f; q = q * t + (-0.142248368f); q = q * t + 0.127414796f; q = q * t;
    const f32x2 s = (v * v) * (-0.72134752044f);
    f32x2 e; e.x = __builtin_amdgcn_exp2f(s.x); e.y = __builtin_amdgcn_exp2f(s.y);
    const f32x2 m = v * (q * e), r = v - m;
    f32x2 o; o.x = v.x < 0.f ? m.x : r.x; o.y = v.y < 0.f ? m.y : r.y; return o;
}

template <int ACT  > struct EpiBf16 {
    static constexpr bool PERM = true, AFTER_DRAIN = false; static_assert(ACT == 0 || ACT == 1, "EpiBf16: ACT is 0 (none) or 1 (gelu_pk)");
    bf16_t* O; int ldc; const float* bias; int split_cols; size_t split_stride; float scale0;
    __device__ __forceinline__ void operator()(const f32x4 (&acc)[2][2][4][2], const Unit& u, int wr, int wc, int fr, int fq) const {
        const int row0 = u.pm * BM + wr * 64 + fr; int colt = u.pn * BM; bf16_t* base = O;
        float sc = 1.f; if (split_cols) { const int t = colt / split_cols; base += (size_t)t * split_stride; colt -= t * split_cols; if (t == 0) sc = scale0; }
        const int col0 = colt + wc * 32 + 8 * fq, bcol0 = u.pn * BM + wc * 32 + 8 * fq;
        f32x4 bv[2][2];
#pragma unroll
        for (int bj = 0; bj < 2; ++bj)
#pragma unroll
            for (int n = 0; n < 2; ++n) bv[bj][n] = bias ? *(const f32x4*)(bias + bcol0 + bj * HALF + 4 * n) : (f32x4){0.f, 0.f, 0.f, 0.f};
#pragma unroll
        for (int ai = 0; ai < 2; ++ai)
#pragma unroll
            for (int m = 0; m < 4; ++m) { bf16_t* rowp = base + (size_t)(row0 + ai * HALF + m * 16) * ldc + col0;
#pragma unroll
                for (int bj = 0; bj < 2; ++bj) { f32x4 v0 = acc[ai][bj][m][0] + bv[bj][0], v1 = acc[ai][bj][m][1] + bv[bj][1];
                    if (ACT == 1) { f32x2 a = gelu_pk((f32x2){v0[0], v0[1]}), b = gelu_pk((f32x2){v0[2], v0[3]}), c = gelu_pk((f32x2){v1[0], v1[1]}), d = gelu_pk((f32x2){v1[2], v1[3]});
                        v0 = (f32x4){a.x, a.y, b.x, b.y}; v1 = (f32x4){c.x, c.y, d.x, d.y}; }
                    v0 = v0 * sc; v1 = v1 * sc; u32x4 w; w.x = cvt_pk_bf16(v0[0], v0[1]); w.y = cvt_pk_bf16(v0[2], v0[3]); w.z = cvt_pk_bf16(v1[0], v1[1]); w.w = cvt_pk_bf16(v1[2], v1[3]);
                    *(u32x4*)(rowp + bj * HALF) = w; } }
    }
};

typedef int i32x4 __attribute__((ext_vector_type(4))); typedef int i32x8 __attribute__((ext_vector_type(8)));
__device__ __forceinline__ i32x8 cat16(bf16x8 lo, bf16x8 hi) { const i32x4 a = __builtin_bit_cast(i32x4, lo), b = __builtin_bit_cast(i32x4, hi); return __builtin_shufflevector(a, b, 0, 1, 2, 3, 4, 5, 6, 7); }
__device__ __forceinline__ void mfma_f8_acc(f32x4& acc, const i32x8& b, const i32x8& a, int sc) {
    asm volatile("v_mfma_scale_f32_16x16x128_f8f6f4 %0, %1, %2, %0, %3, %3 op_sel_hi:[0,0,0]" : "+v"(acc) : "v"(b), "v"(a), "v"(sc)); }
template <class Epi, class Sched, bool ALIGN_EPI = false, bool SP2 = false, bool FP8 = false>
__device__ __forceinline__ void gemm_phase(PG8_LAS unsigned char* lds, const Gemm g, const Sched& S, const Epi& E) {
    const int tid = threadIdx.x, wid = __builtin_amdgcn_readfirstlane(tid >> 6), lane = tid & 63, wr = wid >> 2, wc = wid & 3, fr = lane & 15, fq = lane >> 4;
    const int K = g.K, nt = K / BK;
    unsigned voffA[2], voffB[2];
#pragma unroll
    for (int i = 0; i < 2; ++i) { int R, C; stage_rc(tid * 16 + i * 8192, R, C); const int Rb = Epi::PERM ? ((R & ~31) + perm32(R & 31)) : R;
        voffA[i] = (unsigned)(R * K + C) * 2u; voffB[i] = (unsigned)(Rb * K + C) * 2u; }
    const size_t kstep = (size_t)(BK * 2);
    const size_t hstep = (size_t)HALF * K * 2;
    const size_t tstep = 2 * hstep;
    const unsigned ldsw = (unsigned)wid * 1024u;
    const int aoff = FP8 ? lds_byte(wr * 64 + fr, 16 * fq) : lds_byte(wr * 64 + fr, fq * 8), boff = FP8 ? lds_byte(wc * 32 + fr, 16 * fq) : lds_byte(wc * 32 + fr, fq * 8);
    constexpr int KOFF = FP8 ? 16 : 1024;
#define PG8_SA(b, h) (((b) * 2 + (h)) * HTB)
#define PG8_SB(b, h) ((4 + (b) * 2 + (h)) * HTB)
#define PG8_STAGE(bufoff, gbase, voff) do { _Pragma("unroll") for (int _i = 0; _i < 2; ++_i) \
        __builtin_amdgcn_global_load_lds((const unsigned*)((const char*)(gbase) + (voff)[_i]), (PG8_LAS unsigned*)(lds + (bufoff) + ldsw + _i * 8192), 16, 0, 0); } while (0)
#define PG8_LDA(dst, b, h) do { _Pragma("unroll") for (int m = 0; m < 4; ++m) _Pragma("unroll") for (int k = 0; k < 2; ++k) dst[m][k] = *(const PG8_LAS bf16x8*)(lds + PG8_SA(b, h) + aoff + m * 2048 + k * KOFF); } while (0)
#define PG8_LDB(dst, b, h) do { _Pragma("unroll") for (int n = 0; n < 2; ++n) _Pragma("unroll") for (int k = 0; k < 2; ++k) dst[n][k] = *(const PG8_LAS bf16x8*)(lds + PG8_SB(b, h) + boff + n * 2048 + k * KOFF); } while (0)
#define PG8_MMA(ai, bj, At, Bt) do { __builtin_amdgcn_s_setprio(1); _Pragma("unroll") for (int m = 0; m < 4; ++m) _Pragma("unroll") for (int n = 0; n < 2; ++n) { \
        if constexpr (FP8) mfma_f8_acc(acc[ai][bj][m][n], cat16(Bt[n][0], Bt[n][1]), cat16(At[m][0], At[m][1]), f8scale); \
        else { _Pragma("unroll") for (int k = 0; k < 2; ++k) acc[ai][bj][m][n] = __builtin_amdgcn_mfma_f32_16x16x32_bf16(Bt[n][k], At[m][k], acc[ai][bj][m][n], 0, 0, 0); } } __builtin_amdgcn_s_setprio(0); } while (0)
#define PG8_WAIT_V(n) asm volatile("s_waitcnt vmcnt(" #n ")" ::: "memory")
#define PG8_WAIT_L(n) asm volatile("s_waitcnt lgkmcnt(" #n ")" ::: "memory")
#define PG8_BAR __builtin_amdgcn_s_barrier()
#define PG8_SCHED __builtin_amdgcn_sched_barrier(0)
    Unit cur, nxt; int ui = 0;
    if (!S.next(0, cur)) return;
    f32x4 acc[2][2][4][2];
#pragma unroll
    for (int a = 0; a < 2; ++a)
#pragma unroll
        for (int b = 0; b < 2; ++b)
#pragma unroll
            for (int m = 0; m < 4; ++m)
#pragma unroll
                for (int n = 0; n < 2; ++n) acc[a][b][m][n] = (f32x4){0.f, 0.f, 0.f, 0.f};
    int f8scale = 0x7F7F7F7F; asm volatile("" : "+v"(f8scale));
    bf16x8 At[4][2], B0[2][2], B1[2][2];
    const char* cA = (const char*)g.A + (size_t)cur.pm * tstep; const char* cB = (const char*)g.Bt + (size_t)cur.pn * tstep + (size_t)cur.e * g.bstride;
    S.a_ready(cur);
    if constexpr (SP2) {
        PG8_STAGE(PG8_SB(0, 0), cB, voffB); PG8_STAGE(PG8_SB(0, 1), cB + hstep, voffB); PG8_STAGE(PG8_SA(0, 0), cA, voffA); PG8_STAGE(PG8_SA(0, 1), cA + hstep, voffA);
        if (wr == 1) PG8_BAR;
        PG8_WAIT_V(2); PG8_BAR;
        PG8_STAGE(PG8_SB(1, 0), cB + kstep, voffB); PG8_STAGE(PG8_SA(1, 0), cA + kstep, voffA); PG8_STAGE(PG8_SB(1, 1), cB + hstep + kstep, voffB);
        PG8_WAIT_V(6); PG8_BAR;
    } else {
        PG8_STAGE(PG8_SB(0, 0), cB, voffB); PG8_STAGE(PG8_SA(0, 0), cA, voffA); PG8_STAGE(PG8_SB(0, 1), cB + hstep, voffB); PG8_STAGE(PG8_SA(0, 1), cA + hstep, voffA);
        if (wr == 1) PG8_BAR;
        PG8_WAIT_V(4); PG8_BAR;
        PG8_STAGE(PG8_SB(1, 0), cB + kstep, voffB); PG8_STAGE(PG8_SA(1, 0), cA + kstep, voffA); PG8_STAGE(PG8_SB(1, 1), cB + hstep + kstep, voffB);
        PG8_WAIT_V(6); PG8_BAR;
    }
    for (;;) {
        const bool has_next = S.next(ui + 1, nxt);
        const char* nA = has_next ? (const char*)g.A + (size_t)nxt.pm * tstep : cA; const char* nB = has_next ? (const char*)g.Bt + (size_t)nxt.pn * tstep + (size_t)nxt.e * g.bstride : cB;
        for (int t = 0; t < nt; t += 2) {
            const bool last = (t == nt - 2);
            const char* a1 = cA + (size_t)(t + 1) * kstep;
            const char* a2 = last ? nA : cA + (size_t)(t + 2) * kstep; const char* b2 = last ? nB : cB + (size_t)(t + 2) * kstep;
            const char* a3 = a2 + kstep; const char* b3 = b2 + kstep;
            if (last && has_next) S.a_ready(nxt);
            if constexpr (SP2) {
            PG8_LDB(B0, 0, 0); PG8_LDB(B1, 0, 1); PG8_SCHED; PG8_LDA(At, 0, 0); PG8_STAGE(PG8_SA(1, 1), a1 + hstep, voffA);
            PG8_WAIT_V(8); PG8_WAIT_L(0); PG8_BAR; PG8_MMA(0, 0, At, B0); PG8_MMA(0, 1, At, B1); PG8_BAR; PG8_SCHED;
            PG8_LDA(At, 0, 1); PG8_STAGE(PG8_SB(0, 0), b2, voffB); PG8_STAGE(PG8_SB(0, 1), b2 + hstep, voffB); PG8_STAGE(PG8_SA(0, 0), a2, voffA);
            PG8_WAIT_V(8); PG8_WAIT_L(0); PG8_BAR; PG8_MMA(1, 0, At, B0); PG8_MMA(1, 1, At, B1); PG8_BAR; PG8_SCHED;
            PG8_LDB(B0, 1, 0); PG8_LDB(B1, 1, 1); PG8_SCHED; PG8_LDA(At, 1, 0); PG8_STAGE(PG8_SA(0, 1), a2 + hstep, voffA);
            PG8_WAIT_V(8); PG8_WAIT_L(0); PG8_BAR; PG8_MMA(0, 0, At, B0); PG8_MMA(0, 1, At, B1); PG8_BAR; PG8_SCHED;
            PG8_LDA(At, 1, 1); PG8_STAGE(PG8_SB(1, 0), b3, voffB); PG8_STAGE(PG8_SB(1, 1), b3 + hstep, voffB); PG8_STAGE(PG8_SA(1, 0), a3, voffA);
            PG8_WAIT_V(8); PG8_WAIT_L(0); PG8_BAR; PG8_MMA(1, 0, At, B0); PG8_MMA(1, 1, At, B1); PG8_BAR; PG8_SCHED;
            } else {
            PG8_LDB(B0, 0, 0); PG8_SCHED; PG8_LDA(At, 0, 0); PG8_STAGE(PG8_SA(1, 1), a1 + hstep, voffA);
            PG8_WAIT_L(8); PG8_BAR; PG8_WAIT_L(0); PG8_MMA(0, 0, At, B0); PG8_BAR; PG8_SCHED;
            PG8_LDB(B1, 0, 1); PG8_STAGE(PG8_SB(0, 0), b2, voffB);
            PG8_BAR; PG8_WAIT_L(0); PG8_MMA(0, 1, At, B1); PG8_BAR;
            PG8_LDA(At, 0, 1); PG8_STAGE(PG8_SA(0, 0), a2, voffA);
            PG8_BAR; PG8_WAIT_L(0); PG8_MMA(1, 0, At, B0); PG8_BAR; PG8_SCHED;
            PG8_STAGE(PG8_SB(0, 1), b2 + hstep, voffB);
            PG8_WAIT_V(6); PG8_BAR; PG8_MMA(1, 1, At, B1); PG8_BAR;
            PG8_LDB(B0, 1, 0); PG8_SCHED; PG8_LDA(At, 1, 0); PG8_STAGE(PG8_SA(0, 1), a2 + hstep, voffA);
            PG8_WAIT_L(8); PG8_BAR; PG8_WAIT_L(0); PG8_MMA(0, 0, At, B0); PG8_BAR; PG8_SCHED;
            PG8_LDB(B1, 1, 1); PG8_STAGE(PG8_SB(1, 0), b3, voffB);
            PG8_BAR; PG8_WAIT_L(0); PG8_MMA(0, 1, At, B1); PG8_BAR;
            PG8_LDA(At, 1, 1); PG8_STAGE(PG8_SA(1, 0), a3, voffA);
            PG8_BAR; PG8_WAIT_L(0); PG8_MMA(1, 0, At, B0); PG8_BAR; PG8_SCHED;
            PG8_STAGE(PG8_SB(1, 1), b3 + hstep, voffB);
            PG8_WAIT_V(6); PG8_BAR; PG8_MMA(1, 1, At, B1); PG8_BAR;
            }
        }
        if constexpr (ALIGN_EPI) { if (wr == 0) PG8_BAR; }
        if constexpr (FP8) asm volatile("s_nop 15\n\ts_nop 15" : "+v"(acc[1][1][0][0]), "+v"(acc[1][1][0][1]), "+v"(acc[1][1][1][0]), "+v"(acc[1][1][1][1]), "+v"(acc[1][1][2][0]), "+v"(acc[1][1][2][1]), "+v"(acc[1][1][3][0]), "+v"(acc[1][1][3][1]));
        if constexpr (!Epi::AFTER_DRAIN) { E(acc, cur, wr, wc, fr, fq); S.done(cur); }
        if (!has_next) break;
#pragma unroll
        for (int a = 0; a < 2; ++a)
#pragma unroll
            for (int b = 0; b < 2; ++b)
#pragma unroll
                for (int m = 0; m < 4; ++m)
#pragma unroll
                    for (int n = 0; n < 2; ++n) acc[a][b][m][n] = (f32x4){0.f, 0.f, 0.f, 0.f};
        cur = nxt; cA = nA; cB = nB; ++ui;
        if constexpr (ALIGN_EPI) { if (wr == 1) PG8_BAR; }
    }
    PG8_WAIT_V(0);
    if constexpr (!ALIGN_EPI) { if (wr == 0) PG8_BAR; }
    PG8_BAR;
    if constexpr (Epi::AFTER_DRAIN) { E.fused(acc, cur, wr, wc, fr, fq, lds, wid, lane); S.done(cur); }
#undef PG8_SA
#undef PG8_SB
#undef PG8_STAGE
#undef PG8_LDA
#undef PG8_LDB
#undef PG8_MMA
#undef PG8_WAIT_V
#undef PG8_WAIT_L
#undef PG8_BAR
#undef PG8_SCHED
}
}

namespace pg8 {
struct EpiF32P {
    static constexpr bool PERM = false, AFTER_DRAIN = false;
    float* O; int ldc;
    __device__ __forceinline__ void operator()(const f32x4 (&acc)[2][2][4][2], const Unit& u, int wr, int wc, int fr, int fq) const {
        const int row0 = u.pm * BM + wr * 64 + fr, col0 = u.pn * BM + wc * 32 + 4 * fq;
#pragma unroll
        for (int ai = 0; ai < 2; ++ai)
#pragma unroll
            for (int m = 0; m < 4; ++m) { float* rowp = O + (size_t)(row0 + ai * HALF + m * 16) * ldc + col0;
#pragma unroll
                for (int bj = 0; bj < 2; ++bj)
#pragma unroll
                    for (int n = 0; n < 2; ++n) *(f32x4*)(rowp + bj * HALF + n * 16) = acc[ai][bj][m][n]; }
    }
};
struct EpiSwigluP {
    static constexpr bool PERM = true, AFTER_DRAIN = false;
    bf16_t* O; int ldc;
    __device__ __forceinline__ void operator()(const f32x4 (&acc)[2][2][4][2], const Unit& u, int wr, int wc, int fr, int fq) const {
        const int row0 = u.pm * BM + wr * 64 + fr, col0 = u.pn * HALF + wc * 32 + 8 * fq;
#pragma unroll
        for (int ai = 0; ai < 2; ++ai)
#pragma unroll
            for (int m = 0; m < 4; ++m) {
                float h[8];
#pragma unroll
                for (int n = 0; n < 2; ++n)
#pragma unroll
                    for (int j = 0; j < 4; ++j) { const float g = acc[ai][0][m][n][j], up = acc[ai][1][m][n][j];
                        h[4 * n + j] = g * up * __builtin_amdgcn_rcpf(1.0f + __builtin_amdgcn_exp2f(-1.4426950408889634f * g)); }
                u32x4 w; w.x = cvt_pk_bf16(h[0], h[1]); w.y = cvt_pk_bf16(h[2], h[3]); w.z = cvt_pk_bf16(h[4], h[5]); w.w = cvt_pk_bf16(h[6], h[7]);
                *(u32x4*)(O + (size_t)(row0 + ai * HALF + m * 16) * ldc + col0) = w; }
    }
};
struct EpiGateP {
    static constexpr bool PERM = true, AFTER_DRAIN = false;
    bf16_t* O; int ldc; const float* gate;
    __device__ __forceinline__ void operator()(const f32x4 (&acc)[2][2][4][2], const Unit& u, int wr, int wc, int fr, int fq) const {
        const int row0 = u.pm * BM + wr * 64 + fr, col0 = u.pn * BM + wc * 32 + 8 * fq;
#pragma unroll
        for (int ai = 0; ai < 2; ++ai)
#pragma unroll
            for (int m = 0; m < 4; ++m) { const int row = row0 + ai * HALF + m * 16; const float gt = gate[row]; bf16_t* rowp = O + (size_t)row * ldc + col0;
#pragma unroll
                for (int bj = 0; bj < 2; ++bj) { const f32x4 v0 = acc[ai][bj][m][0] * gt, v1 = acc[ai][bj][m][1] * gt;
                    u32x4 w; w.x = cvt_pk_bf16(v0[0], v0[1]); w.y = cvt_pk_bf16(v0[2], v0[3]); w.z = cvt_pk_bf16(v1[0], v1[1]); w.w = cvt_pk_bf16(v1[2], v1[3]);
                    *(u32x4*)(rowp + bj * HALF) = w; } }
    }
};
__device__ __forceinline__ unsigned pk4_fp8(float a, float b, float c, float d) {
    a = __builtin_fminf(__builtin_fmaxf(a, -448.f), 448.f); b = __builtin_fminf(__builtin_fmaxf(b, -448.f), 448.f);
    c = __builtin_fminf(__builtin_fmaxf(c, -448.f), 448.f); d = __builtin_fminf(__builtin_fmaxf(d, -448.f), 448.f);
    int w = 0; w = __builtin_amdgcn_cvt_pk_fp8_f32(a, b, w, false); w = __builtin_amdgcn_cvt_pk_fp8_f32(c, d, w, true); return (unsigned)w; }
struct EpiSwigluF8 {
    static constexpr bool PERM = true, AFTER_DRAIN = false;
    unsigned char* O; int ldc; float ws, hs;
    __device__ __forceinline__ void operator()(const f32x4 (&acc)[2][2][4][2], const Unit& u, int wr, int wc, int fr, int fq) const {
        const int row0 = u.pm * BM + wr * 64 + fr, col0 = u.pn * HALF + wc * 32 + 8 * fq;
#pragma unroll
        for (int ai = 0; ai < 2; ++ai)
#pragma unroll
            for (int m = 0; m < 4; ++m) {
                float h[8];
#pragma unroll
                for (int n = 0; n < 2; ++n)
#pragma unroll
                    for (int j = 0; j < 4; ++j) { const float g = acc[ai][0][m][n][j] * ws, up = acc[ai][1][m][n][j] * ws;
                        h[4 * n + j] = g * up * hs * __builtin_amdgcn_rcpf(1.0f + __builtin_amdgcn_exp2f(-1.4426950408889634f * g)); }
                typedef unsigned u32x2 __attribute__((ext_vector_type(2)));
                *(u32x2*)(O + (size_t)(row0 + ai * HALF + m * 16) * ldc + col0) = (u32x2){pk4_fp8(h[0], h[1], h[2], h[3]), pk4_fp8(h[4], h[5], h[6], h[7])}; }
    }
};
struct EpiGateS {
    static constexpr bool PERM = true, AFTER_DRAIN = false;
    bf16_t* O; int ldc; const float* gate; float sc;
    __device__ __forceinline__ void operator()(const f32x4 (&acc)[2][2][4][2], const Unit& u, int wr, int wc, int fr, int fq) const {
        const int row0 = u.pm * BM + wr * 64 + fr, col0 = u.pn * BM + wc * 32 + 8 * fq;
#pragma unroll
        for (int ai = 0; ai < 2; ++ai)
#pragma unroll
            for (int m = 0; m < 4; ++m) { const int row = row0 + ai * HALF + m * 16; const float gt = gate[row] * sc; bf16_t* rowp = O + (size_t)row * ldc + col0;
#pragma unroll
                for (int bj = 0; bj < 2; ++bj) { const f32x4 v0 = acc[ai][bj][m][0] * gt, v1 = acc[ai][bj][m][1] * gt;
                    u32x4 w; w.x = cvt_pk_bf16(v0[0], v0[1]); w.y = cvt_pk_bf16(v0[2], v0[3]); w.z = cvt_pk_bf16(v1[0], v1[1]); w.w = cvt_pk_bf16(v1[2], v1[3]);
                    *(u32x4*)(rowp + bj * HALF) = w; } }
    }
};
struct GroupedOrder {
    int nMe, nN, ntot, G, c;
    __device__ void init(int nMe_, int nN_, int ne, int G_, int c_) { nMe = nMe_; nN = nN_; ntot = nMe_ * nN_ * ne; G = G_; c = c_; }
    __device__ bool next(int i, Unit& u) const {
        const int L = i * G + c; if (L >= ntot) return false;
        const int per = nMe * nN, e = L / per, rem = L - e * per;
        u.e = e; u.pn = rem / nMe; u.pm = e * nMe + (rem - u.pn * nMe); return true;
    }
    __device__ __forceinline__ void a_ready(const Unit&) const {}
    __device__ __forceinline__ void done(const Unit&) const {}
};
struct L1InOrder {
    StaticOrder so; int G, c;
    __device__ void init(int G_, int c_) { so.init(16384, 2048, G_, 0); G = G_; c = c_; }
    __device__ bool next(int i, Unit& u) const {
        const int L = i * G + c;
        if (L < 512) { StaticOrder t = so; t.G = 1; t.c = 0; return t.next(L, u); }
        if (L < 544) { const int l = L - 512; u.pm = 64 + (l >> 2); u.pn = 2 + (l & 3); u.e = 0; return true; }
        return false;
    }
    __device__ __forceinline__ void a_ready(const Unit&) const {}
    __device__ __forceinline__ void done(const Unit&) const {}
};
}

#include <hip/hip_bf16.h>
#include <cmath>
namespace attn_body {
using bf16=__hip_bfloat16;
using bf16x8=__attribute__((ext_vector_type(8)))short;
using s16x4=__attribute__((ext_vector_type(4)))short;
using f32x16=__attribute__((ext_vector_type(16)))float;
using u32x4=__attribute__((ext_vector_type(4)))unsigned;
constexpr int D=64,OPITCH=1024;
constexpr int NW=8,QBLK=32,QB=QBLK*NW,KVBLK=64;
__device__ __forceinline__ int crow(int r,int hi){return (r&3)+8*(r>>2)+4*hi;}
#define SBAR() __builtin_amdgcn_sched_barrier(0)
__device__ __forceinline__ void cmask(f32x16&p0,f32x16&p1,int jb,int qrel,int hi){
  const float NEG=-INFINITY; int kb=64*jb+4*hi;
  #pragma unroll
  for(int r=0;r<16;++r){int kv=kb+(r&3)+8*(r>>2); if(kv>qrel)p0[r]=NEG; if(kv+32>qrel)p1[r]=NEG;}
}

constexpr int NSLOT=3, SLOTB=8192;
constexpr int LDS_K=0, LDS_V=NSLOT*SLOTB, LDS_WS=2*NSLOT*SLOTB, LDS_OST=LDS_WS+NW*64*4, LDS_BYTES=LDS_OST+NW*4096;
constexpr float C2=0.125f*1.4426950408889634f;
__device__ __forceinline__ void glds16(const void*gsrc,unsigned lds_dst){unsigned keep;
  asm volatile("s_mov_b32 %0, m0\n\ts_mov_b32 m0, %2\n\ts_nop 0\n\tglobal_load_lds_dwordx4 %1, off\n\ts_mov_b32 m0, %0":"=&s"(keep):"v"(gsrc),"s"(lds_dst):"memory");}
__device__ __forceinline__ float max3f(float a,float b,float c){float r;asm("v_max3_f32 %0, %1, %2, %3":"=v"(r):"v"(a),"v"(b),"v"(c));return r;}
__device__ __forceinline__ float max2f(float a,float b){float r;asm("v_max_f32_e32 %0, %1, %2":"=v"(r):"v"(a),"v"(b));return r;}
__device__ __forceinline__ float fadd_s(float a,float b){float r;asm("v_add_f32_e32 %0, %1, %2":"=v"(r):"v"(a),"v"(b));return r;}
__device__ __forceinline__ float fsub_s(float a,float b){float r;asm("v_sub_f32_e32 %0, %1, %2":"=v"(r):"v"(a),"v"(b));return r;}
typedef float f32x2_t __attribute__((ext_vector_type(2))); typedef __bf16 bf16x2_t __attribute__((ext_vector_type(2)));
__device__ __forceinline__ unsigned cvtpk_s(float lo,float hi){f32x2_t v={lo,hi};bf16x2_t b=__builtin_convertvector(v,bf16x2_t);return __builtin_bit_cast(unsigned,b);}
#define WAIT_BAR(N) asm volatile("s_waitcnt vmcnt(" #N ") lgkmcnt(0)\n\ts_barrier":::"memory")

__device__ __forceinline__ void qkt(f32x16&p0,f32x16&p1,const char*Kslot,const bf16x8*qr,const f32x16&negm,int r32,int hi){
  const char*kb=Kslot+hi*1024+r32*16;
  #pragma unroll
  for(int d0=0;d0<4;++d0){
    const bf16x8 b0=*reinterpret_cast<const bf16x8*>(kb+d0*2048);
    const bf16x8 b1=*reinterpret_cast<const bf16x8*>(kb+d0*2048+512);
    if(d0==0){p0=__builtin_amdgcn_mfma_f32_32x32x16_bf16(b0,qr[0],negm,0,0,0);p1=__builtin_amdgcn_mfma_f32_32x32x16_bf16(b1,qr[0],negm,0,0,0);}
    else{p0=__builtin_amdgcn_mfma_f32_32x32x16_bf16(b0,qr[d0],p0,0,0,0);p1=__builtin_amdgcn_mfma_f32_32x32x16_bf16(b1,qr[d0],p1,0,0,0);}}
}
typedef __attribute__((address_space(3))) const char* lds_cptr;
typedef short v4i16_t __attribute__((ext_vector_type(4)));
__device__ __forceinline__ void kload8(bf16x8*kf,lds_cptr kp){
  kf[0]=*(const __attribute__((address_space(3))) bf16x8*)(kp);      kf[1]=*(const __attribute__((address_space(3))) bf16x8*)(kp+512);
  kf[2]=*(const __attribute__((address_space(3))) bf16x8*)(kp+2048); kf[3]=*(const __attribute__((address_space(3))) bf16x8*)(kp+2560);
  kf[4]=*(const __attribute__((address_space(3))) bf16x8*)(kp+4096); kf[5]=*(const __attribute__((address_space(3))) bf16x8*)(kp+4608);
  kf[6]=*(const __attribute__((address_space(3))) bf16x8*)(kp+6144); kf[7]=*(const __attribute__((address_space(3))) bf16x8*)(kp+6656);
}
__device__ __forceinline__ void kload2(bf16x8*kf,lds_cptr kp,int j){ kf[2*j]=*(const __attribute__((address_space(3))) bf16x8*)(kp+j*2048); kf[2*j+1]=*(const __attribute__((address_space(3))) bf16x8*)(kp+j*2048+512); }
__device__ __forceinline__ s16x4 vtr(lds_cptr p){ return __builtin_bit_cast(s16x4,__builtin_amdgcn_ds_read_tr16_b64_v4i16((__attribute__((address_space(3))) v4i16_t*)p)); }
__device__ __forceinline__ float rowmax(const f32x16&p0,const f32x16&p1){
  float a=max3f(p0[0],p0[1],p1[0]),b=max3f(p0[2],p0[3],p1[1]);a=max3f(a,p1[2],p1[3]);
  #pragma unroll
  for(int r=4;r<16;r+=4){a=max3f(a,p0[r],p0[r+1]);b=max3f(b,p0[r+2],p0[r+3]);a=max3f(a,p1[r],p1[r+1]);b=max3f(b,p1[r+2],p1[r+3]);}
  const float m=max2f(a,b);
  auto rr=__builtin_amdgcn_permlane32_swap(__float_as_uint(m),__float_as_uint(m),false,false);
  return max2f(__uint_as_float(rr[0]),__uint_as_float(rr[1]));
}
__device__ __forceinline__ void pv(f32x16*o,int vb,bf16x8 pa0,bf16x8 pa1,bf16x8 pa2,bf16x8 pa3){
  #pragma unroll
  for(int d0=0;d0<2;++d0){s16x4 lo[4],hi[4];
    #pragma unroll
    for(int ks=0;ks<4;++ks){
      asm volatile("ds_read_b64_tr_b16 %0,%1 offset:%c2":"=&v"(lo[ks]):"v"(vb),"i"(d0*4096+ks*1024):"memory");
      asm volatile("ds_read_b64_tr_b16 %0,%1 offset:%c2":"=&v"(hi[ks]):"v"(vb),"i"(d0*4096+ks*1024+512):"memory");}
    asm volatile("s_waitcnt lgkmcnt(0)":::"memory");SBAR();
    #define PK(k) (bf16x8){lo[k][0],lo[k][1],lo[k][2],lo[k][3],hi[k][0],hi[k][1],hi[k][2],hi[k][3]}
    o[d0]=__builtin_amdgcn_mfma_f32_32x32x16_bf16(pa0,PK(0),o[d0],0,0,0);
    o[d0]=__builtin_amdgcn_mfma_f32_32x32x16_bf16(pa1,PK(1),o[d0],0,0,0);
    o[d0]=__builtin_amdgcn_mfma_f32_32x32x16_bf16(pa2,PK(2),o[d0],0,0,0);
    o[d0]=__builtin_amdgcn_mfma_f32_32x32x16_bf16(pa3,PK(3),o[d0],0,0,0);
    #undef PK
  }
}

#ifndef ATTN_STORE16
#define ATTN_STORE16(p,v) (*(u32x4*)(p)=(v))
#endif
struct AU { const bf16* Qp; const bf16* Kp; const bf16* Vp; bf16* Op; int qrow0, lat_row0, ctx_row0, nlat_t, NT; };
struct NoMask { __device__ __forceinline__ void apply(f32x16&,f32x16&,int,int)const{} };
typedef __attribute__((address_space(3))) const float* lds_cfptr;
struct NAMask { lds_cfptr tb0; int r, rs, rs_min, cb;
  __device__ __forceinline__ void apply(f32x16&p0,f32x16&p1,int t,int hi)const{
    if(t<4)return;
    const int kr=rs_min+t-4; const float NEG=-INFINITY;
    if((unsigned)(kr-rs)>7u){
      #pragma unroll
      for(int i=0;i<16;++i){p0[i]=NEG;p1[i]=NEG;}
      return; }
    const lds_cfptr tb=tb0+(kr-r+7)*32+4*hi;
    #pragma unroll
    for(int i=0;i<16;++i){ const int k0=(i&3)+8*(i>>2); const int d0=cb+k0, d1=cb+k0+32;
      const float b0=tb[k0], b1=tb[k0+32];
      p0[i]=((unsigned)d0<=15u)?p0[i]+b0:NEG; p1[i]=((unsigned)d1<=15u)?p1[i]+b1:NEG; }
  }
};
template<int THRL,int PITCH,class MaskT> __device__ __forceinline__ void attn_unit(const AU& u,char*shm,const MaskT& mk){
  const int tid=threadIdx.x,lane=tid&63,r32=lane&31,hi=lane>>5; const int wid=__builtin_amdgcn_readfirstlane(tid>>6);
  const bf16*Qw=u.Qp+(long)(u.qrow0+wid*QBLK)*PITCH;
  const bf16*Kh=u.Kp,*Vh=u.Vp;
  const unsigned lds0=(unsigned)(uintptr_t)shm;
  float*wsf=(float*)(shm+LDS_WS)+wid*64;
  const bf16*ksrc=Kh+(long)lane*PITCH+wid*8;
  const bf16*vsrc=Vh+(long)(16*(wid&3)+(lane>>2))*PITCH+(wid>>2)*32+(lane&3)*8;
  const unsigned kdst=lds0+LDS_K+wid*1024, vdst=lds0+LDS_V+wid*1024;
  #define TROW(t) ((long)((t)<u.nlat_t?u.lat_row0+KVBLK*(t):u.ctx_row0+KVBLK*((t)-u.nlat_t))*PITCH)
  #define DMA_K(t,slot) glds16(ksrc+TROW(t),(unsigned)__builtin_amdgcn_readfirstlane(kdst+(slot)))
  #define DMA_V(t,slot) glds16(vsrc+TROW(t),(unsigned)__builtin_amdgcn_readfirstlane(vdst+(slot)))
  const int vb0=(int)(lds0+LDS_V)+((lane>>4)&1)*32+(lane&3)*8+(4*hi+((lane&15)>>2))*64;
  const char*Kbase=shm+LDS_K; bf16x8 kf[8];
  const lds_cptr shm3=(lds_cptr)shm; const lds_cptr kp0=shm3+LDS_K+hi*1024+r32*16; const lds_cptr vp0=shm3+LDS_V+((lane>>4)&1)*32+(lane&3)*8+(4*hi+((lane&15)>>2))*64;
  const int NT=u.NT;
  DMA_K(0,0);DMA_V(0,0);DMA_K(1,SLOTB);
  bf16x8 qr[4];
  #pragma unroll
  for(int d0=0;d0<4;++d0)qr[d0]=*reinterpret_cast<const bf16x8*>(&Qw[(long)r32*PITCH+d0*16+hi*8]);
  float mhat=0.f,l_reg=0.f;f32x16 o[2];o[0]=f32x16{};o[1]=f32x16{};f32x16 negm=f32x16{};asm volatile("":"+v"(negm));
  #define CMASK(P0,P1,t) mk.apply(P0,P1,(t),hi)
  bool resc=false;
  #define START(P0,P1) do{ const float rm=rowmax(P0,P1); resc=false; \
    { const float dl=rm; mhat=fadd_s(mhat,dl); \
      _Pragma("unroll") for(int r=0;r<16;++r){P0[r]=fsub_s(P0[r],dl);P1[r]=fsub_s(P1[r],dl);} \
      _Pragma("unroll") for(int r=0;r<16;++r)negm[r]=-mhat; asm volatile("":"+v"(negm)); } \
    _Pragma("unroll") for(int r=0;r<16;++r)P0[r]=__builtin_amdgcn_exp2f(P0[r]); }while(0)
  #define RESC() do{ if(resc){ asm volatile("s_waitcnt lgkmcnt(0)":::"memory"); \
      _Pragma("unroll") for(int d_=0;d_<2;++d_) _Pragma("unroll") for(int r=0;r<16;++r)o[d_][r]*=wsf[crow(r,hi)]; } }while(0)
  f32x16 pA0,pA1,pB0,pB1;
  int sl_prev=0,sl_cur=0,sl_next=SLOTB;
  #define ROT() do{sl_prev=sl_cur;sl_cur=sl_next;sl_next=(sl_next==(NSLOT-1)*SLOTB)?0:sl_next+SLOTB;}while(0)
  DMA_K(2,2*SLOTB);
  WAIT_BAR(3);
  qkt(pA0,pA1,Kbase,qr,negm,r32,hi);asm volatile("s_nop 15\n\ts_nop 7":"+v"(pA0),"+v"(pA1));CMASK(pA0,pA1,0);
  START(pA0,pA1);
  _Pragma("unroll") for(int r=0;r<16;++r)pA1[r]=__builtin_amdgcn_exp2f(pA1[r]);
  WAIT_BAR(0);
  DMA_K(3,0);DMA_V(1,SLOTB);
  ROT();
  kload8(kf,kp0+sl_cur);
  WAIT_BAR(2);
  s16x4 vlo[8],vhi[8]; u32x4 pw0,pw1,pw2,pw3;
  #define PKW(P,B) cvtpk_s(P[B],P[B+1])
  #define PAF(k) __builtin_bit_cast(bf16x8,pw##k)
  #define VFR(i) (bf16x8){vlo[i][0],vlo[i][1],vlo[i][2],vlo[i][3],vhi[i][0],vhi[i][1],vhi[i][2],vhi[i][3]}
  #define PIN(x) asm volatile("":"+v"(x))
  #define MX3(a,b,c) __builtin_fmaxf(__builtin_fmaxf((a),(b)),(c))
  #define GAPA(MF,A0,A1,A2,A3,W0,W1,PW) do{ MF; sacc+=A0; sacc+=A1; sacc+=A2; sacc+=A3; PIN(sacc); W0; W1; PIN(PW); SBAR(); }while(0)
  #define EX(v) __builtin_amdgcn_exp2f(v)
  #define GAPB(MF,X,B) do{ MF; X[B]=EX(X[B]); X[B+1]=EX(X[B+1]); X[B+2]=EX(X[B+2]); X[B+3]=EX(X[B+3]); PIN(X); SBAR(); }while(0)
  #define VRD(i) do{ vlo[i]=vtr(vp_+(((i)>>2)*4096+((i)&3)*1024)); vhi[i]=vtr(vp_+(((i)>>2)*4096+((i)&3)*1024+512)); }while(0)
  #define KRD(G,j) do{ if(G){ kload2(kf,kp0+sl_next,j); SBAR(); } }while(0)
  #define STEP(C0,C1,P0,P1,t,GK,GV,GL) do{ SBAR(); \
    const lds_cptr vp_=vp0+sl_prev; \
    VRD(0); SBAR(); float sacc=(P0[0]+P0[1]); \
    GAPA(C0=__builtin_amdgcn_mfma_f32_32x32x16_bf16(kf[0],qr[0],negm,0,0,0), P0[2],P0[3],P0[4],P0[5],     pw0[0]=PKW(P0,0), pw0[1]=PKW(P0,2), pw0); \
    VRD(4); SBAR(); GAPA(C1=__builtin_amdgcn_mfma_f32_32x32x16_bf16(kf[1],qr[0],negm,0,0,0), P0[6],P0[7],P0[8],P0[9],     pw0[2]=PKW(P0,4), pw0[3]=PKW(P0,6), pw0); \
    VRD(1); SBAR(); GAPA(C0=__builtin_amdgcn_mfma_f32_32x32x16_bf16(kf[2],qr[1],C0,0,0,0),   P0[10],P0[11],P0[12],P0[13], pw1[0]=PKW(P0,8), pw1[1]=PKW(P0,10), pw1); \
    VRD(5); SBAR(); GAPA(C1=__builtin_amdgcn_mfma_f32_32x32x16_bf16(kf[3],qr[1],C1,0,0,0),   P0[14],P0[15],P1[0],P1[1],   pw1[2]=PKW(P0,12),pw1[3]=PKW(P0,14), pw1); \
    VRD(2); SBAR(); GAPA(C0=__builtin_amdgcn_mfma_f32_32x32x16_bf16(kf[4],qr[2],C0,0,0,0),   P1[2],P1[3],P1[4],P1[5],     pw2[0]=PKW(P1,0), pw2[1]=PKW(P1,2), pw2); \
    VRD(6); SBAR(); GAPA(C1=__builtin_amdgcn_mfma_f32_32x32x16_bf16(kf[5],qr[2],C1,0,0,0),   P1[6],P1[7],P1[8],P1[9],     pw2[2]=PKW(P1,4), pw2[3]=PKW(P1,6), pw2); \
    VRD(3); SBAR(); GAPA(C0=__builtin_amdgcn_mfma_f32_32x32x16_bf16(kf[6],qr[3],C0,0,0,0),   P1[10],P1[11],P1[12],P1[13], pw3[0]=PKW(P1,8), pw3[1]=PKW(P1,10), pw3); \
    VRD(7); SBAR(); GAPA(C1=__builtin_amdgcn_mfma_f32_32x32x16_bf16(kf[7],qr[3],C1,0,0,0),   P1[14],P1[15],0.f,0.f,       pw3[2]=PKW(P1,12),pw3[3]=PKW(P1,14), pw3); \
    l_reg+=sacc; \
    if(GK){DMA_K((t)+3,sl_cur);} if(GV){DMA_V((t)+1,sl_next);} \
    CMASK(C0,C1,t); \
    { float a=MX3(C0[0],C0[1],C1[0]),b=MX3(C0[2],C0[3],C1[1]); a=MX3(a,C1[2],C1[3]); \
      _Pragma("unroll") for(int r=4;r<16;r+=4){a=MX3(a,C0[r],C0[r+1]);b=MX3(b,C0[r+2],C0[r+3]);a=MX3(a,C1[r],C1[r+1]);b=MX3(b,C1[r+2],C1[r+3]);} \
      float rm=__builtin_fmaxf(a,b); { auto rr=__builtin_amdgcn_permlane32_swap(__float_as_uint(rm),__float_as_uint(rm),false,false); rm=__builtin_fmaxf(__uint_as_float(rr[0]),__uint_as_float(rr[1])); } \
      resc=false; \
      if(__builtin_expect(__any(rm>(float)THRL),0)){ const float dl=__builtin_fmaxf(rm,0.f); mhat+=dl; \
        _Pragma("unroll") for(int r=0;r<16;++r){C0[r]-=dl;C1[r]-=dl;} \
        _Pragma("unroll") for(int r=0;r<16;++r)negm[r]=-mhat; asm volatile("":"+v"(negm)); \
        const float f=__builtin_amdgcn_exp2f(-dl); l_reg*=f; if(hi==0)wsf[r32]=f; resc=true; } } \
    SBAR(); \
    GAPB(o[0]=__builtin_amdgcn_mfma_f32_32x32x16_bf16(PAF(0),VFR(0),o[0],0,0,0), C0,0); \
    GAPB(o[1]=__builtin_amdgcn_mfma_f32_32x32x16_bf16(PAF(0),VFR(4),o[1],0,0,0), C0,4); \
    KRD(GL,0); GAPB(o[0]=__builtin_amdgcn_mfma_f32_32x32x16_bf16(PAF(1),VFR(1),o[0],0,0,0), C0,8); \
    KRD(GL,1); GAPB(o[1]=__builtin_amdgcn_mfma_f32_32x32x16_bf16(PAF(1),VFR(5),o[1],0,0,0), C0,12); \
    KRD(GL,2); GAPB(o[0]=__builtin_amdgcn_mfma_f32_32x32x16_bf16(PAF(2),VFR(2),o[0],0,0,0), C1,0); \
    KRD(GL,3); GAPB(o[1]=__builtin_amdgcn_mfma_f32_32x32x16_bf16(PAF(2),VFR(6),o[1],0,0,0), C1,4); \
    GAPB(o[0]=__builtin_amdgcn_mfma_f32_32x32x16_bf16(PAF(3),VFR(3),o[0],0,0,0), C1,8); \
    GAPB(o[1]=__builtin_amdgcn_mfma_f32_32x32x16_bf16(PAF(3),VFR(7),o[1],0,0,0), C1,12); \
    }while(0)
  int t=1;
  #undef CMASK
  #define CMASK(P0,P1,t) mk.apply(P0,P1,(t),hi)
  for(;t+5<NT;t+=2){
    STEP(pB0,pB1,pA0,pA1,t,true,true,true);     WAIT_BAR(2); RESC(); ROT();
    STEP(pA0,pA1,pB0,pB1,t+1,true,true,true);   WAIT_BAR(2); RESC(); ROT();
  }
  #undef CMASK
  #define CMASK(P0,P1,t) mk.apply(P0,P1,(t),hi)
  #define ENDW(tt) do{ if((tt)+3<NT){WAIT_BAR(2);} else if((tt)+2<NT){WAIT_BAR(1);} else {WAIT_BAR(0);} }while(0)
  for(;t+1<NT;t+=2){
    STEP(pB0,pB1,pA0,pA1,t,(t+3<NT),(t+1<NT),(t+1<NT));       ENDW(t);   RESC(); ROT();
    STEP(pA0,pA1,pB0,pB1,t+1,(t+4<NT),(t+2<NT),(t+2<NT));     ENDW(t+1); RESC(); ROT();
  }
  STEP(pB0,pB1,pA0,pA1,NT-1,false,false,false); RESC();
  { float sacc=pB0[0]+pB0[1]; _Pragma("unroll") for(int r=2;r<16;++r)sacc+=pB0[r]; _Pragma("unroll") for(int r=0;r<16;++r)sacc+=pB1[r]; l_reg+=sacc;
    pw0=(u32x4){PKW(pB0,0),PKW(pB0,2),PKW(pB0,4),PKW(pB0,6)};pw1=(u32x4){PKW(pB0,8),PKW(pB0,10),PKW(pB0,12),PKW(pB0,14)};pw2=(u32x4){PKW(pB1,0),PKW(pB1,2),PKW(pB1,4),PKW(pB1,6)};pw3=(u32x4){PKW(pB1,8),PKW(pB1,10),PKW(pB1,12),PKW(pB1,14)};
    SBAR(); pv(o,vb0+sl_cur,PAF(0),PAF(1),PAF(2),PAF(3)); }
  #undef PKW
  #undef PAF
  #undef VFR
  #undef PIN
  #undef MX3
  #undef GAPA
  #undef GAPB
  #undef EX
  #undef VRD
  #undef KRD
  #undef STEP
  #undef ENDW
  {auto rr=__builtin_amdgcn_permlane32_swap(__float_as_uint(l_reg),__float_as_uint(l_reg),false,false);l_reg=__uint_as_float(rr[0])+__uint_as_float(rr[1]);}
  if(hi==0)wsf[32+r32]=l_reg;asm volatile("s_waitcnt lgkmcnt(0)":::"memory");
  float rli[16];
  #pragma unroll
  for(int r=0;r<16;++r)rli[r]=__builtin_amdgcn_rcpf(wsf[32+crow(r,hi)]);
  bf16*Ow=u.Op+(long)(u.qrow0+wid*QBLK)*OPITCH;
  { bf16*stg=(bf16*)(shm+LDS_OST)+wid*2048;
    #pragma unroll
    for(int r=0;r<16;++r){const int orow=crow(r,hi);
      #pragma unroll
      for(int d0=0;d0<2;++d0)stg[orow*64+d0*32+r32]=__float2bfloat16(o[d0][r]*rli[r]);}
    asm volatile("s_waitcnt lgkmcnt(0)":::"memory");
    #pragma unroll
    for(int i=0;i<4;++i){const int row=i*8+(lane>>3),ch=lane&7; const u32x4 v=*(const u32x4*)(stg+row*64+ch*8); ATTN_STORE16(Ow+(long)row*OPITCH+ch*8,v);} }
  asm volatile("s_waitcnt lgkmcnt(0)\n\ts_barrier":::"memory");
  #undef DMA_K
  #undef TROW
  #undef DMA_V
  #undef CMASK
  #undef START
  #undef RESC
  #undef ROT
}
constexpr int ATTN_LDS_BYTES=LDS_BYTES;
#undef SBAR
#undef WAIT_BAR
}

struct Params { const float* in[26]; float* out; unsigned char* ws; int ph_lo, ph_hi; };
struct Ctx { LAS unsigned char* lds; int tid, lane, wave, vcu, G, gw, NGW; };
enum { I_X = 0, I_C, I_CTX, I_CCTX, I_ADAW, I_ADAB, I_LNG, I_LNB, I_W0IN, I_W0OUT, I_LQ1, I_LK1, I_LQ2, I_LK2, I_SUBLN, I_QN, I_KN,
       I_W1IN, I_W1OUT, I_RPB, I_POOLW, I_POOLS, I_ROUTER, I_WG, I_WU, I_WD };

__device__ __forceinline__ const float* mod_row(const Params& p, int layer, int row) {
    return (const float*)(p.ws + WS_MOD) + (size_t)(layer * 9 + (row < LAT ? (row >> 11) : 8)) * 6144;
}

__device__ __forceinline__ void ph_prologue(const Params& p, const Ctx& c) {
    const float* cin = p.in[I_C]; const float* cctx = p.in[I_CCTX]; const float* ada_w = p.in[I_ADAW]; const float* ada_b = p.in[I_ADAB];
    float* MOD = (float*)(p.ws + WS_MOD);
    LAS float* sc = (LAS float*)c.lds;
    LAS float* red = sc + 9 * 1024;
    for (int i = c.tid; i < 9 * 1024; i += 512) { const float v = i < 8192 ? cin[i] : cctx[i - 8192]; sc[i] = v / (1.f + expf(-v)); }
    __syncthreads();
    for (int u = c.vcu; u < 256; u += c.G) {
        const int layer = u >> 7, j0 = (u & 127) * 48;
        const int jc = c.tid % 48, kg = c.tid / 48;
        if (kg < 10) {
            float acc[9];
#pragma unroll
            for (int m = 0; m < 9; ++m) acc[m] = 0.f;
            const float* wp = ada_w + (size_t)layer * 1024 * 6144 + j0 + jc;
#pragma unroll 8
            for (int k = kg; k < 1024; k += 10) {
                const float w = wp[(size_t)k * 6144];
#pragma unroll
                for (int m = 0; m < 9; ++m) acc[m] += sc[m * 1024 + k] * w;
            }
#pragma unroll
            for (int m = 0; m < 9; ++m) red[(kg * 9 + m) * 48 + jc] = acc[m];
        }
        __syncthreads();
        if (c.tid < 432) {
            const int m = c.tid / 48, j = c.tid % 48; float s = 0.f;
#pragma unroll
            for (int g = 0; g < 10; ++g) s += red[(g * 9 + m) * 48 + j];
            MOD[(size_t)(layer * 9 + m) * 6144 + j0 + j] = s + ada_b[layer * 6144 + j0 + j];
        }
        __syncthreads();
    }
    if (c.vcu == 0) {
        f32x2* R = (f32x2*)(p.ws + WS_ROPE);
        for (int i = c.tid; i < 1024; i += 512) {
            const int pos = i >> 4, f = i & 15;
            const float inv = exp2f(-(float)f * (13.287712379549449f / 16.f));
            const float a = (float)pos * inv;
            const float k = rintf(a * 0.15915494309189535f);
            float rr = fmaf(-k, 6.28125f, a); rr = fmaf(-k, 1.9353071795864769e-3f, rr);
            R[i] = (f32x2){__cosf(rr), __sinf(rr)};
        }
    }
}


__device__ __forceinline__ void transpose_item(const float* W, int ldw, int k0, int n0, bf16* WT, int Kd, int drow0, LAS float* scr, int lane) {
#pragma unroll 8
    for (int i = 0; i < 32; ++i) { const int kk = 2 * i + (lane >> 5); scr[kk * 33 + (lane & 31)] = W[(size_t)(k0 + kk) * ldw + n0 + (lane & 31)]; }
    asm volatile("s_waitcnt lgkmcnt(0)" ::: "memory");
    const int ch = lane & 7;
#pragma unroll
    for (int j = 0; j < 4; ++j) { const int n = (lane >> 3) + 8 * j; const LAS float* sp = scr + (8 * ch) * 33 + n;
        v4u o; o.x = pk2(sp[0 * 33], sp[1 * 33]); o.y = pk2(sp[2 * 33], sp[3 * 33]); o.z = pk2(sp[4 * 33], sp[5 * 33]); o.w = pk2(sp[6 * 33], sp[7 * 33]);
        *(v4u*)(WT + (size_t)(drow0 + n) * Kd + k0 + 8 * ch) = o; }
    asm volatile("s_waitcnt lgkmcnt(0)" ::: "memory");
}
__device__ __forceinline__ void transpose_item8(const float* W, int ldw, int k0, int n0, unsigned char* WT8, int Kd, int drow0, float scale, LAS float* scr, int lane) {
#pragma unroll 8
    for (int i = 0; i < 32; ++i) { const int kk = 2 * i + (lane >> 5); scr[kk * 33 + (lane & 31)] = W[(size_t)(k0 + kk) * ldw + n0 + (lane & 31)]; }
    asm volatile("s_waitcnt lgkmcnt(0)" ::: "memory");
    const int n = lane >> 1, hf = lane & 1; const LAS float* sp = scr + (32 * hf) * 33 + n;
    v4u o0, o1;
    o0.x = pg8::pk4_fp8(sp[0 * 33] * scale, sp[1 * 33] * scale, sp[2 * 33] * scale, sp[3 * 33] * scale);     o0.y = pg8::pk4_fp8(sp[4 * 33] * scale, sp[5 * 33] * scale, sp[6 * 33] * scale, sp[7 * 33] * scale);
    o0.z = pg8::pk4_fp8(sp[8 * 33] * scale, sp[9 * 33] * scale, sp[10 * 33] * scale, sp[11 * 33] * scale);   o0.w = pg8::pk4_fp8(sp[12 * 33] * scale, sp[13 * 33] * scale, sp[14 * 33] * scale, sp[15 * 33] * scale);
    o1.x = pg8::pk4_fp8(sp[16 * 33] * scale, sp[17 * 33] * scale, sp[18 * 33] * scale, sp[19 * 33] * scale); o1.y = pg8::pk4_fp8(sp[20 * 33] * scale, sp[21 * 33] * scale, sp[22 * 33] * scale, sp[23 * 33] * scale);
    o1.z = pg8::pk4_fp8(sp[24 * 33] * scale, sp[25 * 33] * scale, sp[26 * 33] * scale, sp[27 * 33] * scale); o1.w = pg8::pk4_fp8(sp[28 * 33] * scale, sp[29 * 33] * scale, sp[30 * 33] * scale, sp[31 * 33] * scale);
    unsigned char* dst = WT8 + (size_t)(drow0 + n) * Kd + k0 + 32 * hf;
    *(v4u*)dst = o0; *(v4u*)(dst + 16) = o1;
    asm volatile("s_waitcnt lgkmcnt(0)" ::: "memory");
}
struct TBlk { const float* src; unsigned char* dst; int ldw, Kd; float scale; };
__device__ __forceinline__ TBlk tblk_decode(const Params& p, int blk) {
    const int ie = blk / 1536, q = blk - ie * 1536, layer = ie >> 4, e = ie & 15, which = q >> 9, idx = q & 511;
    TBlk t;
    if (which < 2) { const int nb = idx & 63, kb2 = idx >> 6, k0 = 128 * kb2, n0 = 32 * nb;
        t.src = (which == 0 ? p.in[I_WG] : p.in[I_WU]) + (size_t)ie * DM * FF + (size_t)k0 * FF + n0; t.ldw = FF; t.Kd = DM; t.scale = W8_GU;
        t.dst = p.ws + WS_WGU + (size_t)layer * WS_MOE_LSTRIDE + (size_t)e * 4096 * DM + (size_t)((n0 >> 7) * 256 + (n0 & 127) + which * 128) * DM + k0; }
    else { const int nb = idx & 31, kb2 = idx >> 5, k0 = 128 * kb2, n0 = 32 * nb;
        t.src = p.in[I_WD] + (size_t)ie * FF * DM + (size_t)k0 * DM + n0; t.ldw = DM; t.Kd = FF; t.scale = W8_DN;
        t.dst = p.ws + WS_WDN + (size_t)layer * WS_MOE_LSTRIDE + (size_t)e * DM * FF + (size_t)n0 * FF + k0; }
    return t;
}
__device__ __forceinline__ void tblk_load(const TBlk& t, f32x4 (&v)[16], int lane) {
    const float* sp = t.src + (size_t)(lane >> 3) * t.ldw + 4 * (lane & 7);
#pragma unroll
    for (int i = 0; i < 16; ++i) v[i] = *(const f32x4*)(sp + (size_t)(8 * i) * t.ldw);
}
__device__ __forceinline__ void tblk_store(const TBlk& t, const f32x4 (&v)[16], LAS float* scr, int lane) {
#pragma unroll
    for (int h = 0; h < 2; ++h) {
#pragma unroll
        for (int i = 0; i < 8; ++i) { LAS float* d = scr + (8 * i + (lane >> 3)) * 33 + 4 * (lane & 7); const f32x4 x = v[8 * h + i] * t.scale; d[0] = x.x; d[1] = x.y; d[2] = x.z; d[3] = x.w; }
        asm volatile("s_waitcnt lgkmcnt(0)" ::: "memory");
        const int n = lane >> 1, hf = lane & 1; const LAS float* sp = scr + (32 * hf) * 33 + n;
        v4u o0, o1;
        o0.x = pg8::pk4_fp8(sp[0 * 33], sp[1 * 33], sp[2 * 33], sp[3 * 33]);     o0.y = pg8::pk4_fp8(sp[4 * 33], sp[5 * 33], sp[6 * 33], sp[7 * 33]);
        o0.z = pg8::pk4_fp8(sp[8 * 33], sp[9 * 33], sp[10 * 33], sp[11 * 33]);   o0.w = pg8::pk4_fp8(sp[12 * 33], sp[13 * 33], sp[14 * 33], sp[15 * 33]);
        o1.x = pg8::pk4_fp8(sp[16 * 33], sp[17 * 33], sp[18 * 33], sp[19 * 33]); o1.y = pg8::pk4_fp8(sp[20 * 33], sp[21 * 33], sp[22 * 33], sp[23 * 33]);
        o1.z = pg8::pk4_fp8(sp[24 * 33], sp[25 * 33], sp[26 * 33], sp[27 * 33]); o1.w = pg8::pk4_fp8(sp[28 * 33], sp[29 * 33], sp[30 * 33], sp[31 * 33]);
        unsigned char* dst = t.dst + (size_t)n * t.Kd + 64 * h + 32 * hf;
        *(v4u*)dst = o0; *(v4u*)(dst + 16) = o1;
        asm volatile("s_waitcnt lgkmcnt(0)" ::: "memory");
    }
}
__device__ __forceinline__ void ph_transposes(const Params& p, const Ctx& c) {
    LAS float* scr = (LAS float*)(c.lds + c.wave * 16384);
    constexpr int I0 = 16 * 72, I1 = 16 * 32, I2 = 16 * 64, I3 = 16 * 32, ISM = I0 + I1 + I2 + I3;
    for (int r0 = c.gw; r0 < ISM; r0 += c.NGW) {
        int r = r0;
        if (r < I0) { transpose_item(p.in[I_W0IN], EIN, 64 * (r / 72), 32 * (r % 72), (bf16*)(p.ws + WS_W0IN), DM, 32 * (r % 72), scr, c.lane); continue; } r -= I0;
        if (r < I1) { transpose_item(p.in[I_W0OUT], DM, 64 * (r / 32), 32 * (r % 32), (bf16*)(p.ws + WS_W0OUT), DM, 32 * (r % 32), scr, c.lane); continue; } r -= I1;
        if (r < I2) { transpose_item(p.in[I_W1IN], OIN, 64 * (r / 64), 32 * (r % 64), (bf16*)(p.ws + WS_W1IN), DM, 32 * (r % 64), scr, c.lane); continue; } r -= I2;
        transpose_item(p.in[I_W1OUT], DM, 64 * (r / 32), 32 * (r % 32), (bf16*)(p.ws + WS_W1OUT), DM, 32 * (r % 32), scr, c.lane);
    }
    static_assert(MOE_FP8, "the pipelined expert-weight transposes write e4m3 copies");
    constexpr int NBLK = 32 * 1536;
    f32x4 va[16], vb[16];
    int blk = c.gw;
    TBlk ta = tblk_decode(p, blk < NBLK ? blk : 0), tb;
    if (blk < NBLK) tblk_load(ta, va, c.lane);
    for (; blk < NBLK; blk += 2 * c.NGW) {
        const int b1 = blk + c.NGW, b2 = blk + 2 * c.NGW;
        if (b1 < NBLK) { tb = tblk_decode(p, b1); tblk_load(tb, vb, c.lane); }
        tblk_store(ta, va, scr, c.lane);
        if (b1 < NBLK) {
            if (b2 < NBLK) { ta = tblk_decode(p, b2); tblk_load(ta, va, c.lane); }
            tblk_store(tb, vb, scr, c.lane);
        }
    }
}

__device__ __forceinline__ void ph_modulate0(const Params& p, const Ctx& c) {
    bf16* HB = (bf16*)(p.ws + WS_HB);
    for (int row = c.gw; row < NTOK; row += c.NGW) {
        const float* src = row < LAT ? p.in[I_X] + (size_t)row * DM : p.in[I_CTX] + (size_t)(row - LAT) * DM;
        const float* mod = mod_row(p, 0, row);
#pragma unroll
        for (int j = 0; j < 4; ++j) {
            const int col = 4 * c.lane + 256 * j;
            const f32x4 v = *(const f32x4*)(src + col), sh = *(const f32x4*)(mod + col), s = *(const f32x4*)(mod + 1024 + col);
            const f32x4 h = v * (s + 1.f) + sh;
            *(v2u*)(HB + (size_t)row * DM + col) = (v2u){pk2(h.x, h.y), pk2(h.z, h.w)};
        }
    }
}

struct NG { const bf16* A; int lda; const float* W0; const float* W1; int ldw; size_t wstride; int Mb; int row_begin, row_end, col_begin, col_end, K; };
template <int NB, class Epi>
__device__ __forceinline__ void ngemm(const NG& g, const Ctx& c, const Epi& epi) {
    const int nmt = (g.row_end - g.row_begin) / 32, nnt = (g.col_end - g.col_begin) / 32;
    const int l31 = c.lane & 31, lh = c.lane >> 5;
    for (int t = c.gw; t < nmt * nnt; t += c.NGW) {
        const int mt = t / nnt, nt = t % nnt;
        const int row0 = g.row_begin + mt * 32, col0 = g.col_begin + nt * 32;
        const int e = row0 / g.Mb;
        const bf16* ap = g.A + (size_t)(row0 + l31) * g.lda + lh;
        const float* bp0 = g.W0 + (size_t)e * g.wstride + (size_t)lh * g.ldw + col0 + l31;
        const float* bp1 = NB == 2 ? g.W1 + (size_t)e * g.wstride + (size_t)lh * g.ldw + col0 + l31 : nullptr;
        f32x16 acc0 = {}, acc1 = {};
#pragma unroll 8
        for (int k = 0; k < g.K; k += 2) {
            const float a = bf2f((unsigned)ap[k]);
            const float b0 = bp0[(size_t)k * g.ldw];
            acc0 = __builtin_amdgcn_mfma_f32_32x32x2f32(a, b0, acc0, 0, 0, 0);
            if (NB == 2) { const float b1 = bp1[(size_t)k * g.ldw]; acc1 = __builtin_amdgcn_mfma_f32_32x32x2f32(a, b1, acc1, 0, 0, 0); }
        }
#pragma unroll
        for (int r = 0; r < 16; ++r) {
            const int row = row0 + (r & 3) + 8 * (r >> 2) + 4 * lh, col = col0 + l31;
            epi(row, col, acc0[r], acc1[r]);
        }
    }
}
struct EpiF32 { float* O; int ldc; __device__ __forceinline__ void operator()(int row, int col, float v0, float) const { O[(size_t)row * ldc + col] = v0; } };
struct EpiBf { bf16* O; int ldc; int scale_cols; float sc; __device__ __forceinline__ void operator()(int row, int col, float v0, float) const { O[(size_t)row * ldc + col] = (bf16)f2bf(col < scale_cols ? v0 * sc : v0); } };
struct EpiSwiglu { bf16* O; __device__ __forceinline__ void operator()(int row, int col, float g, float u) const { const float s = g / (1.f + __expf(-g)); O[(size_t)row * FF + col] = (bf16)f2bf(s * u); } };
struct EpiGate { bf16* O; const float* gate; __device__ __forceinline__ void operator()(int row, int col, float v0, float) const { O[(size_t)row * DM + col] = (bf16)f2bf(v0 * gate[row]); } };

template <bool F32IN> __device__ __forceinline__ void ph_qkv_post(const Params& p, const Ctx& c) {
    const float* PF = (const float*)(p.ws + WS_PF);
    bf16* QKV = (bf16*)(p.ws + WS_QKV);
    const f32x2* R = (const f32x2*)(p.ws + WS_ROPE);
    const float* qn = p.in[I_QN]; const float* kn = p.in[I_KN];
    const int d = c.lane;
    const float qg = qn[d], kg = kn[d];
    for (int row = c.gw; row < NTOK; row += c.NGW) {
        const bool lat = row < LAT;
        const int t = row & 2047;
        const int pos = (d < 32) ? (t >> 6) : (t & 63);
        const f32x2 cs = R[pos * 16 + (d & 15)];
        const bool first = (d & 16) == 0;
        float vv[36];
#pragma unroll
        for (int hs = 0; hs < 36; ++hs) vv[hs] = F32IN ? PF[(size_t)row * EIN + hs * 64 + d] : bf2f((unsigned)QKV[(size_t)row * EIN + hs * 64 + d]);
#pragma unroll
        for (int hs = 0; hs < 36; ++hs) {
            float v = vv[hs];
            const bool isq = hs < 8 || (hs >= 24 && hs < 32);
            const bool isk = (hs >= 8 && hs < 16) || hs == 32 || hs == 33;
            const bool nrm = hs >= 24 && hs < 34;
            if (nrm) { const float ss = wave_sum(v * v); v = v * rsqrtf(ss * (1.f / 64.f) + RMS_EPS) * (hs < 32 ? qg : kg); }
            if ((isq || isk) && lat) { const float pr = __shfl_xor(v, 16); v = first ? v * cs.x - pr * cs.y : v * cs.x + pr * cs.y; }
            if (isq) v *= C2;
            QKV[(size_t)row * EIN + hs * 64 + d] = (bf16)f2bf(v);
        }
    }
}

__device__ __forceinline__ void ph_attn0_naive(const Params& p, const Ctx& c) {
    const bf16* QKV = (const bf16*)(p.ws + WS_QKV);
    bf16* CC = (bf16*)(p.ws + WS_CC);
    bf16* AO = (bf16*)(p.ws + WS_AO);
    LAS float* Ks = (LAS float*)c.lds;
    LAS float* Vs = Ks + 4096;
    for (int u = c.vcu; u < 960; u += c.G) {
        const bool isctx = u >= 768;
        int b, vh, qrow, ntiles; bool active = true;
        if (!isctx) { b = u / 96; const int r = u % 96; vh = r >> 2; qrow = b * SEQ + (r & 3) * 512 + c.tid; ntiles = 36; }
        else { const int uu = u - 768; b = uu / 24; vh = uu % 24; qrow = LAT + b * NCTX + (c.tid & 255); active = c.tid < 256; ntiles = 4; }
        int qcol, kcol, vcol;
        if (vh < 16) { const int a = vh >> 2, s = (vh >> 1) & 1, half = vh & 1; qcol = a * 128 + s * 64; kcol = 512 + a * 128 + s * 64; vcol = 1024 + a * 128 + half * 64; }
        else { const int h = vh - 16; qcol = 1536 + h * 64; kcol = 2048 + (h >> 2) * 64; vcol = 2176 + (h >> 2) * 64; }
        float q[64], o[64];
#pragma unroll
        for (int i = 0; i < 8; ++i) { const v4u w = *(const v4u*)(QKV + (size_t)qrow * EIN + qcol + 8 * i); unpack8(w, q + 8 * i); }
#pragma unroll
        for (int i = 0; i < 64; ++i) o[i] = 0.f;
        float m = -1e30f, l = 0.f;
        for (int t = 0; t < ntiles; ++t) {
            const int krow0 = isctx ? LAT + b * NCTX + 64 * t : (t < 32 ? b * SEQ + 64 * t : LAT + b * NCTX + 64 * (t - 32));
            __syncthreads();
            { const int r = c.tid >> 3, ch = c.tid & 7; float f[8];
              const v4u kw = *(const v4u*)(QKV + (size_t)(krow0 + r) * EIN + kcol + ch * 8); unpack8(kw, f);
#pragma unroll
              for (int j = 0; j < 8; ++j) Ks[r * 64 + ch * 8 + j] = f[j];
              const v4u vw = *(const v4u*)(QKV + (size_t)(krow0 + r) * EIN + vcol + ch * 8); unpack8(vw, f);
#pragma unroll
              for (int j = 0; j < 8; ++j) Vs[r * 64 + ch * 8 + j] = f[j]; }
            __syncthreads();
            if (active) {
                for (int kk = 0; kk < 64; ++kk) {
                    float s = 0.f;
#pragma unroll
                    for (int dd = 0; dd < 64; ++dd) s += q[dd] * Ks[kk * 64 + dd];
                    const float mn = fmaxf(m, s), al = exp2f(m - mn), pp = exp2f(s - mn);
                    l = l * al + pp; m = mn;
#pragma unroll
                    for (int dd = 0; dd < 64; ++dd) o[dd] = o[dd] * al + pp * Vs[kk * 64 + dd];
                }
            }
        }
        if (active) {
            const float rl = 1.f / l;
            bf16* dst = vh < 16 ? AO + (size_t)qrow * DM + (vh >> 2) * 256 + ((vh >> 1) & 1) * 128 + (vh & 1) * 64 : CC + (size_t)qrow * DM + 512 + (vh - 16) * 64;
            {
#pragma unroll
                for (int i = 0; i < 8; ++i) *(v4u*)(dst + 8 * i) = (v4u){pk2(o[8 * i] * rl, o[8 * i + 1] * rl), pk2(o[8 * i + 2] * rl, o[8 * i + 3] * rl), pk2(o[8 * i + 4] * rl, o[8 * i + 5] * rl), pk2(o[8 * i + 6] * rl, o[8 * i + 7] * rl)}; }
        }
    }
}


__device__ __forceinline__ void attn_combine_rows(const Params& p, const Ctx& c, int row0, int a, float lam, float g0, float g1) {
    const bf16* AO = (const bf16*)(p.ws + WS_AO); bf16* CC = (bf16*)(p.ws + WS_CC);
    asm volatile("s_waitcnt vmcnt(0)" ::: "memory");
#pragma unroll 1
    for (int rb = 0; rb < 32; rb += 8) {
        float x0[8], x1[8];
#pragma unroll
        for (int j = 0; j < 8; ++j) { const bf16* src = AO + (size_t)(row0 + rb + j) * DM + a * 256;
            x0[j] = bf2f((unsigned)src[c.lane]) - lam * bf2f((unsigned)src[128 + c.lane]); x1[j] = bf2f((unsigned)src[64 + c.lane]) - lam * bf2f((unsigned)src[192 + c.lane]); }
#pragma unroll
        for (int j = 0; j < 8; ++j) { const float ss = wave_sum(x0[j] * x0[j] + x1[j] * x1[j]); const float r = rsqrtf(ss * (1.f / 128.f) + RMS_EPS);
            bf16* dst = CC + (size_t)(row0 + rb + j) * DM + a * 128;
            dst[c.lane] = (bf16)f2bf(x0[j] * r * g0); dst[64 + c.lane] = (bf16)f2bf(x1[j] * r * g1); }
    }
}
__device__ __forceinline__ void ph_attn0_fast(const Params& p, const Ctx& c, char* lds_generic) {
    typedef attn_body::bf16 abf;
    const abf* Q = (const abf*)(p.ws + WS_QKV); abf* CCb = (abf*)(p.ws + WS_CC); abf* AOb = (abf*)(p.ws + WS_AO);
    const float d1 = wave_sum(p.in[I_LQ1][c.lane] * p.in[I_LK1][c.lane]), d2 = wave_sum(p.in[I_LQ2][c.lane] * p.in[I_LK2][c.lane]);
    const float lam = expf(d1) - expf(d2) + LAM_INIT;
    const float g0 = p.in[I_SUBLN][c.lane] * (1.f - LAM_INIT), g1 = p.in[I_SUBLN][c.lane + 64] * (1.f - LAM_INIT);
    for (int v = c.vcu; v < 256; v += c.G) {
#pragma unroll 1
        for (int step = 0; step < 10; ++step) {
            attn_body::AU u; int vh; bool ctxu = false;
            if (step < 4) { const int b = v >> 5, a = (v >> 3) & 3; vh = 4 * a + step; u.qrow0 = b * SEQ + (v & 7) * 256; u.lat_row0 = b * SEQ; u.ctx_row0 = LAT + b * NCTX; }
            else if (step < 6) { const int U = (step - 4) * 256 + v, b = U >> 6; vh = 16 + ((U >> 3) & 7); u.qrow0 = b * SEQ + (U & 7) * 256; u.lat_row0 = b * SEQ; u.ctx_row0 = LAT + b * NCTX; }
            else { ctxu = true; int b;
                if (v < 32) { b = v >> 2; vh = 4 * (v & 3) + (step - 6); }
                else if (v < 96 && step == 6) { b = (v - 32) >> 3; vh = 16 + ((v - 32) & 7); }
                else break;
                u.qrow0 = LAT + b * NCTX; u.lat_row0 = 0; u.ctx_row0 = LAT + b * NCTX; }
            if (!ctxu) { u.nlat_t = 32; u.NT = 36; } else { u.nlat_t = 0; u.NT = 4; }
            int qcol, kcol, vcol; abf* op;
            if (vh < 16) { const int a = vh >> 2, s = (vh >> 1) & 1, half = vh & 1; qcol = a * 128 + s * 64; kcol = 512 + a * 128 + s * 64; vcol = 1024 + a * 128 + half * 64; op = AOb + a * 256 + s * 128 + half * 64; }
            else { const int h = vh - 16; qcol = 1536 + h * 64; kcol = 2048 + (h >> 2) * 64; vcol = 2176 + (h >> 2) * 64; op = CCb + 512 + h * 64; }
            u.Qp = Q + qcol; u.Kp = Q + kcol; u.Vp = Q + vcol; u.Op = op;
            attn_body::attn_unit<8, EIN, attn_body::NoMask>(u, lds_generic, attn_body::NoMask{});
            if (vh < 16 && (vh & 3) == 3) attn_combine_rows(p, c, u.qrow0 + c.wave * 32, vh >> 2, lam, g0, g1);
        }
    }
}

__device__ __forceinline__ void ph_attn_combine(const Params& p, const Ctx& c) {
    const bf16* AO = (const bf16*)(p.ws + WS_AO);
    bf16* CC = (bf16*)(p.ws + WS_CC);
    const float d1 = wave_sum(p.in[I_LQ1][c.lane] * p.in[I_LK1][c.lane]);
    const float d2 = wave_sum(p.in[I_LQ2][c.lane] * p.in[I_LK2][c.lane]);
    const float lam = expf(d1) - expf(d2) + LAM_INIT;
    const float g0 = p.in[I_SUBLN][c.lane] * (1.f - LAM_INIT), g1 = p.in[I_SUBLN][c.lane + 64] * (1.f - LAM_INIT);
    for (int it = c.gw; it < NTOK * 4; it += c.NGW) {
        const int row = it >> 2, a = it & 3;
        const bf16* src = AO + (size_t)row * DM + a * 256;
        const float x0 = bf2f((unsigned)src[c.lane]) - lam * bf2f((unsigned)src[128 + c.lane]), x1 = bf2f((unsigned)src[64 + c.lane]) - lam * bf2f((unsigned)src[192 + c.lane]);
        const float ss = wave_sum(x0 * x0 + x1 * x1);
        const float r = rsqrtf(ss * (1.f / 128.f) + RMS_EPS);
        CC[(size_t)row * DM + a * 128 + c.lane] = (bf16)f2bf(x0 * r * g0);
        CC[(size_t)row * DM + a * 128 + 64 + c.lane] = (bf16)f2bf(x1 * r * g1);
    }
}

__device__ __forceinline__ void ph_ln1_router(const Params& p, const Ctx& c, int layer) {
    const float* Y = (const float*)(p.ws + WS_Y);
    float* XS = (float*)(p.ws + WS_XS);
    bf16* HB = (bf16*)(p.ws + WS_HB);
    float* AFF = (float*)(p.ws + WS_AFF);
    const float* lng = p.in[I_LNG] + (size_t)(layer * 2 + 0) * DM; const float* lnb = p.in[I_LNB] + (size_t)(layer * 2 + 0) * DM;
    const float* router = p.in[I_ROUTER] + (size_t)layer * DM * NE;
    LAS f32x4* R = (LAS f32x4*)c.lds;
    for (int idx = c.tid; idx < 4096; idx += 512) { const int e4 = idx & 3, k = idx >> 2, ln = (k & 255) >> 2, q = k & 3, j = k >> 8;
        R[((j * 4 + q) * 4 + e4) * 64 + ln] = *(const f32x4*)(router + (size_t)k * NE + 4 * e4); }
    __syncthreads();
    const int nrows = layer == 0 ? NTOK : LAT;
    const int lane = c.lane;
    for (int row = c.gw; row < nrows; row += c.NGW) {
        const float* xin = layer == 0 ? (row < LAT ? p.in[I_X] + (size_t)row * DM : p.in[I_CTX] + (size_t)(row - LAT) * DM) : XS + (size_t)row * DM;
        const float* mod = mod_row(p, layer, row);
        f32x4 v[4]; float s = 0.f;
#pragma unroll
        for (int j = 0; j < 4; ++j) { const int col = 4 * lane + 256 * j;
            v[j] = *(const f32x4*)(xin + col) * ALPHA + *(const f32x4*)(mod + 2048 + col) * *(const f32x4*)(Y + (size_t)row * DM + col);
            s += (v[j].x + v[j].y) + (v[j].z + v[j].w); }
        const float mean = wave_sum(s) * (1.f / DM); float s2 = 0.f;
#pragma unroll
        for (int j = 0; j < 4; ++j) { v[j] = v[j] - mean; s2 += (v[j].x * v[j].x + v[j].y * v[j].y) + (v[j].z * v[j].z + v[j].w * v[j].w); }
        const float rstd = 1.f / sqrtf(wave_sum(s2) * (1.f / DM) + LN_EPS);
        f32x4 lg[4];
#pragma unroll
        for (int e = 0; e < 4; ++e) lg[e] = (f32x4){0.f, 0.f, 0.f, 0.f};
#pragma unroll
        for (int j = 0; j < 4; ++j) { const int col = 4 * lane + 256 * j;
            const f32x4 x1 = v[j] * rstd * *(const f32x4*)(lng + col) + *(const f32x4*)(lnb + col);
            *(f32x4*)(XS + (size_t)row * DM + col) = x1;
            const f32x4 hm = x1 * (*(const f32x4*)(mod + 4096 + col) + 1.f) + *(const f32x4*)(mod + 3072 + col);
            if (MOE_FP8) *(unsigned*)((unsigned char*)HB + (size_t)row * DM + col) = pg8::pk4_fp8(hm.x, hm.y, hm.z, hm.w);
            else *(v2u*)(HB + (size_t)row * DM + col) = (v2u){pk2(hm.x, hm.y), pk2(hm.z, hm.w)};
            asm volatile("" ::: "memory");
#pragma unroll
            for (int q = 0; q < 4; ++q) { const float hv = hm[q];
#pragma unroll
                for (int e4 = 0; e4 < 4; ++e4) lg[e4] += R[((j * 4 + q) * 4 + e4) * 64 + lane] * hv; } }
        float w8[8], w4[4], w2[2], w1;
        { const bool hi = (lane & 32) != 0;
#pragma unroll
          for (int i = 0; i < 8; ++i) { const float a0 = lg[i >> 2][i & 3], a1 = lg[2 + (i >> 2)][i & 3]; const float keep = hi ? a1 : a0, send = hi ? a0 : a1; w8[i] = keep + __shfl_xor(send, 32); } }
        { const bool hi = (lane & 16) != 0;
#pragma unroll
          for (int i = 0; i < 4; ++i) { const float keep = hi ? w8[i + 4] : w8[i], send = hi ? w8[i] : w8[i + 4]; w4[i] = keep + __shfl_xor(send, 16); } }
        { const bool hi = (lane & 8) != 0;
#pragma unroll
          for (int i = 0; i < 2; ++i) { const float keep = hi ? w4[i + 2] : w4[i], send = hi ? w4[i] : w4[i + 2]; w2[i] = keep + __shfl_xor(send, 8); } }
        { const bool hi = (lane & 4) != 0; const float keep = hi ? w2[1] : w2[0], send = hi ? w2[0] : w2[1]; w1 = keep + __shfl_xor(send, 4); }
        w1 += __shfl_xor(w1, 2); w1 += __shfl_xor(w1, 1);
        float mx = w1;
#pragma unroll
        for (int o = 4; o < 64; o <<= 1) mx = fmaxf(mx, __shfl_xor(mx, o));
        const float ex = expf(w1 - mx); float den = ex;
#pragma unroll
        for (int o = 4; o < 64; o <<= 1) den += __shfl_xor(den, o);
        if ((lane & 3) == 0) { const int e = ((lane >> 5) & 1) * 8 + ((lane >> 4) & 1) * 4 + ((lane >> 3) & 1) * 2 + ((lane >> 2) & 1); AFF[(size_t)row * NE + e] = ex / den; }
    }
}

__device__ __forceinline__ void ph_topk(const Params& p, const Ctx& c, int layer) {
    const float* AFF = (const float*)(p.ws + WS_AFF);
    int* INV = (int*)(p.ws + WS_INV);
    float* GATE = (float*)(p.ws + WS_GATE);
    const bf16* HB = (const bf16*)(p.ws + WS_HB);
    bf16* XG = (bf16*)(p.ws + WS_XG);
    LAS unsigned* hist = (LAS unsigned*)c.lds;
    LAS unsigned* ctl = hist + 256;
    LAS int* sel = (LAS int*)(c.lds + 2048);
    const int MR = layer == 0 ? MR0 : MR1;
    const int ntasks = layer == 0 ? 256 : 128;
    const int lane = c.lane;
    for (int task = c.vcu; task < ntasks; task += c.G) {
        int set, e, n, cap, rowbase, slotbase;
        if (task < 128) { set = task >> 4; e = task & 15; n = SEQ; cap = 256; rowbase = set * SEQ; slotbase = set * 256; }
        else { const int t2 = task - 128; set = t2 >> 4; e = t2 & 15; n = NCTX; cap = 32; rowbase = LAT + set * NCTX; slotbase = 2048 + set * 32; }
        const bool valid = 4 * c.tid < n;
        unsigned key[4];
#pragma unroll
        for (int q = 0; q < 4; ++q) key[q] = valid ? __float_as_uint(AFF[(size_t)(rowbase + 4 * c.tid + q) * NE + e]) : 0u;
        unsigned prefix = 0u, need = (unsigned)cap;
#pragma unroll 1
        for (int pass = 0; pass < 4; ++pass) {
            const int shift = 24 - 8 * pass;
            if (c.tid < 256) hist[c.tid] = 0u;
            __syncthreads();
            if (valid) {
#pragma unroll
                for (int q = 0; q < 4; ++q) if (pass == 0 || (key[q] >> (shift + 8)) == (prefix >> (shift + 8))) __hip_atomic_fetch_add(&hist[(key[q] >> shift) & 255u], 1u, __ATOMIC_RELAXED, __HIP_MEMORY_SCOPE_WORKGROUP);
            }
            __syncthreads();
            if (c.wave == 0) {
                const unsigned h0 = hist[4 * lane], h1 = hist[4 * lane + 1], h2 = hist[4 * lane + 2], h3 = hist[4 * lane + 3];
                const unsigned tot = h0 + h1 + h2 + h3; unsigned sfx = tot;
#pragma unroll
                for (int o = 1; o < 64; o <<= 1) { const unsigned t = __shfl_down(sfx, o); if (lane + o < 64) sfx += t; }
                const unsigned above = sfx - tot, c3 = above + h3, c2 = c3 + h2, c1 = c2 + h1, c0 = c1 + h0;
                int d = -1; unsigned gtc = 0u;
                if (above < need && need <= c3) { d = 3; gtc = above; }
                else if (c3 < need && need <= c2) { d = 2; gtc = c3; }
                else if (c2 < need && need <= c1) { d = 1; gtc = c2; }
                else if (c1 < need && need <= c0) { d = 0; gtc = c1; }
                if (d >= 0) { ctl[0] = prefix | ((unsigned)(4 * lane + d) << shift); ctl[1] = need - gtc; }
            }
            __syncthreads();
            prefix = ctl[0]; need = ctl[1];
        }
        unsigned ngt = 0u, neq = 0u;
#pragma unroll
        for (int q = 0; q < 4; ++q) { ngt += (valid && key[q] > prefix) ? 1u : 0u; neq += (valid && key[q] == prefix) ? 1u : 0u; }
        const unsigned cnt = ngt | (neq << 16); unsigned inc = cnt;
#pragma unroll
        for (int o = 1; o < 64; o <<= 1) { const unsigned t = __shfl_up(inc, o); if (lane >= o) inc += t; }
        if (lane == 63) ctl[8 + c.wave] = inc;
        __syncthreads();
        unsigned base = 0u;
#pragma unroll
        for (int w = 0; w < 8; ++w) base += (w < c.wave) ? ctl[8 + w] : 0u;
        const unsigned ex = base + inc - cnt; unsigned gtb = ex & 0xffffu, eqb = ex >> 16;
        if (valid) {
#pragma unroll
            for (int q = 0; q < 4; ++q) { const int i = 4 * c.tid + q; int slot = -1;
                if (key[q] > prefix) { slot = (int)(gtb + (eqb < need ? eqb : need)); ++gtb; }
                else if (key[q] == prefix) { if (eqb < need) slot = (int)(gtb + eqb); ++eqb; }
                int gs = -1;
                if (slot >= 0) { gs = e * MR + slotbase + slot; sel[slot] = i; GATE[gs] = __uint_as_float(key[q]); }
                INV[(size_t)(rowbase + i) * NE + e] = gs; }
        }
        __syncthreads();
        for (int sidx = c.wave; sidx < cap; sidx += 8) {
            if (MOE_FP8) { const unsigned char* src = (const unsigned char*)HB + (size_t)(rowbase + sel[sidx]) * DM; unsigned char* dst = (unsigned char*)XG + (size_t)(e * MR + slotbase + sidx) * DM;
                *(v4u*)(dst + 16 * lane) = *(const v4u*)(src + 16 * lane); }
            else { const bf16* src = HB + (size_t)(rowbase + sel[sidx]) * DM; bf16* dst = XG + (size_t)(e * MR + slotbase + sidx) * DM;
            const v4u a0 = *(const v4u*)(src + 8 * lane), a1 = *(const v4u*)(src + 512 + 8 * lane);
            *(v4u*)(dst + 8 * lane) = a0; *(v4u*)(dst + 512 + 8 * lane) = a1; }
        }
        __syncthreads();
    }
}

__device__ __forceinline__ void ph_combine(const Params& p, const Ctx& c, int layer) {
    const bf16* YS = (const bf16*)(p.ws + WS_YS);
    const int* INV = (const int*)(p.ws + WS_INV);
    float* XS = (float*)(p.ws + WS_XS);
    bf16* HB = (bf16*)(p.ws + WS_HB);
    const float* lng = p.in[I_LNG] + (size_t)(layer * 2 + 1) * DM; const float* lnb = p.in[I_LNB] + (size_t)(layer * 2 + 1) * DM;
    const int nrows = layer == 0 ? NTOK : LAT;
    for (int row = c.gw; row < nrows; row += c.NGW) {
        const float* mod = mod_row(p, layer, row);
        f32x4 mo[4];
#pragma unroll
        for (int j = 0; j < 4; ++j) mo[j] = (f32x4){0.f, 0.f, 0.f, 0.f};
        const int inv = (c.lane < NE) ? INV[(size_t)row * NE + c.lane] : -1;
        unsigned long long msk = __ballot(inv >= 0);
        while (msk) {
            const int e = __builtin_ctzll(msk); msk &= msk - 1;
            const int sl = __builtin_amdgcn_readlane(inv, e);
#pragma unroll
            for (int j = 0; j < 4; ++j) { const v2u w = *(const v2u*)(YS + (size_t)sl * DM + 4 * c.lane + 256 * j);
                mo[j].x += bf2f(w.x & 0xffffu); mo[j].y += __uint_as_float(w.x & 0xffff0000u); mo[j].z += bf2f(w.y & 0xffffu); mo[j].w += __uint_as_float(w.y & 0xffff0000u); }
        }
        f32x4 v[4]; float s = 0.f;
#pragma unroll
        for (int j = 0; j < 4; ++j) { const int col = 4 * c.lane + 256 * j;
            v[j] = *(const f32x4*)(XS + (size_t)row * DM + col) * ALPHA + *(const f32x4*)(mod + 5120 + col) * mo[j];
            s += (v[j].x + v[j].y) + (v[j].z + v[j].w); }
        const float mean = wave_sum(s) * (1.f / DM); float s2 = 0.f;
#pragma unroll
        for (int j = 0; j < 4; ++j) { v[j] = v[j] - mean; s2 += (v[j].x * v[j].x + v[j].y * v[j].y) + (v[j].z * v[j].z + v[j].w * v[j].w); }
        const float rstd = 1.f / sqrtf(wave_sum(s2) * (1.f / DM) + LN_EPS);
        const float* modn = mod_row(p, 1, row);
#pragma unroll
        for (int j = 0; j < 4; ++j) { const int col = 4 * c.lane + 256 * j;
            const f32x4 x2 = v[j] * rstd * *(const f32x4*)(lng + col) + *(const f32x4*)(lnb + col);
            if (layer == 0) {
                *(f32x4*)(XS + (size_t)row * DM + col) = x2;
                const f32x4 h = x2 * (*(const f32x4*)(modn + 1024 + col) + 1.f) + *(const f32x4*)(modn + col);
                *(v2u*)(HB + (size_t)row * DM + col) = (v2u){pk2(h.x, h.y), pk2(h.z, h.w)};
            } else {
                *(f32x4*)(p.out + (size_t)row * DM + col) = x2;
            } }
    }
}

__device__ __forceinline__ void na_key(const float* q, float* o, float& m, float& l, const bf16* kp, const bf16* vp, float bias) {
    float s = bias;
#pragma unroll
    for (int i = 0; i < 8; ++i) { float f[8]; unpack8(*(const v4u*)(kp + 8 * i), f);
#pragma unroll
        for (int j = 0; j < 8; ++j) s += q[8 * i + j] * f[j]; }
    const float mn = fmaxf(m, s), al = exp2f(m - mn), pp = exp2f(s - mn);
    l = l * al + pp; m = mn;
#pragma unroll
    for (int i = 0; i < 8; ++i) { float f[8]; unpack8(*(const v4u*)(vp + 8 * i), f);
#pragma unroll
        for (int j = 0; j < 8; ++j) o[8 * i + j] = o[8 * i + j] * al + pp * f[j]; }
}
__device__ __forceinline__ void ph_mixer1_naive(const Params& p, const Ctx& c) {
    const bf16* P2 = (const bf16*)(p.ws + WS_QKV);
    bf16* CC = (bf16*)(p.ws + WS_CC);
    const float* rpb = p.in[I_RPB]; const float* pool_w = p.in[I_POOLW]; const float* pool_s = p.in[I_POOLS];
    LAS float* pl = (LAS float*)c.lds;
    for (int u = c.vcu; u < 256; u += c.G) {
        const int b = u >> 5, r = u & 31;
        {
            const int h = c.wave, col = c.lane, row = b * SEQ + r * 64 + col;
            const int rs = min(max(r - 4, 0), 24), cs = min(max(col - 8, 0), 48);
            float q[64], o[64];
#pragma unroll
            for (int i = 0; i < 8; ++i) unpack8(*(const v4u*)(P2 + (size_t)row * OIN + h * 64 + 8 * i), q + 8 * i);
#pragma unroll
            for (int i = 0; i < 64; ++i) o[i] = 0.f;
            float m = -1e30f, l = 0.f;
#pragma unroll 1
            for (int i = 0; i < 8; ++i)
#pragma unroll 1
                for (int j = 0; j < 16; ++j) {
                    const int krow = b * SEQ + (rs + i) * 64 + cs + j;
                    const float bias = rpb[(h * 15 + (rs + i - r + 7)) * 31 + (cs + j - col + 15)] * LOG2E;
                    na_key(q, o, m, l, P2 + (size_t)krow * OIN + 512 + h * 64, P2 + (size_t)krow * OIN + 1024 + h * 64, bias);
                }
#pragma unroll 1
            for (int j = 0; j < NCTX; ++j) {
                const int krow = LAT + b * NCTX + j;
                na_key(q, o, m, l, P2 + (size_t)krow * OIN + 512 + h * 64, P2 + (size_t)krow * OIN + 1024 + h * 64, 0.f);
            }
            const float rl = 1.f / l; bf16* dst = CC + (size_t)row * DM + h * 64;
#pragma unroll
            for (int i = 0; i < 8; ++i) *(v4u*)(dst + 8 * i) = (v4u){pk2(o[8 * i] * rl, o[8 * i + 1] * rl), pk2(o[8 * i + 2] * rl, o[8 * i + 3] * rl), pk2(o[8 * i + 4] * rl, o[8 * i + 5] * rl), pk2(o[8 * i + 6] * rl, o[8 * i + 7] * rl)};
        }
        __syncthreads();
        {
            const int ch = c.tid, g = ch >> 7, half = 1 << g;
            for (int tt = 0; tt < 64; ++tt) {
                const int t = r * 64 + tt, lo = max(t - half, 0), hi = min(t + half, SEQ);
                float s = 0.f;
                for (int t2 = lo; t2 < hi; ++t2) s += bf2f((unsigned)P2[(size_t)(b * SEQ + t2) * OIN + 1536 + ch]);
                pl[tt * 512 + ch] = s / (float)(hi - lo) - bf2f((unsigned)P2[(size_t)(b * SEQ + t) * OIN + 1536 + ch]);
            }
        }
        __syncthreads();
        {
            const int g = c.tid >> 7, e = c.tid & 127;
            const float ps = pool_s[g * 128 + e];
#pragma unroll 1
            for (int tb = 0; tb < 64; tb += 16) {
                float acc[16];
#pragma unroll
                for (int i = 0; i < 16; ++i) acc[i] = 0.f;
#pragma unroll 4
                for (int cc = 0; cc < 128; ++cc) {
                    const float w = pool_w[(size_t)(g * 128 + cc) * 128 + e];
#pragma unroll
                    for (int i = 0; i < 16; ++i) acc[i] += pl[(tb + i) * 512 + g * 128 + cc] * w;
                }
#pragma unroll
                for (int i = 0; i < 16; ++i) CC[(size_t)(b * SEQ + r * 64 + tb + i) * DM + 512 + g * 128 + e] = (bf16)f2bf(acc[i] * ps);
            }
        }
        __syncthreads();
    }
}


constexpr int NA_TAB_OFF = 86016 + 1024;
__device__ __forceinline__ void ph_mixer1_fast(const Params& p, const Ctx& c, char* lds_generic) {
    typedef attn_body::bf16 abf;
    const abf* P2a = (const abf*)(p.ws + WS_QKV); abf* CCa = (abf*)(p.ws + WS_CC);
    LAS float* tab = (LAS float*)(c.lds + NA_TAB_OFF);
    for (int i = c.tid; i < 8 * 15 * 32; i += 512) { const int hd = i >> 5, j = i & 31; tab[i] = j < 31 ? p.in[I_RPB][hd * 31 + j] * LOG2E : 0.f; }
    __syncthreads();
    for (int it = 0;; ++it) {
        const int U = it * c.G + c.vcu;
        if (U >= 512) break;
        const int b = U >> 6, h = (U >> 3) & 7, rq = U & 7;
        const int rs_min = min(max(4 * rq - 4, 0), 24);
        const int nloc = (rq == 0 || rq == 7) ? 8 : 12;
        attn_body::AU u;
        u.qrow0 = b * SEQ + rq * 256; u.lat_row0 = LAT + b * NCTX; u.nlat_t = 4; u.ctx_row0 = b * SEQ + rs_min * 64; u.NT = 4 + nloc;
        u.Qp = P2a + h * 64; u.Kp = P2a + 512 + h * 64; u.Vp = P2a + 1024 + h * 64; u.Op = CCa + h * 64;
        const int r = 4 * rq + (c.wave >> 1), col = (c.wave & 1) * 32 + (c.lane & 31), hi = c.lane >> 5;
        const int cs = min(max(col - 8, 0), 48);
        attn_body::NAMask mk; mk.tb0 = (attn_body::lds_cfptr)(tab + h * 15 * 32 + 15 - col); mk.r = r; mk.rs = min(max(r - 4, 0), 24); mk.rs_min = rs_min; mk.cb = 4 * hi - cs;
        attn_body::attn_unit<8, OIN, attn_body::NAMask>(u, lds_generic, mk);
    }
    __syncthreads();
    const bf16* P2 = (const bf16*)(p.ws + WS_QKV); bf16* CC = (bf16*)(p.ws + WS_CC);
    const float* pool_w = p.in[I_POOLW]; const float* pool_s = p.in[I_POOLS];
    LAS float* pl = (LAS float*)c.lds;
    for (int u = c.vcu; u < 256; u += c.G) {
        const int b = u >> 5, r = u & 31;
        {
            const int ch = c.tid, g = ch >> 7, half = 1 << g;
            const bf16* du = P2 + (size_t)b * SEQ * OIN + 1536 + ch;
            const int t0 = r * 64;
            float ws = 0.f;
            { float iv[16];
#pragma unroll
              for (int k = 0; k < 16; ++k) { const int t2 = t0 - half + k; const float w = (k < 2 * half && t2 >= 0 && t2 < SEQ) ? 1.f : 0.f; iv[k] = w * bf2f((unsigned)du[(size_t)min(max(t2, 0), SEQ - 1) * OIN]); }
#pragma unroll
              for (int k = 0; k < 16; ++k) ws += iv[k]; }
#pragma unroll 1
            for (int tb = 0; tb < 64; tb += 8) {
                float cur[8], add[8], sub[8];
#pragma unroll
                for (int k = 0; k < 8; ++k) { const int t = t0 + tb + k;
                    cur[k] = bf2f((unsigned)du[(size_t)t * OIN]);
                    add[k] = ((t + half < SEQ) ? 1.f : 0.f) * bf2f((unsigned)du[(size_t)min(t + half, SEQ - 1) * OIN]);
                    sub[k] = ((t - half >= 0) ? 1.f : 0.f) * bf2f((unsigned)du[(size_t)max(t - half, 0) * OIN]); }
#pragma unroll
                for (int k = 0; k < 8; ++k) { const int t = t0 + tb + k, lo = max(t - half, 0), hi = min(t + half, SEQ);
                    pl[(tb + k) * 512 + ch] = ws / (float)(hi - lo) - cur[k];
                    ws += add[k] - sub[k]; }
            }
        }
        __syncthreads();
        {
            const int g = c.tid >> 7, e = c.tid & 127;
            const float ps = pool_s[g * 128 + e];
#pragma unroll 1
            for (int tb = 0; tb < 64; tb += 16) {
                float acc[16];
#pragma unroll
                for (int i = 0; i < 16; ++i) acc[i] = 0.f;
#pragma unroll 2
                for (int cc = 0; cc < 128; cc += 4) {
                    const float w0 = pool_w[(size_t)(g * 128 + cc) * 128 + e], w1 = pool_w[(size_t)(g * 128 + cc + 1) * 128 + e], w2 = pool_w[(size_t)(g * 128 + cc + 2) * 128 + e], w3 = pool_w[(size_t)(g * 128 + cc + 3) * 128 + e];
#pragma unroll
                    for (int i = 0; i < 16; ++i) { const f32x4 pv = *(const LAS f32x4*)(pl + (tb + i) * 512 + g * 128 + cc); acc[i] += pv.x * w0 + pv.y * w1 + pv.z * w2 + pv.w * w3; }
                }
#pragma unroll
                for (int i = 0; i < 16; ++i) CC[(size_t)(b * SEQ + r * 64 + tb + i) * DM + 512 + g * 128 + e] = (bf16)f2bf(acc[i] * ps);
            }
        }
        __syncthreads();
    }
}

__global__ void __launch_bounds__(512, 2) mk_fwd(Params p) {
    extern __shared__ __attribute__((aligned(16))) unsigned char lds_raw[];
    Ctx c;
    c.lds = (LAS unsigned char*)lds_raw;
    c.tid = threadIdx.x; c.lane = c.tid & 63; c.wave = __builtin_amdgcn_readfirstlane(c.tid >> 6);
    c.G = gridDim.x; { const int bx = blockIdx.x; c.vcu = (c.G % 8 == 0) ? (bx % 8) * (c.G / 8) + bx / 8 : bx; }
    c.gw = c.vcu * 8 + c.wave; c.NGW = c.G * 8;
    volatile LAS unsigned* MISC = (volatile LAS unsigned*)(c.lds + MISC_OFF);
    if (c.tid < 32) MISC[c.tid] = 0u;
    __syncthreads();
    gu32* ctl = (gu32*)(p.ws + WS_CTL);
    XcdBarrier bar; bar.bar = (unsigned*)(ctl + CW_BAR); bar.x = 0; bar.st = nullptr;
    if (!MK_MULTI) bar = xcd_barrier_post((unsigned*)(ctl + CW_BAR), MISC + 8);
    const int lo = p.ph_lo, hi = p.ph_hi;
    unsigned long long pt0 = 0, pt1 = 0; if (PROBE_PH == 0) pt0 = __builtin_amdgcn_s_memrealtime();
#define IN(k) (lo <= (k) && (k) < hi)
#define SEAM(k) do { if (IN(k) && IN((k) + 1) && !(FAST_ATTN && (k) == 5)) xcd_barrier(bar); if ((k) + 1 == PROBE_PH) pt0 = __builtin_amdgcn_s_memrealtime(); if ((k) == PROBE_PH) pt1 = __builtin_amdgcn_s_memrealtime(); } while (0)

    bf16* HB = (bf16*)(p.ws + WS_HB); bf16* QKV = (bf16*)(p.ws + WS_QKV); bf16* CC = (bf16*)(p.ws + WS_CC);
    float* Y = (float*)(p.ws + WS_Y); float* PF = (float*)(p.ws + WS_PF);
    bf16* XG = (bf16*)(p.ws + WS_XG); bf16* HID = (bf16*)(p.ws + WS_HID); bf16* YS = (bf16*)(p.ws + WS_YS);
    const float* GATE = (const float*)(p.ws + WS_GATE);

    if (IN(0)) for (int rep_ = 0; rep_ < 1 + (int)((PROBE_MASK >> 0) & 1u); ++rep_) { if (rep_) __syncthreads(); ph_prologue(p, c); if (FAST_GEMM) { __syncthreads(); ph_transposes(p, c); } } SEAM(0);
    if (IN(1)) for (int rep_ = 0; rep_ < 1 + (int)((PROBE_MASK >> 1) & 1u); ++rep_) { if (rep_) __syncthreads(); ph_modulate0(p, c); } SEAM(1);
    if (IN(2)) for (int rep_ = 0; rep_ < 1 + (int)((PROBE_MASK >> 2) & 1u); ++rep_) { if (rep_) __syncthreads();
        if (FAST_GEMM) { pg8::Gemm g{HB, (const bf16*)(p.ws + WS_W0IN), NTOK, EIN, DM, 0}; pg8::StaticOrder S; S.init(NTOK, EIN, c.G, (int)blockIdx.x);
            pg8::EpiBf16<0> E{QKV, EIN, nullptr, 0, 0, 1.f}; pg8::gemm_phase<pg8::EpiBf16<0>, pg8::StaticOrder, true, true>(c.lds, g, S, E); }
        else { NG g{HB, DM, p.in[I_W0IN], nullptr, EIN, 0, 1 << 30, 0, NTOK, 0, EIN, DM}; ngemm<1>(g, c, EpiF32{PF, EIN}); }
    } SEAM(2);
    if (IN(3)) for (int rep_ = 0; rep_ < 1 + (int)((PROBE_MASK >> 3) & 1u); ++rep_) { if (rep_) __syncthreads(); if (FAST_GEMM) ph_qkv_post<false>(p, c); else ph_qkv_post<true>(p, c); } SEAM(3);
    if (IN(4)) for (int rep_ = 0; rep_ < 1 + (int)((PROBE_MASK >> 4) & 1u); ++rep_) { if (rep_) __syncthreads(); if (FAST_ATTN) ph_attn0_fast(p, c, (char*)lds_raw); else ph_attn0_naive(p, c); } SEAM(4);
    if (!FAST_ATTN) { if (IN(5)) { ph_attn_combine(p, c); } } SEAM(5);
    if (IN(6)) for (int rep_ = 0; rep_ < 1 + (int)((PROBE_MASK >> 6) & 1u); ++rep_) { if (rep_) __syncthreads();
        if (FAST_GEMM) { pg8::Gemm g{CC, (const bf16*)(p.ws + WS_W0OUT), NTOK, DM, DM, 0}; pg8::StaticOrder S; S.init(NTOK, DM, c.G, (int)blockIdx.x);
            pg8::EpiF32P E{Y, DM}; pg8::gemm_phase<pg8::EpiF32P, pg8::StaticOrder, true, true>(c.lds, g, S, E); }
        else { NG g{CC, DM, p.in[I_W0OUT], nullptr, DM, 0, 1 << 30, 0, NTOK, 0, DM, DM}; ngemm<1>(g, c, EpiF32{Y, DM}); }
    } SEAM(6);
    if (IN(7)) for (int rep_ = 0; rep_ < 1 + (int)((PROBE_MASK >> 7) & 1u); ++rep_) { if (rep_) __syncthreads(); ph_ln1_router(p, c, 0); } SEAM(7);
    if (IN(8)) for (int rep_ = 0; rep_ < 1 + (int)((PROBE_MASK >> 8) & 1u); ++rep_) { if (rep_) __syncthreads(); ph_topk(p, c, 0); } SEAM(8);
    if (IN(9)) for (int rep_ = 0; rep_ < 1 + (int)((PROBE_MASK >> 9) & 1u); ++rep_) { if (rep_) __syncthreads();
        if (FAST_GEMM && MOE_FP8) { pg8::Gemm g{XG, (const bf16*)(p.ws + WS_WGU), NE * MR0, 4096, DM / 2, (size_t)4096 * DM}; pg8::GroupedOrder S; S.init(MR0 / 256, 16, NE, c.G, c.vcu);
            pg8::EpiSwigluF8 E{(unsigned char*)HID, FF, 1.f / W8_GU, H8_SC}; pg8::gemm_phase<pg8::EpiSwigluF8, pg8::GroupedOrder, true, true, true>(c.lds, g, S, E); }
        else if (FAST_GEMM) { pg8::Gemm g{XG, (const bf16*)(p.ws + WS_WGU), NE * MR0, 4096, DM, (size_t)4096 * DM * 2}; pg8::GroupedOrder S; S.init(MR0 / 256, 16, NE, c.G, c.vcu);
            pg8::EpiSwigluP E{HID, FF}; pg8::gemm_phase<pg8::EpiSwigluP, pg8::GroupedOrder, true, true>(c.lds, g, S, E); }
        else { NG g{XG, DM, p.in[I_WG], p.in[I_WU], FF, (size_t)DM * FF, MR0, 0, NE * MR0, 0, FF, DM}; ngemm<2>(g, c, EpiSwiglu{HID}); }
    } SEAM(9);
    if (IN(10)) for (int rep_ = 0; rep_ < 1 + (int)((PROBE_MASK >> 10) & 1u); ++rep_) { if (rep_) __syncthreads();
        if (FAST_GEMM && MOE_FP8) { pg8::Gemm g{HID, (const bf16*)(p.ws + WS_WDN), NE * MR0, DM, FF / 2, (size_t)DM * FF}; pg8::GroupedOrder S; S.init(MR0 / 256, 4, NE, c.G, c.vcu);
            pg8::EpiGateS E{YS, DM, GATE, 1.f / (W8_DN * H8_SC)}; pg8::gemm_phase<pg8::EpiGateS, pg8::GroupedOrder, true, true, true>(c.lds, g, S, E); }
        else if (FAST_GEMM) { pg8::Gemm g{HID, (const bf16*)(p.ws + WS_WDN), NE * MR0, DM, FF, (size_t)DM * FF * 2}; pg8::GroupedOrder S; S.init(MR0 / 256, 4, NE, c.G, c.vcu);
            pg8::EpiGateP E{YS, DM, GATE}; pg8::gemm_phase<pg8::EpiGateP, pg8::GroupedOrder, true, true>(c.lds, g, S, E); }
        else { NG g{HID, FF, p.in[I_WD], nullptr, DM, (size_t)FF * DM, MR0, 0, NE * MR0, 0, DM, FF}; ngemm<1>(g, c, EpiGate{YS, GATE}); }
    } SEAM(10);
    if (IN(11)) for (int rep_ = 0; rep_ < 1 + (int)((PROBE_MASK >> 11) & 1u); ++rep_) { if (rep_) __syncthreads(); ph_combine(p, c, 0); } SEAM(11);
    if (IN(12)) for (int rep_ = 0; rep_ < 1 + (int)((PROBE_MASK >> 12) & 1u); ++rep_) { if (rep_) __syncthreads();
        if (FAST_GEMM) { pg8::Gemm g{HB, (const bf16*)(p.ws + WS_W1IN), NTOK, OIN, DM, 0}; pg8::L1InOrder S; S.init(c.G, (int)blockIdx.x);
            pg8::EpiBf16<0> E{QKV, OIN, nullptr, 512, 512, C2}; pg8::gemm_phase<pg8::EpiBf16<0>, pg8::L1InOrder, true, true>(c.lds, g, S, E); }
        else {
        NG g{HB, DM, p.in[I_W1IN], nullptr, OIN, 0, 1 << 30, 0, LAT, 0, OIN, DM}; ngemm<1>(g, c, EpiBf{QKV, OIN, 512, C2});
        NG g2{HB, DM, p.in[I_W1IN], nullptr, OIN, 0, 1 << 30, LAT, NTOK, 512, 1536, DM}; ngemm<1>(g2, c, EpiBf{QKV, OIN, 0, 1.f}); }
    } SEAM(12);
    if (IN(13)) for (int rep_ = 0; rep_ < 1 + (int)((PROBE_MASK >> 13) & 1u); ++rep_) { if (rep_) __syncthreads(); if (FAST_NA) ph_mixer1_fast(p, c, (char*)lds_raw); else ph_mixer1_naive(p, c); } SEAM(13);
    if (IN(14)) for (int rep_ = 0; rep_ < 1 + (int)((PROBE_MASK >> 14) & 1u); ++rep_) { if (rep_) __syncthreads();
        if (FAST_GEMM) { pg8::Gemm g{CC, (const bf16*)(p.ws + WS_W1OUT), LAT, DM, DM, 0}; pg8::StaticOrder S; S.init(LAT, DM, c.G, (int)blockIdx.x);
            pg8::EpiF32P E{Y, DM}; pg8::gemm_phase<pg8::EpiF32P, pg8::StaticOrder, true, true>(c.lds, g, S, E); }
        else { NG g{CC, DM, p.in[I_W1OUT], nullptr, DM, 0, 1 << 30, 0, LAT, 0, DM, DM}; ngemm<1>(g, c, EpiF32{Y, DM}); }
    } SEAM(14);
    if (IN(15)) for (int rep_ = 0; rep_ < 1 + (int)((PROBE_MASK >> 15) & 1u); ++rep_) { if (rep_) __syncthreads(); ph_ln1_router(p, c, 1); } SEAM(15);
    if (IN(16)) for (int rep_ = 0; rep_ < 1 + (int)((PROBE_MASK >> 16) & 1u); ++rep_) { if (rep_) __syncthreads(); ph_topk(p, c, 1); } SEAM(16);
    if (IN(17)) for (int rep_ = 0; rep_ < 1 + (int)((PROBE_MASK >> 17) & 1u); ++rep_) { if (rep_) __syncthreads();
        if (FAST_GEMM && MOE_FP8) { pg8::Gemm g{XG, (const bf16*)(p.ws + WS_WGU + WS_MOE_LSTRIDE), NE * MR1, 4096, DM / 2, (size_t)4096 * DM}; pg8::GroupedOrder S; S.init(MR1 / 256, 16, NE, c.G, c.vcu);
            pg8::EpiSwigluF8 E{(unsigned char*)HID, FF, 1.f / W8_GU, H8_SC}; pg8::gemm_phase<pg8::EpiSwigluF8, pg8::GroupedOrder, true, true, true>(c.lds, g, S, E); }
        else if (FAST_GEMM) { pg8::Gemm g{XG, (const bf16*)(p.ws + WS_WGU + WS_MOE_LSTRIDE), NE * MR1, 4096, DM, (size_t)4096 * DM * 2}; pg8::GroupedOrder S; S.init(MR1 / 256, 16, NE, c.G, c.vcu);
            pg8::EpiSwigluP E{HID, FF}; pg8::gemm_phase<pg8::EpiSwigluP, pg8::GroupedOrder, true, true>(c.lds, g, S, E); }
        else { NG g{XG, DM, p.in[I_WG] + (size_t)NE * DM * FF, p.in[I_WU] + (size_t)NE * DM * FF, FF, (size_t)DM * FF, MR1, 0, NE * MR1, 0, FF, DM}; ngemm<2>(g, c, EpiSwiglu{HID}); }
    } SEAM(17);
    if (IN(18)) for (int rep_ = 0; rep_ < 1 + (int)((PROBE_MASK >> 18) & 1u); ++rep_) { if (rep_) __syncthreads();
        if (FAST_GEMM && MOE_FP8) { pg8::Gemm g{HID, (const bf16*)(p.ws + WS_WDN + WS_MOE_LSTRIDE), NE * MR1, DM, FF / 2, (size_t)DM * FF}; pg8::GroupedOrder S; S.init(MR1 / 256, 4, NE, c.G, c.vcu);
            pg8::EpiGateS E{YS, DM, GATE, 1.f / (W8_DN * H8_SC)}; pg8::gemm_phase<pg8::EpiGateS, pg8::GroupedOrder, true, true, true>(c.lds, g, S, E); }
        else if (FAST_GEMM) { pg8::Gemm g{HID, (const bf16*)(p.ws + WS_WDN + WS_MOE_LSTRIDE), NE * MR1, DM, FF, (size_t)DM * FF * 2}; pg8::GroupedOrder S; S.init(MR1 / 256, 4, NE, c.G, c.vcu);
            pg8::EpiGateP E{YS, DM, GATE}; pg8::gemm_phase<pg8::EpiGateP, pg8::GroupedOrder, true, true>(c.lds, g, S, E); }
        else { NG g{HID, FF, p.in[I_WD] + (size_t)NE * FF * DM, nullptr, DM, (size_t)FF * DM, MR1, 0, NE * MR1, 0, DM, FF}; ngemm<1>(g, c, EpiGate{YS, GATE}); }
    } SEAM(18);
    if (IN(19)) for (int rep_ = 0; rep_ < 1 + (int)((PROBE_MASK >> 19) & 1u); ++rep_) { if (rep_) __syncthreads(); ph_combine(p, c, 1); }
    if (PROBE_PH == 19) pt1 = __builtin_amdgcn_s_memrealtime();
    if (PROBE_PH >= 0 && blockIdx.x == 0 && c.tid == 0) { const unsigned long long te = __builtin_amdgcn_s_memrealtime(); while (__builtin_amdgcn_s_memrealtime() - te < pt1 - pt0) __builtin_amdgcn_s_sleep(8); }
#undef IN
#undef SEAM
}

extern "C" void kernel_launch(void* const* d_in, const int* in_sizes, int n_in, void* d_out, int out_size, void* d_ws, size_t ws_size, hipStream_t stream) {
    static int grid = 0;
    if (grid == 0) {
        if (n_in != 26 || out_size != LAT * DM || ws_size < WS_END) { fprintf(stderr, "kernel_launch: unexpected shapes (n_in %d out %d ws %zu)\n", n_in, out_size, ws_size); grid = -1; return; }
        int dev = 0, cus = 0;
        if (hipGetDevice(&dev) != hipSuccess || hipDeviceGetAttribute(&cus, hipDeviceAttributeMultiprocessorCount, dev) != hipSuccess) { grid = -1; return; }
        if (hipFuncSetAttribute((const void*)mk_fwd, hipFuncAttributeMaxDynamicSharedMemorySize, LDS_BYTES) != hipSuccess) { fprintf(stderr, "kernel_launch: hipFuncSetAttribute failed\n"); grid = -1; return; }
        int per_cu = 0;
        if (hipOccupancyMaxActiveBlocksPerMultiprocessor(&per_cu, (const void*)mk_fwd, 512, LDS_BYTES) != hipSuccess || per_cu < 1) fprintf(stderr, "kernel_launch: occupancy query says %d\n", per_cu);
        (void)hipGetLastError();
        grid = cus;
    }
    if (grid < 0) return;
    (void)hipMemsetAsync((char*)d_ws + WS_CTL, 0, CTL_ZERO_BYTES, stream);
    Params a{};
    for (int i = 0; i < 26; ++i) a.in[i] = (const float*)d_in[i];
    a.out = (float*)d_out; a.ws = (unsigned char*)d_ws;
#if MK_MULTI
    for (int ph = 0; ph < NPHASE; ++ph) { a.ph_lo = ph; a.ph_hi = ph + 1; hipLaunchKernelGGL(mk_fwd, dim3(grid), dim3(512), LDS_BYTES, stream, a); }
#else
    a.ph_lo = 0; a.ph_hi = NPHASE;
    hipLaunchKernelGGL(mk_fwd, dim3(grid), dim3(512), LDS_BYTES, stream, a);
#endif
}
```

```cpp
#include <hip/hip_runtime.h>
#include <cstdio>
#include <cstdint>

#define GAS __attribute__((address_space(1)))
#define LAS __attribute__((address_space(3)))
typedef unsigned short bf16;
typedef unsigned v4u __attribute__((ext_vector_type(4)));
typedef unsigned v2u __attribute__((ext_vector_type(2)));
typedef float f32x4 __attribute__((ext_vector_type(4)));
typedef float f32x2 __attribute__((ext_vector_type(2)));
typedef float f32x16 __attribute__((ext_vector_type(16)));
typedef GAS unsigned gu32;

#ifndef PROBE_PH
#define PROBE_PH -1
#endif
#ifndef PROBE_MASK
#define PROBE_MASK 0u
#endif
#ifndef MOE_FP8
#define MOE_FP8 1
#endif
#ifndef FAST_NA
#define FAST_NA 1
#endif
#ifndef FAST_ATTN
#define FAST_ATTN 1
#endif
#ifndef FAST_GEMM
#define FAST_GEMM 1
#endif
#ifndef MK_MULTI
#define MK_MULTI 0
#endif

constexpr int NBATCH = 8, SEQ = 2048, DM = 1024, NCTX = 256;
constexpr int LAT = NBATCH * SEQ;
constexpr int NTOK = LAT + NBATCH * NCTX;
constexpr int EIN = 2304, OIN = 2048, NE = 16, FF = 2048;
constexpr int MR0 = 2304, MR1 = 2048;
constexpr float LOG2E = 1.4426950408889634f;
constexpr float C2 = 0.125f * LOG2E;
constexpr float ALPHA = 1.4142135623730951f;
constexpr float LN_EPS = 1e-5f, RMS_EPS = 1e-6f;
constexpr float LAM_INIT = 0.2f;
constexpr int NPHASE = 20;
constexpr float W8_GU = 32.f, W8_DN = 64.f, H8_SC = 8.f;

constexpr size_t MiB = 1u << 20;
constexpr size_t WS_CTL = 0, CTL_ZERO_BYTES = 1 * MiB;
constexpr size_t WS_MOD = 1 * MiB;
constexpr size_t WS_ROPE = 1 * MiB + 512 * 1024;
constexpr size_t WS_W0IN = 2 * MiB;
constexpr size_t WS_W0OUT = 7 * MiB;
constexpr size_t WS_W1IN = 9 * MiB;
constexpr size_t WS_W1OUT = 13 * MiB;
constexpr size_t WS_AFF = 16 * MiB;
constexpr size_t WS_INV = 18 * MiB;
constexpr size_t WS_GATE = 20 * MiB;
constexpr size_t WS_WGU = 24 * MiB;
constexpr size_t WS_WDN = 152 * MiB;
constexpr size_t WS_MOE_LSTRIDE = 192 * MiB;
constexpr size_t WS_XS = 408 * MiB;
constexpr size_t WS_HB = 480 * MiB;
constexpr size_t WS_QKV = 516 * MiB;
constexpr size_t WS_CC = 597 * MiB;
constexpr size_t WS_AO = 633 * MiB;
constexpr size_t WS_Y = 705 * MiB;
constexpr size_t WS_XG = 516 * MiB;
constexpr size_t WS_HID = 588 * MiB;
constexpr size_t WS_YS = 732 * MiB;
constexpr size_t WS_PF = 804 * MiB;
constexpr size_t WS_END = 968 * MiB;

constexpr int CW_BAR = 4096;
constexpr int LDS_BYTES = 147456;
constexpr int MISC_OFF = 131072 + 320;

__device__ __forceinline__ float bf2f(unsigned v) { return __uint_as_float(v << 16); }
__device__ __forceinline__ unsigned f2bf(float f) { unsigned u = __float_as_uint(f); return (u + 0x7fffu + ((u >> 16) & 1u)) >> 16; }
__device__ __forceinline__ unsigned pk2(float lo, float hi) { return f2bf(lo) | (f2bf(hi) << 16); }
__device__ __forceinline__ float wave_sum(float v) {
#pragma unroll
    for (int o = 1; o < 64; o <<= 1) v += __shfl_xor(v, o);
    return v;
}
__device__ __forceinline__ float wave_max(float v) {
#pragma unroll
    for (int o = 1; o < 64; o <<= 1) v = fmaxf(v, __shfl_xor(v, o));
    return v;
}
__device__ __forceinline__ void unpack8(const v4u w, float* f) {
    f[0] = bf2f(w.x & 0xffffu); f[1] = __uint_as_float(w.x & 0xffff0000u);
    f[2] = bf2f(w.y & 0xffffu); f[3] = __uint_as_float(w.y & 0xffff0000u);
    f[4] = bf2f(w.z & 0xffffu); f[5] = __uint_as_float(w.z & 0xffff0000u);
    f[6] = bf2f(w.w & 0xffffu); f[7] = __uint_as_float(w.w & 0xffff0000u);
}

#define XB_TMO      128
#define XB_XCNT(j)  (256  + 64 * (j))
#define XB_XSUB(j)  (1280 + 64 * (j))
#define XB_XGEN(j)  (2304 + 64 * (j))
#define XB_TOP      3328
#define XB_TOPGEN   3392
#define XCD_BAR_WORDS 3456
#define XB_SPIN_CAP (1u << 18)
__device__ __forceinline__ unsigned xb_ld(unsigned* p)              { return __hip_atomic_load(p, __ATOMIC_RELAXED, __HIP_MEMORY_SCOPE_AGENT); }
__device__ __forceinline__ unsigned xb_add(unsigned* p, unsigned v) { return __hip_atomic_fetch_add(p, v, __ATOMIC_RELAXED, __HIP_MEMORY_SCOPE_AGENT); }
__device__ __forceinline__ unsigned xb_xcc_id() { return (unsigned)__builtin_amdgcn_s_getreg((3 << 11) | 20) & 0xFu; }
#define XB_SPIN(cond, bar) do { unsigned _sp = 0; while (cond) { __builtin_amdgcn_s_sleep(1); \
    if ((++_sp & 255u) == 0u) { if (xb_ld(&(bar)[XB_TMO])) break; if (_sp > XB_SPIN_CAP) { atomicAdd(&(bar)[XB_TMO], 1u); break; } } } } while (0)
struct XcdBarrier { unsigned* bar; unsigned x; volatile LAS unsigned* st; };
__device__ __forceinline__ XcdBarrier xcd_barrier_post(unsigned* bar, volatile LAS unsigned* st) {
    XcdBarrier b; b.bar = bar; b.x = xb_xcc_id(); b.st = st;
    if (threadIdx.x == 0) (void)xb_add(&bar[XB_XCNT(b.x)], 1u);
    return b;
}
__device__ __forceinline__ void xcd_barrier_complete(unsigned* bar, unsigned x, unsigned& nloc, unsigned& nx) {
    const unsigned G = gridDim.x * gridDim.y * gridDim.z;
    unsigned sum, cnt, mine, sp = 0u;
    for (;;) {
        sum = 0u; cnt = 0u; mine = 0u;
#pragma unroll
        for (unsigned j = 0; j < 16; ++j) { const unsigned c = xb_ld(&bar[XB_XCNT(j)]); sum += c; cnt += (c > 0u) ? 1u : 0u; mine = (j == x) ? c : mine; }
        if (sum == G) break;
        __builtin_amdgcn_s_sleep(1);
        if ((++sp & 255u) == 0u) { if (xb_ld(&bar[XB_TMO])) break; if (sp > XB_SPIN_CAP) { atomicAdd(&bar[XB_TMO], 1u); break; } }
    }
    nloc = mine > 0u ? mine : 1u; nx = cnt > 0u ? cnt : 1u;
}
__device__ __forceinline__ void xcd_barrier(const XcdBarrier& b) {
    asm volatile("s_waitcnt vmcnt(0)" ::: "memory");
    __syncthreads();
    if (threadIdx.x == 0) {
        unsigned* bar = b.bar;
        __builtin_amdgcn_s_waitcnt(0);
        unsigned nloc = b.st[0], nx = b.st[1];
        if (nloc == 0u) { xcd_barrier_complete(bar, b.x, nloc, nx); b.st[0] = nloc; b.st[1] = nx; }
        const unsigned old = xb_add(&bar[XB_XSUB(b.x)], 1u);
        const unsigned gen = old / nloc;
        if (old + 1u == (gen + 1u) * nloc) {
            __builtin_amdgcn_fence(__ATOMIC_RELEASE, "agent");
            asm volatile("s_waitcnt vmcnt(0)" ::: "memory");
            const unsigned og = xb_add(&bar[XB_TOP], 1u);
            const unsigned tg = og / nx;
            if (og + 1u == (tg + 1u) * nx) xb_add(&bar[XB_TOPGEN], 1u);
            else XB_SPIN(xb_ld(&bar[XB_TOPGEN]) == tg, bar);
            __builtin_amdgcn_fence(__ATOMIC_ACQUIRE, "agent");
            xb_add(&bar[XB_XGEN(b.x)], 1u);
            asm volatile("s_waitcnt vmcnt(0)" ::: "memory");
        } else {
            XB_SPIN(xb_ld(&bar[XB_XGEN(b.x)]) == gen, bar);
            __builtin_amdgcn_fence(__ATOMIC_ACQUIRE, "agent");
            asm volatile("s_waitcnt vmcnt(0)" ::: "memory");
        }
    }
    __syncthreads();
}

namespace pg8 {
#define PG8_LAS __attribute__((address_space(3)))
typedef unsigned short bf16_t;
typedef short bf16x8 __attribute__((ext_vector_type(8)));
typedef float f32x4 __attribute__((ext_vector_type(4)));
typedef unsigned u32x4 __attribute__((ext_vector_type(4)));
constexpr int BM = 256, BK = 64, HALF = 128, HTB = HALF * BK * 2  , STAGE_BYTES = 8 * HTB, NXCD = 8, WGM = 8;

__host__ __device__ __forceinline__ int lds_byte(int r, int c) { const int st = (r >> 4) * 2 + (c >> 5), rr = r & 15, cc = c & 31, ob = rr * 64 + cc * 2; return st * 1024 + (ob ^ (((ob >> 9) & 1) << 5)); }
__host__ __device__ __forceinline__ void stage_rc(int b, int& R, int& C) { const int st = b / 1024, sb = b % 1024, swz = sb ^ (((sb >> 9) & 1) << 5); R = (st >> 1) * 16 + swz / 64; C = (st & 1) * 32 + (swz % 64) / 2; }
__host__ __device__ __forceinline__ int perm32(int rho) { const int n = rho >> 4, i = rho & 15; return 8 * (i >> 2) + 4 * n + (i & 3); }

struct Unit { int pm, pn, e; };
struct Gemm { const bf16_t* A; const bf16_t* Bt; int M, N, K; size_t bstride; };

struct StaticOrder {
    int nM, nN, nwg, G, c;
    __host__ __device__ void init(int M, int N, int G_, int c_) { nM = M / BM; nN = N / BM; nwg = nM * nN; G = G_; c = c_; }
    __host__ __device__ bool next(int i, Unit& u) const {
        const long L = (long)i * G + c; if (L >= nwg) return false;
        int wgid = (int)L; { const int q = nwg / NXCD, r = nwg % NXCD, xcd = wgid % NXCD, off = wgid / NXCD; wgid = (xcd < r ? xcd * (q + 1) : r * (q + 1) + (xcd - r) * q) + off; }
        const int nig = WGM * nN, gid = wgid / nig, fm = gid * WGM, gsz = (nM - fm) < WGM ? (nM - fm) : WGM;
        u.pm = fm + ((wgid % nig) % gsz); u.pn = (wgid % nig) / gsz; u.e = 0; return true;
    }
    __device__ __forceinline__ void a_ready(const Unit&) const {}
    __device__ __forceinline__ void done(const Unit&) const {}
};

__device__ __forceinline__ unsigned cvt_pk_bf16(float lo, float hi) { unsigned r; asm volatile("v_cvt_pk_bf16_f32 %0, %1, %2" : "=v"(r) : "v"(lo), "v"(hi)); return r; }
typedef float f32x2 __attribute__((ext_vector_type(2)));
__device__ __forceinline__ f32x2 gelu_pk(f32x2 v) {
    const f32x2 av = __builtin_elementwise_abs(v), d = av * 0.2316418882f + 1.0f;
    f32x2 t; t.x = __builtin_amdgcn_rcpf(d.x); t.y = __builtin_amdgcn_rcpf(d.y);
    f32x2 q = t * 0.5307027145f + (-0.7265760135f); q = q * t + 0.7107068705f; q = q * t + (-0.142248368f); q = q * t + 0.127414796f; q = q * t;
    const f32x2 s = (v * v) * (-0.72134752044f);
    f32x2 e; e.x = __builtin_amdgcn_exp2f(s.x); e.y = __builtin_amdgcn_exp2f(s.y);
    const f32x2 m = v * (q * e), r = v - m;
    f32x2 o; o.x = v.x < 0.f ? m.x : r.x; o.y = v.y < 0.f ? m.y : r.y; return o;
}

template <int ACT  > struct EpiBf16 {
    static constexpr bool PERM = true, AFTER_DRAIN = false; static_assert(ACT == 0 || ACT == 1, "EpiBf16: ACT is 0 (none) or 1 (gelu_pk)");
    bf16_t* O; int ldc; const float* bias; int split_cols; size_t split_stride; float scale0;
    __device__ __forceinline__ void operator()(const f32x4 (&acc)[2][2][4][2], const Unit& u, int wr, int wc, int fr, int fq) const {
        const int row0 = u.pm * BM + wr * 64 + fr; int colt = u.pn * BM; bf16_t* base = O;
        float sc = 1.f; if (split_cols) { const int t = colt / split_cols; base += (size_t)t * split_stride; colt -= t * split_cols; if (t == 0) sc = scale0; }
        const int col0 = colt + wc * 32 + 8 * fq, bcol0 = u.pn * BM + wc * 32 + 8 * fq;
        f32x4 bv[2][2];
#pragma unroll
        for (int bj = 0; bj < 2; ++bj)
#pragma unroll
            for (int n = 0; n < 2; ++n) bv[bj][n] = bias ? *(const f32x4*)(bias + bcol0 + bj * HALF + 4 * n) : (f32x4){0.f, 0.f, 0.f, 0.f};
#pragma unroll
        for (int ai = 0; ai < 2; ++ai)
#pragma unroll
            for (int m = 0; m < 4; ++m) { bf16_t* rowp = base + (size_t)(row0 + ai * HALF + m * 16) * ldc + col0;
#pragma unroll
                for (int bj = 0; bj < 2; ++bj) { f32x4 v0 = acc[ai][bj][m][0] + bv[bj][0], v1 = acc[ai][bj][m][1] + bv[bj][1];
                    if (ACT == 1) { f32x2 a = gelu_pk((f32x2){v0[0], v0[1]}), b = gelu_pk((f32x2){v0[2], v0[3]}), c = gelu_pk((f32x2){v1[0], v1[1]}), d = gelu_pk((f32x2){v1[2], v1[3]});
                        v0 = (f32x4){a.x, a.y, b.x, b.y}; v1 = (f32x4){c.x, c.y, d.x, d.y}; }
                    v0 = v0 * sc; v1 = v1 * sc; u32x4 w; w.x = cvt_pk_bf16(v0[0], v0[1]); w.y = cvt_pk_bf16(v0[2], v0[3]); w.z = cvt_pk_bf16(v1[0], v1[1]); w.w = cvt_pk_bf16(v1[2], v1[3]);
                    *(u32x4*)(rowp + bj * HALF) = w; } }
    }
};

typedef int i32x4 __attribute__((ext_vector_type(4))); typedef int i32x8 __attribute__((ext_vector_type(8)));
__device__ __forceinline__ i32x8 cat16(bf16x8 lo, bf16x8 hi) { const i32x4 a = __builtin_bit_cast(i32x4, lo), b = __builtin_bit_cast(i32x4, hi); return __builtin_shufflevector(a, b, 0, 1, 2, 3, 4, 5, 6, 7); }
__device__ __forceinline__ void mfma_f8_acc(f32x4& acc, const i32x8& b, const i32x8& a, int sc) {
    asm volatile("v_mfma_scale_f32_16x16x128_f8f6f4 %0, %1, %2, %0, %3, %3 op_sel_hi:[0,0,0]" : "+v"(acc) : "v"(b), "v"(a), "v"(sc)); }
template <class Epi, class Sched, bool ALIGN_EPI = false, bool SP2 = false, bool FP8 = false>
__device__ __forceinline__ void gemm_phase(PG8_LAS unsigned char* lds, const Gemm g, const Sched& S, const Epi& E) {
    const int tid = threadIdx.x, wid = __builtin_amdgcn_readfirstlane(tid >> 6), lane = tid & 63, wr = wid >> 2, wc = wid & 3, fr = lane & 15, fq = lane >> 4;
    const int K = g.K, nt = K / BK;
    unsigned voffA[2], voffB[2];
#pragma unroll
    for (int i = 0; i < 2; ++i) { int R, C; stage_rc(tid * 16 + i * 8192, R, C); const int Rb = Epi::PERM ? ((R & ~31) + perm32(R & 31)) : R;
        voffA[i] = (unsigned)(R * K + C) * 2u; voffB[i] = (unsigned)(Rb * K + C) * 2u; }
    const size_t kstep = (size_t)(BK * 2);
    const size_t hstep = (size_t)HALF * K * 2;
    const size_t tstep = 2 * hstep;
    const unsigned ldsw = (unsigned)wid * 1024u;
    const int aoff = FP8 ? lds_byte(wr * 64 + fr, 16 * fq) : lds_byte(wr * 64 + fr, fq * 8), boff = FP8 ? lds_byte(wc * 32 + fr, 16 * fq) : lds_byte(wc * 32 + fr, fq * 8);
    constexpr int KOFF = FP8 ? 16 : 1024;
#define PG8_SA(b, h) (((b) * 2 + (h)) * HTB)
#define PG8_SB(b, h) ((4 + (b) * 2 + (h)) * HTB)
#define PG8_STAGE(bufoff, gbase, voff) do { _Pragma("unroll") for (int _i = 0; _i < 2; ++_i) \
        __builtin_amdgcn_global_load_lds((const unsigned*)((const char*)(gbase) + (voff)[_i]), (PG8_LAS unsigned*)(lds + (bufoff) + ldsw + _i * 8192), 16, 0, 0); } while (0)
#define PG8_LDA(dst, b, h) do { _Pragma("unroll") for (int m = 0; m < 4; ++m) _Pragma("unroll") for (int k = 0; k < 2; ++k) dst[m][k] = *(const PG8_LAS bf16x8*)(lds + PG8_SA(b, h) + aoff + m * 2048 + k * KOFF); } while (0)
#define PG8_LDB(dst, b, h) do { _Pragma("unroll") for (int n = 0; n < 2; ++n) _Pragma("unroll") for (int k = 0; k < 2; ++k) dst[n][k] = *(const PG8_LAS bf16x8*)(lds + PG8_SB(b, h) + boff + n * 2048 + k * KOFF); } while (0)
#define PG8_MMA(ai, bj, At, Bt) do { __builtin_amdgcn_s_setprio(1); _Pragma("unroll") for (int m = 0; m < 4; ++m) _Pragma("unroll") for (int n = 0; n < 2; ++n) { \
        if constexpr (FP8) mfma_f8_acc(acc[ai][bj][m][n], cat16(Bt[n][0], Bt[n][1]), cat16(At[m][0], At[m][1]), f8scale); \
        else { _Pragma("unroll") for (int k = 0; k < 2; ++k) acc[ai][bj][m][n] = __builtin_amdgcn_mfma_f32_16x16x32_bf16(Bt[n][k], At[m][k], acc[ai][bj][m][n], 0, 0, 0); } } __builtin_amdgcn_s_setprio(0); } while (0)
#define PG8_WAIT_V(n) asm volatile("s_waitcnt vmcnt(" #n ")" ::: "memory")
#define PG8_WAIT_L(n) asm volatile("s_waitcnt lgkmcnt(" #n ")" ::: "memory")
#define PG8_BAR __builtin_amdgcn_s_barrier()
#define PG8_SCHED __builtin_amdgcn_sched_barrier(0)
    Unit cur, nxt; int ui = 0;
    if (!S.next(0, cur)) return;
    f32x4 acc[2][2][4][2];
#pragma unroll
    for (int a = 0; a < 2; ++a)
#pragma unroll
        for (int b = 0; b < 2; ++b)
#pragma unroll
            for (int m = 0; m < 4; ++m)
#pragma unroll
                for (int n = 0; n < 2; ++n) acc[a][b][m][n] = (f32x4){0.f, 0.f, 0.f, 0.f};
    int f8scale = 0x7F7F7F7F; asm volatile("" : "+v"(f8scale));
    bf16x8 At[4][2], B0[2][2], B1[2][2];
    const char* cA = (const char*)g.A + (size_t)cur.pm * tstep; const char* cB = (const char*)g.Bt + (size_t)cur.pn * tstep + (size_t)cur.e * g.bstride;
    S.a_ready(cur);
    if constexpr (SP2) {
        PG8_STAGE(PG8_SB(0, 0), cB, voffB); PG8_STAGE(PG8_SB(0, 1), cB + hstep, voffB); PG8_STAGE(PG8_SA(0, 0), cA, voffA); PG8_STAGE(PG8_SA(0, 1), cA + hstep, voffA);
        if (wr == 1) PG8_BAR;
        PG8_WAIT_V(2); PG8_BAR;
        PG8_STAGE(PG8_SB(1, 0), cB + kstep, voffB); PG8_STAGE(PG8_SA(1, 0), cA + kstep, voffA); PG8_STAGE(PG8_SB(1, 1), cB + hstep + kstep, voffB);
        PG8_WAIT_V(6); PG8_BAR;
    } else {
        PG8_STAGE(PG8_SB(0, 0), cB, voffB); PG8_STAGE(PG8_SA(0, 0), cA, voffA); PG8_STAGE(PG8_SB(0, 1), cB + hstep, voffB); PG8_STAGE(PG8_SA(0, 1), cA + hstep, voffA);
        if (wr == 1) PG8_BAR;
        PG8_WAIT_V(4); PG8_BAR;
        PG8_STAGE(PG8_SB(1, 0), cB + kstep, voffB); PG8_STAGE(PG8_SA(1, 0), cA + kstep, voffA); PG8_STAGE(PG8_SB(1, 1), cB + hstep + kstep, voffB);
        PG8_WAIT_V(6); PG8_BAR;
    }
    for (;;) {
        const bool has_next = S.next(ui + 1, nxt);
        const char* nA = has_next ? (const char*)g.A + (size_t)nxt.pm * tstep : cA; const char* nB = has_next ? (const char*)g.Bt + (size_t)nxt.pn * tstep + (size_t)nxt.e * g.bstride : cB;
        for (int t = 0; t < nt; t += 2) {
            const bool last = (t == nt - 2);
            const char* a1 = cA + (size_t)(t + 1) * kstep;
            const char* a2 = last ? nA : cA + (size_t)(t + 2) * kstep; const char* b2 = last ? nB : cB + (size_t)(t + 2) * kstep;
            const char* a3 = a2 + kstep; const char* b3 = b2 + kstep;
            if (last && has_next) S.a_ready(nxt);
            if constexpr (SP2) {
            PG8_LDB(B0, 0, 0); PG8_LDB(B1, 0, 1); PG8_SCHED; PG8_LDA(At, 0, 0); PG8_STAGE(PG8_SA(1, 1), a1 + hstep, voffA);
            PG8_WAIT_V(8); PG8_WAIT_L(0); PG8_BAR; PG8_MMA(0, 0, At, B0); PG8_MMA(0, 1, At, B1); PG8_BAR; PG8_SCHED;
            PG8_LDA(At, 0, 1); PG8_STAGE(PG8_SB(0, 0), b2, voffB); PG8_STAGE(PG8_SB(0, 1), b2 + hstep, voffB); PG8_STAGE(PG8_SA(0, 0), a2, voffA);
            PG8_WAIT_V(8); PG8_WAIT_L(0); PG8_BAR; PG8_MMA(1, 0, At, B0); PG8_MMA(1, 1, At, B1); PG8_BAR; PG8_SCHED;
            PG8_LDB(B0, 1, 0); PG8_LDB(B1, 1, 1); PG8_SCHED; PG8_LDA(At, 1, 0); PG8_STAGE(PG8_SA(0, 1), a2 + hstep, voffA);
            PG8_WAIT_V(8); PG8_WAIT_L(0); PG8_BAR; PG8_MMA(0, 0, At, B0); PG8_MMA(0, 1, At, B1); PG8_BAR; PG8_SCHED;
            PG8_LDA(At, 1, 1); PG8_STAGE(PG8_SB(1, 0), b3, voffB); PG8_STAGE(PG8_SB(1, 1), b3 + hstep, voffB); PG8_STAGE(PG8_SA(1, 0), a3, voffA);
            PG8_WAIT_V(8); PG8_WAIT_L(0); PG8_BAR; PG8_MMA(1, 0, At, B0); PG8_MMA(1, 1, At, B1); PG8_BAR; PG8_SCHED;
            } else {
            PG8_LDB(B0, 0, 0); PG8_SCHED; PG8_LDA(At, 0, 0); PG8_STAGE(PG8_SA(1, 1), a1 + hstep, voffA);
            PG8_WAIT_L(8); PG8_BAR; PG8_WAIT_L(0); PG8_MMA(0, 0, At, B0); PG8_BAR; PG8_SCHED;
            PG8_LDB(B1, 0, 1); PG8_STAGE(PG8_SB(0, 0), b2, voffB);
            PG8_BAR; PG8_WAIT_L(0); PG8_MMA(0, 1, At, B1); PG8_BAR;
            PG8_LDA(At, 0, 1); PG8_STAGE(PG8_SA(0, 0), a2, voffA);
            PG8_BAR; PG8_WAIT_L(0); PG8_MMA(1, 0, At, B0); PG8_BAR; PG8_SCHED;
            PG8_STAGE(PG8_SB(0, 1), b2 + hstep, voffB);
            PG8_WAIT_V(6); PG8_BAR; PG8_MMA(1, 1, At, B1); PG8_BAR;
            PG8_LDB(B0, 1, 0); PG8_SCHED; PG8_LDA(At, 1, 0); PG8_STAGE(PG8_SA(0, 1), a2 + hstep, voffA);
            PG8_WAIT_L(8); PG8_BAR; PG8_WAIT_L(0); PG8_MMA(0, 0, At, B0); PG8_BAR; PG8_SCHED;
            PG8_LDB(B1, 1, 1); PG8_STAGE(PG8_SB(1, 0), b3, voffB);
            PG8_BAR; PG8_WAIT_L(0); PG8_MMA(0, 1, At, B1); PG8_BAR;
            PG8_LDA(At, 1, 1); PG8_STAGE(PG8_SA(1, 0), a3, voffA);
            PG8_BAR; PG8_WAIT_L(0); PG8_MMA(1, 0, At, B0); PG8_BAR; PG8_SCHED;
            PG8_STAGE(PG8_SB(1, 1), b3 + hstep, voffB);
            PG8_WAIT_V(6); PG8_BAR; PG8_MMA(1, 1, At, B1); PG8_BAR;
            }
        }
        if constexpr (ALIGN_EPI) { if (wr == 0) PG8_BAR; }
        if constexpr (FP8) asm volatile("s_nop 15\n\ts_nop 15" : "+v"(acc[1][1][0][0]), "+v"(acc[1][1][0][1]), "+v"(acc[1][1][1][0]), "+v"(acc[1][1][1][1]), "+v"(acc[1][1][2][0]), "+v"(acc[1][1][2][1]), "+v"(acc[1][1][3][0]), "+v"(acc[1][1][3][1]));
        if constexpr (!Epi::AFTER_DRAIN) { E(acc, cur, wr, wc, fr, fq); S.done(cur); }
        if (!has_next) break;
#pragma unroll
        for (int a = 0; a < 2; ++a)
#pragma unroll
            for (int b = 0; b < 2; ++b)
#pragma unroll
                for (int m = 0; m < 4; ++m)
#pragma unroll
                    for (int n = 0; n < 2; ++n) acc[a][b][m][n] = (f32x4){0.f, 0.f, 0.f, 0.f};
        cur = nxt; cA = nA; cB = nB; ++ui;
        if constexpr (ALIGN_EPI) { if (wr == 1) PG8_BAR; }
    }
    PG8_WAIT_V(0);
    if constexpr (!ALIGN_EPI) { if (wr == 0) PG8_BAR; }
    PG8_BAR;
    if constexpr (Epi::AFTER_DRAIN) { E.fused(acc, cur, wr, wc, fr, fq, lds, wid, lane); S.done(cur); }
#undef PG8_SA
#undef PG8_SB
#undef PG8_STAGE
#undef PG8_LDA
#undef PG8_LDB
#undef PG8_MMA
#undef PG8_WAIT_V
#undef PG8_WAIT_L
#undef PG8_BAR
#undef PG8_SCHED
}
}

namespace pg8 {
struct EpiF32P {
    static constexpr bool PERM = false, AFTER_DRAIN = false;
    float* O; int ldc;
    __device__ __forceinline__ void operator()(const f32x4 (&acc)[2][2][4][2], const Unit& u, int wr, int wc, int fr, int fq) const {
        const int row0 = u.pm * BM + wr * 64 + fr, col0 = u.pn * BM + wc * 32 + 4 * fq;
#pragma unroll
        for (int ai = 0; ai < 2; ++ai)
#pragma unroll
            for (int m = 0; m < 4; ++m) { float* rowp = O + (size_t)(row0 + ai * HALF + m * 16) * ldc + col0;
#pragma unroll
                for (int bj = 0; bj < 2; ++bj)
#pragma unroll
                    for (int n = 0; n < 2; ++n) *(f32x4*)(rowp + bj * HALF + n * 16) = acc[ai][bj][m][n]; }
    }
};
struct EpiSwigluP {
    static constexpr bool PERM = true, AFTER_DRAIN = false;
    bf16_t* O; int ldc;
    __device__ __forceinline__ void operator()(const f32x4 (&acc)[2][2][4][2], const Unit& u, int wr, int wc, int fr, int fq) const {
        const int row0 = u.pm * BM + wr * 64 + fr, col0 = u.pn * HALF + wc * 32 + 8 * fq;
#pragma unroll
        for (int ai = 0; ai < 2; ++ai)
#pragma unroll
            for (int m = 0; m < 4; ++m) {
                float h[8];
#pragma unroll
                for (int n = 0; n < 2; ++n)
#pragma unroll
                    for (int j = 0; j < 4; ++j) { const float g = acc[ai][0][m][n][j], up = acc[ai][1][m][n][j];
                        h[4 * n + j] = g * up * __builtin_amdgcn_rcpf(1.0f + __builtin_amdgcn_exp2f(-1.4426950408889634f * g)); }
                u32x4 w; w.x = cvt_pk_bf16(h[0], h[1]); w.y = cvt_pk_bf16(h[2], h[3]); w.z = cvt_pk_bf16(h[4], h[5]); w.w = cvt_pk_bf16(h[6], h[7]);
                *(u32x4*)(O + (size_t)(row0 + ai * HALF + m * 16) * ldc + col0) = w; }
    }
};
struct EpiGateP {
    static constexpr bool PERM = true, AFTER_DRAIN = false;
    bf16_t* O; int ldc; const float* gate;
    __device__ __forceinline__ void operator()(const f32x4 (&acc)[2][2][4][2], const Unit& u, int wr, int wc, int fr, int fq) const {
        const int row0 = u.pm * BM + wr * 64 + fr, col0 = u.pn * BM + wc * 32 + 8 * fq;
#pragma unroll
        for (int ai = 0; ai < 2; ++ai)
#pragma unroll
            for (int m = 0; m < 4; ++m) { const int row = row0 + ai * HALF + m * 16; const float gt = gate[row]; bf16_t* rowp = O + (size_t)row * ldc + col0;
#pragma unroll
                for (int bj = 0; bj < 2; ++bj) { const f32x4 v0 = acc[ai][bj][m][0] * gt, v1 = acc[ai][bj][m][1] * gt;
                    u32x4 w; w.x = cvt_pk_bf16(v0[0], v0[1]); w.y = cvt_pk_bf16(v0[2], v0[3]); w.z = cvt_pk_bf16(v1[0], v1[1]); w.w = cvt_pk_bf16(v1[2], v1[3]);
                    *(u32x4*)(rowp + bj * HALF) = w; } }
    }
};
__device__ __forceinline__ unsigned pk4_fp8(float a, float b, float c, float d) {
    a = __builtin_fminf(__builtin_fmaxf(a, -448.f), 448.f); b = __builtin_fminf(__builtin_fmaxf(b, -448.f), 448.f);
    c = __builtin_fminf(__builtin_fmaxf(c, -448.f), 448.f); d = __builtin_fminf(__builtin_fmaxf(d, -448.f), 448.f);
    int w = 0; w = __builtin_amdgcn_cvt_pk_fp8_f32(a, b, w, false); w = __builtin_amdgcn_cvt_pk_fp8_f32(c, d, w, true); return (unsigned)w; }
struct EpiSwigluF8 {
    static constexpr bool PERM = true, AFTER_DRAIN = false;
    unsigned char* O; int ldc; float ws, hs;
    __device__ __forceinline__ void operator()(const f32x4 (&acc)[2][2][4][2], const Unit& u, int wr, int wc, int fr, int fq) const {
        const int row0 = u.pm * BM + wr * 64 + fr, col0 = u.pn * HALF + wc * 32 + 8 * fq;
#pragma unroll
        for (int ai = 0; ai < 2; ++ai)
#pragma unroll
            for (int m = 0; m < 4; ++m) {
                float h[8];
#pragma unroll
                for (int n = 0; n < 2; ++n)
#pragma unroll
                    for (int j = 0; j < 4; ++j) { const float g = acc[ai][0][m][n][j] * ws, up = acc[ai][1][m][n][j] * ws;
                        h[4 * n + j] = g * up * hs * __builtin_amdgcn_rcpf(1.0f + __builtin_amdgcn_exp2f(-1.4426950408889634f * g)); }
                typedef unsigned u32x2 __attribute__((ext_vector_type(2)));
                *(u32x2*)(O + (size_t)(row0 + ai * HALF + m * 16) * ldc + col0) = (u32x2){pk4_fp8(h[0], h[1], h[2], h[3]), pk4_fp8(h[4], h[5], h[6], h[7])}; }
    }
};
struct EpiGateS {
    static constexpr bool PERM = true, AFTER_DRAIN = false;
    bf16_t* O; int ldc; const float* gate; float sc;
    __device__ __forceinline__ void operator()(const f32x4 (&acc)[2][2][4][2], const Unit& u, int wr, int wc, int fr, int fq) const {
        const int row0 = u.pm * BM + wr * 64 + fr, col0 = u.pn * BM + wc * 32 + 8 * fq;
#pragma unroll
        for (int ai = 0; ai < 2; ++ai)
#pragma unroll
            for (int m = 0; m < 4; ++m) { const int row = row0 + ai * HALF + m * 16; const float gt = gate[row] * sc; bf16_t* rowp = O + (size_t)row * ldc + col0;
#pragma unroll
                for (int bj = 0; bj < 2; ++bj) { const f32x4 v0 = acc[ai][bj][m][0] * gt, v1 = acc[ai][bj][m][1] * gt;
                    u32x4 w; w.x = cvt_pk_bf16(v0[0], v0[1]); w.y = cvt_pk_bf16(v0[2], v0[3]); w.z = cvt_pk_bf16(v1[0], v1[1]); w.w = cvt_pk_bf16(v1[2], v1[3]);
                    *(u32x4*)(rowp + bj * HALF) = w; } }
    }
};
struct GroupedOrder {
    int nMe, nN, ntot, G, c;
    __device__ void init(int nMe_, int nN_, int ne, int G_, int c_) { nMe = nMe_; nN = nN_; ntot = nMe_ * nN_ * ne; G = G_; c = c_; }
    __device__ bool next(int i, Unit& u) const {
        const int L = i * G + c; if (L >= ntot) return false;
        const int per = nMe * nN, e = L / per, rem = L - e * per;
        u.e = e; u.pn = rem / nMe; u.pm = e * nMe + (rem - u.pn * nMe); return true;
    }
    __device__ __forceinline__ void a_ready(const Unit&) const {}
    __device__ __forceinline__ void done(const Unit&) const {}
};
struct L1InOrder {
    StaticOrder so; int G, c;
    __device__ void init(int G_, int c_) { so.init(16384, 2048, G_, 0); G = G_; c = c_; }
    __device__ bool next(int i, Unit& u) const {
        const int L = i * G + c;
        if (L < 512) { StaticOrder t = so; t.G = 1; t.c = 0; return t.next(L, u); }
        if (L < 544) { const int l = L - 512; u.pm = 64 + (l >> 2); u.pn = 2 + (l & 3); u.e = 0; return true; }
        return false;
    }
    __device__ __forceinline__ void a_ready(const Unit&) const {}
    __device__ __forceinline__ void done(const Unit&) const {}
};
}

#include <hip/hip_bf16.h>
#include <cmath>
namespace attn_body {
using bf16=__hip_bfloat16;
using bf16x8=__attribute__((ext_vector_type(8)))short;
using s16x4=__attribute__((ext_vector_type(4)))short;
using f32x16=__attribute__((ext_vector_type(16)))float;
using u32x4=__attribute__((ext_vector_type(4)))unsigned;
constexpr int D=64,OPITCH=1024;
constexpr int NW=8,QBLK=32,QB=QBLK*NW,KVBLK=64;
__device__ __forceinline__ int crow(int r,int hi){return (r&3)+8*(r>>2)+4*hi;}
#define SBAR() __builtin_amdgcn_sched_barrier(0)
__device__ __forceinline__ void cmask(f32x16&p0,f32x16&p1,int jb,int qrel,int hi){
  const float NEG=-INFINITY; int kb=64*jb+4*hi;
  #pragma unroll
  for(int r=0;r<16;++r){int kv=kb+(r&3)+8*(r>>2); if(kv>qrel)p0[r]=NEG; if(kv+32>qrel)p1[r]=NEG;}
}

constexpr int NSLOT=3, SLOTB=8192;
constexpr int LDS_K=0, LDS_V=NSLOT*SLOTB, LDS_WS=2*NSLOT*SLOTB, LDS_OST=LDS_WS+NW*64*4, LDS_BYTES=LDS_OST+NW*4096;
constexpr float C2=0.125f*1.4426950408889634f;
__device__ __forceinline__ void glds16(const void*gsrc,unsigned lds_dst){unsigned keep;
  asm volatile("s_mov_b32 %0, m0\n\ts_mov_b32 m0, %2\n\ts_nop 0\n\tglobal_load_lds_dwordx4 %1, off\n\ts_mov_b32 m0, %0":"=&s"(keep):"v"(gsrc),"s"(lds_dst):"memory");}
__device__ __forceinline__ float max3f(float a,float b,float c){float r;asm("v_max3_f32 %0, %1, %2, %3":"=v"(r):"v"(a),"v"(b),"v"(c));return r;}
__device__ __forceinline__ float max2f(float a,float b){float r;asm("v_max_f32_e32 %0, %1, %2":"=v"(r):"v"(a),"v"(b));return r;}
__device__ __forceinline__ float fadd_s(float a,float b){float r;asm("v_add_f32_e32 %0, %1, %2":"=v"(r):"v"(a),"v"(b));return r;}
__device__ __forceinline__ float fsub_s(float a,float b){float r;asm("v_sub_f32_e32 %0, %1, %2":"=v"(r):"v"(a),"v"(b));return r;}
typedef float f32x2_t __attribute__((ext_vector_type(2))); typedef __bf16 bf16x2_t __attribute__((ext_vector_type(2)));
__device__ __forceinline__ unsigned cvtpk_s(float lo,float hi){f32x2_t v={lo,hi};bf16x2_t b=__builtin_convertvector(v,bf16x2_t);return __builtin_bit_cast(unsigned,b);}
#define WAIT_BAR(N) asm volatile("s_waitcnt vmcnt(" #N ") lgkmcnt(0)\n\ts_barrier":::"memory")

__device__ __forceinline__ void qkt(f32x16&p0,f32x16&p1,const char*Kslot,const bf16x8*qr,const f32x16&negm,int r32,int hi){
  const char*kb=Kslot+hi*1024+r32*16;
  #pragma unroll
  for(int d0=0;d0<4;++d0){
    const bf16x8 b0=*reinterpret_cast<const bf16x8*>(kb+d0*2048);
    const bf16x8 b1=*reinterpret_cast<const bf16x8*>(kb+d0*2048+512);
    if(d0==0){p0=__builtin_amdgcn_mfma_f32_32x32x16_bf16(b0,qr[0],negm,0,0,0);p1=__builtin_amdgcn_mfma_f32_32x32x16_bf16(b1,qr[0],negm,0,0,0);}
    else{p0=__builtin_amdgcn_mfma_f32_32x32x16_bf16(b0,qr[d0],p0,0,0,0);p1=__builtin_amdgcn_mfma_f32_32x32x16_bf16(b1,qr[d0],p1,0,0,0);}}
}
typedef __attribute__((address_space(3))) const char* lds_cptr;
typedef short v4i16_t __attribute__((ext_vector_type(4)));
__device__ __forceinline__ void kload8(bf16x8*kf,lds_cptr kp){
  kf[0]=*(const __attribute__((address_space(3))) bf16x8*)(kp);      kf[1]=*(const __attribute__((address_space(3))) bf16x8*)(kp+512);
  kf[2]=*(const __attribute__((address_space(3))) bf16x8*)(kp+2048); kf[3]=*(const __attribute__((address_space(3))) bf16x8*)(kp+2560);
  kf[4]=*(const __attribute__((address_space(3))) bf16x8*)(kp+4096); kf[5]=*(const __attribute__((address_space(3))) bf16x8*)(kp+4608);
  kf[6]=*(const __attribute__((address_space(3))) bf16x8*)(kp+6144); kf[7]=*(const __attribute__((address_space(3))) bf16x8*)(kp+6656);
}
__device__ __forceinline__ void kload2(bf16x8*kf,lds_cptr kp,int j){ kf[2*j]=*(const __attribute__((address_space(3))) bf16x8*)(kp+j*2048); kf[2*j+1]=*(const __attribute__((address_space(3))) bf16x8*)(kp+j*2048+512); }
__device__ __forceinline__ s16x4 vtr(lds_cptr p){ return __builtin_bit_cast(s16x4,__builtin_amdgcn_ds_read_tr16_b64_v4i16((__attribute__((address_space(3))) v4i16_t*)p)); }
__device__ __forceinline__ float rowmax(const f32x16&p0,const f32x16&p1){
  float a=max3f(p0[0],p0[1],p1[0]),b=max3f(p0[2],p0[3],p1[1]);a=max3f(a,p1[2],p1[3]);
  #pragma unroll
  for(int r=4;r<16;r+=4){a=max3f(a,p0[r],p0[r+1]);b=max3f(b,p0[r+2],p0[r+3]);a=max3f(a,p1[r],p1[r+1]);b=max3f(b,p1[r+2],p1[r+3]);}
  const float m=max2f(a,b);
  auto rr=__builtin_amdgcn_permlane32_swap(__float_as_uint(m),__float_as_uint(m),false,false);
  return max2f(__uint_as_float(rr[0]),__uint_as_float(rr[1]));
}
__device__ __forceinline__ void pv(f32x16*o,int vb,bf16x8 pa0,bf16x8 pa1,bf16x8 pa2,bf16x8 pa3){
  #pragma unroll
  for(int d0=0;d0<2;++d0){s16x4 lo[4],hi[4];
    #pragma unroll
    for(int ks=0;ks<4;++ks){
      asm volatile("ds_read_b64_tr_b16 %0,%1 offset:%c2":"=&v"(lo[ks]):"v"(vb),"i"(d0*4096+ks*1024):"memory");
      asm volatile("ds_read_b64_tr_b16 %0,%1 offset:%c2":"=&v"(hi[ks]):"v"(vb),"i"(d0*4096+ks*1024+512):"memory");}
    asm volatile("s_waitcnt lgkmcnt(0)":::"memory");SBAR();
    #define PK(k) (bf16x8){lo[k][0],lo[k][1],lo[k][2],lo[k][3],hi[k][0],hi[k][1],hi[k][2],hi[k][3]}
    o[d0]=__builtin_amdgcn_mfma_f32_32x32x16_bf16(pa0,PK(0),o[d0],0,0,0);
    o[d0]=__builtin_amdgcn_mfma_f32_32x32x16_bf16(pa1,PK(1),o[d0],0,0,0);
    o[d0]=__builtin_amdgcn_mfma_f32_32x32x16_bf16(pa2,PK(2),o[d0],0,0,0);
    o[d0]=__builtin_amdgcn_mfma_f32_32x32x16_bf16(pa3,PK(3),o[d0],0,0,0);
    #undef PK
  }
}

#ifndef ATTN_STORE16
#define ATTN_STORE16(p,v) (*(u32x4*)(p)=(v))
#endif
struct AU { const bf16* Qp; const bf16* Kp; const bf16* Vp; bf16* Op; int qrow0, lat_row0, ctx_row0, nlat_t, NT; };
struct NoMask { __device__ __forceinline__ void apply(f32x16&,f32x16&,int,int)const{} };
typedef __attribute__((address_space(3))) const float* lds_cfptr;
struct NAMask { lds_cfptr tb0; int r, rs, rs_min, cb;
  __device__ __forceinline__ void apply(f32x16&p0,f32x16&p1,int t,int hi)const{
    if(t<4)return;
    const int kr=rs_min+t-4; const float NEG=-INFINITY;
    if((unsigned)(kr-rs)>7u){
      #pragma unroll
      for(int i=0;i<16;++i){p0[i]=NEG;p1[i]=NEG;}
      return; }
    const lds_cfptr tb=tb0+(kr-r+7)*32+4*hi;
    #pragma unroll
    for(int i=0;i<16;++i){ const int k0=(i&3)+8*(i>>2); const int d0=cb+k0, d1=cb+k0+32;
      const float b0=tb[k0], b1=tb[k0+32];
      p0[i]=((unsigned)d0<=15u)?p0[i]+b0:NEG; p1[i]=((unsigned)d1<=15u)?p1[i]+b1:NEG; }
  }
};
template<int THRL,int PITCH,class MaskT> __device__ __forceinline__ void attn_unit(const AU& u,char*shm,const MaskT& mk){
  const int tid=threadIdx.x,lane=tid&63,r32=lane&31,hi=lane>>5; const int wid=__builtin_amdgcn_readfirstlane(tid>>6);
  const bf16*Qw=u.Qp+(long)(u.qrow0+wid*QBLK)*PITCH;
  const bf16*Kh=u.Kp,*Vh=u.Vp;
  const unsigned lds0=(unsigned)(uintptr_t)shm;
  float*wsf=(float*)(shm+LDS_WS)+wid*64;
  const bf16*ksrc=Kh+(long)lane*PITCH+wid*8;
  const bf16*vsrc=Vh+(long)(16*(wid&3)+(lane>>2))*PITCH+(wid>>2)*32+(lane&3)*8;
  const unsigned kdst=lds0+LDS_K+wid*1024, vdst=lds0+LDS_V+wid*1024;
  #define TROW(t) ((long)((t)<u.nlat_t?u.lat_row0+KVBLK*(t):u.ctx_row0+KVBLK*((t)-u.nlat_t))*PITCH)
  #define DMA_K(t,slot) glds16(ksrc+TROW(t),(unsigned)__builtin_amdgcn_readfirstlane(kdst+(slot)))
  #define DMA_V(t,slot) glds16(vsrc+TROW(t),(unsigned)__builtin_amdgcn_readfirstlane(vdst+(slot)))
  const int vb0=(int)(lds0+LDS_V)+((lane>>4)&1)*32+(lane&3)*8+(4*hi+((lane&15)>>2))*64;
  const char*Kbase=shm+LDS_K; bf16x8 kf[8];
  const lds_cptr shm3=(lds_cptr)shm; const lds_cptr kp0=shm3+LDS_K+hi*1024+r32*16; const lds_cptr vp0=shm3+LDS_V+((lane>>4)&1)*32+(lane&3)*8+(4*hi+((lane&15)>>2))*64;
  const int NT=u.NT;
  DMA_K(0,0);DMA_V(0,0);DMA_K(1,SLOTB);
  bf16x8 qr[4];
  #pragma unroll
  for(int d0=0;d0<4;++d0)qr[d0]=*reinterpret_cast<const bf16x8*>(&Qw[(long)r32*PITCH+d0*16+hi*8]);
  float mhat=0.f,l_reg=0.f;f32x16 o[2];o[0]=f32x16{};o[1]=f32x16{};f32x16 negm=f32x16{};asm volatile("":"+v"(negm));
  #define CMASK(P0,P1,t) mk.apply(P0,P1,(t),hi)
  bool resc=false;
  #define START(P0,P1) do{ const float rm=rowmax(P0,P1); resc=false; \
    { const float dl=rm; mhat=fadd_s(mhat,dl); \
      _Pragma("unroll") for(int r=0;r<16;++r){P0[r]=fsub_s(P0[r],dl);P1[r]=fsub_s(P1[r],dl);} \
      _Pragma("unroll") for(int r=0;r<16;++r)negm[r]=-mhat; asm volatile("":"+v"(negm)); } \
    _Pragma("unroll") for(int r=0;r<16;++r)P0[r]=__builtin_amdgcn_exp2f(P0[r]); }while(0)
  #define RESC() do{ if(resc){ asm volatile("s_waitcnt lgkmcnt(0)":::"memory"); \
      _Pragma("unroll") for(int d_=0;d_<2;++d_) _Pragma("unroll") for(int r=0;r<16;++r)o[d_][r]*=wsf[crow(r,hi)]; } }while(0)
  f32x16 pA0,pA1,pB0,pB1;
  int sl_prev=0,sl_cur=0,sl_next=SLOTB;
  #define ROT() do{sl_prev=sl_cur;sl_cur=sl_next;sl_next=(sl_next==(NSLOT-1)*SLOTB)?0:sl_next+SLOTB;}while(0)
  DMA_K(2,2*SLOTB);
  WAIT_BAR(3);
  qkt(pA0,pA1,Kbase,qr,negm,r32,hi);asm volatile("s_nop 15\n\ts_nop 7":"+v"(pA0),"+v"(pA1));CMASK(pA0,pA1,0);
  START(pA0,pA1);
  _Pragma("unroll") for(int r=0;r<16;++r)pA1[r]=__builtin_amdgcn_exp2f(pA1[r]);
  WAIT_BAR(0);
  DMA_K(3,0);DMA_V(1,SLOTB);
  ROT();
  kload8(kf,kp0+sl_cur);
  WAIT_BAR(2);
  s16x4 vlo[8],vhi[8]; u32x4 pw0,pw1,pw2,pw3;
  #define PKW(P,B) cvtpk_s(P[B],P[B+1])
  #define PAF(k) __builtin_bit_cast(bf16x8,pw##k)
  #define VFR(i) (bf16x8){vlo[i][0],vlo[i][1],vlo[i][2],vlo[i][3],vhi[i][0],vhi[i][1],vhi[i][2],vhi[i][3]}
  #define PIN(x) asm volatile("":"+v"(x))
  #define MX3(a,b,c) __builtin_fmaxf(__builtin_fmaxf((a),(b)),(c))
  #define GAPA(MF,A0,A1,A2,A3,W0,W1,PW) do{ MF; sacc+=A0; sacc+=A1; sacc+=A2; sacc+=A3; PIN(sacc); W0; W1; PIN(PW); SBAR(); }while(0)
  #define EX(v) __builtin_amdgcn_exp2f(v)
  #define GAPB(MF,X,B) do{ MF; X[B]=EX(X[B]); X[B+1]=EX(X[B+1]); X[B+2]=EX(X[B+2]); X[B+3]=EX(X[B+3]); PIN(X); SBAR(); }while(0)
  #define VRD(i) do{ vlo[i]=vtr(vp_+(((i)>>2)*4096+((i)&3)*1024)); vhi[i]=vtr(vp_+(((i)>>2)*4096+((i)&3)*1024+512)); }while(0)
  #define KRD(G,j) do{ if(G){ kload2(kf,kp0+sl_next,j); SBAR(); } }while(0)
  #define STEP(C0,C1,P0,P1,t,GK,GV,GL) do{ SBAR(); \
    const lds_cptr vp_=vp0+sl_prev; \
    VRD(0); SBAR(); float sacc=(P0[0]+P0[1]); \
    GAPA(C0=__builtin_amdgcn_mfma_f32_32x32x16_bf16(kf[0],qr[0],negm,0,0,0), P0[2],P0[3],P0[4],P0[5],     pw0[0]=PKW(P0,0), pw0[1]=PKW(P0,2), pw0); \
    VRD(4); SBAR(); GAPA(C1=__builtin_amdgcn_mfma_f32_32x32x16_bf16(kf[1],qr[0],negm,0,0,0), P0[6],P0[7],P0[8],P0[9],     pw0[2]=PKW(P0,4), pw0[3]=PKW(P0,6), pw0); \
    VRD(1); SBAR(); GAPA(C0=__builtin_amdgcn_mfma_f32_32x32x16_bf16(kf[2],qr[1],C0,0,0,0),   P0[10],P0[11],P0[12],P0[13], pw1[0]=PKW(P0,8), pw1[1]=PKW(P0,10), pw1); \
    VRD(5); SBAR(); GAPA(C1=__builtin_amdgcn_mfma_f32_32x32x16_bf16(kf[3],qr[1],C1,0,0,0),   P0[14],P0[15],P1[0],P1[1],   pw1[2]=PKW(P0,12),pw1[3]=PKW(P0,14), pw1); \
    VRD(2); SBAR(); GAPA(C0=__builtin_amdgcn_mfma_f32_32x32x16_bf16(kf[4],qr[2],C0,0,0,0),   P1[2],P1[3],P1[4],P1[5],     pw2[0]=PKW(P1,0), pw2[1]=PKW(P1,2), pw2); \
    VRD(6); SBAR(); GAPA(C1=__builtin_amdgcn_mfma_f32_32x32x16_bf16(kf[5],qr[2],C1,0,0,0),   P1[6],P1[7],P1[8],P1[9],     pw2[2]=PKW(P1,4), pw2[3]=PKW(P1,6), pw2); \
    VRD(3); SBAR(); GAPA(C0=__builtin_amdgcn_mfma_f32_32x32x16_bf16(kf[6],qr[3],C0,0,0,0),   P1[10],P1[11],P1[12],P1[13], pw3[0]=PKW(P1,8), pw3[1]=PKW(P1,10), pw3); \
    VRD(7); SBAR(); GAPA(C1=__builtin_amdgcn_mfma_f32_32x32x16_bf16(kf[7],qr[3],C1,0,0,0),   P1[14],P1[15],0.f,0.f,       pw3[2]=PKW(P1,12),pw3[3]=PKW(P1,14), pw3); \
    l_reg+=sacc; \
    if(GK){DMA_K((t)+3,sl_cur);} if(GV){DMA_V((t)+1,sl_next);} \
    CMASK(C0,C1,t); \
    { float a=MX3(C0[0],C0[1],C1[0]),b=MX3(C0[2],C0[3],C1[1]); a=MX3(a,C1[2],C1[3]); \
      _Pragma("unroll") for(int r=4;r<16;r+=4){a=MX3(a,C0[r],C0[r+1]);b=MX3(b,C0[r+2],C0[r+3]);a=MX3(a,C1[r],C1[r+1]);b=MX3(b,C1[r+2],C1[r+3]);} \
      float rm=__builtin_fmaxf(a,b); { auto rr=__builtin_amdgcn_permlane32_swap(__float_as_uint(rm),__float_as_uint(rm),false,false); rm=__builtin_fmaxf(__uint_as_float(rr[0]),__uint_as_float(rr[1])); } \
      resc=false; \
      if(__builtin_expect(__any(rm>(float)THRL),0)){ const float dl=__builtin_fmaxf(rm,0.f); mhat+=dl; \
        _Pragma("unroll") for(int r=0;r<16;++r){C0[r]-=dl;C1[r]-=dl;} \
        _Pragma("unroll") for(int r=0;r<16;++r)negm[r]=-mhat; asm volatile("":"+v"(negm)); \
        const float f=__builtin_amdgcn_exp2f(-dl); l_reg*=f; if(hi==0)wsf[r32]=f; resc=true; } } \
    SBAR(); \
    GAPB(o[0]=__builtin_amdgcn_mfma_f32_32x32x16_bf16(PAF(0),VFR(0),o[0],0,0,0), C0,0); \
    GAPB(o[1]=__builtin_amdgcn_mfma_f32_32x32x16_bf16(PAF(0),VFR(4),o[1],0,0,0), C0,4); \
    KRD(GL,0); GAPB(o[0]=__builtin_amdgcn_mfma_f32_32x32x16_bf16(PAF(1),VFR(1),o[0],0,0,0), C0,8); \
    KRD(GL,1); GAPB(o[1]=__builtin_amdgcn_mfma_f32_32x32x16_bf16(PAF(1),VFR(5),o[1],0,0,0), C0,12); \
    KRD(GL,2); GAPB(o[0]=__builtin_amdgcn_mfma_f32_32x32x16_bf16(PAF(2),VFR(2),o[0],0,0,0), C1,0); \
    KRD(GL,3); GAPB(o[1]=__builtin_amdgcn_mfma_f32_32x32x16_bf16(PAF(2),VFR(6),o[1],0,0,0), C1,4); \
    GAPB(o[0]=__builtin_amdgcn_mfma_f32_32x32x16_bf16(PAF(3),VFR(3),o[0],0,0,0), C1,8); \
    GAPB(o[1]=__builtin_amdgcn_mfma_f32_32x32x16_bf16(PAF(3),VFR(7),o[1],0,0,0), C1,12); \
    }while(0)
  int t=1;
  #undef CMASK
  #define CMASK(P0,P1,t) mk.apply(P0,P1,(t),hi)
  for(;t+5<NT;t+=2){
    STEP(pB0,pB1,pA0,pA1,t,true,true,true);     WAIT_BAR(2); RESC(); ROT();
    STEP(pA0,pA1,pB0,pB1,t+1,true,true,true);   WAIT_BAR(2); RESC(); ROT();
  }
  #undef CMASK
  #define CMASK(P0,P1,t) mk.apply(P0,P1,(t),hi)
  #define ENDW(tt) do{ if((tt)+3<NT){WAIT_BAR(2);} else if((tt)+2<NT){WAIT_BAR(1);} else {WAIT_BAR(0);} }while(0)
  for(;t+1<NT;t+=2){
    STEP(pB0,pB1,pA0,pA1,t,(t+3<NT),(t+1<NT),(t+1<NT));       ENDW(t);   RESC(); ROT();
    STEP(pA0,pA1,pB0,pB1,t+1,(t+4<NT),(t+2<NT),(t+2<NT));     ENDW(t+1); RESC(); ROT();
  }
  STEP(pB0,pB1,pA0,pA1,NT-1,false,false,false); RESC();
  { float sacc=pB0[0]+pB0[1]; _Pragma("unroll") for(int r=2;r<16;++r)sacc+=pB0[r]; _Pragma("unroll") for(int r=0;r<16;++r)sacc+=pB1[r]; l_reg+=sacc;
    pw0=(u32x4){PKW(pB0,0),PKW(pB0,2),PKW(pB0,4),PKW(pB0,6)};pw1=(u32x4){PKW(pB0,8),PKW(pB0,10),PKW(pB0,12),PKW(pB0,14)};pw2=(u32x4){PKW(pB1,0),PKW(pB1,2),PKW(pB1,4),PKW(pB1,6)};pw3=(u32x4){PKW(pB1,8),PKW(pB1,10),PKW(pB1,12),PKW(pB1,14)};
    SBAR(); pv(o,vb0+sl_cur,PAF(0),PAF(1),PAF(2),PAF(3)); }
  #undef PKW
  #undef PAF
  #undef VFR
  #undef PIN
  #undef MX3
  #undef GAPA
  #undef GAPB
  #undef EX
  #undef VRD
  #undef KRD
  #undef STEP
  #undef ENDW
  {auto rr=__builtin_amdgcn_permlane32_swap(__float_as_uint(l_reg),__float_as_uint(l_reg),false,false);l_reg=__uint_as_float(rr[0])+__uint_as_float(rr[1]);}
  if(hi==0)wsf[32+r32]=l_reg;asm volatile("s_waitcnt lgkmcnt(0)":::"memory");
  float rli[16];
  #pragma unroll
  for(int r=0;r<16;++r)rli[r]=__builtin_amdgcn_rcpf(wsf[32+crow(r,hi)]);
  bf16*Ow=u.Op+(long)(u.qrow0+wid*QBLK)*OPITCH;
  { bf16*stg=(bf16*)(shm+LDS_OST)+wid*2048;
    #pragma unroll
    for(int r=0;r<16;++r){const int orow=crow(r,hi);
      #pragma unroll
      for(int d0=0;d0<2;++d0)stg[orow*64+d0*32+r32]=__float2bfloat16(o[d0][r]*rli[r]);}
    asm volatile("s_waitcnt lgkmcnt(0)":::"memory");
    #pragma unroll
    for(int i=0;i<4;++i){const int row=i*8+(lane>>3),ch=lane&7; const u32x4 v=*(const u32x4*)(stg+row*64+ch*8); ATTN_STORE16(Ow+(long)row*OPITCH+ch*8,v);} }
  asm volatile("s_waitcnt lgkmcnt(0)\n\ts_barrier":::"memory");
  #undef DMA_K
  #undef TROW
  #undef DMA_V
  #undef CMASK
  #undef START
  #undef RESC
  #undef ROT
}
constexpr int ATTN_LDS_BYTES=LDS_BYTES;
#undef SBAR
#undef WAIT_BAR
}

struct Params { const float* in[26]; float* out; unsigned char* ws; int ph_lo, ph_hi; };
struct Ctx { LAS unsigned char* lds; int tid, lane, wave, vcu, G, gw, NGW; };
enum { I_X = 0, I_C, I_CTX, I_CCTX, I_ADAW, I_ADAB, I_LNG, I_LNB, I_W0IN, I_W0OUT, I_LQ1, I_LK1, I_LQ2, I_LK2, I_SUBLN, I_QN, I_KN,
       I_W1IN, I_W1OUT, I_RPB, I_POOLW, I_POOLS, I_ROUTER, I_WG, I_WU, I_WD };

__device__ __forceinline__ const float* mod_row(const Params& p, int layer, int row) {
    return (const float*)(p.ws + WS_MOD) + (size_t)(layer * 9 + (row < LAT ? (row >> 11) : 8)) * 6144;
}

__device__ __forceinline__ void ph_prologue(const Params& p, const Ctx& c) {
    const float* cin = p.in[I_C]; const float* cctx = p.in[I_CCTX]; const float* ada_w = p.in[I_ADAW]; const float* ada_b = p.in[I_ADAB];
    float* MOD = (float*)(p.ws + WS_MOD);
    LAS float* sc = (LAS float*)c.lds;
    LAS float* red = sc + 9 * 1024;
    for (int i = c.tid; i < 9 * 1024; i += 512) { const float v = i < 8192 ? cin[i] : cctx[i - 8192]; sc[i] = v / (1.f + expf(-v)); }
    __syncthreads();
    for (int u = c.vcu; u < 256; u += c.G) {
        const int layer = u >> 7, j0 = (u & 127) * 48;
        const int jc = c.tid % 48, kg = c.tid / 48;
        if (kg < 10) {
            float acc[9];
#pragma unroll
            for (int m = 0; m < 9; ++m) acc[m] = 0.f;
            const float* wp = ada_w + (size_t)layer * 1024 * 6144 + j0 + jc;
#pragma unroll 8
            for (int k = kg; k < 1024; k += 10) {
                const float w = wp[(size_t)k * 6144];
#pragma unroll
                for (int m = 0; m < 9; ++m) acc[m] += sc[m * 1024 + k] * w;
            }
#pragma unroll
            for (int m = 0; m < 9; ++m) red[(kg * 9 + m) * 48 + jc] = acc[m];
        }
        __syncthreads();
        if (c.tid < 432) {
            const int m = c.tid / 48, j = c.tid % 48; float s = 0.f;
#pragma unroll
            for (int g = 0; g < 10; ++g) s += red[(g * 9 + m) * 48 + j];
            MOD[(size_t)(layer * 9 + m) * 6144 + j0 + j] = s + ada_b[layer * 6144 + j0 + j];
        }
        __syncthreads();
    }
    if (c.vcu == 0) {
        f32x2* R = (f32x2*)(p.ws + WS_ROPE);
        for (int i = c.tid; i < 1024; i += 512) {
            const int pos = i >> 4, f = i & 15;
            const float inv = exp2f(-(float)f * (13.287712379549449f / 16.f));
            const float a = (float)pos * inv;
            const float k = rintf(a * 0.15915494309189535f);
            float rr = fmaf(-k, 6.28125f, a); rr = fmaf(-k, 1.9353071795864769e-3f, rr);
            R[i] = (f32x2){__cosf(rr), __sinf(rr)};
        }
    }
}


__device__ __forceinline__ void transpose_item(const float* W, int ldw, int k0, int n0, bf16* WT, int Kd, int drow0, LAS float* scr, int lane) {
#pragma unroll 8
    for (int i = 0; i < 32; ++i) { const int kk = 2 * i + (lane >> 5); scr[kk * 33 + (lane & 31)] = W[(size_t)(k0 + kk) * ldw + n0 + (lane & 31)]; }
    asm volatile("s_waitcnt lgkmcnt(0)" ::: "memory");
    const int ch = lane & 7;
#pragma unroll
    for (int j = 0; j < 4; ++j) { const int n = (lane >> 3) + 8 * j; const LAS float* sp = scr + (8 * ch) * 33 + n;
        v4u o; o.x = pk2(sp[0 * 33], sp[1 * 33]); o.y = pk2(sp[2 * 33], sp[3 * 33]); o.z = pk2(sp[4 * 33], sp[5 * 33]); o.w = pk2(sp[6 * 33], sp[7 * 33]);
        *(v4u*)(WT + (size_t)(drow0 + n) * Kd + k0 + 8 * ch) = o; }
    asm volatile("s_waitcnt lgkmcnt(0)" ::: "memory");
}
__device__ __forceinline__ void transpose_item8(const float* W, int ldw, int k0, int n0, unsigned char* WT8, int Kd, int drow0, float scale, LAS float* scr, int lane) {
#pragma unroll 8
    for (int i = 0; i < 32; ++i) { const int kk = 2 * i + (lane >> 5); scr[kk * 33 + (lane & 31)] = W[(size_t)(k0 + kk) * ldw + n0 + (lane & 31)]; }
    asm volatile("s_waitcnt lgkmcnt(0)" ::: "memory");
    const int n = lane >> 1, hf = lane & 1; const LAS float* sp = scr + (32 * hf) * 33 + n;
    v4u o0, o1;
    o0.x = pg8::pk4_fp8(sp[0 * 33] * scale, sp[1 * 33] * scale, sp[2 * 33] * scale, sp[3 * 33] * scale);     o0.y = pg8::pk4_fp8(sp[4 * 33] * scale, sp[5 * 33] * scale, sp[6 * 33] * scale, sp[7 * 33] * scale);
    o0.z = pg8::pk4_fp8(sp[8 * 33] * scale, sp[9 * 33] * scale, sp[10 * 33] * scale, sp[11 * 33] * scale);   o0.w = pg8::pk4_fp8(sp[12 * 33] * scale, sp[13 * 33] * scale, sp[14 * 33] * scale, sp[15 * 33] * scale);
    o1.x = pg8::pk4_fp8(sp[16 * 33] * scale, sp[17 * 33] * scale, sp[18 * 33] * scale, sp[19 * 33] * scale); o1.y = pg8::pk4_fp8(sp[20 * 33] * scale, sp[21 * 33] * scale, sp[22 * 33] * scale, sp[23 * 33] * scale);
    o1.z = pg8::pk4_fp8(sp[24 * 33] * scale, sp[25 * 33] * scale, sp[26 * 33] * scale, sp[27 * 33] * scale); o1.w = pg8::pk4_fp8(sp[28 * 33] * scale, sp[29 * 33] * scale, sp[30 * 33] * scale, sp[31 * 33] * scale);
    unsigned char* dst = WT8 + (size_t)(drow0 + n) * Kd + k0 + 32 * hf;
    *(v4u*)dst = o0; *(v4u*)(dst + 16) = o1;
    asm volatile("s_waitcnt lgkmcnt(0)" ::: "memory");
}
struct TBlk { const float* src; unsigned char* dst; int ldw, Kd, gu, which; float scale; };
__device__ __forceinline__ TBlk tblk_decode(const Params& p, int blk) {
    const int ie = blk / 96, q = blk - ie * 96, layer = ie >> 4, e = ie & 15, which = q >> 5, idx = q & 31;
    TBlk t; t.which = which;
    if (which < 2) { const int kb = idx & 3, nb = idx >> 2, k0 = 256 * kb, n0 = 256 * nb;
        t.src = (which == 0 ? p.in[I_WG] : p.in[I_WU]) + (size_t)ie * DM * FF + (size_t)k0 * FF + n0; t.ldw = FF; t.Kd = DM; t.scale = W8_GU; t.gu = 1;
        t.dst = p.ws + WS_WGU + (size_t)layer * WS_MOE_LSTRIDE + (size_t)e * 4096 * DM + (size_t)(2 * nb) * 256 * DM + k0; }
    else { const int kb = idx & 7, nb = idx >> 3, k0 = 256 * kb, n0 = 256 * nb;
        t.src = p.in[I_WD] + (size_t)ie * FF * DM + (size_t)k0 * DM + n0; t.ldw = DM; t.Kd = FF; t.scale = W8_DN; t.gu = 0;
        t.dst = p.ws + WS_WDN + (size_t)layer * WS_MOE_LSTRIDE + (size_t)e * DM * FF + (size_t)n0 * FF + k0; }
    return t;
}
__device__ __forceinline__ void tblk_load(const TBlk& t, f32x4 (&v)[16], int wave, int lane, int hf) {
    const float* sp = t.src + (size_t)(32 * wave + 16 * hf) * t.ldw + 4 * lane;
#pragma unroll
    for (int i = 0; i < 16; ++i) v[i] = *(const f32x4*)(sp + (size_t)i * t.ldw);
}
constexpr int TPITCH = 264;
__device__ __forceinline__ void tblk_pack(const TBlk& t, const f32x4 (&v)[16], LAS unsigned char* T, int wave, int lane, int hf) {
#pragma unroll
    for (int i = 0; i < 4; ++i) {
        const f32x4 r0 = v[4 * i] * t.scale, r1 = v[4 * i + 1] * t.scale, r2 = v[4 * i + 2] * t.scale, r3 = v[4 * i + 3] * t.scale;
#pragma unroll
        for (int j = 0; j < 4; ++j) { int w = 0; w = __builtin_amdgcn_cvt_pk_fp8_f32(r0[j], r1[j], w, false); w = __builtin_amdgcn_cvt_pk_fp8_f32(r2[j], r3[j], w, true);
            *(LAS unsigned*)(T + (64 * j + lane) * TPITCH + 32 * wave + 16 * hf + 4 * i) = (unsigned)w; }
    }
}
__device__ __forceinline__ void tblk_writeout(const TBlk& t, const LAS unsigned char* T, int tid) {
#pragma unroll
    for (int it = 0; it < 8; ++it) { const int idx = it * 512 + tid, n = idx >> 4, ch = idx & 15, rho = (n & 3) * 64 + (n >> 2);
        const LAS unsigned char* sp = T + rho * TPITCH + 16 * ch;
        const v2u a = *(const LAS v2u*)sp, b2 = *(const LAS v2u*)(sp + 8);
        const int drow = t.gu ? ((n >> 7) * 256 + (n & 127) + t.which * 128) : n;
        *(v4u*)(t.dst + (size_t)drow * t.Kd + 16 * ch) = (v4u){a.x, a.y, b2.x, b2.y}; }
}
__device__ __forceinline__ void ph_transposes(const Params& p, const Ctx& c) {
    LAS float* scr = (LAS float*)(c.lds + c.wave * 16384);
    constexpr int I0 = 16 * 72, I1 = 16 * 32, I2 = 16 * 64, I3 = 16 * 32, ISM = I0 + I1 + I2 + I3;
    for (int r0 = c.gw; r0 < ISM; r0 += c.NGW) {
        int r = r0;
        if (r < I0) { transpose_item(p.in[I_W0IN], EIN, 64 * (r / 72), 32 * (r % 72), (bf16*)(p.ws + WS_W0IN), DM, 32 * (r % 72), scr, c.lane); continue; } r -= I0;
        if (r < I1) { transpose_item(p.in[I_W0OUT], DM, 64 * (r / 32), 32 * (r % 32), (bf16*)(p.ws + WS_W0OUT), DM, 32 * (r % 32), scr, c.lane); continue; } r -= I1;
        if (r < I2) { transpose_item(p.in[I_W1IN], OIN, 64 * (r / 64), 32 * (r % 64), (bf16*)(p.ws + WS_W1IN), DM, 32 * (r % 64), scr, c.lane); continue; } r -= I2;
        transpose_item(p.in[I_W1OUT], DM, 64 * (r / 32), 32 * (r % 32), (bf16*)(p.ws + WS_W1OUT), DM, 32 * (r % 32), scr, c.lane);
    }
    static_assert(MOE_FP8, "the expert-weight transposes write e4m3 copies");
    __syncthreads();
    constexpr int NBLK = 32 * 96;
    LAS unsigned char* T = c.lds;
    f32x4 va[16], vb[16];
    int blk = c.vcu;
    TBlk t = tblk_decode(p, blk < NBLK ? blk : 0);
    if (blk < NBLK) tblk_load(t, va, c.wave, c.lane, 0);
#pragma unroll 1
    for (; blk < NBLK; blk += c.G) {
        tblk_load(t, vb, c.wave, c.lane, 1);
        tblk_pack(t, va, T, c.wave, c.lane, 0);
        const int nb = blk + c.G;
        TBlk tn = tblk_decode(p, nb < NBLK ? nb : 0);
        if (nb < NBLK) tblk_load(tn, va, c.wave, c.lane, 0);
        tblk_pack(t, vb, T, c.wave, c.lane, 1);
        __syncthreads();
        tblk_writeout(t, T, c.tid);
        __syncthreads();
        t = tn;
    }
}

__device__ __forceinline__ void ph_modulate0(const Params& p, const Ctx& c) {
    bf16* HB = (bf16*)(p.ws + WS_HB);
    for (int row = c.gw; row < NTOK; row += c.NGW) {
        const float* src = row < LAT ? p.in[I_X] + (size_t)row * DM : p.in[I_CTX] + (size_t)(row - LAT) * DM;
        const float* mod = mod_row(p, 0, row);
#pragma unroll
        for (int j = 0; j < 4; ++j) {
            const int col = 4 * c.lane + 256 * j;
            const f32x4 v = *(const f32x4*)(src + col), sh = *(const f32x4*)(mod + col), s = *(const f32x4*)(mod + 1024 + col);
            const f32x4 h = v * (s + 1.f) + sh;
            *(v2u*)(HB + (size_t)row * DM + col) = (v2u){pk2(h.x, h.y), pk2(h.z, h.w)};
        }
    }
}

struct NG { const bf16* A; int lda; const float* W0; const float* W1; int ldw; size_t wstride; int Mb; int row_begin, row_end, col_begin, col_end, K; };
template <int NB, class Epi>
__device__ __forceinline__ void ngemm(const NG& g, const Ctx& c, const Epi& epi) {
    const int nmt = (g.row_end - g.row_begin) / 32, nnt = (g.col_end - g.col_begin) / 32;
    const int l31 = c.lane & 31, lh = c.lane >> 5;
    for (int t = c.gw; t < nmt * nnt; t += c.NGW) {
        const int mt = t / nnt, nt = t % nnt;
        const int row0 = g.row_begin + mt * 32, col0 = g.col_begin + nt * 32;
        const int e = row0 / g.Mb;
        const bf16* ap = g.A + (size_t)(row0 + l31) * g.lda + lh;
        const float* bp0 = g.W0 + (size_t)e * g.wstride + (size_t)lh * g.ldw + col0 + l31;
        const float* bp1 = NB == 2 ? g.W1 + (size_t)e * g.wstride + (size_t)lh * g.ldw + col0 + l31 : nullptr;
        f32x16 acc0 = {}, acc1 = {};
#pragma unroll 8
        for (int k = 0; k < g.K; k += 2) {
            const float a = bf2f((unsigned)ap[k]);
            const float b0 = bp0[(size_t)k * g.ldw];
            acc0 = __builtin_amdgcn_mfma_f32_32x32x2f32(a, b0, acc0, 0, 0, 0);
            if (NB == 2) { const float b1 = bp1[(size_t)k * g.ldw]; acc1 = __builtin_amdgcn_mfma_f32_32x32x2f32(a, b1, acc1, 0, 0, 0); }
        }
#pragma unroll
        for (int r = 0; r < 16; ++r) {
            const int row = row0 + (r & 3) + 8 * (r >> 2) + 4 * lh, col = col0 + l31;
            epi(row, col, acc0[r], acc1[r]);
        }
    }
}
struct EpiF32 { float* O; int ldc; __device__ __forceinline__ void operator()(int row, int col, float v0, float) const { O[(size_t)row * ldc + col] = v0; } };
struct EpiBf { bf16* O; int ldc; int scale_cols; float sc; __device__ __forceinline__ void operator()(int row, int col, float v0, float) const { O[(size_t)row * ldc + col] = (bf16)f2bf(col < scale_cols ? v0 * sc : v0); } };
struct EpiSwiglu { bf16* O; __device__ __forceinline__ void operator()(int row, int col, float g, float u) const { const float s = g / (1.f + __expf(-g)); O[(size_t)row * FF + col] = (bf16)f2bf(s * u); } };
struct EpiGate { bf16* O; const float* gate; __device__ __forceinline__ void operator()(int row, int col, float v0, float) const { O[(size_t)row * DM + col] = (bf16)f2bf(v0 * gate[row]); } };

template <bool F32IN> __device__ __forceinline__ void ph_qkv_post(const Params& p, const Ctx& c) {
    const float* PF = (const float*)(p.ws + WS_PF);
    bf16* QKV = (bf16*)(p.ws + WS_QKV);
    const f32x2* R = (const f32x2*)(p.ws + WS_ROPE);
    const float* qn = p.in[I_QN]; const float* kn = p.in[I_KN];
    const int d = c.lane;
    const float qg = qn[d], kg = kn[d];
    for (int row = c.gw; row < NTOK; row += c.NGW) {
        const bool lat = row < LAT;
        const int t = row & 2047;
        const int pos = (d < 32) ? (t >> 6) : (t & 63);
        const f32x2 cs = R[pos * 16 + (d & 15)];
        const bool first = (d & 16) == 0;
        float vv[36];
#pragma unroll
        for (int hs = 0; hs < 36; ++hs) vv[hs] = F32IN ? PF[(size_t)row * EIN + hs * 64 + d] : bf2f((unsigned)QKV[(size_t)row * EIN + hs * 64 + d]);
#pragma unroll
        for (int hs = 0; hs < 36; ++hs) {
            float v = vv[hs];
            const bool isq = hs < 8 || (hs >= 24 && hs < 32);
            const bool isk = (hs >= 8 && hs < 16) || hs == 32 || hs == 33;
            const bool nrm = hs >= 24 && hs < 34;
            if (nrm) { const float ss = wave_sum(v * v); v = v * rsqrtf(ss * (1.f / 64.f) + RMS_EPS) * (hs < 32 ? qg : kg); }
            if ((isq || isk) && lat) { const float pr = __shfl_xor(v, 16); v = first ? v * cs.x - pr * cs.y : v * cs.x + pr * cs.y; }
            if (isq) v *= C2;
            QKV[(size_t)row * EIN + hs * 64 + d] = (bf16)f2bf(v);
        }
    }
}

__device__ __forceinline__ void ph_attn0_naive(const Params& p, const Ctx& c) {
    const bf16* QKV = (const bf16*)(p.ws + WS_QKV);
    bf16* CC = (bf16*)(p.ws + WS_CC);
    bf16* AO = (bf16*)(p.ws + WS_AO);
    LAS float* Ks = (LAS float*)c.lds;
    LAS float* Vs = Ks + 4096;
    for (int u = c.vcu; u < 960; u += c.G) {
        const bool isctx = u >= 768;
        int b, vh, qrow, ntiles; bool active = true;
        if (!isctx) { b = u / 96; const int r = u % 96; vh = r >> 2; qrow = b * SEQ + (r & 3) * 512 + c.tid; ntiles = 36; }
        else { const int uu = u - 768; b = uu / 24; vh = uu % 24; qrow = LAT + b * NCTX + (c.tid & 255); active = c.tid < 256; ntiles = 4; }
        int qcol, kcol, vcol;
        if (vh < 16) { const int a = vh >> 2, s = (vh >> 1) & 1, half = vh & 1; qcol = a * 128 + s * 64; kcol = 512 + a * 128 + s * 64; vcol = 1024 + a * 128 + half * 64; }
        else { const int h = vh - 16; qcol = 1536 + h * 64; kcol = 2048 + (h >> 2) * 64; vcol = 2176 + (h >> 2) * 64; }
        float q[64], o[64];
#pragma unroll
        for (int i = 0; i < 8; ++i) { const v4u w = *(const v4u*)(QKV + (size_t)qrow * EIN + qcol + 8 * i); unpack8(w, q + 8 * i); }
#pragma unroll
        for (int i = 0; i < 64; ++i) o[i] = 0.f;
        float m = -1e30f, l = 0.f;
        for (int t = 0; t < ntiles; ++t) {
            const int krow0 = isctx ? LAT + b * NCTX + 64 * t : (t < 32 ? b * SEQ + 64 * t : LAT + b * NCTX + 64 * (t - 32));
            __syncthreads();
            { const int r = c.tid >> 3, ch = c.tid & 7; float f[8];
              const v4u kw = *(const v4u*)(QKV + (size_t)(krow0 + r) * EIN + kcol + ch * 8); unpack8(kw, f);
#pragma unroll
              for (int j = 0; j < 8; ++j) Ks[r * 64 + ch * 8 + j] = f[j];
              const v4u vw = *(const v4u*)(QKV + (size_t)(krow0 + r) * EIN + vcol + ch * 8); unpack8(vw, f);
#pragma unroll
              for (int j = 0; j < 8; ++j) Vs[r * 64 + ch * 8 + j] = f[j]; }
            __syncthreads();
            if (active) {
                for (int kk = 0; kk < 64; ++kk) {
                    float s = 0.f;
#pragma unroll
                    for (int dd = 0; dd < 64; ++dd) s += q[dd] * Ks[kk * 64 + dd];
                    const float mn = fmaxf(m, s), al = exp2f(m - mn), pp = exp2f(s - mn);
                    l = l * al + pp; m = mn;
#pragma unroll
                    for (int dd = 0; dd < 64; ++dd) o[dd] = o[dd] * al + pp * Vs[kk * 64 + dd];
                }
            }
        }
        if (active) {
            const float rl = 1.f / l;
            bf16* dst = vh < 16 ? AO + (size_t)qrow * DM + (vh >> 2) * 256 + ((vh >> 1) & 1) * 128 + (vh & 1) * 64 : CC + (size_t)qrow * DM + 512 + (vh - 16) * 64;
            {
#pragma unroll
                for (int i = 0; i < 8; ++i) *(v4u*)(dst + 8 * i) = (v4u){pk2(o[8 * i] * rl, o[8 * i + 1] * rl), pk2(o[8 * i + 2] * rl, o[8 * i + 3] * rl), pk2(o[8 * i + 4] * rl, o[8 * i + 5] * rl), pk2(o[8 * i + 6] * rl, o[8 * i + 7] * rl)}; }
        }
    }
}


__device__ __forceinline__ void attn_combine_rows(const Params& p, const Ctx& c, int row0, int a, float lam, float g0, float g1) {
    const bf16* AO = (const bf16*)(p.ws + WS_AO); bf16* CC = (bf16*)(p.ws + WS_CC);
    asm volatile("s_waitcnt vmcnt(0)" ::: "memory");
#pragma unroll 1
    for (int rb = 0; rb < 32; rb += 8) {
        float x0[8], x1[8];
#pragma unroll
        for (int j = 0; j < 8; ++j) { const bf16* src = AO + (size_t)(row0 + rb + j) * DM + a * 256;
            x0[j] = bf2f((unsigned)src[c.lane]) - lam * bf2f((unsigned)src[128 + c.lane]); x1[j] = bf2f((unsigned)src[64 + c.lane]) - lam * bf2f((unsigned)src[192 + c.lane]); }
#pragma unroll
        for (int j = 0; j < 8; ++j) { const float ss = wave_sum(x0[j] * x0[j] + x1[j] * x1[j]); const float r = rsqrtf(ss * (1.f / 128.f) + RMS_EPS);
            bf16* dst = CC + (size_t)(row0 + rb + j) * DM + a * 128;
            dst[c.lane] = (bf16)f2bf(x0[j] * r * g0); dst[64 + c.lane] = (bf16)f2bf(x1[j] * r * g1); }
    }
}
__device__ __forceinline__ void ph_attn0_fast(const Params& p, const Ctx& c, char* lds_generic) {
    typedef attn_body::bf16 abf;
    const abf* Q = (const abf*)(p.ws + WS_QKV); abf* CCb = (abf*)(p.ws + WS_CC); abf* AOb = (abf*)(p.ws + WS_AO);
    const float d1 = wave_sum(p.in[I_LQ1][c.lane] * p.in[I_LK1][c.lane]), d2 = wave_sum(p.in[I_LQ2][c.lane] * p.in[I_LK2][c.lane]);
    const float lam = expf(d1) - expf(d2) + LAM_INIT;
    const float g0 = p.in[I_SUBLN][c.lane] * (1.f - LAM_INIT), g1 = p.in[I_SUBLN][c.lane + 64] * (1.f - LAM_INIT);
    for (int v = c.vcu; v < 256; v += c.G) {
#pragma unroll 1
        for (int step = 0; step < 10; ++step) {
            attn_body::AU u; int vh; bool ctxu = false;
            if (step < 4) { const int b = v >> 5, a = (v >> 3) & 3; vh = 4 * a + step; u.qrow0 = b * SEQ + (v & 7) * 256; u.lat_row0 = b * SEQ; u.ctx_row0 = LAT + b * NCTX; }
            else if (step < 6) { const int U = (step - 4) * 256 + v, b = U >> 6; vh = 16 + ((U >> 3) & 7); u.qrow0 = b * SEQ + (U & 7) * 256; u.lat_row0 = b * SEQ; u.ctx_row0 = LAT + b * NCTX; }
            else { ctxu = true; int b;
                if (v < 32) { b = v >> 2; vh = 4 * (v & 3) + (step - 6); }
                else if (v < 96 && step == 6) { b = (v - 32) >> 3; vh = 16 + ((v - 32) & 7); }
                else break;
                u.qrow0 = LAT + b * NCTX; u.lat_row0 = 0; u.ctx_row0 = LAT + b * NCTX; }
            if (!ctxu) { u.nlat_t = 32; u.NT = 36; } else { u.nlat_t = 0; u.NT = 4; }
            int qcol, kcol, vcol; abf* op;
            if (vh < 16) { const int a = vh >> 2, s = (vh >> 1) & 1, half = vh & 1; qcol = a * 128 + s * 64; kcol = 512 + a * 128 + s * 64; vcol = 1024 + a * 128 + half * 64; op = AOb + a * 256 + s * 128 + half * 64; }
            else { const int h = vh - 16; qcol = 1536 + h * 64; kcol = 2048 + (h >> 2) * 64; vcol = 2176 + (h >> 2) * 64; op = CCb + 512 + h * 64; }
            u.Qp = Q + qcol; u.Kp = Q + kcol; u.Vp = Q + vcol; u.Op = op;
            attn_body::attn_unit<8, EIN, attn_body::NoMask>(u, lds_generic, attn_body::NoMask{});
            if (vh < 16 && (vh & 3) == 3) attn_combine_rows(p, c, u.qrow0 + c.wave * 32, vh >> 2, lam, g0, g1);
        }
    }
}

__device__ __forceinline__ void ph_attn_combine(const Params& p, const Ctx& c) {
    const bf16* AO = (const bf16*)(p.ws + WS_AO);
    bf16* CC = (bf16*)(p.ws + WS_CC);
    const float d1 = wave_sum(p.in[I_LQ1][c.lane] * p.in[I_LK1][c.lane]);
    const float d2 = wave_sum(p.in[I_LQ2][c.lane] * p.in[I_LK2][c.lane]);
    const float lam = expf(d1) - expf(d2) + LAM_INIT;
    const float g0 = p.in[I_SUBLN][c.lane] * (1.f - LAM_INIT), g1 = p.in[I_SUBLN][c.lane + 64] * (1.f - LAM_INIT);
    for (int it = c.gw; it < NTOK * 4; it += c.NGW) {
        const int row = it >> 2, a = it & 3;
        const bf16* src = AO + (size_t)row * DM + a * 256;
        const float x0 = bf2f((unsigned)src[c.lane]) - lam * bf2f((unsigned)src[128 + c.lane]), x1 = bf2f((unsigned)src[64 + c.lane]) - lam * bf2f((unsigned)src[192 + c.lane]);
        const float ss = wave_sum(x0 * x0 + x1 * x1);
        const float r = rsqrtf(ss * (1.f / 128.f) + RMS_EPS);
        CC[(size_t)row * DM + a * 128 + c.lane] = (bf16)f2bf(x0 * r * g0);
        CC[(size_t)row * DM + a * 128 + 64 + c.lane] = (bf16)f2bf(x1 * r * g1);
    }
}

__device__ __forceinline__ f32x4 unpack4(const v2u w) { return (f32x4){bf2f(w.x & 0xffffu), __uint_as_float(w.x & 0xffff0000u), bf2f(w.y & 0xffffu), __uint_as_float(w.y & 0xffff0000u)}; }
__device__ __forceinline__ float reduce_logits(const f32x4 (&lg)[4], int lane) {
    float w8[8], w4[4], w2[2], w1;
    { const bool hi = (lane & 32) != 0;
#pragma unroll
      for (int i = 0; i < 8; ++i) { const float a0 = lg[i >> 2][i & 3], a1 = lg[2 + (i >> 2)][i & 3]; const float keep = hi ? a1 : a0, send = hi ? a0 : a1; w8[i] = keep + __shfl_xor(send, 32); } }
    { const bool hi = (lane & 16) != 0;
#pragma unroll
      for (int i = 0; i < 4; ++i) { const float keep = hi ? w8[i + 4] : w8[i], send = hi ? w8[i] : w8[i + 4]; w4[i] = keep + __shfl_xor(send, 16); } }
    { const bool hi = (lane & 8) != 0;
#pragma unroll
      for (int i = 0; i < 2; ++i) { const float keep = hi ? w4[i + 2] : w4[i], send = hi ? w4[i] : w4[i + 2]; w2[i] = keep + __shfl_xor(send, 8); } }
    { const bool hi = (lane & 4) != 0; const float keep = hi ? w2[1] : w2[0], send = hi ? w2[0] : w2[1]; w1 = keep + __shfl_xor(send, 4); }
    w1 += __shfl_xor(w1, 2); w1 += __shfl_xor(w1, 1);
    return w1;
}
__device__ __forceinline__ void ph_ln1_router(const Params& p, const Ctx& c, int layer) {
    const bf16* Y = (const bf16*)(p.ws + WS_Y);
    bf16* XS = (bf16*)(p.ws + WS_XS);
    bf16* HB = (bf16*)(p.ws + WS_HB);
    float* AFF = (float*)(p.ws + WS_AFF);
    const float* lng = p.in[I_LNG] + (size_t)(layer * 2 + 0) * DM; const float* lnb = p.in[I_LNB] + (size_t)(layer * 2 + 0) * DM;
    const float* router = p.in[I_ROUTER] + (size_t)layer * DM * NE;
    LAS f32x4* R = (LAS f32x4*)c.lds;
    for (int idx = c.tid; idx < 4096; idx += 512) { const int e4 = idx & 3, k = idx >> 2, ln = (k & 255) >> 2, q = k & 3, j = k >> 8;
        R[((j * 4 + q) * 4 + e4) * 64 + ln] = *(const f32x4*)(router + (size_t)k * NE + 4 * e4); }
    __syncthreads();
    const int nrows = layer == 0 ? NTOK : LAT;
    const int lane = c.lane;
    for (int row = 2 * c.gw; row < nrows; row += 2 * c.NGW) {
        const float* mod = mod_row(p, layer, row);
        f32x4 va[4], vb[4]; float sa = 0.f, sb = 0.f;
#pragma unroll
        for (int j = 0; j < 4; ++j) { const int col = 4 * lane + 256 * j;
            f32x4 xa, xb;
            if (layer == 0) { const float* xin = row < LAT ? p.in[I_X] + (size_t)row * DM : p.in[I_CTX] + (size_t)(row - LAT) * DM; xa = *(const f32x4*)(xin + col); xb = *(const f32x4*)(xin + DM + col); }
            else { xa = unpack4(*(const v2u*)(XS + (size_t)row * DM + col)); xb = unpack4(*(const v2u*)(XS + (size_t)(row + 1) * DM + col)); }
            const f32x4 g1 = *(const f32x4*)(mod + 2048 + col);
            va[j] = xa * ALPHA + g1 * unpack4(*(const v2u*)(Y + (size_t)row * DM + col));
            vb[j] = xb * ALPHA + g1 * unpack4(*(const v2u*)(Y + (size_t)(row + 1) * DM + col));
            sa += (va[j].x + va[j].y) + (va[j].z + va[j].w); sb += (vb[j].x + vb[j].y) + (vb[j].z + vb[j].w); }
        const float meana = wave_sum(sa) * (1.f / DM), meanb = wave_sum(sb) * (1.f / DM); float qa = 0.f, qb = 0.f;
#pragma unroll
        for (int j = 0; j < 4; ++j) { va[j] = va[j] - meana; vb[j] = vb[j] - meanb;
            qa += (va[j].x * va[j].x + va[j].y * va[j].y) + (va[j].z * va[j].z + va[j].w * va[j].w); qb += (vb[j].x * vb[j].x + vb[j].y * vb[j].y) + (vb[j].z * vb[j].z + vb[j].w * vb[j].w); }
        const float rstda = 1.f / sqrtf(wave_sum(qa) * (1.f / DM) + LN_EPS), rstdb = 1.f / sqrtf(wave_sum(qb) * (1.f / DM) + LN_EPS);
        f32x4 lga[4], lgb[4];
#pragma unroll
        for (int e = 0; e < 4; ++e) { lga[e] = (f32x4){0.f, 0.f, 0.f, 0.f}; lgb[e] = (f32x4){0.f, 0.f, 0.f, 0.f}; }
#pragma unroll
        for (int j = 0; j < 4; ++j) { const int col = 4 * lane + 256 * j;
            const f32x4 g = *(const f32x4*)(lng + col), bb = *(const f32x4*)(lnb + col), sc = *(const f32x4*)(mod + 4096 + col) + 1.f, sh = *(const f32x4*)(mod + 3072 + col);
            const f32x4 x1a = va[j] * rstda * g + bb, x1b = vb[j] * rstdb * g + bb;
            *(v2u*)(XS + (size_t)row * DM + col) = (v2u){pk2(x1a.x, x1a.y), pk2(x1a.z, x1a.w)};
            *(v2u*)(XS + (size_t)(row + 1) * DM + col) = (v2u){pk2(x1b.x, x1b.y), pk2(x1b.z, x1b.w)};
            const f32x4 hma = x1a * sc + sh, hmb = x1b * sc + sh;
            if (MOE_FP8) { *(unsigned*)((unsigned char*)HB + (size_t)row * DM + col) = pg8::pk4_fp8(hma.x, hma.y, hma.z, hma.w);
                           *(unsigned*)((unsigned char*)HB + (size_t)(row + 1) * DM + col) = pg8::pk4_fp8(hmb.x, hmb.y, hmb.z, hmb.w); }
            else { *(v2u*)(HB + (size_t)row * DM + col) = (v2u){pk2(hma.x, hma.y), pk2(hma.z, hma.w)}; *(v2u*)(HB + (size_t)(row + 1) * DM + col) = (v2u){pk2(hmb.x, hmb.y), pk2(hmb.z, hmb.w)}; }
            asm volatile("" ::: "memory");
#pragma unroll
            for (int q = 0; q < 4; ++q) { const float ha = hma[q], hb = hmb[q];
#pragma unroll
                for (int e4 = 0; e4 < 4; ++e4) { const f32x4 rw = R[((j * 4 + q) * 4 + e4) * 64 + lane]; lga[e4] += rw * ha; lgb[e4] += rw * hb; } } }
        const float wa = reduce_logits(lga, lane), wb = reduce_logits(lgb, lane);
        float mxa = wa, mxb = wb;
#pragma unroll
        for (int o = 4; o < 64; o <<= 1) { mxa = fmaxf(mxa, __shfl_xor(mxa, o)); mxb = fmaxf(mxb, __shfl_xor(mxb, o)); }
        const float exa = expf(wa - mxa), exb = expf(wb - mxb); float dena = exa, denb = exb;
#pragma unroll
        for (int o = 4; o < 64; o <<= 1) { dena += __shfl_xor(dena, o); denb += __shfl_xor(denb, o); }
        if ((lane & 3) == 0) { const int e = ((lane >> 5) & 1) * 8 + ((lane >> 4) & 1) * 4 + ((lane >> 3) & 1) * 2 + ((lane >> 2) & 1);
            AFF[(size_t)row * NE + e] = exa / dena; AFF[(size_t)(row + 1) * NE + e] = exb / denb; }
    }
}

__device__ __forceinline__ void ph_topk(const Params& p, const Ctx& c, int layer) {
    const float* AFF = (const float*)(p.ws + WS_AFF);
    int* INV = (int*)(p.ws + WS_INV);
    float* GATE = (float*)(p.ws + WS_GATE);
    const bf16* HB = (const bf16*)(p.ws + WS_HB);
    bf16* XG = (bf16*)(p.ws + WS_XG);
    LAS unsigned* hist = (LAS unsigned*)c.lds;
    LAS unsigned* ctl = hist + 256;
    LAS int* sel = (LAS int*)(c.lds + 2048);
    const int MR = layer == 0 ? MR0 : MR1;
    const int ntasks = layer == 0 ? 256 : 128;
    const int lane = c.lane;
    for (int task = c.vcu; task < ntasks; task += c.G) {
        int set, e, n, cap, rowbase, slotbase;
        if (task < 128) { set = task >> 4; e = task & 15; n = SEQ; cap = 256; rowbase = set * SEQ; slotbase = set * 256; }
        else { const int t2 = task - 128; set = t2 >> 4; e = t2 & 15; n = NCTX; cap = 32; rowbase = LAT + set * NCTX; slotbase = 2048 + set * 32; }
        const bool valid = 4 * c.tid < n;
        unsigned key[4];
#pragma unroll
        for (int q = 0; q < 4; ++q) key[q] = valid ? __float_as_uint(AFF[(size_t)(rowbase + 4 * c.tid + q) * NE + e]) : 0u;
        unsigned prefix = 0u, need = (unsigned)cap;
#pragma unroll 1
        for (int pass = 0; pass < 4; ++pass) {
            const int shift = 24 - 8 * pass;
            if (c.tid < 256) hist[c.tid] = 0u;
            __syncthreads();
            if (valid) {
#pragma unroll
                for (int q = 0; q < 4; ++q) if (pass == 0 || (key[q] >> (shift + 8)) == (prefix >> (shift + 8))) __hip_atomic_fetch_add(&hist[(key[q] >> shift) & 255u], 1u, __ATOMIC_RELAXED, __HIP_MEMORY_SCOPE_WORKGROUP);
            }
            __syncthreads();
            if (c.wave == 0) {
                const unsigned h0 = hist[4 * lane], h1 = hist[4 * lane + 1], h2 = hist[4 * lane + 2], h3 = hist[4 * lane + 3];
                const unsigned tot = h0 + h1 + h2 + h3; unsigned sfx = tot;
#pragma unroll
                for (int o = 1; o < 64; o <<= 1) { const unsigned t = __shfl_down(sfx, o); if (lane + o < 64) sfx += t; }
                const unsigned above = sfx - tot, c3 = above + h3, c2 = c3 + h2, c1 = c2 + h1, c0 = c1 + h0;
                int d = -1; unsigned gtc = 0u;
                if (above < need && need <= c3) { d = 3; gtc = above; }
                else if (c3 < need && need <= c2) { d = 2; gtc = c3; }
                else if (c2 < need && need <= c1) { d = 1; gtc = c2; }
                else if (c1 < need && need <= c0) { d = 0; gtc = c1; }
                if (d >= 0) { ctl[0] = prefix | ((unsigned)(4 * lane + d) << shift); ctl[1] = need - gtc; }
            }
            __syncthreads();
            prefix = ctl[0]; need = ctl[1];
        }
        unsigned ngt = 0u, neq = 0u;
#pragma unroll
        for (int q = 0; q < 4; ++q) { ngt += (valid && key[q] > prefix) ? 1u : 0u; neq += (valid && key[q] == prefix) ? 1u : 0u; }
        const unsigned cnt = ngt | (neq << 16); unsigned inc = cnt;
#pragma unroll
        for (int o = 1; o < 64; o <<= 1) { const unsigned t = __shfl_up(inc, o); if (lane >= o) inc += t; }
        if (lane == 63) ctl[8 + c.wave] = inc;
        __syncthreads();
        unsigned base = 0u;
#pragma unroll
        for (int w = 0; w < 8; ++w) base += (w < c.wave) ? ctl[8 + w] : 0u;
        const unsigned ex = base + inc - cnt; unsigned gtb = ex & 0xffffu, eqb = ex >> 16;
        if (valid) {
#pragma unroll
            for (int q = 0; q < 4; ++q) { const int i = 4 * c.tid + q; int slot = -1;
                if (key[q] > prefix) { slot = (int)(gtb + (eqb < need ? eqb : need)); ++gtb; }
                else if (key[q] == prefix) { if (eqb < need) slot = (int)(gtb + eqb); ++eqb; }
                int gs = -1;
                if (slot >= 0) { gs = e * MR + slotbase + slot; sel[slot] = i; GATE[gs] = __uint_as_float(key[q]); }
                INV[(size_t)(rowbase + i) * NE + e] = gs; }
        }
        __syncthreads();
        for (int sidx = c.wave; sidx < cap; sidx += 8) {
            if (MOE_FP8) { const unsigned char* src = (const unsigned char*)HB + (size_t)(rowbase + sel[sidx]) * DM; unsigned char* dst = (unsigned char*)XG + (size_t)(e * MR + slotbase + sidx) * DM;
                *(v4u*)(dst + 16 * lane) = *(const v4u*)(src + 16 * lane); }
            else { const bf16* src = HB + (size_t)(rowbase + sel[sidx]) * DM; bf16* dst = XG + (size_t)(e * MR + slotbase + sidx) * DM;
            const v4u a0 = *(const v4u*)(src + 8 * lane), a1 = *(const v4u*)(src + 512 + 8 * lane);
            *(v4u*)(dst + 8 * lane) = a0; *(v4u*)(dst + 512 + 8 * lane) = a1; }
        }
        __syncthreads();
    }
}

__device__ __forceinline__ void ph_combine(const Params& p, const Ctx& c, int layer) {
    const bf16* YS = (const bf16*)(p.ws + WS_YS);
    const int* INV = (const int*)(p.ws + WS_INV);
    bf16* XS = (bf16*)(p.ws + WS_XS);
    bf16* HB = (bf16*)(p.ws + WS_HB);
    const float* lng = p.in[I_LNG] + (size_t)(layer * 2 + 1) * DM; const float* lnb = p.in[I_LNB] + (size_t)(layer * 2 + 1) * DM;
    const int nrows = layer == 0 ? NTOK : LAT;
    const int lane = c.lane;
    for (int row = 2 * c.gw; row < nrows; row += 2 * c.NGW) {
        const float* mod = mod_row(p, layer, row);
        const int inv = (lane < 2 * NE) ? INV[(size_t)row * NE + lane] : -1;
        const unsigned mall = (unsigned)__ballot(inv >= 0);
        unsigned ma = mall & 0xffffu, mb = mall >> 16;
        int sla[4], slb[4]; float wa[4], wb[4];
#pragma unroll
        for (int q = 0; q < 4; ++q) {
            if (ma) { const int e = __builtin_ctz(ma); ma &= ma - 1; sla[q] = __builtin_amdgcn_readlane(inv, e); wa[q] = 1.f; } else { sla[q] = 0; wa[q] = 0.f; }
            if (mb) { const int e = __builtin_ctz(mb); mb &= mb - 1; slb[q] = __builtin_amdgcn_readlane(inv, 16 + e); wb[q] = 1.f; } else { slb[q] = 0; wb[q] = 0.f; } }
        f32x4 moa[4], mob[4];
#pragma unroll
        for (int j = 0; j < 4; ++j) { moa[j] = (f32x4){0.f, 0.f, 0.f, 0.f}; mob[j] = (f32x4){0.f, 0.f, 0.f, 0.f}; }
#pragma unroll
        for (int q = 0; q < 4; ++q)
#pragma unroll
            for (int j = 0; j < 4; ++j) { moa[j] += unpack4(*(const v2u*)(YS + (size_t)sla[q] * DM + 4 * lane + 256 * j)) * wa[q]; mob[j] += unpack4(*(const v2u*)(YS + (size_t)slb[q] * DM + 4 * lane + 256 * j)) * wb[q]; }
        while (ma) { const int e = __builtin_ctz(ma); ma &= ma - 1; const int sl = __builtin_amdgcn_readlane(inv, e);
#pragma unroll
            for (int j = 0; j < 4; ++j) moa[j] += unpack4(*(const v2u*)(YS + (size_t)sl * DM + 4 * lane + 256 * j)); }
        while (mb) { const int e = __builtin_ctz(mb); mb &= mb - 1; const int sl = __builtin_amdgcn_readlane(inv, 16 + e);
#pragma unroll
            for (int j = 0; j < 4; ++j) mob[j] += unpack4(*(const v2u*)(YS + (size_t)sl * DM + 4 * lane + 256 * j)); }
        f32x4 va[4], vb[4]; float sa = 0.f, sb = 0.f;
#pragma unroll
        for (int j = 0; j < 4; ++j) { const int col = 4 * lane + 256 * j; const f32x4 g2 = *(const f32x4*)(mod + 5120 + col);
            va[j] = unpack4(*(const v2u*)(XS + (size_t)row * DM + col)) * ALPHA + g2 * moa[j];
            vb[j] = unpack4(*(const v2u*)(XS + (size_t)(row + 1) * DM + col)) * ALPHA + g2 * mob[j];
            sa += (va[j].x + va[j].y) + (va[j].z + va[j].w); sb += (vb[j].x + vb[j].y) + (vb[j].z + vb[j].w); }
        const float meana = wave_sum(sa) * (1.f / DM), meanb = wave_sum(sb) * (1.f / DM); float qa = 0.f, qb = 0.f;
#pragma unroll
        for (int j = 0; j < 4; ++j) { va[j] = va[j] - meana; vb[j] = vb[j] - meanb;
            qa += (va[j].x * va[j].x + va[j].y * va[j].y) + (va[j].z * va[j].z + va[j].w * va[j].w); qb += (vb[j].x * vb[j].x + vb[j].y * vb[j].y) + (vb[j].z * vb[j].z + vb[j].w * vb[j].w); }
        const float rstda = 1.f / sqrtf(wave_sum(qa) * (1.f / DM) + LN_EPS), rstdb = 1.f / sqrtf(wave_sum(qb) * (1.f / DM) + LN_EPS);
        const float* modn = mod_row(p, 1, row);
#pragma unroll
        for (int j = 0; j < 4; ++j) { const int col = 4 * lane + 256 * j;
            const f32x4 g = *(const f32x4*)(lng + col), bb = *(const f32x4*)(lnb + col);
            const f32x4 x2a = va[j] * rstda * g + bb, x2b = vb[j] * rstdb * g + bb;
            if (layer == 0) {
                *(v2u*)(XS + (size_t)row * DM + col) = (v2u){pk2(x2a.x, x2a.y), pk2(x2a.z, x2a.w)};
                *(v2u*)(XS + (size_t)(row + 1) * DM + col) = (v2u){pk2(x2b.x, x2b.y), pk2(x2b.z, x2b.w)};
                const f32x4 sc = *(const f32x4*)(modn + 1024 + col) + 1.f, sh = *(const f32x4*)(modn + col);
                const f32x4 ha = x2a * sc + sh, hb = x2b * sc + sh;
                *(v2u*)(HB + (size_t)row * DM + col) = (v2u){pk2(ha.x, ha.y), pk2(ha.z, ha.w)};
                *(v2u*)(HB + (size_t)(row + 1) * DM + col) = (v2u){pk2(hb.x, hb.y), pk2(hb.z, hb.w)};
            } else {
                *(f32x4*)(p.out + (size_t)row * DM + col) = x2a; *(f32x4*)(p.out + (size_t)(row + 1) * DM + col) = x2b;
            } }
    }
}

__device__ __forceinline__ void na_key(const float* q, float* o, float& m, float& l, const bf16* kp, const bf16* vp, float bias) {
    float s = bias;
#pragma unroll
    for (int i = 0; i < 8; ++i) { float f[8]; unpack8(*(const v4u*)(kp + 8 * i), f);
#pragma unroll
        for (int j = 0; j < 8; ++j) s += q[8 * i + j] * f[j]; }
    const float mn = fmaxf(m, s), al = exp2f(m - mn), pp = exp2f(s - mn);
    l = l * al + pp; m = mn;
#pragma unroll
    for (int i = 0; i < 8; ++i) { float f[8]; unpack8(*(const v4u*)(vp + 8 * i), f);
#pragma unroll
        for (int j = 0; j < 8; ++j) o[8 * i + j] = o[8 * i + j] * al + pp * f[j]; }
}
__device__ __forceinline__ void ph_mixer1_naive(const Params& p, const Ctx& c) {
    const bf16* P2 = (const bf16*)(p.ws + WS_QKV);
    bf16* CC = (bf16*)(p.ws + WS_CC);
    const float* rpb = p.in[I_RPB]; const float* pool_w = p.in[I_POOLW]; const float* pool_s = p.in[I_POOLS];
    LAS float* pl = (LAS float*)c.lds;
    for (int u = c.vcu; u < 256; u += c.G) {
        const int b = u >> 5, r = u & 31;
        {
            const int h = c.wave, col = c.lane, row = b * SEQ + r * 64 + col;
            const int rs = min(max(r - 4, 0), 24), cs = min(max(col - 8, 0), 48);
            float q[64], o[64];
#pragma unroll
            for (int i = 0; i < 8; ++i) unpack8(*(const v4u*)(P2 + (size_t)row * OIN + h * 64 + 8 * i), q + 8 * i);
#pragma unroll
            for (int i = 0; i < 64; ++i) o[i] = 0.f;
            float m = -1e30f, l = 0.f;
#pragma unroll 1
            for (int i = 0; i < 8; ++i)
#pragma unroll 1
                for (int j = 0; j < 16; ++j) {
                    const int krow = b * SEQ + (rs + i) * 64 + cs + j;
                    const float bias = rpb[(h * 15 + (rs + i - r + 7)) * 31 + (cs + j - col + 15)] * LOG2E;
                    na_key(q, o, m, l, P2 + (size_t)krow * OIN + 512 + h * 64, P2 + (size_t)krow * OIN + 1024 + h * 64, bias);
                }
#pragma unroll 1
            for (int j = 0; j < NCTX; ++j) {
                const int krow = LAT + b * NCTX + j;
                na_key(q, o, m, l, P2 + (size_t)krow * OIN + 512 + h * 64, P2 + (size_t)krow * OIN + 1024 + h * 64, 0.f);
            }
            const float rl = 1.f / l; bf16* dst = CC + (size_t)row * DM + h * 64;
#pragma unroll
            for (int i = 0; i < 8; ++i) *(v4u*)(dst + 8 * i) = (v4u){pk2(o[8 * i] * rl, o[8 * i + 1] * rl), pk2(o[8 * i + 2] * rl, o[8 * i + 3] * rl), pk2(o[8 * i + 4] * rl, o[8 * i + 5] * rl), pk2(o[8 * i + 6] * rl, o[8 * i + 7] * rl)};
        }
        __syncthreads();
        {
            const int ch = c.tid, g = ch >> 7, half = 1 << g;
            for (int tt = 0; tt < 64; ++tt) {
                const int t = r * 64 + tt, lo = max(t - half, 0), hi = min(t + half, SEQ);
                float s = 0.f;
                for (int t2 = lo; t2 < hi; ++t2) s += bf2f((unsigned)P2[(size_t)(b * SEQ + t2) * OIN + 1536 + ch]);
                pl[tt * 512 + ch] = s / (float)(hi - lo) - bf2f((unsigned)P2[(size_t)(b * SEQ + t) * OIN + 1536 + ch]);
            }
        }
        __syncthreads();
        {
            const int g = c.tid >> 7, e = c.tid & 127;
            const float ps = pool_s[g * 128 + e];
#pragma unroll 1
            for (int tb = 0; tb < 64; tb += 16) {
                float acc[16];
#pragma unroll
                for (int i = 0; i < 16; ++i) acc[i] = 0.f;
#pragma unroll 4
                for (int cc = 0; cc < 128; ++cc) {
                    const float w = pool_w[(size_t)(g * 128 + cc) * 128 + e];
#pragma unroll
                    for (int i = 0; i < 16; ++i) acc[i] += pl[(tb + i) * 512 + g * 128 + cc] * w;
                }
#pragma unroll
                for (int i = 0; i < 16; ++i) CC[(size_t)(b * SEQ + r * 64 + tb + i) * DM + 512 + g * 128 + e] = (bf16)f2bf(acc[i] * ps);
            }
        }
        __syncthreads();
    }
}


constexpr int NA_TAB_OFF = 86016 + 1024;
__device__ __forceinline__ void ph_mixer1_fast(const Params& p, const Ctx& c, char* lds_generic) {
    typedef attn_body::bf16 abf;
    const abf* P2a = (const abf*)(p.ws + WS_QKV); abf* CCa = (abf*)(p.ws + WS_CC);
    LAS float* tab = (LAS float*)(c.lds + NA_TAB_OFF);
    for (int i = c.tid; i < 8 * 15 * 32; i += 512) { const int hd = i >> 5, j = i & 31; tab[i] = j < 31 ? p.in[I_RPB][hd * 31 + j] * LOG2E : 0.f; }
    __syncthreads();
    for (int it = 0;; ++it) {
        const int U = it * c.G + c.vcu;
        if (U >= 512) break;
        const int b = U >> 6, h = (U >> 3) & 7, rq = U & 7;
        const int rs_min = min(max(4 * rq - 4, 0), 24);
        const int nloc = (rq == 0 || rq == 7) ? 8 : 12;
        attn_body::AU u;
        u.qrow0 = b * SEQ + rq * 256; u.lat_row0 = LAT + b * NCTX; u.nlat_t = 4; u.ctx_row0 = b * SEQ + rs_min * 64; u.NT = 4 + nloc;
        u.Qp = P2a + h * 64; u.Kp = P2a + 512 + h * 64; u.Vp = P2a + 1024 + h * 64; u.Op = CCa + h * 64;
        const int r = 4 * rq + (c.wave >> 1), col = (c.wave & 1) * 32 + (c.lane & 31), hi = c.lane >> 5;
        const int cs = min(max(col - 8, 0), 48);
        attn_body::NAMask mk; mk.tb0 = (attn_body::lds_cfptr)(tab + h * 15 * 32 + 15 - col); mk.r = r; mk.rs = min(max(r - 4, 0), 24); mk.rs_min = rs_min; mk.cb = 4 * hi - cs;
        attn_body::attn_unit<8, OIN, attn_body::NAMask>(u, lds_generic, mk);
    }
    __syncthreads();
    const bf16* P2 = (const bf16*)(p.ws + WS_QKV); bf16* CC = (bf16*)(p.ws + WS_CC);
    const float* pool_w = p.in[I_POOLW]; const float* pool_s = p.in[I_POOLS];
    LAS float* pl = (LAS float*)c.lds;
    for (int u = c.vcu; u < 256; u += c.G) {
        const int b = u >> 5, r = u & 31;
        {
            const int ch = c.tid, g = ch >> 7, half = 1 << g;
            const bf16* du = P2 + (size_t)b * SEQ * OIN + 1536 + ch;
            const int t0 = r * 64;
            float ws = 0.f;
            { float iv[16];
#pragma unroll
              for (int k = 0; k < 16; ++k) { const int t2 = t0 - half + k; const float w = (k < 2 * half && t2 >= 0 && t2 < SEQ) ? 1.f : 0.f; iv[k] = w * bf2f((unsigned)du[(size_t)min(max(t2, 0), SEQ - 1) * OIN]); }
#pragma unroll
              for (int k = 0; k < 16; ++k) ws += iv[k]; }
#pragma unroll 1
            for (int tb = 0; tb < 64; tb += 8) {
                float cur[8], add[8], sub[8];
#pragma unroll
                for (int k = 0; k < 8; ++k) { const int t = t0 + tb + k;
                    cur[k] = bf2f((unsigned)du[(size_t)t * OIN]);
                    add[k] = ((t + half < SEQ) ? 1.f : 0.f) * bf2f((unsigned)du[(size_t)min(t + half, SEQ - 1) * OIN]);
                    sub[k] = ((t - half >= 0) ? 1.f : 0.f) * bf2f((unsigned)du[(size_t)max(t - half, 0) * OIN]); }
#pragma unroll
                for (int k = 0; k < 8; ++k) { const int t = t0 + tb + k, lo = max(t - half, 0), hi = min(t + half, SEQ);
                    pl[(tb + k) * 512 + ch] = ws / (float)(hi - lo) - cur[k];
                    ws += add[k] - sub[k]; }
            }
        }
        __syncthreads();
        {
            const int g = c.tid >> 7, e = c.tid & 127;
            const float ps = pool_s[g * 128 + e];
#pragma unroll 1
            for (int tb = 0; tb < 64; tb += 16) {
                float acc[16];
#pragma unroll
                for (int i = 0; i < 16; ++i) acc[i] = 0.f;
#pragma unroll 2
                for (int cc = 0; cc < 128; cc += 4) {
                    const float w0 = pool_w[(size_t)(g * 128 + cc) * 128 + e], w1 = pool_w[(size_t)(g * 128 + cc + 1) * 128 + e], w2 = pool_w[(size_t)(g * 128 + cc + 2) * 128 + e], w3 = pool_w[(size_t)(g * 128 + cc + 3) * 128 + e];
#pragma unroll
                    for (int i = 0; i < 16; ++i) { const f32x4 pv = *(const LAS f32x4*)(pl + (tb + i) * 512 + g * 128 + cc); acc[i] += pv.x * w0 + pv.y * w1 + pv.z * w2 + pv.w * w3; }
                }
#pragma unroll
                for (int i = 0; i < 16; ++i) CC[(size_t)(b * SEQ + r * 64 + tb + i) * DM + 512 + g * 128 + e] = (bf16)f2bf(acc[i] * ps);
            }
        }
        __syncthreads();
    }
}

__global__ void __launch_bounds__(512, 2) mk_fwd(Params p) {
    extern __shared__ __attribute__((aligned(16))) unsigned char lds_raw[];
    Ctx c;
    c.lds = (LAS unsigned char*)lds_raw;
    c.tid = threadIdx.x; c.lane = c.tid & 63; c.wave = __builtin_amdgcn_readfirstlane(c.tid >> 6);
    c.G = gridDim.x; { const int bx = blockIdx.x; c.vcu = (c.G % 8 == 0) ? (bx % 8) * (c.G / 8) + bx / 8 : bx; }
    c.gw = c.vcu * 8 + c.wave; c.NGW = c.G * 8;
    volatile LAS unsigned* MISC = (volatile LAS unsigned*)(c.lds + MISC_OFF);
    if (c.tid < 32) MISC[c.tid] = 0u;
    __syncthreads();
    gu32* ctl = (gu32*)(p.ws + WS_CTL);
    XcdBarrier bar; bar.bar = (unsigned*)(ctl + CW_BAR); bar.x = 0; bar.st = nullptr;
    if (!MK_MULTI) bar = xcd_barrier_post((unsigned*)(ctl + CW_BAR), MISC + 8);
    const int lo = p.ph_lo, hi = p.ph_hi;
    unsigned long long pt0 = 0, pt1 = 0; if (PROBE_PH == 0) pt0 = __builtin_amdgcn_s_memrealtime();
#define IN(k) (lo <= (k) && (k) < hi)
#define SEAM(k) do { if (IN(k) && IN((k) + 1) && !(FAST_ATTN && (k) == 5)) xcd_barrier(bar); if ((k) + 1 == PROBE_PH) pt0 = __builtin_amdgcn_s_memrealtime(); if ((k) == PROBE_PH) pt1 = __builtin_amdgcn_s_memrealtime(); } while (0)

    bf16* HB = (bf16*)(p.ws + WS_HB); bf16* QKV = (bf16*)(p.ws + WS_QKV); bf16* CC = (bf16*)(p.ws + WS_CC);
    float* Y = (float*)(p.ws + WS_Y); float* PF = (float*)(p.ws + WS_PF);
    bf16* XG = (bf16*)(p.ws + WS_XG); bf16* HID = (bf16*)(p.ws + WS_HID); bf16* YS = (bf16*)(p.ws + WS_YS);
    const float* GATE = (const float*)(p.ws + WS_GATE);

    if (IN(0)) for (int rep_ = 0; rep_ < 1 + (int)((PROBE_MASK >> 0) & 1u); ++rep_) { if (rep_) __syncthreads(); ph_prologue(p, c); if (FAST_GEMM) { __syncthreads(); ph_transposes(p, c); } } SEAM(0);
    if (IN(1)) for (int rep_ = 0; rep_ < 1 + (int)((PROBE_MASK >> 1) & 1u); ++rep_) { if (rep_) __syncthreads(); ph_modulate0(p, c); } SEAM(1);
    if (IN(2)) for (int rep_ = 0; rep_ < 1 + (int)((PROBE_MASK >> 2) & 1u); ++rep_) { if (rep_) __syncthreads();
        if (FAST_GEMM) { pg8::Gemm g{HB, (const bf16*)(p.ws + WS_W0IN), NTOK, EIN, DM, 0}; pg8::StaticOrder S; S.init(NTOK, EIN, c.G, (int)blockIdx.x);
            pg8::EpiBf16<0> E{QKV, EIN, nullptr, 0, 0, 1.f}; pg8::gemm_phase<pg8::EpiBf16<0>, pg8::StaticOrder, true, true>(c.lds, g, S, E); }
        else { NG g{HB, DM, p.in[I_W0IN], nullptr, EIN, 0, 1 << 30, 0, NTOK, 0, EIN, DM}; ngemm<1>(g, c, EpiF32{PF, EIN}); }
    } SEAM(2);
    if (IN(3)) for (int rep_ = 0; rep_ < 1 + (int)((PROBE_MASK >> 3) & 1u); ++rep_) { if (rep_) __syncthreads(); if (FAST_GEMM) ph_qkv_post<false>(p, c); else ph_qkv_post<true>(p, c); } SEAM(3);
    if (IN(4)) for (int rep_ = 0; rep_ < 1 + (int)((PROBE_MASK >> 4) & 1u); ++rep_) { if (rep_) __syncthreads(); if (FAST_ATTN) ph_attn0_fast(p, c, (char*)lds_raw); else ph_attn0_naive(p, c); } SEAM(4);
    if (!FAST_ATTN) { if (IN(5)) { ph_attn_combine(p, c); } } SEAM(5);
    if (IN(6)) for (int rep_ = 0; rep_ < 1 + (int)((PROBE_MASK >> 6) & 1u); ++rep_) { if (rep_) __syncthreads();
        if (FAST_GEMM) { pg8::Gemm g{CC, (const bf16*)(p.ws + WS_W0OUT), NTOK, DM, DM, 0}; pg8::StaticOrder S; S.init(NTOK, DM, c.G, (int)blockIdx.x);
            pg8::EpiBf16<0> E{(bf16*)Y, DM, nullptr, 0, 0, 1.f}; pg8::gemm_phase<pg8::EpiBf16<0>, pg8::StaticOrder, true, true>(c.lds, g, S, E); }
        else { NG g{CC, DM, p.in[I_W0OUT], nullptr, DM, 0, 1 << 30, 0, NTOK, 0, DM, DM}; ngemm<1>(g, c, EpiBf{(bf16*)Y, DM, 0, 1.f}); }
    } SEAM(6);
    if (IN(7)) for (int rep_ = 0; rep_ < 1 + (int)((PROBE_MASK >> 7) & 1u); ++rep_) { if (rep_) __syncthreads(); ph_ln1_router(p, c, 0); } SEAM(7);
    if (IN(8)) for (int rep_ = 0; rep_ < 1 + (int)((PROBE_MASK >> 8) & 1u); ++rep_) { if (rep_) __syncthreads(); ph_topk(p, c, 0); } SEAM(8);
    if (IN(9)) for (int rep_ = 0; rep_ < 1 + (int)((PROBE_MASK >> 9) & 1u); ++rep_) { if (rep_) __syncthreads();
        if (FAST_GEMM && MOE_FP8) { pg8::Gemm g{XG, (const bf16*)(p.ws + WS_WGU), NE * MR0, 4096, DM / 2, (size_t)4096 * DM}; pg8::GroupedOrder S; S.init(MR0 / 256, 16, NE, c.G, c.vcu);
            pg8::EpiSwigluF8 E{(unsigned char*)HID, FF, 1.f / W8_GU, H8_SC}; pg8::gemm_phase<pg8::EpiSwigluF8, pg8::GroupedOrder, true, true, true>(c.lds, g, S, E); }
        else if (FAST_GEMM) { pg8::Gemm g{XG, (const bf16*)(p.ws + WS_WGU), NE * MR0, 4096, DM, (size_t)4096 * DM * 2}; pg8::GroupedOrder S; S.init(MR0 / 256, 16, NE, c.G, c.vcu);
            pg8::EpiSwigluP E{HID, FF}; pg8::gemm_phase<pg8::EpiSwigluP, pg8::GroupedOrder, true, true>(c.lds, g, S, E); }
        else { NG g{XG, DM, p.in[I_WG], p.in[I_WU], FF, (size_t)DM * FF, MR0, 0, NE * MR0, 0, FF, DM}; ngemm<2>(g, c, EpiSwiglu{HID}); }
    } SEAM(9);
    if (IN(10)) for (int rep_ = 0; rep_ < 1 + (int)((PROBE_MASK >> 10) & 1u); ++rep_) { if (rep_) __syncthreads();
        if (FAST_GEMM && MOE_FP8) { pg8::Gemm g{HID, (const bf16*)(p.ws + WS_WDN), NE * MR0, DM, FF / 2, (size_t)DM * FF}; pg8::GroupedOrder S; S.init(MR0 / 256, 4, NE, c.G, c.vcu);
            pg8::EpiGateS E{YS, DM, GATE, 1.f / (W8_DN * H8_SC)}; pg8::gemm_phase<pg8::EpiGateS, pg8::GroupedOrder, true, true, true>(c.lds, g, S, E); }
        else if (FAST_GEMM) { pg8::Gemm g{HID, (const bf16*)(p.ws + WS_WDN), NE * MR0, DM, FF, (size_t)DM * FF * 2}; pg8::GroupedOrder S; S.init(MR0 / 256, 4, NE, c.G, c.vcu);
            pg8::EpiGateP E{YS, DM, GATE}; pg8::gemm_phase<pg8::EpiGateP, pg8::GroupedOrder, true, true>(c.lds, g, S, E); }
        else { NG g{HID, FF, p.in[I_WD], nullptr, DM, (size_t)FF * DM, MR0, 0, NE * MR0, 0, DM, FF}; ngemm<1>(g, c, EpiGate{YS, GATE}); }
    } SEAM(10);
    if (IN(11)) for (int rep_ = 0; rep_ < 1 + (int)((PROBE_MASK >> 11) & 1u); ++rep_) { if (rep_) __syncthreads(); ph_combine(p, c, 0); } SEAM(11);
    if (IN(12)) for (int rep_ = 0; rep_ < 1 + (int)((PROBE_MASK >> 12) & 1u); ++rep_) { if (rep_) __syncthreads();
        if (FAST_GEMM) { pg8::Gemm g{HB, (const bf16*)(p.ws + WS_W1IN), NTOK, OIN, DM, 0}; pg8::L1InOrder S; S.init(c.G, (int)blockIdx.x);
            pg8::EpiBf16<0> E{QKV, OIN, nullptr, 512, 512, C2}; pg8::gemm_phase<pg8::EpiBf16<0>, pg8::L1InOrder, true, true>(c.lds, g, S, E); }
        else {
        NG g{HB, DM, p.in[I_W1IN], nullptr, OIN, 0, 1 << 30, 0, LAT, 0, OIN, DM}; ngemm<1>(g, c, EpiBf{QKV, OIN, 512, C2});
        NG g2{HB, DM, p.in[I_W1IN], nullptr, OIN, 0, 1 << 30, LAT, NTOK, 512, 1536, DM}; ngemm<1>(g2, c, EpiBf{QKV, OIN, 0, 1.f}); }
    } SEAM(12);
    if (IN(13)) for (int rep_ = 0; rep_ < 1 + (int)((PROBE_MASK >> 13) & 1u); ++rep_) { if (rep_) __syncthreads(); if (FAST_NA) ph_mixer1_fast(p, c, (char*)lds_raw); else ph_mixer1_naive(p, c); } SEAM(13);
    if (IN(14)) for (int rep_ = 0; rep_ < 1 + (int)((PROBE_MASK >> 14) & 1u); ++rep_) { if (rep_) __syncthreads();
        if (FAST_GEMM) { pg8::Gemm g{CC, (const bf16*)(p.ws + WS_W1OUT), LAT, DM, DM, 0}; pg8::StaticOrder S; S.init(LAT, DM, c.G, (int)blockIdx.x);
            pg8::EpiBf16<0> E{(bf16*)Y, DM, nullptr, 0, 0, 1.f}; pg8::gemm_phase<pg8::EpiBf16<0>, pg8::StaticOrder, true, true>(c.lds, g, S, E); }
        else { NG g{CC, DM, p.in[I_W1OUT], nullptr, DM, 0, 1 << 30, 0, LAT, 0, DM, DM}; ngemm<1>(g, c, EpiBf{(bf16*)Y, DM, 0, 1.f}); }
    } SEAM(14);
    if (IN(15)) for (int rep_ = 0; rep_ < 1 + (int)((PROBE_MASK >> 15) & 1u); ++rep_) { if (rep_) __syncthreads(); ph_ln1_router(p, c, 1); } SEAM(15);
    if (IN(16)) for (int rep_ = 0; rep_ < 1 + (int)((PROBE_MASK >> 16) & 1u); ++rep_) { if (rep_) __syncthreads(); ph_topk(p, c, 1); } SEAM(16);
    if (IN(17)) for (int rep_ = 0; rep_ < 1 + (int)((PROBE_MASK >> 17) & 1u); ++rep_) { if (rep_) __syncthreads();
        if (FAST_GEMM && MOE_FP8) { pg8::Gemm g{XG, (const bf16*)(p.ws + WS_WGU + WS_MOE_LSTRIDE), NE * MR1, 4096, DM / 2, (size_t)4096 * DM}; pg8::GroupedOrder S; S.init(MR1 / 256, 16, NE, c.G, c.vcu);
            pg8::EpiSwigluF8 E{(unsigned char*)HID, FF, 1.f / W8_GU, H8_SC}; pg8::gemm_phase<pg8::EpiSwigluF8, pg8::GroupedOrder, true, true, true>(c.lds, g, S, E); }
        else if (FAST_GEMM) { pg8::Gemm g{XG, (const bf16*)(p.ws + WS_WGU + WS_MOE_LSTRIDE), NE * MR1, 4096, DM, (size_t)4096 * DM * 2}; pg8::GroupedOrder S; S.init(MR1 / 256, 16, NE, c.G, c.vcu);
            pg8::EpiSwigluP E{HID, FF}; pg8::gemm_phase<pg8::EpiSwigluP, pg8::GroupedOrder, true, true>(c.lds, g, S, E); }
        else { NG g{XG, DM, p.in[I_WG] + (size_t)NE * DM * FF, p.in[I_WU] + (size_t)NE * DM * FF, FF, (size_t)DM * FF, MR1, 0, NE * MR1, 0, FF, DM}; ngemm<2>(g, c, EpiSwiglu{HID}); }
    } SEAM(17);
    if (IN(18)) for (int rep_ = 0; rep_ < 1 + (int)((PROBE_MASK >> 18) & 1u); ++rep_) { if (rep_) __syncthreads();
        if (FAST_GEMM && MOE_FP8) { pg8::Gemm g{HID, (const bf16*)(p.ws + WS_WDN + WS_MOE_LSTRIDE), NE * MR1, DM, FF / 2, (size_t)DM * FF}; pg8::GroupedOrder S; S.init(MR1 / 256, 4, NE, c.G, c.vcu);
            pg8::EpiGateS E{YS, DM, GATE, 1.f / (W8_DN * H8_SC)}; pg8::gemm_phase<pg8::EpiGateS, pg8::GroupedOrder, true, true, true>(c.lds, g, S, E); }
        else if (FAST_GEMM) { pg8::Gemm g{HID, (const bf16*)(p.ws + WS_WDN + WS_MOE_LSTRIDE), NE * MR1, DM, FF, (size_t)DM * FF * 2}; pg8::GroupedOrder S; S.init(MR1 / 256, 4, NE, c.G, c.vcu);
            pg8::EpiGateP E{YS, DM, GATE}; pg8::gemm_phase<pg8::EpiGateP, pg8::GroupedOrder, true, true>(c.lds, g, S, E); }
        else { NG g{HID, FF, p.in[I_WD] + (size_t)NE * FF * DM, nullptr, DM, (size_t)FF * DM, MR1, 0, NE * MR1, 0, DM, FF}; ngemm<1>(g, c, EpiGate{YS, GATE}); }
    } SEAM(18);
    if (IN(19)) for (int rep_ = 0; rep_ < 1 + (int)((PROBE_MASK >> 19) & 1u); ++rep_) { if (rep_) __syncthreads(); ph_combine(p, c, 1); }
    if (PROBE_PH == 19) pt1 = __builtin_amdgcn_s_memrealtime();
    if (PROBE_PH >= 0 && blockIdx.x == 0 && c.tid == 0) { const unsigned long long te = __builtin_amdgcn_s_memrealtime(); while (__builtin_amdgcn_s_memrealtime() - te < pt1 - pt0) __builtin_amdgcn_s_sleep(8); }
#undef IN
#undef SEAM
}

extern "C" void kernel_launch(void* const* d_in, const int* in_sizes, int n_in, void* d_out, int out_size, void* d_ws, size_t ws_size, hipStream_t stream) {
    static int grid = 0;
    if (grid == 0) {
        if (n_in != 26 || out_size != LAT * DM || ws_size < WS_END) { fprintf(stderr, "kernel_launch: unexpected shapes (n_in %d out %d ws %zu)\n", n_in, out_size, ws_size); grid = -1; return; }
        int dev = 0, cus = 0;
        if (hipGetDevice(&dev) != hipSuccess || hipDeviceGetAttribute(&cus, hipDeviceAttributeMultiprocessorCount, dev) != hipSuccess) { grid = -1; return; }
        if (hipFuncSetAttribute((const void*)mk_fwd, hipFuncAttributeMaxDynamicSharedMemorySize, LDS_BYTES) != hipSuccess) { fprintf(stderr, "kernel_launch: hipFuncSetAttribute failed\n"); grid = -1; return; }
        int per_cu = 0;
        if (hipOccupancyMaxActiveBlocksPerMultiprocessor(&per_cu, (const void*)mk_fwd, 512, LDS_BYTES) != hipSuccess || per_cu < 1) fprintf(stderr, "kernel_launch: occupancy query says %d\n", per_cu);
        (void)hipGetLastError();
        grid = cus;
    }
    if (grid < 0) return;
    (void)hipMemsetAsync((char*)d_ws + WS_CTL, 0, CTL_ZERO_BYTES, stream);
    Params a{};
    for (int i = 0; i < 26; ++i) a.in[i] = (const float*)d_in[i];
    a.out = (float*)d_out; a.ws = (unsigned char*)d_ws;
#if MK_MULTI
    for (int ph = 0; ph < NPHASE; ++ph) { a.ph_lo = ph; a.ph_hi = ph + 1; hipLaunchKernelGGL(mk_fwd, dim3(grid), dim3(512), LDS_BYTES, stream, a); }
#else
    a.ph_lo = 0; a.ph_hi = NPHASE;
    hipLaunchKernelGGL(mk_fwd, dim3(grid), dim3(512), LDS_BYTES, stream, a);
#endif
}
```

```cpp
#include <hip/hip_runtime.h>
#include <cstdio>
#include <cstdint>

#define GAS __attribute__((address_space(1)))
#define LAS __attribute__((address_space(3)))
typedef unsigned short bf16;
typedef unsigned v4u __attribute__((ext_vector_type(4)));
typedef unsigned v2u __attribute__((ext_vector_type(2)));
typedef float f32x4 __attribute__((ext_vector_type(4)));
typedef float f32x2 __attribute__((ext_vector_type(2)));
typedef float f32x16 __attribute__((ext_vector_type(16)));
typedef GAS unsigned gu32;

#ifndef PROBE_PH
#define PROBE_PH -1
#endif
#ifndef PROBE_MASK
#define PROBE_MASK 0u
#endif
#ifndef FUSE_QKV
#define FUSE_QKV 1
#endif
#ifndef MOE_FP8
#define MOE_FP8 1
#endif
#ifndef FAST_NA
#define FAST_NA 1
#endif
#ifndef FAST_ATTN
#define FAST_ATTN 1
#endif
#ifndef FAST_GEMM
#define FAST_GEMM 1
#endif
#ifndef MK_MULTI
#define MK_MULTI 0
#endif

constexpr int NBATCH = 8, SEQ = 2048, DM = 1024, NCTX = 256;
constexpr int LAT = NBATCH * SEQ;
constexpr int NTOK = LAT + NBATCH * NCTX;
constexpr int EIN = 2304, OIN = 2048, NE = 16, FF = 2048;
constexpr int MR0 = 2304, MR1 = 2048;
constexpr float LOG2E = 1.4426950408889634f;
constexpr float C2 = 0.125f * LOG2E;
constexpr float ALPHA = 1.4142135623730951f;
constexpr float LN_EPS = 1e-5f, RMS_EPS = 1e-6f;
constexpr float LAM_INIT = 0.2f;
constexpr int NPHASE = 20;
constexpr float W8_GU = 32.f, W8_DN = 64.f, H8_SC = 8.f;

constexpr size_t MiB = 1u << 20;
constexpr size_t WS_CTL = 0, CTL_ZERO_BYTES = 1 * MiB;
constexpr size_t WS_MOD = 1 * MiB;
constexpr size_t WS_ROPE = 1 * MiB + 512 * 1024;
constexpr size_t WS_W0IN = 2 * MiB;
constexpr size_t WS_W0OUT = 7 * MiB;
constexpr size_t WS_W1IN = 9 * MiB;
constexpr size_t WS_W1OUT = 13 * MiB;
constexpr size_t WS_AFF = 16 * MiB;
constexpr size_t WS_INV = 18 * MiB;
constexpr size_t WS_GATE = 20 * MiB;
constexpr size_t WS_WGU = 24 * MiB;
constexpr size_t WS_WDN = 152 * MiB;
constexpr size_t WS_MOE_LSTRIDE = 192 * MiB;
constexpr size_t WS_XS = 408 * MiB;
constexpr size_t WS_HB = 480 * MiB;
constexpr size_t WS_QKV = 516 * MiB;
constexpr size_t WS_CC = 597 * MiB;
constexpr size_t WS_AO = 633 * MiB;
constexpr size_t WS_Y = 705 * MiB;
constexpr size_t WS_XG = 516 * MiB;
constexpr size_t WS_HID = 588 * MiB;
constexpr size_t WS_YS = 732 * MiB;
constexpr size_t WS_PF = 804 * MiB;
constexpr size_t WS_END = 968 * MiB;

constexpr int CW_BAR = 4096;
constexpr int LDS_BYTES = 147456;
constexpr int MISC_OFF = 131072 + 320;

__device__ __forceinline__ float bf2f(unsigned v) { return __uint_as_float(v << 16); }
__device__ __forceinline__ unsigned f2bf(float f) { unsigned u = __float_as_uint(f); return (u + 0x7fffu + ((u >> 16) & 1u)) >> 16; }
__device__ __forceinline__ unsigned pk2(float lo, float hi) { return f2bf(lo) | (f2bf(hi) << 16); }
__device__ __forceinline__ float wave_sum(float v) {
#pragma unroll
    for (int o = 1; o < 64; o <<= 1) v += __shfl_xor(v, o);
    return v;
}
__device__ __forceinline__ float wave_max(float v) {
#pragma unroll
    for (int o = 1; o < 64; o <<= 1) v = fmaxf(v, __shfl_xor(v, o));
    return v;
}
__device__ __forceinline__ void unpack8(const v4u w, float* f) {
    f[0] = bf2f(w.x & 0xffffu); f[1] = __uint_as_float(w.x & 0xffff0000u);
    f[2] = bf2f(w.y & 0xffffu); f[3] = __uint_as_float(w.y & 0xffff0000u);
    f[4] = bf2f(w.z & 0xffffu); f[5] = __uint_as_float(w.z & 0xffff0000u);
    f[6] = bf2f(w.w & 0xffffu); f[7] = __uint_as_float(w.w & 0xffff0000u);
}

#define XB_TMO      128
#define XB_XCNT(j)  (256  + 64 * (j))
#define XB_XSUB(j)  (1280 + 64 * (j))
#define XB_XGEN(j)  (2304 + 64 * (j))
#define XB_TOP      3328
#define XB_TOPGEN   3392
#define XCD_BAR_WORDS 3456
#define XB_SPIN_CAP (1u << 18)
__device__ __forceinline__ unsigned xb_ld(unsigned* p)              { return __hip_atomic_load(p, __ATOMIC_RELAXED, __HIP_MEMORY_SCOPE_AGENT); }
__device__ __forceinline__ unsigned xb_add(unsigned* p, unsigned v) { return __hip_atomic_fetch_add(p, v, __ATOMIC_RELAXED, __HIP_MEMORY_SCOPE_AGENT); }
__device__ __forceinline__ unsigned xb_xcc_id() { return (unsigned)__builtin_amdgcn_s_getreg((3 << 11) | 20) & 0xFu; }
#define XB_SPIN(cond, bar) do { unsigned _sp = 0; while (cond) { __builtin_amdgcn_s_sleep(1); \
    if ((++_sp & 255u) == 0u) { if (xb_ld(&(bar)[XB_TMO])) break; if (_sp > XB_SPIN_CAP) { atomicAdd(&(bar)[XB_TMO], 1u); break; } } } } while (0)
struct XcdBarrier { unsigned* bar; unsigned x; volatile LAS unsigned* st; };
__device__ __forceinline__ XcdBarrier xcd_barrier_post(unsigned* bar, volatile LAS unsigned* st) {
    XcdBarrier b; b.bar = bar; b.x = xb_xcc_id(); b.st = st;
    if (threadIdx.x == 0) (void)xb_add(&bar[XB_XCNT(b.x)], 1u);
    return b;
}
__device__ __forceinline__ void xcd_barrier_complete(unsigned* bar, unsigned x, unsigned& nloc, unsigned& nx) {
    const unsigned G = gridDim.x * gridDim.y * gridDim.z;
    unsigned sum, cnt, mine, sp = 0u;
    for (;;) {
        sum = 0u; cnt = 0u; mine = 0u;
#pragma unroll
        for (unsigned j = 0; j < 16; ++j) { const unsigned c = xb_ld(&bar[XB_XCNT(j)]); sum += c; cnt += (c > 0u) ? 1u : 0u; mine = (j == x) ? c : mine; }
        if (sum == G) break;
        __builtin_amdgcn_s_sleep(1);
        if ((++sp & 255u) == 0u) { if (xb_ld(&bar[XB_TMO])) break; if (sp > XB_SPIN_CAP) { atomicAdd(&bar[XB_TMO], 1u); break; } }
    }
    nloc = mine > 0u ? mine : 1u; nx = cnt > 0u ? cnt : 1u;
}
__device__ __forceinline__ void xcd_barrier(const XcdBarrier& b) {
    asm volatile("s_waitcnt vmcnt(0)" ::: "memory");
    __syncthreads();
    if (threadIdx.x == 0) {
        unsigned* bar = b.bar;
        __builtin_amdgcn_s_waitcnt(0);
        unsigned nloc = b.st[0], nx = b.st[1];
        if (nloc == 0u) { xcd_barrier_complete(bar, b.x, nloc, nx); b.st[0] = nloc; b.st[1] = nx; }
        const unsigned old = xb_add(&bar[XB_XSUB(b.x)], 1u);
        const unsigned gen = old / nloc;
        if (old + 1u == (gen + 1u) * nloc) {
            __builtin_amdgcn_fence(__ATOMIC_RELEASE, "agent");
            asm volatile("s_waitcnt vmcnt(0)" ::: "memory");
            const unsigned og = xb_add(&bar[XB_TOP], 1u);
            const unsigned tg = og / nx;
            if (og + 1u == (tg + 1u) * nx) xb_add(&bar[XB_TOPGEN], 1u);
            else XB_SPIN(xb_ld(&bar[XB_TOPGEN]) == tg, bar);
            __builtin_amdgcn_fence(__ATOMIC_ACQUIRE, "agent");
            xb_add(&bar[XB_XGEN(b.x)], 1u);
            asm volatile("s_waitcnt vmcnt(0)" ::: "memory");
        } else {
            XB_SPIN(xb_ld(&bar[XB_XGEN(b.x)]) == gen, bar);
            __builtin_amdgcn_fence(__ATOMIC_ACQUIRE, "agent");
            asm volatile("s_waitcnt vmcnt(0)" ::: "memory");
        }
    }
    __syncthreads();
}

namespace pg8 {
#define PG8_LAS __attribute__((address_space(3)))
typedef unsigned short bf16_t;
typedef short bf16x8 __attribute__((ext_vector_type(8)));
typedef float f32x4 __attribute__((ext_vector_type(4)));
typedef unsigned u32x4 __attribute__((ext_vector_type(4)));
constexpr int BM = 256, BK = 64, HALF = 128, HTB = HALF * BK * 2  , STAGE_BYTES = 8 * HTB, NXCD = 8, WGM = 8;

__host__ __device__ __forceinline__ int lds_byte(int r, int c) { const int st = (r >> 4) * 2 + (c >> 5), rr = r & 15, cc = c & 31, ob = rr * 64 + cc * 2; return st * 1024 + (ob ^ (((ob >> 9) & 1) << 5)); }
__host__ __device__ __forceinline__ void stage_rc(int b, int& R, int& C) { const int st = b / 1024, sb = b % 1024, swz = sb ^ (((sb >> 9) & 1) << 5); R = (st >> 1) * 16 + swz / 64; C = (st & 1) * 32 + (swz % 64) / 2; }
__host__ __device__ __forceinline__ int perm32(int rho) { const int n = rho >> 4, i = rho & 15; return 8 * (i >> 2) + 4 * n + (i & 3); }

struct Unit { int pm, pn, e; };
struct Gemm { const bf16_t* A; const bf16_t* Bt; int M, N, K; size_t bstride; };

struct StaticOrder {
    int nM, nN, nwg, G, c;
    __host__ __device__ void init(int M, int N, int G_, int c_) { nM = M / BM; nN = N / BM; nwg = nM * nN; G = G_; c = c_; }
    __host__ __device__ bool next(int i, Unit& u) const {
        const long L = (long)i * G + c; if (L >= nwg) return false;
        int wgid = (int)L; { const int q = nwg / NXCD, r = nwg % NXCD, xcd = wgid % NXCD, off = wgid / NXCD; wgid = (xcd < r ? xcd * (q + 1) : r * (q + 1) + (xcd - r) * q) + off; }
        const int nig = WGM * nN, gid = wgid / nig, fm = gid * WGM, gsz = (nM - fm) < WGM ? (nM - fm) : WGM;
        u.pm = fm + ((wgid % nig) % gsz); u.pn = (wgid % nig) / gsz; u.e = 0; return true;
    }
    __device__ __forceinline__ void a_ready(const Unit&) const {}
    __device__ __forceinline__ void done(const Unit&) const {}
};

__device__ __forceinline__ unsigned cvt_pk_bf16(float lo, float hi) { unsigned r; asm volatile("v_cvt_pk_bf16_f32 %0, %1, %2" : "=v"(r) : "v"(lo), "v"(hi)); return r; }
typedef float f32x2 __attribute__((ext_vector_type(2)));
__device__ __forceinline__ f32x2 gelu_pk(f32x2 v) {
    const f32x2 av = __builtin_elementwise_abs(v), d = av * 0.2316418882f + 1.0f;
    f32x2 t; t.x = __builtin_amdgcn_rcpf(d.x); t.y = __builtin_amdgcn_rcpf(d.y);
    f32x2 q = t * 0.5307027145f + (-0.7265760135f); q = q * t + 0.7107068705f; q = q * t + (-0.142248368f); q = q * t + 0.127414796f; q = q * t;
    const f32x2 s = (v * v) * (-0.72134752044f);
    f32x2 e; e.x = __builtin_amdgcn_exp2f(s.x); e.y = __builtin_amdgcn_exp2f(s.y);
    const f32x2 m = v * (q * e), r = v - m;
    f32x2 o; o.x = v.x < 0.f ? m.x : r.x; o.y = v.y < 0.f ? m.y : r.y; return o;
}

template <int ACT  > struct EpiBf16 {
    static constexpr bool PERM = true, AFTER_DRAIN = false; static_assert(ACT == 0 || ACT == 1, "EpiBf16: ACT is 0 (none) or 1 (gelu_pk)");
    bf16_t* O; int ldc; const float* bias; int split_cols; size_t split_stride; float scale0;
    __device__ __forceinline__ void operator()(const f32x4 (&acc)[2][2][4][2], const Unit& u, int wr, int wc, int fr, int fq) const {
        const int row0 = u.pm * BM + wr * 64 + fr; int colt = u.pn * BM; bf16_t* base = O;
        float sc = 1.f; if (split_cols) { const int t = colt / split_cols; base += (size_t)t * split_stride; colt -= t * split_cols; if (t == 0) sc = scale0; }
        const int col0 = colt + wc * 32 + 8 * fq, bcol0 = u.pn * BM + wc * 32 + 8 * fq;
        f32x4 bv[2][2];
#pragma unroll
        for (int bj = 0; bj < 2; ++bj)
#pragma unroll
            for (int n = 0; n < 2; ++n) bv[bj][n] = bias ? *(const f32x4*)(bias + bcol0 + bj * HALF + 4 * n) : (f32x4){0.f, 0.f, 0.f, 0.f};
#pragma unroll
        for (int ai = 0; ai < 2; ++ai)
#pragma unroll
            for (int m = 0; m < 4; ++m) { bf16_t* rowp = base + (size_t)(row0 + ai * HALF + m * 16) * ldc + col0;
#pragma unroll
                for (int bj = 0; bj < 2; ++bj) { f32x4 v0 = acc[ai][bj][m][0] + bv[bj][0], v1 = acc[ai][bj][m][1] + bv[bj][1];
                    if (ACT == 1) { f32x2 a = gelu_pk((f32x2){v0[0], v0[1]}), b = gelu_pk((f32x2){v0[2], v0[3]}), c = gelu_pk((f32x2){v1[0], v1[1]}), d = gelu_pk((f32x2){v1[2], v1[3]});
                        v0 = (f32x4){a.x, a.y, b.x, b.y}; v1 = (f32x4){c.x, c.y, d.x, d.y}; }
                    v0 = v0 * sc; v1 = v1 * sc; u32x4 w; w.x = cvt_pk_bf16(v0[0], v0[1]); w.y = cvt_pk_bf16(v0[2], v0[3]); w.z = cvt_pk_bf16(v1[0], v1[1]); w.w = cvt_pk_bf16(v1[2], v1[3]);
                    *(u32x4*)(rowp + bj * HALF) = w; } }
    }
};

typedef int i32x4 __attribute__((ext_vector_type(4))); typedef int i32x8 __attribute__((ext_vector_type(8)));
__device__ __forceinline__ i32x8 cat16(bf16x8 lo, bf16x8 hi) { const i32x4 a = __builtin_bit_cast(i32x4, lo), b = __builtin_bit_cast(i32x4, hi); return __builtin_shufflevector(a, b, 0, 1, 2, 3, 4, 5, 6, 7); }
__device__ __forceinline__ void mfma_f8_acc(f32x4& acc, const i32x8& b, const i32x8& a, int sc) {
    asm volatile("v_mfma_scale_f32_16x16x128_f8f6f4 %0, %1, %2, %0, %3, %3 op_sel_hi:[0,0,0]" : "+v"(acc) : "v"(b), "v"(a), "v"(sc)); }
template <class Epi, class Sched, bool ALIGN_EPI = false, bool SP2 = false, bool FP8 = false>
__device__ __forceinline__ void gemm_phase(PG8_LAS unsigned char* lds, const Gemm g, const Sched& S, const Epi& E) {
    const int tid = threadIdx.x, wid = __builtin_amdgcn_readfirstlane(tid >> 6), lane = tid & 63, wr = wid >> 2, wc = wid & 3, fr = lane & 15, fq = lane >> 4;
    const int K = g.K, nt = K / BK;
    unsigned voffA[2], voffB[2];
#pragma unroll
    for (int i = 0; i < 2; ++i) { int R, C; stage_rc(tid * 16 + i * 8192, R, C); const int Rb = Epi::PERM ? ((R & ~31) + perm32(R & 31)) : R;
        voffA[i] = (unsigned)(R * K + C) * 2u; voffB[i] = (unsigned)(Rb * K + C) * 2u; }
    const size_t kstep = (size_t)(BK * 2);
    const size_t hstep = (size_t)HALF * K * 2;
    const size_t tstep = 2 * hstep;
    const unsigned ldsw = (unsigned)wid * 1024u;
    const int aoff = FP8 ? lds_byte(wr * 64 + fr, 16 * fq) : lds_byte(wr * 64 + fr, fq * 8), boff = FP8 ? lds_byte(wc * 32 + fr, 16 * fq) : lds_byte(wc * 32 + fr, fq * 8);
    constexpr int KOFF = FP8 ? 16 : 1024;
#define PG8_SA(b, h) (((b) * 2 + (h)) * HTB)
#define PG8_SB(b, h) ((4 + (b) * 2 + (h)) * HTB)
#define PG8_STAGE(bufoff, gbase, voff) do { _Pragma("unroll") for (int _i = 0; _i < 2; ++_i) \
        __builtin_amdgcn_global_load_lds((const unsigned*)((const char*)(gbase) + (voff)[_i]), (PG8_LAS unsigned*)(lds + (bufoff) + ldsw + _i * 8192), 16, 0, 0); } while (0)
#define PG8_LDA(dst, b, h) do { _Pragma("unroll") for (int m = 0; m < 4; ++m) _Pragma("unroll") for (int k = 0; k < 2; ++k) dst[m][k] = *(const PG8_LAS bf16x8*)(lds + PG8_SA(b, h) + aoff + m * 2048 + k * KOFF); } while (0)
#define PG8_LDB(dst, b, h) do { _Pragma("unroll") for (int n = 0; n < 2; ++n) _Pragma("unroll") for (int k = 0; k < 2; ++k) dst[n][k] = *(const PG8_LAS bf16x8*)(lds + PG8_SB(b, h) + boff + n * 2048 + k * KOFF); } while (0)
#define PG8_MMA(ai, bj, At, Bt) do { __builtin_amdgcn_s_setprio(1); _Pragma("unroll") for (int m = 0; m < 4; ++m) _Pragma("unroll") for (int n = 0; n < 2; ++n) { \
        if constexpr (FP8) mfma_f8_acc(acc[ai][bj][m][n], cat16(Bt[n][0], Bt[n][1]), cat16(At[m][0], At[m][1]), f8scale); \
        else { _Pragma("unroll") for (int k = 0; k < 2; ++k) acc[ai][bj][m][n] = __builtin_amdgcn_mfma_f32_16x16x32_bf16(Bt[n][k], At[m][k], acc[ai][bj][m][n], 0, 0, 0); } } __builtin_amdgcn_s_setprio(0); } while (0)
#define PG8_WAIT_V(n) asm volatile("s_waitcnt vmcnt(" #n ")" ::: "memory")
#define PG8_WAIT_L(n) asm volatile("s_waitcnt lgkmcnt(" #n ")" ::: "memory")
#define PG8_BAR __builtin_amdgcn_s_barrier()
#define PG8_SCHED __builtin_amdgcn_sched_barrier(0)
    Unit cur, nxt; int ui = 0;
    if (!S.next(0, cur)) return;
    f32x4 acc[2][2][4][2];
#pragma unroll
    for (int a = 0; a < 2; ++a)
#pragma unroll
        for (int b = 0; b < 2; ++b)
#pragma unroll
            for (int m = 0; m < 4; ++m)
#pragma unroll
                for (int n = 0; n < 2; ++n) acc[a][b][m][n] = (f32x4){0.f, 0.f, 0.f, 0.f};
    int f8scale = 0x7F7F7F7F; asm volatile("" : "+v"(f8scale));
    bf16x8 At[4][2], B0[2][2], B1[2][2];
    const char* cA = (const char*)g.A + (size_t)cur.pm * tstep; const char* cB = (const char*)g.Bt + (size_t)cur.pn * tstep + (size_t)cur.e * g.bstride;
    S.a_ready(cur);
    if constexpr (SP2) {
        PG8_STAGE(PG8_SB(0, 0), cB, voffB); PG8_STAGE(PG8_SB(0, 1), cB + hstep, voffB); PG8_STAGE(PG8_SA(0, 0), cA, voffA); PG8_STAGE(PG8_SA(0, 1), cA + hstep, voffA);
        if (wr == 1) PG8_BAR;
        PG8_WAIT_V(2); PG8_BAR;
        PG8_STAGE(PG8_SB(1, 0), cB + kstep, voffB); PG8_STAGE(PG8_SA(1, 0), cA + kstep, voffA); PG8_STAGE(PG8_SB(1, 1), cB + hstep + kstep, voffB);
        PG8_WAIT_V(6); PG8_BAR;
    } else {
        PG8_STAGE(PG8_SB(0, 0), cB, voffB); PG8_STAGE(PG8_SA(0, 0), cA, voffA); PG8_STAGE(PG8_SB(0, 1), cB + hstep, voffB); PG8_STAGE(PG8_SA(0, 1), cA + hstep, voffA);
        if (wr == 1) PG8_BAR;
        PG8_WAIT_V(4); PG8_BAR;
        PG8_STAGE(PG8_SB(1, 0), cB + kstep, voffB); PG8_STAGE(PG8_SA(1, 0), cA + kstep, voffA); PG8_STAGE(PG8_SB(1, 1), cB + hstep + kstep, voffB);
        PG8_WAIT_V(6); PG8_BAR;
    }
    for (;;) {
        const bool has_next = S.next(ui + 1, nxt);
        const char* nA = has_next ? (const char*)g.A + (size_t)nxt.pm * tstep : cA; const char* nB = has_next ? (const char*)g.Bt + (size_t)nxt.pn * tstep + (size_t)nxt.e * g.bstride : cB;
        for (int t = 0; t < nt; t += 2) {
            const bool last = (t == nt - 2);
            const char* a1 = cA + (size_t)(t + 1) * kstep;
            const char* a2 = last ? nA : cA + (size_t)(t + 2) * kstep; const char* b2 = last ? nB : cB + (size_t)(t + 2) * kstep;
            const char* a3 = a2 + kstep; const char* b3 = b2 + kstep;
            if (last && has_next) S.a_ready(nxt);
            if constexpr (SP2) {
            PG8_LDB(B0, 0, 0); PG8_LDB(B1, 0, 1); PG8_SCHED; PG8_LDA(At, 0, 0); PG8_STAGE(PG8_SA(1, 1), a1 + hstep, voffA);
            PG8_WAIT_V(8); PG8_WAIT_L(0); PG8_BAR; PG8_MMA(0, 0, At, B0); PG8_MMA(0, 1, At, B1); PG8_BAR; PG8_SCHED;
            PG8_LDA(At, 0, 1); PG8_STAGE(PG8_SB(0, 0), b2, voffB); PG8_STAGE(PG8_SB(0, 1), b2 + hstep, voffB); PG8_STAGE(PG8_SA(0, 0), a2, voffA);
            PG8_WAIT_V(8); PG8_WAIT_L(0); PG8_BAR; PG8_MMA(1, 0, At, B0); PG8_MMA(1, 1, At, B1); PG8_BAR; PG8_SCHED;
            PG8_LDB(B0, 1, 0); PG8_LDB(B1, 1, 1); PG8_SCHED; PG8_LDA(At, 1, 0); PG8_STAGE(PG8_SA(0, 1), a2 + hstep, voffA);
            PG8_WAIT_V(8); PG8_WAIT_L(0); PG8_BAR; PG8_MMA(0, 0, At, B0); PG8_MMA(0, 1, At, B1); PG8_BAR; PG8_SCHED;
            PG8_LDA(At, 1, 1); PG8_STAGE(PG8_SB(1, 0), b3, voffB); PG8_STAGE(PG8_SB(1, 1), b3 + hstep, voffB); PG8_STAGE(PG8_SA(1, 0), a3, voffA);
            PG8_WAIT_V(8); PG8_WAIT_L(0); PG8_BAR; PG8_MMA(1, 0, At, B0); PG8_MMA(1, 1, At, B1); PG8_BAR; PG8_SCHED;
            } else {
            PG8_LDB(B0, 0, 0); PG8_SCHED; PG8_LDA(At, 0, 0); PG8_STAGE(PG8_SA(1, 1), a1 + hstep, voffA);
            PG8_WAIT_L(8); PG8_BAR; PG8_WAIT_L(0); PG8_MMA(0, 0, At, B0); PG8_BAR; PG8_SCHED;
            PG8_LDB(B1, 0, 1); PG8_STAGE(PG8_SB(0, 0), b2, voffB);
            PG8_BAR; PG8_WAIT_L(0); PG8_MMA(0, 1, At, B1); PG8_BAR;
            PG8_LDA(At, 0, 1); PG8_STAGE(PG8_SA(0, 0), a2, voffA);
            PG8_BAR; PG8_WAIT_L(0); PG8_MMA(1, 0, At, B0); PG8_BAR; PG8_SCHED;
            PG8_STAGE(PG8_SB(0, 1), b2 + hstep, voffB);
            PG8_WAIT_V(6); PG8_BAR; PG8_MMA(1, 1, At, B1); PG8_BAR;
            PG8_LDB(B0, 1, 0); PG8_SCHED; PG8_LDA(At, 1, 0); PG8_STAGE(PG8_SA(0, 1), a2 + hstep, voffA);
            PG8_WAIT_L(8); PG8_BAR; PG8_WAIT_L(0); PG8_MMA(0, 0, At, B0); PG8_BAR; PG8_SCHED;
            PG8_LDB(B1, 1, 1); PG8_STAGE(PG8_SB(1, 0), b3, voffB);
            PG8_BAR; PG8_WAIT_L(0); PG8_MMA(0, 1, At, B1); PG8_BAR;
            PG8_LDA(At, 1, 1); PG8_STAGE(PG8_SA(1, 0), a3, voffA);
            PG8_BAR; PG8_WAIT_L(0); PG8_MMA(1, 0, At, B0); PG8_BAR; PG8_SCHED;
            PG8_STAGE(PG8_SB(1, 1), b3 + hstep, voffB);
            PG8_WAIT_V(6); PG8_BAR; PG8_MMA(1, 1, At, B1); PG8_BAR;
            }
        }
        if constexpr (ALIGN_EPI) { if (wr == 0) PG8_BAR; }
        if constexpr (FP8) asm volatile("s_nop 15\n\ts_nop 15" : "+v"(acc[1][1][0][0]), "+v"(acc[1][1][0][1]), "+v"(acc[1][1][1][0]), "+v"(acc[1][1][1][1]), "+v"(acc[1][1][2][0]), "+v"(acc[1][1][2][1]), "+v"(acc[1][1][3][0]), "+v"(acc[1][1][3][1]));
        if constexpr (!Epi::AFTER_DRAIN) { E(acc, cur, wr, wc, fr, fq); S.done(cur); }
        if (!has_next) break;
#pragma unroll
        for (int a = 0; a < 2; ++a)
#pragma unroll
            for (int b = 0; b < 2; ++b)
#pragma unroll
                for (int m = 0; m < 4; ++m)
#pragma unroll
                    for (int n = 0; n < 2; ++n) acc[a][b][m][n] = (f32x4){0.f, 0.f, 0.f, 0.f};
        cur = nxt; cA = nA; cB = nB; ++ui;
        if constexpr (ALIGN_EPI) { if (wr == 1) PG8_BAR; }
    }
    PG8_WAIT_V(0);
    if constexpr (!ALIGN_EPI) { if (wr == 0) PG8_BAR; }
    PG8_BAR;
    if constexpr (Epi::AFTER_DRAIN) { E.fused(acc, cur, wr, wc, fr, fq, lds, wid, lane); S.done(cur); }
#undef PG8_SA
#undef PG8_SB
#undef PG8_STAGE
#undef PG8_LDA
#undef PG8_LDB
#undef PG8_MMA
#undef PG8_WAIT_V
#undef PG8_WAIT_L
#undef PG8_BAR
#undef PG8_SCHED
}
}

namespace pg8 {
struct EpiF32P {
    static constexpr bool PERM = false, AFTER_DRAIN = false;
    float* O; int ldc;
    __device__ __forceinline__ void operator()(const f32x4 (&acc)[2][2][4][2], const Unit& u, int wr, int wc, int fr, int fq) const {
        const int row0 = u.pm * BM + wr * 64 + fr, col0 = u.pn * BM + wc * 32 + 4 * fq;
#pragma unroll
        for (int ai = 0; ai < 2; ++ai)
#pragma unroll
            for (int m = 0; m < 4; ++m) { float* rowp = O + (size_t)(row0 + ai * HALF + m * 16) * ldc + col0;
#pragma unroll
                for (int bj = 0; bj < 2; ++bj)
#pragma unroll
                    for (int n = 0; n < 2; ++n) *(f32x4*)(rowp + bj * HALF + n * 16) = acc[ai][bj][m][n]; }
    }
};
struct EpiSwigluP {
    static constexpr bool PERM = true, AFTER_DRAIN = false;
    bf16_t* O; int ldc;
    __device__ __forceinline__ void operator()(const f32x4 (&acc)[2][2][4][2], const Unit& u, int wr, int wc, int fr, int fq) const {
        const int row0 = u.pm * BM + wr * 64 + fr, col0 = u.pn * HALF + wc * 32 + 8 * fq;
#pragma unroll
        for (int ai = 0; ai < 2; ++ai)
#pragma unroll
            for (int m = 0; m < 4; ++m) {
                float h[8];
#pragma unroll
                for (int n = 0; n < 2; ++n)
#pragma unroll
                    for (int j = 0; j < 4; ++j) { const float g = acc[ai][0][m][n][j], up = acc[ai][1][m][n][j];
                        h[4 * n + j] = g * up * __builtin_amdgcn_rcpf(1.0f + __builtin_amdgcn_exp2f(-1.4426950408889634f * g)); }
                u32x4 w; w.x = cvt_pk_bf16(h[0], h[1]); w.y = cvt_pk_bf16(h[2], h[3]); w.z = cvt_pk_bf16(h[4], h[5]); w.w = cvt_pk_bf16(h[6], h[7]);
                *(u32x4*)(O + (size_t)(row0 + ai * HALF + m * 16) * ldc + col0) = w; }
    }
};
struct EpiGateP {
    static constexpr bool PERM = true, AFTER_DRAIN = false;
    bf16_t* O; int ldc; const float* gate;
    __device__ __forceinline__ void operator()(const f32x4 (&acc)[2][2][4][2], const Unit& u, int wr, int wc, int fr, int fq) const {
        const int row0 = u.pm * BM + wr * 64 + fr, col0 = u.pn * BM + wc * 32 + 8 * fq;
#pragma unroll
        for (int ai = 0; ai < 2; ++ai)
#pragma unroll
            for (int m = 0; m < 4; ++m) { const int row = row0 + ai * HALF + m * 16; const float gt = gate[row]; bf16_t* rowp = O + (size_t)row * ldc + col0;
#pragma unroll
                for (int bj = 0; bj < 2; ++bj) { const f32x4 v0 = acc[ai][bj][m][0] * gt, v1 = acc[ai][bj][m][1] * gt;
                    u32x4 w; w.x = cvt_pk_bf16(v0[0], v0[1]); w.y = cvt_pk_bf16(v0[2], v0[3]); w.z = cvt_pk_bf16(v1[0], v1[1]); w.w = cvt_pk_bf16(v1[2], v1[3]);
                    *(u32x4*)(rowp + bj * HALF) = w; } }
    }
};
__device__ __forceinline__ unsigned pk4_fp8(float a, float b, float c, float d) {
    a = __builtin_fminf(__builtin_fmaxf(a, -448.f), 448.f); b = __builtin_fminf(__builtin_fmaxf(b, -448.f), 448.f);
    c = __builtin_fminf(__builtin_fmaxf(c, -448.f), 448.f); d = __builtin_fminf(__builtin_fmaxf(d, -448.f), 448.f);
    int w = 0; w = __builtin_amdgcn_cvt_pk_fp8_f32(a, b, w, false); w = __builtin_amdgcn_cvt_pk_fp8_f32(c, d, w, true); return (unsigned)w; }
struct EpiSwigluF8 {
    static constexpr bool PERM = true, AFTER_DRAIN = false;
    unsigned char* O; int ldc; float ws, hs;
    __device__ __forceinline__ void operator()(const f32x4 (&acc)[2][2][4][2], const Unit& u, int wr, int wc, int fr, int fq) const {
        const int row0 = u.pm * BM + wr * 64 + fr, col0 = u.pn * HALF + wc * 32 + 8 * fq;
#pragma unroll
        for (int ai = 0; ai < 2; ++ai)
#pragma unroll
            for (int m = 0; m < 4; ++m) {
                float h[8];
#pragma unroll
                for (int n = 0; n < 2; ++n)
#pragma unroll
                    for (int j = 0; j < 4; ++j) { const float g = acc[ai][0][m][n][j] * ws, up = acc[ai][1][m][n][j] * ws;
                        h[4 * n + j] = g * up * hs * __builtin_amdgcn_rcpf(1.0f + __builtin_amdgcn_exp2f(-1.4426950408889634f * g)); }
                typedef unsigned u32x2 __attribute__((ext_vector_type(2)));
                *(u32x2*)(O + (size_t)(row0 + ai * HALF + m * 16) * ldc + col0) = (u32x2){pk4_fp8(h[0], h[1], h[2], h[3]), pk4_fp8(h[4], h[5], h[6], h[7])}; }
    }
};
struct EpiGateS {
    static constexpr bool PERM = true, AFTER_DRAIN = false;
    bf16_t* O; int ldc; const float* gate; float sc;
    __device__ __forceinline__ void operator()(const f32x4 (&acc)[2][2][4][2], const Unit& u, int wr, int wc, int fr, int fq) const {
        const int row0 = u.pm * BM + wr * 64 + fr, col0 = u.pn * BM + wc * 32 + 8 * fq;
#pragma unroll
        for (int ai = 0; ai < 2; ++ai)
#pragma unroll
            for (int m = 0; m < 4; ++m) { const int row = row0 + ai * HALF + m * 16; const float gt = gate[row] * sc; bf16_t* rowp = O + (size_t)row * ldc + col0;
#pragma unroll
                for (int bj = 0; bj < 2; ++bj) { const f32x4 v0 = acc[ai][bj][m][0] * gt, v1 = acc[ai][bj][m][1] * gt;
                    u32x4 w; w.x = cvt_pk_bf16(v0[0], v0[1]); w.y = cvt_pk_bf16(v0[2], v0[3]); w.z = cvt_pk_bf16(v1[0], v1[1]); w.w = cvt_pk_bf16(v1[2], v1[3]);
                    *(u32x4*)(rowp + bj * HALF) = w; } }
    }
};
struct EpiQKV {
    static constexpr bool PERM = true, AFTER_DRAIN = false;
    bf16_t* O; int ldc; const float* rope; const float* qn; const float* kn; float qscale; float rms_eps;
    __device__ __forceinline__ void operator()(const f32x4 (&acc)[2][2][4][2], const Unit& u, int wr, int wc, int fr, int fq) const {
        const int hs = 4 * u.pn + wc;
        const bool isq = hs < 8 || (hs >= 24 && hs < 32), isk = (hs >= 8 && hs < 16) || hs == 32 || hs == 33, nrm = hs >= 24 && hs < 34;
        const bool rope_on = (isq || isk) && u.pm < 64;
        const float osc = isq ? qscale : 1.f;
        const bool first = fq < 2;
        f32x4 gv[2][2];
#pragma unroll
        for (int bj = 0; bj < 2; ++bj)
#pragma unroll
            for (int n = 0; n < 2; ++n) gv[bj][n] = nrm ? *(const f32x4*)((hs < 32 ? qn : kn) + 32 * bj + 8 * fq + 4 * n) : (f32x4){1.f, 1.f, 1.f, 1.f};
#pragma unroll
        for (int ai = 0; ai < 2; ++ai)
#pragma unroll
            for (int m = 0; m < 4; ++m) {
                const int row = u.pm * BM + ai * HALF + wr * 64 + m * 16 + fr;
                f32x4 v[2][2];
#pragma unroll
                for (int bj = 0; bj < 2; ++bj)
#pragma unroll
                    for (int n = 0; n < 2; ++n) v[bj][n] = acc[ai][bj][m][n];
                if (nrm) {
                    float ss = 0.f;
#pragma unroll
                    for (int bj = 0; bj < 2; ++bj)
#pragma unroll
                        for (int n = 0; n < 2; ++n) ss += (v[bj][n][0] * v[bj][n][0] + v[bj][n][1] * v[bj][n][1]) + (v[bj][n][2] * v[bj][n][2] + v[bj][n][3] * v[bj][n][3]);
                    ss += __shfl_xor(ss, 16); ss += __shfl_xor(ss, 32);
                    const float r = __builtin_amdgcn_rsqf(ss * (1.f / 64.f) + rms_eps);
#pragma unroll
                    for (int bj = 0; bj < 2; ++bj)
#pragma unroll
                        for (int n = 0; n < 2; ++n) v[bj][n] = v[bj][n] * r * gv[bj][n];
                }
                if (rope_on) {
                    const int t = row & 2047;
#pragma unroll
                    for (int bj = 0; bj < 2; ++bj) {
                        const int pos = bj ? (t & 63) : (t >> 6);
#pragma unroll
                        for (int n = 0; n < 2; ++n) {
                            const float* cp = rope + (size_t)(pos * 16 + 8 * (fq & 1) + 4 * n) * 2;
                            const f32x4 c01 = *(const f32x4*)cp, c23 = *(const f32x4*)(cp + 4);
                            const float cs[4] = {c01[0], c01[2], c23[0], c23[2]}, sn[4] = {c01[1], c01[3], c23[1], c23[3]};
#pragma unroll
                            for (int j = 0; j < 4; ++j) { const float x = v[bj][n][j], pr = __shfl_xor(x, 32); v[bj][n][j] = first ? x * cs[j] - pr * sn[j] : x * cs[j] + pr * sn[j]; }
                        }
                    }
                }
                bf16_t* rowp = O + (size_t)row * ldc + hs * 64 + 8 * fq;
#pragma unroll
                for (int bj = 0; bj < 2; ++bj) { const f32x4 v0 = v[bj][0] * osc, v1 = v[bj][1] * osc;
                    u32x4 w; w.x = cvt_pk_bf16(v0[0], v0[1]); w.y = cvt_pk_bf16(v0[2], v0[3]); w.z = cvt_pk_bf16(v1[0], v1[1]); w.w = cvt_pk_bf16(v1[2], v1[3]);
                    *(u32x4*)(rowp + 32 * bj) = w; }
            }
    }
};
struct GroupedOrder {
    int nMe, nN, ntot, G, c;
    __device__ void init(int nMe_, int nN_, int ne, int G_, int c_) { nMe = nMe_; nN = nN_; ntot = nMe_ * nN_ * ne; G = G_; c = c_; }
    __device__ bool next(int i, Unit& u) const {
        const int L = i * G + c; if (L >= ntot) return false;
        const int per = nMe * nN, e = L / per, rem = L - e * per;
        u.e = e; u.pn = rem / nMe; u.pm = e * nMe + (rem - u.pn * nMe); return true;
    }
    __device__ __forceinline__ void a_ready(const Unit&) const {}
    __device__ __forceinline__ void done(const Unit&) const {}
};
struct L1InOrder {
    StaticOrder so; int G, c;
    __device__ void init(int G_, int c_) { so.init(16384, 2048, G_, 0); G = G_; c = c_; }
    __device__ bool next(int i, Unit& u) const {
        const int L = i * G + c;
        if (L < 512) { StaticOrder t = so; t.G = 1; t.c = 0; return t.next(L, u); }
        if (L < 544) { const int l = L - 512; u.pm = 64 + (l >> 2); u.pn = 2 + (l & 3); u.e = 0; return true; }
        return false;
    }
    __device__ __forceinline__ void a_ready(const Unit&) const {}
    __device__ __forceinline__ void done(const Unit&) const {}
};
}

#include <hip/hip_bf16.h>
#include <cmath>
namespace attn_body {
using bf16=__hip_bfloat16;
using bf16x8=__attribute__((ext_vector_type(8)))short;
using s16x4=__attribute__((ext_vector_type(4)))short;
using f32x16=__attribute__((ext_vector_type(16)))float;
using u32x4=__attribute__((ext_vector_type(4)))unsigned;
constexpr int D=64,OPITCH=1024;
constexpr int NW=8,QBLK=32,QB=QBLK*NW,KVBLK=64;
__device__ __forceinline__ int crow(int r,int hi){return (r&3)+8*(r>>2)+4*hi;}
#define SBAR() __builtin_amdgcn_sched_barrier(0)
__device__ __forceinline__ void cmask(f32x16&p0,f32x16&p1,int jb,int qrel,int hi){
  const float NEG=-INFINITY; int kb=64*jb+4*hi;
  #pragma unroll
  for(int r=0;r<16;++r){int kv=kb+(r&3)+8*(r>>2); if(kv>qrel)p0[r]=NEG; if(kv+32>qrel)p1[r]=NEG;}
}

constexpr int NSLOT=3, SLOTB=8192;
constexpr int LDS_K=0, LDS_V=NSLOT*SLOTB, LDS_WS=2*NSLOT*SLOTB, LDS_OST=LDS_WS+NW*64*4, LDS_BYTES=LDS_OST+NW*4096;
constexpr float C2=0.125f*1.4426950408889634f;
__device__ __forceinline__ void glds16(const void*gsrc,unsigned lds_dst){unsigned keep;
  asm volatile("s_mov_b32 %0, m0\n\ts_mov_b32 m0, %2\n\ts_nop 0\n\tglobal_load_lds_dwordx4 %1, off\n\ts_mov_b32 m0, %0":"=&s"(keep):"v"(gsrc),"s"(lds_dst):"memory");}
__device__ __forceinline__ float max3f(float a,float b,float c){float r;asm("v_max3_f32 %0, %1, %2, %3":"=v"(r):"v"(a),"v"(b),"v"(c));return r;}
__device__ __forceinline__ float max2f(float a,float b){float r;asm("v_max_f32_e32 %0, %1, %2":"=v"(r):"v"(a),"v"(b));return r;}
__device__ __forceinline__ float fadd_s(float a,float b){float r;asm("v_add_f32_e32 %0, %1, %2":"=v"(r):"v"(a),"v"(b));return r;}
__device__ __forceinline__ float fsub_s(float a,float b){float r;asm("v_sub_f32_e32 %0, %1, %2":"=v"(r):"v"(a),"v"(b));return r;}
typedef float f32x2_t __attribute__((ext_vector_type(2))); typedef __bf16 bf16x2_t __attribute__((ext_vector_type(2)));
__device__ __forceinline__ unsigned cvtpk_s(float lo,float hi){f32x2_t v={lo,hi};bf16x2_t b=__builtin_convertvector(v,bf16x2_t);return __builtin_bit_cast(unsigned,b);}
#define WAIT_BAR(N) asm volatile("s_waitcnt vmcnt(" #N ") lgkmcnt(0)\n\ts_barrier":::"memory")

__device__ __forceinline__ void qkt(f32x16&p0,f32x16&p1,const char*Kslot,const bf16x8*qr,const f32x16&negm,int r32,int hi){
  const char*kb=Kslot+hi*1024+r32*16;
  #pragma unroll
  for(int d0=0;d0<4;++d0){
    const bf16x8 b0=*reinterpret_cast<const bf16x8*>(kb+d0*2048);
    const bf16x8 b1=*reinterpret_cast<const bf16x8*>(kb+d0*2048+512);
    if(d0==0){p0=__builtin_amdgcn_mfma_f32_32x32x16_bf16(b0,qr[0],negm,0,0,0);p1=__builtin_amdgcn_mfma_f32_32x32x16_bf16(b1,qr[0],negm,0,0,0);}
    else{p0=__builtin_amdgcn_mfma_f32_32x32x16_bf16(b0,qr[d0],p0,0,0,0);p1=__builtin_amdgcn_mfma_f32_32x32x16_bf16(b1,qr[d0],p1,0,0,0);}}
}
typedef __attribute__((address_space(3))) const char* lds_cptr;
typedef short v4i16_t __attribute__((ext_vector_type(4)));
__device__ __forceinline__ void kload8(bf16x8*kf,lds_cptr kp){
  kf[0]=*(const __attribute__((address_space(3))) bf16x8*)(kp);      kf[1]=*(const __attribute__((address_space(3))) bf16x8*)(kp+512);
  kf[2]=*(const __attribute__((address_space(3))) bf16x8*)(kp+2048); kf[3]=*(const __attribute__((address_space(3))) bf16x8*)(kp+2560);
  kf[4]=*(const __attribute__((address_space(3))) bf16x8*)(kp+4096); kf[5]=*(const __attribute__((address_space(3))) bf16x8*)(kp+4608);
  kf[6]=*(const __attribute__((address_space(3))) bf16x8*)(kp+6144); kf[7]=*(const __attribute__((address_space(3))) bf16x8*)(kp+6656);
}
__device__ __forceinline__ void kload2(bf16x8*kf,lds_cptr kp,int j){ kf[2*j]=*(const __attribute__((address_space(3))) bf16x8*)(kp+j*2048); kf[2*j+1]=*(const __attribute__((address_space(3))) bf16x8*)(kp+j*2048+512); }
__device__ __forceinline__ s16x4 vtr(lds_cptr p){ return __builtin_bit_cast(s16x4,__builtin_amdgcn_ds_read_tr16_b64_v4i16((__attribute__((address_space(3))) v4i16_t*)p)); }
__device__ __forceinline__ float rowmax(const f32x16&p0,const f32x16&p1){
  float a=max3f(p0[0],p0[1],p1[0]),b=max3f(p0[2],p0[3],p1[1]);a=max3f(a,p1[2],p1[3]);
  #pragma unroll
  for(int r=4;r<16;r+=4){a=max3f(a,p0[r],p0[r+1]);b=max3f(b,p0[r+2],p0[r+3]);a=max3f(a,p1[r],p1[r+1]);b=max3f(b,p1[r+2],p1[r+3]);}
  const float m=max2f(a,b);
  auto rr=__builtin_amdgcn_permlane32_swap(__float_as_uint(m),__float_as_uint(m),false,false);
  return max2f(__uint_as_float(rr[0]),__uint_as_float(rr[1]));
}
__device__ __forceinline__ void pv(f32x16*o,int vb,bf16x8 pa0,bf16x8 pa1,bf16x8 pa2,bf16x8 pa3){
  #pragma unroll
  for(int d0=0;d0<2;++d0){s16x4 lo[4],hi[4];
    #pragma unroll
    for(int ks=0;ks<4;++ks){
      asm volatile("ds_read_b64_tr_b16 %0,%1 offset:%c2":"=&v"(lo[ks]):"v"(vb),"i"(d0*4096+ks*1024):"memory");
      asm volatile("ds_read_b64_tr_b16 %0,%1 offset:%c2":"=&v"(hi[ks]):"v"(vb),"i"(d0*4096+ks*1024+512):"memory");}
    asm volatile("s_waitcnt lgkmcnt(0)":::"memory");SBAR();
    #define PK(k) (bf16x8){lo[k][0],lo[k][1],lo[k][2],lo[k][3],hi[k][0],hi[k][1],hi[k][2],hi[k][3]}
    o[d0]=__builtin_amdgcn_mfma_f32_32x32x16_bf16(pa0,PK(0),o[d0],0,0,0);
    o[d0]=__builtin_amdgcn_mfma_f32_32x32x16_bf16(pa1,PK(1),o[d0],0,0,0);
    o[d0]=__builtin_amdgcn_mfma_f32_32x32x16_bf16(pa2,PK(2),o[d0],0,0,0);
    o[d0]=__builtin_amdgcn_mfma_f32_32x32x16_bf16(pa3,PK(3),o[d0],0,0,0);
    #undef PK
  }
}

#ifndef ATTN_STORE16
#define ATTN_STORE16(p,v) (*(u32x4*)(p)=(v))
#endif
struct AU { const bf16* Qp; const bf16* Kp; const bf16* Vp; bf16* Op; int qrow0, lat_row0, ctx_row0, nlat_t, NT; };
struct NoMask { __device__ __forceinline__ void apply(f32x16&,f32x16&,int,int)const{} };
typedef __attribute__((address_space(3))) const float* lds_cfptr;
struct NAMask { lds_cfptr tb0; int r, rs, rs_min, cb;
  __device__ __forceinline__ void apply(f32x16&p0,f32x16&p1,int t,int hi)const{
    if(t<4)return;
    const int kr=rs_min+t-4; const float NEG=-INFINITY;
    if((unsigned)(kr-rs)>7u){
      #pragma unroll
      for(int i=0;i<16;++i){p0[i]=NEG;p1[i]=NEG;}
      return; }
    const lds_cfptr tb=tb0+(kr-r+7)*32+4*hi;
    #pragma unroll
    for(int i=0;i<16;++i){ const int k0=(i&3)+8*(i>>2); const int d0=cb+k0, d1=cb+k0+32;
      const float b0=tb[k0], b1=tb[k0+32];
      p0[i]=((unsigned)d0<=15u)?p0[i]+b0:NEG; p1[i]=((unsigned)d1<=15u)?p1[i]+b1:NEG; }
  }
};
template<int THRL,int PITCH,class MaskT> __device__ __forceinline__ void attn_unit(const AU& u,char*shm,const MaskT& mk){
  const int tid=threadIdx.x,lane=tid&63,r32=lane&31,hi=lane>>5; const int wid=__builtin_amdgcn_readfirstlane(tid>>6);
  const bf16*Qw=u.Qp+(long)(u.qrow0+wid*QBLK)*PITCH;
  const bf16*Kh=u.Kp,*Vh=u.Vp;
  const unsigned lds0=(unsigned)(uintptr_t)shm;
  float*wsf=(float*)(shm+LDS_WS)+wid*64;
  const bf16*ksrc=Kh+(long)lane*PITCH+wid*8;
  const bf16*vsrc=Vh+(long)(16*(wid&3)+(lane>>2))*PITCH+(wid>>2)*32+(lane&3)*8;
  const unsigned kdst=lds0+LDS_K+wid*1024, vdst=lds0+LDS_V+wid*1024;
  #define TROW(t) ((long)((t)<u.nlat_t?u.lat_row0+KVBLK*(t):u.ctx_row0+KVBLK*((t)-u.nlat_t))*PITCH)
  #define DMA_K(t,slot) glds16(ksrc+TROW(t),(unsigned)__builtin_amdgcn_readfirstlane(kdst+(slot)))
  #define DMA_V(t,slot) glds16(vsrc+TROW(t),(unsigned)__builtin_amdgcn_readfirstlane(vdst+(slot)))
  const int vb0=(int)(lds0+LDS_V)+((lane>>4)&1)*32+(lane&3)*8+(4*hi+((lane&15)>>2))*64;
  const char*Kbase=shm+LDS_K; bf16x8 kf[8];
  const lds_cptr shm3=(lds_cptr)shm; const lds_cptr kp0=shm3+LDS_K+hi*1024+r32*16; const lds_cptr vp0=shm3+LDS_V+((lane>>4)&1)*32+(lane&3)*8+(4*hi+((lane&15)>>2))*64;
  const int NT=u.NT;
  DMA_K(0,0);DMA_V(0,0);DMA_K(1,SLOTB);
  bf16x8 qr[4];
  #pragma unroll
  for(int d0=0;d0<4;++d0)qr[d0]=*reinterpret_cast<const bf16x8*>(&Qw[(long)r32*PITCH+d0*16+hi*8]);
  float mhat=0.f,l_reg=0.f;f32x16 o[2];o[0]=f32x16{};o[1]=f32x16{};f32x16 negm=f32x16{};asm volatile("":"+v"(negm));
  #define CMASK(P0,P1,t) mk.apply(P0,P1,(t),hi)
  bool resc=false;
  #define START(P0,P1) do{ const float rm=rowmax(P0,P1); resc=false; \
    { const float dl=rm; mhat=fadd_s(mhat,dl); \
      _Pragma("unroll") for(int r=0;r<16;++r){P0[r]=fsub_s(P0[r],dl);P1[r]=fsub_s(P1[r],dl);} \
      _Pragma("unroll") for(int r=0;r<16;++r)negm[r]=-mhat; asm volatile("":"+v"(negm)); } \
    _Pragma("unroll") for(int r=0;r<16;++r)P0[r]=__builtin_amdgcn_exp2f(P0[r]); }while(0)
  #define RESC() do{ if(resc){ asm volatile("s_waitcnt lgkmcnt(0)":::"memory"); \
      _Pragma("unroll") for(int d_=0;d_<2;++d_) _Pragma("unroll") for(int r=0;r<16;++r)o[d_][r]*=wsf[crow(r,hi)]; } }while(0)
  f32x16 pA0,pA1,pB0,pB1;
  int sl_prev=0,sl_cur=0,sl_next=SLOTB;
  #define ROT() do{sl_prev=sl_cur;sl_cur=sl_next;sl_next=(sl_next==(NSLOT-1)*SLOTB)?0:sl_next+SLOTB;}while(0)
  DMA_K(2,2*SLOTB);
  WAIT_BAR(3);
  qkt(pA0,pA1,Kbase,qr,negm,r32,hi);asm volatile("s_nop 15\n\ts_nop 7":"+v"(pA0),"+v"(pA1));CMASK(pA0,pA1,0);
  START(pA0,pA1);
  _Pragma("unroll") for(int r=0;r<16;++r)pA1[r]=__builtin_amdgcn_exp2f(pA1[r]);
  WAIT_BAR(0);
  DMA_K(3,0);DMA_V(1,SLOTB);
  ROT();
  kload8(kf,kp0+sl_cur);
  WAIT_BAR(2);
  s16x4 vlo[8],vhi[8]; u32x4 pw0,pw1,pw2,pw3;
  #define PKW(P,B) cvtpk_s(P[B],P[B+1])
  #define PAF(k) __builtin_bit_cast(bf16x8,pw##k)
  #define VFR(i) (bf16x8){vlo[i][0],vlo[i][1],vlo[i][2],vlo[i][3],vhi[i][0],vhi[i][1],vhi[i][2],vhi[i][3]}
  #define PIN(x) asm volatile("":"+v"(x))
  #define MX3(a,b,c) __builtin_fmaxf(__builtin_fmaxf((a),(b)),(c))
  #define GAPA(MF,A0,A1,A2,A3,W0,W1,PW) do{ MF; sacc+=A0; sacc+=A1; sacc+=A2; sacc+=A3; PIN(sacc); W0; W1; PIN(PW); SBAR(); }while(0)
  #define EX(v) __builtin_amdgcn_exp2f(v)
  #define GAPB(MF,X,B) do{ MF; X[B]=EX(X[B]); X[B+1]=EX(X[B+1]); X[B+2]=EX(X[B+2]); X[B+3]=EX(X[B+3]); PIN(X); SBAR(); }while(0)
  #define VRD(i) do{ vlo[i]=vtr(vp_+(((i)>>2)*4096+((i)&3)*1024)); vhi[i]=vtr(vp_+(((i)>>2)*4096+((i)&3)*1024+512)); }while(0)
  #define KRD(G,j) do{ if(G){ kload2(kf,kp0+sl_next,j); SBAR(); } }while(0)
  #define STEP(C0,C1,P0,P1,t,GK,GV,GL) do{ SBAR(); \
    const lds_cptr vp_=vp0+sl_prev; \
    VRD(0); SBAR(); float sacc=(P0[0]+P0[1]); \
    GAPA(C0=__builtin_amdgcn_mfma_f32_32x32x16_bf16(kf[0],qr[0],negm,0,0,0), P0[2],P0[3],P0[4],P0[5],     pw0[0]=PKW(P0,0), pw0[1]=PKW(P0,2), pw0); \
    VRD(4); SBAR(); GAPA(C1=__builtin_amdgcn_mfma_f32_32x32x16_bf16(kf[1],qr[0],negm,0,0,0), P0[6],P0[7],P0[8],P0[9],     pw0[2]=PKW(P0,4), pw0[3]=PKW(P0,6), pw0); \
    VRD(1); SBAR(); GAPA(C0=__builtin_amdgcn_mfma_f32_32x32x16_bf16(kf[2],qr[1],C0,0,0,0),   P0[10],P0[11],P0[12],P0[13], pw1[0]=PKW(P0,8), pw1[1]=PKW(P0,10), pw1); \
    VRD(5); SBAR(); GAPA(C1=__builtin_amdgcn_mfma_f32_32x32x16_bf16(kf[3],qr[1],C1,0,0,0),   P0[14],P0[15],P1[0],P1[1],   pw1[2]=PKW(P0,12),pw1[3]=PKW(P0,14), pw1); \
    VRD(2); SBAR(); GAPA(C0=__builtin_amdgcn_mfma_f32_32x32x16_bf16(kf[4],qr[2],C0,0,0,0),   P1[2],P1[3],P1[4],P1[5],     pw2[0]=PKW(P1,0), pw2[1]=PKW(P1,2), pw2); \
    VRD(6); SBAR(); GAPA(C1=__builtin_amdgcn_mfma_f32_32x32x16_bf16(kf[5],qr[2],C1,0,0,0),   P1[6],P1[7],P1[8],P1[9],     pw2[2]=PKW(P1,4), pw2[3]=PKW(P1,6), pw2); \
    VRD(3); SBAR(); GAPA(C0=__builtin_amdgcn_mfma_f32_32x32x16_bf16(kf[6],qr[3],C0,0,0,0),   P1[10],P1[11],P1[12],P1[13], pw3[0]=PKW(P1,8), pw3[1]=PKW(P1,10), pw3); \
    VRD(7); SBAR(); GAPA(C1=__builtin_amdgcn_mfma_f32_32x32x16_bf16(kf[7],qr[3],C1,0,0,0),   P1[14],P1[15],0.f,0.f,       pw3[2]=PKW(P1,12),pw3[3]=PKW(P1,14), pw3); \
    l_reg+=sacc; \
    if(GK){DMA_K((t)+3,sl_cur);} if(GV){DMA_V((t)+1,sl_next);} \
    CMASK(C0,C1,t); \
    { float a=MX3(C0[0],C0[1],C1[0]),b=MX3(C0[2],C0[3],C1[1]); a=MX3(a,C1[2],C1[3]); \
      _Pragma("unroll") for(int r=4;r<16;r+=4){a=MX3(a,C0[r],C0[r+1]);b=MX3(b,C0[r+2],C0[r+3]);a=MX3(a,C1[r],C1[r+1]);b=MX3(b,C1[r+2],C1[r+3]);} \
      float rm=__builtin_fmaxf(a,b); { auto rr=__builtin_amdgcn_permlane32_swap(__float_as_uint(rm),__float_as_uint(rm),false,false); rm=__builtin_fmaxf(__uint_as_float(rr[0]),__uint_as_float(rr[1])); } \
      resc=false; \
      if(__builtin_expect(__any(rm>(float)THRL),0)){ const float dl=__builtin_fmaxf(rm,0.f); mhat+=dl; \
        _Pragma("unroll") for(int r=0;r<16;++r){C0[r]-=dl;C1[r]-=dl;} \
        _Pragma("unroll") for(int r=0;r<16;++r)negm[r]=-mhat; asm volatile("":"+v"(negm)); \
        const float f=__builtin_amdgcn_exp2f(-dl); l_reg*=f; if(hi==0)wsf[r32]=f; resc=true; } } \
    SBAR(); \
    GAPB(o[0]=__builtin_amdgcn_mfma_f32_32x32x16_bf16(PAF(0),VFR(0),o[0],0,0,0), C0,0); \
    GAPB(o[1]=__builtin_amdgcn_mfma_f32_32x32x16_bf16(PAF(0),VFR(4),o[1],0,0,0), C0,4); \
    KRD(GL,0); GAPB(o[0]=__builtin_amdgcn_mfma_f32_32x32x16_bf16(PAF(1),VFR(1),o[0],0,0,0), C0,8); \
    KRD(GL,1); GAPB(o[1]=__builtin_amdgcn_mfma_f32_32x32x16_bf16(PAF(1),VFR(5),o[1],0,0,0), C0,12); \
    KRD(GL,2); GAPB(o[0]=__builtin_amdgcn_mfma_f32_32x32x16_bf16(PAF(2),VFR(2),o[0],0,0,0), C1,0); \
    KRD(GL,3); GAPB(o[1]=__builtin_amdgcn_mfma_f32_32x32x16_bf16(PAF(2),VFR(6),o[1],0,0,0), C1,4); \
    GAPB(o[0]=__builtin_amdgcn_mfma_f32_32x32x16_bf16(PAF(3),VFR(3),o[0],0,0,0), C1,8); \
    GAPB(o[1]=__builtin_amdgcn_mfma_f32_32x32x16_bf16(PAF(3),VFR(7),o[1],0,0,0), C1,12); \
    }while(0)
  int t=1;
  #undef CMASK
  #define CMASK(P0,P1,t) mk.apply(P0,P1,(t),hi)
  for(;t+5<NT;t+=2){
    STEP(pB0,pB1,pA0,pA1,t,true,true,true);     WAIT_BAR(2); RESC(); ROT();
    STEP(pA0,pA1,pB0,pB1,t+1,true,true,true);   WAIT_BAR(2); RESC(); ROT();
  }
  #undef CMASK
  #define CMASK(P0,P1,t) mk.apply(P0,P1,(t),hi)
  #define ENDW(tt) do{ if((tt)+3<NT){WAIT_BAR(2);} else if((tt)+2<NT){WAIT_BAR(1);} else {WAIT_BAR(0);} }while(0)
  for(;t+1<NT;t+=2){
    STEP(pB0,pB1,pA0,pA1,t,(t+3<NT),(t+1<NT),(t+1<NT));       ENDW(t);   RESC(); ROT();
    STEP(pA0,pA1,pB0,pB1,t+1,(t+4<NT),(t+2<NT),(t+2<NT));     ENDW(t+1); RESC(); ROT();
  }
  STEP(pB0,pB1,pA0,pA1,NT-1,false,false,false); RESC();
  { float sacc=pB0[0]+pB0[1]; _Pragma("unroll") for(int r=2;r<16;++r)sacc+=pB0[r]; _Pragma("unroll") for(int r=0;r<16;++r)sacc+=pB1[r]; l_reg+=sacc;
    pw0=(u32x4){PKW(pB0,0),PKW(pB0,2),PKW(pB0,4),PKW(pB0,6)};pw1=(u32x4){PKW(pB0,8),PKW(pB0,10),PKW(pB0,12),PKW(pB0,14)};pw2=(u32x4){PKW(pB1,0),PKW(pB1,2),PKW(pB1,4),PKW(pB1,6)};pw3=(u32x4){PKW(pB1,8),PKW(pB1,10),PKW(pB1,12),PKW(pB1,14)};
    SBAR(); pv(o,vb0+sl_cur,PAF(0),PAF(1),PAF(2),PAF(3)); }
  #undef PKW
  #undef PAF
  #undef VFR
  #undef PIN
  #undef MX3
  #undef GAPA
  #undef GAPB
  #undef EX
  #undef VRD
  #undef KRD
  #undef STEP
  #undef ENDW
  {auto rr=__builtin_amdgcn_permlane32_swap(__float_as_uint(l_reg),__float_as_uint(l_reg),false,false);l_reg=__uint_as_float(rr[0])+__uint_as_float(rr[1]);}
  if(hi==0)wsf[32+r32]=l_reg;asm volatile("s_waitcnt lgkmcnt(0)":::"memory");
  float rli[16];
  #pragma unroll
  for(int r=0;r<16;++r)rli[r]=__builtin_amdgcn_rcpf(wsf[32+crow(r,hi)]);
  bf16*Ow=u.Op+(long)(u.qrow0+wid*QBLK)*OPITCH;
  { bf16*stg=(bf16*)(shm+LDS_OST)+wid*2048;
    #pragma unroll
    for(int r=0;r<16;++r){const int orow=crow(r,hi);
      #pragma unroll
      for(int d0=0;d0<2;++d0)stg[orow*64+d0*32+r32]=__float2bfloat16(o[d0][r]*rli[r]);}
    asm volatile("s_waitcnt lgkmcnt(0)":::"memory");
    #pragma unroll
    for(int i=0;i<4;++i){const int row=i*8+(lane>>3),ch=lane&7; const u32x4 v=*(const u32x4*)(stg+row*64+ch*8); ATTN_STORE16(Ow+(long)row*OPITCH+ch*8,v);} }
  asm volatile("s_waitcnt lgkmcnt(0)\n\ts_barrier":::"memory");
  #undef DMA_K
  #undef TROW
  #undef DMA_V
  #undef CMASK
  #undef START
  #undef RESC
  #undef ROT
}
constexpr int ATTN_LDS_BYTES=LDS_BYTES;
#undef SBAR
#undef WAIT_BAR
}

struct Params { const float* in[26]; float* out; unsigned char* ws; int ph_lo, ph_hi; };
struct Ctx { LAS unsigned char* lds; int tid, lane, wave, vcu, G, gw, NGW; };
enum { I_X = 0, I_C, I_CTX, I_CCTX, I_ADAW, I_ADAB, I_LNG, I_LNB, I_W0IN, I_W0OUT, I_LQ1, I_LK1, I_LQ2, I_LK2, I_SUBLN, I_QN, I_KN,
       I_W1IN, I_W1OUT, I_RPB, I_POOLW, I_POOLS, I_ROUTER, I_WG, I_WU, I_WD };

__device__ __forceinline__ const float* mod_row(const Params& p, int layer, int row) {
    return (const float*)(p.ws + WS_MOD) + (size_t)(layer * 9 + (row < LAT ? (row >> 11) : 8)) * 6144;
}

__device__ __forceinline__ void ph_prologue(const Params& p, const Ctx& c) {
    const float* cin = p.in[I_C]; const float* cctx = p.in[I_CCTX]; const float* ada_w = p.in[I_ADAW]; const float* ada_b = p.in[I_ADAB];
    float* MOD = (float*)(p.ws + WS_MOD);
    LAS float* sc = (LAS float*)c.lds;
    LAS float* red = sc + 9 * 1024;
    for (int i = c.tid; i < 9 * 1024; i += 512) { const float v = i < 8192 ? cin[i] : cctx[i - 8192]; sc[i] = v / (1.f + expf(-v)); }
    __syncthreads();
    for (int u = c.vcu; u < 256; u += c.G) {
        const int layer = u >> 7, j0 = (u & 127) * 48;
        const int jc = c.tid % 48, kg = c.tid / 48;
        if (kg < 10) {
            float acc[9];
#pragma unroll
            for (int m = 0; m < 9; ++m) acc[m] = 0.f;
            const float* wp = ada_w + (size_t)layer * 1024 * 6144 + j0 + jc;
#pragma unroll 8
            for (int k = kg; k < 1024; k += 10) {
                const float w = wp[(size_t)k * 6144];
#pragma unroll
                for (int m = 0; m < 9; ++m) acc[m] += sc[m * 1024 + k] * w;
            }
#pragma unroll
            for (int m = 0; m < 9; ++m) red[(kg * 9 + m) * 48 + jc] = acc[m];
        }
        __syncthreads();
        if (c.tid < 432) {
            const int m = c.tid / 48, j = c.tid % 48; float s = 0.f;
#pragma unroll
            for (int g = 0; g < 10; ++g) s += red[(g * 9 + m) * 48 + j];
            MOD[(size_t)(layer * 9 + m) * 6144 + j0 + j] = s + ada_b[layer * 6144 + j0 + j];
        }
        __syncthreads();
    }
    if (c.vcu == 0) {
        f32x2* R = (f32x2*)(p.ws + WS_ROPE);
        for (int i = c.tid; i < 1024; i += 512) {
            const int pos = i >> 4, f = i & 15;
            const float inv = exp2f(-(float)f * (13.287712379549449f / 16.f));
            const float a = (float)pos * inv;
            const float k = rintf(a * 0.15915494309189535f);
            float rr = fmaf(-k, 6.28125f, a); rr = fmaf(-k, 1.9353071795864769e-3f, rr);
            R[i] = (f32x2){__cosf(rr), __sinf(rr)};
        }
    }
}


__device__ __forceinline__ void transpose_item(const float* W, int ldw, int k0, int n0, bf16* WT, int Kd, int drow0, LAS float* scr, int lane) {
#pragma unroll 8
    for (int i = 0; i < 32; ++i) { const int kk = 2 * i + (lane >> 5); scr[kk * 33 + (lane & 31)] = W[(size_t)(k0 + kk) * ldw + n0 + (lane & 31)]; }
    asm volatile("s_waitcnt lgkmcnt(0)" ::: "memory");
    const int ch = lane & 7;
#pragma unroll
    for (int j = 0; j < 4; ++j) { const int n = (lane >> 3) + 8 * j; const LAS float* sp = scr + (8 * ch) * 33 + n;
        v4u o; o.x = pk2(sp[0 * 33], sp[1 * 33]); o.y = pk2(sp[2 * 33], sp[3 * 33]); o.z = pk2(sp[4 * 33], sp[5 * 33]); o.w = pk2(sp[6 * 33], sp[7 * 33]);
        *(v4u*)(WT + (size_t)(drow0 + n) * Kd + k0 + 8 * ch) = o; }
    asm volatile("s_waitcnt lgkmcnt(0)" ::: "memory");
}
__device__ __forceinline__ void transpose_item8(const float* W, int ldw, int k0, int n0, unsigned char* WT8, int Kd, int drow0, float scale, LAS float* scr, int lane) {
#pragma unroll 8
    for (int i = 0; i < 32; ++i) { const int kk = 2 * i + (lane >> 5); scr[kk * 33 + (lane & 31)] = W[(size_t)(k0 + kk) * ldw + n0 + (lane & 31)]; }
    asm volatile("s_waitcnt lgkmcnt(0)" ::: "memory");
    const int n = lane >> 1, hf = lane & 1; const LAS float* sp = scr + (32 * hf) * 33 + n;
    v4u o0, o1;
    o0.x = pg8::pk4_fp8(sp[0 * 33] * scale, sp[1 * 33] * scale, sp[2 * 33] * scale, sp[3 * 33] * scale);     o0.y = pg8::pk4_fp8(sp[4 * 33] * scale, sp[5 * 33] * scale, sp[6 * 33] * scale, sp[7 * 33] * scale);
    o0.z = pg8::pk4_fp8(sp[8 * 33] * scale, sp[9 * 33] * scale, sp[10 * 33] * scale, sp[11 * 33] * scale);   o0.w = pg8::pk4_fp8(sp[12 * 33] * scale, sp[13 * 33] * scale, sp[14 * 33] * scale, sp[15 * 33] * scale);
    o1.x = pg8::pk4_fp8(sp[16 * 33] * scale, sp[17 * 33] * scale, sp[18 * 33] * scale, sp[19 * 33] * scale); o1.y = pg8::pk4_fp8(sp[20 * 33] * scale, sp[21 * 33] * scale, sp[22 * 33] * scale, sp[23 * 33] * scale);
    o1.z = pg8::pk4_fp8(sp[24 * 33] * scale, sp[25 * 33] * scale, sp[26 * 33] * scale, sp[27 * 33] * scale); o1.w = pg8::pk4_fp8(sp[28 * 33] * scale, sp[29 * 33] * scale, sp[30 * 33] * scale, sp[31 * 33] * scale);
    unsigned char* dst = WT8 + (size_t)(drow0 + n) * Kd + k0 + 32 * hf;
    *(v4u*)dst = o0; *(v4u*)(dst + 16) = o1;
    asm volatile("s_waitcnt lgkmcnt(0)" ::: "memory");
}
struct TBlk { const float* src; unsigned char* dst; int ldw, Kd, gu, which; float scale; };
__device__ __forceinline__ TBlk tblk_decode(const Params& p, int blk) {
    const int ie = blk / 96, q = blk - ie * 96, layer = ie >> 4, e = ie & 15, which = q >> 5, idx = q & 31;
    TBlk t; t.which = which;
    if (which < 2) { const int kb = idx & 3, nb = idx >> 2, k0 = 256 * kb, n0 = 256 * nb;
        t.src = (which == 0 ? p.in[I_WG] : p.in[I_WU]) + (size_t)ie * DM * FF + (size_t)k0 * FF + n0; t.ldw = FF; t.Kd = DM; t.scale = W8_GU; t.gu = 1;
        t.dst = p.ws + WS_WGU + (size_t)layer * WS_MOE_LSTRIDE + (size_t)e * 4096 * DM + (size_t)(2 * nb) * 256 * DM + k0; }
    else { const int kb = idx & 7, nb = idx >> 3, k0 = 256 * kb, n0 = 256 * nb;
        t.src = p.in[I_WD] + (size_t)ie * FF * DM + (size_t)k0 * DM + n0; t.ldw = DM; t.Kd = FF; t.scale = W8_DN; t.gu = 0;
        t.dst = p.ws + WS_WDN + (size_t)layer * WS_MOE_LSTRIDE + (size_t)e * DM * FF + (size_t)n0 * FF + k0; }
    return t;
}
__device__ __forceinline__ void tblk_load(const TBlk& t, f32x4 (&v)[16], int wave, int lane, int hf) {
    const float* sp = t.src + (size_t)(32 * wave + 16 * hf) * t.ldw + 4 * lane;
#pragma unroll
    for (int i = 0; i < 16; ++i) v[i] = *(const f32x4*)(sp + (size_t)i * t.ldw);
}
constexpr int TPITCH = 264;
__device__ __forceinline__ void tblk_pack(const TBlk& t, const f32x4 (&v)[16], LAS unsigned char* T, int wave, int lane, int hf) {
#pragma unroll
    for (int i = 0; i < 4; ++i) {
        const f32x4 r0 = v[4 * i] * t.scale, r1 = v[4 * i + 1] * t.scale, r2 = v[4 * i + 2] * t.scale, r3 = v[4 * i + 3] * t.scale;
#pragma unroll
        for (int j = 0; j < 4; ++j) { int w = 0; w = __builtin_amdgcn_cvt_pk_fp8_f32(r0[j], r1[j], w, false); w = __builtin_amdgcn_cvt_pk_fp8_f32(r2[j], r3[j], w, true);
            *(LAS unsigned*)(T + (64 * j + lane) * TPITCH + 32 * wave + 16 * hf + 4 * i) = (unsigned)w; }
    }
}
__device__ __forceinline__ void tblk_writeout(const TBlk& t, const LAS unsigned char* T, int tid) {
#pragma unroll
    for (int it = 0; it < 8; ++it) { const int idx = it * 512 + tid, n = idx >> 4, ch = idx & 15, rho = (n & 3) * 64 + (n >> 2);
        const LAS unsigned char* sp = T + rho * TPITCH + 16 * ch;
        const v2u a = *(const LAS v2u*)sp, b2 = *(const LAS v2u*)(sp + 8);
        const int drow = t.gu ? ((n >> 7) * 256 + (n & 127) + t.which * 128) : n;
        *(v4u*)(t.dst + (size_t)drow * t.Kd + 16 * ch) = (v4u){a.x, a.y, b2.x, b2.y}; }
}
__device__ __forceinline__ void ph_transposes(const Params& p, const Ctx& c) {
    LAS float* scr = (LAS float*)(c.lds + c.wave * 16384);
    constexpr int I0 = 16 * 72, I1 = 16 * 32, I2 = 16 * 64, I3 = 16 * 32, ISM = I0 + I1 + I2 + I3;
    for (int r0 = c.gw; r0 < ISM; r0 += c.NGW) {
        int r = r0;
        if (r < I0) { const int n0 = 32 * (r % 72), drow = FUSE_QKV ? ((n0 >> 8) * 256 + 128 * ((n0 >> 5) & 1) + 32 * ((n0 >> 6) & 3)) : n0;
            transpose_item(p.in[I_W0IN], EIN, 64 * (r / 72), n0, (bf16*)(p.ws + WS_W0IN), DM, drow, scr, c.lane); continue; } r -= I0;
        if (r < I1) { transpose_item(p.in[I_W0OUT], DM, 64 * (r / 32), 32 * (r % 32), (bf16*)(p.ws + WS_W0OUT), DM, 32 * (r % 32), scr, c.lane); continue; } r -= I1;
        if (r < I2) { transpose_item(p.in[I_W1IN], OIN, 64 * (r / 64), 32 * (r % 64), (bf16*)(p.ws + WS_W1IN), DM, 32 * (r % 64), scr, c.lane); continue; } r -= I2;
        transpose_item(p.in[I_W1OUT], DM, 64 * (r / 32), 32 * (r % 32), (bf16*)(p.ws + WS_W1OUT), DM, 32 * (r % 32), scr, c.lane);
    }
    static_assert(MOE_FP8, "the expert-weight transposes write e4m3 copies");
    __syncthreads();
    constexpr int NBLK = 32 * 96;
    LAS unsigned char* T = c.lds;
    f32x4 va[16], vb[16];
    int blk = c.vcu;
    TBlk t = tblk_decode(p, blk < NBLK ? blk : 0);
    if (blk < NBLK) tblk_load(t, va, c.wave, c.lane, 0);
#pragma unroll 1
    for (; blk < NBLK; blk += c.G) {
        tblk_load(t, vb, c.wave, c.lane, 1);
        tblk_pack(t, va, T, c.wave, c.lane, 0);
        const int nb = blk + c.G;
        TBlk tn = tblk_decode(p, nb < NBLK ? nb : 0);
        if (nb < NBLK) tblk_load(tn, va, c.wave, c.lane, 0);
        tblk_pack(t, vb, T, c.wave, c.lane, 1);
        __syncthreads();
        tblk_writeout(t, T, c.tid);
        __syncthreads();
        t = tn;
    }
}

__device__ __forceinline__ void ph_modulate0(const Params& p, const Ctx& c) {
    bf16* HB = (bf16*)(p.ws + WS_HB);
    for (int row = c.gw; row < NTOK; row += c.NGW) {
        const float* src = row < LAT ? p.in[I_X] + (size_t)row * DM : p.in[I_CTX] + (size_t)(row - LAT) * DM;
        const float* mod = mod_row(p, 0, row);
#pragma unroll
        for (int j = 0; j < 4; ++j) {
            const int col = 4 * c.lane + 256 * j;
            const f32x4 v = *(const f32x4*)(src + col), sh = *(const f32x4*)(mod + col), s = *(const f32x4*)(mod + 1024 + col);
            const f32x4 h = v * (s + 1.f) + sh;
            *(v2u*)(HB + (size_t)row * DM + col) = (v2u){pk2(h.x, h.y), pk2(h.z, h.w)};
        }
    }
}

struct NG { const bf16* A; int lda; const float* W0; const float* W1; int ldw; size_t wstride; int Mb; int row_begin, row_end, col_begin, col_end, K; };
template <int NB, class Epi>
__device__ __forceinline__ void ngemm(const NG& g, const Ctx& c, const Epi& epi) {
    const int nmt = (g.row_end - g.row_begin) / 32, nnt = (g.col_end - g.col_begin) / 32;
    const int l31 = c.lane & 31, lh = c.lane >> 5;
    for (int t = c.gw; t < nmt * nnt; t += c.NGW) {
        const int mt = t / nnt, nt = t % nnt;
        const int row0 = g.row_begin + mt * 32, col0 = g.col_begin + nt * 32;
        const int e = row0 / g.Mb;
        const bf16* ap = g.A + (size_t)(row0 + l31) * g.lda + lh;
        const float* bp0 = g.W0 + (size_t)e * g.wstride + (size_t)lh * g.ldw + col0 + l31;
        const float* bp1 = NB == 2 ? g.W1 + (size_t)e * g.wstride + (size_t)lh * g.ldw + col0 + l31 : nullptr;
        f32x16 acc0 = {}, acc1 = {};
#pragma unroll 8
        for (int k = 0; k < g.K; k += 2) {
            const float a = bf2f((unsigned)ap[k]);
            const float b0 = bp0[(size_t)k * g.ldw];
            acc0 = __builtin_amdgcn_mfma_f32_32x32x2f32(a, b0, acc0, 0, 0, 0);
            if (NB == 2) { const float b1 = bp1[(size_t)k * g.ldw]; acc1 = __builtin_amdgcn_mfma_f32_32x32x2f32(a, b1, acc1, 0, 0, 0); }
        }
#pragma unroll
        for (int r = 0; r < 16; ++r) {
            const int row = row0 + (r & 3) + 8 * (r >> 2) + 4 * lh, col = col0 + l31;
            epi(row, col, acc0[r], acc1[r]);
        }
    }
}
struct EpiF32 { float* O; int ldc; __device__ __forceinline__ void operator()(int row, int col, float v0, float) const { O[(size_t)row * ldc + col] = v0; } };
struct EpiBf { bf16* O; int ldc; int scale_cols; float sc; __device__ __forceinline__ void operator()(int row, int col, float v0, float) const { O[(size_t)row * ldc + col] = (bf16)f2bf(col < scale_cols ? v0 * sc : v0); } };
struct EpiSwiglu { bf16* O; __device__ __forceinline__ void operator()(int row, int col, float g, float u) const { const float s = g / (1.f + __expf(-g)); O[(size_t)row * FF + col] = (bf16)f2bf(s * u); } };
struct EpiGate { bf16* O; const float* gate; __device__ __forceinline__ void operator()(int row, int col, float v0, float) const { O[(size_t)row * DM + col] = (bf16)f2bf(v0 * gate[row]); } };

template <bool F32IN> __device__ __forceinline__ void ph_qkv_post(const Params& p, const Ctx& c) {
    const float* PF = (const float*)(p.ws + WS_PF);
    bf16* QKV = (bf16*)(p.ws + WS_QKV);
    const f32x2* R = (const f32x2*)(p.ws + WS_ROPE);
    const float* qn = p.in[I_QN]; const float* kn = p.in[I_KN];
    const int d = c.lane;
    const float qg = qn[d], kg = kn[d];
    for (int row = c.gw; row < NTOK; row += c.NGW) {
        const bool lat = row < LAT;
        const int t = row & 2047;
        const int pos = (d < 32) ? (t >> 6) : (t & 63);
        const f32x2 cs = R[pos * 16 + (d & 15)];
        const bool first = (d & 16) == 0;
        float vv[36];
#pragma unroll
        for (int hs = 0; hs < 36; ++hs) vv[hs] = F32IN ? PF[(size_t)row * EIN + hs * 64 + d] : bf2f((unsigned)QKV[(size_t)row * EIN + hs * 64 + d]);
#pragma unroll
        for (int hs = 0; hs < 36; ++hs) {
            float v = vv[hs];
            const bool isq = hs < 8 || (hs >= 24 && hs < 32);
            const bool isk = (hs >= 8 && hs < 16) || hs == 32 || hs == 33;
            const bool nrm = hs >= 24 && hs < 34;
            if (nrm) { const float ss = wave_sum(v * v); v = v * rsqrtf(ss * (1.f / 64.f) + RMS_EPS) * (hs < 32 ? qg : kg); }
            if ((isq || isk) && lat) { const float pr = __shfl_xor(v, 16); v = first ? v * cs.x - pr * cs.y : v * cs.x + pr * cs.y; }
            if (isq) v *= C2;
            QKV[(size_t)row * EIN + hs * 64 + d] = (bf16)f2bf(v);
        }
    }
}

__device__ __forceinline__ void ph_attn0_naive(const Params& p, const Ctx& c) {
    const bf16* QKV = (const bf16*)(p.ws + WS_QKV);
    bf16* CC = (bf16*)(p.ws + WS_CC);
    bf16* AO = (bf16*)(p.ws + WS_AO);
    LAS float* Ks = (LAS float*)c.lds;
    LAS float* Vs = Ks + 4096;
    for (int u = c.vcu; u < 960; u += c.G) {
        const bool isctx = u >= 768;
        int b, vh, qrow, ntiles; bool active = true;
        if (!isctx) { b = u / 96; const int r = u % 96; vh = r >> 2; qrow = b * SEQ + (r & 3) * 512 + c.tid; ntiles = 36; }
        else { const int uu = u - 768; b = uu / 24; vh = uu % 24; qrow = LAT + b * NCTX + (c.tid & 255); active = c.tid < 256; ntiles = 4; }
        int qcol, kcol, vcol;
        if (vh < 16) { const int a = vh >> 2, s = (vh >> 1) & 1, half = vh & 1; qcol = a * 128 + s * 64; kcol = 512 + a * 128 + s * 64; vcol = 1024 + a * 128 + half * 64; }
        else { const int h = vh - 16; qcol = 1536 + h * 64; kcol = 2048 + (h >> 2) * 64; vcol = 2176 + (h >> 2) * 64; }
        float q[64], o[64];
#pragma unroll
        for (int i = 0; i < 8; ++i) { const v4u w = *(const v4u*)(QKV + (size_t)qrow * EIN + qcol + 8 * i); unpack8(w, q + 8 * i); }
#pragma unroll
        for (int i = 0; i < 64; ++i) o[i] = 0.f;
        float m = -1e30f, l = 0.f;
        for (int t = 0; t < ntiles; ++t) {
            const int krow0 = isctx ? LAT + b * NCTX + 64 * t : (t < 32 ? b * SEQ + 64 * t : LAT + b * NCTX + 64 * (t - 32));
            __syncthreads();
            { const int r = c.tid >> 3, ch = c.tid & 7; float f[8];
              const v4u kw = *(const v4u*)(QKV + (size_t)(krow0 + r) * EIN + kcol + ch * 8); unpack8(kw, f);
#pragma unroll
              for (int j = 0; j < 8; ++j) Ks[r * 64 + ch * 8 + j] = f[j];
              const v4u vw = *(const v4u*)(QKV + (size_t)(krow0 + r) * EIN + vcol + ch * 8); unpack8(vw, f);
#pragma unroll
              for (int j = 0; j < 8; ++j) Vs[r * 64 + ch * 8 + j] = f[j]; }
            __syncthreads();
            if (active) {
                for (int kk = 0; kk < 64; ++kk) {
                    float s = 0.f;
#pragma unroll
                    for (int dd = 0; dd < 64; ++dd) s += q[dd] * Ks[kk * 64 + dd];
                    const float mn = fmaxf(m, s), al = exp2f(m - mn), pp = exp2f(s - mn);
                    l = l * al + pp; m = mn;
#pragma unroll
                    for (int dd = 0; dd < 64; ++dd) o[dd] = o[dd] * al + pp * Vs[kk * 64 + dd];
                }
            }
        }
        if (active) {
            const float rl = 1.f / l;
            bf16* dst = vh < 16 ? AO + (size_t)qrow * DM + (vh >> 2) * 256 + ((vh >> 1) & 1) * 128 + (vh & 1) * 64 : CC + (size_t)qrow * DM + 512 + (vh - 16) * 64;
            {
#pragma unroll
                for (int i = 0; i < 8; ++i) *(v4u*)(dst + 8 * i) = (v4u){pk2(o[8 * i] * rl, o[8 * i + 1] * rl), pk2(o[8 * i + 2] * rl, o[8 * i + 3] * rl), pk2(o[8 * i + 4] * rl, o[8 * i + 5] * rl), pk2(o[8 * i + 6] * rl, o[8 * i + 7] * rl)}; }
        }
    }
}


__device__ __forceinline__ void attn_combine_rows(const Params& p, const Ctx& c, int row0, int a, float lam, float g0, float g1) {
    const bf16* AO = (const bf16*)(p.ws + WS_AO); bf16* CC = (bf16*)(p.ws + WS_CC);
    asm volatile("s_waitcnt vmcnt(0)" ::: "memory");
#pragma unroll 1
    for (int rb = 0; rb < 32; rb += 8) {
        float x0[8], x1[8];
#pragma unroll
        for (int j = 0; j < 8; ++j) { const bf16* src = AO + (size_t)(row0 + rb + j) * DM + a * 256;
            x0[j] = bf2f((unsigned)src[c.lane]) - lam * bf2f((unsigned)src[128 + c.lane]); x1[j] = bf2f((unsigned)src[64 + c.lane]) - lam * bf2f((unsigned)src[192 + c.lane]); }
#pragma unroll
        for (int j = 0; j < 8; ++j) { const float ss = wave_sum(x0[j] * x0[j] + x1[j] * x1[j]); const float r = rsqrtf(ss * (1.f / 128.f) + RMS_EPS);
            bf16* dst = CC + (size_t)(row0 + rb + j) * DM + a * 128;
            dst[c.lane] = (bf16)f2bf(x0[j] * r * g0); dst[64 + c.lane] = (bf16)f2bf(x1[j] * r * g1); }
    }
}
__device__ __forceinline__ void ph_attn0_fast(const Params& p, const Ctx& c, char* lds_generic) {
    typedef attn_body::bf16 abf;
    const abf* Q = (const abf*)(p.ws + WS_QKV); abf* CCb = (abf*)(p.ws + WS_CC); abf* AOb = (abf*)(p.ws + WS_AO);
    const float d1 = wave_sum(p.in[I_LQ1][c.lane] * p.in[I_LK1][c.lane]), d2 = wave_sum(p.in[I_LQ2][c.lane] * p.in[I_LK2][c.lane]);
    const float lam = expf(d1) - expf(d2) + LAM_INIT;
    const float g0 = p.in[I_SUBLN][c.lane] * (1.f - LAM_INIT), g1 = p.in[I_SUBLN][c.lane + 64] * (1.f - LAM_INIT);
    for (int v = c.vcu; v < 256; v += c.G) {
#pragma unroll 1
        for (int step = 0; step < 10; ++step) {
            attn_body::AU u; int vh; bool ctxu = false;
            if (step < 4) { const int b = v >> 5, a = (v >> 3) & 3; vh = 4 * a + step; u.qrow0 = b * SEQ + (v & 7) * 256; u.lat_row0 = b * SEQ; u.ctx_row0 = LAT + b * NCTX; }
            else if (step < 6) { const int U = (step - 4) * 256 + v, b = U >> 6; vh = 16 + ((U >> 3) & 7); u.qrow0 = b * SEQ + (U & 7) * 256; u.lat_row0 = b * SEQ; u.ctx_row0 = LAT + b * NCTX; }
            else { ctxu = true; int b;
                if (v < 32) { b = v >> 2; vh = 4 * (v & 3) + (step - 6); }
                else if (v < 96 && step == 6) { b = (v - 32) >> 3; vh = 16 + ((v - 32) & 7); }
                else break;
                u.qrow0 = LAT + b * NCTX; u.lat_row0 = 0; u.ctx_row0 = LAT + b * NCTX; }
            if (!ctxu) { u.nlat_t = 32; u.NT = 36; } else { u.nlat_t = 0; u.NT = 4; }
            int qcol, kcol, vcol; abf* op;
            if (vh < 16) { const int a = vh >> 2, s = (vh >> 1) & 1, half = vh & 1; qcol = a * 128 + s * 64; kcol = 512 + a * 128 + s * 64; vcol = 1024 + a * 128 + half * 64; op = AOb + a * 256 + s * 128 + half * 64; }
            else { const int h = vh - 16; qcol = 1536 + h * 64; kcol = 2048 + (h >> 2) * 64; vcol = 2176 + (h >> 2) * 64; op = CCb + 512 + h * 64; }
            u.Qp = Q + qcol; u.Kp = Q + kcol; u.Vp = Q + vcol; u.Op = op;
            attn_body::attn_unit<8, EIN, attn_body::NoMask>(u, lds_generic, attn_body::NoMask{});
            if (vh < 16 && (vh & 3) == 3) attn_combine_rows(p, c, u.qrow0 + c.wave * 32, vh >> 2, lam, g0, g1);
        }
    }
}

__device__ __forceinline__ void ph_attn_combine(const Params& p, const Ctx& c) {
    const bf16* AO = (const bf16*)(p.ws + WS_AO);
    bf16* CC = (bf16*)(p.ws + WS_CC);
    const float d1 = wave_sum(p.in[I_LQ1][c.lane] * p.in[I_LK1][c.lane]);
    const float d2 = wave_sum(p.in[I_LQ2][c.lane] * p.in[I_LK2][c.lane]);
    const float lam = expf(d1) - expf(d2) + LAM_INIT;
    const float g0 = p.in[I_SUBLN][c.lane] * (1.f - LAM_INIT), g1 = p.in[I_SUBLN][c.lane + 64] * (1.f - LAM_INIT);
    for (int it = c.gw; it < NTOK * 4; it += c.NGW) {
        const int row = it >> 2, a = it & 3;
        const bf16* src = AO + (size_t)row * DM + a * 256;
        const float x0 = bf2f((unsigned)src[c.lane]) - lam * bf2f((unsigned)src[128 + c.lane]), x1 = bf2f((unsigned)src[64 + c.lane]) - lam * bf2f((unsigned)src[192 + c.lane]);
        const float ss = wave_sum(x0 * x0 + x1 * x1);
        const float r = rsqrtf(ss * (1.f / 128.f) + RMS_EPS);
        CC[(size_t)row * DM + a * 128 + c.lane] = (bf16)f2bf(x0 * r * g0);
        CC[(size_t)row * DM + a * 128 + 64 + c.lane] = (bf16)f2bf(x1 * r * g1);
    }
}

__device__ __forceinline__ f32x4 unpack4(const v2u w) { return (f32x4){bf2f(w.x & 0xffffu), __uint_as_float(w.x & 0xffff0000u), bf2f(w.y & 0xffffu), __uint_as_float(w.y & 0xffff0000u)}; }
__device__ __forceinline__ float reduce_logits(const f32x4 (&lg)[4], int lane) {
    float w8[8], w4[4], w2[2], w1;
    { const bool hi = (lane & 32) != 0;
#pragma unroll
      for (int i = 0; i < 8; ++i) { const float a0 = lg[i >> 2][i & 3], a1 = lg[2 + (i >> 2)][i & 3]; const float keep = hi ? a1 : a0, send = hi ? a0 : a1; w8[i] = keep + __shfl_xor(send, 32); } }
    { const bool hi = (lane & 16) != 0;
#pragma unroll
      for (int i = 0; i < 4; ++i) { const float keep = hi ? w8[i + 4] : w8[i], send = hi ? w8[i] : w8[i + 4]; w4[i] = keep + __shfl_xor(send, 16); } }
    { const bool hi = (lane & 8) != 0;
#pragma unroll
      for (int i = 0; i < 2; ++i) { const float keep = hi ? w4[i + 2] : w4[i], send = hi ? w4[i] : w4[i + 2]; w2[i] = keep + __shfl_xor(send, 8); } }
    { const bool hi = (lane & 4) != 0; const float keep = hi ? w2[1] : w2[0], send = hi ? w2[0] : w2[1]; w1 = keep + __shfl_xor(send, 4); }
    w1 += __shfl_xor(w1, 2); w1 += __shfl_xor(w1, 1);
    return w1;
}
__device__ __forceinline__ void ph_ln1_router(const Params& p, const Ctx& c, int layer) {
    const bf16* Y = (const bf16*)(p.ws + WS_Y);
    bf16* XS = (bf16*)(p.ws + WS_XS);
    bf16* HB = (bf16*)(p.ws + WS_HB);
    float* AFF = (float*)(p.ws + WS_AFF);
    const float* lng = p.in[I_LNG] + (size_t)(layer * 2 + 0) * DM; const float* lnb = p.in[I_LNB] + (size_t)(layer * 2 + 0) * DM;
    const float* router = p.in[I_ROUTER] + (size_t)layer * DM * NE;
    LAS f32x4* R = (LAS f32x4*)c.lds;
    for (int idx = c.tid; idx < 4096; idx += 512) { const int e4 = idx & 3, k = idx >> 2, ln = (k & 255) >> 2, q = k & 3, j = k >> 8;
        R[((j * 4 + q) * 4 + e4) * 64 + ln] = *(const f32x4*)(router + (size_t)k * NE + 4 * e4); }
    __syncthreads();
    const int nrows = layer == 0 ? NTOK : LAT;
    const int lane = c.lane;
    for (int row = 2 * c.gw; row < nrows; row += 2 * c.NGW) {
        const float* mod = mod_row(p, layer, row);
        f32x4 va[4], vb[4]; float sa = 0.f, sb = 0.f;
#pragma unroll
        for (int j = 0; j < 4; ++j) { const int col = 4 * lane + 256 * j;
            f32x4 xa, xb;
            if (layer == 0) { const float* xin = row < LAT ? p.in[I_X] + (size_t)row * DM : p.in[I_CTX] + (size_t)(row - LAT) * DM; xa = *(const f32x4*)(xin + col); xb = *(const f32x4*)(xin + DM + col); }
            else { xa = unpack4(*(const v2u*)(XS + (size_t)row * DM + col)); xb = unpack4(*(const v2u*)(XS + (size_t)(row + 1) * DM + col)); }
            const f32x4 g1 = *(const f32x4*)(mod + 2048 + col);
            va[j] = xa * ALPHA + g1 * unpack4(*(const v2u*)(Y + (size_t)row * DM + col));
            vb[j] = xb * ALPHA + g1 * unpack4(*(const v2u*)(Y + (size_t)(row + 1) * DM + col));
            sa += (va[j].x + va[j].y) + (va[j].z + va[j].w); sb += (vb[j].x + vb[j].y) + (vb[j].z + vb[j].w); }
        const float meana = wave_sum(sa) * (1.f / DM), meanb = wave_sum(sb) * (1.f / DM); float qa = 0.f, qb = 0.f;
#pragma unroll
        for (int j = 0; j < 4; ++j) { va[j] = va[j] - meana; vb[j] = vb[j] - meanb;
            qa += (va[j].x * va[j].x + va[j].y * va[j].y) + (va[j].z * va[j].z + va[j].w * va[j].w); qb += (vb[j].x * vb[j].x + vb[j].y * vb[j].y) + (vb[j].z * vb[j].z + vb[j].w * vb[j].w); }
        const float rstda = 1.f / sqrtf(wave_sum(qa) * (1.f / DM) + LN_EPS), rstdb = 1.f / sqrtf(wave_sum(qb) * (1.f / DM) + LN_EPS);
        f32x4 lga[4], lgb[4];
#pragma unroll
        for (int e = 0; e < 4; ++e) { lga[e] = (f32x4){0.f, 0.f, 0.f, 0.f}; lgb[e] = (f32x4){0.f, 0.f, 0.f, 0.f}; }
#pragma unroll
        for (int j = 0; j < 4; ++j) { const int col = 4 * lane + 256 * j;
            const f32x4 g = *(const f32x4*)(lng + col), bb = *(const f32x4*)(lnb + col), sc = *(const f32x4*)(mod + 4096 + col) + 1.f, sh = *(const f32x4*)(mod + 3072 + col);
            const f32x4 x1a = va[j] * rstda * g + bb, x1b = vb[j] * rstdb * g + bb;
            *(v2u*)(XS + (size_t)row * DM + col) = (v2u){pk2(x1a.x, x1a.y), pk2(x1a.z, x1a.w)};
            *(v2u*)(XS + (size_t)(row + 1) * DM + col) = (v2u){pk2(x1b.x, x1b.y), pk2(x1b.z, x1b.w)};
            const f32x4 hma = x1a * sc + sh, hmb = x1b * sc + sh;
            if (MOE_FP8) { *(unsigned*)((unsigned char*)HB + (size_t)row * DM + col) = pg8::pk4_fp8(hma.x, hma.y, hma.z, hma.w);
                           *(unsigned*)((unsigned char*)HB + (size_t)(row + 1) * DM + col) = pg8::pk4_fp8(hmb.x, hmb.y, hmb.z, hmb.w); }
            else { *(v2u*)(HB + (size_t)row * DM + col) = (v2u){pk2(hma.x, hma.y), pk2(hma.z, hma.w)}; *(v2u*)(HB + (size_t)(row + 1) * DM + col) = (v2u){pk2(hmb.x, hmb.y), pk2(hmb.z, hmb.w)}; }
            asm volatile("" ::: "memory");
#pragma unroll
            for (int q = 0; q < 4; ++q) { const float ha = hma[q], hb = hmb[q];
#pragma unroll
                for (int e4 = 0; e4 < 4; ++e4) { const f32x4 rw = R[((j * 4 + q) * 4 + e4) * 64 + lane]; lga[e4] += rw * ha; lgb[e4] += rw * hb; } } }
        const float wa = reduce_logits(lga, lane), wb = reduce_logits(lgb, lane);
        float mxa = wa, mxb = wb;
#pragma unroll
        for (int o = 4; o < 64; o <<= 1) { mxa = fmaxf(mxa, __shfl_xor(mxa, o)); mxb = fmaxf(mxb, __shfl_xor(mxb, o)); }
        const float exa = expf(wa - mxa), exb = expf(wb - mxb); float dena = exa, denb = exb;
#pragma unroll
        for (int o = 4; o < 64; o <<= 1) { dena += __shfl_xor(dena, o); denb += __shfl_xor(denb, o); }
        if ((lane & 3) == 0) { const int e = ((lane >> 5) & 1) * 8 + ((lane >> 4) & 1) * 4 + ((lane >> 3) & 1) * 2 + ((lane >> 2) & 1);
            AFF[(size_t)row * NE + e] = exa / dena; AFF[(size_t)(row + 1) * NE + e] = exb / denb; }
    }
}

__device__ __forceinline__ void ph_topk(const Params& p, const Ctx& c, int layer) {
    const float* AFF = (const float*)(p.ws + WS_AFF);
    int* INV = (int*)(p.ws + WS_INV);
    float* GATE = (float*)(p.ws + WS_GATE);
    const bf16* HB = (const bf16*)(p.ws + WS_HB);
    bf16* XG = (bf16*)(p.ws + WS_XG);
    LAS unsigned* hist = (LAS unsigned*)c.lds;
    LAS unsigned* ctl = hist + 256;
    LAS int* sel = (LAS int*)(c.lds + 2048);
    const int MR = layer == 0 ? MR0 : MR1;
    const int ntasks = layer == 0 ? 256 : 128;
    const int lane = c.lane;
    for (int task = c.vcu; task < ntasks; task += c.G) {
        int set, e, n, cap, rowbase, slotbase;
        if (task < 128) { set = task >> 4; e = task & 15; n = SEQ; cap = 256; rowbase = set * SEQ; slotbase = set * 256; }
        else { const int t2 = task - 128; set = t2 >> 4; e = t2 & 15; n = NCTX; cap = 32; rowbase = LAT + set * NCTX; slotbase = 2048 + set * 32; }
        const bool valid = 4 * c.tid < n;
        unsigned key[4];
#pragma unroll
        for (int q = 0; q < 4; ++q) key[q] = valid ? __float_as_uint(AFF[(size_t)(rowbase + 4 * c.tid + q) * NE + e]) : 0u;
        unsigned prefix = 0u, need = (unsigned)cap;
#pragma unroll 1
        for (int pass = 0; pass < 4; ++pass) {
            const int shift = 24 - 8 * pass;
            if (c.tid < 256) hist[c.tid] = 0u;
            __syncthreads();
            if (valid) {
#pragma unroll
                for (int q = 0; q < 4; ++q) if (pass == 0 || (key[q] >> (shift + 8)) == (prefix >> (shift + 8))) __hip_atomic_fetch_add(&hist[(key[q] >> shift) & 255u], 1u, __ATOMIC_RELAXED, __HIP_MEMORY_SCOPE_WORKGROUP);
            }
            __syncthreads();
            if (c.wave == 0) {
                const unsigned h0 = hist[4 * lane], h1 = hist[4 * lane + 1], h2 = hist[4 * lane + 2], h3 = hist[4 * lane + 3];
                const unsigned tot = h0 + h1 + h2 + h3; unsigned sfx = tot;
#pragma unroll
                for (int o = 1; o < 64; o <<= 1) { const unsigned t = __shfl_down(sfx, o); if (lane + o < 64) sfx += t; }
                const unsigned above = sfx - tot, c3 = above + h3, c2 = c3 + h2, c1 = c2 + h1, c0 = c1 + h0;
                int d = -1; unsigned gtc = 0u;
                if (above < need && need <= c3) { d = 3; gtc = above; }
                else if (c3 < need && need <= c2) { d = 2; gtc = c3; }
                else if (c2 < need && need <= c1) { d = 1; gtc = c2; }
                else if (c1 < need && need <= c0) { d = 0; gtc = c1; }
                if (d >= 0) { ctl[0] = prefix | ((unsigned)(4 * lane + d) << shift); ctl[1] = need - gtc; }
            }
            __syncthreads();
            prefix = ctl[0]; need = ctl[1];
        }
        unsigned ngt = 0u, neq = 0u;
#pragma unroll
        for (int q = 0; q < 4; ++q) { ngt += (valid && key[q] > prefix) ? 1u : 0u; neq += (valid && key[q] == prefix) ? 1u : 0u; }
        const unsigned cnt = ngt | (neq << 16); unsigned inc = cnt;
#pragma unroll
        for (int o = 1; o < 64; o <<= 1) { const unsigned t = __shfl_up(inc, o); if (lane >= o) inc += t; }
        if (lane == 63) ctl[8 + c.wave] = inc;
        __syncthreads();
        unsigned base = 0u;
#pragma unroll
        for (int w = 0; w < 8; ++w) base += (w < c.wave) ? ctl[8 + w] : 0u;
        const unsigned ex = base + inc - cnt; unsigned gtb = ex & 0xffffu, eqb = ex >> 16;
        if (valid) {
#pragma unroll
            for (int q = 0; q < 4; ++q) { const int i = 4 * c.tid + q; int slot = -1;
                if (key[q] > prefix) { slot = (int)(gtb + (eqb < need ? eqb : need)); ++gtb; }
                else if (key[q] == prefix) { if (eqb < need) slot = (int)(gtb + eqb); ++eqb; }
                int gs = -1;
                if (slot >= 0) { gs = e * MR + slotbase + slot; sel[slot] = i; GATE[gs] = __uint_as_float(key[q]); }
                INV[(size_t)(rowbase + i) * NE + e] = gs; }
        }
        __syncthreads();
        for (int sidx = c.wave; sidx < cap; sidx += 8) {
            if (MOE_FP8) { const unsigned char* src = (const unsigned char*)HB + (size_t)(rowbase + sel[sidx]) * DM; unsigned char* dst = (unsigned char*)XG + (size_t)(e * MR + slotbase + sidx) * DM;
                *(v4u*)(dst + 16 * lane) = *(const v4u*)(src + 16 * lane); }
            else { const bf16* src = HB + (size_t)(rowbase + sel[sidx]) * DM; bf16* dst = XG + (size_t)(e * MR + slotbase + sidx) * DM;
            const v4u a0 = *(const v4u*)(src + 8 * lane), a1 = *(const v4u*)(src + 512 + 8 * lane);
            *(v4u*)(dst + 8 * lane) = a0; *(v4u*)(dst + 512 + 8 * lane) = a1; }
        }
        __syncthreads();
    }
}

__device__ __forceinline__ void ph_combine(const Params& p, const Ctx& c, int layer) {
    const bf16* YS = (const bf16*)(p.ws + WS_YS);
    const int* INV = (const int*)(p.ws + WS_INV);
    bf16* XS = (bf16*)(p.ws + WS_XS);
    bf16* HB = (bf16*)(p.ws + WS_HB);
    const float* lng = p.in[I_LNG] + (size_t)(layer * 2 + 1) * DM; const float* lnb = p.in[I_LNB] + (size_t)(layer * 2 + 1) * DM;
    const int nrows = layer == 0 ? NTOK : LAT;
    const int lane = c.lane;
    for (int row = 2 * c.gw; row < nrows; row += 2 * c.NGW) {
        const float* mod = mod_row(p, layer, row);
        const int inv = (lane < 2 * NE) ? INV[(size_t)row * NE + lane] : -1;
        const unsigned mall = (unsigned)__ballot(inv >= 0);
        unsigned ma = mall & 0xffffu, mb = mall >> 16;
        int sla[4], slb[4]; float wa[4], wb[4];
#pragma unroll
        for (int q = 0; q < 4; ++q) {
            if (ma) { const int e = __builtin_ctz(ma); ma &= ma - 1; sla[q] = __builtin_amdgcn_readlane(inv, e); wa[q] = 1.f; } else { sla[q] = 0; wa[q] = 0.f; }
            if (mb) { const int e = __builtin_ctz(mb); mb &= mb - 1; slb[q] = __builtin_amdgcn_readlane(inv, 16 + e); wb[q] = 1.f; } else { slb[q] = 0; wb[q] = 0.f; } }
        f32x4 moa[4], mob[4];
#pragma unroll
        for (int j = 0; j < 4; ++j) { moa[j] = (f32x4){0.f, 0.f, 0.f, 0.f}; mob[j] = (f32x4){0.f, 0.f, 0.f, 0.f}; }
#pragma unroll
        for (int q = 0; q < 4; ++q)
#pragma unroll
            for (int j = 0; j < 4; ++j) { moa[j] += unpack4(*(const v2u*)(YS + (size_t)sla[q] * DM + 4 * lane + 256 * j)) * wa[q]; mob[j] += unpack4(*(const v2u*)(YS + (size_t)slb[q] * DM + 4 * lane + 256 * j)) * wb[q]; }
        while (ma) { const int e = __builtin_ctz(ma); ma &= ma - 1; const int sl = __builtin_amdgcn_readlane(inv, e);
#pragma unroll
            for (int j = 0; j < 4; ++j) moa[j] += unpack4(*(const v2u*)(YS + (size_t)sl * DM + 4 * lane + 256 * j)); }
        while (mb) { const int e = __builtin_ctz(mb); mb &= mb - 1; const int sl = __builtin_amdgcn_readlane(inv, 16 + e);
#pragma unroll
            for (int j = 0; j < 4; ++j) mob[j] += unpack4(*(const v2u*)(YS + (size_t)sl * DM + 4 * lane + 256 * j)); }
        f32x4 va[4], vb[4]; float sa = 0.f, sb = 0.f;
#pragma unroll
        for (int j = 0; j < 4; ++j) { const int col = 4 * lane + 256 * j; const f32x4 g2 = *(const f32x4*)(mod + 5120 + col);
            va[j] = unpack4(*(const v2u*)(XS + (size_t)row * DM + col)) * ALPHA + g2 * moa[j];
            vb[j] = unpack4(*(const v2u*)(XS + (size_t)(row + 1) * DM + col)) * ALPHA + g2 * mob[j];
            sa += (va[j].x + va[j].y) + (va[j].z + va[j].w); sb += (vb[j].x + vb[j].y) + (vb[j].z + vb[j].w); }
        const float meana = wave_sum(sa) * (1.f / DM), meanb = wave_sum(sb) * (1.f / DM); float qa = 0.f, qb = 0.f;
#pragma unroll
        for (int j = 0; j < 4; ++j) { va[j] = va[j] - meana; vb[j] = vb[j] - meanb;
            qa += (va[j].x * va[j].x + va[j].y * va[j].y) + (va[j].z * va[j].z + va[j].w * va[j].w); qb += (vb[j].x * vb[j].x + vb[j].y * vb[j].y) + (vb[j].z * vb[j].z + vb[j].w * vb[j].w); }
        const float rstda = 1.f / sqrtf(wave_sum(qa) * (1.f / DM) + LN_EPS), rstdb = 1.f / sqrtf(wave_sum(qb) * (1.f / DM) + LN_EPS);
        const float* modn = mod_row(p, 1, row);
#pragma unroll
        for (int j = 0; j < 4; ++j) { const int col = 4 * lane + 256 * j;
            const f32x4 g = *(const f32x4*)(lng + col), bb = *(const f32x4*)(lnb + col);
            const f32x4 x2a = va[j] * rstda * g + bb, x2b = vb[j] * rstdb * g + bb;
            if (layer == 0) {
                *(v2u*)(XS + (size_t)row * DM + col) = (v2u){pk2(x2a.x, x2a.y), pk2(x2a.z, x2a.w)};
                *(v2u*)(XS + (size_t)(row + 1) * DM + col) = (v2u){pk2(x2b.x, x2b.y), pk2(x2b.z, x2b.w)};
                const f32x4 sc = *(const f32x4*)(modn + 1024 + col) + 1.f, sh = *(const f32x4*)(modn + col);
                const f32x4 ha = x2a * sc + sh, hb = x2b * sc + sh;
                *(v2u*)(HB + (size_t)row * DM + col) = (v2u){pk2(ha.x, ha.y), pk2(ha.z, ha.w)};
                *(v2u*)(HB + (size_t)(row + 1) * DM + col) = (v2u){pk2(hb.x, hb.y), pk2(hb.z, hb.w)};
            } else {
                *(f32x4*)(p.out + (size_t)row * DM + col) = x2a; *(f32x4*)(p.out + (size_t)(row + 1) * DM + col) = x2b;
            } }
    }
}

__device__ __forceinline__ void na_key(const float* q, float* o, float& m, float& l, const bf16* kp, const bf16* vp, float bias) {
    float s = bias;
#pragma unroll
    for (int i = 0; i < 8; ++i) { float f[8]; unpack8(*(const v4u*)(kp + 8 * i), f);
#pragma unroll
        for (int j = 0; j < 8; ++j) s += q[8 * i + j] * f[j]; }
    const float mn = fmaxf(m, s), al = exp2f(m - mn), pp = exp2f(s - mn);
    l = l * al + pp; m = mn;
#pragma unroll
    for (int i = 0; i < 8; ++i) { float f[8]; unpack8(*(const v4u*)(vp + 8 * i), f);
#pragma unroll
        for (int j = 0; j < 8; ++j) o[8 * i + j] = o[8 * i + j] * al + pp * f[j]; }
}
__device__ __forceinline__ void ph_mixer1_naive(const Params& p, const Ctx& c) {
    const bf16* P2 = (const bf16*)(p.ws + WS_QKV);
    bf16* CC = (bf16*)(p.ws + WS_CC);
    const float* rpb = p.in[I_RPB]; const float* pool_w = p.in[I_POOLW]; const float* pool_s = p.in[I_POOLS];
    LAS float* pl = (LAS float*)c.lds;
    for (int u = c.vcu; u < 256; u += c.G) {
        const int b = u >> 5, r = u & 31;
        {
            const int h = c.wave, col = c.lane, row = b * SEQ + r * 64 + col;
            const int rs = min(max(r - 4, 0), 24), cs = min(max(col - 8, 0), 48);
            float q[64], o[64];
#pragma unroll
            for (int i = 0; i < 8; ++i) unpack8(*(const v4u*)(P2 + (size_t)row * OIN + h * 64 + 8 * i), q + 8 * i);
#pragma unroll
            for (int i = 0; i < 64; ++i) o[i] = 0.f;
            float m = -1e30f, l = 0.f;
#pragma unroll 1
            for (int i = 0; i < 8; ++i)
#pragma unroll 1
                for (int j = 0; j < 16; ++j) {
                    const int krow = b * SEQ + (rs + i) * 64 + cs + j;
                    const float bias = rpb[(h * 15 + (rs + i - r + 7)) * 31 + (cs + j - col + 15)] * LOG2E;
                    na_key(q, o, m, l, P2 + (size_t)krow * OIN + 512 + h * 64, P2 + (size_t)krow * OIN + 1024 + h * 64, bias);
                }
#pragma unroll 1
            for (int j = 0; j < NCTX; ++j) {
                const int krow = LAT + b * NCTX + j;
                na_key(q, o, m, l, P2 + (size_t)krow * OIN + 512 + h * 64, P2 + (size_t)krow * OIN + 1024 + h * 64, 0.f);
            }
            const float rl = 1.f / l; bf16* dst = CC + (size_t)row * DM + h * 64;
#pragma unroll
            for (int i = 0; i < 8; ++i) *(v4u*)(dst + 8 * i) = (v4u){pk2(o[8 * i] * rl, o[8 * i + 1] * rl), pk2(o[8 * i + 2] * rl, o[8 * i + 3] * rl), pk2(o[8 * i + 4] * rl, o[8 * i + 5] * rl), pk2(o[8 * i + 6] * rl, o[8 * i + 7] * rl)};
        }
        __syncthreads();
        {
            const int ch = c.tid, g = ch >> 7, half = 1 << g;
            for (int tt = 0; tt < 64; ++tt) {
                const int t = r * 64 + tt, lo = max(t - half, 0), hi = min(t + half, SEQ);
                float s = 0.f;
                for (int t2 = lo; t2 < hi; ++t2) s += bf2f((unsigned)P2[(size_t)(b * SEQ + t2) * OIN + 1536 + ch]);
                pl[tt * 512 + ch] = s / (float)(hi - lo) - bf2f((unsigned)P2[(size_t)(b * SEQ + t) * OIN + 1536 + ch]);
            }
        }
        __syncthreads();
        {
            const int g = c.tid >> 7, e = c.tid & 127;
            const float ps = pool_s[g * 128 + e];
#pragma unroll 1
            for (int tb = 0; tb < 64; tb += 16) {
                float acc[16];
#pragma unroll
                for (int i = 0; i < 16; ++i) acc[i] = 0.f;
#pragma unroll 4
                for (int cc = 0; cc < 128; ++cc) {
                    const float w = pool_w[(size_t)(g * 128 + cc) * 128 + e];
#pragma unroll
                    for (int i = 0; i < 16; ++i) acc[i] += pl[(tb + i) * 512 + g * 128 + cc] * w;
                }
#pragma unroll
                for (int i = 0; i < 16; ++i) CC[(size_t)(b * SEQ + r * 64 + tb + i) * DM + 512 + g * 128 + e] = (bf16)f2bf(acc[i] * ps);
            }
        }
        __syncthreads();
    }
}


constexpr int NA_TAB_OFF = 86016 + 1024;
__device__ __forceinline__ void ph_mixer1_fast(const Params& p, const Ctx& c, char* lds_generic) {
    typedef attn_body::bf16 abf;
    const abf* P2a = (const abf*)(p.ws + WS_QKV); abf* CCa = (abf*)(p.ws + WS_CC);
    LAS float* tab = (LAS float*)(c.lds + NA_TAB_OFF);
    for (int i = c.tid; i < 8 * 15 * 32; i += 512) { const int hd = i >> 5, j = i & 31; tab[i] = j < 31 ? p.in[I_RPB][hd * 31 + j] * LOG2E : 0.f; }
    __syncthreads();
    for (int it = 0;; ++it) {
        const int U = it * c.G + c.vcu;
        if (U >= 512) break;
        const int b = U >> 6, h = (U >> 3) & 7, rq = U & 7;
        const int rs_min = min(max(4 * rq - 4, 0), 24);
        const int nloc = (rq == 0 || rq == 7) ? 8 : 12;
        attn_body::AU u;
        u.qrow0 = b * SEQ + rq * 256; u.lat_row0 = LAT + b * NCTX; u.nlat_t = 4; u.ctx_row0 = b * SEQ + rs_min * 64; u.NT = 4 + nloc;
        u.Qp = P2a + h * 64; u.Kp = P2a + 512 + h * 64; u.Vp = P2a + 1024 + h * 64; u.Op = CCa + h * 64;
        const int r = 4 * rq + (c.wave >> 1), col = (c.wave & 1) * 32 + (c.lane & 31), hi = c.lane >> 5;
        const int cs = min(max(col - 8, 0), 48);
        attn_body::NAMask mk; mk.tb0 = (attn_body::lds_cfptr)(tab + h * 15 * 32 + 15 - col); mk.r = r; mk.rs = min(max(r - 4, 0), 24); mk.rs_min = rs_min; mk.cb = 4 * hi - cs;
        attn_body::attn_unit<8, OIN, attn_body::NAMask>(u, lds_generic, mk);
    }
    __syncthreads();
    const bf16* P2 = (const bf16*)(p.ws + WS_QKV); bf16* CC = (bf16*)(p.ws + WS_CC);
    const float* pool_w = p.in[I_POOLW]; const float* pool_s = p.in[I_POOLS];
    LAS float* pl = (LAS float*)c.lds;
    for (int u = c.vcu; u < 256; u += c.G) {
        const int b = u >> 5, r = u & 31;
        {
            const int ch = c.tid, g = ch >> 7, half = 1 << g;
            const bf16* du = P2 + (size_t)b * SEQ * OIN + 1536 + ch;
            const int t0 = r * 64;
            float ws = 0.f;
            { float iv[16];
#pragma unroll
              for (int k = 0; k < 16; ++k) { const int t2 = t0 - half + k; const float w = (k < 2 * half && t2 >= 0 && t2 < SEQ) ? 1.f : 0.f; iv[k] = w * bf2f((unsigned)du[(size_t)min(max(t2, 0), SEQ - 1) * OIN]); }
#pragma unroll
              for (int k = 0; k < 16; ++k) ws += iv[k]; }
#pragma unroll 1
            for (int tb = 0; tb < 64; tb += 8) {
                float cur[8], add[8], sub[8];
#pragma unroll
                for (int k = 0; k < 8; ++k) { const int t = t0 + tb + k;
                    cur[k] = bf2f((unsigned)du[(size_t)t * OIN]);
                    add[k] = ((t + half < SEQ) ? 1.f : 0.f) * bf2f((unsigned)du[(size_t)min(t + half, SEQ - 1) * OIN]);
                    sub[k] = ((t - half >= 0) ? 1.f : 0.f) * bf2f((unsigned)du[(size_t)max(t - half, 0) * OIN]); }
#pragma unroll
                for (int k = 0; k < 8; ++k) { const int t = t0 + tb + k, lo = max(t - half, 0), hi = min(t + half, SEQ);
                    pl[(tb + k) * 512 + ch] = ws / (float)(hi - lo) - cur[k];
                    ws += add[k] - sub[k]; }
            }
        }
        __syncthreads();
        {
            const int g = c.tid >> 7, e = c.tid & 127;
            const float ps = pool_s[g * 128 + e];
#pragma unroll 1
            for (int tb = 0; tb < 64; tb += 16) {
                float acc[16];
#pragma unroll
                for (int i = 0; i < 16; ++i) acc[i] = 0.f;
#pragma unroll 2
                for (int cc = 0; cc < 128; cc += 4) {
                    const float w0 = pool_w[(size_t)(g * 128 + cc) * 128 + e], w1 = pool_w[(size_t)(g * 128 + cc + 1) * 128 + e], w2 = pool_w[(size_t)(g * 128 + cc + 2) * 128 + e], w3 = pool_w[(size_t)(g * 128 + cc + 3) * 128 + e];
#pragma unroll
                    for (int i = 0; i < 16; ++i) { const f32x4 pv = *(const LAS f32x4*)(pl + (tb + i) * 512 + g * 128 + cc); acc[i] += pv.x * w0 + pv.y * w1 + pv.z * w2 + pv.w * w3; }
                }
#pragma unroll
                for (int i = 0; i < 16; ++i) CC[(size_t)(b * SEQ + r * 64 + tb + i) * DM + 512 + g * 128 + e] = (bf16)f2bf(acc[i] * ps);
            }
        }
        __syncthreads();
    }
}

__global__ void __launch_bounds__(512, 2) mk_fwd(Params p) {
    extern __shared__ __attribute__((aligned(16))) unsigned char lds_raw[];
    Ctx c;
    c.lds = (LAS unsigned char*)lds_raw;
    c.tid = threadIdx.x; c.lane = c.tid & 63; c.wave = __builtin_amdgcn_readfirstlane(c.tid >> 6);
    c.G = gridDim.x; { const int bx = blockIdx.x; c.vcu = (c.G % 8 == 0) ? (bx % 8) * (c.G / 8) + bx / 8 : bx; }
    c.gw = c.vcu * 8 + c.wave; c.NGW = c.G * 8;
    volatile LAS unsigned* MISC = (volatile LAS unsigned*)(c.lds + MISC_OFF);
    if (c.tid < 32) MISC[c.tid] = 0u;
    __syncthreads();
    gu32* ctl = (gu32*)(p.ws + WS_CTL);
    XcdBarrier bar; bar.bar = (unsigned*)(ctl + CW_BAR); bar.x = 0; bar.st = nullptr;
    if (!MK_MULTI) bar = xcd_barrier_post((unsigned*)(ctl + CW_BAR), MISC + 8);
    const int lo = p.ph_lo, hi = p.ph_hi;
    unsigned long long pt0 = 0, pt1 = 0; if (PROBE_PH == 0) pt0 = __builtin_amdgcn_s_memrealtime();
#define IN(k) (lo <= (k) && (k) < hi)
#define SEAM(k) do { if (IN(k) && IN((k) + 1) && !(FAST_ATTN && (k) == 5) && !(FAST_GEMM && FUSE_QKV && (k) == 3)) xcd_barrier(bar); if ((k) + 1 == PROBE_PH) pt0 = __builtin_amdgcn_s_memrealtime(); if ((k) == PROBE_PH) pt1 = __builtin_amdgcn_s_memrealtime(); } while (0)

    bf16* HB = (bf16*)(p.ws + WS_HB); bf16* QKV = (bf16*)(p.ws + WS_QKV); bf16* CC = (bf16*)(p.ws + WS_CC);
    float* Y = (float*)(p.ws + WS_Y); float* PF = (float*)(p.ws + WS_PF);
    bf16* XG = (bf16*)(p.ws + WS_XG); bf16* HID = (bf16*)(p.ws + WS_HID); bf16* YS = (bf16*)(p.ws + WS_YS);
    const float* GATE = (const float*)(p.ws + WS_GATE);

    if (IN(0)) for (int rep_ = 0; rep_ < 1 + (int)((PROBE_MASK >> 0) & 1u); ++rep_) { if (rep_) __syncthreads(); ph_prologue(p, c); if (FAST_GEMM) { __syncthreads(); ph_transposes(p, c); } } SEAM(0);
    if (IN(1)) for (int rep_ = 0; rep_ < 1 + (int)((PROBE_MASK >> 1) & 1u); ++rep_) { if (rep_) __syncthreads(); ph_modulate0(p, c); } SEAM(1);
    if (IN(2)) for (int rep_ = 0; rep_ < 1 + (int)((PROBE_MASK >> 2) & 1u); ++rep_) { if (rep_) __syncthreads();
        if (FAST_GEMM) { pg8::Gemm g{HB, (const bf16*)(p.ws + WS_W0IN), NTOK, EIN, DM, 0}; pg8::StaticOrder S; S.init(NTOK, EIN, c.G, (int)blockIdx.x);
            if (FUSE_QKV) { pg8::EpiQKV E{QKV, EIN, (const float*)(p.ws + WS_ROPE), p.in[I_QN], p.in[I_KN], C2, RMS_EPS}; pg8::gemm_phase<pg8::EpiQKV, pg8::StaticOrder, true, true>(c.lds, g, S, E); }
            else { pg8::EpiBf16<0> E{QKV, EIN, nullptr, 0, 0, 1.f}; pg8::gemm_phase<pg8::EpiBf16<0>, pg8::StaticOrder, true, true>(c.lds, g, S, E); } }
        else { NG g{HB, DM, p.in[I_W0IN], nullptr, EIN, 0, 1 << 30, 0, NTOK, 0, EIN, DM}; ngemm<1>(g, c, EpiF32{PF, EIN}); }
    } SEAM(2);
    if (!(FAST_GEMM && FUSE_QKV)) { if (IN(3)) { if (FAST_GEMM) ph_qkv_post<false>(p, c); else ph_qkv_post<true>(p, c); } } SEAM(3);
    if (IN(4)) for (int rep_ = 0; rep_ < 1 + (int)((PROBE_MASK >> 4) & 1u); ++rep_) { if (rep_) __syncthreads(); if (FAST_ATTN) ph_attn0_fast(p, c, (char*)lds_raw); else ph_attn0_naive(p, c); } SEAM(4);
    if (!FAST_ATTN) { if (IN(5)) { ph_attn_combine(p, c); } } SEAM(5);
    if (IN(6)) for (int rep_ = 0; rep_ < 1 + (int)((PROBE_MASK >> 6) & 1u); ++rep_) { if (rep_) __syncthreads();
        if (FAST_GEMM) { pg8::Gemm g{CC, (const bf16*)(p.ws + WS_W0OUT), NTOK, DM, DM, 0}; pg8::StaticOrder S; S.init(NTOK, DM, c.G, (int)blockIdx.x);
            pg8::EpiBf16<0> E{(bf16*)Y, DM, nullptr, 0, 0, 1.f}; pg8::gemm_phase<pg8::EpiBf16<0>, pg8::StaticOrder, true, true>(c.lds, g, S, E); }
        else { NG g{CC, DM, p.in[I_W0OUT], nullptr, DM, 0, 1 << 30, 0, NTOK, 0, DM, DM}; ngemm<1>(g, c, EpiBf{(bf16*)Y, DM, 0, 1.f}); }
    } SEAM(6);
    if (IN(7)) for (int rep_ = 0; rep_ < 1 + (int)((PROBE_MASK >> 7) & 1u); ++rep_) { if (rep_) __syncthreads(); ph_ln1_router(p, c, 0); } SEAM(7);
    if (IN(8)) for (int rep_ = 0; rep_ < 1 + (int)((PROBE_MASK >> 8) & 1u); ++rep_) { if (rep_) __syncthreads(); ph_topk(p, c, 0); } SEAM(8);
    if (IN(9)) for (int rep_ = 0; rep_ < 1 + (int)((PROBE_MASK >> 9) & 1u); ++rep_) { if (rep_) __syncthreads();
        if (FAST_GEMM && MOE_FP8) { pg8::Gemm g{XG, (const bf16*)(p.ws + WS_WGU), NE * MR0, 4096, DM / 2, (size_t)4096 * DM}; pg8::GroupedOrder S; S.init(MR0 / 256, 16, NE, c.G, c.vcu);
            pg8::EpiSwigluF8 E{(unsigned char*)HID, FF, 1.f / W8_GU, H8_SC}; pg8::gemm_phase<pg8::EpiSwigluF8, pg8::GroupedOrder, true, true, true>(c.lds, g, S, E); }
        else if (FAST_GEMM) { pg8::Gemm g{XG, (const bf16*)(p.ws + WS_WGU), NE * MR0, 4096, DM, (size_t)4096 * DM * 2}; pg8::GroupedOrder S; S.init(MR0 / 256, 16, NE, c.G, c.vcu);
            pg8::EpiSwigluP E{HID, FF}; pg8::gemm_phase<pg8::EpiSwigluP, pg8::GroupedOrder, true, true>(c.lds, g, S, E); }
        else { NG g{XG, DM, p.in[I_WG], p.in[I_WU], FF, (size_t)DM * FF, MR0, 0, NE * MR0, 0, FF, DM}; ngemm<2>(g, c, EpiSwiglu{HID}); }
    } SEAM(9);
    if (IN(10)) for (int rep_ = 0; rep_ < 1 + (int)((PROBE_MASK >> 10) & 1u); ++rep_) { if (rep_) __syncthreads();
        if (FAST_GEMM && MOE_FP8) { pg8::Gemm g{HID, (const bf16*)(p.ws + WS_WDN), NE * MR0, DM, FF / 2, (size_t)DM * FF}; pg8::GroupedOrder S; S.init(MR0 / 256, 4, NE, c.G, c.vcu);
            pg8::EpiGateS E{YS, DM, GATE, 1.f / (W8_DN * H8_SC)}; pg8::gemm_phase<pg8::EpiGateS, pg8::GroupedOrder, true, true, true>(c.lds, g, S, E); }
        else if (FAST_GEMM) { pg8::Gemm g{HID, (const bf16*)(p.ws + WS_WDN), NE * MR0, DM, FF, (size_t)DM * FF * 2}; pg8::GroupedOrder S; S.init(MR0 / 256, 4, NE, c.G, c.vcu);
            pg8::EpiGateP E{YS, DM, GATE}; pg8::gemm_phase<pg8::EpiGateP, pg8::GroupedOrder, true, true>(c.lds, g, S, E); }
        else { NG g{HID, FF, p.in[I_WD], nullptr, DM, (size_t)FF * DM, MR0, 0, NE * MR0, 0, DM, FF}; ngemm<1>(g, c, EpiGate{YS, GATE}); }
    } SEAM(10);
    if (IN(11)) for (int rep_ = 0; rep_ < 1 + (int)((PROBE_MASK >> 11) & 1u); ++rep_) { if (rep_) __syncthreads(); ph_combine(p, c, 0); } SEAM(11);
    if (IN(12)) for (int rep_ = 0; rep_ < 1 + (int)((PROBE_MASK >> 12) & 1u); ++rep_) { if (rep_) __syncthreads();
        if (FAST_GEMM) { pg8::Gemm g{HB, (const bf16*)(p.ws + WS_W1IN), NTOK, OIN, DM, 0}; pg8::L1InOrder S; S.init(c.G, (int)blockIdx.x);
            pg8::EpiBf16<0> E{QKV, OIN, nullptr, 512, 512, C2}; pg8::gemm_phase<pg8::EpiBf16<0>, pg8::L1InOrder, true, true>(c.lds, g, S, E); }
        else {
        NG g{HB, DM, p.in[I_W1IN], nullptr, OIN, 0, 1 << 30, 0, LAT, 0, OIN, DM}; ngemm<1>(g, c, EpiBf{QKV, OIN, 512, C2});
        NG g2{HB, DM, p.in[I_W1IN], nullptr, OIN, 0, 1 << 30, LAT, NTOK, 512, 1536, DM}; ngemm<1>(g2, c, EpiBf{QKV, OIN, 0, 1.f}); }
    } SEAM(12);
    if (IN(13)) for (int rep_ = 0; rep_ < 1 + (int)((PROBE_MASK >> 13) & 1u); ++rep_) { if (rep_) __syncthreads(); if (FAST_NA) ph_mixer1_fast(p, c, (char*)lds_raw); else ph_mixer1_naive(p, c); } SEAM(13);
    if (IN(14)) for (int rep_ = 0; rep_ < 1 + (int)((PROBE_MASK >> 14) & 1u); ++rep_) { if (rep_) __syncthreads();
        if (FAST_GEMM) { pg8::Gemm g{CC, (const bf16*)(p.ws + WS_W1OUT), LAT, DM, DM, 0}; pg8::StaticOrder S; S.init(LAT, DM, c.G, (int)blockIdx.x);
            pg8::EpiBf16<0> E{(bf16*)Y, DM, nullptr, 0, 0, 1.f}; pg8::gemm_phase<pg8::EpiBf16<0>, pg8::StaticOrder, true, true>(c.lds, g, S, E); }
        else { NG g{CC, DM, p.in[I_W1OUT], nullptr, DM, 0, 1 << 30, 0, LAT, 0, DM, DM}; ngemm<1>(g, c, EpiBf{(bf16*)Y, DM, 0, 1.f}); }
    } SEAM(14);
    if (IN(15)) for (int rep_ = 0; rep_ < 1 + (int)((PROBE_MASK >> 15) & 1u); ++rep_) { if (rep_) __syncthreads(); ph_ln1_router(p, c, 1); } SEAM(15);
    if (IN(16)) for (int rep_ = 0; rep_ < 1 + (int)((PROBE_MASK >> 16) & 1u); ++rep_) { if (rep_) __syncthreads(); ph_topk(p, c, 1); } SEAM(16);
    if (IN(17)) for (int rep_ = 0; rep_ < 1 + (int)((PROBE_MASK >> 17) & 1u); ++rep_) { if (rep_) __syncthreads();
        if (FAST_GEMM && MOE_FP8) { pg8::Gemm g{XG, (const bf16*)(p.ws + WS_WGU + WS_MOE_LSTRIDE), NE * MR1, 4096, DM / 2, (size_t)4096 * DM}; pg8::GroupedOrder S; S.init(MR1 / 256, 16, NE, c.G, c.vcu);
            pg8::EpiSwigluF8 E{(unsigned char*)HID, FF, 1.f / W8_GU, H8_SC}; pg8::gemm_phase<pg8::EpiSwigluF8, pg8::GroupedOrder, true, true, true>(c.lds, g, S, E); }
        else if (FAST_GEMM) { pg8::Gemm g{XG, (const bf16*)(p.ws + WS_WGU + WS_MOE_LSTRIDE), NE * MR1, 4096, DM, (size_t)4096 * DM * 2}; pg8::GroupedOrder S; S.init(MR1 / 256, 16, NE, c.G, c.vcu);
            pg8::EpiSwigluP E{HID, FF}; pg8::gemm_phase<pg8::EpiSwigluP, pg8::GroupedOrder, true, true>(c.lds, g, S, E); }
        else { NG g{XG, DM, p.in[I_WG] + (size_t)NE * DM * FF, p.in[I_WU] + (size_t)NE * DM * FF, FF, (size_t)DM * FF, MR1, 0, NE * MR1, 0, FF, DM}; ngemm<2>(g, c, EpiSwiglu{HID}); }
    } SEAM(17);
    if (IN(18)) for (int rep_ = 0; rep_ < 1 + (int)((PROBE_MASK >> 18) & 1u); ++rep_) { if (rep_) __syncthreads();
        if (FAST_GEMM && MOE_FP8) { pg8::Gemm g{HID, (const bf16*)(p.ws + WS_WDN + WS_MOE_LSTRIDE), NE * MR1, DM, FF / 2, (size_t)DM * FF}; pg8::GroupedOrder S; S.init(MR1 / 256, 4, NE, c.G, c.vcu);
            pg8::EpiGateS E{YS, DM, GATE, 1.f / (W8_DN * H8_SC)}; pg8::gemm_phase<pg8::EpiGateS, pg8::GroupedOrder, true, true, true>(c.lds, g, S, E); }
        else if (FAST_GEMM) { pg8::Gemm g{HID, (const bf16*)(p.ws + WS_WDN + WS_MOE_LSTRIDE), NE * MR1, DM, FF, (size_t)DM * FF * 2}; pg8::GroupedOrder S; S.init(MR1 / 256, 4, NE, c.G, c.vcu);
            pg8::EpiGateP E{YS, DM, GATE}; pg8::gemm_phase<pg8::EpiGateP, pg8::GroupedOrder, true, true>(c.lds, g, S, E); }
        else { NG g{HID, FF, p.in[I_WD] + (size_t)NE * FF * DM, nullptr, DM, (size_t)FF * DM, MR1, 0, NE * MR1, 0, DM, FF}; ngemm<1>(g, c, EpiGate{YS, GATE}); }
    } SEAM(18);
    if (IN(19)) for (int rep_ = 0; rep_ < 1 + (int)((PROBE_MASK >> 19) & 1u); ++rep_) { if (rep_) __syncthreads(); ph_combine(p, c, 1); }
    if (PROBE_PH == 19) pt1 = __builtin_amdgcn_s_memrealtime();
    if (PROBE_PH >= 0 && blockIdx.x == 0 && c.tid == 0) { const unsigned long long te = __builtin_amdgcn_s_memrealtime(); while (__builtin_amdgcn_s_memrealtime() - te < pt1 - pt0) __builtin_amdgcn_s_sleep(8); }
#undef IN
#undef SEAM
}

extern "C" void kernel_launch(void* const* d_in, const int* in_sizes, int n_in, void* d_out, int out_size, void* d_ws, size_t ws_size, hipStream_t stream) {
    static int grid = 0;
    if (grid == 0) {
        if (n_in != 26 || out_size != LAT * DM || ws_size < WS_END) { fprintf(stderr, "kernel_launch: unexpected shapes (n_in %d out %d ws %zu)\n", n_in, out_size, ws_size); grid = -1; return; }
        int dev = 0, cus = 0;
        if (hipGetDevice(&dev) != hipSuccess || hipDeviceGetAttribute(&cus, hipDeviceAttributeMultiprocessorCount, dev) != hipSuccess) { grid = -1; return; }
        if (hipFuncSetAttribute((const void*)mk_fwd, hipFuncAttributeMaxDynamicSharedMemorySize, LDS_BYTES) != hipSuccess) { fprintf(stderr, "kernel_launch: hipFuncSetAttribute failed\n"); grid = -1; return; }
        int per_cu = 0;
        if (hipOccupancyMaxActiveBlocksPerMultiprocessor(&per_cu, (const void*)mk_fwd, 512, LDS_BYTES) != hipSuccess || per_cu < 1) fprintf(stderr, "kernel_launch: occupancy query says %d\n", per_cu);
        (void)hipGetLastError();
        grid = cus;
    }
    if (grid < 0) return;
    (void)hipMemsetAsync((char*)d_ws + WS_CTL, 0, CTL_ZERO_BYTES, stream);
    Params a{};
    for (int i = 0; i < 26; ++i) a.in[i] = (const float*)d_in[i];
    a.out = (float*)d_out; a.ws = (unsigned char*)d_ws;
#if MK_MULTI
    for (int ph = 0; ph < NPHASE; ++ph) { a.ph_lo = ph; a.ph_hi = ph + 1; hipLaunchKernelGGL(mk_fwd, dim3(grid), dim3(512), LDS_BYTES, stream, a); }
#else
    a.ph_lo = 0; a.ph_hi = NPHASE;
    hipLaunchKernelGGL(mk_fwd, dim3(grid), dim3(512), LDS_BYTES, stream, a);
#endif
}
```

```cpp
#include <hip/hip_runtime.h>
#include <cstdio>
#include <cstdint>

#define GAS __attribute__((address_space(1)))
#define LAS __attribute__((address_space(3)))
typedef unsigned short bf16;
typedef unsigned v4u __attribute__((ext_vector_type(4)));
typedef unsigned v2u __attribute__((ext_vector_type(2)));
typedef float f32x4 __attribute__((ext_vector_type(4)));
typedef float f32x2 __attribute__((ext_vector_type(2)));
typedef float f32x16 __attribute__((ext_vector_type(16)));
typedef GAS unsigned gu32;

#ifndef PROBE_PH
#define PROBE_PH -1
#endif
#ifndef PROBE_MASK
#define PROBE_MASK 0u
#endif
#ifndef FUSE_QKV
#define FUSE_QKV 1
#endif
#ifndef MOE_FP8
#define MOE_FP8 1
#endif
#ifndef FAST_NA
#define FAST_NA 1
#endif
#ifndef FAST_ATTN
#define FAST_ATTN 1
#endif
#ifndef FAST_GEMM
#define FAST_GEMM 1
#endif
#ifndef MK_MULTI
#define MK_MULTI 0
#endif

constexpr int NBATCH = 8, SEQ = 2048, DM = 1024, NCTX = 256;
constexpr int LAT = NBATCH * SEQ;
constexpr int NTOK = LAT + NBATCH * NCTX;
constexpr int EIN = 2304, OIN = 2048, NE = 16, FF = 2048;
constexpr int MR0 = 2304, MR1 = 2048;
constexpr float LOG2E = 1.4426950408889634f;
constexpr float C2 = 0.125f * LOG2E;
constexpr float ALPHA = 1.4142135623730951f;
constexpr float LN_EPS = 1e-5f, RMS_EPS = 1e-6f;
constexpr float LAM_INIT = 0.2f;
constexpr int NPHASE = 20;
constexpr float W8_GU = 32.f, W8_DN = 64.f, H8_SC = 8.f;

constexpr size_t MiB = 1u << 20;
constexpr size_t WS_CTL = 0, CTL_ZERO_BYTES = 1 * MiB;
constexpr size_t WS_MOD = 1 * MiB;
constexpr size_t WS_ROPE = 1 * MiB + 512 * 1024;
constexpr size_t WS_W0IN = 2 * MiB;
constexpr size_t WS_W0OUT = 7 * MiB;
constexpr size_t WS_W1IN = 9 * MiB;
constexpr size_t WS_W1OUT = 13 * MiB;
constexpr size_t WS_AFF = 16 * MiB;
constexpr size_t WS_INV = 18 * MiB;
constexpr size_t WS_GATE = 20 * MiB;
constexpr size_t WS_WGU = 24 * MiB;
constexpr size_t WS_WDN = 152 * MiB;
constexpr size_t WS_MOE_LSTRIDE = 192 * MiB;
constexpr size_t WS_XS = 408 * MiB;
constexpr size_t WS_HB = 480 * MiB;
constexpr size_t WS_QKV = 516 * MiB;
constexpr size_t WS_CC = 597 * MiB;
constexpr size_t WS_AO = 633 * MiB;
constexpr size_t WS_Y = 705 * MiB;
constexpr size_t WS_XG = 516 * MiB;
constexpr size_t WS_HID = 588 * MiB;
constexpr size_t WS_YS = 732 * MiB;
constexpr size_t WS_PF = 804 * MiB;
constexpr size_t WS_END = 968 * MiB;

constexpr int CW_BAR = 4096;
constexpr int LDS_BYTES = 147456;
constexpr int MISC_OFF = 131072 + 320;

__device__ __forceinline__ float bf2f(unsigned v) { return __uint_as_float(v << 16); }
__device__ __forceinline__ unsigned f2bf(float f) { unsigned u = __float_as_uint(f); return (u + 0x7fffu + ((u >> 16) & 1u)) >> 16; }
__device__ __forceinline__ unsigned pk2(float lo, float hi) { return f2bf(lo) | (f2bf(hi) << 16); }
__device__ __forceinline__ float wave_sum(float v) {
#pragma unroll
    for (int o = 1; o < 64; o <<= 1) v += __shfl_xor(v, o);
    return v;
}
__device__ __forceinline__ float wave_max(float v) {
#pragma unroll
    for (int o = 1; o < 64; o <<= 1) v = fmaxf(v, __shfl_xor(v, o));
    return v;
}
__device__ __forceinline__ void unpack8(const v4u w, float* f) {
    f[0] = bf2f(w.x & 0xffffu); f[1] = __uint_as_float(w.x & 0xffff0000u);
    f[2] = bf2f(w.y & 0xffffu); f[3] = __uint_as_float(w.y & 0xffff0000u);
    f[4] = bf2f(w.z & 0xffffu); f[5] = __uint_as_float(w.z & 0xffff0000u);
    f[6] = bf2f(w.w & 0xffffu); f[7] = __uint_as_float(w.w & 0xffff0000u);
}

#define XB_TMO      128
#define XB_XCNT(j)  (256  + 64 * (j))
#define XB_XSUB(j)  (1280 + 64 * (j))
#define XB_XGEN(j)  (2304 + 64 * (j))
#define XB_TOP      3328
#define XB_TOPGEN   3392
#define XCD_BAR_WORDS 3456
#define XB_SPIN_CAP (1u << 18)
__device__ __forceinline__ unsigned xb_ld(unsigned* p)              { return __hip_atomic_load(p, __ATOMIC_RELAXED, __HIP_MEMORY_SCOPE_AGENT); }
__device__ __forceinline__ unsigned xb_add(unsigned* p, unsigned v) { return __hip_atomic_fetch_add(p, v, __ATOMIC_RELAXED, __HIP_MEMORY_SCOPE_AGENT); }
__device__ __forceinline__ unsigned xb_xcc_id() { return (unsigned)__builtin_amdgcn_s_getreg((3 << 11) | 20) & 0xFu; }
#define XB_SPIN(cond, bar) do { unsigned _sp = 0; while (cond) { __builtin_amdgcn_s_sleep(1); \
    if ((++_sp & 255u) == 0u) { if (xb_ld(&(bar)[XB_TMO])) break; if (_sp > XB_SPIN_CAP) { atomicAdd(&(bar)[XB_TMO], 1u); break; } } } } while (0)
struct XcdBarrier { unsigned* bar; unsigned x; volatile LAS unsigned* st; };
__device__ __forceinline__ XcdBarrier xcd_barrier_post(unsigned* bar, volatile LAS unsigned* st) {
    XcdBarrier b; b.bar = bar; b.x = xb_xcc_id(); b.st = st;
    if (threadIdx.x == 0) (void)xb_add(&bar[XB_XCNT(b.x)], 1u);
    return b;
}
__device__ __forceinline__ void xcd_barrier_complete(unsigned* bar, unsigned x, unsigned& nloc, unsigned& nx) {
    const unsigned G = gridDim.x * gridDim.y * gridDim.z;
    unsigned sum, cnt, mine, sp = 0u;
    for (;;) {
        sum = 0u; cnt = 0u; mine = 0u;
#pragma unroll
        for (unsigned j = 0; j < 16; ++j) { const unsigned c = xb_ld(&bar[XB_XCNT(j)]); sum += c; cnt += (c > 0u) ? 1u : 0u; mine = (j == x) ? c : mine; }
        if (sum == G) break;
        __builtin_amdgcn_s_sleep(1);
        if ((++sp & 255u) == 0u) { if (xb_ld(&bar[XB_TMO])) break; if (sp > XB_SPIN_CAP) { atomicAdd(&bar[XB_TMO], 1u); break; } }
    }
    nloc = mine > 0u ? mine : 1u; nx = cnt > 0u ? cnt : 1u;
}
__device__ __forceinline__ void xcd_barrier(const XcdBarrier& b) {
    asm volatile("s_waitcnt vmcnt(0)" ::: "memory");
    __syncthreads();
    if (threadIdx.x == 0) {
        unsigned* bar = b.bar;
        __builtin_amdgcn_s_waitcnt(0);
        unsigned nloc = b.st[0], nx = b.st[1];
        if (nloc == 0u) { xcd_barrier_complete(bar, b.x, nloc, nx); b.st[0] = nloc; b.st[1] = nx; }
        const unsigned old = xb_add(&bar[XB_XSUB(b.x)], 1u);
        const unsigned gen = old / nloc;
        if (old + 1u == (gen + 1u) * nloc) {
            __builtin_amdgcn_fence(__ATOMIC_RELEASE, "agent");
            asm volatile("s_waitcnt vmcnt(0)" ::: "memory");
            const unsigned og = xb_add(&bar[XB_TOP], 1u);
            const unsigned tg = og / nx;
            if (og + 1u == (tg + 1u) * nx) xb_add(&bar[XB_TOPGEN], 1u);
            else XB_SPIN(xb_ld(&bar[XB_TOPGEN]) == tg, bar);
            __builtin_amdgcn_fence(__ATOMIC_ACQUIRE, "agent");
            xb_add(&bar[XB_XGEN(b.x)], 1u);
            asm volatile("s_waitcnt vmcnt(0)" ::: "memory");
        } else {
            XB_SPIN(xb_ld(&bar[XB_XGEN(b.x)]) == gen, bar);
            __builtin_amdgcn_fence(__ATOMIC_ACQUIRE, "agent");
            asm volatile("s_waitcnt vmcnt(0)" ::: "memory");
        }
    }
    __syncthreads();
}

namespace pg8 {
#define PG8_LAS __attribute__((address_space(3)))
typedef unsigned short bf16_t;
typedef short bf16x8 __attribute__((ext_vector_type(8)));
typedef float f32x4 __attribute__((ext_vector_type(4)));
typedef unsigned u32x4 __attribute__((ext_vector_type(4)));
constexpr int BM = 256, BK = 64, HALF = 128, HTB = HALF * BK * 2  , STAGE_BYTES = 8 * HTB, NXCD = 8, WGM = 8;

__host__ __device__ __forceinline__ int lds_byte(int r, int c) { const int st = (r >> 4) * 2 + (c >> 5), rr = r & 15, cc = c & 31, ob = rr * 64 + cc * 2; return st * 1024 + (ob ^ (((ob >> 9) & 1) << 5)); }
__host__ __device__ __forceinline__ void stage_rc(int b, int& R, int& C) { const int st = b / 1024, sb = b % 1024, swz = sb ^ (((sb >> 9) & 1) << 5); R = (st >> 1) * 16 + swz / 64; C = (st & 1) * 32 + (swz % 64) / 2; }
__host__ __device__ __forceinline__ int perm32(int rho) { const int n = rho >> 4, i = rho & 15; return 8 * (i >> 2) + 4 * n + (i & 3); }

struct Unit { int pm, pn, e; };
struct Gemm { const bf16_t* A; const bf16_t* Bt; int M, N, K; size_t bstride; };

struct StaticOrder {
    int nM, nN, nwg, G, c;
    __host__ __device__ void init(int M, int N, int G_, int c_) { nM = M / BM; nN = N / BM; nwg = nM * nN; G = G_; c = c_; }
    __host__ __device__ bool next(int i, Unit& u) const {
        const long L = (long)i * G + c; if (L >= nwg) return false;
        int wgid = (int)L; { const int q = nwg / NXCD, r = nwg % NXCD, xcd = wgid % NXCD, off = wgid / NXCD; wgid = (xcd < r ? xcd * (q + 1) : r * (q + 1) + (xcd - r) * q) + off; }
        const int nig = WGM * nN, gid = wgid / nig, fm = gid * WGM, gsz = (nM - fm) < WGM ? (nM - fm) : WGM;
        u.pm = fm + ((wgid % nig) % gsz); u.pn = (wgid % nig) / gsz; u.e = 0; return true;
    }
    __device__ __forceinline__ void a_ready(const Unit&) const {}
    __device__ __forceinline__ void done(const Unit&) const {}
};

__device__ __forceinline__ unsigned cvt_pk_bf16(float lo, float hi) { unsigned r; asm volatile("v_cvt_pk_bf16_f32 %0, %1, %2" : "=v"(r) : "v"(lo), "v"(hi)); return r; }
typedef float f32x2 __attribute__((ext_vector_type(2)));
__device__ __forceinline__ f32x2 gelu_pk(f32x2 v) {
    const f32x2 av = __builtin_elementwise_abs(v), d = av * 0.2316418882f + 1.0f;
    f32x2 t; t.x = __builtin_amdgcn_rcpf(d.x); t.y = __builtin_amdgcn_rcpf(d.y);
    f32x2 q = t * 0.5307027145f + (-0.7265760135f); q = q * t + 0.7107068705f; q = q * t + (-0.142248368f); q = q * t + 0.127414796f; q = q * t;
    const f32x2 s = (v * v) * (-0.72134752044f);
    f32x2 e; e.x = __builtin_amdgcn_exp2f(s.x); e.y = __builtin_amdgcn_exp2f(s.y);
    const f32x2 m = v * (q * e), r = v - m;
    f32x2 o; o.x = v.x < 0.f ? m.x : r.x; o.y = v.y < 0.f ? m.y : r.y; return o;
}

template <int ACT  > struct EpiBf16 {
    static constexpr bool PERM = true, AFTER_DRAIN = false; static_assert(ACT == 0 || ACT == 1, "EpiBf16: ACT is 0 (none) or 1 (gelu_pk)");
    bf16_t* O; int ldc; const float* bias; int split_cols; size_t split_stride; float scale0;
    __device__ __forceinline__ void operator()(const f32x4 (&acc)[2][2][4][2], const Unit& u, int wr, int wc, int fr, int fq) const {
        const int row0 = u.pm * BM + wr * 64 + fr; int colt = u.pn * BM; bf16_t* base = O;
        float sc = 1.f; if (split_cols) { const int t = colt / split_cols; base += (size_t)t * split_stride; colt -= t * split_cols; if (t == 0) sc = scale0; }
        const int col0 = colt + wc * 32 + 8 * fq, bcol0 = u.pn * BM + wc * 32 + 8 * fq;
        f32x4 bv[2][2];
#pragma unroll
        for (int bj = 0; bj < 2; ++bj)
#pragma unroll
            for (int n = 0; n < 2; ++n) bv[bj][n] = bias ? *(const f32x4*)(bias + bcol0 + bj * HALF + 4 * n) : (f32x4){0.f, 0.f, 0.f, 0.f};
#pragma unroll
        for (int ai = 0; ai < 2; ++ai)
#pragma unroll
            for (int m = 0; m < 4; ++m) { bf16_t* rowp = base + (size_t)(row0 + ai * HALF + m * 16) * ldc + col0;
#pragma unroll
                for (int bj = 0; bj < 2; ++bj) { f32x4 v0 = acc[ai][bj][m][0] + bv[bj][0], v1 = acc[ai][bj][m][1] + bv[bj][1];
                    if (ACT == 1) { f32x2 a = gelu_pk((f32x2){v0[0], v0[1]}), b = gelu_pk((f32x2){v0[2], v0[3]}), c = gelu_pk((f32x2){v1[0], v1[1]}), d = gelu_pk((f32x2){v1[2], v1[3]});
                        v0 = (f32x4){a.x, a.y, b.x, b.y}; v1 = (f32x4){c.x, c.y, d.x, d.y}; }
                    v0 = v0 * sc; v1 = v1 * sc; u32x4 w; w.x = cvt_pk_bf16(v0[0], v0[1]); w.y = cvt_pk_bf16(v0[2], v0[3]); w.z = cvt_pk_bf16(v1[0], v1[1]); w.w = cvt_pk_bf16(v1[2], v1[3]);
                    *(u32x4*)(rowp + bj * HALF) = w; } }
    }
};

typedef int i32x4 __attribute__((ext_vector_type(4))); typedef int i32x8 __attribute__((ext_vector_type(8)));
__device__ __forceinline__ i32x8 cat16(bf16x8 lo, bf16x8 hi) { const i32x4 a = __builtin_bit_cast(i32x4, lo), b = __builtin_bit_cast(i32x4, hi); return __builtin_shufflevector(a, b, 0, 1, 2, 3, 4, 5, 6, 7); }
__device__ __forceinline__ void mfma_f8_acc(f32x4& acc, const i32x8& b, const i32x8& a, int sc) {
    asm volatile("v_mfma_scale_f32_16x16x128_f8f6f4 %0, %1, %2, %0, %3, %3 op_sel_hi:[0,0,0]" : "+v"(acc) : "v"(b), "v"(a), "v"(sc)); }
template <class Epi, class Sched, bool ALIGN_EPI = false, bool SP2 = false, bool FP8 = false>
__device__ __forceinline__ void gemm_phase(PG8_LAS unsigned char* lds, const Gemm g, const Sched& S, const Epi& E) {
    const int tid = threadIdx.x, wid = __builtin_amdgcn_readfirstlane(tid >> 6), lane = tid & 63, wr = wid >> 2, wc = wid & 3, fr = lane & 15, fq = lane >> 4;
    const int K = g.K, nt = K / BK;
    unsigned voffA[2], voffB[2];
#pragma unroll
    for (int i = 0; i < 2; ++i) { int R, C; stage_rc(tid * 16 + i * 8192, R, C); const int Rb = Epi::PERM ? ((R & ~31) + perm32(R & 31)) : R;
        voffA[i] = (unsigned)(R * K + C) * 2u; voffB[i] = (unsigned)(Rb * K + C) * 2u; }
    const size_t kstep = (size_t)(BK * 2);
    const size_t hstep = (size_t)HALF * K * 2;
    const size_t tstep = 2 * hstep;
    const unsigned ldsw = (unsigned)wid * 1024u;
    const int aoff = FP8 ? lds_byte(wr * 64 + fr, 16 * fq) : lds_byte(wr * 64 + fr, fq * 8), boff = FP8 ? lds_byte(wc * 32 + fr, 16 * fq) : lds_byte(wc * 32 + fr, fq * 8);
    constexpr int KOFF = FP8 ? 16 : 1024;
#define PG8_SA(b, h) (((b) * 2 + (h)) * HTB)
#define PG8_SB(b, h) ((4 + (b) * 2 + (h)) * HTB)
#define PG8_STAGE(bufoff, gbase, voff) do { _Pragma("unroll") for (int _i = 0; _i < 2; ++_i) \
        __builtin_amdgcn_global_load_lds((const unsigned*)((const char*)(gbase) + (voff)[_i]), (PG8_LAS unsigned*)(lds + (bufoff) + ldsw + _i * 8192), 16, 0, 0); } while (0)
#define PG8_LDA(dst, b, h) do { _Pragma("unroll") for (int m = 0; m < 4; ++m) _Pragma("unroll") for (int k = 0; k < 2; ++k) dst[m][k] = *(const PG8_LAS bf16x8*)(lds + PG8_SA(b, h) + aoff + m * 2048 + k * KOFF); } while (0)
#define PG8_LDB(dst, b, h) do { _Pragma("unroll") for (int n = 0; n < 2; ++n) _Pragma("unroll") for (int k = 0; k < 2; ++k) dst[n][k] = *(const PG8_LAS bf16x8*)(lds + PG8_SB(b, h) + boff + n * 2048 + k * KOFF); } while (0)
#define PG8_MMA(ai, bj, At, Bt) do { __builtin_amdgcn_s_setprio(1); _Pragma("unroll") for (int m = 0; m < 4; ++m) _Pragma("unroll") for (int n = 0; n < 2; ++n) { \
        if constexpr (FP8) mfma_f8_acc(acc[ai][bj][m][n], cat16(Bt[n][0], Bt[n][1]), cat16(At[m][0], At[m][1]), f8scale); \
        else { _Pragma("unroll") for (int k = 0; k < 2; ++k) acc[ai][bj][m][n] = __builtin_amdgcn_mfma_f32_16x16x32_bf16(Bt[n][k], At[m][k], acc[ai][bj][m][n], 0, 0, 0); } } __builtin_amdgcn_s_setprio(0); } while (0)
#define PG8_WAIT_V(n) asm volatile("s_waitcnt vmcnt(" #n ")" ::: "memory")
#define PG8_WAIT_L(n) asm volatile("s_waitcnt lgkmcnt(" #n ")" ::: "memory")
#define PG8_BAR __builtin_amdgcn_s_barrier()
#define PG8_SCHED __builtin_amdgcn_sched_barrier(0)
    Unit cur, nxt; int ui = 0;
    if (!S.next(0, cur)) return;
    f32x4 acc[2][2][4][2];
#pragma unroll
    for (int a = 0; a < 2; ++a)
#pragma unroll
        for (int b = 0; b < 2; ++b)
#pragma unroll
            for (int m = 0; m < 4; ++m)
#pragma unroll
                for (int n = 0; n < 2; ++n) acc[a][b][m][n] = (f32x4){0.f, 0.f, 0.f, 0.f};
    int f8scale = 0x7F7F7F7F; asm volatile("" : "+v"(f8scale));
    bf16x8 At[4][2], B0[2][2], B1[2][2];
    const char* cA = (const char*)g.A + (size_t)cur.pm * tstep; const char* cB = (const char*)g.Bt + (size_t)cur.pn * tstep + (size_t)cur.e * g.bstride;
    S.a_ready(cur);
    if constexpr (SP2) {
        PG8_STAGE(PG8_SB(0, 0), cB, voffB); PG8_STAGE(PG8_SB(0, 1), cB + hstep, voffB); PG8_STAGE(PG8_SA(0, 0), cA, voffA); PG8_STAGE(PG8_SA(0, 1), cA + hstep, voffA);
        if (wr == 1) PG8_BAR;
        PG8_WAIT_V(2); PG8_BAR;
        PG8_STAGE(PG8_SB(1, 0), cB + kstep, voffB); PG8_STAGE(PG8_SA(1, 0), cA + kstep, voffA); PG8_STAGE(PG8_SB(1, 1), cB + hstep + kstep, voffB);
        PG8_WAIT_V(6); PG8_BAR;
    } else {
        PG8_STAGE(PG8_SB(0, 0), cB, voffB); PG8_STAGE(PG8_SA(0, 0), cA, voffA); PG8_STAGE(PG8_SB(0, 1), cB + hstep, voffB); PG8_STAGE(PG8_SA(0, 1), cA + hstep, voffA);
        if (wr == 1) PG8_BAR;
        PG8_WAIT_V(4); PG8_BAR;
        PG8_STAGE(PG8_SB(1, 0), cB + kstep, voffB); PG8_STAGE(PG8_SA(1, 0), cA + kstep, voffA); PG8_STAGE(PG8_SB(1, 1), cB + hstep + kstep, voffB);
        PG8_WAIT_V(6); PG8_BAR;
    }
    for (;;) {
        const bool has_next = S.next(ui + 1, nxt);
        const char* nA = has_next ? (const char*)g.A + (size_t)nxt.pm * tstep : cA; const char* nB = has_next ? (const char*)g.Bt + (size_t)nxt.pn * tstep + (size_t)nxt.e * g.bstride : cB;
        for (int t = 0; t < nt; t += 2) {
            const bool last = (t == nt - 2);
            const char* a1 = cA + (size_t)(t + 1) * kstep;
            const char* a2 = last ? nA : cA + (size_t)(t + 2) * kstep; const char* b2 = last ? nB : cB + (size_t)(t + 2) * kstep;
            const char* a3 = a2 + kstep; const char* b3 = b2 + kstep;
            if (last && has_next) S.a_ready(nxt);
            if constexpr (SP2) {
            PG8_LDB(B0, 0, 0); PG8_LDB(B1, 0, 1); PG8_SCHED; PG8_LDA(At, 0, 0); PG8_STAGE(PG8_SA(1, 1), a1 + hstep, voffA);
            PG8_WAIT_V(8); PG8_WAIT_L(0); PG8_BAR; PG8_MMA(0, 0, At, B0); PG8_MMA(0, 1, At, B1); PG8_BAR; PG8_SCHED;
            PG8_LDA(At, 0, 1); PG8_STAGE(PG8_SB(0, 0), b2, voffB); PG8_STAGE(PG8_SB(0, 1), b2 + hstep, voffB); PG8_STAGE(PG8_SA(0, 0), a2, voffA);
            PG8_WAIT_V(8); PG8_WAIT_L(0); PG8_BAR; PG8_MMA(1, 0, At, B0); PG8_MMA(1, 1, At, B1); PG8_BAR; PG8_SCHED;
            PG8_LDB(B0, 1, 0); PG8_LDB(B1, 1, 1); PG8_SCHED; PG8_LDA(At, 1, 0); PG8_STAGE(PG8_SA(0, 1), a2 + hstep, voffA);
            PG8_WAIT_V(8); PG8_WAIT_L(0); PG8_BAR; PG8_MMA(0, 0, At, B0); PG8_MMA(0, 1, At, B1); PG8_BAR; PG8_SCHED;
            PG8_LDA(At, 1, 1); PG8_STAGE(PG8_SB(1, 0), b3, voffB); PG8_STAGE(PG8_SB(1, 1), b3 + hstep, voffB); PG8_STAGE(PG8_SA(1, 0), a3, voffA);
            PG8_WAIT_V(8); PG8_WAIT_L(0); PG8_BAR; PG8_MMA(1, 0, At, B0); PG8_MMA(1, 1, At, B1); PG8_BAR; PG8_SCHED;
            } else {
            PG8_LDB(B0, 0, 0); PG8_SCHED; PG8_LDA(At, 0, 0); PG8_STAGE(PG8_SA(1, 1), a1 + hstep, voffA);
            PG8_WAIT_L(8); PG8_BAR; PG8_WAIT_L(0); PG8_MMA(0, 0, At, B0); PG8_BAR; PG8_SCHED;
            PG8_LDB(B1, 0, 1); PG8_STAGE(PG8_SB(0, 0), b2, voffB);
            PG8_BAR; PG8_WAIT_L(0); PG8_MMA(0, 1, At, B1); PG8_BAR;
            PG8_LDA(At, 0, 1); PG8_STAGE(PG8_SA(0, 0), a2, voffA);
            PG8_BAR; PG8_WAIT_L(0); PG8_MMA(1, 0, At, B0); PG8_BAR; PG8_SCHED;
            PG8_STAGE(PG8_SB(0, 1), b2 + hstep, voffB);
            PG8_WAIT_V(6); PG8_BAR; PG8_MMA(1, 1, At, B1); PG8_BAR;
            PG8_LDB(B0, 1, 0); PG8_SCHED; PG8_LDA(At, 1, 0); PG8_STAGE(PG8_SA(0, 1), a2 + hstep, voffA);
            PG8_WAIT_L(8); PG8_BAR; PG8_WAIT_L(0); PG8_MMA(0, 0, At, B0); PG8_BAR; PG8_SCHED;
            PG8_LDB(B1, 1, 1); PG8_STAGE(PG8_SB(1, 0), b3, voffB);
            PG8_BAR; PG8_WAIT_L(0); PG8_MMA(0, 1, At, B1); PG8_BAR;
            PG8_LDA(At, 1, 1); PG8_STAGE(PG8_SA(1, 0), a3, voffA);
            PG8_BAR; PG8_WAIT_L(0); PG8_MMA(1, 0, At, B0); PG8_BAR; PG8_SCHED;
            PG8_STAGE(PG8_SB(1, 1), b3 + hstep, voffB);
            PG8_WAIT_V(6); PG8_BAR; PG8_MMA(1, 1, At, B1); PG8_BAR;
            }
        }
        if constexpr (ALIGN_EPI) { if (wr == 0) PG8_BAR; }
        if constexpr (FP8) asm volatile("s_nop 15\n\ts_nop 15" : "+v"(acc[1][1][0][0]), "+v"(acc[1][1][0][1]), "+v"(acc[1][1][1][0]), "+v"(acc[1][1][1][1]), "+v"(acc[1][1][2][0]), "+v"(acc[1][1][2][1]), "+v"(acc[1][1][3][0]), "+v"(acc[1][1][3][1]));
        if constexpr (!Epi::AFTER_DRAIN) { E(acc, cur, wr, wc, fr, fq); S.done(cur); }
        if (!has_next) break;
#pragma unroll
        for (int a = 0; a < 2; ++a)
#pragma unroll
            for (int b = 0; b < 2; ++b)
#pragma unroll
                for (int m = 0; m < 4; ++m)
#pragma unroll
                    for (int n = 0; n < 2; ++n) acc[a][b][m][n] = (f32x4){0.f, 0.f, 0.f, 0.f};
        cur = nxt; cA = nA; cB = nB; ++ui;
        if constexpr (ALIGN_EPI) { if (wr == 1) PG8_BAR; }
    }
    PG8_WAIT_V(0);
    if constexpr (!ALIGN_EPI) { if (wr == 0) PG8_BAR; }
    PG8_BAR;
    if constexpr (Epi::AFTER_DRAIN) { E.fused(acc, cur, wr, wc, fr, fq, lds, wid, lane); S.done(cur); }
#undef PG8_SA
#undef PG8_SB
#undef PG8_STAGE
#undef PG8_LDA
#undef PG8_LDB
#undef PG8_MMA
#undef PG8_WAIT_V
#undef PG8_WAIT_L
#undef PG8_BAR
#undef PG8_SCHED
}
}

namespace pg8 {
struct EpiF32P {
    static constexpr bool PERM = false, AFTER_DRAIN = false;
    float* O; int ldc;
    __device__ __forceinline__ void operator()(const f32x4 (&acc)[2][2][4][2], const Unit& u, int wr, int wc, int fr, int fq) const {
        const int row0 = u.pm * BM + wr * 64 + fr, col0 = u.pn * BM + wc * 32 + 4 * fq;
#pragma unroll
        for (int ai = 0; ai < 2; ++ai)
#pragma unroll
            for (int m = 0; m < 4; ++m) { float* rowp = O + (size_t)(row0 + ai * HALF + m * 16) * ldc + col0;
#pragma unroll
                for (int bj = 0; bj < 2; ++bj)
#pragma unroll
                    for (int n = 0; n < 2; ++n) *(f32x4*)(rowp + bj * HALF + n * 16) = acc[ai][bj][m][n]; }
    }
};
struct EpiSwigluP {
    static constexpr bool PERM = true, AFTER_DRAIN = false;
    bf16_t* O; int ldc;
    __device__ __forceinline__ void operator()(const f32x4 (&acc)[2][2][4][2], const Unit& u, int wr, int wc, int fr, int fq) const {
        const int row0 = u.pm * BM + wr * 64 + fr, col0 = u.pn * HALF + wc * 32 + 8 * fq;
#pragma unroll
        for (int ai = 0; ai < 2; ++ai)
#pragma unroll
            for (int m = 0; m < 4; ++m) {
                float h[8];
#pragma unroll
                for (int n = 0; n < 2; ++n)
#pragma unroll
                    for (int j = 0; j < 4; ++j) { const float g = acc[ai][0][m][n][j], up = acc[ai][1][m][n][j];
                        h[4 * n + j] = g * up * __builtin_amdgcn_rcpf(1.0f + __builtin_amdgcn_exp2f(-1.4426950408889634f * g)); }
                u32x4 w; w.x = cvt_pk_bf16(h[0], h[1]); w.y = cvt_pk_bf16(h[2], h[3]); w.z = cvt_pk_bf16(h[4], h[5]); w.w = cvt_pk_bf16(h[6], h[7]);
                *(u32x4*)(O + (size_t)(row0 + ai * HALF + m * 16) * ldc + col0) = w; }
    }
};
struct EpiGateP {
    static constexpr bool PERM = true, AFTER_DRAIN = false;
    bf16_t* O; int ldc; const float* gate;
    __device__ __forceinline__ void operator()(const f32x4 (&acc)[2][2][4][2], const Unit& u, int wr, int wc, int fr, int fq) const {
        const int row0 = u.pm * BM + wr * 64 + fr, col0 = u.pn * BM + wc * 32 + 8 * fq;
#pragma unroll
        for (int ai = 0; ai < 2; ++ai)
#pragma unroll
            for (int m = 0; m < 4; ++m) { const int row = row0 + ai * HALF + m * 16; const float gt = gate[row]; bf16_t* rowp = O + (size_t)row * ldc + col0;
#pragma unroll
                for (int bj = 0; bj < 2; ++bj) { const f32x4 v0 = acc[ai][bj][m][0] * gt, v1 = acc[ai][bj][m][1] * gt;
                    u32x4 w; w.x = cvt_pk_bf16(v0[0], v0[1]); w.y = cvt_pk_bf16(v0[2], v0[3]); w.z = cvt_pk_bf16(v1[0], v1[1]); w.w = cvt_pk_bf16(v1[2], v1[3]);
                    *(u32x4*)(rowp + bj * HALF) = w; } }
    }
};
__device__ __forceinline__ unsigned pk4_fp8(float a, float b, float c, float d) {
    a = __builtin_fminf(__builtin_fmaxf(a, -448.f), 448.f); b = __builtin_fminf(__builtin_fmaxf(b, -448.f), 448.f);
    c = __builtin_fminf(__builtin_fmaxf(c, -448.f), 448.f); d = __builtin_fminf(__builtin_fmaxf(d, -448.f), 448.f);
    int w = 0; w = __builtin_amdgcn_cvt_pk_fp8_f32(a, b, w, false); w = __builtin_amdgcn_cvt_pk_fp8_f32(c, d, w, true); return (unsigned)w; }
struct EpiSwigluF8 {
    static constexpr bool PERM = true, AFTER_DRAIN = false;
    unsigned char* O; int ldc; float ws, hs;
    __device__ __forceinline__ void operator()(const f32x4 (&acc)[2][2][4][2], const Unit& u, int wr, int wc, int fr, int fq) const {
        const int row0 = u.pm * BM + wr * 64 + fr, col0 = u.pn * HALF + wc * 32 + 8 * fq;
#pragma unroll
        for (int ai = 0; ai < 2; ++ai)
#pragma unroll
            for (int m = 0; m < 4; ++m) {
                float h[8];
#pragma unroll
                for (int n = 0; n < 2; ++n)
#pragma unroll
                    for (int j = 0; j < 4; ++j) { const float g = acc[ai][0][m][n][j] * ws, up = acc[ai][1][m][n][j] * ws;
                        h[4 * n + j] = g * up * hs * __builtin_amdgcn_rcpf(1.0f + __builtin_amdgcn_exp2f(-1.4426950408889634f * g)); }
                typedef unsigned u32x2 __attribute__((ext_vector_type(2)));
                *(u32x2*)(O + (size_t)(row0 + ai * HALF + m * 16) * ldc + col0) = (u32x2){pk4_fp8(h[0], h[1], h[2], h[3]), pk4_fp8(h[4], h[5], h[6], h[7])}; }
    }
};
struct EpiGateS {
    static constexpr bool PERM = true, AFTER_DRAIN = false;
    bf16_t* O; int ldc; const float* gate; float sc;
    __device__ __forceinline__ void operator()(const f32x4 (&acc)[2][2][4][2], const Unit& u, int wr, int wc, int fr, int fq) const {
        const int row0 = u.pm * BM + wr * 64 + fr, col0 = u.pn * BM + wc * 32 + 8 * fq;
#pragma unroll
        for (int ai = 0; ai < 2; ++ai)
#pragma unroll
            for (int m = 0; m < 4; ++m) { const int row = row0 + ai * HALF + m * 16; const float gt = gate[row] * sc; bf16_t* rowp = O + (size_t)row * ldc + col0;
#pragma unroll
                for (int bj = 0; bj < 2; ++bj) { const f32x4 v0 = acc[ai][bj][m][0] * gt, v1 = acc[ai][bj][m][1] * gt;
                    u32x4 w; w.x = cvt_pk_bf16(v0[0], v0[1]); w.y = cvt_pk_bf16(v0[2], v0[3]); w.z = cvt_pk_bf16(v1[0], v1[1]); w.w = cvt_pk_bf16(v1[2], v1[3]);
                    *(u32x4*)(rowp + bj * HALF) = w; } }
    }
};
struct EpiQKV {
    static constexpr bool PERM = true, AFTER_DRAIN = false;
    bf16_t* O; int ldc; const float* rope; const float* qn; const float* kn; float qscale; float rms_eps;
    __device__ __forceinline__ void operator()(const f32x4 (&acc)[2][2][4][2], const Unit& u, int wr, int wc, int fr, int fq) const {
        const int hs = 4 * u.pn + wc;
        const bool isq = hs < 8 || (hs >= 24 && hs < 32), isk = (hs >= 8 && hs < 16) || hs == 32 || hs == 33, nrm = hs >= 24 && hs < 34;
        const bool rope_on = (isq || isk) && u.pm < 64;
        const float osc = isq ? qscale : 1.f;
        const bool first = fq < 2;
        f32x4 gv[2][2];
#pragma unroll
        for (int bj = 0; bj < 2; ++bj)
#pragma unroll
            for (int n = 0; n < 2; ++n) gv[bj][n] = nrm ? *(const f32x4*)((hs < 32 ? qn : kn) + 32 * bj + 8 * fq + 4 * n) : (f32x4){1.f, 1.f, 1.f, 1.f};
#pragma unroll
        for (int ai = 0; ai < 2; ++ai)
#pragma unroll
            for (int m = 0; m < 4; ++m) {
                const int row = u.pm * BM + ai * HALF + wr * 64 + m * 16 + fr;
                f32x4 v[2][2];
#pragma unroll
                for (int bj = 0; bj < 2; ++bj)
#pragma unroll
                    for (int n = 0; n < 2; ++n) v[bj][n] = acc[ai][bj][m][n];
                if (nrm) {
                    float ss = 0.f;
#pragma unroll
                    for (int bj = 0; bj < 2; ++bj)
#pragma unroll
                        for (int n = 0; n < 2; ++n) ss += (v[bj][n][0] * v[bj][n][0] + v[bj][n][1] * v[bj][n][1]) + (v[bj][n][2] * v[bj][n][2] + v[bj][n][3] * v[bj][n][3]);
                    ss += __shfl_xor(ss, 16); ss += __shfl_xor(ss, 32);
                    const float r = __builtin_amdgcn_rsqf(ss * (1.f / 64.f) + rms_eps);
#pragma unroll
                    for (int bj = 0; bj < 2; ++bj)
#pragma unroll
                        for (int n = 0; n < 2; ++n) v[bj][n] = v[bj][n] * r * gv[bj][n];
                }
                if (rope_on) {
                    const int t = row & 2047;
#pragma unroll
                    for (int bj = 0; bj < 2; ++bj) {
                        const int pos = bj ? (t & 63) : (t >> 6);
#pragma unroll
                        for (int n = 0; n < 2; ++n) {
                            const float* cp = rope + (size_t)(pos * 16 + 8 * (fq & 1) + 4 * n) * 2;
                            const f32x4 c01 = *(const f32x4*)cp, c23 = *(const f32x4*)(cp + 4);
                            const float cs[4] = {c01[0], c01[2], c23[0], c23[2]}, sn[4] = {c01[1], c01[3], c23[1], c23[3]};
#pragma unroll
                            for (int j = 0; j < 4; ++j) { const float x = v[bj][n][j], pr = __shfl_xor(x, 32); v[bj][n][j] = first ? x * cs[j] - pr * sn[j] : x * cs[j] + pr * sn[j]; }
                        }
                    }
                }
                bf16_t* rowp = O + (size_t)row * ldc + hs * 64 + 8 * fq;
#pragma unroll
                for (int bj = 0; bj < 2; ++bj) { const f32x4 v0 = v[bj][0] * osc, v1 = v[bj][1] * osc;
                    u32x4 w; w.x = cvt_pk_bf16(v0[0], v0[1]); w.y = cvt_pk_bf16(v0[2], v0[3]); w.z = cvt_pk_bf16(v1[0], v1[1]); w.w = cvt_pk_bf16(v1[2], v1[3]);
                    *(u32x4*)(rowp + 32 * bj) = w; }
            }
    }
};
struct GroupedOrder {
    int nMe, nN, ntot, G, c;
    __device__ void init(int nMe_, int nN_, int ne, int G_, int c_) { nMe = nMe_; nN = nN_; ntot = nMe_ * nN_ * ne; G = G_; c = c_; }
    __device__ bool next(int i, Unit& u) const {
        const int L = i * G + c; if (L >= ntot) return false;
        const int per = nMe * nN, e = L / per, rem = L - e * per;
        u.e = e; u.pn = rem / nMe; u.pm = e * nMe + (rem - u.pn * nMe); return true;
    }
    __device__ __forceinline__ void a_ready(const Unit&) const {}
    __device__ __forceinline__ void done(const Unit&) const {}
};
struct L1InOrder {
    StaticOrder so; int G, c;
    __device__ void init(int G_, int c_) { so.init(16384, 2048, G_, 0); G = G_; c = c_; }
    __device__ bool next(int i, Unit& u) const {
        const int L = i * G + c;
        if (L < 512) { StaticOrder t = so; t.G = 1; t.c = 0; return t.next(L, u); }
        if (L < 544) { const int l = L - 512; u.pm = 64 + (l >> 2); u.pn = 2 + (l & 3); u.e = 0; return true; }
        return false;
    }
    __device__ __forceinline__ void a_ready(const Unit&) const {}
    __device__ __forceinline__ void done(const Unit&) const {}
};
}

#include <hip/hip_bf16.h>
#include <cmath>
namespace attn_body {
using bf16=__hip_bfloat16;
using bf16x8=__attribute__((ext_vector_type(8)))short;
using s16x4=__attribute__((ext_vector_type(4)))short;
using f32x16=__attribute__((ext_vector_type(16)))float;
using u32x4=__attribute__((ext_vector_type(4)))unsigned;
constexpr int D=64,OPITCH=1024;
constexpr int NW=8,QBLK=32,QB=QBLK*NW,KVBLK=64;
__device__ __forceinline__ int crow(int r,int hi){return (r&3)+8*(r>>2)+4*hi;}
#define SBAR() __builtin_amdgcn_sched_barrier(0)
__device__ __forceinline__ void cmask(f32x16&p0,f32x16&p1,int jb,int qrel,int hi){
  const float NEG=-INFINITY; int kb=64*jb+4*hi;
  #pragma unroll
  for(int r=0;r<16;++r){int kv=kb+(r&3)+8*(r>>2); if(kv>qrel)p0[r]=NEG; if(kv+32>qrel)p1[r]=NEG;}
}

constexpr int NSLOT=3, SLOTB=8192;
constexpr int LDS_K=0, LDS_V=NSLOT*SLOTB, LDS_WS=2*NSLOT*SLOTB, LDS_OST=LDS_WS+NW*64*4, LDS_BYTES=LDS_OST+NW*4096;
constexpr float C2=0.125f*1.4426950408889634f;
__device__ __forceinline__ void glds16(const void*gsrc,unsigned lds_dst){unsigned keep;
  asm volatile("s_mov_b32 %0, m0\n\ts_mov_b32 m0, %2\n\ts_nop 0\n\tglobal_load_lds_dwordx4 %1, off\n\ts_mov_b32 m0, %0":"=&s"(keep):"v"(gsrc),"s"(lds_dst):"memory");}
__device__ __forceinline__ float max3f(float a,float b,float c){float r;asm("v_max3_f32 %0, %1, %2, %3":"=v"(r):"v"(a),"v"(b),"v"(c));return r;}
__device__ __forceinline__ float max2f(float a,float b){float r;asm("v_max_f32_e32 %0, %1, %2":"=v"(r):"v"(a),"v"(b));return r;}
__device__ __forceinline__ float fadd_s(float a,float b){float r;asm("v_add_f32_e32 %0, %1, %2":"=v"(r):"v"(a),"v"(b));return r;}
__device__ __forceinline__ float fsub_s(float a,float b){float r;asm("v_sub_f32_e32 %0, %1, %2":"=v"(r):"v"(a),"v"(b));return r;}
typedef float f32x2_t __attribute__((ext_vector_type(2))); typedef __bf16 bf16x2_t __attribute__((ext_vector_type(2)));
__device__ __forceinline__ unsigned cvtpk_s(float lo,float hi){f32x2_t v={lo,hi};bf16x2_t b=__builtin_convertvector(v,bf16x2_t);return __builtin_bit_cast(unsigned,b);}
#define WAIT_BAR(N) asm volatile("s_waitcnt vmcnt(" #N ") lgkmcnt(0)\n\ts_barrier":::"memory")

__device__ __forceinline__ void qkt(f32x16&p0,f32x16&p1,const char*Kslot,const bf16x8*qr,const f32x16&negm,int r32,int hi){
  const char*kb=Kslot+hi*1024+r32*16;
  #pragma unroll
  for(int d0=0;d0<4;++d0){
    const bf16x8 b0=*reinterpret_cast<const bf16x8*>(kb+d0*2048);
    const bf16x8 b1=*reinterpret_cast<const bf16x8*>(kb+d0*2048+512);
    if(d0==0){p0=__builtin_amdgcn_mfma_f32_32x32x16_bf16(b0,qr[0],negm,0,0,0);p1=__builtin_amdgcn_mfma_f32_32x32x16_bf16(b1,qr[0],negm,0,0,0);}
    else{p0=__builtin_amdgcn_mfma_f32_32x32x16_bf16(b0,qr[d0],p0,0,0,0);p1=__builtin_amdgcn_mfma_f32_32x32x16_bf16(b1,qr[d0],p1,0,0,0);}}
}
typedef __attribute__((address_space(3))) const char* lds_cptr;
typedef short v4i16_t __attribute__((ext_vector_type(4)));
__device__ __forceinline__ void kload8(bf16x8*kf,lds_cptr kp){
  kf[0]=*(const __attribute__((address_space(3))) bf16x8*)(kp);      kf[1]=*(const __attribute__((address_space(3))) bf16x8*)(kp+512);
  kf[2]=*(const __attribute__((address_space(3))) bf16x8*)(kp+2048); kf[3]=*(const __attribute__((address_space(3))) bf16x8*)(kp+2560);
  kf[4]=*(const __attribute__((address_space(3))) bf16x8*)(kp+4096); kf[5]=*(const __attribute__((address_space(3))) bf16x8*)(kp+4608);
  kf[6]=*(const __attribute__((address_space(3))) bf16x8*)(kp+6144); kf[7]=*(const __attribute__((address_space(3))) bf16x8*)(kp+6656);
}
__device__ __forceinline__ void kload2(bf16x8*kf,lds_cptr kp,int j){ kf[2*j]=*(const __attribute__((address_space(3))) bf16x8*)(kp+j*2048); kf[2*j+1]=*(const __attribute__((address_space(3))) bf16x8*)(kp+j*2048+512); }
__device__ __forceinline__ s16x4 vtr(lds_cptr p){ return __builtin_bit_cast(s16x4,__builtin_amdgcn_ds_read_tr16_b64_v4i16((__attribute__((address_space(3))) v4i16_t*)p)); }
__device__ __forceinline__ float rowmax(const f32x16&p0,const f32x16&p1){
  float a=max3f(p0[0],p0[1],p1[0]),b=max3f(p0[2],p0[3],p1[1]);a=max3f(a,p1[2],p1[3]);
  #pragma unroll
  for(int r=4;r<16;r+=4){a=max3f(a,p0[r],p0[r+1]);b=max3f(b,p0[r+2],p0[r+3]);a=max3f(a,p1[r],p1[r+1]);b=max3f(b,p1[r+2],p1[r+3]);}
  const float m=max2f(a,b);
  auto rr=__builtin_amdgcn_permlane32_swap(__float_as_uint(m),__float_as_uint(m),false,false);
  return max2f(__uint_as_float(rr[0]),__uint_as_float(rr[1]));
}
__device__ __forceinline__ void pv(f32x16*o,int vb,bf16x8 pa0,bf16x8 pa1,bf16x8 pa2,bf16x8 pa3){
  #pragma unroll
  for(int d0=0;d0<2;++d0){s16x4 lo[4],hi[4];
    #pragma unroll
    for(int ks=0;ks<4;++ks){
      asm volatile("ds_read_b64_tr_b16 %0,%1 offset:%c2":"=&v"(lo[ks]):"v"(vb),"i"(d0*4096+ks*1024):"memory");
      asm volatile("ds_read_b64_tr_b16 %0,%1 offset:%c2":"=&v"(hi[ks]):"v"(vb),"i"(d0*4096+ks*1024+512):"memory");}
    asm volatile("s_waitcnt lgkmcnt(0)":::"memory");SBAR();
    #define PK(k) (bf16x8){lo[k][0],lo[k][1],lo[k][2],lo[k][3],hi[k][0],hi[k][1],hi[k][2],hi[k][3]}
    o[d0]=__builtin_amdgcn_mfma_f32_32x32x16_bf16(pa0,PK(0),o[d0],0,0,0);
    o[d0]=__builtin_amdgcn_mfma_f32_32x32x16_bf16(pa1,PK(1),o[d0],0,0,0);
    o[d0]=__builtin_amdgcn_mfma_f32_32x32x16_bf16(pa2,PK(2),o[d0],0,0,0);
    o[d0]=__builtin_amdgcn_mfma_f32_32x32x16_bf16(pa3,PK(3),o[d0],0,0,0);
    #undef PK
  }
}

#ifndef ATTN_STORE16
#define ATTN_STORE16(p,v) (*(u32x4*)(p)=(v))
#endif
struct AU { const bf16* Qp; const bf16* Kp; const bf16* Vp; bf16* Op; int qrow0, lat_row0, ctx_row0, nlat_t, NT; };
struct NoMask { __device__ __forceinline__ void apply(f32x16&,f32x16&,int,int)const{} };
typedef __attribute__((address_space(3))) const float* lds_cfptr;
struct NAMask { lds_cfptr tb0; int r, rs, rs_min, cb;
  __device__ __forceinline__ void apply(f32x16&p0,f32x16&p1,int t,int hi)const{
    if(t<4)return;
    const int kr=rs_min+t-4; const float NEG=-INFINITY;
    if((unsigned)(kr-rs)>7u){
      #pragma unroll
      for(int i=0;i<16;++i){p0[i]=NEG;p1[i]=NEG;}
      return; }
    const lds_cfptr tb=tb0+(kr-r+7)*32+4*hi;
    #pragma unroll
    for(int i=0;i<16;++i){ const int k0=(i&3)+8*(i>>2); const int d0=cb+k0, d1=cb+k0+32;
      const float b0=tb[k0], b1=tb[k0+32];
      p0[i]=((unsigned)d0<=15u)?p0[i]+b0:NEG; p1[i]=((unsigned)d1<=15u)?p1[i]+b1:NEG; }
  }
};
template<int THRL,int PITCH,class MaskT> __device__ __forceinline__ void attn_unit(const AU& u,char*shm,const MaskT& mk){
  const int tid=threadIdx.x,lane=tid&63,r32=lane&31,hi=lane>>5; const int wid=__builtin_amdgcn_readfirstlane(tid>>6);
  const bf16*Qw=u.Qp+(long)(u.qrow0+wid*QBLK)*PITCH;
  const bf16*Kh=u.Kp,*Vh=u.Vp;
  const unsigned lds0=(unsigned)(uintptr_t)shm;
  float*wsf=(float*)(shm+LDS_WS)+wid*64;
  const bf16*ksrc=Kh+(long)lane*PITCH+wid*8;
  const bf16*vsrc=Vh+(long)(16*(wid&3)+(lane>>2))*PITCH+(wid>>2)*32+(lane&3)*8;
  const unsigned kdst=lds0+LDS_K+wid*1024, vdst=lds0+LDS_V+wid*1024;
  #define TROW(t) ((long)((t)<u.nlat_t?u.lat_row0+KVBLK*(t):u.ctx_row0+KVBLK*((t)-u.nlat_t))*PITCH)
  #define DMA_K(t,slot) glds16(ksrc+TROW(t),(unsigned)__builtin_amdgcn_readfirstlane(kdst+(slot)))
  #define DMA_V(t,slot) glds16(vsrc+TROW(t),(unsigned)__builtin_amdgcn_readfirstlane(vdst+(slot)))
  const int vb0=(int)(lds0+LDS_V)+((lane>>4)&1)*32+(lane&3)*8+(4*hi+((lane&15)>>2))*64;
  const char*Kbase=shm+LDS_K; bf16x8 kf[8];
  const lds_cptr shm3=(lds_cptr)shm; const lds_cptr kp0=shm3+LDS_K+hi*1024+r32*16; const lds_cptr vp0=shm3+LDS_V+((lane>>4)&1)*32+(lane&3)*8+(4*hi+((lane&15)>>2))*64;
  const int NT=u.NT;
  DMA_K(0,0);DMA_V(0,0);DMA_K(1,SLOTB);
  bf16x8 qr[4];
  #pragma unroll
  for(int d0=0;d0<4;++d0)qr[d0]=*reinterpret_cast<const bf16x8*>(&Qw[(long)r32*PITCH+d0*16+hi*8]);
  float mhat=0.f,l_reg=0.f;f32x16 o[2];o[0]=f32x16{};o[1]=f32x16{};f32x16 negm=f32x16{};asm volatile("":"+v"(negm));
  #define CMASK(P0,P1,t) mk.apply(P0,P1,(t),hi)
  bool resc=false;
  #define START(P0,P1) do{ const float rm=rowmax(P0,P1); resc=false; \
    { const float dl=rm; mhat=fadd_s(mhat,dl); \
      _Pragma("unroll") for(int r=0;r<16;++r){P0[r]=fsub_s(P0[r],dl);P1[r]=fsub_s(P1[r],dl);} \
      _Pragma("unroll") for(int r=0;r<16;++r)negm[r]=-mhat; asm volatile("":"+v"(negm)); } \
    _Pragma("unroll") for(int r=0;r<16;++r)P0[r]=__builtin_amdgcn_exp2f(P0[r]); }while(0)
  #define RESC() do{ if(resc){ asm volatile("s_waitcnt lgkmcnt(0)":::"memory"); \
      _Pragma("unroll") for(int d_=0;d_<2;++d_) _Pragma("unroll") for(int r=0;r<16;++r)o[d_][r]*=wsf[crow(r,hi)]; } }while(0)
  f32x16 pA0,pA1,pB0,pB1;
  int sl_prev=0,sl_cur=0,sl_next=SLOTB;
  #define ROT() do{sl_prev=sl_cur;sl_cur=sl_next;sl_next=(sl_next==(NSLOT-1)*SLOTB)?0:sl_next+SLOTB;}while(0)
  DMA_K(2,2*SLOTB);
  WAIT_BAR(3);
  qkt(pA0,pA1,Kbase,qr,negm,r32,hi);asm volatile("s_nop 15\n\ts_nop 7":"+v"(pA0),"+v"(pA1));CMASK(pA0,pA1,0);
  START(pA0,pA1);
  _Pragma("unroll") for(int r=0;r<16;++r)pA1[r]=__builtin_amdgcn_exp2f(pA1[r]);
  WAIT_BAR(0);
  DMA_K(3,0);DMA_V(1,SLOTB);
  ROT();
  kload8(kf,kp0+sl_cur);
  WAIT_BAR(2);
  s16x4 vlo[8],vhi[8]; u32x4 pw0,pw1,pw2,pw3;
  #define PKW(P,B) cvtpk_s(P[B],P[B+1])
  #define PAF(k) __builtin_bit_cast(bf16x8,pw##k)
  #define VFR(i) (bf16x8){vlo[i][0],vlo[i][1],vlo[i][2],vlo[i][3],vhi[i][0],vhi[i][1],vhi[i][2],vhi[i][3]}
  #define PIN(x) asm volatile("":"+v"(x))
  #define MX3(a,b,c) __builtin_fmaxf(__builtin_fmaxf((a),(b)),(c))
  #define GAPA(MF,A0,A1,A2,A3,W0,W1,PW) do{ MF; sacc+=A0; sacc+=A1; sacc+=A2; sacc+=A3; PIN(sacc); W0; W1; PIN(PW); SBAR(); }while(0)
  #define EX(v) __builtin_amdgcn_exp2f(v)
  #define GAPB(MF,X,B) do{ MF; X[B]=EX(X[B]); X[B+1]=EX(X[B+1]); X[B+2]=EX(X[B+2]); X[B+3]=EX(X[B+3]); PIN(X); SBAR(); }while(0)
  #define VRD(i) do{ vlo[i]=vtr(vp_+(((i)>>2)*4096+((i)&3)*1024)); vhi[i]=vtr(vp_+(((i)>>2)*4096+((i)&3)*1024+512)); }while(0)
  #define KRD(G,j) do{ if(G){ kload2(kf,kp0+sl_next,j); SBAR(); } }while(0)
  #define STEP(C0,C1,P0,P1,t,GK,GV,GL) do{ SBAR(); \
    const lds_cptr vp_=vp0+sl_prev; \
    VRD(0); SBAR(); float sacc=(P0[0]+P0[1]); \
    GAPA(C0=__builtin_amdgcn_mfma_f32_32x32x16_bf16(kf[0],qr[0],negm,0,0,0), P0[2],P0[3],P0[4],P0[5],     pw0[0]=PKW(P0,0), pw0[1]=PKW(P0,2), pw0); \
    VRD(4); SBAR(); GAPA(C1=__builtin_amdgcn_mfma_f32_32x32x16_bf16(kf[1],qr[0],negm,0,0,0), P0[6],P0[7],P0[8],P0[9],     pw0[2]=PKW(P0,4), pw0[3]=PKW(P0,6), pw0); \
    VRD(1); SBAR(); GAPA(C0=__builtin_amdgcn_mfma_f32_32x32x16_bf16(kf[2],qr[1],C0,0,0,0),   P0[10],P0[11],P0[12],P0[13], pw1[0]=PKW(P0,8), pw1[1]=PKW(P0,10), pw1); \
    VRD(5); SBAR(); GAPA(C1=__builtin_amdgcn_mfma_f32_32x32x16_bf16(kf[3],qr[1],C1,0,0,0),   P0[14],P0[15],P1[0],P1[1],   pw1[2]=PKW(P0,12),pw1[3]=PKW(P0,14), pw1); \
    VRD(2); SBAR(); GAPA(C0=__builtin_amdgcn_mfma_f32_32x32x16_bf16(kf[4],qr[2],C0,0,0,0),   P1[2],P1[3],P1[4],P1[5],     pw2[0]=PKW(P1,0), pw2[1]=PKW(P1,2), pw2); \
    VRD(6); SBAR(); GAPA(C1=__builtin_amdgcn_mfma_f32_32x32x16_bf16(kf[5],qr[2],C1,0,0,0),   P1[6],P1[7],P1[8],P1[9],     pw2[2]=PKW(P1,4), pw2[3]=PKW(P1,6), pw2); \
    VRD(3); SBAR(); GAPA(C0=__builtin_amdgcn_mfma_f32_32x32x16_bf16(kf[6],qr[3],C0,0,0,0),   P1[10],P1[11],P1[12],P1[13], pw3[0]=PKW(P1,8), pw3[1]=PKW(P1,10), pw3); \
    VRD(7); SBAR(); GAPA(C1=__builtin_amdgcn_mfma_f32_32x32x16_bf16(kf[7],qr[3],C1,0,0,0),   P1[14],P1[15],0.f,0.f,       pw3[2]=PKW(P1,12),pw3[3]=PKW(P1,14), pw3); \
    l_reg+=sacc; \
    if(GK){DMA_K((t)+3,sl_cur);} if(GV){DMA_V((t)+1,sl_next);} \
    CMASK(C0,C1,t); \
    { float a=MX3(C0[0],C0[1],C1[0]),b=MX3(C0[2],C0[3],C1[1]); a=MX3(a,C1[2],C1[3]); \
      _Pragma("unroll") for(int r=4;r<16;r+=4){a=MX3(a,C0[r],C0[r+1]);b=MX3(b,C0[r+2],C0[r+3]);a=MX3(a,C1[r],C1[r+1]);b=MX3(b,C1[r+2],C1[r+3]);} \
      float rm=__builtin_fmaxf(a,b); { auto rr=__builtin_amdgcn_permlane32_swap(__float_as_uint(rm),__float_as_uint(rm),false,false); rm=__builtin_fmaxf(__uint_as_float(rr[0]),__uint_as_float(rr[1])); } \
      resc=false; \
      if(__builtin_expect(__any(rm>(float)THRL),0)){ const float dl=__builtin_fmaxf(rm,0.f); mhat+=dl; \
        _Pragma("unroll") for(int r=0;r<16;++r){C0[r]-=dl;C1[r]-=dl;} \
        _Pragma("unroll") for(int r=0;r<16;++r)negm[r]=-mhat; asm volatile("":"+v"(negm)); \
        const float f=__builtin_amdgcn_exp2f(-dl); l_reg*=f; if(hi==0)wsf[r32]=f; resc=true; } } \
    SBAR(); \
    GAPB(o[0]=__builtin_amdgcn_mfma_f32_32x32x16_bf16(PAF(0),VFR(0),o[0],0,0,0), C0,0); \
    GAPB(o[1]=__builtin_amdgcn_mfma_f32_32x32x16_bf16(PAF(0),VFR(4),o[1],0,0,0), C0,4); \
    KRD(GL,0); GAPB(o[0]=__builtin_amdgcn_mfma_f32_32x32x16_bf16(PAF(1),VFR(1),o[0],0,0,0), C0,8); \
    KRD(GL,1); GAPB(o[1]=__builtin_amdgcn_mfma_f32_32x32x16_bf16(PAF(1),VFR(5),o[1],0,0,0), C0,12); \
    KRD(GL,2); GAPB(o[0]=__builtin_amdgcn_mfma_f32_32x32x16_bf16(PAF(2),VFR(2),o[0],0,0,0), C1,0); \
    KRD(GL,3); GAPB(o[1]=__builtin_amdgcn_mfma_f32_32x32x16_bf16(PAF(2),VFR(6),o[1],0,0,0), C1,4); \
    GAPB(o[0]=__builtin_amdgcn_mfma_f32_32x32x16_bf16(PAF(3),VFR(3),o[0],0,0,0), C1,8); \
    GAPB(o[1]=__builtin_amdgcn_mfma_f32_32x32x16_bf16(PAF(3),VFR(7),o[1],0,0,0), C1,12); \
    }while(0)
  int t=1;
  #undef CMASK
  #define CMASK(P0,P1,t) mk.apply(P0,P1,(t),hi)
  for(;t+5<NT;t+=2){
    STEP(pB0,pB1,pA0,pA1,t,true,true,true);     WAIT_BAR(2); RESC(); ROT();
    STEP(pA0,pA1,pB0,pB1,t+1,true,true,true);   WAIT_BAR(2); RESC(); ROT();
  }
  #undef CMASK
  #define CMASK(P0,P1,t) mk.apply(P0,P1,(t),hi)
  #define ENDW(tt) do{ if((tt)+3<NT){WAIT_BAR(2);} else if((tt)+2<NT){WAIT_BAR(1);} else {WAIT_BAR(0);} }while(0)
  for(;t+1<NT;t+=2){
    STEP(pB0,pB1,pA0,pA1,t,(t+3<NT),(t+1<NT),(t+1<NT));       ENDW(t);   RESC(); ROT();
    STEP(pA0,pA1,pB0,pB1,t+1,(t+4<NT),(t+2<NT),(t+2<NT));     ENDW(t+1); RESC(); ROT();
  }
  STEP(pB0,pB1,pA0,pA1,NT-1,false,false,false); RESC();
  { float sacc=pB0[0]+pB0[1]; _Pragma("unroll") for(int r=2;r<16;++r)sacc+=pB0[r]; _Pragma("unroll") for(int r=0;r<16;++r)sacc+=pB1[r]; l_reg+=sacc;
    pw0=(u32x4){PKW(pB0,0),PKW(pB0,2),PKW(pB0,4),PKW(pB0,6)};pw1=(u32x4){PKW(pB0,8),PKW(pB0,10),PKW(pB0,12),PKW(pB0,14)};pw2=(u32x4){PKW(pB1,0),PKW(pB1,2),PKW(pB1,4),PKW(pB1,6)};pw3=(u32x4){PKW(pB1,8),PKW(pB1,10),PKW(pB1,12),PKW(pB1,14)};
    SBAR(); pv(o,vb0+sl_cur,PAF(0),PAF(1),PAF(2),PAF(3)); }
  #undef PKW
  #undef PAF
  #undef VFR
  #undef PIN
  #undef MX3
  #undef GAPA
  #undef GAPB
  #undef EX
  #undef VRD
  #undef KRD
  #undef STEP
  #undef ENDW
  {auto rr=__builtin_amdgcn_permlane32_swap(__float_as_uint(l_reg),__float_as_uint(l_reg),false,false);l_reg=__uint_as_float(rr[0])+__uint_as_float(rr[1]);}
  if(hi==0)wsf[32+r32]=l_reg;asm volatile("s_waitcnt lgkmcnt(0)":::"memory");
  float rli[16];
  #pragma unroll
  for(int r=0;r<16;++r)rli[r]=__builtin_amdgcn_rcpf(wsf[32+crow(r,hi)]);
  bf16*Ow=u.Op+(long)(u.qrow0+wid*QBLK)*OPITCH;
  { bf16*stg=(bf16*)(shm+LDS_OST)+wid*2048;
    #pragma unroll
    for(int r=0;r<16;++r){const int orow=crow(r,hi);
      #pragma unroll
      for(int d0=0;d0<2;++d0)stg[orow*64+d0*32+r32]=__float2bfloat16(o[d0][r]*rli[r]);}
    asm volatile("s_waitcnt lgkmcnt(0)":::"memory");
    #pragma unroll
    for(int i=0;i<4;++i){const int row=i*8+(lane>>3),ch=lane&7; const u32x4 v=*(const u32x4*)(stg+row*64+ch*8); ATTN_STORE16(Ow+(long)row*OPITCH+ch*8,v);} }
  asm volatile("s_waitcnt lgkmcnt(0)\n\ts_barrier":::"memory");
  #undef DMA_K
  #undef TROW
  #undef DMA_V
  #undef CMASK
  #undef START
  #undef RESC
  #undef ROT
}
constexpr int ATTN_LDS_BYTES=LDS_BYTES;
#undef SBAR
#undef WAIT_BAR
}

struct Params { const float* in[26]; float* out; unsigned char* ws; int ph_lo, ph_hi; };
struct Ctx { LAS unsigned char* lds; int tid, lane, wave, vcu, G, gw, NGW; };
enum { I_X = 0, I_C, I_CTX, I_CCTX, I_ADAW, I_ADAB, I_LNG, I_LNB, I_W0IN, I_W0OUT, I_LQ1, I_LK1, I_LQ2, I_LK2, I_SUBLN, I_QN, I_KN,
       I_W1IN, I_W1OUT, I_RPB, I_POOLW, I_POOLS, I_ROUTER, I_WG, I_WU, I_WD };

__device__ __forceinline__ const float* mod_row(const Params& p, int layer, int row) {
    return (const float*)(p.ws + WS_MOD) + (size_t)(layer * 9 + (row < LAT ? (row >> 11) : 8)) * 6144;
}

__device__ __forceinline__ void ph_prologue(const Params& p, const Ctx& c) {
    const float* cin = p.in[I_C]; const float* cctx = p.in[I_CCTX]; const float* ada_w = p.in[I_ADAW]; const float* ada_b = p.in[I_ADAB];
    float* MOD = (float*)(p.ws + WS_MOD);
    LAS float* sc = (LAS float*)c.lds;
    LAS float* red = sc + 9 * 1024;
    for (int i = c.tid; i < 9 * 1024; i += 512) { const float v = i < 8192 ? cin[i] : cctx[i - 8192]; sc[i] = v / (1.f + expf(-v)); }
    __syncthreads();
    for (int u = c.vcu; u < 256; u += c.G) {
        const int layer = u >> 7, j0 = (u & 127) * 48;
        const int jc = c.tid % 48, kg = c.tid / 48;
        if (kg < 10) {
            float acc[9];
#pragma unroll
            for (int m = 0; m < 9; ++m) acc[m] = 0.f;
            const float* wp = ada_w + (size_t)layer * 1024 * 6144 + j0 + jc;
#pragma unroll 8
            for (int k = kg; k < 1024; k += 10) {
                const float w = wp[(size_t)k * 6144];
#pragma unroll
                for (int m = 0; m < 9; ++m) acc[m] += sc[m * 1024 + k] * w;
            }
#pragma unroll
            for (int m = 0; m < 9; ++m) red[(kg * 9 + m) * 48 + jc] = acc[m];
        }
        __syncthreads();
        if (c.tid < 432) {
            const int m = c.tid / 48, j = c.tid % 48; float s = 0.f;
#pragma unroll
            for (int g = 0; g < 10; ++g) s += red[(g * 9 + m) * 48 + j];
            MOD[(size_t)(layer * 9 + m) * 6144 + j0 + j] = s + ada_b[layer * 6144 + j0 + j];
        }
        __syncthreads();
    }
    if (c.vcu == 0) {
        f32x2* R = (f32x2*)(p.ws + WS_ROPE);
        for (int i = c.tid; i < 1024; i += 512) {
            const int pos = i >> 4, f = i & 15;
            const float inv = exp2f(-(float)f * (13.287712379549449f / 16.f));
            const float a = (float)pos * inv;
            const float k = rintf(a * 0.15915494309189535f);
            float rr = fmaf(-k, 6.28125f, a); rr = fmaf(-k, 1.9353071795864769e-3f, rr);
            R[i] = (f32x2){__cosf(rr), __sinf(rr)};
        }
    }
}


__device__ __forceinline__ void transpose_item(const float* W, int ldw, int k0, int n0, bf16* WT, int Kd, int drow0, LAS float* scr, int lane) {
#pragma unroll 8
    for (int i = 0; i < 32; ++i) { const int kk = 2 * i + (lane >> 5); scr[kk * 33 + (lane & 31)] = W[(size_t)(k0 + kk) * ldw + n0 + (lane & 31)]; }
    asm volatile("s_waitcnt lgkmcnt(0)" ::: "memory");
    const int ch = lane & 7;
#pragma unroll
    for (int j = 0; j < 4; ++j) { const int n = (lane >> 3) + 8 * j; const LAS float* sp = scr + (8 * ch) * 33 + n;
        v4u o; o.x = pk2(sp[0 * 33], sp[1 * 33]); o.y = pk2(sp[2 * 33], sp[3 * 33]); o.z = pk2(sp[4 * 33], sp[5 * 33]); o.w = pk2(sp[6 * 33], sp[7 * 33]);
        *(v4u*)(WT + (size_t)(drow0 + n) * Kd + k0 + 8 * ch) = o; }
    asm volatile("s_waitcnt lgkmcnt(0)" ::: "memory");
}
__device__ __forceinline__ void transpose_item8(const float* W, int ldw, int k0, int n0, unsigned char* WT8, int Kd, int drow0, float scale, LAS float* scr, int lane) {
#pragma unroll 8
    for (int i = 0; i < 32; ++i) { const int kk = 2 * i + (lane >> 5); scr[kk * 33 + (lane & 31)] = W[(size_t)(k0 + kk) * ldw + n0 + (lane & 31)]; }
    asm volatile("s_waitcnt lgkmcnt(0)" ::: "memory");
    const int n = lane >> 1, hf = lane & 1; const LAS float* sp = scr + (32 * hf) * 33 + n;
    v4u o0, o1;
    o0.x = pg8::pk4_fp8(sp[0 * 33] * scale, sp[1 * 33] * scale, sp[2 * 33] * scale, sp[3 * 33] * scale);     o0.y = pg8::pk4_fp8(sp[4 * 33] * scale, sp[5 * 33] * scale, sp[6 * 33] * scale, sp[7 * 33] * scale);
    o0.z = pg8::pk4_fp8(sp[8 * 33] * scale, sp[9 * 33] * scale, sp[10 * 33] * scale, sp[11 * 33] * scale);   o0.w = pg8::pk4_fp8(sp[12 * 33] * scale, sp[13 * 33] * scale, sp[14 * 33] * scale, sp[15 * 33] * scale);
    o1.x = pg8::pk4_fp8(sp[16 * 33] * scale, sp[17 * 33] * scale, sp[18 * 33] * scale, sp[19 * 33] * scale); o1.y = pg8::pk4_fp8(sp[20 * 33] * scale, sp[21 * 33] * scale, sp[22 * 33] * scale, sp[23 * 33] * scale);
    o1.z = pg8::pk4_fp8(sp[24 * 33] * scale, sp[25 * 33] * scale, sp[26 * 33] * scale, sp[27 * 33] * scale); o1.w = pg8::pk4_fp8(sp[28 * 33] * scale, sp[29 * 33] * scale, sp[30 * 33] * scale, sp[31 * 33] * scale);
    unsigned char* dst = WT8 + (size_t)(drow0 + n) * Kd + k0 + 32 * hf;
    *(v4u*)dst = o0; *(v4u*)(dst + 16) = o1;
    asm volatile("s_waitcnt lgkmcnt(0)" ::: "memory");
}
struct TBlk { const float* src; unsigned char* dst; int ldw, Kd, gu, which; float scale; };
__device__ __forceinline__ TBlk tblk_decode(const Params& p, int blk) {
    const int ie = blk / 96, q = blk - ie * 96, layer = ie >> 4, e = ie & 15, which = q >> 5, idx = q & 31;
    TBlk t; t.which = which;
    if (which < 2) { const int kb = idx & 3, nb = idx >> 2, k0 = 256 * kb, n0 = 256 * nb;
        t.src = (which == 0 ? p.in[I_WG] : p.in[I_WU]) + (size_t)ie * DM * FF + (size_t)k0 * FF + n0; t.ldw = FF; t.Kd = DM; t.scale = W8_GU; t.gu = 1;
        t.dst = p.ws + WS_WGU + (size_t)layer * WS_MOE_LSTRIDE + (size_t)e * 4096 * DM + (size_t)(2 * nb) * 256 * DM + k0; }
    else { const int kb = idx & 7, nb = idx >> 3, k0 = 256 * kb, n0 = 256 * nb;
        t.src = p.in[I_WD] + (size_t)ie * FF * DM + (size_t)k0 * DM + n0; t.ldw = DM; t.Kd = FF; t.scale = W8_DN; t.gu = 0;
        t.dst = p.ws + WS_WDN + (size_t)layer * WS_MOE_LSTRIDE + (size_t)e * DM * FF + (size_t)n0 * FF + k0; }
    return t;
}
__device__ __forceinline__ void tblk_load(const TBlk& t, f32x4 (&v)[16], int wave, int lane, int hf) {
    const float* sp = t.src + (size_t)(32 * wave + 16 * hf) * t.ldw + 4 * lane;
#pragma unroll
    for (int i = 0; i < 16; ++i) v[i] = *(const f32x4*)(sp + (size_t)i * t.ldw);
}
constexpr int TPITCH = 264;
__device__ __forceinline__ void tblk_pack(const TBlk& t, const f32x4 (&v)[16], LAS unsigned char* T, int wave, int lane, int hf) {
#pragma unroll
    for (int i = 0; i < 4; ++i) {
        const f32x4 r0 = v[4 * i] * t.scale, r1 = v[4 * i + 1] * t.scale, r2 = v[4 * i + 2] * t.scale, r3 = v[4 * i + 3] * t.scale;
#pragma unroll
        for (int j = 0; j < 4; ++j) { int w = 0; w = __builtin_amdgcn_cvt_pk_fp8_f32(r0[j], r1[j], w, false); w = __builtin_amdgcn_cvt_pk_fp8_f32(r2[j], r3[j], w, true);
            *(LAS unsigned*)(T + (64 * j + lane) * TPITCH + 32 * wave + 16 * hf + 4 * i) = (unsigned)w; }
    }
}
__device__ __forceinline__ void tblk_writeout(const TBlk& t, const LAS unsigned char* T, int tid) {
#pragma unroll
    for (int it = 0; it < 8; ++it) { const int idx = it * 512 + tid, n = idx >> 4, ch = idx & 15, rho = (n & 3) * 64 + (n >> 2);
        const LAS unsigned char* sp = T + rho * TPITCH + 16 * ch;
        const v2u a = *(const LAS v2u*)sp, b2 = *(const LAS v2u*)(sp + 8);
        const int drow = t.gu ? ((n >> 7) * 256 + (n & 127) + t.which * 128) : n;
        *(v4u*)(t.dst + (size_t)drow * t.Kd + 16 * ch) = (v4u){a.x, a.y, b2.x, b2.y}; }
}
__device__ __forceinline__ void ph_transposes(const Params& p, const Ctx& c) {
    LAS float* scr = (LAS float*)(c.lds + c.wave * 16384);
    constexpr int I0 = 16 * 72, I1 = 16 * 32, I2 = 16 * 64, I3 = 16 * 32, ISM = I0 + I1 + I2 + I3;
    for (int r0 = c.gw; r0 < ISM; r0 += c.NGW) {
        int r = r0;
        if (r < I0) { const int n0 = 32 * (r % 72), drow = FUSE_QKV ? ((n0 >> 8) * 256 + 128 * ((n0 >> 5) & 1) + 32 * ((n0 >> 6) & 3)) : n0;
            transpose_item(p.in[I_W0IN], EIN, 64 * (r / 72), n0, (bf16*)(p.ws + WS_W0IN), DM, drow, scr, c.lane); continue; } r -= I0;
        if (r < I1) { transpose_item(p.in[I_W0OUT], DM, 64 * (r / 32), 32 * (r % 32), (bf16*)(p.ws + WS_W0OUT), DM, 32 * (r % 32), scr, c.lane); continue; } r -= I1;
        if (r < I2) { transpose_item(p.in[I_W1IN], OIN, 64 * (r / 64), 32 * (r % 64), (bf16*)(p.ws + WS_W1IN), DM, 32 * (r % 64), scr, c.lane); continue; } r -= I2;
        transpose_item(p.in[I_W1OUT], DM, 64 * (r / 32), 32 * (r % 32), (bf16*)(p.ws + WS_W1OUT), DM, 32 * (r % 32), scr, c.lane);
    }
    static_assert(MOE_FP8, "the expert-weight transposes write e4m3 copies");
    __syncthreads();
    constexpr int NBLK = 32 * 96;
    LAS unsigned char* T = c.lds;
    f32x4 va[16], vb[16];
    int blk = c.vcu;
    TBlk t = tblk_decode(p, blk < NBLK ? blk : 0);
    if (blk < NBLK) tblk_load(t, va, c.wave, c.lane, 0);
#pragma unroll 1
    for (; blk < NBLK; blk += c.G) {
        tblk_load(t, vb, c.wave, c.lane, 1);
        tblk_pack(t, va, T, c.wave, c.lane, 0);
        const int nb = blk + c.G;
        TBlk tn = tblk_decode(p, nb < NBLK ? nb : 0);
        if (nb < NBLK) tblk_load(tn, va, c.wave, c.lane, 0);
        tblk_pack(t, vb, T, c.wave, c.lane, 1);
        __syncthreads();
        tblk_writeout(t, T, c.tid);
        __syncthreads();
        t = tn;
    }
}

__device__ __forceinline__ void ph_modulate0(const Params& p, const Ctx& c) {
    bf16* HB = (bf16*)(p.ws + WS_HB);
    for (int row = c.gw; row < NTOK; row += c.NGW) {
        const float* src = row < LAT ? p.in[I_X] + (size_t)row * DM : p.in[I_CTX] + (size_t)(row - LAT) * DM;
        const float* mod = mod_row(p, 0, row);
#pragma unroll
        for (int j = 0; j < 4; ++j) {
            const int col = 4 * c.lane + 256 * j;
            const f32x4 v = *(const f32x4*)(src + col), sh = *(const f32x4*)(mod + col), s = *(const f32x4*)(mod + 1024 + col);
            const f32x4 h = v * (s + 1.f) + sh;
            *(v2u*)(HB + (size_t)row * DM + col) = (v2u){pk2(h.x, h.y), pk2(h.z, h.w)};
        }
    }
}

struct NG { const bf16* A; int lda; const float* W0; const float* W1; int ldw; size_t wstride; int Mb; int row_begin, row_end, col_begin, col_end, K; };
template <int NB, class Epi>
__device__ __forceinline__ void ngemm(const NG& g, const Ctx& c, const Epi& epi) {
    const int nmt = (g.row_end - g.row_begin) / 32, nnt = (g.col_end - g.col_begin) / 32;
    const int l31 = c.lane & 31, lh = c.lane >> 5;
    for (int t = c.gw; t < nmt * nnt; t += c.NGW) {
        const int mt = t / nnt, nt = t % nnt;
        const int row0 = g.row_begin + mt * 32, col0 = g.col_begin + nt * 32;
        const int e = row0 / g.Mb;
        const bf16* ap = g.A + (size_t)(row0 + l31) * g.lda + lh;
        const float* bp0 = g.W0 + (size_t)e * g.wstride + (size_t)lh * g.ldw + col0 + l31;
        const float* bp1 = NB == 2 ? g.W1 + (size_t)e * g.wstride + (size_t)lh * g.ldw + col0 + l31 : nullptr;
        f32x16 acc0 = {}, acc1 = {};
#pragma unroll 8
        for (int k = 0; k < g.K; k += 2) {
            const float a = bf2f((unsigned)ap[k]);
            const float b0 = bp0[(size_t)k * g.ldw];
            acc0 = __builtin_amdgcn_mfma_f32_32x32x2f32(a, b0, acc0, 0, 0, 0);
            if (NB == 2) { const float b1 = bp1[(size_t)k * g.ldw]; acc1 = __builtin_amdgcn_mfma_f32_32x32x2f32(a, b1, acc1, 0, 0, 0); }
        }
#pragma unroll
        for (int r = 0; r < 16; ++r) {
            const int row = row0 + (r & 3) + 8 * (r >> 2) + 4 * lh, col = col0 + l31;
            epi(row, col, acc0[r], acc1[r]);
        }
    }
}
struct EpiF32 { float* O; int ldc; __device__ __forceinline__ void operator()(int row, int col, float v0, float) const { O[(size_t)row * ldc + col] = v0; } };
struct EpiBf { bf16* O; int ldc; int scale_cols; float sc; __device__ __forceinline__ void operator()(int row, int col, float v0, float) const { O[(size_t)row * ldc + col] = (bf16)f2bf(col < scale_cols ? v0 * sc : v0); } };
struct EpiSwiglu { bf16* O; __device__ __forceinline__ void operator()(int row, int col, float g, float u) const { const float s = g / (1.f + __expf(-g)); O[(size_t)row * FF + col] = (bf16)f2bf(s * u); } };
struct EpiGate { bf16* O; const float* gate; __device__ __forceinline__ void operator()(int row, int col, float v0, float) const { O[(size_t)row * DM + col] = (bf16)f2bf(v0 * gate[row]); } };

template <bool F32IN> __device__ __forceinline__ void ph_qkv_post(const Params& p, const Ctx& c) {
    const float* PF = (const float*)(p.ws + WS_PF);
    bf16* QKV = (bf16*)(p.ws + WS_QKV);
    const f32x2* R = (const f32x2*)(p.ws + WS_ROPE);
    const float* qn = p.in[I_QN]; const float* kn = p.in[I_KN];
    const int d = c.lane;
    const float qg = qn[d], kg = kn[d];
    for (int row = c.gw; row < NTOK; row += c.NGW) {
        const bool lat = row < LAT;
        const int t = row & 2047;
        const int pos = (d < 32) ? (t >> 6) : (t & 63);
        const f32x2 cs = R[pos * 16 + (d & 15)];
        const bool first = (d & 16) == 0;
        float vv[36];
#pragma unroll
        for (int hs = 0; hs < 36; ++hs) vv[hs] = F32IN ? PF[(size_t)row * EIN + hs * 64 + d] : bf2f((unsigned)QKV[(size_t)row * EIN + hs * 64 + d]);
#pragma unroll
        for (int hs = 0; hs < 36; ++hs) {
            float v = vv[hs];
            const bool isq = hs < 8 || (hs >= 24 && hs < 32);
            const bool isk = (hs >= 8 && hs < 16) || hs == 32 || hs == 33;
            const bool nrm = hs >= 24 && hs < 34;
            if (nrm) { const float ss = wave_sum(v * v); v = v * rsqrtf(ss * (1.f / 64.f) + RMS_EPS) * (hs < 32 ? qg : kg); }
            if ((isq || isk) && lat) { const float pr = __shfl_xor(v, 16); v = first ? v * cs.x - pr * cs.y : v * cs.x + pr * cs.y; }
            if (isq) v *= C2;
            QKV[(size_t)row * EIN + hs * 64 + d] = (bf16)f2bf(v);
        }
    }
}

__device__ __forceinline__ void ph_attn0_naive(const Params& p, const Ctx& c) {
    const bf16* QKV = (const bf16*)(p.ws + WS_QKV);
    bf16* CC = (bf16*)(p.ws + WS_CC);
    bf16* AO = (bf16*)(p.ws + WS_AO);
    LAS float* Ks = (LAS float*)c.lds;
    LAS float* Vs = Ks + 4096;
    for (int u = c.vcu; u < 960; u += c.G) {
        const bool isctx = u >= 768;
        int b, vh, qrow, ntiles; bool active = true;
        if (!isctx) { b = u / 96; const int r = u % 96; vh = r >> 2; qrow = b * SEQ + (r & 3) * 512 + c.tid; ntiles = 36; }
        else { const int uu = u - 768; b = uu / 24; vh = uu % 24; qrow = LAT + b * NCTX + (c.tid & 255); active = c.tid < 256; ntiles = 4; }
        int qcol, kcol, vcol;
        if (vh < 16) { const int a = vh >> 2, s = (vh >> 1) & 1, half = vh & 1; qcol = a * 128 + s * 64; kcol = 512 + a * 128 + s * 64; vcol = 1024 + a * 128 + half * 64; }
        else { const int h = vh - 16; qcol = 1536 + h * 64; kcol = 2048 + (h >> 2) * 64; vcol = 2176 + (h >> 2) * 64; }
        float q[64], o[64];
#pragma unroll
        for (int i = 0; i < 8; ++i) { const v4u w = *(const v4u*)(QKV + (size_t)qrow * EIN + qcol + 8 * i); unpack8(w, q + 8 * i); }
#pragma unroll
        for (int i = 0; i < 64; ++i) o[i] = 0.f;
        float m = -1e30f, l = 0.f;
        for (int t = 0; t < ntiles; ++t) {
            const int krow0 = isctx ? LAT + b * NCTX + 64 * t : (t < 32 ? b * SEQ + 64 * t : LAT + b * NCTX + 64 * (t - 32));
            __syncthreads();
            { const int r = c.tid >> 3, ch = c.tid & 7; float f[8];
              const v4u kw = *(const v4u*)(QKV + (size_t)(krow0 + r) * EIN + kcol + ch * 8); unpack8(kw, f);
#pragma unroll
              for (int j = 0; j < 8; ++j) Ks[r * 64 + ch * 8 + j] = f[j];
              const v4u vw = *(const v4u*)(QKV + (size_t)(krow0 + r) * EIN + vcol + ch * 8); unpack8(vw, f);
#pragma unroll
              for (int j = 0; j < 8; ++j) Vs[r * 64 + ch * 8 + j] = f[j]; }
            __syncthreads();
            if (active) {
                for (int kk = 0; kk < 64; ++kk) {
                    float s = 0.f;
#pragma unroll
                    for (int dd = 0; dd < 64; ++dd) s += q[dd] * Ks[kk * 64 + dd];
                    const float mn = fmaxf(m, s), al = exp2f(m - mn), pp = exp2f(s - mn);
                    l = l * al + pp; m = mn;
#pragma unroll
                    for (int dd = 0; dd < 64; ++dd) o[dd] = o[dd] * al + pp * Vs[kk * 64 + dd];
                }
            }
        }
        if (active) {
            const float rl = 1.f / l;
            bf16* dst = vh < 16 ? AO + (size_t)qrow * DM + (vh >> 2) * 256 + ((vh >> 1) & 1) * 128 + (vh & 1) * 64 : CC + (size_t)qrow * DM + 512 + (vh - 16) * 64;
            {
#pragma unroll
                for (int i = 0; i < 8; ++i) *(v4u*)(dst + 8 * i) = (v4u){pk2(o[8 * i] * rl, o[8 * i + 1] * rl), pk2(o[8 * i + 2] * rl, o[8 * i + 3] * rl), pk2(o[8 * i + 4] * rl, o[8 * i + 5] * rl), pk2(o[8 * i + 6] * rl, o[8 * i + 7] * rl)}; }
        }
    }
}


__device__ __forceinline__ void attn_combine_rows(const Params& p, const Ctx& c, int row0, int a, float lam, float g0, float g1) {
    const bf16* AO = (const bf16*)(p.ws + WS_AO); bf16* CC = (bf16*)(p.ws + WS_CC);
    asm volatile("s_waitcnt vmcnt(0)" ::: "memory");
#pragma unroll 1
    for (int rb = 0; rb < 32; rb += 8) {
        float x0[8], x1[8];
#pragma unroll
        for (int j = 0; j < 8; ++j) { const bf16* src = AO + (size_t)(row0 + rb + j) * DM + a * 256;
            x0[j] = bf2f((unsigned)src[c.lane]) - lam * bf2f((unsigned)src[128 + c.lane]); x1[j] = bf2f((unsigned)src[64 + c.lane]) - lam * bf2f((unsigned)src[192 + c.lane]); }
#pragma unroll
        for (int j = 0; j < 8; ++j) { const float ss = wave_sum(x0[j] * x0[j] + x1[j] * x1[j]); const float r = rsqrtf(ss * (1.f / 128.f) + RMS_EPS);
            bf16* dst = CC + (size_t)(row0 + rb + j) * DM + a * 128;
            dst[c.lane] = (bf16)f2bf(x0[j] * r * g0); dst[64 + c.lane] = (bf16)f2bf(x1[j] * r * g1); }
    }
}
__device__ __forceinline__ void ph_attn0_fast(const Params& p, const Ctx& c, char* lds_generic) {
    typedef attn_body::bf16 abf;
    const abf* Q = (const abf*)(p.ws + WS_QKV); abf* CCb = (abf*)(p.ws + WS_CC); abf* AOb = (abf*)(p.ws + WS_AO);
    const float d1 = wave_sum(p.in[I_LQ1][c.lane] * p.in[I_LK1][c.lane]), d2 = wave_sum(p.in[I_LQ2][c.lane] * p.in[I_LK2][c.lane]);
    const float lam = expf(d1) - expf(d2) + LAM_INIT;
    const float g0 = p.in[I_SUBLN][c.lane] * (1.f - LAM_INIT), g1 = p.in[I_SUBLN][c.lane + 64] * (1.f - LAM_INIT);
    for (int v = c.vcu; v < 256; v += c.G) {
#pragma unroll 1
        for (int step = 0; step < 10; ++step) {
            attn_body::AU u; int vh; bool ctxu = false;
            if (step < 4) { const int b = v >> 5, a = (v >> 3) & 3; vh = 4 * a + step; u.qrow0 = b * SEQ + (v & 7) * 256; u.lat_row0 = b * SEQ; u.ctx_row0 = LAT + b * NCTX; }
            else if (step < 6) { const int U = (step - 4) * 256 + v, b = U >> 6; vh = 16 + ((U >> 3) & 7); u.qrow0 = b * SEQ + (U & 7) * 256; u.lat_row0 = b * SEQ; u.ctx_row0 = LAT + b * NCTX; }
            else { ctxu = true; int b;
                if (v < 32) { b = v >> 2; vh = 4 * (v & 3) + (step - 6); }
                else if (v < 96 && step == 6) { b = (v - 32) >> 3; vh = 16 + ((v - 32) & 7); }
                else break;
                u.qrow0 = LAT + b * NCTX; u.lat_row0 = 0; u.ctx_row0 = LAT + b * NCTX; }
            if (!ctxu) { u.nlat_t = 32; u.NT = 36; } else { u.nlat_t = 0; u.NT = 4; }
            int qcol, kcol, vcol; abf* op;
            if (vh < 16) { const int a = vh >> 2, s = (vh >> 1) & 1, half = vh & 1; qcol = a * 128 + s * 64; kcol = 512 + a * 128 + s * 64; vcol = 1024 + a * 128 + half * 64; op = AOb + a * 256 + s * 128 + half * 64; }
            else { const int h = vh - 16; qcol = 1536 + h * 64; kcol = 2048 + (h >> 2) * 64; vcol = 2176 + (h >> 2) * 64; op = CCb + 512 + h * 64; }
            u.Qp = Q + qcol; u.Kp = Q + kcol; u.Vp = Q + vcol; u.Op = op;
            attn_body::attn_unit<8, EIN, attn_body::NoMask>(u, lds_generic, attn_body::NoMask{});
            if (vh < 16 && (vh & 3) == 3) attn_combine_rows(p, c, u.qrow0 + c.wave * 32, vh >> 2, lam, g0, g1);
        }
    }
}

__device__ __forceinline__ void ph_attn_combine(const Params& p, const Ctx& c) {
    const bf16* AO = (const bf16*)(p.ws + WS_AO);
    bf16* CC = (bf16*)(p.ws + WS_CC);
    const float d1 = wave_sum(p.in[I_LQ1][c.lane] * p.in[I_LK1][c.lane]);
    const float d2 = wave_sum(p.in[I_LQ2][c.lane] * p.in[I_LK2][c.lane]);
    const float lam = expf(d1) - expf(d2) + LAM_INIT;
    const float g0 = p.in[I_SUBLN][c.lane] * (1.f - LAM_INIT), g1 = p.in[I_SUBLN][c.lane + 64] * (1.f - LAM_INIT);
    for (int it = c.gw; it < NTOK * 4; it += c.NGW) {
        const int row = it >> 2, a = it & 3;
        const bf16* src = AO + (size_t)row * DM + a * 256;
        const float x0 = bf2f((unsigned)src[c.lane]) - lam * bf2f((unsigned)src[128 + c.lane]), x1 = bf2f((unsigned)src[64 + c.lane]) - lam * bf2f((unsigned)src[192 + c.lane]);
        const float ss = wave_sum(x0 * x0 + x1 * x1);
        const float r = rsqrtf(ss * (1.f / 128.f) + RMS_EPS);
        CC[(size_t)row * DM + a * 128 + c.lane] = (bf16)f2bf(x0 * r * g0);
        CC[(size_t)row * DM + a * 128 + 64 + c.lane] = (bf16)f2bf(x1 * r * g1);
    }
}

__device__ __forceinline__ f32x4 unpack4(const v2u w) { return (f32x4){bf2f(w.x & 0xffffu), __uint_as_float(w.x & 0xffff0000u), bf2f(w.y & 0xffffu), __uint_as_float(w.y & 0xffff0000u)}; }
__device__ __forceinline__ float reduce_logits(const f32x4 (&lg)[4], int lane) {
    float w8[8], w4[4], w2[2], w1;
    { const bool hi = (lane & 32) != 0;
#pragma unroll
      for (int i = 0; i < 8; ++i) { const float a0 = lg[i >> 2][i & 3], a1 = lg[2 + (i >> 2)][i & 3]; const float keep = hi ? a1 : a0, send = hi ? a0 : a1; w8[i] = keep + __shfl_xor(send, 32); } }
    { const bool hi = (lane & 16) != 0;
#pragma unroll
      for (int i = 0; i < 4; ++i) { const float keep = hi ? w8[i + 4] : w8[i], send = hi ? w8[i] : w8[i + 4]; w4[i] = keep + __shfl_xor(send, 16); } }
    { const bool hi = (lane & 8) != 0;
#pragma unroll
      for (int i = 0; i < 2; ++i) { const float keep = hi ? w4[i + 2] : w4[i], send = hi ? w4[i] : w4[i + 2]; w2[i] = keep + __shfl_xor(send, 8); } }
    { const bool hi = (lane & 4) != 0; const float keep = hi ? w2[1] : w2[0], send = hi ? w2[0] : w2[1]; w1 = keep + __shfl_xor(send, 4); }
    w1 += __shfl_xor(w1, 2); w1 += __shfl_xor(w1, 1);
    return w1;
}
__device__ __forceinline__ void ph_ln1_router(const Params& p, const Ctx& c, int layer) {
    const bf16* Y = (const bf16*)(p.ws + WS_Y);
    bf16* XS = (bf16*)(p.ws + WS_XS);
    bf16* HB = (bf16*)(p.ws + WS_HB);
    float* AFF = (float*)(p.ws + WS_AFF);
    const float* lng = p.in[I_LNG] + (size_t)(layer * 2 + 0) * DM; const float* lnb = p.in[I_LNB] + (size_t)(layer * 2 + 0) * DM;
    const float* router = p.in[I_ROUTER] + (size_t)layer * DM * NE;
    LAS f32x4* R = (LAS f32x4*)c.lds;
    for (int idx = c.tid; idx < 4096; idx += 512) { const int e4 = idx & 3, k = idx >> 2, ln = (k & 255) >> 2, q = k & 3, j = k >> 8;
        R[((j * 4 + q) * 4 + e4) * 64 + ln] = *(const f32x4*)(router + (size_t)k * NE + 4 * e4); }
    __syncthreads();
    const int nrows = layer == 0 ? NTOK : LAT;
    const int lane = c.lane;
    for (int row = 2 * c.gw; row < nrows; row += 2 * c.NGW) {
        const float* mod = mod_row(p, layer, row);
        f32x4 va[4], vb[4]; float sa = 0.f, sb = 0.f;
#pragma unroll
        for (int j = 0; j < 4; ++j) { const int col = 4 * lane + 256 * j;
            f32x4 xa, xb;
            if (layer == 0) { const float* xin = row < LAT ? p.in[I_X] + (size_t)row * DM : p.in[I_CTX] + (size_t)(row - LAT) * DM; xa = *(const f32x4*)(xin + col); xb = *(const f32x4*)(xin + DM + col); }
            else { xa = unpack4(*(const v2u*)(XS + (size_t)row * DM + col)); xb = unpack4(*(const v2u*)(XS + (size_t)(row + 1) * DM + col)); }
            const f32x4 g1 = *(const f32x4*)(mod + 2048 + col);
            va[j] = xa * ALPHA + g1 * unpack4(*(const v2u*)(Y + (size_t)row * DM + col));
            vb[j] = xb * ALPHA + g1 * unpack4(*(const v2u*)(Y + (size_t)(row + 1) * DM + col));
            sa += (va[j].x + va[j].y) + (va[j].z + va[j].w); sb += (vb[j].x + vb[j].y) + (vb[j].z + vb[j].w); }
        const float meana = wave_sum(sa) * (1.f / DM), meanb = wave_sum(sb) * (1.f / DM); float qa = 0.f, qb = 0.f;
#pragma unroll
        for (int j = 0; j < 4; ++j) { va[j] = va[j] - meana; vb[j] = vb[j] - meanb;
            qa += (va[j].x * va[j].x + va[j].y * va[j].y) + (va[j].z * va[j].z + va[j].w * va[j].w); qb += (vb[j].x * vb[j].x + vb[j].y * vb[j].y) + (vb[j].z * vb[j].z + vb[j].w * vb[j].w); }
        const float rstda = 1.f / sqrtf(wave_sum(qa) * (1.f / DM) + LN_EPS), rstdb = 1.f / sqrtf(wave_sum(qb) * (1.f / DM) + LN_EPS);
        f32x4 lga[4], lgb[4];
#pragma unroll
        for (int e = 0; e < 4; ++e) { lga[e] = (f32x4){0.f, 0.f, 0.f, 0.f}; lgb[e] = (f32x4){0.f, 0.f, 0.f, 0.f}; }
#pragma unroll
        for (int j = 0; j < 4; ++j) { const int col = 4 * lane + 256 * j;
            const f32x4 g = *(const f32x4*)(lng + col), bb = *(const f32x4*)(lnb + col), sc = *(const f32x4*)(mod + 4096 + col) + 1.f, sh = *(const f32x4*)(mod + 3072 + col);
            const f32x4 x1a = va[j] * rstda * g + bb, x1b = vb[j] * rstdb * g + bb;
            *(v2u*)(XS + (size_t)row * DM + col) = (v2u){pk2(x1a.x, x1a.y), pk2(x1a.z, x1a.w)};
            *(v2u*)(XS + (size_t)(row + 1) * DM + col) = (v2u){pk2(x1b.x, x1b.y), pk2(x1b.z, x1b.w)};
            const f32x4 hma = x1a * sc + sh, hmb = x1b * sc + sh;
            if (MOE_FP8) { *(unsigned*)((unsigned char*)HB + (size_t)row * DM + col) = pg8::pk4_fp8(hma.x, hma.y, hma.z, hma.w);
                           *(unsigned*)((unsigned char*)HB + (size_t)(row + 1) * DM + col) = pg8::pk4_fp8(hmb.x, hmb.y, hmb.z, hmb.w); }
            else { *(v2u*)(HB + (size_t)row * DM + col) = (v2u){pk2(hma.x, hma.y), pk2(hma.z, hma.w)}; *(v2u*)(HB + (size_t)(row + 1) * DM + col) = (v2u){pk2(hmb.x, hmb.y), pk2(hmb.z, hmb.w)}; }
            asm volatile("" ::: "memory");
#pragma unroll
            for (int q = 0; q < 4; ++q) { const float ha = hma[q], hb = hmb[q];
#pragma unroll
                for (int e4 = 0; e4 < 4; ++e4) { const f32x4 rw = R[((j * 4 + q) * 4 + e4) * 64 + lane]; lga[e4] += rw * ha; lgb[e4] += rw * hb; } } }
        const float wa = reduce_logits(lga, lane), wb = reduce_logits(lgb, lane);
        float mxa = wa, mxb = wb;
#pragma unroll
        for (int o = 4; o < 64; o <<= 1) { mxa = fmaxf(mxa, __shfl_xor(mxa, o)); mxb = fmaxf(mxb, __shfl_xor(mxb, o)); }
        const float exa = expf(wa - mxa), exb = expf(wb - mxb); float dena = exa, denb = exb;
#pragma unroll
        for (int o = 4; o < 64; o <<= 1) { dena += __shfl_xor(dena, o); denb += __shfl_xor(denb, o); }
        if ((lane & 3) == 0) { const int e = ((lane >> 5) & 1) * 8 + ((lane >> 4) & 1) * 4 + ((lane >> 3) & 1) * 2 + ((lane >> 2) & 1);
            AFF[(size_t)row * NE + e] = exa / dena; AFF[(size_t)(row + 1) * NE + e] = exb / denb; }
    }
}

__device__ __forceinline__ void ph_topk(const Params& p, const Ctx& c, int layer) {
    const float* AFF = (const float*)(p.ws + WS_AFF);
    int* INV = (int*)(p.ws + WS_INV);
    float* GATE = (float*)(p.ws + WS_GATE);
    const bf16* HB = (const bf16*)(p.ws + WS_HB);
    bf16* XG = (bf16*)(p.ws + WS_XG);
    LAS unsigned* hist = (LAS unsigned*)c.lds;
    LAS unsigned* ctl = hist + 256;
    LAS int* sel = (LAS int*)(c.lds + 2048);
    const int MR = layer == 0 ? MR0 : MR1;
    const int ntasks = layer == 0 ? 256 : 128;
    const int lane = c.lane;
    for (int task = c.vcu; task < ntasks; task += c.G) {
        int set, e, n, cap, rowbase, slotbase;
        if (task < 128) { set = task >> 4; e = task & 15; n = SEQ; cap = 256; rowbase = set * SEQ; slotbase = set * 256; }
        else { const int t2 = task - 128; set = t2 >> 4; e = t2 & 15; n = NCTX; cap = 32; rowbase = LAT + set * NCTX; slotbase = 2048 + set * 32; }
        const bool valid = 4 * c.tid < n;
        unsigned key[4];
#pragma unroll
        for (int q = 0; q < 4; ++q) key[q] = valid ? __float_as_uint(AFF[(size_t)(rowbase + 4 * c.tid + q) * NE + e]) : 0u;
        unsigned prefix = 0u, need = (unsigned)cap;
#pragma unroll 1
        for (int pass = 0; pass < 4; ++pass) {
            const int shift = 24 - 8 * pass;
            if (c.tid < 256) hist[c.tid] = 0u;
            __syncthreads();
            if (valid) {
#pragma unroll
                for (int q = 0; q < 4; ++q) if (pass == 0 || (key[q] >> (shift + 8)) == (prefix >> (shift + 8))) __hip_atomic_fetch_add(&hist[(key[q] >> shift) & 255u], 1u, __ATOMIC_RELAXED, __HIP_MEMORY_SCOPE_WORKGROUP);
            }
            __syncthreads();
            if (c.wave == 0) {
                const unsigned h0 = hist[4 * lane], h1 = hist[4 * lane + 1], h2 = hist[4 * lane + 2], h3 = hist[4 * lane + 3];
                const unsigned tot = h0 + h1 + h2 + h3; unsigned sfx = tot;
#pragma unroll
                for (int o = 1; o < 64; o <<= 1) { const unsigned t = __shfl_down(sfx, o); if (lane + o < 64) sfx += t; }
                const unsigned above = sfx - tot, c3 = above + h3, c2 = c3 + h2, c1 = c2 + h1, c0 = c1 + h0;
                int d = -1; unsigned gtc = 0u;
                if (above < need && need <= c3) { d = 3; gtc = above; }
                else if (c3 < need && need <= c2) { d = 2; gtc = c3; }
                else if (c2 < need && need <= c1) { d = 1; gtc = c2; }
                else if (c1 < need && need <= c0) { d = 0; gtc = c1; }
                if (d >= 0) { ctl[0] = prefix | ((unsigned)(4 * lane + d) << shift); ctl[1] = need - gtc; }
            }
            __syncthreads();
            prefix = ctl[0]; need = ctl[1];
        }
        unsigned ngt = 0u, neq = 0u;
#pragma unroll
        for (int q = 0; q < 4; ++q) { ngt += (valid && key[q] > prefix) ? 1u : 0u; neq += (valid && key[q] == prefix) ? 1u : 0u; }
        const unsigned cnt = ngt | (neq << 16); unsigned inc = cnt;
#pragma unroll
        for (int o = 1; o < 64; o <<= 1) { const unsigned t = __shfl_up(inc, o); if (lane >= o) inc += t; }
        if (lane == 63) ctl[8 + c.wave] = inc;
        __syncthreads();
        unsigned base = 0u;
#pragma unroll
        for (int w = 0; w < 8; ++w) base += (w < c.wave) ? ctl[8 + w] : 0u;
        const unsigned ex = base + inc - cnt; unsigned gtb = ex & 0xffffu, eqb = ex >> 16;
        if (valid) {
#pragma unroll
            for (int q = 0; q < 4; ++q) { const int i = 4 * c.tid + q; int slot = -1;
                if (key[q] > prefix) { slot = (int)(gtb + (eqb < need ? eqb : need)); ++gtb; }
                else if (key[q] == prefix) { if (eqb < need) slot = (int)(gtb + eqb); ++eqb; }
                int gs = -1;
                if (slot >= 0) { gs = e * MR + slotbase + slot; sel[slot] = i; GATE[gs] = __uint_as_float(key[q]); }
                INV[(size_t)(rowbase + i) * NE + e] = gs; }
        }
        __syncthreads();
        for (int sidx = c.wave; sidx < cap; sidx += 8) {
            if (MOE_FP8) { const unsigned char* src = (const unsigned char*)HB + (size_t)(rowbase + sel[sidx]) * DM; unsigned char* dst = (unsigned char*)XG + (size_t)(e * MR + slotbase + sidx) * DM;
                *(v4u*)(dst + 16 * lane) = *(const v4u*)(src + 16 * lane); }
            else { const bf16* src = HB + (size_t)(rowbase + sel[sidx]) * DM; bf16* dst = XG + (size_t)(e * MR + slotbase + sidx) * DM;
            const v4u a0 = *(const v4u*)(src + 8 * lane), a1 = *(const v4u*)(src + 512 + 8 * lane);
            *(v4u*)(dst + 8 * lane) = a0; *(v4u*)(dst + 512 + 8 * lane) = a1; }
        }
        __syncthreads();
    }
}

__device__ __forceinline__ void ph_combine(const Params& p, const Ctx& c, int layer) {
    const bf16* YS = (const bf16*)(p.ws + WS_YS);
    const int* INV = (const int*)(p.ws + WS_INV);
    bf16* XS = (bf16*)(p.ws + WS_XS);
    bf16* HB = (bf16*)(p.ws + WS_HB);
    const float* lng = p.in[I_LNG] + (size_t)(layer * 2 + 1) * DM; const float* lnb = p.in[I_LNB] + (size_t)(layer * 2 + 1) * DM;
    const int nrows = layer == 0 ? NTOK : LAT;
    const int lane = c.lane;
    for (int row = 2 * c.gw; row < nrows; row += 2 * c.NGW) {
        const float* mod = mod_row(p, layer, row);
        const int inv = (lane < 2 * NE) ? INV[(size_t)row * NE + lane] : -1;
        const unsigned mall = (unsigned)__ballot(inv >= 0);
        unsigned ma = mall & 0xffffu, mb = mall >> 16;
        int sla[4], slb[4]; float wa[4], wb[4];
#pragma unroll
        for (int q = 0; q < 4; ++q) {
            if (ma) { const int e = __builtin_ctz(ma); ma &= ma - 1; sla[q] = __builtin_amdgcn_readlane(inv, e); wa[q] = 1.f; } else { sla[q] = 0; wa[q] = 0.f; }
            if (mb) { const int e = __builtin_ctz(mb); mb &= mb - 1; slb[q] = __builtin_amdgcn_readlane(inv, 16 + e); wb[q] = 1.f; } else { slb[q] = 0; wb[q] = 0.f; } }
        f32x4 moa[4], mob[4];
#pragma unroll
        for (int j = 0; j < 4; ++j) { moa[j] = (f32x4){0.f, 0.f, 0.f, 0.f}; mob[j] = (f32x4){0.f, 0.f, 0.f, 0.f}; }
#pragma unroll
        for (int q = 0; q < 4; ++q)
#pragma unroll
            for (int j = 0; j < 4; ++j) { moa[j] += unpack4(*(const v2u*)(YS + (size_t)sla[q] * DM + 4 * lane + 256 * j)) * wa[q]; mob[j] += unpack4(*(const v2u*)(YS + (size_t)slb[q] * DM + 4 * lane + 256 * j)) * wb[q]; }
        while (ma) { const int e = __builtin_ctz(ma); ma &= ma - 1; const int sl = __builtin_amdgcn_readlane(inv, e);
#pragma unroll
            for (int j = 0; j < 4; ++j) moa[j] += unpack4(*(const v2u*)(YS + (size_t)sl * DM + 4 * lane + 256 * j)); }
        while (mb) { const int e = __builtin_ctz(mb); mb &= mb - 1; const int sl = __builtin_amdgcn_readlane(inv, 16 + e);
#pragma unroll
            for (int j = 0; j < 4; ++j) mob[j] += unpack4(*(const v2u*)(YS + (size_t)sl * DM + 4 * lane + 256 * j)); }
        f32x4 va[4], vb[4]; float sa = 0.f, sb = 0.f;
#pragma unroll
        for (int j = 0; j < 4; ++j) { const int col = 4 * lane + 256 * j; const f32x4 g2 = *(const f32x4*)(mod + 5120 + col);
            va[j] = unpack4(*(const v2u*)(XS + (size_t)row * DM + col)) * ALPHA + g2 * moa[j];
            vb[j] = unpack4(*(const v2u*)(XS + (size_t)(row + 1) * DM + col)) * ALPHA + g2 * mob[j];
            sa += (va[j].x + va[j].y) + (va[j].z + va[j].w); sb += (vb[j].x + vb[j].y) + (vb[j].z + vb[j].w); }
        const float meana = wave_sum(sa) * (1.f / DM), meanb = wave_sum(sb) * (1.f / DM); float qa = 0.f, qb = 0.f;
#pragma unroll
        for (int j = 0; j < 4; ++j) { va[j] = va[j] - meana; vb[j] = vb[j] - meanb;
            qa += (va[j].x * va[j].x + va[j].y * va[j].y) + (va[j].z * va[j].z + va[j].w * va[j].w); qb += (vb[j].x * vb[j].x + vb[j].y * vb[j].y) + (vb[j].z * vb[j].z + vb[j].w * vb[j].w); }
        const float rstda = 1.f / sqrtf(wave_sum(qa) * (1.f / DM) + LN_EPS), rstdb = 1.f / sqrtf(wave_sum(qb) * (1.f / DM) + LN_EPS);
        const float* modn = mod_row(p, 1, row);
#pragma unroll
        for (int j = 0; j < 4; ++j) { const int col = 4 * lane + 256 * j;
            const f32x4 g = *(const f32x4*)(lng + col), bb = *(const f32x4*)(lnb + col);
            const f32x4 x2a = va[j] * rstda * g + bb, x2b = vb[j] * rstdb * g + bb;
            if (layer == 0) {
                *(v2u*)(XS + (size_t)row * DM + col) = (v2u){pk2(x2a.x, x2a.y), pk2(x2a.z, x2a.w)};
                *(v2u*)(XS + (size_t)(row + 1) * DM + col) = (v2u){pk2(x2b.x, x2b.y), pk2(x2b.z, x2b.w)};
                const f32x4 sc = *(const f32x4*)(modn + 1024 + col) + 1.f, sh = *(const f32x4*)(modn + col);
                const f32x4 ha = x2a * sc + sh, hb = x2b * sc + sh;
                *(v2u*)(HB + (size_t)row * DM + col) = (v2u){pk2(ha.x, ha.y), pk2(ha.z, ha.w)};
                *(v2u*)(HB + (size_t)(row + 1) * DM + col) = (v2u){pk2(hb.x, hb.y), pk2(hb.z, hb.w)};
            } else {
                *(f32x4*)(p.out + (size_t)row * DM + col) = x2a; *(f32x4*)(p.out + (size_t)(row + 1) * DM + col) = x2b;
            } }
    }
}

__device__ __forceinline__ void na_key(const float* q, float* o, float& m, float& l, const bf16* kp, const bf16* vp, float bias) {
    float s = bias;
#pragma unroll
    for (int i = 0; i < 8; ++i) { float f[8]; unpack8(*(const v4u*)(kp + 8 * i), f);
#pragma unroll
        for (int j = 0; j < 8; ++j) s += q[8 * i + j] * f[j]; }
    const float mn = fmaxf(m, s), al = exp2f(m - mn), pp = exp2f(s - mn);
    l = l * al + pp; m = mn;
#pragma unroll
    for (int i = 0; i < 8; ++i) { float f[8]; unpack8(*(const v4u*)(vp + 8 * i), f);
#pragma unroll
        for (int j = 0; j < 8; ++j) o[8 * i + j] = o[8 * i + j] * al + pp * f[j]; }
}
__device__ __forceinline__ void ph_mixer1_naive(const Params& p, const Ctx& c) {
    const bf16* P2 = (const bf16*)(p.ws + WS_QKV);
    bf16* CC = (bf16*)(p.ws + WS_CC);
    const float* rpb = p.in[I_RPB]; const float* pool_w = p.in[I_POOLW]; const float* pool_s = p.in[I_POOLS];
    LAS float* pl = (LAS float*)c.lds;
    for (int u = c.vcu; u < 256; u += c.G) {
        const int b = u >> 5, r = u & 31;
        {
            const int h = c.wave, col = c.lane, row = b * SEQ + r * 64 + col;
            const int rs = min(max(r - 4, 0), 24), cs = min(max(col - 8, 0), 48);
            float q[64], o[64];
#pragma unroll
            for (int i = 0; i < 8; ++i) unpack8(*(const v4u*)(P2 + (size_t)row * OIN + h * 64 + 8 * i), q + 8 * i);
#pragma unroll
            for (int i = 0; i < 64; ++i) o[i] = 0.f;
            float m = -1e30f, l = 0.f;
#pragma unroll 1
            for (int i = 0; i < 8; ++i)
#pragma unroll 1
                for (int j = 0; j < 16; ++j) {
                    const int krow = b * SEQ + (rs + i) * 64 + cs + j;
                    const float bias = rpb[(h * 15 + (rs + i - r + 7)) * 31 + (cs + j - col + 15)] * LOG2E;
                    na_key(q, o, m, l, P2 + (size_t)krow * OIN + 512 + h * 64, P2 + (size_t)krow * OIN + 1024 + h * 64, bias);
                }
#pragma unroll 1
            for (int j = 0; j < NCTX; ++j) {
                const int krow = LAT + b * NCTX + j;
                na_key(q, o, m, l, P2 + (size_t)krow * OIN + 512 + h * 64, P2 + (size_t)krow * OIN + 1024 + h * 64, 0.f);
            }
            const float rl = 1.f / l; bf16* dst = CC + (size_t)row * DM + h * 64;
#pragma unroll
            for (int i = 0; i < 8; ++i) *(v4u*)(dst + 8 * i) = (v4u){pk2(o[8 * i] * rl, o[8 * i + 1] * rl), pk2(o[8 * i + 2] * rl, o[8 * i + 3] * rl), pk2(o[8 * i + 4] * rl, o[8 * i + 5] * rl), pk2(o[8 * i + 6] * rl, o[8 * i + 7] * rl)};
        }
        __syncthreads();
        {
            const int ch = c.tid, g = ch >> 7, half = 1 << g;
            for (int tt = 0; tt < 64; ++tt) {
                const int t = r * 64 + tt, lo = max(t - half, 0), hi = min(t + half, SEQ);
                float s = 0.f;
                for (int t2 = lo; t2 < hi; ++t2) s += bf2f((unsigned)P2[(size_t)(b * SEQ + t2) * OIN + 1536 + ch]);
                pl[tt * 512 + ch] = s / (float)(hi - lo) - bf2f((unsigned)P2[(size_t)(b * SEQ + t) * OIN + 1536 + ch]);
            }
        }
        __syncthreads();
        {
            const int g = c.tid >> 7, e = c.tid & 127;
            const float ps = pool_s[g * 128 + e];
#pragma unroll 1
            for (int tb = 0; tb < 64; tb += 16) {
                float acc[16];
#pragma unroll
                for (int i = 0; i < 16; ++i) acc[i] = 0.f;
#pragma unroll 4
                for (int cc = 0; cc < 128; ++cc) {
                    const float w = pool_w[(size_t)(g * 128 + cc) * 128 + e];
#pragma unroll
                    for (int i = 0; i < 16; ++i) acc[i] += pl[(tb + i) * 512 + g * 128 + cc] * w;
                }
#pragma unroll
                for (int i = 0; i < 16; ++i) CC[(size_t)(b * SEQ + r * 64 + tb + i) * DM + 512 + g * 128 + e] = (bf16)f2bf(acc[i] * ps);
            }
        }
        __syncthreads();
    }
}


constexpr int NA_TAB_OFF = 86016 + 1024;
__device__ __forceinline__ void ph_mixer1_fast(const Params& p, const Ctx& c, char* lds_generic) {
    typedef attn_body::bf16 abf;
    const abf* P2a = (const abf*)(p.ws + WS_QKV); abf* CCa = (abf*)(p.ws + WS_CC);
    LAS float* tab = (LAS float*)(c.lds + NA_TAB_OFF);
    for (int i = c.tid; i < 8 * 15 * 32; i += 512) { const int hd = i >> 5, j = i & 31; tab[i] = j < 31 ? p.in[I_RPB][hd * 31 + j] * LOG2E : 0.f; }
    __syncthreads();
    for (int it = 0;; ++it) {
        const int U = it * c.G + c.vcu;
        if (U >= 512) break;
        const int b = U >> 6, h = (U >> 3) & 7, rq = U & 7;
        const int rs_min = min(max(4 * rq - 4, 0), 24);
        const int nloc = (rq == 0 || rq == 7) ? 8 : 12;
        attn_body::AU u;
        u.qrow0 = b * SEQ + rq * 256; u.lat_row0 = LAT + b * NCTX; u.nlat_t = 4; u.ctx_row0 = b * SEQ + rs_min * 64; u.NT = 4 + nloc;
        u.Qp = P2a + h * 64; u.Kp = P2a + 512 + h * 64; u.Vp = P2a + 1024 + h * 64; u.Op = CCa + h * 64;
        const int r = 4 * rq + (c.wave >> 1), col = (c.wave & 1) * 32 + (c.lane & 31), hi = c.lane >> 5;
        const int cs = min(max(col - 8, 0), 48);
        attn_body::NAMask mk; mk.tb0 = (attn_body::lds_cfptr)(tab + h * 15 * 32 + 15 - col); mk.r = r; mk.rs = min(max(r - 4, 0), 24); mk.rs_min = rs_min; mk.cb = 4 * hi - cs;
        attn_body::attn_unit<8, OIN, attn_body::NAMask>(u, lds_generic, mk);
    }
    __syncthreads();
    const bf16* P2 = (const bf16*)(p.ws + WS_QKV); bf16* CC = (bf16*)(p.ws + WS_CC);
    const float* pool_w = p.in[I_POOLW]; const float* pool_s = p.in[I_POOLS];
    constexpr int PLP = 1040;
    for (int u = c.vcu; u < 256; u += c.G) {
        const int b = u >> 5, r = u & 31;
        {   const int ch = c.tid, g = c.wave >> 1;
            const bf16* du = P2 + (size_t)b * SEQ * OIN + 1536 + ch;
            const int t0 = r * 64;
            float v[80];
#pragma unroll
            for (int k = 0; k < 80; ++k) { const int t2 = t0 - 8 + k; v[k] = ((t2 >= 0 && t2 < SEQ) ? 1.f : 0.f) * bf2f((unsigned)du[(size_t)min(max(t2, 0), SEQ - 1) * OIN]); }
            LAS bf16* plc = (LAS bf16*)(c.lds) + ch;
#define POOL_COL(HALF) do { float ws = 0.f; _Pragma("unroll") for (int k = 8 - HALF; k < 8 + HALF; ++k) ws += v[k]; \
            _Pragma("unroll") for (int tt = 0; tt < 64; ++tt) { const int t = t0 + tt, lo = max(t - HALF, 0), hi = min(t + HALF, SEQ); \
                plc[tt * (PLP / 2)] = (bf16)f2bf(ws / (float)(hi - lo) - v[tt + 8]); ws += v[tt + 8 + HALF] - v[tt + 8 - HALF]; } } while (0)
            if (g == 0) POOL_COL(1); else if (g == 1) POOL_COL(2); else if (g == 2) POOL_COL(4); else POOL_COL(8);
#undef POOL_COL
        }
        __syncthreads();
        {   typedef short bf16x8v __attribute__((ext_vector_type(8)));
            const int g = c.wave >> 1, th = c.wave & 1, l31 = c.lane & 31, lh = c.lane >> 5;
            f32x16 acc[4];
#pragma unroll
            for (int et = 0; et < 4; ++et) acc[et] = (f32x16){};
#pragma unroll
            for (int ks = 0; ks < 8; ++ks) {
                const bf16x8v af = *(const LAS bf16x8v*)(c.lds + (32 * th + l31) * PLP + (g * 128 + 16 * ks + 8 * lh) * 2);
#pragma unroll
                for (int et = 0; et < 4; ++et) {
                    const float* wp = pool_w + (size_t)(g * 128 + 16 * ks + 8 * lh) * 128 + 32 * et + l31;
                    bf16x8v bfr;
#pragma unroll
                    for (int j = 0; j < 8; ++j) bfr[j] = (short)f2bf(wp[(size_t)j * 128]);
                    acc[et] = __builtin_amdgcn_mfma_f32_32x32x16_bf16(af, bfr, acc[et], 0, 0, 0);
                }
            }
#pragma unroll
            for (int et = 0; et < 4; ++et) { const int e = 32 * et + l31; const float ps = pool_s[g * 128 + e];
#pragma unroll
                for (int rg = 0; rg < 16; ++rg) { const int tok = 32 * th + (rg & 3) + 8 * (rg >> 2) + 4 * lh;
                    CC[(size_t)(b * SEQ + r * 64 + tok) * DM + 512 + g * 128 + e] = (bf16)f2bf(acc[et][rg] * ps); } }
        }
        __syncthreads();
    }
}

__global__ void __launch_bounds__(512, 2) mk_fwd(Params p) {
    extern __shared__ __attribute__((aligned(16))) unsigned char lds_raw[];
    Ctx c;
    c.lds = (LAS unsigned char*)lds_raw;
    c.tid = threadIdx.x; c.lane = c.tid & 63; c.wave = __builtin_amdgcn_readfirstlane(c.tid >> 6);
    c.G = gridDim.x; { const int bx = blockIdx.x; c.vcu = (c.G % 8 == 0) ? (bx % 8) * (c.G / 8) + bx / 8 : bx; }
    c.gw = c.vcu * 8 + c.wave; c.NGW = c.G * 8;
    volatile LAS unsigned* MISC = (volatile LAS unsigned*)(c.lds + MISC_OFF);
    if (c.tid < 32) MISC[c.tid] = 0u;
    __syncthreads();
    gu32* ctl = (gu32*)(p.ws + WS_CTL);
    XcdBarrier bar; bar.bar = (unsigned*)(ctl + CW_BAR); bar.x = 0; bar.st = nullptr;
    if (!MK_MULTI) bar = xcd_barrier_post((unsigned*)(ctl + CW_BAR), MISC + 8);
    const int lo = p.ph_lo, hi = p.ph_hi;
    unsigned long long pt0 = 0, pt1 = 0; if (PROBE_PH == 0) pt0 = __builtin_amdgcn_s_memrealtime();
#define IN(k) (lo <= (k) && (k) < hi)
#define SEAM(k) do { if (IN(k) && IN((k) + 1) && !(FAST_ATTN && (k) == 5) && !(FAST_GEMM && FUSE_QKV && (k) == 3)) xcd_barrier(bar); if ((k) + 1 == PROBE_PH) pt0 = __builtin_amdgcn_s_memrealtime(); if ((k) == PROBE_PH) pt1 = __builtin_amdgcn_s_memrealtime(); } while (0)

    bf16* HB = (bf16*)(p.ws + WS_HB); bf16* QKV = (bf16*)(p.ws + WS_QKV); bf16* CC = (bf16*)(p.ws + WS_CC);
    float* Y = (float*)(p.ws + WS_Y); float* PF = (float*)(p.ws + WS_PF);
    bf16* XG = (bf16*)(p.ws + WS_XG); bf16* HID = (bf16*)(p.ws + WS_HID); bf16* YS = (bf16*)(p.ws + WS_YS);
    const float* GATE = (const float*)(p.ws + WS_GATE);

    if (IN(0)) for (int rep_ = 0; rep_ < 1 + (int)((PROBE_MASK >> 0) & 1u); ++rep_) { if (rep_) __syncthreads(); ph_prologue(p, c); if (FAST_GEMM) { __syncthreads(); ph_transposes(p, c); } } SEAM(0);
    if (IN(1)) for (int rep_ = 0; rep_ < 1 + (int)((PROBE_MASK >> 1) & 1u); ++rep_) { if (rep_) __syncthreads(); ph_modulate0(p, c); } SEAM(1);
    if (IN(2)) for (int rep_ = 0; rep_ < 1 + (int)((PROBE_MASK >> 2) & 1u); ++rep_) { if (rep_) __syncthreads();
        if (FAST_GEMM) { pg8::Gemm g{HB, (const bf16*)(p.ws + WS_W0IN), NTOK, EIN, DM, 0}; pg8::StaticOrder S; S.init(NTOK, EIN, c.G, (int)blockIdx.x);
            if (FUSE_QKV) { pg8::EpiQKV E{QKV, EIN, (const float*)(p.ws + WS_ROPE), p.in[I_QN], p.in[I_KN], C2, RMS_EPS}; pg8::gemm_phase<pg8::EpiQKV, pg8::StaticOrder, true, true>(c.lds, g, S, E); }
            else { pg8::EpiBf16<0> E{QKV, EIN, nullptr, 0, 0, 1.f}; pg8::gemm_phase<pg8::EpiBf16<0>, pg8::StaticOrder, true, true>(c.lds, g, S, E); } }
        else { NG g{HB, DM, p.in[I_W0IN], nullptr, EIN, 0, 1 << 30, 0, NTOK, 0, EIN, DM}; ngemm<1>(g, c, EpiF32{PF, EIN}); }
    } SEAM(2);
    if (!(FAST_GEMM && FUSE_QKV)) { if (IN(3)) { if (FAST_GEMM) ph_qkv_post<false>(p, c); else ph_qkv_post<true>(p, c); } } SEAM(3);
    if (IN(4)) for (int rep_ = 0; rep_ < 1 + (int)((PROBE_MASK >> 4) & 1u); ++rep_) { if (rep_) __syncthreads(); if (FAST_ATTN) ph_attn0_fast(p, c, (char*)lds_raw); else ph_attn0_naive(p, c); } SEAM(4);
    if (!FAST_ATTN) { if (IN(5)) { ph_attn_combine(p, c); } } SEAM(5);
    if (IN(6)) for (int rep_ = 0; rep_ < 1 + (int)((PROBE_MASK >> 6) & 1u); ++rep_) { if (rep_) __syncthreads();
        if (FAST_GEMM) { pg8::Gemm g{CC, (const bf16*)(p.ws + WS_W0OUT), NTOK, DM, DM, 0}; pg8::StaticOrder S; S.init(NTOK, DM, c.G, (int)blockIdx.x);
            pg8::EpiBf16<0> E{(bf16*)Y, DM, nullptr, 0, 0, 1.f}; pg8::gemm_phase<pg8::EpiBf16<0>, pg8::StaticOrder, true, true>(c.lds, g, S, E); }
        else { NG g{CC, DM, p.in[I_W0OUT], nullptr, DM, 0, 1 << 30, 0, NTOK, 0, DM, DM}; ngemm<1>(g, c, EpiBf{(bf16*)Y, DM, 0, 1.f}); }
    } SEAM(6);
    if (IN(7)) for (int rep_ = 0; rep_ < 1 + (int)((PROBE_MASK >> 7) & 1u); ++rep_) { if (rep_) __syncthreads(); ph_ln1_router(p, c, 0); } SEAM(7);
    if (IN(8)) for (int rep_ = 0; rep_ < 1 + (int)((PROBE_MASK >> 8) & 1u); ++rep_) { if (rep_) __syncthreads(); ph_topk(p, c, 0); } SEAM(8);
    if (IN(9)) for (int rep_ = 0; rep_ < 1 + (int)((PROBE_MASK >> 9) & 1u); ++rep_) { if (rep_) __syncthreads();
        if (FAST_GEMM && MOE_FP8) { pg8::Gemm g{XG, (const bf16*)(p.ws + WS_WGU), NE * MR0, 4096, DM / 2, (size_t)4096 * DM}; pg8::GroupedOrder S; S.init(MR0 / 256, 16, NE, c.G, c.vcu);
            pg8::EpiSwigluF8 E{(unsigned char*)HID, FF, 1.f / W8_GU, H8_SC}; pg8::gemm_phase<pg8::EpiSwigluF8, pg8::GroupedOrder, true, true, true>(c.lds, g, S, E); }
        else if (FAST_GEMM) { pg8::Gemm g{XG, (const bf16*)(p.ws + WS_WGU), NE * MR0, 4096, DM, (size_t)4096 * DM * 2}; pg8::GroupedOrder S; S.init(MR0 / 256, 16, NE, c.G, c.vcu);
            pg8::EpiSwigluP E{HID, FF}; pg8::gemm_phase<pg8::EpiSwigluP, pg8::GroupedOrder, true, true>(c.lds, g, S, E); }
        else { NG g{XG, DM, p.in[I_WG], p.in[I_WU], FF, (size_t)DM * FF, MR0, 0, NE * MR0, 0, FF, DM}; ngemm<2>(g, c, EpiSwiglu{HID}); }
    } SEAM(9);
    if (IN(10)) for (int rep_ = 0; rep_ < 1 + (int)((PROBE_MASK >> 10) & 1u); ++rep_) { if (rep_) __syncthreads();
        if (FAST_GEMM && MOE_FP8) { pg8::Gemm g{HID, (const bf16*)(p.ws + WS_WDN), NE * MR0, DM, FF / 2, (size_t)DM * FF}; pg8::GroupedOrder S; S.init(MR0 / 256, 4, NE, c.G, c.vcu);
            pg8::EpiGateS E{YS, DM, GATE, 1.f / (W8_DN * H8_SC)}; pg8::gemm_phase<pg8::EpiGateS, pg8::GroupedOrder, true, true, true>(c.lds, g, S, E); }
        else if (FAST_GEMM) { pg8::Gemm g{HID, (const bf16*)(p.ws + WS_WDN), NE * MR0, DM, FF, (size_t)DM * FF * 2}; pg8::GroupedOrder S; S.init(MR0 / 256, 4, NE, c.G, c.vcu);
            pg8::EpiGateP E{YS, DM, GATE}; pg8::gemm_phase<pg8::EpiGateP, pg8::GroupedOrder, true, true>(c.lds, g, S, E); }
        else { NG g{HID, FF, p.in[I_WD], nullptr, DM, (size_t)FF * DM, MR0, 0, NE * MR0, 0, DM, FF}; ngemm<1>(g, c, EpiGate{YS, GATE}); }
    } SEAM(10);
    if (IN(11)) for (int rep_ = 0; rep_ < 1 + (int)((PROBE_MASK >> 11) & 1u); ++rep_) { if (rep_) __syncthreads(); ph_combine(p, c, 0); } SEAM(11);
    if (IN(12)) for (int rep_ = 0; rep_ < 1 + (int)((PROBE_MASK >> 12) & 1u); ++rep_) { if (rep_) __syncthreads();
        if (FAST_GEMM) { pg8::Gemm g{HB, (const bf16*)(p.ws + WS_W1IN), NTOK, OIN, DM, 0}; pg8::L1InOrder S; S.init(c.G, (int)blockIdx.x);
            pg8::EpiBf16<0> E{QKV, OIN, nullptr, 512, 512, C2}; pg8::gemm_phase<pg8::EpiBf16<0>, pg8::L1InOrder, true, true>(c.lds, g, S, E); }
        else {
        NG g{HB, DM, p.in[I_W1IN], nullptr, OIN, 0, 1 << 30, 0, LAT, 0, OIN, DM}; ngemm<1>(g, c, EpiBf{QKV, OIN, 512, C2});
        NG g2{HB, DM, p.in[I_W1IN], nullptr, OIN, 0, 1 << 30, LAT, NTOK, 512, 1536, DM}; ngemm<1>(g2, c, EpiBf{QKV, OIN, 0, 1.f}); }
    } SEAM(12);
    if (IN(13)) for (int rep_ = 0; rep_ < 1 + (int)((PROBE_MASK >> 13) & 1u); ++rep_) { if (rep_) __syncthreads(); if (FAST_NA) ph_mixer1_fast(p, c, (char*)lds_raw); else ph_mixer1_naive(p, c); } SEAM(13);
    if (IN(14)) for (int rep_ = 0; rep_ < 1 + (int)((PROBE_MASK >> 14) & 1u); ++rep_) { if (rep_) __syncthreads();
        if (FAST_GEMM) { pg8::Gemm g{CC, (const bf16*)(p.ws + WS_W1OUT), LAT, DM, DM, 0}; pg8::StaticOrder S; S.init(LAT, DM, c.G, (int)blockIdx.x);
            pg8::EpiBf16<0> E{(bf16*)Y, DM, nullptr, 0, 0, 1.f}; pg8::gemm_phase<pg8::EpiBf16<0>, pg8::StaticOrder, true, true>(c.lds, g, S, E); }
        else { NG g{CC, DM, p.in[I_W1OUT], nullptr, DM, 0, 1 << 30, 0, LAT, 0, DM, DM}; ngemm<1>(g, c, EpiBf{(bf16*)Y, DM, 0, 1.f}); }
    } SEAM(14);
    if (IN(15)) for (int rep_ = 0; rep_ < 1 + (int)((PROBE_MASK >> 15) & 1u); ++rep_) { if (rep_) __syncthreads(); ph_ln1_router(p, c, 1); } SEAM(15);
    if (IN(16)) for (int rep_ = 0; rep_ < 1 + (int)((PROBE_MASK >> 16) & 1u); ++rep_) { if (rep_) __syncthreads(); ph_topk(p, c, 1); } SEAM(16);
    if (IN(17)) for (int rep_ = 0; rep_ < 1 + (int)((PROBE_MASK >> 17) & 1u); ++rep_) { if (rep_) __syncthreads();
        if (FAST_GEMM && MOE_FP8) { pg8::Gemm g{XG, (const bf16*)(p.ws + WS_WGU + WS_MOE_LSTRIDE), NE * MR1, 4096, DM / 2, (size_t)4096 * DM}; pg8::GroupedOrder S; S.init(MR1 / 256, 16, NE, c.G, c.vcu);
            pg8::EpiSwigluF8 E{(unsigned char*)HID, FF, 1.f / W8_GU, H8_SC}; pg8::gemm_phase<pg8::EpiSwigluF8, pg8::GroupedOrder, true, true, true>(c.lds, g, S, E); }
        else if (FAST_GEMM) { pg8::Gemm g{XG, (const bf16*)(p.ws + WS_WGU + WS_MOE_LSTRIDE), NE * MR1, 4096, DM, (size_t)4096 * DM * 2}; pg8::GroupedOrder S; S.init(MR1 / 256, 16, NE, c.G, c.vcu);
            pg8::EpiSwigluP E{HID, FF}; pg8::gemm_phase<pg8::EpiSwigluP, pg8::GroupedOrder, true, true>(c.lds, g, S, E); }
        else { NG g{XG, DM, p.in[I_WG] + (size_t)NE * DM * FF, p.in[I_WU] + (size_t)NE * DM * FF, FF, (size_t)DM * FF, MR1, 0, NE * MR1, 0, FF, DM}; ngemm<2>(g, c, EpiSwiglu{HID}); }
    } SEAM(17);
    if (IN(18)) for (int rep_ = 0; rep_ < 1 + (int)((PROBE_MASK >> 18) & 1u); ++rep_) { if (rep_) __syncthreads();
        if (FAST_GEMM && MOE_FP8) { pg8::Gemm g{HID, (const bf16*)(p.ws + WS_WDN + WS_MOE_LSTRIDE), NE * MR1, DM, FF / 2, (size_t)DM * FF}; pg8::GroupedOrder S; S.init(MR1 / 256, 4, NE, c.G, c.vcu);
            pg8::EpiGateS E{YS, DM, GATE, 1.f / (W8_DN * H8_SC)}; pg8::gemm_phase<pg8::EpiGateS, pg8::GroupedOrder, true, true, true>(c.lds, g, S, E); }
        else if (FAST_GEMM) { pg8::Gemm g{HID, (const bf16*)(p.ws + WS_WDN + WS_MOE_LSTRIDE), NE * MR1, DM, FF, (size_t)DM * FF * 2}; pg8::GroupedOrder S; S.init(MR1 / 256, 4, NE, c.G, c.vcu);
            pg8::EpiGateP E{YS, DM, GATE}; pg8::gemm_phase<pg8::EpiGateP, pg8::GroupedOrder, true, true>(c.lds, g, S, E); }
        else { NG g{HID, FF, p.in[I_WD] + (size_t)NE * FF * DM, nullptr, DM, (size_t)FF * DM, MR1, 0, NE * MR1, 0, DM, FF}; ngemm<1>(g, c, EpiGate{YS, GATE}); }
    } SEAM(18);
    if (IN(19)) for (int rep_ = 0; rep_ < 1 + (int)((PROBE_MASK >> 19) & 1u); ++rep_) { if (rep_) __syncthreads(); ph_combine(p, c, 1); }
    if (PROBE_PH == 19) pt1 = __builtin_amdgcn_s_memrealtime();
    if (PROBE_PH >= 0 && blockIdx.x == 0 && c.tid == 0) { const unsigned long long te = __builtin_amdgcn_s_memrealtime(); while (__builtin_amdgcn_s_memrealtime() - te < pt1 - pt0) __builtin_amdgcn_s_sleep(8); }
#undef IN
#undef SEAM
}

extern "C" void kernel_launch(void* const* d_in, const int* in_sizes, int n_in, void* d_out, int out_size, void* d_ws, size_t ws_size, hipStream_t stream) {
    static int grid = 0;
    if (grid == 0) {
        if (n_in != 26 || out_size != LAT * DM || ws_size < WS_END) { fprintf(stderr, "kernel_launch: unexpected shapes (n_in %d out %d ws %zu)\n", n_in, out_size, ws_size); grid = -1; return; }
        int dev = 0, cus = 0;
        if (hipGetDevice(&dev) != hipSuccess || hipDeviceGetAttribute(&cus, hipDeviceAttributeMultiprocessorCount, dev) != hipSuccess) { grid = -1; return; }
        if (hipFuncSetAttribute((const void*)mk_fwd, hipFuncAttributeMaxDynamicSharedMemorySize, LDS_BYTES) != hipSuccess) { fprintf(stderr, "kernel_launch: hipFuncSetAttribute failed\n"); grid = -1; return; }
        int per_cu = 0;
        if (hipOccupancyMaxActiveBlocksPerMultiprocessor(&per_cu, (const void*)mk_fwd, 512, LDS_BYTES) != hipSuccess || per_cu < 1) fprintf(stderr, "kernel_launch: occupancy query says %d\n", per_cu);
        (void)hipGetLastError();
        grid = cus;
    }
    if (grid < 0) return;
    (void)hipMemsetAsync((char*)d_ws + WS_CTL, 0, CTL_ZERO_BYTES, stream);
    Params a{};
    for (int i = 0; i < 26; ++i) a.in[i] = (const float*)d_in[i];
    a.out = (float*)d_out; a.ws = (unsigned char*)d_ws;
#if MK_MULTI
    for (int ph = 0; ph < NPHASE; ++ph) { a.ph_lo = ph; a.ph_hi = ph + 1; hipLaunchKernelGGL(mk_fwd, dim3(grid), dim3(512), LDS_BYTES, stream, a); }
#else
    a.ph_lo = 0; a.ph_hi = NPHASE;
    hipLaunchKernelGGL(mk_fwd, dim3(grid), dim3(512), LDS_BYTES, stream, a);
#endif
}
```

```cpp
#include <hip/hip_runtime.h>
#include <cstdio>
#include <cstdint>

#define GAS __attribute__((address_space(1)))
#define LAS __attribute__((address_space(3)))
typedef unsigned short bf16;
typedef unsigned v4u __attribute__((ext_vector_type(4)));
typedef unsigned v2u __attribute__((ext_vector_type(2)));
typedef float f32x4 __attribute__((ext_vector_type(4)));
typedef float f32x2 __attribute__((ext_vector_type(2)));
typedef float f32x16 __attribute__((ext_vector_type(16)));
typedef GAS unsigned gu32;

#ifndef PROBE_PH
#define PROBE_PH -1
#endif
#ifndef PROBE_MASK
#define PROBE_MASK 0u
#endif
#ifndef TAIL_TRANSPOSE
#define TAIL_TRANSPOSE 1
#endif
#ifndef FUSE_QKV
#define FUSE_QKV 1
#endif
#ifndef MOE_FP8
#define MOE_FP8 1
#endif
#ifndef FAST_NA
#define FAST_NA 1
#endif
#ifndef FAST_ATTN
#define FAST_ATTN 1
#endif
#ifndef FAST_GEMM
#define FAST_GEMM 1
#endif
#ifndef MK_MULTI
#define MK_MULTI 0
#endif

constexpr int NBATCH = 8, SEQ = 2048, DM = 1024, NCTX = 256;
constexpr int LAT = NBATCH * SEQ;
constexpr int NTOK = LAT + NBATCH * NCTX;
constexpr int EIN = 2304, OIN = 2048, NE = 16, FF = 2048;
constexpr int MR0 = 2304, MR1 = 2048;
constexpr float LOG2E = 1.4426950408889634f;
constexpr float C2 = 0.125f * LOG2E;
constexpr float ALPHA = 1.4142135623730951f;
constexpr float LN_EPS = 1e-5f, RMS_EPS = 1e-6f;
constexpr float LAM_INIT = 0.2f;
constexpr int NPHASE = 20;
constexpr float W8_GU = 32.f, W8_DN = 64.f, H8_SC = 8.f;

constexpr size_t MiB = 1u << 20;
constexpr size_t WS_CTL = 0, CTL_ZERO_BYTES = 1 * MiB;
constexpr size_t WS_MOD = 1 * MiB;
constexpr size_t WS_ROPE = 1 * MiB + 512 * 1024;
constexpr size_t WS_W0IN = 2 * MiB;
constexpr size_t WS_W0OUT = 7 * MiB;
constexpr size_t WS_W1IN = 9 * MiB;
constexpr size_t WS_W1OUT = 13 * MiB;
constexpr size_t WS_AFF = 16 * MiB;
constexpr size_t WS_INV = 18 * MiB;
constexpr size_t WS_GATE = 20 * MiB;
constexpr size_t WS_WGU = 24 * MiB;
constexpr size_t WS_WDN = 152 * MiB;
constexpr size_t WS_MOE_LSTRIDE = 192 * MiB;
constexpr size_t WS_XS = 408 * MiB;
constexpr size_t WS_HB = 480 * MiB;
constexpr size_t WS_QKV = 516 * MiB;
constexpr size_t WS_CC = 597 * MiB;
constexpr size_t WS_AO = 633 * MiB;
constexpr size_t WS_Y = 705 * MiB;
constexpr size_t WS_XG = 516 * MiB;
constexpr size_t WS_HID = 588 * MiB;
constexpr size_t WS_YS = 732 * MiB;
constexpr size_t WS_PF = 804 * MiB;
constexpr size_t WS_END = 968 * MiB;

constexpr int CW_BAR = 4096;
constexpr int LDS_BYTES = 147456;
constexpr int MISC_OFF = 131072 + 320;

__device__ __forceinline__ float bf2f(unsigned v) { return __uint_as_float(v << 16); }
__device__ __forceinline__ unsigned f2bf(float f) { unsigned u = __float_as_uint(f); return (u + 0x7fffu + ((u >> 16) & 1u)) >> 16; }
__device__ __forceinline__ unsigned pk2(float lo, float hi) { return f2bf(lo) | (f2bf(hi) << 16); }
__device__ __forceinline__ float wave_sum(float v) {
#pragma unroll
    for (int o = 1; o < 64; o <<= 1) v += __shfl_xor(v, o);
    return v;
}
__device__ __forceinline__ float wave_max(float v) {
#pragma unroll
    for (int o = 1; o < 64; o <<= 1) v = fmaxf(v, __shfl_xor(v, o));
    return v;
}
__device__ __forceinline__ void unpack8(const v4u w, float* f) {
    f[0] = bf2f(w.x & 0xffffu); f[1] = __uint_as_float(w.x & 0xffff0000u);
    f[2] = bf2f(w.y & 0xffffu); f[3] = __uint_as_float(w.y & 0xffff0000u);
    f[4] = bf2f(w.z & 0xffffu); f[5] = __uint_as_float(w.z & 0xffff0000u);
    f[6] = bf2f(w.w & 0xffffu); f[7] = __uint_as_float(w.w & 0xffff0000u);
}

#define XB_TMO      128
#define XB_XCNT(j)  (256  + 64 * (j))
#define XB_XSUB(j)  (1280 + 64 * (j))
#define XB_XGEN(j)  (2304 + 64 * (j))
#define XB_TOP      3328
#define XB_TOPGEN   3392
#define XCD_BAR_WORDS 3456
#define XB_SPIN_CAP (1u << 18)
__device__ __forceinline__ unsigned xb_ld(unsigned* p)              { return __hip_atomic_load(p, __ATOMIC_RELAXED, __HIP_MEMORY_SCOPE_AGENT); }
__device__ __forceinline__ unsigned xb_add(unsigned* p, unsigned v) { return __hip_atomic_fetch_add(p, v, __ATOMIC_RELAXED, __HIP_MEMORY_SCOPE_AGENT); }
__device__ __forceinline__ unsigned xb_xcc_id() { return (unsigned)__builtin_amdgcn_s_getreg((3 << 11) | 20) & 0xFu; }
#define XB_SPIN(cond, bar) do { unsigned _sp = 0; while (cond) { __builtin_amdgcn_s_sleep(1); \
    if ((++_sp & 255u) == 0u) { if (xb_ld(&(bar)[XB_TMO])) break; if (_sp > XB_SPIN_CAP) { atomicAdd(&(bar)[XB_TMO], 1u); break; } } } } while (0)
struct XcdBarrier { unsigned* bar; unsigned x; volatile LAS unsigned* st; };
__device__ __forceinline__ XcdBarrier xcd_barrier_post(unsigned* bar, volatile LAS unsigned* st) {
    XcdBarrier b; b.bar = bar; b.x = xb_xcc_id(); b.st = st;
    if (threadIdx.x == 0) (void)xb_add(&bar[XB_XCNT(b.x)], 1u);
    return b;
}
__device__ __forceinline__ void xcd_barrier_complete(unsigned* bar, unsigned x, unsigned& nloc, unsigned& nx) {
    const unsigned G = gridDim.x * gridDim.y * gridDim.z;
    unsigned sum, cnt, mine, sp = 0u;
    for (;;) {
        sum = 0u; cnt = 0u; mine = 0u;
#pragma unroll
        for (unsigned j = 0; j < 16; ++j) { const unsigned c = xb_ld(&bar[XB_XCNT(j)]); sum += c; cnt += (c > 0u) ? 1u : 0u; mine = (j == x) ? c : mine; }
        if (sum == G) break;
        __builtin_amdgcn_s_sleep(1);
        if ((++sp & 255u) == 0u) { if (xb_ld(&bar[XB_TMO])) break; if (sp > XB_SPIN_CAP) { atomicAdd(&bar[XB_TMO], 1u); break; } }
    }
    nloc = mine > 0u ? mine : 1u; nx = cnt > 0u ? cnt : 1u;
}
__device__ __forceinline__ void xcd_barrier(const XcdBarrier& b) {
    asm volatile("s_waitcnt vmcnt(0)" ::: "memory");
    __syncthreads();
    if (threadIdx.x == 0) {
        unsigned* bar = b.bar;
        __builtin_amdgcn_s_waitcnt(0);
        unsigned nloc = b.st[0], nx = b.st[1];
        if (nloc == 0u) { xcd_barrier_complete(bar, b.x, nloc, nx); b.st[0] = nloc; b.st[1] = nx; }
        const unsigned old = xb_add(&bar[XB_XSUB(b.x)], 1u);
        const unsigned gen = old / nloc;
        if (old + 1u == (gen + 1u) * nloc) {
            __builtin_amdgcn_fence(__ATOMIC_RELEASE, "agent");
            asm volatile("s_waitcnt vmcnt(0)" ::: "memory");
            const unsigned og = xb_add(&bar[XB_TOP], 1u);
            const unsigned tg = og / nx;
            if (og + 1u == (tg + 1u) * nx) xb_add(&bar[XB_TOPGEN], 1u);
            else XB_SPIN(xb_ld(&bar[XB_TOPGEN]) == tg, bar);
            __builtin_amdgcn_fence(__ATOMIC_ACQUIRE, "agent");
            xb_add(&bar[XB_XGEN(b.x)], 1u);
            asm volatile("s_waitcnt vmcnt(0)" ::: "memory");
        } else {
            XB_SPIN(xb_ld(&bar[XB_XGEN(b.x)]) == gen, bar);
            __builtin_amdgcn_fence(__ATOMIC_ACQUIRE, "agent");
            asm volatile("s_waitcnt vmcnt(0)" ::: "memory");
        }
    }
    __syncthreads();
}

namespace pg8 {
#define PG8_LAS __attribute__((address_space(3)))
typedef unsigned short bf16_t;
typedef short bf16x8 __attribute__((ext_vector_type(8)));
typedef float f32x4 __attribute__((ext_vector_type(4)));
typedef unsigned u32x4 __attribute__((ext_vector_type(4)));
constexpr int BM = 256, BK = 64, HALF = 128, HTB = HALF * BK * 2  , STAGE_BYTES = 8 * HTB, NXCD = 8, WGM = 8;

__host__ __device__ __forceinline__ int lds_byte(int r, int c) { const int st = (r >> 4) * 2 + (c >> 5), rr = r & 15, cc = c & 31, ob = rr * 64 + cc * 2; return st * 1024 + (ob ^ (((ob >> 9) & 1) << 5)); }
__host__ __device__ __forceinline__ void stage_rc(int b, int& R, int& C) { const int st = b / 1024, sb = b % 1024, swz = sb ^ (((sb >> 9) & 1) << 5); R = (st >> 1) * 16 + swz / 64; C = (st & 1) * 32 + (swz % 64) / 2; }
__host__ __device__ __forceinline__ int perm32(int rho) { const int n = rho >> 4, i = rho & 15; return 8 * (i >> 2) + 4 * n + (i & 3); }

struct Unit { int pm, pn, e; };
struct Gemm { const bf16_t* A; const bf16_t* Bt; int M, N, K; size_t bstride; };

struct StaticOrder {
    int nM, nN, nwg, G, c;
    __host__ __device__ void init(int M, int N, int G_, int c_) { nM = M / BM; nN = N / BM; nwg = nM * nN; G = G_; c = c_; }
    __host__ __device__ bool next(int i, Unit& u) const {
        const long L = (long)i * G + c; if (L >= nwg) return false;
        int wgid = (int)L; { const int q = nwg / NXCD, r = nwg % NXCD, xcd = wgid % NXCD, off = wgid / NXCD; wgid = (xcd < r ? xcd * (q + 1) : r * (q + 1) + (xcd - r) * q) + off; }
        const int nig = WGM * nN, gid = wgid / nig, fm = gid * WGM, gsz = (nM - fm) < WGM ? (nM - fm) : WGM;
        u.pm = fm + ((wgid % nig) % gsz); u.pn = (wgid % nig) / gsz; u.e = 0; return true;
    }
    __device__ __forceinline__ void a_ready(const Unit&) const {}
    __device__ __forceinline__ void done(const Unit&) const {}
};

__device__ __forceinline__ unsigned cvt_pk_bf16(float lo, float hi) { unsigned r; asm volatile("v_cvt_pk_bf16_f32 %0, %1, %2" : "=v"(r) : "v"(lo), "v"(hi)); return r; }
typedef float f32x2 __attribute__((ext_vector_type(2)));
__device__ __forceinline__ f32x2 gelu_pk(f32x2 v) {
    const f32x2 av = __builtin_elementwise_abs(v), d = av * 0.2316418882f + 1.0f;
    f32x2 t; t.x = __builtin_amdgcn_rcpf(d.x); t.y = __builtin_amdgcn_rcpf(d.y);
    f32x2 q = t * 0.5307027145f + (-0.7265760135f); q = q * t + 0.7107068705f; q = q * t + (-0.142248368f); q = q * t + 0.127414796f; q = q * t;
    const f32x2 s = (v * v) * (-0.72134752044f);
    f32x2 e; e.x = __builtin_amdgcn_exp2f(s.x); e.y = __builtin_amdgcn_exp2f(s.y);
    const f32x2 m = v * (q * e), r = v - m;
    f32x2 o; o.x = v.x < 0.f ? m.x : r.x; o.y = v.y < 0.f ? m.y : r.y; return o;
}

template <int ACT  > struct EpiBf16 {
    static constexpr bool PERM = true, AFTER_DRAIN = false; static_assert(ACT == 0 || ACT == 1, "EpiBf16: ACT is 0 (none) or 1 (gelu_pk)");
    bf16_t* O; int ldc; const float* bias; int split_cols; size_t split_stride; float scale0;
    __device__ __forceinline__ void operator()(const f32x4 (&acc)[2][2][4][2], const Unit& u, int wr, int wc, int fr, int fq) const {
        const int row0 = u.pm * BM + wr * 64 + fr; int colt = u.pn * BM; bf16_t* base = O;
        float sc = 1.f; if (split_cols) { const int t = colt / split_cols; base += (size_t)t * split_stride; colt -= t * split_cols; if (t == 0) sc = scale0; }
        const int col0 = colt + wc * 32 + 8 * fq, bcol0 = u.pn * BM + wc * 32 + 8 * fq;
        f32x4 bv[2][2];
#pragma unroll
        for (int bj = 0; bj < 2; ++bj)
#pragma unroll
            for (int n = 0; n < 2; ++n) bv[bj][n] = bias ? *(const f32x4*)(bias + bcol0 + bj * HALF + 4 * n) : (f32x4){0.f, 0.f, 0.f, 0.f};
#pragma unroll
        for (int ai = 0; ai < 2; ++ai)
#pragma unroll
            for (int m = 0; m < 4; ++m) { bf16_t* rowp = base + (size_t)(row0 + ai * HALF + m * 16) * ldc + col0;
#pragma unroll
                for (int bj = 0; bj < 2; ++bj) { f32x4 v0 = acc[ai][bj][m][0] + bv[bj][0], v1 = acc[ai][bj][m][1] + bv[bj][1];
                    if (ACT == 1) { f32x2 a = gelu_pk((f32x2){v0[0], v0[1]}), b = gelu_pk((f32x2){v0[2], v0[3]}), c = gelu_pk((f32x2){v1[0], v1[1]}), d = gelu_pk((f32x2){v1[2], v1[3]});
                        v0 = (f32x4){a.x, a.y, b.x, b.y}; v1 = (f32x4){c.x, c.y, d.x, d.y}; }
                    v0 = v0 * sc; v1 = v1 * sc; u32x4 w; w.x = cvt_pk_bf16(v0[0], v0[1]); w.y = cvt_pk_bf16(v0[2], v0[3]); w.z = cvt_pk_bf16(v1[0], v1[1]); w.w = cvt_pk_bf16(v1[2], v1[3]);
                    *(u32x4*)(rowp + bj * HALF) = w; } }
    }
};

typedef int i32x4 __attribute__((ext_vector_type(4))); typedef int i32x8 __attribute__((ext_vector_type(8)));
__device__ __forceinline__ i32x8 cat16(bf16x8 lo, bf16x8 hi) { const i32x4 a = __builtin_bit_cast(i32x4, lo), b = __builtin_bit_cast(i32x4, hi); return __builtin_shufflevector(a, b, 0, 1, 2, 3, 4, 5, 6, 7); }
__device__ __forceinline__ void mfma_f8_acc(f32x4& acc, const i32x8& b, const i32x8& a, int sc) {
    asm volatile("v_mfma_scale_f32_16x16x128_f8f6f4 %0, %1, %2, %0, %3, %3 op_sel_hi:[0,0,0]" : "+v"(acc) : "v"(b), "v"(a), "v"(sc)); }
template <class Epi, class Sched, bool ALIGN_EPI = false, bool SP2 = false, bool FP8 = false>
__device__ __forceinline__ void gemm_phase(PG8_LAS unsigned char* lds, const Gemm g, const Sched& S, const Epi& E) {
    const int tid = threadIdx.x, wid = __builtin_amdgcn_readfirstlane(tid >> 6), lane = tid & 63, wr = wid >> 2, wc = wid & 3, fr = lane & 15, fq = lane >> 4;
    const int K = g.K, nt = K / BK;
    unsigned voffA[2], voffB[2];
#pragma unroll
    for (int i = 0; i < 2; ++i) { int R, C; stage_rc(tid * 16 + i * 8192, R, C); const int Rb = Epi::PERM ? ((R & ~31) + perm32(R & 31)) : R;
        voffA[i] = (unsigned)(R * K + C) * 2u; voffB[i] = (unsigned)(Rb * K + C) * 2u; }
    const size_t kstep = (size_t)(BK * 2);
    const size_t hstep = (size_t)HALF * K * 2;
    const size_t tstep = 2 * hstep;
    const unsigned ldsw = (unsigned)wid * 1024u;
    const int aoff = FP8 ? lds_byte(wr * 64 + fr, 16 * fq) : lds_byte(wr * 64 + fr, fq * 8), boff = FP8 ? lds_byte(wc * 32 + fr, 16 * fq) : lds_byte(wc * 32 + fr, fq * 8);
    constexpr int KOFF = FP8 ? 16 : 1024;
#define PG8_SA(b, h) (((b) * 2 + (h)) * HTB)
#define PG8_SB(b, h) ((4 + (b) * 2 + (h)) * HTB)
#define PG8_STAGE(bufoff, gbase, voff) do { _Pragma("unroll") for (int _i = 0; _i < 2; ++_i) \
        __builtin_amdgcn_global_load_lds((const unsigned*)((const char*)(gbase) + (voff)[_i]), (PG8_LAS unsigned*)(lds + (bufoff) + ldsw + _i * 8192), 16, 0, 0); } while (0)
#define PG8_LDA(dst, b, h) do { _Pragma("unroll") for (int m = 0; m < 4; ++m) _Pragma("unroll") for (int k = 0; k < 2; ++k) dst[m][k] = *(const PG8_LAS bf16x8*)(lds + PG8_SA(b, h) + aoff + m * 2048 + k * KOFF); } while (0)
#define PG8_LDB(dst, b, h) do { _Pragma("unroll") for (int n = 0; n < 2; ++n) _Pragma("unroll") for (int k = 0; k < 2; ++k) dst[n][k] = *(const PG8_LAS bf16x8*)(lds + PG8_SB(b, h) + boff + n * 2048 + k * KOFF); } while (0)
#define PG8_MMA(ai, bj, At, Bt) do { __builtin_amdgcn_s_setprio(1); _Pragma("unroll") for (int m = 0; m < 4; ++m) _Pragma("unroll") for (int n = 0; n < 2; ++n) { \
        if constexpr (FP8) mfma_f8_acc(acc[ai][bj][m][n], cat16(Bt[n][0], Bt[n][1]), cat16(At[m][0], At[m][1]), f8scale); \
        else { _Pragma("unroll") for (int k = 0; k < 2; ++k) acc[ai][bj][m][n] = __builtin_amdgcn_mfma_f32_16x16x32_bf16(Bt[n][k], At[m][k], acc[ai][bj][m][n], 0, 0, 0); } } __builtin_amdgcn_s_setprio(0); } while (0)
#define PG8_WAIT_V(n) asm volatile("s_waitcnt vmcnt(" #n ")" ::: "memory")
#define PG8_WAIT_L(n) asm volatile("s_waitcnt lgkmcnt(" #n ")" ::: "memory")
#define PG8_BAR __builtin_amdgcn_s_barrier()
#define PG8_SCHED __builtin_amdgcn_sched_barrier(0)
    Unit cur, nxt; int ui = 0;
    if (!S.next(0, cur)) return;
    f32x4 acc[2][2][4][2];
#pragma unroll
    for (int a = 0; a < 2; ++a)
#pragma unroll
        for (int b = 0; b < 2; ++b)
#pragma unroll
            for (int m = 0; m < 4; ++m)
#pragma unroll
                for (int n = 0; n < 2; ++n) acc[a][b][m][n] = (f32x4){0.f, 0.f, 0.f, 0.f};
    int f8scale = 0x7F7F7F7F; asm volatile("" : "+v"(f8scale));
    bf16x8 At[4][2], B0[2][2], B1[2][2];
    const char* cA = (const char*)g.A + (size_t)cur.pm * tstep; const char* cB = (const char*)g.Bt + (size_t)cur.pn * tstep + (size_t)cur.e * g.bstride;
    S.a_ready(cur);
    if constexpr (SP2) {
        PG8_STAGE(PG8_SB(0, 0), cB, voffB); PG8_STAGE(PG8_SB(0, 1), cB + hstep, voffB); PG8_STAGE(PG8_SA(0, 0), cA, voffA); PG8_STAGE(PG8_SA(0, 1), cA + hstep, voffA);
        if (wr == 1) PG8_BAR;
        PG8_WAIT_V(2); PG8_BAR;
        PG8_STAGE(PG8_SB(1, 0), cB + kstep, voffB); PG8_STAGE(PG8_SA(1, 0), cA + kstep, voffA); PG8_STAGE(PG8_SB(1, 1), cB + hstep + kstep, voffB);
        PG8_WAIT_V(6); PG8_BAR;
    } else {
        PG8_STAGE(PG8_SB(0, 0), cB, voffB); PG8_STAGE(PG8_SA(0, 0), cA, voffA); PG8_STAGE(PG8_SB(0, 1), cB + hstep, voffB); PG8_STAGE(PG8_SA(0, 1), cA + hstep, voffA);
        if (wr == 1) PG8_BAR;
        PG8_WAIT_V(4); PG8_BAR;
        PG8_STAGE(PG8_SB(1, 0), cB + kstep, voffB); PG8_STAGE(PG8_SA(1, 0), cA + kstep, voffA); PG8_STAGE(PG8_SB(1, 1), cB + hstep + kstep, voffB);
        PG8_WAIT_V(6); PG8_BAR;
    }
    for (;;) {
        const bool has_next = S.next(ui + 1, nxt);
        const char* nA = has_next ? (const char*)g.A + (size_t)nxt.pm * tstep : cA; const char* nB = has_next ? (const char*)g.Bt + (size_t)nxt.pn * tstep + (size_t)nxt.e * g.bstride : cB;
        for (int t = 0; t < nt; t += 2) {
            const bool last = (t == nt - 2);
            const char* a1 = cA + (size_t)(t + 1) * kstep;
            const char* a2 = last ? nA : cA + (size_t)(t + 2) * kstep; const char* b2 = last ? nB : cB + (size_t)(t + 2) * kstep;
            const char* a3 = a2 + kstep; const char* b3 = b2 + kstep;
            if (last && has_next) S.a_ready(nxt);
            if constexpr (SP2) {
            PG8_LDB(B0, 0, 0); PG8_LDB(B1, 0, 1); PG8_SCHED; PG8_LDA(At, 0, 0); PG8_STAGE(PG8_SA(1, 1), a1 + hstep, voffA);
            PG8_WAIT_V(8); PG8_WAIT_L(0); PG8_BAR; PG8_MMA(0, 0, At, B0); PG8_MMA(0, 1, At, B1); PG8_BAR; PG8_SCHED;
            PG8_LDA(At, 0, 1); PG8_STAGE(PG8_SB(0, 0), b2, voffB); PG8_STAGE(PG8_SB(0, 1), b2 + hstep, voffB); PG8_STAGE(PG8_SA(0, 0), a2, voffA);
            PG8_WAIT_V(8); PG8_WAIT_L(0); PG8_BAR; PG8_MMA(1, 0, At, B0); PG8_MMA(1, 1, At, B1); PG8_BAR; PG8_SCHED;
            PG8_LDB(B0, 1, 0); PG8_LDB(B1, 1, 1); PG8_SCHED; PG8_LDA(At, 1, 0); PG8_STAGE(PG8_SA(0, 1), a2 + hstep, voffA);
            PG8_WAIT_V(8); PG8_WAIT_L(0); PG8_BAR; PG8_MMA(0, 0, At, B0); PG8_MMA(0, 1, At, B1); PG8_BAR; PG8_SCHED;
            PG8_LDA(At, 1, 1); PG8_STAGE(PG8_SB(1, 0), b3, voffB); PG8_STAGE(PG8_SB(1, 1), b3 + hstep, voffB); PG8_STAGE(PG8_SA(1, 0), a3, voffA);
            PG8_WAIT_V(8); PG8_WAIT_L(0); PG8_BAR; PG8_MMA(1, 0, At, B0); PG8_MMA(1, 1, At, B1); PG8_BAR; PG8_SCHED;
            } else {
            PG8_LDB(B0, 0, 0); PG8_SCHED; PG8_LDA(At, 0, 0); PG8_STAGE(PG8_SA(1, 1), a1 + hstep, voffA);
            PG8_WAIT_L(8); PG8_BAR; PG8_WAIT_L(0); PG8_MMA(0, 0, At, B0); PG8_BAR; PG8_SCHED;
            PG8_LDB(B1, 0, 1); PG8_STAGE(PG8_SB(0, 0), b2, voffB);
            PG8_BAR; PG8_WAIT_L(0); PG8_MMA(0, 1, At, B1); PG8_BAR;
            PG8_LDA(At, 0, 1); PG8_STAGE(PG8_SA(0, 0), a2, voffA);
            PG8_BAR; PG8_WAIT_L(0); PG8_MMA(1, 0, At, B0); PG8_BAR; PG8_SCHED;
            PG8_STAGE(PG8_SB(0, 1), b2 + hstep, voffB);
            PG8_WAIT_V(6); PG8_BAR; PG8_MMA(1, 1, At, B1); PG8_BAR;
            PG8_LDB(B0, 1, 0); PG8_SCHED; PG8_LDA(At, 1, 0); PG8_STAGE(PG8_SA(0, 1), a2 + hstep, voffA);
            PG8_WAIT_L(8); PG8_BAR; PG8_WAIT_L(0); PG8_MMA(0, 0, At, B0); PG8_BAR; PG8_SCHED;
            PG8_LDB(B1, 1, 1); PG8_STAGE(PG8_SB(1, 0), b3, voffB);
            PG8_BAR; PG8_WAIT_L(0); PG8_MMA(0, 1, At, B1); PG8_BAR;
            PG8_LDA(At, 1, 1); PG8_STAGE(PG8_SA(1, 0), a3, voffA);
            PG8_BAR; PG8_WAIT_L(0); PG8_MMA(1, 0, At, B0); PG8_BAR; PG8_SCHED;
            PG8_STAGE(PG8_SB(1, 1), b3 + hstep, voffB);
            PG8_WAIT_V(6); PG8_BAR; PG8_MMA(1, 1, At, B1); PG8_BAR;
            }
        }
        if constexpr (ALIGN_EPI) { if (wr == 0) PG8_BAR; }
        if constexpr (FP8) asm volatile("s_nop 15\n\ts_nop 15" : "+v"(acc[1][1][0][0]), "+v"(acc[1][1][0][1]), "+v"(acc[1][1][1][0]), "+v"(acc[1][1][1][1]), "+v"(acc[1][1][2][0]), "+v"(acc[1][1][2][1]), "+v"(acc[1][1][3][0]), "+v"(acc[1][1][3][1]));
        if constexpr (!Epi::AFTER_DRAIN) { E(acc, cur, wr, wc, fr, fq); S.done(cur); }
        if (!has_next) break;
#pragma unroll
        for (int a = 0; a < 2; ++a)
#pragma unroll
            for (int b = 0; b < 2; ++b)
#pragma unroll
                for (int m = 0; m < 4; ++m)
#pragma unroll
                    for (int n = 0; n < 2; ++n) acc[a][b][m][n] = (f32x4){0.f, 0.f, 0.f, 0.f};
        cur = nxt; cA = nA; cB = nB; ++ui;
        if constexpr (ALIGN_EPI) { if (wr == 1) PG8_BAR; }
    }
    PG8_WAIT_V(0);
    if constexpr (!ALIGN_EPI) { if (wr == 0) PG8_BAR; }
    PG8_BAR;
    if constexpr (Epi::AFTER_DRAIN) { E.fused(acc, cur, wr, wc, fr, fq, lds, wid, lane); S.done(cur); }
#undef PG8_SA
#undef PG8_SB
#undef PG8_STAGE
#undef PG8_LDA
#undef PG8_LDB
#undef PG8_MMA
#undef PG8_WAIT_V
#undef PG8_WAIT_L
#undef PG8_BAR
#undef PG8_SCHED
}
}

namespace pg8 {
struct EpiF32P {
    static constexpr bool PERM = false, AFTER_DRAIN = false;
    float* O; int ldc;
    __device__ __forceinline__ void operator()(const f32x4 (&acc)[2][2][4][2], const Unit& u, int wr, int wc, int fr, int fq) const {
        const int row0 = u.pm * BM + wr * 64 + fr, col0 = u.pn * BM + wc * 32 + 4 * fq;
#pragma unroll
        for (int ai = 0; ai < 2; ++ai)
#pragma unroll
            for (int m = 0; m < 4; ++m) { float* rowp = O + (size_t)(row0 + ai * HALF + m * 16) * ldc + col0;
#pragma unroll
                for (int bj = 0; bj < 2; ++bj)
#pragma unroll
                    for (int n = 0; n < 2; ++n) *(f32x4*)(rowp + bj * HALF + n * 16) = acc[ai][bj][m][n]; }
    }
};
struct EpiSwigluP {
    static constexpr bool PERM = true, AFTER_DRAIN = false;
    bf16_t* O; int ldc;
    __device__ __forceinline__ void operator()(const f32x4 (&acc)[2][2][4][2], const Unit& u, int wr, int wc, int fr, int fq) const {
        const int row0 = u.pm * BM + wr * 64 + fr, col0 = u.pn * HALF + wc * 32 + 8 * fq;
#pragma unroll
        for (int ai = 0; ai < 2; ++ai)
#pragma unroll
            for (int m = 0; m < 4; ++m) {
                float h[8];
#pragma unroll
                for (int n = 0; n < 2; ++n)
#pragma unroll
                    for (int j = 0; j < 4; ++j) { const float g = acc[ai][0][m][n][j], up = acc[ai][1][m][n][j];
                        h[4 * n + j] = g * up * __builtin_amdgcn_rcpf(1.0f + __builtin_amdgcn_exp2f(-1.4426950408889634f * g)); }
                u32x4 w; w.x = cvt_pk_bf16(h[0], h[1]); w.y = cvt_pk_bf16(h[2], h[3]); w.z = cvt_pk_bf16(h[4], h[5]); w.w = cvt_pk_bf16(h[6], h[7]);
                *(u32x4*)(O + (size_t)(row0 + ai * HALF + m * 16) * ldc + col0) = w; }
    }
};
struct EpiGateP {
    static constexpr bool PERM = true, AFTER_DRAIN = false;
    bf16_t* O; int ldc; const float* gate;
    __device__ __forceinline__ void operator()(const f32x4 (&acc)[2][2][4][2], const Unit& u, int wr, int wc, int fr, int fq) const {
        const int row0 = u.pm * BM + wr * 64 + fr, col0 = u.pn * BM + wc * 32 + 8 * fq;
#pragma unroll
        for (int ai = 0; ai < 2; ++ai)
#pragma unroll
            for (int m = 0; m < 4; ++m) { const int row = row0 + ai * HALF + m * 16; const float gt = gate[row]; bf16_t* rowp = O + (size_t)row * ldc + col0;
#pragma unroll
                for (int bj = 0; bj < 2; ++bj) { const f32x4 v0 = acc[ai][bj][m][0] * gt, v1 = acc[ai][bj][m][1] * gt;
                    u32x4 w; w.x = cvt_pk_bf16(v0[0], v0[1]); w.y = cvt_pk_bf16(v0[2], v0[3]); w.z = cvt_pk_bf16(v1[0], v1[1]); w.w = cvt_pk_bf16(v1[2], v1[3]);
                    *(u32x4*)(rowp + bj * HALF) = w; } }
    }
};
__device__ __forceinline__ unsigned pk4_fp8(float a, float b, float c, float d) {
    a = __builtin_fminf(__builtin_fmaxf(a, -448.f), 448.f); b = __builtin_fminf(__builtin_fmaxf(b, -448.f), 448.f);
    c = __builtin_fminf(__builtin_fmaxf(c, -448.f), 448.f); d = __builtin_fminf(__builtin_fmaxf(d, -448.f), 448.f);
    int w = 0; w = __builtin_amdgcn_cvt_pk_fp8_f32(a, b, w, false); w = __builtin_amdgcn_cvt_pk_fp8_f32(c, d, w, true); return (unsigned)w; }
struct EpiSwigluF8 {
    static constexpr bool PERM = true, AFTER_DRAIN = false;
    unsigned char* O; int ldc; float ws, hs;
    __device__ __forceinline__ void operator()(const f32x4 (&acc)[2][2][4][2], const Unit& u, int wr, int wc, int fr, int fq) const {
        const int row0 = u.pm * BM + wr * 64 + fr, col0 = u.pn * HALF + wc * 32 + 8 * fq;
#pragma unroll
        for (int ai = 0; ai < 2; ++ai)
#pragma unroll
            for (int m = 0; m < 4; ++m) {
                float h[8];
#pragma unroll
                for (int n = 0; n < 2; ++n)
#pragma unroll
                    for (int j = 0; j < 4; ++j) { const float g = acc[ai][0][m][n][j] * ws, up = acc[ai][1][m][n][j] * ws;
                        h[4 * n + j] = g * up * hs * __builtin_amdgcn_rcpf(1.0f + __builtin_amdgcn_exp2f(-1.4426950408889634f * g)); }
                typedef unsigned u32x2 __attribute__((ext_vector_type(2)));
                *(u32x2*)(O + (size_t)(row0 + ai * HALF + m * 16) * ldc + col0) = (u32x2){pk4_fp8(h[0], h[1], h[2], h[3]), pk4_fp8(h[4], h[5], h[6], h[7])}; }
    }
};
struct EpiGateS {
    static constexpr bool PERM = true, AFTER_DRAIN = false;
    bf16_t* O; int ldc; const float* gate; float sc;
    __device__ __forceinline__ void operator()(const f32x4 (&acc)[2][2][4][2], const Unit& u, int wr, int wc, int fr, int fq) const {
        const int row0 = u.pm * BM + wr * 64 + fr, col0 = u.pn * BM + wc * 32 + 8 * fq;
#pragma unroll
        for (int ai = 0; ai < 2; ++ai)
#pragma unroll
            for (int m = 0; m < 4; ++m) { const int row = row0 + ai * HALF + m * 16; const float gt = gate[row] * sc; bf16_t* rowp = O + (size_t)row * ldc + col0;
#pragma unroll
                for (int bj = 0; bj < 2; ++bj) { const f32x4 v0 = acc[ai][bj][m][0] * gt, v1 = acc[ai][bj][m][1] * gt;
                    u32x4 w; w.x = cvt_pk_bf16(v0[0], v0[1]); w.y = cvt_pk_bf16(v0[2], v0[3]); w.z = cvt_pk_bf16(v1[0], v1[1]); w.w = cvt_pk_bf16(v1[2], v1[3]);
                    *(u32x4*)(rowp + bj * HALF) = w; } }
    }
};
struct EpiQKV {
    static constexpr bool PERM = true, AFTER_DRAIN = false;
    bf16_t* O; int ldc; const float* rope; const float* qn; const float* kn; float qscale; float rms_eps;
    __device__ __forceinline__ void operator()(const f32x4 (&acc)[2][2][4][2], const Unit& u, int wr, int wc, int fr, int fq) const {
        const int hs = 4 * u.pn + wc;
        const bool isq = hs < 8 || (hs >= 24 && hs < 32), isk = (hs >= 8 && hs < 16) || hs == 32 || hs == 33, nrm = hs >= 24 && hs < 34;
        const bool rope_on = (isq || isk) && u.pm < 64;
        const float osc = isq ? qscale : 1.f;
        const bool first = fq < 2;
        f32x4 gv[2][2];
#pragma unroll
        for (int bj = 0; bj < 2; ++bj)
#pragma unroll
            for (int n = 0; n < 2; ++n) gv[bj][n] = nrm ? *(const f32x4*)((hs < 32 ? qn : kn) + 32 * bj + 8 * fq + 4 * n) : (f32x4){1.f, 1.f, 1.f, 1.f};
#pragma unroll
        for (int ai = 0; ai < 2; ++ai)
#pragma unroll
            for (int m = 0; m < 4; ++m) {
                const int row = u.pm * BM + ai * HALF + wr * 64 + m * 16 + fr;
                f32x4 v[2][2];
#pragma unroll
                for (int bj = 0; bj < 2; ++bj)
#pragma unroll
                    for (int n = 0; n < 2; ++n) v[bj][n] = acc[ai][bj][m][n];
                if (nrm) {
                    float ss = 0.f;
#pragma unroll
                    for (int bj = 0; bj < 2; ++bj)
#pragma unroll
                        for (int n = 0; n < 2; ++n) ss += (v[bj][n][0] * v[bj][n][0] + v[bj][n][1] * v[bj][n][1]) + (v[bj][n][2] * v[bj][n][2] + v[bj][n][3] * v[bj][n][3]);
                    ss += __shfl_xor(ss, 16); ss += __shfl_xor(ss, 32);
                    const float r = __builtin_amdgcn_rsqf(ss * (1.f / 64.f) + rms_eps);
#pragma unroll
                    for (int bj = 0; bj < 2; ++bj)
#pragma unroll
                        for (int n = 0; n < 2; ++n) v[bj][n] = v[bj][n] * r * gv[bj][n];
                }
                if (rope_on) {
                    const int t = row & 2047;
#pragma unroll
                    for (int bj = 0; bj < 2; ++bj) {
                        const int pos = bj ? (t & 63) : (t >> 6);
#pragma unroll
                        for (int n = 0; n < 2; ++n) {
                            const float* cp = rope + (size_t)(pos * 16 + 8 * (fq & 1) + 4 * n) * 2;
                            const f32x4 c01 = *(const f32x4*)cp, c23 = *(const f32x4*)(cp + 4);
                            const float cs[4] = {c01[0], c01[2], c23[0], c23[2]}, sn[4] = {c01[1], c01[3], c23[1], c23[3]};
#pragma unroll
                            for (int j = 0; j < 4; ++j) { const float x = v[bj][n][j], pr = __shfl_xor(x, 32); v[bj][n][j] = first ? x * cs[j] - pr * sn[j] : x * cs[j] + pr * sn[j]; }
                        }
                    }
                }
                bf16_t* rowp = O + (size_t)row * ldc + hs * 64 + 8 * fq;
#pragma unroll
                for (int bj = 0; bj < 2; ++bj) { const f32x4 v0 = v[bj][0] * osc, v1 = v[bj][1] * osc;
                    u32x4 w; w.x = cvt_pk_bf16(v0[0], v0[1]); w.y = cvt_pk_bf16(v0[2], v0[3]); w.z = cvt_pk_bf16(v1[0], v1[1]); w.w = cvt_pk_bf16(v1[2], v1[3]);
                    *(u32x4*)(rowp + 32 * bj) = w; }
            }
    }
};
struct GroupedOrder {
    int nMe, nN, ntot, G, c;
    __device__ void init(int nMe_, int nN_, int ne, int G_, int c_) { nMe = nMe_; nN = nN_; ntot = nMe_ * nN_ * ne; G = G_; c = c_; }
    __device__ bool next(int i, Unit& u) const {
        const int L = i * G + c; if (L >= ntot) return false;
        const int per = nMe * nN, e = L / per, rem = L - e * per;
        u.e = e; u.pn = rem / nMe; u.pm = e * nMe + (rem - u.pn * nMe); return true;
    }
    __device__ __forceinline__ void a_ready(const Unit&) const {}
    __device__ __forceinline__ void done(const Unit&) const {}
};
struct L1InOrder {
    StaticOrder so; int G, c;
    __device__ void init(int G_, int c_) { so.init(16384, 2048, G_, 0); G = G_; c = c_; }
    __device__ bool next(int i, Unit& u) const {
        const int L = i * G + c;
        if (L < 512) { StaticOrder t = so; t.G = 1; t.c = 0; return t.next(L, u); }
        if (L < 544) { const int l = L - 512; u.pm = 64 + (l >> 2); u.pn = 2 + (l & 3); u.e = 0; return true; }
        return false;
    }
    __device__ __forceinline__ void a_ready(const Unit&) const {}
    __device__ __forceinline__ void done(const Unit&) const {}
};
}

#include <hip/hip_bf16.h>
#include <cmath>
namespace attn_body {
using bf16=__hip_bfloat16;
using bf16x8=__attribute__((ext_vector_type(8)))short;
using s16x4=__attribute__((ext_vector_type(4)))short;
using f32x16=__attribute__((ext_vector_type(16)))float;
using u32x4=__attribute__((ext_vector_type(4)))unsigned;
constexpr int D=64,OPITCH=1024;
constexpr int NW=8,QBLK=32,QB=QBLK*NW,KVBLK=64;
__device__ __forceinline__ int crow(int r,int hi){return (r&3)+8*(r>>2)+4*hi;}
#define SBAR() __builtin_amdgcn_sched_barrier(0)
__device__ __forceinline__ void cmask(f32x16&p0,f32x16&p1,int jb,int qrel,int hi){
  const float NEG=-INFINITY; int kb=64*jb+4*hi;
  #pragma unroll
  for(int r=0;r<16;++r){int kv=kb+(r&3)+8*(r>>2); if(kv>qrel)p0[r]=NEG; if(kv+32>qrel)p1[r]=NEG;}
}

constexpr int NSLOT=3, SLOTB=8192;
constexpr int LDS_K=0, LDS_V=NSLOT*SLOTB, LDS_WS=2*NSLOT*SLOTB, LDS_OST=LDS_WS+NW*64*4, LDS_BYTES=LDS_OST+NW*4096;
constexpr float C2=0.125f*1.4426950408889634f;
__device__ __forceinline__ void glds16(const void*gsrc,unsigned lds_dst){unsigned keep;
  asm volatile("s_mov_b32 %0, m0\n\ts_mov_b32 m0, %2\n\ts_nop 0\n\tglobal_load_lds_dwordx4 %1, off\n\ts_mov_b32 m0, %0":"=&s"(keep):"v"(gsrc),"s"(lds_dst):"memory");}
__device__ __forceinline__ float max3f(float a,float b,float c){float r;asm("v_max3_f32 %0, %1, %2, %3":"=v"(r):"v"(a),"v"(b),"v"(c));return r;}
__device__ __forceinline__ float max2f(float a,float b){float r;asm("v_max_f32_e32 %0, %1, %2":"=v"(r):"v"(a),"v"(b));return r;}
__device__ __forceinline__ float fadd_s(float a,float b){float r;asm("v_add_f32_e32 %0, %1, %2":"=v"(r):"v"(a),"v"(b));return r;}
__device__ __forceinline__ float fsub_s(float a,float b){float r;asm("v_sub_f32_e32 %0, %1, %2":"=v"(r):"v"(a),"v"(b));return r;}
typedef float f32x2_t __attribute__((ext_vector_type(2))); typedef __bf16 bf16x2_t __attribute__((ext_vector_type(2)));
__device__ __forceinline__ unsigned cvtpk_s(float lo,float hi){f32x2_t v={lo,hi};bf16x2_t b=__builtin_convertvector(v,bf16x2_t);return __builtin_bit_cast(unsigned,b);}
#define WAIT_BAR(N) asm volatile("s_waitcnt vmcnt(" #N ") lgkmcnt(0)\n\ts_barrier":::"memory")

__device__ __forceinline__ void qkt(f32x16&p0,f32x16&p1,const char*Kslot,const bf16x8*qr,const f32x16&negm,int r32,int hi){
  const char*kb=Kslot+hi*1024+r32*16;
  #pragma unroll
  for(int d0=0;d0<4;++d0){
    const bf16x8 b0=*reinterpret_cast<const bf16x8*>(kb+d0*2048);
    const bf16x8 b1=*reinterpret_cast<const bf16x8*>(kb+d0*2048+512);
    if(d0==0){p0=__builtin_amdgcn_mfma_f32_32x32x16_bf16(b0,qr[0],negm,0,0,0);p1=__builtin_amdgcn_mfma_f32_32x32x16_bf16(b1,qr[0],negm,0,0,0);}
    else{p0=__builtin_amdgcn_mfma_f32_32x32x16_bf16(b0,qr[d0],p0,0,0,0);p1=__builtin_amdgcn_mfma_f32_32x32x16_bf16(b1,qr[d0],p1,0,0,0);}}
}
typedef __attribute__((address_space(3))) const char* lds_cptr;
typedef short v4i16_t __attribute__((ext_vector_type(4)));
__device__ __forceinline__ void kload8(bf16x8*kf,lds_cptr kp){
  kf[0]=*(const __attribute__((address_space(3))) bf16x8*)(kp);      kf[1]=*(const __attribute__((address_space(3))) bf16x8*)(kp+512);
  kf[2]=*(const __attribute__((address_space(3))) bf16x8*)(kp+2048); kf[3]=*(const __attribute__((address_space(3))) bf16x8*)(kp+2560);
  kf[4]=*(const __attribute__((address_space(3))) bf16x8*)(kp+4096); kf[5]=*(const __attribute__((address_space(3))) bf16x8*)(kp+4608);
  kf[6]=*(const __attribute__((address_space(3))) bf16x8*)(kp+6144); kf[7]=*(const __attribute__((address_space(3))) bf16x8*)(kp+6656);
}
__device__ __forceinline__ void kload2(bf16x8*kf,lds_cptr kp,int j){ kf[2*j]=*(const __attribute__((address_space(3))) bf16x8*)(kp+j*2048); kf[2*j+1]=*(const __attribute__((address_space(3))) bf16x8*)(kp+j*2048+512); }
__device__ __forceinline__ s16x4 vtr(lds_cptr p){ return __builtin_bit_cast(s16x4,__builtin_amdgcn_ds_read_tr16_b64_v4i16((__attribute__((address_space(3))) v4i16_t*)p)); }
__device__ __forceinline__ float rowmax(const f32x16&p0,const f32x16&p1){
  float a=max3f(p0[0],p0[1],p1[0]),b=max3f(p0[2],p0[3],p1[1]);a=max3f(a,p1[2],p1[3]);
  #pragma unroll
  for(int r=4;r<16;r+=4){a=max3f(a,p0[r],p0[r+1]);b=max3f(b,p0[r+2],p0[r+3]);a=max3f(a,p1[r],p1[r+1]);b=max3f(b,p1[r+2],p1[r+3]);}
  const float m=max2f(a,b);
  auto rr=__builtin_amdgcn_permlane32_swap(__float_as_uint(m),__float_as_uint(m),false,false);
  return max2f(__uint_as_float(rr[0]),__uint_as_float(rr[1]));
}
__device__ __forceinline__ void pv(f32x16*o,int vb,bf16x8 pa0,bf16x8 pa1,bf16x8 pa2,bf16x8 pa3){
  #pragma unroll
  for(int d0=0;d0<2;++d0){s16x4 lo[4],hi[4];
    #pragma unroll
    for(int ks=0;ks<4;++ks){
      asm volatile("ds_read_b64_tr_b16 %0,%1 offset:%c2":"=&v"(lo[ks]):"v"(vb),"i"(d0*4096+ks*1024):"memory");
      asm volatile("ds_read_b64_tr_b16 %0,%1 offset:%c2":"=&v"(hi[ks]):"v"(vb),"i"(d0*4096+ks*1024+512):"memory");}
    asm volatile("s_waitcnt lgkmcnt(0)":::"memory");SBAR();
    #define PK(k) (bf16x8){lo[k][0],lo[k][1],lo[k][2],lo[k][3],hi[k][0],hi[k][1],hi[k][2],hi[k][3]}
    o[d0]=__builtin_amdgcn_mfma_f32_32x32x16_bf16(pa0,PK(0),o[d0],0,0,0);
    o[d0]=__builtin_amdgcn_mfma_f32_32x32x16_bf16(pa1,PK(1),o[d0],0,0,0);
    o[d0]=__builtin_amdgcn_mfma_f32_32x32x16_bf16(pa2,PK(2),o[d0],0,0,0);
    o[d0]=__builtin_amdgcn_mfma_f32_32x32x16_bf16(pa3,PK(3),o[d0],0,0,0);
    #undef PK
  }
}

#ifndef ATTN_STORE16
#define ATTN_STORE16(p,v) (*(u32x4*)(p)=(v))
#endif
struct AU { const bf16* Qp; const bf16* Kp; const bf16* Vp; bf16* Op; int qrow0, lat_row0, ctx_row0, nlat_t, NT; };
struct NoMask { __device__ __forceinline__ void apply(f32x16&,f32x16&,int,int)const{} };
typedef __attribute__((address_space(3))) const float* lds_cfptr;
struct NAMask { lds_cfptr tb0; int r, rs, rs_min, cb;
  __device__ __forceinline__ void apply(f32x16&p0,f32x16&p1,int t,int hi)const{
    if(t<4)return;
    const int kr=rs_min+t-4; const float NEG=-INFINITY;
    if((unsigned)(kr-rs)>7u){
      #pragma unroll
      for(int i=0;i<16;++i){p0[i]=NEG;p1[i]=NEG;}
      return; }
    const lds_cfptr tb=tb0+(kr-r+7)*32+4*hi;
    #pragma unroll
    for(int i=0;i<16;++i){ const int k0=(i&3)+8*(i>>2); const int d0=cb+k0, d1=cb+k0+32;
      const float b0=tb[k0], b1=tb[k0+32];
      p0[i]=((unsigned)d0<=15u)?p0[i]+b0:NEG; p1[i]=((unsigned)d1<=15u)?p1[i]+b1:NEG; }
  }
};
template<int THRL,int PITCH,class MaskT> __device__ __forceinline__ void attn_unit(const AU& u,char*shm,const MaskT& mk){
  const int tid=threadIdx.x,lane=tid&63,r32=lane&31,hi=lane>>5; const int wid=__builtin_amdgcn_readfirstlane(tid>>6);
  const bf16*Qw=u.Qp+(long)(u.qrow0+wid*QBLK)*PITCH;
  const bf16*Kh=u.Kp,*Vh=u.Vp;
  const unsigned lds0=(unsigned)(uintptr_t)shm;
  float*wsf=(float*)(shm+LDS_WS)+wid*64;
  const bf16*ksrc=Kh+(long)lane*PITCH+wid*8;
  const bf16*vsrc=Vh+(long)(16*(wid&3)+(lane>>2))*PITCH+(wid>>2)*32+(lane&3)*8;
  const unsigned kdst=lds0+LDS_K+wid*1024, vdst=lds0+LDS_V+wid*1024;
  #define TROW(t) ((long)((t)<u.nlat_t?u.lat_row0+KVBLK*(t):u.ctx_row0+KVBLK*((t)-u.nlat_t))*PITCH)
  #define DMA_K(t,slot) glds16(ksrc+TROW(t),(unsigned)__builtin_amdgcn_readfirstlane(kdst+(slot)))
  #define DMA_V(t,slot) glds16(vsrc+TROW(t),(unsigned)__builtin_amdgcn_readfirstlane(vdst+(slot)))
  const int vb0=(int)(lds0+LDS_V)+((lane>>4)&1)*32+(lane&3)*8+(4*hi+((lane&15)>>2))*64;
  const char*Kbase=shm+LDS_K; bf16x8 kf[8];
  const lds_cptr shm3=(lds_cptr)shm; const lds_cptr kp0=shm3+LDS_K+hi*1024+r32*16; const lds_cptr vp0=shm3+LDS_V+((lane>>4)&1)*32+(lane&3)*8+(4*hi+((lane&15)>>2))*64;
  const int NT=u.NT;
  DMA_K(0,0);DMA_V(0,0);DMA_K(1,SLOTB);
  bf16x8 qr[4];
  #pragma unroll
  for(int d0=0;d0<4;++d0)qr[d0]=*reinterpret_cast<const bf16x8*>(&Qw[(long)r32*PITCH+d0*16+hi*8]);
  float mhat=0.f,l_reg=0.f;f32x16 o[2];o[0]=f32x16{};o[1]=f32x16{};f32x16 negm=f32x16{};asm volatile("":"+v"(negm));
  #define CMASK(P0,P1,t) mk.apply(P0,P1,(t),hi)
  bool resc=false;
  #define START(P0,P1) do{ const float rm=rowmax(P0,P1); resc=false; \
    { const float dl=rm; mhat=fadd_s(mhat,dl); \
      _Pragma("unroll") for(int r=0;r<16;++r){P0[r]=fsub_s(P0[r],dl);P1[r]=fsub_s(P1[r],dl);} \
      _Pragma("unroll") for(int r=0;r<16;++r)negm[r]=-mhat; asm volatile("":"+v"(negm)); } \
    _Pragma("unroll") for(int r=0;r<16;++r)P0[r]=__builtin_amdgcn_exp2f(P0[r]); }while(0)
  #define RESC() do{ if(resc){ asm volatile("s_waitcnt lgkmcnt(0)":::"memory"); \
      _Pragma("unroll") for(int d_=0;d_<2;++d_) _Pragma("unroll") for(int r=0;r<16;++r)o[d_][r]*=wsf[crow(r,hi)]; } }while(0)
  f32x16 pA0,pA1,pB0,pB1;
  int sl_prev=0,sl_cur=0,sl_next=SLOTB;
  #define ROT() do{sl_prev=sl_cur;sl_cur=sl_next;sl_next=(sl_next==(NSLOT-1)*SLOTB)?0:sl_next+SLOTB;}while(0)
  DMA_K(2,2*SLOTB);
  WAIT_BAR(3);
  qkt(pA0,pA1,Kbase,qr,negm,r32,hi);asm volatile("s_nop 15\n\ts_nop 7":"+v"(pA0),"+v"(pA1));CMASK(pA0,pA1,0);
  START(pA0,pA1);
  _Pragma("unroll") for(int r=0;r<16;++r)pA1[r]=__builtin_amdgcn_exp2f(pA1[r]);
  WAIT_BAR(0);
  DMA_K(3,0);DMA_V(1,SLOTB);
  ROT();
  kload8(kf,kp0+sl_cur);
  WAIT_BAR(2);
  s16x4 vlo[8],vhi[8]; u32x4 pw0,pw1,pw2,pw3;
  #define PKW(P,B) cvtpk_s(P[B],P[B+1])
  #define PAF(k) __builtin_bit_cast(bf16x8,pw##k)
  #define VFR(i) (bf16x8){vlo[i][0],vlo[i][1],vlo[i][2],vlo[i][3],vhi[i][0],vhi[i][1],vhi[i][2],vhi[i][3]}
  #define PIN(x) asm volatile("":"+v"(x))
  #define MX3(a,b,c) __builtin_fmaxf(__builtin_fmaxf((a),(b)),(c))
  #define GAPA(MF,A0,A1,A2,A3,W0,W1,PW) do{ MF; sacc+=A0; sacc+=A1; sacc+=A2; sacc+=A3; PIN(sacc); W0; W1; PIN(PW); SBAR(); }while(0)
  #define EX(v) __builtin_amdgcn_exp2f(v)
  #define GAPB(MF,X,B) do{ MF; X[B]=EX(X[B]); X[B+1]=EX(X[B+1]); X[B+2]=EX(X[B+2]); X[B+3]=EX(X[B+3]); PIN(X); SBAR(); }while(0)
  #define VRD(i) do{ vlo[i]=vtr(vp_+(((i)>>2)*4096+((i)&3)*1024)); vhi[i]=vtr(vp_+(((i)>>2)*4096+((i)&3)*1024+512)); }while(0)
  #define KRD(G,j) do{ if(G){ kload2(kf,kp0+sl_next,j); SBAR(); } }while(0)
  #define STEP(C0,C1,P0,P1,t,GK,GV,GL) do{ SBAR(); \
    const lds_cptr vp_=vp0+sl_prev; \
    VRD(0); SBAR(); float sacc=(P0[0]+P0[1]); \
    GAPA(C0=__builtin_amdgcn_mfma_f32_32x32x16_bf16(kf[0],qr[0],negm,0,0,0), P0[2],P0[3],P0[4],P0[5],     pw0[0]=PKW(P0,0), pw0[1]=PKW(P0,2), pw0); \
    VRD(4); SBAR(); GAPA(C1=__builtin_amdgcn_mfma_f32_32x32x16_bf16(kf[1],qr[0],negm,0,0,0), P0[6],P0[7],P0[8],P0[9],     pw0[2]=PKW(P0,4), pw0[3]=PKW(P0,6), pw0); \
    VRD(1); SBAR(); GAPA(C0=__builtin_amdgcn_mfma_f32_32x32x16_bf16(kf[2],qr[1],C0,0,0,0),   P0[10],P0[11],P0[12],P0[13], pw1[0]=PKW(P0,8), pw1[1]=PKW(P0,10), pw1); \
    VRD(5); SBAR(); GAPA(C1=__builtin_amdgcn_mfma_f32_32x32x16_bf16(kf[3],qr[1],C1,0,0,0),   P0[14],P0[15],P1[0],P1[1],   pw1[2]=PKW(P0,12),pw1[3]=PKW(P0,14), pw1); \
    VRD(2); SBAR(); GAPA(C0=__builtin_amdgcn_mfma_f32_32x32x16_bf16(kf[4],qr[2],C0,0,0,0),   P1[2],P1[3],P1[4],P1[5],     pw2[0]=PKW(P1,0), pw2[1]=PKW(P1,2), pw2); \
    VRD(6); SBAR(); GAPA(C1=__builtin_amdgcn_mfma_f32_32x32x16_bf16(kf[5],qr[2],C1,0,0,0),   P1[6],P1[7],P1[8],P1[9],     pw2[2]=PKW(P1,4), pw2[3]=PKW(P1,6), pw2); \
    VRD(3); SBAR(); GAPA(C0=__builtin_amdgcn_mfma_f32_32x32x16_bf16(kf[6],qr[3],C0,0,0,0),   P1[10],P1[11],P1[12],P1[13], pw3[0]=PKW(P1,8), pw3[1]=PKW(P1,10), pw3); \
    VRD(7); SBAR(); GAPA(C1=__builtin_amdgcn_mfma_f32_32x32x16_bf16(kf[7],qr[3],C1,0,0,0),   P1[14],P1[15],0.f,0.f,       pw3[2]=PKW(P1,12),pw3[3]=PKW(P1,14), pw3); \
    l_reg+=sacc; \
    if(GK){DMA_K((t)+3,sl_cur);} if(GV){DMA_V((t)+1,sl_next);} \
    CMASK(C0,C1,t); \
    { float a=MX3(C0[0],C0[1],C1[0]),b=MX3(C0[2],C0[3],C1[1]); a=MX3(a,C1[2],C1[3]); \
      _Pragma("unroll") for(int r=4;r<16;r+=4){a=MX3(a,C0[r],C0[r+1]);b=MX3(b,C0[r+2],C0[r+3]);a=MX3(a,C1[r],C1[r+1]);b=MX3(b,C1[r+2],C1[r+3]);} \
      float rm=__builtin_fmaxf(a,b); { auto rr=__builtin_amdgcn_permlane32_swap(__float_as_uint(rm),__float_as_uint(rm),false,false); rm=__builtin_fmaxf(__uint_as_float(rr[0]),__uint_as_float(rr[1])); } \
      resc=false; \
      if(__builtin_expect(__any(rm>(float)THRL),0)){ const float dl=__builtin_fmaxf(rm,0.f); mhat+=dl; \
        _Pragma("unroll") for(int r=0;r<16;++r){C0[r]-=dl;C1[r]-=dl;} \
        _Pragma("unroll") for(int r=0;r<16;++r)negm[r]=-mhat; asm volatile("":"+v"(negm)); \
        const float f=__builtin_amdgcn_exp2f(-dl); l_reg*=f; if(hi==0)wsf[r32]=f; resc=true; } } \
    SBAR(); \
    GAPB(o[0]=__builtin_amdgcn_mfma_f32_32x32x16_bf16(PAF(0),VFR(0),o[0],0,0,0), C0,0); \
    GAPB(o[1]=__builtin_amdgcn_mfma_f32_32x32x16_bf16(PAF(0),VFR(4),o[1],0,0,0), C0,4); \
    KRD(GL,0); GAPB(o[0]=__builtin_amdgcn_mfma_f32_32x32x16_bf16(PAF(1),VFR(1),o[0],0,0,0), C0,8); \
    KRD(GL,1); GAPB(o[1]=__builtin_amdgcn_mfma_f32_32x32x16_bf16(PAF(1),VFR(5),o[1],0,0,0), C0,12); \
    KRD(GL,2); GAPB(o[0]=__builtin_amdgcn_mfma_f32_32x32x16_bf16(PAF(2),VFR(2),o[0],0,0,0), C1,0); \
    KRD(GL,3); GAPB(o[1]=__builtin_amdgcn_mfma_f32_32x32x16_bf16(PAF(2),VFR(6),o[1],0,0,0), C1,4); \
    GAPB(o[0]=__builtin_amdgcn_mfma_f32_32x32x16_bf16(PAF(3),VFR(3),o[0],0,0,0), C1,8); \
    GAPB(o[1]=__builtin_amdgcn_mfma_f32_32x32x16_bf16(PAF(3),VFR(7),o[1],0,0,0), C1,12); \
    }while(0)
  int t=1;
  #undef CMASK
  #define CMASK(P0,P1,t) mk.apply(P0,P1,(t),hi)
  for(;t+5<NT;t+=2){
    STEP(pB0,pB1,pA0,pA1,t,true,true,true);     WAIT_BAR(2); RESC(); ROT();
    STEP(pA0,pA1,pB0,pB1,t+1,true,true,true);   WAIT_BAR(2); RESC(); ROT();
  }
  #undef CMASK
  #define CMASK(P0,P1,t) mk.apply(P0,P1,(t),hi)
  #define ENDW(tt) do{ if((tt)+3<NT){WAIT_BAR(2);} else if((tt)+2<NT){WAIT_BAR(1);} else {WAIT_BAR(0);} }while(0)
  for(;t+1<NT;t+=2){
    STEP(pB0,pB1,pA0,pA1,t,(t+3<NT),(t+1<NT),(t+1<NT));       ENDW(t);   RESC(); ROT();
    STEP(pA0,pA1,pB0,pB1,t+1,(t+4<NT),(t+2<NT),(t+2<NT));     ENDW(t+1); RESC(); ROT();
  }
  STEP(pB0,pB1,pA0,pA1,NT-1,false,false,false); RESC();
  { float sacc=pB0[0]+pB0[1]; _Pragma("unroll") for(int r=2;r<16;++r)sacc+=pB0[r]; _Pragma("unroll") for(int r=0;r<16;++r)sacc+=pB1[r]; l_reg+=sacc;
    pw0=(u32x4){PKW(pB0,0),PKW(pB0,2),PKW(pB0,4),PKW(pB0,6)};pw1=(u32x4){PKW(pB0,8),PKW(pB0,10),PKW(pB0,12),PKW(pB0,14)};pw2=(u32x4){PKW(pB1,0),PKW(pB1,2),PKW(pB1,4),PKW(pB1,6)};pw3=(u32x4){PKW(pB1,8),PKW(pB1,10),PKW(pB1,12),PKW(pB1,14)};
    SBAR(); pv(o,vb0+sl_cur,PAF(0),PAF(1),PAF(2),PAF(3)); }
  #undef PKW
  #undef PAF
  #undef VFR
  #undef PIN
  #undef MX3
  #undef GAPA
  #undef GAPB
  #undef EX
  #undef VRD
  #undef KRD
  #undef STEP
  #undef ENDW
  {auto rr=__builtin_amdgcn_permlane32_swap(__float_as_uint(l_reg),__float_as_uint(l_reg),false,false);l_reg=__uint_as_float(rr[0])+__uint_as_float(rr[1]);}
  if(hi==0)wsf[32+r32]=l_reg;asm volatile("s_waitcnt lgkmcnt(0)":::"memory");
  float rli[16];
  #pragma unroll
  for(int r=0;r<16;++r)rli[r]=__builtin_amdgcn_rcpf(wsf[32+crow(r,hi)]);
  bf16*Ow=u.Op+(long)(u.qrow0+wid*QBLK)*OPITCH;
  { bf16*stg=(bf16*)(shm+LDS_OST)+wid*2048;
    #pragma unroll
    for(int r=0;r<16;++r){const int orow=crow(r,hi);
      #pragma unroll
      for(int d0=0;d0<2;++d0)stg[orow*64+d0*32+r32]=__float2bfloat16(o[d0][r]*rli[r]);}
    asm volatile("s_waitcnt lgkmcnt(0)":::"memory");
    #pragma unroll
    for(int i=0;i<4;++i){const int row=i*8+(lane>>3),ch=lane&7; const u32x4 v=*(const u32x4*)(stg+row*64+ch*8); ATTN_STORE16(Ow+(long)row*OPITCH+ch*8,v);} }
  asm volatile("s_waitcnt lgkmcnt(0)\n\ts_barrier":::"memory");
  #undef DMA_K
  #undef TROW
  #undef DMA_V
  #undef CMASK
  #undef START
  #undef RESC
  #undef ROT
}
constexpr int ATTN_LDS_BYTES=LDS_BYTES;
#undef SBAR
#undef WAIT_BAR
}

struct Params { const float* in[26]; float* out; unsigned char* ws; int ph_lo, ph_hi; };
struct Ctx { LAS unsigned char* lds; int tid, lane, wave, vcu, G, gw, NGW; };
enum { I_X = 0, I_C, I_CTX, I_CCTX, I_ADAW, I_ADAB, I_LNG, I_LNB, I_W0IN, I_W0OUT, I_LQ1, I_LK1, I_LQ2, I_LK2, I_SUBLN, I_QN, I_KN,
       I_W1IN, I_W1OUT, I_RPB, I_POOLW, I_POOLS, I_ROUTER, I_WG, I_WU, I_WD };

__device__ __forceinline__ const float* mod_row(const Params& p, int layer, int row) {
    return (const float*)(p.ws + WS_MOD) + (size_t)(layer * 9 + (row < LAT ? (row >> 11) : 8)) * 6144;
}

__device__ __forceinline__ void ph_prologue(const Params& p, const Ctx& c) {
    const float* cin = p.in[I_C]; const float* cctx = p.in[I_CCTX]; const float* ada_w = p.in[I_ADAW]; const float* ada_b = p.in[I_ADAB];
    float* MOD = (float*)(p.ws + WS_MOD);
    LAS float* sc = (LAS float*)c.lds;
    LAS float* red = sc + 9 * 1024;
    for (int i = c.tid; i < 9 * 1024; i += 512) { const float v = i < 8192 ? cin[i] : cctx[i - 8192]; sc[i] = v / (1.f + expf(-v)); }
    __syncthreads();
    for (int u = c.vcu; u < 256; u += c.G) {
        const int layer = u >> 7, j0 = (u & 127) * 48;
        const int jc = c.tid % 48, kg = c.tid / 48;
        if (kg < 10) {
            float acc[9];
#pragma unroll
            for (int m = 0; m < 9; ++m) acc[m] = 0.f;
            const float* wp = ada_w + (size_t)layer * 1024 * 6144 + j0 + jc;
#pragma unroll 8
            for (int k = kg; k < 1024; k += 10) {
                const float w = wp[(size_t)k * 6144];
#pragma unroll
                for (int m = 0; m < 9; ++m) acc[m] += sc[m * 1024 + k] * w;
            }
#pragma unroll
            for (int m = 0; m < 9; ++m) red[(kg * 9 + m) * 48 + jc] = acc[m];
        }
        __syncthreads();
        if (c.tid < 432) {
            const int m = c.tid / 48, j = c.tid % 48; float s = 0.f;
#pragma unroll
            for (int g = 0; g < 10; ++g) s += red[(g * 9 + m) * 48 + j];
            MOD[(size_t)(layer * 9 + m) * 6144 + j0 + j] = s + ada_b[layer * 6144 + j0 + j];
        }
        __syncthreads();
    }
    if (c.vcu == 0) {
        f32x2* R = (f32x2*)(p.ws + WS_ROPE);
        for (int i = c.tid; i < 1024; i += 512) {
            const int pos = i >> 4, f = i & 15;
            const float inv = exp2f(-(float)f * (13.287712379549449f / 16.f));
            const float a = (float)pos * inv;
            const float k = rintf(a * 0.15915494309189535f);
            float rr = fmaf(-k, 6.28125f, a); rr = fmaf(-k, 1.9353071795864769e-3f, rr);
            R[i] = (f32x2){__cosf(rr), __sinf(rr)};
        }
    }
}


__device__ __forceinline__ void transpose_item(const float* W, int ldw, int k0, int n0, bf16* WT, int Kd, int drow0, LAS float* scr, int lane) {
#pragma unroll 8
    for (int i = 0; i < 32; ++i) { const int kk = 2 * i + (lane >> 5); scr[kk * 33 + (lane & 31)] = W[(size_t)(k0 + kk) * ldw + n0 + (lane & 31)]; }
    asm volatile("s_waitcnt lgkmcnt(0)" ::: "memory");
    const int ch = lane & 7;
#pragma unroll
    for (int j = 0; j < 4; ++j) { const int n = (lane >> 3) + 8 * j; const LAS float* sp = scr + (8 * ch) * 33 + n;
        v4u o; o.x = pk2(sp[0 * 33], sp[1 * 33]); o.y = pk2(sp[2 * 33], sp[3 * 33]); o.z = pk2(sp[4 * 33], sp[5 * 33]); o.w = pk2(sp[6 * 33], sp[7 * 33]);
        *(v4u*)(WT + (size_t)(drow0 + n) * Kd + k0 + 8 * ch) = o; }
    asm volatile("s_waitcnt lgkmcnt(0)" ::: "memory");
}
__device__ __forceinline__ void transpose_item8(const float* W, int ldw, int k0, int n0, unsigned char* WT8, int Kd, int drow0, float scale, LAS float* scr, int lane) {
#pragma unroll 8
    for (int i = 0; i < 32; ++i) { const int kk = 2 * i + (lane >> 5); scr[kk * 33 + (lane & 31)] = W[(size_t)(k0 + kk) * ldw + n0 + (lane & 31)]; }
    asm volatile("s_waitcnt lgkmcnt(0)" ::: "memory");
    const int n = lane >> 1, hf = lane & 1; const LAS float* sp = scr + (32 * hf) * 33 + n;
    v4u o0, o1;
    o0.x = pg8::pk4_fp8(sp[0 * 33] * scale, sp[1 * 33] * scale, sp[2 * 33] * scale, sp[3 * 33] * scale);     o0.y = pg8::pk4_fp8(sp[4 * 33] * scale, sp[5 * 33] * scale, sp[6 * 33] * scale, sp[7 * 33] * scale);
    o0.z = pg8::pk4_fp8(sp[8 * 33] * scale, sp[9 * 33] * scale, sp[10 * 33] * scale, sp[11 * 33] * scale);   o0.w = pg8::pk4_fp8(sp[12 * 33] * scale, sp[13 * 33] * scale, sp[14 * 33] * scale, sp[15 * 33] * scale);
    o1.x = pg8::pk4_fp8(sp[16 * 33] * scale, sp[17 * 33] * scale, sp[18 * 33] * scale, sp[19 * 33] * scale); o1.y = pg8::pk4_fp8(sp[20 * 33] * scale, sp[21 * 33] * scale, sp[22 * 33] * scale, sp[23 * 33] * scale);
    o1.z = pg8::pk4_fp8(sp[24 * 33] * scale, sp[25 * 33] * scale, sp[26 * 33] * scale, sp[27 * 33] * scale); o1.w = pg8::pk4_fp8(sp[28 * 33] * scale, sp[29 * 33] * scale, sp[30 * 33] * scale, sp[31 * 33] * scale);
    unsigned char* dst = WT8 + (size_t)(drow0 + n) * Kd + k0 + 32 * hf;
    *(v4u*)dst = o0; *(v4u*)(dst + 16) = o1;
    asm volatile("s_waitcnt lgkmcnt(0)" ::: "memory");
}
struct TBlk { const float* src; unsigned char* dst; int ldw, Kd, gu, which; float scale; };
__device__ __forceinline__ TBlk tblk_decode(const Params& p, int blk) {
    const int ie = blk / 96, q = blk - ie * 96, layer = ie >> 4, e = ie & 15, which = q >> 5, idx = q & 31;
    TBlk t; t.which = which;
    if (which < 2) { const int kb = idx & 3, nb = idx >> 2, k0 = 256 * kb, n0 = 256 * nb;
        t.src = (which == 0 ? p.in[I_WG] : p.in[I_WU]) + (size_t)ie * DM * FF + (size_t)k0 * FF + n0; t.ldw = FF; t.Kd = DM; t.scale = W8_GU; t.gu = 1;
        t.dst = p.ws + WS_WGU + (size_t)layer * WS_MOE_LSTRIDE + (size_t)e * 4096 * DM + (size_t)(2 * nb) * 256 * DM + k0; }
    else { const int kb = idx & 7, nb = idx >> 3, k0 = 256 * kb, n0 = 256 * nb;
        t.src = p.in[I_WD] + (size_t)ie * FF * DM + (size_t)k0 * DM + n0; t.ldw = DM; t.Kd = FF; t.scale = W8_DN; t.gu = 0;
        t.dst = p.ws + WS_WDN + (size_t)layer * WS_MOE_LSTRIDE + (size_t)e * DM * FF + (size_t)n0 * FF + k0; }
    return t;
}
__device__ __forceinline__ void tblk_load(const TBlk& t, f32x4 (&v)[16], int wave, int lane, int hf) {
    const float* sp = t.src + (size_t)(32 * wave + 16 * hf) * t.ldw + 4 * lane;
#pragma unroll
    for (int i = 0; i < 16; ++i) v[i] = *(const f32x4*)(sp + (size_t)i * t.ldw);
}
constexpr int TPITCH = 264;
__device__ __forceinline__ void tblk_pack(const TBlk& t, const f32x4 (&v)[16], LAS unsigned char* T, int wave, int lane, int hf) {
#pragma unroll
    for (int i = 0; i < 4; ++i) {
        const f32x4 r0 = v[4 * i] * t.scale, r1 = v[4 * i + 1] * t.scale, r2 = v[4 * i + 2] * t.scale, r3 = v[4 * i + 3] * t.scale;
#pragma unroll
        for (int j = 0; j < 4; ++j) { int w = 0; w = __builtin_amdgcn_cvt_pk_fp8_f32(r0[j], r1[j], w, false); w = __builtin_amdgcn_cvt_pk_fp8_f32(r2[j], r3[j], w, true);
            *(LAS unsigned*)(T + (64 * j + lane) * TPITCH + 32 * wave + 16 * hf + 4 * i) = (unsigned)w; }
    }
}
__device__ __forceinline__ void tblk_writeout(const TBlk& t, const LAS unsigned char* T, int tid) {
#pragma unroll
    for (int it = 0; it < 8; ++it) { const int idx = it * 512 + tid, n = idx >> 4, ch = idx & 15, rho = (n & 3) * 64 + (n >> 2);
        const LAS unsigned char* sp = T + rho * TPITCH + 16 * ch;
        const v2u a = *(const LAS v2u*)sp, b2 = *(const LAS v2u*)(sp + 8);
        const int drow = t.gu ? ((n >> 7) * 256 + (n & 127) + t.which * 128) : n;
        *(v4u*)(t.dst + (size_t)drow * t.Kd + 16 * ch) = (v4u){a.x, a.y, b2.x, b2.y}; }
}
__device__ __forceinline__ void moe_transpose_blocks(const Params& p, const Ctx& c, int blk0, int blk1, int widx, int nw) {
    LAS unsigned char* T = c.lds;
    f32x4 va[16], vb[16];
    int blk = blk0 + widx;
    if (blk >= blk1) return;
    TBlk t = tblk_decode(p, blk);
    tblk_load(t, va, c.wave, c.lane, 0);
#pragma unroll 1
    for (; blk < blk1; blk += nw) {
        tblk_load(t, vb, c.wave, c.lane, 1);
        tblk_pack(t, va, T, c.wave, c.lane, 0);
        const int nb = blk + nw;
        TBlk tn = tblk_decode(p, nb < blk1 ? nb : blk0);
        if (nb < blk1) tblk_load(tn, va, c.wave, c.lane, 0);
        tblk_pack(t, vb, T, c.wave, c.lane, 1);
        __syncthreads();
        tblk_writeout(t, T, c.tid);
        __syncthreads();
        t = tn;
    }
}
__device__ __forceinline__ void tail_transposes(const Params& p, const Ctx& c, int first_idle, int my, int blk0, int nblk) {
    if (!TAIL_TRANSPOSE || c.G != 256 || my < first_idle) return;
    moe_transpose_blocks(p, c, blk0, blk0 + nblk, my - first_idle, c.G - first_idle);
}
__device__ __forceinline__ void ph_transposes(const Params& p, const Ctx& c) {
    LAS float* scr = (LAS float*)(c.lds + c.wave * 16384);
    constexpr int I0 = 16 * 72, I1 = 16 * 32, I2 = 16 * 64, I3 = 16 * 32, ISM = I0 + I1 + I2 + I3;
    for (int r0 = c.gw; r0 < ISM; r0 += c.NGW) {
        int r = r0;
        if (r < I0) { const int n0 = 32 * (r % 72), drow = FUSE_QKV ? ((n0 >> 8) * 256 + 128 * ((n0 >> 5) & 1) + 32 * ((n0 >> 6) & 3)) : n0;
            transpose_item(p.in[I_W0IN], EIN, 64 * (r / 72), n0, (bf16*)(p.ws + WS_W0IN), DM, drow, scr, c.lane); continue; } r -= I0;
        if (r < I1) { transpose_item(p.in[I_W0OUT], DM, 64 * (r / 32), 32 * (r % 32), (bf16*)(p.ws + WS_W0OUT), DM, 32 * (r % 32), scr, c.lane); continue; } r -= I1;
        if (r < I2) { transpose_item(p.in[I_W1IN], OIN, 64 * (r / 64), 32 * (r % 64), (bf16*)(p.ws + WS_W1IN), DM, 32 * (r % 64), scr, c.lane); continue; } r -= I2;
        transpose_item(p.in[I_W1OUT], DM, 64 * (r / 32), 32 * (r % 32), (bf16*)(p.ws + WS_W1OUT), DM, 32 * (r % 32), scr, c.lane);
    }
    static_assert(MOE_FP8, "the expert-weight transposes write e4m3 copies");
    __syncthreads();
    moe_transpose_blocks(p, c, 0, (TAIL_TRANSPOSE && c.G == 256) ? 1536 : 3072, c.vcu, c.G);
}

__device__ __forceinline__ void ph_modulate0(const Params& p, const Ctx& c) {
    bf16* HB = (bf16*)(p.ws + WS_HB);
    for (int row = c.gw; row < NTOK; row += c.NGW) {
        const float* src = row < LAT ? p.in[I_X] + (size_t)row * DM : p.in[I_CTX] + (size_t)(row - LAT) * DM;
        const float* mod = mod_row(p, 0, row);
#pragma unroll
        for (int j = 0; j < 4; ++j) {
            const int col = 4 * c.lane + 256 * j;
            const f32x4 v = *(const f32x4*)(src + col), sh = *(const f32x4*)(mod + col), s = *(const f32x4*)(mod + 1024 + col);
            const f32x4 h = v * (s + 1.f) + sh;
            *(v2u*)(HB + (size_t)row * DM + col) = (v2u){pk2(h.x, h.y), pk2(h.z, h.w)};
        }
    }
}

struct NG { const bf16* A; int lda; const float* W0; const float* W1; int ldw; size_t wstride; int Mb; int row_begin, row_end, col_begin, col_end, K; };
template <int NB, class Epi>
__device__ __forceinline__ void ngemm(const NG& g, const Ctx& c, const Epi& epi) {
    const int nmt = (g.row_end - g.row_begin) / 32, nnt = (g.col_end - g.col_begin) / 32;
    const int l31 = c.lane & 31, lh = c.lane >> 5;
    for (int t = c.gw; t < nmt * nnt; t += c.NGW) {
        const int mt = t / nnt, nt = t % nnt;
        const int row0 = g.row_begin + mt * 32, col0 = g.col_begin + nt * 32;
        const int e = row0 / g.Mb;
        const bf16* ap = g.A + (size_t)(row0 + l31) * g.lda + lh;
        const float* bp0 = g.W0 + (size_t)e * g.wstride + (size_t)lh * g.ldw + col0 + l31;
        const float* bp1 = NB == 2 ? g.W1 + (size_t)e * g.wstride + (size_t)lh * g.ldw + col0 + l31 : nullptr;
        f32x16 acc0 = {}, acc1 = {};
#pragma unroll 8
        for (int k = 0; k < g.K; k += 2) {
            const float a = bf2f((unsigned)ap[k]);
            const float b0 = bp0[(size_t)k * g.ldw];
            acc0 = __builtin_amdgcn_mfma_f32_32x32x2f32(a, b0, acc0, 0, 0, 0);
            if (NB == 2) { const float b1 = bp1[(size_t)k * g.ldw]; acc1 = __builtin_amdgcn_mfma_f32_32x32x2f32(a, b1, acc1, 0, 0, 0); }
        }
#pragma unroll
        for (int r = 0; r < 16; ++r) {
            const int row = row0 + (r & 3) + 8 * (r >> 2) + 4 * lh, col = col0 + l31;
            epi(row, col, acc0[r], acc1[r]);
        }
    }
}
struct EpiF32 { float* O; int ldc; __device__ __forceinline__ void operator()(int row, int col, float v0, float) const { O[(size_t)row * ldc + col] = v0; } };
struct EpiBf { bf16* O; int ldc; int scale_cols; float sc; __device__ __forceinline__ void operator()(int row, int col, float v0, float) const { O[(size_t)row * ldc + col] = (bf16)f2bf(col < scale_cols ? v0 * sc : v0); } };
struct EpiSwiglu { bf16* O; __device__ __forceinline__ void operator()(int row, int col, float g, float u) const { const float s = g / (1.f + __expf(-g)); O[(size_t)row * FF + col] = (bf16)f2bf(s * u); } };
struct EpiGate { bf16* O; const float* gate; __device__ __forceinline__ void operator()(int row, int col, float v0, float) const { O[(size_t)row * DM + col] = (bf16)f2bf(v0 * gate[row]); } };

template <bool F32IN> __device__ __forceinline__ void ph_qkv_post(const Params& p, const Ctx& c) {
    const float* PF = (const float*)(p.ws + WS_PF);
    bf16* QKV = (bf16*)(p.ws + WS_QKV);
    const f32x2* R = (const f32x2*)(p.ws + WS_ROPE);
    const float* qn = p.in[I_QN]; const float* kn = p.in[I_KN];
    const int d = c.lane;
    const float qg = qn[d], kg = kn[d];
    for (int row = c.gw; row < NTOK; row += c.NGW) {
        const bool lat = row < LAT;
        const int t = row & 2047;
        const int pos = (d < 32) ? (t >> 6) : (t & 63);
        const f32x2 cs = R[pos * 16 + (d & 15)];
        const bool first = (d & 16) == 0;
        float vv[36];
#pragma unroll
        for (int hs = 0; hs < 36; ++hs) vv[hs] = F32IN ? PF[(size_t)row * EIN + hs * 64 + d] : bf2f((unsigned)QKV[(size_t)row * EIN + hs * 64 + d]);
#pragma unroll
        for (int hs = 0; hs < 36; ++hs) {
            float v = vv[hs];
            const bool isq = hs < 8 || (hs >= 24 && hs < 32);
            const bool isk = (hs >= 8 && hs < 16) || hs == 32 || hs == 33;
            const bool nrm = hs >= 24 && hs < 34;
            if (nrm) { const float ss = wave_sum(v * v); v = v * rsqrtf(ss * (1.f / 64.f) + RMS_EPS) * (hs < 32 ? qg : kg); }
            if ((isq || isk) && lat) { const float pr = __shfl_xor(v, 16); v = first ? v * cs.x - pr * cs.y : v * cs.x + pr * cs.y; }
            if (isq) v *= C2;
            QKV[(size_t)row * EIN + hs * 64 + d] = (bf16)f2bf(v);
        }
    }
}

__device__ __forceinline__ void ph_attn0_naive(const Params& p, const Ctx& c) {
    const bf16* QKV = (const bf16*)(p.ws + WS_QKV);
    bf16* CC = (bf16*)(p.ws + WS_CC);
    bf16* AO = (bf16*)(p.ws + WS_AO);
    LAS float* Ks = (LAS float*)c.lds;
    LAS float* Vs = Ks + 4096;
    for (int u = c.vcu; u < 960; u += c.G) {
        const bool isctx = u >= 768;
        int b, vh, qrow, ntiles; bool active = true;
        if (!isctx) { b = u / 96; const int r = u % 96; vh = r >> 2; qrow = b * SEQ + (r & 3) * 512 + c.tid; ntiles = 36; }
        else { const int uu = u - 768; b = uu / 24; vh = uu % 24; qrow = LAT + b * NCTX + (c.tid & 255); active = c.tid < 256; ntiles = 4; }
        int qcol, kcol, vcol;
        if (vh < 16) { const int a = vh >> 2, s = (vh >> 1) & 1, half = vh & 1; qcol = a * 128 + s * 64; kcol = 512 + a * 128 + s * 64; vcol = 1024 + a * 128 + half * 64; }
        else { const int h = vh - 16; qcol = 1536 + h * 64; kcol = 2048 + (h >> 2) * 64; vcol = 2176 + (h >> 2) * 64; }
        float q[64], o[64];
#pragma unroll
        for (int i = 0; i < 8; ++i) { const v4u w = *(const v4u*)(QKV + (size_t)qrow * EIN + qcol + 8 * i); unpack8(w, q + 8 * i); }
#pragma unroll
        for (int i = 0; i < 64; ++i) o[i] = 0.f;
        float m = -1e30f, l = 0.f;
        for (int t = 0; t < ntiles; ++t) {
            const int krow0 = isctx ? LAT + b * NCTX + 64 * t : (t < 32 ? b * SEQ + 64 * t : LAT + b * NCTX + 64 * (t - 32));
            __syncthreads();
            { const int r = c.tid >> 3, ch = c.tid & 7; float f[8];
              const v4u kw = *(const v4u*)(QKV + (size_t)(krow0 + r) * EIN + kcol + ch * 8); unpack8(kw, f);
#pragma unroll
              for (int j = 0; j < 8; ++j) Ks[r * 64 + ch * 8 + j] = f[j];
              const v4u vw = *(const v4u*)(QKV + (size_t)(krow0 + r) * EIN + vcol + ch * 8); unpack8(vw, f);
#pragma unroll
              for (int j = 0; j < 8; ++j) Vs[r * 64 + ch * 8 + j] = f[j]; }
            __syncthreads();
            if (active) {
                for (int kk = 0; kk < 64; ++kk) {
                    float s = 0.f;
#pragma unroll
                    for (int dd = 0; dd < 64; ++dd) s += q[dd] * Ks[kk * 64 + dd];
                    const float mn = fmaxf(m, s), al = exp2f(m - mn), pp = exp2f(s - mn);
                    l = l * al + pp; m = mn;
#pragma unroll
                    for (int dd = 0; dd < 64; ++dd) o[dd] = o[dd] * al + pp * Vs[kk * 64 + dd];
                }
            }
        }
        if (active) {
            const float rl = 1.f / l;
            bf16* dst = vh < 16 ? AO + (size_t)qrow * DM + (vh >> 2) * 256 + ((vh >> 1) & 1) * 128 + (vh & 1) * 64 : CC + (size_t)qrow * DM + 512 + (vh - 16) * 64;
            {
#pragma unroll
                for (int i = 0; i < 8; ++i) *(v4u*)(dst + 8 * i) = (v4u){pk2(o[8 * i] * rl, o[8 * i + 1] * rl), pk2(o[8 * i + 2] * rl, o[8 * i + 3] * rl), pk2(o[8 * i + 4] * rl, o[8 * i + 5] * rl), pk2(o[8 * i + 6] * rl, o[8 * i + 7] * rl)}; }
        }
    }
}


__device__ __forceinline__ void attn_combine_rows(const Params& p, const Ctx& c, int row0, int a, float lam, float g0, float g1) {
    const bf16* AO = (const bf16*)(p.ws + WS_AO); bf16* CC = (bf16*)(p.ws + WS_CC);
    asm volatile("s_waitcnt vmcnt(0)" ::: "memory");
#pragma unroll 1
    for (int rb = 0; rb < 32; rb += 8) {
        float x0[8], x1[8];
#pragma unroll
        for (int j = 0; j < 8; ++j) { const bf16* src = AO + (size_t)(row0 + rb + j) * DM + a * 256;
            x0[j] = bf2f((unsigned)src[c.lane]) - lam * bf2f((unsigned)src[128 + c.lane]); x1[j] = bf2f((unsigned)src[64 + c.lane]) - lam * bf2f((unsigned)src[192 + c.lane]); }
#pragma unroll
        for (int j = 0; j < 8; ++j) { const float ss = wave_sum(x0[j] * x0[j] + x1[j] * x1[j]); const float r = rsqrtf(ss * (1.f / 128.f) + RMS_EPS);
            bf16* dst = CC + (size_t)(row0 + rb + j) * DM + a * 128;
            dst[c.lane] = (bf16)f2bf(x0[j] * r * g0); dst[64 + c.lane] = (bf16)f2bf(x1[j] * r * g1); }
    }
}
__device__ __forceinline__ void ph_attn0_fast(const Params& p, const Ctx& c, char* lds_generic) {
    typedef attn_body::bf16 abf;
    const abf* Q = (const abf*)(p.ws + WS_QKV); abf* CCb = (abf*)(p.ws + WS_CC); abf* AOb = (abf*)(p.ws + WS_AO);
    const float d1 = wave_sum(p.in[I_LQ1][c.lane] * p.in[I_LK1][c.lane]), d2 = wave_sum(p.in[I_LQ2][c.lane] * p.in[I_LK2][c.lane]);
    const float lam = expf(d1) - expf(d2) + LAM_INIT;
    const float g0 = p.in[I_SUBLN][c.lane] * (1.f - LAM_INIT), g1 = p.in[I_SUBLN][c.lane + 64] * (1.f - LAM_INIT);
    for (int v = c.vcu; v < 256; v += c.G) {
#pragma unroll 1
        for (int step = 0; step < 10; ++step) {
            attn_body::AU u; int vh; bool ctxu = false;
            if (step < 4) { const int b = v >> 5, a = (v >> 3) & 3; vh = 4 * a + step; u.qrow0 = b * SEQ + (v & 7) * 256; u.lat_row0 = b * SEQ; u.ctx_row0 = LAT + b * NCTX; }
            else if (step < 6) { const int U = (step - 4) * 256 + v, b = U >> 6; vh = 16 + ((U >> 3) & 7); u.qrow0 = b * SEQ + (U & 7) * 256; u.lat_row0 = b * SEQ; u.ctx_row0 = LAT + b * NCTX; }
            else { ctxu = true; int b;
                if (v < 32) { b = v >> 2; vh = 4 * (v & 3) + (step - 6); }
                else if (v < 96 && step == 6) { b = (v - 32) >> 3; vh = 16 + ((v - 32) & 7); }
                else break;
                u.qrow0 = LAT + b * NCTX; u.lat_row0 = 0; u.ctx_row0 = LAT + b * NCTX; }
            if (!ctxu) { u.nlat_t = 32; u.NT = 36; } else { u.nlat_t = 0; u.NT = 4; }
            int qcol, kcol, vcol; abf* op;
            if (vh < 16) { const int a = vh >> 2, s = (vh >> 1) & 1, half = vh & 1; qcol = a * 128 + s * 64; kcol = 512 + a * 128 + s * 64; vcol = 1024 + a * 128 + half * 64; op = AOb + a * 256 + s * 128 + half * 64; }
            else { const int h = vh - 16; qcol = 1536 + h * 64; kcol = 2048 + (h >> 2) * 64; vcol = 2176 + (h >> 2) * 64; op = CCb + 512 + h * 64; }
            u.Qp = Q + qcol; u.Kp = Q + kcol; u.Vp = Q + vcol; u.Op = op;
            attn_body::attn_unit<8, EIN, attn_body::NoMask>(u, lds_generic, attn_body::NoMask{});
            if (vh < 16 && (vh & 3) == 3) attn_combine_rows(p, c, u.qrow0 + c.wave * 32, vh >> 2, lam, g0, g1);
        }
    }
    tail_transposes(p, c, 96, c.vcu, 1536 + 120, 320);
}

__device__ __forceinline__ void ph_attn_combine(const Params& p, const Ctx& c) {
    const bf16* AO = (const bf16*)(p.ws + WS_AO);
    bf16* CC = (bf16*)(p.ws + WS_CC);
    const float d1 = wave_sum(p.in[I_LQ1][c.lane] * p.in[I_LK1][c.lane]);
    const float d2 = wave_sum(p.in[I_LQ2][c.lane] * p.in[I_LK2][c.lane]);
    const float lam = expf(d1) - expf(d2) + LAM_INIT;
    const float g0 = p.in[I_SUBLN][c.lane] * (1.f - LAM_INIT), g1 = p.in[I_SUBLN][c.lane + 64] * (1.f - LAM_INIT);
    for (int it = c.gw; it < NTOK * 4; it += c.NGW) {
        const int row = it >> 2, a = it & 3;
        const bf16* src = AO + (size_t)row * DM + a * 256;
        const float x0 = bf2f((unsigned)src[c.lane]) - lam * bf2f((unsigned)src[128 + c.lane]), x1 = bf2f((unsigned)src[64 + c.lane]) - lam * bf2f((unsigned)src[192 + c.lane]);
        const float ss = wave_sum(x0 * x0 + x1 * x1);
        const float r = rsqrtf(ss * (1.f / 128.f) + RMS_EPS);
        CC[(size_t)row * DM + a * 128 + c.lane] = (bf16)f2bf(x0 * r * g0);
        CC[(size_t)row * DM + a * 128 + 64 + c.lane] = (bf16)f2bf(x1 * r * g1);
    }
}

__device__ __forceinline__ f32x4 unpack4(const v2u w) { return (f32x4){bf2f(w.x & 0xffffu), __uint_as_float(w.x & 0xffff0000u), bf2f(w.y & 0xffffu), __uint_as_float(w.y & 0xffff0000u)}; }
__device__ __forceinline__ float reduce_logits(const f32x4 (&lg)[4], int lane) {
    float w8[8], w4[4], w2[2], w1;
    { const bool hi = (lane & 32) != 0;
#pragma unroll
      for (int i = 0; i < 8; ++i) { const float a0 = lg[i >> 2][i & 3], a1 = lg[2 + (i >> 2)][i & 3]; const float keep = hi ? a1 : a0, send = hi ? a0 : a1; w8[i] = keep + __shfl_xor(send, 32); } }
    { const bool hi = (lane & 16) != 0;
#pragma unroll
      for (int i = 0; i < 4; ++i) { const float keep = hi ? w8[i + 4] : w8[i], send = hi ? w8[i] : w8[i + 4]; w4[i] = keep + __shfl_xor(send, 16); } }
    { const bool hi = (lane & 8) != 0;
#pragma unroll
      for (int i = 0; i < 2; ++i) { const float keep = hi ? w4[i + 2] : w4[i], send = hi ? w4[i] : w4[i + 2]; w2[i] = keep + __shfl_xor(send, 8); } }
    { const bool hi = (lane & 4) != 0; const float keep = hi ? w2[1] : w2[0], send = hi ? w2[0] : w2[1]; w1 = keep + __shfl_xor(send, 4); }
    w1 += __shfl_xor(w1, 2); w1 += __shfl_xor(w1, 1);
    return w1;
}
__device__ __forceinline__ void ph_ln1_router(const Params& p, const Ctx& c, int layer) {
    const bf16* Y = (const bf16*)(p.ws + WS_Y);
    bf16* XS = (bf16*)(p.ws + WS_XS);
    bf16* HB = (bf16*)(p.ws + WS_HB);
    float* AFF = (float*)(p.ws + WS_AFF);
    const float* lng = p.in[I_LNG] + (size_t)(layer * 2 + 0) * DM; const float* lnb = p.in[I_LNB] + (size_t)(layer * 2 + 0) * DM;
    const float* router = p.in[I_ROUTER] + (size_t)layer * DM * NE;
    LAS f32x4* R = (LAS f32x4*)c.lds;
    for (int idx = c.tid; idx < 4096; idx += 512) { const int e4 = idx & 3, k = idx >> 2, ln = (k & 255) >> 2, q = k & 3, j = k >> 8;
        R[((j * 4 + q) * 4 + e4) * 64 + ln] = *(const f32x4*)(router + (size_t)k * NE + 4 * e4); }
    __syncthreads();
    const int nrows = layer == 0 ? NTOK : LAT;
    const int lane = c.lane;
    for (int row = 2 * c.gw; row < nrows; row += 2 * c.NGW) {
        const float* mod = mod_row(p, layer, row);
        f32x4 va[4], vb[4]; float sa = 0.f, sb = 0.f;
#pragma unroll
        for (int j = 0; j < 4; ++j) { const int col = 4 * lane + 256 * j;
            f32x4 xa, xb;
            if (layer == 0) { const float* xin = row < LAT ? p.in[I_X] + (size_t)row * DM : p.in[I_CTX] + (size_t)(row - LAT) * DM; xa = *(const f32x4*)(xin + col); xb = *(const f32x4*)(xin + DM + col); }
            else { xa = unpack4(*(const v2u*)(XS + (size_t)row * DM + col)); xb = unpack4(*(const v2u*)(XS + (size_t)(row + 1) * DM + col)); }
            const f32x4 g1 = *(const f32x4*)(mod + 2048 + col);
            va[j] = xa * ALPHA + g1 * unpack4(*(const v2u*)(Y + (size_t)row * DM + col));
            vb[j] = xb * ALPHA + g1 * unpack4(*(const v2u*)(Y + (size_t)(row + 1) * DM + col));
            sa += (va[j].x + va[j].y) + (va[j].z + va[j].w); sb += (vb[j].x + vb[j].y) + (vb[j].z + vb[j].w); }
        const float meana = wave_sum(sa) * (1.f / DM), meanb = wave_sum(sb) * (1.f / DM); float qa = 0.f, qb = 0.f;
#pragma unroll
        for (int j = 0; j < 4; ++j) { va[j] = va[j] - meana; vb[j] = vb[j] - meanb;
            qa += (va[j].x * va[j].x + va[j].y * va[j].y) + (va[j].z * va[j].z + va[j].w * va[j].w); qb += (vb[j].x * vb[j].x + vb[j].y * vb[j].y) + (vb[j].z * vb[j].z + vb[j].w * vb[j].w); }
        const float rstda = 1.f / sqrtf(wave_sum(qa) * (1.f / DM) + LN_EPS), rstdb = 1.f / sqrtf(wave_sum(qb) * (1.f / DM) + LN_EPS);
        f32x4 lga[4], lgb[4];
#pragma unroll
        for (int e = 0; e < 4; ++e) { lga[e] = (f32x4){0.f, 0.f, 0.f, 0.f}; lgb[e] = (f32x4){0.f, 0.f, 0.f, 0.f}; }
#pragma unroll
        for (int j = 0; j < 4; ++j) { const int col = 4 * lane + 256 * j;
            const f32x4 g = *(const f32x4*)(lng + col), bb = *(const f32x4*)(lnb + col), sc = *(const f32x4*)(mod + 4096 + col) + 1.f, sh = *(const f32x4*)(mod + 3072 + col);
            const f32x4 x1a = va[j] * rstda * g + bb, x1b = vb[j] * rstdb * g + bb;
            *(v2u*)(XS + (size_t)row * DM + col) = (v2u){pk2(x1a.x, x1a.y), pk2(x1a.z, x1a.w)};
            *(v2u*)(XS + (size_t)(row + 1) * DM + col) = (v2u){pk2(x1b.x, x1b.y), pk2(x1b.z, x1b.w)};
            const f32x4 hma = x1a * sc + sh, hmb = x1b * sc + sh;
            if (MOE_FP8) { *(unsigned*)((unsigned char*)HB + (size_t)row * DM + col) = pg8::pk4_fp8(hma.x, hma.y, hma.z, hma.w);
                           *(unsigned*)((unsigned char*)HB + (size_t)(row + 1) * DM + col) = pg8::pk4_fp8(hmb.x, hmb.y, hmb.z, hmb.w); }
            else { *(v2u*)(HB + (size_t)row * DM + col) = (v2u){pk2(hma.x, hma.y), pk2(hma.z, hma.w)}; *(v2u*)(HB + (size_t)(row + 1) * DM + col) = (v2u){pk2(hmb.x, hmb.y), pk2(hmb.z, hmb.w)}; }
            asm volatile("" ::: "memory");
#pragma unroll
            for (int q = 0; q < 4; ++q) { const float ha = hma[q], hb = hmb[q];
#pragma unroll
                for (int e4 = 0; e4 < 4; ++e4) { const f32x4 rw = R[((j * 4 + q) * 4 + e4) * 64 + lane]; lga[e4] += rw * ha; lgb[e4] += rw * hb; } } }
        const float wa = reduce_logits(lga, lane), wb = reduce_logits(lgb, lane);
        float mxa = wa, mxb = wb;
#pragma unroll
        for (int o = 4; o < 64; o <<= 1) { mxa = fmaxf(mxa, __shfl_xor(mxa, o)); mxb = fmaxf(mxb, __shfl_xor(mxb, o)); }
        const float exa = expf(wa - mxa), exb = expf(wb - mxb); float dena = exa, denb = exb;
#pragma unroll
        for (int o = 4; o < 64; o <<= 1) { dena += __shfl_xor(dena, o); denb += __shfl_xor(denb, o); }
        if ((lane & 3) == 0) { const int e = ((lane >> 5) & 1) * 8 + ((lane >> 4) & 1) * 4 + ((lane >> 3) & 1) * 2 + ((lane >> 2) & 1);
            AFF[(size_t)row * NE + e] = exa / dena; AFF[(size_t)(row + 1) * NE + e] = exb / denb; }
    }
}

__device__ __forceinline__ void ph_topk(const Params& p, const Ctx& c, int layer) {
    const float* AFF = (const float*)(p.ws + WS_AFF);
    int* INV = (int*)(p.ws + WS_INV);
    float* GATE = (float*)(p.ws + WS_GATE);
    const bf16* HB = (const bf16*)(p.ws + WS_HB);
    bf16* XG = (bf16*)(p.ws + WS_XG);
    LAS unsigned* hist = (LAS unsigned*)c.lds;
    LAS unsigned* ctl = hist + 256;
    LAS int* sel = (LAS int*)(c.lds + 2048);
    const int MR = layer == 0 ? MR0 : MR1;
    const int ntasks = layer == 0 ? 256 : 128;
    const int lane = c.lane;
    for (int task = c.vcu; task < ntasks; task += c.G) {
        int set, e, n, cap, rowbase, slotbase;
        if (task < 128) { set = task >> 4; e = task & 15; n = SEQ; cap = 256; rowbase = set * SEQ; slotbase = set * 256; }
        else { const int t2 = task - 128; set = t2 >> 4; e = t2 & 15; n = NCTX; cap = 32; rowbase = LAT + set * NCTX; slotbase = 2048 + set * 32; }
        const bool valid = 4 * c.tid < n;
        unsigned key[4];
#pragma unroll
        for (int q = 0; q < 4; ++q) key[q] = valid ? __float_as_uint(AFF[(size_t)(rowbase + 4 * c.tid + q) * NE + e]) : 0u;
        unsigned prefix = 0u, need = (unsigned)cap;
#pragma unroll 1
        for (int pass = 0; pass < 4; ++pass) {
            const int shift = 24 - 8 * pass;
            if (c.tid < 256) hist[c.tid] = 0u;
            __syncthreads();
            if (valid) {
#pragma unroll
                for (int q = 0; q < 4; ++q) if (pass == 0 || (key[q] >> (shift + 8)) == (prefix >> (shift + 8))) __hip_atomic_fetch_add(&hist[(key[q] >> shift) & 255u], 1u, __ATOMIC_RELAXED, __HIP_MEMORY_SCOPE_WORKGROUP);
            }
            __syncthreads();
            if (c.wave == 0) {
                const unsigned h0 = hist[4 * lane], h1 = hist[4 * lane + 1], h2 = hist[4 * lane + 2], h3 = hist[4 * lane + 3];
                const unsigned tot = h0 + h1 + h2 + h3; unsigned sfx = tot;
#pragma unroll
                for (int o = 1; o < 64; o <<= 1) { const unsigned t = __shfl_down(sfx, o); if (lane + o < 64) sfx += t; }
                const unsigned above = sfx - tot, c3 = above + h3, c2 = c3 + h2, c1 = c2 + h1, c0 = c1 + h0;
                int d = -1; unsigned gtc = 0u;
                if (above < need && need <= c3) { d = 3; gtc = above; }
                else if (c3 < need && need <= c2) { d = 2; gtc = c3; }
                else if (c2 < need && need <= c1) { d = 1; gtc = c2; }
                else if (c1 < need && need <= c0) { d = 0; gtc = c1; }
                if (d >= 0) { ctl[0] = prefix | ((unsigned)(4 * lane + d) << shift); ctl[1] = need - gtc; }
            }
            __syncthreads();
            prefix = ctl[0]; need = ctl[1];
        }
        unsigned ngt = 0u, neq = 0u;
#pragma unroll
        for (int q = 0; q < 4; ++q) { ngt += (valid && key[q] > prefix) ? 1u : 0u; neq += (valid && key[q] == prefix) ? 1u : 0u; }
        const unsigned cnt = ngt | (neq << 16); unsigned inc = cnt;
#pragma unroll
        for (int o = 1; o < 64; o <<= 1) { const unsigned t = __shfl_up(inc, o); if (lane >= o) inc += t; }
        if (lane == 63) ctl[8 + c.wave] = inc;
        __syncthreads();
        unsigned base = 0u;
#pragma unroll
        for (int w = 0; w < 8; ++w) base += (w < c.wave) ? ctl[8 + w] : 0u;
        const unsigned ex = base + inc - cnt; unsigned gtb = ex & 0xffffu, eqb = ex >> 16;
        if (valid) {
#pragma unroll
            for (int q = 0; q < 4; ++q) { const int i = 4 * c.tid + q; int slot = -1;
                if (key[q] > prefix) { slot = (int)(gtb + (eqb < need ? eqb : need)); ++gtb; }
                else if (key[q] == prefix) { if (eqb < need) slot = (int)(gtb + eqb); ++eqb; }
                int gs = -1;
                if (slot >= 0) { gs = e * MR + slotbase + slot; sel[slot] = i; GATE[gs] = __uint_as_float(key[q]); }
                INV[(size_t)(rowbase + i) * NE + e] = gs; }
        }
        __syncthreads();
        for (int sidx = c.wave; sidx < cap; sidx += 8) {
            if (MOE_FP8) { const unsigned char* src = (const unsigned char*)HB + (size_t)(rowbase + sel[sidx]) * DM; unsigned char* dst = (unsigned char*)XG + (size_t)(e * MR + slotbase + sidx) * DM;
                *(v4u*)(dst + 16 * lane) = *(const v4u*)(src + 16 * lane); }
            else { const bf16* src = HB + (size_t)(rowbase + sel[sidx]) * DM; bf16* dst = XG + (size_t)(e * MR + slotbase + sidx) * DM;
            const v4u a0 = *(const v4u*)(src + 8 * lane), a1 = *(const v4u*)(src + 512 + 8 * lane);
            *(v4u*)(dst + 8 * lane) = a0; *(v4u*)(dst + 512 + 8 * lane) = a1; }
        }
        __syncthreads();
    }
}

__device__ __forceinline__ void ph_combine(const Params& p, const Ctx& c, int layer) {
    const bf16* YS = (const bf16*)(p.ws + WS_YS);
    const int* INV = (const int*)(p.ws + WS_INV);
    bf16* XS = (bf16*)(p.ws + WS_XS);
    bf16* HB = (bf16*)(p.ws + WS_HB);
    const float* lng = p.in[I_LNG] + (size_t)(layer * 2 + 1) * DM; const float* lnb = p.in[I_LNB] + (size_t)(layer * 2 + 1) * DM;
    const int nrows = layer == 0 ? NTOK : LAT;
    const int lane = c.lane;
    for (int row = 2 * c.gw; row < nrows; row += 2 * c.NGW) {
        const float* mod = mod_row(p, layer, row);
        const int inv = (lane < 2 * NE) ? INV[(size_t)row * NE + lane] : -1;
        const unsigned mall = (unsigned)__ballot(inv >= 0);
        unsigned ma = mall & 0xffffu, mb = mall >> 16;
        int sla[4], slb[4]; float wa[4], wb[4];
#pragma unroll
        for (int q = 0; q < 4; ++q) {
            if (ma) { const int e = __builtin_ctz(ma); ma &= ma - 1; sla[q] = __builtin_amdgcn_readlane(inv, e); wa[q] = 1.f; } else { sla[q] = 0; wa[q] = 0.f; }
            if (mb) { const int e = __builtin_ctz(mb); mb &= mb - 1; slb[q] = __builtin_amdgcn_readlane(inv, 16 + e); wb[q] = 1.f; } else { slb[q] = 0; wb[q] = 0.f; } }
        f32x4 moa[4], mob[4];
#pragma unroll
        for (int j = 0; j < 4; ++j) { moa[j] = (f32x4){0.f, 0.f, 0.f, 0.f}; mob[j] = (f32x4){0.f, 0.f, 0.f, 0.f}; }
#pragma unroll
        for (int q = 0; q < 4; ++q)
#pragma unroll
            for (int j = 0; j < 4; ++j) { moa[j] += unpack4(*(const v2u*)(YS + (size_t)sla[q] * DM + 4 * lane + 256 * j)) * wa[q]; mob[j] += unpack4(*(const v2u*)(YS + (size_t)slb[q] * DM + 4 * lane + 256 * j)) * wb[q]; }
        while (ma) { const int e = __builtin_ctz(ma); ma &= ma - 1; const int sl = __builtin_amdgcn_readlane(inv, e);
#pragma unroll
            for (int j = 0; j < 4; ++j) moa[j] += unpack4(*(const v2u*)(YS + (size_t)sl * DM + 4 * lane + 256 * j)); }
        while (mb) { const int e = __builtin_ctz(mb); mb &= mb - 1; const int sl = __builtin_amdgcn_readlane(inv, 16 + e);
#pragma unroll
            for (int j = 0; j < 4; ++j) mob[j] += unpack4(*(const v2u*)(YS + (size_t)sl * DM + 4 * lane + 256 * j)); }
        f32x4 va[4], vb[4]; float sa = 0.f, sb = 0.f;
#pragma unroll
        for (int j = 0; j < 4; ++j) { const int col = 4 * lane + 256 * j; const f32x4 g2 = *(const f32x4*)(mod + 5120 + col);
            va[j] = unpack4(*(const v2u*)(XS + (size_t)row * DM + col)) * ALPHA + g2 * moa[j];
            vb[j] = unpack4(*(const v2u*)(XS + (size_t)(row + 1) * DM + col)) * ALPHA + g2 * mob[j];
            sa += (va[j].x + va[j].y) + (va[j].z + va[j].w); sb += (vb[j].x + vb[j].y) + (vb[j].z + vb[j].w); }
        const float meana = wave_sum(sa) * (1.f / DM), meanb = wave_sum(sb) * (1.f / DM); float qa = 0.f, qb = 0.f;
#pragma unroll
        for (int j = 0; j < 4; ++j) { va[j] = va[j] - meana; vb[j] = vb[j] - meanb;
            qa += (va[j].x * va[j].x + va[j].y * va[j].y) + (va[j].z * va[j].z + va[j].w * va[j].w); qb += (vb[j].x * vb[j].x + vb[j].y * vb[j].y) + (vb[j].z * vb[j].z + vb[j].w * vb[j].w); }
        const float rstda = 1.f / sqrtf(wave_sum(qa) * (1.f / DM) + LN_EPS), rstdb = 1.f / sqrtf(wave_sum(qb) * (1.f / DM) + LN_EPS);
        const float* modn = mod_row(p, 1, row);
#pragma unroll
        for (int j = 0; j < 4; ++j) { const int col = 4 * lane + 256 * j;
            const f32x4 g = *(const f32x4*)(lng + col), bb = *(const f32x4*)(lnb + col);
            const f32x4 x2a = va[j] * rstda * g + bb, x2b = vb[j] * rstdb * g + bb;
            if (layer == 0) {
                *(v2u*)(XS + (size_t)row * DM + col) = (v2u){pk2(x2a.x, x2a.y), pk2(x2a.z, x2a.w)};
                *(v2u*)(XS + (size_t)(row + 1) * DM + col) = (v2u){pk2(x2b.x, x2b.y), pk2(x2b.z, x2b.w)};
                const f32x4 sc = *(const f32x4*)(modn + 1024 + col) + 1.f, sh = *(const f32x4*)(modn + col);
                const f32x4 ha = x2a * sc + sh, hb = x2b * sc + sh;
                *(v2u*)(HB + (size_t)row * DM + col) = (v2u){pk2(ha.x, ha.y), pk2(ha.z, ha.w)};
                *(v2u*)(HB + (size_t)(row + 1) * DM + col) = (v2u){pk2(hb.x, hb.y), pk2(hb.z, hb.w)};
            } else {
                *(f32x4*)(p.out + (size_t)row * DM + col) = x2a; *(f32x4*)(p.out + (size_t)(row + 1) * DM + col) = x2b;
            } }
    }
}

__device__ __forceinline__ void na_key(const float* q, float* o, float& m, float& l, const bf16* kp, const bf16* vp, float bias) {
    float s = bias;
#pragma unroll
    for (int i = 0; i < 8; ++i) { float f[8]; unpack8(*(const v4u*)(kp + 8 * i), f);
#pragma unroll
        for (int j = 0; j < 8; ++j) s += q[8 * i + j] * f[j]; }
    const float mn = fmaxf(m, s), al = exp2f(m - mn), pp = exp2f(s - mn);
    l = l * al + pp; m = mn;
#pragma unroll
    for (int i = 0; i < 8; ++i) { float f[8]; unpack8(*(const v4u*)(vp + 8 * i), f);
#pragma unroll
        for (int j = 0; j < 8; ++j) o[8 * i + j] = o[8 * i + j] * al + pp * f[j]; }
}
__device__ __forceinline__ void ph_mixer1_naive(const Params& p, const Ctx& c) {
    const bf16* P2 = (const bf16*)(p.ws + WS_QKV);
    bf16* CC = (bf16*)(p.ws + WS_CC);
    const float* rpb = p.in[I_RPB]; const float* pool_w = p.in[I_POOLW]; const float* pool_s = p.in[I_POOLS];
    LAS float* pl = (LAS float*)c.lds;
    for (int u = c.vcu; u < 256; u += c.G) {
        const int b = u >> 5, r = u & 31;
        {
            const int h = c.wave, col = c.lane, row = b * SEQ + r * 64 + col;
            const int rs = min(max(r - 4, 0), 24), cs = min(max(col - 8, 0), 48);
            float q[64], o[64];
#pragma unroll
            for (int i = 0; i < 8; ++i) unpack8(*(const v4u*)(P2 + (size_t)row * OIN + h * 64 + 8 * i), q + 8 * i);
#pragma unroll
            for (int i = 0; i < 64; ++i) o[i] = 0.f;
            float m = -1e30f, l = 0.f;
#pragma unroll 1
            for (int i = 0; i < 8; ++i)
#pragma unroll 1
                for (int j = 0; j < 16; ++j) {
                    const int krow = b * SEQ + (rs + i) * 64 + cs + j;
                    const float bias = rpb[(h * 15 + (rs + i - r + 7)) * 31 + (cs + j - col + 15)] * LOG2E;
                    na_key(q, o, m, l, P2 + (size_t)krow * OIN + 512 + h * 64, P2 + (size_t)krow * OIN + 1024 + h * 64, bias);
                }
#pragma unroll 1
            for (int j = 0; j < NCTX; ++j) {
                const int krow = LAT + b * NCTX + j;
                na_key(q, o, m, l, P2 + (size_t)krow * OIN + 512 + h * 64, P2 + (size_t)krow * OIN + 1024 + h * 64, 0.f);
            }
            const float rl = 1.f / l; bf16* dst = CC + (size_t)row * DM + h * 64;
#pragma unroll
            for (int i = 0; i < 8; ++i) *(v4u*)(dst + 8 * i) = (v4u){pk2(o[8 * i] * rl, o[8 * i + 1] * rl), pk2(o[8 * i + 2] * rl, o[8 * i + 3] * rl), pk2(o[8 * i + 4] * rl, o[8 * i + 5] * rl), pk2(o[8 * i + 6] * rl, o[8 * i + 7] * rl)};
        }
        __syncthreads();
        {
            const int ch = c.tid, g = ch >> 7, half = 1 << g;
            for (int tt = 0; tt < 64; ++tt) {
                const int t = r * 64 + tt, lo = max(t - half, 0), hi = min(t + half, SEQ);
                float s = 0.f;
                for (int t2 = lo; t2 < hi; ++t2) s += bf2f((unsigned)P2[(size_t)(b * SEQ + t2) * OIN + 1536 + ch]);
                pl[tt * 512 + ch] = s / (float)(hi - lo) - bf2f((unsigned)P2[(size_t)(b * SEQ + t) * OIN + 1536 + ch]);
            }
        }
        __syncthreads();
        {
            const int g = c.tid >> 7, e = c.tid & 127;
            const float ps = pool_s[g * 128 + e];
#pragma unroll 1
            for (int tb = 0; tb < 64; tb += 16) {
                float acc[16];
#pragma unroll
                for (int i = 0; i < 16; ++i) acc[i] = 0.f;
#pragma unroll 4
                for (int cc = 0; cc < 128; ++cc) {
                    const float w = pool_w[(size_t)(g * 128 + cc) * 128 + e];
#pragma unroll
                    for (int i = 0; i < 16; ++i) acc[i] += pl[(tb + i) * 512 + g * 128 + cc] * w;
                }
#pragma unroll
                for (int i = 0; i < 16; ++i) CC[(size_t)(b * SEQ + r * 64 + tb + i) * DM + 512 + g * 128 + e] = (bf16)f2bf(acc[i] * ps);
            }
        }
        __syncthreads();
    }
}


constexpr int NA_TAB_OFF = 86016 + 1024;
__device__ __forceinline__ void ph_mixer1_fast(const Params& p, const Ctx& c, char* lds_generic) {
    typedef attn_body::bf16 abf;
    const abf* P2a = (const abf*)(p.ws + WS_QKV); abf* CCa = (abf*)(p.ws + WS_CC);
    LAS float* tab = (LAS float*)(c.lds + NA_TAB_OFF);
    for (int i = c.tid; i < 8 * 15 * 32; i += 512) { const int hd = i >> 5, j = i & 31; tab[i] = j < 31 ? p.in[I_RPB][hd * 31 + j] * LOG2E : 0.f; }
    __syncthreads();
    for (int it = 0;; ++it) {
        const int U = it * c.G + c.vcu;
        if (U >= 512) break;
        const int b = U >> 6, h = (U >> 3) & 7, rq = U & 7;
        const int rs_min = min(max(4 * rq - 4, 0), 24);
        const int nloc = (rq == 0 || rq == 7) ? 8 : 12;
        attn_body::AU u;
        u.qrow0 = b * SEQ + rq * 256; u.lat_row0 = LAT + b * NCTX; u.nlat_t = 4; u.ctx_row0 = b * SEQ + rs_min * 64; u.NT = 4 + nloc;
        u.Qp = P2a + h * 64; u.Kp = P2a + 512 + h * 64; u.Vp = P2a + 1024 + h * 64; u.Op = CCa + h * 64;
        const int r = 4 * rq + (c.wave >> 1), col = (c.wave & 1) * 32 + (c.lane & 31), hi = c.lane >> 5;
        const int cs = min(max(col - 8, 0), 48);
        attn_body::NAMask mk; mk.tb0 = (attn_body::lds_cfptr)(tab + h * 15 * 32 + 15 - col); mk.r = r; mk.rs = min(max(r - 4, 0), 24); mk.rs_min = rs_min; mk.cb = 4 * hi - cs;
        attn_body::attn_unit<8, OIN, attn_body::NAMask>(u, lds_generic, mk);
    }
    __syncthreads();
    const bf16* P2 = (const bf16*)(p.ws + WS_QKV); bf16* CC = (bf16*)(p.ws + WS_CC);
    const float* pool_w = p.in[I_POOLW]; const float* pool_s = p.in[I_POOLS];
    constexpr int PLP = 1040;
    for (int u = c.vcu; u < 256; u += c.G) {
        const int b = u >> 5, r = u & 31;
        {   const int ch = c.tid, g = c.wave >> 1;
            const bf16* du = P2 + (size_t)b * SEQ * OIN + 1536 + ch;
            const int t0 = r * 64;
            float v[80];
#pragma unroll
            for (int k = 0; k < 80; ++k) { const int t2 = t0 - 8 + k; v[k] = ((t2 >= 0 && t2 < SEQ) ? 1.f : 0.f) * bf2f((unsigned)du[(size_t)min(max(t2, 0), SEQ - 1) * OIN]); }
            LAS bf16* plc = (LAS bf16*)(c.lds) + ch;
#define POOL_COL(HALF) do { float ws = 0.f; _Pragma("unroll") for (int k = 8 - HALF; k < 8 + HALF; ++k) ws += v[k]; \
            _Pragma("unroll") for (int tt = 0; tt < 64; ++tt) { const int t = t0 + tt, lo = max(t - HALF, 0), hi = min(t + HALF, SEQ); \
                plc[tt * (PLP / 2)] = (bf16)f2bf(ws / (float)(hi - lo) - v[tt + 8]); ws += v[tt + 8 + HALF] - v[tt + 8 - HALF]; } } while (0)
            if (g == 0) POOL_COL(1); else if (g == 1) POOL_COL(2); else if (g == 2) POOL_COL(4); else POOL_COL(8);
#undef POOL_COL
        }
        __syncthreads();
        {   typedef short bf16x8v __attribute__((ext_vector_type(8)));
            const int g = c.wave >> 1, th = c.wave & 1, l31 = c.lane & 31, lh = c.lane >> 5;
            f32x16 acc[4];
#pragma unroll
            for (int et = 0; et < 4; ++et) acc[et] = (f32x16){};
#pragma unroll
            for (int ks = 0; ks < 8; ++ks) {
                const bf16x8v af = *(const LAS bf16x8v*)(c.lds + (32 * th + l31) * PLP + (g * 128 + 16 * ks + 8 * lh) * 2);
#pragma unroll
                for (int et = 0; et < 4; ++et) {
                    const float* wp = pool_w + (size_t)(g * 128 + 16 * ks + 8 * lh) * 128 + 32 * et + l31;
                    bf16x8v bfr;
#pragma unroll
                    for (int j = 0; j < 8; ++j) bfr[j] = (short)f2bf(wp[(size_t)j * 128]);
                    acc[et] = __builtin_amdgcn_mfma_f32_32x32x16_bf16(af, bfr, acc[et], 0, 0, 0);
                }
            }
#pragma unroll
            for (int et = 0; et < 4; ++et) { const int e = 32 * et + l31; const float ps = pool_s[g * 128 + e];
#pragma unroll
                for (int rg = 0; rg < 16; ++rg) { const int tok = 32 * th + (rg & 3) + 8 * (rg >> 2) + 4 * lh;
                    CC[(size_t)(b * SEQ + r * 64 + tok) * DM + 512 + g * 128 + e] = (bf16)f2bf(acc[et][rg] * ps); } }
        }
        __syncthreads();
    }
}

__global__ void __launch_bounds__(512, 2) mk_fwd(Params p) {
    extern __shared__ __attribute__((aligned(16))) unsigned char lds_raw[];
    Ctx c;
    c.lds = (LAS unsigned char*)lds_raw;
    c.tid = threadIdx.x; c.lane = c.tid & 63; c.wave = __builtin_amdgcn_readfirstlane(c.tid >> 6);
    c.G = gridDim.x; { const int bx = blockIdx.x; c.vcu = (c.G % 8 == 0) ? (bx % 8) * (c.G / 8) + bx / 8 : bx; }
    c.gw = c.vcu * 8 + c.wave; c.NGW = c.G * 8;
    volatile LAS unsigned* MISC = (volatile LAS unsigned*)(c.lds + MISC_OFF);
    if (c.tid < 32) MISC[c.tid] = 0u;
    __syncthreads();
    gu32* ctl = (gu32*)(p.ws + WS_CTL);
    XcdBarrier bar; bar.bar = (unsigned*)(ctl + CW_BAR); bar.x = 0; bar.st = nullptr;
    if (!MK_MULTI) bar = xcd_barrier_post((unsigned*)(ctl + CW_BAR), MISC + 8);
    const int lo = p.ph_lo, hi = p.ph_hi;
    unsigned long long pt0 = 0, pt1 = 0; if (PROBE_PH == 0) pt0 = __builtin_amdgcn_s_memrealtime();
#define IN(k) (lo <= (k) && (k) < hi)
#define SEAM(k) do { if (IN(k) && IN((k) + 1) && !(FAST_ATTN && (k) == 5) && !(FAST_GEMM && FUSE_QKV && (k) == 3)) xcd_barrier(bar); if ((k) + 1 == PROBE_PH) pt0 = __builtin_amdgcn_s_memrealtime(); if ((k) == PROBE_PH) pt1 = __builtin_amdgcn_s_memrealtime(); } while (0)

    bf16* HB = (bf16*)(p.ws + WS_HB); bf16* QKV = (bf16*)(p.ws + WS_QKV); bf16* CC = (bf16*)(p.ws + WS_CC);
    float* Y = (float*)(p.ws + WS_Y); float* PF = (float*)(p.ws + WS_PF);
    bf16* XG = (bf16*)(p.ws + WS_XG); bf16* HID = (bf16*)(p.ws + WS_HID); bf16* YS = (bf16*)(p.ws + WS_YS);
    const float* GATE = (const float*)(p.ws + WS_GATE);

    if (IN(0)) for (int rep_ = 0; rep_ < 1 + (int)((PROBE_MASK >> 0) & 1u); ++rep_) { if (rep_) __syncthreads(); ph_prologue(p, c); if (FAST_GEMM) { __syncthreads(); ph_transposes(p, c); } } SEAM(0);
    if (IN(1)) for (int rep_ = 0; rep_ < 1 + (int)((PROBE_MASK >> 1) & 1u); ++rep_) { if (rep_) __syncthreads(); ph_modulate0(p, c); } SEAM(1);
    if (IN(2)) for (int rep_ = 0; rep_ < 1 + (int)((PROBE_MASK >> 2) & 1u); ++rep_) { if (rep_) __syncthreads();
        if (FAST_GEMM) { pg8::Gemm g{HB, (const bf16*)(p.ws + WS_W0IN), NTOK, EIN, DM, 0}; pg8::StaticOrder S; S.init(NTOK, EIN, c.G, (int)blockIdx.x);
            if (FUSE_QKV) { pg8::EpiQKV E{QKV, EIN, (const float*)(p.ws + WS_ROPE), p.in[I_QN], p.in[I_KN], C2, RMS_EPS}; pg8::gemm_phase<pg8::EpiQKV, pg8::StaticOrder, true, true>(c.lds, g, S, E); }
            else { pg8::EpiBf16<0> E{QKV, EIN, nullptr, 0, 0, 1.f}; pg8::gemm_phase<pg8::EpiBf16<0>, pg8::StaticOrder, true, true>(c.lds, g, S, E); }
            tail_transposes(p, c, 648 - 512, (int)blockIdx.x, 1536, 120); }
        else { NG g{HB, DM, p.in[I_W0IN], nullptr, EIN, 0, 1 << 30, 0, NTOK, 0, EIN, DM}; ngemm<1>(g, c, EpiF32{PF, EIN}); }
    } SEAM(2);
    if (!(FAST_GEMM && FUSE_QKV)) { if (IN(3)) { if (FAST_GEMM) ph_qkv_post<false>(p, c); else ph_qkv_post<true>(p, c); } } SEAM(3);
    if (IN(4)) for (int rep_ = 0; rep_ < 1 + (int)((PROBE_MASK >> 4) & 1u); ++rep_) { if (rep_) __syncthreads(); if (FAST_ATTN) ph_attn0_fast(p, c, (char*)lds_raw); else ph_attn0_naive(p, c); } SEAM(4);
    if (!FAST_ATTN) { if (IN(5)) { ph_attn_combine(p, c); } } SEAM(5);
    if (IN(6)) for (int rep_ = 0; rep_ < 1 + (int)((PROBE_MASK >> 6) & 1u); ++rep_) { if (rep_) __syncthreads();
        if (FAST_GEMM) { pg8::Gemm g{CC, (const bf16*)(p.ws + WS_W0OUT), NTOK, DM, DM, 0}; pg8::StaticOrder S; S.init(NTOK, DM, c.G, (int)blockIdx.x);
            pg8::EpiBf16<0> E{(bf16*)Y, DM, nullptr, 0, 0, 1.f}; pg8::gemm_phase<pg8::EpiBf16<0>, pg8::StaticOrder, true, true>(c.lds, g, S, E);
            tail_transposes(p, c, 288 - 256, (int)blockIdx.x, 1536 + 120 + 320, 224); }
        else { NG g{CC, DM, p.in[I_W0OUT], nullptr, DM, 0, 1 << 30, 0, NTOK, 0, DM, DM}; ngemm<1>(g, c, EpiBf{(bf16*)Y, DM, 0, 1.f}); }
    } SEAM(6);
    if (IN(7)) for (int rep_ = 0; rep_ < 1 + (int)((PROBE_MASK >> 7) & 1u); ++rep_) { if (rep_) __syncthreads(); ph_ln1_router(p, c, 0); } SEAM(7);
    if (IN(8)) for (int rep_ = 0; rep_ < 1 + (int)((PROBE_MASK >> 8) & 1u); ++rep_) { if (rep_) __syncthreads(); ph_topk(p, c, 0); } SEAM(8);
    if (IN(9)) for (int rep_ = 0; rep_ < 1 + (int)((PROBE_MASK >> 9) & 1u); ++rep_) { if (rep_) __syncthreads();
        if (FAST_GEMM && MOE_FP8) { pg8::Gemm g{XG, (const bf16*)(p.ws + WS_WGU), NE * MR0, 4096, DM / 2, (size_t)4096 * DM}; pg8::GroupedOrder S; S.init(MR0 / 256, 16, NE, c.G, c.vcu);
            pg8::EpiSwigluF8 E{(unsigned char*)HID, FF, 1.f / W8_GU, H8_SC}; pg8::gemm_phase<pg8::EpiSwigluF8, pg8::GroupedOrder, true, true, true>(c.lds, g, S, E); }
        else if (FAST_GEMM) { pg8::Gemm g{XG, (const bf16*)(p.ws + WS_WGU), NE * MR0, 4096, DM, (size_t)4096 * DM * 2}; pg8::GroupedOrder S; S.init(MR0 / 256, 16, NE, c.G, c.vcu);
            pg8::EpiSwigluP E{HID, FF}; pg8::gemm_phase<pg8::EpiSwigluP, pg8::GroupedOrder, true, true>(c.lds, g, S, E); }
        else { NG g{XG, DM, p.in[I_WG], p.in[I_WU], FF, (size_t)DM * FF, MR0, 0, NE * MR0, 0, FF, DM}; ngemm<2>(g, c, EpiSwiglu{HID}); }
    } SEAM(9);
    if (IN(10)) for (int rep_ = 0; rep_ < 1 + (int)((PROBE_MASK >> 10) & 1u); ++rep_) { if (rep_) __syncthreads();
        if (FAST_GEMM && MOE_FP8) { pg8::Gemm g{HID, (const bf16*)(p.ws + WS_WDN), NE * MR0, DM, FF / 2, (size_t)DM * FF}; pg8::GroupedOrder S; S.init(MR0 / 256, 4, NE, c.G, c.vcu);
            pg8::EpiGateS E{YS, DM, GATE, 1.f / (W8_DN * H8_SC)}; pg8::gemm_phase<pg8::EpiGateS, pg8::GroupedOrder, true, true, true>(c.lds, g, S, E);
            tail_transposes(p, c, 576 - 512, c.vcu, 1536 + 120 + 320 + 224, 576); }
        else if (FAST_GEMM) { pg8::Gemm g{HID, (const bf16*)(p.ws + WS_WDN), NE * MR0, DM, FF, (size_t)DM * FF * 2}; pg8::GroupedOrder S; S.init(MR0 / 256, 4, NE, c.G, c.vcu);
            pg8::EpiGateP E{YS, DM, GATE}; pg8::gemm_phase<pg8::EpiGateP, pg8::GroupedOrder, true, true>(c.lds, g, S, E); }
        else { NG g{HID, FF, p.in[I_WD], nullptr, DM, (size_t)FF * DM, MR0, 0, NE * MR0, 0, DM, FF}; ngemm<1>(g, c, EpiGate{YS, GATE}); }
    } SEAM(10);
    if (IN(11)) for (int rep_ = 0; rep_ < 1 + (int)((PROBE_MASK >> 11) & 1u); ++rep_) { if (rep_) __syncthreads(); ph_combine(p, c, 0); } SEAM(11);
    if (IN(12)) for (int rep_ = 0; rep_ < 1 + (int)((PROBE_MASK >> 12) & 1u); ++rep_) { if (rep_) __syncthreads();
        if (FAST_GEMM) { pg8::Gemm g{HB, (const bf16*)(p.ws + WS_W1IN), NTOK, OIN, DM, 0}; pg8::L1InOrder S; S.init(c.G, (int)blockIdx.x);
            pg8::EpiBf16<0> E{QKV, OIN, nullptr, 512, 512, C2}; pg8::gemm_phase<pg8::EpiBf16<0>, pg8::L1InOrder, true, true>(c.lds, g, S, E);
            tail_transposes(p, c, 544 - 512, (int)blockIdx.x, 1536 + 120 + 320 + 224 + 576, 296); }
        else {
        NG g{HB, DM, p.in[I_W1IN], nullptr, OIN, 0, 1 << 30, 0, LAT, 0, OIN, DM}; ngemm<1>(g, c, EpiBf{QKV, OIN, 512, C2});
        NG g2{HB, DM, p.in[I_W1IN], nullptr, OIN, 0, 1 << 30, LAT, NTOK, 512, 1536, DM}; ngemm<1>(g2, c, EpiBf{QKV, OIN, 0, 1.f}); }
    } SEAM(12);
    if (IN(13)) for (int rep_ = 0; rep_ < 1 + (int)((PROBE_MASK >> 13) & 1u); ++rep_) { if (rep_) __syncthreads(); if (FAST_NA) ph_mixer1_fast(p, c, (char*)lds_raw); else ph_mixer1_naive(p, c); } SEAM(13);
    if (IN(14)) for (int rep_ = 0; rep_ < 1 + (int)((PROBE_MASK >> 14) & 1u); ++rep_) { if (rep_) __syncthreads();
        if (FAST_GEMM) { pg8::Gemm g{CC, (const bf16*)(p.ws + WS_W1OUT), LAT, DM, DM, 0}; pg8::StaticOrder S; S.init(LAT, DM, c.G, (int)blockIdx.x);
            pg8::EpiBf16<0> E{(bf16*)Y, DM, nullptr, 0, 0, 1.f}; pg8::gemm_phase<pg8::EpiBf16<0>, pg8::StaticOrder, true, true>(c.lds, g, S, E); }
        else { NG g{CC, DM, p.in[I_W1OUT], nullptr, DM, 0, 1 << 30, 0, LAT, 0, DM, DM}; ngemm<1>(g, c, EpiBf{(bf16*)Y, DM, 0, 1.f}); }
    } SEAM(14);
    if (IN(15)) for (int rep_ = 0; rep_ < 1 + (int)((PROBE_MASK >> 15) & 1u); ++rep_) { if (rep_) __syncthreads(); ph_ln1_router(p, c, 1); } SEAM(15);
    if (IN(16)) for (int rep_ = 0; rep_ < 1 + (int)((PROBE_MASK >> 16) & 1u); ++rep_) { if (rep_) __syncthreads(); ph_topk(p, c, 1); } SEAM(16);
    if (IN(17)) for (int rep_ = 0; rep_ < 1 + (int)((PROBE_MASK >> 17) & 1u); ++rep_) { if (rep_) __syncthreads();
        if (FAST_GEMM && MOE_FP8) { pg8::Gemm g{XG, (const bf16*)(p.ws + WS_WGU + WS_MOE_LSTRIDE), NE * MR1, 4096, DM / 2, (size_t)4096 * DM}; pg8::GroupedOrder S; S.init(MR1 / 256, 16, NE, c.G, c.vcu);
            pg8::EpiSwigluF8 E{(unsigned char*)HID, FF, 1.f / W8_GU, H8_SC}; pg8::gemm_phase<pg8::EpiSwigluF8, pg8::GroupedOrder, true, true, true>(c.lds, g, S, E); }
        else if (FAST_GEMM) { pg8::Gemm g{XG, (const bf16*)(p.ws + WS_WGU + WS_MOE_LSTRIDE), NE * MR1, 4096, DM, (size_t)4096 * DM * 2}; pg8::GroupedOrder S; S.init(MR1 / 256, 16, NE, c.G, c.vcu);
            pg8::EpiSwigluP E{HID, FF}; pg8::gemm_phase<pg8::EpiSwigluP, pg8::GroupedOrder, true, true>(c.lds, g, S, E); }
        else { NG g{XG, DM, p.in[I_WG] + (size_t)NE * DM * FF, p.in[I_WU] + (size_t)NE * DM * FF, FF, (size_t)DM * FF, MR1, 0, NE * MR1, 0, FF, DM}; ngemm<2>(g, c, EpiSwiglu{HID}); }
    } SEAM(17);
    if (IN(18)) for (int rep_ = 0; rep_ < 1 + (int)((PROBE_MASK >> 18) & 1u); ++rep_) { if (rep_) __syncthreads();
        if (FAST_GEMM && MOE_FP8) { pg8::Gemm g{HID, (const bf16*)(p.ws + WS_WDN + WS_MOE_LSTRIDE), NE * MR1, DM, FF / 2, (size_t)DM * FF}; pg8::GroupedOrder S; S.init(MR1 / 256, 4, NE, c.G, c.vcu);
            pg8::EpiGateS E{YS, DM, GATE, 1.f / (W8_DN * H8_SC)}; pg8::gemm_phase<pg8::EpiGateS, pg8::GroupedOrder, true, true, true>(c.lds, g, S, E); }
        else if (FAST_GEMM) { pg8::Gemm g{HID, (const bf16*)(p.ws + WS_WDN + WS_MOE_LSTRIDE), NE * MR1, DM, FF, (size_t)DM * FF * 2}; pg8::GroupedOrder S; S.init(MR1 / 256, 4, NE, c.G, c.vcu);
            pg8::EpiGateP E{YS, DM, GATE}; pg8::gemm_phase<pg8::EpiGateP, pg8::GroupedOrder, true, true>(c.lds, g, S, E); }
        else { NG g{HID, FF, p.in[I_WD] + (size_t)NE * FF * DM, nullptr, DM, (size_t)FF * DM, MR1, 0, NE * MR1, 0, DM, FF}; ngemm<1>(g, c, EpiGate{YS, GATE}); }
    } SEAM(18);
    if (IN(19)) for (int rep_ = 0; rep_ < 1 + (int)((PROBE_MASK >> 19) & 1u); ++rep_) { if (rep_) __syncthreads(); ph_combine(p, c, 1); }
    if (PROBE_PH == 19) pt1 = __builtin_amdgcn_s_memrealtime();
    if (PROBE_PH >= 0 && blockIdx.x == 0 && c.tid == 0) { const unsigned long long te = __builtin_amdgcn_s_memrealtime(); while (__builtin_amdgcn_s_memrealtime() - te < pt1 - pt0) __builtin_amdgcn_s_sleep(8); }
#undef IN
#undef SEAM
}

extern "C" void kernel_launch(void* const* d_in, const int* in_sizes, int n_in, void* d_out, int out_size, void* d_ws, size_t ws_size, hipStream_t stream) {
    static int grid = 0;
    if (grid == 0) {
        if (n_in != 26 || out_size != LAT * DM || ws_size < WS_END) { fprintf(stderr, "kernel_launch: unexpected shapes (n_in %d out %d ws %zu)\n", n_in, out_size, ws_size); grid = -1; return; }
        int dev = 0, cus = 0;
        if (hipGetDevice(&dev) != hipSuccess || hipDeviceGetAttribute(&cus, hipDeviceAttributeMultiprocessorCount, dev) != hipSuccess) { grid = -1; return; }
        if (hipFuncSetAttribute((const void*)mk_fwd, hipFuncAttributeMaxDynamicSharedMemorySize, LDS_BYTES) != hipSuccess) { fprintf(stderr, "kernel_launch: hipFuncSetAttribute failed\n"); grid = -1; return; }
        int per_cu = 0;
        if (hipOccupancyMaxActiveBlocksPerMultiprocessor(&per_cu, (const void*)mk_fwd, 512, LDS_BYTES) != hipSuccess || per_cu < 1) fprintf(stderr, "kernel_launch: occupancy query says %d\n", per_cu);
        (void)hipGetLastError();
        grid = cus;
    }
    if (grid < 0) return;
    (void)hipMemsetAsync((char*)d_ws + WS_CTL, 0, CTL_ZERO_BYTES, stream);
    Params a{};
    for (int i = 0; i < 26; ++i) a.in[i] = (const float*)d_in[i];
    a.out = (float*)d_out; a.ws = (unsigned char*)d_ws;
#if MK_MULTI
    for (int ph = 0; ph < NPHASE; ++ph) { a.ph_lo = ph; a.ph_hi = ph + 1; hipLaunchKernelGGL(mk_fwd, dim3(grid), dim3(512), LDS_BYTES, stream, a); }
#else
    a.ph_lo = 0; a.ph_hi = NPHASE;
    hipLaunchKernelGGL(mk_fwd, dim3(grid), dim3(512), LDS_BYTES, stream, a);
#endif
}
```

```cpp
#include <hip/hip_runtime.h>
#include <cstdio>
#include <cstdint>

#define GAS __attribute__((address_space(1)))
#define LAS __attribute__((address_space(3)))
typedef unsigned short bf16;
typedef unsigned v4u __attribute__((ext_vector_type(4)));
typedef unsigned v2u __attribute__((ext_vector_type(2)));
typedef float f32x4 __attribute__((ext_vector_type(4)));
typedef float f32x2 __attribute__((ext_vector_type(2)));
typedef float f32x16 __attribute__((ext_vector_type(16)));
typedef GAS unsigned gu32;

#ifndef PROBE_PH
#define PROBE_PH -1
#endif
#ifndef PROBE_MASK
#define PROBE_MASK 0u
#endif
#ifndef TAIL_TRANSPOSE
#define TAIL_TRANSPOSE 1
#endif
#ifndef FUSE_QKV
#define FUSE_QKV 1
#endif
#ifndef MOE_FP8
#define MOE_FP8 1
#endif
#ifndef FAST_NA
#define FAST_NA 1
#endif
#ifndef FAST_ATTN
#define FAST_ATTN 1
#endif
#ifndef FAST_GEMM
#define FAST_GEMM 1
#endif
#ifndef MK_MULTI
#define MK_MULTI 0
#endif

constexpr int NBATCH = 8, SEQ = 2048, DM = 1024, NCTX = 256;
constexpr int LAT = NBATCH * SEQ;
constexpr int NTOK = LAT + NBATCH * NCTX;
constexpr int EIN = 2304, OIN = 2048, NE = 16, FF = 2048;
constexpr int MR0 = 2304, MR1 = 2048;
constexpr float LOG2E = 1.4426950408889634f;
constexpr float C2 = 0.125f * LOG2E;
constexpr float ALPHA = 1.4142135623730951f;
constexpr float LN_EPS = 1e-5f, RMS_EPS = 1e-6f;
constexpr float LAM_INIT = 0.2f;
constexpr int NPHASE = 20;
constexpr float W8_GU = 32.f, W8_DN = 64.f, H8_SC = 8.f;

constexpr size_t MiB = 1u << 20;
constexpr size_t WS_CTL = 0, CTL_ZERO_BYTES = 1 * MiB;
constexpr size_t WS_MOD = 1 * MiB;
constexpr size_t WS_ROPE = 1 * MiB + 512 * 1024;
constexpr size_t WS_W0IN = 2 * MiB;
constexpr size_t WS_W0OUT = 7 * MiB;
constexpr size_t WS_W1IN = 9 * MiB;
constexpr size_t WS_W1OUT = 13 * MiB;
constexpr size_t WS_AFF = 16 * MiB;
constexpr size_t WS_INV = 18 * MiB;
constexpr size_t WS_GATE = 20 * MiB;
constexpr size_t WS_WGU = 24 * MiB;
constexpr size_t WS_WDN = 152 * MiB;
constexpr size_t WS_MOE_LSTRIDE = 192 * MiB;
constexpr size_t WS_XS = 408 * MiB;
constexpr size_t WS_HB = 480 * MiB;
constexpr size_t WS_QKV = 516 * MiB;
constexpr size_t WS_CC = 597 * MiB;
constexpr size_t WS_AO = 633 * MiB;
constexpr size_t WS_Y = 705 * MiB;
constexpr size_t WS_XG = 516 * MiB;
constexpr size_t WS_HID = 588 * MiB;
constexpr size_t WS_YS = 732 * MiB;
constexpr size_t WS_PF = 804 * MiB;
constexpr size_t WS_END = 968 * MiB;

constexpr int CW_BAR = 4096;
constexpr int LDS_BYTES = 147456;
constexpr int MISC_OFF = 131072 + 320;

__device__ __forceinline__ float bf2f(unsigned v) { return __uint_as_float(v << 16); }
__device__ __forceinline__ unsigned f2bf(float f) { unsigned u = __float_as_uint(f); return (u + 0x7fffu + ((u >> 16) & 1u)) >> 16; }
__device__ __forceinline__ unsigned pk2(float lo, float hi) { return f2bf(lo) | (f2bf(hi) << 16); }
__device__ __forceinline__ float wave_sum(float v) {
#pragma unroll
    for (int o = 1; o < 64; o <<= 1) v += __shfl_xor(v, o);
    return v;
}
__device__ __forceinline__ float wave_max(float v) {
#pragma unroll
    for (int o = 1; o < 64; o <<= 1) v = fmaxf(v, __shfl_xor(v, o));
    return v;
}
__device__ __forceinline__ void unpack8(const v4u w, float* f) {
    f[0] = bf2f(w.x & 0xffffu); f[1] = __uint_as_float(w.x & 0xffff0000u);
    f[2] = bf2f(w.y & 0xffffu); f[3] = __uint_as_float(w.y & 0xffff0000u);
    f[4] = bf2f(w.z & 0xffffu); f[5] = __uint_as_float(w.z & 0xffff0000u);
    f[6] = bf2f(w.w & 0xffffu); f[7] = __uint_as_float(w.w & 0xffff0000u);
}

#define XB_TMO      128
#define XB_XCNT(j)  (256  + 64 * (j))
#define XB_XSUB(j)  (1280 + 64 * (j))
#define XB_XGEN(j)  (2304 + 64 * (j))
#define XB_TOP      3328
#define XB_TOPGEN   3392
#define XCD_BAR_WORDS 3456
#define XB_SPIN_CAP (1u << 18)
__device__ __forceinline__ unsigned xb_ld(unsigned* p)              { return __hip_atomic_load(p, __ATOMIC_RELAXED, __HIP_MEMORY_SCOPE_AGENT); }
__device__ __forceinline__ unsigned xb_add(unsigned* p, unsigned v) { return __hip_atomic_fetch_add(p, v, __ATOMIC_RELAXED, __HIP_MEMORY_SCOPE_AGENT); }
__device__ __forceinline__ unsigned xb_xcc_id() { return (unsigned)__builtin_amdgcn_s_getreg((3 << 11) | 20) & 0xFu; }
#define XB_SPIN(cond, bar) do { unsigned _sp = 0; while (cond) { __builtin_amdgcn_s_sleep(1); \
    if ((++_sp & 255u) == 0u) { if (xb_ld(&(bar)[XB_TMO])) break; if (_sp > XB_SPIN_CAP) { atomicAdd(&(bar)[XB_TMO], 1u); break; } } } } while (0)
struct XcdBarrier { unsigned* bar; unsigned x; volatile LAS unsigned* st; };
__device__ __forceinline__ XcdBarrier xcd_barrier_post(unsigned* bar, volatile LAS unsigned* st) {
    XcdBarrier b; b.bar = bar; b.x = xb_xcc_id(); b.st = st;
    if (threadIdx.x == 0) (void)xb_add(&bar[XB_XCNT(b.x)], 1u);
    return b;
}
__device__ __forceinline__ void xcd_barrier_complete(unsigned* bar, unsigned x, unsigned& nloc, unsigned& nx) {
    const unsigned G = gridDim.x * gridDim.y * gridDim.z;
    unsigned sum, cnt, mine, sp = 0u;
    for (;;) {
        sum = 0u; cnt = 0u; mine = 0u;
#pragma unroll
        for (unsigned j = 0; j < 16; ++j) { const unsigned c = xb_ld(&bar[XB_XCNT(j)]); sum += c; cnt += (c > 0u) ? 1u : 0u; mine = (j == x) ? c : mine; }
        if (sum == G) break;
        __builtin_amdgcn_s_sleep(1);
        if ((++sp & 255u) == 0u) { if (xb_ld(&bar[XB_TMO])) break; if (sp > XB_SPIN_CAP) { atomicAdd(&bar[XB_TMO], 1u); break; } }
    }
    nloc = mine > 0u ? mine : 1u; nx = cnt > 0u ? cnt : 1u;
}
__device__ __forceinline__ void xcd_barrier(const XcdBarrier& b) {
    asm volatile("s_waitcnt vmcnt(0)" ::: "memory");
    __syncthreads();
    if (threadIdx.x == 0) {
        unsigned* bar = b.bar;
        __builtin_amdgcn_s_waitcnt(0);
        unsigned nloc = b.st[0], nx = b.st[1];
        if (nloc == 0u) { xcd_barrier_complete(bar, b.x, nloc, nx); b.st[0] = nloc; b.st[1] = nx; }
        const unsigned old = xb_add(&bar[XB_XSUB(b.x)], 1u);
        const unsigned gen = old / nloc;
        if (old + 1u == (gen + 1u) * nloc) {
            __builtin_amdgcn_fence(__ATOMIC_RELEASE, "agent");
            asm volatile("s_waitcnt vmcnt(0)" ::: "memory");
            const unsigned og = xb_add(&bar[XB_TOP], 1u);
            const unsigned tg = og / nx;
            if (og + 1u == (tg + 1u) * nx) xb_add(&bar[XB_TOPGEN], 1u);
            else XB_SPIN(xb_ld(&bar[XB_TOPGEN]) == tg, bar);
            __builtin_amdgcn_fence(__ATOMIC_ACQUIRE, "agent");
            xb_add(&bar[XB_XGEN(b.x)], 1u);
            asm volatile("s_waitcnt vmcnt(0)" ::: "memory");
        } else {
            XB_SPIN(xb_ld(&bar[XB_XGEN(b.x)]) == gen, bar);
            __builtin_amdgcn_fence(__ATOMIC_ACQUIRE, "agent");
            asm volatile("s_waitcnt vmcnt(0)" ::: "memory");
        }
    }
    __syncthreads();
}

namespace pg8 {
#define PG8_LAS __attribute__((address_space(3)))
typedef unsigned short bf16_t;
typedef short bf16x8 __attribute__((ext_vector_type(8)));
typedef float f32x4 __attribute__((ext_vector_type(4)));
typedef unsigned u32x4 __attribute__((ext_vector_type(4)));
constexpr int BM = 256, BK = 64, HALF = 128, HTB = HALF * BK * 2  , STAGE_BYTES = 8 * HTB, NXCD = 8, WGM = 8;

__host__ __device__ __forceinline__ int lds_byte(int r, int c) { const int st = (r >> 4) * 2 + (c >> 5), rr = r & 15, cc = c & 31, ob = rr * 64 + cc * 2; return st * 1024 + (ob ^ (((ob >> 9) & 1) << 5)); }
__host__ __device__ __forceinline__ void stage_rc(int b, int& R, int& C) { const int st = b / 1024, sb = b % 1024, swz = sb ^ (((sb >> 9) & 1) << 5); R = (st >> 1) * 16 + swz / 64; C = (st & 1) * 32 + (swz % 64) / 2; }
__host__ __device__ __forceinline__ int perm32(int rho) { const int n = rho >> 4, i = rho & 15; return 8 * (i >> 2) + 4 * n + (i & 3); }

struct Unit { int pm, pn, e; };
struct Gemm { const bf16_t* A; const bf16_t* Bt; int M, N, K; size_t bstride; };

struct StaticOrder {
    int nM, nN, nwg, G, c;
    __host__ __device__ void init(int M, int N, int G_, int c_) { nM = M / BM; nN = N / BM; nwg = nM * nN; G = G_; c = c_; }
    __host__ __device__ bool next(int i, Unit& u) const {
        const long L = (long)i * G + c; if (L >= nwg) return false;
        int wgid = (int)L; { const int q = nwg / NXCD, r = nwg % NXCD, xcd = wgid % NXCD, off = wgid / NXCD; wgid = (xcd < r ? xcd * (q + 1) : r * (q + 1) + (xcd - r) * q) + off; }
        const int nig = WGM * nN, gid = wgid / nig, fm = gid * WGM, gsz = (nM - fm) < WGM ? (nM - fm) : WGM;
        u.pm = fm + ((wgid % nig) % gsz); u.pn = (wgid % nig) / gsz; u.e = 0; return true;
    }
    __device__ __forceinline__ void a_ready(const Unit&) const {}
    __device__ __forceinline__ void done(const Unit&) const {}
};

__device__ __forceinline__ unsigned cvt_pk_bf16(float lo, float hi) { unsigned r; asm volatile("v_cvt_pk_bf16_f32 %0, %1, %2" : "=v"(r) : "v"(lo), "v"(hi)); return r; }
typedef float f32x2 __attribute__((ext_vector_type(2)));
__device__ __forceinline__ f32x2 gelu_pk(f32x2 v) {
    const f32x2 av = __builtin_elementwise_abs(v), d = av * 0.2316418882f + 1.0f;
    f32x2 t; t.x = __builtin_amdgcn_rcpf(d.x); t.y = __builtin_amdgcn_rcpf(d.y);
    f32x2 q = t * 0.5307027145f + (-0.7265760135f); q = q * t + 0.7107068705f; q = q * t + (-0.142248368f); q = q * t + 0.127414796f; q = q * t;
    const f32x2 s = (v * v) * (-0.72134752044f);
    f32x2 e; e.x = __builtin_amdgcn_exp2f(s.x); e.y = __builtin_amdgcn_exp2f(s.y);
    const f32x2 m = v * (q * e), r = v - m;
    f32x2 o; o.x = v.x < 0.f ? m.x : r.x; o.y = v.y < 0.f ? m.y : r.y; return o;
}

template <int ACT  > struct EpiBf16 {
    static constexpr bool PERM = true, AFTER_DRAIN = false; static_assert(ACT == 0 || ACT == 1, "EpiBf16: ACT is 0 (none) or 1 (gelu_pk)");
    bf16_t* O; int ldc; const float* bias; int split_cols; size_t split_stride; float scale0;
    __device__ __forceinline__ void operator()(const f32x4 (&acc)[2][2][4][2], const Unit& u, int wr, int wc, int fr, int fq) const {
        const int row0 = u.pm * BM + wr * 64 + fr; int colt = u.pn * BM; bf16_t* base = O;
        float sc = 1.f; if (split_cols) { const int t = colt / split_cols; base += (size_t)t * split_stride; colt -= t * split_cols; if (t == 0) sc = scale0; }
        const int col0 = colt + wc * 32 + 8 * fq, bcol0 = u.pn * BM + wc * 32 + 8 * fq;
        f32x4 bv[2][2];
#pragma unroll
        for (int bj = 0; bj < 2; ++bj)
#pragma unroll
            for (int n = 0; n < 2; ++n) bv[bj][n] = bias ? *(const f32x4*)(bias + bcol0 + bj * HALF + 4 * n) : (f32x4){0.f, 0.f, 0.f, 0.f};
#pragma unroll
        for (int ai = 0; ai < 2; ++ai)
#pragma unroll
            for (int m = 0; m < 4; ++m) { bf16_t* rowp = base + (size_t)(row0 + ai * HALF + m * 16) * ldc + col0;
#pragma unroll
                for (int bj = 0; bj < 2; ++bj) { f32x4 v0 = acc[ai][bj][m][0] + bv[bj][0], v1 = acc[ai][bj][m][1] + bv[bj][1];
                    if (ACT == 1) { f32x2 a = gelu_pk((f32x2){v0[0], v0[1]}), b = gelu_pk((f32x2){v0[2], v0[3]}), c = gelu_pk((f32x2){v1[0], v1[1]}), d = gelu_pk((f32x2){v1[2], v1[3]});
                        v0 = (f32x4){a.x, a.y, b.x, b.y}; v1 = (f32x4){c.x, c.y, d.x, d.y}; }
                    v0 = v0 * sc; v1 = v1 * sc; u32x4 w; w.x = cvt_pk_bf16(v0[0], v0[1]); w.y = cvt_pk_bf16(v0[2], v0[3]); w.z = cvt_pk_bf16(v1[0], v1[1]); w.w = cvt_pk_bf16(v1[2], v1[3]);
                    *(u32x4*)(rowp + bj * HALF) = w; } }
    }
};

typedef int i32x4 __attribute__((ext_vector_type(4))); typedef int i32x8 __attribute__((ext_vector_type(8)));
__device__ __forceinline__ i32x8 cat16(bf16x8 lo, bf16x8 hi) { const i32x4 a = __builtin_bit_cast(i32x4, lo), b = __builtin_bit_cast(i32x4, hi); return __builtin_shufflevector(a, b, 0, 1, 2, 3, 4, 5, 6, 7); }
__device__ __forceinline__ void mfma_f8_acc(f32x4& acc, const i32x8& b, const i32x8& a, int sc) {
    asm volatile("v_mfma_scale_f32_16x16x128_f8f6f4 %0, %1, %2, %0, %3, %3 op_sel_hi:[0,0,0]" : "+v"(acc) : "v"(b), "v"(a), "v"(sc)); }
template <class Epi, class Sched, bool ALIGN_EPI = false, bool SP2 = false, bool FP8 = false>
__device__ __forceinline__ void gemm_phase(PG8_LAS unsigned char* lds, const Gemm g, const Sched& S, const Epi& E) {
    const int tid = threadIdx.x, wid = __builtin_amdgcn_readfirstlane(tid >> 6), lane = tid & 63, wr = wid >> 2, wc = wid & 3, fr = lane & 15, fq = lane >> 4;
    const int K = g.K, nt = K / BK;
    unsigned voffA[2], voffB[2];
#pragma unroll
    for (int i = 0; i < 2; ++i) { int R, C; stage_rc(tid * 16 + i * 8192, R, C); const int Rb = Epi::PERM ? ((R & ~31) + perm32(R & 31)) : R;
        voffA[i] = (unsigned)(R * K + C) * 2u; voffB[i] = (unsigned)(Rb * K + C) * 2u; }
    const size_t kstep = (size_t)(BK * 2);
    const size_t hstep = (size_t)HALF * K * 2;
    const size_t tstep = 2 * hstep;
    const unsigned ldsw = (unsigned)wid * 1024u;
    const int aoff = FP8 ? lds_byte(wr * 64 + fr, 16 * fq) : lds_byte(wr * 64 + fr, fq * 8), boff = FP8 ? lds_byte(wc * 32 + fr, 16 * fq) : lds_byte(wc * 32 + fr, fq * 8);
    constexpr int KOFF = FP8 ? 16 : 1024;
#define PG8_SA(b, h) (((b) * 2 + (h)) * HTB)
#define PG8_SB(b, h) ((4 + (b) * 2 + (h)) * HTB)
#define PG8_STAGE(bufoff, gbase, voff) do { _Pragma("unroll") for (int _i = 0; _i < 2; ++_i) \
        __builtin_amdgcn_global_load_lds((const unsigned*)((const char*)(gbase) + (voff)[_i]), (PG8_LAS unsigned*)(lds + (bufoff) + ldsw + _i * 8192), 16, 0, 0); } while (0)
#define PG8_LDA(dst, b, h) do { _Pragma("unroll") for (int m = 0; m < 4; ++m) _Pragma("unroll") for (int k = 0; k < 2; ++k) dst[m][k] = *(const PG8_LAS bf16x8*)(lds + PG8_SA(b, h) + aoff + m * 2048 + k * KOFF); } while (0)
#define PG8_LDB(dst, b, h) do { _Pragma("unroll") for (int n = 0; n < 2; ++n) _Pragma("unroll") for (int k = 0; k < 2; ++k) dst[n][k] = *(const PG8_LAS bf16x8*)(lds + PG8_SB(b, h) + boff + n * 2048 + k * KOFF); } while (0)
#define PG8_MMA(ai, bj, At, Bt) do { __builtin_amdgcn_s_setprio(1); _Pragma("unroll") for (int m = 0; m < 4; ++m) _Pragma("unroll") for (int n = 0; n < 2; ++n) { \
        if constexpr (FP8) mfma_f8_acc(acc[ai][bj][m][n], cat16(Bt[n][0], Bt[n][1]), cat16(At[m][0], At[m][1]), f8scale); \
        else { _Pragma("unroll") for (int k = 0; k < 2; ++k) acc[ai][bj][m][n] = __builtin_amdgcn_mfma_f32_16x16x32_bf16(Bt[n][k], At[m][k], acc[ai][bj][m][n], 0, 0, 0); } } __builtin_amdgcn_s_setprio(0); } while (0)
#define PG8_WAIT_V(n) asm volatile("s_waitcnt vmcnt(" #n ")" ::: "memory")
#define PG8_WAIT_L(n) asm volatile("s_waitcnt lgkmcnt(" #n ")" ::: "memory")
#define PG8_BAR __builtin_amdgcn_s_barrier()
#define PG8_SCHED __builtin_amdgcn_sched_barrier(0)
    Unit cur, nxt; int ui = 0;
    if (!S.next(0, cur)) return;
    f32x4 acc[2][2][4][2];
#pragma unroll
    for (int a = 0; a < 2; ++a)
#pragma unroll
        for (int b = 0; b < 2; ++b)
#pragma unroll
            for (int m = 0; m < 4; ++m)
#pragma unroll
                for (int n = 0; n < 2; ++n) acc[a][b][m][n] = (f32x4){0.f, 0.f, 0.f, 0.f};
    int f8scale = 0x7F7F7F7F; asm volatile("" : "+v"(f8scale));
    bf16x8 At[4][2], B0[2][2], B1[2][2];
    const char* cA = (const char*)g.A + (size_t)cur.pm * tstep; const char* cB = (const char*)g.Bt + (size_t)cur.pn * tstep + (size_t)cur.e * g.bstride;
    S.a_ready(cur);
    if constexpr (SP2) {
        PG8_STAGE(PG8_SB(0, 0), cB, voffB); PG8_STAGE(PG8_SB(0, 1), cB + hstep, voffB); PG8_STAGE(PG8_SA(0, 0), cA, voffA); PG8_STAGE(PG8_SA(0, 1), cA + hstep, voffA);
        if (wr == 1) PG8_BAR;
        PG8_WAIT_V(2); PG8_BAR;
        PG8_STAGE(PG8_SB(1, 0), cB + kstep, voffB); PG8_STAGE(PG8_SA(1, 0), cA + kstep, voffA); PG8_STAGE(PG8_SB(1, 1), cB + hstep + kstep, voffB);
        PG8_WAIT_V(6); PG8_BAR;
    } else {
        PG8_STAGE(PG8_SB(0, 0), cB, voffB); PG8_STAGE(PG8_SA(0, 0), cA, voffA); PG8_STAGE(PG8_SB(0, 1), cB + hstep, voffB); PG8_STAGE(PG8_SA(0, 1), cA + hstep, voffA);
        if (wr == 1) PG8_BAR;
        PG8_WAIT_V(4); PG8_BAR;
        PG8_STAGE(PG8_SB(1, 0), cB + kstep, voffB); PG8_STAGE(PG8_SA(1, 0), cA + kstep, voffA); PG8_STAGE(PG8_SB(1, 1), cB + hstep + kstep, voffB);
        PG8_WAIT_V(6); PG8_BAR;
    }
    for (;;) {
        const bool has_next = S.next(ui + 1, nxt);
        const char* nA = has_next ? (const char*)g.A + (size_t)nxt.pm * tstep : cA; const char* nB = has_next ? (const char*)g.Bt + (size_t)nxt.pn * tstep + (size_t)nxt.e * g.bstride : cB;
        for (int t = 0; t < nt; t += 2) {
            const bool last = (t == nt - 2);
            const char* a1 = cA + (size_t)(t + 1) * kstep;
            const char* a2 = last ? nA : cA + (size_t)(t + 2) * kstep; const char* b2 = last ? nB : cB + (size_t)(t + 2) * kstep;
            const char* a3 = a2 + kstep; const char* b3 = b2 + kstep;
            if (last && has_next) S.a_ready(nxt);
            if constexpr (SP2) {
            PG8_LDB(B0, 0, 0); PG8_LDB(B1, 0, 1); PG8_SCHED; PG8_LDA(At, 0, 0); PG8_STAGE(PG8_SA(1, 1), a1 + hstep, voffA);
            PG8_WAIT_V(8); PG8_WAIT_L(0); PG8_BAR; PG8_MMA(0, 0, At, B0); PG8_MMA(0, 1, At, B1); PG8_BAR; PG8_SCHED;
            PG8_LDA(At, 0, 1); PG8_STAGE(PG8_SB(0, 0), b2, voffB); PG8_STAGE(PG8_SB(0, 1), b2 + hstep, voffB); PG8_STAGE(PG8_SA(0, 0), a2, voffA);
            PG8_WAIT_V(8); PG8_WAIT_L(0); PG8_BAR; PG8_MMA(1, 0, At, B0); PG8_MMA(1, 1, At, B1); PG8_BAR; PG8_SCHED;
            PG8_LDB(B0, 1, 0); PG8_LDB(B1, 1, 1); PG8_SCHED; PG8_LDA(At, 1, 0); PG8_STAGE(PG8_SA(0, 1), a2 + hstep, voffA);
            PG8_WAIT_V(8); PG8_WAIT_L(0); PG8_BAR; PG8_MMA(0, 0, At, B0); PG8_MMA(0, 1, At, B1); PG8_BAR; PG8_SCHED;
            PG8_LDA(At, 1, 1); PG8_STAGE(PG8_SB(1, 0), b3, voffB); PG8_STAGE(PG8_SB(1, 1), b3 + hstep, voffB); PG8_STAGE(PG8_SA(1, 0), a3, voffA);
            PG8_WAIT_V(8); PG8_WAIT_L(0); PG8_BAR; PG8_MMA(1, 0, At, B0); PG8_MMA(1, 1, At, B1); PG8_BAR; PG8_SCHED;
            } else {
            PG8_LDB(B0, 0, 0); PG8_SCHED; PG8_LDA(At, 0, 0); PG8_STAGE(PG8_SA(1, 1), a1 + hstep, voffA);
            PG8_WAIT_L(8); PG8_BAR; PG8_WAIT_L(0); PG8_MMA(0, 0, At, B0); PG8_BAR; PG8_SCHED;
            PG8_LDB(B1, 0, 1); PG8_STAGE(PG8_SB(0, 0), b2, voffB);
            PG8_BAR; PG8_WAIT_L(0); PG8_MMA(0, 1, At, B1); PG8_BAR;
            PG8_LDA(At, 0, 1); PG8_STAGE(PG8_SA(0, 0), a2, voffA);
            PG8_BAR; PG8_WAIT_L(0); PG8_MMA(1, 0, At, B0); PG8_BAR; PG8_SCHED;
            PG8_STAGE(PG8_SB(0, 1), b2 + hstep, voffB);
            PG8_WAIT_V(6); PG8_BAR; PG8_MMA(1, 1, At, B1); PG8_BAR;
            PG8_LDB(B0, 1, 0); PG8_SCHED; PG8_LDA(At, 1, 0); PG8_STAGE(PG8_SA(0, 1), a2 + hstep, voffA);
            PG8_WAIT_L(8); PG8_BAR; PG8_WAIT_L(0); PG8_MMA(0, 0, At, B0); PG8_BAR; PG8_SCHED;
            PG8_LDB(B1, 1, 1); PG8_STAGE(PG8_SB(1, 0), b3, voffB);
            PG8_BAR; PG8_WAIT_L(0); PG8_MMA(0, 1, At, B1); PG8_BAR;
            PG8_LDA(At, 1, 1); PG8_STAGE(PG8_SA(1, 0), a3, voffA);
            PG8_BAR; PG8_WAIT_L(0); PG8_MMA(1, 0, At, B0); PG8_BAR; PG8_SCHED;
            PG8_STAGE(PG8_SB(1, 1), b3 + hstep, voffB);
            PG8_WAIT_V(6); PG8_BAR; PG8_MMA(1, 1, At, B1); PG8_BAR;
            }
        }
        if constexpr (ALIGN_EPI) { if (wr == 0) PG8_BAR; }
        if constexpr (FP8) asm volatile("s_nop 15\n\ts_nop 15" : "+v"(acc[1][1][0][0]), "+v"(acc[1][1][0][1]), "+v"(acc[1][1][1][0]), "+v"(acc[1][1][1][1]), "+v"(acc[1][1][2][0]), "+v"(acc[1][1][2][1]), "+v"(acc[1][1][3][0]), "+v"(acc[1][1][3][1]));
        if constexpr (!Epi::AFTER_DRAIN) { E(acc, cur, wr, wc, fr, fq); S.done(cur); }
        if (!has_next) break;
#pragma unroll
        for (int a = 0; a < 2; ++a)
#pragma unroll
            for (int b = 0; b < 2; ++b)
#pragma unroll
                for (int m = 0; m < 4; ++m)
#pragma unroll
                    for (int n = 0; n < 2; ++n) acc[a][b][m][n] = (f32x4){0.f, 0.f, 0.f, 0.f};
        cur = nxt; cA = nA; cB = nB; ++ui;
        if constexpr (ALIGN_EPI) { if (wr == 1) PG8_BAR; }
    }
    PG8_WAIT_V(0);
    if constexpr (!ALIGN_EPI) { if (wr == 0) PG8_BAR; }
    PG8_BAR;
    if constexpr (Epi::AFTER_DRAIN) { E.fused(acc, cur, wr, wc, fr, fq, lds, wid, lane); S.done(cur); }
#undef PG8_SA
#undef PG8_SB
#undef PG8_STAGE
#undef PG8_LDA
#undef PG8_LDB
#undef PG8_MMA
#undef PG8_WAIT_V
#undef PG8_WAIT_L
#undef PG8_BAR
#undef PG8_SCHED
}
}

namespace pg8 {
struct EpiF32P {
    static constexpr bool PERM = false, AFTER_DRAIN = false;
    float* O; int ldc;
    __device__ __forceinline__ void operator()(const f32x4 (&acc)[2][2][4][2], const Unit& u, int wr, int wc, int fr, int fq) const {
        const int row0 = u.pm * BM + wr * 64 + fr, col0 = u.pn * BM + wc * 32 + 4 * fq;
#pragma unroll
        for (int ai = 0; ai < 2; ++ai)
#pragma unroll
            for (int m = 0; m < 4; ++m) { float* rowp = O + (size_t)(row0 + ai * HALF + m * 16) * ldc + col0;
#pragma unroll
                for (int bj = 0; bj < 2; ++bj)
#pragma unroll
                    for (int n = 0; n < 2; ++n) *(f32x4*)(rowp + bj * HALF + n * 16) = acc[ai][bj][m][n]; }
    }
};
struct EpiSwigluP {
    static constexpr bool PERM = true, AFTER_DRAIN = false;
    bf16_t* O; int ldc;
    __device__ __forceinline__ void operator()(const f32x4 (&acc)[2][2][4][2], const Unit& u, int wr, int wc, int fr, int fq) const {
        const int row0 = u.pm * BM + wr * 64 + fr, col0 = u.pn * HALF + wc * 32 + 8 * fq;
#pragma unroll
        for (int ai = 0; ai < 2; ++ai)
#pragma unroll
            for (int m = 0; m < 4; ++m) {
                float h[8];
#pragma unroll
                for (int n = 0; n < 2; ++n)
#pragma unroll
                    for (int j = 0; j < 4; ++j) { const float g = acc[ai][0][m][n][j], up = acc[ai][1][m][n][j];
                        h[4 * n + j] = g * up * __builtin_amdgcn_rcpf(1.0f + __builtin_amdgcn_exp2f(-1.4426950408889634f * g)); }
                u32x4 w; w.x = cvt_pk_bf16(h[0], h[1]); w.y = cvt_pk_bf16(h[2], h[3]); w.z = cvt_pk_bf16(h[4], h[5]); w.w = cvt_pk_bf16(h[6], h[7]);
                *(u32x4*)(O + (size_t)(row0 + ai * HALF + m * 16) * ldc + col0) = w; }
    }
};
struct EpiGateP {
    static constexpr bool PERM = true, AFTER_DRAIN = false;
    bf16_t* O; int ldc; const float* gate;
    __device__ __forceinline__ void operator()(const f32x4 (&acc)[2][2][4][2], const Unit& u, int wr, int wc, int fr, int fq) const {
        const int row0 = u.pm * BM + wr * 64 + fr, col0 = u.pn * BM + wc * 32 + 8 * fq;
#pragma unroll
        for (int ai = 0; ai < 2; ++ai)
#pragma unroll
            for (int m = 0; m < 4; ++m) { const int row = row0 + ai * HALF + m * 16; const float gt = gate[row]; bf16_t* rowp = O + (size_t)row * ldc + col0;
#pragma unroll
                for (int bj = 0; bj < 2; ++bj) { const f32x4 v0 = acc[ai][bj][m][0] * gt, v1 = acc[ai][bj][m][1] * gt;
                    u32x4 w; w.x = cvt_pk_bf16(v0[0], v0[1]); w.y = cvt_pk_bf16(v0[2], v0[3]); w.z = cvt_pk_bf16(v1[0], v1[1]); w.w = cvt_pk_bf16(v1[2], v1[3]);
                    *(u32x4*)(rowp + bj * HALF) = w; } }
    }
};
__device__ __forceinline__ unsigned pk4_fp8(float a, float b, float c, float d) {
    a = __builtin_fminf(__builtin_fmaxf(a, -448.f), 448.f); b = __builtin_fminf(__builtin_fmaxf(b, -448.f), 448.f);
    c = __builtin_fminf(__builtin_fmaxf(c, -448.f), 448.f); d = __builtin_fminf(__builtin_fmaxf(d, -448.f), 448.f);
    int w = 0; w = __builtin_amdgcn_cvt_pk_fp8_f32(a, b, w, false); w = __builtin_amdgcn_cvt_pk_fp8_f32(c, d, w, true); return (unsigned)w; }
struct EpiSwigluF8 {
    static constexpr bool PERM = true, AFTER_DRAIN = false;
    unsigned char* O; int ldc; float ws, hs;
    __device__ __forceinline__ void operator()(const f32x4 (&acc)[2][2][4][2], const Unit& u, int wr, int wc, int fr, int fq) const {
        const int row0 = u.pm * BM + wr * 64 + fr, col0 = u.pn * HALF + wc * 32 + 8 * fq;
#pragma unroll
        for (int ai = 0; ai < 2; ++ai)
#pragma unroll
            for (int m = 0; m < 4; ++m) {
                float h[8];
#pragma unroll
                for (int n = 0; n < 2; ++n)
#pragma unroll
                    for (int j = 0; j < 4; ++j) { const float g = acc[ai][0][m][n][j] * ws, up = acc[ai][1][m][n][j] * ws;
                        h[4 * n + j] = g * up * hs * __builtin_amdgcn_rcpf(1.0f + __builtin_amdgcn_exp2f(-1.4426950408889634f * g)); }
                typedef unsigned u32x2 __attribute__((ext_vector_type(2)));
                *(u32x2*)(O + (size_t)(row0 + ai * HALF + m * 16) * ldc + col0) = (u32x2){pk4_fp8(h[0], h[1], h[2], h[3]), pk4_fp8(h[4], h[5], h[6], h[7])}; }
    }
};
struct EpiGateS {
    static constexpr bool PERM = true, AFTER_DRAIN = false;
    bf16_t* O; int ldc; const float* gate; float sc;
    __device__ __forceinline__ void operator()(const f32x4 (&acc)[2][2][4][2], const Unit& u, int wr, int wc, int fr, int fq) const {
        const int row0 = u.pm * BM + wr * 64 + fr, col0 = u.pn * BM + wc * 32 + 8 * fq;
#pragma unroll
        for (int ai = 0; ai < 2; ++ai)
#pragma unroll
            for (int m = 0; m < 4; ++m) { const int row = row0 + ai * HALF + m * 16; const float gt = gate[row] * sc; bf16_t* rowp = O + (size_t)row * ldc + col0;
#pragma unroll
                for (int bj = 0; bj < 2; ++bj) { const f32x4 v0 = acc[ai][bj][m][0] * gt, v1 = acc[ai][bj][m][1] * gt;
                    u32x4 w; w.x = cvt_pk_bf16(v0[0], v0[1]); w.y = cvt_pk_bf16(v0[2], v0[3]); w.z = cvt_pk_bf16(v1[0], v1[1]); w.w = cvt_pk_bf16(v1[2], v1[3]);
                    *(u32x4*)(rowp + bj * HALF) = w; } }
    }
};
struct EpiQKV {
    static constexpr bool PERM = true, AFTER_DRAIN = false;
    bf16_t* O; int ldc; const float* rope; const float* qn; const float* kn; float qscale; float rms_eps;
    __device__ __forceinline__ void operator()(const f32x4 (&acc)[2][2][4][2], const Unit& u, int wr, int wc, int fr, int fq) const {
        const int hs = 4 * u.pn + wc;
        const bool isq = hs < 8 || (hs >= 24 && hs < 32), isk = (hs >= 8 && hs < 16) || hs == 32 || hs == 33, nrm = hs >= 24 && hs < 34;
        const bool rope_on = (isq || isk) && u.pm < 64;
        const float osc = isq ? qscale : 1.f;
        const bool first = fq < 2;
        f32x4 gv[2][2];
#pragma unroll
        for (int bj = 0; bj < 2; ++bj)
#pragma unroll
            for (int n = 0; n < 2; ++n) gv[bj][n] = nrm ? *(const f32x4*)((hs < 32 ? qn : kn) + 32 * bj + 8 * fq + 4 * n) : (f32x4){1.f, 1.f, 1.f, 1.f};
#pragma unroll
        for (int ai = 0; ai < 2; ++ai)
#pragma unroll
            for (int m = 0; m < 4; ++m) {
                const int row = u.pm * BM + ai * HALF + wr * 64 + m * 16 + fr;
                f32x4 v[2][2];
#pragma unroll
                for (int bj = 0; bj < 2; ++bj)
#pragma unroll
                    for (int n = 0; n < 2; ++n) v[bj][n] = acc[ai][bj][m][n];
                if (nrm) {
                    float ss = 0.f;
#pragma unroll
                    for (int bj = 0; bj < 2; ++bj)
#pragma unroll
                        for (int n = 0; n < 2; ++n) ss += (v[bj][n][0] * v[bj][n][0] + v[bj][n][1] * v[bj][n][1]) + (v[bj][n][2] * v[bj][n][2] + v[bj][n][3] * v[bj][n][3]);
                    ss += __shfl_xor(ss, 16); ss += __shfl_xor(ss, 32);
                    const float r = __builtin_amdgcn_rsqf(ss * (1.f / 64.f) + rms_eps);
#pragma unroll
                    for (int bj = 0; bj < 2; ++bj)
#pragma unroll
                        for (int n = 0; n < 2; ++n) v[bj][n] = v[bj][n] * r * gv[bj][n];
                }
                if (rope_on) {
                    const int t = row & 2047;
#pragma unroll
                    for (int bj = 0; bj < 2; ++bj) {
                        const int pos = bj ? (t & 63) : (t >> 6);
#pragma unroll
                        for (int n = 0; n < 2; ++n) {
                            const float* cp = rope + (size_t)(pos * 16 + 8 * (fq & 1) + 4 * n) * 2;
                            const f32x4 c01 = *(const f32x4*)cp, c23 = *(const f32x4*)(cp + 4);
                            const float cs[4] = {c01[0], c01[2], c23[0], c23[2]}, sn[4] = {c01[1], c01[3], c23[1], c23[3]};
#pragma unroll
                            for (int j = 0; j < 4; ++j) { const float x = v[bj][n][j], pr = __shfl_xor(x, 32); v[bj][n][j] = first ? x * cs[j] - pr * sn[j] : x * cs[j] + pr * sn[j]; }
                        }
                    }
                }
                bf16_t* rowp = O + (size_t)row * ldc + hs * 64 + 8 * fq;
#pragma unroll
                for (int bj = 0; bj < 2; ++bj) { const f32x4 v0 = v[bj][0] * osc, v1 = v[bj][1] * osc;
                    u32x4 w; w.x = cvt_pk_bf16(v0[0], v0[1]); w.y = cvt_pk_bf16(v0[2], v0[3]); w.z = cvt_pk_bf16(v1[0], v1[1]); w.w = cvt_pk_bf16(v1[2], v1[3]);
                    *(u32x4*)(rowp + 32 * bj) = w; }
            }
    }
};
struct GroupedOrder {
    int nMe, nN, ntot, G, c;
    __device__ void init(int nMe_, int nN_, int ne, int G_, int c_) { nMe = nMe_; nN = nN_; ntot = nMe_ * nN_ * ne; G = G_; c = c_; }
    __device__ bool next(int i, Unit& u) const {
        const int L = i * G + c; if (L >= ntot) return false;
        const int per = nMe * nN, e = L / per, rem = L - e * per;
        u.e = e; u.pn = rem / nMe; u.pm = e * nMe + (rem - u.pn * nMe); return true;
    }
    __device__ __forceinline__ void a_ready(const Unit&) const {}
    __device__ __forceinline__ void done(const Unit&) const {}
};
struct L1InOrder {
    StaticOrder so; int G, c;
    __device__ void init(int G_, int c_) { so.init(16384, 2048, G_, 0); G = G_; c = c_; }
    __device__ bool next(int i, Unit& u) const {
        const int L = i * G + c;
        if (L < 512) { StaticOrder t = so; t.G = 1; t.c = 0; return t.next(L, u); }
        if (L < 544) { const int l = L - 512; u.pm = 64 + (l >> 2); u.pn = 2 + (l & 3); u.e = 0; return true; }
        return false;
    }
    __device__ __forceinline__ void a_ready(const Unit&) const {}
    __device__ __forceinline__ void done(const Unit&) const {}
};
}

#include <hip/hip_bf16.h>
#include <cmath>
namespace attn_body {
using bf16=__hip_bfloat16;
using bf16x8=__attribute__((ext_vector_type(8)))short;
using s16x4=__attribute__((ext_vector_type(4)))short;
using f32x16=__attribute__((ext_vector_type(16)))float;
using u32x4=__attribute__((ext_vector_type(4)))unsigned;
constexpr int D=64,OPITCH=1024;
constexpr int NW=8,QBLK=32,QB=QBLK*NW,KVBLK=64;
__device__ __forceinline__ int crow(int r,int hi){return (r&3)+8*(r>>2)+4*hi;}
#define SBAR() __builtin_amdgcn_sched_barrier(0)
__device__ __forceinline__ void cmask(f32x16&p0,f32x16&p1,int jb,int qrel,int hi){
  const float NEG=-INFINITY; int kb=64*jb+4*hi;
  #pragma unroll
  for(int r=0;r<16;++r){int kv=kb+(r&3)+8*(r>>2); if(kv>qrel)p0[r]=NEG; if(kv+32>qrel)p1[r]=NEG;}
}

constexpr int NSLOT=3, SLOTB=8192;
constexpr int LDS_K=0, LDS_V=NSLOT*SLOTB, LDS_WS=2*NSLOT*SLOTB, LDS_OST=LDS_WS+NW*64*4, LDS_BYTES=LDS_OST+NW*4096;
constexpr float C2=0.125f*1.4426950408889634f;
__device__ __forceinline__ void glds16(const void*gsrc,unsigned lds_dst){unsigned keep;
  asm volatile("s_mov_b32 %0, m0\n\ts_mov_b32 m0, %2\n\ts_nop 0\n\tglobal_load_lds_dwordx4 %1, off\n\ts_mov_b32 m0, %0":"=&s"(keep):"v"(gsrc),"s"(lds_dst):"memory");}
__device__ __forceinline__ float max3f(float a,float b,float c){float r;asm("v_max3_f32 %0, %1, %2, %3":"=v"(r):"v"(a),"v"(b),"v"(c));return r;}
__device__ __forceinline__ float max2f(float a,float b){float r;asm("v_max_f32_e32 %0, %1, %2":"=v"(r):"v"(a),"v"(b));return r;}
__device__ __forceinline__ float fadd_s(float a,float b){float r;asm("v_add_f32_e32 %0, %1, %2":"=v"(r):"v"(a),"v"(b));return r;}
__device__ __forceinline__ float fsub_s(float a,float b){float r;asm("v_sub_f32_e32 %0, %1, %2":"=v"(r):"v"(a),"v"(b));return r;}
typedef float f32x2_t __attribute__((ext_vector_type(2))); typedef __bf16 bf16x2_t __attribute__((ext_vector_type(2)));
__device__ __forceinline__ unsigned cvtpk_s(float lo,float hi){f32x2_t v={lo,hi};bf16x2_t b=__builtin_convertvector(v,bf16x2_t);return __builtin_bit_cast(unsigned,b);}
#define WAIT_BAR(N) asm volatile("s_waitcnt vmcnt(" #N ") lgkmcnt(0)\n\ts_barrier":::"memory")

__device__ __forceinline__ void qkt(f32x16&p0,f32x16&p1,const char*Kslot,const bf16x8*qr,const f32x16&negm,int r32,int hi){
  const char*kb=Kslot+hi*1024+r32*16;
  #pragma unroll
  for(int d0=0;d0<4;++d0){
    const bf16x8 b0=*reinterpret_cast<const bf16x8*>(kb+d0*2048);
    const bf16x8 b1=*reinterpret_cast<const bf16x8*>(kb+d0*2048+512);
    if(d0==0){p0=__builtin_amdgcn_mfma_f32_32x32x16_bf16(b0,qr[0],negm,0,0,0);p1=__builtin_amdgcn_mfma_f32_32x32x16_bf16(b1,qr[0],negm,0,0,0);}
    else{p0=__builtin_amdgcn_mfma_f32_32x32x16_bf16(b0,qr[d0],p0,0,0,0);p1=__builtin_amdgcn_mfma_f32_32x32x16_bf16(b1,qr[d0],p1,0,0,0);}}
}
typedef __attribute__((address_space(3))) const char* lds_cptr;
typedef short v4i16_t __attribute__((ext_vector_type(4)));
__device__ __forceinline__ void kload8(bf16x8*kf,lds_cptr kp){
  kf[0]=*(const __attribute__((address_space(3))) bf16x8*)(kp);      kf[1]=*(const __attribute__((address_space(3))) bf16x8*)(kp+512);
  kf[2]=*(const __attribute__((address_space(3))) bf16x8*)(kp+2048); kf[3]=*(const __attribute__((address_space(3))) bf16x8*)(kp+2560);
  kf[4]=*(const __attribute__((address_space(3))) bf16x8*)(kp+4096); kf[5]=*(const __attribute__((address_space(3))) bf16x8*)(kp+4608);
  kf[6]=*(const __attribute__((address_space(3))) bf16x8*)(kp+6144); kf[7]=*(const __attribute__((address_space(3))) bf16x8*)(kp+6656);
}
__device__ __forceinline__ void kload2(bf16x8*kf,lds_cptr kp,int j){ kf[2*j]=*(const __attribute__((address_space(3))) bf16x8*)(kp+j*2048); kf[2*j+1]=*(const __attribute__((address_space(3))) bf16x8*)(kp+j*2048+512); }
__device__ __forceinline__ s16x4 vtr(lds_cptr p){ return __builtin_bit_cast(s16x4,__builtin_amdgcn_ds_read_tr16_b64_v4i16((__attribute__((address_space(3))) v4i16_t*)p)); }
__device__ __forceinline__ float rowmax(const f32x16&p0,const f32x16&p1){
  float a=max3f(p0[0],p0[1],p1[0]),b=max3f(p0[2],p0[3],p1[1]);a=max3f(a,p1[2],p1[3]);
  #pragma unroll
  for(int r=4;r<16;r+=4){a=max3f(a,p0[r],p0[r+1]);b=max3f(b,p0[r+2],p0[r+3]);a=max3f(a,p1[r],p1[r+1]);b=max3f(b,p1[r+2],p1[r+3]);}
  const float m=max2f(a,b);
  auto rr=__builtin_amdgcn_permlane32_swap(__float_as_uint(m),__float_as_uint(m),false,false);
  return max2f(__uint_as_float(rr[0]),__uint_as_float(rr[1]));
}
__device__ __forceinline__ void pv(f32x16*o,int vb,bf16x8 pa0,bf16x8 pa1,bf16x8 pa2,bf16x8 pa3){
  #pragma unroll
  for(int d0=0;d0<2;++d0){s16x4 lo[4],hi[4];
    #pragma unroll
    for(int ks=0;ks<4;++ks){
      asm volatile("ds_read_b64_tr_b16 %0,%1 offset:%c2":"=&v"(lo[ks]):"v"(vb),"i"(d0*4096+ks*1024):"memory");
      asm volatile("ds_read_b64_tr_b16 %0,%1 offset:%c2":"=&v"(hi[ks]):"v"(vb),"i"(d0*4096+ks*1024+512):"memory");}
    asm volatile("s_waitcnt lgkmcnt(0)":::"memory");SBAR();
    #define PK(k) (bf16x8){lo[k][0],lo[k][1],lo[k][2],lo[k][3],hi[k][0],hi[k][1],hi[k][2],hi[k][3]}
    o[d0]=__builtin_amdgcn_mfma_f32_32x32x16_bf16(pa0,PK(0),o[d0],0,0,0);
    o[d0]=__builtin_amdgcn_mfma_f32_32x32x16_bf16(pa1,PK(1),o[d0],0,0,0);
    o[d0]=__builtin_amdgcn_mfma_f32_32x32x16_bf16(pa2,PK(2),o[d0],0,0,0);
    o[d0]=__builtin_amdgcn_mfma_f32_32x32x16_bf16(pa3,PK(3),o[d0],0,0,0);
    #undef PK
  }
}

#ifndef ATTN_STORE16
#define ATTN_STORE16(p,v) (*(u32x4*)(p)=(v))
#endif
struct AU { const bf16* Qp; const bf16* Kp; const bf16* Vp; bf16* Op; int qrow0, lat_row0, ctx_row0, nlat_t, NT; };
struct NoMask { __device__ __forceinline__ void apply(f32x16&,f32x16&,int,int)const{} };
typedef __attribute__((address_space(3))) const float* lds_cfptr;
struct NAMask { lds_cfptr tb0; int r, rs, rs_min, cb;
  __device__ __forceinline__ void apply(f32x16&p0,f32x16&p1,int t,int hi)const{
    if(t<4)return;
    const int kr=rs_min+t-4; const float NEG=-INFINITY;
    if((unsigned)(kr-rs)>7u){
      #pragma unroll
      for(int i=0;i<16;++i){p0[i]=NEG;p1[i]=NEG;}
      return; }
    const lds_cfptr tb=tb0+(kr-r+7)*32+4*hi;
    #pragma unroll
    for(int i=0;i<16;++i){ const int k0=(i&3)+8*(i>>2); const int d0=cb+k0, d1=cb+k0+32;
      const float b0=tb[k0], b1=tb[k0+32];
      p0[i]=((unsigned)d0<=15u)?p0[i]+b0:NEG; p1[i]=((unsigned)d1<=15u)?p1[i]+b1:NEG; }
  }
};
template<int THRL,int PITCH,class MaskT> __device__ __forceinline__ void attn_unit(const AU& u,char*shm,const MaskT& mk){
  const int tid=threadIdx.x,lane=tid&63,r32=lane&31,hi=lane>>5; const int wid=__builtin_amdgcn_readfirstlane(tid>>6);
  const bf16*Qw=u.Qp+(long)(u.qrow0+wid*QBLK)*PITCH;
  const bf16*Kh=u.Kp,*Vh=u.Vp;
  const unsigned lds0=(unsigned)(uintptr_t)shm;
  float*wsf=(float*)(shm+LDS_WS)+wid*64;
  const bf16*ksrc=Kh+(long)lane*PITCH+wid*8;
  const bf16*vsrc=Vh+(long)(16*(wid&3)+(lane>>2))*PITCH+(wid>>2)*32+(lane&3)*8;
  const unsigned kdst=lds0+LDS_K+wid*1024, vdst=lds0+LDS_V+wid*1024;
  #define TROW(t) ((long)((t)<u.nlat_t?u.lat_row0+KVBLK*(t):u.ctx_row0+KVBLK*((t)-u.nlat_t))*PITCH)
  #define DMA_K(t,slot) glds16(ksrc+TROW(t),(unsigned)__builtin_amdgcn_readfirstlane(kdst+(slot)))
  #define DMA_V(t,slot) glds16(vsrc+TROW(t),(unsigned)__builtin_amdgcn_readfirstlane(vdst+(slot)))
  const int vb0=(int)(lds0+LDS_V)+((lane>>4)&1)*32+(lane&3)*8+(4*hi+((lane&15)>>2))*64;
  const char*Kbase=shm+LDS_K; bf16x8 kf[8];
  const lds_cptr shm3=(lds_cptr)shm; const lds_cptr kp0=shm3+LDS_K+hi*1024+r32*16; const lds_cptr vp0=shm3+LDS_V+((lane>>4)&1)*32+(lane&3)*8+(4*hi+((lane&15)>>2))*64;
  const int NT=u.NT;
  DMA_K(0,0);DMA_V(0,0);DMA_K(1,SLOTB);
  bf16x8 qr[4];
  #pragma unroll
  for(int d0=0;d0<4;++d0)qr[d0]=*reinterpret_cast<const bf16x8*>(&Qw[(long)r32*PITCH+d0*16+hi*8]);
  float mhat=0.f,l_reg=0.f;f32x16 o[2];o[0]=f32x16{};o[1]=f32x16{};f32x16 negm=f32x16{};asm volatile("":"+v"(negm));
  #define CMASK(P0,P1,t) mk.apply(P0,P1,(t),hi)
  bool resc=false;
  #define START(P0,P1) do{ const float rm=rowmax(P0,P1); resc=false; \
    { const float dl=rm; mhat=fadd_s(mhat,dl); \
      _Pragma("unroll") for(int r=0;r<16;++r){P0[r]=fsub_s(P0[r],dl);P1[r]=fsub_s(P1[r],dl);} \
      _Pragma("unroll") for(int r=0;r<16;++r)negm[r]=-mhat; asm volatile("":"+v"(negm)); } \
    _Pragma("unroll") for(int r=0;r<16;++r)P0[r]=__builtin_amdgcn_exp2f(P0[r]); }while(0)
  #define RESC() do{ if(resc){ asm volatile("s_waitcnt lgkmcnt(0)":::"memory"); \
      _Pragma("unroll") for(int d_=0;d_<2;++d_) _Pragma("unroll") for(int r=0;r<16;++r)o[d_][r]*=wsf[crow(r,hi)]; } }while(0)
  f32x16 pA0,pA1,pB0,pB1;
  int sl_prev=0,sl_cur=0,sl_next=SLOTB;
  #define ROT() do{sl_prev=sl_cur;sl_cur=sl_next;sl_next=(sl_next==(NSLOT-1)*SLOTB)?0:sl_next+SLOTB;}while(0)
  DMA_K(2,2*SLOTB);
  WAIT_BAR(3);
  qkt(pA0,pA1,Kbase,qr,negm,r32,hi);asm volatile("s_nop 15\n\ts_nop 7":"+v"(pA0),"+v"(pA1));CMASK(pA0,pA1,0);
  START(pA0,pA1);
  _Pragma("unroll") for(int r=0;r<16;++r)pA1[r]=__builtin_amdgcn_exp2f(pA1[r]);
  WAIT_BAR(0);
  DMA_K(3,0);DMA_V(1,SLOTB);
  ROT();
  kload8(kf,kp0+sl_cur);
  WAIT_BAR(2);
  s16x4 vlo[8],vhi[8]; u32x4 pw0,pw1,pw2,pw3;
  #define PKW(P,B) cvtpk_s(P[B],P[B+1])
  #define PAF(k) __builtin_bit_cast(bf16x8,pw##k)
  #define VFR(i) (bf16x8){vlo[i][0],vlo[i][1],vlo[i][2],vlo[i][3],vhi[i][0],vhi[i][1],vhi[i][2],vhi[i][3]}
  #define PIN(x) asm volatile("":"+v"(x))
  #define MX3(a,b,c) __builtin_fmaxf(__builtin_fmaxf((a),(b)),(c))
  #define GAPA(MF,A0,A1,A2,A3,W0,W1,PW) do{ MF; sacc+=A0; sacc+=A1; sacc+=A2; sacc+=A3; PIN(sacc); W0; W1; PIN(PW); SBAR(); }while(0)
  #define EX(v) __builtin_amdgcn_exp2f(v)
  #define GAPB(MF,X,B) do{ MF; X[B]=EX(X[B]); X[B+1]=EX(X[B+1]); X[B+2]=EX(X[B+2]); X[B+3]=EX(X[B+3]); PIN(X); SBAR(); }while(0)
  #define VRD(i) do{ vlo[i]=vtr(vp_+(((i)>>2)*4096+((i)&3)*1024)); vhi[i]=vtr(vp_+(((i)>>2)*4096+((i)&3)*1024+512)); }while(0)
  #define KRD(G,j) do{ if(G){ kload2(kf,kp0+sl_next,j); SBAR(); } }while(0)
  #define STEP(C0,C1,P0,P1,t,GK,GV,GL) do{ SBAR(); \
    const lds_cptr vp_=vp0+sl_prev; \
    VRD(0); SBAR(); float sacc=(P0[0]+P0[1]); \
    GAPA(C0=__builtin_amdgcn_mfma_f32_32x32x16_bf16(kf[0],qr[0],negm,0,0,0), P0[2],P0[3],P0[4],P0[5],     pw0[0]=PKW(P0,0), pw0[1]=PKW(P0,2), pw0); \
    VRD(4); SBAR(); GAPA(C1=__builtin_amdgcn_mfma_f32_32x32x16_bf16(kf[1],qr[0],negm,0,0,0), P0[6],P0[7],P0[8],P0[9],     pw0[2]=PKW(P0,4), pw0[3]=PKW(P0,6), pw0); \
    VRD(1); SBAR(); GAPA(C0=__builtin_amdgcn_mfma_f32_32x32x16_bf16(kf[2],qr[1],C0,0,0,0),   P0[10],P0[11],P0[12],P0[13], pw1[0]=PKW(P0,8), pw1[1]=PKW(P0,10), pw1); \
    VRD(5); SBAR(); GAPA(C1=__builtin_amdgcn_mfma_f32_32x32x16_bf16(kf[3],qr[1],C1,0,0,0),   P0[14],P0[15],P1[0],P1[1],   pw1[2]=PKW(P0,12),pw1[3]=PKW(P0,14), pw1); \
    VRD(2); SBAR(); GAPA(C0=__builtin_amdgcn_mfma_f32_32x32x16_bf16(kf[4],qr[2],C0,0,0,0),   P1[2],P1[3],P1[4],P1[5],     pw2[0]=PKW(P1,0), pw2[1]=PKW(P1,2), pw2); \
    VRD(6); SBAR(); GAPA(C1=__builtin_amdgcn_mfma_f32_32x32x16_bf16(kf[5],qr[2],C1,0,0,0),   P1[6],P1[7],P1[8],P1[9],     pw2[2]=PKW(P1,4), pw2[3]=PKW(P1,6), pw2); \
    VRD(3); SBAR(); GAPA(C0=__builtin_amdgcn_mfma_f32_32x32x16_bf16(kf[6],qr[3],C0,0,0,0),   P1[10],P1[11],P1[12],P1[13], pw3[0]=PKW(P1,8), pw3[1]=PKW(P1,10), pw3); \
    VRD(7); SBAR(); GAPA(C1=__builtin_amdgcn_mfma_f32_32x32x16_bf16(kf[7],qr[3],C1,0,0,0),   P1[14],P1[15],0.f,0.f,       pw3[2]=PKW(P1,12),pw3[3]=PKW(P1,14), pw3); \
    l_reg+=sacc; \
    if(GK){DMA_K((t)+3,sl_cur);} if(GV){DMA_V((t)+1,sl_next);} \
    CMASK(C0,C1,t); \
    { float a=MX3(C0[0],C0[1],C1[0]),b=MX3(C0[2],C0[3],C1[1]); a=MX3(a,C1[2],C1[3]); \
      _Pragma("unroll") for(int r=4;r<16;r+=4){a=MX3(a,C0[r],C0[r+1]);b=MX3(b,C0[r+2],C0[r+3]);a=MX3(a,C1[r],C1[r+1]);b=MX3(b,C1[r+2],C1[r+3]);} \
      float rm=__builtin_fmaxf(a,b); { auto rr=__builtin_amdgcn_permlane32_swap(__float_as_uint(rm),__float_as_uint(rm),false,false); rm=__builtin_fmaxf(__uint_as_float(rr[0]),__uint_as_float(rr[1])); } \
      resc=false; \
      if(__builtin_expect(__any(rm>(float)THRL),0)){ const float dl=__builtin_fmaxf(rm,0.f); mhat+=dl; \
        _Pragma("unroll") for(int r=0;r<16;++r){C0[r]-=dl;C1[r]-=dl;} \
        _Pragma("unroll") for(int r=0;r<16;++r)negm[r]=-mhat; asm volatile("":"+v"(negm)); \
        const float f=__builtin_amdgcn_exp2f(-dl); l_reg*=f; if(hi==0)wsf[r32]=f; resc=true; } } \
    SBAR(); \
    GAPB(o[0]=__builtin_amdgcn_mfma_f32_32x32x16_bf16(PAF(0),VFR(0),o[0],0,0,0), C0,0); \
    GAPB(o[1]=__builtin_amdgcn_mfma_f32_32x32x16_bf16(PAF(0),VFR(4),o[1],0,0,0), C0,4); \
    KRD(GL,0); GAPB(o[0]=__builtin_amdgcn_mfma_f32_32x32x16_bf16(PAF(1),VFR(1),o[0],0,0,0), C0,8); \
    KRD(GL,1); GAPB(o[1]=__builtin_amdgcn_mfma_f32_32x32x16_bf16(PAF(1),VFR(5),o[1],0,0,0), C0,12); \
    KRD(GL,2); GAPB(o[0]=__builtin_amdgcn_mfma_f32_32x32x16_bf16(PAF(2),VFR(2),o[0],0,0,0), C1,0); \
    KRD(GL,3); GAPB(o[1]=__builtin_amdgcn_mfma_f32_32x32x16_bf16(PAF(2),VFR(6),o[1],0,0,0), C1,4); \
    GAPB(o[0]=__builtin_amdgcn_mfma_f32_32x32x16_bf16(PAF(3),VFR(3),o[0],0,0,0), C1,8); \
    GAPB(o[1]=__builtin_amdgcn_mfma_f32_32x32x16_bf16(PAF(3),VFR(7),o[1],0,0,0), C1,12); \
    }while(0)
  int t=1;
  #undef CMASK
  #define CMASK(P0,P1,t) mk.apply(P0,P1,(t),hi)
  for(;t+5<NT;t+=2){
    STEP(pB0,pB1,pA0,pA1,t,true,true,true);     WAIT_BAR(2); RESC(); ROT();
    STEP(pA0,pA1,pB0,pB1,t+1,true,true,true);   WAIT_BAR(2); RESC(); ROT();
  }
  #undef CMASK
  #define CMASK(P0,P1,t) mk.apply(P0,P1,(t),hi)
  #define ENDW(tt) do{ if((tt)+3<NT){WAIT_BAR(2);} else if((tt)+2<NT){WAIT_BAR(1);} else {WAIT_BAR(0);} }while(0)
  for(;t+1<NT;t+=2){
    STEP(pB0,pB1,pA0,pA1,t,(t+3<NT),(t+1<NT),(t+1<NT));       ENDW(t);   RESC(); ROT();
    STEP(pA0,pA1,pB0,pB1,t+1,(t+4<NT),(t+2<NT),(t+2<NT));     ENDW(t+1); RESC(); ROT();
  }
  STEP(pB0,pB1,pA0,pA1,NT-1,false,false,false); RESC();
  { float sacc=pB0[0]+pB0[1]; _Pragma("unroll") for(int r=2;r<16;++r)sacc+=pB0[r]; _Pragma("unroll") for(int r=0;r<16;++r)sacc+=pB1[r]; l_reg+=sacc;
    pw0=(u32x4){PKW(pB0,0),PKW(pB0,2),PKW(pB0,4),PKW(pB0,6)};pw1=(u32x4){PKW(pB0,8),PKW(pB0,10),PKW(pB0,12),PKW(pB0,14)};pw2=(u32x4){PKW(pB1,0),PKW(pB1,2),PKW(pB1,4),PKW(pB1,6)};pw3=(u32x4){PKW(pB1,8),PKW(pB1,10),PKW(pB1,12),PKW(pB1,14)};
    SBAR(); pv(o,vb0+sl_cur,PAF(0),PAF(1),PAF(2),PAF(3)); }
  #undef PKW
  #undef PAF
  #undef VFR
  #undef PIN
  #undef MX3
  #undef GAPA
  #undef GAPB
  #undef EX
  #undef VRD
  #undef KRD
  #undef STEP
  #undef ENDW
  {auto rr=__builtin_amdgcn_permlane32_swap(__float_as_uint(l_reg),__float_as_uint(l_reg),false,false);l_reg=__uint_as_float(rr[0])+__uint_as_float(rr[1]);}
  if(hi==0)wsf[32+r32]=l_reg;asm volatile("s_waitcnt lgkmcnt(0)":::"memory");
  float rli[16];
  #pragma unroll
  for(int r=0;r<16;++r)rli[r]=__builtin_amdgcn_rcpf(wsf[32+crow(r,hi)]);
  bf16*Ow=u.Op+(long)(u.qrow0+wid*QBLK)*OPITCH;
  { bf16*stg=(bf16*)(shm+LDS_OST)+wid*2048;
    #pragma unroll
    for(int r=0;r<16;++r){const int orow=crow(r,hi);
      #pragma unroll
      for(int d0=0;d0<2;++d0)stg[orow*64+d0*32+r32]=__float2bfloat16(o[d0][r]*rli[r]);}
    asm volatile("s_waitcnt lgkmcnt(0)":::"memory");
    #pragma unroll
    for(int i=0;i<4;++i){const int row=i*8+(lane>>3),ch=lane&7; const u32x4 v=*(const u32x4*)(stg+row*64+ch*8); ATTN_STORE16(Ow+(long)row*OPITCH+ch*8,v);} }
  asm volatile("s_waitcnt lgkmcnt(0)\n\ts_barrier":::"memory");
  #undef DMA_K
  #undef TROW
  #undef DMA_V
  #undef CMASK
  #undef START
  #undef RESC
  #undef ROT
}
constexpr int ATTN_LDS_BYTES=LDS_BYTES;
#undef SBAR
#undef WAIT_BAR
}

struct Params { const float* in[26]; float* out; unsigned char* ws; int ph_lo, ph_hi; };
struct Ctx { LAS unsigned char* lds; int tid, lane, wave, vcu, G, gw, NGW; };
enum { I_X = 0, I_C, I_CTX, I_CCTX, I_ADAW, I_ADAB, I_LNG, I_LNB, I_W0IN, I_W0OUT, I_LQ1, I_LK1, I_LQ2, I_LK2, I_SUBLN, I_QN, I_KN,
       I_W1IN, I_W1OUT, I_RPB, I_POOLW, I_POOLS, I_ROUTER, I_WG, I_WU, I_WD };

__device__ __forceinline__ const float* mod_row(const Params& p, int layer, int row) {
    return (const float*)(p.ws + WS_MOD) + (size_t)(layer * 9 + (row < LAT ? (row >> 11) : 8)) * 6144;
}

__device__ __forceinline__ void ph_prologue(const Params& p, const Ctx& c) {
    const float* cin = p.in[I_C]; const float* cctx = p.in[I_CCTX]; const float* ada_w = p.in[I_ADAW]; const float* ada_b = p.in[I_ADAB];
    float* MOD = (float*)(p.ws + WS_MOD);
    LAS float* sc = (LAS float*)c.lds;
    LAS float* red = sc + 9 * 1024;
    for (int i = c.tid; i < 9 * 1024; i += 512) { const float v = i < 8192 ? cin[i] : cctx[i - 8192]; sc[i] = v / (1.f + expf(-v)); }
    __syncthreads();
    for (int u = c.vcu; u < 256; u += c.G) {
        const int layer = u >> 7, j0 = (u & 127) * 48;
        const int jc = c.tid % 48, kg = c.tid / 48;
        if (kg < 10) {
            float acc[9];
#pragma unroll
            for (int m = 0; m < 9; ++m) acc[m] = 0.f;
            const float* wp = ada_w + (size_t)layer * 1024 * 6144 + j0 + jc;
#pragma unroll 8
            for (int k = kg; k < 1024; k += 10) {
                const float w = wp[(size_t)k * 6144];
#pragma unroll
                for (int m = 0; m < 9; ++m) acc[m] += sc[m * 1024 + k] * w;
            }
#pragma unroll
            for (int m = 0; m < 9; ++m) red[(kg * 9 + m) * 48 + jc] = acc[m];
        }
        __syncthreads();
        if (c.tid < 432) {
            const int m = c.tid / 48, j = c.tid % 48; float s = 0.f;
#pragma unroll
            for (int g = 0; g < 10; ++g) s += red[(g * 9 + m) * 48 + j];
            MOD[(size_t)(layer * 9 + m) * 6144 + j0 + j] = s + ada_b[layer * 6144 + j0 + j];
        }
        __syncthreads();
    }
    if (c.vcu == 0) {
        f32x2* R = (f32x2*)(p.ws + WS_ROPE);
        for (int i = c.tid; i < 1024; i += 512) {
            const int pos = i >> 4, f = i & 15;
            const float inv = exp2f(-(float)f * (13.287712379549449f / 16.f));
            const float a = (float)pos * inv;
            const float k = rintf(a * 0.15915494309189535f);
            float rr = fmaf(-k, 6.28125f, a); rr = fmaf(-k, 1.9353071795864769e-3f, rr);
            R[i] = (f32x2){__cosf(rr), __sinf(rr)};
        }
    }
}


__device__ __forceinline__ void transpose_item(const float* W, int ldw, int k0, int n0, bf16* WT, int Kd, int drow0, LAS float* scr, int lane) {
#pragma unroll 8
    for (int i = 0; i < 32; ++i) { const int kk = 2 * i + (lane >> 5); scr[kk * 33 + (lane & 31)] = W[(size_t)(k0 + kk) * ldw + n0 + (lane & 31)]; }
    asm volatile("s_waitcnt lgkmcnt(0)" ::: "memory");
    const int ch = lane & 7;
#pragma unroll
    for (int j = 0; j < 4; ++j) { const int n = (lane >> 3) + 8 * j; const LAS float* sp = scr + (8 * ch) * 33 + n;
        v4u o; o.x = pk2(sp[0 * 33], sp[1 * 33]); o.y = pk2(sp[2 * 33], sp[3 * 33]); o.z = pk2(sp[4 * 33], sp[5 * 33]); o.w = pk2(sp[6 * 33], sp[7 * 33]);
        *(v4u*)(WT + (size_t)(drow0 + n) * Kd + k0 + 8 * ch) = o; }
    asm volatile("s_waitcnt lgkmcnt(0)" ::: "memory");
}
__device__ __forceinline__ void transpose_item8(const float* W, int ldw, int k0, int n0, unsigned char* WT8, int Kd, int drow0, float scale, LAS float* scr, int lane) {
#pragma unroll 8
    for (int i = 0; i < 32; ++i) { const int kk = 2 * i + (lane >> 5); scr[kk * 33 + (lane & 31)] = W[(size_t)(k0 + kk) * ldw + n0 + (lane & 31)]; }
    asm volatile("s_waitcnt lgkmcnt(0)" ::: "memory");
    const int n = lane >> 1, hf = lane & 1; const LAS float* sp = scr + (32 * hf) * 33 + n;
    v4u o0, o1;
    o0.x = pg8::pk4_fp8(sp[0 * 33] * scale, sp[1 * 33] * scale, sp[2 * 33] * scale, sp[3 * 33] * scale);     o0.y = pg8::pk4_fp8(sp[4 * 33] * scale, sp[5 * 33] * scale, sp[6 * 33] * scale, sp[7 * 33] * scale);
    o0.z = pg8::pk4_fp8(sp[8 * 33] * scale, sp[9 * 33] * scale, sp[10 * 33] * scale, sp[11 * 33] * scale);   o0.w = pg8::pk4_fp8(sp[12 * 33] * scale, sp[13 * 33] * scale, sp[14 * 33] * scale, sp[15 * 33] * scale);
    o1.x = pg8::pk4_fp8(sp[16 * 33] * scale, sp[17 * 33] * scale, sp[18 * 33] * scale, sp[19 * 33] * scale); o1.y = pg8::pk4_fp8(sp[20 * 33] * scale, sp[21 * 33] * scale, sp[22 * 33] * scale, sp[23 * 33] * scale);
    o1.z = pg8::pk4_fp8(sp[24 * 33] * scale, sp[25 * 33] * scale, sp[26 * 33] * scale, sp[27 * 33] * scale); o1.w = pg8::pk4_fp8(sp[28 * 33] * scale, sp[29 * 33] * scale, sp[30 * 33] * scale, sp[31 * 33] * scale);
    unsigned char* dst = WT8 + (size_t)(drow0 + n) * Kd + k0 + 32 * hf;
    *(v4u*)dst = o0; *(v4u*)(dst + 16) = o1;
    asm volatile("s_waitcnt lgkmcnt(0)" ::: "memory");
}
struct TBlk { const float* src; unsigned char* dst; int ldw, Kd, gu, which; float scale; };
__device__ __forceinline__ TBlk tblk_decode(const Params& p, int blk) {
    const int ie = blk / 96, q = blk - ie * 96, layer = ie >> 4, e = ie & 15, which = q >> 5, idx = q & 31;
    TBlk t; t.which = which;
    if (which < 2) { const int kb = idx & 3, nb = idx >> 2, k0 = 256 * kb, n0 = 256 * nb;
        t.src = (which == 0 ? p.in[I_WG] : p.in[I_WU]) + (size_t)ie * DM * FF + (size_t)k0 * FF + n0; t.ldw = FF; t.Kd = DM; t.scale = W8_GU; t.gu = 1;
        t.dst = p.ws + WS_WGU + (size_t)layer * WS_MOE_LSTRIDE + (size_t)e * 4096 * DM + (size_t)(2 * nb) * 256 * DM + k0; }
    else { const int kb = idx & 7, nb = idx >> 3, k0 = 256 * kb, n0 = 256 * nb;
        t.src = p.in[I_WD] + (size_t)ie * FF * DM + (size_t)k0 * DM + n0; t.ldw = DM; t.Kd = FF; t.scale = W8_DN; t.gu = 0;
        t.dst = p.ws + WS_WDN + (size_t)layer * WS_MOE_LSTRIDE + (size_t)e * DM * FF + (size_t)n0 * FF + k0; }
    return t;
}
__device__ __forceinline__ void tblk_load(const TBlk& t, f32x4 (&v)[16], int wave, int lane, int hf) {
    const float* sp = t.src + (size_t)(32 * wave + 16 * hf) * t.ldw + 4 * lane;
#pragma unroll
    for (int i = 0; i < 16; ++i) v[i] = __builtin_nontemporal_load((const f32x4*)(sp + (size_t)i * t.ldw));
}
constexpr int TPITCH = 264;
__device__ __forceinline__ void tblk_pack(const TBlk& t, const f32x4 (&v)[16], LAS unsigned char* T, int wave, int lane, int hf) {
#pragma unroll
    for (int i = 0; i < 4; ++i) {
        const f32x4 r0 = v[4 * i] * t.scale, r1 = v[4 * i + 1] * t.scale, r2 = v[4 * i + 2] * t.scale, r3 = v[4 * i + 3] * t.scale;
#pragma unroll
        for (int j = 0; j < 4; ++j) { int w = 0; w = __builtin_amdgcn_cvt_pk_fp8_f32(r0[j], r1[j], w, false); w = __builtin_amdgcn_cvt_pk_fp8_f32(r2[j], r3[j], w, true);
            *(LAS unsigned*)(T + (64 * j + lane) * TPITCH + 32 * wave + 16 * hf + 4 * i) = (unsigned)w; }
    }
}
__device__ __forceinline__ void tblk_writeout(const TBlk& t, const LAS unsigned char* T, int tid) {
#pragma unroll
    for (int it = 0; it < 8; ++it) { const int idx = it * 512 + tid, n = idx >> 4, ch = idx & 15, rho = (n & 3) * 64 + (n >> 2);
        const LAS unsigned char* sp = T + rho * TPITCH + 16 * ch;
        const v2u a = *(const LAS v2u*)sp, b2 = *(const LAS v2u*)(sp + 8);
        const int drow = t.gu ? ((n >> 7) * 256 + (n & 127) + t.which * 128) : n;
        __builtin_nontemporal_store((v4u){a.x, a.y, b2.x, b2.y}, (v4u*)(t.dst + (size_t)drow * t.Kd + 16 * ch)); }
}
__device__ __forceinline__ void moe_transpose_blocks(const Params& p, const Ctx& c, int blk0, int blk1, int widx, int nw) {
    LAS unsigned char* T = c.lds;
    f32x4 va[16], vb[16];
    int blk = blk0 + widx;
    if (blk >= blk1) return;
    TBlk t = tblk_decode(p, blk);
    tblk_load(t, va, c.wave, c.lane, 0);
#pragma unroll 1
    for (; blk < blk1; blk += nw) {
        tblk_load(t, vb, c.wave, c.lane, 1);
        tblk_pack(t, va, T, c.wave, c.lane, 0);
        const int nb = blk + nw;
        TBlk tn = tblk_decode(p, nb < blk1 ? nb : blk0);
        if (nb < blk1) tblk_load(tn, va, c.wave, c.lane, 0);
        tblk_pack(t, vb, T, c.wave, c.lane, 1);
        __syncthreads();
        tblk_writeout(t, T, c.tid);
        __syncthreads();
        t = tn;
    }
}
__device__ __forceinline__ void tail_transposes(const Params& p, const Ctx& c, int first_idle, int my, int blk0, int nblk) {
    if (!TAIL_TRANSPOSE || c.G != 256 || my < first_idle) return;
    moe_transpose_blocks(p, c, blk0, blk0 + nblk, my - first_idle, c.G - first_idle);
}
__device__ __forceinline__ void ph_transposes(const Params& p, const Ctx& c) {
    LAS float* scr = (LAS float*)(c.lds + c.wave * 16384);
    constexpr int I0 = 16 * 72, I1 = 16 * 32, I2 = 16 * 64, I3 = 16 * 32, ISM = I0 + I1 + I2 + I3;
    for (int r0 = c.gw; r0 < ISM; r0 += c.NGW) {
        int r = r0;
        if (r < I0) { const int n0 = 32 * (r % 72), drow = FUSE_QKV ? ((n0 >> 8) * 256 + 128 * ((n0 >> 5) & 1) + 32 * ((n0 >> 6) & 3)) : n0;
            transpose_item(p.in[I_W0IN], EIN, 64 * (r / 72), n0, (bf16*)(p.ws + WS_W0IN), DM, drow, scr, c.lane); continue; } r -= I0;
        if (r < I1) { transpose_item(p.in[I_W0OUT], DM, 64 * (r / 32), 32 * (r % 32), (bf16*)(p.ws + WS_W0OUT), DM, 32 * (r % 32), scr, c.lane); continue; } r -= I1;
        if (r < I2) { transpose_item(p.in[I_W1IN], OIN, 64 * (r / 64), 32 * (r % 64), (bf16*)(p.ws + WS_W1IN), DM, 32 * (r % 64), scr, c.lane); continue; } r -= I2;
        transpose_item(p.in[I_W1OUT], DM, 64 * (r / 32), 32 * (r % 32), (bf16*)(p.ws + WS_W1OUT), DM, 32 * (r % 32), scr, c.lane);
    }
    static_assert(MOE_FP8, "the expert-weight transposes write e4m3 copies");
    __syncthreads();
    moe_transpose_blocks(p, c, 0, (TAIL_TRANSPOSE && c.G == 256) ? 1536 : 3072, c.vcu, c.G);
}

__device__ __forceinline__ void ph_modulate0(const Params& p, const Ctx& c) {
    bf16* HB = (bf16*)(p.ws + WS_HB);
    for (int row = c.gw; row < NTOK; row += c.NGW) {
        const float* src = row < LAT ? p.in[I_X] + (size_t)row * DM : p.in[I_CTX] + (size_t)(row - LAT) * DM;
        const float* mod = mod_row(p, 0, row);
#pragma unroll
        for (int j = 0; j < 4; ++j) {
            const int col = 4 * c.lane + 256 * j;
            const f32x4 v = *(const f32x4*)(src + col), sh = *(const f32x4*)(mod + col), s = *(const f32x4*)(mod + 1024 + col);
            const f32x4 h = v * (s + 1.f) + sh;
            *(v2u*)(HB + (size_t)row * DM + col) = (v2u){pk2(h.x, h.y), pk2(h.z, h.w)};
        }
    }
}

struct NG { const bf16* A; int lda; const float* W0; const float* W1; int ldw; size_t wstride; int Mb; int row_begin, row_end, col_begin, col_end, K; };
template <int NB, class Epi>
__device__ __forceinline__ void ngemm(const NG& g, const Ctx& c, const Epi& epi) {
    const int nmt = (g.row_end - g.row_begin) / 32, nnt = (g.col_end - g.col_begin) / 32;
    const int l31 = c.lane & 31, lh = c.lane >> 5;
    for (int t = c.gw; t < nmt * nnt; t += c.NGW) {
        const int mt = t / nnt, nt = t % nnt;
        const int row0 = g.row_begin + mt * 32, col0 = g.col_begin + nt * 32;
        const int e = row0 / g.Mb;
        const bf16* ap = g.A + (size_t)(row0 + l31) * g.lda + lh;
        const float* bp0 = g.W0 + (size_t)e * g.wstride + (size_t)lh * g.ldw + col0 + l31;
        const float* bp1 = NB == 2 ? g.W1 + (size_t)e * g.wstride + (size_t)lh * g.ldw + col0 + l31 : nullptr;
        f32x16 acc0 = {}, acc1 = {};
#pragma unroll 8
        for (int k = 0; k < g.K; k += 2) {
            const float a = bf2f((unsigned)ap[k]);
            const float b0 = bp0[(size_t)k * g.ldw];
            acc0 = __builtin_amdgcn_mfma_f32_32x32x2f32(a, b0, acc0, 0, 0, 0);
            if (NB == 2) { const float b1 = bp1[(size_t)k * g.ldw]; acc1 = __builtin_amdgcn_mfma_f32_32x32x2f32(a, b1, acc1, 0, 0, 0); }
        }
#pragma unroll
        for (int r = 0; r < 16; ++r) {
            const int row = row0 + (r & 3) + 8 * (r >> 2) + 4 * lh, col = col0 + l31;
            epi(row, col, acc0[r], acc1[r]);
        }
    }
}
struct EpiF32 { float* O; int ldc; __device__ __forceinline__ void operator()(int row, int col, float v0, float) const { O[(size_t)row * ldc + col] = v0; } };
struct EpiBf { bf16* O; int ldc; int scale_cols; float sc; __device__ __forceinline__ void operator()(int row, int col, float v0, float) const { O[(size_t)row * ldc + col] = (bf16)f2bf(col < scale_cols ? v0 * sc : v0); } };
struct EpiSwiglu { bf16* O; __device__ __forceinline__ void operator()(int row, int col, float g, float u) const { const float s = g / (1.f + __expf(-g)); O[(size_t)row * FF + col] = (bf16)f2bf(s * u); } };
struct EpiGate { bf16* O; const float* gate; __device__ __forceinline__ void operator()(int row, int col, float v0, float) const { O[(size_t)row * DM + col] = (bf16)f2bf(v0 * gate[row]); } };

template <bool F32IN> __device__ __forceinline__ void ph_qkv_post(const Params& p, const Ctx& c) {
    const float* PF = (const float*)(p.ws + WS_PF);
    bf16* QKV = (bf16*)(p.ws + WS_QKV);
    const f32x2* R = (const f32x2*)(p.ws + WS_ROPE);
    const float* qn = p.in[I_QN]; const float* kn = p.in[I_KN];
    const int d = c.lane;
    const float qg = qn[d], kg = kn[d];
    for (int row = c.gw; row < NTOK; row += c.NGW) {
        const bool lat = row < LAT;
        const int t = row & 2047;
        const int pos = (d < 32) ? (t >> 6) : (t & 63);
        const f32x2 cs = R[pos * 16 + (d & 15)];
        const bool first = (d & 16) == 0;
        float vv[36];
#pragma unroll
        for (int hs = 0; hs < 36; ++hs) vv[hs] = F32IN ? PF[(size_t)row * EIN + hs * 64 + d] : bf2f((unsigned)QKV[(size_t)row * EIN + hs * 64 + d]);
#pragma unroll
        for (int hs = 0; hs < 36; ++hs) {
            float v = vv[hs];
            const bool isq = hs < 8 || (hs >= 24 && hs < 32);
            const bool isk = (hs >= 8 && hs < 16) || hs == 32 || hs == 33;
            const bool nrm = hs >= 24 && hs < 34;
            if (nrm) { const float ss = wave_sum(v * v); v = v * rsqrtf(ss * (1.f / 64.f) + RMS_EPS) * (hs < 32 ? qg : kg); }
            if ((isq || isk) && lat) { const float pr = __shfl_xor(v, 16); v = first ? v * cs.x - pr * cs.y : v * cs.x + pr * cs.y; }
            if (isq) v *= C2;
            QKV[(size_t)row * EIN + hs * 64 + d] = (bf16)f2bf(v);
        }
    }
}

__device__ __forceinline__ void ph_attn0_naive(const Params& p, const Ctx& c) {
    const bf16* QKV = (const bf16*)(p.ws + WS_QKV);
    bf16* CC = (bf16*)(p.ws + WS_CC);
    bf16* AO = (bf16*)(p.ws + WS_AO);
    LAS float* Ks = (LAS float*)c.lds;
    LAS float* Vs = Ks + 4096;
    for (int u = c.vcu; u < 960; u += c.G) {
        const bool isctx = u >= 768;
        int b, vh, qrow, ntiles; bool active = true;
        if (!isctx) { b = u / 96; const int r = u % 96; vh = r >> 2; qrow = b * SEQ + (r & 3) * 512 + c.tid; ntiles = 36; }
        else { const int uu = u - 768; b = uu / 24; vh = uu % 24; qrow = LAT + b * NCTX + (c.tid & 255); active = c.tid < 256; ntiles = 4; }
        int qcol, kcol, vcol;
        if (vh < 16) { const int a = vh >> 2, s = (vh >> 1) & 1, half = vh & 1; qcol = a * 128 + s * 64; kcol = 512 + a * 128 + s * 64; vcol = 1024 + a * 128 + half * 64; }
        else { const int h = vh - 16; qcol = 1536 + h * 64; kcol = 2048 + (h >> 2) * 64; vcol = 2176 + (h >> 2) * 64; }
        float q[64], o[64];
#pragma unroll
        for (int i = 0; i < 8; ++i) { const v4u w = *(const v4u*)(QKV + (size_t)qrow * EIN + qcol + 8 * i); unpack8(w, q + 8 * i); }
#pragma unroll
        for (int i = 0; i < 64; ++i) o[i] = 0.f;
        float m = -1e30f, l = 0.f;
        for (int t = 0; t < ntiles; ++t) {
            const int krow0 = isctx ? LAT + b * NCTX + 64 * t : (t < 32 ? b * SEQ + 64 * t : LAT + b * NCTX + 64 * (t - 32));
            __syncthreads();
            { const int r = c.tid >> 3, ch = c.tid & 7; float f[8];
              const v4u kw = *(const v4u*)(QKV + (size_t)(krow0 + r) * EIN + kcol + ch * 8); unpack8(kw, f);
#pragma unroll
              for (int j = 0; j < 8; ++j) Ks[r * 64 + ch * 8 + j] = f[j];
              const v4u vw = *(const v4u*)(QKV + (size_t)(krow0 + r) * EIN + vcol + ch * 8); unpack8(vw, f);
#pragma unroll
              for (int j = 0; j < 8; ++j) Vs[r * 64 + ch * 8 + j] = f[j]; }
            __syncthreads();
            if (active) {
                for (int kk = 0; kk < 64; ++kk) {
                    float s = 0.f;
#pragma unroll
                    for (int dd = 0; dd < 64; ++dd) s += q[dd] * Ks[kk * 64 + dd];
                    const float mn = fmaxf(m, s), al = exp2f(m - mn), pp = exp2f(s - mn);
                    l = l * al + pp; m = mn;
#pragma unroll
                    for (int dd = 0; dd < 64; ++dd) o[dd] = o[dd] * al + pp * Vs[kk * 64 + dd];
                }
            }
        }
        if (active) {
            const float rl = 1.f / l;
            bf16* dst = vh < 16 ? AO + (size_t)qrow * DM + (vh >> 2) * 256 + ((vh >> 1) & 1) * 128 + (vh & 1) * 64 : CC + (size_t)qrow * DM + 512 + (vh - 16) * 64;
            {
#pragma unroll
                for (int i = 0; i < 8; ++i) *(v4u*)(dst + 8 * i) = (v4u){pk2(o[8 * i] * rl, o[8 * i + 1] * rl), pk2(o[8 * i + 2] * rl, o[8 * i + 3] * rl), pk2(o[8 * i + 4] * rl, o[8 * i + 5] * rl), pk2(o[8 * i + 6] * rl, o[8 * i + 7] * rl)}; }
        }
    }
}


__device__ __forceinline__ void attn_combine_rows(const Params& p, const Ctx& c, int row0, int a, float lam, float g0, float g1) {
    const bf16* AO = (const bf16*)(p.ws + WS_AO); bf16* CC = (bf16*)(p.ws + WS_CC);
    asm volatile("s_waitcnt vmcnt(0)" ::: "memory");
#pragma unroll 1
    for (int rb = 0; rb < 32; rb += 8) {
        float x0[8], x1[8];
#pragma unroll
        for (int j = 0; j < 8; ++j) { const bf16* src = AO + (size_t)(row0 + rb + j) * DM + a * 256;
            x0[j] = bf2f((unsigned)src[c.lane]) - lam * bf2f((unsigned)src[128 + c.lane]); x1[j] = bf2f((unsigned)src[64 + c.lane]) - lam * bf2f((unsigned)src[192 + c.lane]); }
#pragma unroll
        for (int j = 0; j < 8; ++j) { const float ss = wave_sum(x0[j] * x0[j] + x1[j] * x1[j]); const float r = rsqrtf(ss * (1.f / 128.f) + RMS_EPS);
            bf16* dst = CC + (size_t)(row0 + rb + j) * DM + a * 128;
            dst[c.lane] = (bf16)f2bf(x0[j] * r * g0); dst[64 + c.lane] = (bf16)f2bf(x1[j] * r * g1); }
    }
}
__device__ __forceinline__ void ph_attn0_fast(const Params& p, const Ctx& c, char* lds_generic) {
    typedef attn_body::bf16 abf;
    const abf* Q = (const abf*)(p.ws + WS_QKV); abf* CCb = (abf*)(p.ws + WS_CC); abf* AOb = (abf*)(p.ws + WS_AO);
    const float d1 = wave_sum(p.in[I_LQ1][c.lane] * p.in[I_LK1][c.lane]), d2 = wave_sum(p.in[I_LQ2][c.lane] * p.in[I_LK2][c.lane]);
    const float lam = expf(d1) - expf(d2) + LAM_INIT;
    const float g0 = p.in[I_SUBLN][c.lane] * (1.f - LAM_INIT), g1 = p.in[I_SUBLN][c.lane + 64] * (1.f - LAM_INIT);
    for (int v = c.vcu; v < 256; v += c.G) {
#pragma unroll 1
        for (int step = 0; step < 10; ++step) {
            attn_body::AU u; int vh; bool ctxu = false;
            if (step < 4) { const int b = v >> 5, a = (v >> 3) & 3; vh = 4 * a + step; u.qrow0 = b * SEQ + (v & 7) * 256; u.lat_row0 = b * SEQ; u.ctx_row0 = LAT + b * NCTX; }
            else if (step < 6) { const int U = (step - 4) * 256 + v, b = U >> 6; vh = 16 + ((U >> 3) & 7); u.qrow0 = b * SEQ + (U & 7) * 256; u.lat_row0 = b * SEQ; u.ctx_row0 = LAT + b * NCTX; }
            else { ctxu = true; int b;
                if (v < 32) { b = v >> 2; vh = 4 * (v & 3) + (step - 6); }
                else if (v < 96 && step == 6) { b = (v - 32) >> 3; vh = 16 + ((v - 32) & 7); }
                else break;
                u.qrow0 = LAT + b * NCTX; u.lat_row0 = 0; u.ctx_row0 = LAT + b * NCTX; }
            if (!ctxu) { u.nlat_t = 32; u.NT = 36; } else { u.nlat_t = 0; u.NT = 4; }
            int qcol, kcol, vcol; abf* op;
            if (vh < 16) { const int a = vh >> 2, s = (vh >> 1) & 1, half = vh & 1; qcol = a * 128 + s * 64; kcol = 512 + a * 128 + s * 64; vcol = 1024 + a * 128 + half * 64; op = AOb + a * 256 + s * 128 + half * 64; }
            else { const int h = vh - 16; qcol = 1536 + h * 64; kcol = 2048 + (h >> 2) * 64; vcol = 2176 + (h >> 2) * 64; op = CCb + 512 + h * 64; }
            u.Qp = Q + qcol; u.Kp = Q + kcol; u.Vp = Q + vcol; u.Op = op;
            attn_body::attn_unit<8, EIN, attn_body::NoMask>(u, lds_generic, attn_body::NoMask{});
            if (vh < 16 && (vh & 3) == 3) attn_combine_rows(p, c, u.qrow0 + c.wave * 32, vh >> 2, lam, g0, g1);
        }
    }
    tail_transposes(p, c, 96, c.vcu, 1536 + 120, 320);
}

__device__ __forceinline__ void ph_attn_combine(const Params& p, const Ctx& c) {
    const bf16* AO = (const bf16*)(p.ws + WS_AO);
    bf16* CC = (bf16*)(p.ws + WS_CC);
    const float d1 = wave_sum(p.in[I_LQ1][c.lane] * p.in[I_LK1][c.lane]);
    const float d2 = wave_sum(p.in[I_LQ2][c.lane] * p.in[I_LK2][c.lane]);
    const float lam = expf(d1) - expf(d2) + LAM_INIT;
    const float g0 = p.in[I_SUBLN][c.lane] * (1.f - LAM_INIT), g1 = p.in[I_SUBLN][c.lane + 64] * (1.f - LAM_INIT);
    for (int it = c.gw; it < NTOK * 4; it += c.NGW) {
        const int row = it >> 2, a = it & 3;
        const bf16* src = AO + (size_t)row * DM + a * 256;
        const float x0 = bf2f((unsigned)src[c.lane]) - lam * bf2f((unsigned)src[128 + c.lane]), x1 = bf2f((unsigned)src[64 + c.lane]) - lam * bf2f((unsigned)src[192 + c.lane]);
        const float ss = wave_sum(x0 * x0 + x1 * x1);
        const float r = rsqrtf(ss * (1.f / 128.f) + RMS_EPS);
        CC[(size_t)row * DM + a * 128 + c.lane] = (bf16)f2bf(x0 * r * g0);
        CC[(size_t)row * DM + a * 128 + 64 + c.lane] = (bf16)f2bf(x1 * r * g1);
    }
}

__device__ __forceinline__ f32x4 unpack4(const v2u w) { return (f32x4){bf2f(w.x & 0xffffu), __uint_as_float(w.x & 0xffff0000u), bf2f(w.y & 0xffffu), __uint_as_float(w.y & 0xffff0000u)}; }
__device__ __forceinline__ float reduce_logits(const f32x4 (&lg)[4], int lane) {
    float w8[8], w4[4], w2[2], w1;
    { const bool hi = (lane & 32) != 0;
#pragma unroll
      for (int i = 0; i < 8; ++i) { const float a0 = lg[i >> 2][i & 3], a1 = lg[2 + (i >> 2)][i & 3]; const float keep = hi ? a1 : a0, send = hi ? a0 : a1; w8[i] = keep + __shfl_xor(send, 32); } }
    { const bool hi = (lane & 16) != 0;
#pragma unroll
      for (int i = 0; i < 4; ++i) { const float keep = hi ? w8[i + 4] : w8[i], send = hi ? w8[i] : w8[i + 4]; w4[i] = keep + __shfl_xor(send, 16); } }
    { const bool hi = (lane & 8) != 0;
#pragma unroll
      for (int i = 0; i < 2; ++i) { const float keep = hi ? w4[i + 2] : w4[i], send = hi ? w4[i] : w4[i + 2]; w2[i] = keep + __shfl_xor(send, 8); } }
    { const bool hi = (lane & 4) != 0; const float keep = hi ? w2[1] : w2[0], send = hi ? w2[0] : w2[1]; w1 = keep + __shfl_xor(send, 4); }
    w1 += __shfl_xor(w1, 2); w1 += __shfl_xor(w1, 1);
    return w1;
}
__device__ __forceinline__ void ph_ln1_router(const Params& p, const Ctx& c, int layer) {
    const bf16* Y = (const bf16*)(p.ws + WS_Y);
    bf16* XS = (bf16*)(p.ws + WS_XS);
    bf16* HB = (bf16*)(p.ws + WS_HB);
    float* AFF = (float*)(p.ws + WS_AFF);
    const float* lng = p.in[I_LNG] + (size_t)(layer * 2 + 0) * DM; const float* lnb = p.in[I_LNB] + (size_t)(layer * 2 + 0) * DM;
    const float* router = p.in[I_ROUTER] + (size_t)layer * DM * NE;
    LAS f32x4* R = (LAS f32x4*)c.lds;
    for (int idx = c.tid; idx < 4096; idx += 512) { const int e4 = idx & 3, k = idx >> 2, ln = (k & 255) >> 2, q = k & 3, j = k >> 8;
        R[((j * 4 + q) * 4 + e4) * 64 + ln] = *(const f32x4*)(router + (size_t)k * NE + 4 * e4); }
    __syncthreads();
    const int nrows = layer == 0 ? NTOK : LAT;
    const int lane = c.lane;
    for (int row = 2 * c.gw; row < nrows; row += 2 * c.NGW) {
        const float* mod = mod_row(p, layer, row);
        f32x4 va[4], vb[4]; float sa = 0.f, sb = 0.f;
#pragma unroll
        for (int j = 0; j < 4; ++j) { const int col = 4 * lane + 256 * j;
            f32x4 xa, xb;
            if (layer == 0) { const float* xin = row < LAT ? p.in[I_X] + (size_t)row * DM : p.in[I_CTX] + (size_t)(row - LAT) * DM; xa = *(const f32x4*)(xin + col); xb = *(const f32x4*)(xin + DM + col); }
            else { xa = unpack4(*(const v2u*)(XS + (size_t)row * DM + col)); xb = unpack4(*(const v2u*)(XS + (size_t)(row + 1) * DM + col)); }
            const f32x4 g1 = *(const f32x4*)(mod + 2048 + col);
            va[j] = xa * ALPHA + g1 * unpack4(*(const v2u*)(Y + (size_t)row * DM + col));
            vb[j] = xb * ALPHA + g1 * unpack4(*(const v2u*)(Y + (size_t)(row + 1) * DM + col));
            sa += (va[j].x + va[j].y) + (va[j].z + va[j].w); sb += (vb[j].x + vb[j].y) + (vb[j].z + vb[j].w); }
        const float meana = wave_sum(sa) * (1.f / DM), meanb = wave_sum(sb) * (1.f / DM); float qa = 0.f, qb = 0.f;
#pragma unroll
        for (int j = 0; j < 4; ++j) { va[j] = va[j] - meana; vb[j] = vb[j] - meanb;
            qa += (va[j].x * va[j].x + va[j].y * va[j].y) + (va[j].z * va[j].z + va[j].w * va[j].w); qb += (vb[j].x * vb[j].x + vb[j].y * vb[j].y) + (vb[j].z * vb[j].z + vb[j].w * vb[j].w); }
        const float rstda = 1.f / sqrtf(wave_sum(qa) * (1.f / DM) + LN_EPS), rstdb = 1.f / sqrtf(wave_sum(qb) * (1.f / DM) + LN_EPS);
        f32x4 lga[4], lgb[4];
#pragma unroll
        for (int e = 0; e < 4; ++e) { lga[e] = (f32x4){0.f, 0.f, 0.f, 0.f}; lgb[e] = (f32x4){0.f, 0.f, 0.f, 0.f}; }
#pragma unroll
        for (int j = 0; j < 4; ++j) { const int col = 4 * lane + 256 * j;
            const f32x4 g = *(const f32x4*)(lng + col), bb = *(const f32x4*)(lnb + col), sc = *(const f32x4*)(mod + 4096 + col) + 1.f, sh = *(const f32x4*)(mod + 3072 + col);
            const f32x4 x1a = va[j] * rstda * g + bb, x1b = vb[j] * rstdb * g + bb;
            *(v2u*)(XS + (size_t)row * DM + col) = (v2u){pk2(x1a.x, x1a.y), pk2(x1a.z, x1a.w)};
            *(v2u*)(XS + (size_t)(row + 1) * DM + col) = (v2u){pk2(x1b.x, x1b.y), pk2(x1b.z, x1b.w)};
            const f32x4 hma = x1a * sc + sh, hmb = x1b * sc + sh;
            if (MOE_FP8) { *(unsigned*)((unsigned char*)HB + (size_t)row * DM + col) = pg8::pk4_fp8(hma.x, hma.y, hma.z, hma.w);
                           *(unsigned*)((unsigned char*)HB + (size_t)(row + 1) * DM + col) = pg8::pk4_fp8(hmb.x, hmb.y, hmb.z, hmb.w); }
            else { *(v2u*)(HB + (size_t)row * DM + col) = (v2u){pk2(hma.x, hma.y), pk2(hma.z, hma.w)}; *(v2u*)(HB + (size_t)(row + 1) * DM + col) = (v2u){pk2(hmb.x, hmb.y), pk2(hmb.z, hmb.w)}; }
            asm volatile("" ::: "memory");
#pragma unroll
            for (int q = 0; q < 4; ++q) { const float ha = hma[q], hb = hmb[q];
#pragma unroll
                for (int e4 = 0; e4 < 4; ++e4) { const f32x4 rw = R[((j * 4 + q) * 4 + e4) * 64 + lane]; lga[e4] += rw * ha; lgb[e4] += rw * hb; } } }
        const float wa = reduce_logits(lga, lane), wb = reduce_logits(lgb, lane);
        float mxa = wa, mxb = wb;
#pragma unroll
        for (int o = 4; o < 64; o <<= 1) { mxa = fmaxf(mxa, __shfl_xor(mxa, o)); mxb = fmaxf(mxb, __shfl_xor(mxb, o)); }
        const float exa = expf(wa - mxa), exb = expf(wb - mxb); float dena = exa, denb = exb;
#pragma unroll
        for (int o = 4; o < 64; o <<= 1) { dena += __shfl_xor(dena, o); denb += __shfl_xor(denb, o); }
        if ((lane & 3) == 0) { const int e = ((lane >> 5) & 1) * 8 + ((lane >> 4) & 1) * 4 + ((lane >> 3) & 1) * 2 + ((lane >> 2) & 1);
            AFF[(size_t)row * NE + e] = exa / dena; AFF[(size_t)(row + 1) * NE + e] = exb / denb; }
    }
}

__device__ __forceinline__ void ph_topk(const Params& p, const Ctx& c, int layer) {
    const float* AFF = (const float*)(p.ws + WS_AFF);
    int* INV = (int*)(p.ws + WS_INV);
    float* GATE = (float*)(p.ws + WS_GATE);
    const bf16* HB = (const bf16*)(p.ws + WS_HB);
    bf16* XG = (bf16*)(p.ws + WS_XG);
    LAS unsigned* hist = (LAS unsigned*)c.lds;
    LAS unsigned* ctl = hist + 256;
    LAS int* sel = (LAS int*)(c.lds + 2048);
    const int MR = layer == 0 ? MR0 : MR1;
    const int ntasks = layer == 0 ? 256 : 128;
    const int lane = c.lane;
    for (int task = c.vcu; task < ntasks; task += c.G) {
        int set, e, n, cap, rowbase, slotbase;
        if (task < 128) { set = task >> 4; e = task & 15; n = SEQ; cap = 256; rowbase = set * SEQ; slotbase = set * 256; }
        else { const int t2 = task - 128; set = t2 >> 4; e = t2 & 15; n = NCTX; cap = 32; rowbase = LAT + set * NCTX; slotbase = 2048 + set * 32; }
        const bool valid = 4 * c.tid < n;
        unsigned key[4];
#pragma unroll
        for (int q = 0; q < 4; ++q) key[q] = valid ? __float_as_uint(AFF[(size_t)(rowbase + 4 * c.tid + q) * NE + e]) : 0u;
        unsigned prefix = 0u, need = (unsigned)cap;
#pragma unroll 1
        for (int pass = 0; pass < 4; ++pass) {
            const int shift = 24 - 8 * pass;
            if (c.tid < 256) hist[c.tid] = 0u;
            __syncthreads();
            if (valid) {
#pragma unroll
                for (int q = 0; q < 4; ++q) if (pass == 0 || (key[q] >> (shift + 8)) == (prefix >> (shift + 8))) __hip_atomic_fetch_add(&hist[(key[q] >> shift) & 255u], 1u, __ATOMIC_RELAXED, __HIP_MEMORY_SCOPE_WORKGROUP);
            }
            __syncthreads();
            if (c.wave == 0) {
                const unsigned h0 = hist[4 * lane], h1 = hist[4 * lane + 1], h2 = hist[4 * lane + 2], h3 = hist[4 * lane + 3];
                const unsigned tot = h0 + h1 + h2 + h3; unsigned sfx = tot;
#pragma unroll
                for (int o = 1; o < 64; o <<= 1) { const unsigned t = __shfl_down(sfx, o); if (lane + o < 64) sfx += t; }
                const unsigned above = sfx - tot, c3 = above + h3, c2 = c3 + h2, c1 = c2 + h1, c0 = c1 + h0;
                int d = -1; unsigned gtc = 0u;
                if (above < need && need <= c3) { d = 3; gtc = above; }
                else if (c3 < need && need <= c2) { d = 2; gtc = c3; }
                else if (c2 < need && need <= c1) { d = 1; gtc = c2; }
                else if (c1 < need && need <= c0) { d = 0; gtc = c1; }
                if (d >= 0) { ctl[0] = prefix | ((unsigned)(4 * lane + d) << shift); ctl[1] = need - gtc; }
            }
            __syncthreads();
            prefix = ctl[0]; need = ctl[1];
        }
        unsigned ngt = 0u, neq = 0u;
#pragma unroll
        for (int q = 0; q < 4; ++q) { ngt += (valid && key[q] > prefix) ? 1u : 0u; neq += (valid && key[q] == prefix) ? 1u : 0u; }
        const unsigned cnt = ngt | (neq << 16); unsigned inc = cnt;
#pragma unroll
        for (int o = 1; o < 64; o <<= 1) { const unsigned t = __shfl_up(inc, o); if (lane >= o) inc += t; }
        if (lane == 63) ctl[8 + c.wave] = inc;
        __syncthreads();
        unsigned base = 0u;
#pragma unroll
        for (int w = 0; w < 8; ++w) base += (w < c.wave) ? ctl[8 + w] : 0u;
        const unsigned ex = base + inc - cnt; unsigned gtb = ex & 0xffffu, eqb = ex >> 16;
        if (valid) {
#pragma unroll
            for (int q = 0; q < 4; ++q) { const int i = 4 * c.tid + q; int slot = -1;
                if (key[q] > prefix) { slot = (int)(gtb + (eqb < need ? eqb : need)); ++gtb; }
                else if (key[q] == prefix) { if (eqb < need) slot = (int)(gtb + eqb); ++eqb; }
                int gs = -1;
                if (slot >= 0) { gs = e * MR + slotbase + slot; sel[slot] = i; GATE[gs] = __uint_as_float(key[q]); }
                INV[(size_t)(rowbase + i) * NE + e] = gs; }
        }
        __syncthreads();
        for (int sidx = c.wave; sidx < cap; sidx += 8) {
            if (MOE_FP8) { const unsigned char* src = (const unsigned char*)HB + (size_t)(rowbase + sel[sidx]) * DM; unsigned char* dst = (unsigned char*)XG + (size_t)(e * MR + slotbase + sidx) * DM;
                *(v4u*)(dst + 16 * lane) = *(const v4u*)(src + 16 * lane); }
            else { const bf16* src = HB + (size_t)(rowbase + sel[sidx]) * DM; bf16* dst = XG + (size_t)(e * MR + slotbase + sidx) * DM;
            const v4u a0 = *(const v4u*)(src + 8 * lane), a1 = *(const v4u*)(src + 512 + 8 * lane);
            *(v4u*)(dst + 8 * lane) = a0; *(v4u*)(dst + 512 + 8 * lane) = a1; }
        }
        __syncthreads();
    }
}

__device__ __forceinline__ void ph_combine(const Params& p, const Ctx& c, int layer) {
    const bf16* YS = (const bf16*)(p.ws + WS_YS);
    const int* INV = (const int*)(p.ws + WS_INV);
    bf16* XS = (bf16*)(p.ws + WS_XS);
    bf16* HB = (bf16*)(p.ws + WS_HB);
    const float* lng = p.in[I_LNG] + (size_t)(layer * 2 + 1) * DM; const float* lnb = p.in[I_LNB] + (size_t)(layer * 2 + 1) * DM;
    const int nrows = layer == 0 ? NTOK : LAT;
    const int lane = c.lane;
    for (int row = 2 * c.gw; row < nrows; row += 2 * c.NGW) {
        const float* mod = mod_row(p, layer, row);
        const int inv = (lane < 2 * NE) ? INV[(size_t)row * NE + lane] : -1;
        const unsigned mall = (unsigned)__ballot(inv >= 0);
        unsigned ma = mall & 0xffffu, mb = mall >> 16;
        int sla[4], slb[4]; float wa[4], wb[4];
#pragma unroll
        for (int q = 0; q < 4; ++q) {
            if (ma) { const int e = __builtin_ctz(ma); ma &= ma - 1; sla[q] = __builtin_amdgcn_readlane(inv, e); wa[q] = 1.f; } else { sla[q] = 0; wa[q] = 0.f; }
            if (mb) { const int e = __builtin_ctz(mb); mb &= mb - 1; slb[q] = __builtin_amdgcn_readlane(inv, 16 + e); wb[q] = 1.f; } else { slb[q] = 0; wb[q] = 0.f; } }
        f32x4 moa[4], mob[4];
#pragma unroll
        for (int j = 0; j < 4; ++j) { moa[j] = (f32x4){0.f, 0.f, 0.f, 0.f}; mob[j] = (f32x4){0.f, 0.f, 0.f, 0.f}; }
#pragma unroll
        for (int q = 0; q < 4; ++q)
#pragma unroll
            for (int j = 0; j < 4; ++j) { moa[j] += unpack4(*(const v2u*)(YS + (size_t)sla[q] * DM + 4 * lane + 256 * j)) * wa[q]; mob[j] += unpack4(*(const v2u*)(YS + (size_t)slb[q] * DM + 4 * lane + 256 * j)) * wb[q]; }
        while (ma) { const int e = __builtin_ctz(ma); ma &= ma - 1; const int sl = __builtin_amdgcn_readlane(inv, e);
#pragma unroll
            for (int j = 0; j < 4; ++j) moa[j] += unpack4(*(const v2u*)(YS + (size_t)sl * DM + 4 * lane + 256 * j)); }
        while (mb) { const int e = __builtin_ctz(mb); mb &= mb - 1; const int sl = __builtin_amdgcn_readlane(inv, 16 + e);
#pragma unroll
            for (int j = 0; j < 4; ++j) mob[j] += unpack4(*(const v2u*)(YS + (size_t)sl * DM + 4 * lane + 256 * j)); }
        f32x4 va[4], vb[4]; float sa = 0.f, sb = 0.f;
#pragma unroll
        for (int j = 0; j < 4; ++j) { const int col = 4 * lane + 256 * j; const f32x4 g2 = *(const f32x4*)(mod + 5120 + col);
            va[j] = unpack4(*(const v2u*)(XS + (size_t)row * DM + col)) * ALPHA + g2 * moa[j];
            vb[j] = unpack4(*(const v2u*)(XS + (size_t)(row + 1) * DM + col)) * ALPHA + g2 * mob[j];
            sa += (va[j].x + va[j].y) + (va[j].z + va[j].w); sb += (vb[j].x + vb[j].y) + (vb[j].z + vb[j].w); }
        const float meana = wave_sum(sa) * (1.f / DM), meanb = wave_sum(sb) * (1.f / DM); float qa = 0.f, qb = 0.f;
#pragma unroll
        for (int j = 0; j < 4; ++j) { va[j] = va[j] - meana; vb[j] = vb[j] - meanb;
            qa += (va[j].x * va[j].x + va[j].y * va[j].y) + (va[j].z * va[j].z + va[j].w * va[j].w); qb += (vb[j].x * vb[j].x + vb[j].y * vb[j].y) + (vb[j].z * vb[j].z + vb[j].w * vb[j].w); }
        const float rstda = 1.f / sqrtf(wave_sum(qa) * (1.f / DM) + LN_EPS), rstdb = 1.f / sqrtf(wave_sum(qb) * (1.f / DM) + LN_EPS);
        const float* modn = mod_row(p, 1, row);
#pragma unroll
        for (int j = 0; j < 4; ++j) { const int col = 4 * lane + 256 * j;
            const f32x4 g = *(const f32x4*)(lng + col), bb = *(const f32x4*)(lnb + col);
            const f32x4 x2a = va[j] * rstda * g + bb, x2b = vb[j] * rstdb * g + bb;
            if (layer == 0) {
                *(v2u*)(XS + (size_t)row * DM + col) = (v2u){pk2(x2a.x, x2a.y), pk2(x2a.z, x2a.w)};
                *(v2u*)(XS + (size_t)(row + 1) * DM + col) = (v2u){pk2(x2b.x, x2b.y), pk2(x2b.z, x2b.w)};
                const f32x4 sc = *(const f32x4*)(modn + 1024 + col) + 1.f, sh = *(const f32x4*)(modn + col);
                const f32x4 ha = x2a * sc + sh, hb = x2b * sc + sh;
                *(v2u*)(HB + (size_t)row * DM + col) = (v2u){pk2(ha.x, ha.y), pk2(ha.z, ha.w)};
                *(v2u*)(HB + (size_t)(row + 1) * DM + col) = (v2u){pk2(hb.x, hb.y), pk2(hb.z, hb.w)};
            } else {
                *(f32x4*)(p.out + (size_t)row * DM + col) = x2a; *(f32x4*)(p.out + (size_t)(row + 1) * DM + col) = x2b;
            } }
    }
}

__device__ __forceinline__ void na_key(const float* q, float* o, float& m, float& l, const bf16* kp, const bf16* vp, float bias) {
    float s = bias;
#pragma unroll
    for (int i = 0; i < 8; ++i) { float f[8]; unpack8(*(const v4u*)(kp + 8 * i), f);
#pragma unroll
        for (int j = 0; j < 8; ++j) s += q[8 * i + j] * f[j]; }
    const float mn = fmaxf(m, s), al = exp2f(m - mn), pp = exp2f(s - mn);
    l = l * al + pp; m = mn;
#pragma unroll
    for (int i = 0; i < 8; ++i) { float f[8]; unpack8(*(const v4u*)(vp + 8 * i), f);
#pragma unroll
        for (int j = 0; j < 8; ++j) o[8 * i + j] = o[8 * i + j] * al + pp * f[j]; }
}
__device__ __forceinline__ void ph_mixer1_naive(const Params& p, const Ctx& c) {
    const bf16* P2 = (const bf16*)(p.ws + WS_QKV);
    bf16* CC = (bf16*)(p.ws + WS_CC);
    const float* rpb = p.in[I_RPB]; const float* pool_w = p.in[I_POOLW]; const float* pool_s = p.in[I_POOLS];
    LAS float* pl = (LAS float*)c.lds;
    for (int u = c.vcu; u < 256; u += c.G) {
        const int b = u >> 5, r = u & 31;
        {
            const int h = c.wave, col = c.lane, row = b * SEQ + r * 64 + col;
            const int rs = min(max(r - 4, 0), 24), cs = min(max(col - 8, 0), 48);
            float q[64], o[64];
#pragma unroll
            for (int i = 0; i < 8; ++i) unpack8(*(const v4u*)(P2 + (size_t)row * OIN + h * 64 + 8 * i), q + 8 * i);
#pragma unroll
            for (int i = 0; i < 64; ++i) o[i] = 0.f;
            float m = -1e30f, l = 0.f;
#pragma unroll 1
            for (int i = 0; i < 8; ++i)
#pragma unroll 1
                for (int j = 0; j < 16; ++j) {
                    const int krow = b * SEQ + (rs + i) * 64 + cs + j;
                    const float bias = rpb[(h * 15 + (rs + i - r + 7)) * 31 + (cs + j - col + 15)] * LOG2E;
                    na_key(q, o, m, l, P2 + (size_t)krow * OIN + 512 + h * 64, P2 + (size_t)krow * OIN + 1024 + h * 64, bias);
                }
#pragma unroll 1
            for (int j = 0; j < NCTX; ++j) {
                const int krow = LAT + b * NCTX + j;
                na_key(q, o, m, l, P2 + (size_t)krow * OIN + 512 + h * 64, P2 + (size_t)krow * OIN + 1024 + h * 64, 0.f);
            }
            const float rl = 1.f / l; bf16* dst = CC + (size_t)row * DM + h * 64;
#pragma unroll
            for (int i = 0; i < 8; ++i) *(v4u*)(dst + 8 * i) = (v4u){pk2(o[8 * i] * rl, o[8 * i + 1] * rl), pk2(o[8 * i + 2] * rl, o[8 * i + 3] * rl), pk2(o[8 * i + 4] * rl, o[8 * i + 5] * rl), pk2(o[8 * i + 6] * rl, o[8 * i + 7] * rl)};
        }
        __syncthreads();
        {
            const int ch = c.tid, g = ch >> 7, half = 1 << g;
            for (int tt = 0; tt < 64; ++tt) {
                const int t = r * 64 + tt, lo = max(t - half, 0), hi = min(t + half, SEQ);
                float s = 0.f;
                for (int t2 = lo; t2 < hi; ++t2) s += bf2f((unsigned)P2[(size_t)(b * SEQ + t2) * OIN + 1536 + ch]);
                pl[tt * 512 + ch] = s / (float)(hi - lo) - bf2f((unsigned)P2[(size_t)(b * SEQ + t) * OIN + 1536 + ch]);
            }
        }
        __syncthreads();
        {
            const int g = c.tid >> 7, e = c.tid & 127;
            const float ps = pool_s[g * 128 + e];
#pragma unroll 1
            for (int tb = 0; tb < 64; tb += 16) {
                float acc[16];
#pragma unroll
                for (int i = 0; i < 16; ++i) acc[i] = 0.f;
#pragma unroll 4
                for (int cc = 0; cc < 128; ++cc) {
                    const float w = pool_w[(size_t)(g * 128 + cc) * 128 + e];
#pragma unroll
                    for (int i = 0; i < 16; ++i) acc[i] += pl[(tb + i) * 512 + g * 128 + cc] * w;
                }
#pragma unroll
                for (int i = 0; i < 16; ++i) CC[(size_t)(b * SEQ + r * 64 + tb + i) * DM + 512 + g * 128 + e] = (bf16)f2bf(acc[i] * ps);
            }
        }
        __syncthreads();
    }
}


constexpr int NA_TAB_OFF = 86016 + 1024;
__device__ __forceinline__ void ph_mixer1_fast(const Params& p, const Ctx& c, char* lds_generic) {
    typedef attn_body::bf16 abf;
    const abf* P2a = (const abf*)(p.ws + WS_QKV); abf* CCa = (abf*)(p.ws + WS_CC);
    LAS float* tab = (LAS float*)(c.lds + NA_TAB_OFF);
    for (int i = c.tid; i < 8 * 15 * 32; i += 512) { const int hd = i >> 5, j = i & 31; tab[i] = j < 31 ? p.in[I_RPB][hd * 31 + j] * LOG2E : 0.f; }
    __syncthreads();
    for (int it = 0;; ++it) {
        const int U = it * c.G + c.vcu;
        if (U >= 512) break;
        const int b = U >> 6, h = (U >> 3) & 7, rq = U & 7;
        const int rs_min = min(max(4 * rq - 4, 0), 24);
        const int nloc = (rq == 0 || rq == 7) ? 8 : 12;
        attn_body::AU u;
        u.qrow0 = b * SEQ + rq * 256; u.lat_row0 = LAT + b * NCTX; u.nlat_t = 4; u.ctx_row0 = b * SEQ + rs_min * 64; u.NT = 4 + nloc;
        u.Qp = P2a + h * 64; u.Kp = P2a + 512 + h * 64; u.Vp = P2a + 1024 + h * 64; u.Op = CCa + h * 64;
        const int r = 4 * rq + (c.wave >> 1), col = (c.wave & 1) * 32 + (c.lane & 31), hi = c.lane >> 5;
        const int cs = min(max(col - 8, 0), 48);
        attn_body::NAMask mk; mk.tb0 = (attn_body::lds_cfptr)(tab + h * 15 * 32 + 15 - col); mk.r = r; mk.rs = min(max(r - 4, 0), 24); mk.rs_min = rs_min; mk.cb = 4 * hi - cs;
        attn_body::attn_unit<8, OIN, attn_body::NAMask>(u, lds_generic, mk);
    }
    __syncthreads();
    const bf16* P2 = (const bf16*)(p.ws + WS_QKV); bf16* CC = (bf16*)(p.ws + WS_CC);
    const float* pool_w = p.in[I_POOLW]; const float* pool_s = p.in[I_POOLS];
    constexpr int PLP = 1040;
    for (int u = c.vcu; u < 256; u += c.G) {
        const int b = u >> 5, r = u & 31;
        {   const int ch = c.tid, g = c.wave >> 1;
            const bf16* du = P2 + (size_t)b * SEQ * OIN + 1536 + ch;
            const int t0 = r * 64;
            float v[80];
#pragma unroll
            for (int k = 0; k < 80; ++k) { const int t2 = t0 - 8 + k; v[k] = ((t2 >= 0 && t2 < SEQ) ? 1.f : 0.f) * bf2f((unsigned)du[(size_t)min(max(t2, 0), SEQ - 1) * OIN]); }
            LAS bf16* plc = (LAS bf16*)(c.lds) + ch;
#define POOL_COL(HALF) do { float ws = 0.f; _Pragma("unroll") for (int k = 8 - HALF; k < 8 + HALF; ++k) ws += v[k]; \
            _Pragma("unroll") for (int tt = 0; tt < 64; ++tt) { const int t = t0 + tt, lo = max(t - HALF, 0), hi = min(t + HALF, SEQ); \
                plc[tt * (PLP / 2)] = (bf16)f2bf(ws / (float)(hi - lo) - v[tt + 8]); ws += v[tt + 8 + HALF] - v[tt + 8 - HALF]; } } while (0)
            if (g == 0) POOL_COL(1); else if (g == 1) POOL_COL(2); else if (g == 2) POOL_COL(4); else POOL_COL(8);
#undef POOL_COL
        }
        __syncthreads();
        {   typedef short bf16x8v __attribute__((ext_vector_type(8)));
            const int g = c.wave >> 1, th = c.wave & 1, l31 = c.lane & 31, lh = c.lane >> 5;
            f32x16 acc[4];
#pragma unroll
            for (int et = 0; et < 4; ++et) acc[et] = (f32x16){};
#pragma unroll
            for (int ks = 0; ks < 8; ++ks) {
                const bf16x8v af = *(const LAS bf16x8v*)(c.lds + (32 * th + l31) * PLP + (g * 128 + 16 * ks + 8 * lh) * 2);
#pragma unroll
                for (int et = 0; et < 4; ++et) {
                    const float* wp = pool_w + (size_t)(g * 128 + 16 * ks + 8 * lh) * 128 + 32 * et + l31;
                    bf16x8v bfr;
#pragma unroll
                    for (int j = 0; j < 8; ++j) bfr[j] = (short)f2bf(wp[(size_t)j * 128]);
                    acc[et] = __builtin_amdgcn_mfma_f32_32x32x16_bf16(af, bfr, acc[et], 0, 0, 0);
                }
            }
#pragma unroll
            for (int et = 0; et < 4; ++et) { const int e = 32 * et + l31; const float ps = pool_s[g * 128 + e];
#pragma unroll
                for (int rg = 0; rg < 16; ++rg) { const int tok = 32 * th + (rg & 3) + 8 * (rg >> 2) + 4 * lh;
                    CC[(size_t)(b * SEQ + r * 64 + tok) * DM + 512 + g * 128 + e] = (bf16)f2bf(acc[et][rg] * ps); } }
        }
        __syncthreads();
    }
}

__global__ void __launch_bounds__(512, 2) mk_fwd(Params p) {
    extern __shared__ __attribute__((aligned(16))) unsigned char lds_raw[];
    Ctx c;
    c.lds = (LAS unsigned char*)lds_raw;
    c.tid = threadIdx.x; c.lane = c.tid & 63; c.wave = __builtin_amdgcn_readfirstlane(c.tid >> 6);
    c.G = gridDim.x; { const int bx = blockIdx.x; c.vcu = (c.G % 8 == 0) ? (bx % 8) * (c.G / 8) + bx / 8 : bx; }
    c.gw = c.vcu * 8 + c.wave; c.NGW = c.G * 8;
    volatile LAS unsigned* MISC = (volatile LAS unsigned*)(c.lds + MISC_OFF);
    if (c.tid < 32) MISC[c.tid] = 0u;
    __syncthreads();
    gu32* ctl = (gu32*)(p.ws + WS_CTL);
    XcdBarrier bar; bar.bar = (unsigned*)(ctl + CW_BAR); bar.x = 0; bar.st = nullptr;
    if (!MK_MULTI) bar = xcd_barrier_post((unsigned*)(ctl + CW_BAR), MISC + 8);
    const int lo = p.ph_lo, hi = p.ph_hi;
    unsigned long long pt0 = 0, pt1 = 0; if (PROBE_PH == 0) pt0 = __builtin_amdgcn_s_memrealtime();
#define IN(k) (lo <= (k) && (k) < hi)
#define SEAM(k) do { if (IN(k) && IN((k) + 1) && !(FAST_ATTN && (k) == 5) && !(FAST_GEMM && FUSE_QKV && (k) == 3)) xcd_barrier(bar); if ((k) + 1 == PROBE_PH) pt0 = __builtin_amdgcn_s_memrealtime(); if ((k) == PROBE_PH) pt1 = __builtin_amdgcn_s_memrealtime(); } while (0)

    bf16* HB = (bf16*)(p.ws + WS_HB); bf16* QKV = (bf16*)(p.ws + WS_QKV); bf16* CC = (bf16*)(p.ws + WS_CC);
    float* Y = (float*)(p.ws + WS_Y); float* PF = (float*)(p.ws + WS_PF);
    bf16* XG = (bf16*)(p.ws + WS_XG); bf16* HID = (bf16*)(p.ws + WS_HID); bf16* YS = (bf16*)(p.ws + WS_YS);
    const float* GATE = (const float*)(p.ws + WS_GATE);

    if (IN(0)) for (int rep_ = 0; rep_ < 1 + (int)((PROBE_MASK >> 0) & 1u); ++rep_) { if (rep_) __syncthreads(); ph_prologue(p, c); if (FAST_GEMM) { __syncthreads(); ph_transposes(p, c); } } SEAM(0);
    if (IN(1)) for (int rep_ = 0; rep_ < 1 + (int)((PROBE_MASK >> 1) & 1u); ++rep_) { if (rep_) __syncthreads(); ph_modulate0(p, c); } SEAM(1);
    if (IN(2)) for (int rep_ = 0; rep_ < 1 + (int)((PROBE_MASK >> 2) & 1u); ++rep_) { if (rep_) __syncthreads();
        if (FAST_GEMM) { pg8::Gemm g{HB, (const bf16*)(p.ws + WS_W0IN), NTOK, EIN, DM, 0}; pg8::StaticOrder S; S.init(NTOK, EIN, c.G, (int)blockIdx.x);
            if (FUSE_QKV) { pg8::EpiQKV E{QKV, EIN, (const float*)(p.ws + WS_ROPE), p.in[I_QN], p.in[I_KN], C2, RMS_EPS}; pg8::gemm_phase<pg8::EpiQKV, pg8::StaticOrder, true, true>(c.lds, g, S, E); }
            else { pg8::EpiBf16<0> E{QKV, EIN, nullptr, 0, 0, 1.f}; pg8::gemm_phase<pg8::EpiBf16<0>, pg8::StaticOrder, true, true>(c.lds, g, S, E); }
            tail_transposes(p, c, 648 - 512, (int)blockIdx.x, 1536, 120); }
        else { NG g{HB, DM, p.in[I_W0IN], nullptr, EIN, 0, 1 << 30, 0, NTOK, 0, EIN, DM}; ngemm<1>(g, c, EpiF32{PF, EIN}); }
    } SEAM(2);
    if (!(FAST_GEMM && FUSE_QKV)) { if (IN(3)) { if (FAST_GEMM) ph_qkv_post<false>(p, c); else ph_qkv_post<true>(p, c); } } SEAM(3);
    if (IN(4)) for (int rep_ = 0; rep_ < 1 + (int)((PROBE_MASK >> 4) & 1u); ++rep_) { if (rep_) __syncthreads(); if (FAST_ATTN) ph_attn0_fast(p, c, (char*)lds_raw); else ph_attn0_naive(p, c); } SEAM(4);
    if (!FAST_ATTN) { if (IN(5)) { ph_attn_combine(p, c); } } SEAM(5);
    if (IN(6)) for (int rep_ = 0; rep_ < 1 + (int)((PROBE_MASK >> 6) & 1u); ++rep_) { if (rep_) __syncthreads();
        if (FAST_GEMM) { pg8::Gemm g{CC, (const bf16*)(p.ws + WS_W0OUT), NTOK, DM, DM, 0}; pg8::StaticOrder S; S.init(NTOK, DM, c.G, (int)blockIdx.x);
            pg8::EpiBf16<0> E{(bf16*)Y, DM, nullptr, 0, 0, 1.f}; pg8::gemm_phase<pg8::EpiBf16<0>, pg8::StaticOrder, true, true>(c.lds, g, S, E);
            tail_transposes(p, c, 288 - 256, (int)blockIdx.x, 1536 + 120 + 320, 224); }
        else { NG g{CC, DM, p.in[I_W0OUT], nullptr, DM, 0, 1 << 30, 0, NTOK, 0, DM, DM}; ngemm<1>(g, c, EpiBf{(bf16*)Y, DM, 0, 1.f}); }
    } SEAM(6);
    if (IN(7)) for (int rep_ = 0; rep_ < 1 + (int)((PROBE_MASK >> 7) & 1u); ++rep_) { if (rep_) __syncthreads(); ph_ln1_router(p, c, 0); } SEAM(7);
    if (IN(8)) for (int rep_ = 0; rep_ < 1 + (int)((PROBE_MASK >> 8) & 1u); ++rep_) { if (rep_) __syncthreads(); ph_topk(p, c, 0); } SEAM(8);
    if (IN(9)) for (int rep_ = 0; rep_ < 1 + (int)((PROBE_MASK >> 9) & 1u); ++rep_) { if (rep_) __syncthreads();
        if (FAST_GEMM && MOE_FP8) { pg8::Gemm g{XG, (const bf16*)(p.ws + WS_WGU), NE * MR0, 4096, DM / 2, (size_t)4096 * DM}; pg8::GroupedOrder S; S.init(MR0 / 256, 16, NE, c.G, c.vcu);
            pg8::EpiSwigluF8 E{(unsigned char*)HID, FF, 1.f / W8_GU, H8_SC}; pg8::gemm_phase<pg8::EpiSwigluF8, pg8::GroupedOrder, true, true, true>(c.lds, g, S, E); }
        else if (FAST_GEMM) { pg8::Gemm g{XG, (const bf16*)(p.ws + WS_WGU), NE * MR0, 4096, DM, (size_t)4096 * DM * 2}; pg8::GroupedOrder S; S.init(MR0 / 256, 16, NE, c.G, c.vcu);
            pg8::EpiSwigluP E{HID, FF}; pg8::gemm_phase<pg8::EpiSwigluP, pg8::GroupedOrder, true, true>(c.lds, g, S, E); }
        else { NG g{XG, DM, p.in[I_WG], p.in[I_WU], FF, (size_t)DM * FF, MR0, 0, NE * MR0, 0, FF, DM}; ngemm<2>(g, c, EpiSwiglu{HID}); }
    } SEAM(9);
    if (IN(10)) for (int rep_ = 0; rep_ < 1 + (int)((PROBE_MASK >> 10) & 1u); ++rep_) { if (rep_) __syncthreads();
        if (FAST_GEMM && MOE_FP8) { pg8::Gemm g{HID, (const bf16*)(p.ws + WS_WDN), NE * MR0, DM, FF / 2, (size_t)DM * FF}; pg8::GroupedOrder S; S.init(MR0 / 256, 4, NE, c.G, c.vcu);
            pg8::EpiGateS E{YS, DM, GATE, 1.f / (W8_DN * H8_SC)}; pg8::gemm_phase<pg8::EpiGateS, pg8::GroupedOrder, true, true, true>(c.lds, g, S, E);
            tail_transposes(p, c, 576 - 512, c.vcu, 1536 + 120 + 320 + 224, 576); }
        else if (FAST_GEMM) { pg8::Gemm g{HID, (const bf16*)(p.ws + WS_WDN), NE * MR0, DM, FF, (size_t)DM * FF * 2}; pg8::GroupedOrder S; S.init(MR0 / 256, 4, NE, c.G, c.vcu);
            pg8::EpiGateP E{YS, DM, GATE}; pg8::gemm_phase<pg8::EpiGateP, pg8::GroupedOrder, true, true>(c.lds, g, S, E); }
        else { NG g{HID, FF, p.in[I_WD], nullptr, DM, (size_t)FF * DM, MR0, 0, NE * MR0, 0, DM, FF}; ngemm<1>(g, c, EpiGate{YS, GATE}); }
    } SEAM(10);
    if (IN(11)) for (int rep_ = 0; rep_ < 1 + (int)((PROBE_MASK >> 11) & 1u); ++rep_) { if (rep_) __syncthreads(); ph_combine(p, c, 0); } SEAM(11);
    if (IN(12)) for (int rep_ = 0; rep_ < 1 + (int)((PROBE_MASK >> 12) & 1u); ++rep_) { if (rep_) __syncthreads();
        if (FAST_GEMM) { pg8::Gemm g{HB, (const bf16*)(p.ws + WS_W1IN), NTOK, OIN, DM, 0}; pg8::L1InOrder S; S.init(c.G, (int)blockIdx.x);
            pg8::EpiBf16<0> E{QKV, OIN, nullptr, 512, 512, C2}; pg8::gemm_phase<pg8::EpiBf16<0>, pg8::L1InOrder, true, true>(c.lds, g, S, E);
            tail_transposes(p, c, 544 - 512, (int)blockIdx.x, 1536 + 120 + 320 + 224 + 576, 296); }
        else {
        NG g{HB, DM, p.in[I_W1IN], nullptr, OIN, 0, 1 << 30, 0, LAT, 0, OIN, DM}; ngemm<1>(g, c, EpiBf{QKV, OIN, 512, C2});
        NG g2{HB, DM, p.in[I_W1IN], nullptr, OIN, 0, 1 << 30, LAT, NTOK, 512, 1536, DM}; ngemm<1>(g2, c, EpiBf{QKV, OIN, 0, 1.f}); }
    } SEAM(12);
    if (IN(13)) for (int rep_ = 0; rep_ < 1 + (int)((PROBE_MASK >> 13) & 1u); ++rep_) { if (rep_) __syncthreads(); if (FAST_NA) ph_mixer1_fast(p, c, (char*)lds_raw); else ph_mixer1_naive(p, c); } SEAM(13);
    if (IN(14)) for (int rep_ = 0; rep_ < 1 + (int)((PROBE_MASK >> 14) & 1u); ++rep_) { if (rep_) __syncthreads();
        if (FAST_GEMM) { pg8::Gemm g{CC, (const bf16*)(p.ws + WS_W1OUT), LAT, DM, DM, 0}; pg8::StaticOrder S; S.init(LAT, DM, c.G, (int)blockIdx.x);
            pg8::EpiBf16<0> E{(bf16*)Y, DM, nullptr, 0, 0, 1.f}; pg8::gemm_phase<pg8::EpiBf16<0>, pg8::StaticOrder, true, true>(c.lds, g, S, E); }
        else { NG g{CC, DM, p.in[I_W1OUT], nullptr, DM, 0, 1 << 30, 0, LAT, 0, DM, DM}; ngemm<1>(g, c, EpiBf{(bf16*)Y, DM, 0, 1.f}); }
    } SEAM(14);
    if (IN(15)) for (int rep_ = 0; rep_ < 1 + (int)((PROBE_MASK >> 15) & 1u); ++rep_) { if (rep_) __syncthreads(); ph_ln1_router(p, c, 1); } SEAM(15);
    if (IN(16)) for (int rep_ = 0; rep_ < 1 + (int)((PROBE_MASK >> 16) & 1u); ++rep_) { if (rep_) __syncthreads(); ph_topk(p, c, 1); } SEAM(16);
    if (IN(17)) for (int rep_ = 0; rep_ < 1 + (int)((PROBE_MASK >> 17) & 1u); ++rep_) { if (rep_) __syncthreads();
        if (FAST_GEMM && MOE_FP8) { pg8::Gemm g{XG, (const bf16*)(p.ws + WS_WGU + WS_MOE_LSTRIDE), NE * MR1, 4096, DM / 2, (size_t)4096 * DM}; pg8::GroupedOrder S; S.init(MR1 / 256, 16, NE, c.G, c.vcu);
            pg8::EpiSwigluF8 E{(unsigned char*)HID, FF, 1.f / W8_GU, H8_SC}; pg8::gemm_phase<pg8::EpiSwigluF8, pg8::GroupedOrder, true, true, true>(c.lds, g, S, E); }
        else if (FAST_GEMM) { pg8::Gemm g{XG, (const bf16*)(p.ws + WS_WGU + WS_MOE_LSTRIDE), NE * MR1, 4096, DM, (size_t)4096 * DM * 2}; pg8::GroupedOrder S; S.init(MR1 / 256, 16, NE, c.G, c.vcu);
            pg8::EpiSwigluP E{HID, FF}; pg8::gemm_phase<pg8::EpiSwigluP, pg8::GroupedOrder, true, true>(c.lds, g, S, E); }
        else { NG g{XG, DM, p.in[I_WG] + (size_t)NE * DM * FF, p.in[I_WU] + (size_t)NE * DM * FF, FF, (size_t)DM * FF, MR1, 0, NE * MR1, 0, FF, DM}; ngemm<2>(g, c, EpiSwiglu{HID}); }
    } SEAM(17);
    if (IN(18)) for (int rep_ = 0; rep_ < 1 + (int)((PROBE_MASK >> 18) & 1u); ++rep_) { if (rep_) __syncthreads();
        if (FAST_GEMM && MOE_FP8) { pg8::Gemm g{HID, (const bf16*)(p.ws + WS_WDN + WS_MOE_LSTRIDE), NE * MR1, DM, FF / 2, (size_t)DM * FF}; pg8::GroupedOrder S; S.init(MR1 / 256, 4, NE, c.G, c.vcu);
            pg8::EpiGateS E{YS, DM, GATE, 1.f / (W8_DN * H8_SC)}; pg8::gemm_phase<pg8::EpiGateS, pg8::GroupedOrder, true, true, true>(c.lds, g, S, E); }
        else if (FAST_GEMM) { pg8::Gemm g{HID, (const bf16*)(p.ws + WS_WDN + WS_MOE_LSTRIDE), NE * MR1, DM, FF, (size_t)DM * FF * 2}; pg8::GroupedOrder S; S.init(MR1 / 256, 4, NE, c.G, c.vcu);
            pg8::EpiGateP E{YS, DM, GATE}; pg8::gemm_phase<pg8::EpiGateP, pg8::GroupedOrder, true, true>(c.lds, g, S, E); }
        else { NG g{HID, FF, p.in[I_WD] + (size_t)NE * FF * DM, nullptr, DM, (size_t)FF * DM, MR1, 0, NE * MR1, 0, DM, FF}; ngemm<1>(g, c, EpiGate{YS, GATE}); }
    } SEAM(18);
    if (IN(19)) for (int rep_ = 0; rep_ < 1 + (int)((PROBE_MASK >> 19) & 1u); ++rep_) { if (rep_) __syncthreads(); ph_combine(p, c, 1); }
    if (PROBE_PH == 19) pt1 = __builtin_amdgcn_s_memrealtime();
    if (PROBE_PH >= 0 && blockIdx.x == 0 && c.tid == 0) { const unsigned long long te = __builtin_amdgcn_s_memrealtime(); while (__builtin_amdgcn_s_memrealtime() - te < pt1 - pt0) __builtin_amdgcn_s_sleep(8); }
#undef IN
#undef SEAM
}

extern "C" void kernel_launch(void* const* d_in, const int* in_sizes, int n_in, void* d_out, int out_size, void* d_ws, size_t ws_size, hipStream_t stream) {
    static int grid = 0;
    if (grid == 0) {
        if (n_in != 26 || out_size != LAT * DM || ws_size < WS_END) { fprintf(stderr, "kernel_launch: unexpected shapes (n_in %d out %d ws %zu)\n", n_in, out_size, ws_size); grid = -1; return; }
        int dev = 0, cus = 0;
        if (hipGetDevice(&dev) != hipSuccess || hipDeviceGetAttribute(&cus, hipDeviceAttributeMultiprocessorCount, dev) != hipSuccess) { grid = -1; return; }
        if (hipFuncSetAttribute((const void*)mk_fwd, hipFuncAttributeMaxDynamicSharedMemorySize, LDS_BYTES) != hipSuccess) { fprintf(stderr, "kernel_launch: hipFuncSetAttribute failed\n"); grid = -1; return; }
        int per_cu = 0;
        if (hipOccupancyMaxActiveBlocksPerMultiprocessor(&per_cu, (const void*)mk_fwd, 512, LDS_BYTES) != hipSuccess || per_cu < 1) fprintf(stderr, "kernel_launch: occupancy query says %d\n", per_cu);
        (void)hipGetLastError();
        grid = cus;
    }
    if (grid < 0) return;
    (void)hipMemsetAsync((char*)d_ws + WS_CTL, 0, CTL_ZERO_BYTES, stream);
    Params a{};
    for (int i = 0; i < 26; ++i) a.in[i] = (const float*)d_in[i];
    a.out = (float*)d_out; a.ws = (unsigned char*)d_ws;
#if MK_MULTI
    for (int ph = 0; ph < NPHASE; ++ph) { a.ph_lo = ph; a.ph_hi = ph + 1; hipLaunchKernelGGL(mk_fwd, dim3(grid), dim3(512), LDS_BYTES, stream, a); }
#else
    a.ph_lo = 0; a.ph_hi = NPHASE;
    hipLaunchKernelGGL(mk_fwd, dim3(grid), dim3(512), LDS_BYTES, stream, a);
#endif
}
```

```cpp
#include <hip/hip_runtime.h>
#include <cstdio>
#include <cstdint>

#define GAS __attribute__((address_space(1)))
#define LAS __attribute__((address_space(3)))
typedef unsigned short bf16;
typedef unsigned v4u __attribute__((ext_vector_type(4)));
typedef unsigned v2u __attribute__((ext_vector_type(2)));
typedef float f32x4 __attribute__((ext_vector_type(4)));
typedef float f32x2 __attribute__((ext_vector_type(2)));
typedef float f32x16 __attribute__((ext_vector_type(16)));
typedef GAS unsigned gu32;

#ifndef PROBE_PH
#define PROBE_PH -1
#endif
#ifndef PROBE_MASK
#define PROBE_MASK 0u
#endif
#ifndef TAIL_TRANSPOSE
#define TAIL_TRANSPOSE 1
#endif
#ifndef FUSE_QKV
#define FUSE_QKV 1
#endif
#ifndef MOE_FP8
#define MOE_FP8 1
#endif
#ifndef FAST_NA
#define FAST_NA 1
#endif
#ifndef FAST_ATTN
#define FAST_ATTN 1
#endif
#ifndef FAST_GEMM
#define FAST_GEMM 1
#endif
#ifndef MK_MULTI
#define MK_MULTI 0
#endif

constexpr int NBATCH = 8, SEQ = 2048, DM = 1024, NCTX = 256;
constexpr int LAT = NBATCH * SEQ;
constexpr int NTOK = LAT + NBATCH * NCTX;
constexpr int EIN = 2304, OIN = 2048, NE = 16, FF = 2048;
constexpr int MR0 = 2304, MR1 = 2048;
constexpr float LOG2E = 1.4426950408889634f;
constexpr float C2 = 0.125f * LOG2E;
constexpr float ALPHA = 1.4142135623730951f;
constexpr float LN_EPS = 1e-5f, RMS_EPS = 1e-6f;
constexpr float LAM_INIT = 0.2f;
constexpr int NPHASE = 20;
constexpr float W8_GU = 32.f, W8_DN = 64.f, H8_SC = 8.f;

constexpr size_t MiB = 1u << 20;
constexpr size_t WS_CTL = 0, CTL_ZERO_BYTES = 1 * MiB;
constexpr size_t WS_MOD = 1 * MiB;
constexpr size_t WS_ROPE = 1 * MiB + 512 * 1024;
constexpr size_t WS_W0IN = 2 * MiB;
constexpr size_t WS_W0OUT = 7 * MiB;
constexpr size_t WS_W1IN = 9 * MiB;
constexpr size_t WS_W1OUT = 13 * MiB;
constexpr size_t WS_AFF = 16 * MiB;
constexpr size_t WS_INV = 18 * MiB;
constexpr size_t WS_GATE = 20 * MiB;
constexpr size_t WS_WGU = 24 * MiB;
constexpr size_t WS_WDN = 152 * MiB;
constexpr size_t WS_MOE_LSTRIDE = 192 * MiB;
constexpr size_t WS_XS = 408 * MiB;
constexpr size_t WS_HB = 480 * MiB;
constexpr size_t WS_QKV = 516 * MiB;
constexpr size_t WS_CC = 597 * MiB;
constexpr size_t WS_AO = 633 * MiB;
constexpr size_t WS_Y = 705 * MiB;
constexpr size_t WS_XG = 516 * MiB;
constexpr size_t WS_HID = 588 * MiB;
constexpr size_t WS_YS = 732 * MiB;
constexpr size_t WS_PF = 804 * MiB;
constexpr size_t WS_END = 968 * MiB;

constexpr int CW_BAR = 4096;
constexpr int LDS_BYTES = 147456;
constexpr int MISC_OFF = 131072 + 320;

__device__ __forceinline__ float bf2f(unsigned v) { return __uint_as_float(v << 16); }
__device__ __forceinline__ unsigned f2bf(float f) { unsigned u = __float_as_uint(f); return (u + 0x7fffu + ((u >> 16) & 1u)) >> 16; }
__device__ __forceinline__ unsigned pk2(float lo, float hi) { return f2bf(lo) | (f2bf(hi) << 16); }
__device__ __forceinline__ float wave_sum(float v) {
#pragma unroll
    for (int o = 1; o < 64; o <<= 1) v += __shfl_xor(v, o);
    return v;
}
__device__ __forceinline__ float wave_max(float v) {
#pragma unroll
    for (int o = 1; o < 64; o <<= 1) v = fmaxf(v, __shfl_xor(v, o));
    return v;
}
__device__ __forceinline__ void unpack8(const v4u w, float* f) {
    f[0] = bf2f(w.x & 0xffffu); f[1] = __uint_as_float(w.x & 0xffff0000u);
    f[2] = bf2f(w.y & 0xffffu); f[3] = __uint_as_float(w.y & 0xffff0000u);
    f[4] = bf2f(w.z & 0xffffu); f[5] = __uint_as_float(w.z & 0xffff0000u);
    f[6] = bf2f(w.w & 0xffffu); f[7] = __uint_as_float(w.w & 0xffff0000u);
}

#define XB_TMO      128
#define XB_XCNT(j)  (256  + 64 * (j))
#define XB_XSUB(j)  (1280 + 64 * (j))
#define XB_XGEN(j)  (2304 + 64 * (j))
#define XB_TOP      3328
#define XB_TOPGEN   3392
#define XCD_BAR_WORDS 3456
#define XB_SPIN_CAP (1u << 18)
__device__ __forceinline__ unsigned xb_ld(unsigned* p)              { return __hip_atomic_load(p, __ATOMIC_RELAXED, __HIP_MEMORY_SCOPE_AGENT); }
__device__ __forceinline__ unsigned xb_add(unsigned* p, unsigned v) { return __hip_atomic_fetch_add(p, v, __ATOMIC_RELAXED, __HIP_MEMORY_SCOPE_AGENT); }
__device__ __forceinline__ unsigned xb_xcc_id() { return (unsigned)__builtin_amdgcn_s_getreg((3 << 11) | 20) & 0xFu; }
#define XB_SPIN(cond, bar) do { unsigned _sp = 0; while (cond) { __builtin_amdgcn_s_sleep(1); \
    if ((++_sp & 255u) == 0u) { if (xb_ld(&(bar)[XB_TMO])) break; if (_sp > XB_SPIN_CAP) { atomicAdd(&(bar)[XB_TMO], 1u); break; } } } } while (0)
struct XcdBarrier { unsigned* bar; unsigned x; volatile LAS unsigned* st; };
__device__ __forceinline__ XcdBarrier xcd_barrier_post(unsigned* bar, volatile LAS unsigned* st) {
    XcdBarrier b; b.bar = bar; b.x = xb_xcc_id(); b.st = st;
    if (threadIdx.x == 0) (void)xb_add(&bar[XB_XCNT(b.x)], 1u);
    return b;
}
__device__ __forceinline__ void xcd_barrier_complete(unsigned* bar, unsigned x, unsigned& nloc, unsigned& nx) {
    const unsigned G = gridDim.x * gridDim.y * gridDim.z;
    unsigned sum, cnt, mine, sp = 0u;
    for (;;) {
        sum = 0u; cnt = 0u; mine = 0u;
#pragma unroll
        for (unsigned j = 0; j < 16; ++j) { const unsigned c = xb_ld(&bar[XB_XCNT(j)]); sum += c; cnt += (c > 0u) ? 1u : 0u; mine = (j == x) ? c : mine; }
        if (sum == G) break;
        __builtin_amdgcn_s_sleep(1);
        if ((++sp & 255u) == 0u) { if (xb_ld(&bar[XB_TMO])) break; if (sp > XB_SPIN_CAP) { atomicAdd(&bar[XB_TMO], 1u); break; } }
    }
    nloc = mine > 0u ? mine : 1u; nx = cnt > 0u ? cnt : 1u;
}
__device__ __forceinline__ void xcd_barrier(const XcdBarrier& b) {
    asm volatile("s_waitcnt vmcnt(0)" ::: "memory");
    __syncthreads();
    if (threadIdx.x == 0) {
        unsigned* bar = b.bar;
        __builtin_amdgcn_s_waitcnt(0);
        unsigned nloc = b.st[0], nx = b.st[1];
        if (nloc == 0u) { xcd_barrier_complete(bar, b.x, nloc, nx); b.st[0] = nloc; b.st[1] = nx; }
        const unsigned old = xb_add(&bar[XB_XSUB(b.x)], 1u);
        const unsigned gen = old / nloc;
        if (old + 1u == (gen + 1u) * nloc) {
            __builtin_amdgcn_fence(__ATOMIC_RELEASE, "agent");
            asm volatile("s_waitcnt vmcnt(0)" ::: "memory");
            const unsigned og = xb_add(&bar[XB_TOP], 1u);
            const unsigned tg = og / nx;
            if (og + 1u == (tg + 1u) * nx) xb_add(&bar[XB_TOPGEN], 1u);
            else XB_SPIN(xb_ld(&bar[XB_TOPGEN]) == tg, bar);
            __builtin_amdgcn_fence(__ATOMIC_ACQUIRE, "agent");
            xb_add(&bar[XB_XGEN(b.x)], 1u);
            asm volatile("s_waitcnt vmcnt(0)" ::: "memory");
        } else {
            XB_SPIN(xb_ld(&bar[XB_XGEN(b.x)]) == gen, bar);
            __builtin_amdgcn_fence(__ATOMIC_ACQUIRE, "agent");
            asm volatile("s_waitcnt vmcnt(0)" ::: "memory");
        }
    }
    __syncthreads();
}

namespace pg8 {
#define PG8_LAS __attribute__((address_space(3)))
typedef unsigned short bf16_t;
typedef short bf16x8 __attribute__((ext_vector_type(8)));
typedef float f32x4 __attribute__((ext_vector_type(4)));
typedef unsigned u32x4 __attribute__((ext_vector_type(4)));
constexpr int BM = 256, BK = 64, HALF = 128, HTB = HALF * BK * 2  , STAGE_BYTES = 8 * HTB, NXCD = 8, WGM = 8;

__host__ __device__ __forceinline__ int lds_byte(int r, int c) { const int st = (r >> 4) * 2 + (c >> 5), rr = r & 15, cc = c & 31, ob = rr * 64 + cc * 2; return st * 1024 + (ob ^ (((ob >> 9) & 1) << 5)); }
__host__ __device__ __forceinline__ void stage_rc(int b, int& R, int& C) { const int st = b / 1024, sb = b % 1024, swz = sb ^ (((sb >> 9) & 1) << 5); R = (st >> 1) * 16 + swz / 64; C = (st & 1) * 32 + (swz % 64) / 2; }
__host__ __device__ __forceinline__ int perm32(int rho) { const int n = rho >> 4, i = rho & 15; return 8 * (i >> 2) + 4 * n + (i & 3); }

struct Unit { int pm, pn, e; };
struct Gemm { const bf16_t* A; const bf16_t* Bt; int M, N, K; size_t bstride; };

struct StaticOrder {
    int nM, nN, nwg, G, c;
    __host__ __device__ void init(int M, int N, int G_, int c_) { nM = M / BM; nN = N / BM; nwg = nM * nN; G = G_; c = c_; }
    __host__ __device__ bool next(int i, Unit& u) const {
        const long L = (long)i * G + c; if (L >= nwg) return false;
        int wgid = (int)L; { const int q = nwg / NXCD, r = nwg % NXCD, xcd = wgid % NXCD, off = wgid / NXCD; wgid = (xcd < r ? xcd * (q + 1) : r * (q + 1) + (xcd - r) * q) + off; }
        const int nig = WGM * nN, gid = wgid / nig, fm = gid * WGM, gsz = (nM - fm) < WGM ? (nM - fm) : WGM;
        u.pm = fm + ((wgid % nig) % gsz); u.pn = (wgid % nig) / gsz; u.e = 0; return true;
    }
    __device__ __forceinline__ void a_ready(const Unit&) const {}
    __device__ __forceinline__ void done(const Unit&) const {}
};

__device__ __forceinline__ unsigned cvt_pk_bf16(float lo, float hi) { unsigned r; asm volatile("v_cvt_pk_bf16_f32 %0, %1, %2" : "=v"(r) : "v"(lo), "v"(hi)); return r; }
typedef float f32x2 __attribute__((ext_vector_type(2)));
__device__ __forceinline__ f32x2 gelu_pk(f32x2 v) {
    const f32x2 av = __builtin_elementwise_abs(v), d = av * 0.2316418882f + 1.0f;
    f32x2 t; t.x = __builtin_amdgcn_rcpf(d.x); t.y = __builtin_amdgcn_rcpf(d.y);
    f32x2 q = t * 0.5307027145f + (-0.7265760135f); q = q * t + 0.7107068705f; q = q * t + (-0.142248368f); q = q * t + 0.127414796f; q = q * t;
    const f32x2 s = (v * v) * (-0.72134752044f);
    f32x2 e; e.x = __builtin_amdgcn_exp2f(s.x); e.y = __builtin_amdgcn_exp2f(s.y);
    const f32x2 m = v * (q * e), r = v - m;
    f32x2 o; o.x = v.x < 0.f ? m.x : r.x; o.y = v.y < 0.f ? m.y : r.y; return o;
}

template <int ACT  > struct EpiBf16 {
    static constexpr bool PERM = true, AFTER_DRAIN = false; static_assert(ACT == 0 || ACT == 1, "EpiBf16: ACT is 0 (none) or 1 (gelu_pk)");
    bf16_t* O; int ldc; const float* bias; int split_cols; size_t split_stride; float scale0;
    __device__ __forceinline__ void operator()(const f32x4 (&acc)[2][2][4][2], const Unit& u, int wr, int wc, int fr, int fq) const {
        const int row0 = u.pm * BM + wr * 64 + fr; int colt = u.pn * BM; bf16_t* base = O;
        float sc = 1.f; if (split_cols) { const int t = colt / split_cols; base += (size_t)t * split_stride; colt -= t * split_cols; if (t == 0) sc = scale0; }
        const int col0 = colt + wc * 32 + 8 * fq, bcol0 = u.pn * BM + wc * 32 + 8 * fq;
        f32x4 bv[2][2];
#pragma unroll
        for (int bj = 0; bj < 2; ++bj)
#pragma unroll
            for (int n = 0; n < 2; ++n) bv[bj][n] = bias ? *(const f32x4*)(bias + bcol0 + bj * HALF + 4 * n) : (f32x4){0.f, 0.f, 0.f, 0.f};
#pragma unroll
        for (int ai = 0; ai < 2; ++ai)
#pragma unroll
            for (int m = 0; m < 4; ++m) { bf16_t* rowp = base + (size_t)(row0 + ai * HALF + m * 16) * ldc + col0;
#pragma unroll
                for (int bj = 0; bj < 2; ++bj) { f32x4 v0 = acc[ai][bj][m][0] + bv[bj][0], v1 = acc[ai][bj][m][1] + bv[bj][1];
                    if (ACT == 1) { f32x2 a = gelu_pk((f32x2){v0[0], v0[1]}), b = gelu_pk((f32x2){v0[2], v0[3]}), c = gelu_pk((f32x2){v1[0], v1[1]}), d = gelu_pk((f32x2){v1[2], v1[3]});
                        v0 = (f32x4){a.x, a.y, b.x, b.y}; v1 = (f32x4){c.x, c.y, d.x, d.y}; }
                    v0 = v0 * sc; v1 = v1 * sc; u32x4 w; w.x = cvt_pk_bf16(v0[0], v0[1]); w.y = cvt_pk_bf16(v0[2], v0[3]); w.z = cvt_pk_bf16(v1[0], v1[1]); w.w = cvt_pk_bf16(v1[2], v1[3]);
                    *(u32x4*)(rowp + bj * HALF) = w; } }
    }
};

typedef int i32x4 __attribute__((ext_vector_type(4))); typedef int i32x8 __attribute__((ext_vector_type(8)));
__device__ __forceinline__ i32x8 cat16(bf16x8 lo, bf16x8 hi) { const i32x4 a = __builtin_bit_cast(i32x4, lo), b = __builtin_bit_cast(i32x4, hi); return __builtin_shufflevector(a, b, 0, 1, 2, 3, 4, 5, 6, 7); }
__device__ __forceinline__ void mfma_f8_acc(f32x4& acc, const i32x8& b, const i32x8& a, int sc) {
    asm volatile("v_mfma_scale_f32_16x16x128_f8f6f4 %0, %1, %2, %0, %3, %3 op_sel_hi:[0,0,0]" : "+v"(acc) : "v"(b), "v"(a), "v"(sc)); }
template <class Epi, class Sched, bool ALIGN_EPI = false, bool SP2 = false, bool FP8 = false>
__device__ __forceinline__ void gemm_phase(PG8_LAS unsigned char* lds, const Gemm g, const Sched& S, const Epi& E) {
    const int tid = threadIdx.x, wid = __builtin_amdgcn_readfirstlane(tid >> 6), lane = tid & 63, wr = wid >> 2, wc = wid & 3, fr = lane & 15, fq = lane >> 4;
    const int K = g.K, nt = K / BK;
    unsigned voffA[2], voffB[2];
#pragma unroll
    for (int i = 0; i < 2; ++i) { int R, C; stage_rc(tid * 16 + i * 8192, R, C); const int Rb = Epi::PERM ? ((R & ~31) + perm32(R & 31)) : R;
        voffA[i] = (unsigned)(R * K + C) * 2u; voffB[i] = (unsigned)(Rb * K + C) * 2u; }
    const size_t kstep = (size_t)(BK * 2);
    const size_t hstep = (size_t)HALF * K * 2;
    const size_t tstep = 2 * hstep;
    const unsigned ldsw = (unsigned)wid * 1024u;
    const int aoff = FP8 ? lds_byte(wr * 64 + fr, 16 * fq) : lds_byte(wr * 64 + fr, fq * 8), boff = FP8 ? lds_byte(wc * 32 + fr, 16 * fq) : lds_byte(wc * 32 + fr, fq * 8);
    constexpr int KOFF = FP8 ? 16 : 1024;
#define PG8_SA(b, h) (((b) * 2 + (h)) * HTB)
#define PG8_SB(b, h) ((4 + (b) * 2 + (h)) * HTB)
#define PG8_STAGE(bufoff, gbase, voff) do { _Pragma("unroll") for (int _i = 0; _i < 2; ++_i) \
        __builtin_amdgcn_global_load_lds((const unsigned*)((const char*)(gbase) + (voff)[_i]), (PG8_LAS unsigned*)(lds + (bufoff) + ldsw + _i * 8192), 16, 0, 0); } while (0)
#define PG8_LDA(dst, b, h) do { _Pragma("unroll") for (int m = 0; m < 4; ++m) _Pragma("unroll") for (int k = 0; k < 2; ++k) dst[m][k] = *(const PG8_LAS bf16x8*)(lds + PG8_SA(b, h) + aoff + m * 2048 + k * KOFF); } while (0)
#define PG8_LDB(dst, b, h) do { _Pragma("unroll") for (int n = 0; n < 2; ++n) _Pragma("unroll") for (int k = 0; k < 2; ++k) dst[n][k] = *(const PG8_LAS bf16x8*)(lds + PG8_SB(b, h) + boff + n * 2048 + k * KOFF); } while (0)
#define PG8_MMA(ai, bj, At, Bt) do { __builtin_amdgcn_s_setprio(1); _Pragma("unroll") for (int m = 0; m < 4; ++m) _Pragma("unroll") for (int n = 0; n < 2; ++n) { \
        if constexpr (FP8) mfma_f8_acc(acc[ai][bj][m][n], cat16(Bt[n][0], Bt[n][1]), cat16(At[m][0], At[m][1]), f8scale); \
        else { _Pragma("unroll") for (int k = 0; k < 2; ++k) acc[ai][bj][m][n] = __builtin_amdgcn_mfma_f32_16x16x32_bf16(Bt[n][k], At[m][k], acc[ai][bj][m][n], 0, 0, 0); } } __builtin_amdgcn_s_setprio(0); } while (0)
#define PG8_WAIT_V(n) asm volatile("s_waitcnt vmcnt(" #n ")" ::: "memory")
#define PG8_WAIT_L(n) asm volatile("s_waitcnt lgkmcnt(" #n ")" ::: "memory")
#define PG8_BAR __builtin_amdgcn_s_barrier()
#define PG8_SCHED __builtin_amdgcn_sched_barrier(0)
    Unit cur, nxt; int ui = 0;
    if (!S.next(0, cur)) return;
    f32x4 acc[2][2][4][2];
#pragma unroll
    for (int a = 0; a < 2; ++a)
#pragma unroll
        for (int b = 0; b < 2; ++b)
#pragma unroll
            for (int m = 0; m < 4; ++m)
#pragma unroll
                for (int n = 0; n < 2; ++n) acc[a][b][m][n] = (f32x4){0.f, 0.f, 0.f, 0.f};
    int f8scale = 0x7F7F7F7F; asm volatile("" : "+v"(f8scale));
    bf16x8 At[4][2], B0[2][2], B1[2][2];
    const char* cA = (const char*)g.A + (size_t)cur.pm * tstep; const char* cB = (const char*)g.Bt + (size_t)cur.pn * tstep + (size_t)cur.e * g.bstride;
    S.a_ready(cur);
    if constexpr (SP2) {
        PG8_STAGE(PG8_SB(0, 0), cB, voffB); PG8_STAGE(PG8_SB(0, 1), cB + hstep, voffB); PG8_STAGE(PG8_SA(0, 0), cA, voffA); PG8_STAGE(PG8_SA(0, 1), cA + hstep, voffA);
        if (wr == 1) PG8_BAR;
        PG8_WAIT_V(2); PG8_BAR;
        PG8_STAGE(PG8_SB(1, 0), cB + kstep, voffB); PG8_STAGE(PG8_SA(1, 0), cA + kstep, voffA); PG8_STAGE(PG8_SB(1, 1), cB + hstep + kstep, voffB);
        PG8_WAIT_V(6); PG8_BAR;
    } else {
        PG8_STAGE(PG8_SB(0, 0), cB, voffB); PG8_STAGE(PG8_SA(0, 0), cA, voffA); PG8_STAGE(PG8_SB(0, 1), cB + hstep, voffB); PG8_STAGE(PG8_SA(0, 1), cA + hstep, voffA);
        if (wr == 1) PG8_BAR;
        PG8_WAIT_V(4); PG8_BAR;
        PG8_STAGE(PG8_SB(1, 0), cB + kstep, voffB); PG8_STAGE(PG8_SA(1, 0), cA + kstep, voffA); PG8_STAGE(PG8_SB(1, 1), cB + hstep + kstep, voffB);
        PG8_WAIT_V(6); PG8_BAR;
    }
    for (;;) {
        const bool has_next = S.next(ui + 1, nxt);
        const char* nA = has_next ? (const char*)g.A + (size_t)nxt.pm * tstep : cA; const char* nB = has_next ? (const char*)g.Bt + (size_t)nxt.pn * tstep + (size_t)nxt.e * g.bstride : cB;
        for (int t = 0; t < nt; t += 2) {
            const bool last = (t == nt - 2);
            const char* a1 = cA + (size_t)(t + 1) * kstep;
            const char* a2 = last ? nA : cA + (size_t)(t + 2) * kstep; const char* b2 = last ? nB : cB + (size_t)(t + 2) * kstep;
            const char* a3 = a2 + kstep; const char* b3 = b2 + kstep;
            if (last && has_next) S.a_ready(nxt);
            if constexpr (SP2) {
            PG8_LDB(B0, 0, 0); PG8_LDB(B1, 0, 1); PG8_SCHED; PG8_LDA(At, 0, 0); PG8_STAGE(PG8_SA(1, 1), a1 + hstep, voffA);
            PG8_WAIT_V(8); PG8_WAIT_L(0); PG8_BAR; PG8_MMA(0, 0, At, B0); PG8_MMA(0, 1, At, B1); PG8_BAR; PG8_SCHED;
            PG8_LDA(At, 0, 1); PG8_STAGE(PG8_SB(0, 0), b2, voffB); PG8_STAGE(PG8_SB(0, 1), b2 + hstep, voffB); PG8_STAGE(PG8_SA(0, 0), a2, voffA);
            PG8_WAIT_V(8); PG8_WAIT_L(0); PG8_BAR; PG8_MMA(1, 0, At, B0); PG8_MMA(1, 1, At, B1); PG8_BAR; PG8_SCHED;
            PG8_LDB(B0, 1, 0); PG8_LDB(B1, 1, 1); PG8_SCHED; PG8_LDA(At, 1, 0); PG8_STAGE(PG8_SA(0, 1), a2 + hstep, voffA);
            PG8_WAIT_V(8); PG8_WAIT_L(0); PG8_BAR; PG8_MMA(0, 0, At, B0); PG8_MMA(0, 1, At, B1); PG8_BAR; PG8_SCHED;
            PG8_LDA(At, 1, 1); PG8_STAGE(PG8_SB(1, 0), b3, voffB); PG8_STAGE(PG8_SB(1, 1), b3 + hstep, voffB); PG8_STAGE(PG8_SA(1, 0), a3, voffA);
            PG8_WAIT_V(8); PG8_WAIT_L(0); PG8_BAR; PG8_MMA(1, 0, At, B0); PG8_MMA(1, 1, At, B1); PG8_BAR; PG8_SCHED;
            } else {
            PG8_LDB(B0, 0, 0); PG8_SCHED; PG8_LDA(At, 0, 0); PG8_STAGE(PG8_SA(1, 1), a1 + hstep, voffA);
            PG8_WAIT_L(8); PG8_BAR; PG8_WAIT_L(0); PG8_MMA(0, 0, At, B0); PG8_BAR; PG8_SCHED;
            PG8_LDB(B1, 0, 1); PG8_STAGE(PG8_SB(0, 0), b2, voffB);
            PG8_BAR; PG8_WAIT_L(0); PG8_MMA(0, 1, At, B1); PG8_BAR;
            PG8_LDA(At, 0, 1); PG8_STAGE(PG8_SA(0, 0), a2, voffA);
            PG8_BAR; PG8_WAIT_L(0); PG8_MMA(1, 0, At, B0); PG8_BAR; PG8_SCHED;
            PG8_STAGE(PG8_SB(0, 1), b2 + hstep, voffB);
            PG8_WAIT_V(6); PG8_BAR; PG8_MMA(1, 1, At, B1); PG8_BAR;
            PG8_LDB(B0, 1, 0); PG8_SCHED; PG8_LDA(At, 1, 0); PG8_STAGE(PG8_SA(0, 1), a2 + hstep, voffA);
            PG8_WAIT_L(8); PG8_BAR; PG8_WAIT_L(0); PG8_MMA(0, 0, At, B0); PG8_BAR; PG8_SCHED;
            PG8_LDB(B1, 1, 1); PG8_STAGE(PG8_SB(1, 0), b3, voffB);
            PG8_BAR; PG8_WAIT_L(0); PG8_MMA(0, 1, At, B1); PG8_BAR;
            PG8_LDA(At, 1, 1); PG8_STAGE(PG8_SA(1, 0), a3, voffA);
            PG8_BAR; PG8_WAIT_L(0); PG8_MMA(1, 0, At, B0); PG8_BAR; PG8_SCHED;
            PG8_STAGE(PG8_SB(1, 1), b3 + hstep, voffB);
            PG8_WAIT_V(6); PG8_BAR; PG8_MMA(1, 1, At, B1); PG8_BAR;
            }
        }
        if constexpr (ALIGN_EPI) { if (wr == 0) PG8_BAR; }
        if constexpr (FP8) asm volatile("s_nop 15\n\ts_nop 15" : "+v"(acc[1][1][0][0]), "+v"(acc[1][1][0][1]), "+v"(acc[1][1][1][0]), "+v"(acc[1][1][1][1]), "+v"(acc[1][1][2][0]), "+v"(acc[1][1][2][1]), "+v"(acc[1][1][3][0]), "+v"(acc[1][1][3][1]));
        if constexpr (!Epi::AFTER_DRAIN) { E(acc, cur, wr, wc, fr, fq); S.done(cur); }
        if (!has_next) break;
#pragma unroll
        for (int a = 0; a < 2; ++a)
#pragma unroll
            for (int b = 0; b < 2; ++b)
#pragma unroll
                for (int m = 0; m < 4; ++m)
#pragma unroll
                    for (int n = 0; n < 2; ++n) acc[a][b][m][n] = (f32x4){0.f, 0.f, 0.f, 0.f};
        cur = nxt; cA = nA; cB = nB; ++ui;
        if constexpr (ALIGN_EPI) { if (wr == 1) PG8_BAR; }
    }
    PG8_WAIT_V(0);
    if constexpr (!ALIGN_EPI) { if (wr == 0) PG8_BAR; }
    PG8_BAR;
    if constexpr (Epi::AFTER_DRAIN) { E.fused(acc, cur, wr, wc, fr, fq, lds, wid, lane); S.done(cur); }
#undef PG8_SA
#undef PG8_SB
#undef PG8_STAGE
#undef PG8_LDA
#undef PG8_LDB
#undef PG8_MMA
#undef PG8_WAIT_V
#undef PG8_WAIT_L
#undef PG8_BAR
#undef PG8_SCHED
}
}

namespace pg8 {
struct EpiF32P {
    static constexpr bool PERM = false, AFTER_DRAIN = false;
    float* O; int ldc;
    __device__ __forceinline__ void operator()(const f32x4 (&acc)[2][2][4][2], const Unit& u, int wr, int wc, int fr, int fq) const {
        const int row0 = u.pm * BM + wr * 64 + fr, col0 = u.pn * BM + wc * 32 + 4 * fq;
#pragma unroll
        for (int ai = 0; ai < 2; ++ai)
#pragma unroll
            for (int m = 0; m < 4; ++m) { float* rowp = O + (size_t)(row0 + ai * HALF + m * 16) * ldc + col0;
#pragma unroll
                for (int bj = 0; bj < 2; ++bj)
#pragma unroll
                    for (int n = 0; n < 2; ++n) *(f32x4*)(rowp + bj * HALF + n * 16) = acc[ai][bj][m][n]; }
    }
};
struct EpiSwigluP {
    static constexpr bool PERM = true, AFTER_DRAIN = false;
    bf16_t* O; int ldc;
    __device__ __forceinline__ void operator()(const f32x4 (&acc)[2][2][4][2], const Unit& u, int wr, int wc, int fr, int fq) const {
        const int row0 = u.pm * BM + wr * 64 + fr, col0 = u.pn * HALF + wc * 32 + 8 * fq;
#pragma unroll
        for (int ai = 0; ai < 2; ++ai)
#pragma unroll
            for (int m = 0; m < 4; ++m) {
                float h[8];
#pragma unroll
                for (int n = 0; n < 2; ++n)
#pragma unroll
                    for (int j = 0; j < 4; ++j) { const float g = acc[ai][0][m][n][j], up = acc[ai][1][m][n][j];
                        h[4 * n + j] = g * up * __builtin_amdgcn_rcpf(1.0f + __builtin_amdgcn_exp2f(-1.4426950408889634f * g)); }
                u32x4 w; w.x = cvt_pk_bf16(h[0], h[1]); w.y = cvt_pk_bf16(h[2], h[3]); w.z = cvt_pk_bf16(h[4], h[5]); w.w = cvt_pk_bf16(h[6], h[7]);
                *(u32x4*)(O + (size_t)(row0 + ai * HALF + m * 16) * ldc + col0) = w; }
    }
};
struct EpiGateP {
    static constexpr bool PERM = true, AFTER_DRAIN = false;
    bf16_t* O; int ldc; const float* gate;
    __device__ __forceinline__ void operator()(const f32x4 (&acc)[2][2][4][2], const Unit& u, int wr, int wc, int fr, int fq) const {
        const int row0 = u.pm * BM + wr * 64 + fr, col0 = u.pn * BM + wc * 32 + 8 * fq;
#pragma unroll
        for (int ai = 0; ai < 2; ++ai)
#pragma unroll
            for (int m = 0; m < 4; ++m) { const int row = row0 + ai * HALF + m * 16; const float gt = gate[row]; bf16_t* rowp = O + (size_t)row * ldc + col0;
#pragma unroll
                for (int bj = 0; bj < 2; ++bj) { const f32x4 v0 = acc[ai][bj][m][0] * gt, v1 = acc[ai][bj][m][1] * gt;
                    u32x4 w; w.x = cvt_pk_bf16(v0[0], v0[1]); w.y = cvt_pk_bf16(v0[2], v0[3]); w.z = cvt_pk_bf16(v1[0], v1[1]); w.w = cvt_pk_bf16(v1[2], v1[3]);
                    *(u32x4*)(rowp + bj * HALF) = w; } }
    }
};
__device__ __forceinline__ unsigned pk4_fp8(float a, float b, float c, float d) {
    a = __builtin_fminf(__builtin_fmaxf(a, -448.f), 448.f); b = __builtin_fminf(__builtin_fmaxf(b, -448.f), 448.f);
    c = __builtin_fminf(__builtin_fmaxf(c, -448.f), 448.f); d = __builtin_fminf(__builtin_fmaxf(d, -448.f), 448.f);
    int w = 0; w = __builtin_amdgcn_cvt_pk_fp8_f32(a, b, w, false); w = __builtin_amdgcn_cvt_pk_fp8_f32(c, d, w, true); return (unsigned)w; }
struct EpiSwigluF8 {
    static constexpr bool PERM = true, AFTER_DRAIN = false;
    unsigned char* O; int ldc; float ws, hs;
    __device__ __forceinline__ void operator()(const f32x4 (&acc)[2][2][4][2], const Unit& u, int wr, int wc, int fr, int fq) const {
        const int row0 = u.pm * BM + wr * 64 + fr, col0 = u.pn * HALF + wc * 32 + 8 * fq;
#pragma unroll
        for (int ai = 0; ai < 2; ++ai)
#pragma unroll
            for (int m = 0; m < 4; ++m) {
                float h[8];
#pragma unroll
                for (int n = 0; n < 2; ++n)
#pragma unroll
                    for (int j = 0; j < 4; ++j) { const float g = acc[ai][0][m][n][j] * ws, up = acc[ai][1][m][n][j] * ws;
                        h[4 * n + j] = g * up * hs * __builtin_amdgcn_rcpf(1.0f + __builtin_amdgcn_exp2f(-1.4426950408889634f * g)); }
                typedef unsigned u32x2 __attribute__((ext_vector_type(2)));
                *(u32x2*)(O + (size_t)(row0 + ai * HALF + m * 16) * ldc + col0) = (u32x2){pk4_fp8(h[0], h[1], h[2], h[3]), pk4_fp8(h[4], h[5], h[6], h[7])}; }
    }
};
struct EpiGateS {
    static constexpr bool PERM = true, AFTER_DRAIN = false;
    bf16_t* O; int ldc; const float* gate; float sc;
    __device__ __forceinline__ void operator()(const f32x4 (&acc)[2][2][4][2], const Unit& u, int wr, int wc, int fr, int fq) const {
        const int row0 = u.pm * BM + wr * 64 + fr, col0 = u.pn * BM + wc * 32 + 8 * fq;
#pragma unroll
        for (int ai = 0; ai < 2; ++ai)
#pragma unroll
            for (int m = 0; m < 4; ++m) { const int row = row0 + ai * HALF + m * 16; const float gt = gate[row] * sc; bf16_t* rowp = O + (size_t)row * ldc + col0;
#pragma unroll
                for (int bj = 0; bj < 2; ++bj) { const f32x4 v0 = acc[ai][bj][m][0] * gt, v1 = acc[ai][bj][m][1] * gt;
                    u32x4 w; w.x = cvt_pk_bf16(v0[0], v0[1]); w.y = cvt_pk_bf16(v0[2], v0[3]); w.z = cvt_pk_bf16(v1[0], v1[1]); w.w = cvt_pk_bf16(v1[2], v1[3]);
                    *(u32x4*)(rowp + bj * HALF) = w; } }
    }
};
struct EpiQKV {
    static constexpr bool PERM = true, AFTER_DRAIN = false;
    bf16_t* O; int ldc; const float* rope; const float* qn; const float* kn; float qscale; float rms_eps;
    __device__ __forceinline__ void operator()(const f32x4 (&acc)[2][2][4][2], const Unit& u, int wr, int wc, int fr, int fq) const {
        const int hs = 4 * u.pn + wc;
        const bool isq = hs < 8 || (hs >= 24 && hs < 32), isk = (hs >= 8 && hs < 16) || hs == 32 || hs == 33, nrm = hs >= 24 && hs < 34;
        const bool rope_on = (isq || isk) && u.pm < 64;
        const float osc = isq ? qscale : 1.f;
        const bool first = fq < 2;
        f32x4 gv[2][2];
#pragma unroll
        for (int bj = 0; bj < 2; ++bj)
#pragma unroll
            for (int n = 0; n < 2; ++n) gv[bj][n] = nrm ? *(const f32x4*)((hs < 32 ? qn : kn) + 32 * bj + 8 * fq + 4 * n) : (f32x4){1.f, 1.f, 1.f, 1.f};
#pragma unroll
        for (int ai = 0; ai < 2; ++ai)
#pragma unroll
            for (int m = 0; m < 4; ++m) {
                const int row = u.pm * BM + ai * HALF + wr * 64 + m * 16 + fr;
                f32x4 v[2][2];
#pragma unroll
                for (int bj = 0; bj < 2; ++bj)
#pragma unroll
                    for (int n = 0; n < 2; ++n) v[bj][n] = acc[ai][bj][m][n];
                if (nrm) {
                    float ss = 0.f;
#pragma unroll
                    for (int bj = 0; bj < 2; ++bj)
#pragma unroll
                        for (int n = 0; n < 2; ++n) ss += (v[bj][n][0] * v[bj][n][0] + v[bj][n][1] * v[bj][n][1]) + (v[bj][n][2] * v[bj][n][2] + v[bj][n][3] * v[bj][n][3]);
                    ss += __shfl_xor(ss, 16); ss += __shfl_xor(ss, 32);
                    const float r = __builtin_amdgcn_rsqf(ss * (1.f / 64.f) + rms_eps);
#pragma unroll
                    for (int bj = 0; bj < 2; ++bj)
#pragma unroll
                        for (int n = 0; n < 2; ++n) v[bj][n] = v[bj][n] * r * gv[bj][n];
                }
                if (rope_on) {
                    const int t = row & 2047;
#pragma unroll
                    for (int bj = 0; bj < 2; ++bj) {
                        const int pos = bj ? (t & 63) : (t >> 6);
#pragma unroll
                        for (int n = 0; n < 2; ++n) {
                            const float* cp = rope + (size_t)(pos * 16 + 8 * (fq & 1) + 4 * n) * 2;
                            const f32x4 c01 = *(const f32x4*)cp, c23 = *(const f32x4*)(cp + 4);
                            const float cs[4] = {c01[0], c01[2], c23[0], c23[2]}, sn[4] = {c01[1], c01[3], c23[1], c23[3]};
#pragma unroll
                            for (int j = 0; j < 4; ++j) { const float x = v[bj][n][j], pr = __shfl_xor(x, 32); v[bj][n][j] = first ? x * cs[j] - pr * sn[j] : x * cs[j] + pr * sn[j]; }
                        }
                    }
                }
                bf16_t* rowp = O + (size_t)row * ldc + hs * 64 + 8 * fq;
#pragma unroll
                for (int bj = 0; bj < 2; ++bj) { const f32x4 v0 = v[bj][0] * osc, v1 = v[bj][1] * osc;
                    u32x4 w; w.x = cvt_pk_bf16(v0[0], v0[1]); w.y = cvt_pk_bf16(v0[2], v0[3]); w.z = cvt_pk_bf16(v1[0], v1[1]); w.w = cvt_pk_bf16(v1[2], v1[3]);
                    *(u32x4*)(rowp + 32 * bj) = w; }
            }
    }
};
struct GroupedOrder {
    int nMe, nN, ntot, G, c;
    __device__ void init(int nMe_, int nN_, int ne, int G_, int c_) { nMe = nMe_; nN = nN_; ntot = nMe_ * nN_ * ne; G = G_; c = c_; }
    __device__ bool next(int i, Unit& u) const {
        const int L = i * G + c; if (L >= ntot) return false;
        const int per = nMe * nN, e = L / per, rem = L - e * per;
        u.e = e; u.pn = rem / nMe; u.pm = e * nMe + (rem - u.pn * nMe); return true;
    }
    __device__ __forceinline__ void a_ready(const Unit&) const {}
    __device__ __forceinline__ void done(const Unit&) const {}
};
struct L1InOrder {
    StaticOrder so; int G, c;
    __device__ void init(int G_, int c_) { so.init(16384, 2048, G_, 0); G = G_; c = c_; }
    __device__ bool next(int i, Unit& u) const {
        const int L = i * G + c;
        if (L < 512) { StaticOrder t = so; t.G = 1; t.c = 0; return t.next(L, u); }
        if (L < 544) { const int l = L - 512; u.pm = 64 + (l >> 2); u.pn = 2 + (l & 3); u.e = 0; return true; }
        return false;
    }
    __device__ __forceinline__ void a_ready(const Unit&) const {}
    __device__ __forceinline__ void done(const Unit&) const {}
};
}

#include <hip/hip_bf16.h>
#include <cmath>
namespace attn_body {
using bf16=__hip_bfloat16;
using bf16x8=__attribute__((ext_vector_type(8)))short;
using s16x4=__attribute__((ext_vector_type(4)))short;
using f32x16=__attribute__((ext_vector_type(16)))float;
using u32x4=__attribute__((ext_vector_type(4)))unsigned;
constexpr int D=64,OPITCH=1024;
constexpr int NW=8,QBLK=32,QB=QBLK*NW,KVBLK=64;
__device__ __forceinline__ int crow(int r,int hi){return (r&3)+8*(r>>2)+4*hi;}
#define SBAR() __builtin_amdgcn_sched_barrier(0)
__device__ __forceinline__ void cmask(f32x16&p0,f32x16&p1,int jb,int qrel,int hi){
  const float NEG=-INFINITY; int kb=64*jb+4*hi;
  #pragma unroll
  for(int r=0;r<16;++r){int kv=kb+(r&3)+8*(r>>2); if(kv>qrel)p0[r]=NEG; if(kv+32>qrel)p1[r]=NEG;}
}

constexpr int NSLOT=3, SLOTB=8192;
constexpr int LDS_K=0, LDS_V=NSLOT*SLOTB, LDS_WS=2*NSLOT*SLOTB, LDS_OST=LDS_WS+NW*64*4, LDS_BYTES=LDS_OST+NW*4096;
constexpr float C2=0.125f*1.4426950408889634f;
__device__ __forceinline__ void glds16(const void*gsrc,unsigned lds_dst){unsigned keep;
  asm volatile("s_mov_b32 %0, m0\n\ts_mov_b32 m0, %2\n\ts_nop 0\n\tglobal_load_lds_dwordx4 %1, off\n\ts_mov_b32 m0, %0":"=&s"(keep):"v"(gsrc),"s"(lds_dst):"memory");}
__device__ __forceinline__ float max3f(float a,float b,float c){float r;asm("v_max3_f32 %0, %1, %2, %3":"=v"(r):"v"(a),"v"(b),"v"(c));return r;}
__device__ __forceinline__ float max2f(float a,float b){float r;asm("v_max_f32_e32 %0, %1, %2":"=v"(r):"v"(a),"v"(b));return r;}
__device__ __forceinline__ float fadd_s(float a,float b){float r;asm("v_add_f32_e32 %0, %1, %2":"=v"(r):"v"(a),"v"(b));return r;}
__device__ __forceinline__ float fsub_s(float a,float b){float r;asm("v_sub_f32_e32 %0, %1, %2":"=v"(r):"v"(a),"v"(b));return r;}
typedef float f32x2_t __attribute__((ext_vector_type(2))); typedef __bf16 bf16x2_t __attribute__((ext_vector_type(2)));
__device__ __forceinline__ unsigned cvtpk_s(float lo,float hi){f32x2_t v={lo,hi};bf16x2_t b=__builtin_convertvector(v,bf16x2_t);return __builtin_bit_cast(unsigned,b);}
#define WAIT_BAR(N) asm volatile("s_waitcnt vmcnt(" #N ") lgkmcnt(0)\n\ts_barrier":::"memory")

__device__ __forceinline__ void qkt(f32x16&p0,f32x16&p1,const char*Kslot,const bf16x8*qr,const f32x16&negm,int r32,int hi){
  const char*kb=Kslot+hi*1024+r32*16;
  #pragma unroll
  for(int d0=0;d0<4;++d0){
    const bf16x8 b0=*reinterpret_cast<const bf16x8*>(kb+d0*2048);
    const bf16x8 b1=*reinterpret_cast<const bf16x8*>(kb+d0*2048+512);
    if(d0==0){p0=__builtin_amdgcn_mfma_f32_32x32x16_bf16(b0,qr[0],negm,0,0,0);p1=__builtin_amdgcn_mfma_f32_32x32x16_bf16(b1,qr[0],negm,0,0,0);}
    else{p0=__builtin_amdgcn_mfma_f32_32x32x16_bf16(b0,qr[d0],p0,0,0,0);p1=__builtin_amdgcn_mfma_f32_32x32x16_bf16(b1,qr[d0],p1,0,0,0);}}
}
typedef __attribute__((address_space(3))) const char* lds_cptr;
typedef short v4i16_t __attribute__((ext_vector_type(4)));
__device__ __forceinline__ void kload8(bf16x8*kf,lds_cptr kp){
  kf[0]=*(const __attribute__((address_space(3))) bf16x8*)(kp);      kf[1]=*(const __attribute__((address_space(3))) bf16x8*)(kp+512);
  kf[2]=*(const __attribute__((address_space(3))) bf16x8*)(kp+2048); kf[3]=*(const __attribute__((address_space(3))) bf16x8*)(kp+2560);
  kf[4]=*(const __attribute__((address_space(3))) bf16x8*)(kp+4096); kf[5]=*(const __attribute__((address_space(3))) bf16x8*)(kp+4608);
  kf[6]=*(const __attribute__((address_space(3))) bf16x8*)(kp+6144); kf[7]=*(const __attribute__((address_space(3))) bf16x8*)(kp+6656);
}
__device__ __forceinline__ void kload2(bf16x8*kf,lds_cptr kp,int j){ kf[2*j]=*(const __attribute__((address_space(3))) bf16x8*)(kp+j*2048); kf[2*j+1]=*(const __attribute__((address_space(3))) bf16x8*)(kp+j*2048+512); }
__device__ __forceinline__ s16x4 vtr(lds_cptr p){ return __builtin_bit_cast(s16x4,__builtin_amdgcn_ds_read_tr16_b64_v4i16((__attribute__((address_space(3))) v4i16_t*)p)); }
__device__ __forceinline__ float rowmax(const f32x16&p0,const f32x16&p1){
  float a=max3f(p0[0],p0[1],p1[0]),b=max3f(p0[2],p0[3],p1[1]);a=max3f(a,p1[2],p1[3]);
  #pragma unroll
  for(int r=4;r<16;r+=4){a=max3f(a,p0[r],p0[r+1]);b=max3f(b,p0[r+2],p0[r+3]);a=max3f(a,p1[r],p1[r+1]);b=max3f(b,p1[r+2],p1[r+3]);}
  const float m=max2f(a,b);
  auto rr=__builtin_amdgcn_permlane32_swap(__float_as_uint(m),__float_as_uint(m),false,false);
  return max2f(__uint_as_float(rr[0]),__uint_as_float(rr[1]));
}
__device__ __forceinline__ void pv(f32x16*o,int vb,bf16x8 pa0,bf16x8 pa1,bf16x8 pa2,bf16x8 pa3){
  #pragma unroll
  for(int d0=0;d0<2;++d0){s16x4 lo[4],hi[4];
    #pragma unroll
    for(int ks=0;ks<4;++ks){
      asm volatile("ds_read_b64_tr_b16 %0,%1 offset:%c2":"=&v"(lo[ks]):"v"(vb),"i"(d0*4096+ks*1024):"memory");
      asm volatile("ds_read_b64_tr_b16 %0,%1 offset:%c2":"=&v"(hi[ks]):"v"(vb),"i"(d0*4096+ks*1024+512):"memory");}
    asm volatile("s_waitcnt lgkmcnt(0)":::"memory");SBAR();
    #define PK(k) (bf16x8){lo[k][0],lo[k][1],lo[k][2],lo[k][3],hi[k][0],hi[k][1],hi[k][2],hi[k][3]}
    o[d0]=__builtin_amdgcn_mfma_f32_32x32x16_bf16(pa0,PK(0),o[d0],0,0,0);
    o[d0]=__builtin_amdgcn_mfma_f32_32x32x16_bf16(pa1,PK(1),o[d0],0,0,0);
    o[d0]=__builtin_amdgcn_mfma_f32_32x32x16_bf16(pa2,PK(2),o[d0],0,0,0);
    o[d0]=__builtin_amdgcn_mfma_f32_32x32x16_bf16(pa3,PK(3),o[d0],0,0,0);
    #undef PK
  }
}

#ifndef ATTN_STORE16
#define ATTN_STORE16(p,v) (*(u32x4*)(p)=(v))
#endif
struct AU { const bf16* Qp; const bf16* Kp; const bf16* Vp; bf16* Op; int qrow0, lat_row0, ctx_row0, nlat_t, NT; };
struct NoMask { __device__ __forceinline__ void apply(f32x16&,f32x16&,int,int)const{} };
typedef __attribute__((address_space(3))) const float* lds_cfptr;
struct NAMask { lds_cfptr tb0; int r, rs, rs_min, cb;
  __device__ __forceinline__ void apply(f32x16&p0,f32x16&p1,int t,int hi)const{
    if(t<4)return;
    const int kr=rs_min+t-4; const float NEG=-INFINITY;
    if((unsigned)(kr-rs)>7u){
      #pragma unroll
      for(int i=0;i<16;++i){p0[i]=NEG;p1[i]=NEG;}
      return; }
    const lds_cfptr tb=tb0+(kr-r+7)*32+4*hi;
    #pragma unroll
    for(int i=0;i<16;++i){ const int k0=(i&3)+8*(i>>2); const int d0=cb+k0, d1=cb+k0+32;
      const float b0=tb[k0], b1=tb[k0+32];
      p0[i]=((unsigned)d0<=15u)?p0[i]+b0:NEG; p1[i]=((unsigned)d1<=15u)?p1[i]+b1:NEG; }
  }
};
template<int THRL,int PITCH,class MaskT> __device__ __forceinline__ void attn_unit(const AU& u,char*shm,const MaskT& mk){
  const int tid=threadIdx.x,lane=tid&63,r32=lane&31,hi=lane>>5; const int wid=__builtin_amdgcn_readfirstlane(tid>>6);
  const bf16*Qw=u.Qp+(long)(u.qrow0+wid*QBLK)*PITCH;
  const bf16*Kh=u.Kp,*Vh=u.Vp;
  const unsigned lds0=(unsigned)(uintptr_t)shm;
  float*wsf=(float*)(shm+LDS_WS)+wid*64;
  const bf16*ksrc=Kh+(long)lane*PITCH+wid*8;
  const bf16*vsrc=Vh+(long)(16*(wid&3)+(lane>>2))*PITCH+(wid>>2)*32+(lane&3)*8;
  const unsigned kdst=lds0+LDS_K+wid*1024, vdst=lds0+LDS_V+wid*1024;
  #define TROW(t) ((long)((t)<u.nlat_t?u.lat_row0+KVBLK*(t):u.ctx_row0+KVBLK*((t)-u.nlat_t))*PITCH)
  #define DMA_K(t,slot) glds16(ksrc+TROW(t),(unsigned)__builtin_amdgcn_readfirstlane(kdst+(slot)))
  #define DMA_V(t,slot) glds16(vsrc+TROW(t),(unsigned)__builtin_amdgcn_readfirstlane(vdst+(slot)))
  const int vb0=(int)(lds0+LDS_V)+((lane>>4)&1)*32+(lane&3)*8+(4*hi+((lane&15)>>2))*64;
  const char*Kbase=shm+LDS_K; bf16x8 kf[8];
  const lds_cptr shm3=(lds_cptr)shm; const lds_cptr kp0=shm3+LDS_K+hi*1024+r32*16; const lds_cptr vp0=shm3+LDS_V+((lane>>4)&1)*32+(lane&3)*8+(4*hi+((lane&15)>>2))*64;
  const int NT=u.NT;
  DMA_K(0,0);DMA_V(0,0);DMA_K(1,SLOTB);
  bf16x8 qr[4];
  #pragma unroll
  for(int d0=0;d0<4;++d0)qr[d0]=*reinterpret_cast<const bf16x8*>(&Qw[(long)r32*PITCH+d0*16+hi*8]);
  float mhat=0.f,l_reg=0.f;f32x16 o[2];o[0]=f32x16{};o[1]=f32x16{};f32x16 negm=f32x16{};asm volatile("":"+v"(negm));
  #define CMASK(P0,P1,t) mk.apply(P0,P1,(t),hi)
  bool resc=false;
  #define START(P0,P1) do{ const float rm=rowmax(P0,P1); resc=false; \
    { const float dl=rm; mhat=fadd_s(mhat,dl); \
      _Pragma("unroll") for(int r=0;r<16;++r){P0[r]=fsub_s(P0[r],dl);P1[r]=fsub_s(P1[r],dl);} \
      _Pragma("unroll") for(int r=0;r<16;++r)negm[r]=-mhat; asm volatile("":"+v"(negm)); } \
    _Pragma("unroll") for(int r=0;r<16;++r)P0[r]=__builtin_amdgcn_exp2f(P0[r]); }while(0)
  #define RESC() do{ if(resc){ asm volatile("s_waitcnt lgkmcnt(0)":::"memory"); \
      _Pragma("unroll") for(int d_=0;d_<2;++d_) _Pragma("unroll") for(int r=0;r<16;++r)o[d_][r]*=wsf[crow(r,hi)]; } }while(0)
  f32x16 pA0,pA1,pB0,pB1;
  int sl_prev=0,sl_cur=0,sl_next=SLOTB;
  #define ROT() do{sl_prev=sl_cur;sl_cur=sl_next;sl_next=(sl_next==(NSLOT-1)*SLOTB)?0:sl_next+SLOTB;}while(0)
  DMA_K(2,2*SLOTB);
  WAIT_BAR(3);
  qkt(pA0,pA1,Kbase,qr,negm,r32,hi);asm volatile("s_nop 15\n\ts_nop 7":"+v"(pA0),"+v"(pA1));CMASK(pA0,pA1,0);
  START(pA0,pA1);
  _Pragma("unroll") for(int r=0;r<16;++r)pA1[r]=__builtin_amdgcn_exp2f(pA1[r]);
  WAIT_BAR(0);
  DMA_K(3,0);DMA_V(1,SLOTB);
  ROT();
  kload8(kf,kp0+sl_cur);
  WAIT_BAR(2);
  s16x4 vlo[8],vhi[8]; u32x4 pw0,pw1,pw2,pw3;
  #define PKW(P,B) cvtpk_s(P[B],P[B+1])
  #define PAF(k) __builtin_bit_cast(bf16x8,pw##k)
  #define VFR(i) (bf16x8){vlo[i][0],vlo[i][1],vlo[i][2],vlo[i][3],vhi[i][0],vhi[i][1],vhi[i][2],vhi[i][3]}
  #define PIN(x) asm volatile("":"+v"(x))
  #define MX3(a,b,c) __builtin_fmaxf(__builtin_fmaxf((a),(b)),(c))
  #define GAPA(MF,A0,A1,A2,A3,W0,W1,PW) do{ MF; sacc+=A0; sacc+=A1; sacc+=A2; sacc+=A3; PIN(sacc); W0; W1; PIN(PW); SBAR(); }while(0)
  #define EX(v) __builtin_amdgcn_exp2f(v)
  #define GAPB(MF,X,B) do{ MF; X[B]=EX(X[B]); X[B+1]=EX(X[B+1]); X[B+2]=EX(X[B+2]); X[B+3]=EX(X[B+3]); PIN(X); SBAR(); }while(0)
  #define VRD(i) do{ vlo[i]=vtr(vp_+(((i)>>2)*4096+((i)&3)*1024)); vhi[i]=vtr(vp_+(((i)>>2)*4096+((i)&3)*1024+512)); }while(0)
  #define KRD(G,j) do{ if(G){ kload2(kf,kp0+sl_next,j); SBAR(); } }while(0)
  #define STEP(C0,C1,P0,P1,t,GK,GV,GL) do{ SBAR(); \
    const lds_cptr vp_=vp0+sl_prev; \
    VRD(0); SBAR(); float sacc=(P0[0]+P0[1]); \
    GAPA(C0=__builtin_amdgcn_mfma_f32_32x32x16_bf16(kf[0],qr[0],negm,0,0,0), P0[2],P0[3],P0[4],P0[5],     pw0[0]=PKW(P0,0), pw0[1]=PKW(P0,2), pw0); \
    VRD(4); SBAR(); GAPA(C1=__builtin_amdgcn_mfma_f32_32x32x16_bf16(kf[1],qr[0],negm,0,0,0), P0[6],P0[7],P0[8],P0[9],     pw0[2]=PKW(P0,4), pw0[3]=PKW(P0,6), pw0); \
    VRD(1); SBAR(); GAPA(C0=__builtin_amdgcn_mfma_f32_32x32x16_bf16(kf[2],qr[1],C0,0,0,0),   P0[10],P0[11],P0[12],P0[13], pw1[0]=PKW(P0,8), pw1[1]=PKW(P0,10), pw1); \
    VRD(5); SBAR(); GAPA(C1=__builtin_amdgcn_mfma_f32_32x32x16_bf16(kf[3],qr[1],C1,0,0,0),   P0[14],P0[15],P1[0],P1[1],   pw1[2]=PKW(P0,12),pw1[3]=PKW(P0,14), pw1); \
    VRD(2); SBAR(); GAPA(C0=__builtin_amdgcn_mfma_f32_32x32x16_bf16(kf[4],qr[2],C0,0,0,0),   P1[2],P1[3],P1[4],P1[5],     pw2[0]=PKW(P1,0), pw2[1]=PKW(P1,2), pw2); \
    VRD(6); SBAR(); GAPA(C1=__builtin_amdgcn_mfma_f32_32x32x16_bf16(kf[5],qr[2],C1,0,0,0),   P1[6],P1[7],P1[8],P1[9],     pw2[2]=PKW(P1,4), pw2[3]=PKW(P1,6), pw2); \
    VRD(3); SBAR(); GAPA(C0=__builtin_amdgcn_mfma_f32_32x32x16_bf16(kf[6],qr[3],C0,0,0,0),   P1[10],P1[11],P1[12],P1[13], pw3[0]=PKW(P1,8), pw3[1]=PKW(P1,10), pw3); \
    VRD(7); SBAR(); GAPA(C1=__builtin_amdgcn_mfma_f32_32x32x16_bf16(kf[7],qr[3],C1,0,0,0),   P1[14],P1[15],0.f,0.f,       pw3[2]=PKW(P1,12),pw3[3]=PKW(P1,14), pw3); \
    l_reg+=sacc; \
    if(GK){DMA_K((t)+3,sl_cur);} if(GV){DMA_V((t)+1,sl_next);} \
    CMASK(C0,C1,t); \
    { float a=MX3(C0[0],C0[1],C1[0]),b=MX3(C0[2],C0[3],C1[1]); a=MX3(a,C1[2],C1[3]); \
      _Pragma("unroll") for(int r=4;r<16;r+=4){a=MX3(a,C0[r],C0[r+1]);b=MX3(b,C0[r+2],C0[r+3]);a=MX3(a,C1[r],C1[r+1]);b=MX3(b,C1[r+2],C1[r+3]);} \
      float rm=__builtin_fmaxf(a,b); { auto rr=__builtin_amdgcn_permlane32_swap(__float_as_uint(rm),__float_as_uint(rm),false,false); rm=__builtin_fmaxf(__uint_as_float(rr[0]),__uint_as_float(rr[1])); } \
      resc=false; \
      if(__builtin_expect(__any(rm>(float)THRL),0)){ const float dl=__builtin_fmaxf(rm,0.f); mhat+=dl; \
        _Pragma("unroll") for(int r=0;r<16;++r){C0[r]-=dl;C1[r]-=dl;} \
        _Pragma("unroll") for(int r=0;r<16;++r)negm[r]=-mhat; asm volatile("":"+v"(negm)); \
        const float f=__builtin_amdgcn_exp2f(-dl); l_reg*=f; if(hi==0)wsf[r32]=f; resc=true; } } \
    SBAR(); \
    GAPB(o[0]=__builtin_amdgcn_mfma_f32_32x32x16_bf16(PAF(0),VFR(0),o[0],0,0,0), C0,0); \
    GAPB(o[1]=__builtin_amdgcn_mfma_f32_32x32x16_bf16(PAF(0),VFR(4),o[1],0,0,0), C0,4); \
    KRD(GL,0); GAPB(o[0]=__builtin_amdgcn_mfma_f32_32x32x16_bf16(PAF(1),VFR(1),o[0],0,0,0), C0,8); \
    KRD(GL,1); GAPB(o[1]=__builtin_amdgcn_mfma_f32_32x32x16_bf16(PAF(1),VFR(5),o[1],0,0,0), C0,12); \
    KRD(GL,2); GAPB(o[0]=__builtin_amdgcn_mfma_f32_32x32x16_bf16(PAF(2),VFR(2),o[0],0,0,0), C1,0); \
    KRD(GL,3); GAPB(o[1]=__builtin_amdgcn_mfma_f32_32x32x16_bf16(PAF(2),VFR(6),o[1],0,0,0), C1,4); \
    GAPB(o[0]=__builtin_amdgcn_mfma_f32_32x32x16_bf16(PAF(3),VFR(3),o[0],0,0,0), C1,8); \
    GAPB(o[1]=__builtin_amdgcn_mfma_f32_32x32x16_bf16(PAF(3),VFR(7),o[1],0,0,0), C1,12); \
    }while(0)
  int t=1;
  #undef CMASK
  #define CMASK(P0,P1,t) mk.apply(P0,P1,(t),hi)
  for(;t+5<NT;t+=2){
    STEP(pB0,pB1,pA0,pA1,t,true,true,true);     WAIT_BAR(2); RESC(); ROT();
    STEP(pA0,pA1,pB0,pB1,t+1,true,true,true);   WAIT_BAR(2); RESC(); ROT();
  }
  #undef CMASK
  #define CMASK(P0,P1,t) mk.apply(P0,P1,(t),hi)
  #define ENDW(tt) do{ if((tt)+3<NT){WAIT_BAR(2);} else if((tt)+2<NT){WAIT_BAR(1);} else {WAIT_BAR(0);} }while(0)
  for(;t+1<NT;t+=2){
    STEP(pB0,pB1,pA0,pA1,t,(t+3<NT),(t+1<NT),(t+1<NT));       ENDW(t);   RESC(); ROT();
    STEP(pA0,pA1,pB0,pB1,t+1,(t+4<NT),(t+2<NT),(t+2<NT));     ENDW(t+1); RESC(); ROT();
  }
  STEP(pB0,pB1,pA0,pA1,NT-1,false,false,false); RESC();
  { float sacc=pB0[0]+pB0[1]; _Pragma("unroll") for(int r=2;r<16;++r)sacc+=pB0[r]; _Pragma("unroll") for(int r=0;r<16;++r)sacc+=pB1[r]; l_reg+=sacc;
    pw0=(u32x4){PKW(pB0,0),PKW(pB0,2),PKW(pB0,4),PKW(pB0,6)};pw1=(u32x4){PKW(pB0,8),PKW(pB0,10),PKW(pB0,12),PKW(pB0,14)};pw2=(u32x4){PKW(pB1,0),PKW(pB1,2),PKW(pB1,4),PKW(pB1,6)};pw3=(u32x4){PKW(pB1,8),PKW(pB1,10),PKW(pB1,12),PKW(pB1,14)};
    SBAR(); pv(o,vb0+sl_cur,PAF(0),PAF(1),PAF(2),PAF(3)); }
  #undef PKW
  #undef PAF
  #undef VFR
  #undef PIN
  #undef MX3
  #undef GAPA
  #undef GAPB
  #undef EX
  #undef VRD
  #undef KRD
  #undef STEP
  #undef ENDW
  {auto rr=__builtin_amdgcn_permlane32_swap(__float_as_uint(l_reg),__float_as_uint(l_reg),false,false);l_reg=__uint_as_float(rr[0])+__uint_as_float(rr[1]);}
  if(hi==0)wsf[32+r32]=l_reg;asm volatile("s_waitcnt lgkmcnt(0)":::"memory");
  float rli[16];
  #pragma unroll
  for(int r=0;r<16;++r)rli[r]=__builtin_amdgcn_rcpf(wsf[32+crow(r,hi)]);
  bf16*Ow=u.Op+(long)(u.qrow0+wid*QBLK)*OPITCH;
  { bf16*stg=(bf16*)(shm+LDS_OST)+wid*2048;
    #pragma unroll
    for(int r=0;r<16;++r){const int orow=crow(r,hi);
      #pragma unroll
      for(int d0=0;d0<2;++d0)stg[orow*64+d0*32+r32]=__float2bfloat16(o[d0][r]*rli[r]);}
    asm volatile("s_waitcnt lgkmcnt(0)":::"memory");
    #pragma unroll
    for(int i=0;i<4;++i){const int row=i*8+(lane>>3),ch=lane&7; const u32x4 v=*(const u32x4*)(stg+row*64+ch*8); ATTN_STORE16(Ow+(long)row*OPITCH+ch*8,v);} }
  asm volatile("s_waitcnt lgkmcnt(0)\n\ts_barrier":::"memory");
  #undef DMA_K
  #undef TROW
  #undef DMA_V
  #undef CMASK
  #undef START
  #undef RESC
  #undef ROT
}
constexpr int ATTN_LDS_BYTES=LDS_BYTES;
#undef SBAR
#undef WAIT_BAR
}

struct Params { const float* in[26]; float* out; unsigned char* ws; int ph_lo, ph_hi; };
struct Ctx { LAS unsigned char* lds; int tid, lane, wave, vcu, G, gw, NGW; };
enum { I_X = 0, I_C, I_CTX, I_CCTX, I_ADAW, I_ADAB, I_LNG, I_LNB, I_W0IN, I_W0OUT, I_LQ1, I_LK1, I_LQ2, I_LK2, I_SUBLN, I_QN, I_KN,
       I_W1IN, I_W1OUT, I_RPB, I_POOLW, I_POOLS, I_ROUTER, I_WG, I_WU, I_WD };

__device__ __forceinline__ const float* mod_row(const Params& p, int layer, int row) {
    return (const float*)(p.ws + WS_MOD) + (size_t)(layer * 9 + (row < LAT ? (row >> 11) : 8)) * 6144;
}

__device__ __forceinline__ void ph_prologue(const Params& p, const Ctx& c) {
    const float* cin = p.in[I_C]; const float* cctx = p.in[I_CCTX]; const float* ada_w = p.in[I_ADAW]; const float* ada_b = p.in[I_ADAB];
    float* MOD = (float*)(p.ws + WS_MOD);
    LAS float* sc = (LAS float*)c.lds;
    LAS float* red = sc + 9 * 1024;
    for (int i = c.tid; i < 9 * 1024; i += 512) { const float v = i < 8192 ? cin[i] : cctx[i - 8192]; sc[i] = v / (1.f + expf(-v)); }
    __syncthreads();
    for (int u = c.vcu; u < 192; u += c.G) {
        const int layer = u / 96, j0 = (u - layer * 96) * 64;
        float acc[9];
#pragma unroll
        for (int m = 0; m < 9; ++m) acc[m] = 0.f;
        const float* wp = ada_w + (size_t)layer * 1024 * 6144 + (size_t)(128 * c.wave) * 6144 + j0 + c.lane;
#pragma unroll 1
        for (int kb = 0; kb < 128; kb += 32) {
            float wv[32];
#pragma unroll
            for (int i = 0; i < 32; ++i) wv[i] = wp[(size_t)(kb + i) * 6144];
#pragma unroll
            for (int i4 = 0; i4 < 8; ++i4)
#pragma unroll
                for (int m = 0; m < 9; ++m) { const f32x4 sv = *(const LAS f32x4*)(sc + m * 1024 + 128 * c.wave + kb + 4 * i4);
                    acc[m] += sv.x * wv[4 * i4] + sv.y * wv[4 * i4 + 1] + sv.z * wv[4 * i4 + 2] + sv.w * wv[4 * i4 + 3]; }
        }
#pragma unroll
        for (int m = 0; m < 9; ++m) red[(c.wave * 9 + m) * 64 + c.lane] = acc[m];
        __syncthreads();
        for (int o = c.tid; o < 576; o += 512) {
            const int m = o >> 6, j = o & 63; float s2 = 0.f;
#pragma unroll
            for (int w = 0; w < 8; ++w) s2 += red[(w * 9 + m) * 64 + j];
            MOD[(size_t)(layer * 9 + m) * 6144 + j0 + j] = s2 + ada_b[layer * 6144 + j0 + j];
        }
        __syncthreads();
    }
    if (c.vcu == 0) {
        f32x2* R = (f32x2*)(p.ws + WS_ROPE);
        for (int i = c.tid; i < 1024; i += 512) {
            const int pos = i >> 4, f = i & 15;
            const float inv = exp2f(-(float)f * (13.287712379549449f / 16.f));
            const float a = (float)pos * inv;
            const float k = rintf(a * 0.15915494309189535f);
            float rr = fmaf(-k, 6.28125f, a); rr = fmaf(-k, 1.9353071795864769e-3f, rr);
            R[i] = (f32x2){__cosf(rr), __sinf(rr)};
        }
    }
}


__device__ __forceinline__ void transpose_item(const float* W, int ldw, int k0, int n0, bf16* WT, int Kd, int drow0, LAS float* scr, int lane) {
#pragma unroll 8
    for (int i = 0; i < 32; ++i) { const int kk = 2 * i + (lane >> 5); scr[kk * 33 + (lane & 31)] = W[(size_t)(k0 + kk) * ldw + n0 + (lane & 31)]; }
    asm volatile("s_waitcnt lgkmcnt(0)" ::: "memory");
    const int ch = lane & 7;
#pragma unroll
    for (int j = 0; j < 4; ++j) { const int n = (lane >> 3) + 8 * j; const LAS float* sp = scr + (8 * ch) * 33 + n;
        v4u o; o.x = pk2(sp[0 * 33], sp[1 * 33]); o.y = pk2(sp[2 * 33], sp[3 * 33]); o.z = pk2(sp[4 * 33], sp[5 * 33]); o.w = pk2(sp[6 * 33], sp[7 * 33]);
        *(v4u*)(WT + (size_t)(drow0 + n) * Kd + k0 + 8 * ch) = o; }
    asm volatile("s_waitcnt lgkmcnt(0)" ::: "memory");
}
__device__ __forceinline__ void transpose_item8(const float* W, int ldw, int k0, int n0, unsigned char* WT8, int Kd, int drow0, float scale, LAS float* scr, int lane) {
#pragma unroll 8
    for (int i = 0; i < 32; ++i) { const int kk = 2 * i + (lane >> 5); scr[kk * 33 + (lane & 31)] = W[(size_t)(k0 + kk) * ldw + n0 + (lane & 31)]; }
    asm volatile("s_waitcnt lgkmcnt(0)" ::: "memory");
    const int n = lane >> 1, hf = lane & 1; const LAS float* sp = scr + (32 * hf) * 33 + n;
    v4u o0, o1;
    o0.x = pg8::pk4_fp8(sp[0 * 33] * scale, sp[1 * 33] * scale, sp[2 * 33] * scale, sp[3 * 33] * scale);     o0.y = pg8::pk4_fp8(sp[4 * 33] * scale, sp[5 * 33] * scale, sp[6 * 33] * scale, sp[7 * 33] * scale);
    o0.z = pg8::pk4_fp8(sp[8 * 33] * scale, sp[9 * 33] * scale, sp[10 * 33] * scale, sp[11 * 33] * scale);   o0.w = pg8::pk4_fp8(sp[12 * 33] * scale, sp[13 * 33] * scale, sp[14 * 33] * scale, sp[15 * 33] * scale);
    o1.x = pg8::pk4_fp8(sp[16 * 33] * scale, sp[17 * 33] * scale, sp[18 * 33] * scale, sp[19 * 33] * scale); o1.y = pg8::pk4_fp8(sp[20 * 33] * scale, sp[21 * 33] * scale, sp[22 * 33] * scale, sp[23 * 33] * scale);
    o1.z = pg8::pk4_fp8(sp[24 * 33] * scale, sp[25 * 33] * scale, sp[26 * 33] * scale, sp[27 * 33] * scale); o1.w = pg8::pk4_fp8(sp[28 * 33] * scale, sp[29 * 33] * scale, sp[30 * 33] * scale, sp[31 * 33] * scale);
    unsigned char* dst = WT8 + (size_t)(drow0 + n) * Kd + k0 + 32 * hf;
    *(v4u*)dst = o0; *(v4u*)(dst + 16) = o1;
    asm volatile("s_waitcnt lgkmcnt(0)" ::: "memory");
}
struct TBlk { const float* src; unsigned char* dst; int ldw, Kd, gu, which; float scale; };
__device__ __forceinline__ TBlk tblk_decode(const Params& p, int blk) {
    const int ie = blk / 96, q = blk - ie * 96, layer = ie >> 4, e = ie & 15, which = q >> 5, idx = q & 31;
    TBlk t; t.which = which;
    if (which < 2) { const int kb = idx & 3, nb = idx >> 2, k0 = 256 * kb, n0 = 256 * nb;
        t.src = (which == 0 ? p.in[I_WG] : p.in[I_WU]) + (size_t)ie * DM * FF + (size_t)k0 * FF + n0; t.ldw = FF; t.Kd = DM; t.scale = W8_GU; t.gu = 1;
        t.dst = p.ws + WS_WGU + (size_t)layer * WS_MOE_LSTRIDE + (size_t)e * 4096 * DM + (size_t)(2 * nb) * 256 * DM + k0; }
    else { const int kb = idx & 7, nb = idx >> 3, k0 = 256 * kb, n0 = 256 * nb;
        t.src = p.in[I_WD] + (size_t)ie * FF * DM + (size_t)k0 * DM + n0; t.ldw = DM; t.Kd = FF; t.scale = W8_DN; t.gu = 0;
        t.dst = p.ws + WS_WDN + (size_t)layer * WS_MOE_LSTRIDE + (size_t)e * DM * FF + (size_t)n0 * FF + k0; }
    return t;
}
__device__ __forceinline__ void tblk_load(const TBlk& t, f32x4 (&v)[16], int wave, int lane, int hf) {
    const float* sp = t.src + (size_t)(32 * wave + 16 * hf) * t.ldw + 4 * lane;
#pragma unroll
    for (int i = 0; i < 16; ++i) v[i] = __builtin_nontemporal_load((const f32x4*)(sp + (size_t)i * t.ldw));
}
constexpr int TPITCH = 264;
__device__ __forceinline__ void tblk_pack(const TBlk& t, const f32x4 (&v)[16], LAS unsigned char* T, int wave, int lane, int hf) {
#pragma unroll
    for (int i = 0; i < 4; ++i) {
        const f32x4 r0 = v[4 * i] * t.scale, r1 = v[4 * i + 1] * t.scale, r2 = v[4 * i + 2] * t.scale, r3 = v[4 * i + 3] * t.scale;
#pragma unroll
        for (int j = 0; j < 4; ++j) { int w = 0; w = __builtin_amdgcn_cvt_pk_fp8_f32(r0[j], r1[j], w, false); w = __builtin_amdgcn_cvt_pk_fp8_f32(r2[j], r3[j], w, true);
            *(LAS unsigned*)(T + (64 * j + lane) * TPITCH + 32 * wave + 16 * hf + 4 * i) = (unsigned)w; }
    }
}
__device__ __forceinline__ void tblk_writeout(const TBlk& t, const LAS unsigned char* T, int tid) {
#pragma unroll
    for (int it = 0; it < 8; ++it) { const int idx = it * 512 + tid, n = idx >> 4, ch = idx & 15, rho = (n & 3) * 64 + (n >> 2);
        const LAS unsigned char* sp = T + rho * TPITCH + 16 * ch;
        const v2u a = *(const LAS v2u*)sp, b2 = *(const LAS v2u*)(sp + 8);
        const int drow = t.gu ? ((n >> 7) * 256 + (n & 127) + t.which * 128) : n;
        __builtin_nontemporal_store((v4u){a.x, a.y, b2.x, b2.y}, (v4u*)(t.dst + (size_t)drow * t.Kd + 16 * ch)); }
}
__device__ __forceinline__ void moe_transpose_blocks(const Params& p, const Ctx& c, int blk0, int blk1, int widx, int nw) {
    LAS unsigned char* T = c.lds;
    f32x4 va[16], vb[16];
    int blk = blk0 + widx;
    if (blk >= blk1) return;
    TBlk t = tblk_decode(p, blk);
    tblk_load(t, va, c.wave, c.lane, 0);
#pragma unroll 1
    for (; blk < blk1; blk += nw) {
        tblk_load(t, vb, c.wave, c.lane, 1);
        tblk_pack(t, va, T, c.wave, c.lane, 0);
        const int nb = blk + nw;
        TBlk tn = tblk_decode(p, nb < blk1 ? nb : blk0);
        if (nb < blk1) tblk_load(tn, va, c.wave, c.lane, 0);
        tblk_pack(t, vb, T, c.wave, c.lane, 1);
        __syncthreads();
        tblk_writeout(t, T, c.tid);
        __syncthreads();
        t = tn;
    }
}
__device__ __forceinline__ void tail_transposes(const Params& p, const Ctx& c, int first_idle, int my, int blk0, int nblk) {
    if (!TAIL_TRANSPOSE || c.G != 256 || my < first_idle) return;
    moe_transpose_blocks(p, c, blk0, blk0 + nblk, my - first_idle, c.G - first_idle);
}
__device__ __forceinline__ void ph_transposes(const Params& p, const Ctx& c) {
    LAS float* scr = (LAS float*)(c.lds + c.wave * 16384);
    constexpr int I0 = 16 * 72, I1 = 16 * 32, I2 = 16 * 64, I3 = 16 * 32, ISM = I0 + I1 + I2 + I3;
    for (int r0 = c.gw; r0 < ISM; r0 += c.NGW) {
        int r = r0;
        if (r < I0) { const int n0 = 32 * (r % 72), drow = FUSE_QKV ? ((n0 >> 8) * 256 + 128 * ((n0 >> 5) & 1) + 32 * ((n0 >> 6) & 3)) : n0;
            transpose_item(p.in[I_W0IN], EIN, 64 * (r / 72), n0, (bf16*)(p.ws + WS_W0IN), DM, drow, scr, c.lane); continue; } r -= I0;
        if (r < I1) { transpose_item(p.in[I_W0OUT], DM, 64 * (r / 32), 32 * (r % 32), (bf16*)(p.ws + WS_W0OUT), DM, 32 * (r % 32), scr, c.lane); continue; } r -= I1;
        if (r < I2) { transpose_item(p.in[I_W1IN], OIN, 64 * (r / 64), 32 * (r % 64), (bf16*)(p.ws + WS_W1IN), DM, 32 * (r % 64), scr, c.lane); continue; } r -= I2;
        transpose_item(p.in[I_W1OUT], DM, 64 * (r / 32), 32 * (r % 32), (bf16*)(p.ws + WS_W1OUT), DM, 32 * (r % 32), scr, c.lane);
    }
    static_assert(MOE_FP8, "the expert-weight transposes write e4m3 copies");
    __syncthreads();
    moe_transpose_blocks(p, c, 0, (TAIL_TRANSPOSE && c.G == 256) ? 1536 : 3072, c.vcu, c.G);
}

__device__ __forceinline__ void ph_modulate0(const Params& p, const Ctx& c) {
    bf16* HB = (bf16*)(p.ws + WS_HB);
    for (int row = c.gw; row < NTOK; row += c.NGW) {
        const float* src = row < LAT ? p.in[I_X] + (size_t)row * DM : p.in[I_CTX] + (size_t)(row - LAT) * DM;
        const float* mod = mod_row(p, 0, row);
#pragma unroll
        for (int j = 0; j < 4; ++j) {
            const int col = 4 * c.lane + 256 * j;
            const f32x4 v = *(const f32x4*)(src + col), sh = *(const f32x4*)(mod + col), s = *(const f32x4*)(mod + 1024 + col);
            const f32x4 h = v * (s + 1.f) + sh;
            *(v2u*)(HB + (size_t)row * DM + col) = (v2u){pk2(h.x, h.y), pk2(h.z, h.w)};
        }
    }
}

struct NG { const bf16* A; int lda; const float* W0; const float* W1; int ldw; size_t wstride; int Mb; int row_begin, row_end, col_begin, col_end, K; };
template <int NB, class Epi>
__device__ __forceinline__ void ngemm(const NG& g, const Ctx& c, const Epi& epi) {
    const int nmt = (g.row_end - g.row_begin) / 32, nnt = (g.col_end - g.col_begin) / 32;
    const int l31 = c.lane & 31, lh = c.lane >> 5;
    for (int t = c.gw; t < nmt * nnt; t += c.NGW) {
        const int mt = t / nnt, nt = t % nnt;
        const int row0 = g.row_begin + mt * 32, col0 = g.col_begin + nt * 32;
        const int e = row0 / g.Mb;
        const bf16* ap = g.A + (size_t)(row0 + l31) * g.lda + lh;
        const float* bp0 = g.W0 + (size_t)e * g.wstride + (size_t)lh * g.ldw + col0 + l31;
        const float* bp1 = NB == 2 ? g.W1 + (size_t)e * g.wstride + (size_t)lh * g.ldw + col0 + l31 : nullptr;
        f32x16 acc0 = {}, acc1 = {};
#pragma unroll 8
        for (int k = 0; k < g.K; k += 2) {
            const float a = bf2f((unsigned)ap[k]);
            const float b0 = bp0[(size_t)k * g.ldw];
            acc0 = __builtin_amdgcn_mfma_f32_32x32x2f32(a, b0, acc0, 0, 0, 0);
            if (NB == 2) { const float b1 = bp1[(size_t)k * g.ldw]; acc1 = __builtin_amdgcn_mfma_f32_32x32x2f32(a, b1, acc1, 0, 0, 0); }
        }
#pragma unroll
        for (int r = 0; r < 16; ++r) {
            const int row = row0 + (r & 3) + 8 * (r >> 2) + 4 * lh, col = col0 + l31;
            epi(row, col, acc0[r], acc1[r]);
        }
    }
}
struct EpiF32 { float* O; int ldc; __device__ __forceinline__ void operator()(int row, int col, float v0, float) const { O[(size_t)row * ldc + col] = v0; } };
struct EpiBf { bf16* O; int ldc; int scale_cols; float sc; __device__ __forceinline__ void operator()(int row, int col, float v0, float) const { O[(size_t)row * ldc + col] = (bf16)f2bf(col < scale_cols ? v0 * sc : v0); } };
struct EpiSwiglu { bf16* O; __device__ __forceinline__ void operator()(int row, int col, float g, float u) const { const float s = g / (1.f + __expf(-g)); O[(size_t)row * FF + col] = (bf16)f2bf(s * u); } };
struct EpiGate { bf16* O; const float* gate; __device__ __forceinline__ void operator()(int row, int col, float v0, float) const { O[(size_t)row * DM + col] = (bf16)f2bf(v0 * gate[row]); } };

template <bool F32IN> __device__ __forceinline__ void ph_qkv_post(const Params& p, const Ctx& c) {
    const float* PF = (const float*)(p.ws + WS_PF);
    bf16* QKV = (bf16*)(p.ws + WS_QKV);
    const f32x2* R = (const f32x2*)(p.ws + WS_ROPE);
    const float* qn = p.in[I_QN]; const float* kn = p.in[I_KN];
    const int d = c.lane;
    const float qg = qn[d], kg = kn[d];
    for (int row = c.gw; row < NTOK; row += c.NGW) {
        const bool lat = row < LAT;
        const int t = row & 2047;
        const int pos = (d < 32) ? (t >> 6) : (t & 63);
        const f32x2 cs = R[pos * 16 + (d & 15)];
        const bool first = (d & 16) == 0;
        float vv[36];
#pragma unroll
        for (int hs = 0; hs < 36; ++hs) vv[hs] = F32IN ? PF[(size_t)row * EIN + hs * 64 + d] : bf2f((unsigned)QKV[(size_t)row * EIN + hs * 64 + d]);
#pragma unroll
        for (int hs = 0; hs < 36; ++hs) {
            float v = vv[hs];
            const bool isq = hs < 8 || (hs >= 24 && hs < 32);
            const bool isk = (hs >= 8 && hs < 16) || hs == 32 || hs == 33;
            const bool nrm = hs >= 24 && hs < 34;
            if (nrm) { const float ss = wave_sum(v * v); v = v * rsqrtf(ss * (1.f / 64.f) + RMS_EPS) * (hs < 32 ? qg : kg); }
            if ((isq || isk) && lat) { const float pr = __shfl_xor(v, 16); v = first ? v * cs.x - pr * cs.y : v * cs.x + pr * cs.y; }
            if (isq) v *= C2;
            QKV[(size_t)row * EIN + hs * 64 + d] = (bf16)f2bf(v);
        }
    }
}

__device__ __forceinline__ void ph_attn0_naive(const Params& p, const Ctx& c) {
    const bf16* QKV = (const bf16*)(p.ws + WS_QKV);
    bf16* CC = (bf16*)(p.ws + WS_CC);
    bf16* AO = (bf16*)(p.ws + WS_AO);
    LAS float* Ks = (LAS float*)c.lds;
    LAS float* Vs = Ks + 4096;
    for (int u = c.vcu; u < 960; u += c.G) {
        const bool isctx = u >= 768;
        int b, vh, qrow, ntiles; bool active = true;
        if (!isctx) { b = u / 96; const int r = u % 96; vh = r >> 2; qrow = b * SEQ + (r & 3) * 512 + c.tid; ntiles = 36; }
        else { const int uu = u - 768; b = uu / 24; vh = uu % 24; qrow = LAT + b * NCTX + (c.tid & 255); active = c.tid < 256; ntiles = 4; }
        int qcol, kcol, vcol;
        if (vh < 16) { const int a = vh >> 2, s = (vh >> 1) & 1, half = vh & 1; qcol = a * 128 + s * 64; kcol = 512 + a * 128 + s * 64; vcol = 1024 + a * 128 + half * 64; }
        else { const int h = vh - 16; qcol = 1536 + h * 64; kcol = 2048 + (h >> 2) * 64; vcol = 2176 + (h >> 2) * 64; }
        float q[64], o[64];
#pragma unroll
        for (int i = 0; i < 8; ++i) { const v4u w = *(const v4u*)(QKV + (size_t)qrow * EIN + qcol + 8 * i); unpack8(w, q + 8 * i); }
#pragma unroll
        for (int i = 0; i < 64; ++i) o[i] = 0.f;
        float m = -1e30f, l = 0.f;
        for (int t = 0; t < ntiles; ++t) {
            const int krow0 = isctx ? LAT + b * NCTX + 64 * t : (t < 32 ? b * SEQ + 64 * t : LAT + b * NCTX + 64 * (t - 32));
            __syncthreads();
            { const int r = c.tid >> 3, ch = c.tid & 7; float f[8];
              const v4u kw = *(const v4u*)(QKV + (size_t)(krow0 + r) * EIN + kcol + ch * 8); unpack8(kw, f);
#pragma unroll
              for (int j = 0; j < 8; ++j) Ks[r * 64 + ch * 8 + j] = f[j];
              const v4u vw = *(const v4u*)(QKV + (size_t)(krow0 + r) * EIN + vcol + ch * 8); unpack8(vw, f);
#pragma unroll
              for (int j = 0; j < 8; ++j) Vs[r * 64 + ch * 8 + j] = f[j]; }
            __syncthreads();
            if (active) {
                for (int kk = 0; kk < 64; ++kk) {
                    float s = 0.f;
#pragma unroll
                    for (int dd = 0; dd < 64; ++dd) s += q[dd] * Ks[kk * 64 + dd];
                    const float mn = fmaxf(m, s), al = exp2f(m - mn), pp = exp2f(s - mn);
                    l = l * al + pp; m = mn;
#pragma unroll
                    for (int dd = 0; dd < 64; ++dd) o[dd] = o[dd] * al + pp * Vs[kk * 64 + dd];
                }
            }
        }
        if (active) {
            const float rl = 1.f / l;
            bf16* dst = vh < 16 ? AO + (size_t)qrow * DM + (vh >> 2) * 256 + ((vh >> 1) & 1) * 128 + (vh & 1) * 64 : CC + (size_t)qrow * DM + 512 + (vh - 16) * 64;
            {
#pragma unroll
                for (int i = 0; i < 8; ++i) *(v4u*)(dst + 8 * i) = (v4u){pk2(o[8 * i] * rl, o[8 * i + 1] * rl), pk2(o[8 * i + 2] * rl, o[8 * i + 3] * rl), pk2(o[8 * i + 4] * rl, o[8 * i + 5] * rl), pk2(o[8 * i + 6] * rl, o[8 * i + 7] * rl)}; }
        }
    }
}


__device__ __forceinline__ void attn_combine_rows(const Params& p, const Ctx& c, int row0, int a, float lam, float g0, float g1) {
    const bf16* AO = (const bf16*)(p.ws + WS_AO); bf16* CC = (bf16*)(p.ws + WS_CC);
    asm volatile("s_waitcnt vmcnt(0)" ::: "memory");
#pragma unroll 1
    for (int rb = 0; rb < 32; rb += 8) {
        float x0[8], x1[8];
#pragma unroll
        for (int j = 0; j < 8; ++j) { const bf16* src = AO + (size_t)(row0 + rb + j) * DM + a * 256;
            x0[j] = bf2f((unsigned)src[c.lane]) - lam * bf2f((unsigned)src[128 + c.lane]); x1[j] = bf2f((unsigned)src[64 + c.lane]) - lam * bf2f((unsigned)src[192 + c.lane]); }
#pragma unroll
        for (int j = 0; j < 8; ++j) { const float ss = wave_sum(x0[j] * x0[j] + x1[j] * x1[j]); const float r = rsqrtf(ss * (1.f / 128.f) + RMS_EPS);
            bf16* dst = CC + (size_t)(row0 + rb + j) * DM + a * 128;
            dst[c.lane] = (bf16)f2bf(x0[j] * r * g0); dst[64 + c.lane] = (bf16)f2bf(x1[j] * r * g1); }
    }
}
__device__ __forceinline__ void ph_attn0_fast(const Params& p, const Ctx& c, char* lds_generic) {
    typedef attn_body::bf16 abf;
    const abf* Q = (const abf*)(p.ws + WS_QKV); abf* CCb = (abf*)(p.ws + WS_CC); abf* AOb = (abf*)(p.ws + WS_AO);
    const float d1 = wave_sum(p.in[I_LQ1][c.lane] * p.in[I_LK1][c.lane]), d2 = wave_sum(p.in[I_LQ2][c.lane] * p.in[I_LK2][c.lane]);
    const float lam = expf(d1) - expf(d2) + LAM_INIT;
    const float g0 = p.in[I_SUBLN][c.lane] * (1.f - LAM_INIT), g1 = p.in[I_SUBLN][c.lane + 64] * (1.f - LAM_INIT);
    for (int v = c.vcu; v < 256; v += c.G) {
#pragma unroll 1
        for (int step = 0; step < 10; ++step) {
            attn_body::AU u; int vh; bool ctxu = false;
            if (step < 4) { const int b = v >> 5, a = (v >> 3) & 3; vh = 4 * a + step; u.qrow0 = b * SEQ + (v & 7) * 256; u.lat_row0 = b * SEQ; u.ctx_row0 = LAT + b * NCTX; }
            else if (step < 6) { const int U = (step - 4) * 256 + v, b = U >> 6; vh = 16 + ((U >> 3) & 7); u.qrow0 = b * SEQ + (U & 7) * 256; u.lat_row0 = b * SEQ; u.ctx_row0 = LAT + b * NCTX; }
            else { ctxu = true; int b;
                if (v < 32) { b = v >> 2; vh = 4 * (v & 3) + (step - 6); }
                else if (v < 96 && step == 6) { b = (v - 32) >> 3; vh = 16 + ((v - 32) & 7); }
                else break;
                u.qrow0 = LAT + b * NCTX; u.lat_row0 = 0; u.ctx_row0 = LAT + b * NCTX; }
            if (!ctxu) { u.nlat_t = 32; u.NT = 36; } else { u.nlat_t = 0; u.NT = 4; }
            int qcol, kcol, vcol; abf* op;
            if (vh < 16) { const int a = vh >> 2, s = (vh >> 1) & 1, half = vh & 1; qcol = a * 128 + s * 64; kcol = 512 + a * 128 + s * 64; vcol = 1024 + a * 128 + half * 64; op = AOb + a * 256 + s * 128 + half * 64; }
            else { const int h = vh - 16; qcol = 1536 + h * 64; kcol = 2048 + (h >> 2) * 64; vcol = 2176 + (h >> 2) * 64; op = CCb + 512 + h * 64; }
            u.Qp = Q + qcol; u.Kp = Q + kcol; u.Vp = Q + vcol; u.Op = op;
            attn_body::attn_unit<8, EIN, attn_body::NoMask>(u, lds_generic, attn_body::NoMask{});
            if (vh < 16 && (vh & 3) == 3) attn_combine_rows(p, c, u.qrow0 + c.wave * 32, vh >> 2, lam, g0, g1);
        }
    }
    tail_transposes(p, c, 96, c.vcu, 1536 + 120, 320);
}

__device__ __forceinline__ void ph_attn_combine(const Params& p, const Ctx& c) {
    const bf16* AO = (const bf16*)(p.ws + WS_AO);
    bf16* CC = (bf16*)(p.ws + WS_CC);
    const float d1 = wave_sum(p.in[I_LQ1][c.lane] * p.in[I_LK1][c.lane]);
    const float d2 = wave_sum(p.in[I_LQ2][c.lane] * p.in[I_LK2][c.lane]);
    const float lam = expf(d1) - expf(d2) + LAM_INIT;
    const float g0 = p.in[I_SUBLN][c.lane] * (1.f - LAM_INIT), g1 = p.in[I_SUBLN][c.lane + 64] * (1.f - LAM_INIT);
    for (int it = c.gw; it < NTOK * 4; it += c.NGW) {
        const int row = it >> 2, a = it & 3;
        const bf16* src = AO + (size_t)row * DM + a * 256;
        const float x0 = bf2f((unsigned)src[c.lane]) - lam * bf2f((unsigned)src[128 + c.lane]), x1 = bf2f((unsigned)src[64 + c.lane]) - lam * bf2f((unsigned)src[192 + c.lane]);
        const float ss = wave_sum(x0 * x0 + x1 * x1);
        const float r = rsqrtf(ss * (1.f / 128.f) + RMS_EPS);
        CC[(size_t)row * DM + a * 128 + c.lane] = (bf16)f2bf(x0 * r * g0);
        CC[(size_t)row * DM + a * 128 + 64 + c.lane] = (bf16)f2bf(x1 * r * g1);
    }
}

__device__ __forceinline__ f32x4 unpack4(const v2u w) { return (f32x4){bf2f(w.x & 0xffffu), __uint_as_float(w.x & 0xffff0000u), bf2f(w.y & 0xffffu), __uint_as_float(w.y & 0xffff0000u)}; }
__device__ __forceinline__ float reduce_logits(const f32x4 (&lg)[4], int lane) {
    float w8[8], w4[4], w2[2], w1;
    { const bool hi = (lane & 32) != 0;
#pragma unroll
      for (int i = 0; i < 8; ++i) { const float a0 = lg[i >> 2][i & 3], a1 = lg[2 + (i >> 2)][i & 3]; const float keep = hi ? a1 : a0, send = hi ? a0 : a1; w8[i] = keep + __shfl_xor(send, 32); } }
    { const bool hi = (lane & 16) != 0;
#pragma unroll
      for (int i = 0; i < 4; ++i) { const float keep = hi ? w8[i + 4] : w8[i], send = hi ? w8[i] : w8[i + 4]; w4[i] = keep + __shfl_xor(send, 16); } }
    { const bool hi = (lane & 8) != 0;
#pragma unroll
      for (int i = 0; i < 2; ++i) { const float keep = hi ? w4[i + 2] : w4[i], send = hi ? w4[i] : w4[i + 2]; w2[i] = keep + __shfl_xor(send, 8); } }
    { const bool hi = (lane & 4) != 0; const float keep = hi ? w2[1] : w2[0], send = hi ? w2[0] : w2[1]; w1 = keep + __shfl_xor(send, 4); }
    w1 += __shfl_xor(w1, 2); w1 += __shfl_xor(w1, 1);
    return w1;
}
__device__ __forceinline__ void ph_ln1_router(const Params& p, const Ctx& c, int layer) {
    const bf16* Y = (const bf16*)(p.ws + WS_Y);
    bf16* XS = (bf16*)(p.ws + WS_XS);
    bf16* HB = (bf16*)(p.ws + WS_HB);
    float* AFF = (float*)(p.ws + WS_AFF);
    const float* lng = p.in[I_LNG] + (size_t)(layer * 2 + 0) * DM; const float* lnb = p.in[I_LNB] + (size_t)(layer * 2 + 0) * DM;
    const float* router = p.in[I_ROUTER] + (size_t)layer * DM * NE;
    LAS f32x4* R = (LAS f32x4*)c.lds;
    for (int idx = c.tid; idx < 4096; idx += 512) { const int e4 = idx & 3, k = idx >> 2, ln = (k & 255) >> 2, q = k & 3, j = k >> 8;
        R[((j * 4 + q) * 4 + e4) * 64 + ln] = *(const f32x4*)(router + (size_t)k * NE + 4 * e4); }
    __syncthreads();
    const int nrows = layer == 0 ? NTOK : LAT;
    const int lane = c.lane;
    for (int row = 2 * c.gw; row < nrows; row += 2 * c.NGW) {
        const float* mod = mod_row(p, layer, row);
        f32x4 va[4], vb[4]; float sa = 0.f, sb = 0.f;
#pragma unroll
        for (int j = 0; j < 4; ++j) { const int col = 4 * lane + 256 * j;
            f32x4 xa, xb;
            if (layer == 0) { const float* xin = row < LAT ? p.in[I_X] + (size_t)row * DM : p.in[I_CTX] + (size_t)(row - LAT) * DM; xa = *(const f32x4*)(xin + col); xb = *(const f32x4*)(xin + DM + col); }
            else { xa = unpack4(*(const v2u*)(XS + (size_t)row * DM + col)); xb = unpack4(*(const v2u*)(XS + (size_t)(row + 1) * DM + col)); }
            const f32x4 g1 = *(const f32x4*)(mod + 2048 + col);
            va[j] = xa * ALPHA + g1 * unpack4(*(const v2u*)(Y + (size_t)row * DM + col));
            vb[j] = xb * ALPHA + g1 * unpack4(*(const v2u*)(Y + (size_t)(row + 1) * DM + col));
            sa += (va[j].x + va[j].y) + (va[j].z + va[j].w); sb += (vb[j].x + vb[j].y) + (vb[j].z + vb[j].w); }
        const float meana = wave_sum(sa) * (1.f / DM), meanb = wave_sum(sb) * (1.f / DM); float qa = 0.f, qb = 0.f;
#pragma unroll
        for (int j = 0; j < 4; ++j) { va[j] = va[j] - meana; vb[j] = vb[j] - meanb;
            qa += (va[j].x * va[j].x + va[j].y * va[j].y) + (va[j].z * va[j].z + va[j].w * va[j].w); qb += (vb[j].x * vb[j].x + vb[j].y * vb[j].y) + (vb[j].z * vb[j].z + vb[j].w * vb[j].w); }
        const float rstda = 1.f / sqrtf(wave_sum(qa) * (1.f / DM) + LN_EPS), rstdb = 1.f / sqrtf(wave_sum(qb) * (1.f / DM) + LN_EPS);
        f32x4 lga[4], lgb[4];
#pragma unroll
        for (int e = 0; e < 4; ++e) { lga[e] = (f32x4){0.f, 0.f, 0.f, 0.f}; lgb[e] = (f32x4){0.f, 0.f, 0.f, 0.f}; }
#pragma unroll
        for (int j = 0; j < 4; ++j) { const int col = 4 * lane + 256 * j;
            const f32x4 g = *(const f32x4*)(lng + col), bb = *(const f32x4*)(lnb + col), sc = *(const f32x4*)(mod + 4096 + col) + 1.f, sh = *(const f32x4*)(mod + 3072 + col);
            const f32x4 x1a = va[j] * rstda * g + bb, x1b = vb[j] * rstdb * g + bb;
            *(v2u*)(XS + (size_t)row * DM + col) = (v2u){pk2(x1a.x, x1a.y), pk2(x1a.z, x1a.w)};
            *(v2u*)(XS + (size_t)(row + 1) * DM + col) = (v2u){pk2(x1b.x, x1b.y), pk2(x1b.z, x1b.w)};
            const f32x4 hma = x1a * sc + sh, hmb = x1b * sc + sh;
            if (MOE_FP8) { *(unsigned*)((unsigned char*)HB + (size_t)row * DM + col) = pg8::pk4_fp8(hma.x, hma.y, hma.z, hma.w);
                           *(unsigned*)((unsigned char*)HB + (size_t)(row + 1) * DM + col) = pg8::pk4_fp8(hmb.x, hmb.y, hmb.z, hmb.w); }
            else { *(v2u*)(HB + (size_t)row * DM + col) = (v2u){pk2(hma.x, hma.y), pk2(hma.z, hma.w)}; *(v2u*)(HB + (size_t)(row + 1) * DM + col) = (v2u){pk2(hmb.x, hmb.y), pk2(hmb.z, hmb.w)}; }
            asm volatile("" ::: "memory");
#pragma unroll
            for (int q = 0; q < 4; ++q) { const float ha = hma[q], hb = hmb[q];
#pragma unroll
                for (int e4 = 0; e4 < 4; ++e4) { const f32x4 rw = R[((j * 4 + q) * 4 + e4) * 64 + lane]; lga[e4] += rw * ha; lgb[e4] += rw * hb; } } }
        const float wa = reduce_logits(lga, lane), wb = reduce_logits(lgb, lane);
        float mxa = wa, mxb = wb;
#pragma unroll
        for (int o = 4; o < 64; o <<= 1) { mxa = fmaxf(mxa, __shfl_xor(mxa, o)); mxb = fmaxf(mxb, __shfl_xor(mxb, o)); }
        const float exa = expf(wa - mxa), exb = expf(wb - mxb); float dena = exa, denb = exb;
#pragma unroll
        for (int o = 4; o < 64; o <<= 1) { dena += __shfl_xor(dena, o); denb += __shfl_xor(denb, o); }
        if ((lane & 3) == 0) { const int e = ((lane >> 5) & 1) * 8 + ((lane >> 4) & 1) * 4 + ((lane >> 3) & 1) * 2 + ((lane >> 2) & 1);
            AFF[(size_t)row * NE + e] = exa / dena; AFF[(size_t)(row + 1) * NE + e] = exb / denb; }
    }
}

__device__ __forceinline__ void ph_topk(const Params& p, const Ctx& c, int layer) {
    const float* AFF = (const float*)(p.ws + WS_AFF);
    int* INV = (int*)(p.ws + WS_INV);
    float* GATE = (float*)(p.ws + WS_GATE);
    const bf16* HB = (const bf16*)(p.ws + WS_HB);
    bf16* XG = (bf16*)(p.ws + WS_XG);
    LAS unsigned* hist = (LAS unsigned*)c.lds;
    LAS unsigned* ctl = hist + 256;
    LAS int* sel = (LAS int*)(c.lds + 2048);
    const int MR = layer == 0 ? MR0 : MR1;
    const int ntasks = layer == 0 ? 256 : 128;
    const int lane = c.lane;
    for (int task = c.vcu; task < ntasks; task += c.G) {
        int set, e, n, cap, rowbase, slotbase;
        if (task < 128) { set = task >> 4; e = task & 15; n = SEQ; cap = 256; rowbase = set * SEQ; slotbase = set * 256; }
        else { const int t2 = task - 128; set = t2 >> 4; e = t2 & 15; n = NCTX; cap = 32; rowbase = LAT + set * NCTX; slotbase = 2048 + set * 32; }
        const bool valid = 4 * c.tid < n;
        unsigned key[4];
#pragma unroll
        for (int q = 0; q < 4; ++q) key[q] = valid ? __float_as_uint(AFF[(size_t)(rowbase + 4 * c.tid + q) * NE + e]) : 0u;
        unsigned prefix = 0u, need = (unsigned)cap;
#pragma unroll 1
        for (int pass = 0; pass < 4; ++pass) {
            const int shift = 24 - 8 * pass;
            if (c.tid < 256) hist[c.tid] = 0u;
            __syncthreads();
            if (valid) {
#pragma unroll
                for (int q = 0; q < 4; ++q) if (pass == 0 || (key[q] >> (shift + 8)) == (prefix >> (shift + 8))) __hip_atomic_fetch_add(&hist[(key[q] >> shift) & 255u], 1u, __ATOMIC_RELAXED, __HIP_MEMORY_SCOPE_WORKGROUP);
            }
            __syncthreads();
            if (c.wave == 0) {
                const unsigned h0 = hist[4 * lane], h1 = hist[4 * lane + 1], h2 = hist[4 * lane + 2], h3 = hist[4 * lane + 3];
                const unsigned tot = h0 + h1 + h2 + h3; unsigned sfx = tot;
#pragma unroll
                for (int o = 1; o < 64; o <<= 1) { const unsigned t = __shfl_down(sfx, o); if (lane + o < 64) sfx += t; }
                const unsigned above = sfx - tot, c3 = above + h3, c2 = c3 + h2, c1 = c2 + h1, c0 = c1 + h0;
                int d = -1; unsigned gtc = 0u;
                if (above < need && need <= c3) { d = 3; gtc = above; }
                else if (c3 < need && need <= c2) { d = 2; gtc = c3; }
                else if (c2 < need && need <= c1) { d = 1; gtc = c2; }
                else if (c1 < need && need <= c0) { d = 0; gtc = c1; }
                if (d >= 0) { ctl[0] = prefix | ((unsigned)(4 * lane + d) << shift); ctl[1] = need - gtc; }
            }
            __syncthreads();
            prefix = ctl[0]; need = ctl[1];
        }
        unsigned ngt = 0u, neq = 0u;
#pragma unroll
        for (int q = 0; q < 4; ++q) { ngt += (valid && key[q] > prefix) ? 1u : 0u; neq += (valid && key[q] == prefix) ? 1u : 0u; }
        const unsigned cnt = ngt | (neq << 16); unsigned inc = cnt;
#pragma unroll
        for (int o = 1; o < 64; o <<= 1) { const unsigned t = __shfl_up(inc, o); if (lane >= o) inc += t; }
        if (lane == 63) ctl[8 + c.wave] = inc;
        __syncthreads();
        unsigned base = 0u;
#pragma unroll
        for (int w = 0; w < 8; ++w) base += (w < c.wave) ? ctl[8 + w] : 0u;
        const unsigned ex = base + inc - cnt; unsigned gtb = ex & 0xffffu, eqb = ex >> 16;
        if (valid) {
#pragma unroll
            for (int q = 0; q < 4; ++q) { const int i = 4 * c.tid + q; int slot = -1;
                if (key[q] > prefix) { slot = (int)(gtb + (eqb < need ? eqb : need)); ++gtb; }
                else if (key[q] == prefix) { if (eqb < need) slot = (int)(gtb + eqb); ++eqb; }
                int gs = -1;
                if (slot >= 0) { gs = e * MR + slotbase + slot; sel[slot] = i; GATE[gs] = __uint_as_float(key[q]); }
                INV[(size_t)(rowbase + i) * NE + e] = gs; }
        }
        __syncthreads();
        for (int sidx = c.wave; sidx < cap; sidx += 8) {
            if (MOE_FP8) { const unsigned char* src = (const unsigned char*)HB + (size_t)(rowbase + sel[sidx]) * DM; unsigned char* dst = (unsigned char*)XG + (size_t)(e * MR + slotbase + sidx) * DM;
                *(v4u*)(dst + 16 * lane) = *(const v4u*)(src + 16 * lane); }
            else { const bf16* src = HB + (size_t)(rowbase + sel[sidx]) * DM; bf16* dst = XG + (size_t)(e * MR + slotbase + sidx) * DM;
            const v4u a0 = *(const v4u*)(src + 8 * lane), a1 = *(const v4u*)(src + 512 + 8 * lane);
            *(v4u*)(dst + 8 * lane) = a0; *(v4u*)(dst + 512 + 8 * lane) = a1; }
        }
        __syncthreads();
    }
}

__device__ __forceinline__ void ph_combine(const Params& p, const Ctx& c, int layer) {
    const bf16* YS = (const bf16*)(p.ws + WS_YS);
    const int* INV = (const int*)(p.ws + WS_INV);
    bf16* XS = (bf16*)(p.ws + WS_XS);
    bf16* HB = (bf16*)(p.ws + WS_HB);
    const float* lng = p.in[I_LNG] + (size_t)(layer * 2 + 1) * DM; const float* lnb = p.in[I_LNB] + (size_t)(layer * 2 + 1) * DM;
    const int nrows = layer == 0 ? NTOK : LAT;
    const int lane = c.lane;
    for (int row = 2 * c.gw; row < nrows; row += 2 * c.NGW) {
        const float* mod = mod_row(p, layer, row);
        const int inv = (lane < 2 * NE) ? INV[(size_t)row * NE + lane] : -1;
        const unsigned mall = (unsigned)__ballot(inv >= 0);
        unsigned ma = mall & 0xffffu, mb = mall >> 16;
        int sla[4], slb[4]; float wa[4], wb[4];
#pragma unroll
        for (int q = 0; q < 4; ++q) {
            if (ma) { const int e = __builtin_ctz(ma); ma &= ma - 1; sla[q] = __builtin_amdgcn_readlane(inv, e); wa[q] = 1.f; } else { sla[q] = 0; wa[q] = 0.f; }
            if (mb) { const int e = __builtin_ctz(mb); mb &= mb - 1; slb[q] = __builtin_amdgcn_readlane(inv, 16 + e); wb[q] = 1.f; } else { slb[q] = 0; wb[q] = 0.f; } }
        f32x4 moa[4], mob[4];
#pragma unroll
        for (int j = 0; j < 4; ++j) { moa[j] = (f32x4){0.f, 0.f, 0.f, 0.f}; mob[j] = (f32x4){0.f, 0.f, 0.f, 0.f}; }
#pragma unroll
        for (int q = 0; q < 4; ++q)
#pragma unroll
            for (int j = 0; j < 4; ++j) { moa[j] += unpack4(*(const v2u*)(YS + (size_t)sla[q] * DM + 4 * lane + 256 * j)) * wa[q]; mob[j] += unpack4(*(const v2u*)(YS + (size_t)slb[q] * DM + 4 * lane + 256 * j)) * wb[q]; }
        while (ma) { const int e = __builtin_ctz(ma); ma &= ma - 1; const int sl = __builtin_amdgcn_readlane(inv, e);
#pragma unroll
            for (int j = 0; j < 4; ++j) moa[j] += unpack4(*(const v2u*)(YS + (size_t)sl * DM + 4 * lane + 256 * j)); }
        while (mb) { const int e = __builtin_ctz(mb); mb &= mb - 1; const int sl = __builtin_amdgcn_readlane(inv, 16 + e);
#pragma unroll
            for (int j = 0; j < 4; ++j) mob[j] += unpack4(*(const v2u*)(YS + (size_t)sl * DM + 4 * lane + 256 * j)); }
        f32x4 va[4], vb[4]; float sa = 0.f, sb = 0.f;
#pragma unroll
        for (int j = 0; j < 4; ++j) { const int col = 4 * lane + 256 * j; const f32x4 g2 = *(const f32x4*)(mod + 5120 + col);
            va[j] = unpack4(*(const v2u*)(XS + (size_t)row * DM + col)) * ALPHA + g2 * moa[j];
            vb[j] = unpack4(*(const v2u*)(XS + (size_t)(row + 1) * DM + col)) * ALPHA + g2 * mob[j];
            sa += (va[j].x + va[j].y) + (va[j].z + va[j].w); sb += (vb[j].x + vb[j].y) + (vb[j].z + vb[j].w); }
        const float meana = wave_sum(sa) * (1.f / DM), meanb = wave_sum(sb) * (1.f / DM); float qa = 0.f, qb = 0.f;
#pragma unroll
        for (int j = 0; j < 4; ++j) { va[j] = va[j] - meana; vb[j] = vb[j] - meanb;
            qa += (va[j].x * va[j].x + va[j].y * va[j].y) + (va[j].z * va[j].z + va[j].w * va[j].w); qb += (vb[j].x * vb[j].x + vb[j].y * vb[j].y) + (vb[j].z * vb[j].z + vb[j].w * vb[j].w); }
        const float rstda = 1.f / sqrtf(wave_sum(qa) * (1.f / DM) + LN_EPS), rstdb = 1.f / sqrtf(wave_sum(qb) * (1.f / DM) + LN_EPS);
        const float* modn = mod_row(p, 1, row);
#pragma unroll
        for (int j = 0; j < 4; ++j) { const int col = 4 * lane + 256 * j;
            const f32x4 g = *(const f32x4*)(lng + col), bb = *(const f32x4*)(lnb + col);
            const f32x4 x2a = va[j] * rstda * g + bb, x2b = vb[j] * rstdb * g + bb;
            if (layer == 0) {
                *(v2u*)(XS + (size_t)row * DM + col) = (v2u){pk2(x2a.x, x2a.y), pk2(x2a.z, x2a.w)};
                *(v2u*)(XS + (size_t)(row + 1) * DM + col) = (v2u){pk2(x2b.x, x2b.y), pk2(x2b.z, x2b.w)};
                const f32x4 sc = *(const f32x4*)(modn + 1024 + col) + 1.f, sh = *(const f32x4*)(modn + col);
                const f32x4 ha = x2a * sc + sh, hb = x2b * sc + sh;
                *(v2u*)(HB + (size_t)row * DM + col) = (v2u){pk2(ha.x, ha.y), pk2(ha.z, ha.w)};
                *(v2u*)(HB + (size_t)(row + 1) * DM + col) = (v2u){pk2(hb.x, hb.y), pk2(hb.z, hb.w)};
            } else {
                *(f32x4*)(p.out + (size_t)row * DM + col) = x2a; *(f32x4*)(p.out + (size_t)(row + 1) * DM + col) = x2b;
            } }
    }
}

__device__ __forceinline__ void na_key(const float* q, float* o, float& m, float& l, const bf16* kp, const bf16* vp, float bias) {
    float s = bias;
#pragma unroll
    for (int i = 0; i < 8; ++i) { float f[8]; unpack8(*(const v4u*)(kp + 8 * i), f);
#pragma unroll
        for (int j = 0; j < 8; ++j) s += q[8 * i + j] * f[j]; }
    const float mn = fmaxf(m, s), al = exp2f(m - mn), pp = exp2f(s - mn);
    l = l * al + pp; m = mn;
#pragma unroll
    for (int i = 0; i < 8; ++i) { float f[8]; unpack8(*(const v4u*)(vp + 8 * i), f);
#pragma unroll
        for (int j = 0; j < 8; ++j) o[8 * i + j] = o[8 * i + j] * al + pp * f[j]; }
}
__device__ __forceinline__ void ph_mixer1_naive(const Params& p, const Ctx& c) {
    const bf16* P2 = (const bf16*)(p.ws + WS_QKV);
    bf16* CC = (bf16*)(p.ws + WS_CC);
    const float* rpb = p.in[I_RPB]; const float* pool_w = p.in[I_POOLW]; const float* pool_s = p.in[I_POOLS];
    LAS float* pl = (LAS float*)c.lds;
    for (int u = c.vcu; u < 256; u += c.G) {
        const int b = u >> 5, r = u & 31;
        {
            const int h = c.wave, col = c.lane, row = b * SEQ + r * 64 + col;
            const int rs = min(max(r - 4, 0), 24), cs = min(max(col - 8, 0), 48);
            float q[64], o[64];
#pragma unroll
            for (int i = 0; i < 8; ++i) unpack8(*(const v4u*)(P2 + (size_t)row * OIN + h * 64 + 8 * i), q + 8 * i);
#pragma unroll
            for (int i = 0; i < 64; ++i) o[i] = 0.f;
            float m = -1e30f, l = 0.f;
#pragma unroll 1
            for (int i = 0; i < 8; ++i)
#pragma unroll 1
                for (int j = 0; j < 16; ++j) {
                    const int krow = b * SEQ + (rs + i) * 64 + cs + j;
                    const float bias = rpb[(h * 15 + (rs + i - r + 7)) * 31 + (cs + j - col + 15)] * LOG2E;
                    na_key(q, o, m, l, P2 + (size_t)krow * OIN + 512 + h * 64, P2 + (size_t)krow * OIN + 1024 + h * 64, bias);
                }
#pragma unroll 1
            for (int j = 0; j < NCTX; ++j) {
                const int krow = LAT + b * NCTX + j;
                na_key(q, o, m, l, P2 + (size_t)krow * OIN + 512 + h * 64, P2 + (size_t)krow * OIN + 1024 + h * 64, 0.f);
            }
            const float rl = 1.f / l; bf16* dst = CC + (size_t)row * DM + h * 64;
#pragma unroll
            for (int i = 0; i < 8; ++i) *(v4u*)(dst + 8 * i) = (v4u){pk2(o[8 * i] * rl, o[8 * i + 1] * rl), pk2(o[8 * i + 2] * rl, o[8 * i + 3] * rl), pk2(o[8 * i + 4] * rl, o[8 * i + 5] * rl), pk2(o[8 * i + 6] * rl, o[8 * i + 7] * rl)};
        }
        __syncthreads();
        {
            const int ch = c.tid, g = ch >> 7, half = 1 << g;
            for (int tt = 0; tt < 64; ++tt) {
                const int t = r * 64 + tt, lo = max(t - half, 0), hi = min(t + half, SEQ);
                float s = 0.f;
                for (int t2 = lo; t2 < hi; ++t2) s += bf2f((unsigned)P2[(size_t)(b * SEQ + t2) * OIN + 1536 + ch]);
                pl[tt * 512 + ch] = s / (float)(hi - lo) - bf2f((unsigned)P2[(size_t)(b * SEQ + t) * OIN + 1536 + ch]);
            }
        }
        __syncthreads();
        {
            const int g = c.tid >> 7, e = c.tid & 127;
            const float ps = pool_s[g * 128 + e];
#pragma unroll 1
            for (int tb = 0; tb < 64; tb += 16) {
                float acc[16];
#pragma unroll
                for (int i = 0; i < 16; ++i) acc[i] = 0.f;
#pragma unroll 4
                for (int cc = 0; cc < 128; ++cc) {
                    const float w = pool_w[(size_t)(g * 128 + cc) * 128 + e];
#pragma unroll
                    for (int i = 0; i < 16; ++i) acc[i] += pl[(tb + i) * 512 + g * 128 + cc] * w;
                }
#pragma unroll
                for (int i = 0; i < 16; ++i) CC[(size_t)(b * SEQ + r * 64 + tb + i) * DM + 512 + g * 128 + e] = (bf16)f2bf(acc[i] * ps);
            }
        }
        __syncthreads();
    }
}


constexpr int NA_TAB_OFF = 86016 + 1024;
__device__ __forceinline__ void ph_mixer1_fast(const Params& p, const Ctx& c, char* lds_generic) {
    typedef attn_body::bf16 abf;
    const abf* P2a = (const abf*)(p.ws + WS_QKV); abf* CCa = (abf*)(p.ws + WS_CC);
    LAS float* tab = (LAS float*)(c.lds + NA_TAB_OFF);
    for (int i = c.tid; i < 8 * 15 * 32; i += 512) { const int hd = i >> 5, j = i & 31; tab[i] = j < 31 ? p.in[I_RPB][hd * 31 + j] * LOG2E : 0.f; }
    __syncthreads();
    for (int it = 0;; ++it) {
        const int U = it * c.G + c.vcu;
        if (U >= 512) break;
        const int b = U >> 6, h = (U >> 3) & 7, rq = U & 7;
        const int rs_min = min(max(4 * rq - 4, 0), 24);
        const int nloc = (rq == 0 || rq == 7) ? 8 : 12;
        attn_body::AU u;
        u.qrow0 = b * SEQ + rq * 256; u.lat_row0 = LAT + b * NCTX; u.nlat_t = 4; u.ctx_row0 = b * SEQ + rs_min * 64; u.NT = 4 + nloc;
        u.Qp = P2a + h * 64; u.Kp = P2a + 512 + h * 64; u.Vp = P2a + 1024 + h * 64; u.Op = CCa + h * 64;
        const int r = 4 * rq + (c.wave >> 1), col = (c.wave & 1) * 32 + (c.lane & 31), hi = c.lane >> 5;
        const int cs = min(max(col - 8, 0), 48);
        attn_body::NAMask mk; mk.tb0 = (attn_body::lds_cfptr)(tab + h * 15 * 32 + 15 - col); mk.r = r; mk.rs = min(max(r - 4, 0), 24); mk.rs_min = rs_min; mk.cb = 4 * hi - cs;
        attn_body::attn_unit<8, OIN, attn_body::NAMask>(u, lds_generic, mk);
    }
    __syncthreads();
    const bf16* P2 = (const bf16*)(p.ws + WS_QKV); bf16* CC = (bf16*)(p.ws + WS_CC);
    const float* pool_w = p.in[I_POOLW]; const float* pool_s = p.in[I_POOLS];
    constexpr int PLP = 1040;
    for (int u = c.vcu; u < 256; u += c.G) {
        const int b = u >> 5, r = u & 31;
        {   const int ch = c.tid, g = c.wave >> 1;
            const bf16* du = P2 + (size_t)b * SEQ * OIN + 1536 + ch;
            const int t0 = r * 64;
            float v[80];
#pragma unroll
            for (int k = 0; k < 80; ++k) { const int t2 = t0 - 8 + k; v[k] = ((t2 >= 0 && t2 < SEQ) ? 1.f : 0.f) * bf2f((unsigned)du[(size_t)min(max(t2, 0), SEQ - 1) * OIN]); }
            LAS bf16* plc = (LAS bf16*)(c.lds) + ch;
#define POOL_COL(HALF) do { float ws = 0.f; _Pragma("unroll") for (int k = 8 - HALF; k < 8 + HALF; ++k) ws += v[k]; \
            _Pragma("unroll") for (int tt = 0; tt < 64; ++tt) { const int t = t0 + tt, lo = max(t - HALF, 0), hi = min(t + HALF, SEQ); \
                plc[tt * (PLP / 2)] = (bf16)f2bf(ws / (float)(hi - lo) - v[tt + 8]); ws += v[tt + 8 + HALF] - v[tt + 8 - HALF]; } } while (0)
            if (g == 0) POOL_COL(1); else if (g == 1) POOL_COL(2); else if (g == 2) POOL_COL(4); else POOL_COL(8);
#undef POOL_COL
        }
        __syncthreads();
        {   typedef short bf16x8v __attribute__((ext_vector_type(8)));
            const int g = c.wave >> 1, th = c.wave & 1, l31 = c.lane & 31, lh = c.lane >> 5;
            f32x16 acc[4];
#pragma unroll
            for (int et = 0; et < 4; ++et) acc[et] = (f32x16){};
#pragma unroll
            for (int ks = 0; ks < 8; ++ks) {
                const bf16x8v af = *(const LAS bf16x8v*)(c.lds + (32 * th + l31) * PLP + (g * 128 + 16 * ks + 8 * lh) * 2);
#pragma unroll
                for (int et = 0; et < 4; ++et) {
                    const float* wp = pool_w + (size_t)(g * 128 + 16 * ks + 8 * lh) * 128 + 32 * et + l31;
                    bf16x8v bfr;
#pragma unroll
                    for (int j = 0; j < 8; ++j) bfr[j] = (short)f2bf(wp[(size_t)j * 128]);
                    acc[et] = __builtin_amdgcn_mfma_f32_32x32x16_bf16(af, bfr, acc[et], 0, 0, 0);
                }
            }
#pragma unroll
            for (int et = 0; et < 4; ++et) { const int e = 32 * et + l31; const float ps = pool_s[g * 128 + e];
#pragma unroll
                for (int rg = 0; rg < 16; ++rg) { const int tok = 32 * th + (rg & 3) + 8 * (rg >> 2) + 4 * lh;
                    CC[(size_t)(b * SEQ + r * 64 + tok) * DM + 512 + g * 128 + e] = (bf16)f2bf(acc[et][rg] * ps); } }
        }
        __syncthreads();
    }
}

__global__ void __launch_bounds__(512, 2) mk_fwd(Params p_arg) {
    extern __shared__ __attribute__((aligned(16))) unsigned char lds_raw[];
    Ctx c;
    c.lds = (LAS unsigned char*)lds_raw;
    c.tid = threadIdx.x; c.lane = c.tid & 63; c.wave = __builtin_amdgcn_readfirstlane(c.tid >> 6);
    c.G = gridDim.x; { const int bx = blockIdx.x; c.vcu = (c.G % 8 == 0) ? (bx % 8) * (c.G / 8) + bx / 8 : bx; }
    c.gw = c.vcu * 8 + c.wave; c.NGW = c.G * 8;
    volatile LAS unsigned* MISC = (volatile LAS unsigned*)(c.lds + MISC_OFF);
    if (c.tid < 32) MISC[c.tid] = 0u;
    __syncthreads();
    typedef const __attribute__((address_space(4))) Params* KP;
    const KP kp0 = (KP)__builtin_amdgcn_kernarg_segment_ptr();
#define RELOAD_P() ({ KP kq_ = kp0; asm volatile("" : "+s"(kq_)); *(const Params*)kq_; })
    gu32* ctl = (gu32*)(p_arg.ws + WS_CTL);
    XcdBarrier bar; bar.bar = (unsigned*)(ctl + CW_BAR); bar.x = 0; bar.st = nullptr;
    if (!MK_MULTI) bar = xcd_barrier_post((unsigned*)(ctl + CW_BAR), MISC + 8);
    const int lo = p_arg.ph_lo, hi = p_arg.ph_hi;
    unsigned long long pt0 = 0, pt1 = 0; if (PROBE_PH == 0 || PROBE_PH >= 100) pt0 = __builtin_amdgcn_s_memrealtime();
#define IN(k) (lo <= (k) && (k) < hi)
#define SEAM(k) do { if (IN(k) && IN((k) + 1) && !(FAST_ATTN && (k) == 5) && !(FAST_GEMM && FUSE_QKV && (k) == 3)) xcd_barrier(bar); if ((k) + 1 == PROBE_PH) pt0 = __builtin_amdgcn_s_memrealtime(); if ((k) == PROBE_PH || (k) + 200 == PROBE_PH) pt1 = __builtin_amdgcn_s_memrealtime(); } while (0)

#define HB ((bf16*)(p.ws + WS_HB))
#define QKV ((bf16*)(p.ws + WS_QKV))
#define CC ((bf16*)(p.ws + WS_CC))
#define Y ((float*)(p.ws + WS_Y))
#define PF ((float*)(p.ws + WS_PF))
#define XG ((bf16*)(p.ws + WS_XG))
#define HID ((bf16*)(p.ws + WS_HID))
#define YS ((bf16*)(p.ws + WS_YS))
#define GATE ((const float*)(p.ws + WS_GATE))

    if (IN(0)) { const Params p = RELOAD_P(); ph_prologue(p, c); if (FAST_GEMM) { __syncthreads(); ph_transposes(p, c); } } SEAM(0);
    if (IN(1)) { const Params p = RELOAD_P(); ph_modulate0(p, c); } SEAM(1);
    if (IN(2)) { const Params p = RELOAD_P();
        if (FAST_GEMM) { pg8::Gemm g{HB, (const bf16*)(p.ws + WS_W0IN), NTOK, EIN, DM, 0}; pg8::StaticOrder S; S.init(NTOK, EIN, c.G, (int)blockIdx.x);
            if (FUSE_QKV) { pg8::EpiQKV E{QKV, EIN, (const float*)(p.ws + WS_ROPE), p.in[I_QN], p.in[I_KN], C2, RMS_EPS}; pg8::gemm_phase<pg8::EpiQKV, pg8::StaticOrder, true, true>(c.lds, g, S, E); }
            else { pg8::EpiBf16<0> E{QKV, EIN, nullptr, 0, 0, 1.f}; pg8::gemm_phase<pg8::EpiBf16<0>, pg8::StaticOrder, true, true>(c.lds, g, S, E); }
            tail_transposes(p, c, 648 - 512, (int)blockIdx.x, 1536, 120); }
        else { NG g{HB, DM, p.in[I_W0IN], nullptr, EIN, 0, 1 << 30, 0, NTOK, 0, EIN, DM}; ngemm<1>(g, c, EpiF32{PF, EIN}); }
    } SEAM(2);
    if (!(FAST_GEMM && FUSE_QKV)) { if (IN(3)) { const Params p = RELOAD_P(); if (FAST_GEMM) ph_qkv_post<false>(p, c); else ph_qkv_post<true>(p, c); } } SEAM(3);
    if (IN(4)) { const Params p = RELOAD_P(); if (FAST_ATTN) ph_attn0_fast(p, c, (char*)lds_raw); else ph_attn0_naive(p, c); } SEAM(4);
    if (!FAST_ATTN) { if (IN(5)) { const Params p = RELOAD_P(); ph_attn_combine(p, c); } } SEAM(5);
    if (IN(6)) { const Params p = RELOAD_P();
        if (FAST_GEMM) { pg8::Gemm g{CC, (const bf16*)(p.ws + WS_W0OUT), NTOK, DM, DM, 0}; pg8::StaticOrder S; S.init(NTOK, DM, c.G, (int)blockIdx.x);
            pg8::EpiBf16<0> E{(bf16*)Y, DM, nullptr, 0, 0, 1.f}; pg8::gemm_phase<pg8::EpiBf16<0>, pg8::StaticOrder, true, true>(c.lds, g, S, E);
            tail_transposes(p, c, 288 - 256, (int)blockIdx.x, 1536 + 120 + 320, 224); }
        else { NG g{CC, DM, p.in[I_W0OUT], nullptr, DM, 0, 1 << 30, 0, NTOK, 0, DM, DM}; ngemm<1>(g, c, EpiBf{(bf16*)Y, DM, 0, 1.f}); }
    } SEAM(6);
    if (IN(7)) { const Params p = RELOAD_P(); ph_ln1_router(p, c, 0); } SEAM(7);
    if (IN(8)) { const Params p = RELOAD_P(); ph_topk(p, c, 0); } SEAM(8);
    if (IN(9)) { const Params p = RELOAD_P();
        if (FAST_GEMM && MOE_FP8) { pg8::Gemm g{XG, (const bf16*)(p.ws + WS_WGU), NE * MR0, 4096, DM / 2, (size_t)4096 * DM}; pg8::GroupedOrder S; S.init(MR0 / 256, 16, NE, c.G, c.vcu);
            pg8::EpiSwigluF8 E{(unsigned char*)HID, FF, 1.f / W8_GU, H8_SC}; pg8::gemm_phase<pg8::EpiSwigluF8, pg8::GroupedOrder, true, true, true>(c.lds, g, S, E); }
        else if (FAST_GEMM) { pg8::Gemm g{XG, (const bf16*)(p.ws + WS_WGU), NE * MR0, 4096, DM, (size_t)4096 * DM * 2}; pg8::GroupedOrder S; S.init(MR0 / 256, 16, NE, c.G, c.vcu);
            pg8::EpiSwigluP E{HID, FF}; pg8::gemm_phase<pg8::EpiSwigluP, pg8::GroupedOrder, true, true>(c.lds, g, S, E); }
        else { NG g{XG, DM, p.in[I_WG], p.in[I_WU], FF, (size_t)DM * FF, MR0, 0, NE * MR0, 0, FF, DM}; ngemm<2>(g, c, EpiSwiglu{HID}); }
    } SEAM(9);
    if (IN(10)) { const Params p = RELOAD_P();
        if (FAST_GEMM && MOE_FP8) { pg8::Gemm g{HID, (const bf16*)(p.ws + WS_WDN), NE * MR0, DM, FF / 2, (size_t)DM * FF}; pg8::GroupedOrder S; S.init(MR0 / 256, 4, NE, c.G, c.vcu);
            pg8::EpiGateS E{YS, DM, GATE, 1.f / (W8_DN * H8_SC)}; pg8::gemm_phase<pg8::EpiGateS, pg8::GroupedOrder, true, true, true>(c.lds, g, S, E);
            tail_transposes(p, c, 576 - 512, c.vcu, 1536 + 120 + 320 + 224, 576); }
        else if (FAST_GEMM) { pg8::Gemm g{HID, (const bf16*)(p.ws + WS_WDN), NE * MR0, DM, FF, (size_t)DM * FF * 2}; pg8::GroupedOrder S; S.init(MR0 / 256, 4, NE, c.G, c.vcu);
            pg8::EpiGateP E{YS, DM, GATE}; pg8::gemm_phase<pg8::EpiGateP, pg8::GroupedOrder, true, true>(c.lds, g, S, E); }
        else { NG g{HID, FF, p.in[I_WD], nullptr, DM, (size_t)FF * DM, MR0, 0, NE * MR0, 0, DM, FF}; ngemm<1>(g, c, EpiGate{YS, GATE}); }
    } SEAM(10);
    if (IN(11)) { const Params p = RELOAD_P(); ph_combine(p, c, 0); } SEAM(11);
    if (IN(12)) { const Params p = RELOAD_P();
        if (FAST_GEMM) { pg8::Gemm g{HB, (const bf16*)(p.ws + WS_W1IN), NTOK, OIN, DM, 0}; pg8::L1InOrder S; S.init(c.G, (int)blockIdx.x);
            pg8::EpiBf16<0> E{QKV, OIN, nullptr, 512, 512, C2}; pg8::gemm_phase<pg8::EpiBf16<0>, pg8::L1InOrder, true, true>(c.lds, g, S, E);
            tail_transposes(p, c, 544 - 512, (int)blockIdx.x, 1536 + 120 + 320 + 224 + 576, 296); }
        else {
        NG g{HB, DM, p.in[I_W1IN], nullptr, OIN, 0, 1 << 30, 0, LAT, 0, OIN, DM}; ngemm<1>(g, c, EpiBf{QKV, OIN, 512, C2});
        NG g2{HB, DM, p.in[I_W1IN], nullptr, OIN, 0, 1 << 30, LAT, NTOK, 512, 1536, DM}; ngemm<1>(g2, c, EpiBf{QKV, OIN, 0, 1.f}); }
    } SEAM(12);
    if (IN(13)) { const Params p = RELOAD_P(); if (FAST_NA) ph_mixer1_fast(p, c, (char*)lds_raw); else ph_mixer1_naive(p, c); } SEAM(13);
    if (IN(14)) { const Params p = RELOAD_P();
        if (FAST_GEMM) { pg8::Gemm g{CC, (const bf16*)(p.ws + WS_W1OUT), LAT, DM, DM, 0}; pg8::StaticOrder S; S.init(LAT, DM, c.G, (int)blockIdx.x);
            pg8::EpiBf16<0> E{(bf16*)Y, DM, nullptr, 0, 0, 1.f}; pg8::gemm_phase<pg8::EpiBf16<0>, pg8::StaticOrder, true, true>(c.lds, g, S, E); }
        else { NG g{CC, DM, p.in[I_W1OUT], nullptr, DM, 0, 1 << 30, 0, LAT, 0, DM, DM}; ngemm<1>(g, c, EpiBf{(bf16*)Y, DM, 0, 1.f}); }
    } SEAM(14);
    if (IN(15)) { const Params p = RELOAD_P(); ph_ln1_router(p, c, 1); } SEAM(15);
    if (IN(16)) { const Params p = RELOAD_P(); ph_topk(p, c, 1); } SEAM(16);
    if (IN(17)) { const Params p = RELOAD_P();
        if (FAST_GEMM && MOE_FP8) { pg8::Gemm g{XG, (const bf16*)(p.ws + WS_WGU + WS_MOE_LSTRIDE), NE * MR1, 4096, DM / 2, (size_t)4096 * DM}; pg8::GroupedOrder S; S.init(MR1 / 256, 16, NE, c.G, c.vcu);
            pg8::EpiSwigluF8 E{(unsigned char*)HID, FF, 1.f / W8_GU, H8_SC}; pg8::gemm_phase<pg8::EpiSwigluF8, pg8::GroupedOrder, true, true, true>(c.lds, g, S, E); }
        else if (FAST_GEMM) { pg8::Gemm g{XG, (const bf16*)(p.ws + WS_WGU + WS_MOE_LSTRIDE), NE * MR1, 4096, DM, (size_t)4096 * DM * 2}; pg8::GroupedOrder S; S.init(MR1 / 256, 16, NE, c.G, c.vcu);
            pg8::EpiSwigluP E{HID, FF}; pg8::gemm_phase<pg8::EpiSwigluP, pg8::GroupedOrder, true, true>(c.lds, g, S, E); }
        else { NG g{XG, DM, p.in[I_WG] + (size_t)NE * DM * FF, p.in[I_WU] + (size_t)NE * DM * FF, FF, (size_t)DM * FF, MR1, 0, NE * MR1, 0, FF, DM}; ngemm<2>(g, c, EpiSwiglu{HID}); }
    } SEAM(17);
    if (IN(18)) { const Params p = RELOAD_P();
        if (FAST_GEMM && MOE_FP8) { pg8::Gemm g{HID, (const bf16*)(p.ws + WS_WDN + WS_MOE_LSTRIDE), NE * MR1, DM, FF / 2, (size_t)DM * FF}; pg8::GroupedOrder S; S.init(MR1 / 256, 4, NE, c.G, c.vcu);
            pg8::EpiGateS E{YS, DM, GATE, 1.f / (W8_DN * H8_SC)}; pg8::gemm_phase<pg8::EpiGateS, pg8::GroupedOrder, true, true, true>(c.lds, g, S, E); }
        else if (FAST_GEMM) { pg8::Gemm g{HID, (const bf16*)(p.ws + WS_WDN + WS_MOE_LSTRIDE), NE * MR1, DM, FF, (size_t)DM * FF * 2}; pg8::GroupedOrder S; S.init(MR1 / 256, 4, NE, c.G, c.vcu);
            pg8::EpiGateP E{YS, DM, GATE}; pg8::gemm_phase<pg8::EpiGateP, pg8::GroupedOrder, true, true>(c.lds, g, S, E); }
        else { NG g{HID, FF, p.in[I_WD] + (size_t)NE * FF * DM, nullptr, DM, (size_t)FF * DM, MR1, 0, NE * MR1, 0, DM, FF}; ngemm<1>(g, c, EpiGate{YS, GATE}); }
    } SEAM(18);
    if (IN(19)) { const Params p = RELOAD_P(); ph_combine(p, c, 1); }
    if (PROBE_PH == 19 || PROBE_PH == 100) pt1 = __builtin_amdgcn_s_memrealtime();
    if (PROBE_PH >= 0 && blockIdx.x == 0 && c.tid == 0) { const unsigned long long te = __builtin_amdgcn_s_memrealtime(); while (__builtin_amdgcn_s_memrealtime() - te < pt1 - pt0) __builtin_amdgcn_s_sleep(8); }
#undef IN
#undef SEAM
#undef HB
#undef QKV
#undef CC
#undef Y
#undef PF
#undef XG
#undef HID
#undef YS
#undef GATE
#undef RELOAD_P
}

extern "C" void kernel_launch(void* const* d_in, const int* in_sizes, int n_in, void* d_out, int out_size, void* d_ws, size_t ws_size, hipStream_t stream) {
    static int grid = 0;
    if (grid == 0) {
        if (n_in != 26 || out_size != LAT * DM || ws_size < WS_END) { fprintf(stderr, "kernel_launch: unexpected shapes (n_in %d out %d ws %zu)\n", n_in, out_size, ws_size); grid = -1; return; }
        int dev = 0, cus = 0;
        if (hipGetDevice(&dev) != hipSuccess || hipDeviceGetAttribute(&cus, hipDeviceAttributeMultiprocessorCount, dev) != hipSuccess) { grid = -1; return; }
        if (hipFuncSetAttribute((const void*)mk_fwd, hipFuncAttributeMaxDynamicSharedMemorySize, LDS_BYTES) != hipSuccess) { fprintf(stderr, "kernel_launch: hipFuncSetAttribute failed\n"); grid = -1; return; }
        int per_cu = 0;
        if (hipOccupancyMaxActiveBlocksPerMultiprocessor(&per_cu, (const void*)mk_fwd, 512, LDS_BYTES) != hipSuccess || per_cu < 1) fprintf(stderr, "kernel_launch: occupancy query says %d\n", per_cu);
        (void)hipGetLastError();
        grid = cus;
    }
    if (grid < 0) return;
    (void)hipMemsetAsync((char*)d_ws + WS_CTL, 0, CTL_ZERO_BYTES, stream);
    Params a{};
    for (int i = 0; i < 26; ++i) a.in[i] = (const float*)d_in[i];
    a.out = (float*)d_out; a.ws = (unsigned char*)d_ws;
#if MK_MULTI
    for (int ph = 0; ph < NPHASE; ++ph) { a.ph_lo = ph; a.ph_hi = ph + 1; hipLaunchKernelGGL(mk_fwd, dim3(grid), dim3(512), LDS_BYTES, stream, a); }
#else
    a.ph_lo = 0; a.ph_hi = NPHASE;
    hipLaunchKernelGGL(mk_fwd, dim3(grid), dim3(512), LDS_BYTES, stream, a);
#endif
}
```

```cpp
#include <hip/hip_runtime.h>
#include <cstdio>
#include <cstdint>

#define GAS __attribute__((address_space(1)))
#define LAS __attribute__((address_space(3)))
typedef unsigned short bf16;
typedef unsigned v4u __attribute__((ext_vector_type(4)));
typedef unsigned v2u __attribute__((ext_vector_type(2)));
typedef float f32x4 __attribute__((ext_vector_type(4)));
typedef float f32x2 __attribute__((ext_vector_type(2)));
typedef float f32x16 __attribute__((ext_vector_type(16)));
typedef GAS unsigned gu32;

#ifndef PROBE_PH
#define PROBE_PH -1
#endif
#ifndef PROBE_MASK
#define PROBE_MASK 0u
#endif
#ifndef TAIL_TRANSPOSE
#define TAIL_TRANSPOSE 1
#endif
#ifndef FUSE_QKV
#define FUSE_QKV 1
#endif
#ifndef MOE_FP8
#define MOE_FP8 1
#endif
#ifndef FAST_NA
#define FAST_NA 1
#endif
#ifndef FAST_ATTN
#define FAST_ATTN 1
#endif
#ifndef FAST_GEMM
#define FAST_GEMM 1
#endif
#ifndef MK_MULTI
#define MK_MULTI 0
#endif

constexpr int NBATCH = 8, SEQ = 2048, DM = 1024, NCTX = 256;
constexpr int LAT = NBATCH * SEQ;
constexpr int NTOK = LAT + NBATCH * NCTX;
constexpr int EIN = 2304, OIN = 2048, NE = 16, FF = 2048;
constexpr int MR0 = 2304, MR1 = 2048;
constexpr float LOG2E = 1.4426950408889634f;
constexpr float C2 = 0.125f * LOG2E;
constexpr float ALPHA = 1.4142135623730951f;
constexpr float LN_EPS = 1e-5f, RMS_EPS = 1e-6f;
constexpr float LAM_INIT = 0.2f;
constexpr int NPHASE = 20;
constexpr float W8_GU = 32.f, W8_DN = 64.f, H8_SC = 8.f;

constexpr size_t MiB = 1u << 20;
constexpr size_t WS_CTL = 0, CTL_ZERO_BYTES = 1 * MiB;
constexpr size_t WS_MOD = 1 * MiB;
constexpr size_t WS_ROPE = 1 * MiB + 512 * 1024;
constexpr size_t WS_W0IN = 2 * MiB;
constexpr size_t WS_W0OUT = 7 * MiB;
constexpr size_t WS_W1IN = 9 * MiB;
constexpr size_t WS_W1OUT = 13 * MiB;
constexpr size_t WS_AFF = 16 * MiB;
constexpr size_t WS_INV = 18 * MiB;
constexpr size_t WS_GATE = 20 * MiB;
constexpr size_t WS_WGU = 24 * MiB;
constexpr size_t WS_WDN = 152 * MiB;
constexpr size_t WS_MOE_LSTRIDE = 192 * MiB;
constexpr size_t WS_XS = 408 * MiB;
constexpr size_t WS_HB = 480 * MiB;
constexpr size_t WS_QKV = 516 * MiB;
constexpr size_t WS_CC = 597 * MiB;
constexpr size_t WS_AO = 633 * MiB;
constexpr size_t WS_Y = 705 * MiB;
constexpr size_t WS_XG = 516 * MiB;
constexpr size_t WS_HID = 588 * MiB;
constexpr size_t WS_YS = 732 * MiB;
constexpr size_t WS_PF = 804 * MiB;
constexpr size_t WS_END = 968 * MiB;

constexpr int CW_BAR = 4096;
constexpr int LDS_BYTES = 147456;
constexpr int MISC_OFF = 131072 + 320;

__device__ __forceinline__ float bf2f(unsigned v) { return __uint_as_float(v << 16); }
__device__ __forceinline__ unsigned f2bf(float f) { unsigned u = __float_as_uint(f); return (u + 0x7fffu + ((u >> 16) & 1u)) >> 16; }
__device__ __forceinline__ unsigned pk2(float lo, float hi) { return f2bf(lo) | (f2bf(hi) << 16); }
__device__ __forceinline__ float wave_sum(float v) {
#pragma unroll
    for (int o = 1; o < 64; o <<= 1) v += __shfl_xor(v, o);
    return v;
}
__device__ __forceinline__ float wave_max(float v) {
#pragma unroll
    for (int o = 1; o < 64; o <<= 1) v = fmaxf(v, __shfl_xor(v, o));
    return v;
}
__device__ __forceinline__ void unpack8(const v4u w, float* f) {
    f[0] = bf2f(w.x & 0xffffu); f[1] = __uint_as_float(w.x & 0xffff0000u);
    f[2] = bf2f(w.y & 0xffffu); f[3] = __uint_as_float(w.y & 0xffff0000u);
    f[4] = bf2f(w.z & 0xffffu); f[5] = __uint_as_float(w.z & 0xffff0000u);
    f[6] = bf2f(w.w & 0xffffu); f[7] = __uint_as_float(w.w & 0xffff0000u);
}

#define XB_TMO      128
#define XB_XCNT(j)  (256  + 64 * (j))
#define XB_XSUB(j)  (1280 + 64 * (j))
#define XB_XGEN(j)  (2304 + 64 * (j))
#define XB_TOP      3328
#define XB_TOPGEN   3392
#define XCD_BAR_WORDS 3456
#define XB_SPIN_CAP (1u << 18)
__device__ __forceinline__ unsigned xb_ld(unsigned* p)              { return __hip_atomic_load(p, __ATOMIC_RELAXED, __HIP_MEMORY_SCOPE_AGENT); }
__device__ __forceinline__ unsigned xb_add(unsigned* p, unsigned v) { return __hip_atomic_fetch_add(p, v, __ATOMIC_RELAXED, __HIP_MEMORY_SCOPE_AGENT); }
__device__ __forceinline__ unsigned xb_xcc_id() { return (unsigned)__builtin_amdgcn_s_getreg((3 << 11) | 20) & 0xFu; }
#define XB_SPIN(cond, bar) do { unsigned _sp = 0; while (cond) { __builtin_amdgcn_s_sleep(1); \
    if ((++_sp & 255u) == 0u) { if (xb_ld(&(bar)[XB_TMO])) break; if (_sp > XB_SPIN_CAP) { atomicAdd(&(bar)[XB_TMO], 1u); break; } } } } while (0)
struct XcdBarrier { unsigned* bar; unsigned x; volatile LAS unsigned* st; };
__device__ __forceinline__ XcdBarrier xcd_barrier_post(unsigned* bar, volatile LAS unsigned* st) {
    XcdBarrier b; b.bar = bar; b.x = xb_xcc_id(); b.st = st;
    if (threadIdx.x == 0) (void)xb_add(&bar[XB_XCNT(b.x)], 1u);
    return b;
}
__device__ __forceinline__ void xcd_barrier_complete(unsigned* bar, unsigned x, unsigned& nloc, unsigned& nx) {
    const unsigned G = gridDim.x * gridDim.y * gridDim.z;
    unsigned sum, cnt, mine, sp = 0u;
    for (;;) {
        sum = 0u; cnt = 0u; mine = 0u;
#pragma unroll
        for (unsigned j = 0; j < 16; ++j) { const unsigned c = xb_ld(&bar[XB_XCNT(j)]); sum += c; cnt += (c > 0u) ? 1u : 0u; mine = (j == x) ? c : mine; }
        if (sum == G) break;
        __builtin_amdgcn_s_sleep(1);
        if ((++sp & 255u) == 0u) { if (xb_ld(&bar[XB_TMO])) break; if (sp > XB_SPIN_CAP) { atomicAdd(&bar[XB_TMO], 1u); break; } }
    }
    nloc = mine > 0u ? mine : 1u; nx = cnt > 0u ? cnt : 1u;
}
__device__ __forceinline__ void xcd_barrier(const XcdBarrier& b) {
    asm volatile("s_waitcnt vmcnt(0)" ::: "memory");
    __syncthreads();
    if (threadIdx.x == 0) {
        unsigned* bar = b.bar;
        __builtin_amdgcn_s_waitcnt(0);
        unsigned nloc = b.st[0], nx = b.st[1];
        if (nloc == 0u) { xcd_barrier_complete(bar, b.x, nloc, nx); b.st[0] = nloc; b.st[1] = nx; }
        const unsigned old = xb_add(&bar[XB_XSUB(b.x)], 1u);
        const unsigned gen = old / nloc;
        if (old + 1u == (gen + 1u) * nloc) {
            __builtin_amdgcn_fence(__ATOMIC_RELEASE, "agent");
            asm volatile("s_waitcnt vmcnt(0)" ::: "memory");
            const unsigned og = xb_add(&bar[XB_TOP], 1u);
            const unsigned tg = og / nx;
            if (og + 1u == (tg + 1u) * nx) xb_add(&bar[XB_TOPGEN], 1u);
            else XB_SPIN(xb_ld(&bar[XB_TOPGEN]) == tg, bar);
            __builtin_amdgcn_fence(__ATOMIC_ACQUIRE, "agent");
            xb_add(&bar[XB_XGEN(b.x)], 1u);
            asm volatile("s_waitcnt vmcnt(0)" ::: "memory");
        } else {
            XB_SPIN(xb_ld(&bar[XB_XGEN(b.x)]) == gen, bar);
            __builtin_amdgcn_fence(__ATOMIC_ACQUIRE, "agent");
            asm volatile("s_waitcnt vmcnt(0)" ::: "memory");
        }
    }
    __syncthreads();
}

namespace pg8 {
#define PG8_LAS __attribute__((address_space(3)))
typedef unsigned short bf16_t;
typedef short bf16x8 __attribute__((ext_vector_type(8)));
typedef float f32x4 __attribute__((ext_vector_type(4)));
typedef unsigned u32x4 __attribute__((ext_vector_type(4)));
constexpr int BM = 256, BK = 64, HALF = 128, HTB = HALF * BK * 2  , STAGE_BYTES = 8 * HTB, NXCD = 8, WGM = 8;

__host__ __device__ __forceinline__ int lds_byte(int r, int c) { const int st = (r >> 4) * 2 + (c >> 5), rr = r & 15, cc = c & 31, ob = rr * 64 + cc * 2; return st * 1024 + (ob ^ (((ob >> 9) & 1) << 5)); }
__host__ __device__ __forceinline__ void stage_rc(int b, int& R, int& C) { const int st = b / 1024, sb = b % 1024, swz = sb ^ (((sb >> 9) & 1) << 5); R = (st >> 1) * 16 + swz / 64; C = (st & 1) * 32 + (swz % 64) / 2; }
__host__ __device__ __forceinline__ int perm32(int rho) { const int n = rho >> 4, i = rho & 15; return 8 * (i >> 2) + 4 * n + (i & 3); }

struct Unit { int pm, pn, e; };
struct Gemm { const bf16_t* A; const bf16_t* Bt; int M, N, K; size_t bstride; };

struct StaticOrder {
    int nM, nN, nwg, G, c;
    __host__ __device__ void init(int M, int N, int G_, int c_) { nM = M / BM; nN = N / BM; nwg = nM * nN; G = G_; c = c_; }
    __host__ __device__ bool next(int i, Unit& u) const {
        const long L = (long)i * G + c; if (L >= nwg) return false;
        int wgid = (int)L; { const int q = nwg / NXCD, r = nwg % NXCD, xcd = wgid % NXCD, off = wgid / NXCD; wgid = (xcd < r ? xcd * (q + 1) : r * (q + 1) + (xcd - r) * q) + off; }
        const int nig = WGM * nN, gid = wgid / nig, fm = gid * WGM, gsz = (nM - fm) < WGM ? (nM - fm) : WGM;
        u.pm = fm + ((wgid % nig) % gsz); u.pn = (wgid % nig) / gsz; u.e = 0; return true;
    }
    __device__ __forceinline__ void a_ready(const Unit&) const {}
    __device__ __forceinline__ void done(const Unit&) const {}
};

__device__ __forceinline__ unsigned cvt_pk_bf16(float lo, float hi) { unsigned r; asm volatile("v_cvt_pk_bf16_f32 %0, %1, %2" : "=v"(r) : "v"(lo), "v"(hi)); return r; }
typedef float f32x2 __attribute__((ext_vector_type(2)));
__device__ __forceinline__ f32x2 gelu_pk(f32x2 v) {
    const f32x2 av = __builtin_elementwise_abs(v), d = av * 0.2316418882f + 1.0f;
    f32x2 t; t.x = __builtin_amdgcn_rcpf(d.x); t.y = __builtin_amdgcn_rcpf(d.y);
    f32x2 q = t * 0.5307027145f + (-0.7265760135f); q = q * t + 0.7107068705f; q = q * t + (-0.142248368f); q = q * t + 0.127414796f; q = q * t;
    const f32x2 s = (v * v) * (-0.72134752044f);
    f32x2 e; e.x = __builtin_amdgcn_exp2f(s.x); e.y = __builtin_amdgcn_exp2f(s.y);
    const f32x2 m = v * (q * e), r = v - m;
    f32x2 o; o.x = v.x < 0.f ? m.x : r.x; o.y = v.y < 0.f ? m.y : r.y; return o;
}

template <int ACT  > struct EpiBf16 {
    static constexpr bool PERM = true, AFTER_DRAIN = false; static_assert(ACT == 0 || ACT == 1, "EpiBf16: ACT is 0 (none) or 1 (gelu_pk)");
    bf16_t* O; int ldc; const float* bias; int split_cols; size_t split_stride; float scale0;
    __device__ __forceinline__ void operator()(const f32x4 (&acc)[2][2][4][2], const Unit& u, int wr, int wc, int fr, int fq) const {
        const int row0 = u.pm * BM + wr * 64 + fr; int colt = u.pn * BM; bf16_t* base = O;
        float sc = 1.f; if (split_cols) { const int t = colt / split_cols; base += (size_t)t * split_stride; colt -= t * split_cols; if (t == 0) sc = scale0; }
        const int col0 = colt + wc * 32 + 8 * fq, bcol0 = u.pn * BM + wc * 32 + 8 * fq;
        f32x4 bv[2][2];
#pragma unroll
        for (int bj = 0; bj < 2; ++bj)
#pragma unroll
            for (int n = 0; n < 2; ++n) bv[bj][n] = bias ? *(const f32x4*)(bias + bcol0 + bj * HALF + 4 * n) : (f32x4){0.f, 0.f, 0.f, 0.f};
#pragma unroll
        for (int ai = 0; ai < 2; ++ai)
#pragma unroll
            for (int m = 0; m < 4; ++m) { bf16_t* rowp = base + (size_t)(row0 + ai * HALF + m * 16) * ldc + col0;
#pragma unroll
                for (int bj = 0; bj < 2; ++bj) { f32x4 v0 = acc[ai][bj][m][0] + bv[bj][0], v1 = acc[ai][bj][m][1] + bv[bj][1];
                    if (ACT == 1) { f32x2 a = gelu_pk((f32x2){v0[0], v0[1]}), b = gelu_pk((f32x2){v0[2], v0[3]}), c = gelu_pk((f32x2){v1[0], v1[1]}), d = gelu_pk((f32x2){v1[2], v1[3]});
                        v0 = (f32x4){a.x, a.y, b.x, b.y}; v1 = (f32x4){c.x, c.y, d.x, d.y}; }
                    v0 = v0 * sc; v1 = v1 * sc; u32x4 w; w.x = cvt_pk_bf16(v0[0], v0[1]); w.y = cvt_pk_bf16(v0[2], v0[3]); w.z = cvt_pk_bf16(v1[0], v1[1]); w.w = cvt_pk_bf16(v1[2], v1[3]);
                    *(u32x4*)(rowp + bj * HALF) = w; } }
    }
};

typedef int i32x4 __attribute__((ext_vector_type(4))); typedef int i32x8 __attribute__((ext_vector_type(8)));
__device__ __forceinline__ i32x8 cat16(bf16x8 lo, bf16x8 hi) { const i32x4 a = __builtin_bit_cast(i32x4, lo), b = __builtin_bit_cast(i32x4, hi); return __builtin_shufflevector(a, b, 0, 1, 2, 3, 4, 5, 6, 7); }
__device__ __forceinline__ void mfma_f8_acc(f32x4& acc, const i32x8& b, const i32x8& a, int sc) {
    asm volatile("v_mfma_scale_f32_16x16x128_f8f6f4 %0, %1, %2, %0, %3, %3 op_sel_hi:[0,0,0]" : "+v"(acc) : "v"(b), "v"(a), "v"(sc)); }
template <class Epi, class Sched, bool ALIGN_EPI = false, bool SP2 = false, bool FP8 = false>
__device__ __forceinline__ void gemm_phase(PG8_LAS unsigned char* lds, const Gemm g, const Sched& S, const Epi& E) {
    const int tid = threadIdx.x, wid = __builtin_amdgcn_readfirstlane(tid >> 6), lane = tid & 63, wr = wid >> 2, wc = wid & 3, fr = lane & 15, fq = lane >> 4;
    const int K = g.K, nt = K / BK;
    unsigned voffA[2], voffB[2];
#pragma unroll
    for (int i = 0; i < 2; ++i) { int R, C; stage_rc(tid * 16 + i * 8192, R, C); const int Rb = Epi::PERM ? ((R & ~31) + perm32(R & 31)) : R;
        voffA[i] = (unsigned)(R * K + C) * 2u; voffB[i] = (unsigned)(Rb * K + C) * 2u; }
    const size_t kstep = (size_t)(BK * 2);
    const size_t hstep = (size_t)HALF * K * 2;
    const size_t tstep = 2 * hstep;
    const unsigned ldsw = (unsigned)wid * 1024u;
    const int aoff = FP8 ? lds_byte(wr * 64 + fr, 16 * fq) : lds_byte(wr * 64 + fr, fq * 8), boff = FP8 ? lds_byte(wc * 32 + fr, 16 * fq) : lds_byte(wc * 32 + fr, fq * 8);
    constexpr int KOFF = FP8 ? 16 : 1024;
#define PG8_SA(b, h) (((b) * 2 + (h)) * HTB)
#define PG8_SB(b, h) ((4 + (b) * 2 + (h)) * HTB)
#define PG8_STAGE(bufoff, gbase, voff) do { _Pragma("unroll") for (int _i = 0; _i < 2; ++_i) \
        __builtin_amdgcn_global_load_lds((const unsigned*)((const char*)(gbase) + (voff)[_i]), (PG8_LAS unsigned*)(lds + (bufoff) + ldsw + _i * 8192), 16, 0, 0); } while (0)
#define PG8_LDA(dst, b, h) do { _Pragma("unroll") for (int m = 0; m < 4; ++m) _Pragma("unroll") for (int k = 0; k < 2; ++k) dst[m][k] = *(const PG8_LAS bf16x8*)(lds + PG8_SA(b, h) + aoff + m * 2048 + k * KOFF); } while (0)
#define PG8_LDB(dst, b, h) do { _Pragma("unroll") for (int n = 0; n < 2; ++n) _Pragma("unroll") for (int k = 0; k < 2; ++k) dst[n][k] = *(const PG8_LAS bf16x8*)(lds + PG8_SB(b, h) + boff + n * 2048 + k * KOFF); } while (0)
#define PG8_MMA(ai, bj, At, Bt) do { __builtin_amdgcn_s_setprio(1); _Pragma("unroll") for (int m = 0; m < 4; ++m) _Pragma("unroll") for (int n = 0; n < 2; ++n) { \
        if constexpr (FP8) mfma_f8_acc(acc[ai][bj][m][n], cat16(Bt[n][0], Bt[n][1]), cat16(At[m][0], At[m][1]), f8scale); \
        else { _Pragma("unroll") for (int k = 0; k < 2; ++k) acc[ai][bj][m][n] = __builtin_amdgcn_mfma_f32_16x16x32_bf16(Bt[n][k], At[m][k], acc[ai][bj][m][n], 0, 0, 0); } } __builtin_amdgcn_s_setprio(0); } while (0)
#define PG8_WAIT_V(n) asm volatile("s_waitcnt vmcnt(" #n ")" ::: "memory")
#define PG8_WAIT_L(n) asm volatile("s_waitcnt lgkmcnt(" #n ")" ::: "memory")
#define PG8_BAR __builtin_amdgcn_s_barrier()
#define PG8_SCHED __builtin_amdgcn_sched_barrier(0)
    Unit cur, nxt; int ui = 0;
    if (!S.next(0, cur)) return;
    f32x4 acc[2][2][4][2];
#pragma unroll
    for (int a = 0; a < 2; ++a)
#pragma unroll
        for (int b = 0; b < 2; ++b)
#pragma unroll
            for (int m = 0; m < 4; ++m)
#pragma unroll
                for (int n = 0; n < 2; ++n) acc[a][b][m][n] = (f32x4){0.f, 0.f, 0.f, 0.f};
    int f8scale = 0x7F7F7F7F; asm volatile("" : "+v"(f8scale));
    bf16x8 At[4][2], B0[2][2], B1[2][2];
    const char* cA = (const char*)g.A + (size_t)cur.pm * tstep; const char* cB = (const char*)g.Bt + (size_t)cur.pn * tstep + (size_t)cur.e * g.bstride;
    S.a_ready(cur);
    if constexpr (SP2) {
        PG8_STAGE(PG8_SB(0, 0), cB, voffB); PG8_STAGE(PG8_SB(0, 1), cB + hstep, voffB); PG8_STAGE(PG8_SA(0, 0), cA, voffA); PG8_STAGE(PG8_SA(0, 1), cA + hstep, voffA);
        if (wr == 1) PG8_BAR;
        PG8_WAIT_V(2); PG8_BAR;
        PG8_STAGE(PG8_SB(1, 0), cB + kstep, voffB); PG8_STAGE(PG8_SA(1, 0), cA + kstep, voffA); PG8_STAGE(PG8_SB(1, 1), cB + hstep + kstep, voffB);
        PG8_WAIT_V(6); PG8_BAR;
    } else {
        PG8_STAGE(PG8_SB(0, 0), cB, voffB); PG8_STAGE(PG8_SA(0, 0), cA, voffA); PG8_STAGE(PG8_SB(0, 1), cB + hstep, voffB); PG8_STAGE(PG8_SA(0, 1), cA + hstep, voffA);
        if (wr == 1) PG8_BAR;
        PG8_WAIT_V(4); PG8_BAR;
        PG8_STAGE(PG8_SB(1, 0), cB + kstep, voffB); PG8_STAGE(PG8_SA(1, 0), cA + kstep, voffA); PG8_STAGE(PG8_SB(1, 1), cB + hstep + kstep, voffB);
        PG8_WAIT_V(6); PG8_BAR;
    }
    for (;;) {
        const bool has_next = S.next(ui + 1, nxt);
        const char* nA = has_next ? (const char*)g.A + (size_t)nxt.pm * tstep : cA; const char* nB = has_next ? (const char*)g.Bt + (size_t)nxt.pn * tstep + (size_t)nxt.e * g.bstride : cB;
        for (int t = 0; t < nt; t += 2) {
            const bool last = (t == nt - 2);
            const char* a1 = cA + (size_t)(t + 1) * kstep;
            const char* a2 = last ? nA : cA + (size_t)(t + 2) * kstep; const char* b2 = last ? nB : cB + (size_t)(t + 2) * kstep;
            const char* a3 = a2 + kstep; const char* b3 = b2 + kstep;
            if (last && has_next) S.a_ready(nxt);
            if constexpr (SP2) {
            PG8_LDB(B0, 0, 0); PG8_LDB(B1, 0, 1); PG8_SCHED; PG8_LDA(At, 0, 0); PG8_STAGE(PG8_SA(1, 1), a1 + hstep, voffA);
            PG8_WAIT_V(8); PG8_WAIT_L(0); PG8_BAR; PG8_MMA(0, 0, At, B0); PG8_MMA(0, 1, At, B1); PG8_BAR; PG8_SCHED;
            PG8_LDA(At, 0, 1); PG8_STAGE(PG8_SB(0, 0), b2, voffB); PG8_STAGE(PG8_SB(0, 1), b2 + hstep, voffB); PG8_STAGE(PG8_SA(0, 0), a2, voffA);
            PG8_WAIT_V(8); PG8_WAIT_L(0); PG8_BAR; PG8_MMA(1, 0, At, B0); PG8_MMA(1, 1, At, B1); PG8_BAR; PG8_SCHED;
            PG8_LDB(B0, 1, 0); PG8_LDB(B1, 1, 1); PG8_SCHED; PG8_LDA(At, 1, 0); PG8_STAGE(PG8_SA(0, 1), a2 + hstep, voffA);
            PG8_WAIT_V(8); PG8_WAIT_L(0); PG8_BAR; PG8_MMA(0, 0, At, B0); PG8_MMA(0, 1, At, B1); PG8_BAR; PG8_SCHED;
            PG8_LDA(At, 1, 1); PG8_STAGE(PG8_SB(1, 0), b3, voffB); PG8_STAGE(PG8_SB(1, 1), b3 + hstep, voffB); PG8_STAGE(PG8_SA(1, 0), a3, voffA);
            PG8_WAIT_V(8); PG8_WAIT_L(0); PG8_BAR; PG8_MMA(1, 0, At, B0); PG8_MMA(1, 1, At, B1); PG8_BAR; PG8_SCHED;
            } else {
            PG8_LDB(B0, 0, 0); PG8_SCHED; PG8_LDA(At, 0, 0); PG8_STAGE(PG8_SA(1, 1), a1 + hstep, voffA);
            PG8_WAIT_L(8); PG8_BAR; PG8_WAIT_L(0); PG8_MMA(0, 0, At, B0); PG8_BAR; PG8_SCHED;
            PG8_LDB(B1, 0, 1); PG8_STAGE(PG8_SB(0, 0), b2, voffB);
            PG8_BAR; PG8_WAIT_L(0); PG8_MMA(0, 1, At, B1); PG8_BAR;
            PG8_LDA(At, 0, 1); PG8_STAGE(PG8_SA(0, 0), a2, voffA);
            PG8_BAR; PG8_WAIT_L(0); PG8_MMA(1, 0, At, B0); PG8_BAR; PG8_SCHED;
            PG8_STAGE(PG8_SB(0, 1), b2 + hstep, voffB);
            PG8_WAIT_V(6); PG8_BAR; PG8_MMA(1, 1, At, B1); PG8_BAR;
            PG8_LDB(B0, 1, 0); PG8_SCHED; PG8_LDA(At, 1, 0); PG8_STAGE(PG8_SA(0, 1), a2 + hstep, voffA);
            PG8_WAIT_L(8); PG8_BAR; PG8_WAIT_L(0); PG8_MMA(0, 0, At, B0); PG8_BAR; PG8_SCHED;
            PG8_LDB(B1, 1, 1); PG8_STAGE(PG8_SB(1, 0), b3, voffB);
            PG8_BAR; PG8_WAIT_L(0); PG8_MMA(0, 1, At, B1); PG8_BAR;
            PG8_LDA(At, 1, 1); PG8_STAGE(PG8_SA(1, 0), a3, voffA);
            PG8_BAR; PG8_WAIT_L(0); PG8_MMA(1, 0, At, B0); PG8_BAR; PG8_SCHED;
            PG8_STAGE(PG8_SB(1, 1), b3 + hstep, voffB);
            PG8_WAIT_V(6); PG8_BAR; PG8_MMA(1, 1, At, B1); PG8_BAR;
            }
        }
        if constexpr (ALIGN_EPI) { if (wr == 0) PG8_BAR; }
        if constexpr (FP8) asm volatile("s_nop 15\n\ts_nop 15" : "+v"(acc[1][1][0][0]), "+v"(acc[1][1][0][1]), "+v"(acc[1][1][1][0]), "+v"(acc[1][1][1][1]), "+v"(acc[1][1][2][0]), "+v"(acc[1][1][2][1]), "+v"(acc[1][1][3][0]), "+v"(acc[1][1][3][1]));
        if constexpr (!Epi::AFTER_DRAIN) { E(acc, cur, wr, wc, fr, fq); S.done(cur); }
        if (!has_next) break;
#pragma unroll
        for (int a = 0; a < 2; ++a)
#pragma unroll
            for (int b = 0; b < 2; ++b)
#pragma unroll
                for (int m = 0; m < 4; ++m)
#pragma unroll
                    for (int n = 0; n < 2; ++n) acc[a][b][m][n] = (f32x4){0.f, 0.f, 0.f, 0.f};
        cur = nxt; cA = nA; cB = nB; ++ui;
        if constexpr (ALIGN_EPI) { if (wr == 1) PG8_BAR; }
    }
    PG8_WAIT_V(0);
    if constexpr (!ALIGN_EPI) { if (wr == 0) PG8_BAR; }
    PG8_BAR;
    if constexpr (Epi::AFTER_DRAIN) { E.fused(acc, cur, wr, wc, fr, fq, lds, wid, lane); S.done(cur); }
#undef PG8_SA
#undef PG8_SB
#undef PG8_STAGE
#undef PG8_LDA
#undef PG8_LDB
#undef PG8_MMA
#undef PG8_WAIT_V
#undef PG8_WAIT_L
#undef PG8_BAR
#undef PG8_SCHED
}
}

namespace pg8 {
struct EpiF32P {
    static constexpr bool PERM = false, AFTER_DRAIN = false;
    float* O; int ldc;
    __device__ __forceinline__ void operator()(const f32x4 (&acc)[2][2][4][2], const Unit& u, int wr, int wc, int fr, int fq) const {
        const int row0 = u.pm * BM + wr * 64 + fr, col0 = u.pn * BM + wc * 32 + 4 * fq;
#pragma unroll
        for (int ai = 0; ai < 2; ++ai)
#pragma unroll
            for (int m = 0; m < 4; ++m) { float* rowp = O + (size_t)(row0 + ai * HALF + m * 16) * ldc + col0;
#pragma unroll
                for (int bj = 0; bj < 2; ++bj)
#pragma unroll
                    for (int n = 0; n < 2; ++n) *(f32x4*)(rowp + bj * HALF + n * 16) = acc[ai][bj][m][n]; }
    }
};
struct EpiSwigluP {
    static constexpr bool PERM = true, AFTER_DRAIN = false;
    bf16_t* O; int ldc;
    __device__ __forceinline__ void operator()(const f32x4 (&acc)[2][2][4][2], const Unit& u, int wr, int wc, int fr, int fq) const {
        const int row0 = u.pm * BM + wr * 64 + fr, col0 = u.pn * HALF + wc * 32 + 8 * fq;
#pragma unroll
        for (int ai = 0; ai < 2; ++ai)
#pragma unroll
            for (int m = 0; m < 4; ++m) {
                float h[8];
#pragma unroll
                for (int n = 0; n < 2; ++n)
#pragma unroll
                    for (int j = 0; j < 4; ++j) { const float g = acc[ai][0][m][n][j], up = acc[ai][1][m][n][j];
                        h[4 * n + j] = g * up * __builtin_amdgcn_rcpf(1.0f + __builtin_amdgcn_exp2f(-1.4426950408889634f * g)); }
                u32x4 w; w.x = cvt_pk_bf16(h[0], h[1]); w.y = cvt_pk_bf16(h[2], h[3]); w.z = cvt_pk_bf16(h[4], h[5]); w.w = cvt_pk_bf16(h[6], h[7]);
                *(u32x4*)(O + (size_t)(row0 + ai * HALF + m * 16) * ldc + col0) = w; }
    }
};
struct EpiGateP {
    static constexpr bool PERM = true, AFTER_DRAIN = false;
    bf16_t* O; int ldc; const float* gate;
    __device__ __forceinline__ void operator()(const f32x4 (&acc)[2][2][4][2], const Unit& u, int wr, int wc, int fr, int fq) const {
        const int row0 = u.pm * BM + wr * 64 + fr, col0 = u.pn * BM + wc * 32 + 8 * fq;
#pragma unroll
        for (int ai = 0; ai < 2; ++ai)
#pragma unroll
            for (int m = 0; m < 4; ++m) { const int row = row0 + ai * HALF + m * 16; const float gt = gate[row]; bf16_t* rowp = O + (size_t)row * ldc + col0;
#pragma unroll
                for (int bj = 0; bj < 2; ++bj) { const f32x4 v0 = acc[ai][bj][m][0] * gt, v1 = acc[ai][bj][m][1] * gt;
                    u32x4 w; w.x = cvt_pk_bf16(v0[0], v0[1]); w.y = cvt_pk_bf16(v0[2], v0[3]); w.z = cvt_pk_bf16(v1[0], v1[1]); w.w = cvt_pk_bf16(v1[2], v1[3]);
                    *(u32x4*)(rowp + bj * HALF) = w; } }
    }
};
__device__ __forceinline__ unsigned pk4_fp8(float a, float b, float c, float d) {
    a = __builtin_fminf(__builtin_fmaxf(a, -448.f), 448.f); b = __builtin_fminf(__builtin_fmaxf(b, -448.f), 448.f);
    c = __builtin_fminf(__builtin_fmaxf(c, -448.f), 448.f); d = __builtin_fminf(__builtin_fmaxf(d, -448.f), 448.f);
    int w = 0; w = __builtin_amdgcn_cvt_pk_fp8_f32(a, b, w, false); w = __builtin_amdgcn_cvt_pk_fp8_f32(c, d, w, true); return (unsigned)w; }
struct EpiSwigluF8 {
    static constexpr bool PERM = true, AFTER_DRAIN = false;
    unsigned char* O; int ldc; float ws, hs;
    __device__ __forceinline__ void operator()(const f32x4 (&acc)[2][2][4][2], const Unit& u, int wr, int wc, int fr, int fq) const {
        const int row0 = u.pm * BM + wr * 64 + fr, col0 = u.pn * HALF + wc * 32 + 8 * fq;
#pragma unroll
        for (int ai = 0; ai < 2; ++ai)
#pragma unroll
            for (int m = 0; m < 4; ++m) {
                float h[8];
#pragma unroll
                for (int n = 0; n < 2; ++n)
#pragma unroll
                    for (int j = 0; j < 4; ++j) { const float g = acc[ai][0][m][n][j] * ws, up = acc[ai][1][m][n][j] * ws;
                        h[4 * n + j] = g * up * hs * __builtin_amdgcn_rcpf(1.0f + __builtin_amdgcn_exp2f(-1.4426950408889634f * g)); }
                typedef unsigned u32x2 __attribute__((ext_vector_type(2)));
                *(u32x2*)(O + (size_t)(row0 + ai * HALF + m * 16) * ldc + col0) = (u32x2){pk4_fp8(h[0], h[1], h[2], h[3]), pk4_fp8(h[4], h[5], h[6], h[7])}; }
    }
};
struct EpiGateS {
    static constexpr bool PERM = true, AFTER_DRAIN = false;
    bf16_t* O; int ldc; const float* gate; float sc;
    __device__ __forceinline__ void operator()(const f32x4 (&acc)[2][2][4][2], const Unit& u, int wr, int wc, int fr, int fq) const {
        const int row0 = u.pm * BM + wr * 64 + fr, col0 = u.pn * BM + wc * 32 + 8 * fq;
#pragma unroll
        for (int ai = 0; ai < 2; ++ai)
#pragma unroll
            for (int m = 0; m < 4; ++m) { const int row = row0 + ai * HALF + m * 16; const float gt = gate[row] * sc; bf16_t* rowp = O + (size_t)row * ldc + col0;
#pragma unroll
                for (int bj = 0; bj < 2; ++bj) { const f32x4 v0 = acc[ai][bj][m][0] * gt, v1 = acc[ai][bj][m][1] * gt;
                    u32x4 w; w.x = cvt_pk_bf16(v0[0], v0[1]); w.y = cvt_pk_bf16(v0[2], v0[3]); w.z = cvt_pk_bf16(v1[0], v1[1]); w.w = cvt_pk_bf16(v1[2], v1[3]);
                    *(u32x4*)(rowp + bj * HALF) = w; } }
    }
};
struct EpiQKV {
    static constexpr bool PERM = true, AFTER_DRAIN = false;
    bf16_t* O; int ldc; const float* rope; const float* qn; const float* kn; float qscale; float rms_eps;
    __device__ __forceinline__ void operator()(const f32x4 (&acc)[2][2][4][2], const Unit& u, int wr, int wc, int fr, int fq) const {
        const int hs = 4 * u.pn + wc;
        const bool isq = hs < 8 || (hs >= 24 && hs < 32), isk = (hs >= 8 && hs < 16) || hs == 32 || hs == 33, nrm = hs >= 24 && hs < 34;
        const bool rope_on = (isq || isk) && u.pm < 64;
        const float osc = isq ? qscale : 1.f;
        const bool first = fq < 2;
        f32x4 gv[2][2];
#pragma unroll
        for (int bj = 0; bj < 2; ++bj)
#pragma unroll
            for (int n = 0; n < 2; ++n) gv[bj][n] = nrm ? *(const f32x4*)((hs < 32 ? qn : kn) + 32 * bj + 8 * fq + 4 * n) : (f32x4){1.f, 1.f, 1.f, 1.f};
#pragma unroll
        for (int ai = 0; ai < 2; ++ai)
#pragma unroll
            for (int m = 0; m < 4; ++m) {
                const int row = u.pm * BM + ai * HALF + wr * 64 + m * 16 + fr;
                f32x4 v[2][2];
#pragma unroll
                for (int bj = 0; bj < 2; ++bj)
#pragma unroll
                    for (int n = 0; n < 2; ++n) v[bj][n] = acc[ai][bj][m][n];
                if (nrm) {
                    float ss = 0.f;
#pragma unroll
                    for (int bj = 0; bj < 2; ++bj)
#pragma unroll
                        for (int n = 0; n < 2; ++n) ss += (v[bj][n][0] * v[bj][n][0] + v[bj][n][1] * v[bj][n][1]) + (v[bj][n][2] * v[bj][n][2] + v[bj][n][3] * v[bj][n][3]);
                    ss += __shfl_xor(ss, 16); ss += __shfl_xor(ss, 32);
                    const float r = __builtin_amdgcn_rsqf(ss * (1.f / 64.f) + rms_eps);
#pragma unroll
                    for (int bj = 0; bj < 2; ++bj)
#pragma unroll
                        for (int n = 0; n < 2; ++n) v[bj][n] = v[bj][n] * r * gv[bj][n];
                }
                if (rope_on) {
                    const int t = row & 2047;
#pragma unroll
                    for (int bj = 0; bj < 2; ++bj) {
                        const int pos = bj ? (t & 63) : (t >> 6);
#pragma unroll
                        for (int n = 0; n < 2; ++n) {
                            const float* cp = rope + (size_t)(pos * 16 + 8 * (fq & 1) + 4 * n) * 2;
                            const f32x4 c01 = *(const f32x4*)cp, c23 = *(const f32x4*)(cp + 4);
                            const float cs[4] = {c01[0], c01[2], c23[0], c23[2]}, sn[4] = {c01[1], c01[3], c23[1], c23[3]};
#pragma unroll
                            for (int j = 0; j < 4; ++j) { const float x = v[bj][n][j], pr = __shfl_xor(x, 32); v[bj][n][j] = first ? x * cs[j] - pr * sn[j] : x * cs[j] + pr * sn[j]; }
                        }
                    }
                }
                bf16_t* rowp = O + (size_t)row * ldc + hs * 64 + 8 * fq;
#pragma unroll
                for (int bj = 0; bj < 2; ++bj) { const f32x4 v0 = v[bj][0] * osc, v1 = v[bj][1] * osc;
                    u32x4 w; w.x = cvt_pk_bf16(v0[0], v0[1]); w.y = cvt_pk_bf16(v0[2], v0[3]); w.z = cvt_pk_bf16(v1[0], v1[1]); w.w = cvt_pk_bf16(v1[2], v1[3]);
                    *(u32x4*)(rowp + 32 * bj) = w; }
            }
    }
};
struct GroupedOrder {
    int nMe, nN, ntot, G, c;
    __device__ void init(int nMe_, int nN_, int ne, int G_, int c_) { nMe = nMe_; nN = nN_; ntot = nMe_ * nN_ * ne; G = G_; c = c_; }
    __device__ bool next(int i, Unit& u) const {
        const int L = i * G + c; if (L >= ntot) return false;
        const int per = nMe * nN, e = L / per, rem = L - e * per;
        u.e = e; u.pn = rem / nMe; u.pm = e * nMe + (rem - u.pn * nMe); return true;
    }
    __device__ __forceinline__ void a_ready(const Unit&) const {}
    __device__ __forceinline__ void done(const Unit&) const {}
};
struct L1InOrder {
    StaticOrder so; int G, c;
    __device__ void init(int G_, int c_) { so.init(16384, 2048, G_, 0); G = G_; c = c_; }
    __device__ bool next(int i, Unit& u) const {
        const int L = i * G + c;
        if (L < 512) { StaticOrder t = so; t.G = 1; t.c = 0; return t.next(L, u); }
        if (L < 544) { const int l = L - 512; u.pm = 64 + (l >> 2); u.pn = 2 + (l & 3); u.e = 0; return true; }
        return false;
    }
    __device__ __forceinline__ void a_ready(const Unit&) const {}
    __device__ __forceinline__ void done(const Unit&) const {}
};
}

#include <hip/hip_bf16.h>
#include <cmath>
namespace attn_body {
using bf16=__hip_bfloat16;
using bf16x8=__attribute__((ext_vector_type(8)))short;
using s16x4=__attribute__((ext_vector_type(4)))short;
using f32x16=__attribute__((ext_vector_type(16)))float;
using u32x4=__attribute__((ext_vector_type(4)))unsigned;
constexpr int D=64,OPITCH=1024;
constexpr int NW=8,QBLK=32,QB=QBLK*NW,KVBLK=64;
__device__ __forceinline__ int crow(int r,int hi){return (r&3)+8*(r>>2)+4*hi;}
#define SBAR() __builtin_amdgcn_sched_barrier(0)
__device__ __forceinline__ void cmask(f32x16&p0,f32x16&p1,int jb,int qrel,int hi){
  const float NEG=-INFINITY; int kb=64*jb+4*hi;
  #pragma unroll
  for(int r=0;r<16;++r){int kv=kb+(r&3)+8*(r>>2); if(kv>qrel)p0[r]=NEG; if(kv+32>qrel)p1[r]=NEG;}
}

constexpr int NSLOT=3, SLOTB=8192;
constexpr int LDS_K=0, LDS_V=NSLOT*SLOTB, LDS_WS=2*NSLOT*SLOTB, LDS_OST=LDS_WS+NW*64*4, LDS_BYTES=LDS_OST+NW*4096;
constexpr float C2=0.125f*1.4426950408889634f;
__device__ __forceinline__ void glds16(const void*gsrc,unsigned lds_dst){unsigned keep;
  asm volatile("s_mov_b32 %0, m0\n\ts_mov_b32 m0, %2\n\ts_nop 0\n\tglobal_load_lds_dwordx4 %1, off\n\ts_mov_b32 m0, %0":"=&s"(keep):"v"(gsrc),"s"(lds_dst):"memory");}
__device__ __forceinline__ float max3f(float a,float b,float c){float r;asm("v_max3_f32 %0, %1, %2, %3":"=v"(r):"v"(a),"v"(b),"v"(c));return r;}
__device__ __forceinline__ float max2f(float a,float b){float r;asm("v_max_f32_e32 %0, %1, %2":"=v"(r):"v"(a),"v"(b));return r;}
__device__ __forceinline__ float fadd_s(float a,float b){float r;asm("v_add_f32_e32 %0, %1, %2":"=v"(r):"v"(a),"v"(b));return r;}
__device__ __forceinline__ float fsub_s(float a,float b){float r;asm("v_sub_f32_e32 %0, %1, %2":"=v"(r):"v"(a),"v"(b));return r;}
typedef float f32x2_t __attribute__((ext_vector_type(2))); typedef __bf16 bf16x2_t __attribute__((ext_vector_type(2)));
__device__ __forceinline__ unsigned cvtpk_s(float lo,float hi){f32x2_t v={lo,hi};bf16x2_t b=__builtin_convertvector(v,bf16x2_t);return __builtin_bit_cast(unsigned,b);}
#define WAIT_BAR(N) asm volatile("s_waitcnt vmcnt(" #N ") lgkmcnt(0)\n\ts_barrier":::"memory")

__device__ __forceinline__ void qkt(f32x16&p0,f32x16&p1,const char*Kslot,const bf16x8*qr,const f32x16&negm,int r32,int hi){
  const char*kb=Kslot+hi*1024+r32*16;
  #pragma unroll
  for(int d0=0;d0<4;++d0){
    const bf16x8 b0=*reinterpret_cast<const bf16x8*>(kb+d0*2048);
    const bf16x8 b1=*reinterpret_cast<const bf16x8*>(kb+d0*2048+512);
    if(d0==0){p0=__builtin_amdgcn_mfma_f32_32x32x16_bf16(b0,qr[0],negm,0,0,0);p1=__builtin_amdgcn_mfma_f32_32x32x16_bf16(b1,qr[0],negm,0,0,0);}
    else{p0=__builtin_amdgcn_mfma_f32_32x32x16_bf16(b0,qr[d0],p0,0,0,0);p1=__builtin_amdgcn_mfma_f32_32x32x16_bf16(b1,qr[d0],p1,0,0,0);}}
}
typedef __attribute__((address_space(3))) const char* lds_cptr;
typedef short v4i16_t __attribute__((ext_vector_type(4)));
__device__ __forceinline__ void kload8(bf16x8*kf,lds_cptr kp){
  kf[0]=*(const __attribute__((address_space(3))) bf16x8*)(kp);      kf[1]=*(const __attribute__((address_space(3))) bf16x8*)(kp+512);
  kf[2]=*(const __attribute__((address_space(3))) bf16x8*)(kp+2048); kf[3]=*(const __attribute__((address_space(3))) bf16x8*)(kp+2560);
  kf[4]=*(const __attribute__((address_space(3))) bf16x8*)(kp+4096); kf[5]=*(const __attribute__((address_space(3))) bf16x8*)(kp+4608);
  kf[6]=*(const __attribute__((address_space(3))) bf16x8*)(kp+6144); kf[7]=*(const __attribute__((address_space(3))) bf16x8*)(kp+6656);
}
__device__ __forceinline__ void kload2(bf16x8*kf,lds_cptr kp,int j){ kf[2*j]=*(const __attribute__((address_space(3))) bf16x8*)(kp+j*2048); kf[2*j+1]=*(const __attribute__((address_space(3))) bf16x8*)(kp+j*2048+512); }
__device__ __forceinline__ s16x4 vtr(lds_cptr p){ return __builtin_bit_cast(s16x4,__builtin_amdgcn_ds_read_tr16_b64_v4i16((__attribute__((address_space(3))) v4i16_t*)p)); }
__device__ __forceinline__ float rowmax(const f32x16&p0,const f32x16&p1){
  float a=max3f(p0[0],p0[1],p1[0]),b=max3f(p0[2],p0[3],p1[1]);a=max3f(a,p1[2],p1[3]);
  #pragma unroll
  for(int r=4;r<16;r+=4){a=max3f(a,p0[r],p0[r+1]);b=max3f(b,p0[r+2],p0[r+3]);a=max3f(a,p1[r],p1[r+1]);b=max3f(b,p1[r+2],p1[r+3]);}
  const float m=max2f(a,b);
  auto rr=__builtin_amdgcn_permlane32_swap(__float_as_uint(m),__float_as_uint(m),false,false);
  return max2f(__uint_as_float(rr[0]),__uint_as_float(rr[1]));
}
__device__ __forceinline__ void pv(f32x16*o,int vb,bf16x8 pa0,bf16x8 pa1,bf16x8 pa2,bf16x8 pa3){
  #pragma unroll
  for(int d0=0;d0<2;++d0){s16x4 lo[4],hi[4];
    #pragma unroll
    for(int ks=0;ks<4;++ks){
      asm volatile("ds_read_b64_tr_b16 %0,%1 offset:%c2":"=&v"(lo[ks]):"v"(vb),"i"(d0*4096+ks*1024):"memory");
      asm volatile("ds_read_b64_tr_b16 %0,%1 offset:%c2":"=&v"(hi[ks]):"v"(vb),"i"(d0*4096+ks*1024+512):"memory");}
    asm volatile("s_waitcnt lgkmcnt(0)":::"memory");SBAR();
    #define PK(k) (bf16x8){lo[k][0],lo[k][1],lo[k][2],lo[k][3],hi[k][0],hi[k][1],hi[k][2],hi[k][3]}
    o[d0]=__builtin_amdgcn_mfma_f32_32x32x16_bf16(pa0,PK(0),o[d0],0,0,0);
    o[d0]=__builtin_amdgcn_mfma_f32_32x32x16_bf16(pa1,PK(1),o[d0],0,0,0);
    o[d0]=__builtin_amdgcn_mfma_f32_32x32x16_bf16(pa2,PK(2),o[d0],0,0,0);
    o[d0]=__builtin_amdgcn_mfma_f32_32x32x16_bf16(pa3,PK(3),o[d0],0,0,0);
    #undef PK
  }
}

#ifndef ATTN_STORE16
#define ATTN_STORE16(p,v) (*(u32x4*)(p)=(v))
#endif
struct AU { const bf16* Qp; const bf16* Kp; const bf16* Vp; bf16* Op; int qrow0, lat_row0, ctx_row0, nlat_t, NT; };
struct NoMask { __device__ __forceinline__ void apply(f32x16&,f32x16&,int,int)const{} };
typedef __attribute__((address_space(3))) const float* lds_cfptr;
struct NAMask { lds_cfptr tb0; int r, rs, rs_min, cb;
  __device__ __forceinline__ void apply(f32x16&p0,f32x16&p1,int t,int hi)const{
    if(t<4)return;
    const int kr=rs_min+t-4; const float NEG=-INFINITY;
    if((unsigned)(kr-rs)>7u){
      #pragma unroll
      for(int i=0;i<16;++i){p0[i]=NEG;p1[i]=NEG;}
      return; }
    const lds_cfptr tb=tb0+(kr-r+7)*32+4*hi;
    #pragma unroll
    for(int i=0;i<16;++i){ const int k0=(i&3)+8*(i>>2); const int d0=cb+k0, d1=cb+k0+32;
      const float b0=tb[k0], b1=tb[k0+32];
      p0[i]=((unsigned)d0<=15u)?p0[i]+b0:NEG; p1[i]=((unsigned)d1<=15u)?p1[i]+b1:NEG; }
  }
};
template<int THRL,int PITCH,class MaskT,int VD=1> __device__ __forceinline__ void attn_unit(const AU& u,char*shm,const MaskT& mk){
  constexpr int L_WS=LDS_V+NSLOT*SLOTB*VD, L_OST=L_WS+NW*64*4;
  const int tid=threadIdx.x,lane=tid&63,r32=lane&31,hi=lane>>5; const int wid=__builtin_amdgcn_readfirstlane(tid>>6);
  const bf16*Qw=u.Qp+(long)(u.qrow0+wid*QBLK)*PITCH;
  const bf16*Kh=u.Kp,*Vh=u.Vp;
  const unsigned lds0=(unsigned)(uintptr_t)shm;
  float*wsf=(float*)(shm+L_WS)+wid*64;
  const bf16*ksrc=Kh+(long)lane*PITCH+wid*8;
  const bf16*vsrc=Vh+(long)(16*(wid&3)+(lane>>2))*PITCH+(wid>>2)*32+(lane&3)*8;
  const unsigned kdst=lds0+LDS_K+wid*1024, vdst=lds0+LDS_V+wid*1024;
  #define TROW(t) ((long)((t)<u.nlat_t?u.lat_row0+KVBLK*(t):u.ctx_row0+KVBLK*((t)-u.nlat_t))*PITCH)
  #define DMA_K(t,slot) glds16(ksrc+TROW(t),(unsigned)__builtin_amdgcn_readfirstlane(kdst+(slot)))
  #define DMA_V(t,slot) do{ glds16(vsrc+TROW(t),(unsigned)__builtin_amdgcn_readfirstlane(vdst+VD*(slot))); if constexpr(VD==2) glds16(vsrc+64+TROW(t),(unsigned)__builtin_amdgcn_readfirstlane(vdst+VD*(slot)+8192)); }while(0)
  const int vb0=(int)(lds0+LDS_V)+((lane>>4)&1)*32+(lane&3)*8+(4*hi+((lane&15)>>2))*64;
  const char*Kbase=shm+LDS_K; bf16x8 kf[8];
  const lds_cptr shm3=(lds_cptr)shm; const lds_cptr kp0=shm3+LDS_K+hi*1024+r32*16; const lds_cptr vp0=shm3+LDS_V+((lane>>4)&1)*32+(lane&3)*8+(4*hi+((lane&15)>>2))*64;
  const int NT=u.NT;
  DMA_K(0,0);DMA_V(0,0);DMA_K(1,SLOTB);
  bf16x8 qr[4];
  #pragma unroll
  for(int d0=0;d0<4;++d0)qr[d0]=*reinterpret_cast<const bf16x8*>(&Qw[(long)r32*PITCH+d0*16+hi*8]);
  typedef __attribute__((address_space(3))) bf16x8* lds_qptr;
  const lds_qptr qls=(lds_qptr)((lds_cptr)shm+L_OST+wid*4096+lane*16);
  if constexpr(VD==2){
    #pragma unroll
    for(int d0=0;d0<4;++d0)qls[d0*64]=qr[d0];
  }
  #define QF(d0) (VD==2?*(const __attribute__((address_space(3))) bf16x8*)(qls+(d0)*64):qr[d0])
  float mhat=0.f,l_reg=0.f;f32x16 o[2*VD];
  #pragma unroll
  for(int d_=0;d_<2*VD;++d_)o[d_]=f32x16{};
  f32x16 negm=f32x16{}; if constexpr(VD==1) asm volatile("":"+v"(negm));
  #define CMASK(P0,P1,t) mk.apply(P0,P1,(t),hi)
  bool resc=false;
  #define START(P0,P1) do{ const float rm=rowmax(P0,P1); resc=false; \
    { const float dl=rm; mhat=fadd_s(mhat,dl); \
      _Pragma("unroll") for(int r=0;r<16;++r){P0[r]=fsub_s(P0[r],dl);P1[r]=fsub_s(P1[r],dl);} \
      if constexpr(VD==1){ _Pragma("unroll") for(int r=0;r<16;++r)negm[r]=-mhat; asm volatile("":"+v"(negm)); } } \
    _Pragma("unroll") for(int r=0;r<16;++r)P0[r]=__builtin_amdgcn_exp2f(P0[r]); }while(0)
  #define RESC() do{ if(resc){ asm volatile("s_waitcnt lgkmcnt(0)":::"memory"); \
      _Pragma("unroll") for(int d_=0;d_<2*VD;++d_) _Pragma("unroll") for(int r=0;r<16;++r)o[d_][r]*=wsf[crow(r,hi)]; } }while(0)
  f32x16 pA0,pA1,pB0,pB1;
  int sl_prev=0,sl_cur=0,sl_next=SLOTB;
  #define ROT() do{sl_prev=sl_cur;sl_cur=sl_next;sl_next=(sl_next==(NSLOT-1)*SLOTB)?0:sl_next+SLOTB;}while(0)
  DMA_K(2,2*SLOTB);
  if constexpr(VD==2){WAIT_BAR(4);}else{WAIT_BAR(3);}
  qkt(pA0,pA1,Kbase,qr,negm,r32,hi);asm volatile("s_nop 15\n\ts_nop 7":"+v"(pA0),"+v"(pA1));CMASK(pA0,pA1,0);
  START(pA0,pA1);
  _Pragma("unroll") for(int r=0;r<16;++r)pA1[r]=__builtin_amdgcn_exp2f(pA1[r]);
  WAIT_BAR(0);
  DMA_K(3,0);DMA_V(1,SLOTB);
  ROT();
  kload8(kf,kp0+sl_cur);
  if constexpr(VD==2){WAIT_BAR(3);}else{WAIT_BAR(2);}
  s16x4 vlo[8],vhi[8]; u32x4 pw0,pw1,pw2,pw3;
  #define PKW(P,B) cvtpk_s(P[B],P[B+1])
  #define PAF(k) __builtin_bit_cast(bf16x8,pw##k)
  #define VFR(i) (bf16x8){vlo[i][0],vlo[i][1],vlo[i][2],vlo[i][3],vhi[i][0],vhi[i][1],vhi[i][2],vhi[i][3]}
  #define PIN(x) asm volatile("":"+v"(x))
  #define MX3(a,b,c) __builtin_fmaxf(__builtin_fmaxf((a),(b)),(c))
  #define GAPA(MF,A0,A1,A2,A3,W0,W1,PW) do{ MF; sacc+=A0; sacc+=A1; sacc+=A2; sacc+=A3; PIN(sacc); W0; W1; PIN(PW); SBAR(); }while(0)
  #define EX(v) __builtin_amdgcn_exp2f(v)
  #define GAPB(MF,X,B) do{ MF; X[B]=EX(X[B]); X[B+1]=EX(X[B+1]); X[B+2]=EX(X[B+2]); X[B+3]=EX(X[B+3]); PIN(X); SBAR(); }while(0)
  #define VRD(i) do{ vlo[i]=vtr(vp_+(((i)>>2)*4096+((i)&3)*1024)); vhi[i]=vtr(vp_+(((i)>>2)*4096+((i)&3)*1024+512)); }while(0)
  #define KRD(G,j) do{ if(G){ kload2(kf,kp0+sl_next,j); SBAR(); } }while(0)
  #define STEP(C0,C1,P0,P1,t,GK,GV,GL) do{ SBAR(); \
    const lds_cptr vp_=vp0+VD*sl_prev; \
    VRD(0); SBAR(); float sacc=(P0[0]+P0[1]); \
    GAPA(C0=__builtin_amdgcn_mfma_f32_32x32x16_bf16(kf[0],QF(0),negm,0,0,0), P0[2],P0[3],P0[4],P0[5],     pw0[0]=PKW(P0,0), pw0[1]=PKW(P0,2), pw0); \
    VRD(4); SBAR(); GAPA(C1=__builtin_amdgcn_mfma_f32_32x32x16_bf16(kf[1],QF(0),negm,0,0,0), P0[6],P0[7],P0[8],P0[9],     pw0[2]=PKW(P0,4), pw0[3]=PKW(P0,6), pw0); \
    VRD(1); SBAR(); GAPA(C0=__builtin_amdgcn_mfma_f32_32x32x16_bf16(kf[2],QF(1),C0,0,0,0),   P0[10],P0[11],P0[12],P0[13], pw1[0]=PKW(P0,8), pw1[1]=PKW(P0,10), pw1); \
    VRD(5); SBAR(); GAPA(C1=__builtin_amdgcn_mfma_f32_32x32x16_bf16(kf[3],QF(1),C1,0,0,0),   P0[14],P0[15],P1[0],P1[1],   pw1[2]=PKW(P0,12),pw1[3]=PKW(P0,14), pw1); \
    VRD(2); SBAR(); GAPA(C0=__builtin_amdgcn_mfma_f32_32x32x16_bf16(kf[4],QF(2),C0,0,0,0),   P1[2],P1[3],P1[4],P1[5],     pw2[0]=PKW(P1,0), pw2[1]=PKW(P1,2), pw2); \
    VRD(6); SBAR(); GAPA(C1=__builtin_amdgcn_mfma_f32_32x32x16_bf16(kf[5],QF(2),C1,0,0,0),   P1[6],P1[7],P1[8],P1[9],     pw2[2]=PKW(P1,4), pw2[3]=PKW(P1,6), pw2); \
    VRD(3); SBAR(); GAPA(C0=__builtin_amdgcn_mfma_f32_32x32x16_bf16(kf[6],QF(3),C0,0,0,0),   P1[10],P1[11],P1[12],P1[13], pw3[0]=PKW(P1,8), pw3[1]=PKW(P1,10), pw3); \
    VRD(7); SBAR(); GAPA(C1=__builtin_amdgcn_mfma_f32_32x32x16_bf16(kf[7],QF(3),C1,0,0,0),   P1[14],P1[15],0.f,0.f,       pw3[2]=PKW(P1,12),pw3[3]=PKW(P1,14), pw3); \
    l_reg+=sacc; \
    if(GK){DMA_K((t)+3,sl_cur);} if(GV){DMA_V((t)+1,sl_next);} \
    CMASK(C0,C1,t); \
    { float a=MX3(C0[0],C0[1],C1[0]),b=MX3(C0[2],C0[3],C1[1]); a=MX3(a,C1[2],C1[3]); \
      _Pragma("unroll") for(int r=4;r<16;r+=4){a=MX3(a,C0[r],C0[r+1]);b=MX3(b,C0[r+2],C0[r+3]);a=MX3(a,C1[r],C1[r+1]);b=MX3(b,C1[r+2],C1[r+3]);} \
      float rm=__builtin_fmaxf(a,b); { auto rr=__builtin_amdgcn_permlane32_swap(__float_as_uint(rm),__float_as_uint(rm),false,false); rm=__builtin_fmaxf(__uint_as_float(rr[0]),__uint_as_float(rr[1])); } \
      if constexpr(VD==2) rm-=mhat;                   \
      resc=false; \
      if(__builtin_expect(__any(rm>(float)THRL),0)){ const float dl=__builtin_fmaxf(rm,0.f); mhat+=dl; \
        if constexpr(VD==1){ _Pragma("unroll") for(int r=0;r<16;++r){C0[r]-=dl;C1[r]-=dl;} \
          _Pragma("unroll") for(int r=0;r<16;++r)negm[r]=-mhat; asm volatile("":"+v"(negm)); } \
        const float f=__builtin_amdgcn_exp2f(-dl); l_reg*=f; if(hi==0)wsf[r32]=f; resc=true; } \
      if constexpr(VD==2){ _Pragma("unroll") for(int r=0;r<16;++r){C0[r]-=mhat;C1[r]-=mhat;} } } \
    SBAR(); \
    GAPB(o[0]=__builtin_amdgcn_mfma_f32_32x32x16_bf16(PAF(0),VFR(0),o[0],0,0,0), C0,0); \
    GAPB(o[1]=__builtin_amdgcn_mfma_f32_32x32x16_bf16(PAF(0),VFR(4),o[1],0,0,0), C0,4); \
    KRD(GL,0); GAPB(o[0]=__builtin_amdgcn_mfma_f32_32x32x16_bf16(PAF(1),VFR(1),o[0],0,0,0), C0,8); \
    KRD(GL,1); GAPB(o[1]=__builtin_amdgcn_mfma_f32_32x32x16_bf16(PAF(1),VFR(5),o[1],0,0,0), C0,12); \
    KRD(GL,2); GAPB(o[0]=__builtin_amdgcn_mfma_f32_32x32x16_bf16(PAF(2),VFR(2),o[0],0,0,0), C1,0); \
    KRD(GL,3); GAPB(o[1]=__builtin_amdgcn_mfma_f32_32x32x16_bf16(PAF(2),VFR(6),o[1],0,0,0), C1,4); \
    GAPB(o[0]=__builtin_amdgcn_mfma_f32_32x32x16_bf16(PAF(3),VFR(3),o[0],0,0,0), C1,8); \
    GAPB(o[1]=__builtin_amdgcn_mfma_f32_32x32x16_bf16(PAF(3),VFR(7),o[1],0,0,0), C1,12); \
    if constexpr(VD==2){ pv(o+2,vb0+VD*sl_prev+8192,PAF(0),PAF(1),PAF(2),PAF(3)); SBAR(); }     \
    }while(0)
  #define WB_FULL() do{ if constexpr(VD==2){WAIT_BAR(3);}else{WAIT_BAR(2);} }while(0)
  #define WB_VONLY() do{ if constexpr(VD==2){WAIT_BAR(2);}else{WAIT_BAR(1);} }while(0)
  int t=1;
  #undef CMASK
  #define CMASK(P0,P1,t) mk.apply(P0,P1,(t),hi)
  for(;t+5<NT;t+=2){
    STEP(pB0,pB1,pA0,pA1,t,true,true,true);     WB_FULL(); RESC(); ROT();
    STEP(pA0,pA1,pB0,pB1,t+1,true,true,true);   WB_FULL(); RESC(); ROT();
  }
  #undef CMASK
  #define CMASK(P0,P1,t) mk.apply(P0,P1,(t),hi)
  #define ENDW(tt) do{ if((tt)+3<NT){WB_FULL();} else if((tt)+2<NT){WB_VONLY();} else {WAIT_BAR(0);} }while(0)
  for(;t+1<NT;t+=2){
    STEP(pB0,pB1,pA0,pA1,t,(t+3<NT),(t+1<NT),(t+1<NT));       ENDW(t);   RESC(); ROT();
    STEP(pA0,pA1,pB0,pB1,t+1,(t+4<NT),(t+2<NT),(t+2<NT));     ENDW(t+1); RESC(); ROT();
  }
  STEP(pB0,pB1,pA0,pA1,NT-1,false,false,false); RESC();
  { float sacc=pB0[0]+pB0[1]; _Pragma("unroll") for(int r=2;r<16;++r)sacc+=pB0[r]; _Pragma("unroll") for(int r=0;r<16;++r)sacc+=pB1[r]; l_reg+=sacc;
    pw0=(u32x4){PKW(pB0,0),PKW(pB0,2),PKW(pB0,4),PKW(pB0,6)};pw1=(u32x4){PKW(pB0,8),PKW(pB0,10),PKW(pB0,12),PKW(pB0,14)};pw2=(u32x4){PKW(pB1,0),PKW(pB1,2),PKW(pB1,4),PKW(pB1,6)};pw3=(u32x4){PKW(pB1,8),PKW(pB1,10),PKW(pB1,12),PKW(pB1,14)};
    SBAR(); pv(o,vb0+VD*sl_cur,PAF(0),PAF(1),PAF(2),PAF(3)); if constexpr(VD==2) pv(o+2,vb0+VD*sl_cur+8192,PAF(0),PAF(1),PAF(2),PAF(3)); }
  #undef PKW
  #undef PAF
  #undef VFR
  #undef PIN
  #undef MX3
  #undef GAPA
  #undef GAPB
  #undef EX
  #undef VRD
  #undef KRD
  #undef STEP
  #undef ENDW
  #undef WB_FULL
  #undef WB_VONLY
  {auto rr=__builtin_amdgcn_permlane32_swap(__float_as_uint(l_reg),__float_as_uint(l_reg),false,false);l_reg=__uint_as_float(rr[0])+__uint_as_float(rr[1]);}
  if(hi==0)wsf[32+r32]=l_reg;asm volatile("s_waitcnt lgkmcnt(0)":::"memory");
  float rli[16];
  #pragma unroll
  for(int r=0;r<16;++r)rli[r]=__builtin_amdgcn_rcpf(wsf[32+crow(r,hi)]);
  int lane_e=lane; asm volatile("":"+v"(lane_e));
  bf16*Ow=u.Op+(long)(u.qrow0+wid*QBLK)*OPITCH;
  { bf16*stg=(bf16*)(shm+L_OST)+wid*2048;
    #pragma unroll
    for(int vh_=0;vh_<VD;++vh_){
      #pragma unroll
      for(int r=0;r<16;++r){const int orow=crow(r,hi);
        #pragma unroll
        for(int d0=0;d0<2;++d0)stg[orow*64+d0*32+r32]=__float2bfloat16(o[2*vh_+d0][r]*rli[r]);}
      asm volatile("s_waitcnt lgkmcnt(0)":::"memory");
      #pragma unroll
      for(int i=0;i<4;++i){const int row=i*8+(lane_e>>3),ch=lane_e&7; const u32x4 v=*(const u32x4*)(stg+row*64+ch*8); ATTN_STORE16(Ow+(long)row*OPITCH+64*vh_+ch*8,v);}
      asm volatile("s_waitcnt lgkmcnt(0)":::"memory"); } }
  asm volatile("s_waitcnt lgkmcnt(0)\n\ts_barrier":::"memory");
  #undef QF
  #undef DMA_K
  #undef TROW
  #undef DMA_V
  #undef CMASK
  #undef START
  #undef RESC
  #undef ROT
}
constexpr int ATTN_LDS_BYTES=LDS_BYTES;
#undef SBAR
#undef WAIT_BAR
}

struct Params { const float* in[26]; float* out; unsigned char* ws; int ph_lo, ph_hi; };
struct Ctx { LAS unsigned char* lds; int tid, lane, wave, vcu, G, gw, NGW; };
enum { I_X = 0, I_C, I_CTX, I_CCTX, I_ADAW, I_ADAB, I_LNG, I_LNB, I_W0IN, I_W0OUT, I_LQ1, I_LK1, I_LQ2, I_LK2, I_SUBLN, I_QN, I_KN,
       I_W1IN, I_W1OUT, I_RPB, I_POOLW, I_POOLS, I_ROUTER, I_WG, I_WU, I_WD };

__device__ __forceinline__ const float* mod_row(const Params& p, int layer, int row) {
    return (const float*)(p.ws + WS_MOD) + (size_t)(layer * 9 + (row < LAT ? (row >> 11) : 8)) * 6144;
}

__device__ __forceinline__ void ph_prologue(const Params& p, const Ctx& c) {
    const float* cin = p.in[I_C]; const float* cctx = p.in[I_CCTX]; const float* ada_w = p.in[I_ADAW]; const float* ada_b = p.in[I_ADAB];
    float* MOD = (float*)(p.ws + WS_MOD);
    LAS float* sc = (LAS float*)c.lds;
    LAS float* red = sc + 9 * 1024;
    for (int i = c.tid; i < 9 * 1024; i += 512) { const float v = i < 8192 ? cin[i] : cctx[i - 8192]; sc[i] = v / (1.f + expf(-v)); }
    __syncthreads();
    for (int u = c.vcu; u < 192; u += c.G) {
        const int layer = u / 96, j0 = (u - layer * 96) * 64;
        float acc[9];
#pragma unroll
        for (int m = 0; m < 9; ++m) acc[m] = 0.f;
        const float* wp = ada_w + (size_t)layer * 1024 * 6144 + (size_t)(128 * c.wave) * 6144 + j0 + c.lane;
#pragma unroll 1
        for (int kb = 0; kb < 128; kb += 32) {
            float wv[32];
#pragma unroll
            for (int i = 0; i < 32; ++i) wv[i] = wp[(size_t)(kb + i) * 6144];
#pragma unroll
            for (int i4 = 0; i4 < 8; ++i4)
#pragma unroll
                for (int m = 0; m < 9; ++m) { const f32x4 sv = *(const LAS f32x4*)(sc + m * 1024 + 128 * c.wave + kb + 4 * i4);
                    acc[m] += sv.x * wv[4 * i4] + sv.y * wv[4 * i4 + 1] + sv.z * wv[4 * i4 + 2] + sv.w * wv[4 * i4 + 3]; }
        }
#pragma unroll
        for (int m = 0; m < 9; ++m) red[(c.wave * 9 + m) * 64 + c.lane] = acc[m];
        __syncthreads();
        for (int o = c.tid; o < 576; o += 512) {
            const int m = o >> 6, j = o & 63; float s2 = 0.f;
#pragma unroll
            for (int w = 0; w < 8; ++w) s2 += red[(w * 9 + m) * 64 + j];
            MOD[(size_t)(layer * 9 + m) * 6144 + j0 + j] = s2 + ada_b[layer * 6144 + j0 + j];
        }
        __syncthreads();
    }
    if (c.vcu == 0) {
        f32x2* R = (f32x2*)(p.ws + WS_ROPE);
        for (int i = c.tid; i < 1024; i += 512) {
            const int pos = i >> 4, f = i & 15;
            const float inv = exp2f(-(float)f * (13.287712379549449f / 16.f));
            const float a = (float)pos * inv;
            const float k = rintf(a * 0.15915494309189535f);
            float rr = fmaf(-k, 6.28125f, a); rr = fmaf(-k, 1.9353071795864769e-3f, rr);
            R[i] = (f32x2){__cosf(rr), __sinf(rr)};
        }
    }
}


__device__ __forceinline__ void transpose_item(const float* W, int ldw, int k0, int n0, bf16* WT, int Kd, int drow0, LAS float* scr, int lane) {
#pragma unroll 8
    for (int i = 0; i < 32; ++i) { const int kk = 2 * i + (lane >> 5); scr[kk * 33 + (lane & 31)] = W[(size_t)(k0 + kk) * ldw + n0 + (lane & 31)]; }
    asm volatile("s_waitcnt lgkmcnt(0)" ::: "memory");
    const int ch = lane & 7;
#pragma unroll
    for (int j = 0; j < 4; ++j) { const int n = (lane >> 3) + 8 * j; const LAS float* sp = scr + (8 * ch) * 33 + n;
        v4u o; o.x = pk2(sp[0 * 33], sp[1 * 33]); o.y = pk2(sp[2 * 33], sp[3 * 33]); o.z = pk2(sp[4 * 33], sp[5 * 33]); o.w = pk2(sp[6 * 33], sp[7 * 33]);
        *(v4u*)(WT + (size_t)(drow0 + n) * Kd + k0 + 8 * ch) = o; }
    asm volatile("s_waitcnt lgkmcnt(0)" ::: "memory");
}
__device__ __forceinline__ void transpose_item8(const float* W, int ldw, int k0, int n0, unsigned char* WT8, int Kd, int drow0, float scale, LAS float* scr, int lane) {
#pragma unroll 8
    for (int i = 0; i < 32; ++i) { const int kk = 2 * i + (lane >> 5); scr[kk * 33 + (lane & 31)] = W[(size_t)(k0 + kk) * ldw + n0 + (lane & 31)]; }
    asm volatile("s_waitcnt lgkmcnt(0)" ::: "memory");
    const int n = lane >> 1, hf = lane & 1; const LAS float* sp = scr + (32 * hf) * 33 + n;
    v4u o0, o1;
    o0.x = pg8::pk4_fp8(sp[0 * 33] * scale, sp[1 * 33] * scale, sp[2 * 33] * scale, sp[3 * 33] * scale);     o0.y = pg8::pk4_fp8(sp[4 * 33] * scale, sp[5 * 33] * scale, sp[6 * 33] * scale, sp[7 * 33] * scale);
    o0.z = pg8::pk4_fp8(sp[8 * 33] * scale, sp[9 * 33] * scale, sp[10 * 33] * scale, sp[11 * 33] * scale);   o0.w = pg8::pk4_fp8(sp[12 * 33] * scale, sp[13 * 33] * scale, sp[14 * 33] * scale, sp[15 * 33] * scale);
    o1.x = pg8::pk4_fp8(sp[16 * 33] * scale, sp[17 * 33] * scale, sp[18 * 33] * scale, sp[19 * 33] * scale); o1.y = pg8::pk4_fp8(sp[20 * 33] * scale, sp[21 * 33] * scale, sp[22 * 33] * scale, sp[23 * 33] * scale);
    o1.z = pg8::pk4_fp8(sp[24 * 33] * scale, sp[25 * 33] * scale, sp[26 * 33] * scale, sp[27 * 33] * scale); o1.w = pg8::pk4_fp8(sp[28 * 33] * scale, sp[29 * 33] * scale, sp[30 * 33] * scale, sp[31 * 33] * scale);
    unsigned char* dst = WT8 + (size_t)(drow0 + n) * Kd + k0 + 32 * hf;
    *(v4u*)dst = o0; *(v4u*)(dst + 16) = o1;
    asm volatile("s_waitcnt lgkmcnt(0)" ::: "memory");
}
struct TBlk { const float* src; unsigned char* dst; int ldw, Kd, gu, which; float scale; };
__device__ __forceinline__ TBlk tblk_decode(const Params& p, int blk) {
    const int ie = blk / 96, q = blk - ie * 96, layer = ie >> 4, e = ie & 15, which = q >> 5, idx = q & 31;
    TBlk t; t.which = which;
    if (which < 2) { const int kb = idx & 3, nb = idx >> 2, k0 = 256 * kb, n0 = 256 * nb;
        t.src = (which == 0 ? p.in[I_WG] : p.in[I_WU]) + (size_t)ie * DM * FF + (size_t)k0 * FF + n0; t.ldw = FF; t.Kd = DM; t.scale = W8_GU; t.gu = 1;
        t.dst = p.ws + WS_WGU + (size_t)layer * WS_MOE_LSTRIDE + (size_t)e * 4096 * DM + (size_t)(2 * nb) * 256 * DM + k0; }
    else { const int kb = idx & 7, nb = idx >> 3, k0 = 256 * kb, n0 = 256 * nb;
        t.src = p.in[I_WD] + (size_t)ie * FF * DM + (size_t)k0 * DM + n0; t.ldw = DM; t.Kd = FF; t.scale = W8_DN; t.gu = 0;
        t.dst = p.ws + WS_WDN + (size_t)layer * WS_MOE_LSTRIDE + (size_t)e * DM * FF + (size_t)n0 * FF + k0; }
    return t;
}
__device__ __forceinline__ void tblk_load(const TBlk& t, f32x4 (&v)[16], int wave, int lane, int hf) {
    const float* sp = t.src + (size_t)(32 * wave + 16 * hf) * t.ldw + 4 * lane;
#pragma unroll
    for (int i = 0; i < 16; ++i) v[i] = __builtin_nontemporal_load((const f32x4*)(sp + (size_t)i * t.ldw));
}
constexpr int TPITCH = 264;
__device__ __forceinline__ void tblk_pack(const TBlk& t, const f32x4 (&v)[16], LAS unsigned char* T, int wave, int lane, int hf) {
#pragma unroll
    for (int i = 0; i < 4; ++i) {
        const f32x4 r0 = v[4 * i] * t.scale, r1 = v[4 * i + 1] * t.scale, r2 = v[4 * i + 2] * t.scale, r3 = v[4 * i + 3] * t.scale;
#pragma unroll
        for (int j = 0; j < 4; ++j) { int w = 0; w = __builtin_amdgcn_cvt_pk_fp8_f32(r0[j], r1[j], w, false); w = __builtin_amdgcn_cvt_pk_fp8_f32(r2[j], r3[j], w, true);
            *(LAS unsigned*)(T + (64 * j + lane) * TPITCH + 32 * wave + 16 * hf + 4 * i) = (unsigned)w; }
    }
}
__device__ __forceinline__ void tblk_writeout(const TBlk& t, const LAS unsigned char* T, int tid) {
#pragma unroll
    for (int it = 0; it < 8; ++it) { const int idx = it * 512 + tid, n = idx >> 4, ch = idx & 15, rho = (n & 3) * 64 + (n >> 2);
        const LAS unsigned char* sp = T + rho * TPITCH + 16 * ch;
        const v2u a = *(const LAS v2u*)sp, b2 = *(const LAS v2u*)(sp + 8);
        const int drow = t.gu ? ((n >> 7) * 256 + (n & 127) + t.which * 128) : n;
        __builtin_nontemporal_store((v4u){a.x, a.y, b2.x, b2.y}, (v4u*)(t.dst + (size_t)drow * t.Kd + 16 * ch)); }
}
__device__ __forceinline__ void moe_transpose_blocks(const Params& p, const Ctx& c, int blk0, int blk1, int widx, int nw) {
    LAS unsigned char* T = c.lds;
    f32x4 va[16], vb[16];
    int blk = blk0 + widx;
    if (blk >= blk1) return;
    TBlk t = tblk_decode(p, blk);
    tblk_load(t, va, c.wave, c.lane, 0);
#pragma unroll 1
    for (; blk < blk1; blk += nw) {
        tblk_load(t, vb, c.wave, c.lane, 1);
        tblk_pack(t, va, T, c.wave, c.lane, 0);
        const int nb = blk + nw;
        TBlk tn = tblk_decode(p, nb < blk1 ? nb : blk0);
        if (nb < blk1) tblk_load(tn, va, c.wave, c.lane, 0);
        tblk_pack(t, vb, T, c.wave, c.lane, 1);
        __syncthreads();
        tblk_writeout(t, T, c.tid);
        __syncthreads();
        t = tn;
    }
}
__device__ __forceinline__ void tail_transposes(const Params& p, const Ctx& c, int first_idle, int my, int blk0, int nblk) {
    if (!TAIL_TRANSPOSE || c.G != 256 || my < first_idle) return;
    moe_transpose_blocks(p, c, blk0, blk0 + nblk, my - first_idle, c.G - first_idle);
}
__device__ __forceinline__ void ph_transposes(const Params& p, const Ctx& c) {
    LAS float* scr = (LAS float*)(c.lds + c.wave * 16384);
    constexpr int I0 = 16 * 72, I1 = 16 * 32, I2 = 16 * 64, I3 = 16 * 32, ISM = I0 + I1 + I2 + I3;
    for (int r0 = c.gw; r0 < ISM; r0 += c.NGW) {
        int r = r0;
        if (r < I0) { const int n0 = 32 * (r % 72), drow = FUSE_QKV ? ((n0 >> 8) * 256 + 128 * ((n0 >> 5) & 1) + 32 * ((n0 >> 6) & 3)) : n0;
            transpose_item(p.in[I_W0IN], EIN, 64 * (r / 72), n0, (bf16*)(p.ws + WS_W0IN), DM, drow, scr, c.lane); continue; } r -= I0;
        if (r < I1) { transpose_item(p.in[I_W0OUT], DM, 64 * (r / 32), 32 * (r % 32), (bf16*)(p.ws + WS_W0OUT), DM, 32 * (r % 32), scr, c.lane); continue; } r -= I1;
        if (r < I2) { transpose_item(p.in[I_W1IN], OIN, 64 * (r / 64), 32 * (r % 64), (bf16*)(p.ws + WS_W1IN), DM, 32 * (r % 64), scr, c.lane); continue; } r -= I2;
        transpose_item(p.in[I_W1OUT], DM, 64 * (r / 32), 32 * (r % 32), (bf16*)(p.ws + WS_W1OUT), DM, 32 * (r % 32), scr, c.lane);
    }
    static_assert(MOE_FP8, "the expert-weight transposes write e4m3 copies");
    __syncthreads();
    moe_transpose_blocks(p, c, 0, (TAIL_TRANSPOSE && c.G == 256) ? 1536 : 3072, c.vcu, c.G);
}

__device__ __forceinline__ void ph_modulate0(const Params& p, const Ctx& c) {
    bf16* HB = (bf16*)(p.ws + WS_HB);
    for (int row = c.gw; row < NTOK; row += c.NGW) {
        const float* src = row < LAT ? p.in[I_X] + (size_t)row * DM : p.in[I_CTX] + (size_t)(row - LAT) * DM;
        const float* mod = mod_row(p, 0, row);
#pragma unroll
        for (int j = 0; j < 4; ++j) {
            const int col = 4 * c.lane + 256 * j;
            const f32x4 v = *(const f32x4*)(src + col), sh = *(const f32x4*)(mod + col), s = *(const f32x4*)(mod + 1024 + col);
            const f32x4 h = v * (s + 1.f) + sh;
            *(v2u*)(HB + (size_t)row * DM + col) = (v2u){pk2(h.x, h.y), pk2(h.z, h.w)};
        }
    }
}

struct NG { const bf16* A; int lda; const float* W0; const float* W1; int ldw; size_t wstride; int Mb; int row_begin, row_end, col_begin, col_end, K; };
template <int NB, class Epi>
__device__ __forceinline__ void ngemm(const NG& g, const Ctx& c, const Epi& epi) {
    const int nmt = (g.row_end - g.row_begin) / 32, nnt = (g.col_end - g.col_begin) / 32;
    const int l31 = c.lane & 31, lh = c.lane >> 5;
    for (int t = c.gw; t < nmt * nnt; t += c.NGW) {
        const int mt = t / nnt, nt = t % nnt;
        const int row0 = g.row_begin + mt * 32, col0 = g.col_begin + nt * 32;
        const int e = row0 / g.Mb;
        const bf16* ap = g.A + (size_t)(row0 + l31) * g.lda + lh;
        const float* bp0 = g.W0 + (size_t)e * g.wstride + (size_t)lh * g.ldw + col0 + l31;
        const float* bp1 = NB == 2 ? g.W1 + (size_t)e * g.wstride + (size_t)lh * g.ldw + col0 + l31 : nullptr;
        f32x16 acc0 = {}, acc1 = {};
#pragma unroll 8
        for (int k = 0; k < g.K; k += 2) {
            const float a = bf2f((unsigned)ap[k]);
            const float b0 = bp0[(size_t)k * g.ldw];
            acc0 = __builtin_amdgcn_mfma_f32_32x32x2f32(a, b0, acc0, 0, 0, 0);
            if (NB == 2) { const float b1 = bp1[(size_t)k * g.ldw]; acc1 = __builtin_amdgcn_mfma_f32_32x32x2f32(a, b1, acc1, 0, 0, 0); }
        }
#pragma unroll
        for (int r = 0; r < 16; ++r) {
            const int row = row0 + (r & 3) + 8 * (r >> 2) + 4 * lh, col = col0 + l31;
            epi(row, col, acc0[r], acc1[r]);
        }
    }
}
struct EpiF32 { float* O; int ldc; __device__ __forceinline__ void operator()(int row, int col, float v0, float) const { O[(size_t)row * ldc + col] = v0; } };
struct EpiBf { bf16* O; int ldc; int scale_cols; float sc; __device__ __forceinline__ void operator()(int row, int col, float v0, float) const { O[(size_t)row * ldc + col] = (bf16)f2bf(col < scale_cols ? v0 * sc : v0); } };
struct EpiSwiglu { bf16* O; __device__ __forceinline__ void operator()(int row, int col, float g, float u) const { const float s = g / (1.f + __expf(-g)); O[(size_t)row * FF + col] = (bf16)f2bf(s * u); } };
struct EpiGate { bf16* O; const float* gate; __device__ __forceinline__ void operator()(int row, int col, float v0, float) const { O[(size_t)row * DM + col] = (bf16)f2bf(v0 * gate[row]); } };

template <bool F32IN> __device__ __forceinline__ void ph_qkv_post(const Params& p, const Ctx& c) {
    const float* PF = (const float*)(p.ws + WS_PF);
    bf16* QKV = (bf16*)(p.ws + WS_QKV);
    const f32x2* R = (const f32x2*)(p.ws + WS_ROPE);
    const float* qn = p.in[I_QN]; const float* kn = p.in[I_KN];
    const int d = c.lane;
    const float qg = qn[d], kg = kn[d];
    for (int row = c.gw; row < NTOK; row += c.NGW) {
        const bool lat = row < LAT;
        const int t = row & 2047;
        const int pos = (d < 32) ? (t >> 6) : (t & 63);
        const f32x2 cs = R[pos * 16 + (d & 15)];
        const bool first = (d & 16) == 0;
        float vv[36];
#pragma unroll
        for (int hs = 0; hs < 36; ++hs) vv[hs] = F32IN ? PF[(size_t)row * EIN + hs * 64 + d] : bf2f((unsigned)QKV[(size_t)row * EIN + hs * 64 + d]);
#pragma unroll
        for (int hs = 0; hs < 36; ++hs) {
            float v = vv[hs];
            const bool isq = hs < 8 || (hs >= 24 && hs < 32);
            const bool isk = (hs >= 8 && hs < 16) || hs == 32 || hs == 33;
            const bool nrm = hs >= 24 && hs < 34;
            if (nrm) { const float ss = wave_sum(v * v); v = v * rsqrtf(ss * (1.f / 64.f) + RMS_EPS) * (hs < 32 ? qg : kg); }
            if ((isq || isk) && lat) { const float pr = __shfl_xor(v, 16); v = first ? v * cs.x - pr * cs.y : v * cs.x + pr * cs.y; }
            if (isq) v *= C2;
            QKV[(size_t)row * EIN + hs * 64 + d] = (bf16)f2bf(v);
        }
    }
}

__device__ __forceinline__ void ph_attn0_naive(const Params& p, const Ctx& c) {
    const bf16* QKV = (const bf16*)(p.ws + WS_QKV);
    bf16* CC = (bf16*)(p.ws + WS_CC);
    bf16* AO = (bf16*)(p.ws + WS_AO);
    LAS float* Ks = (LAS float*)c.lds;
    LAS float* Vs = Ks + 4096;
    for (int u = c.vcu; u < 960; u += c.G) {
        const bool isctx = u >= 768;
        int b, vh, qrow, ntiles; bool active = true;
        if (!isctx) { b = u / 96; const int r = u % 96; vh = r >> 2; qrow = b * SEQ + (r & 3) * 512 + c.tid; ntiles = 36; }
        else { const int uu = u - 768; b = uu / 24; vh = uu % 24; qrow = LAT + b * NCTX + (c.tid & 255); active = c.tid < 256; ntiles = 4; }
        int qcol, kcol, vcol;
        if (vh < 16) { const int a = vh >> 2, s = (vh >> 1) & 1, half = vh & 1; qcol = a * 128 + s * 64; kcol = 512 + a * 128 + s * 64; vcol = 1024 + a * 128 + half * 64; }
        else { const int h = vh - 16; qcol = 1536 + h * 64; kcol = 2048 + (h >> 2) * 64; vcol = 2176 + (h >> 2) * 64; }
        float q[64], o[64];
#pragma unroll
        for (int i = 0; i < 8; ++i) { const v4u w = *(const v4u*)(QKV + (size_t)qrow * EIN + qcol + 8 * i); unpack8(w, q + 8 * i); }
#pragma unroll
        for (int i = 0; i < 64; ++i) o[i] = 0.f;
        float m = -1e30f, l = 0.f;
        for (int t = 0; t < ntiles; ++t) {
            const int krow0 = isctx ? LAT + b * NCTX + 64 * t : (t < 32 ? b * SEQ + 64 * t : LAT + b * NCTX + 64 * (t - 32));
            __syncthreads();
            { const int r = c.tid >> 3, ch = c.tid & 7; float f[8];
              const v4u kw = *(const v4u*)(QKV + (size_t)(krow0 + r) * EIN + kcol + ch * 8); unpack8(kw, f);
#pragma unroll
              for (int j = 0; j < 8; ++j) Ks[r * 64 + ch * 8 + j] = f[j];
              const v4u vw = *(const v4u*)(QKV + (size_t)(krow0 + r) * EIN + vcol + ch * 8); unpack8(vw, f);
#pragma unroll
              for (int j = 0; j < 8; ++j) Vs[r * 64 + ch * 8 + j] = f[j]; }
            __syncthreads();
            if (active) {
                for (int kk = 0; kk < 64; ++kk) {
                    float s = 0.f;
#pragma unroll
                    for (int dd = 0; dd < 64; ++dd) s += q[dd] * Ks[kk * 64 + dd];
                    const float mn = fmaxf(m, s), al = exp2f(m - mn), pp = exp2f(s - mn);
                    l = l * al + pp; m = mn;
#pragma unroll
                    for (int dd = 0; dd < 64; ++dd) o[dd] = o[dd] * al + pp * Vs[kk * 64 + dd];
                }
            }
        }
        if (active) {
            const float rl = 1.f / l;
            bf16* dst = vh < 16 ? AO + (size_t)qrow * DM + (vh >> 2) * 256 + ((vh >> 1) & 1) * 128 + (vh & 1) * 64 : CC + (size_t)qrow * DM + 512 + (vh - 16) * 64;
            {
#pragma unroll
                for (int i = 0; i < 8; ++i) *(v4u*)(dst + 8 * i) = (v4u){pk2(o[8 * i] * rl, o[8 * i + 1] * rl), pk2(o[8 * i + 2] * rl, o[8 * i + 3] * rl), pk2(o[8 * i + 4] * rl, o[8 * i + 5] * rl), pk2(o[8 * i + 6] * rl, o[8 * i + 7] * rl)}; }
        }
    }
}


__device__ __forceinline__ void attn_combine_rows(const Params& p, const Ctx& c, int row0, int a, float lam, float g0, float g1) {
    const bf16* AO = (const bf16*)(p.ws + WS_AO); bf16* CC = (bf16*)(p.ws + WS_CC);
    asm volatile("s_waitcnt vmcnt(0)" ::: "memory");
#pragma unroll 1
    for (int rb = 0; rb < 32; rb += 8) {
        float x0[8], x1[8];
#pragma unroll
        for (int j = 0; j < 8; ++j) { const bf16* src = AO + (size_t)(row0 + rb + j) * DM + a * 256;
            x0[j] = bf2f((unsigned)src[c.lane]) - lam * bf2f((unsigned)src[128 + c.lane]); x1[j] = bf2f((unsigned)src[64 + c.lane]) - lam * bf2f((unsigned)src[192 + c.lane]); }
#pragma unroll
        for (int j = 0; j < 8; ++j) { const float ss = wave_sum(x0[j] * x0[j] + x1[j] * x1[j]); const float r = rsqrtf(ss * (1.f / 128.f) + RMS_EPS);
            bf16* dst = CC + (size_t)(row0 + rb + j) * DM + a * 128;
            dst[c.lane] = (bf16)f2bf(x0[j] * r * g0); dst[64 + c.lane] = (bf16)f2bf(x1[j] * r * g1); }
    }
}
__device__ __forceinline__ void ph_attn0_fast(const Params& p, const Ctx& c, char* lds_generic) {
    typedef attn_body::bf16 abf;
    const abf* Q = (const abf*)(p.ws + WS_QKV); abf* CCb = (abf*)(p.ws + WS_CC); abf* AOb = (abf*)(p.ws + WS_AO);
    const float d1 = wave_sum(p.in[I_LQ1][c.lane] * p.in[I_LK1][c.lane]), d2 = wave_sum(p.in[I_LQ2][c.lane] * p.in[I_LK2][c.lane]);
    const float lam = expf(d1) - expf(d2) + LAM_INIT;
    const float g0 = p.in[I_SUBLN][c.lane] * (1.f - LAM_INIT), g1 = p.in[I_SUBLN][c.lane + 64] * (1.f - LAM_INIT);
    for (int v = c.vcu; v < 256; v += c.G) {
#pragma unroll 1
        for (int step = 0; step < 6; ++step) {
            attn_body::AU u; int a = -1, sp = 0, h = 0; bool ctxu = false;
            if (step < 2) { const int b = v >> 5; a = (v >> 3) & 3; sp = step; u.qrow0 = b * SEQ + (v & 7) * 256; u.lat_row0 = b * SEQ; u.ctx_row0 = LAT + b * NCTX; }
            else if (step < 4) { const int U = (step - 2) * 256 + v, b = U >> 6; h = (U >> 3) & 7; u.qrow0 = b * SEQ + (U & 7) * 256; u.lat_row0 = b * SEQ; u.ctx_row0 = LAT + b * NCTX; }
            else { ctxu = true; int b;
                if (v < 32) { b = v >> 2; a = v & 3; sp = step - 4; }
                else if (v < 96 && step == 4) { b = (v - 32) >> 3; h = (v - 32) & 7; }
                else break;
                u.qrow0 = LAT + b * NCTX; u.lat_row0 = 0; u.ctx_row0 = LAT + b * NCTX; }
            if (!ctxu) { u.nlat_t = 32; u.NT = 36; } else { u.nlat_t = 0; u.NT = 4; }
            if (a >= 0) {
                u.Qp = Q + a * 128 + sp * 64; u.Kp = Q + 512 + a * 128 + sp * 64; u.Vp = Q + 1024 + a * 128; u.Op = AOb + a * 256 + sp * 128;
                attn_body::attn_unit<8, EIN, attn_body::NoMask, 2>(u, lds_generic, attn_body::NoMask{});
                if (sp == 1) attn_combine_rows(p, c, u.qrow0 + c.wave * 32, a, lam, g0, g1);
            } else {
                u.Qp = Q + 1536 + h * 64; u.Kp = Q + 2048 + (h >> 2) * 64; u.Vp = Q + 2176 + (h >> 2) * 64; u.Op = CCb + 512 + h * 64;
                attn_body::attn_unit<8, EIN, attn_body::NoMask, 1>(u, lds_generic, attn_body::NoMask{});
            }
        }
    }
    tail_transposes(p, c, 96, c.vcu, 1536 + 120, 320);
}

__device__ __forceinline__ void ph_attn_combine(const Params& p, const Ctx& c) {
    const bf16* AO = (const bf16*)(p.ws + WS_AO);
    bf16* CC = (bf16*)(p.ws + WS_CC);
    const float d1 = wave_sum(p.in[I_LQ1][c.lane] * p.in[I_LK1][c.lane]);
    const float d2 = wave_sum(p.in[I_LQ2][c.lane] * p.in[I_LK2][c.lane]);
    const float lam = expf(d1) - expf(d2) + LAM_INIT;
    const float g0 = p.in[I_SUBLN][c.lane] * (1.f - LAM_INIT), g1 = p.in[I_SUBLN][c.lane + 64] * (1.f - LAM_INIT);
    for (int it = c.gw; it < NTOK * 4; it += c.NGW) {
        const int row = it >> 2, a = it & 3;
        const bf16* src = AO + (size_t)row * DM + a * 256;
        const float x0 = bf2f((unsigned)src[c.lane]) - lam * bf2f((unsigned)src[128 + c.lane]), x1 = bf2f((unsigned)src[64 + c.lane]) - lam * bf2f((unsigned)src[192 + c.lane]);
        const float ss = wave_sum(x0 * x0 + x1 * x1);
        const float r = rsqrtf(ss * (1.f / 128.f) + RMS_EPS);
        CC[(size_t)row * DM + a * 128 + c.lane] = (bf16)f2bf(x0 * r * g0);
        CC[(size_t)row * DM + a * 128 + 64 + c.lane] = (bf16)f2bf(x1 * r * g1);
    }
}

__device__ __forceinline__ f32x4 unpack4(const v2u w) { return (f32x4){bf2f(w.x & 0xffffu), __uint_as_float(w.x & 0xffff0000u), bf2f(w.y & 0xffffu), __uint_as_float(w.y & 0xffff0000u)}; }
__device__ __forceinline__ float reduce_logits(const f32x4 (&lg)[4], int lane) {
    float w8[8], w4[4], w2[2], w1;
    { const bool hi = (lane & 32) != 0;
#pragma unroll
      for (int i = 0; i < 8; ++i) { const float a0 = lg[i >> 2][i & 3], a1 = lg[2 + (i >> 2)][i & 3]; const float keep = hi ? a1 : a0, send = hi ? a0 : a1; w8[i] = keep + __shfl_xor(send, 32); } }
    { const bool hi = (lane & 16) != 0;
#pragma unroll
      for (int i = 0; i < 4; ++i) { const float keep = hi ? w8[i + 4] : w8[i], send = hi ? w8[i] : w8[i + 4]; w4[i] = keep + __shfl_xor(send, 16); } }
    { const bool hi = (lane & 8) != 0;
#pragma unroll
      for (int i = 0; i < 2; ++i) { const float keep = hi ? w4[i + 2] : w4[i], send = hi ? w4[i] : w4[i + 2]; w2[i] = keep + __shfl_xor(send, 8); } }
    { const bool hi = (lane & 4) != 0; const float keep = hi ? w2[1] : w2[0], send = hi ? w2[0] : w2[1]; w1 = keep + __shfl_xor(send, 4); }
    w1 += __shfl_xor(w1, 2); w1 += __shfl_xor(w1, 1);
    return w1;
}
__device__ __forceinline__ void ph_ln1_router(const Params& p, const Ctx& c, int layer) {
    const bf16* Y = (const bf16*)(p.ws + WS_Y);
    bf16* XS = (bf16*)(p.ws + WS_XS);
    bf16* HB = (bf16*)(p.ws + WS_HB);
    float* AFF = (float*)(p.ws + WS_AFF);
    const float* lng = p.in[I_LNG] + (size_t)(layer * 2 + 0) * DM; const float* lnb = p.in[I_LNB] + (size_t)(layer * 2 + 0) * DM;
    const float* router = p.in[I_ROUTER] + (size_t)layer * DM * NE;
    LAS f32x4* R = (LAS f32x4*)c.lds;
    for (int idx = c.tid; idx < 4096; idx += 512) { const int e4 = idx & 3, k = idx >> 2, ln = (k & 255) >> 2, q = k & 3, j = k >> 8;
        R[((j * 4 + q) * 4 + e4) * 64 + ln] = *(const f32x4*)(router + (size_t)k * NE + 4 * e4); }
    __syncthreads();
    const int nrows = layer == 0 ? NTOK : LAT;
    const int lane = c.lane;
    for (int row = 2 * c.gw; row < nrows; row += 2 * c.NGW) {
        const float* mod = mod_row(p, layer, row);
        f32x4 va[4], vb[4]; float sa = 0.f, sb = 0.f;
#pragma unroll
        for (int j = 0; j < 4; ++j) { const int col = 4 * lane + 256 * j;
            f32x4 xa, xb;
            if (layer == 0) { const float* xin = row < LAT ? p.in[I_X] + (size_t)row * DM : p.in[I_CTX] + (size_t)(row - LAT) * DM; xa = *(const f32x4*)(xin + col); xb = *(const f32x4*)(xin + DM + col); }
            else { xa = unpack4(*(const v2u*)(XS + (size_t)row * DM + col)); xb = unpack4(*(const v2u*)(XS + (size_t)(row + 1) * DM + col)); }
            const f32x4 g1 = *(const f32x4*)(mod + 2048 + col);
            va[j] = xa * ALPHA + g1 * unpack4(*(const v2u*)(Y + (size_t)row * DM + col));
            vb[j] = xb * ALPHA + g1 * unpack4(*(const v2u*)(Y + (size_t)(row + 1) * DM + col));
            sa += (va[j].x + va[j].y) + (va[j].z + va[j].w); sb += (vb[j].x + vb[j].y) + (vb[j].z + vb[j].w); }
        const float meana = wave_sum(sa) * (1.f / DM), meanb = wave_sum(sb) * (1.f / DM); float qa = 0.f, qb = 0.f;
#pragma unroll
        for (int j = 0; j < 4; ++j) { va[j] = va[j] - meana; vb[j] = vb[j] - meanb;
            qa += (va[j].x * va[j].x + va[j].y * va[j].y) + (va[j].z * va[j].z + va[j].w * va[j].w); qb += (vb[j].x * vb[j].x + vb[j].y * vb[j].y) + (vb[j].z * vb[j].z + vb[j].w * vb[j].w); }
        const float rstda = 1.f / sqrtf(wave_sum(qa) * (1.f / DM) + LN_EPS), rstdb = 1.f / sqrtf(wave_sum(qb) * (1.f / DM) + LN_EPS);
        f32x4 lga[4], lgb[4];
#pragma unroll
        for (int e = 0; e < 4; ++e) { lga[e] = (f32x4){0.f, 0.f, 0.f, 0.f}; lgb[e] = (f32x4){0.f, 0.f, 0.f, 0.f}; }
#pragma unroll
        for (int j = 0; j < 4; ++j) { const int col = 4 * lane + 256 * j;
            const f32x4 g = *(const f32x4*)(lng + col), bb = *(const f32x4*)(lnb + col), sc = *(const f32x4*)(mod + 4096 + col) + 1.f, sh = *(const f32x4*)(mod + 3072 + col);
            const f32x4 x1a = va[j] * rstda * g + bb, x1b = vb[j] * rstdb * g + bb;
            *(v2u*)(XS + (size_t)row * DM + col) = (v2u){pk2(x1a.x, x1a.y), pk2(x1a.z, x1a.w)};
            *(v2u*)(XS + (size_t)(row + 1) * DM + col) = (v2u){pk2(x1b.x, x1b.y), pk2(x1b.z, x1b.w)};
            const f32x4 hma = x1a * sc + sh, hmb = x1b * sc + sh;
            if (MOE_FP8) { *(unsigned*)((unsigned char*)HB + (size_t)row * DM + col) = pg8::pk4_fp8(hma.x, hma.y, hma.z, hma.w);
                           *(unsigned*)((unsigned char*)HB + (size_t)(row + 1) * DM + col) = pg8::pk4_fp8(hmb.x, hmb.y, hmb.z, hmb.w); }
            else { *(v2u*)(HB + (size_t)row * DM + col) = (v2u){pk2(hma.x, hma.y), pk2(hma.z, hma.w)}; *(v2u*)(HB + (size_t)(row + 1) * DM + col) = (v2u){pk2(hmb.x, hmb.y), pk2(hmb.z, hmb.w)}; }
            asm volatile("" ::: "memory");
#pragma unroll
            for (int q = 0; q < 4; ++q) { const float ha = hma[q], hb = hmb[q];
#pragma unroll
                for (int e4 = 0; e4 < 4; ++e4) { const f32x4 rw = R[((j * 4 + q) * 4 + e4) * 64 + lane]; lga[e4] += rw * ha; lgb[e4] += rw * hb; } } }
        const float wa = reduce_logits(lga, lane), wb = reduce_logits(lgb, lane);
        float mxa = wa, mxb = wb;
#pragma unroll
        for (int o = 4; o < 64; o <<= 1) { mxa = fmaxf(mxa, __shfl_xor(mxa, o)); mxb = fmaxf(mxb, __shfl_xor(mxb, o)); }
        const float exa = expf(wa - mxa), exb = expf(wb - mxb); float dena = exa, denb = exb;
#pragma unroll
        for (int o = 4; o < 64; o <<= 1) { dena += __shfl_xor(dena, o); denb += __shfl_xor(denb, o); }
        if ((lane & 3) == 0) { const int e = ((lane >> 5) & 1) * 8 + ((lane >> 4) & 1) * 4 + ((lane >> 3) & 1) * 2 + ((lane >> 2) & 1);
            AFF[(size_t)row * NE + e] = exa / dena; AFF[(size_t)(row + 1) * NE + e] = exb / denb; }
    }
}

__device__ __forceinline__ void ph_topk(const Params& p, const Ctx& c, int layer) {
    const float* AFF = (const float*)(p.ws + WS_AFF);
    int* INV = (int*)(p.ws + WS_INV);
    float* GATE = (float*)(p.ws + WS_GATE);
    const bf16* HB = (const bf16*)(p.ws + WS_HB);
    bf16* XG = (bf16*)(p.ws + WS_XG);
    LAS unsigned* hist = (LAS unsigned*)c.lds;
    LAS unsigned* ctl = hist + 256;
    LAS int* sel = (LAS int*)(c.lds + 2048);
    const int MR = layer == 0 ? MR0 : MR1;
    const int ntasks = layer == 0 ? 256 : 128;
    const int lane = c.lane;
    for (int task = c.vcu; task < ntasks; task += c.G) {
        int set, e, n, cap, rowbase, slotbase;
        if (task < 128) { set = task >> 4; e = task & 15; n = SEQ; cap = 256; rowbase = set * SEQ; slotbase = set * 256; }
        else { const int t2 = task - 128; set = t2 >> 4; e = t2 & 15; n = NCTX; cap = 32; rowbase = LAT + set * NCTX; slotbase = 2048 + set * 32; }
        const bool valid = 4 * c.tid < n;
        unsigned key[4];
#pragma unroll
        for (int q = 0; q < 4; ++q) key[q] = valid ? __float_as_uint(AFF[(size_t)(rowbase + 4 * c.tid + q) * NE + e]) : 0u;
        unsigned prefix = 0u, need = (unsigned)cap;
#pragma unroll 1
        for (int pass = 0; pass < 4; ++pass) {
            const int shift = 24 - 8 * pass;
            if (c.tid < 256) hist[c.tid] = 0u;
            __syncthreads();
            if (valid) {
#pragma unroll
                for (int q = 0; q < 4; ++q) if (pass == 0 || (key[q] >> (shift + 8)) == (prefix >> (shift + 8))) __hip_atomic_fetch_add(&hist[(key[q] >> shift) & 255u], 1u, __ATOMIC_RELAXED, __HIP_MEMORY_SCOPE_WORKGROUP);
            }
            __syncthreads();
            if (c.wave == 0) {
                const unsigned h0 = hist[4 * lane], h1 = hist[4 * lane + 1], h2 = hist[4 * lane + 2], h3 = hist[4 * lane + 3];
                const unsigned tot = h0 + h1 + h2 + h3; unsigned sfx = tot;
#pragma unroll
                for (int o = 1; o < 64; o <<= 1) { const unsigned t = __shfl_down(sfx, o); if (lane + o < 64) sfx += t; }
                const unsigned above = sfx - tot, c3 = above + h3, c2 = c3 + h2, c1 = c2 + h1, c0 = c1 + h0;
                int d = -1; unsigned gtc = 0u;
                if (above < need && need <= c3) { d = 3; gtc = above; }
                else if (c3 < need && need <= c2) { d = 2; gtc = c3; }
                else if (c2 < need && need <= c1) { d = 1; gtc = c2; }
                else if (c1 < need && need <= c0) { d = 0; gtc = c1; }
                if (d >= 0) { ctl[0] = prefix | ((unsigned)(4 * lane + d) << shift); ctl[1] = need - gtc; }
            }
            __syncthreads();
            prefix = ctl[0]; need = ctl[1];
        }
        unsigned ngt = 0u, neq = 0u;
#pragma unroll
        for (int q = 0; q < 4; ++q) { ngt += (valid && key[q] > prefix) ? 1u : 0u; neq += (valid && key[q] == prefix) ? 1u : 0u; }
        const unsigned cnt = ngt | (neq << 16); unsigned inc = cnt;
#pragma unroll
        for (int o = 1; o < 64; o <<= 1) { const unsigned t = __shfl_up(inc, o); if (lane >= o) inc += t; }
        if (lane == 63) ctl[8 + c.wave] = inc;
        __syncthreads();
        unsigned base = 0u;
#pragma unroll
        for (int w = 0; w < 8; ++w) base += (w < c.wave) ? ctl[8 + w] : 0u;
        const unsigned ex = base + inc - cnt; unsigned gtb = ex & 0xffffu, eqb = ex >> 16;
        if (valid) {
#pragma unroll
            for (int q = 0; q < 4; ++q) { const int i = 4 * c.tid + q; int slot = -1;
                if (key[q] > prefix) { slot = (int)(gtb + (eqb < need ? eqb : need)); ++gtb; }
                else if (key[q] == prefix) { if (eqb < need) slot = (int)(gtb + eqb); ++eqb; }
                int gs = -1;
                if (slot >= 0) { gs = e * MR + slotbase + slot; sel[slot] = i; GATE[gs] = __uint_as_float(key[q]); }
                INV[(size_t)(rowbase + i) * NE + e] = gs; }
        }
        __syncthreads();
        for (int sidx = c.wave; sidx < cap; sidx += 8) {
            if (MOE_FP8) { const unsigned char* src = (const unsigned char*)HB + (size_t)(rowbase + sel[sidx]) * DM; unsigned char* dst = (unsigned char*)XG + (size_t)(e * MR + slotbase + sidx) * DM;
                *(v4u*)(dst + 16 * lane) = *(const v4u*)(src + 16 * lane); }
            else { const bf16* src = HB + (size_t)(rowbase + sel[sidx]) * DM; bf16* dst = XG + (size_t)(e * MR + slotbase + sidx) * DM;
            const v4u a0 = *(const v4u*)(src + 8 * lane), a1 = *(const v4u*)(src + 512 + 8 * lane);
            *(v4u*)(dst + 8 * lane) = a0; *(v4u*)(dst + 512 + 8 * lane) = a1; }
        }
        __syncthreads();
    }
}

__device__ __forceinline__ void ph_combine(const Params& p, const Ctx& c, int layer) {
    const bf16* YS = (const bf16*)(p.ws + WS_YS);
    const int* INV = (const int*)(p.ws + WS_INV);
    bf16* XS = (bf16*)(p.ws + WS_XS);
    bf16* HB = (bf16*)(p.ws + WS_HB);
    const float* lng = p.in[I_LNG] + (size_t)(layer * 2 + 1) * DM; const float* lnb = p.in[I_LNB] + (size_t)(layer * 2 + 1) * DM;
    const int nrows = layer == 0 ? NTOK : LAT;
    const int lane = c.lane;
    for (int row = 2 * c.gw; row < nrows; row += 2 * c.NGW) {
        const float* mod = mod_row(p, layer, row);
        const int inv = (lane < 2 * NE) ? INV[(size_t)row * NE + lane] : -1;
        const unsigned mall = (unsigned)__ballot(inv >= 0);
        unsigned ma = mall & 0xffffu, mb = mall >> 16;
        int sla[4], slb[4]; float wa[4], wb[4];
#pragma unroll
        for (int q = 0; q < 4; ++q) {
            if (ma) { const int e = __builtin_ctz(ma); ma &= ma - 1; sla[q] = __builtin_amdgcn_readlane(inv, e); wa[q] = 1.f; } else { sla[q] = 0; wa[q] = 0.f; }
            if (mb) { const int e = __builtin_ctz(mb); mb &= mb - 1; slb[q] = __builtin_amdgcn_readlane(inv, 16 + e); wb[q] = 1.f; } else { slb[q] = 0; wb[q] = 0.f; } }
        f32x4 moa[4], mob[4];
#pragma unroll
        for (int j = 0; j < 4; ++j) { moa[j] = (f32x4){0.f, 0.f, 0.f, 0.f}; mob[j] = (f32x4){0.f, 0.f, 0.f, 0.f}; }
#pragma unroll
        for (int q = 0; q < 4; ++q)
#pragma unroll
            for (int j = 0; j < 4; ++j) { moa[j] += unpack4(*(const v2u*)(YS + (size_t)sla[q] * DM + 4 * lane + 256 * j)) * wa[q]; mob[j] += unpack4(*(const v2u*)(YS + (size_t)slb[q] * DM + 4 * lane + 256 * j)) * wb[q]; }
        while (ma) { const int e = __builtin_ctz(ma); ma &= ma - 1; const int sl = __builtin_amdgcn_readlane(inv, e);
#pragma unroll
            for (int j = 0; j < 4; ++j) moa[j] += unpack4(*(const v2u*)(YS + (size_t)sl * DM + 4 * lane + 256 * j)); }
        while (mb) { const int e = __builtin_ctz(mb); mb &= mb - 1; const int sl = __builtin_amdgcn_readlane(inv, 16 + e);
#pragma unroll
            for (int j = 0; j < 4; ++j) mob[j] += unpack4(*(const v2u*)(YS + (size_t)sl * DM + 4 * lane + 256 * j)); }
        f32x4 va[4], vb[4]; float sa = 0.f, sb = 0.f;
#pragma unroll
        for (int j = 0; j < 4; ++j) { const int col = 4 * lane + 256 * j; const f32x4 g2 = *(const f32x4*)(mod + 5120 + col);
            va[j] = unpack4(*(const v2u*)(XS + (size_t)row * DM + col)) * ALPHA + g2 * moa[j];
            vb[j] = unpack4(*(const v2u*)(XS + (size_t)(row + 1) * DM + col)) * ALPHA + g2 * mob[j];
            sa += (va[j].x + va[j].y) + (va[j].z + va[j].w); sb += (vb[j].x + vb[j].y) + (vb[j].z + vb[j].w); }
        const float meana = wave_sum(sa) * (1.f / DM), meanb = wave_sum(sb) * (1.f / DM); float qa = 0.f, qb = 0.f;
#pragma unroll
        for (int j = 0; j < 4; ++j) { va[j] = va[j] - meana; vb[j] = vb[j] - meanb;
            qa += (va[j].x * va[j].x + va[j].y * va[j].y) + (va[j].z * va[j].z + va[j].w * va[j].w); qb += (vb[j].x * vb[j].x + vb[j].y * vb[j].y) + (vb[j].z * vb[j].z + vb[j].w * vb[j].w); }
        const float rstda = 1.f / sqrtf(wave_sum(qa) * (1.f / DM) + LN_EPS), rstdb = 1.f / sqrtf(wave_sum(qb) * (1.f / DM) + LN_EPS);
        const float* modn = mod_row(p, 1, row);
#pragma unroll
        for (int j = 0; j < 4; ++j) { const int col = 4 * lane + 256 * j;
            const f32x4 g = *(const f32x4*)(lng + col), bb = *(const f32x4*)(lnb + col);
            const f32x4 x2a = va[j] * rstda * g + bb, x2b = vb[j] * rstdb * g + bb;
            if (layer == 0) {
                *(v2u*)(XS + (size_t)row * DM + col) = (v2u){pk2(x2a.x, x2a.y), pk2(x2a.z, x2a.w)};
                *(v2u*)(XS + (size_t)(row + 1) * DM + col) = (v2u){pk2(x2b.x, x2b.y), pk2(x2b.z, x2b.w)};
                const f32x4 sc = *(const f32x4*)(modn + 1024 + col) + 1.f, sh = *(const f32x4*)(modn + col);
                const f32x4 ha = x2a * sc + sh, hb = x2b * sc + sh;
                *(v2u*)(HB + (size_t)row * DM + col) = (v2u){pk2(ha.x, ha.y), pk2(ha.z, ha.w)};
                *(v2u*)(HB + (size_t)(row + 1) * DM + col) = (v2u){pk2(hb.x, hb.y), pk2(hb.z, hb.w)};
            } else {
                *(f32x4*)(p.out + (size_t)row * DM + col) = x2a; *(f32x4*)(p.out + (size_t)(row + 1) * DM + col) = x2b;
            } }
    }
}

__device__ __forceinline__ void na_key(const float* q, float* o, float& m, float& l, const bf16* kp, const bf16* vp, float bias) {
    float s = bias;
#pragma unroll
    for (int i = 0; i < 8; ++i) { float f[8]; unpack8(*(const v4u*)(kp + 8 * i), f);
#pragma unroll
        for (int j = 0; j < 8; ++j) s += q[8 * i + j] * f[j]; }
    const float mn = fmaxf(m, s), al = exp2f(m - mn), pp = exp2f(s - mn);
    l = l * al + pp; m = mn;
#pragma unroll
    for (int i = 0; i < 8; ++i) { float f[8]; unpack8(*(const v4u*)(vp + 8 * i), f);
#pragma unroll
        for (int j = 0; j < 8; ++j) o[8 * i + j] = o[8 * i + j] * al + pp * f[j]; }
}
__device__ __forceinline__ void ph_mixer1_naive(const Params& p, const Ctx& c) {
    const bf16* P2 = (const bf16*)(p.ws + WS_QKV);
    bf16* CC = (bf16*)(p.ws + WS_CC);
    const float* rpb = p.in[I_RPB]; const float* pool_w = p.in[I_POOLW]; const float* pool_s = p.in[I_POOLS];
    LAS float* pl = (LAS float*)c.lds;
    for (int u = c.vcu; u < 256; u += c.G) {
        const int b = u >> 5, r = u & 31;
        {
            const int h = c.wave, col = c.lane, row = b * SEQ + r * 64 + col;
            const int rs = min(max(r - 4, 0), 24), cs = min(max(col - 8, 0), 48);
            float q[64], o[64];
#pragma unroll
            for (int i = 0; i < 8; ++i) unpack8(*(const v4u*)(P2 + (size_t)row * OIN + h * 64 + 8 * i), q + 8 * i);
#pragma unroll
            for (int i = 0; i < 64; ++i) o[i] = 0.f;
            float m = -1e30f, l = 0.f;
#pragma unroll 1
            for (int i = 0; i < 8; ++i)
#pragma unroll 1
                for (int j = 0; j < 16; ++j) {
                    const int krow = b * SEQ + (rs + i) * 64 + cs + j;
                    const float bias = rpb[(h * 15 + (rs + i - r + 7)) * 31 + (cs + j - col + 15)] * LOG2E;
                    na_key(q, o, m, l, P2 + (size_t)krow * OIN + 512 + h * 64, P2 + (size_t)krow * OIN + 1024 + h * 64, bias);
                }
#pragma unroll 1
            for (int j = 0; j < NCTX; ++j) {
                const int krow = LAT + b * NCTX + j;
                na_key(q, o, m, l, P2 + (size_t)krow * OIN + 512 + h * 64, P2 + (size_t)krow * OIN + 1024 + h * 64, 0.f);
            }
            const float rl = 1.f / l; bf16* dst = CC + (size_t)row * DM + h * 64;
#pragma unroll
            for (int i = 0; i < 8; ++i) *(v4u*)(dst + 8 * i) = (v4u){pk2(o[8 * i] * rl, o[8 * i + 1] * rl), pk2(o[8 * i + 2] * rl, o[8 * i + 3] * rl), pk2(o[8 * i + 4] * rl, o[8 * i + 5] * rl), pk2(o[8 * i + 6] * rl, o[8 * i + 7] * rl)};
        }
        __syncthreads();
        {
            const int ch = c.tid, g = ch >> 7, half = 1 << g;
            for (int tt = 0; tt < 64; ++tt) {
                const int t = r * 64 + tt, lo = max(t - half, 0), hi = min(t + half, SEQ);
                float s = 0.f;
                for (int t2 = lo; t2 < hi; ++t2) s += bf2f((unsigned)P2[(size_t)(b * SEQ + t2) * OIN + 1536 + ch]);
                pl[tt * 512 + ch] = s / (float)(hi - lo) - bf2f((unsigned)P2[(size_t)(b * SEQ + t) * OIN + 1536 + ch]);
            }
        }
        __syncthreads();
        {
            const int g = c.tid >> 7, e = c.tid & 127;
            const float ps = pool_s[g * 128 + e];
#pragma unroll 1
            for (int tb = 0; tb < 64; tb += 16) {
                float acc[16];
#pragma unroll
                for (int i = 0; i < 16; ++i) acc[i] = 0.f;
#pragma unroll 4
                for (int cc = 0; cc < 128; ++cc) {
                    const float w = pool_w[(size_t)(g * 128 + cc) * 128 + e];
#pragma unroll
                    for (int i = 0; i < 16; ++i) acc[i] += pl[(tb + i) * 512 + g * 128 + cc] * w;
                }
#pragma unroll
                for (int i = 0; i < 16; ++i) CC[(size_t)(b * SEQ + r * 64 + tb + i) * DM + 512 + g * 128 + e] = (bf16)f2bf(acc[i] * ps);
            }
        }
        __syncthreads();
    }
}


constexpr int NA_TAB_OFF = 86016 + 1024;
__device__ __forceinline__ void ph_mixer1_fast(const Params& p, const Ctx& c, char* lds_generic) {
    typedef attn_body::bf16 abf;
    const abf* P2a = (const abf*)(p.ws + WS_QKV); abf* CCa = (abf*)(p.ws + WS_CC);
    LAS float* tab = (LAS float*)(c.lds + NA_TAB_OFF);
    for (int i = c.tid; i < 8 * 15 * 32; i += 512) { const int hd = i >> 5, j = i & 31; tab[i] = j < 31 ? p.in[I_RPB][hd * 31 + j] * LOG2E : 0.f; }
    __syncthreads();
    for (int it = 0;; ++it) {
        const int U = it * c.G + c.vcu;
        if (U >= 512) break;
        const int b = U >> 6, h = (U >> 3) & 7, rq = U & 7;
        const int rs_min = min(max(4 * rq - 4, 0), 24);
        const int nloc = (rq == 0 || rq == 7) ? 8 : 12;
        attn_body::AU u;
        u.qrow0 = b * SEQ + rq * 256; u.lat_row0 = LAT + b * NCTX; u.nlat_t = 4; u.ctx_row0 = b * SEQ + rs_min * 64; u.NT = 4 + nloc;
        u.Qp = P2a + h * 64; u.Kp = P2a + 512 + h * 64; u.Vp = P2a + 1024 + h * 64; u.Op = CCa + h * 64;
        const int r = 4 * rq + (c.wave >> 1), col = (c.wave & 1) * 32 + (c.lane & 31), hi = c.lane >> 5;
        const int cs = min(max(col - 8, 0), 48);
        attn_body::NAMask mk; mk.tb0 = (attn_body::lds_cfptr)(tab + h * 15 * 32 + 15 - col); mk.r = r; mk.rs = min(max(r - 4, 0), 24); mk.rs_min = rs_min; mk.cb = 4 * hi - cs;
        attn_body::attn_unit<8, OIN, attn_body::NAMask>(u, lds_generic, mk);
    }
    __syncthreads();
    const bf16* P2 = (const bf16*)(p.ws + WS_QKV); bf16* CC = (bf16*)(p.ws + WS_CC);
    const float* pool_w = p.in[I_POOLW]; const float* pool_s = p.in[I_POOLS];
    constexpr int PLP = 1040;
    for (int u = c.vcu; u < 256; u += c.G) {
        const int b = u >> 5, r = u & 31;
        {   const int ch = c.tid, g = c.wave >> 1;
            const bf16* du = P2 + (size_t)b * SEQ * OIN + 1536 + ch;
            const int t0 = r * 64;
            float v[80];
#pragma unroll
            for (int k = 0; k < 80; ++k) { const int t2 = t0 - 8 + k; v[k] = ((t2 >= 0 && t2 < SEQ) ? 1.f : 0.f) * bf2f((unsigned)du[(size_t)min(max(t2, 0), SEQ - 1) * OIN]); }
            LAS bf16* plc = (LAS bf16*)(c.lds) + ch;
#define POOL_COL(HALF) do { float ws = 0.f; _Pragma("unroll") for (int k = 8 - HALF; k < 8 + HALF; ++k) ws += v[k]; \
            _Pragma("unroll") for (int tt = 0; tt < 64; ++tt) { const int t = t0 + tt, lo = max(t - HALF, 0), hi = min(t + HALF, SEQ); \
                plc[tt * (PLP / 2)] = (bf16)f2bf(ws / (float)(hi - lo) - v[tt + 8]); ws += v[tt + 8 + HALF] - v[tt + 8 - HALF]; } } while (0)
            if (g == 0) POOL_COL(1); else if (g == 1) POOL_COL(2); else if (g == 2) POOL_COL(4); else POOL_COL(8);
#undef POOL_COL
        }
        __syncthreads();
        {   typedef short bf16x8v __attribute__((ext_vector_type(8)));
            const int g = c.wave >> 1, th = c.wave & 1, l31 = c.lane & 31, lh = c.lane >> 5;
            f32x16 acc[4];
#pragma unroll
            for (int et = 0; et < 4; ++et) acc[et] = (f32x16){};
#pragma unroll
            for (int ks = 0; ks < 8; ++ks) {
                const bf16x8v af = *(const LAS bf16x8v*)(c.lds + (32 * th + l31) * PLP + (g * 128 + 16 * ks + 8 * lh) * 2);
#pragma unroll
                for (int et = 0; et < 4; ++et) {
                    const float* wp = pool_w + (size_t)(g * 128 + 16 * ks + 8 * lh) * 128 + 32 * et + l31;
                    bf16x8v bfr;
#pragma unroll
                    for (int j = 0; j < 8; ++j) bfr[j] = (short)f2bf(wp[(size_t)j * 128]);
                    acc[et] = __builtin_amdgcn_mfma_f32_32x32x16_bf16(af, bfr, acc[et], 0, 0, 0);
                }
            }
#pragma unroll
            for (int et = 0; et < 4; ++et) { const int e = 32 * et + l31; const float ps = pool_s[g * 128 + e];
#pragma unroll
                for (int rg = 0; rg < 16; ++rg) { const int tok = 32 * th + (rg & 3) + 8 * (rg >> 2) + 4 * lh;
                    CC[(size_t)(b * SEQ + r * 64 + tok) * DM + 512 + g * 128 + e] = (bf16)f2bf(acc[et][rg] * ps); } }
        }
        __syncthreads();
    }
}

__global__ void __launch_bounds__(512, 2) mk_fwd(Params p_arg) {
    extern __shared__ __attribute__((aligned(16))) unsigned char lds_raw[];
    Ctx c;
    c.lds = (LAS unsigned char*)lds_raw;
    c.tid = threadIdx.x; c.lane = c.tid & 63; c.wave = __builtin_amdgcn_readfirstlane(c.tid >> 6);
    c.G = gridDim.x; { const int bx = blockIdx.x; c.vcu = (c.G % 8 == 0) ? (bx % 8) * (c.G / 8) + bx / 8 : bx; }
    c.gw = c.vcu * 8 + c.wave; c.NGW = c.G * 8;
    volatile LAS unsigned* MISC = (volatile LAS unsigned*)(c.lds + MISC_OFF);
    if (c.tid < 32) MISC[c.tid] = 0u;
    __syncthreads();
    typedef const __attribute__((address_space(4))) Params* KP;
    const KP kp0 = (KP)__builtin_amdgcn_kernarg_segment_ptr();
#define RELOAD_P() ({ KP kq_ = kp0; asm volatile("" : "+s"(kq_)); *(const Params*)kq_; })
    gu32* ctl = (gu32*)(p_arg.ws + WS_CTL);
    XcdBarrier bar; bar.bar = (unsigned*)(ctl + CW_BAR); bar.x = 0; bar.st = nullptr;
    if (!MK_MULTI) bar = xcd_barrier_post((unsigned*)(ctl + CW_BAR), MISC + 8);
    const int lo = p_arg.ph_lo, hi = p_arg.ph_hi;
    unsigned long long pt0 = 0, pt1 = 0; if (PROBE_PH == 0 || PROBE_PH >= 100) pt0 = __builtin_amdgcn_s_memrealtime();
#define IN(k) (lo <= (k) && (k) < hi)
#define SEAM(k) do { if (IN(k) && IN((k) + 1) && !(FAST_ATTN && (k) == 5) && !(FAST_GEMM && FUSE_QKV && (k) == 3)) xcd_barrier(bar); if ((k) + 1 == PROBE_PH) pt0 = __builtin_amdgcn_s_memrealtime(); if ((k) == PROBE_PH || (k) + 200 == PROBE_PH) pt1 = __builtin_amdgcn_s_memrealtime(); } while (0)

#define HB ((bf16*)(p.ws + WS_HB))
#define QKV ((bf16*)(p.ws + WS_QKV))
#define CC ((bf16*)(p.ws + WS_CC))
#define Y ((float*)(p.ws + WS_Y))
#define PF ((float*)(p.ws + WS_PF))
#define XG ((bf16*)(p.ws + WS_XG))
#define HID ((bf16*)(p.ws + WS_HID))
#define YS ((bf16*)(p.ws + WS_YS))
#define GATE ((const float*)(p.ws + WS_GATE))

    if (IN(0)) { const Params p = RELOAD_P(); ph_prologue(p, c); if (FAST_GEMM) { __syncthreads(); ph_transposes(p, c); } } SEAM(0);
    if (IN(1)) { const Params p = RELOAD_P(); ph_modulate0(p, c); } SEAM(1);
    if (IN(2)) { const Params p = RELOAD_P();
        if (FAST_GEMM) { pg8::Gemm g{HB, (const bf16*)(p.ws + WS_W0IN), NTOK, EIN, DM, 0}; pg8::StaticOrder S; S.init(NTOK, EIN, c.G, (int)blockIdx.x);
            if (FUSE_QKV) { pg8::EpiQKV E{QKV, EIN, (const float*)(p.ws + WS_ROPE), p.in[I_QN], p.in[I_KN], C2, RMS_EPS}; pg8::gemm_phase<pg8::EpiQKV, pg8::StaticOrder, true, true>(c.lds, g, S, E); }
            else { pg8::EpiBf16<0> E{QKV, EIN, nullptr, 0, 0, 1.f}; pg8::gemm_phase<pg8::EpiBf16<0>, pg8::StaticOrder, true, true>(c.lds, g, S, E); }
            tail_transposes(p, c, 648 - 512, (int)blockIdx.x, 1536, 120); }
        else { NG g{HB, DM, p.in[I_W0IN], nullptr, EIN, 0, 1 << 30, 0, NTOK, 0, EIN, DM}; ngemm<1>(g, c, EpiF32{PF, EIN}); }
    } SEAM(2);
    if (!(FAST_GEMM && FUSE_QKV)) { if (IN(3)) { const Params p = RELOAD_P(); if (FAST_GEMM) ph_qkv_post<false>(p, c); else ph_qkv_post<true>(p, c); } } SEAM(3);
    if (IN(4)) { const Params p = RELOAD_P(); if (FAST_ATTN) ph_attn0_fast(p, c, (char*)lds_raw); else ph_attn0_naive(p, c); } SEAM(4);
    if (!FAST_ATTN) { if (IN(5)) { const Params p = RELOAD_P(); ph_attn_combine(p, c); } } SEAM(5);
    if (IN(6)) { const Params p = RELOAD_P();
        if (FAST_GEMM) { pg8::Gemm g{CC, (const bf16*)(p.ws + WS_W0OUT), NTOK, DM, DM, 0}; pg8::StaticOrder S; S.init(NTOK, DM, c.G, (int)blockIdx.x);
            pg8::EpiBf16<0> E{(bf16*)Y, DM, nullptr, 0, 0, 1.f}; pg8::gemm_phase<pg8::EpiBf16<0>, pg8::StaticOrder, true, true>(c.lds, g, S, E);
            tail_transposes(p, c, 288 - 256, (int)blockIdx.x, 1536 + 120 + 320, 224); }
        else { NG g{CC, DM, p.in[I_W0OUT], nullptr, DM, 0, 1 << 30, 0, NTOK, 0, DM, DM}; ngemm<1>(g, c, EpiBf{(bf16*)Y, DM, 0, 1.f}); }
    } SEAM(6);
    if (IN(7)) { const Params p = RELOAD_P(); ph_ln1_router(p, c, 0); } SEAM(7);
    if (IN(8)) { const Params p = RELOAD_P(); ph_topk(p, c, 0); } SEAM(8);
    if (IN(9)) { const Params p = RELOAD_P();
        if (FAST_GEMM && MOE_FP8) { pg8::Gemm g{XG, (const bf16*)(p.ws + WS_WGU), NE * MR0, 4096, DM / 2, (size_t)4096 * DM}; pg8::GroupedOrder S; S.init(MR0 / 256, 16, NE, c.G, c.vcu);
            pg8::EpiSwigluF8 E{(unsigned char*)HID, FF, 1.f / W8_GU, H8_SC}; pg8::gemm_phase<pg8::EpiSwigluF8, pg8::GroupedOrder, true, true, true>(c.lds, g, S, E); }
        else if (FAST_GEMM) { pg8::Gemm g{XG, (const bf16*)(p.ws + WS_WGU), NE * MR0, 4096, DM, (size_t)4096 * DM * 2}; pg8::GroupedOrder S; S.init(MR0 / 256, 16, NE, c.G, c.vcu);
            pg8::EpiSwigluP E{HID, FF}; pg8::gemm_phase<pg8::EpiSwigluP, pg8::GroupedOrder, true, true>(c.lds, g, S, E); }
        else { NG g{XG, DM, p.in[I_WG], p.in[I_WU], FF, (size_t)DM * FF, MR0, 0, NE * MR0, 0, FF, DM}; ngemm<2>(g, c, EpiSwiglu{HID}); }
    } SEAM(9);
    if (IN(10)) { const Params p = RELOAD_P();
        if (FAST_GEMM && MOE_FP8) { pg8::Gemm g{HID, (const bf16*)(p.ws + WS_WDN), NE * MR0, DM, FF / 2, (size_t)DM * FF}; pg8::GroupedOrder S; S.init(MR0 / 256, 4, NE, c.G, c.vcu);
            pg8::EpiGateS E{YS, DM, GATE, 1.f / (W8_DN * H8_SC)}; pg8::gemm_phase<pg8::EpiGateS, pg8::GroupedOrder, true, true, true>(c.lds, g, S, E);
            tail_transposes(p, c, 576 - 512, c.vcu, 1536 + 120 + 320 + 224, 576); }
        else if (FAST_GEMM) { pg8::Gemm g{HID, (const bf16*)(p.ws + WS_WDN), NE * MR0, DM, FF, (size_t)DM * FF * 2}; pg8::GroupedOrder S; S.init(MR0 / 256, 4, NE, c.G, c.vcu);
            pg8::EpiGateP E{YS, DM, GATE}; pg8::gemm_phase<pg8::EpiGateP, pg8::GroupedOrder, true, true>(c.lds, g, S, E); }
        else { NG g{HID, FF, p.in[I_WD], nullptr, DM, (size_t)FF * DM, MR0, 0, NE * MR0, 0, DM, FF}; ngemm<1>(g, c, EpiGate{YS, GATE}); }
    } SEAM(10);
    if (IN(11)) { const Params p = RELOAD_P(); ph_combine(p, c, 0); } SEAM(11);
    if (IN(12)) { const Params p = RELOAD_P();
        if (FAST_GEMM) { pg8::Gemm g{HB, (const bf16*)(p.ws + WS_W1IN), NTOK, OIN, DM, 0}; pg8::L1InOrder S; S.init(c.G, (int)blockIdx.x);
            pg8::EpiBf16<0> E{QKV, OIN, nullptr, 512, 512, C2}; pg8::gemm_phase<pg8::EpiBf16<0>, pg8::L1InOrder, true, true>(c.lds, g, S, E);
            tail_transposes(p, c, 544 - 512, (int)blockIdx.x, 1536 + 120 + 320 + 224 + 576, 296); }
        else {
        NG g{HB, DM, p.in[I_W1IN], nullptr, OIN, 0, 1 << 30, 0, LAT, 0, OIN, DM}; ngemm<1>(g, c, EpiBf{QKV, OIN, 512, C2});
        NG g2{HB, DM, p.in[I_W1IN], nullptr, OIN, 0, 1 << 30, LAT, NTOK, 512, 1536, DM}; ngemm<1>(g2, c, EpiBf{QKV, OIN, 0, 1.f}); }
    } SEAM(12);
    if (IN(13)) { const Params p = RELOAD_P(); if (FAST_NA) ph_mixer1_fast(p, c, (char*)lds_raw); else ph_mixer1_naive(p, c); } SEAM(13);
    if (IN(14)) { const Params p = RELOAD_P();
        if (FAST_GEMM) { pg8::Gemm g{CC, (const bf16*)(p.ws + WS_W1OUT), LAT, DM, DM, 0}; pg8::StaticOrder S; S.init(LAT, DM, c.G, (int)blockIdx.x);
            pg8::EpiBf16<0> E{(bf16*)Y, DM, nullptr, 0, 0, 1.f}; pg8::gemm_phase<pg8::EpiBf16<0>, pg8::StaticOrder, true, true>(c.lds, g, S, E); }
        else { NG g{CC, DM, p.in[I_W1OUT], nullptr, DM, 0, 1 << 30, 0, LAT, 0, DM, DM}; ngemm<1>(g, c, EpiBf{(bf16*)Y, DM, 0, 1.f}); }
    } SEAM(14);
    if (IN(15)) { const Params p = RELOAD_P(); ph_ln1_router(p, c, 1); } SEAM(15);
    if (IN(16)) { const Params p = RELOAD_P(); ph_topk(p, c, 1); } SEAM(16);
    if (IN(17)) { const Params p = RELOAD_P();
        if (FAST_GEMM && MOE_FP8) { pg8::Gemm g{XG, (const bf16*)(p.ws + WS_WGU + WS_MOE_LSTRIDE), NE * MR1, 4096, DM / 2, (size_t)4096 * DM}; pg8::GroupedOrder S; S.init(MR1 / 256, 16, NE, c.G, c.vcu);
            pg8::EpiSwigluF8 E{(unsigned char*)HID, FF, 1.f / W8_GU, H8_SC}; pg8::gemm_phase<pg8::EpiSwigluF8, pg8::GroupedOrder, true, true, true>(c.lds, g, S, E); }
        else if (FAST_GEMM) { pg8::Gemm g{XG, (const bf16*)(p.ws + WS_WGU + WS_MOE_LSTRIDE), NE * MR1, 4096, DM, (size_t)4096 * DM * 2}; pg8::GroupedOrder S; S.init(MR1 / 256, 16, NE, c.G, c.vcu);
            pg8::EpiSwigluP E{HID, FF}; pg8::gemm_phase<pg8::EpiSwigluP, pg8::GroupedOrder, true, true>(c.lds, g, S, E); }
        else { NG g{XG, DM, p.in[I_WG] + (size_t)NE * DM * FF, p.in[I_WU] + (size_t)NE * DM * FF, FF, (size_t)DM * FF, MR1, 0, NE * MR1, 0, FF, DM}; ngemm<2>(g, c, EpiSwiglu{HID}); }
    } SEAM(17);
    if (IN(18)) { const Params p = RELOAD_P();
        if (FAST_GEMM && MOE_FP8) { pg8::Gemm g{HID, (const bf16*)(p.ws + WS_WDN + WS_MOE_LSTRIDE), NE * MR1, DM, FF / 2, (size_t)DM * FF}; pg8::GroupedOrder S; S.init(MR1 / 256, 4, NE, c.G, c.vcu);
            pg8::EpiGateS E{YS, DM, GATE, 1.f / (W8_DN * H8_SC)}; pg8::gemm_phase<pg8::EpiGateS, pg8::GroupedOrder, true, true, true>(c.lds, g, S, E); }
        else if (FAST_GEMM) { pg8::Gemm g{HID, (const bf16*)(p.ws + WS_WDN + WS_MOE_LSTRIDE), NE * MR1, DM, FF, (size_t)DM * FF * 2}; pg8::GroupedOrder S; S.init(MR1 / 256, 4, NE, c.G, c.vcu);
            pg8::EpiGateP E{YS, DM, GATE}; pg8::gemm_phase<pg8::EpiGateP, pg8::GroupedOrder, true, true>(c.lds, g, S, E); }
        else { NG g{HID, FF, p.in[I_WD] + (size_t)NE * FF * DM, nullptr, DM, (size_t)FF * DM, MR1, 0, NE * MR1, 0, DM, FF}; ngemm<1>(g, c, EpiGate{YS, GATE}); }
    } SEAM(18);
    if (IN(19)) { const Params p = RELOAD_P(); ph_combine(p, c, 1); }
    if (PROBE_PH == 19 || PROBE_PH == 100) pt1 = __builtin_amdgcn_s_memrealtime();
    if (PROBE_PH >= 0 && blockIdx.x == 0 && c.tid == 0) { const unsigned long long te = __builtin_amdgcn_s_memrealtime(); while (__builtin_amdgcn_s_memrealtime() - te < pt1 - pt0) __builtin_amdgcn_s_sleep(8); }
#undef IN
#undef SEAM
#undef HB
#undef QKV
#undef CC
#undef Y
#undef PF
#undef XG
#undef HID
#undef YS
#undef GATE
#undef RELOAD_P
}

extern "C" void kernel_launch(void* const* d_in, const int* in_sizes, int n_in, void* d_out, int out_size, void* d_ws, size_t ws_size, hipStream_t stream) {
    static int grid = 0;
    if (grid == 0) {
        if (n_in != 26 || out_size != LAT * DM || ws_size < WS_END) { fprintf(stderr, "kernel_launch: unexpected shapes (n_in %d out %d ws %zu)\n", n_in, out_size, ws_size); grid = -1; return; }
        int dev = 0, cus = 0;
        if (hipGetDevice(&dev) != hipSuccess || hipDeviceGetAttribute(&cus, hipDeviceAttributeMultiprocessorCount, dev) != hipSuccess) { grid = -1; return; }
        if (hipFuncSetAttribute((const void*)mk_fwd, hipFuncAttributeMaxDynamicSharedMemorySize, LDS_BYTES) != hipSuccess) { fprintf(stderr, "kernel_launch: hipFuncSetAttribute failed\n"); grid = -1; return; }
        int per_cu = 0;
        if (hipOccupancyMaxActiveBlocksPerMultiprocessor(&per_cu, (const void*)mk_fwd, 512, LDS_BYTES) != hipSuccess || per_cu < 1) fprintf(stderr, "kernel_launch: occupancy query says %d\n", per_cu);
        (void)hipGetLastError();
        grid = cus;
    }
    if (grid < 0) return;
    (void)hipMemsetAsync((char*)d_ws + WS_CTL, 0, CTL_ZERO_BYTES, stream);
    Params a{};
    for (int i = 0; i < 26; ++i) a.in[i] = (const float*)d_in[i];
    a.out = (float*)d_out; a.ws = (unsigned char*)d_ws;
#if MK_MULTI
    for (int ph = 0; ph < NPHASE; ++ph) { a.ph_lo = ph; a.ph_hi = ph + 1; hipLaunchKernelGGL(mk_fwd, dim3(grid), dim3(512), LDS_BYTES, stream, a); }
#else
    a.ph_lo = 0; a.ph_hi = NPHASE;
    hipLaunchKernelGGL(mk_fwd, dim3(grid), dim3(512), LDS_BYTES, stream, a);
#endif
}
```

```cpp
#include <hip/hip_runtime.h>
#include <cstdio>
#include <cstdint>

#define GAS __attribute__((address_space(1)))
#define LAS __attribute__((address_space(3)))
typedef unsigned short bf16;
typedef unsigned v4u __attribute__((ext_vector_type(4)));
typedef unsigned v2u __attribute__((ext_vector_type(2)));
typedef float f32x4 __attribute__((ext_vector_type(4)));
typedef float f32x2 __attribute__((ext_vector_type(2)));
typedef float f32x16 __attribute__((ext_vector_type(16)));
typedef GAS unsigned gu32;

#ifndef PROBE_PH
#define PROBE_PH -1
#endif
#ifndef PROBE_MASK
#define PROBE_MASK 0u
#endif
#ifndef TAIL_TRANSPOSE
#define TAIL_TRANSPOSE 1
#endif
#ifndef FUSE_QKV
#define FUSE_QKV 1
#endif
#ifndef MOE_FP8
#define MOE_FP8 1
#endif
#ifndef FAST_NA
#define FAST_NA 1
#endif
#ifndef FAST_ATTN
#define FAST_ATTN 1
#endif
#ifndef FAST_GEMM
#define FAST_GEMM 1
#endif
#ifndef MK_MULTI
#define MK_MULTI 0
#endif

constexpr int NBATCH = 8, SEQ = 2048, DM = 1024, NCTX = 256;
constexpr int LAT = NBATCH * SEQ;
constexpr int NTOK = LAT + NBATCH * NCTX;
constexpr int EIN = 2304, OIN = 2048, NE = 16, FF = 2048;
constexpr int MR0 = 2304, MR1 = 2048;
constexpr float LOG2E = 1.4426950408889634f;
constexpr float C2 = 0.125f * LOG2E;
constexpr float ALPHA = 1.4142135623730951f;
constexpr float LN_EPS = 1e-5f, RMS_EPS = 1e-6f;
constexpr float LAM_INIT = 0.2f;
constexpr int NPHASE = 20;
constexpr float W8_GU = 32.f, W8_DN = 64.f, H8_SC = 8.f;

constexpr size_t MiB = 1u << 20;
constexpr size_t WS_CTL = 0, CTL_ZERO_BYTES = 1 * MiB;
constexpr size_t WS_MOD = 1 * MiB;
constexpr size_t WS_ROPE = 1 * MiB + 512 * 1024;
constexpr size_t WS_W0IN = 2 * MiB;
constexpr size_t WS_W0OUT = 7 * MiB;
constexpr size_t WS_W1IN = 9 * MiB;
constexpr size_t WS_W1OUT = 13 * MiB;
constexpr size_t WS_AFF = 16 * MiB;
constexpr size_t WS_INV = 18 * MiB;
constexpr size_t WS_GATE = 20 * MiB;
constexpr size_t WS_WGU = 24 * MiB;
constexpr size_t WS_WDN = 152 * MiB;
constexpr size_t WS_MOE_LSTRIDE = 192 * MiB;
constexpr size_t WS_XS = 408 * MiB;
constexpr size_t WS_HB = 480 * MiB;
constexpr size_t WS_QKV = 516 * MiB;
constexpr size_t WS_CC = 597 * MiB;
constexpr size_t WS_AO = 633 * MiB;
constexpr size_t WS_Y = 705 * MiB;
constexpr size_t WS_XG = 516 * MiB;
constexpr size_t WS_HID = 588 * MiB;
constexpr size_t WS_YS = 732 * MiB;
constexpr size_t WS_PF = 804 * MiB;
constexpr size_t WS_END = 968 * MiB;

constexpr int CW_BAR = 4096;
constexpr int LDS_BYTES = 147456;
constexpr int MISC_OFF = 131072 + 320;

__device__ __forceinline__ float bf2f(unsigned v) { return __uint_as_float(v << 16); }
__device__ __forceinline__ unsigned f2bf(float f) { unsigned u = __float_as_uint(f); return (u + 0x7fffu + ((u >> 16) & 1u)) >> 16; }
__device__ __forceinline__ unsigned pk2(float lo, float hi) { return f2bf(lo) | (f2bf(hi) << 16); }
__device__ __forceinline__ float wave_sum(float v) {
#pragma unroll
    for (int o = 1; o < 64; o <<= 1) v += __shfl_xor(v, o);
    return v;
}
__device__ __forceinline__ float wave_max(float v) {
#pragma unroll
    for (int o = 1; o < 64; o <<= 1) v = fmaxf(v, __shfl_xor(v, o));
    return v;
}
__device__ __forceinline__ void unpack8(const v4u w, float* f) {
    f[0] = bf2f(w.x & 0xffffu); f[1] = __uint_as_float(w.x & 0xffff0000u);
    f[2] = bf2f(w.y & 0xffffu); f[3] = __uint_as_float(w.y & 0xffff0000u);
    f[4] = bf2f(w.z & 0xffffu); f[5] = __uint_as_float(w.z & 0xffff0000u);
    f[6] = bf2f(w.w & 0xffffu); f[7] = __uint_as_float(w.w & 0xffff0000u);
}

#define XB_TMO      128
#define XB_XCNT(j)  (256  + 64 * (j))
#define XB_XSUB(j)  (1280 + 64 * (j))
#define XB_XGEN(j)  (2304 + 64 * (j))
#define XB_TOP      3328
#define XB_TOPGEN   3392
#define XCD_BAR_WORDS 3456
#define XB_SPIN_CAP (1u << 18)
__device__ __forceinline__ unsigned xb_ld(unsigned* p)              { return __hip_atomic_load(p, __ATOMIC_RELAXED, __HIP_MEMORY_SCOPE_AGENT); }
__device__ __forceinline__ unsigned xb_add(unsigned* p, unsigned v) { return __hip_atomic_fetch_add(p, v, __ATOMIC_RELAXED, __HIP_MEMORY_SCOPE_AGENT); }
__device__ __forceinline__ unsigned xb_xcc_id() { return (unsigned)__builtin_amdgcn_s_getreg((3 << 11) | 20) & 0xFu; }
#define XB_SPIN(cond, bar) do { unsigned _sp = 0; while (cond) { __builtin_amdgcn_s_sleep(1); \
    if ((++_sp & 255u) == 0u) { if (xb_ld(&(bar)[XB_TMO])) break; if (_sp > XB_SPIN_CAP) { atomicAdd(&(bar)[XB_TMO], 1u); break; } } } } while (0)
struct XcdBarrier { unsigned* bar; unsigned x; volatile LAS unsigned* st; };
__device__ __forceinline__ XcdBarrier xcd_barrier_post(unsigned* bar, volatile LAS unsigned* st) {
    XcdBarrier b; b.bar = bar; b.x = xb_xcc_id(); b.st = st;
    if (threadIdx.x == 0) (void)xb_add(&bar[XB_XCNT(b.x)], 1u);
    return b;
}
__device__ __forceinline__ void xcd_barrier_complete(unsigned* bar, unsigned x, unsigned& nloc, unsigned& nx) {
    const unsigned G = gridDim.x * gridDim.y * gridDim.z;
    unsigned sum, cnt, mine, sp = 0u;
    for (;;) {
        sum = 0u; cnt = 0u; mine = 0u;
#pragma unroll
        for (unsigned j = 0; j < 16; ++j) { const unsigned c = xb_ld(&bar[XB_XCNT(j)]); sum += c; cnt += (c > 0u) ? 1u : 0u; mine = (j == x) ? c : mine; }
        if (sum == G) break;
        __builtin_amdgcn_s_sleep(1);
        if ((++sp & 255u) == 0u) { if (xb_ld(&bar[XB_TMO])) break; if (sp > XB_SPIN_CAP) { atomicAdd(&bar[XB_TMO], 1u); break; } }
    }
    nloc = mine > 0u ? mine : 1u; nx = cnt > 0u ? cnt : 1u;
}
__device__ __forceinline__ void xcd_barrier(const XcdBarrier& b) {
    asm volatile("s_waitcnt vmcnt(0)" ::: "memory");
    __syncthreads();
    if (threadIdx.x == 0) {
        unsigned* bar = b.bar;
        __builtin_amdgcn_s_waitcnt(0);
        unsigned nloc = b.st[0], nx = b.st[1];
        if (nloc == 0u) { xcd_barrier_complete(bar, b.x, nloc, nx); b.st[0] = nloc; b.st[1] = nx; }
        const unsigned old = xb_add(&bar[XB_XSUB(b.x)], 1u);
        const unsigned gen = old / nloc;
        if (old + 1u == (gen + 1u) * nloc) {
            __builtin_amdgcn_fence(__ATOMIC_RELEASE, "agent");
            asm volatile("s_waitcnt vmcnt(0)" ::: "memory");
            const unsigned og = xb_add(&bar[XB_TOP], 1u);
            const unsigned tg = og / nx;
            if (og + 1u == (tg + 1u) * nx) xb_add(&bar[XB_TOPGEN], 1u);
            else XB_SPIN(xb_ld(&bar[XB_TOPGEN]) == tg, bar);
            __builtin_amdgcn_fence(__ATOMIC_ACQUIRE, "agent");
            xb_add(&bar[XB_XGEN(b.x)], 1u);
            asm volatile("s_waitcnt vmcnt(0)" ::: "memory");
        } else {
            XB_SPIN(xb_ld(&bar[XB_XGEN(b.x)]) == gen, bar);
            __builtin_amdgcn_fence(__ATOMIC_ACQUIRE, "agent");
            asm volatile("s_waitcnt vmcnt(0)" ::: "memory");
        }
    }
    __syncthreads();
}

namespace pg8 {
#define PG8_LAS __attribute__((address_space(3)))
typedef unsigned short bf16_t;
typedef short bf16x8 __attribute__((ext_vector_type(8)));
typedef float f32x4 __attribute__((ext_vector_type(4)));
typedef unsigned u32x4 __attribute__((ext_vector_type(4)));
constexpr int BM = 256, BK = 64, HALF = 128, HTB = HALF * BK * 2  , STAGE_BYTES = 8 * HTB, NXCD = 8, WGM = 8;

__host__ __device__ __forceinline__ int lds_byte(int r, int c) { const int st = (r >> 4) * 2 + (c >> 5), rr = r & 15, cc = c & 31, ob = rr * 64 + cc * 2; return st * 1024 + (ob ^ (((ob >> 9) & 1) << 5)); }
__host__ __device__ __forceinline__ void stage_rc(int b, int& R, int& C) { const int st = b / 1024, sb = b % 1024, swz = sb ^ (((sb >> 9) & 1) << 5); R = (st >> 1) * 16 + swz / 64; C = (st & 1) * 32 + (swz % 64) / 2; }
__host__ __device__ __forceinline__ int perm32(int rho) { const int n = rho >> 4, i = rho & 15; return 8 * (i >> 2) + 4 * n + (i & 3); }

struct Unit { int pm, pn, e; };
struct Gemm { const bf16_t* A; const bf16_t* Bt; int M, N, K; size_t bstride; };

struct StaticOrder {
    int nM, nN, nwg, G, c;
    __host__ __device__ void init(int M, int N, int G_, int c_) { nM = M / BM; nN = N / BM; nwg = nM * nN; G = G_; c = c_; }
    __host__ __device__ bool next(int i, Unit& u) const {
        const long L = (long)i * G + c; if (L >= nwg) return false;
        int wgid = (int)L; { const int q = nwg / NXCD, r = nwg % NXCD, xcd = wgid % NXCD, off = wgid / NXCD; wgid = (xcd < r ? xcd * (q + 1) : r * (q + 1) + (xcd - r) * q) + off; }
        const int nig = WGM * nN, gid = wgid / nig, fm = gid * WGM, gsz = (nM - fm) < WGM ? (nM - fm) : WGM;
        u.pm = fm + ((wgid % nig) % gsz); u.pn = (wgid % nig) / gsz; u.e = 0; return true;
    }
    __device__ __forceinline__ void a_ready(const Unit&) const {}
    __device__ __forceinline__ void done(const Unit&) const {}
};

__device__ __forceinline__ unsigned cvt_pk_bf16(float lo, float hi) { unsigned r; asm volatile("v_cvt_pk_bf16_f32 %0, %1, %2" : "=v"(r) : "v"(lo), "v"(hi)); return r; }
typedef float f32x2 __attribute__((ext_vector_type(2)));
__device__ __forceinline__ f32x2 gelu_pk(f32x2 v) {
    const f32x2 av = __builtin_elementwise_abs(v), d = av * 0.2316418882f + 1.0f;
    f32x2 t; t.x = __builtin_amdgcn_rcpf(d.x); t.y = __builtin_amdgcn_rcpf(d.y);
    f32x2 q = t * 0.5307027145f + (-0.7265760135f); q = q * t + 0.7107068705f; q = q * t + (-0.142248368f); q = q * t + 0.127414796f; q = q * t;
    const f32x2 s = (v * v) * (-0.72134752044f);
    f32x2 e; e.x = __builtin_amdgcn_exp2f(s.x); e.y = __builtin_amdgcn_exp2f(s.y);
    const f32x2 m = v * (q * e), r = v - m;
    f32x2 o; o.x = v.x < 0.f ? m.x : r.x; o.y = v.y < 0.f ? m.y : r.y; return o;
}

template <int ACT  > struct EpiBf16 {
    static constexpr bool PERM = true, AFTER_DRAIN = false; static_assert(ACT == 0 || ACT == 1, "EpiBf16: ACT is 0 (none) or 1 (gelu_pk)");
    bf16_t* O; int ldc; const float* bias; int split_cols; size_t split_stride; float scale0;
    __device__ __forceinline__ void operator()(const f32x4 (&acc)[2][2][4][2], const Unit& u, int wr, int wc, int fr, int fq) const {
        const int row0 = u.pm * BM + wr * 64 + fr; int colt = u.pn * BM; bf16_t* base = O;
        float sc = 1.f; if (split_cols) { const int t = colt / split_cols; base += (size_t)t * split_stride; colt -= t * split_cols; if (t == 0) sc = scale0; }
        const int col0 = colt + wc * 32 + 8 * fq, bcol0 = u.pn * BM + wc * 32 + 8 * fq;
        f32x4 bv[2][2];
#pragma unroll
        for (int bj = 0; bj < 2; ++bj)
#pragma unroll
            for (int n = 0; n < 2; ++n) bv[bj][n] = bias ? *(const f32x4*)(bias + bcol0 + bj * HALF + 4 * n) : (f32x4){0.f, 0.f, 0.f, 0.f};
#pragma unroll
        for (int ai = 0; ai < 2; ++ai)
#pragma unroll
            for (int m = 0; m < 4; ++m) { bf16_t* rowp = base + (size_t)(row0 + ai * HALF + m * 16) * ldc + col0;
#pragma unroll
                for (int bj = 0; bj < 2; ++bj) { f32x4 v0 = acc[ai][bj][m][0] + bv[bj][0], v1 = acc[ai][bj][m][1] + bv[bj][1];
                    if (ACT == 1) { f32x2 a = gelu_pk((f32x2){v0[0], v0[1]}), b = gelu_pk((f32x2){v0[2], v0[3]}), c = gelu_pk((f32x2){v1[0], v1[1]}), d = gelu_pk((f32x2){v1[2], v1[3]});
                        v0 = (f32x4){a.x, a.y, b.x, b.y}; v1 = (f32x4){c.x, c.y, d.x, d.y}; }
                    v0 = v0 * sc; v1 = v1 * sc; u32x4 w; w.x = cvt_pk_bf16(v0[0], v0[1]); w.y = cvt_pk_bf16(v0[2], v0[3]); w.z = cvt_pk_bf16(v1[0], v1[1]); w.w = cvt_pk_bf16(v1[2], v1[3]);
                    *(u32x4*)(rowp + bj * HALF) = w; } }
    }
};

typedef int i32x4 __attribute__((ext_vector_type(4))); typedef int i32x8 __attribute__((ext_vector_type(8)));
__device__ __forceinline__ i32x8 cat16(bf16x8 lo, bf16x8 hi) { const i32x4 a = __builtin_bit_cast(i32x4, lo), b = __builtin_bit_cast(i32x4, hi); return __builtin_shufflevector(a, b, 0, 1, 2, 3, 4, 5, 6, 7); }
__device__ __forceinline__ void mfma_f8_acc(f32x4& acc, const i32x8& b, const i32x8& a, int sc) {
    asm volatile("v_mfma_scale_f32_16x16x128_f8f6f4 %0, %1, %2, %0, %3, %3 op_sel_hi:[0,0,0]" : "+v"(acc) : "v"(b), "v"(a), "v"(sc)); }
template <class Epi, class Sched, bool ALIGN_EPI = false, bool SP2 = false, bool FP8 = false>
__device__ __forceinline__ void gemm_phase(PG8_LAS unsigned char* lds, const Gemm g, const Sched& S, const Epi& E) {
    const int tid = threadIdx.x, wid = __builtin_amdgcn_readfirstlane(tid >> 6), lane = tid & 63, wr = wid >> 2, wc = wid & 3, fr = lane & 15, fq = lane >> 4;
    const int K = g.K, nt = K / BK;
    unsigned voffA[2], voffB[2];
#pragma unroll
    for (int i = 0; i < 2; ++i) { int R, C; stage_rc(tid * 16 + i * 8192, R, C); const int Rb = Epi::PERM ? ((R & ~31) + perm32(R & 31)) : R;
        voffA[i] = (unsigned)(R * K + C) * 2u; voffB[i] = (unsigned)(Rb * K + C) * 2u; }
    const size_t kstep = (size_t)(BK * 2);
    const size_t hstep = (size_t)HALF * K * 2;
    const size_t tstep = 2 * hstep;
    const unsigned ldsw = (unsigned)wid * 1024u;
    const int aoff = FP8 ? lds_byte(wr * 64 + fr, 16 * fq) : lds_byte(wr * 64 + fr, fq * 8), boff = FP8 ? lds_byte(wc * 32 + fr, 16 * fq) : lds_byte(wc * 32 + fr, fq * 8);
    constexpr int KOFF = FP8 ? 16 : 1024;
#define PG8_SA(b, h) (((b) * 2 + (h)) * HTB)
#define PG8_SB(b, h) ((4 + (b) * 2 + (h)) * HTB)
#define PG8_STAGE(bufoff, gbase, voff) do { _Pragma("unroll") for (int _i = 0; _i < 2; ++_i) \
        __builtin_amdgcn_global_load_lds((const unsigned*)((const char*)(gbase) + (voff)[_i]), (PG8_LAS unsigned*)(lds + (bufoff) + ldsw + _i * 8192), 16, 0, 0); } while (0)
#define PG8_LDA(dst, b, h) do { _Pragma("unroll") for (int m = 0; m < 4; ++m) _Pragma("unroll") for (int k = 0; k < 2; ++k) dst[m][k] = *(const PG8_LAS bf16x8*)(lds + PG8_SA(b, h) + aoff + m * 2048 + k * KOFF); } while (0)
#define PG8_LDB(dst, b, h) do { _Pragma("unroll") for (int n = 0; n < 2; ++n) _Pragma("unroll") for (int k = 0; k < 2; ++k) dst[n][k] = *(const PG8_LAS bf16x8*)(lds + PG8_SB(b, h) + boff + n * 2048 + k * KOFF); } while (0)
#define PG8_MMA(ai, bj, At, Bt) do { __builtin_amdgcn_s_setprio(1); _Pragma("unroll") for (int m = 0; m < 4; ++m) _Pragma("unroll") for (int n = 0; n < 2; ++n) { \
        if constexpr (FP8) mfma_f8_acc(acc[ai][bj][m][n], cat16(Bt[n][0], Bt[n][1]), cat16(At[m][0], At[m][1]), f8scale); \
        else { _Pragma("unroll") for (int k = 0; k < 2; ++k) acc[ai][bj][m][n] = __builtin_amdgcn_mfma_f32_16x16x32_bf16(Bt[n][k], At[m][k], acc[ai][bj][m][n], 0, 0, 0); } } __builtin_amdgcn_s_setprio(0); } while (0)
#define PG8_WAIT_V(n) asm volatile("s_waitcnt vmcnt(" #n ")" ::: "memory")
#define PG8_WAIT_L(n) asm volatile("s_waitcnt lgkmcnt(" #n ")" ::: "memory")
#define PG8_BAR __builtin_amdgcn_s_barrier()
#define PG8_SCHED __builtin_amdgcn_sched_barrier(0)
    Unit cur, nxt; int ui = 0;
    if (!S.next(0, cur)) return;
    f32x4 acc[2][2][4][2];
#pragma unroll
    for (int a = 0; a < 2; ++a)
#pragma unroll
        for (int b = 0; b < 2; ++b)
#pragma unroll
            for (int m = 0; m < 4; ++m)
#pragma unroll
                for (int n = 0; n < 2; ++n) acc[a][b][m][n] = (f32x4){0.f, 0.f, 0.f, 0.f};
    int f8scale = 0x7F7F7F7F; asm volatile("" : "+v"(f8scale));
    bf16x8 At[4][2], B0[2][2], B1[2][2];
    const char* cA = (const char*)g.A + (size_t)cur.pm * tstep; const char* cB = (const char*)g.Bt + (size_t)cur.pn * tstep + (size_t)cur.e * g.bstride;
    S.a_ready(cur);
    if constexpr (SP2) {
        PG8_STAGE(PG8_SB(0, 0), cB, voffB); PG8_STAGE(PG8_SB(0, 1), cB + hstep, voffB); PG8_STAGE(PG8_SA(0, 0), cA, voffA); PG8_STAGE(PG8_SA(0, 1), cA + hstep, voffA);
        if (wr == 1) PG8_BAR;
        PG8_WAIT_V(2); PG8_BAR;
        PG8_STAGE(PG8_SB(1, 0), cB + kstep, voffB); PG8_STAGE(PG8_SA(1, 0), cA + kstep, voffA); PG8_STAGE(PG8_SB(1, 1), cB + hstep + kstep, voffB);
        PG8_WAIT_V(6); PG8_BAR;
    } else {
        PG8_STAGE(PG8_SB(0, 0), cB, voffB); PG8_STAGE(PG8_SA(0, 0), cA, voffA); PG8_STAGE(PG8_SB(0, 1), cB + hstep, voffB); PG8_STAGE(PG8_SA(0, 1), cA + hstep, voffA);
        if (wr == 1) PG8_BAR;
        PG8_WAIT_V(4); PG8_BAR;
        PG8_STAGE(PG8_SB(1, 0), cB + kstep, voffB); PG8_STAGE(PG8_SA(1, 0), cA + kstep, voffA); PG8_STAGE(PG8_SB(1, 1), cB + hstep + kstep, voffB);
        PG8_WAIT_V(6); PG8_BAR;
    }
    for (;;) {
        const bool has_next = S.next(ui + 1, nxt);
        const char* nA = has_next ? (const char*)g.A + (size_t)nxt.pm * tstep : cA; const char* nB = has_next ? (const char*)g.Bt + (size_t)nxt.pn * tstep + (size_t)nxt.e * g.bstride : cB;
        for (int t = 0; t < nt; t += 2) {
            const bool last = (t == nt - 2);
            const char* a1 = cA + (size_t)(t + 1) * kstep;
            const char* a2 = last ? nA : cA + (size_t)(t + 2) * kstep; const char* b2 = last ? nB : cB + (size_t)(t + 2) * kstep;
            const char* a3 = a2 + kstep; const char* b3 = b2 + kstep;
            if (last && has_next) S.a_ready(nxt);
            if constexpr (SP2) {
            PG8_LDB(B0, 0, 0); PG8_LDB(B1, 0, 1); PG8_SCHED; PG8_LDA(At, 0, 0); PG8_STAGE(PG8_SA(1, 1), a1 + hstep, voffA);
            PG8_WAIT_V(8); PG8_WAIT_L(0); PG8_BAR; PG8_MMA(0, 0, At, B0); PG8_MMA(0, 1, At, B1); PG8_BAR; PG8_SCHED;
            PG8_LDA(At, 0, 1); PG8_STAGE(PG8_SB(0, 0), b2, voffB); PG8_STAGE(PG8_SB(0, 1), b2 + hstep, voffB); PG8_STAGE(PG8_SA(0, 0), a2, voffA);
            PG8_WAIT_V(8); PG8_WAIT_L(0); PG8_BAR; PG8_MMA(1, 0, At, B0); PG8_MMA(1, 1, At, B1); PG8_BAR; PG8_SCHED;
            PG8_LDB(B0, 1, 0); PG8_LDB(B1, 1, 1); PG8_SCHED; PG8_LDA(At, 1, 0); PG8_STAGE(PG8_SA(0, 1), a2 + hstep, voffA);
            PG8_WAIT_V(8); PG8_WAIT_L(0); PG8_BAR; PG8_MMA(0, 0, At, B0); PG8_MMA(0, 1, At, B1); PG8_BAR; PG8_SCHED;
            PG8_LDA(At, 1, 1); PG8_STAGE(PG8_SB(1, 0), b3, voffB); PG8_STAGE(PG8_SB(1, 1), b3 + hstep, voffB); PG8_STAGE(PG8_SA(1, 0), a3, voffA);
            PG8_WAIT_V(8); PG8_WAIT_L(0); PG8_BAR; PG8_MMA(1, 0, At, B0); PG8_MMA(1, 1, At, B1); PG8_BAR; PG8_SCHED;
            } else {
            PG8_LDB(B0, 0, 0); PG8_SCHED; PG8_LDA(At, 0, 0); PG8_STAGE(PG8_SA(1, 1), a1 + hstep, voffA);
            PG8_WAIT_L(8); PG8_BAR; PG8_WAIT_L(0); PG8_MMA(0, 0, At, B0); PG8_BAR; PG8_SCHED;
            PG8_LDB(B1, 0, 1); PG8_STAGE(PG8_SB(0, 0), b2, voffB);
            PG8_BAR; PG8_WAIT_L(0); PG8_MMA(0, 1, At, B1); PG8_BAR;
            PG8_LDA(At, 0, 1); PG8_STAGE(PG8_SA(0, 0), a2, voffA);
            PG8_BAR; PG8_WAIT_L(0); PG8_MMA(1, 0, At, B0); PG8_BAR; PG8_SCHED;
            PG8_STAGE(PG8_SB(0, 1), b2 + hstep, voffB);
            PG8_WAIT_V(6); PG8_BAR; PG8_MMA(1, 1, At, B1); PG8_BAR;
            PG8_LDB(B0, 1, 0); PG8_SCHED; PG8_LDA(At, 1, 0); PG8_STAGE(PG8_SA(0, 1), a2 + hstep, voffA);
            PG8_WAIT_L(8); PG8_BAR; PG8_WAIT_L(0); PG8_MMA(0, 0, At, B0); PG8_BAR; PG8_SCHED;
            PG8_LDB(B1, 1, 1); PG8_STAGE(PG8_SB(1, 0), b3, voffB);
            PG8_BAR; PG8_WAIT_L(0); PG8_MMA(0, 1, At, B1); PG8_BAR;
            PG8_LDA(At, 1, 1); PG8_STAGE(PG8_SA(1, 0), a3, voffA);
            PG8_BAR; PG8_WAIT_L(0); PG8_MMA(1, 0, At, B0); PG8_BAR; PG8_SCHED;
            PG8_STAGE(PG8_SB(1, 1), b3 + hstep, voffB);
            PG8_WAIT_V(6); PG8_BAR; PG8_MMA(1, 1, At, B1); PG8_BAR;
            }
        }
        if constexpr (ALIGN_EPI) { if (wr == 0) PG8_BAR; }
        if constexpr (FP8) asm volatile("s_nop 15\n\ts_nop 15" : "+v"(acc[1][1][0][0]), "+v"(acc[1][1][0][1]), "+v"(acc[1][1][1][0]), "+v"(acc[1][1][1][1]), "+v"(acc[1][1][2][0]), "+v"(acc[1][1][2][1]), "+v"(acc[1][1][3][0]), "+v"(acc[1][1][3][1]));
        if constexpr (!Epi::AFTER_DRAIN) { E(acc, cur, wr, wc, fr, fq); S.done(cur); }
        if (!has_next) break;
#pragma unroll
        for (int a = 0; a < 2; ++a)
#pragma unroll
            for (int b = 0; b < 2; ++b)
#pragma unroll
                for (int m = 0; m < 4; ++m)
#pragma unroll
                    for (int n = 0; n < 2; ++n) acc[a][b][m][n] = (f32x4){0.f, 0.f, 0.f, 0.f};
        cur = nxt; cA = nA; cB = nB; ++ui;
        if constexpr (ALIGN_EPI) { if (wr == 1) PG8_BAR; }
    }
    PG8_WAIT_V(0);
    if constexpr (!ALIGN_EPI) { if (wr == 0) PG8_BAR; }
    PG8_BAR;
    if constexpr (Epi::AFTER_DRAIN) { E.fused(acc, cur, wr, wc, fr, fq, lds, wid, lane); S.done(cur); }
#undef PG8_SA
#undef PG8_SB
#undef PG8_STAGE
#undef PG8_LDA
#undef PG8_LDB
#undef PG8_MMA
#undef PG8_WAIT_V
#undef PG8_WAIT_L
#undef PG8_BAR
#undef PG8_SCHED
}
}

namespace pg8 {
struct EpiF32P {
    static constexpr bool PERM = false, AFTER_DRAIN = false;
    float* O; int ldc;
    __device__ __forceinline__ void operator()(const f32x4 (&acc)[2][2][4][2], const Unit& u, int wr, int wc, int fr, int fq) const {
        const int row0 = u.pm * BM + wr * 64 + fr, col0 = u.pn * BM + wc * 32 + 4 * fq;
#pragma unroll
        for (int ai = 0; ai < 2; ++ai)
#pragma unroll
            for (int m = 0; m < 4; ++m) { float* rowp = O + (size_t)(row0 + ai * HALF + m * 16) * ldc + col0;
#pragma unroll
                for (int bj = 0; bj < 2; ++bj)
#pragma unroll
                    for (int n = 0; n < 2; ++n) *(f32x4*)(rowp + bj * HALF + n * 16) = acc[ai][bj][m][n]; }
    }
};
struct EpiSwigluP {
    static constexpr bool PERM = true, AFTER_DRAIN = false;
    bf16_t* O; int ldc;
    __device__ __forceinline__ void operator()(const f32x4 (&acc)[2][2][4][2], const Unit& u, int wr, int wc, int fr, int fq) const {
        const int row0 = u.pm * BM + wr * 64 + fr, col0 = u.pn * HALF + wc * 32 + 8 * fq;
#pragma unroll
        for (int ai = 0; ai < 2; ++ai)
#pragma unroll
            for (int m = 0; m < 4; ++m) {
                float h[8];
#pragma unroll
                for (int n = 0; n < 2; ++n)
#pragma unroll
                    for (int j = 0; j < 4; ++j) { const float g = acc[ai][0][m][n][j], up = acc[ai][1][m][n][j];
                        h[4 * n + j] = g * up * __builtin_amdgcn_rcpf(1.0f + __builtin_amdgcn_exp2f(-1.4426950408889634f * g)); }
                u32x4 w; w.x = cvt_pk_bf16(h[0], h[1]); w.y = cvt_pk_bf16(h[2], h[3]); w.z = cvt_pk_bf16(h[4], h[5]); w.w = cvt_pk_bf16(h[6], h[7]);
                *(u32x4*)(O + (size_t)(row0 + ai * HALF + m * 16) * ldc + col0) = w; }
    }
};
struct EpiGateP {
    static constexpr bool PERM = true, AFTER_DRAIN = false;
    bf16_t* O; int ldc; const float* gate;
    __device__ __forceinline__ void operator()(const f32x4 (&acc)[2][2][4][2], const Unit& u, int wr, int wc, int fr, int fq) const {
        const int row0 = u.pm * BM + wr * 64 + fr, col0 = u.pn * BM + wc * 32 + 8 * fq;
#pragma unroll
        for (int ai = 0; ai < 2; ++ai)
#pragma unroll
            for (int m = 0; m < 4; ++m) { const int row = row0 + ai * HALF + m * 16; const float gt = gate[row]; bf16_t* rowp = O + (size_t)row * ldc + col0;
#pragma unroll
                for (int bj = 0; bj < 2; ++bj) { const f32x4 v0 = acc[ai][bj][m][0] * gt, v1 = acc[ai][bj][m][1] * gt;
                    u32x4 w; w.x = cvt_pk_bf16(v0[0], v0[1]); w.y = cvt_pk_bf16(v0[2], v0[3]); w.z = cvt_pk_bf16(v1[0], v1[1]); w.w = cvt_pk_bf16(v1[2], v1[3]);
                    *(u32x4*)(rowp + bj * HALF) = w; } }
    }
};
__device__ __forceinline__ unsigned pk4_fp8(float a, float b, float c, float d) {
    a = __builtin_fminf(__builtin_fmaxf(a, -448.f), 448.f); b = __builtin_fminf(__builtin_fmaxf(b, -448.f), 448.f);
    c = __builtin_fminf(__builtin_fmaxf(c, -448.f), 448.f); d = __builtin_fminf(__builtin_fmaxf(d, -448.f), 448.f);
    int w = 0; w = __builtin_amdgcn_cvt_pk_fp8_f32(a, b, w, false); w = __builtin_amdgcn_cvt_pk_fp8_f32(c, d, w, true); return (unsigned)w; }
struct EpiSwigluF8 {
    static constexpr bool PERM = true, AFTER_DRAIN = false;
    unsigned char* O; int ldc; float ws, hs;
    __device__ __forceinline__ void operator()(const f32x4 (&acc)[2][2][4][2], const Unit& u, int wr, int wc, int fr, int fq) const {
        const int row0 = u.pm * BM + wr * 64 + fr, col0 = u.pn * HALF + wc * 32 + 8 * fq;
#pragma unroll
        for (int ai = 0; ai < 2; ++ai)
#pragma unroll
            for (int m = 0; m < 4; ++m) {
                float h[8];
#pragma unroll
                for (int n = 0; n < 2; ++n)
#pragma unroll
                    for (int j = 0; j < 4; ++j) { const float g = acc[ai][0][m][n][j] * ws, up = acc[ai][1][m][n][j] * ws;
                        h[4 * n + j] = g * up * hs * __builtin_amdgcn_rcpf(1.0f + __builtin_amdgcn_exp2f(-1.4426950408889634f * g)); }
                typedef unsigned u32x2 __attribute__((ext_vector_type(2)));
                *(u32x2*)(O + (size_t)(row0 + ai * HALF + m * 16) * ldc + col0) = (u32x2){pk4_fp8(h[0], h[1], h[2], h[3]), pk4_fp8(h[4], h[5], h[6], h[7])}; }
    }
};
struct EpiGateS {
    static constexpr bool PERM = true, AFTER_DRAIN = false;
    bf16_t* O; int ldc; const float* gate; float sc;
    __device__ __forceinline__ void operator()(const f32x4 (&acc)[2][2][4][2], const Unit& u, int wr, int wc, int fr, int fq) const {
        const int row0 = u.pm * BM + wr * 64 + fr, col0 = u.pn * BM + wc * 32 + 8 * fq;
#pragma unroll
        for (int ai = 0; ai < 2; ++ai)
#pragma unroll
            for (int m = 0; m < 4; ++m) { const int row = row0 + ai * HALF + m * 16; const float gt = gate[row] * sc; bf16_t* rowp = O + (size_t)row * ldc + col0;
#pragma unroll
                for (int bj = 0; bj < 2; ++bj) { const f32x4 v0 = acc[ai][bj][m][0] * gt, v1 = acc[ai][bj][m][1] * gt;
                    u32x4 w; w.x = cvt_pk_bf16(v0[0], v0[1]); w.y = cvt_pk_bf16(v0[2], v0[3]); w.z = cvt_pk_bf16(v1[0], v1[1]); w.w = cvt_pk_bf16(v1[2], v1[3]);
                    *(u32x4*)(rowp + bj * HALF) = w; } }
    }
};
struct EpiQKV {
    static constexpr bool PERM = true, AFTER_DRAIN = false;
    bf16_t* O; int ldc; const float* rope; const float* qn; const float* kn; float qscale; float rms_eps;
    __device__ __forceinline__ void operator()(const f32x4 (&acc)[2][2][4][2], const Unit& u, int wr, int wc, int fr, int fq) const {
        const int hs = 4 * u.pn + wc;
        const bool isq = hs < 8 || (hs >= 24 && hs < 32), isk = (hs >= 8 && hs < 16) || hs == 32 || hs == 33, nrm = hs >= 24 && hs < 34;
        const bool rope_on = (isq || isk) && u.pm < 64;
        const float osc = isq ? qscale : 1.f;
        const bool first = fq < 2;
        f32x4 gv[2][2];
#pragma unroll
        for (int bj = 0; bj < 2; ++bj)
#pragma unroll
            for (int n = 0; n < 2; ++n) gv[bj][n] = nrm ? *(const f32x4*)((hs < 32 ? qn : kn) + 32 * bj + 8 * fq + 4 * n) : (f32x4){1.f, 1.f, 1.f, 1.f};
#pragma unroll
        for (int ai = 0; ai < 2; ++ai)
#pragma unroll
            for (int m = 0; m < 4; ++m) {
                const int row = u.pm * BM + ai * HALF + wr * 64 + m * 16 + fr;
                f32x4 v[2][2];
#pragma unroll
                for (int bj = 0; bj < 2; ++bj)
#pragma unroll
                    for (int n = 0; n < 2; ++n) v[bj][n] = acc[ai][bj][m][n];
                if (nrm) {
                    float ss = 0.f;
#pragma unroll
                    for (int bj = 0; bj < 2; ++bj)
#pragma unroll
                        for (int n = 0; n < 2; ++n) ss += (v[bj][n][0] * v[bj][n][0] + v[bj][n][1] * v[bj][n][1]) + (v[bj][n][2] * v[bj][n][2] + v[bj][n][3] * v[bj][n][3]);
                    ss += __shfl_xor(ss, 16); ss += __shfl_xor(ss, 32);
                    const float r = __builtin_amdgcn_rsqf(ss * (1.f / 64.f) + rms_eps);
#pragma unroll
                    for (int bj = 0; bj < 2; ++bj)
#pragma unroll
                        for (int n = 0; n < 2; ++n) v[bj][n] = v[bj][n] * r * gv[bj][n];
                }
                if (rope_on) {
                    const int t = row & 2047;
#pragma unroll
                    for (int bj = 0; bj < 2; ++bj) {
                        const int pos = bj ? (t & 63) : (t >> 6);
#pragma unroll
                        for (int n = 0; n < 2; ++n) {
                            const float* cp = rope + (size_t)(pos * 16 + 8 * (fq & 1) + 4 * n) * 2;
                            const f32x4 c01 = *(const f32x4*)cp, c23 = *(const f32x4*)(cp + 4);
                            const float cs[4] = {c01[0], c01[2], c23[0], c23[2]}, sn[4] = {c01[1], c01[3], c23[1], c23[3]};
#pragma unroll
                            for (int j = 0; j < 4; ++j) { const float x = v[bj][n][j], pr = __shfl_xor(x, 32); v[bj][n][j] = first ? x * cs[j] - pr * sn[j] : x * cs[j] + pr * sn[j]; }
                        }
                    }
                }
                bf16_t* rowp = O + (size_t)row * ldc + hs * 64 + 8 * fq;
#pragma unroll
                for (int bj = 0; bj < 2; ++bj) { const f32x4 v0 = v[bj][0] * osc, v1 = v[bj][1] * osc;
                    u32x4 w; w.x = cvt_pk_bf16(v0[0], v0[1]); w.y = cvt_pk_bf16(v0[2], v0[3]); w.z = cvt_pk_bf16(v1[0], v1[1]); w.w = cvt_pk_bf16(v1[2], v1[3]);
                    *(u32x4*)(rowp + 32 * bj) = w; }
            }
    }
};
struct GroupedOrder {
    int nMe, nN, ntot, G, c;
    __device__ void init(int nMe_, int nN_, int ne, int G_, int c_) { nMe = nMe_; nN = nN_; ntot = nMe_ * nN_ * ne; G = G_; c = c_; }
    __device__ bool next(int i, Unit& u) const {
        const int L = i * G + c; if (L >= ntot) return false;
        const int per = nMe * nN, e = L / per, rem = L - e * per;
        u.e = e; u.pn = rem / nMe; u.pm = e * nMe + (rem - u.pn * nMe); return true;
    }
    __device__ __forceinline__ void a_ready(const Unit&) const {}
    __device__ __forceinline__ void done(const Unit&) const {}
};
struct L1InOrder {
    StaticOrder so; int G, c;
    __device__ void init(int G_, int c_) { so.init(16384, 2048, G_, 0); G = G_; c = c_; }
    __device__ bool next(int i, Unit& u) const {
        const int L = i * G + c;
        if (L < 512) { StaticOrder t = so; t.G = 1; t.c = 0; return t.next(L, u); }
        if (L < 544) { const int l = L - 512; u.pm = 64 + (l >> 2); u.pn = 2 + (l & 3); u.e = 0; return true; }
        return false;
    }
    __device__ __forceinline__ void a_ready(const Unit&) const {}
    __device__ __forceinline__ void done(const Unit&) const {}
};
}

#include <hip/hip_bf16.h>
#include <cmath>
namespace attn_body {
using bf16=__hip_bfloat16;
using bf16x8=__attribute__((ext_vector_type(8)))short;
using s16x4=__attribute__((ext_vector_type(4)))short;
using f32x16=__attribute__((ext_vector_type(16)))float;
using u32x4=__attribute__((ext_vector_type(4)))unsigned;
constexpr int D=64,OPITCH=1024;
constexpr int NW=8,QBLK=32,QB=QBLK*NW,KVBLK=64;
__device__ __forceinline__ int crow(int r,int hi){return (r&3)+8*(r>>2)+4*hi;}
#define SBAR() __builtin_amdgcn_sched_barrier(0)
__device__ __forceinline__ void cmask(f32x16&p0,f32x16&p1,int jb,int qrel,int hi){
  const float NEG=-INFINITY; int kb=64*jb+4*hi;
  #pragma unroll
  for(int r=0;r<16;++r){int kv=kb+(r&3)+8*(r>>2); if(kv>qrel)p0[r]=NEG; if(kv+32>qrel)p1[r]=NEG;}
}

constexpr int NSLOT=3, SLOTB=8192;
constexpr int LDS_K=0, LDS_V=NSLOT*SLOTB, LDS_WS=2*NSLOT*SLOTB, LDS_OST=LDS_WS+NW*64*4, LDS_BYTES=LDS_OST+NW*4096;
constexpr float C2=0.125f*1.4426950408889634f;
__device__ __forceinline__ void glds16(const void*gsrc,unsigned lds_dst){unsigned keep;
  asm volatile("s_mov_b32 %0, m0\n\ts_mov_b32 m0, %2\n\ts_nop 0\n\tglobal_load_lds_dwordx4 %1, off\n\ts_mov_b32 m0, %0":"=&s"(keep):"v"(gsrc),"s"(lds_dst):"memory");}
__device__ __forceinline__ float max3f(float a,float b,float c){float r;asm("v_max3_f32 %0, %1, %2, %3":"=v"(r):"v"(a),"v"(b),"v"(c));return r;}
__device__ __forceinline__ float max2f(float a,float b){float r;asm("v_max_f32_e32 %0, %1, %2":"=v"(r):"v"(a),"v"(b));return r;}
__device__ __forceinline__ float fadd_s(float a,float b){float r;asm("v_add_f32_e32 %0, %1, %2":"=v"(r):"v"(a),"v"(b));return r;}
__device__ __forceinline__ float fsub_s(float a,float b){float r;asm("v_sub_f32_e32 %0, %1, %2":"=v"(r):"v"(a),"v"(b));return r;}
typedef float f32x2_t __attribute__((ext_vector_type(2))); typedef __bf16 bf16x2_t __attribute__((ext_vector_type(2)));
__device__ __forceinline__ unsigned cvtpk_s(float lo,float hi){f32x2_t v={lo,hi};bf16x2_t b=__builtin_convertvector(v,bf16x2_t);return __builtin_bit_cast(unsigned,b);}
#define WAIT_BAR(N) asm volatile("s_waitcnt vmcnt(" #N ") lgkmcnt(0)\n\ts_barrier":::"memory")

__device__ __forceinline__ void qkt(f32x16&p0,f32x16&p1,const char*Kslot,const bf16x8*qr,const f32x16&negm,int r32,int hi){
  const char*kb=Kslot+hi*1024+r32*16;
  #pragma unroll
  for(int d0=0;d0<4;++d0){
    const bf16x8 b0=*reinterpret_cast<const bf16x8*>(kb+d0*2048);
    const bf16x8 b1=*reinterpret_cast<const bf16x8*>(kb+d0*2048+512);
    if(d0==0){p0=__builtin_amdgcn_mfma_f32_32x32x16_bf16(b0,qr[0],negm,0,0,0);p1=__builtin_amdgcn_mfma_f32_32x32x16_bf16(b1,qr[0],negm,0,0,0);}
    else{p0=__builtin_amdgcn_mfma_f32_32x32x16_bf16(b0,qr[d0],p0,0,0,0);p1=__builtin_amdgcn_mfma_f32_32x32x16_bf16(b1,qr[d0],p1,0,0,0);}}
}
typedef __attribute__((address_space(3))) const char* lds_cptr;
typedef short v4i16_t __attribute__((ext_vector_type(4)));
__device__ __forceinline__ void kload8(bf16x8*kf,lds_cptr kp){
  kf[0]=*(const __attribute__((address_space(3))) bf16x8*)(kp);      kf[1]=*(const __attribute__((address_space(3))) bf16x8*)(kp+512);
  kf[2]=*(const __attribute__((address_space(3))) bf16x8*)(kp+2048); kf[3]=*(const __attribute__((address_space(3))) bf16x8*)(kp+2560);
  kf[4]=*(const __attribute__((address_space(3))) bf16x8*)(kp+4096); kf[5]=*(const __attribute__((address_space(3))) bf16x8*)(kp+4608);
  kf[6]=*(const __attribute__((address_space(3))) bf16x8*)(kp+6144); kf[7]=*(const __attribute__((address_space(3))) bf16x8*)(kp+6656);
}
__device__ __forceinline__ void kload2(bf16x8*kf,lds_cptr kp,int j){ kf[2*j]=*(const __attribute__((address_space(3))) bf16x8*)(kp+j*2048); kf[2*j+1]=*(const __attribute__((address_space(3))) bf16x8*)(kp+j*2048+512); }
__device__ __forceinline__ s16x4 vtr(lds_cptr p){ return __builtin_bit_cast(s16x4,__builtin_amdgcn_ds_read_tr16_b64_v4i16((__attribute__((address_space(3))) v4i16_t*)p)); }
__device__ __forceinline__ float rowmax(const f32x16&p0,const f32x16&p1){
  float a=max3f(p0[0],p0[1],p1[0]),b=max3f(p0[2],p0[3],p1[1]);a=max3f(a,p1[2],p1[3]);
  #pragma unroll
  for(int r=4;r<16;r+=4){a=max3f(a,p0[r],p0[r+1]);b=max3f(b,p0[r+2],p0[r+3]);a=max3f(a,p1[r],p1[r+1]);b=max3f(b,p1[r+2],p1[r+3]);}
  const float m=max2f(a,b);
  auto rr=__builtin_amdgcn_permlane32_swap(__float_as_uint(m),__float_as_uint(m),false,false);
  return max2f(__uint_as_float(rr[0]),__uint_as_float(rr[1]));
}
__device__ __forceinline__ void pv(f32x16*o,int vb,bf16x8 pa0,bf16x8 pa1,bf16x8 pa2,bf16x8 pa3){
  #pragma unroll
  for(int d0=0;d0<2;++d0){s16x4 lo[4],hi[4];
    #pragma unroll
    for(int ks=0;ks<4;++ks){
      asm volatile("ds_read_b64_tr_b16 %0,%1 offset:%c2":"=&v"(lo[ks]):"v"(vb),"i"(d0*4096+ks*1024):"memory");
      asm volatile("ds_read_b64_tr_b16 %0,%1 offset:%c2":"=&v"(hi[ks]):"v"(vb),"i"(d0*4096+ks*1024+512):"memory");}
    asm volatile("s_waitcnt lgkmcnt(0)":::"memory");SBAR();
    #define PK(k) (bf16x8){lo[k][0],lo[k][1],lo[k][2],lo[k][3],hi[k][0],hi[k][1],hi[k][2],hi[k][3]}
    o[d0]=__builtin_amdgcn_mfma_f32_32x32x16_bf16(pa0,PK(0),o[d0],0,0,0);
    o[d0]=__builtin_amdgcn_mfma_f32_32x32x16_bf16(pa1,PK(1),o[d0],0,0,0);
    o[d0]=__builtin_amdgcn_mfma_f32_32x32x16_bf16(pa2,PK(2),o[d0],0,0,0);
    o[d0]=__builtin_amdgcn_mfma_f32_32x32x16_bf16(pa3,PK(3),o[d0],0,0,0);
    #undef PK
  }
}

#ifndef ATTN_STORE16
#define ATTN_STORE16(p,v) (*(u32x4*)(p)=(v))
#endif
struct AU { const bf16* Qp; const bf16* Kp; const bf16* Vp; bf16* Op; int qrow0, lat_row0, ctx_row0, nlat_t, NT; };
struct NoMask { __device__ __forceinline__ void apply(f32x16&,f32x16&,int,int)const{} };
typedef __attribute__((address_space(3))) const float* lds_cfptr;
struct NAMask { lds_cfptr tb0; int r, rs, rs_min, cb;
  __device__ __forceinline__ void apply(f32x16&p0,f32x16&p1,int t,int hi)const{
    if(t<4)return;
    const int kr=rs_min+t-4; const float NEG=-INFINITY;
    if((unsigned)(kr-rs)>7u){
      #pragma unroll
      for(int i=0;i<16;++i){p0[i]=NEG;p1[i]=NEG;}
      return; }
    const lds_cfptr tb=tb0+(kr-r+7)*32+4*hi;
    #pragma unroll
    for(int i=0;i<16;++i){ const int k0=(i&3)+8*(i>>2); const int d0=cb+k0, d1=cb+k0+32;
      const float b0=tb[k0], b1=tb[k0+32];
      p0[i]=((unsigned)d0<=15u)?p0[i]+b0:NEG; p1[i]=((unsigned)d1<=15u)?p1[i]+b1:NEG; }
  }
};
template<int THRL,int PITCH,class MaskT,int VD=1> __device__ __forceinline__ void attn_unit(const AU& u,char*shm,const MaskT& mk){
  constexpr int L_WS=LDS_V+NSLOT*SLOTB*VD, L_OST=L_WS+NW*64*4;
  const int tid=threadIdx.x,lane=tid&63,r32=lane&31,hi=lane>>5; const int wid=__builtin_amdgcn_readfirstlane(tid>>6);
  const bf16*Qw=u.Qp+(long)(u.qrow0+wid*QBLK)*PITCH;
  const bf16*Kh=u.Kp,*Vh=u.Vp;
  const unsigned lds0=(unsigned)(uintptr_t)shm;
  float*wsf=(float*)(shm+L_WS)+wid*64;
  const bf16*ksrc=Kh+(long)lane*PITCH+wid*8;
  const bf16*vsrc=Vh+(long)(16*(wid&3)+(lane>>2))*PITCH+(wid>>2)*32+(lane&3)*8;
  const unsigned kdst=lds0+LDS_K+wid*1024, vdst=lds0+LDS_V+wid*1024;
  #define TROW(t) ((long)((t)<u.nlat_t?u.lat_row0+KVBLK*(t):u.ctx_row0+KVBLK*((t)-u.nlat_t))*PITCH)
  #define DMA_K(t,slot) glds16(ksrc+TROW(t),(unsigned)__builtin_amdgcn_readfirstlane(kdst+(slot)))
  #define DMA_V(t,slot) do{ glds16(vsrc+TROW(t),(unsigned)__builtin_amdgcn_readfirstlane(vdst+VD*(slot))); if constexpr(VD==2) glds16(vsrc+64+TROW(t),(unsigned)__builtin_amdgcn_readfirstlane(vdst+VD*(slot)+8192)); }while(0)
  const int vb0=(int)(lds0+LDS_V)+((lane>>4)&1)*32+(lane&3)*8+(4*hi+((lane&15)>>2))*64;
  const char*Kbase=shm+LDS_K; bf16x8 kf[8];
  const lds_cptr shm3=(lds_cptr)shm; const lds_cptr kp0=shm3+LDS_K+hi*1024+r32*16; const lds_cptr vp0=shm3+LDS_V+((lane>>4)&1)*32+(lane&3)*8+(4*hi+((lane&15)>>2))*64;
  const int NT=u.NT;
  DMA_K(0,0);DMA_V(0,0);DMA_K(1,SLOTB);
  bf16x8 qr[4];
  #pragma unroll
  for(int d0=0;d0<4;++d0)qr[d0]=*reinterpret_cast<const bf16x8*>(&Qw[(long)r32*PITCH+d0*16+hi*8]);
  typedef __attribute__((address_space(3))) bf16x8* lds_qptr;
  const lds_qptr qls=(lds_qptr)((lds_cptr)shm+L_OST+wid*4096+lane*16);
  if constexpr(VD==2){
    #pragma unroll
    for(int d0=0;d0<4;++d0)qls[d0*64]=qr[d0];
  }
  #define QF(d0) (VD==2?*(const __attribute__((address_space(3))) bf16x8*)(qls+(d0)*64):qr[d0])
  float mhat=0.f,l_reg=0.f;f32x16 o[2*VD];
  #pragma unroll
  for(int d_=0;d_<2*VD;++d_)o[d_]=f32x16{};
  f32x16 negm=f32x16{}; if constexpr(VD==1) asm volatile("":"+v"(negm));
  #define CMASK(P0,P1,t) mk.apply(P0,P1,(t),hi)
  bool resc=false;
  #define START(P0,P1) do{ const float rm=rowmax(P0,P1); resc=false; \
    { const float dl=rm; mhat=fadd_s(mhat,dl); \
      _Pragma("unroll") for(int r=0;r<16;++r){P0[r]=fsub_s(P0[r],dl);P1[r]=fsub_s(P1[r],dl);} \
      if constexpr(VD==1){ _Pragma("unroll") for(int r=0;r<16;++r)negm[r]=-mhat; asm volatile("":"+v"(negm)); } } \
    _Pragma("unroll") for(int r=0;r<16;++r)P0[r]=__builtin_amdgcn_exp2f(P0[r]); }while(0)
  #define RESC() do{ if(resc){ asm volatile("s_waitcnt lgkmcnt(0)":::"memory"); \
      _Pragma("unroll") for(int d_=0;d_<2*VD;++d_) _Pragma("unroll") for(int r=0;r<16;++r)o[d_][r]*=wsf[crow(r,hi)]; } }while(0)
  f32x16 pA0,pA1,pB0,pB1;
  int sl_prev=0,sl_cur=0,sl_next=SLOTB;
  #define ROT() do{sl_prev=sl_cur;sl_cur=sl_next;sl_next=(sl_next==(NSLOT-1)*SLOTB)?0:sl_next+SLOTB;}while(0)
  DMA_K(2,2*SLOTB);
  if constexpr(VD==2){WAIT_BAR(4);}else{WAIT_BAR(3);}
  qkt(pA0,pA1,Kbase,qr,negm,r32,hi);asm volatile("s_nop 15\n\ts_nop 7":"+v"(pA0),"+v"(pA1));CMASK(pA0,pA1,0);
  START(pA0,pA1);
  _Pragma("unroll") for(int r=0;r<16;++r)pA1[r]=__builtin_amdgcn_exp2f(pA1[r]);
  WAIT_BAR(0);
  DMA_K(3,0);DMA_V(1,SLOTB);
  ROT();
  kload8(kf,kp0+sl_cur);
  if constexpr(VD==2){WAIT_BAR(3);}else{WAIT_BAR(2);}
  s16x4 vlo[8],vhi[8]; u32x4 pw0,pw1,pw2,pw3;
  #define PKW(P,B) cvtpk_s(P[B],P[B+1])
  #define PAF(k) __builtin_bit_cast(bf16x8,pw##k)
  #define VFR(i) (bf16x8){vlo[i][0],vlo[i][1],vlo[i][2],vlo[i][3],vhi[i][0],vhi[i][1],vhi[i][2],vhi[i][3]}
  #define PIN(x) asm volatile("":"+v"(x))
  #define MX3(a,b,c) __builtin_fmaxf(__builtin_fmaxf((a),(b)),(c))
  #define GAPA(MF,A0,A1,A2,A3,W0,W1,PW) do{ MF; sacc+=A0; sacc+=A1; sacc+=A2; sacc+=A3; PIN(sacc); W0; W1; PIN(PW); SBAR(); }while(0)
  #define EX(v) __builtin_amdgcn_exp2f(v)
  #define GAPB(MF,X,B) do{ MF; X[B]=EX(X[B]); X[B+1]=EX(X[B+1]); X[B+2]=EX(X[B+2]); X[B+3]=EX(X[B+3]); PIN(X); SBAR(); }while(0)
  #define VRD(i) do{ vlo[i]=vtr(vp_+(((i)>>2)*4096+((i)&3)*1024)); vhi[i]=vtr(vp_+(((i)>>2)*4096+((i)&3)*1024+512)); }while(0)
  #define VRDH(i) do{ if constexpr(VD==2){ vlo[i]=vtr(vp_+8192+(((i)>>2)*4096+((i)&3)*1024)); vhi[i]=vtr(vp_+8192+(((i)>>2)*4096+((i)&3)*1024+512)); SBAR(); } }while(0)
  #define KRD(G,j) do{ if(G){ kload2(kf,kp0+sl_next,j); SBAR(); } }while(0)
  #define STEP(C0,C1,P0,P1,t,GK,GV,GL) do{ SBAR(); \
    const lds_cptr vp_=vp0+VD*sl_prev; \
    VRD(0); SBAR(); float sacc=(P0[0]+P0[1]); \
    GAPA(C0=__builtin_amdgcn_mfma_f32_32x32x16_bf16(kf[0],QF(0),negm,0,0,0), P0[2],P0[3],P0[4],P0[5],     pw0[0]=PKW(P0,0), pw0[1]=PKW(P0,2), pw0); \
    VRD(4); SBAR(); GAPA(C1=__builtin_amdgcn_mfma_f32_32x32x16_bf16(kf[1],QF(0),negm,0,0,0), P0[6],P0[7],P0[8],P0[9],     pw0[2]=PKW(P0,4), pw0[3]=PKW(P0,6), pw0); \
    VRD(1); SBAR(); GAPA(C0=__builtin_amdgcn_mfma_f32_32x32x16_bf16(kf[2],QF(1),C0,0,0,0),   P0[10],P0[11],P0[12],P0[13], pw1[0]=PKW(P0,8), pw1[1]=PKW(P0,10), pw1); \
    VRD(5); SBAR(); GAPA(C1=__builtin_amdgcn_mfma_f32_32x32x16_bf16(kf[3],QF(1),C1,0,0,0),   P0[14],P0[15],P1[0],P1[1],   pw1[2]=PKW(P0,12),pw1[3]=PKW(P0,14), pw1); \
    VRD(2); SBAR(); GAPA(C0=__builtin_amdgcn_mfma_f32_32x32x16_bf16(kf[4],QF(2),C0,0,0,0),   P1[2],P1[3],P1[4],P1[5],     pw2[0]=PKW(P1,0), pw2[1]=PKW(P1,2), pw2); \
    VRD(6); SBAR(); GAPA(C1=__builtin_amdgcn_mfma_f32_32x32x16_bf16(kf[5],QF(2),C1,0,0,0),   P1[6],P1[7],P1[8],P1[9],     pw2[2]=PKW(P1,4), pw2[3]=PKW(P1,6), pw2); \
    VRD(3); SBAR(); GAPA(C0=__builtin_amdgcn_mfma_f32_32x32x16_bf16(kf[6],QF(3),C0,0,0,0),   P1[10],P1[11],P1[12],P1[13], pw3[0]=PKW(P1,8), pw3[1]=PKW(P1,10), pw3); \
    VRD(7); SBAR(); GAPA(C1=__builtin_amdgcn_mfma_f32_32x32x16_bf16(kf[7],QF(3),C1,0,0,0),   P1[14],P1[15],0.f,0.f,       pw3[2]=PKW(P1,12),pw3[3]=PKW(P1,14), pw3); \
    l_reg+=sacc; \
    if(GK){DMA_K((t)+3,sl_cur);} if(GV){DMA_V((t)+1,sl_next);} \
    CMASK(C0,C1,t); \
    { float a=MX3(C0[0],C0[1],C1[0]),b=MX3(C0[2],C0[3],C1[1]); a=MX3(a,C1[2],C1[3]); \
      _Pragma("unroll") for(int r=4;r<16;r+=4){a=MX3(a,C0[r],C0[r+1]);b=MX3(b,C0[r+2],C0[r+3]);a=MX3(a,C1[r],C1[r+1]);b=MX3(b,C1[r+2],C1[r+3]);} \
      float rm=__builtin_fmaxf(a,b); { auto rr=__builtin_amdgcn_permlane32_swap(__float_as_uint(rm),__float_as_uint(rm),false,false); rm=__builtin_fmaxf(__uint_as_float(rr[0]),__uint_as_float(rr[1])); } \
      if constexpr(VD==2) rm-=mhat;                   \
      resc=false; \
      if(__builtin_expect(__any(rm>(float)THRL),0)){ const float dl=__builtin_fmaxf(rm,0.f); mhat+=dl; \
        if constexpr(VD==1){ _Pragma("unroll") for(int r=0;r<16;++r){C0[r]-=dl;C1[r]-=dl;} \
          _Pragma("unroll") for(int r=0;r<16;++r)negm[r]=-mhat; asm volatile("":"+v"(negm)); } \
        const float f=__builtin_amdgcn_exp2f(-dl); l_reg*=f; if(hi==0)wsf[r32]=f; resc=true; } \
      if constexpr(VD==2){ _Pragma("unroll") for(int r=0;r<16;++r){C0[r]-=mhat;C1[r]-=mhat;} } } \
    SBAR(); \
    GAPB(o[0]=__builtin_amdgcn_mfma_f32_32x32x16_bf16(PAF(0),VFR(0),o[0],0,0,0), C0,0); VRDH(0); \
    GAPB(o[1]=__builtin_amdgcn_mfma_f32_32x32x16_bf16(PAF(0),VFR(4),o[1],0,0,0), C0,4); VRDH(4); \
    KRD(GL,0); GAPB(o[0]=__builtin_amdgcn_mfma_f32_32x32x16_bf16(PAF(1),VFR(1),o[0],0,0,0), C0,8); VRDH(1); \
    KRD(GL,1); GAPB(o[1]=__builtin_amdgcn_mfma_f32_32x32x16_bf16(PAF(1),VFR(5),o[1],0,0,0), C0,12); VRDH(5); \
    KRD(GL,2); GAPB(o[0]=__builtin_amdgcn_mfma_f32_32x32x16_bf16(PAF(2),VFR(2),o[0],0,0,0), C1,0); VRDH(2); \
    KRD(GL,3); GAPB(o[1]=__builtin_amdgcn_mfma_f32_32x32x16_bf16(PAF(2),VFR(6),o[1],0,0,0), C1,4); VRDH(6); \
    GAPB(o[0]=__builtin_amdgcn_mfma_f32_32x32x16_bf16(PAF(3),VFR(3),o[0],0,0,0), C1,8); VRDH(3); \
    GAPB(o[1]=__builtin_amdgcn_mfma_f32_32x32x16_bf16(PAF(3),VFR(7),o[1],0,0,0), C1,12); VRDH(7); \
    if constexpr(VD==2){     \
      o[2]=__builtin_amdgcn_mfma_f32_32x32x16_bf16(PAF(0),VFR(0),o[2],0,0,0); o[3]=__builtin_amdgcn_mfma_f32_32x32x16_bf16(PAF(0),VFR(4),o[3],0,0,0); \
      o[2]=__builtin_amdgcn_mfma_f32_32x32x16_bf16(PAF(1),VFR(1),o[2],0,0,0); o[3]=__builtin_amdgcn_mfma_f32_32x32x16_bf16(PAF(1),VFR(5),o[3],0,0,0); \
      o[2]=__builtin_amdgcn_mfma_f32_32x32x16_bf16(PAF(2),VFR(2),o[2],0,0,0); o[3]=__builtin_amdgcn_mfma_f32_32x32x16_bf16(PAF(2),VFR(6),o[3],0,0,0); \
      o[2]=__builtin_amdgcn_mfma_f32_32x32x16_bf16(PAF(3),VFR(3),o[2],0,0,0); o[3]=__builtin_amdgcn_mfma_f32_32x32x16_bf16(PAF(3),VFR(7),o[3],0,0,0); SBAR(); } \
    }while(0)
  #define WB_FULL() do{ if constexpr(VD==2){WAIT_BAR(3);}else{WAIT_BAR(2);} }while(0)
  #define WB_VONLY() do{ if constexpr(VD==2){WAIT_BAR(2);}else{WAIT_BAR(1);} }while(0)
  int t=1;
  #undef CMASK
  #define CMASK(P0,P1,t) mk.apply(P0,P1,(t),hi)
  for(;t+5<NT;t+=2){
    STEP(pB0,pB1,pA0,pA1,t,true,true,true);     WB_FULL(); RESC(); ROT();
    STEP(pA0,pA1,pB0,pB1,t+1,true,true,true);   WB_FULL(); RESC(); ROT();
  }
  #undef CMASK
  #define CMASK(P0,P1,t) mk.apply(P0,P1,(t),hi)
  #define ENDW(tt) do{ if((tt)+3<NT){WB_FULL();} else if((tt)+2<NT){WB_VONLY();} else {WAIT_BAR(0);} }while(0)
  for(;t+1<NT;t+=2){
    STEP(pB0,pB1,pA0,pA1,t,(t+3<NT),(t+1<NT),(t+1<NT));       ENDW(t);   RESC(); ROT();
    STEP(pA0,pA1,pB0,pB1,t+1,(t+4<NT),(t+2<NT),(t+2<NT));     ENDW(t+1); RESC(); ROT();
  }
  STEP(pB0,pB1,pA0,pA1,NT-1,false,false,false); RESC();
  { float sacc=pB0[0]+pB0[1]; _Pragma("unroll") for(int r=2;r<16;++r)sacc+=pB0[r]; _Pragma("unroll") for(int r=0;r<16;++r)sacc+=pB1[r]; l_reg+=sacc;
    pw0=(u32x4){PKW(pB0,0),PKW(pB0,2),PKW(pB0,4),PKW(pB0,6)};pw1=(u32x4){PKW(pB0,8),PKW(pB0,10),PKW(pB0,12),PKW(pB0,14)};pw2=(u32x4){PKW(pB1,0),PKW(pB1,2),PKW(pB1,4),PKW(pB1,6)};pw3=(u32x4){PKW(pB1,8),PKW(pB1,10),PKW(pB1,12),PKW(pB1,14)};
    SBAR(); pv(o,vb0+VD*sl_cur,PAF(0),PAF(1),PAF(2),PAF(3)); if constexpr(VD==2) pv(o+2,vb0+VD*sl_cur+8192,PAF(0),PAF(1),PAF(2),PAF(3)); }
  #undef PKW
  #undef PAF
  #undef VFR
  #undef PIN
  #undef MX3
  #undef GAPA
  #undef GAPB
  #undef EX
  #undef VRD
  #undef VRDH
  #undef KRD
  #undef STEP
  #undef ENDW
  #undef WB_FULL
  #undef WB_VONLY
  {auto rr=__builtin_amdgcn_permlane32_swap(__float_as_uint(l_reg),__float_as_uint(l_reg),false,false);l_reg=__uint_as_float(rr[0])+__uint_as_float(rr[1]);}
  if(hi==0)wsf[32+r32]=l_reg;asm volatile("s_waitcnt lgkmcnt(0)":::"memory");
  float rli[16];
  #pragma unroll
  for(int r=0;r<16;++r)rli[r]=__builtin_amdgcn_rcpf(wsf[32+crow(r,hi)]);
  int lane_e=lane; asm volatile("":"+v"(lane_e));
  bf16*Ow=u.Op+(long)(u.qrow0+wid*QBLK)*OPITCH;
  { bf16*stg=(bf16*)(shm+L_OST)+wid*2048;
    #pragma unroll
    for(int vh_=0;vh_<VD;++vh_){
      #pragma unroll
      for(int r=0;r<16;++r){const int orow=crow(r,hi);
        #pragma unroll
        for(int d0=0;d0<2;++d0)stg[orow*64+d0*32+r32]=__float2bfloat16(o[2*vh_+d0][r]*rli[r]);}
      asm volatile("s_waitcnt lgkmcnt(0)":::"memory");
      #pragma unroll
      for(int i=0;i<4;++i){const int row=i*8+(lane_e>>3),ch=lane_e&7; const u32x4 v=*(const u32x4*)(stg+row*64+ch*8); ATTN_STORE16(Ow+(long)row*OPITCH+64*vh_+ch*8,v);}
      asm volatile("s_waitcnt lgkmcnt(0)":::"memory"); } }
  asm volatile("s_waitcnt lgkmcnt(0)\n\ts_barrier":::"memory");
  #undef QF
  #undef DMA_K
  #undef TROW
  #undef DMA_V
  #undef CMASK
  #undef START
  #undef RESC
  #undef ROT
}
constexpr int ATTN_LDS_BYTES=LDS_BYTES;
#undef SBAR
#undef WAIT_BAR
}

struct Params { const float* in[26]; float* out; unsigned char* ws; int ph_lo, ph_hi; };
struct Ctx { LAS unsigned char* lds; int tid, lane, wave, vcu, G, gw, NGW; };
enum { I_X = 0, I_C, I_CTX, I_CCTX, I_ADAW, I_ADAB, I_LNG, I_LNB, I_W0IN, I_W0OUT, I_LQ1, I_LK1, I_LQ2, I_LK2, I_SUBLN, I_QN, I_KN,
       I_W1IN, I_W1OUT, I_RPB, I_POOLW, I_POOLS, I_ROUTER, I_WG, I_WU, I_WD };

__device__ __forceinline__ const float* mod_row(const Params& p, int layer, int row) {
    return (const float*)(p.ws + WS_MOD) + (size_t)(layer * 9 + (row < LAT ? (row >> 11) : 8)) * 6144;
}

__device__ __forceinline__ void ph_prologue(const Params& p, const Ctx& c) {
    const float* cin = p.in[I_C]; const float* cctx = p.in[I_CCTX]; const float* ada_w = p.in[I_ADAW]; const float* ada_b = p.in[I_ADAB];
    float* MOD = (float*)(p.ws + WS_MOD);
    LAS float* sc = (LAS float*)c.lds;
    LAS float* red = sc + 9 * 1024;
    for (int i = c.tid; i < 9 * 1024; i += 512) { const float v = i < 8192 ? cin[i] : cctx[i - 8192]; sc[i] = v / (1.f + expf(-v)); }
    __syncthreads();
    for (int u = c.vcu; u < 192; u += c.G) {
        const int layer = u / 96, j0 = (u - layer * 96) * 64;
        float acc[9];
#pragma unroll
        for (int m = 0; m < 9; ++m) acc[m] = 0.f;
        const float* wp = ada_w + (size_t)layer * 1024 * 6144 + (size_t)(128 * c.wave) * 6144 + j0 + c.lane;
#pragma unroll 1
        for (int kb = 0; kb < 128; kb += 32) {
            float wv[32];
#pragma unroll
            for (int i = 0; i < 32; ++i) wv[i] = wp[(size_t)(kb + i) * 6144];
#pragma unroll
            for (int i4 = 0; i4 < 8; ++i4)
#pragma unroll
                for (int m = 0; m < 9; ++m) { const f32x4 sv = *(const LAS f32x4*)(sc + m * 1024 + 128 * c.wave + kb + 4 * i4);
                    acc[m] += sv.x * wv[4 * i4] + sv.y * wv[4 * i4 + 1] + sv.z * wv[4 * i4 + 2] + sv.w * wv[4 * i4 + 3]; }
        }
#pragma unroll
        for (int m = 0; m < 9; ++m) red[(c.wave * 9 + m) * 64 + c.lane] = acc[m];
        __syncthreads();
        for (int o = c.tid; o < 576; o += 512) {
            const int m = o >> 6, j = o & 63; float s2 = 0.f;
#pragma unroll
            for (int w = 0; w < 8; ++w) s2 += red[(w * 9 + m) * 64 + j];
            MOD[(size_t)(layer * 9 + m) * 6144 + j0 + j] = s2 + ada_b[layer * 6144 + j0 + j];
        }
        __syncthreads();
    }
    if (c.vcu == 0) {
        f32x2* R = (f32x2*)(p.ws + WS_ROPE);
        for (int i = c.tid; i < 1024; i += 512) {
            const int pos = i >> 4, f = i & 15;
            const float inv = exp2f(-(float)f * (13.287712379549449f / 16.f));
            const float a = (float)pos * inv;
            const float k = rintf(a * 0.15915494309189535f);
            float rr = fmaf(-k, 6.28125f, a); rr = fmaf(-k, 1.9353071795864769e-3f, rr);
            R[i] = (f32x2){__cosf(rr), __sinf(rr)};
        }
    }
}


__device__ __forceinline__ void transpose_item(const float* W, int ldw, int k0, int n0, bf16* WT, int Kd, int drow0, LAS float* scr, int lane) {
#pragma unroll 8
    for (int i = 0; i < 32; ++i) { const int kk = 2 * i + (lane >> 5); scr[kk * 33 + (lane & 31)] = W[(size_t)(k0 + kk) * ldw + n0 + (lane & 31)]; }
    asm volatile("s_waitcnt lgkmcnt(0)" ::: "memory");
    const int ch = lane & 7;
#pragma unroll
    for (int j = 0; j < 4; ++j) { const int n = (lane >> 3) + 8 * j; const LAS float* sp = scr + (8 * ch) * 33 + n;
        v4u o; o.x = pk2(sp[0 * 33], sp[1 * 33]); o.y = pk2(sp[2 * 33], sp[3 * 33]); o.z = pk2(sp[4 * 33], sp[5 * 33]); o.w = pk2(sp[6 * 33], sp[7 * 33]);
        *(v4u*)(WT + (size_t)(drow0 + n) * Kd + k0 + 8 * ch) = o; }
    asm volatile("s_waitcnt lgkmcnt(0)" ::: "memory");
}
__device__ __forceinline__ void transpose_item8(const float* W, int ldw, int k0, int n0, unsigned char* WT8, int Kd, int drow0, float scale, LAS float* scr, int lane) {
#pragma unroll 8
    for (int i = 0; i < 32; ++i) { const int kk = 2 * i + (lane >> 5); scr[kk * 33 + (lane & 31)] = W[(size_t)(k0 + kk) * ldw + n0 + (lane & 31)]; }
    asm volatile("s_waitcnt lgkmcnt(0)" ::: "memory");
    const int n = lane >> 1, hf = lane & 1; const LAS float* sp = scr + (32 * hf) * 33 + n;
    v4u o0, o1;
    o0.x = pg8::pk4_fp8(sp[0 * 33] * scale, sp[1 * 33] * scale, sp[2 * 33] * scale, sp[3 * 33] * scale);     o0.y = pg8::pk4_fp8(sp[4 * 33] * scale, sp[5 * 33] * scale, sp[6 * 33] * scale, sp[7 * 33] * scale);
    o0.z = pg8::pk4_fp8(sp[8 * 33] * scale, sp[9 * 33] * scale, sp[10 * 33] * scale, sp[11 * 33] * scale);   o0.w = pg8::pk4_fp8(sp[12 * 33] * scale, sp[13 * 33] * scale, sp[14 * 33] * scale, sp[15 * 33] * scale);
    o1.x = pg8::pk4_fp8(sp[16 * 33] * scale, sp[17 * 33] * scale, sp[18 * 33] * scale, sp[19 * 33] * scale); o1.y = pg8::pk4_fp8(sp[20 * 33] * scale, sp[21 * 33] * scale, sp[22 * 33] * scale, sp[23 * 33] * scale);
    o1.z = pg8::pk4_fp8(sp[24 * 33] * scale, sp[25 * 33] * scale, sp[26 * 33] * scale, sp[27 * 33] * scale); o1.w = pg8::pk4_fp8(sp[28 * 33] * scale, sp[29 * 33] * scale, sp[30 * 33] * scale, sp[31 * 33] * scale);
    unsigned char* dst = WT8 + (size_t)(drow0 + n) * Kd + k0 + 32 * hf;
    *(v4u*)dst = o0; *(v4u*)(dst + 16) = o1;
    asm volatile("s_waitcnt lgkmcnt(0)" ::: "memory");
}
struct TBlk { const float* src; unsigned char* dst; int ldw, Kd, gu, which; float scale; };
__device__ __forceinline__ TBlk tblk_decode(const Params& p, int blk) {
    const int ie = blk / 96, q = blk - ie * 96, layer = ie >> 4, e = ie & 15, which = q >> 5, idx = q & 31;
    TBlk t; t.which = which;
    if (which < 2) { const int kb = idx & 3, nb = idx >> 2, k0 = 256 * kb, n0 = 256 * nb;
        t.src = (which == 0 ? p.in[I_WG] : p.in[I_WU]) + (size_t)ie * DM * FF + (size_t)k0 * FF + n0; t.ldw = FF; t.Kd = DM; t.scale = W8_GU; t.gu = 1;
        t.dst = p.ws + WS_WGU + (size_t)layer * WS_MOE_LSTRIDE + (size_t)e * 4096 * DM + (size_t)(2 * nb) * 256 * DM + k0; }
    else { const int kb = idx & 7, nb = idx >> 3, k0 = 256 * kb, n0 = 256 * nb;
        t.src = p.in[I_WD] + (size_t)ie * FF * DM + (size_t)k0 * DM + n0; t.ldw = DM; t.Kd = FF; t.scale = W8_DN; t.gu = 0;
        t.dst = p.ws + WS_WDN + (size_t)layer * WS_MOE_LSTRIDE + (size_t)e * DM * FF + (size_t)n0 * FF + k0; }
    return t;
}
__device__ __forceinline__ void tblk_load(const TBlk& t, f32x4 (&v)[16], int wave, int lane, int hf) {
    const float* sp = t.src + (size_t)(32 * wave + 16 * hf) * t.ldw + 4 * lane;
#pragma unroll
    for (int i = 0; i < 16; ++i) v[i] = __builtin_nontemporal_load((const f32x4*)(sp + (size_t)i * t.ldw));
}
constexpr int TPITCH = 264;
__device__ __forceinline__ void tblk_pack(const TBlk& t, const f32x4 (&v)[16], LAS unsigned char* T, int wave, int lane, int hf) {
#pragma unroll
    for (int i = 0; i < 4; ++i) {
        const f32x4 r0 = v[4 * i] * t.scale, r1 = v[4 * i + 1] * t.scale, r2 = v[4 * i + 2] * t.scale, r3 = v[4 * i + 3] * t.scale;
#pragma unroll
        for (int j = 0; j < 4; ++j) { int w = 0; w = __builtin_amdgcn_cvt_pk_fp8_f32(r0[j], r1[j], w, false); w = __builtin_amdgcn_cvt_pk_fp8_f32(r2[j], r3[j], w, true);
            *(LAS unsigned*)(T + (64 * j + lane) * TPITCH + 32 * wave + 16 * hf + 4 * i) = (unsigned)w; }
    }
}
__device__ __forceinline__ void tblk_writeout(const TBlk& t, const LAS unsigned char* T, int tid) {
#pragma unroll
    for (int it = 0; it < 8; ++it) { const int idx = it * 512 + tid, n = idx >> 4, ch = idx & 15, rho = (n & 3) * 64 + (n >> 2);
        const LAS unsigned char* sp = T + rho * TPITCH + 16 * ch;
        const v2u a = *(const LAS v2u*)sp, b2 = *(const LAS v2u*)(sp + 8);
        const int drow = t.gu ? ((n >> 7) * 256 + (n & 127) + t.which * 128) : n;
        __builtin_nontemporal_store((v4u){a.x, a.y, b2.x, b2.y}, (v4u*)(t.dst + (size_t)drow * t.Kd + 16 * ch)); }
}
__device__ __forceinline__ void moe_transpose_blocks(const Params& p, const Ctx& c, int blk0, int blk1, int widx, int nw) {
    LAS unsigned char* T = c.lds;
    f32x4 va[16], vb[16];
    int blk = blk0 + widx;
    if (blk >= blk1) return;
    TBlk t = tblk_decode(p, blk);
    tblk_load(t, va, c.wave, c.lane, 0);
#pragma unroll 1
    for (; blk < blk1; blk += nw) {
        tblk_load(t, vb, c.wave, c.lane, 1);
        tblk_pack(t, va, T, c.wave, c.lane, 0);
        const int nb = blk + nw;
        TBlk tn = tblk_decode(p, nb < blk1 ? nb : blk0);
        if (nb < blk1) tblk_load(tn, va, c.wave, c.lane, 0);
        tblk_pack(t, vb, T, c.wave, c.lane, 1);
        __syncthreads();
        tblk_writeout(t, T, c.tid);
        __syncthreads();
        t = tn;
    }
}
__device__ __forceinline__ void tail_transposes(const Params& p, const Ctx& c, int first_idle, int my, int blk0, int nblk) {
    if (!TAIL_TRANSPOSE || c.G != 256 || my < first_idle) return;
    moe_transpose_blocks(p, c, blk0, blk0 + nblk, my - first_idle, c.G - first_idle);
}
__device__ __forceinline__ void ph_transposes(const Params& p, const Ctx& c) {
    LAS float* scr = (LAS float*)(c.lds + c.wave * 16384);
    constexpr int I0 = 16 * 72, I1 = 16 * 32, I2 = 16 * 64, I3 = 16 * 32, ISM = I0 + I1 + I2 + I3;
    for (int r0 = c.gw; r0 < ISM; r0 += c.NGW) {
        int r = r0;
        if (r < I0) { const int n0 = 32 * (r % 72), drow = FUSE_QKV ? ((n0 >> 8) * 256 + 128 * ((n0 >> 5) & 1) + 32 * ((n0 >> 6) & 3)) : n0;
            transpose_item(p.in[I_W0IN], EIN, 64 * (r / 72), n0, (bf16*)(p.ws + WS_W0IN), DM, drow, scr, c.lane); continue; } r -= I0;
        if (r < I1) { transpose_item(p.in[I_W0OUT], DM, 64 * (r / 32), 32 * (r % 32), (bf16*)(p.ws + WS_W0OUT), DM, 32 * (r % 32), scr, c.lane); continue; } r -= I1;
        if (r < I2) { transpose_item(p.in[I_W1IN], OIN, 64 * (r / 64), 32 * (r % 64), (bf16*)(p.ws + WS_W1IN), DM, 32 * (r % 64), scr, c.lane); continue; } r -= I2;
        transpose_item(p.in[I_W1OUT], DM, 64 * (r / 32), 32 * (r % 32), (bf16*)(p.ws + WS_W1OUT), DM, 32 * (r % 32), scr, c.lane);
    }
    static_assert(MOE_FP8, "the expert-weight transposes write e4m3 copies");
    __syncthreads();
    moe_transpose_blocks(p, c, 0, (TAIL_TRANSPOSE && c.G == 256) ? 1536 : 3072, c.vcu, c.G);
}

__device__ __forceinline__ void ph_modulate0(const Params& p, const Ctx& c) {
    bf16* HB = (bf16*)(p.ws + WS_HB);
    for (int row = c.gw; row < NTOK; row += c.NGW) {
        const float* src = row < LAT ? p.in[I_X] + (size_t)row * DM : p.in[I_CTX] + (size_t)(row - LAT) * DM;
        const float* mod = mod_row(p, 0, row);
#pragma unroll
        for (int j = 0; j < 4; ++j) {
            const int col = 4 * c.lane + 256 * j;
            const f32x4 v = *(const f32x4*)(src + col), sh = *(const f32x4*)(mod + col), s = *(const f32x4*)(mod + 1024 + col);
            const f32x4 h = v * (s + 1.f) + sh;
            *(v2u*)(HB + (size_t)row * DM + col) = (v2u){pk2(h.x, h.y), pk2(h.z, h.w)};
        }
    }
}

struct NG { const bf16* A; int lda; const float* W0; const float* W1; int ldw; size_t wstride; int Mb; int row_begin, row_end, col_begin, col_end, K; };
template <int NB, class Epi>
__device__ __forceinline__ void ngemm(const NG& g, const Ctx& c, const Epi& epi) {
    const int nmt = (g.row_end - g.row_begin) / 32, nnt = (g.col_end - g.col_begin) / 32;
    const int l31 = c.lane & 31, lh = c.lane >> 5;
    for (int t = c.gw; t < nmt * nnt; t += c.NGW) {
        const int mt = t / nnt, nt = t % nnt;
        const int row0 = g.row_begin + mt * 32, col0 = g.col_begin + nt * 32;
        const int e = row0 / g.Mb;
        const bf16* ap = g.A + (size_t)(row0 + l31) * g.lda + lh;
        const float* bp0 = g.W0 + (size_t)e * g.wstride + (size_t)lh * g.ldw + col0 + l31;
        const float* bp1 = NB == 2 ? g.W1 + (size_t)e * g.wstride + (size_t)lh * g.ldw + col0 + l31 : nullptr;
        f32x16 acc0 = {}, acc1 = {};
#pragma unroll 8
        for (int k = 0; k < g.K; k += 2) {
            const float a = bf2f((unsigned)ap[k]);
            const float b0 = bp0[(size_t)k * g.ldw];
            acc0 = __builtin_amdgcn_mfma_f32_32x32x2f32(a, b0, acc0, 0, 0, 0);
            if (NB == 2) { const float b1 = bp1[(size_t)k * g.ldw]; acc1 = __builtin_amdgcn_mfma_f32_32x32x2f32(a, b1, acc1, 0, 0, 0); }
        }
#pragma unroll
        for (int r = 0; r < 16; ++r) {
            const int row = row0 + (r & 3) + 8 * (r >> 2) + 4 * lh, col = col0 + l31;
            epi(row, col, acc0[r], acc1[r]);
        }
    }
}
struct EpiF32 { float* O; int ldc; __device__ __forceinline__ void operator()(int row, int col, float v0, float) const { O[(size_t)row * ldc + col] = v0; } };
struct EpiBf { bf16* O; int ldc; int scale_cols; float sc; __device__ __forceinline__ void operator()(int row, int col, float v0, float) const { O[(size_t)row * ldc + col] = (bf16)f2bf(col < scale_cols ? v0 * sc : v0); } };
struct EpiSwiglu { bf16* O; __device__ __forceinline__ void operator()(int row, int col, float g, float u) const { const float s = g / (1.f + __expf(-g)); O[(size_t)row * FF + col] = (bf16)f2bf(s * u); } };
struct EpiGate { bf16* O; const float* gate; __device__ __forceinline__ void operator()(int row, int col, float v0, float) const { O[(size_t)row * DM + col] = (bf16)f2bf(v0 * gate[row]); } };

template <bool F32IN> __device__ __forceinline__ void ph_qkv_post(const Params& p, const Ctx& c) {
    const float* PF = (const float*)(p.ws + WS_PF);
    bf16* QKV = (bf16*)(p.ws + WS_QKV);
    const f32x2* R = (const f32x2*)(p.ws + WS_ROPE);
    const float* qn = p.in[I_QN]; const float* kn = p.in[I_KN];
    const int d = c.lane;
    const float qg = qn[d], kg = kn[d];
    for (int row = c.gw; row < NTOK; row += c.NGW) {
        const bool lat = row < LAT;
        const int t = row & 2047;
        const int pos = (d < 32) ? (t >> 6) : (t & 63);
        const f32x2 cs = R[pos * 16 + (d & 15)];
        const bool first = (d & 16) == 0;
        float vv[36];
#pragma unroll
        for (int hs = 0; hs < 36; ++hs) vv[hs] = F32IN ? PF[(size_t)row * EIN + hs * 64 + d] : bf2f((unsigned)QKV[(size_t)row * EIN + hs * 64 + d]);
#pragma unroll
        for (int hs = 0; hs < 36; ++hs) {
            float v = vv[hs];
            const bool isq = hs < 8 || (hs >= 24 && hs < 32);
            const bool isk = (hs >= 8 && hs < 16) || hs == 32 || hs == 33;
            const bool nrm = hs >= 24 && hs < 34;
            if (nrm) { const float ss = wave_sum(v * v); v = v * rsqrtf(ss * (1.f / 64.f) + RMS_EPS) * (hs < 32 ? qg : kg); }
            if ((isq || isk) && lat) { const float pr = __shfl_xor(v, 16); v = first ? v * cs.x - pr * cs.y : v * cs.x + pr * cs.y; }
            if (isq) v *= C2;
            QKV[(size_t)row * EIN + hs * 64 + d] = (bf16)f2bf(v);
        }
    }
}

__device__ __forceinline__ void ph_attn0_naive(const Params& p, const Ctx& c) {
    const bf16* QKV = (const bf16*)(p.ws + WS_QKV);
    bf16* CC = (bf16*)(p.ws + WS_CC);
    bf16* AO = (bf16*)(p.ws + WS_AO);
    LAS float* Ks = (LAS float*)c.lds;
    LAS float* Vs = Ks + 4096;
    for (int u = c.vcu; u < 960; u += c.G) {
        const bool isctx = u >= 768;
        int b, vh, qrow, ntiles; bool active = true;
        if (!isctx) { b = u / 96; const int r = u % 96; vh = r >> 2; qrow = b * SEQ + (r & 3) * 512 + c.tid; ntiles = 36; }
        else { const int uu = u - 768; b = uu / 24; vh = uu % 24; qrow = LAT + b * NCTX + (c.tid & 255); active = c.tid < 256; ntiles = 4; }
        int qcol, kcol, vcol;
        if (vh < 16) { const int a = vh >> 2, s = (vh >> 1) & 1, half = vh & 1; qcol = a * 128 + s * 64; kcol = 512 + a * 128 + s * 64; vcol = 1024 + a * 128 + half * 64; }
        else { const int h = vh - 16; qcol = 1536 + h * 64; kcol = 2048 + (h >> 2) * 64; vcol = 2176 + (h >> 2) * 64; }
        float q[64], o[64];
#pragma unroll
        for (int i = 0; i < 8; ++i) { const v4u w = *(const v4u*)(QKV + (size_t)qrow * EIN + qcol + 8 * i); unpack8(w, q + 8 * i); }
#pragma unroll
        for (int i = 0; i < 64; ++i) o[i] = 0.f;
        float m = -1e30f, l = 0.f;
        for (int t = 0; t < ntiles; ++t) {
            const int krow0 = isctx ? LAT + b * NCTX + 64 * t : (t < 32 ? b * SEQ + 64 * t : LAT + b * NCTX + 64 * (t - 32));
            __syncthreads();
            { const int r = c.tid >> 3, ch = c.tid & 7; float f[8];
              const v4u kw = *(const v4u*)(QKV + (size_t)(krow0 + r) * EIN + kcol + ch * 8); unpack8(kw, f);
#pragma unroll
              for (int j = 0; j < 8; ++j) Ks[r * 64 + ch * 8 + j] = f[j];
              const v4u vw = *(const v4u*)(QKV + (size_t)(krow0 + r) * EIN + vcol + ch * 8); unpack8(vw, f);
#pragma unroll
              for (int j = 0; j < 8; ++j) Vs[r * 64 + ch * 8 + j] = f[j]; }
            __syncthreads();
            if (active) {
                for (int kk = 0; kk < 64; ++kk) {
                    float s = 0.f;
#pragma unroll
                    for (int dd = 0; dd < 64; ++dd) s += q[dd] * Ks[kk * 64 + dd];
                    const float mn = fmaxf(m, s), al = exp2f(m - mn), pp = exp2f(s - mn);
                    l = l * al + pp; m = mn;
#pragma unroll
                    for (int dd = 0; dd < 64; ++dd) o[dd] = o[dd] * al + pp * Vs[kk * 64 + dd];
                }
            }
        }
        if (active) {
            const float rl = 1.f / l;
            bf16* dst = vh < 16 ? AO + (size_t)qrow * DM + (vh >> 2) * 256 + ((vh >> 1) & 1) * 128 + (vh & 1) * 64 : CC + (size_t)qrow * DM + 512 + (vh - 16) * 64;
            {
#pragma unroll
                for (int i = 0; i < 8; ++i) *(v4u*)(dst + 8 * i) = (v4u){pk2(o[8 * i] * rl, o[8 * i + 1] * rl), pk2(o[8 * i + 2] * rl, o[8 * i + 3] * rl), pk2(o[8 * i + 4] * rl, o[8 * i + 5] * rl), pk2(o[8 * i + 6] * rl, o[8 * i + 7] * rl)}; }
        }
    }
}


__device__ __forceinline__ void attn_combine_rows(const Params& p, const Ctx& c, int row0, int a, float lam, float g0, float g1) {
    const bf16* AO = (const bf16*)(p.ws + WS_AO); bf16* CC = (bf16*)(p.ws + WS_CC);
    asm volatile("s_waitcnt vmcnt(0)" ::: "memory");
#pragma unroll 1
    for (int rb = 0; rb < 32; rb += 8) {
        float x0[8], x1[8];
#pragma unroll
        for (int j = 0; j < 8; ++j) { const bf16* src = AO + (size_t)(row0 + rb + j) * DM + a * 256;
            x0[j] = bf2f((unsigned)src[c.lane]) - lam * bf2f((unsigned)src[128 + c.lane]); x1[j] = bf2f((unsigned)src[64 + c.lane]) - lam * bf2f((unsigned)src[192 + c.lane]); }
#pragma unroll
        for (int j = 0; j < 8; ++j) { const float ss = wave_sum(x0[j] * x0[j] + x1[j] * x1[j]); const float r = rsqrtf(ss * (1.f / 128.f) + RMS_EPS);
            bf16* dst = CC + (size_t)(row0 + rb + j) * DM + a * 128;
            dst[c.lane] = (bf16)f2bf(x0[j] * r * g0); dst[64 + c.lane] = (bf16)f2bf(x1[j] * r * g1); }
    }
}
__device__ __forceinline__ void ph_attn0_fast(const Params& p, const Ctx& c, char* lds_generic) {
    typedef attn_body::bf16 abf;
    const abf* Q = (const abf*)(p.ws + WS_QKV); abf* CCb = (abf*)(p.ws + WS_CC); abf* AOb = (abf*)(p.ws + WS_AO);
    const float d1 = wave_sum(p.in[I_LQ1][c.lane] * p.in[I_LK1][c.lane]), d2 = wave_sum(p.in[I_LQ2][c.lane] * p.in[I_LK2][c.lane]);
    const float lam = expf(d1) - expf(d2) + LAM_INIT;
    const float g0 = p.in[I_SUBLN][c.lane] * (1.f - LAM_INIT), g1 = p.in[I_SUBLN][c.lane + 64] * (1.f - LAM_INIT);
    for (int v = c.vcu; v < 256; v += c.G) {
#pragma unroll 1
        for (int step = 0; step < 6; ++step) {
            attn_body::AU u; int a = -1, sp = 0, h = 0; bool ctxu = false;
            if (step < 2) { const int b = v >> 5; a = (v >> 3) & 3; sp = step; u.qrow0 = b * SEQ + (v & 7) * 256; u.lat_row0 = b * SEQ; u.ctx_row0 = LAT + b * NCTX; }
            else if (step < 4) { const int U = (step - 2) * 256 + v, b = U >> 6; h = (U >> 3) & 7; u.qrow0 = b * SEQ + (U & 7) * 256; u.lat_row0 = b * SEQ; u.ctx_row0 = LAT + b * NCTX; }
            else { ctxu = true; int b;
                if (v < 32) { b = v >> 2; a = v & 3; sp = step - 4; }
                else if (v < 96 && step == 4) { b = (v - 32) >> 3; h = (v - 32) & 7; }
                else break;
                u.qrow0 = LAT + b * NCTX; u.lat_row0 = 0; u.ctx_row0 = LAT + b * NCTX; }
            if (!ctxu) { u.nlat_t = 32; u.NT = 36; } else { u.nlat_t = 0; u.NT = 4; }
            if (a >= 0) {
                u.Qp = Q + a * 128 + sp * 64; u.Kp = Q + 512 + a * 128 + sp * 64; u.Vp = Q + 1024 + a * 128; u.Op = AOb + a * 256 + sp * 128;
                attn_body::attn_unit<8, EIN, attn_body::NoMask, 2>(u, lds_generic, attn_body::NoMask{});
                if (sp == 1) attn_combine_rows(p, c, u.qrow0 + c.wave * 32, a, lam, g0, g1);
            } else {
                u.Qp = Q + 1536 + h * 64; u.Kp = Q + 2048 + (h >> 2) * 64; u.Vp = Q + 2176 + (h >> 2) * 64; u.Op = CCb + 512 + h * 64;
                attn_body::attn_unit<8, EIN, attn_body::NoMask, 1>(u, lds_generic, attn_body::NoMask{});
            }
        }
    }
    tail_transposes(p, c, 96, c.vcu, 1536 + 120, 320);
}

__device__ __forceinline__ void ph_attn_combine(const Params& p, const Ctx& c) {
    const bf16* AO = (const bf16*)(p.ws + WS_AO);
    bf16* CC = (bf16*)(p.ws + WS_CC);
    const float d1 = wave_sum(p.in[I_LQ1][c.lane] * p.in[I_LK1][c.lane]);
    const float d2 = wave_sum(p.in[I_LQ2][c.lane] * p.in[I_LK2][c.lane]);
    const float lam = expf(d1) - expf(d2) + LAM_INIT;
    const float g0 = p.in[I_SUBLN][c.lane] * (1.f - LAM_INIT), g1 = p.in[I_SUBLN][c.lane + 64] * (1.f - LAM_INIT);
    for (int it = c.gw; it < NTOK * 4; it += c.NGW) {
        const int row = it >> 2, a = it & 3;
        const bf16* src = AO + (size_t)row * DM + a * 256;
        const float x0 = bf2f((unsigned)src[c.lane]) - lam * bf2f((unsigned)src[128 + c.lane]), x1 = bf2f((unsigned)src[64 + c.lane]) - lam * bf2f((unsigned)src[192 + c.lane]);
        const float ss = wave_sum(x0 * x0 + x1 * x1);
        const float r = rsqrtf(ss * (1.f / 128.f) + RMS_EPS);
        CC[(size_t)row * DM + a * 128 + c.lane] = (bf16)f2bf(x0 * r * g0);
        CC[(size_t)row * DM + a * 128 + 64 + c.lane] = (bf16)f2bf(x1 * r * g1);
    }
}

__device__ __forceinline__ f32x4 unpack4(const v2u w) { return (f32x4){bf2f(w.x & 0xffffu), __uint_as_float(w.x & 0xffff0000u), bf2f(w.y & 0xffffu), __uint_as_float(w.y & 0xffff0000u)}; }
__device__ __forceinline__ float reduce_logits(const f32x4 (&lg)[4], int lane) {
    float w8[8], w4[4], w2[2], w1;
    { const bool hi = (lane & 32) != 0;
#pragma unroll
      for (int i = 0; i < 8; ++i) { const float a0 = lg[i >> 2][i & 3], a1 = lg[2 + (i >> 2)][i & 3]; const float keep = hi ? a1 : a0, send = hi ? a0 : a1; w8[i] = keep + __shfl_xor(send, 32); } }
    { const bool hi = (lane & 16) != 0;
#pragma unroll
      for (int i = 0; i < 4; ++i) { const float keep = hi ? w8[i + 4] : w8[i], send = hi ? w8[i] : w8[i + 4]; w4[i] = keep + __shfl_xor(send, 16); } }
    { const bool hi = (lane & 8) != 0;
#pragma unroll
      for (int i = 0; i < 2; ++i) { const float keep = hi ? w4[i + 2] : w4[i], send = hi ? w4[i] : w4[i + 2]; w2[i] = keep + __shfl_xor(send, 8); } }
    { const bool hi = (lane & 4) != 0; const float keep = hi ? w2[1] : w2[0], send = hi ? w2[0] : w2[1]; w1 = keep + __shfl_xor(send, 4); }
    w1 += __shfl_xor(w1, 2); w1 += __shfl_xor(w1, 1);
    return w1;
}
__device__ __forceinline__ void ph_ln1_router(const Params& p, const Ctx& c, int layer) {
    const bf16* Y = (const bf16*)(p.ws + WS_Y);
    bf16* XS = (bf16*)(p.ws + WS_XS);
    bf16* HB = (bf16*)(p.ws + WS_HB);
    float* AFF = (float*)(p.ws + WS_AFF);
    const float* lng = p.in[I_LNG] + (size_t)(layer * 2 + 0) * DM; const float* lnb = p.in[I_LNB] + (size_t)(layer * 2 + 0) * DM;
    const float* router = p.in[I_ROUTER] + (size_t)layer * DM * NE;
    LAS f32x4* R = (LAS f32x4*)c.lds;
    for (int idx = c.tid; idx < 4096; idx += 512) { const int e4 = idx & 3, k = idx >> 2, ln = (k & 255) >> 2, q = k & 3, j = k >> 8;
        R[((j * 4 + q) * 4 + e4) * 64 + ln] = *(const f32x4*)(router + (size_t)k * NE + 4 * e4); }
    __syncthreads();
    const int nrows = layer == 0 ? NTOK : LAT;
    const int lane = c.lane;
    for (int row = 2 * c.gw; row < nrows; row += 2 * c.NGW) {
        const float* mod = mod_row(p, layer, row);
        f32x4 va[4], vb[4]; float sa = 0.f, sb = 0.f;
#pragma unroll
        for (int j = 0; j < 4; ++j) { const int col = 4 * lane + 256 * j;
            f32x4 xa, xb;
            if (layer == 0) { const float* xin = row < LAT ? p.in[I_X] + (size_t)row * DM : p.in[I_CTX] + (size_t)(row - LAT) * DM; xa = *(const f32x4*)(xin + col); xb = *(const f32x4*)(xin + DM + col); }
            else { xa = unpack4(*(const v2u*)(XS + (size_t)row * DM + col)); xb = unpack4(*(const v2u*)(XS + (size_t)(row + 1) * DM + col)); }
            const f32x4 g1 = *(const f32x4*)(mod + 2048 + col);
            va[j] = xa * ALPHA + g1 * unpack4(*(const v2u*)(Y + (size_t)row * DM + col));
            vb[j] = xb * ALPHA + g1 * unpack4(*(const v2u*)(Y + (size_t)(row + 1) * DM + col));
            sa += (va[j].x + va[j].y) + (va[j].z + va[j].w); sb += (vb[j].x + vb[j].y) + (vb[j].z + vb[j].w); }
        const float meana = wave_sum(sa) * (1.f / DM), meanb = wave_sum(sb) * (1.f / DM); float qa = 0.f, qb = 0.f;
#pragma unroll
        for (int j = 0; j < 4; ++j) { va[j] = va[j] - meana; vb[j] = vb[j] - meanb;
            qa += (va[j].x * va[j].x + va[j].y * va[j].y) + (va[j].z * va[j].z + va[j].w * va[j].w); qb += (vb[j].x * vb[j].x + vb[j].y * vb[j].y) + (vb[j].z * vb[j].z + vb[j].w * vb[j].w); }
        const float rstda = 1.f / sqrtf(wave_sum(qa) * (1.f / DM) + LN_EPS), rstdb = 1.f / sqrtf(wave_sum(qb) * (1.f / DM) + LN_EPS);
        f32x4 lga[4], lgb[4];
#pragma unroll
        for (int e = 0; e < 4; ++e) { lga[e] = (f32x4){0.f, 0.f, 0.f, 0.f}; lgb[e] = (f32x4){0.f, 0.f, 0.f, 0.f}; }
#pragma unroll
        for (int j = 0; j < 4; ++j) { const int col = 4 * lane + 256 * j;
            const f32x4 g = *(const f32x4*)(lng + col), bb = *(const f32x4*)(lnb + col), sc = *(const f32x4*)(mod + 4096 + col) + 1.f, sh = *(const f32x4*)(mod + 3072 + col);
            const f32x4 x1a = va[j] * rstda * g + bb, x1b = vb[j] * rstdb * g + bb;
            *(v2u*)(XS + (size_t)row * DM + col) = (v2u){pk2(x1a.x, x1a.y), pk2(x1a.z, x1a.w)};
            *(v2u*)(XS + (size_t)(row + 1) * DM + col) = (v2u){pk2(x1b.x, x1b.y), pk2(x1b.z, x1b.w)};
            const f32x4 hma = x1a * sc + sh, hmb = x1b * sc + sh;
            if (MOE_FP8) { *(unsigned*)((unsigned char*)HB + (size_t)row * DM + col) = pg8::pk4_fp8(hma.x, hma.y, hma.z, hma.w);
                           *(unsigned*)((unsigned char*)HB + (size_t)(row + 1) * DM + col) = pg8::pk4_fp8(hmb.x, hmb.y, hmb.z, hmb.w); }
            else { *(v2u*)(HB + (size_t)row * DM + col) = (v2u){pk2(hma.x, hma.y), pk2(hma.z, hma.w)}; *(v2u*)(HB + (size_t)(row + 1) * DM + col) = (v2u){pk2(hmb.x, hmb.y), pk2(hmb.z, hmb.w)}; }
            asm volatile("" ::: "memory");
#pragma unroll
            for (int q = 0; q < 4; ++q) { const float ha = hma[q], hb = hmb[q];
#pragma unroll
                for (int e4 = 0; e4 < 4; ++e4) { const f32x4 rw = R[((j * 4 + q) * 4 + e4) * 64 + lane]; lga[e4] += rw * ha; lgb[e4] += rw * hb; } } }
        const float wa = reduce_logits(lga, lane), wb = reduce_logits(lgb, lane);
        float mxa = wa, mxb = wb;
#pragma unroll
        for (int o = 4; o < 64; o <<= 1) { mxa = fmaxf(mxa, __shfl_xor(mxa, o)); mxb = fmaxf(mxb, __shfl_xor(mxb, o)); }
        const float exa = expf(wa - mxa), exb = expf(wb - mxb); float dena = exa, denb = exb;
#pragma unroll
        for (int o = 4; o < 64; o <<= 1) { dena += __shfl_xor(dena, o); denb += __shfl_xor(denb, o); }
        if ((lane & 3) == 0) { const int e = ((lane >> 5) & 1) * 8 + ((lane >> 4) & 1) * 4 + ((lane >> 3) & 1) * 2 + ((lane >> 2) & 1);
            AFF[(size_t)row * NE + e] = exa / dena; AFF[(size_t)(row + 1) * NE + e] = exb / denb; }
    }
}

__device__ __forceinline__ void ph_topk(const Params& p, const Ctx& c, int layer) {
    const float* AFF = (const float*)(p.ws + WS_AFF);
    int* INV = (int*)(p.ws + WS_INV);
    float* GATE = (float*)(p.ws + WS_GATE);
    const bf16* HB = (const bf16*)(p.ws + WS_HB);
    bf16* XG = (bf16*)(p.ws + WS_XG);
    LAS unsigned* hist = (LAS unsigned*)c.lds;
    LAS unsigned* ctl = hist + 256;
    LAS int* sel = (LAS int*)(c.lds + 2048);
    const int MR = layer == 0 ? MR0 : MR1;
    const int ntasks = layer == 0 ? 256 : 128;
    const int lane = c.lane;
    for (int task = c.vcu; task < ntasks; task += c.G) {
        int set, e, n, cap, rowbase, slotbase;
        if (task < 128) { set = task >> 4; e = task & 15; n = SEQ; cap = 256; rowbase = set * SEQ; slotbase = set * 256; }
        else { const int t2 = task - 128; set = t2 >> 4; e = t2 & 15; n = NCTX; cap = 32; rowbase = LAT + set * NCTX; slotbase = 2048 + set * 32; }
        const bool valid = 4 * c.tid < n;
        unsigned key[4];
#pragma unroll
        for (int q = 0; q < 4; ++q) key[q] = valid ? __float_as_uint(AFF[(size_t)(rowbase + 4 * c.tid + q) * NE + e]) : 0u;
        unsigned prefix = 0u, need = (unsigned)cap;
#pragma unroll 1
        for (int pass = 0; pass < 4; ++pass) {
            const int shift = 24 - 8 * pass;
            if (c.tid < 256) hist[c.tid] = 0u;
            __syncthreads();
            if (valid) {
#pragma unroll
                for (int q = 0; q < 4; ++q) if (pass == 0 || (key[q] >> (shift + 8)) == (prefix >> (shift + 8))) __hip_atomic_fetch_add(&hist[(key[q] >> shift) & 255u], 1u, __ATOMIC_RELAXED, __HIP_MEMORY_SCOPE_WORKGROUP);
            }
            __syncthreads();
            if (c.wave == 0) {
                const unsigned h0 = hist[4 * lane], h1 = hist[4 * lane + 1], h2 = hist[4 * lane + 2], h3 = hist[4 * lane + 3];
                const unsigned tot = h0 + h1 + h2 + h3; unsigned sfx = tot;
#pragma unroll
                for (int o = 1; o < 64; o <<= 1) { const unsigned t = __shfl_down(sfx, o); if (lane + o < 64) sfx += t; }
                const unsigned above = sfx - tot, c3 = above + h3, c2 = c3 + h2, c1 = c2 + h1, c0 = c1 + h0;
                int d = -1; unsigned gtc = 0u;
                if (above < need && need <= c3) { d = 3; gtc = above; }
                else if (c3 < need && need <= c2) { d = 2; gtc = c3; }
                else if (c2 < need && need <= c1) { d = 1; gtc = c2; }
                else if (c1 < need && need <= c0) { d = 0; gtc = c1; }
                if (d >= 0) { ctl[0] = prefix | ((unsigned)(4 * lane + d) << shift); ctl[1] = need - gtc; }
            }
            __syncthreads();
            prefix = ctl[0]; need = ctl[1];
        }
        unsigned ngt = 0u, neq = 0u;
#pragma unroll
        for (int q = 0; q < 4; ++q) { ngt += (valid && key[q] > prefix) ? 1u : 0u; neq += (valid && key[q] == prefix) ? 1u : 0u; }
        const unsigned cnt = ngt | (neq << 16); unsigned inc = cnt;
#pragma unroll
        for (int o = 1; o < 64; o <<= 1) { const unsigned t = __shfl_up(inc, o); if (lane >= o) inc += t; }
        if (lane == 63) ctl[8 + c.wave] = inc;
        __syncthreads();
        unsigned base = 0u;
#pragma unroll
        for (int w = 0; w < 8; ++w) base += (w < c.wave) ? ctl[8 + w] : 0u;
        const unsigned ex = base + inc - cnt; unsigned gtb = ex & 0xffffu, eqb = ex >> 16;
        if (valid) {
#pragma unroll
            for (int q = 0; q < 4; ++q) { const int i = 4 * c.tid + q; int slot = -1;
                if (key[q] > prefix) { slot = (int)(gtb + (eqb < need ? eqb : need)); ++gtb; }
                else if (key[q] == prefix) { if (eqb < need) slot = (int)(gtb + eqb); ++eqb; }
                int gs = -1;
                if (slot >= 0) { gs = e * MR + slotbase + slot; sel[slot] = i; GATE[gs] = __uint_as_float(key[q]); }
                INV[(size_t)(rowbase + i) * NE + e] = gs; }
        }
        __syncthreads();
        for (int sidx = c.wave; sidx < cap; sidx += 8) {
            if (MOE_FP8) { const unsigned char* src = (const unsigned char*)HB + (size_t)(rowbase + sel[sidx]) * DM; unsigned char* dst = (unsigned char*)XG + (size_t)(e * MR + slotbase + sidx) * DM;
                *(v4u*)(dst + 16 * lane) = *(const v4u*)(src + 16 * lane); }
            else { const bf16* src = HB + (size_t)(rowbase + sel[sidx]) * DM; bf16* dst = XG + (size_t)(e * MR + slotbase + sidx) * DM;
            const v4u a0 = *(const v4u*)(src + 8 * lane), a1 = *(const v4u*)(src + 512 + 8 * lane);
            *(v4u*)(dst + 8 * lane) = a0; *(v4u*)(dst + 512 + 8 * lane) = a1; }
        }
        __syncthreads();
    }
}

__device__ __forceinline__ void ph_combine(const Params& p, const Ctx& c, int layer) {
    const bf16* YS = (const bf16*)(p.ws + WS_YS);
    const int* INV = (const int*)(p.ws + WS_INV);
    bf16* XS = (bf16*)(p.ws + WS_XS);
    bf16* HB = (bf16*)(p.ws + WS_HB);
    const float* lng = p.in[I_LNG] + (size_t)(layer * 2 + 1) * DM; const float* lnb = p.in[I_LNB] + (size_t)(layer * 2 + 1) * DM;
    const int nrows = layer == 0 ? NTOK : LAT;
    const int lane = c.lane;
    for (int row = 2 * c.gw; row < nrows; row += 2 * c.NGW) {
        const float* mod = mod_row(p, layer, row);
        const int inv = (lane < 2 * NE) ? INV[(size_t)row * NE + lane] : -1;
        const unsigned mall = (unsigned)__ballot(inv >= 0);
        unsigned ma = mall & 0xffffu, mb = mall >> 16;
        int sla[4], slb[4]; float wa[4], wb[4];
#pragma unroll
        for (int q = 0; q < 4; ++q) {
            if (ma) { const int e = __builtin_ctz(ma); ma &= ma - 1; sla[q] = __builtin_amdgcn_readlane(inv, e); wa[q] = 1.f; } else { sla[q] = 0; wa[q] = 0.f; }
            if (mb) { const int e = __builtin_ctz(mb); mb &= mb - 1; slb[q] = __builtin_amdgcn_readlane(inv, 16 + e); wb[q] = 1.f; } else { slb[q] = 0; wb[q] = 0.f; } }
        f32x4 moa[4], mob[4];
#pragma unroll
        for (int j = 0; j < 4; ++j) { moa[j] = (f32x4){0.f, 0.f, 0.f, 0.f}; mob[j] = (f32x4){0.f, 0.f, 0.f, 0.f}; }
#pragma unroll
        for (int q = 0; q < 4; ++q)
#pragma unroll
            for (int j = 0; j < 4; ++j) { moa[j] += unpack4(*(const v2u*)(YS + (size_t)sla[q] * DM + 4 * lane + 256 * j)) * wa[q]; mob[j] += unpack4(*(const v2u*)(YS + (size_t)slb[q] * DM + 4 * lane + 256 * j)) * wb[q]; }
        while (ma) { const int e = __builtin_ctz(ma); ma &= ma - 1; const int sl = __builtin_amdgcn_readlane(inv, e);
#pragma unroll
            for (int j = 0; j < 4; ++j) moa[j] += unpack4(*(const v2u*)(YS + (size_t)sl * DM + 4 * lane + 256 * j)); }
        while (mb) { const int e = __builtin_ctz(mb); mb &= mb - 1; const int sl = __builtin_amdgcn_readlane(inv, 16 + e);
#pragma unroll
            for (int j = 0; j < 4; ++j) mob[j] += unpack4(*(const v2u*)(YS + (size_t)sl * DM + 4 * lane + 256 * j)); }
        f32x4 va[4], vb[4]; float sa = 0.f, sb = 0.f;
#pragma unroll
        for (int j = 0; j < 4; ++j) { const int col = 4 * lane + 256 * j; const f32x4 g2 = *(const f32x4*)(mod + 5120 + col);
            va[j] = unpack4(*(const v2u*)(XS + (size_t)row * DM + col)) * ALPHA + g2 * moa[j];
            vb[j] = unpack4(*(const v2u*)(XS + (size_t)(row + 1) * DM + col)) * ALPHA + g2 * mob[j];
            sa += (va[j].x + va[j].y) + (va[j].z + va[j].w); sb += (vb[j].x + vb[j].y) + (vb[j].z + vb[j].w); }
        const float meana = wave_sum(sa) * (1.f / DM), meanb = wave_sum(sb) * (1.f / DM); float qa = 0.f, qb = 0.f;
#pragma unroll
        for (int j = 0; j < 4; ++j) { va[j] = va[j] - meana; vb[j] = vb[j] - meanb;
            qa += (va[j].x * va[j].x + va[j].y * va[j].y) + (va[j].z * va[j].z + va[j].w * va[j].w); qb += (vb[j].x * vb[j].x + vb[j].y * vb[j].y) + (vb[j].z * vb[j].z + vb[j].w * vb[j].w); }
        const float rstda = 1.f / sqrtf(wave_sum(qa) * (1.f / DM) + LN_EPS), rstdb = 1.f / sqrtf(wave_sum(qb) * (1.f / DM) + LN_EPS);
        const float* modn = mod_row(p, 1, row);
#pragma unroll
        for (int j = 0; j < 4; ++j) { const int col = 4 * lane + 256 * j;
            const f32x4 g = *(const f32x4*)(lng + col), bb = *(const f32x4*)(lnb + col);
            const f32x4 x2a = va[j] * rstda * g + bb, x2b = vb[j] * rstdb * g + bb;
            if (layer == 0) {
                *(v2u*)(XS + (size_t)row * DM + col) = (v2u){pk2(x2a.x, x2a.y), pk2(x2a.z, x2a.w)};
                *(v2u*)(XS + (size_t)(row + 1) * DM + col) = (v2u){pk2(x2b.x, x2b.y), pk2(x2b.z, x2b.w)};
                const f32x4 sc = *(const f32x4*)(modn + 1024 + col) + 1.f, sh = *(const f32x4*)(modn + col);
                const f32x4 ha = x2a * sc + sh, hb = x2b * sc + sh;
                *(v2u*)(HB + (size_t)row * DM + col) = (v2u){pk2(ha.x, ha.y), pk2(ha.z, ha.w)};
                *(v2u*)(HB + (size_t)(row + 1) * DM + col) = (v2u){pk2(hb.x, hb.y), pk2(hb.z, hb.w)};
            } else {
                *(f32x4*)(p.out + (size_t)row * DM + col) = x2a; *(f32x4*)(p.out + (size_t)(row + 1) * DM + col) = x2b;
            } }
    }
}

__device__ __forceinline__ void na_key(const float* q, float* o, float& m, float& l, const bf16* kp, const bf16* vp, float bias) {
    float s = bias;
#pragma unroll
    for (int i = 0; i < 8; ++i) { float f[8]; unpack8(*(const v4u*)(kp + 8 * i), f);
#pragma unroll
        for (int j = 0; j < 8; ++j) s += q[8 * i + j] * f[j]; }
    const float mn = fmaxf(m, s), al = exp2f(m - mn), pp = exp2f(s - mn);
    l = l * al + pp; m = mn;
#pragma unroll
    for (int i = 0; i < 8; ++i) { float f[8]; unpack8(*(const v4u*)(vp + 8 * i), f);
#pragma unroll
        for (int j = 0; j < 8; ++j) o[8 * i + j] = o[8 * i + j] * al + pp * f[j]; }
}
__device__ __forceinline__ void ph_mixer1_naive(const Params& p, const Ctx& c) {
    const bf16* P2 = (const bf16*)(p.ws + WS_QKV);
    bf16* CC = (bf16*)(p.ws + WS_CC);
    const float* rpb = p.in[I_RPB]; const float* pool_w = p.in[I_POOLW]; const float* pool_s = p.in[I_POOLS];
    LAS float* pl = (LAS float*)c.lds;
    for (int u = c.vcu; u < 256; u += c.G) {
        const int b = u >> 5, r = u & 31;
        {
            const int h = c.wave, col = c.lane, row = b * SEQ + r * 64 + col;
            const int rs = min(max(r - 4, 0), 24), cs = min(max(col - 8, 0), 48);
            float q[64], o[64];
#pragma unroll
            for (int i = 0; i < 8; ++i) unpack8(*(const v4u*)(P2 + (size_t)row * OIN + h * 64 + 8 * i), q + 8 * i);
#pragma unroll
            for (int i = 0; i < 64; ++i) o[i] = 0.f;
            float m = -1e30f, l = 0.f;
#pragma unroll 1
            for (int i = 0; i < 8; ++i)
#pragma unroll 1
                for (int j = 0; j < 16; ++j) {
                    const int krow = b * SEQ + (rs + i) * 64 + cs + j;
                    const float bias = rpb[(h * 15 + (rs + i - r + 7)) * 31 + (cs + j - col + 15)] * LOG2E;
                    na_key(q, o, m, l, P2 + (size_t)krow * OIN + 512 + h * 64, P2 + (size_t)krow * OIN + 1024 + h * 64, bias);
                }
#pragma unroll 1
            for (int j = 0; j < NCTX; ++j) {
                const int krow = LAT + b * NCTX + j;
                na_key(q, o, m, l, P2 + (size_t)krow * OIN + 512 + h * 64, P2 + (size_t)krow * OIN + 1024 + h * 64, 0.f);
            }
            const float rl = 1.f / l; bf16* dst = CC + (size_t)row * DM + h * 64;
#pragma unroll
            for (int i = 0; i < 8; ++i) *(v4u*)(dst + 8 * i) = (v4u){pk2(o[8 * i] * rl, o[8 * i + 1] * rl), pk2(o[8 * i + 2] * rl, o[8 * i + 3] * rl), pk2(o[8 * i + 4] * rl, o[8 * i + 5] * rl), pk2(o[8 * i + 6] * rl, o[8 * i + 7] * rl)};
        }
        __syncthreads();
        {
            const int ch = c.tid, g = ch >> 7, half = 1 << g;
            for (int tt = 0; tt < 64; ++tt) {
                const int t = r * 64 + tt, lo = max(t - half, 0), hi = min(t + half, SEQ);
                float s = 0.f;
                for (int t2 = lo; t2 < hi; ++t2) s += bf2f((unsigned)P2[(size_t)(b * SEQ + t2) * OIN + 1536 + ch]);
                pl[tt * 512 + ch] = s / (float)(hi - lo) - bf2f((unsigned)P2[(size_t)(b * SEQ + t) * OIN + 1536 + ch]);
            }
        }
        __syncthreads();
        {
            const int g = c.tid >> 7, e = c.tid & 127;
            const float ps = pool_s[g * 128 + e];
#pragma unroll 1
            for (int tb = 0; tb < 64; tb += 16) {
                float acc[16];
#pragma unroll
                for (int i = 0; i < 16; ++i) acc[i] = 0.f;
#pragma unroll 4
                for (int cc = 0; cc < 128; ++cc) {
                    const float w = pool_w[(size_t)(g * 128 + cc) * 128 + e];
#pragma unroll
                    for (int i = 0; i < 16; ++i) acc[i] += pl[(tb + i) * 512 + g * 128 + cc] * w;
                }
#pragma unroll
                for (int i = 0; i < 16; ++i) CC[(size_t)(b * SEQ + r * 64 + tb + i) * DM + 512 + g * 128 + e] = (bf16)f2bf(acc[i] * ps);
            }
        }
        __syncthreads();
    }
}


constexpr int NA_TAB_OFF = 86016 + 1024;
__device__ __forceinline__ void ph_mixer1_fast(const Params& p, const Ctx& c, char* lds_generic) {
    typedef attn_body::bf16 abf;
    const abf* P2a = (const abf*)(p.ws + WS_QKV); abf* CCa = (abf*)(p.ws + WS_CC);
    LAS float* tab = (LAS float*)(c.lds + NA_TAB_OFF);
    for (int i = c.tid; i < 8 * 15 * 32; i += 512) { const int hd = i >> 5, j = i & 31; tab[i] = j < 31 ? p.in[I_RPB][hd * 31 + j] * LOG2E : 0.f; }
    __syncthreads();
    for (int it = 0;; ++it) {
        const int U = it * c.G + c.vcu;
        if (U >= 512) break;
        const int b = U >> 6, h = (U >> 3) & 7, rq = U & 7;
        const int rs_min = min(max(4 * rq - 4, 0), 24);
        const int nloc = (rq == 0 || rq == 7) ? 8 : 12;
        attn_body::AU u;
        u.qrow0 = b * SEQ + rq * 256; u.lat_row0 = LAT + b * NCTX; u.nlat_t = 4; u.ctx_row0 = b * SEQ + rs_min * 64; u.NT = 4 + nloc;
        u.Qp = P2a + h * 64; u.Kp = P2a + 512 + h * 64; u.Vp = P2a + 1024 + h * 64; u.Op = CCa + h * 64;
        const int r = 4 * rq + (c.wave >> 1), col = (c.wave & 1) * 32 + (c.lane & 31), hi = c.lane >> 5;
        const int cs = min(max(col - 8, 0), 48);
        attn_body::NAMask mk; mk.tb0 = (attn_body::lds_cfptr)(tab + h * 15 * 32 + 15 - col); mk.r = r; mk.rs = min(max(r - 4, 0), 24); mk.rs_min = rs_min; mk.cb = 4 * hi - cs;
        attn_body::attn_unit<8, OIN, attn_body::NAMask>(u, lds_generic, mk);
    }
    __syncthreads();
    const bf16* P2 = (const bf16*)(p.ws + WS_QKV); bf16* CC = (bf16*)(p.ws + WS_CC);
    const float* pool_w = p.in[I_POOLW]; const float* pool_s = p.in[I_POOLS];
    constexpr int PLP = 1040;
    for (int u = c.vcu; u < 256; u += c.G) {
        const int b = u >> 5, r = u & 31;
        {   const int ch = c.tid, g = c.wave >> 1;
            const bf16* du = P2 + (size_t)b * SEQ * OIN + 1536 + ch;
            const int t0 = r * 64;
            float v[80];
#pragma unroll
            for (int k = 0; k < 80; ++k) { const int t2 = t0 - 8 + k; v[k] = ((t2 >= 0 && t2 < SEQ) ? 1.f : 0.f) * bf2f((unsigned)du[(size_t)min(max(t2, 0), SEQ - 1) * OIN]); }
            LAS bf16* plc = (LAS bf16*)(c.lds) + ch;
#define POOL_COL(HALF) do { float ws = 0.f; _Pragma("unroll") for (int k = 8 - HALF; k < 8 + HALF; ++k) ws += v[k]; \
            _Pragma("unroll") for (int tt = 0; tt < 64; ++tt) { const int t = t0 + tt, lo = max(t - HALF, 0), hi = min(t + HALF, SEQ); \
                plc[tt * (PLP / 2)] = (bf16)f2bf(ws / (float)(hi - lo) - v[tt + 8]); ws += v[tt + 8 + HALF] - v[tt + 8 - HALF]; } } while (0)
            if (g == 0) POOL_COL(1); else if (g == 1) POOL_COL(2); else if (g == 2) POOL_COL(4); else POOL_COL(8);
#undef POOL_COL
        }
        __syncthreads();
        {   typedef short bf16x8v __attribute__((ext_vector_type(8)));
            const int g = c.wave >> 1, th = c.wave & 1, l31 = c.lane & 31, lh = c.lane >> 5;
            f32x16 acc[4];
#pragma unroll
            for (int et = 0; et < 4; ++et) acc[et] = (f32x16){};
#pragma unroll
            for (int ks = 0; ks < 8; ++ks) {
                const bf16x8v af = *(const LAS bf16x8v*)(c.lds + (32 * th + l31) * PLP + (g * 128 + 16 * ks + 8 * lh) * 2);
#pragma unroll
                for (int et = 0; et < 4; ++et) {
                    const float* wp = pool_w + (size_t)(g * 128 + 16 * ks + 8 * lh) * 128 + 32 * et + l31;
                    bf16x8v bfr;
#pragma unroll
                    for (int j = 0; j < 8; ++j) bfr[j] = (short)f2bf(wp[(size_t)j * 128]);
                    acc[et] = __builtin_amdgcn_mfma_f32_32x32x16_bf16(af, bfr, acc[et], 0, 0, 0);
                }
            }
#pragma unroll
            for (int et = 0; et < 4; ++et) { const int e = 32 * et + l31; const float ps = pool_s[g * 128 + e];
#pragma unroll
                for (int rg = 0; rg < 16; ++rg) { const int tok = 32 * th + (rg & 3) + 8 * (rg >> 2) + 4 * lh;
                    CC[(size_t)(b * SEQ + r * 64 + tok) * DM + 512 + g * 128 + e] = (bf16)f2bf(acc[et][rg] * ps); } }
        }
        __syncthreads();
    }
}

__global__ void __launch_bounds__(512, 2) mk_fwd(Params p_arg) {
    extern __shared__ __attribute__((aligned(16))) unsigned char lds_raw[];
    Ctx c;
    c.lds = (LAS unsigned char*)lds_raw;
    c.tid = threadIdx.x; c.lane = c.tid & 63; c.wave = __builtin_amdgcn_readfirstlane(c.tid >> 6);
    c.G = gridDim.x; { const int bx = blockIdx.x; c.vcu = (c.G % 8 == 0) ? (bx % 8) * (c.G / 8) + bx / 8 : bx; }
    c.gw = c.vcu * 8 + c.wave; c.NGW = c.G * 8;
    volatile LAS unsigned* MISC = (volatile LAS unsigned*)(c.lds + MISC_OFF);
    if (c.tid < 32) MISC[c.tid] = 0u;
    __syncthreads();
    typedef const __attribute__((address_space(4))) Params* KP;
    const KP kp0 = (KP)__builtin_amdgcn_kernarg_segment_ptr();
#define RELOAD_P() ({ KP kq_ = kp0; asm volatile("" : "+s"(kq_)); *(const Params*)kq_; })
    gu32* ctl = (gu32*)(p_arg.ws + WS_CTL);
    XcdBarrier bar; bar.bar = (unsigned*)(ctl + CW_BAR); bar.x = 0; bar.st = nullptr;
    if (!MK_MULTI) bar = xcd_barrier_post((unsigned*)(ctl + CW_BAR), MISC + 8);
    const int lo = p_arg.ph_lo, hi = p_arg.ph_hi;
    unsigned long long pt0 = 0, pt1 = 0; if (PROBE_PH == 0 || PROBE_PH >= 100) pt0 = __builtin_amdgcn_s_memrealtime();
#define IN(k) (lo <= (k) && (k) < hi)
#define SEAM(k) do { if (IN(k) && IN((k) + 1) && !(FAST_ATTN && (k) == 5) && !(FAST_GEMM && FUSE_QKV && (k) == 3)) xcd_barrier(bar); if ((k) + 1 == PROBE_PH) pt0 = __builtin_amdgcn_s_memrealtime(); if ((k) == PROBE_PH || (k) + 200 == PROBE_PH) pt1 = __builtin_amdgcn_s_memrealtime(); } while (0)

#define HB ((bf16*)(p.ws + WS_HB))
#define QKV ((bf16*)(p.ws + WS_QKV))
#define CC ((bf16*)(p.ws + WS_CC))
#define Y ((float*)(p.ws + WS_Y))
#define PF ((float*)(p.ws + WS_PF))
#define XG ((bf16*)(p.ws + WS_XG))
#define HID ((bf16*)(p.ws + WS_HID))
#define YS ((bf16*)(p.ws + WS_YS))
#define GATE ((const float*)(p.ws + WS_GATE))

    if (IN(0)) { const Params p = RELOAD_P(); ph_prologue(p, c); if (FAST_GEMM) { __syncthreads(); ph_transposes(p, c); } } SEAM(0);
    if (IN(1)) { const Params p = RELOAD_P(); ph_modulate0(p, c); } SEAM(1);
    if (IN(2)) { const Params p = RELOAD_P();
        if (FAST_GEMM) { pg8::Gemm g{HB, (const bf16*)(p.ws + WS_W0IN), NTOK, EIN, DM, 0}; pg8::StaticOrder S; S.init(NTOK, EIN, c.G, (int)blockIdx.x);
            if (FUSE_QKV) { pg8::EpiQKV E{QKV, EIN, (const float*)(p.ws + WS_ROPE), p.in[I_QN], p.in[I_KN], C2, RMS_EPS}; pg8::gemm_phase<pg8::EpiQKV, pg8::StaticOrder, true, true>(c.lds, g, S, E); }
            else { pg8::EpiBf16<0> E{QKV, EIN, nullptr, 0, 0, 1.f}; pg8::gemm_phase<pg8::EpiBf16<0>, pg8::StaticOrder, true, true>(c.lds, g, S, E); }
            tail_transposes(p, c, 648 - 512, (int)blockIdx.x, 1536, 120); }
        else { NG g{HB, DM, p.in[I_W0IN], nullptr, EIN, 0, 1 << 30, 0, NTOK, 0, EIN, DM}; ngemm<1>(g, c, EpiF32{PF, EIN}); }
    } SEAM(2);
    if (!(FAST_GEMM && FUSE_QKV)) { if (IN(3)) { const Params p = RELOAD_P(); if (FAST_GEMM) ph_qkv_post<false>(p, c); else ph_qkv_post<true>(p, c); } } SEAM(3);
    if (IN(4)) { const Params p = RELOAD_P(); if (FAST_ATTN) ph_attn0_fast(p, c, (char*)lds_raw); else ph_attn0_naive(p, c); } SEAM(4);
    if (!FAST_ATTN) { if (IN(5)) { const Params p = RELOAD_P(); ph_attn_combine(p, c); } } SEAM(5);
    if (IN(6)) { const Params p = RELOAD_P();
        if (FAST_GEMM) { pg8::Gemm g{CC, (const bf16*)(p.ws + WS_W0OUT), NTOK, DM, DM, 0}; pg8::StaticOrder S; S.init(NTOK, DM, c.G, (int)blockIdx.x);
            pg8::EpiBf16<0> E{(bf16*)Y, DM, nullptr, 0, 0, 1.f}; pg8::gemm_phase<pg8::EpiBf16<0>, pg8::StaticOrder, true, true>(c.lds, g, S, E);
            tail_transposes(p, c, 288 - 256, (int)blockIdx.x, 1536 + 120 + 320, 224); }
        else { NG g{CC, DM, p.in[I_W0OUT], nullptr, DM, 0, 1 << 30, 0, NTOK, 0, DM, DM}; ngemm<1>(g, c, EpiBf{(bf16*)Y, DM, 0, 1.f}); }
    } SEAM(6);
    if (IN(7)) { const Params p = RELOAD_P(); ph_ln1_router(p, c, 0); } SEAM(7);
    if (IN(8)) { const Params p = RELOAD_P(); ph_topk(p, c, 0); } SEAM(8);
    if (IN(9)) { const Params p = RELOAD_P();
        if (FAST_GEMM && MOE_FP8) { pg8::Gemm g{XG, (const bf16*)(p.ws + WS_WGU), NE * MR0, 4096, DM / 2, (size_t)4096 * DM}; pg8::GroupedOrder S; S.init(MR0 / 256, 16, NE, c.G, c.vcu);
            pg8::EpiSwigluF8 E{(unsigned char*)HID, FF, 1.f / W8_GU, H8_SC}; pg8::gemm_phase<pg8::EpiSwigluF8, pg8::GroupedOrder, true, true, true>(c.lds, g, S, E); }
        else if (FAST_GEMM) { pg8::Gemm g{XG, (const bf16*)(p.ws + WS_WGU), NE * MR0, 4096, DM, (size_t)4096 * DM * 2}; pg8::GroupedOrder S; S.init(MR0 / 256, 16, NE, c.G, c.vcu);
            pg8::EpiSwigluP E{HID, FF}; pg8::gemm_phase<pg8::EpiSwigluP, pg8::GroupedOrder, true, true>(c.lds, g, S, E); }
        else { NG g{XG, DM, p.in[I_WG], p.in[I_WU], FF, (size_t)DM * FF, MR0, 0, NE * MR0, 0, FF, DM}; ngemm<2>(g, c, EpiSwiglu{HID}); }
    } SEAM(9);
    if (IN(10)) { const Params p = RELOAD_P();
        if (FAST_GEMM && MOE_FP8) { pg8::Gemm g{HID, (const bf16*)(p.ws + WS_WDN), NE * MR0, DM, FF / 2, (size_t)DM * FF}; pg8::GroupedOrder S; S.init(MR0 / 256, 4, NE, c.G, c.vcu);
            pg8::EpiGateS E{YS, DM, GATE, 1.f / (W8_DN * H8_SC)}; pg8::gemm_phase<pg8::EpiGateS, pg8::GroupedOrder, true, true, true>(c.lds, g, S, E);
            tail_transposes(p, c, 576 - 512, c.vcu, 1536 + 120 + 320 + 224, 576); }
        else if (FAST_GEMM) { pg8::Gemm g{HID, (const bf16*)(p.ws + WS_WDN), NE * MR0, DM, FF, (size_t)DM * FF * 2}; pg8::GroupedOrder S; S.init(MR0 / 256, 4, NE, c.G, c.vcu);
            pg8::EpiGateP E{YS, DM, GATE}; pg8::gemm_phase<pg8::EpiGateP, pg8::GroupedOrder, true, true>(c.lds, g, S, E); }
        else { NG g{HID, FF, p.in[I_WD], nullptr, DM, (size_t)FF * DM, MR0, 0, NE * MR0, 0, DM, FF}; ngemm<1>(g, c, EpiGate{YS, GATE}); }
    } SEAM(10);
    if (IN(11)) { const Params p = RELOAD_P(); ph_combine(p, c, 0); } SEAM(11);
    if (IN(12)) { const Params p = RELOAD_P();
        if (FAST_GEMM) { pg8::Gemm g{HB, (const bf16*)(p.ws + WS_W1IN), NTOK, OIN, DM, 0}; pg8::L1InOrder S; S.init(c.G, (int)blockIdx.x);
            pg8::EpiBf16<0> E{QKV, OIN, nullptr, 512, 512, C2}; pg8::gemm_phase<pg8::EpiBf16<0>, pg8::L1InOrder, true, true>(c.lds, g, S, E);
            tail_transposes(p, c, 544 - 512, (int)blockIdx.x, 1536 + 120 + 320 + 224 + 576, 296); }
        else {
        NG g{HB, DM, p.in[I_W1IN], nullptr, OIN, 0, 1 << 30, 0, LAT, 0, OIN, DM}; ngemm<1>(g, c, EpiBf{QKV, OIN, 512, C2});
        NG g2{HB, DM, p.in[I_W1IN], nullptr, OIN, 0, 1 << 30, LAT, NTOK, 512, 1536, DM}; ngemm<1>(g2, c, EpiBf{QKV, OIN, 0, 1.f}); }
    } SEAM(12);
    if (IN(13)) { const Params p = RELOAD_P(); if (FAST_NA) ph_mixer1_fast(p, c, (char*)lds_raw); else ph_mixer1_naive(p, c); } SEAM(13);
    if (IN(14)) { const Params p = RELOAD_P();
        if (FAST_GEMM) { pg8::Gemm g{CC, (const bf16*)(p.ws + WS_W1OUT), LAT, DM, DM, 0}; pg8::StaticOrder S; S.init(LAT, DM, c.G, (int)blockIdx.x);
            pg8::EpiBf16<0> E{(bf16*)Y, DM, nullptr, 0, 0, 1.f}; pg8::gemm_phase<pg8::EpiBf16<0>, pg8::StaticOrder, true, true>(c.lds, g, S, E); }
        else { NG g{CC, DM, p.in[I_W1OUT], nullptr, DM, 0, 1 << 30, 0, LAT, 0, DM, DM}; ngemm<1>(g, c, EpiBf{(bf16*)Y, DM, 0, 1.f}); }
    } SEAM(14);
    if (IN(15)) { const Params p = RELOAD_P(); ph_ln1_router(p, c, 1); } SEAM(15);
    if (IN(16)) { const Params p = RELOAD_P(); ph_topk(p, c, 1); } SEAM(16);
    if (IN(17)) { const Params p = RELOAD_P();
        if (FAST_GEMM && MOE_FP8) { pg8::Gemm g{XG, (const bf16*)(p.ws + WS_WGU + WS_MOE_LSTRIDE), NE * MR1, 4096, DM / 2, (size_t)4096 * DM}; pg8::GroupedOrder S; S.init(MR1 / 256, 16, NE, c.G, c.vcu);
            pg8::EpiSwigluF8 E{(unsigned char*)HID, FF, 1.f / W8_GU, H8_SC}; pg8::gemm_phase<pg8::EpiSwigluF8, pg8::GroupedOrder, true, true, true>(c.lds, g, S, E); }
        else if (FAST_GEMM) { pg8::Gemm g{XG, (const bf16*)(p.ws + WS_WGU + WS_MOE_LSTRIDE), NE * MR1, 4096, DM, (size_t)4096 * DM * 2}; pg8::GroupedOrder S; S.init(MR1 / 256, 16, NE, c.G, c.vcu);
            pg8::EpiSwigluP E{HID, FF}; pg8::gemm_phase<pg8::EpiSwigluP, pg8::GroupedOrder, true, true>(c.lds, g, S, E); }
        else { NG g{XG, DM, p.in[I_WG] + (size_t)NE * DM * FF, p.in[I_WU] + (size_t)NE * DM * FF, FF, (size_t)DM * FF, MR1, 0, NE * MR1, 0, FF, DM}; ngemm<2>(g, c, EpiSwiglu{HID}); }
    } SEAM(17);
    if (IN(18)) { const Params p = RELOAD_P();
        if (FAST_GEMM && MOE_FP8) { pg8::Gemm g{HID, (const bf16*)(p.ws + WS_WDN + WS_MOE_LSTRIDE), NE * MR1, DM, FF / 2, (size_t)DM * FF}; pg8::GroupedOrder S; S.init(MR1 / 256, 4, NE, c.G, c.vcu);
            pg8::EpiGateS E{YS, DM, GATE, 1.f / (W8_DN * H8_SC)}; pg8::gemm_phase<pg8::EpiGateS, pg8::GroupedOrder, true, true, true>(c.lds, g, S, E); }
        else if (FAST_GEMM) { pg8::Gemm g{HID, (const bf16*)(p.ws + WS_WDN + WS_MOE_LSTRIDE), NE * MR1, DM, FF, (size_t)DM * FF * 2}; pg8::GroupedOrder S; S.init(MR1 / 256, 4, NE, c.G, c.vcu);
            pg8::EpiGateP E{YS, DM, GATE}; pg8::gemm_phase<pg8::EpiGateP, pg8::GroupedOrder, true, true>(c.lds, g, S, E); }
        else { NG g{HID, FF, p.in[I_WD] + (size_t)NE * FF * DM, nullptr, DM, (size_t)FF * DM, MR1, 0, NE * MR1, 0, DM, FF}; ngemm<1>(g, c, EpiGate{YS, GATE}); }
    } SEAM(18);
    if (IN(19)) { const Params p = RELOAD_P(); ph_combine(p, c, 1); }
    if (PROBE_PH == 19 || PROBE_PH == 100) pt1 = __builtin_amdgcn_s_memrealtime();
    if (PROBE_PH >= 0 && blockIdx.x == 0 && c.tid == 0) { const unsigned long long te = __builtin_amdgcn_s_memrealtime(); while (__builtin_amdgcn_s_memrealtime() - te < pt1 - pt0) __builtin_amdgcn_s_sleep(8); }
#undef IN
#undef SEAM
#undef HB
#undef QKV
#undef CC
#undef Y
#undef PF
#undef XG
#undef HID
#undef YS
#undef GATE
#undef RELOAD_P
}

extern "C" void kernel_launch(void* const* d_in, const int* in_sizes, int n_in, void* d_out, int out_size, void* d_ws, size_t ws_size, hipStream_t stream) {
    static int grid = 0;
    if (grid == 0) {
        if (n_in != 26 || out_size != LAT * DM || ws_size < WS_END) { fprintf(stderr, "kernel_launch: unexpected shapes (n_in %d out %d ws %zu)\n", n_in, out_size, ws_size); grid = -1; return; }
        int dev = 0, cus = 0;
        if (hipGetDevice(&dev) != hipSuccess || hipDeviceGetAttribute(&cus, hipDeviceAttributeMultiprocessorCount, dev) != hipSuccess) { grid = -1; return; }
        if (hipFuncSetAttribute((const void*)mk_fwd, hipFuncAttributeMaxDynamicSharedMemorySize, LDS_BYTES) != hipSuccess) { fprintf(stderr, "kernel_launch: hipFuncSetAttribute failed\n"); grid = -1; return; }
        int per_cu = 0;
        if (hipOccupancyMaxActiveBlocksPerMultiprocessor(&per_cu, (const void*)mk_fwd, 512, LDS_BYTES) != hipSuccess || per_cu < 1) fprintf(stderr, "kernel_launch: occupancy query says %d\n", per_cu);
        (void)hipGetLastError();
        grid = cus;
    }
    if (grid < 0) return;
    (void)hipMemsetAsync((char*)d_ws + WS_CTL, 0, CTL_ZERO_BYTES, stream);
    Params a{};
    for (int i = 0; i < 26; ++i) a.in[i] = (const float*)d_in[i];
    a.out = (float*)d_out; a.ws = (unsigned char*)d_ws;
#if MK_MULTI
    for (int ph = 0; ph < NPHASE; ++ph) { a.ph_lo = ph; a.ph_hi = ph + 1; hipLaunchKernelGGL(mk_fwd, dim3(grid), dim3(512), LDS_BYTES, stream, a); }
#else
    a.ph_lo = 0; a.ph_hi = NPHASE;
    hipLaunchKernelGGL(mk_fwd, dim3(grid), dim3(512), LDS_BYTES, stream, a);
#endif
}
```

```cpp
#include <hip/hip_runtime.h>
#include <cstdio>
#include <cstdint>

#define GAS __attribute__((address_space(1)))
#define LAS __attribute__((address_space(3)))
typedef unsigned short bf16;
typedef unsigned v4u __attribute__((ext_vector_type(4)));
typedef unsigned v2u __attribute__((ext_vector_type(2)));
typedef float f32x4 __attribute__((ext_vector_type(4)));
typedef float f32x2 __attribute__((ext_vector_type(2)));
typedef float f32x16 __attribute__((ext_vector_type(16)));
typedef GAS unsigned gu32;

#ifndef PROBE_PH
#define PROBE_PH -1
#endif
#ifndef PROBE_MASK
#define PROBE_MASK 0u
#endif
#ifndef TAIL_TRANSPOSE
#define TAIL_TRANSPOSE 1
#endif
#ifndef FUSE_QKV
#define FUSE_QKV 1
#endif
#ifndef MOE_FP8
#define MOE_FP8 1
#endif
#ifndef FAST_NA
#define FAST_NA 1
#endif
#ifndef FAST_ATTN
#define FAST_ATTN 1
#endif
#ifndef FAST_GEMM
#define FAST_GEMM 1
#endif
#ifndef MK_MULTI
#define MK_MULTI 0
#endif

constexpr int NBATCH = 8, SEQ = 2048, DM = 1024, NCTX = 256;
constexpr int LAT = NBATCH * SEQ;
constexpr int NTOK = LAT + NBATCH * NCTX;
constexpr int EIN = 2304, OIN = 2048, NE = 16, FF = 2048;
constexpr int MR0 = 2304, MR1 = 2048;
constexpr float LOG2E = 1.4426950408889634f;
constexpr float C2 = 0.125f * LOG2E;
constexpr float ALPHA = 1.4142135623730951f;
constexpr float LN_EPS = 1e-5f, RMS_EPS = 1e-6f;
constexpr float LAM_INIT = 0.2f;
constexpr int NPHASE = 20;
constexpr float W8_GU = 32.f, W8_DN = 64.f, H8_SC = 8.f;

constexpr size_t MiB = 1u << 20;
constexpr size_t WS_CTL = 0, CTL_ZERO_BYTES = 1 * MiB;
constexpr size_t WS_MOD = 1 * MiB;
constexpr size_t WS_ROPE = 1 * MiB + 512 * 1024;
constexpr size_t WS_W0IN = 2 * MiB;
constexpr size_t WS_W0OUT = 7 * MiB;
constexpr size_t WS_W1IN = 9 * MiB;
constexpr size_t WS_W1OUT = 13 * MiB;
constexpr size_t WS_AFF = 16 * MiB;
constexpr size_t WS_INV = 18 * MiB;
constexpr size_t WS_GATE = 20 * MiB;
constexpr size_t WS_WGU = 24 * MiB;
constexpr size_t WS_WDN = 152 * MiB;
constexpr size_t WS_MOE_LSTRIDE = 192 * MiB;
constexpr size_t WS_XS = 408 * MiB;
constexpr size_t WS_HB = 480 * MiB;
constexpr size_t WS_QKV = 516 * MiB;
constexpr size_t WS_CC = 597 * MiB;
constexpr size_t WS_AO = 633 * MiB;
constexpr size_t WS_Y = 705 * MiB;
constexpr size_t WS_XG = 516 * MiB;
constexpr size_t WS_HID = 588 * MiB;
constexpr size_t WS_YS = 732 * MiB;
constexpr size_t WS_PF = 804 * MiB;
constexpr size_t WS_END = 968 * MiB;

constexpr int CW_BAR = 4096;
constexpr int LDS_BYTES = 147456;
constexpr int MISC_OFF = 131072 + 320;

__device__ __forceinline__ float bf2f(unsigned v) { return __uint_as_float(v << 16); }
__device__ __forceinline__ unsigned f2bf(float f) { unsigned u = __float_as_uint(f); return (u + 0x7fffu + ((u >> 16) & 1u)) >> 16; }
__device__ __forceinline__ unsigned pk2(float lo, float hi) { return f2bf(lo) | (f2bf(hi) << 16); }
__device__ __forceinline__ float wave_sum(float v) {
#pragma unroll
    for (int o = 1; o < 64; o <<= 1) v += __shfl_xor(v, o);
    return v;
}
__device__ __forceinline__ float wave_max(float v) {
#pragma unroll
    for (int o = 1; o < 64; o <<= 1) v = fmaxf(v, __shfl_xor(v, o));
    return v;
}
__device__ __forceinline__ void unpack8(const v4u w, float* f) {
    f[0] = bf2f(w.x & 0xffffu); f[1] = __uint_as_float(w.x & 0xffff0000u);
    f[2] = bf2f(w.y & 0xffffu); f[3] = __uint_as_float(w.y & 0xffff0000u);
    f[4] = bf2f(w.z & 0xffffu); f[5] = __uint_as_float(w.z & 0xffff0000u);
    f[6] = bf2f(w.w & 0xffffu); f[7] = __uint_as_float(w.w & 0xffff0000u);
}

#define XB_TMO      128
#define XB_XCNT(j)  (256  + 64 * (j))
#define XB_XSUB(j)  (1280 + 64 * (j))
#define XB_XGEN(j)  (2304 + 64 * (j))
#define XB_TOP      3328
#define XB_TOPGEN   3392
#define XCD_BAR_WORDS 3456
#define XB_SPIN_CAP (1u << 18)
__device__ __forceinline__ unsigned xb_ld(unsigned* p)              { return __hip_atomic_load(p, __ATOMIC_RELAXED, __HIP_MEMORY_SCOPE_AGENT); }
__device__ __forceinline__ unsigned xb_add(unsigned* p, unsigned v) { return __hip_atomic_fetch_add(p, v, __ATOMIC_RELAXED, __HIP_MEMORY_SCOPE_AGENT); }
__device__ __forceinline__ unsigned xb_xcc_id() { return (unsigned)__builtin_amdgcn_s_getreg((3 << 11) | 20) & 0xFu; }
#define XB_SPIN(cond, bar) do { unsigned _sp = 0; while (cond) { __builtin_amdgcn_s_sleep(1); \
    if ((++_sp & 255u) == 0u) { if (xb_ld(&(bar)[XB_TMO])) break; if (_sp > XB_SPIN_CAP) { atomicAdd(&(bar)[XB_TMO], 1u); break; } } } } while (0)
struct XcdBarrier { unsigned* bar; unsigned x; volatile LAS unsigned* st; };
__device__ __forceinline__ XcdBarrier xcd_barrier_post(unsigned* bar, volatile LAS unsigned* st) {
    XcdBarrier b; b.bar = bar; b.x = xb_xcc_id(); b.st = st;
    if (threadIdx.x == 0) (void)xb_add(&bar[XB_XCNT(b.x)], 1u);
    return b;
}
__device__ __forceinline__ void xcd_barrier_complete(unsigned* bar, unsigned x, unsigned& nloc, unsigned& nx) {
    const unsigned G = gridDim.x * gridDim.y * gridDim.z;
    unsigned sum, cnt, mine, sp = 0u;
    for (;;) {
        sum = 0u; cnt = 0u; mine = 0u;
#pragma unroll
        for (unsigned j = 0; j < 16; ++j) { const unsigned c = xb_ld(&bar[XB_XCNT(j)]); sum += c; cnt += (c > 0u) ? 1u : 0u; mine = (j == x) ? c : mine; }
        if (sum == G) break;
        __builtin_amdgcn_s_sleep(1);
        if ((++sp & 255u) == 0u) { if (xb_ld(&bar[XB_TMO])) break; if (sp > XB_SPIN_CAP) { atomicAdd(&bar[XB_TMO], 1u); break; } }
    }
    nloc = mine > 0u ? mine : 1u; nx = cnt > 0u ? cnt : 1u;
}
__device__ __forceinline__ void xcd_barrier(const XcdBarrier& b) {
    asm volatile("s_waitcnt vmcnt(0)" ::: "memory");
    __syncthreads();
    if (threadIdx.x == 0) {
        unsigned* bar = b.bar;
        __builtin_amdgcn_s_waitcnt(0);
        unsigned nloc = b.st[0], nx = b.st[1];
        if (nloc == 0u) { xcd_barrier_complete(bar, b.x, nloc, nx); b.st[0] = nloc; b.st[1] = nx; }
        const unsigned old = xb_add(&bar[XB_XSUB(b.x)], 1u);
        const unsigned gen = old / nloc;
        if (old + 1u == (gen + 1u) * nloc) {
            __builtin_amdgcn_fence(__ATOMIC_RELEASE, "agent");
            asm volatile("s_waitcnt vmcnt(0)" ::: "memory");
            const unsigned og = xb_add(&bar[XB_TOP], 1u);
            const unsigned tg = og / nx;
            if (og + 1u == (tg + 1u) * nx) xb_add(&bar[XB_TOPGEN], 1u);
            else XB_SPIN(xb_ld(&bar[XB_TOPGEN]) == tg, bar);
            __builtin_amdgcn_fence(__ATOMIC_ACQUIRE, "agent");
            xb_add(&bar[XB_XGEN(b.x)], 1u);
            asm volatile("s_waitcnt vmcnt(0)" ::: "memory");
        } else {
            XB_SPIN(xb_ld(&bar[XB_XGEN(b.x)]) == gen, bar);
            __builtin_amdgcn_fence(__ATOMIC_ACQUIRE, "agent");
            asm volatile("s_waitcnt vmcnt(0)" ::: "memory");
        }
    }
    __syncthreads();
}

namespace pg8 {
#define PG8_LAS __attribute__((address_space(3)))
typedef unsigned short bf16_t;
typedef short bf16x8 __attribute__((ext_vector_type(8)));
typedef float f32x4 __attribute__((ext_vector_type(4)));
typedef unsigned u32x4 __attribute__((ext_vector_type(4)));
constexpr int BM = 256, BK = 64, HALF = 128, HTB = HALF * BK * 2  , STAGE_BYTES = 8 * HTB, NXCD = 8, WGM = 8;

__host__ __device__ __forceinline__ int lds_byte(int r, int c) { const int st = (r >> 4) * 2 + (c >> 5), rr = r & 15, cc = c & 31, ob = rr * 64 + cc * 2; return st * 1024 + (ob ^ (((ob >> 9) & 1) << 5)); }
__host__ __device__ __forceinline__ void stage_rc(int b, int& R, int& C) { const int st = b / 1024, sb = b % 1024, swz = sb ^ (((sb >> 9) & 1) << 5); R = (st >> 1) * 16 + swz / 64; C = (st & 1) * 32 + (swz % 64) / 2; }
__host__ __device__ __forceinline__ int perm32(int rho) { const int n = rho >> 4, i = rho & 15; return 8 * (i >> 2) + 4 * n + (i & 3); }

struct Unit { int pm, pn, e; };
struct Gemm { const bf16_t* A; const bf16_t* Bt; int M, N, K; size_t bstride; };

struct StaticOrder {
    int nM, nN, nwg, G, c;
    __host__ __device__ void init(int M, int N, int G_, int c_) { nM = M / BM; nN = N / BM; nwg = nM * nN; G = G_; c = c_; }
    __host__ __device__ bool next(int i, Unit& u) const {
        const long L = (long)i * G + c; if (L >= nwg) return false;
        int wgid = (int)L; { const int q = nwg / NXCD, r = nwg % NXCD, xcd = wgid % NXCD, off = wgid / NXCD; wgid = (xcd < r ? xcd * (q + 1) : r * (q + 1) + (xcd - r) * q) + off; }
        const int nig = WGM * nN, gid = wgid / nig, fm = gid * WGM, gsz = (nM - fm) < WGM ? (nM - fm) : WGM;
        u.pm = fm + ((wgid % nig) % gsz); u.pn = (wgid % nig) / gsz; u.e = 0; return true;
    }
    __device__ __forceinline__ void a_ready(const Unit&) const {}
    __device__ __forceinline__ void done(const Unit&) const {}
};

__device__ __forceinline__ unsigned cvt_pk_bf16(float lo, float hi) { unsigned r; asm volatile("v_cvt_pk_bf16_f32 %0, %1, %2" : "=v"(r) : "v"(lo), "v"(hi)); return r; }
typedef float f32x2 __attribute__((ext_vector_type(2)));
__device__ __forceinline__ f32x2 gelu_pk(f32x2 v) {
    const f32x2 av = __builtin_elementwise_abs(v), d = av * 0.2316418882f + 1.0f;
    f32x2 t; t.x = __builtin_amdgcn_rcpf(d.x); t.y = __builtin_amdgcn_rcpf(d.y);
    f32x2 q = t * 0.5307027145f + (-0.7265760135f); q = q * t + 0.7107068705f; q = q * t + (-0.142248368f); q = q * t + 0.127414796f; q = q * t;
    const f32x2 s = (v * v) * (-0.72134752044f);
    f32x2 e; e.x = __builtin_amdgcn_exp2f(s.x); e.y = __builtin_amdgcn_exp2f(s.y);
    const f32x2 m = v * (q * e), r = v - m;
    f32x2 o; o.x = v.x < 0.f ? m.x : r.x; o.y = v.y < 0.f ? m.y : r.y; return o;
}

template <int ACT  > struct EpiBf16 {
    static constexpr bool PERM = true, AFTER_DRAIN = false; static_assert(ACT == 0 || ACT == 1, "EpiBf16: ACT is 0 (none) or 1 (gelu_pk)");
    bf16_t* O; int ldc; const float* bias; int split_cols; size_t split_stride; float scale0;
    __device__ __forceinline__ void operator()(const f32x4 (&acc)[2][2][4][2], const Unit& u, int wr, int wc, int fr, int fq) const {
        const int row0 = u.pm * BM + wr * 64 + fr; int colt = u.pn * BM; bf16_t* base = O;
        float sc = 1.f; if (split_cols) { const int t = colt / split_cols; base += (size_t)t * split_stride; colt -= t * split_cols; if (t == 0) sc = scale0; }
        const int col0 = colt + wc * 32 + 8 * fq, bcol0 = u.pn * BM + wc * 32 + 8 * fq;
        f32x4 bv[2][2];
#pragma unroll
        for (int bj = 0; bj < 2; ++bj)
#pragma unroll
            for (int n = 0; n < 2; ++n) bv[bj][n] = bias ? *(const f32x4*)(bias + bcol0 + bj * HALF + 4 * n) : (f32x4){0.f, 0.f, 0.f, 0.f};
#pragma unroll
        for (int ai = 0; ai < 2; ++ai)
#pragma unroll
            for (int m = 0; m < 4; ++m) { bf16_t* rowp = base + (size_t)(row0 + ai * HALF + m * 16) * ldc + col0;
#pragma unroll
                for (int bj = 0; bj < 2; ++bj) { f32x4 v0 = acc[ai][bj][m][0] + bv[bj][0], v1 = acc[ai][bj][m][1] + bv[bj][1];
                    if (ACT == 1) { f32x2 a = gelu_pk((f32x2){v0[0], v0[1]}), b = gelu_pk((f32x2){v0[2], v0[3]}), c = gelu_pk((f32x2){v1[0], v1[1]}), d = gelu_pk((f32x2){v1[2], v1[3]});
                        v0 = (f32x4){a.x, a.y, b.x, b.y}; v1 = (f32x4){c.x, c.y, d.x, d.y}; }
                    v0 = v0 * sc; v1 = v1 * sc; u32x4 w; w.x = cvt_pk_bf16(v0[0], v0[1]); w.y = cvt_pk_bf16(v0[2], v0[3]); w.z = cvt_pk_bf16(v1[0], v1[1]); w.w = cvt_pk_bf16(v1[2], v1[3]);
                    *(u32x4*)(rowp + bj * HALF) = w; } }
    }
};

typedef int i32x4 __attribute__((ext_vector_type(4))); typedef int i32x8 __attribute__((ext_vector_type(8)));
__device__ __forceinline__ i32x8 cat16(bf16x8 lo, bf16x8 hi) { const i32x4 a = __builtin_bit_cast(i32x4, lo), b = __builtin_bit_cast(i32x4, hi); return __builtin_shufflevector(a, b, 0, 1, 2, 3, 4, 5, 6, 7); }
__device__ __forceinline__ void mfma_f8_acc(f32x4& acc, const i32x8& b, const i32x8& a, int sc) {
    asm volatile("v_mfma_scale_f32_16x16x128_f8f6f4 %0, %1, %2, %0, %3, %3 op_sel_hi:[0,0,0]" : "+v"(acc) : "v"(b), "v"(a), "v"(sc)); }
template <class Epi, class Sched, bool ALIGN_EPI = false, bool SP2 = false, bool FP8 = false>
__device__ __forceinline__ void gemm_phase(PG8_LAS unsigned char* lds, const Gemm g, const Sched& S, const Epi& E) {
    const int tid = threadIdx.x, wid = __builtin_amdgcn_readfirstlane(tid >> 6), lane = tid & 63, wr = wid >> 2, wc = wid & 3, fr = lane & 15, fq = lane >> 4;
    const int K = g.K, nt = K / BK;
    unsigned voffA[2], voffB[2];
#pragma unroll
    for (int i = 0; i < 2; ++i) { int R, C; stage_rc(tid * 16 + i * 8192, R, C); const int Rb = Epi::PERM ? ((R & ~31) + perm32(R & 31)) : R;
        voffA[i] = (unsigned)(R * K + C) * 2u; voffB[i] = (unsigned)(Rb * K + C) * 2u; }
    const size_t kstep = (size_t)(BK * 2);
    const size_t hstep = (size_t)HALF * K * 2;
    const size_t tstep = 2 * hstep;
    const unsigned ldsw = (unsigned)wid * 1024u;
    const int aoff = lds_byte(wr * 64 + fr, fq * 8), boff = lds_byte(wc * 32 + fr, fq * 8);
    constexpr int KOFF = 1024;
#define PG8_SA(b, h) (((b) * 2 + (h)) * HTB)
#define PG8_SB(b, h) ((4 + (b) * 2 + (h)) * HTB)
#define PG8_STAGE(bufoff, gbase, voff) do { _Pragma("unroll") for (int _i = 0; _i < 2; ++_i) \
        __builtin_amdgcn_global_load_lds((const unsigned*)((const char*)(gbase) + (voff)[_i]), (PG8_LAS unsigned*)(lds + (bufoff) + ldsw + _i * 8192), 16, 0, 0); } while (0)
#define PG8_LDA(dst, b, h) do { _Pragma("unroll") for (int m = 0; m < 4; ++m) _Pragma("unroll") for (int k = 0; k < 2; ++k) dst[m][k] = *(const PG8_LAS bf16x8*)(lds + PG8_SA(b, h) + aoff + m * 2048 + k * KOFF); } while (0)
#define PG8_LDB(dst, b, h) do { _Pragma("unroll") for (int n = 0; n < 2; ++n) _Pragma("unroll") for (int k = 0; k < 2; ++k) dst[n][k] = *(const PG8_LAS bf16x8*)(lds + PG8_SB(b, h) + boff + n * 2048 + k * KOFF); } while (0)
#define PG8_MMA(ai, bj, At, Bt) do { __builtin_amdgcn_s_setprio(1); _Pragma("unroll") for (int m = 0; m < 4; ++m) _Pragma("unroll") for (int n = 0; n < 2; ++n) { \
        if constexpr (FP8) mfma_f8_acc(acc[ai][bj][m][n], cat16(Bt[n][0], Bt[n][1]), cat16(At[m][0], At[m][1]), f8scale); \
        else { _Pragma("unroll") for (int k = 0; k < 2; ++k) acc[ai][bj][m][n] = __builtin_amdgcn_mfma_f32_16x16x32_bf16(Bt[n][k], At[m][k], acc[ai][bj][m][n], 0, 0, 0); } } __builtin_amdgcn_s_setprio(0); } while (0)
#define PG8_WAIT_V(n) asm volatile("s_waitcnt vmcnt(" #n ")" ::: "memory")
#define PG8_WAIT_L(n) asm volatile("s_waitcnt lgkmcnt(" #n ")" ::: "memory")
#define PG8_BAR __builtin_amdgcn_s_barrier()
#define PG8_SCHED __builtin_amdgcn_sched_barrier(0)
    Unit cur, nxt; int ui = 0;
    if (!S.next(0, cur)) return;
    f32x4 acc[2][2][4][2];
#pragma unroll
    for (int a = 0; a < 2; ++a)
#pragma unroll
        for (int b = 0; b < 2; ++b)
#pragma unroll
            for (int m = 0; m < 4; ++m)
#pragma unroll
                for (int n = 0; n < 2; ++n) acc[a][b][m][n] = (f32x4){0.f, 0.f, 0.f, 0.f};
    int f8scale = 0x7F7F7F7F; asm volatile("" : "+v"(f8scale));
    bf16x8 At[4][2], B0[2][2], B1[2][2];
    const char* cA = (const char*)g.A + (size_t)cur.pm * tstep; const char* cB = (const char*)g.Bt + (size_t)cur.pn * tstep + (size_t)cur.e * g.bstride;
    S.a_ready(cur);
    if constexpr (SP2) {
        PG8_STAGE(PG8_SB(0, 0), cB, voffB); PG8_STAGE(PG8_SB(0, 1), cB + hstep, voffB); PG8_STAGE(PG8_SA(0, 0), cA, voffA); PG8_STAGE(PG8_SA(0, 1), cA + hstep, voffA);
        if (wr == 1) PG8_BAR;
        PG8_WAIT_V(2); PG8_BAR;
        PG8_STAGE(PG8_SB(1, 0), cB + kstep, voffB); PG8_STAGE(PG8_SA(1, 0), cA + kstep, voffA); PG8_STAGE(PG8_SB(1, 1), cB + hstep + kstep, voffB);
        PG8_WAIT_V(6); PG8_BAR;
    } else {
        PG8_STAGE(PG8_SB(0, 0), cB, voffB); PG8_STAGE(PG8_SA(0, 0), cA, voffA); PG8_STAGE(PG8_SB(0, 1), cB + hstep, voffB); PG8_STAGE(PG8_SA(0, 1), cA + hstep, voffA);
        if (wr == 1) PG8_BAR;
        PG8_WAIT_V(4); PG8_BAR;
        PG8_STAGE(PG8_SB(1, 0), cB + kstep, voffB); PG8_STAGE(PG8_SA(1, 0), cA + kstep, voffA); PG8_STAGE(PG8_SB(1, 1), cB + hstep + kstep, voffB);
        PG8_WAIT_V(6); PG8_BAR;
    }
    for (;;) {
        const bool has_next = S.next(ui + 1, nxt);
        const char* nA = has_next ? (const char*)g.A + (size_t)nxt.pm * tstep : cA; const char* nB = has_next ? (const char*)g.Bt + (size_t)nxt.pn * tstep + (size_t)nxt.e * g.bstride : cB;
        for (int t = 0; t < nt; t += 2) {
            const bool last = (t == nt - 2);
            const char* a1 = cA + (size_t)(t + 1) * kstep;
            const char* a2 = last ? nA : cA + (size_t)(t + 2) * kstep; const char* b2 = last ? nB : cB + (size_t)(t + 2) * kstep;
            const char* a3 = a2 + kstep; const char* b3 = b2 + kstep;
            if (last && has_next) S.a_ready(nxt);
            if constexpr (SP2) {
            PG8_LDB(B0, 0, 0); PG8_LDB(B1, 0, 1); PG8_SCHED; PG8_LDA(At, 0, 0); PG8_STAGE(PG8_SA(1, 1), a1 + hstep, voffA);
            PG8_WAIT_V(8); PG8_WAIT_L(0); PG8_BAR; PG8_MMA(0, 0, At, B0); PG8_MMA(0, 1, At, B1); PG8_BAR; PG8_SCHED;
            PG8_LDA(At, 0, 1); PG8_STAGE(PG8_SB(0, 0), b2, voffB); PG8_STAGE(PG8_SB(0, 1), b2 + hstep, voffB); PG8_STAGE(PG8_SA(0, 0), a2, voffA);
            PG8_WAIT_V(8); PG8_WAIT_L(0); PG8_BAR; PG8_MMA(1, 0, At, B0); PG8_MMA(1, 1, At, B1); PG8_BAR; PG8_SCHED;
            PG8_LDB(B0, 1, 0); PG8_LDB(B1, 1, 1); PG8_SCHED; PG8_LDA(At, 1, 0); PG8_STAGE(PG8_SA(0, 1), a2 + hstep, voffA);
            PG8_WAIT_V(8); PG8_WAIT_L(0); PG8_BAR; PG8_MMA(0, 0, At, B0); PG8_MMA(0, 1, At, B1); PG8_BAR; PG8_SCHED;
            PG8_LDA(At, 1, 1); PG8_STAGE(PG8_SB(1, 0), b3, voffB); PG8_STAGE(PG8_SB(1, 1), b3 + hstep, voffB); PG8_STAGE(PG8_SA(1, 0), a3, voffA);
            PG8_WAIT_V(8); PG8_WAIT_L(0); PG8_BAR; PG8_MMA(1, 0, At, B0); PG8_MMA(1, 1, At, B1); PG8_BAR; PG8_SCHED;
            } else {
            PG8_LDB(B0, 0, 0); PG8_SCHED; PG8_LDA(At, 0, 0); PG8_STAGE(PG8_SA(1, 1), a1 + hstep, voffA);
            PG8_WAIT_L(8); PG8_BAR; PG8_WAIT_L(0); PG8_MMA(0, 0, At, B0); PG8_BAR; PG8_SCHED;
            PG8_LDB(B1, 0, 1); PG8_STAGE(PG8_SB(0, 0), b2, voffB);
            PG8_BAR; PG8_WAIT_L(0); PG8_MMA(0, 1, At, B1); PG8_BAR;
            PG8_LDA(At, 0, 1); PG8_STAGE(PG8_SA(0, 0), a2, voffA);
            PG8_BAR; PG8_WAIT_L(0); PG8_MMA(1, 0, At, B0); PG8_BAR; PG8_SCHED;
            PG8_STAGE(PG8_SB(0, 1), b2 + hstep, voffB);
            PG8_WAIT_V(6); PG8_BAR; PG8_MMA(1, 1, At, B1); PG8_BAR;
            PG8_LDB(B0, 1, 0); PG8_SCHED; PG8_LDA(At, 1, 0); PG8_STAGE(PG8_SA(0, 1), a2 + hstep, voffA);
            PG8_WAIT_L(8); PG8_BAR; PG8_WAIT_L(0); PG8_MMA(0, 0, At, B0); PG8_BAR; PG8_SCHED;
            PG8_LDB(B1, 1, 1); PG8_STAGE(PG8_SB(1, 0), b3, voffB);
            PG8_BAR; PG8_WAIT_L(0); PG8_MMA(0, 1, At, B1); PG8_BAR;
            PG8_LDA(At, 1, 1); PG8_STAGE(PG8_SA(1, 0), a3, voffA);
            PG8_BAR; PG8_WAIT_L(0); PG8_MMA(1, 0, At, B0); PG8_BAR; PG8_SCHED;
            PG8_STAGE(PG8_SB(1, 1), b3 + hstep, voffB);
            PG8_WAIT_V(6); PG8_BAR; PG8_MMA(1, 1, At, B1); PG8_BAR;
            }
        }
        if constexpr (ALIGN_EPI) { if (wr == 0) PG8_BAR; }
        if constexpr (FP8) asm volatile("s_nop 15\n\ts_nop 15" : "+v"(acc[1][1][0][0]), "+v"(acc[1][1][0][1]), "+v"(acc[1][1][1][0]), "+v"(acc[1][1][1][1]), "+v"(acc[1][1][2][0]), "+v"(acc[1][1][2][1]), "+v"(acc[1][1][3][0]), "+v"(acc[1][1][3][1]));
        if constexpr (!Epi::AFTER_DRAIN) { E(acc, cur, wr, wc, fr, fq); S.done(cur); }
        if (!has_next) break;
#pragma unroll
        for (int a = 0; a < 2; ++a)
#pragma unroll
            for (int b = 0; b < 2; ++b)
#pragma unroll
                for (int m = 0; m < 4; ++m)
#pragma unroll
                    for (int n = 0; n < 2; ++n) acc[a][b][m][n] = (f32x4){0.f, 0.f, 0.f, 0.f};
        cur = nxt; cA = nA; cB = nB; ++ui;
        if constexpr (ALIGN_EPI) { if (wr == 1) PG8_BAR; }
    }
    PG8_WAIT_V(0);
    if constexpr (!ALIGN_EPI) { if (wr == 0) PG8_BAR; }
    PG8_BAR;
    if constexpr (Epi::AFTER_DRAIN) { E.fused(acc, cur, wr, wc, fr, fq, lds, wid, lane); S.done(cur); }
#undef PG8_SA
#undef PG8_SB
#undef PG8_STAGE
#undef PG8_LDA
#undef PG8_LDB
#undef PG8_MMA
#undef PG8_WAIT_V
#undef PG8_WAIT_L
#undef PG8_BAR
#undef PG8_SCHED
}
}

namespace pg8 {
struct EpiF32P {
    static constexpr bool PERM = false, AFTER_DRAIN = false;
    float* O; int ldc;
    __device__ __forceinline__ void operator()(const f32x4 (&acc)[2][2][4][2], const Unit& u, int wr, int wc, int fr, int fq) const {
        const int row0 = u.pm * BM + wr * 64 + fr, col0 = u.pn * BM + wc * 32 + 4 * fq;
#pragma unroll
        for (int ai = 0; ai < 2; ++ai)
#pragma unroll
            for (int m = 0; m < 4; ++m) { float* rowp = O + (size_t)(row0 + ai * HALF + m * 16) * ldc + col0;
#pragma unroll
                for (int bj = 0; bj < 2; ++bj)
#pragma unroll
                    for (int n = 0; n < 2; ++n) *(f32x4*)(rowp + bj * HALF + n * 16) = acc[ai][bj][m][n]; }
    }
};
struct EpiSwigluP {
    static constexpr bool PERM = true, AFTER_DRAIN = false;
    bf16_t* O; int ldc;
    __device__ __forceinline__ void operator()(const f32x4 (&acc)[2][2][4][2], const Unit& u, int wr, int wc, int fr, int fq) const {
        const int row0 = u.pm * BM + wr * 64 + fr, col0 = u.pn * HALF + wc * 32 + 8 * fq;
#pragma unroll
        for (int ai = 0; ai < 2; ++ai)
#pragma unroll
            for (int m = 0; m < 4; ++m) {
                float h[8];
#pragma unroll
                for (int n = 0; n < 2; ++n)
#pragma unroll
                    for (int j = 0; j < 4; ++j) { const float g = acc[ai][0][m][n][j], up = acc[ai][1][m][n][j];
                        h[4 * n + j] = g * up * __builtin_amdgcn_rcpf(1.0f + __builtin_amdgcn_exp2f(-1.4426950408889634f * g)); }
                u32x4 w; w.x = cvt_pk_bf16(h[0], h[1]); w.y = cvt_pk_bf16(h[2], h[3]); w.z = cvt_pk_bf16(h[4], h[5]); w.w = cvt_pk_bf16(h[6], h[7]);
                *(u32x4*)(O + (size_t)(row0 + ai * HALF + m * 16) * ldc + col0) = w; }
    }
};
struct EpiGateP {
    static constexpr bool PERM = true, AFTER_DRAIN = false;
    bf16_t* O; int ldc; const float* gate;
    __device__ __forceinline__ void operator()(const f32x4 (&acc)[2][2][4][2], const Unit& u, int wr, int wc, int fr, int fq) const {
        const int row0 = u.pm * BM + wr * 64 + fr, col0 = u.pn * BM + wc * 32 + 8 * fq;
#pragma unroll
        for (int ai = 0; ai < 2; ++ai)
#pragma unroll
            for (int m = 0; m < 4; ++m) { const int row = row0 + ai * HALF + m * 16; const float gt = gate[row]; bf16_t* rowp = O + (size_t)row * ldc + col0;
#pragma unroll
                for (int bj = 0; bj < 2; ++bj) { const f32x4 v0 = acc[ai][bj][m][0] * gt, v1 = acc[ai][bj][m][1] * gt;
                    u32x4 w; w.x = cvt_pk_bf16(v0[0], v0[1]); w.y = cvt_pk_bf16(v0[2], v0[3]); w.z = cvt_pk_bf16(v1[0], v1[1]); w.w = cvt_pk_bf16(v1[2], v1[3]);
                    *(u32x4*)(rowp + bj * HALF) = w; } }
    }
};
__device__ __forceinline__ unsigned pk4_fp8(float a, float b, float c, float d) {
    a = __builtin_fminf(__builtin_fmaxf(a, -448.f), 448.f); b = __builtin_fminf(__builtin_fmaxf(b, -448.f), 448.f);
    c = __builtin_fminf(__builtin_fmaxf(c, -448.f), 448.f); d = __builtin_fminf(__builtin_fmaxf(d, -448.f), 448.f);
    int w = 0; w = __builtin_amdgcn_cvt_pk_fp8_f32(a, b, w, false); w = __builtin_amdgcn_cvt_pk_fp8_f32(c, d, w, true); return (unsigned)w; }
struct EpiSwigluF8 {
    static constexpr bool PERM = true, AFTER_DRAIN = false;
    unsigned char* O; int ldc; float ws, hs;
    __device__ __forceinline__ void operator()(const f32x4 (&acc)[2][2][4][2], const Unit& u, int wr, int wc, int fr, int fq) const {
        const int row0 = u.pm * BM + wr * 64 + fr, col0 = u.pn * HALF + wc * 32 + 8 * fq;
#pragma unroll
        for (int ai = 0; ai < 2; ++ai)
#pragma unroll
            for (int m = 0; m < 4; ++m) {
                float h[8];
#pragma unroll
                for (int n = 0; n < 2; ++n)
#pragma unroll
                    for (int j = 0; j < 4; ++j) { const float g = acc[ai][0][m][n][j] * ws, up = acc[ai][1][m][n][j] * ws;
                        h[4 * n + j] = g * up * hs * __builtin_amdgcn_rcpf(1.0f + __builtin_amdgcn_exp2f(-1.4426950408889634f * g)); }
                typedef unsigned u32x2 __attribute__((ext_vector_type(2)));
                *(u32x2*)(O + (size_t)(row0 + ai * HALF + m * 16) * ldc + col0) = (u32x2){pk4_fp8(h[0], h[1], h[2], h[3]), pk4_fp8(h[4], h[5], h[6], h[7])}; }
    }
};
struct EpiGateS {
    static constexpr bool PERM = true, AFTER_DRAIN = false;
    bf16_t* O; int ldc; const float* gate; float sc;
    __device__ __forceinline__ void operator()(const f32x4 (&acc)[2][2][4][2], const Unit& u, int wr, int wc, int fr, int fq) const {
        const int row0 = u.pm * BM + wr * 64 + fr, col0 = u.pn * BM + wc * 32 + 8 * fq;
#pragma unroll
        for (int ai = 0; ai < 2; ++ai)
#pragma unroll
            for (int m = 0; m < 4; ++m) { const int row = row0 + ai * HALF + m * 16; const float gt = gate[row] * sc; bf16_t* rowp = O + (size_t)row * ldc + col0;
#pragma unroll
                for (int bj = 0; bj < 2; ++bj) { const f32x4 v0 = acc[ai][bj][m][0] * gt, v1 = acc[ai][bj][m][1] * gt;
                    u32x4 w; w.x = cvt_pk_bf16(v0[0], v0[1]); w.y = cvt_pk_bf16(v0[2], v0[3]); w.z = cvt_pk_bf16(v1[0], v1[1]); w.w = cvt_pk_bf16(v1[2], v1[3]);
                    *(u32x4*)(rowp + bj * HALF) = w; } }
    }
};
struct EpiQKV {
    static constexpr bool PERM = true, AFTER_DRAIN = false;
    bf16_t* O; int ldc; const float* rope; const float* qn; const float* kn; float qscale; float rms_eps;
    __device__ __forceinline__ void operator()(const f32x4 (&acc)[2][2][4][2], const Unit& u, int wr, int wc, int fr, int fq) const {
        const int hs = 4 * u.pn + wc;
        const bool isq = hs < 8 || (hs >= 24 && hs < 32), isk = (hs >= 8 && hs < 16) || hs == 32 || hs == 33, nrm = hs >= 24 && hs < 34;
        const bool rope_on = (isq || isk) && u.pm < 64;
        const float osc = isq ? qscale : 1.f;
        const bool first = fq < 2;
        f32x4 gv[2][2];
#pragma unroll
        for (int bj = 0; bj < 2; ++bj)
#pragma unroll
            for (int n = 0; n < 2; ++n) gv[bj][n] = nrm ? *(const f32x4*)((hs < 32 ? qn : kn) + 32 * bj + 8 * fq + 4 * n) : (f32x4){1.f, 1.f, 1.f, 1.f};
#pragma unroll
        for (int ai = 0; ai < 2; ++ai)
#pragma unroll
            for (int m = 0; m < 4; ++m) {
                const int row = u.pm * BM + ai * HALF + wr * 64 + m * 16 + fr;
                f32x4 v[2][2];
#pragma unroll
                for (int bj = 0; bj < 2; ++bj)
#pragma unroll
                    for (int n = 0; n < 2; ++n) v[bj][n] = acc[ai][bj][m][n];
                if (nrm) {
                    float ss = 0.f;
#pragma unroll
                    for (int bj = 0; bj < 2; ++bj)
#pragma unroll
                        for (int n = 0; n < 2; ++n) ss += (v[bj][n][0] * v[bj][n][0] + v[bj][n][1] * v[bj][n][1]) + (v[bj][n][2] * v[bj][n][2] + v[bj][n][3] * v[bj][n][3]);
                    ss += __shfl_xor(ss, 16); ss += __shfl_xor(ss, 32);
                    const float r = __builtin_amdgcn_rsqf(ss * (1.f / 64.f) + rms_eps);
#pragma unroll
                    for (int bj = 0; bj < 2; ++bj)
#pragma unroll
                        for (int n = 0; n < 2; ++n) v[bj][n] = v[bj][n] * r * gv[bj][n];
                }
                if (rope_on) {
                    const int t = row & 2047;
#pragma unroll
                    for (int bj = 0; bj < 2; ++bj) {
                        const int pos = bj ? (t & 63) : (t >> 6);
#pragma unroll
                        for (int n = 0; n < 2; ++n) {
                            const float* cp = rope + (size_t)(pos * 16 + 8 * (fq & 1) + 4 * n) * 2;
                            const f32x4 c01 = *(const f32x4*)cp, c23 = *(const f32x4*)(cp + 4);
                            const float cs[4] = {c01[0], c01[2], c23[0], c23[2]}, sn[4] = {c01[1], c01[3], c23[1], c23[3]};
#pragma unroll
                            for (int j = 0; j < 4; ++j) { const float x = v[bj][n][j], pr = __shfl_xor(x, 32); v[bj][n][j] = first ? x * cs[j] - pr * sn[j] : x * cs[j] + pr * sn[j]; }
                        }
                    }
                }
                bf16_t* rowp = O + (size_t)row * ldc + hs * 64 + 8 * fq;
#pragma unroll
                for (int bj = 0; bj < 2; ++bj) { const f32x4 v0 = v[bj][0] * osc, v1 = v[bj][1] * osc;
                    u32x4 w; w.x = cvt_pk_bf16(v0[0], v0[1]); w.y = cvt_pk_bf16(v0[2], v0[3]); w.z = cvt_pk_bf16(v1[0], v1[1]); w.w = cvt_pk_bf16(v1[2], v1[3]);
                    *(u32x4*)(rowp + 32 * bj) = w; }
            }
    }
};
struct GroupedOrder {
    int nMe, nN, ntot, G, c;
    __device__ void init(int nMe_, int nN_, int ne, int G_, int c_) { nMe = nMe_; nN = nN_; ntot = nMe_ * nN_ * ne; G = G_; c = c_; }
    __device__ bool next(int i, Unit& u) const {
        const int L = i * G + c; if (L >= ntot) return false;
        const int per = nMe * nN, e = L / per, rem = L - e * per;
        u.e = e; u.pn = rem / nMe; u.pm = e * nMe + (rem - u.pn * nMe); return true;
    }
    __device__ __forceinline__ void a_ready(const Unit&) const {}
    __device__ __forceinline__ void done(const Unit&) const {}
};
struct L1InOrder {
    StaticOrder so; int G, c;
    __device__ void init(int G_, int c_) { so.init(16384, 2048, G_, 0); G = G_; c = c_; }
    __device__ bool next(int i, Unit& u) const {
        const int L = i * G + c;
        if (L < 512) { StaticOrder t = so; t.G = 1; t.c = 0; return t.next(L, u); }
        if (L < 544) { const int l = L - 512; u.pm = 64 + (l >> 2); u.pn = 2 + (l & 3); u.e = 0; return true; }
        return false;
    }
    __device__ __forceinline__ void a_ready(const Unit&) const {}
    __device__ __forceinline__ void done(const Unit&) const {}
};
}

#include <hip/hip_bf16.h>
#include <cmath>
namespace attn_body {
using bf16=__hip_bfloat16;
using bf16x8=__attribute__((ext_vector_type(8)))short;
using s16x4=__attribute__((ext_vector_type(4)))short;
using f32x16=__attribute__((ext_vector_type(16)))float;
using u32x4=__attribute__((ext_vector_type(4)))unsigned;
constexpr int D=64,OPITCH=1024;
constexpr int NW=8,QBLK=32,QB=QBLK*NW,KVBLK=64;
__device__ __forceinline__ int crow(int r,int hi){return (r&3)+8*(r>>2)+4*hi;}
#define SBAR() __builtin_amdgcn_sched_barrier(0)
__device__ __forceinline__ void cmask(f32x16&p0,f32x16&p1,int jb,int qrel,int hi){
  const float NEG=-INFINITY; int kb=64*jb+4*hi;
  #pragma unroll
  for(int r=0;r<16;++r){int kv=kb+(r&3)+8*(r>>2); if(kv>qrel)p0[r]=NEG; if(kv+32>qrel)p1[r]=NEG;}
}

constexpr int NSLOT=3, SLOTB=8192;
constexpr int LDS_K=0, LDS_V=NSLOT*SLOTB, LDS_WS=2*NSLOT*SLOTB, LDS_OST=LDS_WS+NW*64*4, LDS_BYTES=LDS_OST+NW*4096;
constexpr float C2=0.125f*1.4426950408889634f;
__device__ __forceinline__ void glds16(const void*gsrc,unsigned lds_dst){unsigned keep;
  asm volatile("s_mov_b32 %0, m0\n\ts_mov_b32 m0, %2\n\ts_nop 0\n\tglobal_load_lds_dwordx4 %1, off\n\ts_mov_b32 m0, %0":"=&s"(keep):"v"(gsrc),"s"(lds_dst):"memory");}
__device__ __forceinline__ float max3f(float a,float b,float c){float r;asm("v_max3_f32 %0, %1, %2, %3":"=v"(r):"v"(a),"v"(b),"v"(c));return r;}
__device__ __forceinline__ float max2f(float a,float b){float r;asm("v_max_f32_e32 %0, %1, %2":"=v"(r):"v"(a),"v"(b));return r;}
__device__ __forceinline__ float fadd_s(float a,float b){float r;asm("v_add_f32_e32 %0, %1, %2":"=v"(r):"v"(a),"v"(b));return r;}
__device__ __forceinline__ float fsub_s(float a,float b){float r;asm("v_sub_f32_e32 %0, %1, %2":"=v"(r):"v"(a),"v"(b));return r;}
typedef float f32x2_t __attribute__((ext_vector_type(2))); typedef __bf16 bf16x2_t __attribute__((ext_vector_type(2)));
__device__ __forceinline__ unsigned cvtpk_s(float lo,float hi){f32x2_t v={lo,hi};bf16x2_t b=__builtin_convertvector(v,bf16x2_t);return __builtin_bit_cast(unsigned,b);}
#define WAIT_BAR(N) asm volatile("s_waitcnt vmcnt(" #N ") lgkmcnt(0)\n\ts_barrier":::"memory")

__device__ __forceinline__ void qkt(f32x16&p0,f32x16&p1,const char*Kslot,const bf16x8*qr,const f32x16&negm,int r32,int hi){
  const char*kb=Kslot+hi*1024+r32*16;
  #pragma unroll
  for(int d0=0;d0<4;++d0){
    const bf16x8 b0=*reinterpret_cast<const bf16x8*>(kb+d0*2048);
    const bf16x8 b1=*reinterpret_cast<const bf16x8*>(kb+d0*2048+512);
    if(d0==0){p0=__builtin_amdgcn_mfma_f32_32x32x16_bf16(b0,qr[0],negm,0,0,0);p1=__builtin_amdgcn_mfma_f32_32x32x16_bf16(b1,qr[0],negm,0,0,0);}
    else{p0=__builtin_amdgcn_mfma_f32_32x32x16_bf16(b0,qr[d0],p0,0,0,0);p1=__builtin_amdgcn_mfma_f32_32x32x16_bf16(b1,qr[d0],p1,0,0,0);}}
}
typedef __attribute__((address_space(3))) const char* lds_cptr;
typedef short v4i16_t __attribute__((ext_vector_type(4)));
__device__ __forceinline__ void kload8(bf16x8*kf,lds_cptr kp){
  kf[0]=*(const __attribute__((address_space(3))) bf16x8*)(kp);      kf[1]=*(const __attribute__((address_space(3))) bf16x8*)(kp+512);
  kf[2]=*(const __attribute__((address_space(3))) bf16x8*)(kp+2048); kf[3]=*(const __attribute__((address_space(3))) bf16x8*)(kp+2560);
  kf[4]=*(const __attribute__((address_space(3))) bf16x8*)(kp+4096); kf[5]=*(const __attribute__((address_space(3))) bf16x8*)(kp+4608);
  kf[6]=*(const __attribute__((address_space(3))) bf16x8*)(kp+6144); kf[7]=*(const __attribute__((address_space(3))) bf16x8*)(kp+6656);
}
__device__ __forceinline__ void kload2(bf16x8*kf,lds_cptr kp,int j){ kf[2*j]=*(const __attribute__((address_space(3))) bf16x8*)(kp+j*2048); kf[2*j+1]=*(const __attribute__((address_space(3))) bf16x8*)(kp+j*2048+512); }
__device__ __forceinline__ s16x4 vtr(lds_cptr p){ return __builtin_bit_cast(s16x4,__builtin_amdgcn_ds_read_tr16_b64_v4i16((__attribute__((address_space(3))) v4i16_t*)p)); }
__device__ __forceinline__ float rowmax(const f32x16&p0,const f32x16&p1){
  float a=max3f(p0[0],p0[1],p1[0]),b=max3f(p0[2],p0[3],p1[1]);a=max3f(a,p1[2],p1[3]);
  #pragma unroll
  for(int r=4;r<16;r+=4){a=max3f(a,p0[r],p0[r+1]);b=max3f(b,p0[r+2],p0[r+3]);a=max3f(a,p1[r],p1[r+1]);b=max3f(b,p1[r+2],p1[r+3]);}
  const float m=max2f(a,b);
  auto rr=__builtin_amdgcn_permlane32_swap(__float_as_uint(m),__float_as_uint(m),false,false);
  return max2f(__uint_as_float(rr[0]),__uint_as_float(rr[1]));
}
__device__ __forceinline__ void pv(f32x16*o,int vb,bf16x8 pa0,bf16x8 pa1,bf16x8 pa2,bf16x8 pa3){
  #pragma unroll
  for(int d0=0;d0<2;++d0){s16x4 lo[4],hi[4];
    #pragma unroll
    for(int ks=0;ks<4;++ks){
      asm volatile("ds_read_b64_tr_b16 %0,%1 offset:%c2":"=&v"(lo[ks]):"v"(vb),"i"(d0*4096+ks*1024):"memory");
      asm volatile("ds_read_b64_tr_b16 %0,%1 offset:%c2":"=&v"(hi[ks]):"v"(vb),"i"(d0*4096+ks*1024+512):"memory");}
    asm volatile("s_waitcnt lgkmcnt(0)":::"memory");SBAR();
    #define PK(k) (bf16x8){lo[k][0],lo[k][1],lo[k][2],lo[k][3],hi[k][0],hi[k][1],hi[k][2],hi[k][3]}
    o[d0]=__builtin_amdgcn_mfma_f32_32x32x16_bf16(pa0,PK(0),o[d0],0,0,0);
    o[d0]=__builtin_amdgcn_mfma_f32_32x32x16_bf16(pa1,PK(1),o[d0],0,0,0);
    o[d0]=__builtin_amdgcn_mfma_f32_32x32x16_bf16(pa2,PK(2),o[d0],0,0,0);
    o[d0]=__builtin_amdgcn_mfma_f32_32x32x16_bf16(pa3,PK(3),o[d0],0,0,0);
    #undef PK
  }
}

#ifndef ATTN_STORE16
#define ATTN_STORE16(p,v) (*(u32x4*)(p)=(v))
#endif
struct AU { const bf16* Qp; const bf16* Kp; const bf16* Vp; bf16* Op; int qrow0, lat_row0, ctx_row0, nlat_t, NT; };
struct NoMask { __device__ __forceinline__ void apply(f32x16&,f32x16&,int,int)const{} };
typedef __attribute__((address_space(3))) const float* lds_cfptr;
struct NAMask { lds_cfptr tb0; int r, rs, rs_min, cb;
  __device__ __forceinline__ void apply(f32x16&p0,f32x16&p1,int t,int hi)const{
    if(t<4)return;
    const int kr=rs_min+t-4; const float NEG=-INFINITY;
    if((unsigned)(kr-rs)>7u){
      #pragma unroll
      for(int i=0;i<16;++i){p0[i]=NEG;p1[i]=NEG;}
      return; }
    const lds_cfptr tb=tb0+(kr-r+7)*32+4*hi;
    #pragma unroll
    for(int i=0;i<16;++i){ const int k0=(i&3)+8*(i>>2); const int d0=cb+k0, d1=cb+k0+32;
      const float b0=tb[k0], b1=tb[k0+32];
      p0[i]=((unsigned)d0<=15u)?p0[i]+b0:NEG; p1[i]=((unsigned)d1<=15u)?p1[i]+b1:NEG; }
  }
};
template<int THRL,int PITCH,class MaskT,int VD=1> __device__ __forceinline__ void attn_unit(const AU& u,char*shm,const MaskT& mk){
  constexpr int L_WS=LDS_V+NSLOT*SLOTB*VD, L_OST=L_WS+NW*64*4;
  const int tid=threadIdx.x,lane=tid&63,r32=lane&31,hi=lane>>5; const int wid=__builtin_amdgcn_readfirstlane(tid>>6);
  const bf16*Qw=u.Qp+(long)(u.qrow0+wid*QBLK)*PITCH;
  const bf16*Kh=u.Kp,*Vh=u.Vp;
  const unsigned lds0=(unsigned)(uintptr_t)shm;
  float*wsf=(float*)(shm+L_WS)+wid*64;
  const bf16*ksrc=Kh+(long)lane*PITCH+wid*8;
  const bf16*vsrc=Vh+(long)(16*(wid&3)+(lane>>2))*PITCH+(wid>>2)*32+(lane&3)*8;
  const unsigned kdst=lds0+LDS_K+wid*1024, vdst=lds0+LDS_V+wid*1024;
  #define TROW(t) ((long)((t)<u.nlat_t?u.lat_row0+KVBLK*(t):u.ctx_row0+KVBLK*((t)-u.nlat_t))*PITCH)
  #define DMA_K(t,slot) glds16(ksrc+TROW(t),(unsigned)__builtin_amdgcn_readfirstlane(kdst+(slot)))
  #define DMA_V(t,slot) do{ glds16(vsrc+TROW(t),(unsigned)__builtin_amdgcn_readfirstlane(vdst+VD*(slot))); if constexpr(VD==2) glds16(vsrc+64+TROW(t),(unsigned)__builtin_amdgcn_readfirstlane(vdst+VD*(slot)+8192)); }while(0)
  const int vb0=(int)(lds0+LDS_V)+((lane>>4)&1)*32+(lane&3)*8+(4*hi+((lane&15)>>2))*64;
  const char*Kbase=shm+LDS_K; bf16x8 kf[8];
  const lds_cptr shm3=(lds_cptr)shm; const lds_cptr kp0=shm3+LDS_K+hi*1024+r32*16; const lds_cptr vp0=shm3+LDS_V+((lane>>4)&1)*32+(lane&3)*8+(4*hi+((lane&15)>>2))*64;
  const int NT=u.NT;
  DMA_K(0,0);DMA_V(0,0);DMA_K(1,SLOTB);
  bf16x8 qr[4];
  #pragma unroll
  for(int d0=0;d0<4;++d0)qr[d0]=*reinterpret_cast<const bf16x8*>(&Qw[(long)r32*PITCH+d0*16+hi*8]);
  typedef __attribute__((address_space(3))) bf16x8* lds_qptr;
  const lds_qptr qls=(lds_qptr)((lds_cptr)shm+L_OST+wid*4096+lane*16);
  if constexpr(VD==2){
    #pragma unroll
    for(int d0=0;d0<4;++d0)qls[d0*64]=qr[d0];
  }
  #define QF(d0) (VD==2?*(const __attribute__((address_space(3))) bf16x8*)(qls+(d0)*64):qr[d0])
  float mhat=0.f,l_reg=0.f;f32x16 o[2*VD];
  #pragma unroll
  for(int d_=0;d_<2*VD;++d_)o[d_]=f32x16{};
  f32x16 negm=f32x16{}; if constexpr(VD==1) asm volatile("":"+v"(negm));
  #define CMASK(P0,P1,t) mk.apply(P0,P1,(t),hi)
  bool resc=false;
  #define START(P0,P1) do{ const float rm=rowmax(P0,P1); resc=false; \
    { const float dl=rm; mhat=fadd_s(mhat,dl); \
      _Pragma("unroll") for(int r=0;r<16;++r){P0[r]=fsub_s(P0[r],dl);P1[r]=fsub_s(P1[r],dl);} \
      if constexpr(VD==1){ _Pragma("unroll") for(int r=0;r<16;++r)negm[r]=-mhat; asm volatile("":"+v"(negm)); } } \
    _Pragma("unroll") for(int r=0;r<16;++r)P0[r]=__builtin_amdgcn_exp2f(P0[r]); }while(0)
  #define RESC() do{ if(resc){ asm volatile("s_waitcnt lgkmcnt(0)":::"memory"); \
      _Pragma("unroll") for(int d_=0;d_<2*VD;++d_) _Pragma("unroll") for(int r=0;r<16;++r)o[d_][r]*=wsf[crow(r,hi)]; } }while(0)
  f32x16 pA0,pA1,pB0,pB1;
  int sl_prev=0,sl_cur=0,sl_next=SLOTB;
  #define ROT() do{sl_prev=sl_cur;sl_cur=sl_next;sl_next=(sl_next==(NSLOT-1)*SLOTB)?0:sl_next+SLOTB;}while(0)
  DMA_K(2,2*SLOTB);
  if constexpr(VD==2){WAIT_BAR(4);}else{WAIT_BAR(3);}
  qkt(pA0,pA1,Kbase,qr,negm,r32,hi);asm volatile("s_nop 15\n\ts_nop 7":"+v"(pA0),"+v"(pA1));CMASK(pA0,pA1,0);
  START(pA0,pA1);
  _Pragma("unroll") for(int r=0;r<16;++r)pA1[r]=__builtin_amdgcn_exp2f(pA1[r]);
  WAIT_BAR(0);
  DMA_K(3,0);DMA_V(1,SLOTB);
  ROT();
  kload8(kf,kp0+sl_cur);
  if constexpr(VD==2){WAIT_BAR(3);}else{WAIT_BAR(2);}
  s16x4 vlo[8],vhi[8]; u32x4 pw0,pw1,pw2,pw3;
  #define PKW(P,B) cvtpk_s(P[B],P[B+1])
  #define PAF(k) __builtin_bit_cast(bf16x8,pw##k)
  #define VFR(i) (bf16x8){vlo[i][0],vlo[i][1],vlo[i][2],vlo[i][3],vhi[i][0],vhi[i][1],vhi[i][2],vhi[i][3]}
  #define PIN(x) asm volatile("":"+v"(x))
  #define MX3(a,b,c) __builtin_fmaxf(__builtin_fmaxf((a),(b)),(c))
  #define GAPA(MF,A0,A1,A2,A3,W0,W1,PW) do{ MF; sacc+=A0; sacc+=A1; sacc+=A2; sacc+=A3; PIN(sacc); W0; W1; PIN(PW); SBAR(); }while(0)
  #define EX(v) __builtin_amdgcn_exp2f(v)
  #define GAPB(MF,X,B) do{ MF; X[B]=EX(X[B]); X[B+1]=EX(X[B+1]); X[B+2]=EX(X[B+2]); X[B+3]=EX(X[B+3]); PIN(X); SBAR(); }while(0)
  #define VRD(i) do{ vlo[i]=vtr(vp_+(((i)>>2)*4096+((i)&3)*1024)); vhi[i]=vtr(vp_+(((i)>>2)*4096+((i)&3)*1024+512)); }while(0)
  #define VRDH(i) do{ if constexpr(VD==2){ vlo[i]=vtr(vp_+8192+(((i)>>2)*4096+((i)&3)*1024)); vhi[i]=vtr(vp_+8192+(((i)>>2)*4096+((i)&3)*1024+512)); SBAR(); } }while(0)
  #define KRD(G,j) do{ if(G){ kload2(kf,kp0+sl_next,j); SBAR(); } }while(0)
  #define STEP(C0,C1,P0,P1,t,GK,GV,GL) do{ SBAR(); \
    const lds_cptr vp_=vp0+VD*sl_prev; \
    VRD(0); SBAR(); float sacc=(P0[0]+P0[1]); \
    GAPA(C0=__builtin_amdgcn_mfma_f32_32x32x16_bf16(kf[0],QF(0),negm,0,0,0), P0[2],P0[3],P0[4],P0[5],     pw0[0]=PKW(P0,0), pw0[1]=PKW(P0,2), pw0); \
    VRD(4); SBAR(); GAPA(C1=__builtin_amdgcn_mfma_f32_32x32x16_bf16(kf[1],QF(0),negm,0,0,0), P0[6],P0[7],P0[8],P0[9],     pw0[2]=PKW(P0,4), pw0[3]=PKW(P0,6), pw0); \
    VRD(1); SBAR(); GAPA(C0=__builtin_amdgcn_mfma_f32_32x32x16_bf16(kf[2],QF(1),C0,0,0,0),   P0[10],P0[11],P0[12],P0[13], pw1[0]=PKW(P0,8), pw1[1]=PKW(P0,10), pw1); \
    VRD(5); SBAR(); GAPA(C1=__builtin_amdgcn_mfma_f32_32x32x16_bf16(kf[3],QF(1),C1,0,0,0),   P0[14],P0[15],P1[0],P1[1],   pw1[2]=PKW(P0,12),pw1[3]=PKW(P0,14), pw1); \
    VRD(2); SBAR(); GAPA(C0=__builtin_amdgcn_mfma_f32_32x32x16_bf16(kf[4],QF(2),C0,0,0,0),   P1[2],P1[3],P1[4],P1[5],     pw2[0]=PKW(P1,0), pw2[1]=PKW(P1,2), pw2); \
    VRD(6); SBAR(); GAPA(C1=__builtin_amdgcn_mfma_f32_32x32x16_bf16(kf[5],QF(2),C1,0,0,0),   P1[6],P1[7],P1[8],P1[9],     pw2[2]=PKW(P1,4), pw2[3]=PKW(P1,6), pw2); \
    VRD(3); SBAR(); GAPA(C0=__builtin_amdgcn_mfma_f32_32x32x16_bf16(kf[6],QF(3),C0,0,0,0),   P1[10],P1[11],P1[12],P1[13], pw3[0]=PKW(P1,8), pw3[1]=PKW(P1,10), pw3); \
    VRD(7); SBAR(); GAPA(C1=__builtin_amdgcn_mfma_f32_32x32x16_bf16(kf[7],QF(3),C1,0,0,0),   P1[14],P1[15],0.f,0.f,       pw3[2]=PKW(P1,12),pw3[3]=PKW(P1,14), pw3); \
    l_reg+=sacc; \
    if(GK){DMA_K((t)+3,sl_cur);} if(GV){DMA_V((t)+1,sl_next);} \
    CMASK(C0,C1,t); \
    { float a=MX3(C0[0],C0[1],C1[0]),b=MX3(C0[2],C0[3],C1[1]); a=MX3(a,C1[2],C1[3]); \
      _Pragma("unroll") for(int r=4;r<16;r+=4){a=MX3(a,C0[r],C0[r+1]);b=MX3(b,C0[r+2],C0[r+3]);a=MX3(a,C1[r],C1[r+1]);b=MX3(b,C1[r+2],C1[r+3]);} \
      float rm=__builtin_fmaxf(a,b); { auto rr=__builtin_amdgcn_permlane32_swap(__float_as_uint(rm),__float_as_uint(rm),false,false); rm=__builtin_fmaxf(__uint_as_float(rr[0]),__uint_as_float(rr[1])); } \
      if constexpr(VD==2) rm-=mhat;                   \
      resc=false; \
      if(__builtin_expect(__any(rm>(float)THRL),0)){ const float dl=__builtin_fmaxf(rm,0.f); mhat+=dl; \
        if constexpr(VD==1){ _Pragma("unroll") for(int r=0;r<16;++r){C0[r]-=dl;C1[r]-=dl;} \
          _Pragma("unroll") for(int r=0;r<16;++r)negm[r]=-mhat; asm volatile("":"+v"(negm)); } \
        const float f=__builtin_amdgcn_exp2f(-dl); l_reg*=f; if(hi==0)wsf[r32]=f; resc=true; } \
      if constexpr(VD==2){ _Pragma("unroll") for(int r=0;r<16;++r){C0[r]-=mhat;C1[r]-=mhat;} } } \
    SBAR(); \
    GAPB(o[0]=__builtin_amdgcn_mfma_f32_32x32x16_bf16(PAF(0),VFR(0),o[0],0,0,0), C0,0); VRDH(0); \
    GAPB(o[1]=__builtin_amdgcn_mfma_f32_32x32x16_bf16(PAF(0),VFR(4),o[1],0,0,0), C0,4); VRDH(4); \
    KRD(GL,0); GAPB(o[0]=__builtin_amdgcn_mfma_f32_32x32x16_bf16(PAF(1),VFR(1),o[0],0,0,0), C0,8); VRDH(1); \
    KRD(GL,1); GAPB(o[1]=__builtin_amdgcn_mfma_f32_32x32x16_bf16(PAF(1),VFR(5),o[1],0,0,0), C0,12); VRDH(5); \
    KRD(GL,2); GAPB(o[0]=__builtin_amdgcn_mfma_f32_32x32x16_bf16(PAF(2),VFR(2),o[0],0,0,0), C1,0); VRDH(2); \
    KRD(GL,3); GAPB(o[1]=__builtin_amdgcn_mfma_f32_32x32x16_bf16(PAF(2),VFR(6),o[1],0,0,0), C1,4); VRDH(6); \
    GAPB(o[0]=__builtin_amdgcn_mfma_f32_32x32x16_bf16(PAF(3),VFR(3),o[0],0,0,0), C1,8); VRDH(3); \
    GAPB(o[1]=__builtin_amdgcn_mfma_f32_32x32x16_bf16(PAF(3),VFR(7),o[1],0,0,0), C1,12); VRDH(7); \
    if constexpr(VD==2){     \
      o[2]=__builtin_amdgcn_mfma_f32_32x32x16_bf16(PAF(0),VFR(0),o[2],0,0,0); o[3]=__builtin_amdgcn_mfma_f32_32x32x16_bf16(PAF(0),VFR(4),o[3],0,0,0); \
      o[2]=__builtin_amdgcn_mfma_f32_32x32x16_bf16(PAF(1),VFR(1),o[2],0,0,0); o[3]=__builtin_amdgcn_mfma_f32_32x32x16_bf16(PAF(1),VFR(5),o[3],0,0,0); \
      o[2]=__builtin_amdgcn_mfma_f32_32x32x16_bf16(PAF(2),VFR(2),o[2],0,0,0); o[3]=__builtin_amdgcn_mfma_f32_32x32x16_bf16(PAF(2),VFR(6),o[3],0,0,0); \
      o[2]=__builtin_amdgcn_mfma_f32_32x32x16_bf16(PAF(3),VFR(3),o[2],0,0,0); o[3]=__builtin_amdgcn_mfma_f32_32x32x16_bf16(PAF(3),VFR(7),o[3],0,0,0); SBAR(); } \
    }while(0)
  #define WB_FULL() do{ if constexpr(VD==2){WAIT_BAR(3);}else{WAIT_BAR(2);} }while(0)
  #define WB_VONLY() do{ if constexpr(VD==2){WAIT_BAR(2);}else{WAIT_BAR(1);} }while(0)
  int t=1;
  #undef CMASK
  #define CMASK(P0,P1,t) mk.apply(P0,P1,(t),hi)
  for(;t+5<NT;t+=2){
    STEP(pB0,pB1,pA0,pA1,t,true,true,true);     WB_FULL(); RESC(); ROT();
    STEP(pA0,pA1,pB0,pB1,t+1,true,true,true);   WB_FULL(); RESC(); ROT();
  }
  #undef CMASK
  #define CMASK(P0,P1,t) mk.apply(P0,P1,(t),hi)
  #define ENDW(tt) do{ if((tt)+3<NT){WB_FULL();} else if((tt)+2<NT){WB_VONLY();} else {WAIT_BAR(0);} }while(0)
  for(;t+1<NT;t+=2){
    STEP(pB0,pB1,pA0,pA1,t,(t+3<NT),(t+1<NT),(t+1<NT));       ENDW(t);   RESC(); ROT();
    STEP(pA0,pA1,pB0,pB1,t+1,(t+4<NT),(t+2<NT),(t+2<NT));     ENDW(t+1); RESC(); ROT();
  }
  STEP(pB0,pB1,pA0,pA1,NT-1,false,false,false); RESC();
  { float sacc=pB0[0]+pB0[1]; _Pragma("unroll") for(int r=2;r<16;++r)sacc+=pB0[r]; _Pragma("unroll") for(int r=0;r<16;++r)sacc+=pB1[r]; l_reg+=sacc;
    pw0=(u32x4){PKW(pB0,0),PKW(pB0,2),PKW(pB0,4),PKW(pB0,6)};pw1=(u32x4){PKW(pB0,8),PKW(pB0,10),PKW(pB0,12),PKW(pB0,14)};pw2=(u32x4){PKW(pB1,0),PKW(pB1,2),PKW(pB1,4),PKW(pB1,6)};pw3=(u32x4){PKW(pB1,8),PKW(pB1,10),PKW(pB1,12),PKW(pB1,14)};
    SBAR(); pv(o,vb0+VD*sl_cur,PAF(0),PAF(1),PAF(2),PAF(3)); if constexpr(VD==2) pv(o+2,vb0+VD*sl_cur+8192,PAF(0),PAF(1),PAF(2),PAF(3)); }
  #undef PKW
  #undef PAF
  #undef VFR
  #undef PIN
  #undef MX3
  #undef GAPA
  #undef GAPB
  #undef EX
  #undef VRD
  #undef VRDH
  #undef KRD
  #undef STEP
  #undef ENDW
  #undef WB_FULL
  #undef WB_VONLY
  {auto rr=__builtin_amdgcn_permlane32_swap(__float_as_uint(l_reg),__float_as_uint(l_reg),false,false);l_reg=__uint_as_float(rr[0])+__uint_as_float(rr[1]);}
  if(hi==0)wsf[32+r32]=l_reg;asm volatile("s_waitcnt lgkmcnt(0)":::"memory");
  float rli[16];
  #pragma unroll
  for(int r=0;r<16;++r)rli[r]=__builtin_amdgcn_rcpf(wsf[32+crow(r,hi)]);
  int lane_e=lane; asm volatile("":"+v"(lane_e));
  bf16*Ow=u.Op+(long)(u.qrow0+wid*QBLK)*OPITCH;
  { bf16*stg=(bf16*)(shm+L_OST)+wid*2048;
    #pragma unroll
    for(int vh_=0;vh_<VD;++vh_){
      #pragma unroll
      for(int r=0;r<16;++r){const int orow=crow(r,hi);
        #pragma unroll
        for(int d0=0;d0<2;++d0)stg[orow*64+d0*32+r32]=__float2bfloat16(o[2*vh_+d0][r]*rli[r]);}
      asm volatile("s_waitcnt lgkmcnt(0)":::"memory");
      #pragma unroll
      for(int i=0;i<4;++i){const int row=i*8+(lane_e>>3),ch=lane_e&7; const u32x4 v=*(const u32x4*)(stg+row*64+ch*8); ATTN_STORE16(Ow+(long)row*OPITCH+64*vh_+ch*8,v);}
      asm volatile("s_waitcnt lgkmcnt(0)":::"memory"); } }
  asm volatile("s_waitcnt lgkmcnt(0)\n\ts_barrier":::"memory");
  #undef QF
  #undef DMA_K
  #undef TROW
  #undef DMA_V
  #undef CMASK
  #undef START
  #undef RESC
  #undef ROT
}
constexpr int ATTN_LDS_BYTES=LDS_BYTES;
#undef SBAR
#undef WAIT_BAR
}

struct Params { const float* in[26]; float* out; unsigned char* ws; int ph_lo, ph_hi; };
struct Ctx { LAS unsigned char* lds; int tid, lane, wave, vcu, G, gw, NGW; };
enum { I_X = 0, I_C, I_CTX, I_CCTX, I_ADAW, I_ADAB, I_LNG, I_LNB, I_W0IN, I_W0OUT, I_LQ1, I_LK1, I_LQ2, I_LK2, I_SUBLN, I_QN, I_KN,
       I_W1IN, I_W1OUT, I_RPB, I_POOLW, I_POOLS, I_ROUTER, I_WG, I_WU, I_WD };

__device__ __forceinline__ const float* mod_row(const Params& p, int layer, int row) {
    return (const float*)(p.ws + WS_MOD) + (size_t)(layer * 9 + (row < LAT ? (row >> 11) : 8)) * 6144;
}

__device__ __forceinline__ void ph_prologue(const Params& p, const Ctx& c) {
    const float* cin = p.in[I_C]; const float* cctx = p.in[I_CCTX]; const float* ada_w = p.in[I_ADAW]; const float* ada_b = p.in[I_ADAB];
    float* MOD = (float*)(p.ws + WS_MOD);
    LAS float* sc = (LAS float*)c.lds;
    LAS float* red = sc + 9 * 1024;
    for (int i = c.tid; i < 9 * 1024; i += 512) { const float v = i < 8192 ? cin[i] : cctx[i - 8192]; sc[i] = v / (1.f + expf(-v)); }
    __syncthreads();
    for (int u = c.vcu; u < 192; u += c.G) {
        const int layer = u / 96, j0 = (u - layer * 96) * 64;
        float acc[9];
#pragma unroll
        for (int m = 0; m < 9; ++m) acc[m] = 0.f;
        const float* wp = ada_w + (size_t)layer * 1024 * 6144 + (size_t)(128 * c.wave) * 6144 + j0 + c.lane;
#pragma unroll 1
        for (int kb = 0; kb < 128; kb += 32) {
            float wv[32];
#pragma unroll
            for (int i = 0; i < 32; ++i) wv[i] = wp[(size_t)(kb + i) * 6144];
#pragma unroll
            for (int i4 = 0; i4 < 8; ++i4)
#pragma unroll
                for (int m = 0; m < 9; ++m) { const f32x4 sv = *(const LAS f32x4*)(sc + m * 1024 + 128 * c.wave + kb + 4 * i4);
                    acc[m] += sv.x * wv[4 * i4] + sv.y * wv[4 * i4 + 1] + sv.z * wv[4 * i4 + 2] + sv.w * wv[4 * i4 + 3]; }
        }
#pragma unroll
        for (int m = 0; m < 9; ++m) red[(c.wave * 9 + m) * 64 + c.lane] = acc[m];
        __syncthreads();
        for (int o = c.tid; o < 576; o += 512) {
            const int m = o >> 6, j = o & 63; float s2 = 0.f;
#pragma unroll
            for (int w = 0; w < 8; ++w) s2 += red[(w * 9 + m) * 64 + j];
            MOD[(size_t)(layer * 9 + m) * 6144 + j0 + j] = s2 + ada_b[layer * 6144 + j0 + j];
        }
        __syncthreads();
    }
    if (c.vcu == 0) {
        f32x2* R = (f32x2*)(p.ws + WS_ROPE);
        for (int i = c.tid; i < 1024; i += 512) {
            const int pos = i >> 4, f = i & 15;
            const float inv = exp2f(-(float)f * (13.287712379549449f / 16.f));
            const float a = (float)pos * inv;
            const float k = rintf(a * 0.15915494309189535f);
            float rr = fmaf(-k, 6.28125f, a); rr = fmaf(-k, 1.9353071795864769e-3f, rr);
            R[i] = (f32x2){__cosf(rr), __sinf(rr)};
        }
    }
}


__device__ __forceinline__ void transpose_item(const float* W, int ldw, int k0, int n0, bf16* WT, int Kd, int drow0, LAS float* scr, int lane) {
#pragma unroll 8
    for (int i = 0; i < 32; ++i) { const int kk = 2 * i + (lane >> 5); scr[kk * 33 + (lane & 31)] = W[(size_t)(k0 + kk) * ldw + n0 + (lane & 31)]; }
    asm volatile("s_waitcnt lgkmcnt(0)" ::: "memory");
    const int ch = lane & 7;
#pragma unroll
    for (int j = 0; j < 4; ++j) { const int n = (lane >> 3) + 8 * j; const LAS float* sp = scr + (8 * ch) * 33 + n;
        v4u o; o.x = pk2(sp[0 * 33], sp[1 * 33]); o.y = pk2(sp[2 * 33], sp[3 * 33]); o.z = pk2(sp[4 * 33], sp[5 * 33]); o.w = pk2(sp[6 * 33], sp[7 * 33]);
        *(v4u*)(WT + (size_t)(drow0 + n) * Kd + k0 + 8 * ch) = o; }
    asm volatile("s_waitcnt lgkmcnt(0)" ::: "memory");
}
__device__ __forceinline__ void transpose_item8(const float* W, int ldw, int k0, int n0, unsigned char* WT8, int Kd, int drow0, float scale, LAS float* scr, int lane) {
#pragma unroll 8
    for (int i = 0; i < 32; ++i) { const int kk = 2 * i + (lane >> 5); scr[kk * 33 + (lane & 31)] = W[(size_t)(k0 + kk) * ldw + n0 + (lane & 31)]; }
    asm volatile("s_waitcnt lgkmcnt(0)" ::: "memory");
    const int n = lane >> 1, hf = lane & 1; const LAS float* sp = scr + (32 * hf) * 33 + n;
    v4u o0, o1;
    o0.x = pg8::pk4_fp8(sp[0 * 33] * scale, sp[1 * 33] * scale, sp[2 * 33] * scale, sp[3 * 33] * scale);     o0.y = pg8::pk4_fp8(sp[4 * 33] * scale, sp[5 * 33] * scale, sp[6 * 33] * scale, sp[7 * 33] * scale);
    o0.z = pg8::pk4_fp8(sp[8 * 33] * scale, sp[9 * 33] * scale, sp[10 * 33] * scale, sp[11 * 33] * scale);   o0.w = pg8::pk4_fp8(sp[12 * 33] * scale, sp[13 * 33] * scale, sp[14 * 33] * scale, sp[15 * 33] * scale);
    o1.x = pg8::pk4_fp8(sp[16 * 33] * scale, sp[17 * 33] * scale, sp[18 * 33] * scale, sp[19 * 33] * scale); o1.y = pg8::pk4_fp8(sp[20 * 33] * scale, sp[21 * 33] * scale, sp[22 * 33] * scale, sp[23 * 33] * scale);
    o1.z = pg8::pk4_fp8(sp[24 * 33] * scale, sp[25 * 33] * scale, sp[26 * 33] * scale, sp[27 * 33] * scale); o1.w = pg8::pk4_fp8(sp[28 * 33] * scale, sp[29 * 33] * scale, sp[30 * 33] * scale, sp[31 * 33] * scale);
    unsigned char* dst = WT8 + (size_t)(drow0 + n) * Kd + k0 + 32 * hf;
    *(v4u*)dst = o0; *(v4u*)(dst + 16) = o1;
    asm volatile("s_waitcnt lgkmcnt(0)" ::: "memory");
}
struct TBlk { const float* src; unsigned char* dst; int ldw, Kd, gu, which; float scale; };
__device__ __forceinline__ TBlk tblk_decode(const Params& p, int blk) {
    const int ie = blk / 96, q = blk - ie * 96, layer = ie >> 4, e = ie & 15, which = q >> 5, idx = q & 31;
    TBlk t; t.which = which;
    if (which < 2) { const int kb = idx & 3, nb = idx >> 2, k0 = 256 * kb, n0 = 256 * nb;
        t.src = (which == 0 ? p.in[I_WG] : p.in[I_WU]) + (size_t)ie * DM * FF + (size_t)k0 * FF + n0; t.ldw = FF; t.Kd = DM; t.scale = W8_GU; t.gu = 1;
        t.dst = p.ws + WS_WGU + (size_t)layer * WS_MOE_LSTRIDE + (size_t)e * 4096 * DM + (size_t)(2 * nb) * 256 * DM + k0; }
    else { const int kb = idx & 7, nb = idx >> 3, k0 = 256 * kb, n0 = 256 * nb;
        t.src = p.in[I_WD] + (size_t)ie * FF * DM + (size_t)k0 * DM + n0; t.ldw = DM; t.Kd = FF; t.scale = W8_DN; t.gu = 0;
        t.dst = p.ws + WS_WDN + (size_t)layer * WS_MOE_LSTRIDE + (size_t)e * DM * FF + (size_t)n0 * FF + k0; }
    return t;
}
__device__ __forceinline__ void tblk_load(const TBlk& t, f32x4 (&v)[16], int wave, int lane, int hf) {
    const float* sp = t.src + (size_t)(32 * wave + 16 * hf) * t.ldw + 4 * lane;
#pragma unroll
    for (int i = 0; i < 16; ++i) v[i] = __builtin_nontemporal_load((const f32x4*)(sp + (size_t)i * t.ldw));
}
constexpr int TPITCH = 264;
__device__ __forceinline__ void tblk_pack(const TBlk& t, const f32x4 (&v)[16], LAS unsigned char* T, int wave, int lane, int hf) {
#pragma unroll
    for (int i = 0; i < 4; ++i) {
        const f32x4 r0 = v[4 * i] * t.scale, r1 = v[4 * i + 1] * t.scale, r2 = v[4 * i + 2] * t.scale, r3 = v[4 * i + 3] * t.scale;
#pragma unroll
        for (int j = 0; j < 4; ++j) { int w = 0; w = __builtin_amdgcn_cvt_pk_fp8_f32(r0[j], r1[j], w, false); w = __builtin_amdgcn_cvt_pk_fp8_f32(r2[j], r3[j], w, true);
            *(LAS unsigned*)(T + (64 * j + lane) * TPITCH + 32 * wave + 16 * hf + 4 * i) = (unsigned)w; }
    }
}
__device__ __forceinline__ void tblk_writeout(const TBlk& t, const LAS unsigned char* T, int tid) {
#pragma unroll
    for (int it = 0; it < 8; ++it) { const int idx = it * 512 + tid, n = idx >> 4, ch = idx & 15, rho = (n & 3) * 64 + (n >> 2);
        const LAS unsigned char* sp = T + rho * TPITCH + 16 * ch;
        const v2u a = *(const LAS v2u*)sp, b2 = *(const LAS v2u*)(sp + 8);
        const int drow = t.gu ? ((n >> 7) * 256 + (n & 127) + t.which * 128) : n;
        __builtin_nontemporal_store((v4u){a.x, a.y, b2.x, b2.y}, (v4u*)(t.dst + (size_t)drow * t.Kd + 16 * ch)); }
}
__device__ __forceinline__ void moe_transpose_blocks(const Params& p, const Ctx& c, int blk0, int blk1, int widx, int nw) {
    LAS unsigned char* T = c.lds;
    f32x4 va[16], vb[16];
    int blk = blk0 + widx;
    if (blk >= blk1) return;
    TBlk t = tblk_decode(p, blk);
    tblk_load(t, va, c.wave, c.lane, 0);
#pragma unroll 1
    for (; blk < blk1; blk += nw) {
        tblk_load(t, vb, c.wave, c.lane, 1);
        tblk_pack(t, va, T, c.wave, c.lane, 0);
        const int nb = blk + nw;
        TBlk tn = tblk_decode(p, nb < blk1 ? nb : blk0);
        if (nb < blk1) tblk_load(tn, va, c.wave, c.lane, 0);
        tblk_pack(t, vb, T, c.wave, c.lane, 1);
        __syncthreads();
        tblk_writeout(t, T, c.tid);
        __syncthreads();
        t = tn;
    }
}
__device__ __forceinline__ void tail_transposes(const Params& p, const Ctx& c, int first_idle, int my, int blk0, int nblk) {
    if (!TAIL_TRANSPOSE || c.G != 256 || my < first_idle) return;
    moe_transpose_blocks(p, c, blk0, blk0 + nblk, my - first_idle, c.G - first_idle);
}
__device__ __forceinline__ void ph_transposes(const Params& p, const Ctx& c) {
    LAS float* scr = (LAS float*)(c.lds + c.wave * 16384);
    constexpr int I0 = 16 * 72, I1 = 16 * 32, I2 = 16 * 64, I3 = 16 * 32, ISM = I0 + I1 + I2 + I3;
    for (int r0 = c.gw; r0 < ISM; r0 += c.NGW) {
        int r = r0;
        if (r < I0) { const int n0 = 32 * (r % 72), drow = FUSE_QKV ? ((n0 >> 8) * 256 + 128 * ((n0 >> 5) & 1) + 32 * ((n0 >> 6) & 3)) : n0;
            transpose_item(p.in[I_W0IN], EIN, 64 * (r / 72), n0, (bf16*)(p.ws + WS_W0IN), DM, drow, scr, c.lane); continue; } r -= I0;
        if (r < I1) { transpose_item(p.in[I_W0OUT], DM, 64 * (r / 32), 32 * (r % 32), (bf16*)(p.ws + WS_W0OUT), DM, 32 * (r % 32), scr, c.lane); continue; } r -= I1;
        if (r < I2) { transpose_item(p.in[I_W1IN], OIN, 64 * (r / 64), 32 * (r % 64), (bf16*)(p.ws + WS_W1IN), DM, 32 * (r % 64), scr, c.lane); continue; } r -= I2;
        transpose_item(p.in[I_W1OUT], DM, 64 * (r / 32), 32 * (r % 32), (bf16*)(p.ws + WS_W1OUT), DM, 32 * (r % 32), scr, c.lane);
    }
    static_assert(MOE_FP8, "the expert-weight transposes write e4m3 copies");
    __syncthreads();
    moe_transpose_blocks(p, c, 0, (TAIL_TRANSPOSE && c.G == 256) ? 1536 : 3072, c.vcu, c.G);
}

__device__ __forceinline__ void ph_modulate0(const Params& p, const Ctx& c) {
    bf16* HB = (bf16*)(p.ws + WS_HB);
    for (int row = c.gw; row < NTOK; row += c.NGW) {
        const float* src = row < LAT ? p.in[I_X] + (size_t)row * DM : p.in[I_CTX] + (size_t)(row - LAT) * DM;
        const float* mod = mod_row(p, 0, row);
#pragma unroll
        for (int j = 0; j < 4; ++j) {
            const int col = 4 * c.lane + 256 * j;
            const f32x4 v = *(const f32x4*)(src + col), sh = *(const f32x4*)(mod + col), s = *(const f32x4*)(mod + 1024 + col);
            const f32x4 h = v * (s + 1.f) + sh;
            *(v2u*)(HB + (size_t)row * DM + col) = (v2u){pk2(h.x, h.y), pk2(h.z, h.w)};
        }
    }
}

struct NG { const bf16* A; int lda; const float* W0; const float* W1; int ldw; size_t wstride; int Mb; int row_begin, row_end, col_begin, col_end, K; };
template <int NB, class Epi>
__device__ __forceinline__ void ngemm(const NG& g, const Ctx& c, const Epi& epi) {
    const int nmt = (g.row_end - g.row_begin) / 32, nnt = (g.col_end - g.col_begin) / 32;
    const int l31 = c.lane & 31, lh = c.lane >> 5;
    for (int t = c.gw; t < nmt * nnt; t += c.NGW) {
        const int mt = t / nnt, nt = t % nnt;
        const int row0 = g.row_begin + mt * 32, col0 = g.col_begin + nt * 32;
        const int e = row0 / g.Mb;
        const bf16* ap = g.A + (size_t)(row0 + l31) * g.lda + lh;
        const float* bp0 = g.W0 + (size_t)e * g.wstride + (size_t)lh * g.ldw + col0 + l31;
        const float* bp1 = NB == 2 ? g.W1 + (size_t)e * g.wstride + (size_t)lh * g.ldw + col0 + l31 : nullptr;
        f32x16 acc0 = {}, acc1 = {};
#pragma unroll 8
        for (int k = 0; k < g.K; k += 2) {
            const float a = bf2f((unsigned)ap[k]);
            const float b0 = bp0[(size_t)k * g.ldw];
            acc0 = __builtin_amdgcn_mfma_f32_32x32x2f32(a, b0, acc0, 0, 0, 0);
            if (NB == 2) { const float b1 = bp1[(size_t)k * g.ldw]; acc1 = __builtin_amdgcn_mfma_f32_32x32x2f32(a, b1, acc1, 0, 0, 0); }
        }
#pragma unroll
        for (int r = 0; r < 16; ++r) {
            const int row = row0 + (r & 3) + 8 * (r >> 2) + 4 * lh, col = col0 + l31;
            epi(row, col, acc0[r], acc1[r]);
        }
    }
}
struct EpiF32 { float* O; int ldc; __device__ __forceinline__ void operator()(int row, int col, float v0, float) const { O[(size_t)row * ldc + col] = v0; } };
struct EpiBf { bf16* O; int ldc; int scale_cols; float sc; __device__ __forceinline__ void operator()(int row, int col, float v0, float) const { O[(size_t)row * ldc + col] = (bf16)f2bf(col < scale_cols ? v0 * sc : v0); } };
struct EpiSwiglu { bf16* O; __device__ __forceinline__ void operator()(int row, int col, float g, float u) const { const float s = g / (1.f + __expf(-g)); O[(size_t)row * FF + col] = (bf16)f2bf(s * u); } };
struct EpiGate { bf16* O; const float* gate; __device__ __forceinline__ void operator()(int row, int col, float v0, float) const { O[(size_t)row * DM + col] = (bf16)f2bf(v0 * gate[row]); } };

template <bool F32IN> __device__ __forceinline__ void ph_qkv_post(const Params& p, const Ctx& c) {
    const float* PF = (const float*)(p.ws + WS_PF);
    bf16* QKV = (bf16*)(p.ws + WS_QKV);
    const f32x2* R = (const f32x2*)(p.ws + WS_ROPE);
    const float* qn = p.in[I_QN]; const float* kn = p.in[I_KN];
    const int d = c.lane;
    const float qg = qn[d], kg = kn[d];
    for (int row = c.gw; row < NTOK; row += c.NGW) {
        const bool lat = row < LAT;
        const int t = row & 2047;
        const int pos = (d < 32) ? (t >> 6) : (t & 63);
        const f32x2 cs = R[pos * 16 + (d & 15)];
        const bool first = (d & 16) == 0;
        float vv[36];
#pragma unroll
        for (int hs = 0; hs < 36; ++hs) vv[hs] = F32IN ? PF[(size_t)row * EIN + hs * 64 + d] : bf2f((unsigned)QKV[(size_t)row * EIN + hs * 64 + d]);
#pragma unroll
        for (int hs = 0; hs < 36; ++hs) {
            float v = vv[hs];
            const bool isq = hs < 8 || (hs >= 24 && hs < 32);
            const bool isk = (hs >= 8 && hs < 16) || hs == 32 || hs == 33;
            const bool nrm = hs >= 24 && hs < 34;
            if (nrm) { const float ss = wave_sum(v * v); v = v * rsqrtf(ss * (1.f / 64.f) + RMS_EPS) * (hs < 32 ? qg : kg); }
            if ((isq || isk) && lat) { const float pr = __shfl_xor(v, 16); v = first ? v * cs.x - pr * cs.y : v * cs.x + pr * cs.y; }
            if (isq) v *= C2;
            QKV[(size_t)row * EIN + hs * 64 + d] = (bf16)f2bf(v);
        }
    }
}

__device__ __forceinline__ void ph_attn0_naive(const Params& p, const Ctx& c) {
    const bf16* QKV = (const bf16*)(p.ws + WS_QKV);
    bf16* CC = (bf16*)(p.ws + WS_CC);
    bf16* AO = (bf16*)(p.ws + WS_AO);
    LAS float* Ks = (LAS float*)c.lds;
    LAS float* Vs = Ks + 4096;
    for (int u = c.vcu; u < 960; u += c.G) {
        const bool isctx = u >= 768;
        int b, vh, qrow, ntiles; bool active = true;
        if (!isctx) { b = u / 96; const int r = u % 96; vh = r >> 2; qrow = b * SEQ + (r & 3) * 512 + c.tid; ntiles = 36; }
        else { const int uu = u - 768; b = uu / 24; vh = uu % 24; qrow = LAT + b * NCTX + (c.tid & 255); active = c.tid < 256; ntiles = 4; }
        int qcol, kcol, vcol;
        if (vh < 16) { const int a = vh >> 2, s = (vh >> 1) & 1, half = vh & 1; qcol = a * 128 + s * 64; kcol = 512 + a * 128 + s * 64; vcol = 1024 + a * 128 + half * 64; }
        else { const int h = vh - 16; qcol = 1536 + h * 64; kcol = 2048 + (h >> 2) * 64; vcol = 2176 + (h >> 2) * 64; }
        float q[64], o[64];
#pragma unroll
        for (int i = 0; i < 8; ++i) { const v4u w = *(const v4u*)(QKV + (size_t)qrow * EIN + qcol + 8 * i); unpack8(w, q + 8 * i); }
#pragma unroll
        for (int i = 0; i < 64; ++i) o[i] = 0.f;
        float m = -1e30f, l = 0.f;
        for (int t = 0; t < ntiles; ++t) {
            const int krow0 = isctx ? LAT + b * NCTX + 64 * t : (t < 32 ? b * SEQ + 64 * t : LAT + b * NCTX + 64 * (t - 32));
            __syncthreads();
            { const int r = c.tid >> 3, ch = c.tid & 7; float f[8];
              const v4u kw = *(const v4u*)(QKV + (size_t)(krow0 + r) * EIN + kcol + ch * 8); unpack8(kw, f);
#pragma unroll
              for (int j = 0; j < 8; ++j) Ks[r * 64 + ch * 8 + j] = f[j];
              const v4u vw = *(const v4u*)(QKV + (size_t)(krow0 + r) * EIN + vcol + ch * 8); unpack8(vw, f);
#pragma unroll
              for (int j = 0; j < 8; ++j) Vs[r * 64 + ch * 8 + j] = f[j]; }
            __syncthreads();
            if (active) {
                for (int kk = 0; kk < 64; ++kk) {
                    float s = 0.f;
#pragma unroll
                    for (int dd = 0; dd < 64; ++dd) s += q[dd] * Ks[kk * 64 + dd];
                    const float mn = fmaxf(m, s), al = exp2f(m - mn), pp = exp2f(s - mn);
                    l = l * al + pp; m = mn;
#pragma unroll
                    for (int dd = 0; dd < 64; ++dd) o[dd] = o[dd] * al + pp * Vs[kk * 64 + dd];
                }
            }
        }
        if (active) {
            const float rl = 1.f / l;
            bf16* dst = vh < 16 ? AO + (size_t)qrow * DM + (vh >> 2) * 256 + ((vh >> 1) & 1) * 128 + (vh & 1) * 64 : CC + (size_t)qrow * DM + 512 + (vh - 16) * 64;
            {
#pragma unroll
                for (int i = 0; i < 8; ++i) *(v4u*)(dst + 8 * i) = (v4u){pk2(o[8 * i] * rl, o[8 * i + 1] * rl), pk2(o[8 * i + 2] * rl, o[8 * i + 3] * rl), pk2(o[8 * i + 4] * rl, o[8 * i + 5] * rl), pk2(o[8 * i + 6] * rl, o[8 * i + 7] * rl)}; }
        }
    }
}


__device__ __forceinline__ void attn_combine_rows(const Params& p, const Ctx& c, int row0, int a, float lam, float g0, float g1) {
    const bf16* AO = (const bf16*)(p.ws + WS_AO); bf16* CC = (bf16*)(p.ws + WS_CC);
    asm volatile("s_waitcnt vmcnt(0)" ::: "memory");
#pragma unroll 1
    for (int rb = 0; rb < 32; rb += 8) {
        float x0[8], x1[8];
#pragma unroll
        for (int j = 0; j < 8; ++j) { const bf16* src = AO + (size_t)(row0 + rb + j) * DM + a * 256;
            x0[j] = bf2f((unsigned)src[c.lane]) - lam * bf2f((unsigned)src[128 + c.lane]); x1[j] = bf2f((unsigned)src[64 + c.lane]) - lam * bf2f((unsigned)src[192 + c.lane]); }
#pragma unroll
        for (int j = 0; j < 8; ++j) { const float ss = wave_sum(x0[j] * x0[j] + x1[j] * x1[j]); const float r = rsqrtf(ss * (1.f / 128.f) + RMS_EPS);
            bf16* dst = CC + (size_t)(row0 + rb + j) * DM + a * 128;
            dst[c.lane] = (bf16)f2bf(x0[j] * r * g0); dst[64 + c.lane] = (bf16)f2bf(x1[j] * r * g1); }
    }
}
__device__ __forceinline__ void ph_attn0_fast(const Params& p, const Ctx& c, char* lds_generic) {
    typedef attn_body::bf16 abf;
    const abf* Q = (const abf*)(p.ws + WS_QKV); abf* CCb = (abf*)(p.ws + WS_CC); abf* AOb = (abf*)(p.ws + WS_AO);
    const float d1 = wave_sum(p.in[I_LQ1][c.lane] * p.in[I_LK1][c.lane]), d2 = wave_sum(p.in[I_LQ2][c.lane] * p.in[I_LK2][c.lane]);
    const float lam = expf(d1) - expf(d2) + LAM_INIT;
    const float g0 = p.in[I_SUBLN][c.lane] * (1.f - LAM_INIT), g1 = p.in[I_SUBLN][c.lane + 64] * (1.f - LAM_INIT);
    for (int v = c.vcu; v < 256; v += c.G) {
#pragma unroll 1
        for (int step = 0; step < 6; ++step) {
            attn_body::AU u; int a = -1, sp = 0, h = 0; bool ctxu = false;
            if (step < 2) { const int b = v >> 5; a = (v >> 3) & 3; sp = step; u.qrow0 = b * SEQ + (v & 7) * 256; u.lat_row0 = b * SEQ; u.ctx_row0 = LAT + b * NCTX; }
            else if (step < 4) { const int U = (step - 2) * 256 + v, b = U >> 6; h = (U >> 3) & 7; u.qrow0 = b * SEQ + (U & 7) * 256; u.lat_row0 = b * SEQ; u.ctx_row0 = LAT + b * NCTX; }
            else { ctxu = true; int b;
                if (v < 32) { b = v >> 2; a = v & 3; sp = step - 4; }
                else if (v < 96 && step == 4) { b = (v - 32) >> 3; h = (v - 32) & 7; }
                else break;
                u.qrow0 = LAT + b * NCTX; u.lat_row0 = 0; u.ctx_row0 = LAT + b * NCTX; }
            if (!ctxu) { u.nlat_t = 32; u.NT = 36; } else { u.nlat_t = 0; u.NT = 4; }
            if (a >= 0) {
                u.Qp = Q + a * 128 + sp * 64; u.Kp = Q + 512 + a * 128 + sp * 64; u.Vp = Q + 1024 + a * 128; u.Op = AOb + a * 256 + sp * 128;
                attn_body::attn_unit<8, EIN, attn_body::NoMask, 2>(u, lds_generic, attn_body::NoMask{});
                if (sp == 1) attn_combine_rows(p, c, u.qrow0 + c.wave * 32, a, lam, g0, g1);
            } else {
                u.Qp = Q + 1536 + h * 64; u.Kp = Q + 2048 + (h >> 2) * 64; u.Vp = Q + 2176 + (h >> 2) * 64; u.Op = CCb + 512 + h * 64;
                attn_body::attn_unit<8, EIN, attn_body::NoMask, 1>(u, lds_generic, attn_body::NoMask{});
            }
        }
    }
    tail_transposes(p, c, 96, c.vcu, 1536 + 120, 320);
}

__device__ __forceinline__ void ph_attn_combine(const Params& p, const Ctx& c) {
    const bf16* AO = (const bf16*)(p.ws + WS_AO);
    bf16* CC = (bf16*)(p.ws + WS_CC);
    const float d1 = wave_sum(p.in[I_LQ1][c.lane] * p.in[I_LK1][c.lane]);
    const float d2 = wave_sum(p.in[I_LQ2][c.lane] * p.in[I_LK2][c.lane]);
    const float lam = expf(d1) - expf(d2) + LAM_INIT;
    const float g0 = p.in[I_SUBLN][c.lane] * (1.f - LAM_INIT), g1 = p.in[I_SUBLN][c.lane + 64] * (1.f - LAM_INIT);
    for (int it = c.gw; it < NTOK * 4; it += c.NGW) {
        const int row = it >> 2, a = it & 3;
        const bf16* src = AO + (size_t)row * DM + a * 256;
        const float x0 = bf2f((unsigned)src[c.lane]) - lam * bf2f((unsigned)src[128 + c.lane]), x1 = bf2f((unsigned)src[64 + c.lane]) - lam * bf2f((unsigned)src[192 + c.lane]);
        const float ss = wave_sum(x0 * x0 + x1 * x1);
        const float r = rsqrtf(ss * (1.f / 128.f) + RMS_EPS);
        CC[(size_t)row * DM + a * 128 + c.lane] = (bf16)f2bf(x0 * r * g0);
        CC[(size_t)row * DM + a * 128 + 64 + c.lane] = (bf16)f2bf(x1 * r * g1);
    }
}

__device__ __forceinline__ f32x4 unpack4(const v2u w) { return (f32x4){bf2f(w.x & 0xffffu), __uint_as_float(w.x & 0xffff0000u), bf2f(w.y & 0xffffu), __uint_as_float(w.y & 0xffff0000u)}; }
__device__ __forceinline__ float reduce_logits(const f32x4 (&lg)[4], int lane) {
    float w8[8], w4[4], w2[2], w1;
    { const bool hi = (lane & 32) != 0;
#pragma unroll
      for (int i = 0; i < 8; ++i) { const float a0 = lg[i >> 2][i & 3], a1 = lg[2 + (i >> 2)][i & 3]; const float keep = hi ? a1 : a0, send = hi ? a0 : a1; w8[i] = keep + __shfl_xor(send, 32); } }
    { const bool hi = (lane & 16) != 0;
#pragma unroll
      for (int i = 0; i < 4; ++i) { const float keep = hi ? w8[i + 4] : w8[i], send = hi ? w8[i] : w8[i + 4]; w4[i] = keep + __shfl_xor(send, 16); } }
    { const bool hi = (lane & 8) != 0;
#pragma unroll
      for (int i = 0; i < 2; ++i) { const float keep = hi ? w4[i + 2] : w4[i], send = hi ? w4[i] : w4[i + 2]; w2[i] = keep + __shfl_xor(send, 8); } }
    { const bool hi = (lane & 4) != 0; const float keep = hi ? w2[1] : w2[0], send = hi ? w2[0] : w2[1]; w1 = keep + __shfl_xor(send, 4); }
    w1 += __shfl_xor(w1, 2); w1 += __shfl_xor(w1, 1);
    return w1;
}
__device__ __forceinline__ void ph_ln1_router(const Params& p, const Ctx& c, int layer) {
    const bf16* Y = (const bf16*)(p.ws + WS_Y);
    bf16* XS = (bf16*)(p.ws + WS_XS);
    bf16* HB = (bf16*)(p.ws + WS_HB);
    float* AFF = (float*)(p.ws + WS_AFF);
    const float* lng = p.in[I_LNG] + (size_t)(layer * 2 + 0) * DM; const float* lnb = p.in[I_LNB] + (size_t)(layer * 2 + 0) * DM;
    const float* router = p.in[I_ROUTER] + (size_t)layer * DM * NE;
    LAS f32x4* R = (LAS f32x4*)c.lds;
    for (int idx = c.tid; idx < 4096; idx += 512) { const int e4 = idx & 3, k = idx >> 2, ln = (k & 255) >> 2, q = k & 3, j = k >> 8;
        R[((j * 4 + q) * 4 + e4) * 64 + ln] = *(const f32x4*)(router + (size_t)k * NE + 4 * e4); }
    __syncthreads();
    const int nrows = layer == 0 ? NTOK : LAT;
    const int lane = c.lane;
    for (int row = 2 * c.gw; row < nrows; row += 2 * c.NGW) {
        const float* mod = mod_row(p, layer, row);
        f32x4 va[4], vb[4]; float sa = 0.f, sb = 0.f;
#pragma unroll
        for (int j = 0; j < 4; ++j) { const int col = 4 * lane + 256 * j;
            f32x4 xa, xb;
            if (layer == 0) { const float* xin = row < LAT ? p.in[I_X] + (size_t)row * DM : p.in[I_CTX] + (size_t)(row - LAT) * DM; xa = *(const f32x4*)(xin + col); xb = *(const f32x4*)(xin + DM + col); }
            else { xa = unpack4(*(const v2u*)(XS + (size_t)row * DM + col)); xb = unpack4(*(const v2u*)(XS + (size_t)(row + 1) * DM + col)); }
            const f32x4 g1 = *(const f32x4*)(mod + 2048 + col);
            va[j] = xa * ALPHA + g1 * unpack4(*(const v2u*)(Y + (size_t)row * DM + col));
            vb[j] = xb * ALPHA + g1 * unpack4(*(const v2u*)(Y + (size_t)(row + 1) * DM + col));
            sa += (va[j].x + va[j].y) + (va[j].z + va[j].w); sb += (vb[j].x + vb[j].y) + (vb[j].z + vb[j].w); }
        const float meana = wave_sum(sa) * (1.f / DM), meanb = wave_sum(sb) * (1.f / DM); float qa = 0.f, qb = 0.f;
#pragma unroll
        for (int j = 0; j < 4; ++j) { va[j] = va[j] - meana; vb[j] = vb[j] - meanb;
            qa += (va[j].x * va[j].x + va[j].y * va[j].y) + (va[j].z * va[j].z + va[j].w * va[j].w); qb += (vb[j].x * vb[j].x + vb[j].y * vb[j].y) + (vb[j].z * vb[j].z + vb[j].w * vb[j].w); }
        const float rstda = 1.f / sqrtf(wave_sum(qa) * (1.f / DM) + LN_EPS), rstdb = 1.f / sqrtf(wave_sum(qb) * (1.f / DM) + LN_EPS);
        f32x4 lga[4], lgb[4];
#pragma unroll
        for (int e = 0; e < 4; ++e) { lga[e] = (f32x4){0.f, 0.f, 0.f, 0.f}; lgb[e] = (f32x4){0.f, 0.f, 0.f, 0.f}; }
#pragma unroll
        for (int j = 0; j < 4; ++j) { const int col = 4 * lane + 256 * j;
            const f32x4 g = *(const f32x4*)(lng + col), bb = *(const f32x4*)(lnb + col), sc = *(const f32x4*)(mod + 4096 + col) + 1.f, sh = *(const f32x4*)(mod + 3072 + col);
            const f32x4 x1a = va[j] * rstda * g + bb, x1b = vb[j] * rstdb * g + bb;
            *(v2u*)(XS + (size_t)row * DM + col) = (v2u){pk2(x1a.x, x1a.y), pk2(x1a.z, x1a.w)};
            *(v2u*)(XS + (size_t)(row + 1) * DM + col) = (v2u){pk2(x1b.x, x1b.y), pk2(x1b.z, x1b.w)};
            const f32x4 hma = x1a * sc + sh, hmb = x1b * sc + sh;
            if (MOE_FP8) { *(unsigned*)((unsigned char*)HB + (size_t)row * DM + col) = pg8::pk4_fp8(hma.x, hma.y, hma.z, hma.w);
                           *(unsigned*)((unsigned char*)HB + (size_t)(row + 1) * DM + col) = pg8::pk4_fp8(hmb.x, hmb.y, hmb.z, hmb.w); }
            else { *(v2u*)(HB + (size_t)row * DM + col) = (v2u){pk2(hma.x, hma.y), pk2(hma.z, hma.w)}; *(v2u*)(HB + (size_t)(row + 1) * DM + col) = (v2u){pk2(hmb.x, hmb.y), pk2(hmb.z, hmb.w)}; }
            asm volatile("" ::: "memory");
#pragma unroll
            for (int q = 0; q < 4; ++q) { const float ha = hma[q], hb = hmb[q];
#pragma unroll
                for (int e4 = 0; e4 < 4; ++e4) { const f32x4 rw = R[((j * 4 + q) * 4 + e4) * 64 + lane]; lga[e4] += rw * ha; lgb[e4] += rw * hb; } } }
        const float wa = reduce_logits(lga, lane), wb = reduce_logits(lgb, lane);
        float mxa = wa, mxb = wb;
#pragma unroll
        for (int o = 4; o < 64; o <<= 1) { mxa = fmaxf(mxa, __shfl_xor(mxa, o)); mxb = fmaxf(mxb, __shfl_xor(mxb, o)); }
        const float exa = expf(wa - mxa), exb = expf(wb - mxb); float dena = exa, denb = exb;
#pragma unroll
        for (int o = 4; o < 64; o <<= 1) { dena += __shfl_xor(dena, o); denb += __shfl_xor(denb, o); }
        if ((lane & 3) == 0) { const int e = ((lane >> 5) & 1) * 8 + ((lane >> 4) & 1) * 4 + ((lane >> 3) & 1) * 2 + ((lane >> 2) & 1);
            AFF[(size_t)row * NE + e] = exa / dena; AFF[(size_t)(row + 1) * NE + e] = exb / denb; }
    }
}

__device__ __forceinline__ void ph_topk(const Params& p, const Ctx& c, int layer) {
    const float* AFF = (const float*)(p.ws + WS_AFF);
    int* INV = (int*)(p.ws + WS_INV);
    float* GATE = (float*)(p.ws + WS_GATE);
    const bf16* HB = (const bf16*)(p.ws + WS_HB);
    bf16* XG = (bf16*)(p.ws + WS_XG);
    LAS unsigned* hist = (LAS unsigned*)c.lds;
    LAS unsigned* ctl = hist + 256;
    LAS int* sel = (LAS int*)(c.lds + 2048);
    const int MR = layer == 0 ? MR0 : MR1;
    const int ntasks = layer == 0 ? 256 : 128;
    const int lane = c.lane;
    for (int task = c.vcu; task < ntasks; task += c.G) {
        int set, e, n, cap, rowbase, slotbase;
        if (task < 128) { set = task >> 4; e = task & 15; n = SEQ; cap = 256; rowbase = set * SEQ; slotbase = set * 256; }
        else { const int t2 = task - 128; set = t2 >> 4; e = t2 & 15; n = NCTX; cap = 32; rowbase = LAT + set * NCTX; slotbase = 2048 + set * 32; }
        const bool valid = 4 * c.tid < n;
        unsigned key[4];
#pragma unroll
        for (int q = 0; q < 4; ++q) key[q] = valid ? __float_as_uint(AFF[(size_t)(rowbase + 4 * c.tid + q) * NE + e]) : 0u;
        unsigned prefix = 0u, need = (unsigned)cap;
#pragma unroll 1
        for (int pass = 0; pass < 4; ++pass) {
            const int shift = 24 - 8 * pass;
            if (c.tid < 256) hist[c.tid] = 0u;
            __syncthreads();
            if (valid) {
#pragma unroll
                for (int q = 0; q < 4; ++q) if (pass == 0 || (key[q] >> (shift + 8)) == (prefix >> (shift + 8))) __hip_atomic_fetch_add(&hist[(key[q] >> shift) & 255u], 1u, __ATOMIC_RELAXED, __HIP_MEMORY_SCOPE_WORKGROUP);
            }
            __syncthreads();
            if (c.wave == 0) {
                const unsigned h0 = hist[4 * lane], h1 = hist[4 * lane + 1], h2 = hist[4 * lane + 2], h3 = hist[4 * lane + 3];
                const unsigned tot = h0 + h1 + h2 + h3; unsigned sfx = tot;
#pragma unroll
                for (int o = 1; o < 64; o <<= 1) { const unsigned t = __shfl_down(sfx, o); if (lane + o < 64) sfx += t; }
                const unsigned above = sfx - tot, c3 = above + h3, c2 = c3 + h2, c1 = c2 + h1, c0 = c1 + h0;
                int d = -1; unsigned gtc = 0u;
                if (above < need && need <= c3) { d = 3; gtc = above; }
                else if (c3 < need && need <= c2) { d = 2; gtc = c3; }
                else if (c2 < need && need <= c1) { d = 1; gtc = c2; }
                else if (c1 < need && need <= c0) { d = 0; gtc = c1; }
                if (d >= 0) { ctl[0] = prefix | ((unsigned)(4 * lane + d) << shift); ctl[1] = need - gtc; }
            }
            __syncthreads();
            prefix = ctl[0]; need = ctl[1];
        }
        unsigned ngt = 0u, neq = 0u;
#pragma unroll
        for (int q = 0; q < 4; ++q) { ngt += (valid && key[q] > prefix) ? 1u : 0u; neq += (valid && key[q] == prefix) ? 1u : 0u; }
        const unsigned cnt = ngt | (neq << 16); unsigned inc = cnt;
#pragma unroll
        for (int o = 1; o < 64; o <<= 1) { const unsigned t = __shfl_up(inc, o); if (lane >= o) inc += t; }
        if (lane == 63) ctl[8 + c.wave] = inc;
        __syncthreads();
        unsigned base = 0u;
#pragma unroll
        for (int w = 0; w < 8; ++w) base += (w < c.wave) ? ctl[8 + w] : 0u;
        const unsigned ex = base + inc - cnt; unsigned gtb = ex & 0xffffu, eqb = ex >> 16;
        if (valid) {
#pragma unroll
            for (int q = 0; q < 4; ++q) { const int i = 4 * c.tid + q; int slot = -1;
                if (key[q] > prefix) { slot = (int)(gtb + (eqb < need ? eqb : need)); ++gtb; }
                else if (key[q] == prefix) { if (eqb < need) slot = (int)(gtb + eqb); ++eqb; }
                int gs = -1;
                if (slot >= 0) { gs = e * MR + slotbase + slot; sel[slot] = i; GATE[gs] = __uint_as_float(key[q]); }
                INV[(size_t)(rowbase + i) * NE + e] = gs; }
        }
        __syncthreads();
        for (int sidx = c.wave; sidx < cap; sidx += 8) {
            if (MOE_FP8) { const unsigned char* src = (const unsigned char*)HB + (size_t)(rowbase + sel[sidx]) * DM; unsigned char* dst = (unsigned char*)XG + (size_t)(e * MR + slotbase + sidx) * DM;
                *(v4u*)(dst + 16 * lane) = *(const v4u*)(src + 16 * lane); }
            else { const bf16* src = HB + (size_t)(rowbase + sel[sidx]) * DM; bf16* dst = XG + (size_t)(e * MR + slotbase + sidx) * DM;
            const v4u a0 = *(const v4u*)(src + 8 * lane), a1 = *(const v4u*)(src + 512 + 8 * lane);
            *(v4u*)(dst + 8 * lane) = a0; *(v4u*)(dst + 512 + 8 * lane) = a1; }
        }
        __syncthreads();
    }
}

__device__ __forceinline__ void ph_combine(const Params& p, const Ctx& c, int layer) {
    const bf16* YS = (const bf16*)(p.ws + WS_YS);
    const int* INV = (const int*)(p.ws + WS_INV);
    bf16* XS = (bf16*)(p.ws + WS_XS);
    bf16* HB = (bf16*)(p.ws + WS_HB);
    const float* lng = p.in[I_LNG] + (size_t)(layer * 2 + 1) * DM; const float* lnb = p.in[I_LNB] + (size_t)(layer * 2 + 1) * DM;
    const int nrows = layer == 0 ? NTOK : LAT;
    const int lane = c.lane;
    for (int row = 2 * c.gw; row < nrows; row += 2 * c.NGW) {
        const float* mod = mod_row(p, layer, row);
        const int inv = (lane < 2 * NE) ? INV[(size_t)row * NE + lane] : -1;
        const unsigned mall = (unsigned)__ballot(inv >= 0);
        unsigned ma = mall & 0xffffu, mb = mall >> 16;
        int sla[4], slb[4]; float wa[4], wb[4];
#pragma unroll
        for (int q = 0; q < 4; ++q) {
            if (ma) { const int e = __builtin_ctz(ma); ma &= ma - 1; sla[q] = __builtin_amdgcn_readlane(inv, e); wa[q] = 1.f; } else { sla[q] = 0; wa[q] = 0.f; }
            if (mb) { const int e = __builtin_ctz(mb); mb &= mb - 1; slb[q] = __builtin_amdgcn_readlane(inv, 16 + e); wb[q] = 1.f; } else { slb[q] = 0; wb[q] = 0.f; } }
        f32x4 moa[4], mob[4];
#pragma unroll
        for (int j = 0; j < 4; ++j) { moa[j] = (f32x4){0.f, 0.f, 0.f, 0.f}; mob[j] = (f32x4){0.f, 0.f, 0.f, 0.f}; }
#pragma unroll
        for (int q = 0; q < 4; ++q)
#pragma unroll
            for (int j = 0; j < 4; ++j) { moa[j] += unpack4(*(const v2u*)(YS + (size_t)sla[q] * DM + 4 * lane + 256 * j)) * wa[q]; mob[j] += unpack4(*(const v2u*)(YS + (size_t)slb[q] * DM + 4 * lane + 256 * j)) * wb[q]; }
        while (ma) { const int e = __builtin_ctz(ma); ma &= ma - 1; const int sl = __builtin_amdgcn_readlane(inv, e);
#pragma unroll
            for (int j = 0; j < 4; ++j) moa[j] += unpack4(*(const v2u*)(YS + (size_t)sl * DM + 4 * lane + 256 * j)); }
        while (mb) { const int e = __builtin_ctz(mb); mb &= mb - 1; const int sl = __builtin_amdgcn_readlane(inv, 16 + e);
#pragma unroll
            for (int j = 0; j < 4; ++j) mob[j] += unpack4(*(const v2u*)(YS + (size_t)sl * DM + 4 * lane + 256 * j)); }
        f32x4 va[4], vb[4]; float sa = 0.f, sb = 0.f;
#pragma unroll
        for (int j = 0; j < 4; ++j) { const int col = 4 * lane + 256 * j; const f32x4 g2 = *(const f32x4*)(mod + 5120 + col);
            va[j] = unpack4(*(const v2u*)(XS + (size_t)row * DM + col)) * ALPHA + g2 * moa[j];
            vb[j] = unpack4(*(const v2u*)(XS + (size_t)(row + 1) * DM + col)) * ALPHA + g2 * mob[j];
            sa += (va[j].x + va[j].y) + (va[j].z + va[j].w); sb += (vb[j].x + vb[j].y) + (vb[j].z + vb[j].w); }
        const float meana = wave_sum(sa) * (1.f / DM), meanb = wave_sum(sb) * (1.f / DM); float qa = 0.f, qb = 0.f;
#pragma unroll
        for (int j = 0; j < 4; ++j) { va[j] = va[j] - meana; vb[j] = vb[j] - meanb;
            qa += (va[j].x * va[j].x + va[j].y * va[j].y) + (va[j].z * va[j].z + va[j].w * va[j].w); qb += (vb[j].x * vb[j].x + vb[j].y * vb[j].y) + (vb[j].z * vb[j].z + vb[j].w * vb[j].w); }
        const float rstda = 1.f / sqrtf(wave_sum(qa) * (1.f / DM) + LN_EPS), rstdb = 1.f / sqrtf(wave_sum(qb) * (1.f / DM) + LN_EPS);
        const float* modn = mod_row(p, 1, row);
#pragma unroll
        for (int j = 0; j < 4; ++j) { const int col = 4 * lane + 256 * j;
            const f32x4 g = *(const f32x4*)(lng + col), bb = *(const f32x4*)(lnb + col);
            const f32x4 x2a = va[j] * rstda * g + bb, x2b = vb[j] * rstdb * g + bb;
            if (layer == 0) {
                *(v2u*)(XS + (size_t)row * DM + col) = (v2u){pk2(x2a.x, x2a.y), pk2(x2a.z, x2a.w)};
                *(v2u*)(XS + (size_t)(row + 1) * DM + col) = (v2u){pk2(x2b.x, x2b.y), pk2(x2b.z, x2b.w)};
                const f32x4 sc = *(const f32x4*)(modn + 1024 + col) + 1.f, sh = *(const f32x4*)(modn + col);
                const f32x4 ha = x2a * sc + sh, hb = x2b * sc + sh;
                *(v2u*)(HB + (size_t)row * DM + col) = (v2u){pk2(ha.x, ha.y), pk2(ha.z, ha.w)};
                *(v2u*)(HB + (size_t)(row + 1) * DM + col) = (v2u){pk2(hb.x, hb.y), pk2(hb.z, hb.w)};
            } else {
                *(f32x4*)(p.out + (size_t)row * DM + col) = x2a; *(f32x4*)(p.out + (size_t)(row + 1) * DM + col) = x2b;
            } }
    }
}

__device__ __forceinline__ void na_key(const float* q, float* o, float& m, float& l, const bf16* kp, const bf16* vp, float bias) {
    float s = bias;
#pragma unroll
    for (int i = 0; i < 8; ++i) { float f[8]; unpack8(*(const v4u*)(kp + 8 * i), f);
#pragma unroll
        for (int j = 0; j < 8; ++j) s += q[8 * i + j] * f[j]; }
    const float mn = fmaxf(m, s), al = exp2f(m - mn), pp = exp2f(s - mn);
    l = l * al + pp; m = mn;
#pragma unroll
    for (int i = 0; i < 8; ++i) { float f[8]; unpack8(*(const v4u*)(vp + 8 * i), f);
#pragma unroll
        for (int j = 0; j < 8; ++j) o[8 * i + j] = o[8 * i + j] * al + pp * f[j]; }
}
__device__ __forceinline__ void ph_mixer1_naive(const Params& p, const Ctx& c) {
    const bf16* P2 = (const bf16*)(p.ws + WS_QKV);
    bf16* CC = (bf16*)(p.ws + WS_CC);
    const float* rpb = p.in[I_RPB]; const float* pool_w = p.in[I_POOLW]; const float* pool_s = p.in[I_POOLS];
    LAS float* pl = (LAS float*)c.lds;
    for (int u = c.vcu; u < 256; u += c.G) {
        const int b = u >> 5, r = u & 31;
        {
            const int h = c.wave, col = c.lane, row = b * SEQ + r * 64 + col;
            const int rs = min(max(r - 4, 0), 24), cs = min(max(col - 8, 0), 48);
            float q[64], o[64];
#pragma unroll
            for (int i = 0; i < 8; ++i) unpack8(*(const v4u*)(P2 + (size_t)row * OIN + h * 64 + 8 * i), q + 8 * i);
#pragma unroll
            for (int i = 0; i < 64; ++i) o[i] = 0.f;
            float m = -1e30f, l = 0.f;
#pragma unroll 1
            for (int i = 0; i < 8; ++i)
#pragma unroll 1
                for (int j = 0; j < 16; ++j) {
                    const int krow = b * SEQ + (rs + i) * 64 + cs + j;
                    const float bias = rpb[(h * 15 + (rs + i - r + 7)) * 31 + (cs + j - col + 15)] * LOG2E;
                    na_key(q, o, m, l, P2 + (size_t)krow * OIN + 512 + h * 64, P2 + (size_t)krow * OIN + 1024 + h * 64, bias);
                }
#pragma unroll 1
            for (int j = 0; j < NCTX; ++j) {
                const int krow = LAT + b * NCTX + j;
                na_key(q, o, m, l, P2 + (size_t)krow * OIN + 512 + h * 64, P2 + (size_t)krow * OIN + 1024 + h * 64, 0.f);
            }
            const float rl = 1.f / l; bf16* dst = CC + (size_t)row * DM + h * 64;
#pragma unroll
            for (int i = 0; i < 8; ++i) *(v4u*)(dst + 8 * i) = (v4u){pk2(o[8 * i] * rl, o[8 * i + 1] * rl), pk2(o[8 * i + 2] * rl, o[8 * i + 3] * rl), pk2(o[8 * i + 4] * rl, o[8 * i + 5] * rl), pk2(o[8 * i + 6] * rl, o[8 * i + 7] * rl)};
        }
        __syncthreads();
        {
            const int ch = c.tid, g = ch >> 7, half = 1 << g;
            for (int tt = 0; tt < 64; ++tt) {
                const int t = r * 64 + tt, lo = max(t - half, 0), hi = min(t + half, SEQ);
                float s = 0.f;
                for (int t2 = lo; t2 < hi; ++t2) s += bf2f((unsigned)P2[(size_t)(b * SEQ + t2) * OIN + 1536 + ch]);
                pl[tt * 512 + ch] = s / (float)(hi - lo) - bf2f((unsigned)P2[(size_t)(b * SEQ + t) * OIN + 1536 + ch]);
            }
        }
        __syncthreads();
        {
            const int g = c.tid >> 7, e = c.tid & 127;
            const float ps = pool_s[g * 128 + e];
#pragma unroll 1
            for (int tb = 0; tb < 64; tb += 16) {
                float acc[16];
#pragma unroll
                for (int i = 0; i < 16; ++i) acc[i] = 0.f;
#pragma unroll 4
                for (int cc = 0; cc < 128; ++cc) {
                    const float w = pool_w[(size_t)(g * 128 + cc) * 128 + e];
#pragma unroll
                    for (int i = 0; i < 16; ++i) acc[i] += pl[(tb + i) * 512 + g * 128 + cc] * w;
                }
#pragma unroll
                for (int i = 0; i < 16; ++i) CC[(size_t)(b * SEQ + r * 64 + tb + i) * DM + 512 + g * 128 + e] = (bf16)f2bf(acc[i] * ps);
            }
        }
        __syncthreads();
    }
}


constexpr int NA_TAB_OFF = 86016 + 1024;
__device__ __forceinline__ void ph_mixer1_fast(const Params& p, const Ctx& c, char* lds_generic) {
    typedef attn_body::bf16 abf;
    const abf* P2a = (const abf*)(p.ws + WS_QKV); abf* CCa = (abf*)(p.ws + WS_CC);
    LAS float* tab = (LAS float*)(c.lds + NA_TAB_OFF);
    for (int i = c.tid; i < 8 * 15 * 32; i += 512) { const int hd = i >> 5, j = i & 31; tab[i] = j < 31 ? p.in[I_RPB][hd * 31 + j] * LOG2E : 0.f; }
    __syncthreads();
    for (int it = 0;; ++it) {
        const int U = it * c.G + c.vcu;
        if (U >= 512) break;
        const int b = U >> 6, h = (U >> 3) & 7, rq = U & 7;
        const int rs_min = min(max(4 * rq - 4, 0), 24);
        const int nloc = (rq == 0 || rq == 7) ? 8 : 12;
        attn_body::AU u;
        u.qrow0 = b * SEQ + rq * 256; u.lat_row0 = LAT + b * NCTX; u.nlat_t = 4; u.ctx_row0 = b * SEQ + rs_min * 64; u.NT = 4 + nloc;
        u.Qp = P2a + h * 64; u.Kp = P2a + 512 + h * 64; u.Vp = P2a + 1024 + h * 64; u.Op = CCa + h * 64;
        const int r = 4 * rq + (c.wave >> 1), col = (c.wave & 1) * 32 + (c.lane & 31), hi = c.lane >> 5;
        const int cs = min(max(col - 8, 0), 48);
        attn_body::NAMask mk; mk.tb0 = (attn_body::lds_cfptr)(tab + h * 15 * 32 + 15 - col); mk.r = r; mk.rs = min(max(r - 4, 0), 24); mk.rs_min = rs_min; mk.cb = 4 * hi - cs;
        attn_body::attn_unit<8, OIN, attn_body::NAMask>(u, lds_generic, mk);
    }
    __syncthreads();
    const bf16* P2 = (const bf16*)(p.ws + WS_QKV); bf16* CC = (bf16*)(p.ws + WS_CC);
    const float* pool_w = p.in[I_POOLW]; const float* pool_s = p.in[I_POOLS];
    constexpr int PLP = 1040;
    for (int u = c.vcu; u < 256; u += c.G) {
        const int b = u >> 5, r = u & 31;
        {   const int ch = c.tid, g = c.wave >> 1;
            const bf16* du = P2 + (size_t)b * SEQ * OIN + 1536 + ch;
            const int t0 = r * 64;
            float v[80];
#pragma unroll
            for (int k = 0; k < 80; ++k) { const int t2 = t0 - 8 + k; v[k] = ((t2 >= 0 && t2 < SEQ) ? 1.f : 0.f) * bf2f((unsigned)du[(size_t)min(max(t2, 0), SEQ - 1) * OIN]); }
            LAS bf16* plc = (LAS bf16*)(c.lds) + ch;
#define POOL_COL(HALF) do { float ws = 0.f; _Pragma("unroll") for (int k = 8 - HALF; k < 8 + HALF; ++k) ws += v[k]; \
            _Pragma("unroll") for (int tt = 0; tt < 64; ++tt) { const int t = t0 + tt, lo = max(t - HALF, 0), hi = min(t + HALF, SEQ); \
                plc[tt * (PLP / 2)] = (bf16)f2bf(ws / (float)(hi - lo) - v[tt + 8]); ws += v[tt + 8 + HALF] - v[tt + 8 - HALF]; } } while (0)
            if (g == 0) POOL_COL(1); else if (g == 1) POOL_COL(2); else if (g == 2) POOL_COL(4); else POOL_COL(8);
#undef POOL_COL
        }
        __syncthreads();
        {   typedef short bf16x8v __attribute__((ext_vector_type(8)));
            const int g = c.wave >> 1, th = c.wave & 1, l31 = c.lane & 31, lh = c.lane >> 5;
            f32x16 acc[4];
#pragma unroll
            for (int et = 0; et < 4; ++et) acc[et] = (f32x16){};
#pragma unroll
            for (int ks = 0; ks < 8; ++ks) {
                const bf16x8v af = *(const LAS bf16x8v*)(c.lds + (32 * th + l31) * PLP + (g * 128 + 16 * ks + 8 * lh) * 2);
#pragma unroll
                for (int et = 0; et < 4; ++et) {
                    const float* wp = pool_w + (size_t)(g * 128 + 16 * ks + 8 * lh) * 128 + 32 * et + l31;
                    bf16x8v bfr;
#pragma unroll
                    for (int j = 0; j < 8; ++j) bfr[j] = (short)f2bf(wp[(size_t)j * 128]);
                    acc[et] = __builtin_amdgcn_mfma_f32_32x32x16_bf16(af, bfr, acc[et], 0, 0, 0);
                }
            }
#pragma unroll
            for (int et = 0; et < 4; ++et) { const int e = 32 * et + l31; const float ps = pool_s[g * 128 + e];
#pragma unroll
                for (int rg = 0; rg < 16; ++rg) { const int tok = 32 * th + (rg & 3) + 8 * (rg >> 2) + 4 * lh;
                    CC[(size_t)(b * SEQ + r * 64 + tok) * DM + 512 + g * 128 + e] = (bf16)f2bf(acc[et][rg] * ps); } }
        }
        __syncthreads();
    }
}

__global__ void __launch_bounds__(512, 2) mk_fwd(Params p_arg) {
    extern __shared__ __attribute__((aligned(16))) unsigned char lds_raw[];
    Ctx c;
    c.lds = (LAS unsigned char*)lds_raw;
    c.tid = threadIdx.x; c.lane = c.tid & 63; c.wave = __builtin_amdgcn_readfirstlane(c.tid >> 6);
    c.G = gridDim.x; { const int bx = blockIdx.x; c.vcu = (c.G % 8 == 0) ? (bx % 8) * (c.G / 8) + bx / 8 : bx; }
    c.gw = c.vcu * 8 + c.wave; c.NGW = c.G * 8;
    volatile LAS unsigned* MISC = (volatile LAS unsigned*)(c.lds + MISC_OFF);
    if (c.tid < 32) MISC[c.tid] = 0u;
    __syncthreads();
    typedef const __attribute__((address_space(4))) Params* KP;
    const KP kp0 = (KP)__builtin_amdgcn_kernarg_segment_ptr();
#define RELOAD_P() ({ KP kq_ = kp0; asm volatile("" : "+s"(kq_)); *(const Params*)kq_; })
    gu32* ctl = (gu32*)(p_arg.ws + WS_CTL);
    XcdBarrier bar; bar.bar = (unsigned*)(ctl + CW_BAR); bar.x = 0; bar.st = nullptr;
    if (!MK_MULTI) bar = xcd_barrier_post((unsigned*)(ctl + CW_BAR), MISC + 8);
    const int lo = p_arg.ph_lo, hi = p_arg.ph_hi;
    unsigned long long pt0 = 0, pt1 = 0; if (PROBE_PH == 0 || PROBE_PH >= 100) pt0 = __builtin_amdgcn_s_memrealtime();
#define IN(k) (lo <= (k) && (k) < hi)
#define SEAM(k) do { if (IN(k) && IN((k) + 1) && !(FAST_ATTN && (k) == 5) && !(FAST_GEMM && FUSE_QKV && (k) == 3)) xcd_barrier(bar); if ((k) + 1 == PROBE_PH) pt0 = __builtin_amdgcn_s_memrealtime(); if ((k) == PROBE_PH || (k) + 200 == PROBE_PH) pt1 = __builtin_amdgcn_s_memrealtime(); } while (0)

#define HB ((bf16*)(p.ws + WS_HB))
#define QKV ((bf16*)(p.ws + WS_QKV))
#define CC ((bf16*)(p.ws + WS_CC))
#define Y ((float*)(p.ws + WS_Y))
#define PF ((float*)(p.ws + WS_PF))
#define XG ((bf16*)(p.ws + WS_XG))
#define HID ((bf16*)(p.ws + WS_HID))
#define YS ((bf16*)(p.ws + WS_YS))
#define GATE ((const float*)(p.ws + WS_GATE))

    if (IN(0)) { const Params p = RELOAD_P(); ph_prologue(p, c); if (FAST_GEMM) { __syncthreads(); ph_transposes(p, c); } } SEAM(0);
    if (IN(1)) { const Params p = RELOAD_P(); ph_modulate0(p, c); } SEAM(1);
    if (IN(2)) { const Params p = RELOAD_P();
        if (FAST_GEMM) { pg8::Gemm g{HB, (const bf16*)(p.ws + WS_W0IN), NTOK, EIN, DM, 0}; pg8::StaticOrder S; S.init(NTOK, EIN, c.G, (int)blockIdx.x);
            if (FUSE_QKV) { pg8::EpiQKV E{QKV, EIN, (const float*)(p.ws + WS_ROPE), p.in[I_QN], p.in[I_KN], C2, RMS_EPS}; pg8::gemm_phase<pg8::EpiQKV, pg8::StaticOrder, true, true>(c.lds, g, S, E); }
            else { pg8::EpiBf16<0> E{QKV, EIN, nullptr, 0, 0, 1.f}; pg8::gemm_phase<pg8::EpiBf16<0>, pg8::StaticOrder, true, true>(c.lds, g, S, E); }
            tail_transposes(p, c, 648 - 512, (int)blockIdx.x, 1536, 120); }
        else { NG g{HB, DM, p.in[I_W0IN], nullptr, EIN, 0, 1 << 30, 0, NTOK, 0, EIN, DM}; ngemm<1>(g, c, EpiF32{PF, EIN}); }
    } SEAM(2);
    if (!(FAST_GEMM && FUSE_QKV)) { if (IN(3)) { const Params p = RELOAD_P(); if (FAST_GEMM) ph_qkv_post<false>(p, c); else ph_qkv_post<true>(p, c); } } SEAM(3);
    if (IN(4)) { const Params p = RELOAD_P(); if (FAST_ATTN) ph_attn0_fast(p, c, (char*)lds_raw); else ph_attn0_naive(p, c); } SEAM(4);
    if (!FAST_ATTN) { if (IN(5)) { const Params p = RELOAD_P(); ph_attn_combine(p, c); } } SEAM(5);
    if (IN(6)) { const Params p = RELOAD_P();
        if (FAST_GEMM) { pg8::Gemm g{CC, (const bf16*)(p.ws + WS_W0OUT), NTOK, DM, DM, 0}; pg8::StaticOrder S; S.init(NTOK, DM, c.G, (int)blockIdx.x);
            pg8::EpiBf16<0> E{(bf16*)Y, DM, nullptr, 0, 0, 1.f}; pg8::gemm_phase<pg8::EpiBf16<0>, pg8::StaticOrder, true, true>(c.lds, g, S, E);
            tail_transposes(p, c, 288 - 256, (int)blockIdx.x, 1536 + 120 + 320, 224); }
        else { NG g{CC, DM, p.in[I_W0OUT], nullptr, DM, 0, 1 << 30, 0, NTOK, 0, DM, DM}; ngemm<1>(g, c, EpiBf{(bf16*)Y, DM, 0, 1.f}); }
    } SEAM(6);
    if (IN(7)) { const Params p = RELOAD_P(); ph_ln1_router(p, c, 0); } SEAM(7);
    if (IN(8)) { const Params p = RELOAD_P(); ph_topk(p, c, 0); } SEAM(8);
    if (IN(9)) { const Params p = RELOAD_P();
        if (FAST_GEMM && MOE_FP8) { pg8::Gemm g{XG, (const bf16*)(p.ws + WS_WGU), NE * MR0, 4096, DM / 2, (size_t)4096 * DM}; pg8::GroupedOrder S; S.init(MR0 / 256, 16, NE, c.G, c.vcu);
            pg8::EpiSwigluF8 E{(unsigned char*)HID, FF, 1.f / W8_GU, H8_SC}; pg8::gemm_phase<pg8::EpiSwigluF8, pg8::GroupedOrder, true, true, true>(c.lds, g, S, E); }
        else if (FAST_GEMM) { pg8::Gemm g{XG, (const bf16*)(p.ws + WS_WGU), NE * MR0, 4096, DM, (size_t)4096 * DM * 2}; pg8::GroupedOrder S; S.init(MR0 / 256, 16, NE, c.G, c.vcu);
            pg8::EpiSwigluP E{HID, FF}; pg8::gemm_phase<pg8::EpiSwigluP, pg8::GroupedOrder, true, true>(c.lds, g, S, E); }
        else { NG g{XG, DM, p.in[I_WG], p.in[I_WU], FF, (size_t)DM * FF, MR0, 0, NE * MR0, 0, FF, DM}; ngemm<2>(g, c, EpiSwiglu{HID}); }
    } SEAM(9);
    if (IN(10)) { const Params p = RELOAD_P();
        if (FAST_GEMM && MOE_FP8) { pg8::Gemm g{HID, (const bf16*)(p.ws + WS_WDN), NE * MR0, DM, FF / 2, (size_t)DM * FF}; pg8::GroupedOrder S; S.init(MR0 / 256, 4, NE, c.G, c.vcu);
            pg8::EpiGateS E{YS, DM, GATE, 1.f / (W8_DN * H8_SC)}; pg8::gemm_phase<pg8::EpiGateS, pg8::GroupedOrder, true, true, true>(c.lds, g, S, E);
            tail_transposes(p, c, 576 - 512, c.vcu, 1536 + 120 + 320 + 224, 576); }
        else if (FAST_GEMM) { pg8::Gemm g{HID, (const bf16*)(p.ws + WS_WDN), NE * MR0, DM, FF, (size_t)DM * FF * 2}; pg8::GroupedOrder S; S.init(MR0 / 256, 4, NE, c.G, c.vcu);
            pg8::EpiGateP E{YS, DM, GATE}; pg8::gemm_phase<pg8::EpiGateP, pg8::GroupedOrder, true, true>(c.lds, g, S, E); }
        else { NG g{HID, FF, p.in[I_WD], nullptr, DM, (size_t)FF * DM, MR0, 0, NE * MR0, 0, DM, FF}; ngemm<1>(g, c, EpiGate{YS, GATE}); }
    } SEAM(10);
    if (IN(11)) { const Params p = RELOAD_P(); ph_combine(p, c, 0); } SEAM(11);
    if (IN(12)) { const Params p = RELOAD_P();
        if (FAST_GEMM) { pg8::Gemm g{HB, (const bf16*)(p.ws + WS_W1IN), NTOK, OIN, DM, 0}; pg8::L1InOrder S; S.init(c.G, (int)blockIdx.x);
            pg8::EpiBf16<0> E{QKV, OIN, nullptr, 512, 512, C2}; pg8::gemm_phase<pg8::EpiBf16<0>, pg8::L1InOrder, true, true>(c.lds, g, S, E);
            tail_transposes(p, c, 544 - 512, (int)blockIdx.x, 1536 + 120 + 320 + 224 + 576, 296); }
        else {
        NG g{HB, DM, p.in[I_W1IN], nullptr, OIN, 0, 1 << 30, 0, LAT, 0, OIN, DM}; ngemm<1>(g, c, EpiBf{QKV, OIN, 512, C2});
        NG g2{HB, DM, p.in[I_W1IN], nullptr, OIN, 0, 1 << 30, LAT, NTOK, 512, 1536, DM}; ngemm<1>(g2, c, EpiBf{QKV, OIN, 0, 1.f}); }
    } SEAM(12);
    if (IN(13)) { const Params p = RELOAD_P(); if (FAST_NA) ph_mixer1_fast(p, c, (char*)lds_raw); else ph_mixer1_naive(p, c); } SEAM(13);
    if (IN(14)) { const Params p = RELOAD_P();
        if (FAST_GEMM) { pg8::Gemm g{CC, (const bf16*)(p.ws + WS_W1OUT), LAT, DM, DM, 0}; pg8::StaticOrder S; S.init(LAT, DM, c.G, (int)blockIdx.x);
            pg8::EpiBf16<0> E{(bf16*)Y, DM, nullptr, 0, 0, 1.f}; pg8::gemm_phase<pg8::EpiBf16<0>, pg8::StaticOrder, true, true>(c.lds, g, S, E); }
        else { NG g{CC, DM, p.in[I_W1OUT], nullptr, DM, 0, 1 << 30, 0, LAT, 0, DM, DM}; ngemm<1>(g, c, EpiBf{(bf16*)Y, DM, 0, 1.f}); }
    } SEAM(14);
    if (IN(15)) { const Params p = RELOAD_P(); ph_ln1_router(p, c, 1); } SEAM(15);
    if (IN(16)) { const Params p = RELOAD_P(); ph_topk(p, c, 1); } SEAM(16);
    if (IN(17)) { const Params p = RELOAD_P();
        if (FAST_GEMM && MOE_FP8) { pg8::Gemm g{XG, (const bf16*)(p.ws + WS_WGU + WS_MOE_LSTRIDE), NE * MR1, 4096, DM / 2, (size_t)4096 * DM}; pg8::GroupedOrder S; S.init(MR1 / 256, 16, NE, c.G, c.vcu);
            pg8::EpiSwigluF8 E{(unsigned char*)HID, FF, 1.f / W8_GU, H8_SC}; pg8::gemm_phase<pg8::EpiSwigluF8, pg8::GroupedOrder, true, true, true>(c.lds, g, S, E); }
        else if (FAST_GEMM) { pg8::Gemm g{XG, (const bf16*)(p.ws + WS_WGU + WS_MOE_LSTRIDE), NE * MR1, 4096, DM, (size_t)4096 * DM * 2}; pg8::GroupedOrder S; S.init(MR1 / 256, 16, NE, c.G, c.vcu);
            pg8::EpiSwigluP E{HID, FF}; pg8::gemm_phase<pg8::EpiSwigluP, pg8::GroupedOrder, true, true>(c.lds, g, S, E); }
        else { NG g{XG, DM, p.in[I_WG] + (size_t)NE * DM * FF, p.in[I_WU] + (size_t)NE * DM * FF, FF, (size_t)DM * FF, MR1, 0, NE * MR1, 0, FF, DM}; ngemm<2>(g, c, EpiSwiglu{HID}); }
    } SEAM(17);
    if (IN(18)) { const Params p = RELOAD_P();
        if (FAST_GEMM && MOE_FP8) { pg8::Gemm g{HID, (const bf16*)(p.ws + WS_WDN + WS_MOE_LSTRIDE), NE * MR1, DM, FF / 2, (size_t)DM * FF}; pg8::GroupedOrder S; S.init(MR1 / 256, 4, NE, c.G, c.vcu);
            pg8::EpiGateS E{YS, DM, GATE, 1.f / (W8_DN * H8_SC)}; pg8::gemm_phase<pg8::EpiGateS, pg8::GroupedOrder, true, true, true>(c.lds, g, S, E); }
        else if (FAST_GEMM) { pg8::Gemm g{HID, (const bf16*)(p.ws + WS_WDN + WS_MOE_LSTRIDE), NE * MR1, DM, FF, (size_t)DM * FF * 2}; pg8::GroupedOrder S; S.init(MR1 / 256, 4, NE, c.G, c.vcu);
            pg8::EpiGateP E{YS, DM, GATE}; pg8::gemm_phase<pg8::EpiGateP, pg8::GroupedOrder, true, true>(c.lds, g, S, E); }
        else { NG g{HID, FF, p.in[I_WD] + (size_t)NE * FF * DM, nullptr, DM, (size_t)FF * DM, MR1, 0, NE * MR1, 0, DM, FF}; ngemm<1>(g, c, EpiGate{YS, GATE}); }
    } SEAM(18);
    if (IN(19)) { const Params p = RELOAD_P(); ph_combine(p, c, 1); }
    if (PROBE_PH == 19 || PROBE_PH == 100) pt1 = __builtin_amdgcn_s_memrealtime();
    if (PROBE_PH >= 0 && blockIdx.x == 0 && c.tid == 0) { const unsigned long long te = __builtin_amdgcn_s_memrealtime(); while (__builtin_amdgcn_s_memrealtime() - te < pt1 - pt0) __builtin_amdgcn_s_sleep(8); }
#undef IN
#undef SEAM
#undef HB
#undef QKV
#undef CC
#undef Y
#undef PF
#undef XG
#undef HID
#undef YS
#undef GATE
#undef RELOAD_P
}

extern "C" void kernel_launch(void* const* d_in, const int* in_sizes, int n_in, void* d_out, int out_size, void* d_ws, size_t ws_size, hipStream_t stream) {
    static int grid = 0;
    if (grid == 0) {
        if (n_in != 26 || out_size != LAT * DM || ws_size < WS_END) { fprintf(stderr, "kernel_launch: unexpected shapes (n_in %d out %d ws %zu)\n", n_in, out_size, ws_size); grid = -1; return; }
        int dev = 0, cus = 0;
        if (hipGetDevice(&dev) != hipSuccess || hipDeviceGetAttribute(&cus, hipDeviceAttributeMultiprocessorCount, dev) != hipSuccess) { grid = -1; return; }
        if (hipFuncSetAttribute((const void*)mk_fwd, hipFuncAttributeMaxDynamicSharedMemorySize, LDS_BYTES) != hipSuccess) { fprintf(stderr, "kernel_launch: hipFuncSetAttribute failed\n"); grid = -1; return; }
        int per_cu = 0;
        if (hipOccupancyMaxActiveBlocksPerMultiprocessor(&per_cu, (const void*)mk_fwd, 512, LDS_BYTES) != hipSuccess || per_cu < 1) fprintf(stderr, "kernel_launch: occupancy query says %d\n", per_cu);
        (void)hipGetLastError();
        grid = cus;
    }
    if (grid < 0) return;
    (void)hipMemsetAsync((char*)d_ws + WS_CTL, 0, CTL_ZERO_BYTES, stream);
    Params a{};
    for (int i = 0; i < 26; ++i) a.in[i] = (const float*)d_in[i];
    a.out = (float*)d_out; a.ws = (unsigned char*)d_ws;
#if MK_MULTI
    for (int ph = 0; ph < NPHASE; ++ph) { a.ph_lo = ph; a.ph_hi = ph + 1; hipLaunchKernelGGL(mk_fwd, dim3(grid), dim3(512), LDS_BYTES, stream, a); }
#else
    a.ph_lo = 0; a.ph_hi = NPHASE;
    hipLaunchKernelGGL(mk_fwd, dim3(grid), dim3(512), LDS_BYTES, stream, a);
#endif
}
```

```cpp
#include <hip/hip_runtime.h>
#include <cstdio>
#include <cstdint>

#define GAS __attribute__((address_space(1)))
#define LAS __attribute__((address_space(3)))
typedef unsigned short bf16;
typedef unsigned v4u __attribute__((ext_vector_type(4)));
typedef unsigned v2u __attribute__((ext_vector_type(2)));
typedef float f32x4 __attribute__((ext_vector_type(4)));
typedef float f32x2 __attribute__((ext_vector_type(2)));
typedef float f32x16 __attribute__((ext_vector_type(16)));
typedef GAS unsigned gu32;

#ifndef PROBE_PH
#define PROBE_PH -1
#endif
#ifndef PROBE_MASK
#define PROBE_MASK 0u
#endif
#ifndef TAIL_TRANSPOSE
#define TAIL_TRANSPOSE 1
#endif
#ifndef FUSE_QKV
#define FUSE_QKV 1
#endif
#ifndef MOE_FP8
#define MOE_FP8 1
#endif
#ifndef FAST_NA
#define FAST_NA 1
#endif
#ifndef FAST_ATTN
#define FAST_ATTN 1
#endif
#ifndef FAST_GEMM
#define FAST_GEMM 1
#endif
#ifndef MK_MULTI
#define MK_MULTI 0
#endif

constexpr int NBATCH = 8, SEQ = 2048, DM = 1024, NCTX = 256;
constexpr int LAT = NBATCH * SEQ;
constexpr int NTOK = LAT + NBATCH * NCTX;
constexpr int EIN = 2304, OIN = 2048, NE = 16, FF = 2048;
constexpr int MR0 = 2304, MR1 = 2048;
constexpr float LOG2E = 1.4426950408889634f;
constexpr float C2 = 0.125f * LOG2E;
constexpr float ALPHA = 1.4142135623730951f;
constexpr float LN_EPS = 1e-5f, RMS_EPS = 1e-6f;
constexpr float LAM_INIT = 0.2f;
constexpr int NPHASE = 20;
constexpr float W8_GU = 32.f, W8_DN = 64.f, H8_SC = 8.f, Y8_SC = 8.f;

constexpr size_t MiB = 1u << 20;
constexpr size_t WS_CTL = 0, CTL_ZERO_BYTES = 32 * 1024;
constexpr size_t WS_MOD = 1 * MiB;
constexpr size_t WS_ROPE = 1 * MiB + 512 * 1024;
constexpr size_t WS_POOLB = WS_ROPE + 65536;
constexpr size_t WS_W0IN = 2 * MiB;
constexpr size_t WS_W0OUT = 7 * MiB;
constexpr size_t WS_W1IN = 9 * MiB;
constexpr size_t WS_W1OUT = 13 * MiB;
constexpr size_t WS_AFF = 16 * MiB;
constexpr size_t WS_INV = 18 * MiB;
constexpr size_t WS_GATE = 20 * MiB;
constexpr size_t WS_WGU = 24 * MiB;
constexpr size_t WS_WDN = 152 * MiB;
constexpr size_t WS_MOE_LSTRIDE = 192 * MiB;
constexpr size_t WS_XS = 408 * MiB;
constexpr size_t WS_HB = 480 * MiB;
constexpr size_t WS_QKV = 516 * MiB;
constexpr size_t WS_CC = 597 * MiB;
constexpr size_t WS_AO = 633 * MiB;
constexpr size_t WS_Y = 705 * MiB;
constexpr size_t WS_XG = 516 * MiB;
constexpr size_t WS_HID = 588 * MiB;
constexpr size_t WS_YS = 732 * MiB;
constexpr size_t WS_PF = 804 * MiB;
constexpr size_t WS_END = 968 * MiB;

constexpr int CW_BAR = 4096;
constexpr int LDS_BYTES = 147456;
constexpr int MISC_OFF = 131072 + 320;

__device__ __forceinline__ float bf2f(unsigned v) { return __uint_as_float(v << 16); }
__device__ __forceinline__ unsigned f2bf(float f) { unsigned u = __float_as_uint(f); return (u + 0x7fffu + ((u >> 16) & 1u)) >> 16; }
__device__ __forceinline__ unsigned pk2(float lo, float hi) { return f2bf(lo) | (f2bf(hi) << 16); }
template <int CTRL, int RM> __device__ __forceinline__ float dppf(float old, float v) { return __int_as_float(__builtin_amdgcn_update_dpp(__float_as_int(old), __float_as_int(v), CTRL, RM, 0xf, false)); }
__device__ __forceinline__ float wave_sum(float v) {
    v += dppf<0xB1, 0xf>(0.f, v); v += dppf<0x4E, 0xf>(0.f, v); v += dppf<0x141, 0xf>(0.f, v); v += dppf<0x140, 0xf>(0.f, v);
    v += dppf<0x142, 0xa>(0.f, v); v += dppf<0x143, 0xc>(0.f, v);
    return __int_as_float(__builtin_amdgcn_readlane(__float_as_int(v), 63));
}
__device__ __forceinline__ float wave_max(float v) {
    v = fmaxf(v, dppf<0xB1, 0xf>(v, v)); v = fmaxf(v, dppf<0x4E, 0xf>(v, v)); v = fmaxf(v, dppf<0x141, 0xf>(v, v)); v = fmaxf(v, dppf<0x140, 0xf>(v, v));
    v = fmaxf(v, dppf<0x142, 0xa>(v, v)); v = fmaxf(v, dppf<0x143, 0xc>(v, v));
    return __int_as_float(__builtin_amdgcn_readlane(__float_as_int(v), 63));
}
__device__ __forceinline__ void unpack8(const v4u w, float* f) {
    f[0] = bf2f(w.x & 0xffffu); f[1] = __uint_as_float(w.x & 0xffff0000u);
    f[2] = bf2f(w.y & 0xffffu); f[3] = __uint_as_float(w.y & 0xffff0000u);
    f[4] = bf2f(w.z & 0xffffu); f[5] = __uint_as_float(w.z & 0xffff0000u);
    f[6] = bf2f(w.w & 0xffffu); f[7] = __uint_as_float(w.w & 0xffff0000u);
}
__device__ __forceinline__ f32x4 unpack4(const v2u w) { return (f32x4){bf2f(w.x & 0xffffu), __uint_as_float(w.x & 0xffff0000u), bf2f(w.y & 0xffffu), __uint_as_float(w.y & 0xffff0000u)}; }

#define XB_TMO      128
#define XB_XCNT(j)  (256  + 64 * (j))
#define XB_XSUB(j)  (1280 + 64 * (j))
#define XB_XGEN(j)  (2304 + 64 * (j))
#define XB_TOP      3328
#define XB_TOPGEN   3392
#define XCD_BAR_WORDS 3456
#define XB_SPIN_CAP (1u << 18)
__device__ __forceinline__ unsigned xb_ld(unsigned* p)              { return __hip_atomic_load(p, __ATOMIC_RELAXED, __HIP_MEMORY_SCOPE_AGENT); }
__device__ __forceinline__ unsigned xb_add(unsigned* p, unsigned v) { return __hip_atomic_fetch_add(p, v, __ATOMIC_RELAXED, __HIP_MEMORY_SCOPE_AGENT); }
__device__ __forceinline__ unsigned xb_xcc_id() { return (unsigned)__builtin_amdgcn_s_getreg((3 << 11) | 20) & 0xFu; }
#define XB_SPIN(cond, bar) do { unsigned _sp = 0; while (cond) { __builtin_amdgcn_s_sleep(1); \
    if ((++_sp & 255u) == 0u) { if (xb_ld(&(bar)[XB_TMO])) break; if (_sp > XB_SPIN_CAP) { atomicAdd(&(bar)[XB_TMO], 1u); break; } } } } while (0)
struct XcdBarrier { unsigned* bar; unsigned x; volatile LAS unsigned* st; };
__device__ __forceinline__ XcdBarrier xcd_barrier_post(unsigned* bar, volatile LAS unsigned* st) {
    XcdBarrier b; b.bar = bar; b.x = xb_xcc_id(); b.st = st;
    if (threadIdx.x == 0) (void)xb_add(&bar[XB_XCNT(b.x)], 1u);
    return b;
}
__device__ __forceinline__ void xcd_barrier_complete(unsigned* bar, unsigned x, unsigned& nloc, unsigned& nx) {
    const unsigned G = gridDim.x * gridDim.y * gridDim.z;
    unsigned sum, cnt, mine, sp = 0u;
    for (;;) {
        sum = 0u; cnt = 0u; mine = 0u;
#pragma unroll
        for (unsigned j = 0; j < 16; ++j) { const unsigned c = xb_ld(&bar[XB_XCNT(j)]); sum += c; cnt += (c > 0u) ? 1u : 0u; mine = (j == x) ? c : mine; }
        if (sum == G) break;
        __builtin_amdgcn_s_sleep(1);
        if ((++sp & 255u) == 0u) { if (xb_ld(&bar[XB_TMO])) break; if (sp > XB_SPIN_CAP) { atomicAdd(&bar[XB_TMO], 1u); break; } }
    }
    nloc = mine > 0u ? mine : 1u; nx = cnt > 0u ? cnt : 1u;
}
__device__ __forceinline__ void xcd_barrier(const XcdBarrier& b) {
    asm volatile("s_waitcnt vmcnt(0)" ::: "memory");
    __syncthreads();
    if (threadIdx.x == 0) {
        unsigned* bar = b.bar;
        __builtin_amdgcn_s_waitcnt(0);
        unsigned nloc = b.st[0], nx = b.st[1];
        if (nloc == 0u) { xcd_barrier_complete(bar, b.x, nloc, nx); b.st[0] = nloc; b.st[1] = nx; }
        const unsigned old = xb_add(&bar[XB_XSUB(b.x)], 1u);
        const unsigned gen = old / nloc;
        if (old + 1u == (gen + 1u) * nloc) {
            __builtin_amdgcn_fence(__ATOMIC_RELEASE, "agent");
            asm volatile("s_waitcnt vmcnt(0)" ::: "memory");
            const unsigned og = xb_add(&bar[XB_TOP], 1u);
            const unsigned tg = og / nx;
            if (og + 1u == (tg + 1u) * nx) xb_add(&bar[XB_TOPGEN], 1u);
            else XB_SPIN(xb_ld(&bar[XB_TOPGEN]) == tg, bar);
            __builtin_amdgcn_fence(__ATOMIC_ACQUIRE, "agent");
            xb_add(&bar[XB_XGEN(b.x)], 1u);
            asm volatile("s_waitcnt vmcnt(0)" ::: "memory");
        } else {
            XB_SPIN(xb_ld(&bar[XB_XGEN(b.x)]) == gen, bar);
            __builtin_amdgcn_fence(__ATOMIC_ACQUIRE, "agent");
            asm volatile("s_waitcnt vmcnt(0)" ::: "memory");
        }
    }
    __syncthreads();
}

namespace pg8 {
#define PG8_LAS __attribute__((address_space(3)))
typedef unsigned short bf16_t;
typedef short bf16x8 __attribute__((ext_vector_type(8)));
typedef float f32x4 __attribute__((ext_vector_type(4)));
typedef unsigned u32x4 __attribute__((ext_vector_type(4)));
constexpr int BM = 256, BK = 64, HALF = 128, HTB = HALF * BK * 2  , STAGE_BYTES = 8 * HTB, NXCD = 8, WGM = 8;

__host__ __device__ __forceinline__ int lds_byte(int r, int c) { const int st = (r >> 4) * 2 + (c >> 5), rr = r & 15, cc = c & 31, ob = rr * 64 + cc * 2; return st * 1024 + (ob ^ (((ob >> 9) & 1) << 5)); }
__host__ __device__ __forceinline__ void stage_rc(int b, int& R, int& C) { const int st = b / 1024, sb = b % 1024, swz = sb ^ (((sb >> 9) & 1) << 5); R = (st >> 1) * 16 + swz / 64; C = (st & 1) * 32 + (swz % 64) / 2; }
__host__ __device__ __forceinline__ int perm32(int rho) { const int n = rho >> 4, i = rho & 15; return 8 * (i >> 2) + 4 * n + (i & 3); }

struct Unit { int pm, pn, e; };
struct Gemm { const bf16_t* A; const bf16_t* Bt; int M, N, K; size_t bstride; const int* rid = nullptr; };

struct StaticOrder {
    int nM, nN, nwg, G, c, wgm;
    __host__ __device__ void init(int M, int N, int G_, int c_, int wgm_ = WGM) { nM = M / BM; nN = N / BM; nwg = nM * nN; G = G_; c = c_; wgm = wgm_; }
    __host__ __device__ bool next(int i, Unit& u) const {
        const long L = (long)i * G + c; if (L >= nwg) return false;
        int wgid = (int)L; { const int q = nwg / NXCD, r = nwg % NXCD, xcd = wgid % NXCD, off = wgid / NXCD; wgid = (xcd < r ? xcd * (q + 1) : r * (q + 1) + (xcd - r) * q) + off; }
        const int nig = wgm * nN, gid = wgid / nig, fm = gid * wgm, gsz = (nM - fm) < wgm ? (nM - fm) : wgm;
        u.pm = fm + ((wgid % nig) % gsz); u.pn = (wgid % nig) / gsz; u.e = 0; return true;
    }
    __device__ __forceinline__ void a_ready(const Unit&) const {}
    __device__ __forceinline__ void done(const Unit&) const {}
};

__device__ __forceinline__ unsigned cvt_pk_bf16(float lo, float hi) { unsigned r; asm volatile("v_cvt_pk_bf16_f32 %0, %1, %2" : "=v"(r) : "v"(lo), "v"(hi)); return r; }
typedef float f32x2 __attribute__((ext_vector_type(2)));
__device__ __forceinline__ f32x2 gelu_pk(f32x2 v) {
    const f32x2 av = __builtin_elementwise_abs(v), d = av * 0.2316418882f + 1.0f;
    f32x2 t; t.x = __builtin_amdgcn_rcpf(d.x); t.y = __builtin_amdgcn_rcpf(d.y);
    f32x2 q = t * 0.5307027145f + (-0.7265760135f); q = q * t + 0.7107068705f; q = q * t + (-0.142248368f); q = q * t + 0.127414796f; q = q * t;
    const f32x2 s = (v * v) * (-0.72134752044f);
    f32x2 e; e.x = __builtin_amdgcn_exp2f(s.x); e.y = __builtin_amdgcn_exp2f(s.y);
    const f32x2 m = v * (q * e), r = v - m;
    f32x2 o; o.x = v.x < 0.f ? m.x : r.x; o.y = v.y < 0.f ? m.y : r.y; return o;
}

template <int ACT  > struct EpiBf16 {
    static constexpr bool PERM = true, AFTER_DRAIN = false; static_assert(ACT == 0 || ACT == 1, "EpiBf16: ACT is 0 (none) or 1 (gelu_pk)");
    bf16_t* O; int ldc; const float* bias; int split_cols; size_t split_stride; float scale0;
    __device__ __forceinline__ void operator()(const f32x4 (&acc)[2][2][4][2], const Unit& u, int wr, int wc, int fr, int fq) const {
        const int row0 = u.pm * BM + wr * 64 + fr; int colt = u.pn * BM; bf16_t* base = O;
        float sc = 1.f; if (split_cols) { const int t = colt / split_cols; base += (size_t)t * split_stride; colt -= t * split_cols; if (t == 0) sc = scale0; }
        const int col0 = colt + wc * 32 + 8 * fq, bcol0 = u.pn * BM + wc * 32 + 8 * fq;
        f32x4 bv[2][2];
#pragma unroll
        for (int bj = 0; bj < 2; ++bj)
#pragma unroll
            for (int n = 0; n < 2; ++n) bv[bj][n] = bias ? *(const f32x4*)(bias + bcol0 + bj * HALF + 4 * n) : (f32x4){0.f, 0.f, 0.f, 0.f};
#pragma unroll
        for (int ai = 0; ai < 2; ++ai)
#pragma unroll
            for (int m = 0; m < 4; ++m) { bf16_t* rowp = base + (size_t)(row0 + ai * HALF + m * 16) * ldc + col0;
#pragma unroll
                for (int bj = 0; bj < 2; ++bj) { f32x4 v0 = acc[ai][bj][m][0], v1 = acc[ai][bj][m][1]; if (bias) { v0 += bv[bj][0]; v1 += bv[bj][1]; }
                    if (ACT == 1) { f32x2 a = gelu_pk((f32x2){v0[0], v0[1]}), b = gelu_pk((f32x2){v0[2], v0[3]}), c = gelu_pk((f32x2){v1[0], v1[1]}), d = gelu_pk((f32x2){v1[2], v1[3]});
                        v0 = (f32x4){a.x, a.y, b.x, b.y}; v1 = (f32x4){c.x, c.y, d.x, d.y}; }
                    v0 = v0 * sc; v1 = v1 * sc; u32x4 w; w.x = cvt_pk_bf16(v0[0], v0[1]); w.y = cvt_pk_bf16(v0[2], v0[3]); w.z = cvt_pk_bf16(v1[0], v1[1]); w.w = cvt_pk_bf16(v1[2], v1[3]);
                    *(u32x4*)(rowp + bj * HALF) = w; } }
    }
};

typedef int i32x4 __attribute__((ext_vector_type(4))); typedef int i32x8 __attribute__((ext_vector_type(8)));
__device__ __forceinline__ i32x8 cat16(bf16x8 lo, bf16x8 hi) { const i32x4 a = __builtin_bit_cast(i32x4, lo), b = __builtin_bit_cast(i32x4, hi); return __builtin_shufflevector(a, b, 0, 1, 2, 3, 4, 5, 6, 7); }
template <bool SEL1> __device__ __forceinline__ void mfma_f8_acc(f32x4& acc, const i32x8& b, const i32x8& a, int sc) {
    if constexpr (SEL1) asm volatile("v_mfma_scale_f32_16x16x128_f8f6f4 %0, %1, %2, %0, %3, %3 op_sel:[1,0,0] op_sel_hi:[0,0,0]" : "+v"(acc) : "v"(b), "v"(a), "v"(sc));
    else asm volatile("v_mfma_scale_f32_16x16x128_f8f6f4 %0, %1, %2, %0, %3, %3 op_sel_hi:[0,0,0]" : "+v"(acc) : "v"(b), "v"(a), "v"(sc)); }
constexpr int RID_LDS_OFF = STAGE_BYTES + 1024;
template <class Epi, class Sched, bool ALIGN_EPI = false, bool SP2 = false, bool FP8 = false, bool GA = false>
__device__ __forceinline__ void gemm_phase(PG8_LAS unsigned char* lds, const Gemm g, const Sched& S, const Epi& E) {
    const int tid = threadIdx.x, wid = __builtin_amdgcn_readfirstlane(tid >> 6), lane = tid & 63, wr = wid >> 2, wc = wid & 3, fr = lane & 15, fq = lane >> 4;
    const int K = g.K, nt = K / BK;
    unsigned voffA[2], voffB[2], cbA[2];
#pragma unroll
    for (int i = 0; i < 2; ++i) { int R, C; stage_rc(tid * 16 + i * 8192, R, C); const int Rb = Epi::PERM ? ((R & ~31) + perm32(R & 31)) : R;
        voffA[i] = (unsigned)(R * K + C) * 2u; voffB[i] = (unsigned)(Rb * K + C) * 2u; cbA[i] = (unsigned)C * 2u; }
    unsigned voA[2][2] = {{0u, 0u}, {0u, 0u}};
    const size_t kstep = (size_t)(BK * 2);
    const size_t hstep = (size_t)HALF * K * 2;
    const size_t tstep = 2 * hstep;
    const unsigned ldsw = (unsigned)wid * 1024u;
    const int aoff = lds_byte(wr * 64 + fr, fq * 8), boff = lds_byte(wc * 32 + fr, fq * 8);
    constexpr int KOFF = 1024;
#define PG8_SA(b, h) (((b) * 2 + (h)) * HTB)
#define PG8_SB(b, h) ((4 + (b) * 2 + (h)) * HTB)
#define PG8_STAGE(bufoff, gbase, voff) do { _Pragma("unroll") for (int _i = 0; _i < 2; ++_i) \
        __builtin_amdgcn_global_load_lds((const unsigned*)((const char*)(gbase) + (voff)[_i]), (PG8_LAS unsigned*)(lds + (bufoff) + ldsw + _i * 8192), 16, 0, 0); } while (0)
#define PG8_STAGE_A(bufoff, ptr, h) do { if constexpr (GA) PG8_STAGE(bufoff, ptr, voA[h]); else PG8_STAGE(bufoff, (ptr) + (h) * hstep, voffA); } while (0)
#define PG8_RID_DMA(u_, par) do { if (wid == 0) __builtin_amdgcn_global_load_lds((const unsigned*)(g.rid + (size_t)(u_).pm * BM + lane * 4), (PG8_LAS unsigned*)(lds + RID_LDS_OFF + (par) * 1024), 16, 0, 0); } while (0)
#define PG8_RID_RD(par) do { _Pragma("unroll") for (int h_ = 0; h_ < 2; ++h_) _Pragma("unroll") for (int i_ = 0; i_ < 2; ++i_) \
        voA[h_][i_] = *(const PG8_LAS unsigned*)(lds + RID_LDS_OFF + (par) * 1024 + (h_ * HALF + 16 * ((wid + 8 * i_) >> 1) + (lane >> 2)) * 4) * (unsigned)(K * 2) + cbA[i_]; } while (0)
#define PG8_LDA(dst, b, h) do { _Pragma("unroll") for (int m = 0; m < 4; ++m) _Pragma("unroll") for (int k = 0; k < 2; ++k) dst[m][k] = *(const PG8_LAS bf16x8*)(lds + PG8_SA(b, h) + aoff + m * 2048 + k * KOFF); } while (0)
#define PG8_LDB(dst, b, h) do { _Pragma("unroll") for (int n = 0; n < 2; ++n) _Pragma("unroll") for (int k = 0; k < 2; ++k) dst[n][k] = *(const PG8_LAS bf16x8*)(lds + PG8_SB(b, h) + boff + n * 2048 + k * KOFF); } while (0)
#define PG8_MMA(ai, bj, At, Bt) do { __builtin_amdgcn_s_setprio(1); _Pragma("unroll") for (int m = 0; m < 4; ++m) _Pragma("unroll") for (int n = 0; n < 2; ++n) { \
        if constexpr (FP8) mfma_f8_acc<(Epi::GATE_SCALE && (bj) == 0)>(acc[ai][bj][m][n], cat16(Bt[n][0], Bt[n][1]), cat16(At[m][0], At[m][1]), f8scale); \
        else { _Pragma("unroll") for (int k = 0; k < 2; ++k) acc[ai][bj][m][n] = __builtin_amdgcn_mfma_f32_16x16x32_bf16(Bt[n][k], At[m][k], acc[ai][bj][m][n], 0, 0, 0); } } __builtin_amdgcn_s_setprio(0); } while (0)
#define PG8_WAIT_V(n) asm volatile("s_waitcnt vmcnt(" #n ")" ::: "memory")
#define PG8_WAIT_L(n) asm volatile("s_waitcnt lgkmcnt(" #n ")" ::: "memory")
#define PG8_BAR __builtin_amdgcn_s_barrier()
#define PG8_SCHED __builtin_amdgcn_sched_barrier(0)
    Unit cur, nxt; int ui = 0;
    if (!S.next(0, cur)) return;
    f32x4 acc[2][2][4][2];
#pragma unroll
    for (int a = 0; a < 2; ++a)
#pragma unroll
        for (int b = 0; b < 2; ++b)
#pragma unroll
            for (int m = 0; m < 4; ++m)
#pragma unroll
                for (int n = 0; n < 2; ++n) acc[a][b][m][n] = (f32x4){0.f, 0.f, 0.f, 0.f};
    int f8scale = 0x7F7F7F7F; if constexpr (FP8) { if (Epi::GATE_SCALE) f8scale = 0x7A7A7A7F; } asm volatile("" : "+v"(f8scale));
    bf16x8 At[4][2], B0[2][2], B1[2][2];
    const size_t tstepA = GA ? (size_t)0 : tstep;
    const char* cA = (const char*)g.A + (size_t)cur.pm * tstepA; const char* cB = (const char*)g.Bt + (size_t)cur.pn * tstep + (size_t)cur.e * g.bstride;
    S.a_ready(cur);
    if constexpr (GA) { PG8_RID_DMA(cur, 0); PG8_WAIT_V(0); PG8_BAR; PG8_RID_RD(0); }
    if constexpr (SP2) {
        PG8_STAGE(PG8_SB(0, 0), cB, voffB); PG8_STAGE(PG8_SB(0, 1), cB + hstep, voffB); PG8_STAGE_A(PG8_SA(0, 0), cA, 0); PG8_STAGE_A(PG8_SA(0, 1), cA, 1);
        PG8_STAGE(PG8_SB(1, 0), cB + kstep, voffB); PG8_STAGE_A(PG8_SA(1, 0), cA + kstep, 0); PG8_STAGE(PG8_SB(1, 1), cB + hstep + kstep, voffB);
        if (wr == 1) PG8_BAR;
        PG8_WAIT_V(8); PG8_BAR;
        PG8_WAIT_V(6); PG8_BAR;
    } else {
        static_assert(!GA, "the gathered-A form is written for the SP2 loop");
        PG8_STAGE(PG8_SB(0, 0), cB, voffB); PG8_STAGE(PG8_SA(0, 0), cA, voffA); PG8_STAGE(PG8_SB(0, 1), cB + hstep, voffB); PG8_STAGE(PG8_SA(0, 1), cA + hstep, voffA);
        if (wr == 1) PG8_BAR;
        PG8_WAIT_V(4); PG8_BAR;
        PG8_STAGE(PG8_SB(1, 0), cB + kstep, voffB); PG8_STAGE(PG8_SA(1, 0), cA + kstep, voffA); PG8_STAGE(PG8_SB(1, 1), cB + hstep + kstep, voffB);
        PG8_WAIT_V(6); PG8_BAR;
    }
    for (;;) {
        const bool has_next = S.next(ui + 1, nxt);
        const char* nA = has_next ? (const char*)g.A + (size_t)nxt.pm * tstepA : cA; const char* nB = has_next ? (const char*)g.Bt + (size_t)nxt.pn * tstep + (size_t)nxt.e * g.bstride : cB;
        for (int t = 0; t < nt; t += 2) {
            const bool last = (t == nt - 2);
            const char* a1 = cA + (size_t)(t + 1) * kstep;
            const char* a2 = last ? nA : cA + (size_t)(t + 2) * kstep; const char* b2 = last ? nB : cB + (size_t)(t + 2) * kstep;
            const char* a3 = a2 + kstep; const char* b3 = b2 + kstep;
            if (last && has_next) S.a_ready(nxt);
            if constexpr (GA) { if (t == 0 && has_next) PG8_RID_DMA(nxt, (ui + 1) & 1); }
            if constexpr (SP2) {
            PG8_LDB(B0, 0, 0); PG8_LDB(B1, 0, 1); PG8_SCHED; PG8_LDA(At, 0, 0); PG8_STAGE_A(PG8_SA(1, 1), a1, 1);
            if constexpr (GA) { if (last && has_next) PG8_RID_RD((ui + 1) & 1); }
            PG8_WAIT_V(8); PG8_WAIT_L(0); PG8_BAR; PG8_MMA(0, 0, At, B0); PG8_MMA(0, 1, At, B1); PG8_BAR; PG8_SCHED;
            PG8_LDA(At, 0, 1); PG8_STAGE(PG8_SB(0, 0), b2, voffB); PG8_STAGE(PG8_SB(0, 1), b2 + hstep, voffB); PG8_STAGE_A(PG8_SA(0, 0), a2, 0);
            PG8_WAIT_V(8); PG8_WAIT_L(0); PG8_BAR; PG8_MMA(1, 0, At, B0); PG8_MMA(1, 1, At, B1); PG8_BAR; PG8_SCHED;
            PG8_LDB(B0, 1, 0); PG8_LDB(B1, 1, 1); PG8_SCHED; PG8_LDA(At, 1, 0); PG8_STAGE_A(PG8_SA(0, 1), a2, 1);
            PG8_WAIT_V(8); PG8_WAIT_L(0); PG8_BAR; PG8_MMA(0, 0, At, B0); PG8_MMA(0, 1, At, B1); PG8_BAR; PG8_SCHED;
            PG8_LDA(At, 1, 1); PG8_STAGE(PG8_SB(1, 0), b3, voffB); PG8_STAGE(PG8_SB(1, 1), b3 + hstep, voffB); PG8_STAGE_A(PG8_SA(1, 0), a3, 0);
            PG8_WAIT_V(8); PG8_WAIT_L(0); PG8_BAR; PG8_MMA(1, 0, At, B0); PG8_MMA(1, 1, At, B1); PG8_BAR; PG8_SCHED;
            } else {
            PG8_LDB(B0, 0, 0); PG8_SCHED; PG8_LDA(At, 0, 0); PG8_STAGE(PG8_SA(1, 1), a1 + hstep, voffA);
            PG8_WAIT_L(8); PG8_BAR; PG8_WAIT_L(0); PG8_MMA(0, 0, At, B0); PG8_BAR; PG8_SCHED;
            PG8_LDB(B1, 0, 1); PG8_STAGE(PG8_SB(0, 0), b2, voffB);
            PG8_BAR; PG8_WAIT_L(0); PG8_MMA(0, 1, At, B1); PG8_BAR;
            PG8_LDA(At, 0, 1); PG8_STAGE(PG8_SA(0, 0), a2, voffA);
            PG8_BAR; PG8_WAIT_L(0); PG8_MMA(1, 0, At, B0); PG8_BAR; PG8_SCHED;
            PG8_STAGE(PG8_SB(0, 1), b2 + hstep, voffB);
            PG8_WAIT_V(6); PG8_BAR; PG8_MMA(1, 1, At, B1); PG8_BAR;
            PG8_LDB(B0, 1, 0); PG8_SCHED; PG8_LDA(At, 1, 0); PG8_STAGE(PG8_SA(0, 1), a2 + hstep, voffA);
            PG8_WAIT_L(8); PG8_BAR; PG8_WAIT_L(0); PG8_MMA(0, 0, At, B0); PG8_BAR; PG8_SCHED;
            PG8_LDB(B1, 1, 1); PG8_STAGE(PG8_SB(1, 0), b3, voffB);
            PG8_BAR; PG8_WAIT_L(0); PG8_MMA(0, 1, At, B1); PG8_BAR;
            PG8_LDA(At, 1, 1); PG8_STAGE(PG8_SA(1, 0), a3, voffA);
            PG8_BAR; PG8_WAIT_L(0); PG8_MMA(1, 0, At, B0); PG8_BAR; PG8_SCHED;
            PG8_STAGE(PG8_SB(1, 1), b3 + hstep, voffB);
            PG8_WAIT_V(6); PG8_BAR; PG8_MMA(1, 1, At, B1); PG8_BAR;
            }
        }
        if constexpr (ALIGN_EPI) { if (wr == 0) PG8_BAR; }
        if constexpr (FP8) asm volatile("s_nop 15\n\ts_nop 15" : "+v"(acc[1][1][0][0]), "+v"(acc[1][1][0][1]), "+v"(acc[1][1][1][0]), "+v"(acc[1][1][1][1]), "+v"(acc[1][1][2][0]), "+v"(acc[1][1][2][1]), "+v"(acc[1][1][3][0]), "+v"(acc[1][1][3][1]));
        if constexpr (!Epi::AFTER_DRAIN) { E(acc, cur, wr, wc, fr, fq); S.done(cur); }
        if (!has_next) break;
#pragma unroll
        for (int a = 0; a < 2; ++a)
#pragma unroll
            for (int b = 0; b < 2; ++b)
#pragma unroll
                for (int m = 0; m < 4; ++m)
#pragma unroll
                    for (int n = 0; n < 2; ++n) acc[a][b][m][n] = (f32x4){0.f, 0.f, 0.f, 0.f};
        cur = nxt; cA = nA; cB = nB; ++ui;
        if constexpr (ALIGN_EPI) { if (wr == 1) PG8_BAR; }
    }
    PG8_WAIT_V(0);
    if constexpr (!ALIGN_EPI) { if (wr == 0) PG8_BAR; }
    PG8_BAR;
    if constexpr (Epi::AFTER_DRAIN) { E.fused(acc, cur, wr, wc, fr, fq, lds, wid, lane); S.done(cur); }
#undef PG8_SA
#undef PG8_SB
#undef PG8_STAGE
#undef PG8_LDA
#undef PG8_STAGE_A
#undef PG8_RID_DMA
#undef PG8_RID_RD
#undef PG8_LDB
#undef PG8_MMA
#undef PG8_WAIT_V
#undef PG8_WAIT_L
#undef PG8_BAR
#undef PG8_SCHED
}
}

namespace pg8 {
struct EpiF32P {
    static constexpr bool PERM = false, AFTER_DRAIN = false;
    float* O; int ldc;
    __device__ __forceinline__ void operator()(const f32x4 (&acc)[2][2][4][2], const Unit& u, int wr, int wc, int fr, int fq) const {
        const int row0 = u.pm * BM + wr * 64 + fr, col0 = u.pn * BM + wc * 32 + 4 * fq;
#pragma unroll
        for (int ai = 0; ai < 2; ++ai)
#pragma unroll
            for (int m = 0; m < 4; ++m) { float* rowp = O + (size_t)(row0 + ai * HALF + m * 16) * ldc + col0;
#pragma unroll
                for (int bj = 0; bj < 2; ++bj)
#pragma unroll
                    for (int n = 0; n < 2; ++n) *(f32x4*)(rowp + bj * HALF + n * 16) = acc[ai][bj][m][n]; }
    }
};
struct EpiSwigluP {
    static constexpr bool PERM = true, AFTER_DRAIN = false;
    bf16_t* O; int ldc;
    __device__ __forceinline__ void operator()(const f32x4 (&acc)[2][2][4][2], const Unit& u, int wr, int wc, int fr, int fq) const {
        const int row0 = u.pm * BM + wr * 64 + fr, col0 = u.pn * HALF + wc * 32 + 8 * fq;
#pragma unroll
        for (int ai = 0; ai < 2; ++ai)
#pragma unroll
            for (int m = 0; m < 4; ++m) {
                float h[8];
#pragma unroll
                for (int n = 0; n < 2; ++n)
#pragma unroll
                    for (int j = 0; j < 4; ++j) { const float g = acc[ai][0][m][n][j], up = acc[ai][1][m][n][j];
                        h[4 * n + j] = g * up * __builtin_amdgcn_rcpf(1.0f + __builtin_amdgcn_exp2f(-1.4426950408889634f * g)); }
                u32x4 w; w.x = cvt_pk_bf16(h[0], h[1]); w.y = cvt_pk_bf16(h[2], h[3]); w.z = cvt_pk_bf16(h[4], h[5]); w.w = cvt_pk_bf16(h[6], h[7]);
                *(u32x4*)(O + (size_t)(row0 + ai * HALF + m * 16) * ldc + col0) = w; }
    }
};
struct EpiGateP {
    static constexpr bool PERM = true, AFTER_DRAIN = false;
    bf16_t* O; int ldc; const float* gate;
    __device__ __forceinline__ void operator()(const f32x4 (&acc)[2][2][4][2], const Unit& u, int wr, int wc, int fr, int fq) const {
        const int row0 = u.pm * BM + wr * 64 + fr, col0 = u.pn * BM + wc * 32 + 8 * fq;
#pragma unroll
        for (int ai = 0; ai < 2; ++ai)
#pragma unroll
            for (int m = 0; m < 4; ++m) { const int row = row0 + ai * HALF + m * 16; const float gt = gate[row]; bf16_t* rowp = O + (size_t)row * ldc + col0;
#pragma unroll
                for (int bj = 0; bj < 2; ++bj) { const f32x4 v0 = acc[ai][bj][m][0] * gt, v1 = acc[ai][bj][m][1] * gt;
                    u32x4 w; w.x = cvt_pk_bf16(v0[0], v0[1]); w.y = cvt_pk_bf16(v0[2], v0[3]); w.z = cvt_pk_bf16(v1[0], v1[1]); w.w = cvt_pk_bf16(v1[2], v1[3]);
                    *(u32x4*)(rowp + bj * HALF) = w; } }
    }
};
__device__ __forceinline__ unsigned pk4_fp8(float a, float b, float c, float d) {
    int w = 0; w = __builtin_amdgcn_cvt_pk_fp8_f32(a, b, w, false); w = __builtin_amdgcn_cvt_pk_fp8_f32(c, d, w, true); return (unsigned)w; }
struct EpiSwigluF8 {
    static constexpr bool PERM = true, AFTER_DRAIN = false, GATE_SCALE = true;
    unsigned char* O; int ldc; float ws, hs;
    __device__ __forceinline__ void operator()(const f32x4 (&acc)[2][2][4][2], const Unit& u, int wr, int wc, int fr, int fq) const {
        const float ck = 1.4426950408889634f / (ws * hs);
        const int row0 = u.pm * BM + wr * 64 + fr, col0 = u.pn * HALF + wc * 32 + 8 * fq;
#pragma unroll
        for (int ai = 0; ai < 2; ++ai)
#pragma unroll
            for (int m = 0; m < 4; ++m) {
                float h[8];
#pragma unroll
                for (int n = 0; n < 2; ++n) {
                    const f32x4 ag4 = acc[ai][0][m][n], au4 = acc[ai][1][m][n]; f32x4 e4, r4;
#pragma unroll
                    for (int j = 0; j < 4; ++j) e4[j] = __builtin_amdgcn_exp2f(-ag4[j]);
                    const f32x4 d4 = e4 * ck + ck;
#pragma unroll
                    for (int j = 0; j < 4; ++j) r4[j] = __builtin_amdgcn_rcpf(d4[j]);
                    f32x4 h4;
                    { f32x2 p0, p1, q0, q1; const f32x2 g0 = {ag4[0], ag4[1]}, g1 = {ag4[2], ag4[3]}, u0 = {au4[0], au4[1]}, u1 = {au4[2], au4[3]}, r0 = {r4[0], r4[1]}, r1 = {r4[2], r4[3]};
                      asm("v_pk_mul_f32 %0, %1, %2" : "=v"(p0) : "v"(g0), "v"(u0)); asm("v_pk_mul_f32 %0, %1, %2" : "=v"(p1) : "v"(g1), "v"(u1));
                      asm("s_nop 1\n\tv_pk_mul_f32 %0, %1, %2" : "=v"(q0) : "v"(p0), "v"(r0)); asm("s_nop 1\n\tv_pk_mul_f32 %0, %1, %2" : "=v"(q1) : "v"(p1), "v"(r1));
                      h4 = (f32x4){q0[0], q0[1], q1[0], q1[1]}; }
#pragma unroll
                    for (int j = 0; j < 4; ++j) h[4 * n + j] = h4[j]; }
                typedef unsigned u32x2 __attribute__((ext_vector_type(2)));
                *(u32x2*)(O + (size_t)(row0 + ai * HALF + m * 16) * ldc + col0) = (u32x2){pk4_fp8(h[0], h[1], h[2], h[3]), pk4_fp8(h[4], h[5], h[6], h[7])}; }
    }
};
struct EpiGateS {
    static constexpr bool PERM = true, AFTER_DRAIN = false, GATE_SCALE = false;
    unsigned char* O; int ldc; const float* gate; float sc;
    __device__ __forceinline__ void operator()(const f32x4 (&acc)[2][2][4][2], const Unit& u, int wr, int wc, int fr, int fq) const {
        const int row0 = u.pm * BM + wr * 64 + fr, col0 = u.pn * BM + wc * 32 + 8 * fq;
        float gts[2][4];
#pragma unroll
        for (int ai = 0; ai < 2; ++ai)
#pragma unroll
            for (int m = 0; m < 4; ++m) gts[ai][m] = gate[row0 + ai * HALF + m * 16];
        typedef unsigned u32x2 __attribute__((ext_vector_type(2)));
#pragma unroll
        for (int ai = 0; ai < 2; ++ai)
#pragma unroll
            for (int m = 0; m < 4; ++m) { const int row = row0 + ai * HALF + m * 16; const float gt = gts[ai][m] * sc; unsigned char* rowp = O + (size_t)row * ldc + col0;
#pragma unroll
                for (int bj = 0; bj < 2; ++bj) { const f32x4 v0 = acc[ai][bj][m][0] * gt, v1 = acc[ai][bj][m][1] * gt;
                    *(u32x2*)(rowp + bj * HALF) = (u32x2){pk4_fp8(v0[0], v0[1], v0[2], v0[3]), pk4_fp8(v1[0], v1[1], v1[2], v1[3])}; } }
    }
};
struct EpiQKV {
    static constexpr bool PERM = true, AFTER_DRAIN = false;
    bf16_t* O; int ldc; const float* rope; const float* qn; const float* kn; float qscale; float rms_eps;
    __device__ __forceinline__ void operator()(const f32x4 (&acc)[2][2][4][2], const Unit& u, int wr, int wc, int fr, int fq) const {
        const int hs = 4 * u.pn + wc;
        const bool isq = hs < 8 || (hs >= 24 && hs < 32), isk = (hs >= 8 && hs < 16) || hs == 32 || hs == 33, nrm = hs >= 24 && hs < 34;
        const bool rope_on = (isq || isk) && u.pm < 64;
        const float osc = isq ? qscale : 1.f;
        const bool first = fq < 2;
        f32x4 gv[2][2];
#pragma unroll
        for (int bj = 0; bj < 2; ++bj)
#pragma unroll
            for (int n = 0; n < 2; ++n) gv[bj][n] = nrm ? *(const f32x4*)((hs < 32 ? qn : kn) + 32 * bj + 8 * fq + 4 * n) : (f32x4){1.f, 1.f, 1.f, 1.f};
#pragma unroll
        for (int ai = 0; ai < 2; ++ai)
#pragma unroll
            for (int m = 0; m < 4; ++m) {
                const int row = u.pm * BM + ai * HALF + wr * 64 + m * 16 + fr;
                f32x4 v[2][2];
#pragma unroll
                for (int bj = 0; bj < 2; ++bj)
#pragma unroll
                    for (int n = 0; n < 2; ++n) v[bj][n] = acc[ai][bj][m][n];
                if (nrm) {
                    float ss = 0.f;
#pragma unroll
                    for (int bj = 0; bj < 2; ++bj)
#pragma unroll
                        for (int n = 0; n < 2; ++n) ss += (v[bj][n][0] * v[bj][n][0] + v[bj][n][1] * v[bj][n][1]) + (v[bj][n][2] * v[bj][n][2] + v[bj][n][3] * v[bj][n][3]);
                    ss += __shfl_xor(ss, 16); ss += __shfl_xor(ss, 32);
                    const float r = __builtin_amdgcn_rsqf(ss * (1.f / 64.f) + rms_eps);
#pragma unroll
                    for (int bj = 0; bj < 2; ++bj)
#pragma unroll
                        for (int n = 0; n < 2; ++n) v[bj][n] = v[bj][n] * r * gv[bj][n];
                }
                if (rope_on) {
                    const int t = row & 2047;
#pragma unroll
                    for (int bj = 0; bj < 2; ++bj) {
                        const int pos = bj ? (t & 63) : (t >> 6);
#pragma unroll
                        for (int n = 0; n < 2; ++n) {
                            const float* cp = rope + (size_t)(pos * 16 + 8 * (fq & 1) + 4 * n) * 2;
                            const f32x4 c01 = *(const f32x4*)cp, c23 = *(const f32x4*)(cp + 4);
                            const float cs[4] = {c01[0], c01[2], c23[0], c23[2]}, sn[4] = {c01[1], c01[3], c23[1], c23[3]};
#pragma unroll
                            for (int j = 0; j < 4; ++j) { const float x = v[bj][n][j], pr = __shfl_xor(x, 32); v[bj][n][j] = first ? x * cs[j] - pr * sn[j] : x * cs[j] + pr * sn[j]; }
                        }
                    }
                }
                bf16_t* rowp = O + (size_t)row * ldc + hs * 64 + 8 * fq;
#pragma unroll
                for (int bj = 0; bj < 2; ++bj) { const f32x4 v0 = v[bj][0] * osc, v1 = v[bj][1] * osc;
                    u32x4 w; w.x = cvt_pk_bf16(v0[0], v0[1]); w.y = cvt_pk_bf16(v0[2], v0[3]); w.z = cvt_pk_bf16(v1[0], v1[1]); w.w = cvt_pk_bf16(v1[2], v1[3]);
                    *(u32x4*)(rowp + 32 * bj) = w; }
            }
    }
};
struct GroupedOrder {
    int nMe, nN, ntot, G, c;
    __device__ void init(int nMe_, int nN_, int ne, int G_, int c_) { nMe = nMe_; nN = nN_; ntot = nMe_ * nN_ * ne; G = G_; c = c_; }
    __device__ bool next(int i, Unit& u) const {
        const int L = i * G + c; if (L >= ntot) return false;
        const int per = nMe * nN, e = L / per, rem = L - e * per;
        u.e = e; u.pn = rem / nMe; u.pm = e * nMe + (rem - u.pn * nMe); return true;
    }
    __device__ __forceinline__ void a_ready(const Unit&) const {}
    __device__ __forceinline__ void done(const Unit&) const {}
};
struct L1InOrder {
    StaticOrder so; int G, c;
    __device__ void init(int G_, int c_) { so.init(16384, 2048, G_, 0, G_ == 184 ? 3 : WGM); G = G_; c = c_; }
    __device__ bool next(int i, Unit& u) const {
        const int L = i * G + c;
        if (L < 512) { StaticOrder t = so; t.G = 1; t.c = 0; return t.next(L, u); }
        if (L < 544) { const int l = L - 512; u.pm = 64 + (l >> 2); u.pn = 2 + (l & 3); u.e = 0; return true; }
        return false;
    }
    __device__ __forceinline__ void a_ready(const Unit&) const {}
    __device__ __forceinline__ void done(const Unit&) const {}
};
}

#include <hip/hip_bf16.h>
#include <cmath>
namespace attn_body {
using bf16=__hip_bfloat16;
using bf16x8=__attribute__((ext_vector_type(8)))short;
using s16x4=__attribute__((ext_vector_type(4)))short;
using f32x16=__attribute__((ext_vector_type(16)))float;
using u32x4=__attribute__((ext_vector_type(4)))unsigned;
constexpr int D=64,OPITCH=1024;
constexpr int NW=8,QBLK=32,QB=QBLK*NW,KVBLK=64;
__device__ __forceinline__ int crow(int r,int hi){return (r&3)+8*(r>>2)+4*hi;}
#define SBAR() __builtin_amdgcn_sched_barrier(0)
__device__ __forceinline__ void cmask(f32x16&p0,f32x16&p1,int jb,int qrel,int hi){
  const float NEG=-INFINITY; int kb=64*jb+4*hi;
  #pragma unroll
  for(int r=0;r<16;++r){int kv=kb+(r&3)+8*(r>>2); if(kv>qrel)p0[r]=NEG; if(kv+32>qrel)p1[r]=NEG;}
}

constexpr int NSLOT=3, SLOTB=8192;
constexpr int LDS_K=0, LDS_V=NSLOT*SLOTB, LDS_WS=2*NSLOT*SLOTB, LDS_OST=LDS_WS+NW*64*4, LDS_BYTES=LDS_OST+NW*4096;
constexpr float C2=0.125f*1.4426950408889634f;
__device__ __forceinline__ void glds16(const void*gsrc,unsigned lds_dst){unsigned keep;
  asm volatile("s_mov_b32 %0, m0\n\ts_mov_b32 m0, %2\n\ts_nop 0\n\tglobal_load_lds_dwordx4 %1, off\n\ts_mov_b32 m0, %0":"=&s"(keep):"v"(gsrc),"s"(lds_dst):"memory");}
__device__ __forceinline__ float max3f(float a,float b,float c){float r;asm("v_max3_f32 %0, %1, %2, %3":"=v"(r):"v"(a),"v"(b),"v"(c));return r;}
__device__ __forceinline__ float max2f(float a,float b){float r;asm("v_max_f32_e32 %0, %1, %2":"=v"(r):"v"(a),"v"(b));return r;}
__device__ __forceinline__ float fadd_s(float a,float b){float r;asm("v_add_f32_e32 %0, %1, %2":"=v"(r):"v"(a),"v"(b));return r;}
__device__ __forceinline__ float fsub_s(float a,float b){float r;asm("v_sub_f32_e32 %0, %1, %2":"=v"(r):"v"(a),"v"(b));return r;}
typedef float f32x2_t __attribute__((ext_vector_type(2))); typedef __bf16 bf16x2_t __attribute__((ext_vector_type(2)));
__device__ __forceinline__ unsigned cvtpk_s(float lo,float hi){f32x2_t v={lo,hi};bf16x2_t b=__builtin_convertvector(v,bf16x2_t);return __builtin_bit_cast(unsigned,b);}
#define WAIT_BAR(N) asm volatile("s_waitcnt vmcnt(" #N ") lgkmcnt(0)\n\ts_barrier":::"memory")

__device__ __forceinline__ void qkt(f32x16&p0,f32x16&p1,const char*Kslot,const bf16x8*qr,const f32x16&negm,int r32,int hi){
  const char*kb=Kslot+hi*1024+r32*16;
  #pragma unroll
  for(int d0=0;d0<4;++d0){
    const bf16x8 b0=*reinterpret_cast<const bf16x8*>(kb+d0*2048);
    const bf16x8 b1=*reinterpret_cast<const bf16x8*>(kb+d0*2048+512);
    if(d0==0){p0=__builtin_amdgcn_mfma_f32_32x32x16_bf16(b0,qr[0],negm,0,0,0);p1=__builtin_amdgcn_mfma_f32_32x32x16_bf16(b1,qr[0],negm,0,0,0);}
    else{p0=__builtin_amdgcn_mfma_f32_32x32x16_bf16(b0,qr[d0],p0,0,0,0);p1=__builtin_amdgcn_mfma_f32_32x32x16_bf16(b1,qr[d0],p1,0,0,0);}}
}
typedef __attribute__((address_space(3))) const char* lds_cptr;
typedef short v4i16_t __attribute__((ext_vector_type(4)));
__device__ __forceinline__ void kload8(bf16x8*kf,lds_cptr kp){
  kf[0]=*(const __attribute__((address_space(3))) bf16x8*)(kp);      kf[1]=*(const __attribute__((address_space(3))) bf16x8*)(kp+512);
  kf[2]=*(const __attribute__((address_space(3))) bf16x8*)(kp+2048); kf[3]=*(const __attribute__((address_space(3))) bf16x8*)(kp+2560);
  kf[4]=*(const __attribute__((address_space(3))) bf16x8*)(kp+4096); kf[5]=*(const __attribute__((address_space(3))) bf16x8*)(kp+4608);
  kf[6]=*(const __attribute__((address_space(3))) bf16x8*)(kp+6144); kf[7]=*(const __attribute__((address_space(3))) bf16x8*)(kp+6656);
}
__device__ __forceinline__ void kload2(bf16x8*kf,lds_cptr kp,int j){ kf[2*j]=*(const __attribute__((address_space(3))) bf16x8*)(kp+j*2048); kf[2*j+1]=*(const __attribute__((address_space(3))) bf16x8*)(kp+j*2048+512); }
__device__ __forceinline__ s16x4 vtr(lds_cptr p){ return __builtin_bit_cast(s16x4,__builtin_amdgcn_ds_read_tr16_b64_v4i16((__attribute__((address_space(3))) v4i16_t*)p)); }
__device__ __forceinline__ float rowmax(const f32x16&p0,const f32x16&p1){
  float a=max3f(p0[0],p0[1],p1[0]),b=max3f(p0[2],p0[3],p1[1]);a=max3f(a,p1[2],p1[3]);
  #pragma unroll
  for(int r=4;r<16;r+=4){a=max3f(a,p0[r],p0[r+1]);b=max3f(b,p0[r+2],p0[r+3]);a=max3f(a,p1[r],p1[r+1]);b=max3f(b,p1[r+2],p1[r+3]);}
  const float m=max2f(a,b);
  auto rr=__builtin_amdgcn_permlane32_swap(__float_as_uint(m),__float_as_uint(m),false,false);
  return max2f(__uint_as_float(rr[0]),__uint_as_float(rr[1]));
}
__device__ __forceinline__ void pv(f32x16*o,int vb,bf16x8 pa0,bf16x8 pa1,bf16x8 pa2,bf16x8 pa3){
  #pragma unroll
  for(int d0=0;d0<2;++d0){s16x4 lo[4],hi[4];
    #pragma unroll
    for(int ks=0;ks<4;++ks){
      asm volatile("ds_read_b64_tr_b16 %0,%1 offset:%c2":"=&v"(lo[ks]):"v"(vb),"i"(d0*4096+ks*1024):"memory");
      asm volatile("ds_read_b64_tr_b16 %0,%1 offset:%c2":"=&v"(hi[ks]):"v"(vb),"i"(d0*4096+ks*1024+512):"memory");}
    asm volatile("s_waitcnt lgkmcnt(0)":::"memory");SBAR();
    #define PK(k) (bf16x8){lo[k][0],lo[k][1],lo[k][2],lo[k][3],hi[k][0],hi[k][1],hi[k][2],hi[k][3]}
    o[d0]=__builtin_amdgcn_mfma_f32_32x32x16_bf16(pa0,PK(0),o[d0],0,0,0);
    o[d0]=__builtin_amdgcn_mfma_f32_32x32x16_bf16(pa1,PK(1),o[d0],0,0,0);
    o[d0]=__builtin_amdgcn_mfma_f32_32x32x16_bf16(pa2,PK(2),o[d0],0,0,0);
    o[d0]=__builtin_amdgcn_mfma_f32_32x32x16_bf16(pa3,PK(3),o[d0],0,0,0);
    #undef PK
  }
}

#ifndef ATTN_STORE16
#define ATTN_STORE16(p,v) (*(u32x4*)(p)=(v))
#endif
struct AU { const bf16* Qp; const bf16* Kp; const bf16* Vp; bf16* Op; int qrow0, lat_row0, ctx_row0, nlat_t, NT; };
struct NoMask { __device__ __forceinline__ void apply(f32x16&,f32x16&,int,int)const{} };
typedef __attribute__((address_space(3))) const float* lds_cfptr;
struct NAMask { lds_cfptr tb0; int r, rs, rs_min, cb;
  __device__ __forceinline__ void apply(f32x16&p0,f32x16&p1,int t,int hi)const{
    if(t<4)return;
    const int kr=rs_min+t-4; const float NEG=-INFINITY;
    if((unsigned)(kr-rs)>7u){
      #pragma unroll
      for(int i=0;i<16;++i){p0[i]=NEG;p1[i]=NEG;}
      return; }
    const lds_cfptr tb=tb0+(kr-r+7)*32+4*hi;
    { float b[16];
      #pragma unroll
      for(int i=0;i<16;++i) b[i]=tb[(i&3)+8*(i>>2)];
      #pragma unroll
      for(int i=0;i<16;++i) asm volatile("" : "+v"(b[i]));
      #pragma unroll
      for(int i=0;i<16;++i){ const int d0=cb+(i&3)+8*(i>>2); const float t=p0[i]+b[i]; p0[i]=((unsigned)d0<=15u)?t:NEG; } }
    { float b[16];
      #pragma unroll
      for(int i=0;i<16;++i) b[i]=tb[(i&3)+8*(i>>2)+32];
      #pragma unroll
      for(int i=0;i<16;++i) asm volatile("" : "+v"(b[i]));
      #pragma unroll
      for(int i=0;i<16;++i){ const int d1=cb+(i&3)+8*(i>>2)+32; const float t=p1[i]+b[i]; p1[i]=((unsigned)d1<=15u)?t:NEG; } }
  }
};
template<int THRL,int PITCH,class MaskT,int VD=1> __device__ __forceinline__ void attn_unit(const AU& u,char*shm,const MaskT& mk){
  constexpr int L_WS=LDS_V+NSLOT*SLOTB*VD, L_OST=L_WS+NW*64*4;
  const int tid=threadIdx.x,lane=tid&63,r32=lane&31,hi=lane>>5; const int wid=__builtin_amdgcn_readfirstlane(tid>>6);
  const bf16*Qw=u.Qp+(long)(u.qrow0+wid*QBLK)*PITCH;
  const bf16*Kh=u.Kp,*Vh=u.Vp;
  const unsigned lds0=(unsigned)(uintptr_t)shm;
  float*wsf=(float*)(shm+L_WS)+wid*64;
  const bf16*ksrc=Kh+(long)lane*PITCH+wid*8;
  const bf16*vsrc=Vh+(long)(16*(wid&3)+(lane>>2))*PITCH+(wid>>2)*32+(lane&3)*8;
  const unsigned kdst=lds0+LDS_K+wid*1024, vdst=lds0+LDS_V+wid*1024;
  #define TROW(t) ((long)((t)<u.nlat_t?u.lat_row0+KVBLK*(t):u.ctx_row0+KVBLK*((t)-u.nlat_t))*PITCH)
  #define DMA_K(t,slot) glds16(ksrc+TROW(t),(unsigned)__builtin_amdgcn_readfirstlane(kdst+(slot)))
  #define DMA_V(t,slot) do{ glds16(vsrc+TROW(t),(unsigned)__builtin_amdgcn_readfirstlane(vdst+VD*(slot))); if constexpr(VD==2) glds16(vsrc+64+TROW(t),(unsigned)__builtin_amdgcn_readfirstlane(vdst+VD*(slot)+8192)); }while(0)
  const int vb0=(int)(lds0+LDS_V)+((lane>>4)&1)*32+(lane&3)*8+(4*hi+((lane&15)>>2))*64;
  const char*Kbase=shm+LDS_K; bf16x8 kf[8];
  const lds_cptr shm3=(lds_cptr)shm; const lds_cptr kp0=shm3+LDS_K+hi*1024+r32*16; const lds_cptr vp0=shm3+LDS_V+((lane>>4)&1)*32+(lane&3)*8+(4*hi+((lane&15)>>2))*64;
  const int NT=u.NT;
  bf16x8 qr[4];
  #pragma unroll
  for(int d0=0;d0<4;++d0)qr[d0]=*reinterpret_cast<const bf16x8*>(&Qw[(long)r32*PITCH+d0*16+hi*8]);
  DMA_K(0,0);DMA_V(0,0);DMA_K(1,SLOTB);
  typedef __attribute__((address_space(3))) bf16x8* lds_qptr;
  const lds_qptr qls=(lds_qptr)((lds_cptr)shm+L_OST+wid*4096+lane*16);
  if constexpr(VD==2){
    #pragma unroll
    for(int d0=0;d0<4;++d0)qls[d0*64]=qr[d0];
  }
  #define QF(d0) (VD==2?*(const __attribute__((address_space(3))) bf16x8*)(qls+(d0)*64):qr[d0])
  float mhat=0.f,l_reg=0.f;f32x16 o[2*VD];
  #pragma unroll
  for(int d_=0;d_<2*VD;++d_)o[d_]=f32x16{};
  f32x16 negm=f32x16{}; if constexpr(VD==1) asm volatile("":"+v"(negm));
  #define CMASK(P0,P1,t) mk.apply(P0,P1,(t),hi)
  bool resc=false;
  #define START(P0,P1) do{ const float rm=rowmax(P0,P1); resc=false; \
    { const float dl=rm; mhat=fadd_s(mhat,dl); \
      _Pragma("unroll") for(int r=0;r<16;++r){P0[r]=fsub_s(P0[r],dl);P1[r]=fsub_s(P1[r],dl);} \
      if constexpr(VD==1){ _Pragma("unroll") for(int r=0;r<16;++r)negm[r]=-mhat; asm volatile("":"+v"(negm)); } } \
    _Pragma("unroll") for(int r=0;r<16;++r)P0[r]=__builtin_amdgcn_exp2f(P0[r]); }while(0)
  #define RESC() do{ if(resc){ asm volatile("s_waitcnt lgkmcnt(0)":::"memory"); \
      _Pragma("unroll") for(int d_=0;d_<2*VD;++d_) _Pragma("unroll") for(int r=0;r<16;++r)o[d_][r]*=wsf[crow(r,hi)]; } }while(0)
  f32x16 pA0,pA1,pB0,pB1;
  int sl_prev=0,sl_cur=0,sl_next=SLOTB;
  #define ROT() do{sl_prev=sl_cur;sl_cur=sl_next;sl_next=(sl_next==(NSLOT-1)*SLOTB)?0:sl_next+SLOTB;}while(0)
  DMA_K(2,2*SLOTB);
  if constexpr(VD==2){WAIT_BAR(4);}else{WAIT_BAR(3);}
  qkt(pA0,pA1,Kbase,qr,negm,r32,hi);asm volatile("s_nop 15\n\ts_nop 7":"+v"(pA0),"+v"(pA1));CMASK(pA0,pA1,0);
  START(pA0,pA1);
  _Pragma("unroll") for(int r=0;r<16;++r)pA1[r]=__builtin_amdgcn_exp2f(pA1[r]);
  WAIT_BAR(0);
  DMA_K(3,0);DMA_V(1,SLOTB);
  ROT();
  kload8(kf,kp0+sl_cur);
  if constexpr(VD==2){WAIT_BAR(3);}else{WAIT_BAR(2);}
  s16x4 vlo[8],vhi[8]; u32x4 pw0,pw1,pw2,pw3;
  #define PKW(P,B) cvtpk_s(P[B],P[B+1])
  #define PAF(k) __builtin_bit_cast(bf16x8,pw##k)
  #define VFR(i) (bf16x8){vlo[i][0],vlo[i][1],vlo[i][2],vlo[i][3],vhi[i][0],vhi[i][1],vhi[i][2],vhi[i][3]}
  #define PIN(x) asm volatile("":"+v"(x))
  #define MX3(a,b,c) __builtin_fmaxf(__builtin_fmaxf((a),(b)),(c))
  #define GAPA(MF,A0,A1,A2,A3,W0,W1,PW) do{ MF; sacc+=A0; sacc+=A1; sacc+=A2; sacc+=A3; PIN(sacc); W0; W1; PIN(PW); SBAR(); }while(0)
  #define EX(v) __builtin_amdgcn_exp2f(v)
  #define GAPB(MF,X,B) do{ MF; X[B]=EX(X[B]); X[B+1]=EX(X[B+1]); X[B+2]=EX(X[B+2]); X[B+3]=EX(X[B+3]); PIN(X); SBAR(); }while(0)
  #define VRD(i) do{ vlo[i]=vtr(vp_+(((i)>>2)*4096+((i)&3)*1024)); vhi[i]=vtr(vp_+(((i)>>2)*4096+((i)&3)*1024+512)); }while(0)
  #define VRDH(i) do{ if constexpr(VD==2){ vlo[i]=vtr(vp_+8192+(((i)>>2)*4096+((i)&3)*1024)); vhi[i]=vtr(vp_+8192+(((i)>>2)*4096+((i)&3)*1024+512)); SBAR(); } }while(0)
  #define KRD(G,j) do{ if(G){ kload2(kf,kp0+sl_next,j); SBAR(); } }while(0)
  #define STEP(C0,C1,P0,P1,t,GK,GV,GL) do{ SBAR(); \
    const lds_cptr vp_=vp0+VD*sl_prev; \
    VRD(0); SBAR(); float sacc=(P0[0]+P0[1]); \
    GAPA(C0=__builtin_amdgcn_mfma_f32_32x32x16_bf16(kf[0],QF(0),negm,0,0,0), P0[2],P0[3],P0[4],P0[5],     pw0[0]=PKW(P0,0), pw0[1]=PKW(P0,2), pw0); \
    VRD(4); SBAR(); GAPA(C1=__builtin_amdgcn_mfma_f32_32x32x16_bf16(kf[1],QF(0),negm,0,0,0), P0[6],P0[7],P0[8],P0[9],     pw0[2]=PKW(P0,4), pw0[3]=PKW(P0,6), pw0); \
    VRD(1); SBAR(); GAPA(C0=__builtin_amdgcn_mfma_f32_32x32x16_bf16(kf[2],QF(1),C0,0,0,0),   P0[10],P0[11],P0[12],P0[13], pw1[0]=PKW(P0,8), pw1[1]=PKW(P0,10), pw1); \
    VRD(5); SBAR(); GAPA(C1=__builtin_amdgcn_mfma_f32_32x32x16_bf16(kf[3],QF(1),C1,0,0,0),   P0[14],P0[15],P1[0],P1[1],   pw1[2]=PKW(P0,12),pw1[3]=PKW(P0,14), pw1); \
    VRD(2); SBAR(); GAPA(C0=__builtin_amdgcn_mfma_f32_32x32x16_bf16(kf[4],QF(2),C0,0,0,0),   P1[2],P1[3],P1[4],P1[5],     pw2[0]=PKW(P1,0), pw2[1]=PKW(P1,2), pw2); \
    VRD(6); SBAR(); GAPA(C1=__builtin_amdgcn_mfma_f32_32x32x16_bf16(kf[5],QF(2),C1,0,0,0),   P1[6],P1[7],P1[8],P1[9],     pw2[2]=PKW(P1,4), pw2[3]=PKW(P1,6), pw2); \
    VRD(3); SBAR(); GAPA(C0=__builtin_amdgcn_mfma_f32_32x32x16_bf16(kf[6],QF(3),C0,0,0,0),   P1[10],P1[11],P1[12],P1[13], pw3[0]=PKW(P1,8), pw3[1]=PKW(P1,10), pw3); \
    VRD(7); SBAR(); GAPA(C1=__builtin_amdgcn_mfma_f32_32x32x16_bf16(kf[7],QF(3),C1,0,0,0),   P1[14],P1[15],0.f,0.f,       pw3[2]=PKW(P1,12),pw3[3]=PKW(P1,14), pw3); \
    l_reg+=sacc; \
    if(GK){DMA_K((t)+3,sl_cur);} if(GV){DMA_V((t)+1,sl_next);} \
    CMASK(C0,C1,t); \
    { float a=MX3(C0[0],C0[1],C1[0]),b=MX3(C0[2],C0[3],C1[1]); a=MX3(a,C1[2],C1[3]); \
      _Pragma("unroll") for(int r=4;r<16;r+=4){a=MX3(a,C0[r],C0[r+1]);b=MX3(b,C0[r+2],C0[r+3]);a=MX3(a,C1[r],C1[r+1]);b=MX3(b,C1[r+2],C1[r+3]);} \
      float rm=__builtin_fmaxf(a,b); { auto rr=__builtin_amdgcn_permlane32_swap(__float_as_uint(rm),__float_as_uint(rm),false,false); rm=__builtin_fmaxf(__uint_as_float(rr[0]),__uint_as_float(rr[1])); } \
      if constexpr(VD==2) rm-=mhat;                   \
      resc=false; \
      if(__builtin_expect(__any(rm>(float)THRL),0)){ const float dl=__builtin_fmaxf(rm,0.f); mhat+=dl; \
        if constexpr(VD==1){ _Pragma("unroll") for(int r=0;r<16;++r){C0[r]-=dl;C1[r]-=dl;} \
          _Pragma("unroll") for(int r=0;r<16;++r)negm[r]=-mhat; asm volatile("":"+v"(negm)); } \
        const float f=__builtin_amdgcn_exp2f(-dl); l_reg*=f; if(hi==0)wsf[r32]=f; resc=true; } \
      if constexpr(VD==2){ _Pragma("unroll") for(int r=0;r<16;++r){C0[r]-=mhat;C1[r]-=mhat;} } } \
    SBAR(); \
    GAPB(o[0]=__builtin_amdgcn_mfma_f32_32x32x16_bf16(PAF(0),VFR(0),o[0],0,0,0), C0,0); VRDH(0); \
    GAPB(o[1]=__builtin_amdgcn_mfma_f32_32x32x16_bf16(PAF(0),VFR(4),o[1],0,0,0), C0,4); VRDH(4); \
    KRD(GL,0); GAPB(o[0]=__builtin_amdgcn_mfma_f32_32x32x16_bf16(PAF(1),VFR(1),o[0],0,0,0), C0,8); VRDH(1); \
    KRD(GL,1); GAPB(o[1]=__builtin_amdgcn_mfma_f32_32x32x16_bf16(PAF(1),VFR(5),o[1],0,0,0), C0,12); VRDH(5); \
    KRD(GL,2); GAPB(o[0]=__builtin_amdgcn_mfma_f32_32x32x16_bf16(PAF(2),VFR(2),o[0],0,0,0), C1,0); VRDH(2); \
    KRD(GL,3); GAPB(o[1]=__builtin_amdgcn_mfma_f32_32x32x16_bf16(PAF(2),VFR(6),o[1],0,0,0), C1,4); VRDH(6); \
    GAPB(o[0]=__builtin_amdgcn_mfma_f32_32x32x16_bf16(PAF(3),VFR(3),o[0],0,0,0), C1,8); VRDH(3); \
    GAPB(o[1]=__builtin_amdgcn_mfma_f32_32x32x16_bf16(PAF(3),VFR(7),o[1],0,0,0), C1,12); VRDH(7); \
    if constexpr(VD==2){     \
      o[2]=__builtin_amdgcn_mfma_f32_32x32x16_bf16(PAF(0),VFR(0),o[2],0,0,0); o[3]=__builtin_amdgcn_mfma_f32_32x32x16_bf16(PAF(0),VFR(4),o[3],0,0,0); \
      o[2]=__builtin_amdgcn_mfma_f32_32x32x16_bf16(PAF(1),VFR(1),o[2],0,0,0); o[3]=__builtin_amdgcn_mfma_f32_32x32x16_bf16(PAF(1),VFR(5),o[3],0,0,0); \
      o[2]=__builtin_amdgcn_mfma_f32_32x32x16_bf16(PAF(2),VFR(2),o[2],0,0,0); o[3]=__builtin_amdgcn_mfma_f32_32x32x16_bf16(PAF(2),VFR(6),o[3],0,0,0); \
      o[2]=__builtin_amdgcn_mfma_f32_32x32x16_bf16(PAF(3),VFR(3),o[2],0,0,0); o[3]=__builtin_amdgcn_mfma_f32_32x32x16_bf16(PAF(3),VFR(7),o[3],0,0,0); SBAR(); } \
    }while(0)
  #define WB_FULL() do{ if constexpr(VD==2){WAIT_BAR(3);}else{WAIT_BAR(2);} }while(0)
  #define WB_VONLY() do{ if constexpr(VD==2){WAIT_BAR(2);}else{WAIT_BAR(1);} }while(0)
  if(wid>=4)__builtin_amdgcn_s_setprio(1);
  int t=1;
  #undef CMASK
  #define CMASK(P0,P1,t) mk.apply(P0,P1,(t),hi)
  for(;t+5<NT;t+=2){
    STEP(pB0,pB1,pA0,pA1,t,true,true,true);     WB_FULL(); RESC(); ROT();
    STEP(pA0,pA1,pB0,pB1,t+1,true,true,true);   WB_FULL(); RESC(); ROT();
  }
  #undef CMASK
  #define CMASK(P0,P1,t) mk.apply(P0,P1,(t),hi)
  #define ENDW(tt) do{ if((tt)+3<NT){WB_FULL();} else if((tt)+2<NT){WB_VONLY();} else {WAIT_BAR(0);} }while(0)
  for(;t+1<NT;t+=2){
    STEP(pB0,pB1,pA0,pA1,t,(t+3<NT),(t+1<NT),(t+1<NT));       ENDW(t);   RESC(); ROT();
    STEP(pA0,pA1,pB0,pB1,t+1,(t+4<NT),(t+2<NT),(t+2<NT));     ENDW(t+1); RESC(); ROT();
  }
  STEP(pB0,pB1,pA0,pA1,NT-1,false,false,false); RESC();
  { float sacc=pB0[0]+pB0[1]; _Pragma("unroll") for(int r=2;r<16;++r)sacc+=pB0[r]; _Pragma("unroll") for(int r=0;r<16;++r)sacc+=pB1[r]; l_reg+=sacc;
    pw0=(u32x4){PKW(pB0,0),PKW(pB0,2),PKW(pB0,4),PKW(pB0,6)};pw1=(u32x4){PKW(pB0,8),PKW(pB0,10),PKW(pB0,12),PKW(pB0,14)};pw2=(u32x4){PKW(pB1,0),PKW(pB1,2),PKW(pB1,4),PKW(pB1,6)};pw3=(u32x4){PKW(pB1,8),PKW(pB1,10),PKW(pB1,12),PKW(pB1,14)};
    SBAR(); pv(o,vb0+VD*sl_cur,PAF(0),PAF(1),PAF(2),PAF(3)); if constexpr(VD==2) pv(o+2,vb0+VD*sl_cur+8192,PAF(0),PAF(1),PAF(2),PAF(3)); }
  #undef PKW
  #undef PAF
  #undef VFR
  #undef PIN
  #undef MX3
  #undef GAPA
  #undef GAPB
  #undef EX
  #undef VRD
  #undef VRDH
  #undef KRD
  #undef STEP
  #undef ENDW
  #undef WB_FULL
  #undef WB_VONLY
  __builtin_amdgcn_s_setprio(0);
  {auto rr=__builtin_amdgcn_permlane32_swap(__float_as_uint(l_reg),__float_as_uint(l_reg),false,false);l_reg=__uint_as_float(rr[0])+__uint_as_float(rr[1]);}
  if(hi==0)wsf[32+r32]=l_reg;asm volatile("s_waitcnt lgkmcnt(0)":::"memory");
  float rli[16];
  #pragma unroll
  for(int r=0;r<16;++r)rli[r]=__builtin_amdgcn_rcpf(wsf[32+crow(r,hi)]);
  int lane_e=lane; asm volatile("":"+v"(lane_e));
  bf16*Ow=u.Op+(long)(u.qrow0+wid*QBLK)*OPITCH;
  { bf16*stg=(bf16*)(shm+L_OST)+wid*2048;
    #pragma unroll
    for(int vh_=0;vh_<VD;++vh_){
      #pragma unroll
      for(int r=0;r<16;++r){const int orow=crow(r,hi);
        #pragma unroll
        for(int d0=0;d0<2;++d0)stg[orow*64+d0*32+r32]=__float2bfloat16(o[2*vh_+d0][r]*rli[r]);}
      asm volatile("s_waitcnt lgkmcnt(0)":::"memory");
      #pragma unroll
      for(int i=0;i<4;++i){const int row=i*8+(lane_e>>3),ch=lane_e&7; const u32x4 v=*(const u32x4*)(stg+row*64+ch*8); ATTN_STORE16(Ow+(long)row*OPITCH+64*vh_+ch*8,v);}
      asm volatile("s_waitcnt lgkmcnt(0)":::"memory"); } }
  asm volatile("s_waitcnt lgkmcnt(0)\n\ts_barrier":::"memory");
  #undef QF
  #undef DMA_K
  #undef TROW
  #undef DMA_V
  #undef CMASK
  #undef START
  #undef RESC
  #undef ROT
}
constexpr int ATTN_LDS_BYTES=LDS_BYTES;
#undef SBAR
#undef WAIT_BAR
}

struct Params { const float* in[26]; float* out; unsigned char* ws; int ph_lo, ph_hi; };
struct Ctx { LAS unsigned char* lds; int tid, lane, wave, vcu, G, gw, NGW; };
enum { I_X = 0, I_C, I_CTX, I_CCTX, I_ADAW, I_ADAB, I_LNG, I_LNB, I_W0IN, I_W0OUT, I_LQ1, I_LK1, I_LQ2, I_LK2, I_SUBLN, I_QN, I_KN,
       I_W1IN, I_W1OUT, I_RPB, I_POOLW, I_POOLS, I_ROUTER, I_WG, I_WU, I_WD };

__device__ __forceinline__ const float* mod_row(const Params& p, int layer, int row) {
    return (const float*)(p.ws + WS_MOD) + (size_t)(layer * 9 + (row < LAT ? (row >> 11) : 8)) * 6144;
}

__device__ __forceinline__ void ph_prologue(const Params& p, const Ctx& c) {
    const float* cin = p.in[I_C]; const float* cctx = p.in[I_CCTX]; const float* ada_w = p.in[I_ADAW]; const float* ada_b = p.in[I_ADAB];
    float* MOD = (float*)(p.ws + WS_MOD);
    LAS float* sc = (LAS float*)c.lds;
    LAS float* red = sc + 9 * 1024;
    if (c.vcu < 192) {
        f32x4 cv[5];
#pragma unroll
        for (int j = 0; j < 4; ++j) cv[j] = *(const f32x4*)(cin + 4 * (c.tid + 512 * j));
        cv[4] = c.tid < 256 ? *(const f32x4*)(cctx + 4 * c.tid) : (f32x4){0.f, 0.f, 0.f, 0.f};
#pragma unroll
        for (int j = 0; j < 5; ++j) { f32x4 o;
#pragma unroll
            for (int q = 0; q < 4; ++q) o[q] = cv[j][q] / (1.f + expf(-cv[j][q]));
            if (j < 4 || c.tid < 256) *(LAS f32x4*)(sc + 4 * (c.tid + 512 * j)) = o; }
    }
    __syncthreads();
    for (int u = c.vcu; u < 192; u += c.G) {
        const int layer = u / 96, j0 = (u - layer * 96) * 64, kq = c.lane >> 4, cq = c.lane & 15;
        f32x4 acc[9];
#pragma unroll
        for (int m = 0; m < 9; ++m) acc[m] = (f32x4){0.f, 0.f, 0.f, 0.f};
        const char* ub = (const char*)(ada_w + (size_t)layer * 1024 * 6144 + (size_t)(128 * c.wave) * 6144 + j0);
        const unsigned loff = (unsigned)((32 * kq) * 6144 + 4 * cq) * 4u;
        const LAS float* sk = sc + 128 * c.wave + 32 * kq;
#pragma unroll 1
        for (int hb = 0; hb < 2; ++hb) {
            f32x4 wa[16];
#pragma unroll
            for (int i = 0; i < 16; ++i) wa[i] = __builtin_nontemporal_load((const f32x4*)(ub + (size_t)(16 * hb + i) * 6144 * 4 + loff));
            __builtin_amdgcn_sched_barrier(0);
#pragma unroll
            for (int i4 = 0; i4 < 4; ++i4)
#pragma unroll
                for (int m = 0; m < 9; ++m) { const f32x4 sv = *(const LAS f32x4*)(sk + m * 1024 + 16 * hb + 4 * i4);
                    acc[m] += wa[4 * i4] * sv.x + wa[4 * i4 + 1] * sv.y + wa[4 * i4 + 2] * sv.z + wa[4 * i4 + 3] * sv.w; if (m == 8) __builtin_amdgcn_sched_barrier(0); }
        }
#pragma unroll
        for (int m = 0; m < 9; ++m) {
#pragma unroll
            for (int q = 0; q < 4; ++q) { float v = acc[m][q]; v += __shfl_xor(v, 16); v += __shfl_xor(v, 32); acc[m][q] = v; }
            if (kq == 0) *(LAS f32x4*)(red + (c.wave * 9 + m) * 64 + 4 * cq) = acc[m]; }
        __syncthreads();
        for (int o = c.tid; o < 576; o += 512) {
            const int m = o >> 6, j = o & 63; float s2 = 0.f;
#pragma unroll
            for (int w = 0; w < 8; ++w) s2 += red[(w * 9 + m) * 64 + j];
            MOD[(size_t)(layer * 9 + m) * 6144 + j0 + j] = s2 + ada_b[layer * 6144 + j0 + j];
        }
        __syncthreads();
    }
    {
        bf16* PB = (bf16*)(p.ws + WS_POOLB); const float* pw = p.in[I_POOLW];
        for (int i = c.vcu * 512 + c.tid; i < 65536; i += c.G * 512) { const int j = i & 7, ln = (i >> 3) & 63, et = (i >> 9) & 3, ks = (i >> 11) & 7, g = i >> 14;
            PB[i] = (bf16)f2bf(pw[(size_t)(g * 128 + 16 * ks + 8 * (ln >> 5) + j) * 128 + 32 * et + (ln & 31)]); }
    }
    if (c.vcu == 0) {
        f32x2* R = (f32x2*)(p.ws + WS_ROPE);
        for (int i = c.tid; i < 1024; i += 512) {
            const int pos = i >> 4, f = i & 15;
            const float inv = exp2f(-(float)f * (13.287712379549449f / 16.f));
            const float a = (float)pos * inv;
            const float k = rintf(a * 0.15915494309189535f);
            float rr = fmaf(-k, 6.28125f, a); rr = fmaf(-k, 1.9353071795864769e-3f, rr);
            R[i] = (f32x2){__cosf(rr), __sinf(rr)};
        }
    }
}


__device__ __forceinline__ void transpose_item(const float* W, int ldw, int k0, int n0, bf16* WT, int Kd, int drow0, LAS float* scr, int lane) {
#pragma unroll
    for (int i = 0; i < 32; ++i) { const int kk = 2 * i + (lane >> 5); scr[kk * 33 + (lane & 31)] = W[(size_t)(k0 + kk) * ldw + n0 + (lane & 31)]; }
    asm volatile("s_waitcnt lgkmcnt(0)" ::: "memory");
    const int ch = lane & 7;
#pragma unroll
    for (int j = 0; j < 4; ++j) { const int n = (lane >> 3) + 8 * j; const LAS float* sp = scr + (8 * ch) * 33 + n;
        v4u o; o.x = pk2(sp[0 * 33], sp[1 * 33]); o.y = pk2(sp[2 * 33], sp[3 * 33]); o.z = pk2(sp[4 * 33], sp[5 * 33]); o.w = pk2(sp[6 * 33], sp[7 * 33]);
        *(v4u*)(WT + (size_t)(drow0 + n) * Kd + k0 + 8 * ch) = o; }
    asm volatile("s_waitcnt lgkmcnt(0)" ::: "memory");
}
__device__ __forceinline__ void transpose_item8(const float* W, int ldw, int k0, int n0, unsigned char* WT8, int Kd, int drow0, float scale, LAS float* scr, int lane) {
#pragma unroll 8
    for (int i = 0; i < 32; ++i) { const int kk = 2 * i + (lane >> 5); scr[kk * 33 + (lane & 31)] = W[(size_t)(k0 + kk) * ldw + n0 + (lane & 31)]; }
    asm volatile("s_waitcnt lgkmcnt(0)" ::: "memory");
    const int n = lane >> 1, hf = lane & 1; const LAS float* sp = scr + (32 * hf) * 33 + n;
    v4u o0, o1;
    o0.x = pg8::pk4_fp8(sp[0 * 33] * scale, sp[1 * 33] * scale, sp[2 * 33] * scale, sp[3 * 33] * scale);     o0.y = pg8::pk4_fp8(sp[4 * 33] * scale, sp[5 * 33] * scale, sp[6 * 33] * scale, sp[7 * 33] * scale);
    o0.z = pg8::pk4_fp8(sp[8 * 33] * scale, sp[9 * 33] * scale, sp[10 * 33] * scale, sp[11 * 33] * scale);   o0.w = pg8::pk4_fp8(sp[12 * 33] * scale, sp[13 * 33] * scale, sp[14 * 33] * scale, sp[15 * 33] * scale);
    o1.x = pg8::pk4_fp8(sp[16 * 33] * scale, sp[17 * 33] * scale, sp[18 * 33] * scale, sp[19 * 33] * scale); o1.y = pg8::pk4_fp8(sp[20 * 33] * scale, sp[21 * 33] * scale, sp[22 * 33] * scale, sp[23 * 33] * scale);
    o1.z = pg8::pk4_fp8(sp[24 * 33] * scale, sp[25 * 33] * scale, sp[26 * 33] * scale, sp[27 * 33] * scale); o1.w = pg8::pk4_fp8(sp[28 * 33] * scale, sp[29 * 33] * scale, sp[30 * 33] * scale, sp[31 * 33] * scale);
    unsigned char* dst = WT8 + (size_t)(drow0 + n) * Kd + k0 + 32 * hf;
    *(v4u*)dst = o0; *(v4u*)(dst + 16) = o1;
    asm volatile("s_waitcnt lgkmcnt(0)" ::: "memory");
}
struct TBlk { const float* src; unsigned char* dst; int ldw, Kd, gu, which; float scale; };
__device__ __forceinline__ TBlk tblk_decode(const Params& p, int blk) {
    const int ie = blk / 96, q = blk - ie * 96, layer = ie >> 4, e = ie & 15, which = q >> 5, idx = q & 31;
    TBlk t; t.which = which;
    if (which < 2) { const int kb = idx & 3, nb = idx >> 2, k0 = 256 * kb, n0 = 256 * nb;
        t.src = (which == 0 ? p.in[I_WG] : p.in[I_WU]) + (size_t)ie * DM * FF + (size_t)k0 * FF + n0; t.ldw = FF; t.Kd = DM; t.scale = which == 0 ? W8_GU * 1.4426950408889634f : W8_GU; t.gu = 1;
        t.dst = p.ws + WS_WGU + (size_t)layer * WS_MOE_LSTRIDE + (size_t)e * 4096 * DM + (size_t)(2 * nb) * 256 * DM + k0; }
    else { const int kb = idx & 7, nb = idx >> 3, k0 = 256 * kb, n0 = 256 * nb;
        t.src = p.in[I_WD] + (size_t)ie * FF * DM + (size_t)k0 * DM + n0; t.ldw = DM; t.Kd = FF; t.scale = W8_DN; t.gu = 0;
        t.dst = p.ws + WS_WDN + (size_t)layer * WS_MOE_LSTRIDE + (size_t)e * DM * FF + (size_t)n0 * FF + k0; }
    return t;
}
__device__ __forceinline__ void tblk_load(const TBlk& t, f32x4 (&v)[16], int wave, int lane, int hf) {
    const float* sp = t.src + (size_t)(32 * wave + 16 * hf) * t.ldw + 4 * lane;
#pragma unroll
    for (int i = 0; i < 16; ++i) v[i] = __builtin_nontemporal_load((const f32x4*)(sp + (size_t)i * t.ldw));
}
constexpr int TPITCH = 264;
__device__ __forceinline__ void tblk_pack(const TBlk& t, const f32x4 (&v)[16], LAS unsigned char* T, int wave, int lane, int hf) {
#pragma unroll
    for (int i = 0; i < 4; ++i) {
        const f32x4 r0 = v[4 * i] * t.scale, r1 = v[4 * i + 1] * t.scale, r2 = v[4 * i + 2] * t.scale, r3 = v[4 * i + 3] * t.scale;
#pragma unroll
        for (int j = 0; j < 4; ++j) { int w = 0; w = __builtin_amdgcn_cvt_pk_fp8_f32(r0[j], r1[j], w, false); w = __builtin_amdgcn_cvt_pk_fp8_f32(r2[j], r3[j], w, true);
            *(LAS unsigned*)(T + (64 * j + lane) * TPITCH + 32 * wave + 16 * hf + 4 * i) = (unsigned)w; }
    }
}
__device__ __forceinline__ void tblk_writeout(const TBlk& t, const LAS unsigned char* T, int tid) {
#pragma unroll
    for (int it = 0; it < 8; ++it) { const int idx = it * 512 + tid, n = idx >> 4, ch = idx & 15, rho = (n & 3) * 64 + (n >> 2);
        const LAS unsigned char* sp = T + rho * TPITCH + 16 * ch;
        const v2u a = *(const LAS v2u*)sp, b2 = *(const LAS v2u*)(sp + 8);
        const int drow = t.gu ? ((n >> 7) * 256 + (n & 127) + t.which * 128) : n;
        __builtin_nontemporal_store((v4u){a.x, a.y, b2.x, b2.y}, (v4u*)(t.dst + (size_t)drow * t.Kd + 16 * ch)); }
}
__device__ __forceinline__ void moe_transpose_blocks(const Params& p, const Ctx& c, int blk0, int blk1, int widx, int nw) {
    LAS unsigned char* T = c.lds;
    f32x4 va[16], vb[16];
    int blk = blk0 + widx;
    if (blk >= blk1) return;
    TBlk t = tblk_decode(p, blk);
    tblk_load(t, va, c.wave, c.lane, 0);
#pragma unroll 1
    for (; blk < blk1; blk += nw) {
        tblk_load(t, vb, c.wave, c.lane, 1);
        tblk_pack(t, va, T, c.wave, c.lane, 0);
        const int nb = blk + nw;
        TBlk tn = tblk_decode(p, nb < blk1 ? nb : blk0);
        if (nb < blk1) tblk_load(tn, va, c.wave, c.lane, 0);
        tblk_pack(t, vb, T, c.wave, c.lane, 1);
        __syncthreads();
        tblk_writeout(t, T, c.tid);
        __syncthreads();
        t = tn;
    }
}
constexpr int CV_G2 = 216, CV_G6 = 144, CV_G10 = 192, CV_G12 = 184;
constexpr int CVB_P0 = 256, CVB_2 = CVB_P0 + 400, CVB_4 = CVB_2 + 320, CVB_6 = CVB_4 + 648;
constexpr int CVB_8 = CVB_6 + 128, CVB_10 = CVB_8 + 576, CVB_12 = CVB_10 + 648, CVB_16 = 3072;
static_assert(CVB_6 >= 1536 && CVB_12 <= CVB_16, "layer 0's expert weights must be complete before phase 9");
__device__ __forceinline__ void tail_transposes(const Params& p, const Ctx& c, int first_idle, int my, int blk0, int nblk) {
    if (!TAIL_TRANSPOSE || c.G != 256 || my < first_idle) return;
    moe_transpose_blocks(p, c, blk0, blk0 + nblk, my - first_idle, c.G - first_idle);
}
__device__ __forceinline__ void ph_transposes(const Params& p, const Ctx& c) {
    LAS float* scr = (LAS float*)(c.lds + c.wave * 16384);
    constexpr int I0 = 16 * 72, I1 = 16 * 32, I2 = 16 * 64, I3 = 16 * 32, ISM = I0 + I1 + I2 + I3;
    for (int r0 = c.gw; r0 < ISM; r0 += c.NGW) {
        int r = r0;
        if (r < I0) { const int n0 = 32 * (r % 72), drow = FUSE_QKV ? ((n0 >> 8) * 256 + 128 * ((n0 >> 5) & 1) + 32 * ((n0 >> 6) & 3)) : n0;
            transpose_item(p.in[I_W0IN], EIN, 64 * (r / 72), n0, (bf16*)(p.ws + WS_W0IN), DM, drow, scr, c.lane); continue; } r -= I0;
        if (r < I1) { transpose_item(p.in[I_W0OUT], DM, 64 * (r / 32), 32 * (r % 32), (bf16*)(p.ws + WS_W0OUT), DM, 32 * (r % 32), scr, c.lane); continue; } r -= I1;
        if (r < I2) { transpose_item(p.in[I_W1IN], OIN, 64 * (r / 64), 32 * (r % 64), (bf16*)(p.ws + WS_W1IN), DM, 32 * (r % 64), scr, c.lane); continue; } r -= I2;
        transpose_item(p.in[I_W1OUT], DM, 64 * (r / 32), 32 * (r % 32), (bf16*)(p.ws + WS_W1OUT), DM, 32 * (r % 32), scr, c.lane);
    }
    static_assert(MOE_FP8, "the expert-weight transposes write e4m3 copies");
    __syncthreads();
    if (TAIL_TRANSPOSE && c.G == 256) moe_transpose_blocks(p, c, 0, CVB_P0, c.vcu, 256);
    else moe_transpose_blocks(p, c, 0, 3072, c.vcu, c.G);
}

__device__ __forceinline__ void ph_modulate0(const Params& p, const Ctx& c) {
    bf16* HB = (bf16*)(p.ws + WS_HB);
    for (int chunk = c.gw; chunk < NTOK / 9; chunk += c.NGW) {
        const int r0 = 9 * chunk;
        const float* m0 = mod_row(p, 0, r0);
        if (m0 == mod_row(p, 0, r0 + 8)) {
            const float* src = r0 < LAT ? p.in[I_X] + (size_t)r0 * DM : p.in[I_CTX] + (size_t)(r0 - LAT) * DM;
            f32x4 sh[4], sc[4], xv[9][4];
#pragma unroll
            for (int j = 0; j < 4; ++j) { sh[j] = *(const f32x4*)(m0 + 4 * c.lane + 256 * j); sc[j] = *(const f32x4*)(m0 + 1024 + 4 * c.lane + 256 * j); }
#pragma unroll
            for (int r = 0; r < 9; ++r)
#pragma unroll
                for (int j = 0; j < 4; ++j) xv[r][j] = __builtin_nontemporal_load((const f32x4*)(src + (size_t)r * DM + 4 * c.lane + 256 * j));
            __builtin_amdgcn_sched_barrier(0);
#pragma unroll
            for (int j = 0; j < 4; ++j) sc[j] = sc[j] + 1.f;
#pragma unroll
            for (int r = 0; r < 9; ++r)
#pragma unroll
                for (int j = 0; j < 4; ++j) { const f32x4 h = xv[r][j] * sc[j] + sh[j];
                    *(v2u*)(HB + (size_t)(r0 + r) * DM + 4 * c.lane + 256 * j) = (v2u){pk2(h.x, h.y), pk2(h.z, h.w)}; }
        } else {
#pragma unroll 1
            for (int r = 0; r < 9; ++r) { const int row = r0 + r;
                const float* src = row < LAT ? p.in[I_X] + (size_t)row * DM : p.in[I_CTX] + (size_t)(row - LAT) * DM;
                const float* mod = mod_row(p, 0, row);
                f32x4 v[4], sh[4], sc[4];
#pragma unroll
                for (int j = 0; j < 4; ++j) { const int col = 4 * c.lane + 256 * j; v[j] = *(const f32x4*)(src + col); sh[j] = *(const f32x4*)(mod + col); sc[j] = *(const f32x4*)(mod + 1024 + col); }
#pragma unroll
                for (int j = 0; j < 4; ++j) { const f32x4 h = v[j] * (sc[j] + 1.f) + sh[j];
                    *(v2u*)(HB + (size_t)row * DM + 4 * c.lane + 256 * j) = (v2u){pk2(h.x, h.y), pk2(h.z, h.w)}; }
            }
        }
    }
}


struct NG { const bf16* A; int lda; const float* W0; const float* W1; int ldw; size_t wstride; int Mb; int row_begin, row_end, col_begin, col_end, K; };
template <int NB, class Epi>
__device__ __forceinline__ void ngemm(const NG& g, const Ctx& c, const Epi& epi) {
    const int nmt = (g.row_end - g.row_begin) / 32, nnt = (g.col_end - g.col_begin) / 32;
    const int l31 = c.lane & 31, lh = c.lane >> 5;
    for (int t = c.gw; t < nmt * nnt; t += c.NGW) {
        const int mt = t / nnt, nt = t % nnt;
        const int row0 = g.row_begin + mt * 32, col0 = g.col_begin + nt * 32;
        const int e = row0 / g.Mb;
        const bf16* ap = g.A + (size_t)(row0 + l31) * g.lda + lh;
        const float* bp0 = g.W0 + (size_t)e * g.wstride + (size_t)lh * g.ldw + col0 + l31;
        const float* bp1 = NB == 2 ? g.W1 + (size_t)e * g.wstride + (size_t)lh * g.ldw + col0 + l31 : nullptr;
        f32x16 acc0 = {}, acc1 = {};
#pragma unroll 8
        for (int k = 0; k < g.K; k += 2) {
            const float a = bf2f((unsigned)ap[k]);
            const float b0 = bp0[(size_t)k * g.ldw];
            acc0 = __builtin_amdgcn_mfma_f32_32x32x2f32(a, b0, acc0, 0, 0, 0);
            if (NB == 2) { const float b1 = bp1[(size_t)k * g.ldw]; acc1 = __builtin_amdgcn_mfma_f32_32x32x2f32(a, b1, acc1, 0, 0, 0); }
        }
#pragma unroll
        for (int r = 0; r < 16; ++r) {
            const int row = row0 + (r & 3) + 8 * (r >> 2) + 4 * lh, col = col0 + l31;
            epi(row, col, acc0[r], acc1[r]);
        }
    }
}
struct EpiF32 { float* O; int ldc; __device__ __forceinline__ void operator()(int row, int col, float v0, float) const { O[(size_t)row * ldc + col] = v0; } };
struct EpiBf { bf16* O; int ldc; int scale_cols; float sc; __device__ __forceinline__ void operator()(int row, int col, float v0, float) const { O[(size_t)row * ldc + col] = (bf16)f2bf(col < scale_cols ? v0 * sc : v0); } };
struct EpiSwiglu { bf16* O; __device__ __forceinline__ void operator()(int row, int col, float g, float u) const { const float s = g / (1.f + __expf(-g)); O[(size_t)row * FF + col] = (bf16)f2bf(s * u); } };
struct EpiGate { bf16* O; const float* gate; __device__ __forceinline__ void operator()(int row, int col, float v0, float) const { O[(size_t)row * DM + col] = (bf16)f2bf(v0 * gate[row]); } };

template <bool F32IN> __device__ __forceinline__ void ph_qkv_post(const Params& p, const Ctx& c) {
    const float* PF = (const float*)(p.ws + WS_PF);
    bf16* QKV = (bf16*)(p.ws + WS_QKV);
    const f32x2* R = (const f32x2*)(p.ws + WS_ROPE);
    const float* qn = p.in[I_QN]; const float* kn = p.in[I_KN];
    const int d = c.lane;
    const float qg = qn[d], kg = kn[d];
    for (int row = c.gw; row < NTOK; row += c.NGW) {
        const bool lat = row < LAT;
        const int t = row & 2047;
        const int pos = (d < 32) ? (t >> 6) : (t & 63);
        const f32x2 cs = R[pos * 16 + (d & 15)];
        const bool first = (d & 16) == 0;
        float vv[36];
#pragma unroll
        for (int hs = 0; hs < 36; ++hs) vv[hs] = F32IN ? PF[(size_t)row * EIN + hs * 64 + d] : bf2f((unsigned)QKV[(size_t)row * EIN + hs * 64 + d]);
#pragma unroll
        for (int hs = 0; hs < 36; ++hs) {
            float v = vv[hs];
            const bool isq = hs < 8 || (hs >= 24 && hs < 32);
            const bool isk = (hs >= 8 && hs < 16) || hs == 32 || hs == 33;
            const bool nrm = hs >= 24 && hs < 34;
            if (nrm) { const float ss = wave_sum(v * v); v = v * rsqrtf(ss * (1.f / 64.f) + RMS_EPS) * (hs < 32 ? qg : kg); }
            if ((isq || isk) && lat) { const float pr = __shfl_xor(v, 16); v = first ? v * cs.x - pr * cs.y : v * cs.x + pr * cs.y; }
            if (isq) v *= C2;
            QKV[(size_t)row * EIN + hs * 64 + d] = (bf16)f2bf(v);
        }
    }
}

__device__ __forceinline__ void ph_attn0_naive(const Params& p, const Ctx& c) {
    const bf16* QKV = (const bf16*)(p.ws + WS_QKV);
    bf16* CC = (bf16*)(p.ws + WS_CC);
    bf16* AO = (bf16*)(p.ws + WS_AO);
    LAS float* Ks = (LAS float*)c.lds;
    LAS float* Vs = Ks + 4096;
    for (int u = c.vcu; u < 960; u += c.G) {
        const bool isctx = u >= 768;
        int b, vh, qrow, ntiles; bool active = true;
        if (!isctx) { b = u / 96; const int r = u % 96; vh = r >> 2; qrow = b * SEQ + (r & 3) * 512 + c.tid; ntiles = 36; }
        else { const int uu = u - 768; b = uu / 24; vh = uu % 24; qrow = LAT + b * NCTX + (c.tid & 255); active = c.tid < 256; ntiles = 4; }
        int qcol, kcol, vcol;
        if (vh < 16) { const int a = vh >> 2, s = (vh >> 1) & 1, half = vh & 1; qcol = a * 128 + s * 64; kcol = 512 + a * 128 + s * 64; vcol = 1024 + a * 128 + half * 64; }
        else { const int h = vh - 16; qcol = 1536 + h * 64; kcol = 2048 + (h >> 2) * 64; vcol = 2176 + (h >> 2) * 64; }
        float q[64], o[64];
#pragma unroll
        for (int i = 0; i < 8; ++i) { const v4u w = *(const v4u*)(QKV + (size_t)qrow * EIN + qcol + 8 * i); unpack8(w, q + 8 * i); }
#pragma unroll
        for (int i = 0; i < 64; ++i) o[i] = 0.f;
        float m = -1e30f, l = 0.f;
        for (int t = 0; t < ntiles; ++t) {
            const int krow0 = isctx ? LAT + b * NCTX + 64 * t : (t < 32 ? b * SEQ + 64 * t : LAT + b * NCTX + 64 * (t - 32));
            __syncthreads();
            { const int r = c.tid >> 3, ch = c.tid & 7; float f[8];
              const v4u kw = *(const v4u*)(QKV + (size_t)(krow0 + r) * EIN + kcol + ch * 8); unpack8(kw, f);
#pragma unroll
              for (int j = 0; j < 8; ++j) Ks[r * 64 + ch * 8 + j] = f[j];
              const v4u vw = *(const v4u*)(QKV + (size_t)(krow0 + r) * EIN + vcol + ch * 8); unpack8(vw, f);
#pragma unroll
              for (int j = 0; j < 8; ++j) Vs[r * 64 + ch * 8 + j] = f[j]; }
            __syncthreads();
            if (active) {
                for (int kk = 0; kk < 64; ++kk) {
                    float s = 0.f;
#pragma unroll
                    for (int dd = 0; dd < 64; ++dd) s += q[dd] * Ks[kk * 64 + dd];
                    const float mn = fmaxf(m, s), al = exp2f(m - mn), pp = exp2f(s - mn);
                    l = l * al + pp; m = mn;
#pragma unroll
                    for (int dd = 0; dd < 64; ++dd) o[dd] = o[dd] * al + pp * Vs[kk * 64 + dd];
                }
            }
        }
        if (active) {
            const float rl = 1.f / l;
            bf16* dst = vh < 16 ? AO + (size_t)qrow * DM + (vh >> 2) * 256 + ((vh >> 1) & 1) * 128 + (vh & 1) * 64 : CC + (size_t)qrow * DM + 512 + (vh - 16) * 64;
            {
#pragma unroll
                for (int i = 0; i < 8; ++i) *(v4u*)(dst + 8 * i) = (v4u){pk2(o[8 * i] * rl, o[8 * i + 1] * rl), pk2(o[8 * i + 2] * rl, o[8 * i + 3] * rl), pk2(o[8 * i + 4] * rl, o[8 * i + 5] * rl), pk2(o[8 * i + 6] * rl, o[8 * i + 7] * rl)}; }
        }
    }
}


__device__ __forceinline__ void attn_combine_rows(const Params& p, const Ctx& c, int row0, int a, float lam) {
    const bf16* AO = (const bf16*)(p.ws + WS_AO); bf16* CC = (bf16*)(p.ws + WS_CC);
    const int r4 = c.lane >> 4, cg = c.lane & 15;
    asm volatile("s_waitcnt vmcnt(0)" ::: "memory");
    const f32x4 ga = *(const f32x4*)(p.in[I_SUBLN] + 8 * cg) * (1.f - LAM_INIT), gb = *(const f32x4*)(p.in[I_SUBLN] + 8 * cg + 4) * (1.f - LAM_INIT);
    v4u w0[8], w1[8];
#pragma unroll
    for (int it = 0; it < 8; ++it) { const bf16* src = AO + (size_t)(row0 + 4 * it + r4) * DM + a * 256 + 8 * cg; w0[it] = *(const v4u*)src; w1[it] = *(const v4u*)(src + 128); }
#pragma unroll
    for (int it = 0; it < 8; ++it) {
        const f32x4 xa = unpack4((v2u){w0[it].x, w0[it].y}) - unpack4((v2u){w1[it].x, w1[it].y}) * lam, xb = unpack4((v2u){w0[it].z, w0[it].w}) - unpack4((v2u){w1[it].z, w1[it].w}) * lam;
        const f32x4 sq = xa * xa + xb * xb;
        float ss = (sq.x + sq.y) + (sq.z + sq.w);
        ss += dppf<0xB1, 0xf>(0.f, ss); ss += dppf<0x4E, 0xf>(0.f, ss); ss += dppf<0x141, 0xf>(0.f, ss); ss += dppf<0x140, 0xf>(0.f, ss);
        const float r = rsqrtf(ss * (1.f / 128.f) + RMS_EPS);
        const f32x4 oa = xa * r * ga, ob = xb * r * gb;
        *(v4u*)(CC + (size_t)(row0 + 4 * it + r4) * DM + a * 128 + 8 * cg) = (v4u){pk2(oa.x, oa.y), pk2(oa.z, oa.w), pk2(ob.x, ob.y), pk2(ob.z, ob.w)};
    }
}
__device__ __forceinline__ void ph_attn0_fast(const Params& p, const Ctx& c, char* lds_generic) {
    typedef attn_body::bf16 abf;
    const abf* Q = (const abf*)(p.ws + WS_QKV); abf* CCb = (abf*)(p.ws + WS_CC); abf* AOb = (abf*)(p.ws + WS_AO);
    const float d1 = wave_sum(p.in[I_LQ1][c.lane] * p.in[I_LK1][c.lane]), d2 = wave_sum(p.in[I_LQ2][c.lane] * p.in[I_LK2][c.lane]);
    const float lam = expf(d1) - expf(d2) + LAM_INIT;
    for (int v = c.vcu; v < 256; v += c.G) {
#pragma unroll 1
        for (int step = 0; step < 6; ++step) {
            attn_body::AU u; int a = -1, sp = 0, h = 0; bool ctxu = false;
            if (step < 2) { const int b = v >> 5; a = (v >> 3) & 3; sp = step; u.qrow0 = b * SEQ + (v & 7) * 256; u.lat_row0 = b * SEQ; u.ctx_row0 = LAT + b * NCTX; }
            else if (step < 4) { const int U = (step - 2) * 256 + v, b = U >> 6; h = (U >> 3) & 7; u.qrow0 = b * SEQ + (U & 7) * 256; u.lat_row0 = b * SEQ; u.ctx_row0 = LAT + b * NCTX; }
            else { ctxu = true; int b;
                if (v < 32) { b = v >> 2; a = v & 3; sp = step - 4; }
                else if (v < 96 && step == 4) { b = (v - 32) >> 3; h = (v - 32) & 7; }
                else break;
                u.qrow0 = LAT + b * NCTX; u.lat_row0 = 0; u.ctx_row0 = LAT + b * NCTX; }
            if (!ctxu) { u.nlat_t = 32; u.NT = 36; } else { u.nlat_t = 0; u.NT = 4; }
            if (a >= 0) {
                u.Qp = Q + a * 128 + sp * 64; u.Kp = Q + 512 + a * 128 + sp * 64; u.Vp = Q + 1024 + a * 128; u.Op = AOb + a * 256 + sp * 128;
                attn_body::attn_unit<8, EIN, attn_body::NoMask, 2>(u, lds_generic, attn_body::NoMask{});
                if (sp == 1) attn_combine_rows(p, c, u.qrow0 + c.wave * 32, a, lam);
            } else {
                u.Qp = Q + 1536 + h * 64; u.Kp = Q + 2048 + (h >> 2) * 64; u.Vp = Q + 2176 + (h >> 2) * 64; u.Op = CCb + 512 + h * 64;
                attn_body::attn_unit<8, EIN, attn_body::NoMask, 1>(u, lds_generic, attn_body::NoMask{});
            }
        }
    }
    tail_transposes(p, c, 96, c.vcu, CVB_2, CVB_4 - CVB_2);
}

__device__ __forceinline__ void ph_attn_combine(const Params& p, const Ctx& c) {
    const bf16* AO = (const bf16*)(p.ws + WS_AO);
    bf16* CC = (bf16*)(p.ws + WS_CC);
    const float d1 = wave_sum(p.in[I_LQ1][c.lane] * p.in[I_LK1][c.lane]);
    const float d2 = wave_sum(p.in[I_LQ2][c.lane] * p.in[I_LK2][c.lane]);
    const float lam = expf(d1) - expf(d2) + LAM_INIT;
    const float g0 = p.in[I_SUBLN][c.lane] * (1.f - LAM_INIT), g1 = p.in[I_SUBLN][c.lane + 64] * (1.f - LAM_INIT);
    for (int it = c.gw; it < NTOK * 4; it += c.NGW) {
        const int row = it >> 2, a = it & 3;
        const bf16* src = AO + (size_t)row * DM + a * 256;
        const float x0 = bf2f((unsigned)src[c.lane]) - lam * bf2f((unsigned)src[128 + c.lane]), x1 = bf2f((unsigned)src[64 + c.lane]) - lam * bf2f((unsigned)src[192 + c.lane]);
        const float ss = wave_sum(x0 * x0 + x1 * x1);
        const float r = rsqrtf(ss * (1.f / 128.f) + RMS_EPS);
        CC[(size_t)row * DM + a * 128 + c.lane] = (bf16)f2bf(x0 * r * g0);
        CC[(size_t)row * DM + a * 128 + 64 + c.lane] = (bf16)f2bf(x1 * r * g1);
    }
}

typedef unsigned xl_u2 __attribute__((ext_vector_type(2)));
__device__ __forceinline__ float swap32_sum(float a0, float a1) { const xl_u2 r = __builtin_amdgcn_permlane32_swap(__float_as_uint(a0), __float_as_uint(a1), false, false); return __uint_as_float(r.x) + __uint_as_float(r.y); }
__device__ __forceinline__ float swap16_sum(float a0, float a1) { const xl_u2 r = __builtin_amdgcn_permlane16_swap(__float_as_uint(a0), __float_as_uint(a1), false, false); return __uint_as_float(r.x) + __uint_as_float(r.y); }
__device__ __forceinline__ float reduce_logits(const f32x4 (&lg)[4], int lane) {
    float w8[8], w4[4], w2[2], w1;
#pragma unroll
    for (int i = 0; i < 8; ++i) w8[i] = swap32_sum(lg[i >> 2][i & 3], lg[2 + (i >> 2)][i & 3]);
#pragma unroll
    for (int i = 0; i < 4; ++i) w4[i] = swap16_sum(w8[i], w8[i + 4]);
    { const bool hi = (lane & 2) != 0;
#pragma unroll
      for (int i = 0; i < 2; ++i) { const float keep = hi ? w4[i + 2] : w4[i], send = hi ? w4[i] : w4[i + 2]; w2[i] = keep + dppf<0x4E, 0xf>(0.f, send); } }
    { const bool hi = (lane & 1) != 0; const float keep = hi ? w2[1] : w2[0], send = hi ? w2[0] : w2[1]; w1 = keep + dppf<0xB1, 0xf>(0.f, send); }
    w1 += dppf<0x128, 0xf>(0.f, w1); w1 += dppf<0x124, 0xf>(0.f, w1);
    return w1;
}
__device__ __forceinline__ float experts_max(float v) {
    v = fmaxf(v, dppf<0xB1, 0xf>(v, v)); v = fmaxf(v, dppf<0x4E, 0xf>(v, v));
    { const xl_u2 r = __builtin_amdgcn_permlane16_swap(__float_as_uint(v), __float_as_uint(v), false, false); v = fmaxf(__uint_as_float(r.x), __uint_as_float(r.y)); }
    { const xl_u2 r = __builtin_amdgcn_permlane32_swap(__float_as_uint(v), __float_as_uint(v), false, false); v = fmaxf(__uint_as_float(r.x), __uint_as_float(r.y)); }
    return v;
}
__device__ __forceinline__ float experts_sum(float v) {
    v += dppf<0xB1, 0xf>(0.f, v); v += dppf<0x4E, 0xf>(0.f, v);
    v = swap16_sum(v, v); v = swap32_sum(v, v);
    return v;
}
__device__ __forceinline__ void ph_ln1_router(const Params& p, const Ctx& c, int layer) {
    const bf16* Y = (const bf16*)(p.ws + WS_Y);
    bf16* XS = (bf16*)(p.ws + WS_XS);
    bf16* HB = (bf16*)(p.ws + WS_HB);
    float* AFF = (float*)(p.ws + WS_AFF);
    const float* lng = p.in[I_LNG] + (size_t)(layer * 2 + 0) * DM; const float* lnb = p.in[I_LNB] + (size_t)(layer * 2 + 0) * DM;
    const float* router = p.in[I_ROUTER] + (size_t)layer * DM * NE;
    LAS f32x4* R = (LAS f32x4*)c.lds;
    {   f32x4 rv[8];
#pragma unroll
        for (int t = 0; t < 8; ++t) { const int idx = c.tid + 512 * t, e4 = idx & 3, k = idx >> 2; rv[t] = *(const f32x4*)(router + (size_t)k * NE + 4 * e4); }
#pragma unroll
        for (int t = 0; t < 8; ++t) { const int idx = c.tid + 512 * t, e4 = idx & 3, k = idx >> 2, ln = (k & 255) >> 2, q = k & 3, j = k >> 8; R[((j * 4 + q) * 4 + e4) * 64 + ln] = rv[t]; } }
    __syncthreads();
    const int nrows = layer == 0 ? NTOK : LAT;
    const int lane = c.lane;
    f32x4 Gv[4], Bv[4];
#pragma unroll
    for (int j = 0; j < 4; ++j) { Gv[j] = *(const f32x4*)(lng + 4 * lane + 256 * j); Bv[j] = *(const f32x4*)(lnb + 4 * lane + 256 * j); }
    for (int row = 2 * c.gw; row < nrows; row += 2 * c.NGW) {
        const float* mod = mod_row(p, layer, row);
        f32x4 SCv[4], SHv[4];
#pragma unroll
        for (int j = 0; j < 4; ++j) { SCv[j] = *(const f32x4*)(mod + 4096 + 4 * lane + 256 * j); SHv[j] = *(const f32x4*)(mod + 3072 + 4 * lane + 256 * j); }
        f32x4 va[4], vb[4]; float sa = 0.f, sb = 0.f;
#pragma unroll
        for (int j = 0; j < 4; ++j) { const int col = 4 * lane + 256 * j;
            f32x4 xa, xb;
            if (layer == 0) { const float* xin = row < LAT ? p.in[I_X] + (size_t)row * DM : p.in[I_CTX] + (size_t)(row - LAT) * DM; xa = *(const f32x4*)(xin + col); xb = *(const f32x4*)(xin + DM + col); }
            else { xa = unpack4(*(const v2u*)(XS + (size_t)row * DM + col)); xb = unpack4(*(const v2u*)(XS + (size_t)(row + 1) * DM + col)); }
            const f32x4 g1 = *(const f32x4*)(mod + 2048 + col);
            va[j] = xa * ALPHA + g1 * unpack4(*(const v2u*)(Y + (size_t)row * DM + col));
            vb[j] = xb * ALPHA + g1 * unpack4(*(const v2u*)(Y + (size_t)(row + 1) * DM + col));
            sa += (va[j].x + va[j].y) + (va[j].z + va[j].w); sb += (vb[j].x + vb[j].y) + (vb[j].z + vb[j].w); }
        const float meana = wave_sum(sa) * (1.f / DM), meanb = wave_sum(sb) * (1.f / DM); float qa = 0.f, qb = 0.f;
#pragma unroll
        for (int j = 0; j < 4; ++j) { va[j] = va[j] - meana; vb[j] = vb[j] - meanb;
            qa += (va[j].x * va[j].x + va[j].y * va[j].y) + (va[j].z * va[j].z + va[j].w * va[j].w); qb += (vb[j].x * vb[j].x + vb[j].y * vb[j].y) + (vb[j].z * vb[j].z + vb[j].w * vb[j].w); }
        const float rstda = __builtin_amdgcn_rsqf(wave_sum(qa) * (1.f / DM) + LN_EPS), rstdb = __builtin_amdgcn_rsqf(wave_sum(qb) * (1.f / DM) + LN_EPS);
        f32x4 lga[4], lgb[4];
#pragma unroll
        for (int e = 0; e < 4; ++e) { lga[e] = (f32x4){0.f, 0.f, 0.f, 0.f}; lgb[e] = (f32x4){0.f, 0.f, 0.f, 0.f}; }
#pragma unroll
        for (int j = 0; j < 4; ++j) { const int col = 4 * lane + 256 * j;
            const f32x4 g = Gv[j], bb = Bv[j], sc = SCv[j] + 1.f, sh = SHv[j];
            const f32x4 x1a = va[j] * rstda * g + bb, x1b = vb[j] * rstdb * g + bb;
            *(v2u*)(XS + (size_t)row * DM + col) = (v2u){pk2(x1a.x, x1a.y), pk2(x1a.z, x1a.w)};
            *(v2u*)(XS + (size_t)(row + 1) * DM + col) = (v2u){pk2(x1b.x, x1b.y), pk2(x1b.z, x1b.w)};
            const f32x4 hma = x1a * sc + sh, hmb = x1b * sc + sh;
            if (MOE_FP8) { *(unsigned*)((unsigned char*)HB + (size_t)row * DM + col) = pg8::pk4_fp8(hma.x, hma.y, hma.z, hma.w);
                           *(unsigned*)((unsigned char*)HB + (size_t)(row + 1) * DM + col) = pg8::pk4_fp8(hmb.x, hmb.y, hmb.z, hmb.w); }
            else { *(v2u*)(HB + (size_t)row * DM + col) = (v2u){pk2(hma.x, hma.y), pk2(hma.z, hma.w)}; *(v2u*)(HB + (size_t)(row + 1) * DM + col) = (v2u){pk2(hmb.x, hmb.y), pk2(hmb.z, hmb.w)}; }
            asm volatile("" ::: "memory");
#pragma unroll
            for (int q = 0; q < 4; ++q) { const float ha = hma[q], hb = hmb[q];
#pragma unroll
                for (int e4 = 0; e4 < 4; ++e4) { const f32x4 rw = R[((j * 4 + q) * 4 + e4) * 64 + lane]; lga[e4] += rw * ha; lgb[e4] += rw * hb; } } }
        const float wa = reduce_logits(lga, lane), wb = reduce_logits(lgb, lane);
        const float mxa = experts_max(wa), mxb = experts_max(wb);
        const float exa = expf(wa - mxa), exb = expf(wb - mxb); const float dena = experts_sum(exa), denb = experts_sum(exb);
        if ((lane & 12) == 0) { const int e = ((lane >> 5) & 1) * 8 + ((lane >> 4) & 1) * 4 + (lane & 3);
            AFF[(size_t)row * NE + e] = exa / dena; AFF[(size_t)(row + 1) * NE + e] = exb / denb; }
    }
}

__device__ __forceinline__ void ph_topk(const Params& p, const Ctx& c, int layer) {
    const float* AFF = (const float*)(p.ws + WS_AFF);
    int* INV = (int*)(p.ws + WS_INV);
    float* GATE = (float*)(p.ws + WS_GATE);
    const bf16* HB = (const bf16*)(p.ws + WS_HB);
    bf16* XG = (bf16*)(p.ws + WS_XG);
    int* ROWID = (int*)(p.ws + WS_XG);
    LAS unsigned* hist = (LAS unsigned*)c.lds;
    LAS unsigned* ctl = hist + 256;
    LAS int* sel = (LAS int*)(c.lds + 2048);
    const int MR = layer == 0 ? MR0 : MR1;
    const int ntasks = layer == 0 ? 256 : 128;
    const int lane = c.lane;
    for (int task = c.vcu; task < ntasks; task += c.G) {
        int set, e, n, cap, rowbase, slotbase;
        if (task < 128) { set = task >> 4; e = task & 15; n = SEQ; cap = 256; rowbase = set * SEQ; slotbase = set * 256; }
        else { const int t2 = task - 128; set = t2 >> 4; e = t2 & 15; n = NCTX; cap = 32; rowbase = LAT + set * NCTX; slotbase = 2048 + set * 32; }
        const bool valid = 4 * c.tid < n;
        unsigned key[4];
#pragma unroll
        for (int q = 0; q < 4; ++q) key[q] = valid ? __float_as_uint(AFF[(size_t)(rowbase + 4 * c.tid + q) * NE + e]) : 0u;
        unsigned prefix = 0u, need = (unsigned)cap;
#pragma unroll 1
        for (int pass = 0; pass < 4; ++pass) {
            const int shift = 24 - 8 * pass;
            if (c.tid < 256) hist[c.tid] = 0u;
            __syncthreads();
            if (valid) {
#pragma unroll
                for (int q = 0; q < 4; ++q) if (pass == 0 || (key[q] >> (shift + 8)) == (prefix >> (shift + 8))) __hip_atomic_fetch_add(&hist[(key[q] >> shift) & 255u], 1u, __ATOMIC_RELAXED, __HIP_MEMORY_SCOPE_WORKGROUP);
            }
            __syncthreads();
            if (c.wave == 0) {
                const unsigned h0 = hist[4 * lane], h1 = hist[4 * lane + 1], h2 = hist[4 * lane + 2], h3 = hist[4 * lane + 3];
                const unsigned tot = h0 + h1 + h2 + h3; unsigned sfx = tot;
#pragma unroll
                for (int o = 1; o < 64; o <<= 1) { const unsigned t = __shfl_down(sfx, o); if (lane + o < 64) sfx += t; }
                const unsigned above = sfx - tot, c3 = above + h3, c2 = c3 + h2, c1 = c2 + h1, c0 = c1 + h0;
                int d = -1; unsigned gtc = 0u;
                if (above < need && need <= c3) { d = 3; gtc = above; }
                else if (c3 < need && need <= c2) { d = 2; gtc = c3; }
                else if (c2 < need && need <= c1) { d = 1; gtc = c2; }
                else if (c1 < need && need <= c0) { d = 0; gtc = c1; }
                if (d >= 0) { ctl[0] = prefix | ((unsigned)(4 * lane + d) << shift); ctl[1] = need - gtc; }
            }
            __syncthreads();
            prefix = ctl[0]; need = ctl[1];
        }
        unsigned ngt = 0u, neq = 0u;
#pragma unroll
        for (int q = 0; q < 4; ++q) { ngt += (valid && key[q] > prefix) ? 1u : 0u; neq += (valid && key[q] == prefix) ? 1u : 0u; }
        const unsigned cnt = ngt | (neq << 16); unsigned inc = cnt;
#pragma unroll
        for (int o = 1; o < 64; o <<= 1) { const unsigned t = __shfl_up(inc, o); if (lane >= o) inc += t; }
        if (lane == 63) ctl[8 + c.wave] = inc;
        __syncthreads();
        unsigned base = 0u;
#pragma unroll
        for (int w = 0; w < 8; ++w) base += (w < c.wave) ? ctl[8 + w] : 0u;
        const unsigned ex = base + inc - cnt; unsigned gtb = ex & 0xffffu, eqb = ex >> 16;
        if (valid) {
#pragma unroll
            for (int q = 0; q < 4; ++q) { const int i = 4 * c.tid + q; int slot = -1;
                if (key[q] > prefix) { slot = (int)(gtb + (eqb < need ? eqb : need)); ++gtb; }
                else if (key[q] == prefix) { if (eqb < need) slot = (int)(gtb + eqb); ++eqb; }
                int gs = -1;
                if (slot >= 0) { gs = e * MR + slotbase + slot; sel[slot] = i; GATE[gs] = __uint_as_float(key[q]); if (MOE_FP8) ROWID[gs] = rowbase + i; }
                INV[(size_t)(rowbase + i) * NE + e] = gs; }
        }
        __syncthreads();
        if (MOE_FP8) {
        } else
        for (int sidx = c.wave; sidx < cap; sidx += 8) {
            const bf16* src = HB + (size_t)(rowbase + sel[sidx]) * DM; bf16* dst = XG + (size_t)(e * MR + slotbase + sidx) * DM;
            const v4u a0 = *(const v4u*)(src + 8 * lane), a1 = *(const v4u*)(src + 512 + 8 * lane);
            *(v4u*)(dst + 8 * lane) = a0; *(v4u*)(dst + 512 + 8 * lane) = a1;
        }
        __syncthreads();
    }
}

__device__ __forceinline__ f32x4 unpack4y(const unsigned char* q) { const int w = *(const int*)q; const f32x2 lo = __builtin_amdgcn_cvt_pk_f32_fp8(w, false), hi = __builtin_amdgcn_cvt_pk_f32_fp8(w, true); return (f32x4){lo.x, lo.y, hi.x, hi.y}; }
__device__ __forceinline__ void ph_combine(const Params& p, const Ctx& c, int layer) {
    const unsigned char* YS8 = (const unsigned char*)(p.ws + WS_YS);
    const int* INV = (const int*)(p.ws + WS_INV);
    bf16* XS = (bf16*)(p.ws + WS_XS);
    bf16* HB = (bf16*)(p.ws + WS_HB);
    const float* lng = p.in[I_LNG] + (size_t)(layer * 2 + 1) * DM; const float* lnb = p.in[I_LNB] + (size_t)(layer * 2 + 1) * DM;
    const int nrows = layer == 0 ? NTOK : LAT;
    const int lane = c.lane;
    f32x4 Gv[4], Bv[4];
#pragma unroll
    for (int j = 0; j < 4; ++j) { Gv[j] = *(const f32x4*)(lng + 4 * lane + 256 * j); Bv[j] = *(const f32x4*)(lnb + 4 * lane + 256 * j); }
    int inv_nx = (lane < 2 * NE && 2 * c.gw < nrows) ? INV[(size_t)(2 * c.gw) * NE + lane] : -1;
    for (int row = 2 * c.gw; row < nrows; row += 2 * c.NGW) {
        const float* mod = mod_row(p, layer, row);
        const int inv = inv_nx;
        { const int nrow = row + 2 * c.NGW; inv_nx = (lane < 2 * NE && nrow < nrows) ? INV[(size_t)nrow * NE + lane] : -1; }
        f32x4 SCv[4], SHv[4];
        if (layer == 0) { const float* modn = mod_row(p, 1, row);
#pragma unroll
            for (int j = 0; j < 4; ++j) { SCv[j] = *(const f32x4*)(modn + 1024 + 4 * lane + 256 * j); SHv[j] = *(const f32x4*)(modn + 4 * lane + 256 * j); } }
        const unsigned mall = (unsigned)__ballot(inv >= 0);
        unsigned ma = mall & 0xffffu, mb = mall >> 16;
        int sla[4], slb[4]; float wa[4], wb[4];
#pragma unroll
        for (int q = 0; q < 4; ++q) {
            if (ma) { const int e = __builtin_ctz(ma); ma &= ma - 1; sla[q] = __builtin_amdgcn_readlane(inv, e); wa[q] = 1.f / Y8_SC; } else { sla[q] = 0; wa[q] = 0.f; }
            if (mb) { const int e = __builtin_ctz(mb); mb &= mb - 1; slb[q] = __builtin_amdgcn_readlane(inv, 16 + e); wb[q] = 1.f / Y8_SC; } else { slb[q] = 0; wb[q] = 0.f; } }
        f32x4 moa[4], mob[4];
#pragma unroll
        for (int j = 0; j < 4; ++j) { moa[j] = (f32x4){0.f, 0.f, 0.f, 0.f}; mob[j] = (f32x4){0.f, 0.f, 0.f, 0.f}; }
#pragma unroll
        for (int q = 0; q < 4; ++q)
#pragma unroll
            for (int j = 0; j < 4; ++j) { moa[j] += unpack4y(YS8 + (size_t)sla[q] * DM + 4 * lane + 256 * j) * wa[q]; mob[j] += unpack4y(YS8 + (size_t)slb[q] * DM + 4 * lane + 256 * j) * wb[q]; }
        while (ma) { const int e = __builtin_ctz(ma); ma &= ma - 1; const int sl = __builtin_amdgcn_readlane(inv, e);
#pragma unroll
            for (int j = 0; j < 4; ++j) moa[j] += unpack4y(YS8 + (size_t)sl * DM + 4 * lane + 256 * j) * (1.f / Y8_SC); }
        while (mb) { const int e = __builtin_ctz(mb); mb &= mb - 1; const int sl = __builtin_amdgcn_readlane(inv, 16 + e);
#pragma unroll
            for (int j = 0; j < 4; ++j) mob[j] += unpack4y(YS8 + (size_t)sl * DM + 4 * lane + 256 * j) * (1.f / Y8_SC); }
        f32x4 va[4], vb[4]; float sa = 0.f, sb = 0.f;
#pragma unroll
        for (int j = 0; j < 4; ++j) { const int col = 4 * lane + 256 * j; const f32x4 g2 = *(const f32x4*)(mod + 5120 + col);
            va[j] = unpack4(*(const v2u*)(XS + (size_t)row * DM + col)) * ALPHA + g2 * moa[j];
            vb[j] = unpack4(*(const v2u*)(XS + (size_t)(row + 1) * DM + col)) * ALPHA + g2 * mob[j];
            sa += (va[j].x + va[j].y) + (va[j].z + va[j].w); sb += (vb[j].x + vb[j].y) + (vb[j].z + vb[j].w); }
        const float meana = wave_sum(sa) * (1.f / DM), meanb = wave_sum(sb) * (1.f / DM); float qa = 0.f, qb = 0.f;
#pragma unroll
        for (int j = 0; j < 4; ++j) { va[j] = va[j] - meana; vb[j] = vb[j] - meanb;
            qa += (va[j].x * va[j].x + va[j].y * va[j].y) + (va[j].z * va[j].z + va[j].w * va[j].w); qb += (vb[j].x * vb[j].x + vb[j].y * vb[j].y) + (vb[j].z * vb[j].z + vb[j].w * vb[j].w); }
        const float rstda = __builtin_amdgcn_rsqf(wave_sum(qa) * (1.f / DM) + LN_EPS), rstdb = __builtin_amdgcn_rsqf(wave_sum(qb) * (1.f / DM) + LN_EPS);
#pragma unroll
        for (int j = 0; j < 4; ++j) { const int col = 4 * lane + 256 * j;
            const f32x4 g = Gv[j], bb = Bv[j];
            const f32x4 x2a = va[j] * rstda * g + bb, x2b = vb[j] * rstdb * g + bb;
            if (layer == 0) {
                if (row < LAT) {
                *(v2u*)(XS + (size_t)row * DM + col) = (v2u){pk2(x2a.x, x2a.y), pk2(x2a.z, x2a.w)};
                *(v2u*)(XS + (size_t)(row + 1) * DM + col) = (v2u){pk2(x2b.x, x2b.y), pk2(x2b.z, x2b.w)}; }
                const f32x4 sc = SCv[j] + 1.f, sh = SHv[j];
                const f32x4 ha = x2a * sc + sh, hb = x2b * sc + sh;
                *(v2u*)(HB + (size_t)row * DM + col) = (v2u){pk2(ha.x, ha.y), pk2(ha.z, ha.w)};
                *(v2u*)(HB + (size_t)(row + 1) * DM + col) = (v2u){pk2(hb.x, hb.y), pk2(hb.z, hb.w)};
            } else {
                *(f32x4*)(p.out + (size_t)row * DM + col) = x2a; *(f32x4*)(p.out + (size_t)(row + 1) * DM + col) = x2b;
            } }
    }
}

__device__ __forceinline__ void na_key(const float* q, float* o, float& m, float& l, const bf16* kp, const bf16* vp, float bias) {
    float s = bias;
#pragma unroll
    for (int i = 0; i < 8; ++i) { float f[8]; unpack8(*(const v4u*)(kp + 8 * i), f);
#pragma unroll
        for (int j = 0; j < 8; ++j) s += q[8 * i + j] * f[j]; }
    const float mn = fmaxf(m, s), al = exp2f(m - mn), pp = exp2f(s - mn);
    l = l * al + pp; m = mn;
#pragma unroll
    for (int i = 0; i < 8; ++i) { float f[8]; unpack8(*(const v4u*)(vp + 8 * i), f);
#pragma unroll
        for (int j = 0; j < 8; ++j) o[8 * i + j] = o[8 * i + j] * al + pp * f[j]; }
}
__device__ __forceinline__ void ph_mixer1_naive(const Params& p, const Ctx& c) {
    const bf16* P2 = (const bf16*)(p.ws + WS_QKV);
    bf16* CC = (bf16*)(p.ws + WS_CC);
    const float* rpb = p.in[I_RPB]; const float* pool_w = p.in[I_POOLW]; const float* pool_s = p.in[I_POOLS];
    LAS float* pl = (LAS float*)c.lds;
    for (int u = c.vcu; u < 256; u += c.G) {
        const int b = u >> 5, r = u & 31;
        {
            const int h = c.wave, col = c.lane, row = b * SEQ + r * 64 + col;
            const int rs = min(max(r - 4, 0), 24), cs = min(max(col - 8, 0), 48);
            float q[64], o[64];
#pragma unroll
            for (int i = 0; i < 8; ++i) unpack8(*(const v4u*)(P2 + (size_t)row * OIN + h * 64 + 8 * i), q + 8 * i);
#pragma unroll
            for (int i = 0; i < 64; ++i) o[i] = 0.f;
            float m = -1e30f, l = 0.f;
#pragma unroll 1
            for (int i = 0; i < 8; ++i)
#pragma unroll 1
                for (int j = 0; j < 16; ++j) {
                    const int krow = b * SEQ + (rs + i) * 64 + cs + j;
                    const float bias = rpb[(h * 15 + (rs + i - r + 7)) * 31 + (cs + j - col + 15)] * LOG2E;
                    na_key(q, o, m, l, P2 + (size_t)krow * OIN + 512 + h * 64, P2 + (size_t)krow * OIN + 1024 + h * 64, bias);
                }
#pragma unroll 1
            for (int j = 0; j < NCTX; ++j) {
                const int krow = LAT + b * NCTX + j;
                na_key(q, o, m, l, P2 + (size_t)krow * OIN + 512 + h * 64, P2 + (size_t)krow * OIN + 1024 + h * 64, 0.f);
            }
            const float rl = 1.f / l; bf16* dst = CC + (size_t)row * DM + h * 64;
#pragma unroll
            for (int i = 0; i < 8; ++i) *(v4u*)(dst + 8 * i) = (v4u){pk2(o[8 * i] * rl, o[8 * i + 1] * rl), pk2(o[8 * i + 2] * rl, o[8 * i + 3] * rl), pk2(o[8 * i + 4] * rl, o[8 * i + 5] * rl), pk2(o[8 * i + 6] * rl, o[8 * i + 7] * rl)};
        }
        __syncthreads();
        {
            const int ch = c.tid, g = ch >> 7, half = 1 << g;
            for (int tt = 0; tt < 64; ++tt) {
                const int t = r * 64 + tt, lo = max(t - half, 0), hi = min(t + half, SEQ);
                float s = 0.f;
                for (int t2 = lo; t2 < hi; ++t2) s += bf2f((unsigned)P2[(size_t)(b * SEQ + t2) * OIN + 1536 + ch]);
                pl[tt * 512 + ch] = s / (float)(hi - lo) - bf2f((unsigned)P2[(size_t)(b * SEQ + t) * OIN + 1536 + ch]);
            }
        }
        __syncthreads();
        {
            const int g = c.tid >> 7, e = c.tid & 127;
            const float ps = pool_s[g * 128 + e];
#pragma unroll 1
            for (int tb = 0; tb < 64; tb += 16) {
                float acc[16];
#pragma unroll
                for (int i = 0; i < 16; ++i) acc[i] = 0.f;
#pragma unroll 4
                for (int cc = 0; cc < 128; ++cc) {
                    const float w = pool_w[(size_t)(g * 128 + cc) * 128 + e];
#pragma unroll
                    for (int i = 0; i < 16; ++i) acc[i] += pl[(tb + i) * 512 + g * 128 + cc] * w;
                }
#pragma unroll
                for (int i = 0; i < 16; ++i) CC[(size_t)(b * SEQ + r * 64 + tb + i) * DM + 512 + g * 128 + e] = (bf16)f2bf(acc[i] * ps);
            }
        }
        __syncthreads();
    }
}


constexpr int NA_TAB_OFF = 86016 + 1024;
__device__ __forceinline__ void ph_mixer1_fast(const Params& p, const Ctx& c, char* lds_generic) {
    typedef attn_body::bf16 abf;
    const abf* P2a = (const abf*)(p.ws + WS_QKV); abf* CCa = (abf*)(p.ws + WS_CC);
    LAS float* tab = (LAS float*)(c.lds + NA_TAB_OFF);
    {   float tv[8];
#pragma unroll
        for (int k = 0; k < 8; ++k) { const int i = min(c.tid + 512 * k, 8 * 15 * 32 - 1), hd = i >> 5, j = min(i & 31, 30); tv[k] = p.in[I_RPB][hd * 31 + j]; }
#pragma unroll
        for (int k = 0; k < 8; ++k) { const int i = c.tid + 512 * k; if (i < 8 * 15 * 32) tab[i] = (i & 31) < 31 ? tv[k] * LOG2E : 0.f; } }
    __syncthreads();
    for (int it = 0;; ++it) {
        const int U = it * c.G + c.vcu;
        if (U >= 512) break;
        const int b = U >> 6, h = (U >> 3) & 7, rq = U & 7;
        const int rs_min = min(max(4 * rq - 4, 0), 24);
        const int nloc = (rq == 0 || rq == 7) ? 8 : 12;
        attn_body::AU u;
        u.qrow0 = b * SEQ + rq * 256; u.lat_row0 = LAT + b * NCTX; u.nlat_t = 4; u.ctx_row0 = b * SEQ + rs_min * 64; u.NT = 4 + nloc;
        u.Qp = P2a + h * 64; u.Kp = P2a + 512 + h * 64; u.Vp = P2a + 1024 + h * 64; u.Op = CCa + h * 64;
        const int r = 4 * rq + (c.wave >> 1), col = (c.wave & 1) * 32 + (c.lane & 31), hi = c.lane >> 5;
        const int cs = min(max(col - 8, 0), 48);
        attn_body::NAMask mk; mk.tb0 = (attn_body::lds_cfptr)(tab + h * 15 * 32 + 15 - col); mk.r = r; mk.rs = min(max(r - 4, 0), 24); mk.rs_min = rs_min; mk.cb = 4 * hi - cs;
        attn_body::attn_unit<8, OIN, attn_body::NAMask>(u, lds_generic, mk);
    }
    __syncthreads();
    const bf16* P2 = (const bf16*)(p.ws + WS_QKV); bf16* CC = (bf16*)(p.ws + WS_CC);
    const float* pool_w = p.in[I_POOLW]; const float* pool_s = p.in[I_POOLS];
    constexpr int PLP = 1040;
    for (int u = c.vcu; u < 256; u += c.G) {
        const int b = u >> 5, r = u & 31;
        {   const int ch = c.tid, g = c.wave >> 1;
            const bf16* du = P2 + (size_t)b * SEQ * OIN + 1536 + ch;
            const int t0 = r * 64;
            float v[80];
#pragma unroll
            for (int k = 0; k < 80; ++k) { const int t2 = t0 - 8 + k; v[k] = ((t2 >= 0 && t2 < SEQ) ? 1.f : 0.f) * bf2f((unsigned)du[(size_t)min(max(t2, 0), SEQ - 1) * OIN]); }
            LAS bf16* plc = (LAS bf16*)(c.lds) + ch;
#define POOL_COL(HALF) do { float ws = 0.f; _Pragma("unroll") for (int k = 8 - HALF; k < 8 + HALF; ++k) ws += v[k]; \
            _Pragma("unroll") for (int tt = 0; tt < 64; ++tt) { const int t = t0 + tt, lo = max(t - HALF, 0), hi = min(t + HALF, SEQ); \
                plc[tt * (PLP / 2)] = (bf16)f2bf(ws / (float)(hi - lo) - v[tt + 8]); ws += v[tt + 8 + HALF] - v[tt + 8 - HALF]; } } while (0)
            if (g == 0) POOL_COL(1); else if (g == 1) POOL_COL(2); else if (g == 2) POOL_COL(4); else POOL_COL(8);
#undef POOL_COL
        }
        __syncthreads();
        {   typedef short bf16x8v __attribute__((ext_vector_type(8)));
            const int g = c.wave >> 1, th = c.wave & 1, l31 = c.lane & 31, lh = c.lane >> 5;
            f32x16 acc[4];
#pragma unroll
            for (int et = 0; et < 4; ++et) acc[et] = (f32x16){};
#pragma unroll
            for (int ks = 0; ks < 8; ++ks) {
                const bf16x8v af = *(const LAS bf16x8v*)(c.lds + (32 * th + l31) * PLP + (g * 128 + 16 * ks + 8 * lh) * 2);
#pragma unroll
                for (int et = 0; et < 4; ++et) {
                    const bf16x8v bfr = *(const bf16x8v*)((const bf16*)(p.ws + WS_POOLB) + (size_t)((((g * 8 + ks) * 4 + et) * 64 + c.lane) * 8));
                    acc[et] = __builtin_amdgcn_mfma_f32_32x32x16_bf16(af, bfr, acc[et], 0, 0, 0);
                }
            }
#pragma unroll
            for (int et = 0; et < 4; ++et) { const int e = 32 * et + l31; const float ps = pool_s[g * 128 + e];
#pragma unroll
                for (int rg = 0; rg < 16; ++rg) { const int tok = 32 * th + (rg & 3) + 8 * (rg >> 2) + 4 * lh;
                    CC[(size_t)(b * SEQ + r * 64 + tok) * DM + 512 + g * 128 + e] = (bf16)f2bf(acc[et][rg] * ps); } }
        }
        __syncthreads();
    }
}

__global__ void __launch_bounds__(512, 2) mk_fwd(Params p_arg) {
    extern __shared__ __attribute__((aligned(16))) unsigned char lds_raw[];
    Ctx c;
    c.lds = (LAS unsigned char*)lds_raw;
    __builtin_amdgcn_s_setreg(1 | (23 << 6) | (0 << 11), 1);
    c.tid = threadIdx.x; c.lane = c.tid & 63; c.wave = __builtin_amdgcn_readfirstlane(c.tid >> 6);
    c.G = gridDim.x; { const int bx = blockIdx.x; c.vcu = (c.G % 8 == 0) ? (bx % 8) * (c.G / 8) + bx / 8 : bx; }
    c.gw = c.vcu * 8 + c.wave; c.NGW = c.G * 8;
    volatile LAS unsigned* MISC = (volatile LAS unsigned*)(c.lds + MISC_OFF);
    if (c.tid < 32) MISC[c.tid] = 0u;
    __syncthreads();
    typedef const __attribute__((address_space(4))) Params* KP;
    const KP kp0 = (KP)__builtin_amdgcn_kernarg_segment_ptr();
#define RELOAD_P() ({ KP kq_ = kp0; asm volatile("" : "+s"(kq_)); *(const Params*)kq_; })
    gu32* ctl = (gu32*)(p_arg.ws + WS_CTL);
    XcdBarrier bar; bar.bar = (unsigned*)(ctl + CW_BAR); bar.x = 0; bar.st = nullptr;
    if (!MK_MULTI) bar = xcd_barrier_post((unsigned*)(ctl + CW_BAR), MISC + 8);
    const int lo = p_arg.ph_lo, hi = p_arg.ph_hi;
    unsigned long long pt0 = 0, pt1 = 0; if (PROBE_PH == 0 || PROBE_PH >= 100) pt0 = __builtin_amdgcn_s_memrealtime();
#define IN(k) (lo <= (k) && (k) < hi)
#define SEAM(k) do { if (IN(k) && IN((k) + 1) && !(FAST_ATTN && (k) == 5) && !(FAST_GEMM && FUSE_QKV && (k) == 3)) xcd_barrier(bar); if ((k) + 1 == PROBE_PH) pt0 = __builtin_amdgcn_s_memrealtime(); if ((k) == PROBE_PH || (k) + 200 == PROBE_PH) pt1 = __builtin_amdgcn_s_memrealtime(); } while (0)

#define HB ((bf16*)(p.ws + WS_HB))
#define QKV ((bf16*)(p.ws + WS_QKV))
#define CC ((bf16*)(p.ws + WS_CC))
#define Y ((float*)(p.ws + WS_Y))
#define PF ((float*)(p.ws + WS_PF))
#define XG ((bf16*)(p.ws + WS_XG))
#define HID ((bf16*)(p.ws + WS_HID))
#define YS ((bf16*)(p.ws + WS_YS))
#define GATE ((const float*)(p.ws + WS_GATE))

    if (IN(0)) { const Params p = RELOAD_P(); ph_prologue(p, c); if (FAST_GEMM) { __syncthreads(); ph_transposes(p, c); } } SEAM(0);
    if (IN(1)) { const Params p = RELOAD_P(); ph_modulate0(p, c); } SEAM(1);
    if (IN(2)) { const Params p = RELOAD_P();
        const bool cv = TAIL_TRANSPOSE && c.G == 256; const int Gg = cv ? CV_G2 : c.G;
        if (FAST_GEMM && (int)blockIdx.x >= Gg) moe_transpose_blocks(p, c, CVB_P0, CVB_2, (int)blockIdx.x - Gg, c.G - Gg);
        else if (FAST_GEMM) { pg8::Gemm g{HB, (const bf16*)(p.ws + WS_W0IN), NTOK, EIN, DM, 0}; pg8::StaticOrder S; S.init(NTOK, EIN, Gg, (int)blockIdx.x, cv ? 3 : pg8::WGM);
            if (FUSE_QKV) { pg8::EpiQKV E{QKV, EIN, (const float*)(p.ws + WS_ROPE), p.in[I_QN], p.in[I_KN], C2, RMS_EPS}; pg8::gemm_phase<pg8::EpiQKV, pg8::StaticOrder, true, true>(c.lds, g, S, E); }
            else { pg8::EpiBf16<0> E{QKV, EIN, nullptr, 0, 0, 1.f}; pg8::gemm_phase<pg8::EpiBf16<0>, pg8::StaticOrder, true, true>(c.lds, g, S, E); }
            }
        else { NG g{HB, DM, p.in[I_W0IN], nullptr, EIN, 0, 1 << 30, 0, NTOK, 0, EIN, DM}; ngemm<1>(g, c, EpiF32{PF, EIN}); }
    } SEAM(2);
    if (!(FAST_GEMM && FUSE_QKV)) { if (IN(3)) { const Params p = RELOAD_P(); if (FAST_GEMM) ph_qkv_post<false>(p, c); else ph_qkv_post<true>(p, c); } } SEAM(3);
    if (IN(4)) { const Params p = RELOAD_P(); if (FAST_ATTN) ph_attn0_fast(p, c, (char*)lds_raw); else ph_attn0_naive(p, c); } SEAM(4);
    if (!FAST_ATTN) { if (IN(5)) { const Params p = RELOAD_P(); ph_attn_combine(p, c); } } SEAM(5);
    if (IN(6)) { const Params p = RELOAD_P();
        const bool cv = TAIL_TRANSPOSE && c.G == 256; const int Gg = cv ? CV_G6 : c.G;
        if (FAST_GEMM && (int)blockIdx.x >= Gg) moe_transpose_blocks(p, c, CVB_4, CVB_6, (int)blockIdx.x - Gg, c.G - Gg);
        else if (FAST_GEMM) { pg8::Gemm g{CC, (const bf16*)(p.ws + WS_W0OUT), NTOK, DM, DM, 0}; pg8::StaticOrder S; S.init(NTOK, DM, Gg, (int)blockIdx.x, cv ? 4 : pg8::WGM);
            pg8::EpiBf16<0> E{(bf16*)Y, DM, nullptr, 0, 0, 1.f}; pg8::gemm_phase<pg8::EpiBf16<0>, pg8::StaticOrder, true, true>(c.lds, g, S, E); }
        else { NG g{CC, DM, p.in[I_W0OUT], nullptr, DM, 0, 1 << 30, 0, NTOK, 0, DM, DM}; ngemm<1>(g, c, EpiBf{(bf16*)Y, DM, 0, 1.f}); }
    } SEAM(6);
    if (IN(7)) { const Params p = RELOAD_P(); ph_ln1_router(p, c, 0); } SEAM(7);
    if (IN(8)) { const Params p = RELOAD_P(); ph_topk(p, c, 0); if (TAIL_TRANSPOSE && c.G == 256 && c.vcu >= 128) moe_transpose_blocks(p, c, CVB_6, CVB_8, c.vcu - 128, 128); } SEAM(8);
    if (IN(9)) { const Params p = RELOAD_P();
        if (FAST_GEMM && MOE_FP8) { pg8::Gemm g{HB, (const bf16*)(p.ws + WS_WGU), NE * MR0, 4096, DM / 2, (size_t)4096 * DM, (const int*)(p.ws + WS_XG)}; pg8::GroupedOrder S; S.init(MR0 / 256, 16, NE, c.G, c.vcu);
            pg8::EpiSwigluF8 E{(unsigned char*)HID, FF, 1.f / W8_GU, H8_SC}; pg8::gemm_phase<pg8::EpiSwigluF8, pg8::GroupedOrder, true, true, true, true>(c.lds, g, S, E); }
        else if (FAST_GEMM) { pg8::Gemm g{XG, (const bf16*)(p.ws + WS_WGU), NE * MR0, 4096, DM, (size_t)4096 * DM * 2}; pg8::GroupedOrder S; S.init(MR0 / 256, 16, NE, c.G, c.vcu);
            pg8::EpiSwigluP E{HID, FF}; pg8::gemm_phase<pg8::EpiSwigluP, pg8::GroupedOrder, true, true>(c.lds, g, S, E); }
        else { NG g{XG, DM, p.in[I_WG], p.in[I_WU], FF, (size_t)DM * FF, MR0, 0, NE * MR0, 0, FF, DM}; ngemm<2>(g, c, EpiSwiglu{HID}); }
    } SEAM(9);
    { int t_ = threadIdx.x; asm volatile("" : "+v"(t_)); c.tid = t_; c.lane = t_ & 63; }
    if (IN(10)) { const Params p = RELOAD_P();
        const bool cv = TAIL_TRANSPOSE && c.G == 256; const int Gg = cv ? CV_G10 : c.G; const int bx = (int)blockIdx.x;
        if (FAST_GEMM && MOE_FP8 && bx >= Gg) moe_transpose_blocks(p, c, CVB_8, CVB_10, bx - Gg, c.G - Gg);
        else if (FAST_GEMM && MOE_FP8) { pg8::Gemm g{HID, (const bf16*)(p.ws + WS_WDN), NE * MR0, DM, FF / 2, (size_t)DM * FF}; pg8::GroupedOrder S; S.init(MR0 / 256, 4, NE, Gg, cv ? (bx % 8) * (Gg / 8) + bx / 8 : c.vcu);
            pg8::EpiGateS E{(unsigned char*)YS, DM, GATE, Y8_SC / (W8_DN * H8_SC)}; pg8::gemm_phase<pg8::EpiGateS, pg8::GroupedOrder, true, true, true>(c.lds, g, S, E);
            }
        else if (FAST_GEMM) { pg8::Gemm g{HID, (const bf16*)(p.ws + WS_WDN), NE * MR0, DM, FF, (size_t)DM * FF * 2}; pg8::GroupedOrder S; S.init(MR0 / 256, 4, NE, c.G, c.vcu);
            pg8::EpiGateP E{YS, DM, GATE}; pg8::gemm_phase<pg8::EpiGateP, pg8::GroupedOrder, true, true>(c.lds, g, S, E); }
        else { NG g{HID, FF, p.in[I_WD], nullptr, DM, (size_t)FF * DM, MR0, 0, NE * MR0, 0, DM, FF}; ngemm<1>(g, c, EpiGate{YS, GATE}); }
    } SEAM(10);
    if (IN(11)) { const Params p = RELOAD_P(); ph_combine(p, c, 0); } SEAM(11);
    { int t_ = threadIdx.x; asm volatile("" : "+v"(t_)); c.tid = t_; c.lane = t_ & 63; }
    if (IN(12)) { const Params p = RELOAD_P();
        const bool cv = TAIL_TRANSPOSE && c.G == 256; const int Gg = cv ? CV_G12 : c.G;
        if (FAST_GEMM && (int)blockIdx.x >= Gg) moe_transpose_blocks(p, c, CVB_10, CVB_12, (int)blockIdx.x - Gg, c.G - Gg);
        else if (FAST_GEMM) { pg8::Gemm g{HB, (const bf16*)(p.ws + WS_W1IN), NTOK, OIN, DM, 0}; pg8::L1InOrder S; S.init(Gg, (int)blockIdx.x);
            pg8::EpiBf16<0> E{QKV, OIN, nullptr, 512, 512, C2}; pg8::gemm_phase<pg8::EpiBf16<0>, pg8::L1InOrder, true, true>(c.lds, g, S, E);
            }
        else {
        NG g{HB, DM, p.in[I_W1IN], nullptr, OIN, 0, 1 << 30, 0, LAT, 0, OIN, DM}; ngemm<1>(g, c, EpiBf{QKV, OIN, 512, C2});
        NG g2{HB, DM, p.in[I_W1IN], nullptr, OIN, 0, 1 << 30, LAT, NTOK, 512, 1536, DM}; ngemm<1>(g2, c, EpiBf{QKV, OIN, 0, 1.f}); }
    } SEAM(12);
    { int t_ = threadIdx.x; asm volatile("" : "+v"(t_)); c.tid = t_; c.lane = t_ & 63; }
    if (IN(13)) { const Params p = RELOAD_P(); if (FAST_NA) ph_mixer1_fast(p, c, (char*)lds_raw); else ph_mixer1_naive(p, c); } SEAM(13);
    { int t_ = threadIdx.x; asm volatile("" : "+v"(t_)); c.tid = t_; c.lane = t_ & 63; }
    if (IN(14)) { const Params p = RELOAD_P();
        if (FAST_GEMM) { pg8::Gemm g{CC, (const bf16*)(p.ws + WS_W1OUT), LAT, DM, DM, 0}; pg8::StaticOrder S; S.init(LAT, DM, c.G, (int)blockIdx.x);
            pg8::EpiBf16<0> E{(bf16*)Y, DM, nullptr, 0, 0, 1.f}; pg8::gemm_phase<pg8::EpiBf16<0>, pg8::StaticOrder, true, true>(c.lds, g, S, E); }
        else { NG g{CC, DM, p.in[I_W1OUT], nullptr, DM, 0, 1 << 30, 0, LAT, 0, DM, DM}; ngemm<1>(g, c, EpiBf{(bf16*)Y, DM, 0, 1.f}); }
    } SEAM(14);
    { int t_ = threadIdx.x; asm volatile("" : "+v"(t_)); c.tid = t_; c.lane = t_ & 63; }
    if (IN(15)) { const Params p = RELOAD_P(); ph_ln1_router(p, c, 1); } SEAM(15);
    if (IN(16)) { const Params p = RELOAD_P(); ph_topk(p, c, 1); if (TAIL_TRANSPOSE && c.G == 256 && c.vcu >= 128) moe_transpose_blocks(p, c, CVB_12, CVB_16, c.vcu - 128, 128); } SEAM(16);
    if (IN(17)) { const Params p = RELOAD_P();
        if (FAST_GEMM && MOE_FP8) { pg8::Gemm g{HB, (const bf16*)(p.ws + WS_WGU + WS_MOE_LSTRIDE), NE * MR1, 4096, DM / 2, (size_t)4096 * DM, (const int*)(p.ws + WS_XG)}; pg8::GroupedOrder S; S.init(MR1 / 256, 16, NE, c.G, c.vcu);
            pg8::EpiSwigluF8 E{(unsigned char*)HID, FF, 1.f / W8_GU, H8_SC}; pg8::gemm_phase<pg8::EpiSwigluF8, pg8::GroupedOrder, true, true, true, true>(c.lds, g, S, E); }
        else if (FAST_GEMM) { pg8::Gemm g{XG, (const bf16*)(p.ws + WS_WGU + WS_MOE_LSTRIDE), NE * MR1, 4096, DM, (size_t)4096 * DM * 2}; pg8::GroupedOrder S; S.init(MR1 / 256, 16, NE, c.G, c.vcu);
            pg8::EpiSwigluP E{HID, FF}; pg8::gemm_phase<pg8::EpiSwigluP, pg8::GroupedOrder, true, true>(c.lds, g, S, E); }
        else { NG g{XG, DM, p.in[I_WG] + (size_t)NE * DM * FF, p.in[I_WU] + (size_t)NE * DM * FF, FF, (size_t)DM * FF, MR1, 0, NE * MR1, 0, FF, DM}; ngemm<2>(g, c, EpiSwiglu{HID}); }
    } SEAM(17);
    { int t_ = threadIdx.x; asm volatile("" : "+v"(t_)); c.tid = t_; c.lane = t_ & 63; }
    if (IN(18)) { const Params p = RELOAD_P();
        if (FAST_GEMM && MOE_FP8) { pg8::Gemm g{HID, (const bf16*)(p.ws + WS_WDN + WS_MOE_LSTRIDE), NE * MR1, DM, FF / 2, (size_t)DM * FF}; pg8::GroupedOrder S; S.init(MR1 / 256, 4, NE, c.G, c.vcu);
            pg8::EpiGateS E{(unsigned char*)YS, DM, GATE, Y8_SC / (W8_DN * H8_SC)}; pg8::gemm_phase<pg8::EpiGateS, pg8::GroupedOrder, true, true, true>(c.lds, g, S, E); }
        else if (FAST_GEMM) { pg8::Gemm g{HID, (const bf16*)(p.ws + WS_WDN + WS_MOE_LSTRIDE), NE * MR1, DM, FF, (size_t)DM * FF * 2}; pg8::GroupedOrder S; S.init(MR1 / 256, 4, NE, c.G, c.vcu);
            pg8::EpiGateP E{YS, DM, GATE}; pg8::gemm_phase<pg8::EpiGateP, pg8::GroupedOrder, true, true>(c.lds, g, S, E); }
        else { NG g{HID, FF, p.in[I_WD] + (size_t)NE * FF * DM, nullptr, DM, (size_t)FF * DM, MR1, 0, NE * MR1, 0, DM, FF}; ngemm<1>(g, c, EpiGate{YS, GATE}); }
    } SEAM(18);
    if (IN(19)) { const Params p = RELOAD_P(); ph_combine(p, c, 1); }
    if (PROBE_PH == 19 || PROBE_PH == 100) pt1 = __builtin_amdgcn_s_memrealtime();
    if (PROBE_PH >= 0 && blockIdx.x == 0 && c.tid == 0) { const unsigned long long te = __builtin_amdgcn_s_memrealtime(); while (__builtin_amdgcn_s_memrealtime() - te < pt1 - pt0) __builtin_amdgcn_s_sleep(8); }
#undef IN
#undef SEAM
#undef HB
#undef QKV
#undef CC
#undef Y
#undef PF
#undef XG
#undef HID
#undef YS
#undef GATE
#undef RELOAD_P
}

extern "C" void kernel_launch(void* const* d_in, const int* in_sizes, int n_in, void* d_out, int out_size, void* d_ws, size_t ws_size, hipStream_t stream) {
    static int grid = 0;
    if (grid == 0) {
        if (n_in != 26 || out_size != LAT * DM || ws_size < WS_END) { fprintf(stderr, "kernel_launch: unexpected shapes (n_in %d out %d ws %zu)\n", n_in, out_size, ws_size); grid = -1; return; }
        int dev = 0, cus = 0;
        if (hipGetDevice(&dev) != hipSuccess || hipDeviceGetAttribute(&cus, hipDeviceAttributeMultiprocessorCount, dev) != hipSuccess) { grid = -1; return; }
        if (hipFuncSetAttribute((const void*)mk_fwd, hipFuncAttributeMaxDynamicSharedMemorySize, LDS_BYTES) != hipSuccess) { fprintf(stderr, "kernel_launch: hipFuncSetAttribute failed\n"); grid = -1; return; }
        int per_cu = 0;
        if (hipOccupancyMaxActiveBlocksPerMultiprocessor(&per_cu, (const void*)mk_fwd, 512, LDS_BYTES) != hipSuccess || per_cu < 1) fprintf(stderr, "kernel_launch: occupancy query says %d\n", per_cu);
        (void)hipGetLastError();
        grid = cus;
    }
    if (grid < 0) return;
    (void)hipMemsetAsync((char*)d_ws + WS_CTL, 0, CTL_ZERO_BYTES, stream);
    Params a{};
    for (int i = 0; i < 26; ++i) a.in[i] = (const float*)d_in[i];
    a.out = (float*)d_out; a.ws = (unsigned char*)d_ws;
#if MK_MULTI
    for (int ph = 0; ph < NPHASE; ++ph) { a.ph_lo = ph; a.ph_hi = ph + 1; hipLaunchKernelGGL(mk_fwd, dim3(grid), dim3(512), LDS_BYTES, stream, a); }
#else
    a.ph_lo = 0; a.ph_hi = NPHASE;
    hipLaunchKernelGGL(mk_fwd, dim3(grid), dim3(512), LDS_BYTES, stream, a);
#endif
}
```
